# Optimizing an MI355X kernel written in HIP

```python
import math
import jax, jax.numpy as jnp
from jax import lax
import numpy as np

D_MODEL = 2048
BATCH = 8
SEQ = 2048
DEPTH = 4

CHUNK = 64
MIX_WIDTH = D_MODEL
GLA_WIDTH = D_MODEL // 2
GLA_HEADS = 4
GLA_KEY_WIDTH = GLA_WIDTH // 2
GLA_DK = GLA_KEY_WIDTH // GLA_HEADS
GLA_DV = GLA_WIDTH // GLA_HEADS
GLA_GATE_RANK = 16
GLA_GATE_TAU = 16.0
CONV_WIDTH = MIX_WIDTH - GLA_WIDTH
CONV_K = 3
IN_PROJ_WIDTH = 2 * GLA_KEY_WIDTH + 2 * GLA_WIDTH + GLA_GATE_RANK + 3 * CONV_WIDTH
PEER_HEADS = 8
N_KEYS = 128
N_EXPERTS = N_KEYS * N_KEYS
PEER_TOPK = 16
PEER_QDIM = 256
PEER_HALF = PEER_QDIM // 2
PEER_TOKEN_BLOCK = 128
DEEPNORM_ALPHA = (2.0 * DEPTH) ** 0.25
DEEPNORM_BETA = (8.0 * DEPTH) ** -0.25
EPS = 1e-5

kernel_name = "hybrid_gla_shortconv_peer_deepnorm_adaln"


def layer_norm(x, g, b):
    xf = x.astype(jnp.float32)
    mu = jnp.mean(xf, axis=-1, keepdims=True)
    var = jnp.mean(jnp.square(xf - mu), axis=-1, keepdims=True)
    y = (xf - mu) * lax.rsqrt(var + EPS) * g.astype(jnp.float32) + b.astype(jnp.float32)
    return y.astype(x.dtype)


def rms_norm(x, g):
    xf = x.astype(jnp.float32)
    y = xf * lax.rsqrt(jnp.mean(jnp.square(xf), axis=-1, keepdims=True) + EPS) * g.astype(jnp.float32)
    return y.astype(x.dtype)


def gla_chunk_state(q, k, v, a_lr, w_gate2, b_gate):
    bsz, seq, _ = q.shape
    nc = seq // CHUNK
    f32 = jnp.float32
    qf = q.astype(f32).reshape(bsz, nc, CHUNK, GLA_HEADS, GLA_DK) * (GLA_DK ** -0.5)
    kf = k.astype(f32).reshape(bsz, nc, CHUNK, GLA_HEADS, GLA_DK)
    vf = v.astype(f32).reshape(bsz, nc, CHUNK, GLA_HEADS, GLA_DV)
    gate_logit = jnp.einsum('bsr,rk->bsk', a_lr.astype(f32), w_gate2.astype(f32)) + b_gate.astype(f32)
    log_a = (jax.nn.log_sigmoid(gate_logit) / GLA_GATE_TAU).reshape(bsz, nc, CHUNK, GLA_HEADS, GLA_DK)
    cum = jnp.cumsum(log_a, axis=2)
    total = cum[:, :, -1]
    k_dec = kf * jnp.exp(total[:, :, None] - cum)

    def step(state, xs):
        dec, kc, vc, qc = xs
        state = jnp.exp(dec)[..., None] * state + jnp.einsum('blhk,blhv->bhkv', kc, vc)
        return state, jnp.einsum('blhk,bhkv->blhv', qc, state)

    xs = (jnp.moveaxis(total, 1, 0), jnp.moveaxis(k_dec, 1, 0),
          jnp.moveaxis(vf, 1, 0), jnp.moveaxis(qf, 1, 0))
    init = jnp.zeros((bsz, GLA_HEADS, GLA_DK, GLA_DV), f32)
    _, o = lax.scan(step, init, xs)
    return jnp.moveaxis(o, 0, 1).reshape(bsz, seq, GLA_HEADS, GLA_DV)


def token_mixer(h, w_in, w_gate2, b_gate, gla_norm_g, conv_w, conv_norm_g, w_out):
    bsz, seq, _ = h.shape
    proj = jnp.einsum('bsd,de->bse', h, w_in)
    widths = [GLA_KEY_WIDTH, GLA_KEY_WIDTH, GLA_WIDTH, GLA_WIDTH, GLA_GATE_RANK,
              CONV_WIDTH, CONV_WIDTH, CONV_WIDTH]
    split_at = np.cumsum(widths)[:-1].tolist()
    q, k, v, r, a_lr, cb, cc, ch = jnp.split(proj, split_at, axis=-1)

    o = gla_chunk_state(q, k, v, a_lr, w_gate2, b_gate).astype(h.dtype)
    o = rms_norm(o, gla_norm_g) * jax.nn.silu(r.reshape(bsz, seq, GLA_HEADS, GLA_DV))
    y_gla = o.reshape(bsz, seq, GLA_WIDTH)

    u = cc * ch
    up = jnp.pad(u, ((0, 0), (CONV_K - 1, 0), (0, 0)))
    conv = conv_w[0] * up[:, :-2] + conv_w[1] * up[:, 1:-1] + conv_w[2] * up[:, 2:]
    y_conv = rms_norm(cb * conv, conv_norm_g)

    y = jnp.concatenate([y_gla, y_conv], axis=-1)
    return jnp.einsum('bse,ed->bsd', y, w_out)


def peer_ffn(h, wq, keys, u_tab, v_tab):
    bsz, seq, dm = h.shape
    t = bsz * seq
    xt = h.reshape(t, dm)
    q = jnp.einsum('td,de->te', xt, wq).reshape(t, PEER_HEADS, 2, PEER_HALF)
    s = jnp.einsum('thpd,hpnd->thpn', q, keys).astype(jnp.float32)
    sv, si = lax.top_k(s, PEER_TOPK)
    cand = sv[:, :, 0, :, None] + sv[:, :, 1, None, :]
    cv, ci = lax.top_k(cand.reshape(t, PEER_HEADS, PEER_TOPK * PEER_TOPK), PEER_TOPK)
    e1 = jnp.take_along_axis(si[:, :, 0], ci // PEER_TOPK, axis=-1)
    e2 = jnp.take_along_axis(si[:, :, 1], ci % PEER_TOPK, axis=-1)
    experts = e1 * N_KEYS + e2
    gates = jax.nn.softmax(cv, axis=-1).astype(h.dtype)

    nb = t // PEER_TOKEN_BLOCK

    def block(args):
        xb, eb, gb = args
        a = jnp.einsum('thkd,td->thk', u_tab[eb], xb)
        return jnp.einsum('thk,thkd->td', gb * jax.nn.gelu(a), v_tab[eb])

    y = lax.map(block, (xt.reshape(nb, PEER_TOKEN_BLOCK, dm),
                        experts.reshape(nb, PEER_TOKEN_BLOCK, PEER_HEADS, PEER_TOPK),
                        gates.reshape(nb, PEER_TOKEN_BLOCK, PEER_HEADS, PEER_TOPK)))
    return y.reshape(bsz, seq, dm)


def setup_inputs(seed: int = 0) -> dict:
    key = jax.random.key(seed)
    ks = jax.random.split(key, 20)
    nrm = lambda k, shape, s: jax.random.normal(k, shape, jnp.float32) * s
    L, D = DEPTH, D_MODEL
    return {
        "x": nrm(ks[0], (BATCH, SEQ, D), 1.0),
        "c": nrm(ks[1], (BATCH, D), 1.0),
        "ada_w": nrm(ks[2], (L, D, 6 * D), 0.2 * D ** -0.5),
        "ada_b": nrm(ks[3], (L, 6 * D), 0.01),
        "w_in": nrm(ks[4], (L, D, IN_PROJ_WIDTH), D ** -0.5),
        "w_gate2": nrm(ks[5], (L, GLA_GATE_RANK, GLA_KEY_WIDTH), GLA_GATE_RANK ** -0.5),
        "b_gate": nrm(ks[6], (L, GLA_KEY_WIDTH), 0.1),
        "gla_norm_g": 1.0 + nrm(ks[7], (L, GLA_DV), 0.02),
        "conv_w": nrm(ks[8], (L, CONV_K, CONV_WIDTH), CONV_K ** -0.5),
        "conv_norm_g": 1.0 + nrm(ks[9], (L, CONV_WIDTH), 0.02),
        "w_out": nrm(ks[10], (L, MIX_WIDTH, D), DEEPNORM_BETA * MIX_WIDTH ** -0.5),
        "ln1_g": 1.0 + nrm(ks[11], (L, D), 0.02),
        "ln1_b": nrm(ks[12], (L, D), 0.02),
        "peer_wq": nrm(ks[13], (L, D, PEER_HEADS * PEER_QDIM), D ** -0.5),
        "peer_keys": nrm(ks[14], (L, PEER_HEADS, 2, N_KEYS, PEER_HALF), PEER_HALF ** -0.5),
        "peer_u": nrm(ks[15], (L, N_EXPERTS, D), D ** -0.5),
        "peer_v": nrm(ks[16], (L, N_EXPERTS, D), DEEPNORM_BETA * PEER_HEADS ** -0.5),
        "ln2_g": 1.0 + nrm(ks[17], (L, D), 0.02),
        "ln2_b": nrm(ks[18], (L, D), 0.02),
    }


def reference(x, c, ada_w, ada_b, w_in, w_gate2, b_gate, gla_norm_g, conv_w, conv_norm_g,
              w_out, ln1_g, ln1_b, peer_wq, peer_keys, peer_u, peer_v, ln2_g, ln2_b):
    c_act = jax.nn.silu(c)
    for l in range(DEPTH):
        mod = jnp.einsum('bd,de->be', c_act, ada_w[l]) + ada_b[l]
        sh1, sc1, g1, sh2, sc2, g2 = jnp.split(mod[:, None, :], 6, axis=-1)
        h = x * (1.0 + sc1) + sh1
        mix = token_mixer(h, w_in[l], w_gate2[l], b_gate[l], gla_norm_g[l], conv_w[l],
                          conv_norm_g[l], w_out[l])
        x = layer_norm(DEEPNORM_ALPHA * x + (1.0 + g1) * mix, ln1_g[l], ln1_b[l])
        h = x * (1.0 + sc2) + sh2
        ffn = peer_ffn(h, peer_wq[l], peer_keys[l], peer_u[l], peer_v[l])
        x = layer_norm(DEEPNORM_ALPHA * x + (1.0 + g2) * ffn, ln2_g[l], ln2_b[l])
    return x
```

```cpp
#include <hip/hip_runtime.h>
#include <stdint.h>

namespace {
constexpr int D = 2048, NB = 8, SEQ = 2048, NL = 4, T = NB * SEQ;
constexpr int CHUNK = 64, NCH = SEQ / CHUNK;
constexpr int GKW = 512, DK = 128, DV = 256, RANK = 16;
constexpr int INW = 6160, NP = 6144;
constexpr int PH = 8, NKEY = 128, NE = 16384, TOPK = 16;
constexpr float ALPHA = 1.6817928305074290f;
constexpr float EPS = 1e-5f;
constexpr int PQ = 0, PK = 512, PV = 1024, PR = 2048, PCB = 3072, PCC = 4096, PCH = 5120;

typedef uint16_t bf16_t;
__device__ __forceinline__ bf16_t f2bf(float f) { uint32_t u = __float_as_uint(f); u += 0x7fffu + ((u >> 16) & 1u); return (bf16_t)(u >> 16); }
__device__ __forceinline__ float bf2f(bf16_t b) { return __uint_as_float(((uint32_t)b) << 16); }
__device__ __forceinline__ float silu_f(float x) { return x / (1.0f + __expf(-x)); }
__device__ __forceinline__ float logsigmoid_f(float x) { return fminf(x, 0.0f) - log1pf(__expf(-fabsf(x))); }
__device__ __forceinline__ float gelu_tanh_f(float x) { const float u = 0.7978845608028654f * (x + 0.044715f * x * x * x); return 0.5f * x * (1.0f + tanhf(u)); }

__global__ void k_cvt_transpose(const float* __restrict__ src, bf16_t* __restrict__ dst, int K, int NS, int ND, int mode) {
    __shared__ float tile[64][65];
    const int n0 = blockIdx.x * 64, k0 = blockIdx.y * 64;
    const int tx = threadIdx.x & 63, ty = threadIdx.x >> 6;
    for (int r = ty; r < 64; r += 4) {
        const int nd = n0 + tx; float v = 0.f;
        if (nd < ND) { int ns = nd; if (mode == 1) ns = nd < 3072 ? nd : (nd < 6144 ? nd + 16 : 3072 + (nd - 6144)); v = src[(size_t)(k0 + r) * NS + ns]; }
        tile[r][tx] = v;
    }
    __syncthreads();
    for (int r = ty; r < 64; r += 4) { const int nd = n0 + r; if (nd < ND) dst[(size_t)nd * K + k0 + tx] = f2bf(tile[tx][r]); }
}
__global__ void k_cvt(const float* __restrict__ src, bf16_t* __restrict__ dst, size_t n4) {
    for (size_t i = (size_t)blockIdx.x * blockDim.x + threadIdx.x; i < n4; i += (size_t)gridDim.x * blockDim.x) {
        const float4 v = ((const float4*)src)[i]; uint2 o; o.x = (uint32_t)f2bf(v.x) | ((uint32_t)f2bf(v.y) << 16); o.y = (uint32_t)f2bf(v.z) | ((uint32_t)f2bf(v.w) << 16); ((uint2*)dst)[i] = o; }
}
__global__ void k_mod_partial(const float* __restrict__ c, const float* __restrict__ ada_w, float* __restrict__ partial) {
    __shared__ float ca[NB][128];
    const int e = blockIdx.x * 256 + threadIdx.x, dc = blockIdx.y, l = blockIdx.z;
    for (int i = threadIdx.x; i < NB * 128; i += 256) { const int b = i / 128, d = i % 128; ca[b][d] = silu_f(c[b * D + dc * 128 + d]); }
    __syncthreads();
    float acc[NB];
#pragma unroll
    for (int b = 0; b < NB; ++b) acc[b] = 0.f;
    const float* w = ada_w + ((size_t)l * D + dc * 128) * (6 * D) + e;
    for (int d = 0; d < 128; ++d) { const float wv = w[(size_t)d * (6 * D)];
#pragma unroll
        for (int b = 0; b < NB; ++b) acc[b] += ca[b][d] * wv; }
#pragma unroll
    for (int b = 0; b < NB; ++b) partial[(((size_t)l * 16 + dc) * NB + b) * (6 * D) + e] = acc[b];
}
__global__ void k_mod_reduce(const float* __restrict__ partial, const float* __restrict__ ada_b, float* __restrict__ mod) {
    const int i = blockIdx.x * 256 + threadIdx.x;
    if (i >= NL * NB * 6 * D) return;
    const int e = i % (6 * D), b = (i / (6 * D)) % NB, l = i / (6 * D * NB);
    float s = ada_b[l * 6 * D + e];
    for (int dc = 0; dc < 16; ++dc) s += partial[(((size_t)l * 16 + dc) * NB + b) * (6 * D) + e];
    mod[i] = s;
}
__global__ void k_modulate(const float* __restrict__ x, const float* __restrict__ modl, int sh_idx, int sc_idx, bf16_t* __restrict__ h) {
    const size_t i = (size_t)blockIdx.x * 256 + threadIdx.x;
    const int t = (int)(i / (D / 4)), d = (int)(i % (D / 4)) * 4, b = t / SEQ;
    const float4 xv = *(const float4*)(x + (size_t)t * D + d);
    const float4 sc = *(const float4*)(modl + (size_t)b * 6 * D + sc_idx * D + d), sh = *(const float4*)(modl + (size_t)b * 6 * D + sh_idx * D + d);
    uint2 o; o.x = (uint32_t)f2bf(xv.x * (1.f + sc.x) + sh.x) | ((uint32_t)f2bf(xv.y * (1.f + sc.y) + sh.y) << 16);
    o.y = (uint32_t)f2bf(xv.z * (1.f + sc.z) + sh.z) | ((uint32_t)f2bf(xv.w * (1.f + sc.w) + sh.w) << 16);
    *(uint2*)(h + (size_t)t * D + d) = o;
}
struct EpiStoreBf16 { bf16_t* O; int ldc; int pad; __device__ void operator()(int m, int n, float v) const { O[(size_t)m * ldc + n] = f2bf(v); } };
struct EpiStoreF32 { float* O; int ldc; int pad; __device__ void operator()(int m, int n, float v) const { O[(size_t)m * ldc + n] = v; } };
struct EpiResid { float* Z; const float* X; const float* modl; int g_idx; int pad; __device__ void operator()(int m, int n, float v) const { const int b = m / SEQ; Z[(size_t)m * D + n] = ALPHA * X[(size_t)m * D + n] + (1.f + modl[(size_t)b * 6 * D + g_idx * D + n]) * v; } };
template <class Epi>
__global__ void __launch_bounds__(256) k_gemm(const bf16_t* __restrict__ A, const bf16_t* __restrict__ Bt, int M, int N, int K, Epi epi) {
    __shared__ float As[32][68], Bs[32][68];
    const int m0 = blockIdx.y * 64, n0 = blockIdx.x * 64, tid = threadIdx.x, tx = tid & 15, ty = tid >> 4;
    const int lr = tid >> 2, lk = (tid & 3) * 8;
    float acc[4][4];
#pragma unroll
    for (int i = 0; i < 4; ++i)
#pragma unroll
        for (int j = 0; j < 4; ++j) acc[i][j] = 0.f;
    for (int k0 = 0; k0 < K; k0 += 32) {
        uint4 av = *(const uint4*)(A + (size_t)(m0 + lr) * K + k0 + lk);
        uint4 bv = make_uint4(0, 0, 0, 0); if (n0 + lr < N) bv = *(const uint4*)(Bt + (size_t)(n0 + lr) * K + k0 + lk);
        const uint32_t aw[4] = {av.x, av.y, av.z, av.w}, bw[4] = {bv.x, bv.y, bv.z, bv.w};
#pragma unroll
        for (int j = 0; j < 4; ++j) { As[lk + 2 * j][lr] = __uint_as_float(aw[j] << 16); As[lk + 2 * j + 1][lr] = __uint_as_float(aw[j] & 0xffff0000u);
            Bs[lk + 2 * j][lr] = __uint_as_float(bw[j] << 16); Bs[lk + 2 * j + 1][lr] = __uint_as_float(bw[j] & 0xffff0000u); }
        __syncthreads();
#pragma unroll 8
        for (int k = 0; k < 32; ++k) { const float4 a = *(const float4*)&As[k][ty * 4], b = *(const float4*)&Bs[k][tx * 4];
            const float aa[4] = {a.x, a.y, a.z, a.w}, bb[4] = {b.x, b.y, b.z, b.w};
#pragma unroll
            for (int i = 0; i < 4; ++i)
#pragma unroll
                for (int j = 0; j < 4; ++j) acc[i][j] += aa[i] * bb[j]; }
        __syncthreads();
    }
#pragma unroll
    for (int i = 0; i < 4; ++i)
#pragma unroll
        for (int j = 0; j < 4; ++j) { const int n = n0 + tx * 4 + j; if (n < N) epi(m0 + ty * 4 + i, n, acc[i][j]); }
}
__global__ void __launch_bounds__(256) k_gla(const bf16_t* __restrict__ proj, const float* __restrict__ alr, const float* __restrict__ wg2, const float* __restrict__ bg, float* __restrict__ ogla) {
    __shared__ float Sst[DK][33], kd[CHUNK][DK + 1], vv[CHUNK][33], tot[DK];
    const int dvs = blockIdx.x & 7, hh = (blockIdx.x >> 3) & 3, b = blockIdx.x >> 5, tid = threadIdx.x;
    for (int i = tid; i < DK * 32; i += 256) Sst[i / 32][i % 32] = 0.f;
    __syncthreads();
    for (int c = 0; c < NCH; ++c) {
        const int t0 = b * SEQ + c * CHUNK;
        for (int idx = tid; idx < CHUNK * DK; idx += 256) { const int j = idx / DK, dk = idx % DK, col = hh * DK + dk;
            float lg = bg[col];
#pragma unroll
            for (int r = 0; r < RANK; ++r) lg += alr[(size_t)(t0 + j) * RANK + r] * wg2[r * GKW + col];
            kd[j][dk] = logsigmoid_f(lg) * (1.0f / 16.0f); }
        __syncthreads();
        if (tid < DK) { float run = 0.f; for (int j = 0; j < CHUNK; ++j) { run += kd[j][tid]; kd[j][tid] = run; } tot[tid] = run; }
        __syncthreads();
        for (int idx = tid; idx < CHUNK * DK; idx += 256) { const int j = idx / DK, dk = idx % DK;
            kd[j][dk] = bf2f(proj[(size_t)(t0 + j) * NP + PK + hh * DK + dk]) * __expf(tot[dk] - kd[j][dk]); }
        for (int idx = tid; idx < CHUNK * 32; idx += 256) { const int j = idx / 32, i = idx % 32; vv[j][i] = bf2f(proj[(size_t)(t0 + j) * NP + PV + hh * DV + dvs * 32 + i]); }
        __syncthreads();
        for (int idx = tid; idx < DK * 32; idx += 256) { const int dk = idx / 32, i = idx % 32; float s = __expf(tot[dk]) * Sst[dk][i];
            for (int j = 0; j < CHUNK; ++j) s += kd[j][dk] * vv[j][i];
            Sst[dk][i] = s; }
        __syncthreads();
        for (int idx = tid; idx < CHUNK * 32; idx += 256) { const int j = idx / 32, i = idx % 32; float o = 0.f;
            const bf16_t* qrow = proj + (size_t)(t0 + j) * NP + PQ + hh * DK;
            for (int dk = 0; dk < DK; ++dk) o += bf2f(qrow[dk]) * Sst[dk][i];
            ogla[(size_t)(t0 + j) * 1024 + hh * DV + dvs * 32 + i] = o * 0.08838834764831845f; }
        __syncthreads();
    }
}
__global__ void __launch_bounds__(256) k_mixpost(const bf16_t* __restrict__ proj, const float* __restrict__ ogla, const float* __restrict__ gng, const float* __restrict__ cw, const float* __restrict__ cng, bf16_t* __restrict__ y) {
    __shared__ float red[4];
    const int t = blockIdx.x, tid = threadIdx.x, s = t % SEQ, c0 = tid * 4;
    const bf16_t* pr = proj + (size_t)t * NP;
    float o[4]; float ss = 0.f;
#pragma unroll
    for (int i = 0; i < 4; ++i) { o[i] = ogla[(size_t)t * 1024 + c0 + i]; ss += o[i] * o[i]; }
    for (int m = 32; m >= 1; m >>= 1) ss += __shfl_xor(ss, m);
    const float rg = rsqrtf(ss * (1.0f / DV) + EPS);
#pragma unroll
    for (int i = 0; i < 4; ++i) { const float r = bf2f(pr[PR + c0 + i]); y[(size_t)t * D + c0 + i] = f2bf(o[i] * rg * gng[(c0 + i) % DV] * silu_f(r)); }
    float val[4]; float s2 = 0.f;
#pragma unroll
    for (int i = 0; i < 4; ++i) { const int c = c0 + i;
        const float u0 = bf2f(pr[PCC + c]) * bf2f(pr[PCH + c]);
        const float u1 = s >= 1 ? bf2f(pr[PCC + c - NP]) * bf2f(pr[PCH + c - NP]) : 0.f;
        const float u2 = s >= 2 ? bf2f(pr[PCC + c - 2 * NP]) * bf2f(pr[PCH + c - 2 * NP]) : 0.f;
        const float cv = cw[c] * u2 + cw[1024 + c] * u1 + cw[2048 + c] * u0;
        val[i] = bf2f(pr[PCB + c]) * cv; s2 += val[i] * val[i]; }
    for (int m = 32; m >= 1; m >>= 1) s2 += __shfl_xor(s2, m);
    if ((tid & 63) == 0) red[tid >> 6] = s2;
    __syncthreads();
    const float rc = rsqrtf((red[0] + red[1] + red[2] + red[3]) * (1.0f / 1024.f) + EPS);
#pragma unroll
    for (int i = 0; i < 4; ++i) y[(size_t)t * D + 1024 + c0 + i] = f2bf(val[i] * rc * cng[c0 + i]);
}
__device__ __forceinline__ void ln_row_store(const float (&z)[8], int t, int tid, float* red, const float* g, const float* bta, float* xout, float* xout2, const float* modn, int sh_idx, int sc_idx, bf16_t* hout) {
    float s = 0.f;
#pragma unroll
    for (int i = 0; i < 8; ++i) s += z[i];
    for (int m = 32; m >= 1; m >>= 1) s += __shfl_xor(s, m);
    if ((tid & 63) == 0) red[tid >> 6] = s;
    __syncthreads();
    const float mu = (red[0] + red[1] + red[2] + red[3]) * (1.0f / D);
    float q = 0.f;
#pragma unroll
    for (int i = 0; i < 8; ++i) { const float d = z[i] - mu; q += d * d; }
    for (int m = 32; m >= 1; m >>= 1) q += __shfl_xor(q, m);
    if ((tid & 63) == 0) red[4 + (tid >> 6)] = q;
    __syncthreads();
    const float rs = rsqrtf((red[4] + red[5] + red[6] + red[7]) * (1.0f / D) + EPS);
    const int b = t / SEQ, d0 = tid * 8;
#pragma unroll
    for (int i = 0; i < 8; ++i) { const int d = d0 + i; const float xv = (z[i] - mu) * rs * g[d] + bta[d];
        if (xout) xout[(size_t)t * D + d] = xv;
        if (xout2) xout2[(size_t)t * D + d] = xv;
        if (hout) hout[(size_t)t * D + d] = f2bf(xv * (1.f + modn[(size_t)b * 6 * D + sc_idx * D + d]) + modn[(size_t)b * 6 * D + sh_idx * D + d]); }
}
__global__ void __launch_bounds__(256) k_ln(const float* __restrict__ z, const float* __restrict__ g, const float* __restrict__ bta, float* __restrict__ xout, const float* __restrict__ modn, int sh_idx, int sc_idx, bf16_t* __restrict__ hout) {
    __shared__ float red[8];
    const int t = blockIdx.x, tid = threadIdx.x;
    float zz[8];
#pragma unroll
    for (int i = 0; i < 8; ++i) zz[i] = z[(size_t)t * D + tid * 8 + i];
    ln_row_store(zz, t, tid, red, g, bta, xout, nullptr, modn, sh_idx, sc_idx, hout);
}
__device__ __forceinline__ unsigned long long okey(float v, unsigned idx) { unsigned u = __float_as_uint(v); u = (u & 0x80000000u) ? ~u : (u | 0x80000000u); return ((unsigned long long)u << 32) | (unsigned long long)(0xffffffffu - idx); }
__device__ __forceinline__ unsigned long long wave_max64(unsigned long long k) {
    for (int m = 32; m >= 1; m >>= 1) { const unsigned lo = __shfl_xor((unsigned)k, m), hi = __shfl_xor((unsigned)(k >> 32), m); const unsigned long long o = ((unsigned long long)hi << 32) | lo; k = o > k ? o : k; }
    return k;
}
__global__ void __launch_bounds__(256) k_topk(const bf16_t* __restrict__ q, const float* __restrict__ keys, int* __restrict__ experts, float* __restrict__ gates) {
    __shared__ float qs[256], sv[2][TOPK], cvs[TOPK];
    __shared__ int si[2][TOPK], ce[TOPK];
    __shared__ unsigned long long wk[4];
    const int t = blockIdx.x >> 3, h = blockIdx.x & 7, tid = threadIdx.x, p = tid >> 7, n = tid & 127, wv = tid >> 6;
    qs[tid] = bf2f(q[(size_t)t * D + h * 256 + tid]);
    __syncthreads();
    const float* kr = keys + (((size_t)h * 2 + p) * NKEY + n) * 128;
    float sc = 0.f;
    for (int d = 0; d < 128; ++d) sc += qs[p * 128 + d] * kr[d];
    bool taken = false;
    for (int r = 0; r < TOPK; ++r) {
        unsigned long long k = taken ? 0ull : okey(sc, (unsigned)n);
        k = wave_max64(k);
        if ((tid & 63) == 0) wk[wv] = k;
        __syncthreads();
        const unsigned long long best = wk[2 * p] > wk[2 * p + 1] ? wk[2 * p] : wk[2 * p + 1];
        const unsigned bi = 0xffffffffu - (unsigned)best;
        if ((unsigned)n == bi) { taken = true; sv[p][r] = sc; si[p][r] = n; }
        __syncthreads();
    }
    const float cv = sv[0][tid >> 4] + sv[1][tid & 15];
    taken = false;
    for (int r = 0; r < TOPK; ++r) {
        unsigned long long k = taken ? 0ull : okey(cv, (unsigned)tid);
        k = wave_max64(k);
        if ((tid & 63) == 0) wk[wv] = k;
        __syncthreads();
        unsigned long long best = wk[0]; if (wk[1] > best) best = wk[1]; if (wk[2] > best) best = wk[2]; if (wk[3] > best) best = wk[3];
        const unsigned bi = 0xffffffffu - (unsigned)best;
        if ((unsigned)tid == bi) { taken = true; cvs[r] = cv; ce[r] = si[0][tid >> 4] * NKEY + si[1][tid & 15]; }
        __syncthreads();
    }
    if (tid < TOPK) { float den = 0.f; for (int r = 0; r < TOPK; ++r) den += __expf(cvs[r] - cvs[0]);
        experts[(size_t)t * 128 + h * TOPK + tid] = ce[tid]; gates[(size_t)t * 128 + h * TOPK + tid] = __expf(cvs[tid] - cvs[0]) / den; }
}
__global__ void __launch_bounds__(256) k_peer(const bf16_t* h2, const float* __restrict__ x1, const int* __restrict__ experts, const float* __restrict__ gates,
                                              const bf16_t* __restrict__ ut, const bf16_t* __restrict__ vt, const float* __restrict__ modl, const float* __restrict__ g, const float* __restrict__ bta,
                                              float* xout, float* xout2, const float* __restrict__ modn, bf16_t* hout) {
    __shared__ float wts[128]; __shared__ int eid[128]; __shared__ float red[8];
    const int t = blockIdx.x, tid = threadIdx.x, lane = tid & 63, wv = tid >> 6;
    if (tid < 128) eid[tid] = experts[(size_t)t * 128 + tid];
    float hv[32];
#pragma unroll
    for (int c = 0; c < 4; ++c) { const uint4 v = *(const uint4*)(h2 + (size_t)t * D + (c * 64 + lane) * 8); const uint32_t w[4] = {v.x, v.y, v.z, v.w};
#pragma unroll
        for (int j = 0; j < 4; ++j) { hv[c * 8 + 2 * j] = __uint_as_float(w[j] << 16); hv[c * 8 + 2 * j + 1] = __uint_as_float(w[j] & 0xffff0000u); } }
    __syncthreads();
    for (int i = 0; i < 32; ++i) { const int ei = wv * 32 + i; const bf16_t* row = ut + (size_t)eid[ei] * D; float a = 0.f;
#pragma unroll
        for (int c = 0; c < 4; ++c) { const uint4 v = *(const uint4*)(row + (c * 64 + lane) * 8); const uint32_t w[4] = {v.x, v.y, v.z, v.w};
#pragma unroll
            for (int j = 0; j < 4; ++j) { a += hv[c * 8 + 2 * j] * __uint_as_float(w[j] << 16); a += hv[c * 8 + 2 * j + 1] * __uint_as_float(w[j] & 0xffff0000u); } }
        for (int m = 32; m >= 1; m >>= 1) a += __shfl_xor(a, m);
        if (lane == 0) wts[ei] = gates[(size_t)t * 128 + ei] * gelu_tanh_f(a); }
    __syncthreads();
    float acc[8];
#pragma unroll
    for (int i = 0; i < 8; ++i) acc[i] = 0.f;
    for (int ei = 0; ei < 128; ++ei) { const float w = wts[ei]; const uint4 v = *(const uint4*)(vt + (size_t)eid[ei] * D + tid * 8); const uint32_t vw[4] = {v.x, v.y, v.z, v.w};
#pragma unroll
        for (int j = 0; j < 4; ++j) { acc[2 * j] += w * __uint_as_float(vw[j] << 16); acc[2 * j + 1] += w * __uint_as_float(vw[j] & 0xffff0000u); } }
    const int b = t / SEQ;
    float zz[8];
#pragma unroll
    for (int i = 0; i < 8; ++i) { const int d = tid * 8 + i; zz[i] = ALPHA * x1[(size_t)t * D + d] + (1.f + modl[(size_t)b * 6 * D + 5 * D + d]) * acc[i]; }
    ln_row_store(zz, t, tid, red, g, bta, xout, xout2, modn, 0, 1, hout);
}
}

extern "C" void kernel_launch(void* const* d_in, const int* in_sizes, int n_in, void* d_out, int out_size, void* d_ws, size_t ws_size, hipStream_t stream) {
    const float* x_in = (const float*)d_in[0]; const float* c_in = (const float*)d_in[1]; const float* ada_w = (const float*)d_in[2]; const float* ada_b = (const float*)d_in[3];
    const float* w_in = (const float*)d_in[4]; const float* w_gate2 = (const float*)d_in[5]; const float* b_gate = (const float*)d_in[6]; const float* gla_norm_g = (const float*)d_in[7];
    const float* conv_w = (const float*)d_in[8]; const float* conv_norm_g = (const float*)d_in[9]; const float* w_out = (const float*)d_in[10]; const float* ln1_g = (const float*)d_in[11];
    const float* ln1_b = (const float*)d_in[12]; const float* peer_wq = (const float*)d_in[13]; const float* peer_keys = (const float*)d_in[14]; const float* peer_u = (const float*)d_in[15];
    const float* peer_v = (const float*)d_in[16]; const float* ln2_g = (const float*)d_in[17]; const float* ln2_b = (const float*)d_in[18];
    float* out = (float*)d_out;
    char* wp = (char*)d_ws; size_t off = 0;
    auto take = [&](size_t bytes) { char* p = wp + off; off += (bytes + 255) & ~(size_t)255; return p; };
    bf16_t* utab = (bf16_t*)take((size_t)NL * NE * D * 2); bf16_t* vtab = (bf16_t*)take((size_t)NL * NE * D * 2);
    bf16_t* winT = (bf16_t*)take((size_t)NL * INW * D * 2); bf16_t* woutT = (bf16_t*)take((size_t)NL * D * D * 2); bf16_t* wqT = (bf16_t*)take((size_t)NL * D * D * 2);
    float* partial = (float*)take((size_t)NL * 16 * NB * 6 * D * 4); float* mod = (float*)take((size_t)NL * NB * 6 * D * 4);
    bf16_t* hbuf = (bf16_t*)take((size_t)T * D * 2); bf16_t* proj = (bf16_t*)take((size_t)T * NP * 2); float* alr = (float*)take((size_t)T * RANK * 4);
    float* ogla = (float*)take((size_t)T * 1024 * 4); bf16_t* ybuf = (bf16_t*)take((size_t)T * D * 2); float* zbuf = (float*)take((size_t)T * D * 4);
    float* x1buf = (float*)take((size_t)T * D * 4); float* xbuf = (float*)take((size_t)T * D * 4); bf16_t* qbuf = (bf16_t*)take((size_t)T * D * 2);
    int* experts = (int*)take((size_t)T * 128 * 4); float* gates = (float*)take((size_t)T * 128 * 4);
    (void)ws_size; (void)in_sizes; (void)n_in; (void)out_size;

    k_cvt<<<2048, 256, 0, stream>>>(peer_u, utab, (size_t)NL * NE * D / 4);
    k_cvt<<<2048, 256, 0, stream>>>(peer_v, vtab, (size_t)NL * NE * D / 4);
    for (int l = 0; l < NL; ++l) {
        k_cvt_transpose<<<dim3((INW + 63) / 64, D / 64), 256, 0, stream>>>(w_in + (size_t)l * D * INW, winT + (size_t)l * INW * D, D, INW, INW, 1);
        k_cvt_transpose<<<dim3(D / 64, D / 64), 256, 0, stream>>>(w_out + (size_t)l * D * D, woutT + (size_t)l * D * D, D, D, D, 0);
        k_cvt_transpose<<<dim3(D / 64, D / 64), 256, 0, stream>>>(peer_wq + (size_t)l * D * D, wqT + (size_t)l * D * D, D, D, D, 0);
    }
    k_mod_partial<<<dim3(6 * D / 256, 16, NL), 256, 0, stream>>>(c_in, ada_w, partial);
    k_mod_reduce<<<(NL * NB * 6 * D + 255) / 256, 256, 0, stream>>>(partial, ada_b, mod);
    k_modulate<<<T * D / 4 / 256, 256, 0, stream>>>(x_in, mod, 0, 1, hbuf);

    const float* xcur = x_in;
    for (int l = 0; l < NL; ++l) {
        const float* modl = mod + (size_t)l * NB * 6 * D;
        const float* modn = mod + (size_t)(l + 1 < NL ? l + 1 : l) * NB * 6 * D;
        const bf16_t* wl = winT + (size_t)l * INW * D;
        k_gemm<<<dim3(NP / 64, T / 64), 256, 0, stream>>>(hbuf, wl, T, NP, D, EpiStoreBf16{proj, NP, 0});
        k_gemm<<<dim3(1, T / 64), 256, 0, stream>>>(hbuf, wl + (size_t)NP * D, T, RANK, D, EpiStoreF32{alr, RANK, 0});
        k_gla<<<NB * 4 * 8, 256, 0, stream>>>(proj, alr, w_gate2 + (size_t)l * RANK * GKW, b_gate + (size_t)l * GKW, ogla);
        k_mixpost<<<T, 256, 0, stream>>>(proj, ogla, gla_norm_g + (size_t)l * DV, conv_w + (size_t)l * 3 * 1024, conv_norm_g + (size_t)l * 1024, ybuf);
        k_gemm<<<dim3(D / 64, T / 64), 256, 0, stream>>>(ybuf, woutT + (size_t)l * D * D, T, D, D, EpiResid{zbuf, xcur, modl, 2, 0});
        k_ln<<<T, 256, 0, stream>>>(zbuf, ln1_g + (size_t)l * D, ln1_b + (size_t)l * D, x1buf, modl, 3, 4, hbuf);
        k_gemm<<<dim3(D / 64, T / 64), 256, 0, stream>>>(hbuf, wqT + (size_t)l * D * D, T, D, D, EpiStoreBf16{qbuf, D, 0});
        k_topk<<<T * PH, 256, 0, stream>>>(qbuf, peer_keys + (size_t)l * PH * 2 * NKEY * 128, experts, gates);
        const bool last = (l == NL - 1);
        k_peer<<<T, 256, 0, stream>>>(hbuf, x1buf, experts, gates, utab + (size_t)l * NE * D, vtab + (size_t)l * NE * D, modl, ln2_g + (size_t)l * D, ln2_b + (size_t)l * D,
                                      last ? out : xbuf, nullptr, modn, last ? nullptr : hbuf);
        xcur = xbuf;
    }
}
```

```cpp
#include <hip/hip_runtime.h>
#include <cstdio>
#include <cstdint>
namespace pg8 {
#define PG8_LAS __attribute__((address_space(3)))
typedef unsigned short bf16_t;
typedef short bf16x8 __attribute__((ext_vector_type(8)));
typedef float f32x4 __attribute__((ext_vector_type(4)));
typedef unsigned u32x4 __attribute__((ext_vector_type(4)));
constexpr int BM = 256, BK = 64, HALF = 128, HTB = HALF * BK * 2  , STAGE_BYTES = 8 * HTB, NXCD = 8, WGM = 8;

__host__ __device__ __forceinline__ int lds_byte(int r, int c) { const int st = (r >> 4) * 2 + (c >> 5), rr = r & 15, cc = c & 31, ob = rr * 64 + cc * 2; return st * 1024 + (ob ^ (((ob >> 9) & 1) << 5)); }
__host__ __device__ __forceinline__ void stage_rc(int b, int& R, int& C) { const int st = b / 1024, sb = b % 1024, swz = sb ^ (((sb >> 9) & 1) << 5); R = (st >> 1) * 16 + swz / 64; C = (st & 1) * 32 + (swz % 64) / 2; }
__host__ __device__ __forceinline__ int perm32(int rho) { const int n = rho >> 4, i = rho & 15; return 8 * (i >> 2) + 4 * n + (i & 3); }

struct Unit { int pm, pn; };
struct Gemm { const bf16_t* A; const bf16_t* Bt; int M, N, K; };

struct StaticOrder {
    int nM, nN, nwg, G, c;
    __host__ __device__ void init(int M, int N, int G_, int c_) { nM = M / BM; nN = N / BM; nwg = nM * nN; G = G_; c = c_; }
    __host__ __device__ bool next(int i, Unit& u) const {
        const long L = (long)i * G + c; if (L >= nwg) return false;
        int wgid = (int)L; { const int q = nwg / NXCD, r = nwg % NXCD, xcd = wgid % NXCD, off = wgid / NXCD; wgid = (xcd < r ? xcd * (q + 1) : r * (q + 1) + (xcd - r) * q) + off; }
        const int nig = WGM * nN, gid = wgid / nig, fm = gid * WGM, gsz = (nM - fm) < WGM ? (nM - fm) : WGM;
        u.pm = fm + ((wgid % nig) % gsz); u.pn = (wgid % nig) / gsz; return true;
    }
    __device__ __forceinline__ void a_ready(const Unit&) const {}
    __device__ __forceinline__ void done(const Unit&) const {}
};
typedef __bf16 bf16x2_t __attribute__((ext_vector_type(2)));
__device__ __forceinline__ unsigned cvt_pk_bf16(float lo, float hi) { bf16x2_t r; r.x = (__bf16)lo; r.y = (__bf16)hi; return __builtin_bit_cast(unsigned, r); }
struct EpiBf16P {
    static constexpr bool PERM = true, AFTER_DRAIN = false;
    bf16_t* O; int ldc;
    __device__ __forceinline__ void operator()(const f32x4 (&acc)[2][2][4][2], const Unit& u, int wr, int wc, int fr, int fq) const {
        const int row0 = u.pm * BM + wr * 64 + fr, col0 = u.pn * BM + wc * 32 + 8 * fq;
#pragma unroll
        for (int ai = 0; ai < 2; ++ai)
#pragma unroll
            for (int m = 0; m < 4; ++m) { bf16_t* rowp = O + (size_t)(row0 + ai * HALF + m * 16) * ldc + col0;
#pragma unroll
                for (int bj = 0; bj < 2; ++bj) { const f32x4 v0 = acc[ai][bj][m][0], v1 = acc[ai][bj][m][1];
                    u32x4 w; w.x = cvt_pk_bf16(v0[0], v0[1]); w.y = cvt_pk_bf16(v0[2], v0[3]); w.z = cvt_pk_bf16(v1[0], v1[1]); w.w = cvt_pk_bf16(v1[2], v1[3]);
                    *(u32x4*)(rowp + bj * HALF) = w; } }
    }
};
struct EpiResid {
    static constexpr bool PERM = false, AFTER_DRAIN = false;
    float* Z; const float* X; const float* gate; float alpha;
    __device__ __forceinline__ void operator()(const f32x4 (&acc)[2][2][4][2], const Unit& u, int wr, int wc, int fr, int fq) const {
        const int row0 = u.pm * BM + wr * 64 + fr, col0 = u.pn * BM + wc * 32 + 4 * fq;
        const float* gb = gate + (size_t)(u.pm >> 3) * (6 * 2048) + col0;
        f32x4 gv[2][2];
#pragma unroll
        for (int bj = 0; bj < 2; ++bj)
#pragma unroll
            for (int n = 0; n < 2; ++n) gv[bj][n] = *(const f32x4*)(gb + bj * HALF + n * 16) + 1.0f;
#pragma unroll
        for (int ai = 0; ai < 2; ++ai)
#pragma unroll
            for (int m = 0; m < 4; ++m) { const size_t off = (size_t)(row0 + ai * HALF + m * 16) * 2048 + col0;
#pragma unroll
                for (int bj = 0; bj < 2; ++bj)
#pragma unroll
                    for (int n = 0; n < 2; ++n) { const f32x4 xv = *(const f32x4*)(X + off + bj * HALF + n * 16);
                        *(f32x4*)(Z + off + bj * HALF + n * 16) = xv * alpha + gv[bj][n] * acc[ai][bj][m][n]; }
                asm volatile("" ::: "memory"); }
    }
};
template <class Epi, class Sched, bool ALIGN_EPI = false, bool SP2 = false>
__device__ __forceinline__ void gemm_phase(PG8_LAS unsigned char* lds, const Gemm g, const Sched& S, const Epi& E, const int tid_in) {
    const int tid = tid_in, wid = __builtin_amdgcn_readfirstlane(tid >> 6), lane = tid & 63, wr = wid >> 2, wc = wid & 3, fr = lane & 15, fq = lane >> 4;
    const int K = g.K, nt = K / BK;
    unsigned voffA[2], voffB[2];
#pragma unroll
    for (int i = 0; i < 2; ++i) { int R, C; stage_rc(tid * 16 + i * 8192, R, C); const int Rb = Epi::PERM ? ((R & ~31) + perm32(R & 31)) : R;
        voffA[i] = (unsigned)(R * K + C) * 2u; voffB[i] = (unsigned)(Rb * K + C) * 2u; }
    const size_t kstep = (size_t)(BK * 2);
    const size_t hstep = (size_t)HALF * K * 2;
    const size_t tstep = 2 * hstep;
    const unsigned ldsw = (unsigned)wid * 1024u;
    const int aoff = lds_byte(wr * 64 + fr, fq * 8), boff = lds_byte(wc * 32 + fr, fq * 8);
#define PG8_SA(b, h) (((b) * 2 + (h)) * HTB)
#define PG8_SB(b, h) ((4 + (b) * 2 + (h)) * HTB)
#define PG8_STAGE(bufoff, gbase, voff) do { _Pragma("unroll") for (int _i = 0; _i < 2; ++_i) \
        __builtin_amdgcn_global_load_lds((const unsigned*)((const char*)(gbase) + (voff)[_i]), (PG8_LAS unsigned*)(lds + (bufoff) + ldsw + _i * 8192), 16, 0, 0); } while (0)
#define PG8_LDA(dst, b, h) do { _Pragma("unroll") for (int m = 0; m < 4; ++m) _Pragma("unroll") for (int k = 0; k < 2; ++k) dst[m][k] = *(const PG8_LAS bf16x8*)(lds + PG8_SA(b, h) + aoff + m * 2048 + k * 1024); } while (0)
#define PG8_LDB(dst, b, h) do { _Pragma("unroll") for (int n = 0; n < 2; ++n) _Pragma("unroll") for (int k = 0; k < 2; ++k) dst[n][k] = *(const PG8_LAS bf16x8*)(lds + PG8_SB(b, h) + boff + n * 2048 + k * 1024); } while (0)
#define PG8_MMA(ai, bj, At, Bt) do { __builtin_amdgcn_s_setprio(1); _Pragma("unroll") for (int m = 0; m < 4; ++m) _Pragma("unroll") for (int n = 0; n < 2; ++n) _Pragma("unroll") for (int k = 0; k < 2; ++k) \
        acc[ai][bj][m][n] = __builtin_amdgcn_mfma_f32_16x16x32_bf16(Bt[n][k], At[m][k], acc[ai][bj][m][n], 0, 0, 0); __builtin_amdgcn_s_setprio(0); } while (0)
#define PG8_WAIT_V(n) asm volatile("s_waitcnt vmcnt(" #n ")" ::: "memory")
#define PG8_WAIT_L(n) asm volatile("s_waitcnt lgkmcnt(" #n ")" ::: "memory")
#define PG8_BAR __builtin_amdgcn_s_barrier()
#define PG8_SCHED __builtin_amdgcn_sched_barrier(0)
    Unit cur, nxt; int ui = 0;
    if (!S.next(0, cur)) return;
    f32x4 acc[2][2][4][2];
#pragma unroll
    for (int a = 0; a < 2; ++a)
#pragma unroll
        for (int b = 0; b < 2; ++b)
#pragma unroll
            for (int m = 0; m < 4; ++m)
#pragma unroll
                for (int n = 0; n < 2; ++n) acc[a][b][m][n] = (f32x4){0.f, 0.f, 0.f, 0.f};
    bf16x8 At[4][2], B0[2][2], B1[2][2];
    const char* cA = (const char*)g.A + (size_t)cur.pm * tstep; const char* cB = (const char*)g.Bt + (size_t)cur.pn * tstep;
    S.a_ready(cur);
    if constexpr (SP2) {
        PG8_STAGE(PG8_SB(0, 0), cB, voffB); PG8_STAGE(PG8_SB(0, 1), cB + hstep, voffB); PG8_STAGE(PG8_SA(0, 0), cA, voffA); PG8_STAGE(PG8_SA(0, 1), cA + hstep, voffA);
        if (wr == 1) PG8_BAR;
        PG8_WAIT_V(2); PG8_BAR;
        PG8_STAGE(PG8_SB(1, 0), cB + kstep, voffB); PG8_STAGE(PG8_SA(1, 0), cA + kstep, voffA); PG8_STAGE(PG8_SB(1, 1), cB + hstep + kstep, voffB);
        PG8_WAIT_V(6); PG8_BAR;
    } else {
        PG8_STAGE(PG8_SB(0, 0), cB, voffB); PG8_STAGE(PG8_SA(0, 0), cA, voffA); PG8_STAGE(PG8_SB(0, 1), cB + hstep, voffB); PG8_STAGE(PG8_SA(0, 1), cA + hstep, voffA);
        if (wr == 1) PG8_BAR;
        PG8_WAIT_V(4); PG8_BAR;
        PG8_STAGE(PG8_SB(1, 0), cB + kstep, voffB); PG8_STAGE(PG8_SA(1, 0), cA + kstep, voffA); PG8_STAGE(PG8_SB(1, 1), cB + hstep + kstep, voffB);
        PG8_WAIT_V(6); PG8_BAR;
    }
    for (;;) {
        const bool has_next = S.next(ui + 1, nxt);
        const char* nA = has_next ? (const char*)g.A + (size_t)nxt.pm * tstep : cA; const char* nB = has_next ? (const char*)g.Bt + (size_t)nxt.pn * tstep : cB;
        for (int t = 0; t < nt; t += 2) {
            const bool last = (t == nt - 2);
            const char* a1 = cA + (size_t)(t + 1) * kstep;
            const char* a2 = last ? nA : cA + (size_t)(t + 2) * kstep; const char* b2 = last ? nB : cB + (size_t)(t + 2) * kstep;
            const char* a3 = a2 + kstep; const char* b3 = b2 + kstep;
            if (last && has_next) S.a_ready(nxt);
            if constexpr (SP2) {
            PG8_LDB(B0, 0, 0); PG8_LDB(B1, 0, 1); PG8_SCHED; PG8_LDA(At, 0, 0); PG8_STAGE(PG8_SA(1, 1), a1 + hstep, voffA);
            PG8_WAIT_V(8); PG8_WAIT_L(0); PG8_BAR; PG8_MMA(0, 0, At, B0); PG8_MMA(0, 1, At, B1); PG8_BAR; PG8_SCHED;
            PG8_LDA(At, 0, 1); PG8_STAGE(PG8_SB(0, 0), b2, voffB); PG8_STAGE(PG8_SB(0, 1), b2 + hstep, voffB); PG8_STAGE(PG8_SA(0, 0), a2, voffA);
            PG8_WAIT_V(8); PG8_WAIT_L(0); PG8_BAR; PG8_MMA(1, 0, At, B0); PG8_MMA(1, 1, At, B1); PG8_BAR; PG8_SCHED;
            PG8_LDB(B0, 1, 0); PG8_LDB(B1, 1, 1); PG8_SCHED; PG8_LDA(At, 1, 0); PG8_STAGE(PG8_SA(0, 1), a2 + hstep, voffA);
            PG8_WAIT_V(8); PG8_WAIT_L(0); PG8_BAR; PG8_MMA(0, 0, At, B0); PG8_MMA(0, 1, At, B1); PG8_BAR; PG8_SCHED;
            PG8_LDA(At, 1, 1); PG8_STAGE(PG8_SB(1, 0), b3, voffB); PG8_STAGE(PG8_SB(1, 1), b3 + hstep, voffB); PG8_STAGE(PG8_SA(1, 0), a3, voffA);
            PG8_WAIT_V(8); PG8_WAIT_L(0); PG8_BAR; PG8_MMA(1, 0, At, B0); PG8_MMA(1, 1, At, B1); PG8_BAR; PG8_SCHED;
            } else {
            PG8_LDB(B0, 0, 0); PG8_SCHED; PG8_LDA(At, 0, 0); PG8_STAGE(PG8_SA(1, 1), a1 + hstep, voffA);
            PG8_WAIT_L(8); PG8_BAR; PG8_WAIT_L(0); PG8_MMA(0, 0, At, B0); PG8_BAR; PG8_SCHED;
            PG8_LDB(B1, 0, 1); PG8_STAGE(PG8_SB(0, 0), b2, voffB);
            PG8_BAR; PG8_WAIT_L(0); PG8_MMA(0, 1, At, B1); PG8_BAR;
            PG8_LDA(At, 0, 1); PG8_STAGE(PG8_SA(0, 0), a2, voffA);
            PG8_BAR; PG8_WAIT_L(0); PG8_MMA(1, 0, At, B0); PG8_BAR; PG8_SCHED;
            PG8_STAGE(PG8_SB(0, 1), b2 + hstep, voffB);
            PG8_WAIT_V(6); PG8_BAR; PG8_MMA(1, 1, At, B1); PG8_BAR;
            PG8_LDB(B0, 1, 0); PG8_SCHED; PG8_LDA(At, 1, 0); PG8_STAGE(PG8_SA(0, 1), a2 + hstep, voffA);
            PG8_WAIT_L(8); PG8_BAR; PG8_WAIT_L(0); PG8_MMA(0, 0, At, B0); PG8_BAR; PG8_SCHED;
            PG8_LDB(B1, 1, 1); PG8_STAGE(PG8_SB(1, 0), b3, voffB);
            PG8_BAR; PG8_WAIT_L(0); PG8_MMA(0, 1, At, B1); PG8_BAR;
            PG8_LDA(At, 1, 1); PG8_STAGE(PG8_SA(1, 0), a3, voffA);
            PG8_BAR; PG8_WAIT_L(0); PG8_MMA(1, 0, At, B0); PG8_BAR; PG8_SCHED;
            PG8_STAGE(PG8_SB(1, 1), b3 + hstep, voffB);
            PG8_WAIT_V(6); PG8_BAR; PG8_MMA(1, 1, At, B1); PG8_BAR;
            }
        }
        if constexpr (ALIGN_EPI) { if (wr == 0) PG8_BAR; }
        if constexpr (!Epi::AFTER_DRAIN) { E(acc, cur, wr, wc, fr, fq); S.done(cur); }
        if (!has_next) break;
#pragma unroll
        for (int a = 0; a < 2; ++a)
#pragma unroll
            for (int b = 0; b < 2; ++b)
#pragma unroll
                for (int m = 0; m < 4; ++m)
#pragma unroll
                    for (int n = 0; n < 2; ++n) acc[a][b][m][n] = (f32x4){0.f, 0.f, 0.f, 0.f};
        cur = nxt; cA = nA; cB = nB; ++ui;
        if constexpr (ALIGN_EPI) { if (wr == 1) PG8_BAR; }
    }
    PG8_WAIT_V(0);
    if constexpr (!ALIGN_EPI) { if (wr == 0) PG8_BAR; }
    PG8_BAR;
    if constexpr (Epi::AFTER_DRAIN) { E.fused(acc, cur, wr, wc, fr, fq, lds, wid, lane); S.done(cur); }
#undef PG8_SA
#undef PG8_SB
#undef PG8_STAGE
#undef PG8_LDA
#undef PG8_LDB
#undef PG8_MMA
#undef PG8_WAIT_V
#undef PG8_WAIT_L
#undef PG8_BAR
#undef PG8_SCHED
}
}
#define XB_TMO      128
#define XB_XCNT(j)  (256  + 64 * (j))
#define XB_XSUB(j)  (1280 + 64 * (j))
#define XB_XGEN(j)  (2304 + 64 * (j))
#define XB_TOP      3328
#define XB_TOPGEN   3392
#define XCD_BAR_WORDS 3456
#define XB_SPIN_CAP (1u << 18)
#define LAS __attribute__((address_space(3)))

__device__ __forceinline__ unsigned xb_ld(unsigned* p)              { return __hip_atomic_load(p, __ATOMIC_RELAXED, __HIP_MEMORY_SCOPE_AGENT); }
__device__ __forceinline__ unsigned xb_add(unsigned* p, unsigned v) { return __hip_atomic_fetch_add(p, v, __ATOMIC_RELAXED, __HIP_MEMORY_SCOPE_AGENT); }
__device__ __forceinline__ unsigned xb_xcc_id() { return (unsigned)__builtin_amdgcn_s_getreg((3 << 11) | 20) & 0xFu; }
#define XB_SPIN(cond, bar) do { unsigned _sp = 0; while (cond) { __builtin_amdgcn_s_sleep(1); \
    if ((++_sp & 255u) == 0u) { if (xb_ld(&(bar)[XB_TMO])) break; if (_sp > XB_SPIN_CAP) { atomicAdd(&(bar)[XB_TMO], 1u); break; } } } } while (0)

struct XcdBarrier {
    unsigned* bar; unsigned x;
    volatile LAS unsigned* st;
};

__device__ __forceinline__ XcdBarrier xcd_barrier_post(unsigned* bar, volatile LAS unsigned* st) {
    XcdBarrier b; b.bar = bar; b.x = xb_xcc_id(); b.st = st;
    if (threadIdx.x == 0) (void)xb_add(&bar[XB_XCNT(b.x)], 1u);
    return b;
}
__device__ __forceinline__ void xcd_barrier_complete(unsigned* bar, unsigned x, unsigned& nloc, unsigned& nx) {
    const unsigned G = gridDim.x * gridDim.y * gridDim.z;
    unsigned sum, cnt, mine, sp = 0u;
    for (;;) {
        sum = 0u; cnt = 0u; mine = 0u;
#pragma unroll
        for (unsigned j = 0; j < 16; ++j) { const unsigned c = xb_ld(&bar[XB_XCNT(j)]); sum += c; cnt += (c > 0u) ? 1u : 0u; mine = (j == x) ? c : mine; }
        if (sum == G) break;
        __builtin_amdgcn_s_sleep(1);
        if ((++sp & 255u) == 0u) { if (xb_ld(&bar[XB_TMO])) break; if (sp > XB_SPIN_CAP) { atomicAdd(&bar[XB_TMO], 1u); break; } }
    }
    nloc = mine > 0u ? mine : 1u; nx = cnt > 0u ? cnt : 1u;
}

__device__ __forceinline__ void xcd_barrier(const XcdBarrier& b) {
    asm volatile("s_waitcnt vmcnt(0)" ::: "memory");
    __syncthreads();
    if (threadIdx.x == 0) {
        unsigned* bar = b.bar;
        __builtin_amdgcn_s_waitcnt(0);
        unsigned nloc = b.st[0], nx = b.st[1];
        if (nloc == 0u) { xcd_barrier_complete(bar, b.x, nloc, nx); b.st[0] = nloc; b.st[1] = nx; }
        const unsigned old = xb_add(&bar[XB_XSUB(b.x)], 1u);
        const unsigned gen = old / nloc;
        if (old + 1u == (gen + 1u) * nloc) {
            __builtin_amdgcn_fence(__ATOMIC_RELEASE, "agent");
            asm volatile("s_waitcnt vmcnt(0)" ::: "memory");
            const unsigned og = xb_add(&bar[XB_TOP], 1u);
            const unsigned tg = og / nx;
            if (og + 1u == (tg + 1u) * nx) xb_add(&bar[XB_TOPGEN], 1u);
            else XB_SPIN(xb_ld(&bar[XB_TOPGEN]) == tg, bar);
            __builtin_amdgcn_fence(__ATOMIC_ACQUIRE, "agent");
            xb_add(&bar[XB_XGEN(b.x)], 1u);
            asm volatile("s_waitcnt vmcnt(0)" ::: "memory");
        } else {
            XB_SPIN(xb_ld(&bar[XB_XGEN(b.x)]) == gen, bar);
            __builtin_amdgcn_fence(__ATOMIC_ACQUIRE, "agent");
            asm volatile("s_waitcnt vmcnt(0)" ::: "memory");
        }
    }
    __syncthreads();
}
constexpr int D = 2048, NB = 8, SEQ = 2048, NL = 4, T = NB * SEQ;
constexpr int NCH = SEQ / 64, NCHUNK = T / 64;
constexpr int GKW = 512, RANK = 16;
constexpr int INW = 6160, NP = 6144;
constexpr int NE = 16384;
constexpr float ALPHA = 1.6817928305074290f, EPS = 1e-5f;
constexpr int PQ = 0, PK = 512, PV = 1024, PR = 2048, PCB = 3072, PCC = 4096, PCH = 5120;
constexpr int NWAVES = 8, NTHREADS = 512;
constexpr int NPHASES = 2 + 7 * NL;

constexpr size_t MiB = 1u << 20;
constexpr size_t WS_CTL = 0, CTL_ZERO_BYTES = 1 * MiB;
constexpr size_t WS_MOD = 1 * MiB, WS_PART = 3 * MiB, WS_KEYS = 15 * MiB, WS_DTOT = 17 * MiB, WS_WIN = 18 * MiB, WS_WOUT = 115 * MiB, WS_WQ = 147 * MiB;
constexpr size_t WS_UT = 179 * MiB, WS_VT = 435 * MiB, WS_H = 691 * MiB, WS_PROJ = 755 * MiB, WS_E = 947 * MiB, WS_OGLA = 979 * MiB, WS_Y = 1043 * MiB;
constexpr size_t WS_Z = 1107 * MiB, WS_X1 = 1235 * MiB, WS_X = 1363 * MiB, WS_Q = 1491 * MiB, WS_END = 1555 * MiB;
static_assert(WS_WIN + (size_t)NL * INW * D * 2 <= WS_WOUT && WS_PART + (size_t)NL * 8 * NB * 6 * D * 4 <= WS_KEYS && WS_MOD + (size_t)NL * NB * 6 * D * 4 <= WS_PART, "ws map");
constexpr int CW_BAR = 4096;

constexpr int RING_OFF = 0, RING_BYTES = 131072, LDSCTL_OFF = RING_BYTES, LDS_BYTES = 147456;

#define GAS __attribute__((address_space(1)))
typedef unsigned short bf16;
typedef unsigned v4u __attribute__((ext_vector_type(4)));
typedef unsigned v2u __attribute__((ext_vector_type(2)));
typedef float f32x4 __attribute__((ext_vector_type(4)));
typedef float f32x16 __attribute__((ext_vector_type(16)));
typedef short bf16x8 __attribute__((ext_vector_type(8)));
typedef __bf16 bf16x2v __attribute__((ext_vector_type(2)));
#define LDS_WAIT() asm volatile("s_waitcnt lgkmcnt(0)" ::: "memory")

__device__ __forceinline__ unsigned pk2(float lo, float hi) { return pg8::cvt_pk_bf16(lo, hi); }
__device__ __forceinline__ float dot2bf(unsigned w, unsigned x, float acc) { return __builtin_amdgcn_fdot2_f32_bf16(__builtin_bit_cast(bf16x2v, w), __builtin_bit_cast(bf16x2v, x), acc, false); }
__device__ __forceinline__ float bflo(unsigned u) { return __uint_as_float(u << 16); }
__device__ __forceinline__ float bfhi(unsigned u) { return __uint_as_float(u & 0xffff0000u); }
__device__ __forceinline__ float silu_f(float x) { return x / (1.0f + __expf(-x)); }
__device__ __forceinline__ float logsigmoid_f(float x) { return fminf(x, 0.0f) - log1pf(__expf(-fabsf(x))); }
__device__ __forceinline__ float gelu_tanh_f(float x) { const float u = 0.7978845608028654f * (x + 0.044715f * x * x * x); return 0.5f * x * (1.0f + tanhf(u)); }
__device__ __forceinline__ float wave_sum(float v) {
#pragma unroll
    for (int o = 1; o < 64; o <<= 1) v += __shfl_xor(v, o);
    return v;
}

struct Args { const float* in[19]; float* out; unsigned char* ws; int ph_lo, ph_hi; };

__device__ __forceinline__ void transpose_item(const float* W, int ldw, int col0, bf16* WTrows, int k0, int nvalid, LAS float* scr, int lane) {
    const int n = lane & 31;
#pragma unroll 8
    for (int i = 0; i < 32; ++i) { const int kk = 2 * i + (lane >> 5); scr[kk * 33 + n] = (n < nvalid) ? W[(size_t)(k0 + kk) * ldw + col0 + n] : 0.f; }
    LDS_WAIT(); asm volatile("" ::: "memory");
    const int c = lane & 7;
#pragma unroll
    for (int j = 0; j < 4; ++j) { const int nn = (lane >> 3) + 8 * j; const LAS float* s = scr + (8 * c) * 33 + nn;
        v4u o; o.x = pk2(s[0 * 33], s[1 * 33]); o.y = pk2(s[2 * 33], s[3 * 33]); o.z = pk2(s[4 * 33], s[5 * 33]); o.w = pk2(s[6 * 33], s[7 * 33]);
        if (nn < nvalid) *(v4u*)(WTrows + (size_t)nn * D + k0 + 8 * c) = o; }
    LDS_WAIT(); asm volatile("" ::: "memory");
}
__device__ __forceinline__ void cvt_stream(const float* src, bf16* dst, size_t n4, size_t i0, size_t stride) {
    for (size_t i = i0; i < n4; i += stride) { const f32x4 v = ((const f32x4*)src)[i]; v2u o; o.x = pk2(v.x, v.y); o.y = pk2(v.z, v.w); ((v2u*)dst)[i] = o; }
}
__device__ __forceinline__ void ph_prologue_a(const Args& a, LAS unsigned char* lds, int tid, int lane, int wave, int bx, int G) {
    const int gw = bx * NWAVES + wave, NGW = G * NWAVES;
    LAS float* cact = (LAS float*)lds;
    for (int i = tid; i < NB * D; i += NTHREADS) { const int b = i / D, d = i % D; cact[d * 8 + b] = silu_f(a.in[1][i]); }
    __syncthreads();
    float* part = (float*)(a.ws + WS_PART);
    for (int it = gw; it < NL * 8 * 48; it += NGW) {
        const int cg = it % 48, dr = (it / 48) % 8, l = it / 384;
        f32x4 acc[8];
#pragma unroll
        for (int b = 0; b < 8; ++b) acc[b] = (f32x4){0.f, 0.f, 0.f, 0.f};
        const float* w = a.in[2] + ((size_t)l * D + dr * 256) * (6 * D) + cg * 256 + lane * 4;
#pragma unroll 4
        for (int d = 0; d < 256; ++d) {
            const f32x4 wv = *(const f32x4*)(w + (size_t)d * (6 * D));
            const f32x4 c0 = *(const LAS f32x4*)(cact + (dr * 256 + d) * 8), c1 = *(const LAS f32x4*)(cact + (dr * 256 + d) * 8 + 4);
            acc[0] += wv * c0.x; acc[1] += wv * c0.y; acc[2] += wv * c0.z; acc[3] += wv * c0.w;
            acc[4] += wv * c1.x; acc[5] += wv * c1.y; acc[6] += wv * c1.z; acc[7] += wv * c1.w;
        }
#pragma unroll
        for (int b = 0; b < 8; ++b) *(f32x4*)(part + (((size_t)l * 8 + dr) * NB + b) * (6 * D) + cg * 256 + lane * 4) = acc[b];
    }
    __syncthreads();
    LAS float* scr = (LAS float*)(lds + wave * 8448);
    bf16* winT = (bf16*)(a.ws + WS_WIN); bf16* woutT = (bf16*)(a.ws + WS_WOUT); bf16* wqT = (bf16*)(a.ws + WS_WQ);
    constexpr int IPL = 6144 + 32 + 2048 + 2048;
    for (int it = gw; it < NL * IPL; it += NGW) {
        const int l = it / IPL; int r = it % IPL;
        if (r < 6144) { const int nb = r % 192, kb = r / 192, n0 = nb * 32;
            transpose_item(a.in[4] + (size_t)l * D * INW, INW, n0 < 3072 ? n0 : n0 + 16, winT + ((size_t)l * INW + n0) * D, kb * 64, 32, scr, lane); continue; }
        r -= 6144;
        if (r < 32) { transpose_item(a.in[4] + (size_t)l * D * INW, INW, 3072, winT + ((size_t)l * INW + NP) * D, r * 64, 16, scr, lane); continue; }
        r -= 32;
        if (r < 2048) { const int nb = r % 64, kb = r / 64; transpose_item(a.in[10] + (size_t)l * D * D, D, nb * 32, woutT + ((size_t)l * D + nb * 32) * D, kb * 64, 32, scr, lane); continue; }
        r -= 2048;
        { const int nb = r % 64, kb = r / 64; transpose_item(a.in[13] + (size_t)l * D * D, D, nb * 32, wqT + ((size_t)l * D + nb * 32) * D, kb * 64, 32, scr, lane); }
    }
    const size_t i0 = (size_t)bx * NTHREADS + tid, stride = (size_t)G * NTHREADS;
    cvt_stream(a.in[14], (bf16*)(a.ws + WS_KEYS), (size_t)NL * 8 * 2 * 128 * 128 / 4, i0, stride);
    cvt_stream(a.in[15], (bf16*)(a.ws + WS_UT), (size_t)NL * NE * D / 4, i0, stride);
    cvt_stream(a.in[16], (bf16*)(a.ws + WS_VT), (size_t)NL * NE * D / 4, i0, stride);
}

__device__ __forceinline__ void ln_tail(const float (&z)[32], int t, int lane, const float* g, const float* bta, float* xout, const float* sh, const float* sc, bf16* hout) {
    float s = 0.f;
#pragma unroll
    for (int i = 0; i < 32; ++i) s += z[i];
    const float mu = wave_sum(s) * (1.0f / D);
    float q = 0.f;
#pragma unroll
    for (int i = 0; i < 32; ++i) { const float d = z[i] - mu; q += d * d; }
    const float rs = rsqrtf(wave_sum(q) * (1.0f / D) + EPS);
#pragma unroll
    for (int c = 0; c < 4; ++c) { const int col = (c * 64 + lane) * 8;
        const f32x4 g0 = *(const f32x4*)(g + col), g1 = *(const f32x4*)(g + col + 4), b0 = *(const f32x4*)(bta + col), b1 = *(const f32x4*)(bta + col + 4);
        f32x4 x0, x1;
        x0.x = (z[c * 8 + 0] - mu) * rs * g0.x + b0.x; x0.y = (z[c * 8 + 1] - mu) * rs * g0.y + b0.y; x0.z = (z[c * 8 + 2] - mu) * rs * g0.z + b0.z; x0.w = (z[c * 8 + 3] - mu) * rs * g0.w + b0.w;
        x1.x = (z[c * 8 + 4] - mu) * rs * g1.x + b1.x; x1.y = (z[c * 8 + 5] - mu) * rs * g1.y + b1.y; x1.z = (z[c * 8 + 6] - mu) * rs * g1.z + b1.z; x1.w = (z[c * 8 + 7] - mu) * rs * g1.w + b1.w;
        if (xout) { *(f32x4*)(xout + (size_t)t * D + col) = x0; *(f32x4*)(xout + (size_t)t * D + col + 4) = x1; }
        if (hout) { const f32x4 s0 = *(const f32x4*)(sc + col), s1 = *(const f32x4*)(sc + col + 4), h0 = *(const f32x4*)(sh + col), h1 = *(const f32x4*)(sh + col + 4);
            v4u o; o.x = pk2(x0.x * (1.f + s0.x) + h0.x, x0.y * (1.f + s0.y) + h0.y); o.y = pk2(x0.z * (1.f + s0.z) + h0.z, x0.w * (1.f + s0.w) + h0.w);
            o.z = pk2(x1.x * (1.f + s1.x) + h1.x, x1.y * (1.f + s1.y) + h1.y); o.w = pk2(x1.z * (1.f + s1.z) + h1.z, x1.w * (1.f + s1.w) + h1.w);
            *(v4u*)(hout + (size_t)t * D + col) = o; }
    }
}

__device__ __forceinline__ void ph_prologue_b(const Args& a, LAS unsigned char* lds, int tid, int lane, int wave, int bx, int G) {
    const float* part = (const float*)(a.ws + WS_PART); float* mod = (float*)(a.ws + WS_MOD);
    for (int i = bx * NTHREADS + tid; i < NL * NB * 6 * D / 4; i += G * NTHREADS) {
        const int idx = i * 4, e = idx % (6 * D), b = (idx / (6 * D)) % NB, l = idx / (6 * D * NB);
        f32x4 s = *(const f32x4*)(a.in[3] + l * 6 * D + e);
#pragma unroll
        for (int dr = 0; dr < 8; ++dr) s += *(const f32x4*)(part + (((size_t)l * 8 + dr) * NB + b) * (6 * D) + e);
        *(f32x4*)(mod + idx) = s;
    }
    LAS float* msh = (LAS float*)lds;
    bf16* hbuf = (bf16*)(a.ws + WS_H);
    for (int ch = bx; ch < NCHUNK; ch += G) {
        const int b = ch / NCH;
        for (int i = tid; i < 1024; i += NTHREADS) { const int e = i * 4;
            f32x4 s = *(const f32x4*)(a.in[3] + e);
#pragma unroll
            for (int dr = 0; dr < 8; ++dr) s += *(const f32x4*)(part + (((size_t)0 * 8 + dr) * NB + b) * (6 * D) + e);
            *(LAS f32x4*)(msh + e) = s; }
        __syncthreads();
        for (int i = 0; i < 8; ++i) { const int t = ch * 64 + wave * 8 + i;
#pragma unroll
            for (int c = 0; c < 4; ++c) { const int col = (c * 64 + lane) * 8;
                const f32x4 x0 = *(const f32x4*)(a.in[0] + (size_t)t * D + col), x1 = *(const f32x4*)(a.in[0] + (size_t)t * D + col + 4);
                const f32x4 h0 = *(const LAS f32x4*)(msh + col), h1 = *(const LAS f32x4*)(msh + col + 4), s0 = *(const LAS f32x4*)(msh + 2048 + col), s1 = *(const LAS f32x4*)(msh + 2048 + col + 4);
                v4u o; o.x = pk2(x0.x * (1.f + s0.x) + h0.x, x0.y * (1.f + s0.y) + h0.y); o.y = pk2(x0.z * (1.f + s0.z) + h0.z, x0.w * (1.f + s0.w) + h0.w);
                o.z = pk2(x1.x * (1.f + s1.x) + h1.x, x1.y * (1.f + s1.y) + h1.y); o.w = pk2(x1.z * (1.f + s1.z) + h1.z, x1.w * (1.f + s1.w) + h1.w);
                *(v4u*)(hbuf + (size_t)t * D + col) = o; } }
        __syncthreads();
    }
}

__device__ __forceinline__ void gate_prep(const Args& a, int l, LAS unsigned char* lds, int tid, int lane, int wave, int ch) {
    const bf16* hbuf = (const bf16*)(a.ws + WS_H); const bf16* waT = (const bf16*)(a.ws + WS_WIN) + ((size_t)l * INW + NP) * D;
    float* Ebuf = (float*)(a.ws + WS_E); float* dtot = (float*)(a.ws + WS_DTOT);
    const int t0 = ch * 64, l15 = lane & 15, lq = lane >> 4, mt = wave & 3, kh = wave >> 2;
    f32x4 acc = (f32x4){0.f, 0.f, 0.f, 0.f};
    const bf16* hA = hbuf + (size_t)(t0 + 16 * mt + l15) * D + kh * 1024 + 8 * lq;
    const bf16* wB = waT + (size_t)l15 * D + kh * 1024 + 8 * lq;
#pragma unroll 8
    for (int ks = 0; ks < 32; ++ks) { const bf16x8 av = *(const bf16x8*)(hA + 32 * ks), bv = *(const bf16x8*)(wB + 32 * ks); acc = __builtin_amdgcn_mfma_f32_16x16x32_bf16(av, bv, acc, 0, 0, 0); }
    LAS float* alr = (LAS float*)lds;
#pragma unroll
    for (int r = 0; r < 4; ++r) alr[(kh * 64 + 16 * mt + 4 * lq + r) * 16 + l15] = acc[r];
    __syncthreads();
    const int col = tid;
    float wg[16];
#pragma unroll
    for (int r = 0; r < 16; ++r) wg[r] = a.in[5][((size_t)l * RANK + r) * GKW + col];
    const float bgc = a.in[6][l * GKW + col];
    float tot = 0.f;
    for (int j = 0; j < 64; ++j) { float lg = bgc;
#pragma unroll
        for (int r4 = 0; r4 < 4; ++r4) { const f32x4 p = *(const LAS f32x4*)(alr + j * 16 + r4 * 4), q = *(const LAS f32x4*)(alr + (64 + j) * 16 + r4 * 4);
            lg += (p.x + q.x) * wg[r4 * 4] + (p.y + q.y) * wg[r4 * 4 + 1] + (p.z + q.z) * wg[r4 * 4 + 2] + (p.w + q.w) * wg[r4 * 4 + 3]; }
        tot += logsigmoid_f(lg) * (1.0f / 16.0f); }
    float run = 0.f;
    for (int j = 0; j < 64; ++j) { float lg = bgc;
#pragma unroll
        for (int r4 = 0; r4 < 4; ++r4) { const f32x4 p = *(const LAS f32x4*)(alr + j * 16 + r4 * 4), q = *(const LAS f32x4*)(alr + (64 + j) * 16 + r4 * 4);
            lg += (p.x + q.x) * wg[r4 * 4] + (p.y + q.y) * wg[r4 * 4 + 1] + (p.z + q.z) * wg[r4 * 4 + 2] + (p.w + q.w) * wg[r4 * 4 + 3]; }
        run += logsigmoid_f(lg) * (1.0f / 16.0f);
        Ebuf[(size_t)(t0 + j) * GKW + col] = __expf(tot - run); }
    dtot[(size_t)ch * GKW + col] = __expf(tot);
    __syncthreads();
}

__device__ __forceinline__ void gla_unit(const Args& a, LAS unsigned char* lds, int tid, int lane, int wave, int un) {
    const bf16* proj = (const bf16*)(a.ws + WS_PROJ); const float* Ebuf = (const float*)(a.ws + WS_E); const float* dtot = (const float*)(a.ws + WS_DTOT); float* ogla = (float*)(a.ws + WS_OGLA);
    const int dvs = un & 7, hh = (un >> 3) & 3, b = un >> 5;
    LAS bf16* kdT = (LAS bf16*)lds;
    LAS bf16* vT = (LAS bf16*)(lds + 18432);
    LAS bf16* ST = (LAS bf16*)(lds + 18432 + 4608);
    const int l15 = lane & 15, lq = lane >> 4, jl = tid >> 3, d16 = (tid & 7) * 16, dv4 = (tid & 7) * 4, jt = (wave & 3) * 16, dvt = (wave >> 2) * 16;
    f32x4 S0 = (f32x4){0.f, 0.f, 0.f, 0.f}, S1 = (f32x4){0.f, 0.f, 0.f, 0.f};
    v4u kn[2]; f32x4 en[4]; v2u vn; bf16x8 qn[4], qc[4]; f32x4 dn, dc;
#define GLA_LOAD(c) do { const int t0c = b * SEQ + (c) * 64; const bf16* pr = proj + (size_t)(t0c + jl) * NP; \
        kn[0] = *(const v4u*)(pr + PK + hh * 128 + d16); kn[1] = *(const v4u*)(pr + PK + hh * 128 + d16 + 8); \
        _Pragma("unroll") for (int i_ = 0; i_ < 4; ++i_) en[i_] = *(const f32x4*)(Ebuf + (size_t)(t0c + jl) * GKW + hh * 128 + d16 + 4 * i_); \
        vn = *(const v2u*)(pr + PV + hh * 256 + dvs * 32 + dv4); \
        _Pragma("unroll") for (int ks_ = 0; ks_ < 4; ++ks_) qn[ks_] = *(const bf16x8*)(proj + (size_t)(t0c + jt + l15) * NP + PQ + hh * 128 + 32 * ks_ + 8 * lq); \
        dn = *(const f32x4*)(dtot + (size_t)(b * NCH + (c)) * GKW + hh * 128 + 16 * wave + 4 * lq); } while (0)
#define GLA_PREP() do { \
        _Pragma("unroll") for (int i_ = 0; i_ < 16; ++i_) { const unsigned w_ = kn[i_ >> 3][(i_ & 7) >> 1]; const float kf_ = (i_ & 1) ? bfhi(w_) : bflo(w_); \
            kdT[(d16 + i_) * 72 + jl] = (bf16)(pk2(kf_ * en[i_ >> 2][i_ & 3], 0.f) & 0xffffu); } \
        _Pragma("unroll") for (int i_ = 0; i_ < 4; ++i_) { const unsigned w_ = vn[i_ >> 1]; vT[(dv4 + i_) * 72 + jl] = (bf16)((i_ & 1) ? (w_ >> 16) : (w_ & 0xffffu)); } \
        _Pragma("unroll") for (int ks_ = 0; ks_ < 4; ++ks_) qc[ks_] = qn[ks_]; \
        dc = dn; } while (0)
    GLA_LOAD(0); GLA_PREP();
    __syncthreads();
    for (int c = 0; c < NCH; ++c) {
        if (c + 1 < NCH) GLA_LOAD(c + 1);
        S0 = S0 * dc; S1 = S1 * dc;
#pragma unroll
        for (int ks = 0; ks < 2; ++ks) {
            const bf16x8 A = *(const LAS bf16x8*)(kdT + (16 * wave + l15) * 72 + 32 * ks + 8 * lq);
            const bf16x8 B0 = *(const LAS bf16x8*)(vT + l15 * 72 + 32 * ks + 8 * lq), B1 = *(const LAS bf16x8*)(vT + (16 + l15) * 72 + 32 * ks + 8 * lq);
            S0 = __builtin_amdgcn_mfma_f32_16x16x32_bf16(A, B0, S0, 0, 0, 0); S1 = __builtin_amdgcn_mfma_f32_16x16x32_bf16(A, B1, S1, 0, 0, 0); }
        { v2u w0, w1; w0.x = pk2(S0.x, S0.y); w0.y = pk2(S0.z, S0.w); w1.x = pk2(S1.x, S1.y); w1.y = pk2(S1.z, S1.w);
          *(LAS v2u*)(ST + l15 * 136 + 16 * wave + 4 * lq) = w0; *(LAS v2u*)(ST + (16 + l15) * 136 + 16 * wave + 4 * lq) = w1; }
        __syncthreads();
        f32x4 O = (f32x4){0.f, 0.f, 0.f, 0.f};
#pragma unroll
        for (int ks = 0; ks < 4; ++ks) { const bf16x8 A = *(const LAS bf16x8*)(ST + (dvt + l15) * 136 + 32 * ks + 8 * lq); O = __builtin_amdgcn_mfma_f32_16x16x32_bf16(A, qc[ks], O, 0, 0, 0); }
        *(f32x4*)(ogla + (size_t)(b * SEQ + c * 64 + jt + l15) * 1024 + hh * 256 + dvs * 32 + dvt + 4 * lq) = O * 0.08838834764831845f;
        if (c + 1 < NCH) GLA_PREP();
        __syncthreads();
    }
#undef GLA_LOAD
#undef GLA_PREP
}

__device__ __forceinline__ void unpack16(const v4u& p0, const v4u& p1, float (&o)[16]) {
#pragma unroll
    for (int j = 0; j < 4; ++j) { o[2 * j] = bflo(p0[j]); o[2 * j + 1] = bfhi(p0[j]); o[8 + 2 * j] = bflo(p1[j]); o[8 + 2 * j + 1] = bfhi(p1[j]); }
}
__device__ __forceinline__ void mixpost_chunk(const Args& a, int l, int lane, int wave, int ch) {
    const bf16* proj = (const bf16*)(a.ws + WS_PROJ); const float* ogla = (const float*)(a.ws + WS_OGLA); bf16* ybuf = (bf16*)(a.ws + WS_Y);
    const int c0 = 16 * lane, tfirst = ch * 64 + wave * 8, sfirst = tfirst % SEQ;
    float gn[16], cw0[16], cw1[16], cw2[16], cn[16], u1[16], u2[16];
#pragma unroll
    for (int i = 0; i < 16; ++i) { gn[i] = a.in[7][l * 256 + ((c0 + i) & 255)]; cw0[i] = a.in[8][(size_t)l * 3072 + c0 + i]; cw1[i] = a.in[8][(size_t)l * 3072 + 1024 + c0 + i];
        cw2[i] = a.in[8][(size_t)l * 3072 + 2048 + c0 + i]; cn[i] = a.in[9][l * 1024 + c0 + i]; u1[i] = 0.f; u2[i] = 0.f; }
    if (sfirst >= 2) {
        float cc[16], chh[16];
        { const bf16* pr = proj + (size_t)(tfirst - 2) * NP; unpack16(*(const v4u*)(pr + PCC + c0), *(const v4u*)(pr + PCC + c0 + 8), cc); unpack16(*(const v4u*)(pr + PCH + c0), *(const v4u*)(pr + PCH + c0 + 8), chh); }
#pragma unroll
        for (int i = 0; i < 16; ++i) u2[i] = cc[i] * chh[i];
        { const bf16* pr = proj + (size_t)(tfirst - 1) * NP; unpack16(*(const v4u*)(pr + PCC + c0), *(const v4u*)(pr + PCC + c0 + 8), cc); unpack16(*(const v4u*)(pr + PCH + c0), *(const v4u*)(pr + PCH + c0 + 8), chh); }
#pragma unroll
        for (int i = 0; i < 16; ++i) u1[i] = cc[i] * chh[i];
    }
    for (int it = 0; it < 8; ++it) { const int t = tfirst + it; const bf16* pr = proj + (size_t)t * NP;
        float o[16], r[16], cb[16], cc[16], chh[16];
#pragma unroll
        for (int j = 0; j < 4; ++j) { const f32x4 v = *(const f32x4*)(ogla + (size_t)t * 1024 + c0 + 4 * j); o[4 * j] = v.x; o[4 * j + 1] = v.y; o[4 * j + 2] = v.z; o[4 * j + 3] = v.w; }
        unpack16(*(const v4u*)(pr + PR + c0), *(const v4u*)(pr + PR + c0 + 8), r);
        unpack16(*(const v4u*)(pr + PCB + c0), *(const v4u*)(pr + PCB + c0 + 8), cb);
        unpack16(*(const v4u*)(pr + PCC + c0), *(const v4u*)(pr + PCC + c0 + 8), cc);
        unpack16(*(const v4u*)(pr + PCH + c0), *(const v4u*)(pr + PCH + c0 + 8), chh);
        float ss = 0.f;
#pragma unroll
        for (int i = 0; i < 16; ++i) ss += o[i] * o[i];
        ss += __shfl_xor(ss, 1); ss += __shfl_xor(ss, 2); ss += __shfl_xor(ss, 4); ss += __shfl_xor(ss, 8);
        const float rg = rsqrtf(ss * (1.0f / 256.f) + EPS);
        float val[16]; float s2 = 0.f;
#pragma unroll
        for (int i = 0; i < 16; ++i) { const float u0 = cc[i] * chh[i]; val[i] = cb[i] * (cw0[i] * u2[i] + cw1[i] * u1[i] + cw2[i] * u0); s2 += val[i] * val[i]; u2[i] = u1[i]; u1[i] = u0; }
        const float rc = rsqrtf(wave_sum(s2) * (1.0f / 1024.f) + EPS);
        v4u y0, y1, y2, y3;
#pragma unroll
        for (int j = 0; j < 4; ++j) {
            y0[j] = pk2(o[2 * j] * rg * gn[2 * j] * silu_f(r[2 * j]), o[2 * j + 1] * rg * gn[2 * j + 1] * silu_f(r[2 * j + 1]));
            y1[j] = pk2(o[8 + 2 * j] * rg * gn[8 + 2 * j] * silu_f(r[8 + 2 * j]), o[9 + 2 * j] * rg * gn[9 + 2 * j] * silu_f(r[9 + 2 * j]));
            y2[j] = pk2(val[2 * j] * rc * cn[2 * j], val[2 * j + 1] * rc * cn[2 * j + 1]);
            y3[j] = pk2(val[8 + 2 * j] * rc * cn[8 + 2 * j], val[9 + 2 * j] * rc * cn[9 + 2 * j]); }
        bf16* yr = ybuf + (size_t)t * D;
        *(v4u*)(yr + c0) = y0; *(v4u*)(yr + c0 + 8) = y1; *(v4u*)(yr + 1024 + c0) = y2; *(v4u*)(yr + 1024 + c0 + 8) = y3;
    }
}

__device__ __forceinline__ void ln1_chunk(const Args& a, int l, int lane, int wave, int ch) {
    const float* zbuf = (const float*)(a.ws + WS_Z); const float* mod = (const float*)(a.ws + WS_MOD);
    const int b = ch / NCH; const float* mb = mod + ((size_t)l * NB + b) * 6 * D;
    for (int it = 0; it < 8; ++it) { const int t = ch * 64 + wave * 8 + it;
        float z[32];
#pragma unroll
        for (int c = 0; c < 4; ++c) { const int col = (c * 64 + lane) * 8; const f32x4 v0 = *(const f32x4*)(zbuf + (size_t)t * D + col), v1 = *(const f32x4*)(zbuf + (size_t)t * D + col + 4);
            z[c * 8] = v0.x; z[c * 8 + 1] = v0.y; z[c * 8 + 2] = v0.z; z[c * 8 + 3] = v0.w; z[c * 8 + 4] = v1.x; z[c * 8 + 5] = v1.y; z[c * 8 + 6] = v1.z; z[c * 8 + 7] = v1.w; }
        ln_tail(z, t, lane, a.in[11] + (size_t)l * D, a.in[12] + (size_t)l * D, (float*)(a.ws + WS_X1), mb + 3 * D, mb + 4 * D, (bf16*)(a.ws + WS_H));
    }
}

template <int N> __device__ __forceinline__ void bitonic_sort_desc(float (&v)[N]) {
#pragma unroll
    for (int k = 2; k <= N; k <<= 1)
#pragma unroll
        for (int j = k >> 1; j > 0; j >>= 1)
#pragma unroll
            for (int i = 0; i < N; ++i) { const int p = i ^ j; if (p > i) { const bool desc = ((i & k) == 0); const float x = v[i], y = v[p]; const float mx = fmaxf(x, y), mn = fminf(x, y); v[i] = desc ? mx : mn; v[p] = desc ? mn : mx; } }
}
__device__ __forceinline__ void merge_top16(float (&x)[16], const float (&y)[16]) {
#pragma unroll
    for (int i = 0; i < 16; ++i) x[i] = fmaxf(x[i], y[15 - i]);
#pragma unroll
    for (int j = 8; j > 0; j >>= 1)
#pragma unroll
        for (int i = 0; i < 16; ++i) { const int p = i ^ j; if (p > i) { const float u = x[i], w = x[p]; x[i] = fmaxf(u, w); x[p] = fminf(u, w); } }
}
__device__ __forceinline__ void ce_desc(float& ka, int& pa, float& kb, int& pb) { const bool sw = kb > ka; const float k0 = sw ? kb : ka, k1 = sw ? ka : kb; const int p0 = sw ? pb : pa, p1 = sw ? pa : pb; ka = k0; pa = p0; kb = k1; pb = p1; }
__device__ __forceinline__ void bitonic_sort_desc_kp(float (&k)[16], int (&p)[16]) {
#pragma unroll
    for (int kk = 2; kk <= 16; kk <<= 1)
#pragma unroll
        for (int j = kk >> 1; j > 0; j >>= 1)
#pragma unroll
            for (int i = 0; i < 16; ++i) { const int q = i ^ j; if (q > i) { if ((i & kk) == 0) ce_desc(k[i], p[i], k[q], p[q]); else ce_desc(k[q], p[q], k[i], p[i]); } }
}
__device__ __forceinline__ void merge_top16_kp(float (&k)[16], int (&p)[16], const float (&k2)[16], const int (&p2)[16]) {
#pragma unroll
    for (int i = 0; i < 16; ++i) { const bool sw = k2[15 - i] > k[i]; k[i] = sw ? k2[15 - i] : k[i]; p[i] = sw ? p2[15 - i] : p[i]; }
#pragma unroll
    for (int j = 8; j > 0; j >>= 1)
#pragma unroll
        for (int i = 0; i < 16; ++i) { const int q = i ^ j; if (q > i) ce_desc(k[i], p[i], k[q], p[q]); }
}
__device__ constexpr int cand_i(int s) { return s < 16 ? 0 : s < 24 ? 1 : s < 29 ? 2 : s < 33 ? 3 : s < 36 ? 4 : s < 38 ? 5 : s < 40 ? 6 : s < 42 ? 7 : s < 50 ? s - 34 : -1; }
__device__ constexpr int cand_j(int s) { return s < 16 ? s : s < 24 ? s - 16 : s < 29 ? s - 24 : s < 33 ? s - 29 : s < 36 ? s - 33 : s < 38 ? s - 36 : s < 40 ? s - 38 : s < 42 ? s - 40 : s < 50 ? 0 : -1; }

__device__ __forceinline__ void peer_retrieve(const Args& a, int l, LAS unsigned char* lds, int lane, int wave, int ch) {
    const bf16* qbuf = (const bf16*)(a.ws + WS_Q); const bf16* keys = (const bf16*)(a.ws + WS_KEYS) + ((size_t)(l * 8 + wave) * 2) * 128 * 128;
    LAS int* eg_e = (LAS int*)lds; LAS float* eg_g = (LAS float*)(lds + 32768);
    const int l31 = lane & 31, l5 = lane >> 5, h = wave, t0 = ch * 64;
    for (int tt = 0; tt < 2; ++tt) {
        float sv[2][16];
#pragma unroll
        for (int p = 0; p < 2; ++p) {
            f32x16 acc[4];
#pragma unroll
            for (int nt = 0; nt < 4; ++nt)
#pragma unroll
                for (int r = 0; r < 16; ++r) acc[nt][r] = 0.f;
            const bf16* qp = qbuf + (size_t)(t0 + 32 * tt + l31) * D + h * 256 + p * 128 + 8 * l5;
            const bf16* kp = keys + (size_t)(p * 128 + l31) * 128 + 8 * l5;
#pragma unroll 2
            for (int ks = 0; ks < 8; ++ks) { const bf16x8 bq = *(const bf16x8*)(qp + 16 * ks);
#pragma unroll
                for (int nt = 0; nt < 4; ++nt) { const bf16x8 ak = *(const bf16x8*)(kp + (size_t)(32 * nt) * 128 + 16 * ks); acc[nt] = __builtin_amdgcn_mfma_f32_32x32x16_bf16(ak, bq, acc[nt], 0, 0, 0); } }
            float v[4][16];
#pragma unroll
            for (int nt = 0; nt < 4; ++nt)
#pragma unroll
                for (int r = 0; r < 16; ++r) { const unsigned idx = 32u * nt + (r & 3) + 8u * (r >> 2) + 4u * l5; v[nt][r] = __uint_as_float((__float_as_uint(acc[nt][r]) & 0xffffff80u) | idx); }
#pragma unroll
            for (int nt = 0; nt < 4; ++nt) bitonic_sort_desc<16>(v[nt]);
            merge_top16(v[0], v[1]); merge_top16(v[2], v[3]); merge_top16(v[0], v[2]);
            float o[16];
#pragma unroll
            for (int i = 0; i < 16; ++i) o[i] = __shfl_xor(v[0][i], 32);
            merge_top16(v[0], o);
#pragma unroll
            for (int i = 0; i < 16; ++i) sv[p][i] = v[0][i];
        }
        LAS unsigned char* idxb = (LAS unsigned char*)(lds + 69632) + wave * 2048 + lane * 32;
        { v4u w0, w1;
#pragma unroll
          for (int q4 = 0; q4 < 4; ++q4) {
              w0[q4] = (__float_as_uint(sv[0][4 * q4]) & 127u) | ((__float_as_uint(sv[0][4 * q4 + 1]) & 127u) << 8) | ((__float_as_uint(sv[0][4 * q4 + 2]) & 127u) << 16) | ((__float_as_uint(sv[0][4 * q4 + 3]) & 127u) << 24);
              w1[q4] = (__float_as_uint(sv[1][4 * q4]) & 127u) | ((__float_as_uint(sv[1][4 * q4 + 1]) & 127u) << 8) | ((__float_as_uint(sv[1][4 * q4 + 2]) & 127u) << 16) | ((__float_as_uint(sv[1][4 * q4 + 3]) & 127u) << 24); }
          *(LAS v4u*)(idxb) = w0; *(LAS v4u*)(idxb + 16) = w1; }
        float ck[4][16];
#pragma unroll
        for (int s = 0; s < 64; ++s) {
            if (cand_i(s) >= 0) { const unsigned b0 = __float_as_uint(sv[0][cand_i(s) < 0 ? 0 : cand_i(s)]), b1 = __float_as_uint(sv[1][cand_j(s) < 0 ? 0 : cand_j(s)]);
                const float sum = __uint_as_float(b0 & 0xffffff80u) + __uint_as_float(b1 & 0xffffff80u);
                ck[s >> 4][s & 15] = __uint_as_float((__float_as_uint(sum) & 0xffffff00u) | (unsigned)((cand_i(s) < 0 ? 0 : cand_i(s)) * 16 + (cand_j(s) < 0 ? 0 : cand_j(s)))); }
            else ck[s >> 4][s & 15] = -3.0e38f; }
        bitonic_sort_desc<16>(ck[1]); bitonic_sort_desc<16>(ck[2]);
        merge_top16(ck[0], ck[1]); merge_top16(ck[2], ck[3]); merge_top16(ck[0], ck[2]);
        LDS_WAIT(); asm volatile("" ::: "memory");
        float ex[16]; int ce[16]; float den = 0.f;
        const float cmax = __uint_as_float(__float_as_uint(ck[0][0]) & 0xffffff00u);
#pragma unroll
        for (int i = 0; i < 16; ++i) { const unsigned bits = __float_as_uint(ck[0][i]); ex[i] = __expf(__uint_as_float(bits & 0xffffff00u) - cmax); den += ex[i];
            ce[i] = (int)idxb[(bits >> 4) & 15u] * 128 + (int)idxb[16 + (bits & 15u)]; }
        const float inv = 1.0f / den;
        if (l5 == 0) {
            const int base = (32 * tt + l31) * 128 + h * 16;
#pragma unroll
            for (int i4 = 0; i4 < 4; ++i4) { *(LAS v4u*)(eg_e + base + 4 * i4) = (v4u){(unsigned)ce[4 * i4], (unsigned)ce[4 * i4 + 1], (unsigned)ce[4 * i4 + 2], (unsigned)ce[4 * i4 + 3]};
                *(LAS f32x4*)(eg_g + base + 4 * i4) = (f32x4){ex[4 * i4] * inv, ex[4 * i4 + 1] * inv, ex[4 * i4 + 2] * inv, ex[4 * i4 + 3] * inv}; }
        }
        LDS_WAIT(); asm volatile("" ::: "memory");
    }
}

__device__ __forceinline__ void peer_experts(const Args& a, int l, LAS unsigned char* lds, int lane, int wave, int ch) {
    const bf16* hbuf = (const bf16*)(a.ws + WS_H); const float* x1buf = (const float*)(a.ws + WS_X1); const float* mod = (const float*)(a.ws + WS_MOD);
    const bf16* ut = (const bf16*)(a.ws + WS_UT) + (size_t)l * NE * D; const bf16* vt = (const bf16*)(a.ws + WS_VT) + (size_t)l * NE * D;
    LAS int* eg_e = (LAS int*)lds; LAS float* eg_g = (LAS float*)(lds + 32768); LAS float* wts = (LAS float*)(lds + 65536) + wave * 128;
    const int b = ch / NCH; const bool last = (l == NL - 1);
    const float* mb = mod + ((size_t)l * NB + b) * 6 * D; const float* mbn = mod + ((size_t)(last ? l : l + 1) * NB + b) * 6 * D;
    const int b5 = (lane >> 5) & 1, b4 = (lane >> 4) & 1;
    for (int it = 0; it < 8; ++it) {
        const int tl = wave * 8 + it, t = ch * 64 + tl;
        unsigned hq[16];
#pragma unroll
        for (int c = 0; c < 4; ++c) { const v4u v = *(const v4u*)(hbuf + (size_t)t * D + (c * 64 + lane) * 8); hq[c * 4] = v.x; hq[c * 4 + 1] = v.y; hq[c * 4 + 2] = v.z; hq[c * 4 + 3] = v.w; }
#pragma unroll 2
        for (int bt = 0; bt < 32; ++bt) {
            v4u rw[4][4];
#pragma unroll
            for (int k = 0; k < 4; ++k) { const int e = __builtin_amdgcn_readfirstlane(eg_e[tl * 128 + bt * 4 + k]); const bf16* row = ut + (size_t)e * D;
#pragma unroll
                for (int c = 0; c < 4; ++c) rw[k][c] = *(const v4u*)(row + (c * 64 + lane) * 8); }
            float p[4];
#pragma unroll
            for (int k = 0; k < 4; ++k) { float s = 0.f;
#pragma unroll
                for (int c = 0; c < 4; ++c)
#pragma unroll
                    for (int j = 0; j < 4; ++j) s = dot2bf(rw[k][c][j], hq[c * 4 + j], s);
                p[k] = s; }
            float r2[2];
#pragma unroll
            for (int k = 0; k < 2; ++k) { const float send = b5 ? p[k] : p[k + 2], keep = b5 ? p[k + 2] : p[k]; r2[k] = keep + __shfl_xor(send, 32); }
            float s1; { const float send = b4 ? r2[0] : r2[1], keep = b4 ? r2[1] : r2[0]; s1 = keep + __shfl_xor(send, 16); }
            s1 += __shfl_xor(s1, 8); s1 += __shfl_xor(s1, 4); s1 += __shfl_xor(s1, 2); s1 += __shfl_xor(s1, 1);
            const int rowi = bt * 4 + (lane >> 4);
            const float wgt = eg_g[tl * 128 + rowi] * gelu_tanh_f(s1);
            if ((lane & 15) == 0) wts[rowi] = wgt;
        }
        LDS_WAIT(); asm volatile("" ::: "memory");
        float y[32];
#pragma unroll
        for (int i = 0; i < 32; ++i) y[i] = 0.f;
#pragma unroll 2
        for (int bt = 0; bt < 32; ++bt) {
            v4u rw[4][4]; float wk[4];
#pragma unroll
            for (int k = 0; k < 4; ++k) { const int e = __builtin_amdgcn_readfirstlane(eg_e[tl * 128 + bt * 4 + k]); const bf16* row = vt + (size_t)e * D; wk[k] = wts[bt * 4 + k];
#pragma unroll
                for (int c = 0; c < 4; ++c) rw[k][c] = *(const v4u*)(row + (c * 64 + lane) * 8); }
#pragma unroll
            for (int k = 0; k < 4; ++k)
#pragma unroll
                for (int c = 0; c < 4; ++c)
#pragma unroll
                    for (int j = 0; j < 4; ++j) { y[c * 8 + 2 * j] += wk[k] * bflo(rw[k][c][j]); y[c * 8 + 2 * j + 1] += wk[k] * bfhi(rw[k][c][j]); }
        }
        float z[32];
#pragma unroll
        for (int c = 0; c < 4; ++c) { const int col = (c * 64 + lane) * 8;
            const f32x4 x0 = *(const f32x4*)(x1buf + (size_t)t * D + col), x1v = *(const f32x4*)(x1buf + (size_t)t * D + col + 4), g0 = *(const f32x4*)(mb + 5 * D + col), g1 = *(const f32x4*)(mb + 5 * D + col + 4);
            z[c * 8] = ALPHA * x0.x + (1.f + g0.x) * y[c * 8]; z[c * 8 + 1] = ALPHA * x0.y + (1.f + g0.y) * y[c * 8 + 1]; z[c * 8 + 2] = ALPHA * x0.z + (1.f + g0.z) * y[c * 8 + 2]; z[c * 8 + 3] = ALPHA * x0.w + (1.f + g0.w) * y[c * 8 + 3];
            z[c * 8 + 4] = ALPHA * x1v.x + (1.f + g1.x) * y[c * 8 + 4]; z[c * 8 + 5] = ALPHA * x1v.y + (1.f + g1.y) * y[c * 8 + 5]; z[c * 8 + 6] = ALPHA * x1v.z + (1.f + g1.z) * y[c * 8 + 6]; z[c * 8 + 7] = ALPHA * x1v.w + (1.f + g1.w) * y[c * 8 + 7]; }
        ln_tail(z, t, lane, a.in[17] + (size_t)l * D, a.in[18] + (size_t)l * D, last ? a.out : (float*)(a.ws + WS_X), mbn, mbn + D, last ? (bf16*)nullptr : (bf16*)(a.ws + WS_H));
    }
}

#ifndef MK_PER_PHASE
#define MK_PER_PHASE 0
#endif
__global__ void __launch_bounds__(NTHREADS, 2) mk_fwd(Args a) {
    extern __shared__ __attribute__((aligned(16))) unsigned char lds_raw[];
    LAS unsigned char* lds = (LAS unsigned char*)lds_raw;
    const int tid = threadIdx.x, lane = tid & 63, wave = __builtin_amdgcn_readfirstlane(tid >> 6), G = gridDim.x, bx = blockIdx.x;
    if (tid < 64) ((LAS unsigned*)(lds + LDSCTL_OFF))[tid] = 0u;
    __syncthreads();
    unsigned* ctl = (unsigned*)(a.ws + WS_CTL);
    XcdBarrier bar; bar.bar = ctl + CW_BAR; bar.x = 0; bar.st = nullptr;
    const bool use_bar = (a.ph_hi - a.ph_lo) > 1;
    if (use_bar) bar = xcd_barrier_post(ctl + CW_BAR, (volatile LAS unsigned*)(lds + LDSCTL_OFF));
    const int lo = a.ph_lo, hi = a.ph_hi;
#ifndef PH_MASK
#define PH_MASK 0x1ff
#endif
#define IN(k) (lo <= (k) && (k) < hi)
#define EN(b) ((PH_MASK >> (b)) & 1)
#define SEAM(k) do { if (IN((k) + 1)) xcd_barrier(bar); } while (0)
#define PHASE_IDS() int tidp = tid; asm volatile("" : "+v"(tidp)); const int lanep = tidp & 63, wavep = __builtin_amdgcn_readfirstlane(tidp >> 6); (void)lanep; (void)wavep
    if (EN(0) && IN(0)) { PHASE_IDS(); ph_prologue_a(a, lds, tidp, lanep, wavep, bx, G); SEAM(0); }
    if (EN(1) && IN(1)) { PHASE_IDS(); ph_prologue_b(a, lds, tidp, lanep, wavep, bx, G); SEAM(1); }
    for (int l = 0; l < NL; ++l) {
        const int pb = 2 + 7 * l;
        const float* mod = (const float*)(a.ws + WS_MOD);
        if (EN(2) && IN(pb + 0)) {
            PHASE_IDS();
            pg8::Gemm g{(const pg8::bf16_t*)(a.ws + WS_H), (const pg8::bf16_t*)(a.ws + WS_WIN) + (size_t)l * INW * D, T, NP, D}; pg8::StaticOrder S; S.init(T, NP, G, bx);
            pg8::EpiBf16P E{(pg8::bf16_t*)(a.ws + WS_PROJ), NP};
            pg8::gemm_phase<pg8::EpiBf16P, pg8::StaticOrder, true, true>(lds + RING_OFF, g, S, E, tidp);
            for (int ch = bx; ch < NCHUNK; ch += G) gate_prep(a, l, lds, tidp, lanep, wavep, ch);
            SEAM(pb + 0);
        }
        if (EN(3) && IN(pb + 1)) { PHASE_IDS(); for (int un = bx; un < 256; un += G) gla_unit(a, lds, tidp, lanep, wavep, un); SEAM(pb + 1); }
        if (EN(4) && IN(pb + 2)) { PHASE_IDS(); for (int ch = bx; ch < NCHUNK; ch += G) mixpost_chunk(a, l, lanep, wavep, ch); SEAM(pb + 2); }
        if (EN(5) && IN(pb + 3)) {
            PHASE_IDS();
            pg8::Gemm g{(const pg8::bf16_t*)(a.ws + WS_Y), (const pg8::bf16_t*)(a.ws + WS_WOUT) + (size_t)l * D * D, T, D, D}; pg8::StaticOrder S; S.init(T, D, G, bx);
            pg8::EpiResid E{(float*)(a.ws + WS_Z), l == 0 ? a.in[0] : (const float*)(a.ws + WS_X), mod + (size_t)l * NB * 6 * D + 2 * D, ALPHA};
            pg8::gemm_phase<pg8::EpiResid, pg8::StaticOrder, true, true>(lds + RING_OFF, g, S, E, tidp);
            SEAM(pb + 3);
        }
        if (EN(6) && IN(pb + 4)) { PHASE_IDS(); for (int ch = bx; ch < NCHUNK; ch += G) ln1_chunk(a, l, lanep, wavep, ch); SEAM(pb + 4); }
        if (EN(7) && IN(pb + 5)) {
            PHASE_IDS();
            pg8::Gemm g{(const pg8::bf16_t*)(a.ws + WS_H), (const pg8::bf16_t*)(a.ws + WS_WQ) + (size_t)l * D * D, T, D, D}; pg8::StaticOrder S; S.init(T, D, G, bx);
            pg8::EpiBf16P E{(pg8::bf16_t*)(a.ws + WS_Q), D};
            pg8::gemm_phase<pg8::EpiBf16P, pg8::StaticOrder, true, true>(lds + RING_OFF, g, S, E, tidp);
            SEAM(pb + 5);
        }
        if (EN(8) && IN(pb + 6)) {
            #ifndef PEER_DBG
#define PEER_DBG 0
#endif
            for (int ch = bx; ch < NCHUNK; ch += G) {
                int* dbg_e = (int*)(a.ws + WS_END + 40 * MiB); float* dbg_g = (float*)(a.ws + WS_END + 56 * MiB);
                if (PEER_DBG != 2) { PHASE_IDS(); peer_retrieve(a, l, lds, lanep, wavep, ch); }
                else { for (int i = tid; i < 64 * 128; i += NTHREADS) { ((LAS int*)lds)[i] = dbg_e[(size_t)ch * 64 * 128 + i]; ((LAS float*)(lds + 32768))[i] = dbg_g[(size_t)ch * 64 * 128 + i]; } }
                __syncthreads();
                if (PEER_DBG != 1) { PHASE_IDS(); peer_experts(a, l, lds, lanep, wavep, ch); }
                else { for (int i = tid; i < 64 * 128; i += NTHREADS) { dbg_e[(size_t)ch * 64 * 128 + i] = ((LAS int*)lds)[i]; dbg_g[(size_t)ch * 64 * 128 + i] = ((LAS float*)(lds + 32768))[i]; } }
                __syncthreads(); }
            SEAM(pb + 6);
        }
    }
#undef IN
#undef SEAM
}

extern "C" void kernel_launch(void* const* d_in, const int* in_sizes, int n_in, void* d_out, int out_size, void* d_ws, size_t ws_size, hipStream_t stream) {
    static int grid = 0;
    if (grid == 0) {
        if (n_in != 19 || in_sizes[0] != T * D || out_size != T * D || ws_size < WS_END) { fprintf(stderr, "kernel_launch: unexpected shapes / workspace (%d inputs, ws %zu); nothing launched\n", n_in, ws_size); grid = -1; return; }
        int dev = 0, cus = 0, per_cu = 0;
        if (hipGetDevice(&dev) != hipSuccess || hipDeviceGetAttribute(&cus, hipDeviceAttributeMultiprocessorCount, dev) != hipSuccess) { grid = -1; return; }
        if (hipFuncSetAttribute((const void*)mk_fwd, hipFuncAttributeMaxDynamicSharedMemorySize, LDS_BYTES) != hipSuccess) { fprintf(stderr, "kernel_launch: hipFuncSetAttribute failed\n"); grid = -1; return; }
        if (hipOccupancyMaxActiveBlocksPerMultiprocessor(&per_cu, (const void*)mk_fwd, NTHREADS, LDS_BYTES) != hipSuccess || per_cu < 1) fprintf(stderr, "kernel_launch: occupancy query reports %d\n", per_cu);
        (void)hipGetLastError();
        grid = cus;
    }
    if (grid < 0) return;
    if (hipMemsetAsync((char*)d_ws + WS_CTL, 0, CTL_ZERO_BYTES, stream) != hipSuccess) return;
    Args a{};
    for (int i = 0; i < 19; ++i) a.in[i] = (const float*)d_in[i];
    a.out = (float*)d_out; a.ws = (unsigned char*)d_ws;
#if MK_PER_PHASE
    for (int p = 0; p < NPHASES; ++p) { a.ph_lo = p; a.ph_hi = p + 1; hipLaunchKernelGGL(mk_fwd, dim3(grid), dim3(NTHREADS), LDS_BYTES, stream, a); }
#else
    a.ph_lo = 0; a.ph_hi = NPHASES;
    hipLaunchKernelGGL(mk_fwd, dim3(grid), dim3(NTHREADS), LDS_BYTES, stream, a);
#endif
}
```

```cpp
#include <hip/hip_runtime.h>
#include <cstdio>
#include <cstdint>
namespace pg8 {
#define PG8_LAS __attribute__((address_space(3)))
typedef unsigned short bf16_t;
typedef short bf16x8 __attribute__((ext_vector_type(8)));
typedef float f32x4 __attribute__((ext_vector_type(4)));
typedef unsigned u32x4 __attribute__((ext_vector_type(4)));
constexpr int BM = 256, BK = 64, HALF = 128, HTB = HALF * BK * 2  , STAGE_BYTES = 8 * HTB, NXCD = 8, WGM = 8;

__host__ __device__ __forceinline__ int lds_byte(int r, int c) { const int st = (r >> 4) * 2 + (c >> 5), rr = r & 15, cc = c & 31, ob = rr * 64 + cc * 2; return st * 1024 + (ob ^ (((ob >> 9) & 1) << 5)); }
__host__ __device__ __forceinline__ void stage_rc(int b, int& R, int& C) { const int st = b / 1024, sb = b % 1024, swz = sb ^ (((sb >> 9) & 1) << 5); R = (st >> 1) * 16 + swz / 64; C = (st & 1) * 32 + (swz % 64) / 2; }
__host__ __device__ __forceinline__ int perm32(int rho) { const int n = rho >> 4, i = rho & 15; return 8 * (i >> 2) + 4 * n + (i & 3); }

struct Unit { int pm, pn; };
struct Gemm { const bf16_t* A; const bf16_t* Bt; int M, N, K; };

struct StaticOrder {
    int nM, nN, nwg, G, c;
    __host__ __device__ void init(int M, int N, int G_, int c_) { nM = M / BM; nN = N / BM; nwg = nM * nN; G = G_; c = c_; }
    __host__ __device__ bool next(int i, Unit& u) const {
        const long L = (long)i * G + c; if (L >= nwg) return false;
        int wgid = (int)L; { const int q = nwg / NXCD, r = nwg % NXCD, xcd = wgid % NXCD, off = wgid / NXCD; wgid = (xcd < r ? xcd * (q + 1) : r * (q + 1) + (xcd - r) * q) + off; }
        const int nig = WGM * nN, gid = wgid / nig, fm = gid * WGM, gsz = (nM - fm) < WGM ? (nM - fm) : WGM;
        u.pm = fm + ((wgid % nig) % gsz); u.pn = (wgid % nig) / gsz; return true;
    }
    __device__ __forceinline__ void a_ready(const Unit&) const {}
    __device__ __forceinline__ void done(const Unit&) const {}
};
typedef __bf16 bf16x2_t __attribute__((ext_vector_type(2)));
__device__ __forceinline__ unsigned cvt_pk_bf16(float lo, float hi) { bf16x2_t r; r.x = (__bf16)lo; r.y = (__bf16)hi; return __builtin_bit_cast(unsigned, r); }
struct EpiBf16P {
    static constexpr bool PERM = true, AFTER_DRAIN = false;
    bf16_t* O; int ldc;
    __device__ __forceinline__ void operator()(const f32x4 (&acc)[2][2][4][2], const Unit& u, int wr, int wc, int fr, int fq) const {
        const int row0 = u.pm * BM + wr * 64 + fr, col0 = u.pn * BM + wc * 32 + 8 * fq;
#pragma unroll
        for (int ai = 0; ai < 2; ++ai)
#pragma unroll
            for (int m = 0; m < 4; ++m) { bf16_t* rowp = O + (size_t)(row0 + ai * HALF + m * 16) * ldc + col0;
#pragma unroll
                for (int bj = 0; bj < 2; ++bj) { const f32x4 v0 = acc[ai][bj][m][0], v1 = acc[ai][bj][m][1];
                    u32x4 w; w.x = cvt_pk_bf16(v0[0], v0[1]); w.y = cvt_pk_bf16(v0[2], v0[3]); w.z = cvt_pk_bf16(v1[0], v1[1]); w.w = cvt_pk_bf16(v1[2], v1[3]);
                    *(u32x4*)(rowp + bj * HALF) = w; } }
    }
};
struct EpiResid {
    static constexpr bool PERM = false, AFTER_DRAIN = false;
    float* Z; const float* X; const float* gate; float alpha;
    __device__ __forceinline__ void operator()(const f32x4 (&acc)[2][2][4][2], const Unit& u, int wr, int wc, int fr, int fq) const {
        const int row0 = u.pm * BM + wr * 64 + fr, col0 = u.pn * BM + wc * 32 + 4 * fq;
        const float* gb = gate + (size_t)(u.pm >> 3) * (6 * 2048) + col0;
        f32x4 gv[2][2];
#pragma unroll
        for (int bj = 0; bj < 2; ++bj)
#pragma unroll
            for (int n = 0; n < 2; ++n) gv[bj][n] = *(const f32x4*)(gb + bj * HALF + n * 16) + 1.0f;
#pragma unroll
        for (int ai = 0; ai < 2; ++ai)
#pragma unroll
            for (int m = 0; m < 4; ++m) { const size_t off = (size_t)(row0 + ai * HALF + m * 16) * 2048 + col0;
#pragma unroll
                for (int bj = 0; bj < 2; ++bj)
#pragma unroll
                    for (int n = 0; n < 2; ++n) { const f32x4 xv = *(const f32x4*)(X + off + bj * HALF + n * 16);
                        *(f32x4*)(Z + off + bj * HALF + n * 16) = xv * alpha + gv[bj][n] * acc[ai][bj][m][n]; }
                asm volatile("" ::: "memory"); }
    }
};
template <class Epi, class Sched, bool ALIGN_EPI = false, bool SP2 = false>
__device__ __forceinline__ void gemm_phase(PG8_LAS unsigned char* lds, const Gemm g, const Sched& S, const Epi& E, const int tid_in) {
    const int tid = tid_in, wid = __builtin_amdgcn_readfirstlane(tid >> 6), lane = tid & 63, wr = wid >> 2, wc = wid & 3, fr = lane & 15, fq = lane >> 4;
    const int K = g.K, nt = K / BK;
    unsigned voffA[2], voffB[2];
#pragma unroll
    for (int i = 0; i < 2; ++i) { int R, C; stage_rc(tid * 16 + i * 8192, R, C); const int Rb = Epi::PERM ? ((R & ~31) + perm32(R & 31)) : R;
        voffA[i] = (unsigned)(R * K + C) * 2u; voffB[i] = (unsigned)(Rb * K + C) * 2u; }
    const size_t kstep = (size_t)(BK * 2);
    const size_t hstep = (size_t)HALF * K * 2;
    const size_t tstep = 2 * hstep;
    const unsigned ldsw = (unsigned)wid * 1024u;
    const int aoff = lds_byte(wr * 64 + fr, fq * 8), boff = lds_byte(wc * 32 + fr, fq * 8);
#define PG8_SA(b, h) (((b) * 2 + (h)) * HTB)
#define PG8_SB(b, h) ((4 + (b) * 2 + (h)) * HTB)
#define PG8_STAGE(bufoff, gbase, voff) do { _Pragma("unroll") for (int _i = 0; _i < 2; ++_i) \
        __builtin_amdgcn_global_load_lds((const unsigned*)((const char*)(gbase) + (voff)[_i]), (PG8_LAS unsigned*)(lds + (bufoff) + ldsw + _i * 8192), 16, 0, 0); } while (0)
#define PG8_LDA(dst, b, h) do { _Pragma("unroll") for (int m = 0; m < 4; ++m) _Pragma("unroll") for (int k = 0; k < 2; ++k) dst[m][k] = *(const PG8_LAS bf16x8*)(lds + PG8_SA(b, h) + aoff + m * 2048 + k * 1024); } while (0)
#define PG8_LDB(dst, b, h) do { _Pragma("unroll") for (int n = 0; n < 2; ++n) _Pragma("unroll") for (int k = 0; k < 2; ++k) dst[n][k] = *(const PG8_LAS bf16x8*)(lds + PG8_SB(b, h) + boff + n * 2048 + k * 1024); } while (0)
#define PG8_MMA(ai, bj, At, Bt) do { __builtin_amdgcn_s_setprio(1); _Pragma("unroll") for (int m = 0; m < 4; ++m) _Pragma("unroll") for (int n = 0; n < 2; ++n) _Pragma("unroll") for (int k = 0; k < 2; ++k) \
        acc[ai][bj][m][n] = __builtin_amdgcn_mfma_f32_16x16x32_bf16(Bt[n][k], At[m][k], acc[ai][bj][m][n], 0, 0, 0); __builtin_amdgcn_s_setprio(0); } while (0)
#define PG8_WAIT_V(n) asm volatile("s_waitcnt vmcnt(" #n ")" ::: "memory")
#define PG8_WAIT_L(n) asm volatile("s_waitcnt lgkmcnt(" #n ")" ::: "memory")
#define PG8_BAR __builtin_amdgcn_s_barrier()
#define PG8_SCHED __builtin_amdgcn_sched_barrier(0)
    Unit cur, nxt; int ui = 0;
    if (!S.next(0, cur)) return;
    f32x4 acc[2][2][4][2];
#pragma unroll
    for (int a = 0; a < 2; ++a)
#pragma unroll
        for (int b = 0; b < 2; ++b)
#pragma unroll
            for (int m = 0; m < 4; ++m)
#pragma unroll
                for (int n = 0; n < 2; ++n) acc[a][b][m][n] = (f32x4){0.f, 0.f, 0.f, 0.f};
    bf16x8 At[4][2], B0[2][2], B1[2][2];
    const char* cA = (const char*)g.A + (size_t)cur.pm * tstep; const char* cB = (const char*)g.Bt + (size_t)cur.pn * tstep;
    S.a_ready(cur);
    if constexpr (SP2) {
        PG8_STAGE(PG8_SB(0, 0), cB, voffB); PG8_STAGE(PG8_SB(0, 1), cB + hstep, voffB); PG8_STAGE(PG8_SA(0, 0), cA, voffA); PG8_STAGE(PG8_SA(0, 1), cA + hstep, voffA);
        if (wr == 1) PG8_BAR;
        PG8_WAIT_V(2); PG8_BAR;
        PG8_STAGE(PG8_SB(1, 0), cB + kstep, voffB); PG8_STAGE(PG8_SA(1, 0), cA + kstep, voffA); PG8_STAGE(PG8_SB(1, 1), cB + hstep + kstep, voffB);
        PG8_WAIT_V(6); PG8_BAR;
    } else {
        PG8_STAGE(PG8_SB(0, 0), cB, voffB); PG8_STAGE(PG8_SA(0, 0), cA, voffA); PG8_STAGE(PG8_SB(0, 1), cB + hstep, voffB); PG8_STAGE(PG8_SA(0, 1), cA + hstep, voffA);
        if (wr == 1) PG8_BAR;
        PG8_WAIT_V(4); PG8_BAR;
        PG8_STAGE(PG8_SB(1, 0), cB + kstep, voffB); PG8_STAGE(PG8_SA(1, 0), cA + kstep, voffA); PG8_STAGE(PG8_SB(1, 1), cB + hstep + kstep, voffB);
        PG8_WAIT_V(6); PG8_BAR;
    }
    for (;;) {
        const bool has_next = S.next(ui + 1, nxt);
        const char* nA = has_next ? (const char*)g.A + (size_t)nxt.pm * tstep : cA; const char* nB = has_next ? (const char*)g.Bt + (size_t)nxt.pn * tstep : cB;
        for (int t = 0; t < nt; t += 2) {
            const bool last = (t == nt - 2);
            const char* a1 = cA + (size_t)(t + 1) * kstep;
            const char* a2 = last ? nA : cA + (size_t)(t + 2) * kstep; const char* b2 = last ? nB : cB + (size_t)(t + 2) * kstep;
            const char* a3 = a2 + kstep; const char* b3 = b2 + kstep;
            if (last && has_next) S.a_ready(nxt);
            if constexpr (SP2) {
            PG8_LDB(B0, 0, 0); PG8_LDB(B1, 0, 1); PG8_SCHED; PG8_LDA(At, 0, 0); PG8_STAGE(PG8_SA(1, 1), a1 + hstep, voffA);
            PG8_WAIT_V(8); PG8_WAIT_L(0); PG8_BAR; PG8_MMA(0, 0, At, B0); PG8_MMA(0, 1, At, B1); PG8_BAR; PG8_SCHED;
            PG8_LDA(At, 0, 1); PG8_STAGE(PG8_SB(0, 0), b2, voffB); PG8_STAGE(PG8_SB(0, 1), b2 + hstep, voffB); PG8_STAGE(PG8_SA(0, 0), a2, voffA);
            PG8_WAIT_V(8); PG8_WAIT_L(0); PG8_BAR; PG8_MMA(1, 0, At, B0); PG8_MMA(1, 1, At, B1); PG8_BAR; PG8_SCHED;
            PG8_LDB(B0, 1, 0); PG8_LDB(B1, 1, 1); PG8_SCHED; PG8_LDA(At, 1, 0); PG8_STAGE(PG8_SA(0, 1), a2 + hstep, voffA);
            PG8_WAIT_V(8); PG8_WAIT_L(0); PG8_BAR; PG8_MMA(0, 0, At, B0); PG8_MMA(0, 1, At, B1); PG8_BAR; PG8_SCHED;
            PG8_LDA(At, 1, 1); PG8_STAGE(PG8_SB(1, 0), b3, voffB); PG8_STAGE(PG8_SB(1, 1), b3 + hstep, voffB); PG8_STAGE(PG8_SA(1, 0), a3, voffA);
            PG8_WAIT_V(8); PG8_WAIT_L(0); PG8_BAR; PG8_MMA(1, 0, At, B0); PG8_MMA(1, 1, At, B1); PG8_BAR; PG8_SCHED;
            } else {
            PG8_LDB(B0, 0, 0); PG8_SCHED; PG8_LDA(At, 0, 0); PG8_STAGE(PG8_SA(1, 1), a1 + hstep, voffA);
            PG8_WAIT_L(8); PG8_BAR; PG8_WAIT_L(0); PG8_MMA(0, 0, At, B0); PG8_BAR; PG8_SCHED;
            PG8_LDB(B1, 0, 1); PG8_STAGE(PG8_SB(0, 0), b2, voffB);
            PG8_BAR; PG8_WAIT_L(0); PG8_MMA(0, 1, At, B1); PG8_BAR;
            PG8_LDA(At, 0, 1); PG8_STAGE(PG8_SA(0, 0), a2, voffA);
            PG8_BAR; PG8_WAIT_L(0); PG8_MMA(1, 0, At, B0); PG8_BAR; PG8_SCHED;
            PG8_STAGE(PG8_SB(0, 1), b2 + hstep, voffB);
            PG8_WAIT_V(6); PG8_BAR; PG8_MMA(1, 1, At, B1); PG8_BAR;
            PG8_LDB(B0, 1, 0); PG8_SCHED; PG8_LDA(At, 1, 0); PG8_STAGE(PG8_SA(0, 1), a2 + hstep, voffA);
            PG8_WAIT_L(8); PG8_BAR; PG8_WAIT_L(0); PG8_MMA(0, 0, At, B0); PG8_BAR; PG8_SCHED;
            PG8_LDB(B1, 1, 1); PG8_STAGE(PG8_SB(1, 0), b3, voffB);
            PG8_BAR; PG8_WAIT_L(0); PG8_MMA(0, 1, At, B1); PG8_BAR;
            PG8_LDA(At, 1, 1); PG8_STAGE(PG8_SA(1, 0), a3, voffA);
            PG8_BAR; PG8_WAIT_L(0); PG8_MMA(1, 0, At, B0); PG8_BAR; PG8_SCHED;
            PG8_STAGE(PG8_SB(1, 1), b3 + hstep, voffB);
            PG8_WAIT_V(6); PG8_BAR; PG8_MMA(1, 1, At, B1); PG8_BAR;
            }
        }
        if constexpr (ALIGN_EPI) { if (wr == 0) PG8_BAR; }
        if constexpr (!Epi::AFTER_DRAIN) { E(acc, cur, wr, wc, fr, fq); S.done(cur); }
        if (!has_next) break;
#pragma unroll
        for (int a = 0; a < 2; ++a)
#pragma unroll
            for (int b = 0; b < 2; ++b)
#pragma unroll
                for (int m = 0; m < 4; ++m)
#pragma unroll
                    for (int n = 0; n < 2; ++n) acc[a][b][m][n] = (f32x4){0.f, 0.f, 0.f, 0.f};
        cur = nxt; cA = nA; cB = nB; ++ui;
        if constexpr (ALIGN_EPI) { if (wr == 1) PG8_BAR; }
    }
    PG8_WAIT_V(0);
    if constexpr (!ALIGN_EPI) { if (wr == 0) PG8_BAR; }
    PG8_BAR;
    if constexpr (Epi::AFTER_DRAIN) { E.fused(acc, cur, wr, wc, fr, fq, lds, wid, lane); S.done(cur); }
#undef PG8_SA
#undef PG8_SB
#undef PG8_STAGE
#undef PG8_LDA
#undef PG8_LDB
#undef PG8_MMA
#undef PG8_WAIT_V
#undef PG8_WAIT_L
#undef PG8_BAR
#undef PG8_SCHED
}
}
#define XB_TMO      128
#define XB_XCNT(j)  (256  + 64 * (j))
#define XB_XSUB(j)  (1280 + 64 * (j))
#define XB_XGEN(j)  (2304 + 64 * (j))
#define XB_TOP      3328
#define XB_TOPGEN   3392
#define XCD_BAR_WORDS 3456
#define XB_SPIN_CAP (1u << 18)
#define LAS __attribute__((address_space(3)))

__device__ __forceinline__ unsigned xb_ld(unsigned* p)              { return __hip_atomic_load(p, __ATOMIC_RELAXED, __HIP_MEMORY_SCOPE_AGENT); }
__device__ __forceinline__ unsigned xb_add(unsigned* p, unsigned v) { return __hip_atomic_fetch_add(p, v, __ATOMIC_RELAXED, __HIP_MEMORY_SCOPE_AGENT); }
__device__ __forceinline__ unsigned xb_xcc_id() { return (unsigned)__builtin_amdgcn_s_getreg((3 << 11) | 20) & 0xFu; }
#define XB_SPIN(cond, bar) do { unsigned _sp = 0; while (cond) { __builtin_amdgcn_s_sleep(1); \
    if ((++_sp & 255u) == 0u) { if (xb_ld(&(bar)[XB_TMO])) break; if (_sp > XB_SPIN_CAP) { atomicAdd(&(bar)[XB_TMO], 1u); break; } } } } while (0)

struct XcdBarrier {
    unsigned* bar; unsigned x;
    volatile LAS unsigned* st;
};

__device__ __forceinline__ XcdBarrier xcd_barrier_post(unsigned* bar, volatile LAS unsigned* st) {
    XcdBarrier b; b.bar = bar; b.x = xb_xcc_id(); b.st = st;
    if (threadIdx.x == 0) (void)xb_add(&bar[XB_XCNT(b.x)], 1u);
    return b;
}
__device__ __forceinline__ void xcd_barrier_complete(unsigned* bar, unsigned x, unsigned& nloc, unsigned& nx) {
    const unsigned G = gridDim.x * gridDim.y * gridDim.z;
    unsigned sum, cnt, mine, sp = 0u;
    for (;;) {
        sum = 0u; cnt = 0u; mine = 0u;
#pragma unroll
        for (unsigned j = 0; j < 16; ++j) { const unsigned c = xb_ld(&bar[XB_XCNT(j)]); sum += c; cnt += (c > 0u) ? 1u : 0u; mine = (j == x) ? c : mine; }
        if (sum == G) break;
        __builtin_amdgcn_s_sleep(1);
        if ((++sp & 255u) == 0u) { if (xb_ld(&bar[XB_TMO])) break; if (sp > XB_SPIN_CAP) { atomicAdd(&bar[XB_TMO], 1u); break; } }
    }
    nloc = mine > 0u ? mine : 1u; nx = cnt > 0u ? cnt : 1u;
}

__device__ __forceinline__ void xcd_barrier(const XcdBarrier& b) {
    asm volatile("s_waitcnt vmcnt(0)" ::: "memory");
    __syncthreads();
    if (threadIdx.x == 0) {
        unsigned* bar = b.bar;
        __builtin_amdgcn_s_waitcnt(0);
        unsigned nloc = b.st[0], nx = b.st[1];
        if (nloc == 0u) { xcd_barrier_complete(bar, b.x, nloc, nx); b.st[0] = nloc; b.st[1] = nx; }
        const unsigned old = xb_add(&bar[XB_XSUB(b.x)], 1u);
        const unsigned gen = old / nloc;
        if (old + 1u == (gen + 1u) * nloc) {
            __builtin_amdgcn_fence(__ATOMIC_RELEASE, "agent");
            asm volatile("s_waitcnt vmcnt(0)" ::: "memory");
            const unsigned og = xb_add(&bar[XB_TOP], 1u);
            const unsigned tg = og / nx;
            if (og + 1u == (tg + 1u) * nx) xb_add(&bar[XB_TOPGEN], 1u);
            else XB_SPIN(xb_ld(&bar[XB_TOPGEN]) == tg, bar);
            __builtin_amdgcn_fence(__ATOMIC_ACQUIRE, "agent");
            xb_add(&bar[XB_XGEN(b.x)], 1u);
            asm volatile("s_waitcnt vmcnt(0)" ::: "memory");
        } else {
            XB_SPIN(xb_ld(&bar[XB_XGEN(b.x)]) == gen, bar);
            __builtin_amdgcn_fence(__ATOMIC_ACQUIRE, "agent");
            asm volatile("s_waitcnt vmcnt(0)" ::: "memory");
        }
    }
    __syncthreads();
}
constexpr int D = 2048, NB = 8, SEQ = 2048, NL = 4, T = NB * SEQ;
constexpr int NCH = SEQ / 64, NCHUNK = T / 64;
constexpr int GKW = 512, RANK = 16;
constexpr int INW = 6160, NP = 6144;
constexpr int NE = 16384;
constexpr float ALPHA = 1.6817928305074290f, EPS = 1e-5f;
constexpr int PQ = 0, PK = 512, PV = 1024, PR = 2048, PCB = 3072, PCC = 4096, PCH = 5120;
constexpr int NWAVES = 8, NTHREADS = 512;
constexpr int NPHASES = 2 + 7 * NL;

constexpr size_t MiB = 1u << 20;
constexpr size_t WS_CTL = 0, CTL_ZERO_BYTES = 1 * MiB;
constexpr size_t WS_MOD = 1 * MiB, WS_PART = 3 * MiB, WS_KEYS = 15 * MiB, WS_DTOT = 17 * MiB, WS_WIN = 18 * MiB, WS_WOUT = 115 * MiB, WS_WQ = 147 * MiB;
constexpr size_t WS_UT = 179 * MiB, WS_VT = 435 * MiB, WS_H = 691 * MiB, WS_PROJ = 755 * MiB, WS_E = 947 * MiB, WS_OGLA = 979 * MiB, WS_Y = 1043 * MiB;
constexpr size_t WS_Z = 1107 * MiB, WS_X1 = 1235 * MiB, WS_X = 1363 * MiB, WS_Q = 1491 * MiB, WS_H2 = 1555 * MiB, WS_END = 1619 * MiB;
constexpr size_t WS_SU = 17 * MiB + 512 * 1024, WS_SV = 17 * MiB + 768 * 1024;
static_assert(WS_WIN + (size_t)NL * INW * D * 2 <= WS_WOUT && WS_PART + (size_t)NL * 8 * NB * 6 * D * 4 <= WS_KEYS && WS_MOD + (size_t)NL * NB * 6 * D * 4 <= WS_PART, "ws map");
constexpr int CW_BAR = 4096;

constexpr int RING_OFF = 0, RING_BYTES = 131072, LDSCTL_OFF = RING_BYTES, LDS_BYTES = 147456;

#define GAS __attribute__((address_space(1)))
typedef unsigned short bf16;
typedef unsigned v4u __attribute__((ext_vector_type(4)));
typedef unsigned v2u __attribute__((ext_vector_type(2)));
typedef float f32x4 __attribute__((ext_vector_type(4)));
typedef float f32x16 __attribute__((ext_vector_type(16)));
typedef short bf16x8 __attribute__((ext_vector_type(8)));
typedef __bf16 bf16x2v __attribute__((ext_vector_type(2)));
#define LDS_WAIT() asm volatile("s_waitcnt lgkmcnt(0)" ::: "memory")

__device__ __forceinline__ unsigned pk2(float lo, float hi) { return pg8::cvt_pk_bf16(lo, hi); }
__device__ __forceinline__ float dot2bf(unsigned w, unsigned x, float acc) { return __builtin_amdgcn_fdot2_f32_bf16(__builtin_bit_cast(bf16x2v, w), __builtin_bit_cast(bf16x2v, x), acc, false); }
__device__ __forceinline__ float bflo(unsigned u) { return __uint_as_float(u << 16); }
__device__ __forceinline__ float bfhi(unsigned u) { return __uint_as_float(u & 0xffff0000u); }
__device__ __forceinline__ float silu_f(float x) { return x / (1.0f + __expf(-x)); }
__device__ __forceinline__ float logsigmoid_f(float x) { return fminf(x, 0.0f) - log1pf(__expf(-fabsf(x))); }
__device__ __forceinline__ float gelu_tanh_f(float x) { const float u = 0.7978845608028654f * (x + 0.044715f * x * x * x); return 0.5f * x * (1.0f + tanhf(u)); }
__device__ __forceinline__ float wave_sum(float v) {
#pragma unroll
    for (int o = 1; o < 64; o <<= 1) v += __shfl_xor(v, o);
    return v;
}

struct Args { const float* in[19]; float* out; unsigned char* ws; int ph_lo, ph_hi; };

__device__ __forceinline__ void transpose_item(const float* W, int ldw, int col0, bf16* WTrows, int k0, int nvalid, LAS float* scr, int lane) {
    const int n = lane & 31;
#pragma unroll 8
    for (int i = 0; i < 32; ++i) { const int kk = 2 * i + (lane >> 5); scr[kk * 33 + n] = (n < nvalid) ? W[(size_t)(k0 + kk) * ldw + col0 + n] : 0.f; }
    LDS_WAIT(); asm volatile("" ::: "memory");
    const int c = lane & 7;
#pragma unroll
    for (int j = 0; j < 4; ++j) { const int nn = (lane >> 3) + 8 * j; const LAS float* s = scr + (8 * c) * 33 + nn;
        v4u o; o.x = pk2(s[0 * 33], s[1 * 33]); o.y = pk2(s[2 * 33], s[3 * 33]); o.z = pk2(s[4 * 33], s[5 * 33]); o.w = pk2(s[6 * 33], s[7 * 33]);
        if (nn < nvalid) *(v4u*)(WTrows + (size_t)nn * D + k0 + 8 * c) = o; }
    LDS_WAIT(); asm volatile("" ::: "memory");
}
__device__ __forceinline__ void cvt_stream(const float* src, bf16* dst, size_t n4, size_t i0, size_t stride) {
    for (size_t i = i0; i < n4; i += stride) { const f32x4 v = ((const f32x4*)src)[i]; v2u o; o.x = pk2(v.x, v.y); o.y = pk2(v.z, v.w); ((v2u*)dst)[i] = o; }
}
__device__ __forceinline__ void ph_prologue_a(const Args& a, LAS unsigned char* lds, int tid, int lane, int wave, int bx, int G) {
    const int gw = bx * NWAVES + wave, NGW = G * NWAVES;
    LAS float* cact = (LAS float*)lds;
    for (int i = tid; i < NB * D; i += NTHREADS) { const int b = i / D, d = i % D; cact[d * 8 + b] = silu_f(a.in[1][i]); }
    __syncthreads();
    float* part = (float*)(a.ws + WS_PART);
    for (int it = gw; it < NL * 8 * 48; it += NGW) {
        const int cg = it % 48, dr = (it / 48) % 8, l = it / 384;
        f32x4 acc[8];
#pragma unroll
        for (int b = 0; b < 8; ++b) acc[b] = (f32x4){0.f, 0.f, 0.f, 0.f};
        const float* w = a.in[2] + ((size_t)l * D + dr * 256) * (6 * D) + cg * 256 + lane * 4;
#pragma unroll 4
        for (int d = 0; d < 256; ++d) {
            const f32x4 wv = *(const f32x4*)(w + (size_t)d * (6 * D));
            const f32x4 c0 = *(const LAS f32x4*)(cact + (dr * 256 + d) * 8), c1 = *(const LAS f32x4*)(cact + (dr * 256 + d) * 8 + 4);
            acc[0] += wv * c0.x; acc[1] += wv * c0.y; acc[2] += wv * c0.z; acc[3] += wv * c0.w;
            acc[4] += wv * c1.x; acc[5] += wv * c1.y; acc[6] += wv * c1.z; acc[7] += wv * c1.w;
        }
#pragma unroll
        for (int b = 0; b < 8; ++b) *(f32x4*)(part + (((size_t)l * 8 + dr) * NB + b) * (6 * D) + cg * 256 + lane * 4) = acc[b];
    }
    __syncthreads();
    LAS float* scr = (LAS float*)(lds + wave * 8448);
    bf16* winT = (bf16*)(a.ws + WS_WIN); bf16* woutT = (bf16*)(a.ws + WS_WOUT); bf16* wqT = (bf16*)(a.ws + WS_WQ);
    constexpr int IPL = 6144 + 32 + 2048 + 2048;
    for (int it = gw; it < NL * IPL; it += NGW) {
        const int l = it / IPL; int r = it % IPL;
        if (r < 6144) { const int nb = r % 192, kb = r / 192, n0 = nb * 32;
            transpose_item(a.in[4] + (size_t)l * D * INW, INW, n0 < 3072 ? n0 : n0 + 16, winT + ((size_t)l * INW + n0) * D, kb * 64, 32, scr, lane); continue; }
        r -= 6144;
        if (r < 32) { transpose_item(a.in[4] + (size_t)l * D * INW, INW, 3072, winT + ((size_t)l * INW + NP) * D, r * 64, 16, scr, lane); continue; }
        r -= 32;
        if (r < 2048) { const int nb = r % 64, kb = r / 64; transpose_item(a.in[10] + (size_t)l * D * D, D, nb * 32, woutT + ((size_t)l * D + nb * 32) * D, kb * 64, 32, scr, lane); continue; }
        r -= 2048;
        { const int nb = r % 64, kb = r / 64; transpose_item(a.in[13] + (size_t)l * D * D, D, nb * 32, wqT + ((size_t)l * D + nb * 32) * D, kb * 64, 32, scr, lane); }
    }
    const size_t i0 = (size_t)bx * NTHREADS + tid, stride = (size_t)G * NTHREADS;
    cvt_stream(a.in[14], (bf16*)(a.ws + WS_KEYS), (size_t)NL * 8 * 2 * 128 * 128 / 4, i0, stride);
    for (int row = gw; row < 2 * NL * NE; row += NGW) {
        const int tbl = row / (NL * NE), r = row % (NL * NE);
        const float* src = (tbl ? a.in[16] : a.in[15]) + (size_t)r * D;
        f32x4 v[8]; float mx = 0.f;
#pragma unroll
        for (int c8 = 0; c8 < 8; ++c8) { v[c8] = *(const f32x4*)(src + (c8 * 64 + lane) * 4); mx = fmaxf(mx, fmaxf(fmaxf(fabsf(v[c8].x), fabsf(v[c8].y)), fmaxf(fabsf(v[c8].z), fabsf(v[c8].w)))); }
#pragma unroll
        for (int o = 1; o < 64; o <<= 1) mx = fmaxf(mx, __shfl_xor(mx, o));
        const float inv = mx > 0.f ? 127.0f / mx : 0.f; const int off = tbl ? 128 : 0;
        unsigned dw[8];
#pragma unroll
        for (int c8 = 0; c8 < 8; ++c8) { const int q0 = (int)__builtin_rintf(v[c8].x * inv) + off, q1 = (int)__builtin_rintf(v[c8].y * inv) + off, q2 = (int)__builtin_rintf(v[c8].z * inv) + off, q3 = (int)__builtin_rintf(v[c8].w * inv) + off;
            dw[c8] = (unsigned)(q0 & 255) | ((unsigned)(q1 & 255) << 8) | ((unsigned)(q2 & 255) << 16) | ((unsigned)(q3 & 255) << 24); }
        unsigned char* dst = a.ws + (tbl ? WS_VT : WS_UT) + (size_t)r * D;
        *(v4u*)(dst + lane * 16) = (v4u){dw[0], dw[1], dw[2], dw[3]}; *(v4u*)(dst + (64 + lane) * 16) = (v4u){dw[4], dw[5], dw[6], dw[7]};
        if (lane == 0) ((float*)(a.ws + (tbl ? WS_SV : WS_SU)))[r] = mx * (1.0f / 127.0f);
    }
}

__device__ __forceinline__ void ln_tail(const float (&z)[32], int t, int lane, const float* g, const float* bta, float* xout, const float* sh, const float* sc, bf16* hout) {
    float s = 0.f;
#pragma unroll
    for (int i = 0; i < 32; ++i) s += z[i];
    const float mu = wave_sum(s) * (1.0f / D);
    float q = 0.f;
#pragma unroll
    for (int i = 0; i < 32; ++i) { const float d = z[i] - mu; q += d * d; }
    const float rs = rsqrtf(wave_sum(q) * (1.0f / D) + EPS);
#pragma unroll
    for (int c = 0; c < 8; ++c) { const int col = (c * 64 + lane) * 4;
        const f32x4 g0 = *(const f32x4*)(g + col), b0 = *(const f32x4*)(bta + col);
        f32x4 x0;
        x0.x = (z[c * 4 + 0] - mu) * rs * g0.x + b0.x; x0.y = (z[c * 4 + 1] - mu) * rs * g0.y + b0.y; x0.z = (z[c * 4 + 2] - mu) * rs * g0.z + b0.z; x0.w = (z[c * 4 + 3] - mu) * rs * g0.w + b0.w;
        if (xout) *(f32x4*)(xout + (size_t)t * D + col) = x0;
        if (hout) { const f32x4 s0 = *(const f32x4*)(sc + col), h0 = *(const f32x4*)(sh + col);
            v2u o; o.x = pk2(x0.x * (1.f + s0.x) + h0.x, x0.y * (1.f + s0.y) + h0.y); o.y = pk2(x0.z * (1.f + s0.z) + h0.z, x0.w * (1.f + s0.w) + h0.w);
            *(v2u*)(hout + (size_t)t * D + col) = o; }
    }
}

__device__ __forceinline__ void ph_prologue_b(const Args& a, LAS unsigned char* lds, int tid, int lane, int wave, int bx, int G) {
    const float* part = (const float*)(a.ws + WS_PART); float* mod = (float*)(a.ws + WS_MOD);
    for (int i = bx * NTHREADS + tid; i < NL * NB * 6 * D / 4; i += G * NTHREADS) {
        const int idx = i * 4, e = idx % (6 * D), b = (idx / (6 * D)) % NB, l = idx / (6 * D * NB);
        f32x4 s = *(const f32x4*)(a.in[3] + l * 6 * D + e);
#pragma unroll
        for (int dr = 0; dr < 8; ++dr) s += *(const f32x4*)(part + (((size_t)l * 8 + dr) * NB + b) * (6 * D) + e);
        *(f32x4*)(mod + idx) = s;
    }
    LAS float* msh = (LAS float*)lds;
    bf16* hbuf = (bf16*)(a.ws + WS_H);
    for (int ch = bx; ch < NCHUNK; ch += G) {
        const int b = ch / NCH;
        for (int i = tid; i < 1024; i += NTHREADS) { const int e = i * 4;
            f32x4 s = *(const f32x4*)(a.in[3] + e);
#pragma unroll
            for (int dr = 0; dr < 8; ++dr) s += *(const f32x4*)(part + (((size_t)0 * 8 + dr) * NB + b) * (6 * D) + e);
            *(LAS f32x4*)(msh + e) = s; }
        __syncthreads();
        for (int i = 0; i < 8; ++i) { const int t = ch * 64 + wave * 8 + i;
#pragma unroll
            for (int c = 0; c < 4; ++c) { const int col = (c * 64 + lane) * 8;
                const f32x4 x0 = *(const f32x4*)(a.in[0] + (size_t)t * D + col), x1 = *(const f32x4*)(a.in[0] + (size_t)t * D + col + 4);
                const f32x4 h0 = *(const LAS f32x4*)(msh + col), h1 = *(const LAS f32x4*)(msh + col + 4), s0 = *(const LAS f32x4*)(msh + 2048 + col), s1 = *(const LAS f32x4*)(msh + 2048 + col + 4);
                v4u o; o.x = pk2(x0.x * (1.f + s0.x) + h0.x, x0.y * (1.f + s0.y) + h0.y); o.y = pk2(x0.z * (1.f + s0.z) + h0.z, x0.w * (1.f + s0.w) + h0.w);
                o.z = pk2(x1.x * (1.f + s1.x) + h1.x, x1.y * (1.f + s1.y) + h1.y); o.w = pk2(x1.z * (1.f + s1.z) + h1.z, x1.w * (1.f + s1.w) + h1.w);
                *(v4u*)(hbuf + (size_t)t * D + col) = o; } }
        __syncthreads();
    }
}

__device__ __forceinline__ void gate_prep(const Args& a, int l, LAS unsigned char* lds, int tid, int lane, int wave, int ch) {
    const bf16* hbuf = (const bf16*)(a.ws + WS_H); const bf16* waT = (const bf16*)(a.ws + WS_WIN) + ((size_t)l * INW + NP) * D;
    float* Ebuf = (float*)(a.ws + WS_E); float* dtot = (float*)(a.ws + WS_DTOT);
    const int t0 = ch * 64, l15 = lane & 15, lq = lane >> 4, mt = wave & 3, kh = wave >> 2;
    f32x4 acc = (f32x4){0.f, 0.f, 0.f, 0.f};
    const bf16* hA = hbuf + (size_t)(t0 + 16 * mt + l15) * D + kh * 1024 + 8 * lq;
    const bf16* wB = waT + (size_t)l15 * D + kh * 1024 + 8 * lq;
#pragma unroll 8
    for (int ks = 0; ks < 32; ++ks) { const bf16x8 av = *(const bf16x8*)(hA + 32 * ks), bv = *(const bf16x8*)(wB + 32 * ks); acc = __builtin_amdgcn_mfma_f32_16x16x32_bf16(av, bv, acc, 0, 0, 0); }
    LAS float* alr = (LAS float*)lds;
#pragma unroll
    for (int r = 0; r < 4; ++r) alr[(kh * 64 + 16 * mt + 4 * lq + r) * 16 + l15] = acc[r];
    __syncthreads();
    const int col = tid;
    float wg[16];
#pragma unroll
    for (int r = 0; r < 16; ++r) wg[r] = a.in[5][((size_t)l * RANK + r) * GKW + col];
    const float bgc = a.in[6][l * GKW + col];
    float tot = 0.f;
    for (int j = 0; j < 64; ++j) { float lg = bgc;
#pragma unroll
        for (int r4 = 0; r4 < 4; ++r4) { const f32x4 p = *(const LAS f32x4*)(alr + j * 16 + r4 * 4), q = *(const LAS f32x4*)(alr + (64 + j) * 16 + r4 * 4);
            lg += (p.x + q.x) * wg[r4 * 4] + (p.y + q.y) * wg[r4 * 4 + 1] + (p.z + q.z) * wg[r4 * 4 + 2] + (p.w + q.w) * wg[r4 * 4 + 3]; }
        tot += logsigmoid_f(lg) * (1.0f / 16.0f); }
    float run = 0.f;
    for (int j = 0; j < 64; ++j) { float lg = bgc;
#pragma unroll
        for (int r4 = 0; r4 < 4; ++r4) { const f32x4 p = *(const LAS f32x4*)(alr + j * 16 + r4 * 4), q = *(const LAS f32x4*)(alr + (64 + j) * 16 + r4 * 4);
            lg += (p.x + q.x) * wg[r4 * 4] + (p.y + q.y) * wg[r4 * 4 + 1] + (p.z + q.z) * wg[r4 * 4 + 2] + (p.w + q.w) * wg[r4 * 4 + 3]; }
        run += logsigmoid_f(lg) * (1.0f / 16.0f);
        Ebuf[(size_t)(t0 + j) * GKW + col] = __expf(tot - run); }
    dtot[(size_t)ch * GKW + col] = __expf(tot);
    __syncthreads();
}

__device__ __forceinline__ void gla_unit(const Args& a, LAS unsigned char* lds, int tid, int lane, int wave, int un) {
    const bf16* proj = (const bf16*)(a.ws + WS_PROJ); const float* Ebuf = (const float*)(a.ws + WS_E); const float* dtot = (const float*)(a.ws + WS_DTOT); float* ogla = (float*)(a.ws + WS_OGLA);
    const int dvs = un & 7, hh = (un >> 3) & 3, b = un >> 5;
    LAS bf16* kdT = (LAS bf16*)lds;
    LAS bf16* vT = (LAS bf16*)(lds + 18432);
    LAS bf16* ST = (LAS bf16*)(lds + 18432 + 4608);
    const int l15 = lane & 15, lq = lane >> 4, jl = tid >> 3, d16 = (tid & 7) * 16, dv4 = (tid & 7) * 4, jt = (wave & 3) * 16, dvt = (wave >> 2) * 16;
    f32x4 S0 = (f32x4){0.f, 0.f, 0.f, 0.f}, S1 = (f32x4){0.f, 0.f, 0.f, 0.f};
    v4u kn[2]; f32x4 en[4]; v2u vn; bf16x8 qn[4], qc[4]; f32x4 dn, dc;
#define GLA_LOAD(c) do { const int t0c = b * SEQ + (c) * 64; const bf16* pr = proj + (size_t)(t0c + jl) * NP; \
        kn[0] = *(const v4u*)(pr + PK + hh * 128 + d16); kn[1] = *(const v4u*)(pr + PK + hh * 128 + d16 + 8); \
        _Pragma("unroll") for (int i_ = 0; i_ < 4; ++i_) en[i_] = *(const f32x4*)(Ebuf + (size_t)(t0c + jl) * GKW + hh * 128 + d16 + 4 * i_); \
        vn = *(const v2u*)(pr + PV + hh * 256 + dvs * 32 + dv4); \
        _Pragma("unroll") for (int ks_ = 0; ks_ < 4; ++ks_) qn[ks_] = *(const bf16x8*)(proj + (size_t)(t0c + jt + l15) * NP + PQ + hh * 128 + 32 * ks_ + 8 * lq); \
        dn = *(const f32x4*)(dtot + (size_t)(b * NCH + (c)) * GKW + hh * 128 + 16 * wave + 4 * lq); } while (0)
#define GLA_PREP() do { \
        _Pragma("unroll") for (int i_ = 0; i_ < 16; ++i_) { const unsigned w_ = kn[i_ >> 3][(i_ & 7) >> 1]; const float kf_ = (i_ & 1) ? bfhi(w_) : bflo(w_); \
            kdT[(d16 + i_) * 72 + jl] = (bf16)(pk2(kf_ * en[i_ >> 2][i_ & 3], 0.f) & 0xffffu); } \
        _Pragma("unroll") for (int i_ = 0; i_ < 4; ++i_) { const unsigned w_ = vn[i_ >> 1]; vT[(dv4 + i_) * 72 + jl] = (bf16)((i_ & 1) ? (w_ >> 16) : (w_ & 0xffffu)); } \
        _Pragma("unroll") for (int ks_ = 0; ks_ < 4; ++ks_) qc[ks_] = qn[ks_]; \
        dc = dn; } while (0)
    GLA_LOAD(0); GLA_PREP();
    __syncthreads();
    for (int c = 0; c < NCH; ++c) {
        if (c + 1 < NCH) GLA_LOAD(c + 1);
        S0 = S0 * dc; S1 = S1 * dc;
#pragma unroll
        for (int ks = 0; ks < 2; ++ks) {
            const bf16x8 A = *(const LAS bf16x8*)(kdT + (16 * wave + l15) * 72 + 32 * ks + 8 * lq);
            const bf16x8 B0 = *(const LAS bf16x8*)(vT + l15 * 72 + 32 * ks + 8 * lq), B1 = *(const LAS bf16x8*)(vT + (16 + l15) * 72 + 32 * ks + 8 * lq);
            S0 = __builtin_amdgcn_mfma_f32_16x16x32_bf16(A, B0, S0, 0, 0, 0); S1 = __builtin_amdgcn_mfma_f32_16x16x32_bf16(A, B1, S1, 0, 0, 0); }
        { v2u w0, w1; w0.x = pk2(S0.x, S0.y); w0.y = pk2(S0.z, S0.w); w1.x = pk2(S1.x, S1.y); w1.y = pk2(S1.z, S1.w);
          *(LAS v2u*)(ST + l15 * 136 + 16 * wave + 4 * lq) = w0; *(LAS v2u*)(ST + (16 + l15) * 136 + 16 * wave + 4 * lq) = w1; }
        __syncthreads();
        f32x4 O = (f32x4){0.f, 0.f, 0.f, 0.f};
#pragma unroll
        for (int ks = 0; ks < 4; ++ks) { const bf16x8 A = *(const LAS bf16x8*)(ST + (dvt + l15) * 136 + 32 * ks + 8 * lq); O = __builtin_amdgcn_mfma_f32_16x16x32_bf16(A, qc[ks], O, 0, 0, 0); }
        *(f32x4*)(ogla + (size_t)(b * SEQ + c * 64 + jt + l15) * 1024 + hh * 256 + dvs * 32 + dvt + 4 * lq) = O * 0.08838834764831845f;
        if (c + 1 < NCH) GLA_PREP();
        __syncthreads();
    }
#undef GLA_LOAD
#undef GLA_PREP
}

__device__ __forceinline__ void unpack16(const v4u& p0, const v4u& p1, float (&o)[16]) {
#pragma unroll
    for (int j = 0; j < 4; ++j) { o[2 * j] = bflo(p0[j]); o[2 * j + 1] = bfhi(p0[j]); o[8 + 2 * j] = bflo(p1[j]); o[8 + 2 * j + 1] = bfhi(p1[j]); }
}
__device__ __forceinline__ void mixpost_chunk(const Args& a, int l, int lane, int wave, int ch) {
    const bf16* proj = (const bf16*)(a.ws + WS_PROJ); const float* ogla = (const float*)(a.ws + WS_OGLA); bf16* ybuf = (bf16*)(a.ws + WS_Y);
    const int c0 = 16 * lane, tfirst = ch * 64 + wave * 8, sfirst = tfirst % SEQ;
    float gn[16], cw0[16], cw1[16], cw2[16], cn[16], u1[16], u2[16];
#pragma unroll
    for (int i = 0; i < 16; ++i) { gn[i] = a.in[7][l * 256 + ((c0 + i) & 255)]; cw0[i] = a.in[8][(size_t)l * 3072 + c0 + i]; cw1[i] = a.in[8][(size_t)l * 3072 + 1024 + c0 + i];
        cw2[i] = a.in[8][(size_t)l * 3072 + 2048 + c0 + i]; cn[i] = a.in[9][l * 1024 + c0 + i]; u1[i] = 0.f; u2[i] = 0.f; }
    if (sfirst >= 2) {
        float cc[16], chh[16];
        { const bf16* pr = proj + (size_t)(tfirst - 2) * NP; unpack16(*(const v4u*)(pr + PCC + c0), *(const v4u*)(pr + PCC + c0 + 8), cc); unpack16(*(const v4u*)(pr + PCH + c0), *(const v4u*)(pr + PCH + c0 + 8), chh); }
#pragma unroll
        for (int i = 0; i < 16; ++i) u2[i] = cc[i] * chh[i];
        { const bf16* pr = proj + (size_t)(tfirst - 1) * NP; unpack16(*(const v4u*)(pr + PCC + c0), *(const v4u*)(pr + PCC + c0 + 8), cc); unpack16(*(const v4u*)(pr + PCH + c0), *(const v4u*)(pr + PCH + c0 + 8), chh); }
#pragma unroll
        for (int i = 0; i < 16; ++i) u1[i] = cc[i] * chh[i];
    }
    for (int it = 0; it < 8; ++it) { const int t = tfirst + it; const bf16* pr = proj + (size_t)t * NP;
        float o[16], r[16], cb[16], cc[16], chh[16];
#pragma unroll
        for (int j = 0; j < 4; ++j) { const f32x4 v = *(const f32x4*)(ogla + (size_t)t * 1024 + c0 + 4 * j); o[4 * j] = v.x; o[4 * j + 1] = v.y; o[4 * j + 2] = v.z; o[4 * j + 3] = v.w; }
        unpack16(*(const v4u*)(pr + PR + c0), *(const v4u*)(pr + PR + c0 + 8), r);
        unpack16(*(const v4u*)(pr + PCB + c0), *(const v4u*)(pr + PCB + c0 + 8), cb);
        unpack16(*(const v4u*)(pr + PCC + c0), *(const v4u*)(pr + PCC + c0 + 8), cc);
        unpack16(*(const v4u*)(pr + PCH + c0), *(const v4u*)(pr + PCH + c0 + 8), chh);
        float ss = 0.f;
#pragma unroll
        for (int i = 0; i < 16; ++i) ss += o[i] * o[i];
        ss += __shfl_xor(ss, 1); ss += __shfl_xor(ss, 2); ss += __shfl_xor(ss, 4); ss += __shfl_xor(ss, 8);
        const float rg = rsqrtf(ss * (1.0f / 256.f) + EPS);
        float val[16]; float s2 = 0.f;
#pragma unroll
        for (int i = 0; i < 16; ++i) { const float u0 = cc[i] * chh[i]; val[i] = cb[i] * (cw0[i] * u2[i] + cw1[i] * u1[i] + cw2[i] * u0); s2 += val[i] * val[i]; u2[i] = u1[i]; u1[i] = u0; }
        const float rc = rsqrtf(wave_sum(s2) * (1.0f / 1024.f) + EPS);
        v4u y0, y1, y2, y3;
#pragma unroll
        for (int j = 0; j < 4; ++j) {
            y0[j] = pk2(o[2 * j] * rg * gn[2 * j] * silu_f(r[2 * j]), o[2 * j + 1] * rg * gn[2 * j + 1] * silu_f(r[2 * j + 1]));
            y1[j] = pk2(o[8 + 2 * j] * rg * gn[8 + 2 * j] * silu_f(r[8 + 2 * j]), o[9 + 2 * j] * rg * gn[9 + 2 * j] * silu_f(r[9 + 2 * j]));
            y2[j] = pk2(val[2 * j] * rc * cn[2 * j], val[2 * j + 1] * rc * cn[2 * j + 1]);
            y3[j] = pk2(val[8 + 2 * j] * rc * cn[8 + 2 * j], val[9 + 2 * j] * rc * cn[9 + 2 * j]); }
        bf16* yr = ybuf + (size_t)t * D;
        *(v4u*)(yr + c0) = y0; *(v4u*)(yr + c0 + 8) = y1; *(v4u*)(yr + 1024 + c0) = y2; *(v4u*)(yr + 1024 + c0 + 8) = y3;
    }
}

__device__ __forceinline__ void ln1_chunk(const Args& a, int l, int lane, int wave, int ch) {
    const float* zbuf = (const float*)(a.ws + WS_Z); const float* mod = (const float*)(a.ws + WS_MOD);
    const int b = ch / NCH; const float* mb = mod + ((size_t)l * NB + b) * 6 * D;
    for (int it = 0; it < 8; ++it) { const int t = ch * 64 + wave * 8 + it;
        float z[32];
#pragma unroll
        for (int c = 0; c < 8; ++c) { const f32x4 v0 = *(const f32x4*)(zbuf + (size_t)t * D + (c * 64 + lane) * 4); z[c * 4] = v0.x; z[c * 4 + 1] = v0.y; z[c * 4 + 2] = v0.z; z[c * 4 + 3] = v0.w; }
        ln_tail(z, t, lane, a.in[11] + (size_t)l * D, a.in[12] + (size_t)l * D, (float*)(a.ws + WS_X1), mb + 3 * D, mb + 4 * D, (bf16*)(a.ws + WS_H2));
    }
}

template <int N> __device__ __forceinline__ void bitonic_sort_desc(float (&v)[N]) {
#pragma unroll
    for (int k = 2; k <= N; k <<= 1)
#pragma unroll
        for (int j = k >> 1; j > 0; j >>= 1)
#pragma unroll
            for (int i = 0; i < N; ++i) { const int p = i ^ j; if (p > i) { const bool desc = ((i & k) == 0); const float x = v[i], y = v[p]; const float mx = fmaxf(x, y), mn = fminf(x, y); v[i] = desc ? mx : mn; v[p] = desc ? mn : mx; } }
}
__device__ __forceinline__ void merge_top16(float (&x)[16], const float (&y)[16]) {
#pragma unroll
    for (int i = 0; i < 16; ++i) x[i] = fmaxf(x[i], y[15 - i]);
#pragma unroll
    for (int j = 8; j > 0; j >>= 1)
#pragma unroll
        for (int i = 0; i < 16; ++i) { const int p = i ^ j; if (p > i) { const float u = x[i], w = x[p]; x[i] = fmaxf(u, w); x[p] = fminf(u, w); } }
}
__device__ __forceinline__ void ce_desc(float& ka, int& pa, float& kb, int& pb) { const bool sw = kb > ka; const float k0 = sw ? kb : ka, k1 = sw ? ka : kb; const int p0 = sw ? pb : pa, p1 = sw ? pa : pb; ka = k0; pa = p0; kb = k1; pb = p1; }
__device__ __forceinline__ void bitonic_sort_desc_kp(float (&k)[16], int (&p)[16]) {
#pragma unroll
    for (int kk = 2; kk <= 16; kk <<= 1)
#pragma unroll
        for (int j = kk >> 1; j > 0; j >>= 1)
#pragma unroll
            for (int i = 0; i < 16; ++i) { const int q = i ^ j; if (q > i) { if ((i & kk) == 0) ce_desc(k[i], p[i], k[q], p[q]); else ce_desc(k[q], p[q], k[i], p[i]); } }
}
__device__ __forceinline__ void merge_top16_kp(float (&k)[16], int (&p)[16], const float (&k2)[16], const int (&p2)[16]) {
#pragma unroll
    for (int i = 0; i < 16; ++i) { const bool sw = k2[15 - i] > k[i]; k[i] = sw ? k2[15 - i] : k[i]; p[i] = sw ? p2[15 - i] : p[i]; }
#pragma unroll
    for (int j = 8; j > 0; j >>= 1)
#pragma unroll
        for (int i = 0; i < 16; ++i) { const int q = i ^ j; if (q > i) ce_desc(k[i], p[i], k[q], p[q]); }
}
__device__ constexpr int cand_i(int s) { return s < 16 ? 0 : s < 24 ? 1 : s < 29 ? 2 : s < 33 ? 3 : s < 36 ? 4 : s < 38 ? 5 : s < 40 ? 6 : s < 42 ? 7 : s < 50 ? s - 34 : -1; }
__device__ constexpr int cand_j(int s) { return s < 16 ? s : s < 24 ? s - 16 : s < 29 ? s - 24 : s < 33 ? s - 29 : s < 36 ? s - 33 : s < 38 ? s - 36 : s < 40 ? s - 38 : s < 42 ? s - 40 : s < 50 ? 0 : -1; }

__device__ __forceinline__ void peer_retrieve(const Args& a, int l, LAS unsigned char* lds, int lane, int wave, int ch) {
    const bf16* qbuf = (const bf16*)(a.ws + WS_Q); const bf16* keys = (const bf16*)(a.ws + WS_KEYS) + ((size_t)(l * 8 + wave) * 2) * 128 * 128;
    LAS int* eg_e = (LAS int*)lds; LAS float* eg_g = (LAS float*)(lds + 32768);
    const int l31 = lane & 31, l5 = lane >> 5, h = wave, t0 = ch * 64;
    for (int tt = 0; tt < 2; ++tt) {
        float sv[2][16];
#pragma unroll
        for (int p = 0; p < 2; ++p) {
            f32x16 acc[4];
#pragma unroll
            for (int nt = 0; nt < 4; ++nt)
#pragma unroll
                for (int r = 0; r < 16; ++r) acc[nt][r] = 0.f;
            const bf16* qp = qbuf + (size_t)(t0 + 32 * tt + l31) * D + h * 256 + p * 128 + 8 * l5;
            const bf16* kp = keys + (size_t)(p * 128 + l31) * 128 + 8 * l5;
#pragma unroll 2
            for (int ks = 0; ks < 8; ++ks) { const bf16x8 bq = *(const bf16x8*)(qp + 16 * ks);
#pragma unroll
                for (int nt = 0; nt < 4; ++nt) { const bf16x8 ak = *(const bf16x8*)(kp + (size_t)(32 * nt) * 128 + 16 * ks); acc[nt] = __builtin_amdgcn_mfma_f32_32x32x16_bf16(ak, bq, acc[nt], 0, 0, 0); } }
            float v[4][16];
#pragma unroll
            for (int nt = 0; nt < 4; ++nt)
#pragma unroll
                for (int r = 0; r < 16; ++r) { const unsigned idx = 32u * nt + (r & 3) + 8u * (r >> 2) + 4u * l5; v[nt][r] = __uint_as_float((__float_as_uint(acc[nt][r]) & 0xffffff80u) | idx); }
#pragma unroll
            for (int nt = 0; nt < 4; ++nt) bitonic_sort_desc<16>(v[nt]);
            merge_top16(v[0], v[1]); merge_top16(v[2], v[3]); merge_top16(v[0], v[2]);
            float o[16];
#pragma unroll
            for (int i = 0; i < 16; ++i) o[i] = __shfl_xor(v[0][i], 32);
            merge_top16(v[0], o);
#pragma unroll
            for (int i = 0; i < 16; ++i) sv[p][i] = v[0][i];
        }
        LAS unsigned char* idxb = (LAS unsigned char*)(lds + 69632) + wave * 2048 + lane * 32;
        { v4u w0, w1;
#pragma unroll
          for (int q4 = 0; q4 < 4; ++q4) {
              w0[q4] = (__float_as_uint(sv[0][4 * q4]) & 127u) | ((__float_as_uint(sv[0][4 * q4 + 1]) & 127u) << 8) | ((__float_as_uint(sv[0][4 * q4 + 2]) & 127u) << 16) | ((__float_as_uint(sv[0][4 * q4 + 3]) & 127u) << 24);
              w1[q4] = (__float_as_uint(sv[1][4 * q4]) & 127u) | ((__float_as_uint(sv[1][4 * q4 + 1]) & 127u) << 8) | ((__float_as_uint(sv[1][4 * q4 + 2]) & 127u) << 16) | ((__float_as_uint(sv[1][4 * q4 + 3]) & 127u) << 24); }
          *(LAS v4u*)(idxb) = w0; *(LAS v4u*)(idxb + 16) = w1; }
        float ck[4][16];
#pragma unroll
        for (int s = 0; s < 64; ++s) {
            if (cand_i(s) >= 0) { const unsigned b0 = __float_as_uint(sv[0][cand_i(s) < 0 ? 0 : cand_i(s)]), b1 = __float_as_uint(sv[1][cand_j(s) < 0 ? 0 : cand_j(s)]);
                const float sum = __uint_as_float(b0 & 0xffffff80u) + __uint_as_float(b1 & 0xffffff80u);
                ck[s >> 4][s & 15] = __uint_as_float((__float_as_uint(sum) & 0xffffff00u) | (unsigned)((cand_i(s) < 0 ? 0 : cand_i(s)) * 16 + (cand_j(s) < 0 ? 0 : cand_j(s)))); }
            else ck[s >> 4][s & 15] = -3.0e38f; }
        bitonic_sort_desc<16>(ck[1]); bitonic_sort_desc<16>(ck[2]);
        merge_top16(ck[0], ck[1]); merge_top16(ck[2], ck[3]); merge_top16(ck[0], ck[2]);
        LDS_WAIT(); asm volatile("" ::: "memory");
        float ex[16]; int ce[16]; float den = 0.f;
        const float cmax = __uint_as_float(__float_as_uint(ck[0][0]) & 0xffffff00u);
#pragma unroll
        for (int i = 0; i < 16; ++i) { const unsigned bits = __float_as_uint(ck[0][i]); ex[i] = __expf(__uint_as_float(bits & 0xffffff00u) - cmax); den += ex[i];
            ce[i] = (int)idxb[(bits >> 4) & 15u] * 128 + (int)idxb[16 + (bits & 15u)]; }
        const float inv = 1.0f / den;
        if (l5 == 0) {
            const int base = (32 * tt + l31) * 128 + h * 16;
#pragma unroll
            for (int i4 = 0; i4 < 4; ++i4) { *(LAS v4u*)(eg_e + base + 4 * i4) = (v4u){(unsigned)ce[4 * i4], (unsigned)ce[4 * i4 + 1], (unsigned)ce[4 * i4 + 2], (unsigned)ce[4 * i4 + 3]};
                *(LAS f32x4*)(eg_g + base + 4 * i4) = (f32x4){ex[4 * i4] * inv, ex[4 * i4 + 1] * inv, ex[4 * i4 + 2] * inv, ex[4 * i4 + 3] * inv}; }
        }
        LDS_WAIT(); asm volatile("" ::: "memory");
    }
}

typedef unsigned char uc4 __attribute__((ext_vector_type(4)));
__device__ __forceinline__ int sdot4i(unsigned w, unsigned x, int acc) { return __builtin_amdgcn_sdot4((int)w, (int)x, acc, false); }
__device__ __forceinline__ void fma_ub4(unsigned w, float s, float& y0, float& y1, float& y2, float& y3) { const uc4 b = __builtin_bit_cast(uc4, w); y0 += s * (float)b.x; y1 += s * (float)b.y; y2 += s * (float)b.z; y3 += s * (float)b.w; }
__device__ __forceinline__ void peer_experts(const Args& a, int l, LAS unsigned char* lds, int lane, int wave, int ch) {
    const bf16* h2buf = (const bf16*)(a.ws + WS_H2); const float* x1buf = (const float*)(a.ws + WS_X1); const float* mod = (const float*)(a.ws + WS_MOD);
    const unsigned char* ut = a.ws + WS_UT + (size_t)l * NE * D; const unsigned char* vt = a.ws + WS_VT + (size_t)l * NE * D;
    const float* su = (const float*)(a.ws + WS_SU) + (size_t)l * NE; const float* sv = (const float*)(a.ws + WS_SV) + (size_t)l * NE;
    LAS int* eg_e = (LAS int*)lds; LAS float* eg_g = (LAS float*)(lds + 32768); LAS float* wts = (LAS float*)(lds + 65536) + wave * 128;
    const int b = ch / NCH; const bool last = (l == NL - 1);
    const float* mb = mod + ((size_t)l * NB + b) * 6 * D; const float* mbn = mod + ((size_t)(last ? l : l + 1) * NB + b) * 6 * D;
    const int b5 = (lane >> 5) & 1, b4 = (lane >> 4) & 1;
#define PE_LOAD(buf, tab, bt_) do { _Pragma("unroll") for (int k_ = 0; k_ < 4; ++k_) { const int e_ = __builtin_amdgcn_readfirstlane(eg_e[tl * 128 + (bt_) * 4 + k_]); const unsigned char* row_ = (tab) + (size_t)e_ * D; \
            buf[k_][0] = *(const v4u*)(row_ + lane * 16); buf[k_][1] = *(const v4u*)(row_ + (64 + lane) * 16); } } while (0)
#define PE_COMPU(buf, bt_) do { float p_[4]; \
        _Pragma("unroll") for (int k_ = 0; k_ < 4; ++k_) { int acc_ = 0; \
            _Pragma("unroll") for (int c_ = 0; c_ < 2; ++c_) _Pragma("unroll") for (int d_ = 0; d_ < 4; ++d_) acc_ = sdot4i(buf[k_][c_][d_], hq[c_ * 4 + d_], acc_); \
            p_[k_] = (float)acc_; } \
        float r2_[2]; \
        _Pragma("unroll") for (int k_ = 0; k_ < 2; ++k_) { const float send_ = b5 ? p_[k_] : p_[k_ + 2], keep_ = b5 ? p_[k_ + 2] : p_[k_]; r2_[k_] = keep_ + __shfl_xor(send_, 32); } \
        float s1_; { const float send_ = b4 ? r2_[0] : r2_[1], keep_ = b4 ? r2_[1] : r2_[0]; s1_ = keep_ + __shfl_xor(send_, 16); } \
        s1_ += __shfl_xor(s1_, 8); s1_ += __shfl_xor(s1_, 4); s1_ += __shfl_xor(s1_, 2); s1_ += __shfl_xor(s1_, 1); \
        const int rowi_ = (bt_) * 4 + (lane >> 4); const int er_ = eg_e[tl * 128 + rowi_]; \
        const float wgt_ = eg_g[tl * 128 + rowi_] * gelu_tanh_f(s1_ * su[er_] * shs) * sv[er_]; \
        if ((lane & 15) == 0) { wts[rowi_] = wgt_; wsum += wgt_; } } while (0)
#define PE_COMPV(buf, bt_) do { \
        _Pragma("unroll") for (int k_ = 0; k_ < 4; ++k_) { const float wk_ = wts[(bt_) * 4 + k_]; \
            _Pragma("unroll") for (int c_ = 0; c_ < 2; ++c_) _Pragma("unroll") for (int d_ = 0; d_ < 4; ++d_) fma_ub4(buf[k_][c_][d_], wk_, y[(c_ * 4 + d_) * 4], y[(c_ * 4 + d_) * 4 + 1], y[(c_ * 4 + d_) * 4 + 2], y[(c_ * 4 + d_) * 4 + 3]); } } while (0)
    for (int it = 0; it < 8; ++it) {
        const int tl = wave * 8 + it, t = ch * 64 + tl;
        unsigned hq[8]; float shs;
        { float hf[32]; float mx = 0.f;
#pragma unroll
          for (int c = 0; c < 8; ++c) { const v2u w = *(const v2u*)(h2buf + (size_t)t * D + (c * 64 + lane) * 4); hf[c * 4] = bflo(w.x); hf[c * 4 + 1] = bfhi(w.x); hf[c * 4 + 2] = bflo(w.y); hf[c * 4 + 3] = bfhi(w.y);
              mx = fmaxf(mx, fmaxf(fmaxf(fabsf(hf[c * 4]), fabsf(hf[c * 4 + 1])), fmaxf(fabsf(hf[c * 4 + 2]), fabsf(hf[c * 4 + 3])))); }
#pragma unroll
          for (int o = 1; o < 64; o <<= 1) mx = fmaxf(mx, __shfl_xor(mx, o));
          const float inv = mx > 0.f ? 127.0f / mx : 0.f; shs = mx * (1.0f / 127.0f);
#pragma unroll
          for (int c = 0; c < 8; ++c) { const int q0 = (int)__builtin_rintf(hf[c * 4] * inv), q1 = (int)__builtin_rintf(hf[c * 4 + 1] * inv), q2 = (int)__builtin_rintf(hf[c * 4 + 2] * inv), q3 = (int)__builtin_rintf(hf[c * 4 + 3] * inv);
              hq[c] = (unsigned)(q0 & 255) | ((unsigned)(q1 & 255) << 8) | ((unsigned)(q2 & 255) << 16) | ((unsigned)(q3 & 255) << 24); } }
        v4u bufA[4][2], bufB[4][2]; float wsum = 0.f;
        PE_LOAD(bufA, ut, 0);
        for (int bt = 0; bt < 32; bt += 2) {
            PE_LOAD(bufB, ut, bt + 1);
            PE_COMPU(bufA, bt);
            if (bt + 2 < 32) PE_LOAD(bufA, ut, bt + 2);
            PE_COMPU(bufB, bt + 1);
        }
        LDS_WAIT(); asm volatile("" ::: "memory");
        float y[32];
#pragma unroll
        for (int i = 0; i < 32; ++i) y[i] = 0.f;
        PE_LOAD(bufA, vt, 0);
        for (int bt = 0; bt < 32; bt += 2) {
            PE_LOAD(bufB, vt, bt + 1);
            PE_COMPV(bufA, bt);
            if (bt + 2 < 32) PE_LOAD(bufA, vt, bt + 2);
            PE_COMPV(bufB, bt + 1);
        }
        const float woff = 128.0f * wave_sum(wsum);
        float z[32];
#pragma unroll
        for (int c = 0; c < 8; ++c) { const int col = (c * 64 + lane) * 4;
            const f32x4 x0 = *(const f32x4*)(x1buf + (size_t)t * D + col), g0 = *(const f32x4*)(mb + 5 * D + col);
            z[c * 4] = ALPHA * x0.x + (1.f + g0.x) * (y[c * 4] - woff); z[c * 4 + 1] = ALPHA * x0.y + (1.f + g0.y) * (y[c * 4 + 1] - woff);
            z[c * 4 + 2] = ALPHA * x0.z + (1.f + g0.z) * (y[c * 4 + 2] - woff); z[c * 4 + 3] = ALPHA * x0.w + (1.f + g0.w) * (y[c * 4 + 3] - woff); }
        ln_tail(z, t, lane, a.in[17] + (size_t)l * D, a.in[18] + (size_t)l * D, last ? a.out : (float*)(a.ws + WS_X), mbn, mbn + D, last ? (bf16*)nullptr : (bf16*)(a.ws + WS_H));
    }
#undef PE_LOAD
#undef PE_COMPU
#undef PE_COMPV
}

#ifndef MK_PER_PHASE
#define MK_PER_PHASE 0
#endif
__global__ void __launch_bounds__(NTHREADS, 2) mk_fwd(Args a) {
    extern __shared__ __attribute__((aligned(16))) unsigned char lds_raw[];
    LAS unsigned char* lds = (LAS unsigned char*)lds_raw;
    const int tid = threadIdx.x, lane = tid & 63, wave = __builtin_amdgcn_readfirstlane(tid >> 6), G = gridDim.x, bx = blockIdx.x;
    if (tid < 64) ((LAS unsigned*)(lds + LDSCTL_OFF))[tid] = 0u;
    __syncthreads();
    unsigned* ctl = (unsigned*)(a.ws + WS_CTL);
    XcdBarrier bar; bar.bar = ctl + CW_BAR; bar.x = 0; bar.st = nullptr;
    const bool use_bar = (a.ph_hi - a.ph_lo) > 1;
    if (use_bar) bar = xcd_barrier_post(ctl + CW_BAR, (volatile LAS unsigned*)(lds + LDSCTL_OFF));
    const int lo = a.ph_lo, hi = a.ph_hi;
#ifndef PH_MASK
#define PH_MASK 0x1ff
#endif
#define IN(k) (lo <= (k) && (k) < hi)
#define EN(b) ((PH_MASK >> (b)) & 1)
#define SEAM(k) do { if (IN((k) + 1)) xcd_barrier(bar); } while (0)
#define PHASE_IDS() int tidp = tid; asm volatile("" : "+v"(tidp)); const int lanep = tidp & 63, wavep = __builtin_amdgcn_readfirstlane(tidp >> 6); (void)lanep; (void)wavep
    if (EN(0) && IN(0)) { PHASE_IDS(); ph_prologue_a(a, lds, tidp, lanep, wavep, bx, G); SEAM(0); }
    if (EN(1) && IN(1)) { PHASE_IDS(); ph_prologue_b(a, lds, tidp, lanep, wavep, bx, G); SEAM(1); }
    for (int l = 0; l < NL; ++l) {
        const int pb = 2 + 7 * l;
        const float* mod = (const float*)(a.ws + WS_MOD);
        if (EN(2) && IN(pb + 0)) {
            PHASE_IDS();
            pg8::Gemm g{(const pg8::bf16_t*)(a.ws + WS_H), (const pg8::bf16_t*)(a.ws + WS_WIN) + (size_t)l * INW * D, T, NP, D}; pg8::StaticOrder S; S.init(T, NP, G, bx);
            pg8::EpiBf16P E{(pg8::bf16_t*)(a.ws + WS_PROJ), NP};
            pg8::gemm_phase<pg8::EpiBf16P, pg8::StaticOrder, true, true>(lds + RING_OFF, g, S, E, tidp);
            for (int ch = bx; ch < NCHUNK; ch += G) gate_prep(a, l, lds, tidp, lanep, wavep, ch);
            SEAM(pb + 0);
        }
        if (EN(3) && IN(pb + 1)) { PHASE_IDS(); for (int un = bx; un < 256; un += G) gla_unit(a, lds, tidp, lanep, wavep, un); SEAM(pb + 1); }
        if (EN(4) && IN(pb + 2)) { PHASE_IDS(); for (int ch = bx; ch < NCHUNK; ch += G) mixpost_chunk(a, l, lanep, wavep, ch); SEAM(pb + 2); }
        if (EN(5) && IN(pb + 3)) {
            PHASE_IDS();
            pg8::Gemm g{(const pg8::bf16_t*)(a.ws + WS_Y), (const pg8::bf16_t*)(a.ws + WS_WOUT) + (size_t)l * D * D, T, D, D}; pg8::StaticOrder S; S.init(T, D, G, bx);
            pg8::EpiResid E{(float*)(a.ws + WS_Z), l == 0 ? a.in[0] : (const float*)(a.ws + WS_X), mod + (size_t)l * NB * 6 * D + 2 * D, ALPHA};
            pg8::gemm_phase<pg8::EpiResid, pg8::StaticOrder, true, true>(lds + RING_OFF, g, S, E, tidp);
            SEAM(pb + 3);
        }
        if (EN(6) && IN(pb + 4)) { PHASE_IDS(); for (int ch = bx; ch < NCHUNK; ch += G) ln1_chunk(a, l, lanep, wavep, ch); SEAM(pb + 4); }
        if (EN(7) && IN(pb + 5)) {
            PHASE_IDS();
            pg8::Gemm g{(const pg8::bf16_t*)(a.ws + WS_H2), (const pg8::bf16_t*)(a.ws + WS_WQ) + (size_t)l * D * D, T, D, D}; pg8::StaticOrder S; S.init(T, D, G, bx);
            pg8::EpiBf16P E{(pg8::bf16_t*)(a.ws + WS_Q), D};
            pg8::gemm_phase<pg8::EpiBf16P, pg8::StaticOrder, true, true>(lds + RING_OFF, g, S, E, tidp);
            SEAM(pb + 5);
        }
        if (EN(8) && IN(pb + 6)) {
            #ifndef PEER_DBG
#define PEER_DBG 0
#endif
            for (int ch = bx; ch < NCHUNK; ch += G) {
                int* dbg_e = (int*)(a.ws + WS_END + 40 * MiB); float* dbg_g = (float*)(a.ws + WS_END + 56 * MiB);
                if (PEER_DBG != 2) { PHASE_IDS(); peer_retrieve(a, l, lds, lanep, wavep, ch); }
                else { for (int i = tid; i < 64 * 128; i += NTHREADS) { ((LAS int*)lds)[i] = dbg_e[(size_t)ch * 64 * 128 + i]; ((LAS float*)(lds + 32768))[i] = dbg_g[(size_t)ch * 64 * 128 + i]; } }
                __syncthreads();
                if (PEER_DBG != 1) { PHASE_IDS(); peer_experts(a, l, lds, lanep, wavep, ch); }
                else { for (int i = tid; i < 64 * 128; i += NTHREADS) { dbg_e[(size_t)ch * 64 * 128 + i] = ((LAS int*)lds)[i]; dbg_g[(size_t)ch * 64 * 128 + i] = ((LAS float*)(lds + 32768))[i]; } }
                __syncthreads(); }
            SEAM(pb + 6);
        }
    }
#undef IN
#undef SEAM
}

extern "C" void kernel_launch(void* const* d_in, const int* in_sizes, int n_in, void* d_out, int out_size, void* d_ws, size_t ws_size, hipStream_t stream) {
    static int grid = 0;
    if (grid == 0) {
        if (n_in != 19 || in_sizes[0] != T * D || out_size != T * D || ws_size < WS_END) { fprintf(stderr, "kernel_launch: unexpected shapes / workspace (%d inputs, ws %zu); nothing launched\n", n_in, ws_size); grid = -1; return; }
        int dev = 0, cus = 0, per_cu = 0;
        if (hipGetDevice(&dev) != hipSuccess || hipDeviceGetAttribute(&cus, hipDeviceAttributeMultiprocessorCount, dev) != hipSuccess) { grid = -1; return; }
        if (hipFuncSetAttribute((const void*)mk_fwd, hipFuncAttributeMaxDynamicSharedMemorySize, LDS_BYTES) != hipSuccess) { fprintf(stderr, "kernel_launch: hipFuncSetAttribute failed\n"); grid = -1; return; }
        if (hipOccupancyMaxActiveBlocksPerMultiprocessor(&per_cu, (const void*)mk_fwd, NTHREADS, LDS_BYTES) != hipSuccess || per_cu < 1) fprintf(stderr, "kernel_launch: occupancy query reports %d\n", per_cu);
        (void)hipGetLastError();
        grid = cus;
    }
    if (grid < 0) return;
    if (hipMemsetAsync((char*)d_ws + WS_CTL, 0, CTL_ZERO_BYTES, stream) != hipSuccess) return;
    Args a{};
    for (int i = 0; i < 19; ++i) a.in[i] = (const float*)d_in[i];
    a.out = (float*)d_out; a.ws = (unsigned char*)d_ws;
#if MK_PER_PHASE
    for (int p = 0; p < NPHASES; ++p) { a.ph_lo = p; a.ph_hi = p + 1; hipLaunchKernelGGL(mk_fwd, dim3(grid), dim3(NTHREADS), LDS_BYTES, stream, a); }
#else
    a.ph_lo = 0; a.ph_hi = NPHASES;
    hipLaunchKernelGGL(mk_fwd, dim3(grid), dim3(NTHREADS), LDS_BYTES, stream, a);
#endif
}
```

```cpp
#include <hip/hip_runtime.h>
#include <cstdio>
#include <cstdint>
namespace pg8 {
#define PG8_LAS __attribute__((address_space(3)))
typedef unsigned short bf16_t;
typedef short bf16x8 __attribute__((ext_vector_type(8)));
typedef float f32x4 __attribute__((ext_vector_type(4)));
typedef unsigned u32x4 __attribute__((ext_vector_type(4)));
constexpr int BM = 256, BK = 64, HALF = 128, HTB = HALF * BK * 2  , STAGE_BYTES = 8 * HTB, NXCD = 8, WGM = 8;

__host__ __device__ __forceinline__ int lds_byte(int r, int c) { const int st = (r >> 4) * 2 + (c >> 5), rr = r & 15, cc = c & 31, ob = rr * 64 + cc * 2; return st * 1024 + (ob ^ (((ob >> 9) & 1) << 5)); }
__host__ __device__ __forceinline__ void stage_rc(int b, int& R, int& C) { const int st = b / 1024, sb = b % 1024, swz = sb ^ (((sb >> 9) & 1) << 5); R = (st >> 1) * 16 + swz / 64; C = (st & 1) * 32 + (swz % 64) / 2; }
__host__ __device__ __forceinline__ int perm32(int rho) { const int n = rho >> 4, i = rho & 15; return 8 * (i >> 2) + 4 * n + (i & 3); }

struct Unit { int pm, pn; };
struct Gemm { const bf16_t* A; const bf16_t* Bt; int M, N, K; };

struct StaticOrder {
    int nM, nN, nwg, G, c;
    __host__ __device__ void init(int M, int N, int G_, int c_) { nM = M / BM; nN = N / BM; nwg = nM * nN; G = G_; c = c_; }
    __host__ __device__ bool next(int i, Unit& u) const {
        const long L = (long)i * G + c; if (L >= nwg) return false;
        int wgid = (int)L; { const int q = nwg / NXCD, r = nwg % NXCD, xcd = wgid % NXCD, off = wgid / NXCD; wgid = (xcd < r ? xcd * (q + 1) : r * (q + 1) + (xcd - r) * q) + off; }
        const int nig = WGM * nN, gid = wgid / nig, fm = gid * WGM, gsz = (nM - fm) < WGM ? (nM - fm) : WGM;
        u.pm = fm + ((wgid % nig) % gsz); u.pn = (wgid % nig) / gsz; return true;
    }
    __device__ __forceinline__ void a_ready(const Unit&) const {}
    __device__ __forceinline__ void done(const Unit&) const {}
};
typedef __bf16 bf16x2_t __attribute__((ext_vector_type(2)));
__device__ __forceinline__ unsigned cvt_pk_bf16(float lo, float hi) { bf16x2_t r; r.x = (__bf16)lo; r.y = (__bf16)hi; return __builtin_bit_cast(unsigned, r); }
struct EpiBf16P {
    static constexpr bool PERM = true, AFTER_DRAIN = false;
    bf16_t* O; int ldc;
    __device__ __forceinline__ void operator()(const f32x4 (&acc)[2][2][4][2], const Unit& u, int wr, int wc, int fr, int fq) const {
        const int row0 = u.pm * BM + wr * 64 + fr, col0 = u.pn * BM + wc * 32 + 8 * fq;
#pragma unroll
        for (int ai = 0; ai < 2; ++ai)
#pragma unroll
            for (int m = 0; m < 4; ++m) { bf16_t* rowp = O + (size_t)(row0 + ai * HALF + m * 16) * ldc + col0;
#pragma unroll
                for (int bj = 0; bj < 2; ++bj) { const f32x4 v0 = acc[ai][bj][m][0], v1 = acc[ai][bj][m][1];
                    u32x4 w; w.x = cvt_pk_bf16(v0[0], v0[1]); w.y = cvt_pk_bf16(v0[2], v0[3]); w.z = cvt_pk_bf16(v1[0], v1[1]); w.w = cvt_pk_bf16(v1[2], v1[3]);
                    *(u32x4*)(rowp + bj * HALF) = w; } }
    }
};
struct EpiResid {
    static constexpr bool PERM = false, AFTER_DRAIN = false;
    float* Z; const float* X; const float* gate; float alpha;
    __device__ __forceinline__ void operator()(const f32x4 (&acc)[2][2][4][2], const Unit& u, int wr, int wc, int fr, int fq) const {
        const int row0 = u.pm * BM + wr * 64 + fr, col0 = u.pn * BM + wc * 32 + 4 * fq;
        const float* gb = gate + (size_t)(u.pm >> 3) * (6 * 2048) + col0;
        f32x4 gv[2][2];
#pragma unroll
        for (int bj = 0; bj < 2; ++bj)
#pragma unroll
            for (int n = 0; n < 2; ++n) gv[bj][n] = *(const f32x4*)(gb + bj * HALF + n * 16) + 1.0f;
#pragma unroll
        for (int ai = 0; ai < 2; ++ai)
#pragma unroll
            for (int m = 0; m < 4; ++m) { const size_t off = (size_t)(row0 + ai * HALF + m * 16) * 2048 + col0;
#pragma unroll
                for (int bj = 0; bj < 2; ++bj)
#pragma unroll
                    for (int n = 0; n < 2; ++n) { const f32x4 xv = *(const f32x4*)(X + off + bj * HALF + n * 16);
                        *(f32x4*)(Z + off + bj * HALF + n * 16) = xv * alpha + gv[bj][n] * acc[ai][bj][m][n]; }
                asm volatile("" ::: "memory"); }
    }
};
template <class Epi, class Sched, bool ALIGN_EPI = false, bool SP2 = false>
__device__ __forceinline__ void gemm_phase(PG8_LAS unsigned char* lds, const Gemm g, const Sched& S, const Epi& E, const int tid_in) {
    const int tid = tid_in, wid = __builtin_amdgcn_readfirstlane(tid >> 6), lane = tid & 63, wr = wid >> 2, wc = wid & 3, fr = lane & 15, fq = lane >> 4;
    const int K = g.K, nt = K / BK;
    unsigned voffA[2], voffB[2];
#pragma unroll
    for (int i = 0; i < 2; ++i) { int R, C; stage_rc(tid * 16 + i * 8192, R, C); const int Rb = Epi::PERM ? ((R & ~31) + perm32(R & 31)) : R;
        voffA[i] = (unsigned)(R * K + C) * 2u; voffB[i] = (unsigned)(Rb * K + C) * 2u; }
    const size_t kstep = (size_t)(BK * 2);
    const size_t hstep = (size_t)HALF * K * 2;
    const size_t tstep = 2 * hstep;
    const unsigned ldsw = (unsigned)wid * 1024u;
    const int aoff = lds_byte(wr * 64 + fr, fq * 8), boff = lds_byte(wc * 32 + fr, fq * 8);
#define PG8_SA(b, h) (((b) * 2 + (h)) * HTB)
#define PG8_SB(b, h) ((4 + (b) * 2 + (h)) * HTB)
#define PG8_STAGE(bufoff, gbase, voff) do { _Pragma("unroll") for (int _i = 0; _i < 2; ++_i) \
        __builtin_amdgcn_global_load_lds((const unsigned*)((const char*)(gbase) + (voff)[_i]), (PG8_LAS unsigned*)(lds + (bufoff) + ldsw + _i * 8192), 16, 0, 0); } while (0)
#define PG8_LDA(dst, b, h) do { _Pragma("unroll") for (int m = 0; m < 4; ++m) _Pragma("unroll") for (int k = 0; k < 2; ++k) dst[m][k] = *(const PG8_LAS bf16x8*)(lds + PG8_SA(b, h) + aoff + m * 2048 + k * 1024); } while (0)
#define PG8_LDB(dst, b, h) do { _Pragma("unroll") for (int n = 0; n < 2; ++n) _Pragma("unroll") for (int k = 0; k < 2; ++k) dst[n][k] = *(const PG8_LAS bf16x8*)(lds + PG8_SB(b, h) + boff + n * 2048 + k * 1024); } while (0)
#define PG8_MMA(ai, bj, At, Bt) do { __builtin_amdgcn_s_setprio(1); _Pragma("unroll") for (int m = 0; m < 4; ++m) _Pragma("unroll") for (int n = 0; n < 2; ++n) _Pragma("unroll") for (int k = 0; k < 2; ++k) \
        acc[ai][bj][m][n] = __builtin_amdgcn_mfma_f32_16x16x32_bf16(Bt[n][k], At[m][k], acc[ai][bj][m][n], 0, 0, 0); __builtin_amdgcn_s_setprio(0); } while (0)
#define PG8_WAIT_V(n) asm volatile("s_waitcnt vmcnt(" #n ")" ::: "memory")
#define PG8_WAIT_L(n) asm volatile("s_waitcnt lgkmcnt(" #n ")" ::: "memory")
#define PG8_BAR __builtin_amdgcn_s_barrier()
#define PG8_SCHED __builtin_amdgcn_sched_barrier(0)
    Unit cur, nxt; int ui = 0;
    if (!S.next(0, cur)) return;
    f32x4 acc[2][2][4][2];
#pragma unroll
    for (int a = 0; a < 2; ++a)
#pragma unroll
        for (int b = 0; b < 2; ++b)
#pragma unroll
            for (int m = 0; m < 4; ++m)
#pragma unroll
                for (int n = 0; n < 2; ++n) acc[a][b][m][n] = (f32x4){0.f, 0.f, 0.f, 0.f};
    bf16x8 At[4][2], B0[2][2], B1[2][2];
    const char* cA = (const char*)g.A + (size_t)cur.pm * tstep; const char* cB = (const char*)g.Bt + (size_t)cur.pn * tstep;
    S.a_ready(cur);
    if constexpr (SP2) {
        PG8_STAGE(PG8_SB(0, 0), cB, voffB); PG8_STAGE(PG8_SB(0, 1), cB + hstep, voffB); PG8_STAGE(PG8_SA(0, 0), cA, voffA); PG8_STAGE(PG8_SA(0, 1), cA + hstep, voffA);
        if (wr == 1) PG8_BAR;
        PG8_WAIT_V(2); PG8_BAR;
        PG8_STAGE(PG8_SB(1, 0), cB + kstep, voffB); PG8_STAGE(PG8_SA(1, 0), cA + kstep, voffA); PG8_STAGE(PG8_SB(1, 1), cB + hstep + kstep, voffB);
        PG8_WAIT_V(6); PG8_BAR;
    } else {
        PG8_STAGE(PG8_SB(0, 0), cB, voffB); PG8_STAGE(PG8_SA(0, 0), cA, voffA); PG8_STAGE(PG8_SB(0, 1), cB + hstep, voffB); PG8_STAGE(PG8_SA(0, 1), cA + hstep, voffA);
        if (wr == 1) PG8_BAR;
        PG8_WAIT_V(4); PG8_BAR;
        PG8_STAGE(PG8_SB(1, 0), cB + kstep, voffB); PG8_STAGE(PG8_SA(1, 0), cA + kstep, voffA); PG8_STAGE(PG8_SB(1, 1), cB + hstep + kstep, voffB);
        PG8_WAIT_V(6); PG8_BAR;
    }
    for (;;) {
        const bool has_next = S.next(ui + 1, nxt);
        const char* nA = has_next ? (const char*)g.A + (size_t)nxt.pm * tstep : cA; const char* nB = has_next ? (const char*)g.Bt + (size_t)nxt.pn * tstep : cB;
        for (int t = 0; t < nt; t += 2) {
            const bool last = (t == nt - 2);
            const char* a1 = cA + (size_t)(t + 1) * kstep;
            const char* a2 = last ? nA : cA + (size_t)(t + 2) * kstep; const char* b2 = last ? nB : cB + (size_t)(t + 2) * kstep;
            const char* a3 = a2 + kstep; const char* b3 = b2 + kstep;
            if (last && has_next) S.a_ready(nxt);
            if constexpr (SP2) {
            PG8_LDB(B0, 0, 0); PG8_LDB(B1, 0, 1); PG8_SCHED; PG8_LDA(At, 0, 0); PG8_STAGE(PG8_SA(1, 1), a1 + hstep, voffA);
            PG8_WAIT_V(8); PG8_WAIT_L(0); PG8_BAR; PG8_MMA(0, 0, At, B0); PG8_MMA(0, 1, At, B1); PG8_BAR; PG8_SCHED;
            PG8_LDA(At, 0, 1); PG8_STAGE(PG8_SB(0, 0), b2, voffB); PG8_STAGE(PG8_SB(0, 1), b2 + hstep, voffB); PG8_STAGE(PG8_SA(0, 0), a2, voffA);
            PG8_WAIT_V(8); PG8_WAIT_L(0); PG8_BAR; PG8_MMA(1, 0, At, B0); PG8_MMA(1, 1, At, B1); PG8_BAR; PG8_SCHED;
            PG8_LDB(B0, 1, 0); PG8_LDB(B1, 1, 1); PG8_SCHED; PG8_LDA(At, 1, 0); PG8_STAGE(PG8_SA(0, 1), a2 + hstep, voffA);
            PG8_WAIT_V(8); PG8_WAIT_L(0); PG8_BAR; PG8_MMA(0, 0, At, B0); PG8_MMA(0, 1, At, B1); PG8_BAR; PG8_SCHED;
            PG8_LDA(At, 1, 1); PG8_STAGE(PG8_SB(1, 0), b3, voffB); PG8_STAGE(PG8_SB(1, 1), b3 + hstep, voffB); PG8_STAGE(PG8_SA(1, 0), a3, voffA);
            PG8_WAIT_V(8); PG8_WAIT_L(0); PG8_BAR; PG8_MMA(1, 0, At, B0); PG8_MMA(1, 1, At, B1); PG8_BAR; PG8_SCHED;
            } else {
            PG8_LDB(B0, 0, 0); PG8_SCHED; PG8_LDA(At, 0, 0); PG8_STAGE(PG8_SA(1, 1), a1 + hstep, voffA);
            PG8_WAIT_L(8); PG8_BAR; PG8_WAIT_L(0); PG8_MMA(0, 0, At, B0); PG8_BAR; PG8_SCHED;
            PG8_LDB(B1, 0, 1); PG8_STAGE(PG8_SB(0, 0), b2, voffB);
            PG8_BAR; PG8_WAIT_L(0); PG8_MMA(0, 1, At, B1); PG8_BAR;
            PG8_LDA(At, 0, 1); PG8_STAGE(PG8_SA(0, 0), a2, voffA);
            PG8_BAR; PG8_WAIT_L(0); PG8_MMA(1, 0, At, B0); PG8_BAR; PG8_SCHED;
            PG8_STAGE(PG8_SB(0, 1), b2 + hstep, voffB);
            PG8_WAIT_V(6); PG8_BAR; PG8_MMA(1, 1, At, B1); PG8_BAR;
            PG8_LDB(B0, 1, 0); PG8_SCHED; PG8_LDA(At, 1, 0); PG8_STAGE(PG8_SA(0, 1), a2 + hstep, voffA);
            PG8_WAIT_L(8); PG8_BAR; PG8_WAIT_L(0); PG8_MMA(0, 0, At, B0); PG8_BAR; PG8_SCHED;
            PG8_LDB(B1, 1, 1); PG8_STAGE(PG8_SB(1, 0), b3, voffB);
            PG8_BAR; PG8_WAIT_L(0); PG8_MMA(0, 1, At, B1); PG8_BAR;
            PG8_LDA(At, 1, 1); PG8_STAGE(PG8_SA(1, 0), a3, voffA);
            PG8_BAR; PG8_WAIT_L(0); PG8_MMA(1, 0, At, B0); PG8_BAR; PG8_SCHED;
            PG8_STAGE(PG8_SB(1, 1), b3 + hstep, voffB);
            PG8_WAIT_V(6); PG8_BAR; PG8_MMA(1, 1, At, B1); PG8_BAR;
            }
        }
        if constexpr (ALIGN_EPI) { if (wr == 0) PG8_BAR; }
        if constexpr (!Epi::AFTER_DRAIN) { E(acc, cur, wr, wc, fr, fq); S.done(cur); }
        if (!has_next) break;
#pragma unroll
        for (int a = 0; a < 2; ++a)
#pragma unroll
            for (int b = 0; b < 2; ++b)
#pragma unroll
                for (int m = 0; m < 4; ++m)
#pragma unroll
                    for (int n = 0; n < 2; ++n) acc[a][b][m][n] = (f32x4){0.f, 0.f, 0.f, 0.f};
        cur = nxt; cA = nA; cB = nB; ++ui;
        if constexpr (ALIGN_EPI) { if (wr == 1) PG8_BAR; }
    }
    PG8_WAIT_V(0);
    if constexpr (!ALIGN_EPI) { if (wr == 0) PG8_BAR; }
    PG8_BAR;
    if constexpr (Epi::AFTER_DRAIN) { E.fused(acc, cur, wr, wc, fr, fq, lds, wid, lane); S.done(cur); }
#undef PG8_SA
#undef PG8_SB
#undef PG8_STAGE
#undef PG8_LDA
#undef PG8_LDB
#undef PG8_MMA
#undef PG8_WAIT_V
#undef PG8_WAIT_L
#undef PG8_BAR
#undef PG8_SCHED
}
}
#define XB_TMO      128
#define XB_XCNT(j)  (256  + 64 * (j))
#define XB_XSUB(j)  (1280 + 64 * (j))
#define XB_XGEN(j)  (2304 + 64 * (j))
#define XB_TOP      3328
#define XB_TOPGEN   3392
#define XCD_BAR_WORDS 3456
#define XB_SPIN_CAP (1u << 18)
#define LAS __attribute__((address_space(3)))

__device__ __forceinline__ unsigned xb_ld(unsigned* p)              { return __hip_atomic_load(p, __ATOMIC_RELAXED, __HIP_MEMORY_SCOPE_AGENT); }
__device__ __forceinline__ unsigned xb_add(unsigned* p, unsigned v) { return __hip_atomic_fetch_add(p, v, __ATOMIC_RELAXED, __HIP_MEMORY_SCOPE_AGENT); }
__device__ __forceinline__ unsigned xb_xcc_id() { return (unsigned)__builtin_amdgcn_s_getreg((3 << 11) | 20) & 0xFu; }
#define XB_SPIN(cond, bar) do { unsigned _sp = 0; while (cond) { __builtin_amdgcn_s_sleep(1); \
    if ((++_sp & 255u) == 0u) { if (xb_ld(&(bar)[XB_TMO])) break; if (_sp > XB_SPIN_CAP) { atomicAdd(&(bar)[XB_TMO], 1u); break; } } } } while (0)

struct XcdBarrier {
    unsigned* bar; unsigned x;
    volatile LAS unsigned* st;
};

__device__ __forceinline__ XcdBarrier xcd_barrier_post(unsigned* bar, volatile LAS unsigned* st) {
    XcdBarrier b; b.bar = bar; b.x = xb_xcc_id(); b.st = st;
    if (threadIdx.x == 0) (void)xb_add(&bar[XB_XCNT(b.x)], 1u);
    return b;
}
__device__ __forceinline__ void xcd_barrier_complete(unsigned* bar, unsigned x, unsigned& nloc, unsigned& nx) {
    const unsigned G = gridDim.x * gridDim.y * gridDim.z;
    unsigned sum, cnt, mine, sp = 0u;
    for (;;) {
        sum = 0u; cnt = 0u; mine = 0u;
#pragma unroll
        for (unsigned j = 0; j < 16; ++j) { const unsigned c = xb_ld(&bar[XB_XCNT(j)]); sum += c; cnt += (c > 0u) ? 1u : 0u; mine = (j == x) ? c : mine; }
        if (sum == G) break;
        __builtin_amdgcn_s_sleep(1);
        if ((++sp & 255u) == 0u) { if (xb_ld(&bar[XB_TMO])) break; if (sp > XB_SPIN_CAP) { atomicAdd(&bar[XB_TMO], 1u); break; } }
    }
    nloc = mine > 0u ? mine : 1u; nx = cnt > 0u ? cnt : 1u;
}

__device__ __forceinline__ void xcd_barrier(const XcdBarrier& b) {
    asm volatile("s_waitcnt vmcnt(0)" ::: "memory");
    __syncthreads();
    if (threadIdx.x == 0) {
        unsigned* bar = b.bar;
        __builtin_amdgcn_s_waitcnt(0);
        unsigned nloc = b.st[0], nx = b.st[1];
        if (nloc == 0u) { xcd_barrier_complete(bar, b.x, nloc, nx); b.st[0] = nloc; b.st[1] = nx; }
        const unsigned old = xb_add(&bar[XB_XSUB(b.x)], 1u);
        const unsigned gen = old / nloc;
        if (old + 1u == (gen + 1u) * nloc) {
            __builtin_amdgcn_fence(__ATOMIC_RELEASE, "agent");
            asm volatile("s_waitcnt vmcnt(0)" ::: "memory");
            const unsigned og = xb_add(&bar[XB_TOP], 1u);
            const unsigned tg = og / nx;
            if (og + 1u == (tg + 1u) * nx) xb_add(&bar[XB_TOPGEN], 1u);
            else XB_SPIN(xb_ld(&bar[XB_TOPGEN]) == tg, bar);
            __builtin_amdgcn_fence(__ATOMIC_ACQUIRE, "agent");
            xb_add(&bar[XB_XGEN(b.x)], 1u);
            asm volatile("s_waitcnt vmcnt(0)" ::: "memory");
        } else {
            XB_SPIN(xb_ld(&bar[XB_XGEN(b.x)]) == gen, bar);
            __builtin_amdgcn_fence(__ATOMIC_ACQUIRE, "agent");
            asm volatile("s_waitcnt vmcnt(0)" ::: "memory");
        }
    }
    __syncthreads();
}
constexpr int D = 2048, NB = 8, SEQ = 2048, NL = 4, T = NB * SEQ;
constexpr int NCH = SEQ / 64, NCHUNK = T / 64;
constexpr int GKW = 512, RANK = 16;
constexpr int INW = 6160, NP = 6144;
constexpr int NE = 16384;
constexpr float ALPHA = 1.6817928305074290f, EPS = 1e-5f;
constexpr int PQ = 0, PK = 512, PV = 1024, PR = 2048, PCB = 3072, PCC = 4096, PCH = 5120;
constexpr int NWAVES = 8, NTHREADS = 512;
constexpr int NPHASES = 2 + 7 * NL;

constexpr size_t MiB = 1u << 20;
constexpr size_t WS_CTL = 0, CTL_ZERO_BYTES = 1 * MiB;
constexpr size_t WS_MOD = 1 * MiB, WS_PART = 3 * MiB, WS_KEYS = 15 * MiB, WS_DTOT = 17 * MiB, WS_WIN = 18 * MiB, WS_WOUT = 115 * MiB, WS_WQ = 147 * MiB;
constexpr size_t WS_UT = 179 * MiB, WS_VT = 435 * MiB, WS_H = 691 * MiB, WS_PROJ = 755 * MiB, WS_E = 947 * MiB, WS_OGLA = 979 * MiB, WS_Y = 1043 * MiB;
constexpr size_t WS_Z = 1107 * MiB, WS_X1 = 1235 * MiB, WS_X = 1363 * MiB, WS_Q = 1491 * MiB, WS_H2 = 1555 * MiB, WS_HQ8 = 1619 * MiB, WS_END = 1651 * MiB;
constexpr size_t WS_SU = 17 * MiB + 512 * 1024, WS_SV = 17 * MiB + 768 * 1024, WS_HSC = 2 * MiB + 640 * 1024;
static_assert(WS_WIN + (size_t)NL * INW * D * 2 <= WS_WOUT && WS_PART + (size_t)NL * 8 * NB * 6 * D * 4 <= WS_KEYS && WS_MOD + (size_t)NL * NB * 6 * D * 4 <= WS_PART, "ws map");
constexpr int CW_BAR = 4096;

constexpr int RING_OFF = 0, RING_BYTES = 131072, LDSCTL_OFF = RING_BYTES, LDS_BYTES = 147456;

#define GAS __attribute__((address_space(1)))
typedef unsigned short bf16;
typedef unsigned v4u __attribute__((ext_vector_type(4)));
typedef unsigned v2u __attribute__((ext_vector_type(2)));
typedef float f32x4 __attribute__((ext_vector_type(4)));
typedef float f32x16 __attribute__((ext_vector_type(16)));
typedef short bf16x8 __attribute__((ext_vector_type(8)));
typedef __bf16 bf16x2v __attribute__((ext_vector_type(2)));
#define LDS_WAIT() asm volatile("s_waitcnt lgkmcnt(0)" ::: "memory")

__device__ __forceinline__ unsigned pk2(float lo, float hi) { return pg8::cvt_pk_bf16(lo, hi); }
__device__ __forceinline__ float dot2bf(unsigned w, unsigned x, float acc) { return __builtin_amdgcn_fdot2_f32_bf16(__builtin_bit_cast(bf16x2v, w), __builtin_bit_cast(bf16x2v, x), acc, false); }
__device__ __forceinline__ float bflo(unsigned u) { return __uint_as_float(u << 16); }
__device__ __forceinline__ float bfhi(unsigned u) { return __uint_as_float(u & 0xffff0000u); }
__device__ __forceinline__ float silu_f(float x) { return x / (1.0f + __expf(-x)); }
__device__ __forceinline__ float logsigmoid_f(float x) { return fminf(x, 0.0f) - log1pf(__expf(-fabsf(x))); }
__device__ __forceinline__ float gelu_tanh_f(float x) { const float u = 0.7978845608028654f * (x + 0.044715f * x * x * x); return 0.5f * x * (1.0f + tanhf(u)); }
__device__ __forceinline__ float wave_sum(float v) {
#pragma unroll
    for (int o = 1; o < 64; o <<= 1) v += __shfl_xor(v, o);
    return v;
}

struct Args { const float* in[19]; float* out; unsigned char* ws; int ph_lo, ph_hi; };

__device__ __forceinline__ void transpose_item(const float* W, int ldw, int col0, bf16* WTrows, int k0, int nvalid, LAS float* scr, int lane) {
    const int n = lane & 31;
#pragma unroll 8
    for (int i = 0; i < 32; ++i) { const int kk = 2 * i + (lane >> 5); scr[kk * 33 + n] = (n < nvalid) ? W[(size_t)(k0 + kk) * ldw + col0 + n] : 0.f; }
    LDS_WAIT(); asm volatile("" ::: "memory");
    const int c = lane & 7;
#pragma unroll
    for (int j = 0; j < 4; ++j) { const int nn = (lane >> 3) + 8 * j; const LAS float* s = scr + (8 * c) * 33 + nn;
        v4u o; o.x = pk2(s[0 * 33], s[1 * 33]); o.y = pk2(s[2 * 33], s[3 * 33]); o.z = pk2(s[4 * 33], s[5 * 33]); o.w = pk2(s[6 * 33], s[7 * 33]);
        if (nn < nvalid) *(v4u*)(WTrows + (size_t)nn * D + k0 + 8 * c) = o; }
    LDS_WAIT(); asm volatile("" ::: "memory");
}
__device__ __forceinline__ void cvt_stream(const float* src, bf16* dst, size_t n4, size_t i0, size_t stride) {
    for (size_t i = i0; i < n4; i += stride) { const f32x4 v = ((const f32x4*)src)[i]; v2u o; o.x = pk2(v.x, v.y); o.y = pk2(v.z, v.w); ((v2u*)dst)[i] = o; }
}
__device__ __forceinline__ void ph_prologue_a(const Args& a, LAS unsigned char* lds, int tid, int lane, int wave, int bx, int G) {
    const int gw = bx * NWAVES + wave, NGW = G * NWAVES;
    LAS float* cact = (LAS float*)lds;
    for (int i = tid; i < NB * D; i += NTHREADS) { const int b = i / D, d = i % D; cact[d * 8 + b] = silu_f(a.in[1][i]); }
    __syncthreads();
    float* part = (float*)(a.ws + WS_PART);
    for (int it = gw; it < NL * 8 * 48; it += NGW) {
        const int cg = it % 48, dr = (it / 48) % 8, l = it / 384;
        f32x4 acc[8];
#pragma unroll
        for (int b = 0; b < 8; ++b) acc[b] = (f32x4){0.f, 0.f, 0.f, 0.f};
        const float* w = a.in[2] + ((size_t)l * D + dr * 256) * (6 * D) + cg * 256 + lane * 4;
#pragma unroll 4
        for (int d = 0; d < 256; ++d) {
            const f32x4 wv = *(const f32x4*)(w + (size_t)d * (6 * D));
            const f32x4 c0 = *(const LAS f32x4*)(cact + (dr * 256 + d) * 8), c1 = *(const LAS f32x4*)(cact + (dr * 256 + d) * 8 + 4);
            acc[0] += wv * c0.x; acc[1] += wv * c0.y; acc[2] += wv * c0.z; acc[3] += wv * c0.w;
            acc[4] += wv * c1.x; acc[5] += wv * c1.y; acc[6] += wv * c1.z; acc[7] += wv * c1.w;
        }
#pragma unroll
        for (int b = 0; b < 8; ++b) *(f32x4*)(part + (((size_t)l * 8 + dr) * NB + b) * (6 * D) + cg * 256 + lane * 4) = acc[b];
    }
    __syncthreads();
    LAS float* scr = (LAS float*)(lds + wave * 8448);
    bf16* winT = (bf16*)(a.ws + WS_WIN); bf16* woutT = (bf16*)(a.ws + WS_WOUT); bf16* wqT = (bf16*)(a.ws + WS_WQ);
    constexpr int IPL = 6144 + 32 + 2048 + 2048;
    for (int it = gw; it < NL * IPL; it += NGW) {
        const int l = it / IPL; int r = it % IPL;
        if (r < 6144) { const int nb = r % 192, kb = r / 192, n0 = nb * 32;
            transpose_item(a.in[4] + (size_t)l * D * INW, INW, n0 < 3072 ? n0 : n0 + 16, winT + ((size_t)l * INW + n0) * D, kb * 64, 32, scr, lane); continue; }
        r -= 6144;
        if (r < 32) { transpose_item(a.in[4] + (size_t)l * D * INW, INW, 3072, winT + ((size_t)l * INW + NP) * D, r * 64, 16, scr, lane); continue; }
        r -= 32;
        if (r < 2048) { const int nb = r % 64, kb = r / 64; transpose_item(a.in[10] + (size_t)l * D * D, D, nb * 32, woutT + ((size_t)l * D + nb * 32) * D, kb * 64, 32, scr, lane); continue; }
        r -= 2048;
        { const int nb = r % 64, kb = r / 64; transpose_item(a.in[13] + (size_t)l * D * D, D, nb * 32, wqT + ((size_t)l * D + nb * 32) * D, kb * 64, 32, scr, lane); }
    }
    const size_t i0 = (size_t)bx * NTHREADS + tid, stride = (size_t)G * NTHREADS;
    cvt_stream(a.in[14], (bf16*)(a.ws + WS_KEYS), (size_t)NL * 8 * 2 * 128 * 128 / 4, i0, stride);
    for (int row = gw; row < 2 * NL * NE; row += NGW) {
        const int tbl = row / (NL * NE), r = row % (NL * NE);
        const float* src = (tbl ? a.in[16] : a.in[15]) + (size_t)r * D;
        f32x4 v[8]; float mx = 0.f;
#pragma unroll
        for (int c8 = 0; c8 < 8; ++c8) { v[c8] = *(const f32x4*)(src + (c8 * 64 + lane) * 4); mx = fmaxf(mx, fmaxf(fmaxf(fabsf(v[c8].x), fabsf(v[c8].y)), fmaxf(fabsf(v[c8].z), fabsf(v[c8].w)))); }
#pragma unroll
        for (int o = 1; o < 64; o <<= 1) mx = fmaxf(mx, __shfl_xor(mx, o));
        const float inv = mx > 0.f ? 127.0f / mx : 0.f; const int off = tbl ? 128 : 0;
        unsigned dw[8];
#pragma unroll
        for (int c8 = 0; c8 < 8; ++c8) { const int q0 = (int)__builtin_rintf(v[c8].x * inv) + off, q1 = (int)__builtin_rintf(v[c8].y * inv) + off, q2 = (int)__builtin_rintf(v[c8].z * inv) + off, q3 = (int)__builtin_rintf(v[c8].w * inv) + off;
            dw[c8] = (unsigned)(q0 & 255) | ((unsigned)(q1 & 255) << 8) | ((unsigned)(q2 & 255) << 16) | ((unsigned)(q3 & 255) << 24); }
        unsigned char* dst = a.ws + (tbl ? WS_VT : WS_UT) + (size_t)r * D;
        *(v4u*)(dst + lane * 16) = (v4u){dw[0], dw[1], dw[2], dw[3]}; *(v4u*)(dst + (64 + lane) * 16) = (v4u){dw[4], dw[5], dw[6], dw[7]};
        if (lane == 0) ((float*)(a.ws + (tbl ? WS_SV : WS_SU)))[r] = mx * (1.0f / 127.0f);
    }
}

__device__ __forceinline__ void ln_tail(const float (&z)[32], int t, int lane, const float* g, const float* bta, float* xout, const float* sh, const float* sc, bf16* hout, unsigned char* q8, float* q8s) {
    float s = 0.f;
#pragma unroll
    for (int i = 0; i < 32; ++i) s += z[i];
    const float mu = wave_sum(s) * (1.0f / D);
    float q = 0.f;
#pragma unroll
    for (int i = 0; i < 32; ++i) { const float d = z[i] - mu; q += d * d; }
    const float rs = rsqrtf(wave_sum(q) * (1.0f / D) + EPS);
    float hv[32]; float mx = 0.f;
#pragma unroll
    for (int c = 0; c < 8; ++c) { const int col = (c * 64 + lane) * 4;
        const f32x4 g0 = *(const f32x4*)(g + col), b0 = *(const f32x4*)(bta + col);
        f32x4 x0;
        x0.x = (z[c * 4 + 0] - mu) * rs * g0.x + b0.x; x0.y = (z[c * 4 + 1] - mu) * rs * g0.y + b0.y; x0.z = (z[c * 4 + 2] - mu) * rs * g0.z + b0.z; x0.w = (z[c * 4 + 3] - mu) * rs * g0.w + b0.w;
        if (xout) *(f32x4*)(xout + (size_t)t * D + col) = x0;
        if (hout) { const f32x4 s0 = *(const f32x4*)(sc + col), h0 = *(const f32x4*)(sh + col);
            hv[c * 4] = x0.x * (1.f + s0.x) + h0.x; hv[c * 4 + 1] = x0.y * (1.f + s0.y) + h0.y; hv[c * 4 + 2] = x0.z * (1.f + s0.z) + h0.z; hv[c * 4 + 3] = x0.w * (1.f + s0.w) + h0.w;
            v2u o; o.x = pk2(hv[c * 4], hv[c * 4 + 1]); o.y = pk2(hv[c * 4 + 2], hv[c * 4 + 3]);
            *(v2u*)(hout + (size_t)t * D + col) = o;
            if (q8) {
                hv[c * 4] = bflo(o.x); hv[c * 4 + 1] = bfhi(o.x); hv[c * 4 + 2] = bflo(o.y); hv[c * 4 + 3] = bfhi(o.y);
                mx = fmaxf(mx, fmaxf(fmaxf(fabsf(hv[c * 4]), fabsf(hv[c * 4 + 1])), fmaxf(fabsf(hv[c * 4 + 2]), fabsf(hv[c * 4 + 3])))); } }
    }
    if (q8) {
#pragma unroll
        for (int o = 1; o < 64; o <<= 1) mx = fmaxf(mx, __shfl_xor(mx, o));
        const float inv = mx > 0.f ? 127.0f / mx : 0.f;
        unsigned dw[8];
#pragma unroll
        for (int c = 0; c < 8; ++c) { const int q0 = (int)__builtin_rintf(hv[c * 4] * inv), q1 = (int)__builtin_rintf(hv[c * 4 + 1] * inv), q2 = (int)__builtin_rintf(hv[c * 4 + 2] * inv), q3 = (int)__builtin_rintf(hv[c * 4 + 3] * inv);
            dw[c] = (unsigned)(q0 & 255) | ((unsigned)(q1 & 255) << 8) | ((unsigned)(q2 & 255) << 16) | ((unsigned)(q3 & 255) << 24); }
        unsigned char* dst = q8 + (size_t)t * D;
        *(v4u*)(dst + lane * 16) = (v4u){dw[0], dw[1], dw[2], dw[3]}; *(v4u*)(dst + (64 + lane) * 16) = (v4u){dw[4], dw[5], dw[6], dw[7]};
        if (lane == 0) q8s[t] = mx * (1.0f / 127.0f);
    }
}

__device__ __forceinline__ void ph_prologue_b(const Args& a, LAS unsigned char* lds, int tid, int lane, int wave, int bx, int G) {
    const float* part = (const float*)(a.ws + WS_PART); float* mod = (float*)(a.ws + WS_MOD);
    for (int i = bx * NTHREADS + tid; i < NL * NB * 6 * D / 4; i += G * NTHREADS) {
        const int idx = i * 4, e = idx % (6 * D), b = (idx / (6 * D)) % NB, l = idx / (6 * D * NB);
        f32x4 s = *(const f32x4*)(a.in[3] + l * 6 * D + e);
#pragma unroll
        for (int dr = 0; dr < 8; ++dr) s += *(const f32x4*)(part + (((size_t)l * 8 + dr) * NB + b) * (6 * D) + e);
        *(f32x4*)(mod + idx) = s;
    }
    LAS float* msh = (LAS float*)lds;
    bf16* hbuf = (bf16*)(a.ws + WS_H);
    for (int ch = bx; ch < NCHUNK; ch += G) {
        const int b = ch / NCH;
        for (int i = tid; i < 1024; i += NTHREADS) { const int e = i * 4;
            f32x4 s = *(const f32x4*)(a.in[3] + e);
#pragma unroll
            for (int dr = 0; dr < 8; ++dr) s += *(const f32x4*)(part + (((size_t)0 * 8 + dr) * NB + b) * (6 * D) + e);
            *(LAS f32x4*)(msh + e) = s; }
        __syncthreads();
        for (int i = 0; i < 8; ++i) { const int t = ch * 64 + wave * 8 + i;
#pragma unroll
            for (int c = 0; c < 4; ++c) { const int col = (c * 64 + lane) * 8;
                const f32x4 x0 = *(const f32x4*)(a.in[0] + (size_t)t * D + col), x1 = *(const f32x4*)(a.in[0] + (size_t)t * D + col + 4);
                const f32x4 h0 = *(const LAS f32x4*)(msh + col), h1 = *(const LAS f32x4*)(msh + col + 4), s0 = *(const LAS f32x4*)(msh + 2048 + col), s1 = *(const LAS f32x4*)(msh + 2048 + col + 4);
                v4u o; o.x = pk2(x0.x * (1.f + s0.x) + h0.x, x0.y * (1.f + s0.y) + h0.y); o.y = pk2(x0.z * (1.f + s0.z) + h0.z, x0.w * (1.f + s0.w) + h0.w);
                o.z = pk2(x1.x * (1.f + s1.x) + h1.x, x1.y * (1.f + s1.y) + h1.y); o.w = pk2(x1.z * (1.f + s1.z) + h1.z, x1.w * (1.f + s1.w) + h1.w);
                *(v4u*)(hbuf + (size_t)t * D + col) = o; } }
        __syncthreads();
    }
}

__device__ __forceinline__ void gate_prep(const Args& a, int l, LAS unsigned char* lds, int tid, int lane, int wave, int ch) {
    const bf16* hbuf = (const bf16*)(a.ws + WS_H); const bf16* waT = (const bf16*)(a.ws + WS_WIN) + ((size_t)l * INW + NP) * D;
    float* Ebuf = (float*)(a.ws + WS_E); float* dtot = (float*)(a.ws + WS_DTOT);
    const int t0 = ch * 64, l15 = lane & 15, lq = lane >> 4, mt = wave & 3, kh = wave >> 2;
    f32x4 acc = (f32x4){0.f, 0.f, 0.f, 0.f};
    const bf16* hA = hbuf + (size_t)(t0 + 16 * mt + l15) * D + kh * 1024 + 8 * lq;
    const bf16* wB = waT + (size_t)l15 * D + kh * 1024 + 8 * lq;
#pragma unroll 8
    for (int ks = 0; ks < 32; ++ks) { const bf16x8 av = *(const bf16x8*)(hA + 32 * ks), bv = *(const bf16x8*)(wB + 32 * ks); acc = __builtin_amdgcn_mfma_f32_16x16x32_bf16(av, bv, acc, 0, 0, 0); }
    LAS float* alr = (LAS float*)lds;
#pragma unroll
    for (int r = 0; r < 4; ++r) alr[(kh * 64 + 16 * mt + 4 * lq + r) * 16 + l15] = acc[r];
    __syncthreads();
    const int col = tid;
    float wg[16];
#pragma unroll
    for (int r = 0; r < 16; ++r) wg[r] = a.in[5][((size_t)l * RANK + r) * GKW + col];
    const float bgc = a.in[6][l * GKW + col];
    float tot = 0.f;
    for (int j = 0; j < 64; ++j) { float lg = bgc;
#pragma unroll
        for (int r4 = 0; r4 < 4; ++r4) { const f32x4 p = *(const LAS f32x4*)(alr + j * 16 + r4 * 4), q = *(const LAS f32x4*)(alr + (64 + j) * 16 + r4 * 4);
            lg += (p.x + q.x) * wg[r4 * 4] + (p.y + q.y) * wg[r4 * 4 + 1] + (p.z + q.z) * wg[r4 * 4 + 2] + (p.w + q.w) * wg[r4 * 4 + 3]; }
        tot += logsigmoid_f(lg) * (1.0f / 16.0f); }
    float run = 0.f;
    for (int j = 0; j < 64; ++j) { float lg = bgc;
#pragma unroll
        for (int r4 = 0; r4 < 4; ++r4) { const f32x4 p = *(const LAS f32x4*)(alr + j * 16 + r4 * 4), q = *(const LAS f32x4*)(alr + (64 + j) * 16 + r4 * 4);
            lg += (p.x + q.x) * wg[r4 * 4] + (p.y + q.y) * wg[r4 * 4 + 1] + (p.z + q.z) * wg[r4 * 4 + 2] + (p.w + q.w) * wg[r4 * 4 + 3]; }
        run += logsigmoid_f(lg) * (1.0f / 16.0f);
        Ebuf[(size_t)(t0 + j) * GKW + col] = __expf(tot - run); }
    dtot[(size_t)ch * GKW + col] = __expf(tot);
    __syncthreads();
}

__device__ __forceinline__ void gla_unit(const Args& a, LAS unsigned char* lds, int tid, int lane, int wave, int un) {
    const bf16* proj = (const bf16*)(a.ws + WS_PROJ); const float* Ebuf = (const float*)(a.ws + WS_E); const float* dtot = (const float*)(a.ws + WS_DTOT); float* ogla = (float*)(a.ws + WS_OGLA);
    const int dvs = un & 7, hh = (un >> 3) & 3, b = un >> 5;
    LAS bf16* kdT = (LAS bf16*)lds;
    LAS bf16* vT = (LAS bf16*)(lds + 18432);
    LAS bf16* ST = (LAS bf16*)(lds + 18432 + 4608);
    const int l15 = lane & 15, lq = lane >> 4, jl = tid >> 3, d16 = (tid & 7) * 16, dv4 = (tid & 7) * 4, jt = (wave & 3) * 16, dvt = (wave >> 2) * 16;
    f32x4 S0 = (f32x4){0.f, 0.f, 0.f, 0.f}, S1 = (f32x4){0.f, 0.f, 0.f, 0.f};
    v4u kn[2]; f32x4 en[4]; v2u vn; bf16x8 qn[4], qc[4]; f32x4 dn, dc;
#define GLA_LOAD(c) do { const int t0c = b * SEQ + (c) * 64; const bf16* pr = proj + (size_t)(t0c + jl) * NP; \
        kn[0] = *(const v4u*)(pr + PK + hh * 128 + d16); kn[1] = *(const v4u*)(pr + PK + hh * 128 + d16 + 8); \
        _Pragma("unroll") for (int i_ = 0; i_ < 4; ++i_) en[i_] = *(const f32x4*)(Ebuf + (size_t)(t0c + jl) * GKW + hh * 128 + d16 + 4 * i_); \
        vn = *(const v2u*)(pr + PV + hh * 256 + dvs * 32 + dv4); \
        _Pragma("unroll") for (int ks_ = 0; ks_ < 4; ++ks_) qn[ks_] = *(const bf16x8*)(proj + (size_t)(t0c + jt + l15) * NP + PQ + hh * 128 + 32 * ks_ + 8 * lq); \
        dn = *(const f32x4*)(dtot + (size_t)(b * NCH + (c)) * GKW + hh * 128 + 16 * wave + 4 * lq); } while (0)
#define GLA_PREP() do { \
        _Pragma("unroll") for (int i_ = 0; i_ < 16; ++i_) { const unsigned w_ = kn[i_ >> 3][(i_ & 7) >> 1]; const float kf_ = (i_ & 1) ? bfhi(w_) : bflo(w_); \
            kdT[(d16 + i_) * 72 + jl] = (bf16)(pk2(kf_ * en[i_ >> 2][i_ & 3], 0.f) & 0xffffu); } \
        _Pragma("unroll") for (int i_ = 0; i_ < 4; ++i_) { const unsigned w_ = vn[i_ >> 1]; vT[(dv4 + i_) * 72 + jl] = (bf16)((i_ & 1) ? (w_ >> 16) : (w_ & 0xffffu)); } \
        _Pragma("unroll") for (int ks_ = 0; ks_ < 4; ++ks_) qc[ks_] = qn[ks_]; \
        dc = dn; } while (0)
    GLA_LOAD(0); GLA_PREP();
    __syncthreads();
    for (int c = 0; c < NCH; ++c) {
        if (c + 1 < NCH) GLA_LOAD(c + 1);
        S0 = S0 * dc; S1 = S1 * dc;
#pragma unroll
        for (int ks = 0; ks < 2; ++ks) {
            const bf16x8 A = *(const LAS bf16x8*)(kdT + (16 * wave + l15) * 72 + 32 * ks + 8 * lq);
            const bf16x8 B0 = *(const LAS bf16x8*)(vT + l15 * 72 + 32 * ks + 8 * lq), B1 = *(const LAS bf16x8*)(vT + (16 + l15) * 72 + 32 * ks + 8 * lq);
            S0 = __builtin_amdgcn_mfma_f32_16x16x32_bf16(A, B0, S0, 0, 0, 0); S1 = __builtin_amdgcn_mfma_f32_16x16x32_bf16(A, B1, S1, 0, 0, 0); }
        { v2u w0, w1; w0.x = pk2(S0.x, S0.y); w0.y = pk2(S0.z, S0.w); w1.x = pk2(S1.x, S1.y); w1.y = pk2(S1.z, S1.w);
          *(LAS v2u*)(ST + l15 * 136 + 16 * wave + 4 * lq) = w0; *(LAS v2u*)(ST + (16 + l15) * 136 + 16 * wave + 4 * lq) = w1; }
        __syncthreads();
        f32x4 O = (f32x4){0.f, 0.f, 0.f, 0.f};
#pragma unroll
        for (int ks = 0; ks < 4; ++ks) { const bf16x8 A = *(const LAS bf16x8*)(ST + (dvt + l15) * 136 + 32 * ks + 8 * lq); O = __builtin_amdgcn_mfma_f32_16x16x32_bf16(A, qc[ks], O, 0, 0, 0); }
        *(f32x4*)(ogla + (size_t)(b * SEQ + c * 64 + jt + l15) * 1024 + hh * 256 + dvs * 32 + dvt + 4 * lq) = O * 0.08838834764831845f;
        if (c + 1 < NCH) GLA_PREP();
        __syncthreads();
    }
#undef GLA_LOAD
#undef GLA_PREP
}

__device__ __forceinline__ void unpack16(const v4u& p0, const v4u& p1, float (&o)[16]) {
#pragma unroll
    for (int j = 0; j < 4; ++j) { o[2 * j] = bflo(p0[j]); o[2 * j + 1] = bfhi(p0[j]); o[8 + 2 * j] = bflo(p1[j]); o[8 + 2 * j + 1] = bfhi(p1[j]); }
}
__device__ __forceinline__ void mixpost_chunk(const Args& a, int l, int lane, int wave, int ch) {
    const bf16* proj = (const bf16*)(a.ws + WS_PROJ); const float* ogla = (const float*)(a.ws + WS_OGLA); bf16* ybuf = (bf16*)(a.ws + WS_Y);
    const int c0 = 16 * lane, tfirst = ch * 64 + wave * 8, sfirst = tfirst % SEQ;
    float gn[16], cw0[16], cw1[16], cw2[16], cn[16], u1[16], u2[16];
#pragma unroll
    for (int i = 0; i < 16; ++i) { gn[i] = a.in[7][l * 256 + ((c0 + i) & 255)]; cw0[i] = a.in[8][(size_t)l * 3072 + c0 + i]; cw1[i] = a.in[8][(size_t)l * 3072 + 1024 + c0 + i];
        cw2[i] = a.in[8][(size_t)l * 3072 + 2048 + c0 + i]; cn[i] = a.in[9][l * 1024 + c0 + i]; u1[i] = 0.f; u2[i] = 0.f; }
    if (sfirst >= 2) {
        float cc[16], chh[16];
        { const bf16* pr = proj + (size_t)(tfirst - 2) * NP; unpack16(*(const v4u*)(pr + PCC + c0), *(const v4u*)(pr + PCC + c0 + 8), cc); unpack16(*(const v4u*)(pr + PCH + c0), *(const v4u*)(pr + PCH + c0 + 8), chh); }
#pragma unroll
        for (int i = 0; i < 16; ++i) u2[i] = cc[i] * chh[i];
        { const bf16* pr = proj + (size_t)(tfirst - 1) * NP; unpack16(*(const v4u*)(pr + PCC + c0), *(const v4u*)(pr + PCC + c0 + 8), cc); unpack16(*(const v4u*)(pr + PCH + c0), *(const v4u*)(pr + PCH + c0 + 8), chh); }
#pragma unroll
        for (int i = 0; i < 16; ++i) u1[i] = cc[i] * chh[i];
    }
    for (int it = 0; it < 8; ++it) { const int t = tfirst + it; const bf16* pr = proj + (size_t)t * NP;
        float o[16], r[16], cb[16], cc[16], chh[16];
#pragma unroll
        for (int j = 0; j < 4; ++j) { const f32x4 v = *(const f32x4*)(ogla + (size_t)t * 1024 + c0 + 4 * j); o[4 * j] = v.x; o[4 * j + 1] = v.y; o[4 * j + 2] = v.z; o[4 * j + 3] = v.w; }
        unpack16(*(const v4u*)(pr + PR + c0), *(const v4u*)(pr + PR + c0 + 8), r);
        unpack16(*(const v4u*)(pr + PCB + c0), *(const v4u*)(pr + PCB + c0 + 8), cb);
        unpack16(*(const v4u*)(pr + PCC + c0), *(const v4u*)(pr + PCC + c0 + 8), cc);
        unpack16(*(const v4u*)(pr + PCH + c0), *(const v4u*)(pr + PCH + c0 + 8), chh);
        float ss = 0.f;
#pragma unroll
        for (int i = 0; i < 16; ++i) ss += o[i] * o[i];
        ss += __shfl_xor(ss, 1); ss += __shfl_xor(ss, 2); ss += __shfl_xor(ss, 4); ss += __shfl_xor(ss, 8);
        const float rg = rsqrtf(ss * (1.0f / 256.f) + EPS);
        float val[16]; float s2 = 0.f;
#pragma unroll
        for (int i = 0; i < 16; ++i) { const float u0 = cc[i] * chh[i]; val[i] = cb[i] * (cw0[i] * u2[i] + cw1[i] * u1[i] + cw2[i] * u0); s2 += val[i] * val[i]; u2[i] = u1[i]; u1[i] = u0; }
        const float rc = rsqrtf(wave_sum(s2) * (1.0f / 1024.f) + EPS);
        v4u y0, y1, y2, y3;
#pragma unroll
        for (int j = 0; j < 4; ++j) {
            y0[j] = pk2(o[2 * j] * rg * gn[2 * j] * silu_f(r[2 * j]), o[2 * j + 1] * rg * gn[2 * j + 1] * silu_f(r[2 * j + 1]));
            y1[j] = pk2(o[8 + 2 * j] * rg * gn[8 + 2 * j] * silu_f(r[8 + 2 * j]), o[9 + 2 * j] * rg * gn[9 + 2 * j] * silu_f(r[9 + 2 * j]));
            y2[j] = pk2(val[2 * j] * rc * cn[2 * j], val[2 * j + 1] * rc * cn[2 * j + 1]);
            y3[j] = pk2(val[8 + 2 * j] * rc * cn[8 + 2 * j], val[9 + 2 * j] * rc * cn[9 + 2 * j]); }
        bf16* yr = ybuf + (size_t)t * D;
        *(v4u*)(yr + c0) = y0; *(v4u*)(yr + c0 + 8) = y1; *(v4u*)(yr + 1024 + c0) = y2; *(v4u*)(yr + 1024 + c0 + 8) = y3;
    }
}

__device__ __forceinline__ void ln1_chunk(const Args& a, int l, int lane, int wave, int ch) {
    const float* zbuf = (const float*)(a.ws + WS_Z); const float* mod = (const float*)(a.ws + WS_MOD);
    const int b = ch / NCH; const float* mb = mod + ((size_t)l * NB + b) * 6 * D;
    for (int it = 0; it < 8; ++it) { const int t = ch * 64 + wave * 8 + it;
        float z[32];
#pragma unroll
        for (int c = 0; c < 8; ++c) { const f32x4 v0 = *(const f32x4*)(zbuf + (size_t)t * D + (c * 64 + lane) * 4); z[c * 4] = v0.x; z[c * 4 + 1] = v0.y; z[c * 4 + 2] = v0.z; z[c * 4 + 3] = v0.w; }
        ln_tail(z, t, lane, a.in[11] + (size_t)l * D, a.in[12] + (size_t)l * D, (float*)(a.ws + WS_X1), mb + 3 * D, mb + 4 * D, (bf16*)(a.ws + WS_H2), a.ws + WS_HQ8, (float*)(a.ws + WS_HSC));
    }
}

template <int N> __device__ __forceinline__ void bitonic_sort_desc(float (&v)[N]) {
#pragma unroll
    for (int k = 2; k <= N; k <<= 1)
#pragma unroll
        for (int j = k >> 1; j > 0; j >>= 1)
#pragma unroll
            for (int i = 0; i < N; ++i) { const int p = i ^ j; if (p > i) { const bool desc = ((i & k) == 0); const float x = v[i], y = v[p]; const float mx = fmaxf(x, y), mn = fminf(x, y); v[i] = desc ? mx : mn; v[p] = desc ? mn : mx; } }
}
__device__ __forceinline__ void merge_top16(float (&x)[16], const float (&y)[16]) {
#pragma unroll
    for (int i = 0; i < 16; ++i) x[i] = fmaxf(x[i], y[15 - i]);
#pragma unroll
    for (int j = 8; j > 0; j >>= 1)
#pragma unroll
        for (int i = 0; i < 16; ++i) { const int p = i ^ j; if (p > i) { const float u = x[i], w = x[p]; x[i] = fmaxf(u, w); x[p] = fminf(u, w); } }
}
__device__ __forceinline__ void ce_desc(float& ka, int& pa, float& kb, int& pb) { const bool sw = kb > ka; const float k0 = sw ? kb : ka, k1 = sw ? ka : kb; const int p0 = sw ? pb : pa, p1 = sw ? pa : pb; ka = k0; pa = p0; kb = k1; pb = p1; }
__device__ __forceinline__ void bitonic_sort_desc_kp(float (&k)[16], int (&p)[16]) {
#pragma unroll
    for (int kk = 2; kk <= 16; kk <<= 1)
#pragma unroll
        for (int j = kk >> 1; j > 0; j >>= 1)
#pragma unroll
            for (int i = 0; i < 16; ++i) { const int q = i ^ j; if (q > i) { if ((i & kk) == 0) ce_desc(k[i], p[i], k[q], p[q]); else ce_desc(k[q], p[q], k[i], p[i]); } }
}
__device__ __forceinline__ void merge_top16_kp(float (&k)[16], int (&p)[16], const float (&k2)[16], const int (&p2)[16]) {
#pragma unroll
    for (int i = 0; i < 16; ++i) { const bool sw = k2[15 - i] > k[i]; k[i] = sw ? k2[15 - i] : k[i]; p[i] = sw ? p2[15 - i] : p[i]; }
#pragma unroll
    for (int j = 8; j > 0; j >>= 1)
#pragma unroll
        for (int i = 0; i < 16; ++i) { const int q = i ^ j; if (q > i) ce_desc(k[i], p[i], k[q], p[q]); }
}
__device__ constexpr int cand_i(int s) { return s < 16 ? 0 : s < 24 ? 1 : s < 29 ? 2 : s < 33 ? 3 : s < 36 ? 4 : s < 38 ? 5 : s < 40 ? 6 : s < 42 ? 7 : s < 50 ? s - 34 : -1; }
__device__ constexpr int cand_j(int s) { return s < 16 ? s : s < 24 ? s - 16 : s < 29 ? s - 24 : s < 33 ? s - 29 : s < 36 ? s - 33 : s < 38 ? s - 36 : s < 40 ? s - 38 : s < 42 ? s - 40 : s < 50 ? 0 : -1; }

__device__ __forceinline__ void peer_retrieve(const Args& a, int l, LAS unsigned char* lds, int lane, int wave, int ch) {
    const bf16* qbuf = (const bf16*)(a.ws + WS_Q); const bf16* keys = (const bf16*)(a.ws + WS_KEYS) + ((size_t)(l * 8 + wave) * 2) * 128 * 128;
    LAS int* eg_e = (LAS int*)lds; LAS float* eg_g = (LAS float*)(lds + 32768);
    const int l31 = lane & 31, l5 = lane >> 5, h = wave, t0 = ch * 64;
    for (int tt = 0; tt < 2; ++tt) {
        float sv[2][16];
#pragma unroll
        for (int p = 0; p < 2; ++p) {
            f32x16 acc[4];
#pragma unroll
            for (int nt = 0; nt < 4; ++nt)
#pragma unroll
                for (int r = 0; r < 16; ++r) acc[nt][r] = 0.f;
            const bf16* qp = qbuf + (size_t)(t0 + 32 * tt + l31) * D + h * 256 + p * 128 + 8 * l5;
            const bf16* kp = keys + (size_t)(p * 128 + l31) * 128 + 8 * l5;
#pragma unroll 2
            for (int ks = 0; ks < 8; ++ks) { const bf16x8 bq = *(const bf16x8*)(qp + 16 * ks);
#pragma unroll
                for (int nt = 0; nt < 4; ++nt) { const bf16x8 ak = *(const bf16x8*)(kp + (size_t)(32 * nt) * 128 + 16 * ks); acc[nt] = __builtin_amdgcn_mfma_f32_32x32x16_bf16(ak, bq, acc[nt], 0, 0, 0); } }
            float v[4][16];
#pragma unroll
            for (int nt = 0; nt < 4; ++nt)
#pragma unroll
                for (int r = 0; r < 16; ++r) { const unsigned idx = 32u * nt + (r & 3) + 8u * (r >> 2) + 4u * l5; v[nt][r] = __uint_as_float((__float_as_uint(acc[nt][r]) & 0xffffff80u) | idx); }
#pragma unroll
            for (int nt = 0; nt < 4; ++nt) bitonic_sort_desc<16>(v[nt]);
            merge_top16(v[0], v[1]); merge_top16(v[2], v[3]); merge_top16(v[0], v[2]);
            float o[16];
#pragma unroll
            for (int i = 0; i < 16; ++i) o[i] = __shfl_xor(v[0][i], 32);
            merge_top16(v[0], o);
#pragma unroll
            for (int i = 0; i < 16; ++i) sv[p][i] = v[0][i];
        }
        LAS unsigned char* idxb = (LAS unsigned char*)(lds + 69632) + wave * 2048 + lane * 32;
        { v4u w0, w1;
#pragma unroll
          for (int q4 = 0; q4 < 4; ++q4) {
              w0[q4] = (__float_as_uint(sv[0][4 * q4]) & 127u) | ((__float_as_uint(sv[0][4 * q4 + 1]) & 127u) << 8) | ((__float_as_uint(sv[0][4 * q4 + 2]) & 127u) << 16) | ((__float_as_uint(sv[0][4 * q4 + 3]) & 127u) << 24);
              w1[q4] = (__float_as_uint(sv[1][4 * q4]) & 127u) | ((__float_as_uint(sv[1][4 * q4 + 1]) & 127u) << 8) | ((__float_as_uint(sv[1][4 * q4 + 2]) & 127u) << 16) | ((__float_as_uint(sv[1][4 * q4 + 3]) & 127u) << 24); }
          *(LAS v4u*)(idxb) = w0; *(LAS v4u*)(idxb + 16) = w1; }
        float ck[4][16];
#pragma unroll
        for (int s = 0; s < 64; ++s) {
            if (cand_i(s) >= 0) { const unsigned b0 = __float_as_uint(sv[0][cand_i(s) < 0 ? 0 : cand_i(s)]), b1 = __float_as_uint(sv[1][cand_j(s) < 0 ? 0 : cand_j(s)]);
                const float sum = __uint_as_float(b0 & 0xffffff80u) + __uint_as_float(b1 & 0xffffff80u);
                ck[s >> 4][s & 15] = __uint_as_float((__float_as_uint(sum) & 0xffffff00u) | (unsigned)((cand_i(s) < 0 ? 0 : cand_i(s)) * 16 + (cand_j(s) < 0 ? 0 : cand_j(s)))); }
            else ck[s >> 4][s & 15] = -3.0e38f; }
        bitonic_sort_desc<16>(ck[1]); bitonic_sort_desc<16>(ck[2]);
        merge_top16(ck[0], ck[1]); merge_top16(ck[2], ck[3]); merge_top16(ck[0], ck[2]);
        LDS_WAIT(); asm volatile("" ::: "memory");
        float ex[16]; int ce[16]; float den = 0.f;
        const float cmax = __uint_as_float(__float_as_uint(ck[0][0]) & 0xffffff00u);
#pragma unroll
        for (int i = 0; i < 16; ++i) { const unsigned bits = __float_as_uint(ck[0][i]); ex[i] = __expf(__uint_as_float(bits & 0xffffff00u) - cmax); den += ex[i];
            ce[i] = (int)idxb[(bits >> 4) & 15u] * 128 + (int)idxb[16 + (bits & 15u)]; }
        const float inv = 1.0f / den;
        if (l5 == 0) {
            const int base = (32 * tt + l31) * 128 + h * 16;
#pragma unroll
            for (int i4 = 0; i4 < 4; ++i4) { *(LAS v4u*)(eg_e + base + 4 * i4) = (v4u){(unsigned)ce[4 * i4], (unsigned)ce[4 * i4 + 1], (unsigned)ce[4 * i4 + 2], (unsigned)ce[4 * i4 + 3]};
                *(LAS f32x4*)(eg_g + base + 4 * i4) = (f32x4){ex[4 * i4] * inv, ex[4 * i4 + 1] * inv, ex[4 * i4 + 2] * inv, ex[4 * i4 + 3] * inv}; }
        }
        LDS_WAIT(); asm volatile("" ::: "memory");
    }
}

typedef unsigned char uc4 __attribute__((ext_vector_type(4)));
constexpr int NSLICE = 16, SLICE_SHIFT = 10;
__device__ __forceinline__ int sdot4i(unsigned w, unsigned x, int acc) { return __builtin_amdgcn_sdot4((int)w, (int)x, acc, false); }
__device__ __forceinline__ void fma_ub4(unsigned w, float s, float& y0, float& y1, float& y2, float& y3) { const uc4 b = __builtin_bit_cast(uc4, w); y0 += s * (float)b.x; y1 += s * (float)b.y; y2 += s * (float)b.z; y3 += s * (float)b.w; }
__device__ __forceinline__ float peer_v_rows(float (&y)[32], const unsigned char* vt, const LAS int* se, const LAS float* sw, int base, int n, int lane) {
    float wsum = 0.f;
    for (int k0 = 0; k0 < n; k0 += 8) {
        v4u rw[8][2];
#pragma unroll
        for (int k = 0; k < 8; ++k) if (k0 + k < n) { const int e = __builtin_amdgcn_readfirstlane(se[base + k0 + k]); const unsigned char* row = vt + (size_t)e * D;
            rw[k][0] = *(const v4u*)(row + lane * 16); rw[k][1] = *(const v4u*)(row + (64 + lane) * 16); }
#pragma unroll
        for (int k = 0; k < 8; ++k) if (k0 + k < n) { const float wk = sw[base + k0 + k]; wsum += wk;
#pragma unroll
            for (int c = 0; c < 2; ++c)
#pragma unroll
                for (int d = 0; d < 4; ++d) fma_ub4(rw[k][c][d], wk, y[(c * 4 + d) * 4], y[(c * 4 + d) * 4 + 1], y[(c * 4 + d) * 4 + 2], y[(c * 4 + d) * 4 + 3]); }
    }
    return wsum;
}
__device__ __forceinline__ void peer_tail(const Args& a, int l, int t, int lane, float (&y)[32], float wsum, const float* mb, const float* mbn, bool last) {
    const float* x1buf = (const float*)(a.ws + WS_X1);
    const float woff = 128.0f * wsum;
    float z[32];
#pragma unroll
    for (int c = 0; c < 8; ++c) { const int col = (c * 64 + lane) * 4;
        const f32x4 x0 = *(const f32x4*)(x1buf + (size_t)t * D + col), g0 = *(const f32x4*)(mb + 5 * D + col);
        z[c * 4] = ALPHA * x0.x + (1.f + g0.x) * (y[c * 4] - woff); z[c * 4 + 1] = ALPHA * x0.y + (1.f + g0.y) * (y[c * 4 + 1] - woff);
        z[c * 4 + 2] = ALPHA * x0.z + (1.f + g0.z) * (y[c * 4 + 2] - woff); z[c * 4 + 3] = ALPHA * x0.w + (1.f + g0.w) * (y[c * 4 + 3] - woff); }
    ln_tail(z, t, lane, a.in[17] + (size_t)l * D, a.in[18] + (size_t)l * D, last ? a.out : (float*)(a.ws + WS_X), mbn, mbn + D, last ? (bf16*)nullptr : (bf16*)(a.ws + WS_H), nullptr, nullptr);
}
__device__ __forceinline__ void peer_experts(const Args& a, int l, LAS unsigned char* lds, int lane, int wave, int ch) {
    const float* mod = (const float*)(a.ws + WS_MOD);
    const unsigned char* ut = a.ws + WS_UT + (size_t)l * NE * D; const unsigned char* vt = a.ws + WS_VT + (size_t)l * NE * D; const unsigned char* hq8 = a.ws + WS_HQ8;
    const float* su = (const float*)(a.ws + WS_SU) + (size_t)l * NE; const float* sv = (const float*)(a.ws + WS_SV) + (size_t)l * NE; const float* hsc = (const float*)(a.ws + WS_HSC);
    const LAS int* eg_e = (const LAS int*)lds; const LAS float* eg_g = (const LAS float*)(lds + 32768);
    LAS int* se = (LAS int*)(lds + 65536); LAS float* sw = (LAS float*)(lds + 98304); LAS int* soff = (LAS int*)(lds + LDSCTL_OFF + 256);
    const int b = ch / NCH; const bool last = (l == NL - 1);
    const float* mb = mod + ((size_t)l * NB + b) * 6 * D; const float* mbn = mod + ((size_t)(last ? l : l + 1) * NB + b) * 6 * D;
    const int b5 = (lane >> 5) & 1, b4 = (lane >> 4) & 1, b3 = (lane >> 3) & 1;
    for (int it = 0; it < 8; ++it) {
        const int tl = wave * 8 + it;
        const int e0 = eg_e[tl * 128 + lane], e1 = eg_e[tl * 128 + 64 + lane]; const float g0 = eg_g[tl * 128 + lane], g1 = eg_g[tl * 128 + 64 + lane];
        const int s0 = e0 >> SLICE_SHIFT, s1 = e1 >> SLICE_SHIFT;
        int run = 0, pos0 = 0, pos1 = 0;
#pragma unroll
        for (int s = 0; s < NSLICE; ++s) {
            const unsigned long long m0 = __ballot(s0 == s), m1 = __ballot(s1 == s);
            const int c0 = __popcll(m0), c1 = __popcll(m1);
            const int r0 = __builtin_amdgcn_mbcnt_hi((unsigned)(m0 >> 32), __builtin_amdgcn_mbcnt_lo((unsigned)m0, 0u)), r1 = __builtin_amdgcn_mbcnt_hi((unsigned)(m1 >> 32), __builtin_amdgcn_mbcnt_lo((unsigned)m1, 0u));
            if (s0 == s) pos0 = run + r0;
            if (s1 == s) pos1 = run + c0 + r1;
            if (lane == 0) soff[tl * 17 + s] = run;
            run += c0 + c1;
        }
        if (lane == 0) soff[tl * 17 + 16] = run;
        se[tl * 128 + pos0] = e0; sw[tl * 128 + pos0] = g0; se[tl * 128 + pos1] = e1; sw[tl * 128 + pos1] = g1;
    }
    LDS_WAIT(); asm volatile("" ::: "memory");
    for (int s = 0; s < NSLICE; ++s) {
        for (int it = 0; it < 8; ++it) {
            const int tl = wave * 8 + it, t = ch * 64 + tl;
            const int base = __builtin_amdgcn_readfirstlane(soff[tl * 17 + s]), n = __builtin_amdgcn_readfirstlane(soff[tl * 17 + s + 1]) - base;
            if (n <= 0) continue;
            const v4u hq0 = *(const v4u*)(hq8 + (size_t)t * D + lane * 16), hq1 = *(const v4u*)(hq8 + (size_t)t * D + (64 + lane) * 16);
            const float shs = hsc[t];
            for (int k0 = 0; k0 < n; k0 += 8) {
                v4u rw[8][2];
#pragma unroll
                for (int k = 0; k < 8; ++k) { if (k0 + k < n) { const int e = __builtin_amdgcn_readfirstlane(se[tl * 128 + base + k0 + k]); const unsigned char* row = ut + (size_t)e * D;
                        rw[k][0] = *(const v4u*)(row + lane * 16); rw[k][1] = *(const v4u*)(row + (64 + lane) * 16); }
                    else { rw[k][0] = (v4u){0u, 0u, 0u, 0u}; rw[k][1] = (v4u){0u, 0u, 0u, 0u}; } }
                float p[8];
#pragma unroll
                for (int k = 0; k < 8; ++k) { int acc = 0;
#pragma unroll
                    for (int d = 0; d < 4; ++d) { acc = sdot4i(rw[k][0][d], hq0[d], acc); acc = sdot4i(rw[k][1][d], hq1[d], acc); }
                    p[k] = (float)acc; }
                float q4[4], r2[2];
#pragma unroll
                for (int k = 0; k < 4; ++k) { const float send = b5 ? p[k] : p[k + 4], keep = b5 ? p[k + 4] : p[k]; q4[k] = keep + __shfl_xor(send, 32); }
#pragma unroll
                for (int k = 0; k < 2; ++k) { const float send = b4 ? q4[k] : q4[k + 2], keep = b4 ? q4[k + 2] : q4[k]; r2[k] = keep + __shfl_xor(send, 16); }
                float s1; { const float send = b3 ? r2[0] : r2[1], keep = b3 ? r2[1] : r2[0]; s1 = keep + __shfl_xor(send, 8); }
                s1 += __shfl_xor(s1, 4); s1 += __shfl_xor(s1, 2); s1 += __shfl_xor(s1, 1);
                const int slot = k0 + (lane >> 3); const bool valid = slot < n; const int idx = tl * 128 + base + (valid ? slot : 0);
                const int er = se[idx]; const float gt = sw[idx];
                const float wgt = gt * gelu_tanh_f(s1 * su[er] * shs) * sv[er];
                LDS_WAIT(); asm volatile("" ::: "memory");
                if (valid && (lane & 7) == 0) sw[idx] = wgt;
            }
        }
    }
    LDS_WAIT(); asm volatile("" ::: "memory");
    for (int sub = 0; sub < 4; ++sub) {
        const int tlA = wave * 8 + 2 * sub, tlB = tlA + 1;
        float yA[32], yB[32]; float wsA = 0.f, wsB = 0.f;
#pragma unroll
        for (int i = 0; i < 32; ++i) { yA[i] = 0.f; yB[i] = 0.f; }
        for (int s = 0; s < NSLICE; ++s) {
            { const int base = __builtin_amdgcn_readfirstlane(soff[tlA * 17 + s]), n = __builtin_amdgcn_readfirstlane(soff[tlA * 17 + s + 1]) - base;
              wsA += peer_v_rows(yA, vt, se + tlA * 128, sw + tlA * 128, base, n, lane); }
            { const int base = __builtin_amdgcn_readfirstlane(soff[tlB * 17 + s]), n = __builtin_amdgcn_readfirstlane(soff[tlB * 17 + s + 1]) - base;
              wsB += peer_v_rows(yB, vt, se + tlB * 128, sw + tlB * 128, base, n, lane); }
        }
        peer_tail(a, l, ch * 64 + tlA, lane, yA, wsA, mb, mbn, last);
        peer_tail(a, l, ch * 64 + tlB, lane, yB, wsB, mb, mbn, last);
    }
}

#ifndef MK_PER_PHASE
#define MK_PER_PHASE 0
#endif
__global__ void __launch_bounds__(NTHREADS, 2) mk_fwd(Args a) {
    extern __shared__ __attribute__((aligned(16))) unsigned char lds_raw[];
    LAS unsigned char* lds = (LAS unsigned char*)lds_raw;
    const int tid = threadIdx.x, lane = tid & 63, wave = __builtin_amdgcn_readfirstlane(tid >> 6), G = gridDim.x, bx = blockIdx.x;
    if (tid < 64) ((LAS unsigned*)(lds + LDSCTL_OFF))[tid] = 0u;
    __syncthreads();
    unsigned* ctl = (unsigned*)(a.ws + WS_CTL);
    XcdBarrier bar; bar.bar = ctl + CW_BAR; bar.x = 0; bar.st = nullptr;
    const bool use_bar = (a.ph_hi - a.ph_lo) > 1;
    if (use_bar) bar = xcd_barrier_post(ctl + CW_BAR, (volatile LAS unsigned*)(lds + LDSCTL_OFF));
    const int lo = a.ph_lo, hi = a.ph_hi;
#ifndef PH_MASK
#define PH_MASK 0x1ff
#endif
#define IN(k) (lo <= (k) && (k) < hi)
#define EN(b) ((PH_MASK >> (b)) & 1)
#ifndef REP_MASK
#define REP_MASK 0
#endif
#ifndef REP_EXTRA
#define REP_EXTRA 2
#endif
#define REPS(b) (1 + ((REP_MASK >> (b)) & 1) * REP_EXTRA)
#define REP_BEGIN(b) for (int rep_ = 0; rep_ < REPS(b); ++rep_) {
#define REP_END(b) if (rep_ + 1 < REPS(b)) xcd_barrier(bar); }
#define SEAM(k) do { if (IN((k) + 1)) xcd_barrier(bar); } while (0)
#define PHASE_IDS() int tidp = tid; asm volatile("" : "+v"(tidp)); const int lanep = tidp & 63, wavep = __builtin_amdgcn_readfirstlane(tidp >> 6); (void)lanep; (void)wavep
    if (EN(0) && IN(0)) { REP_BEGIN(0) PHASE_IDS(); ph_prologue_a(a, lds, tidp, lanep, wavep, bx, G); REP_END(0) SEAM(0); }
    if (EN(1) && IN(1)) { REP_BEGIN(1) PHASE_IDS(); ph_prologue_b(a, lds, tidp, lanep, wavep, bx, G); REP_END(1) SEAM(1); }
    for (int l = 0; l < NL; ++l) {
        const int pb = 2 + 7 * l;
        const float* mod = (const float*)(a.ws + WS_MOD);
        if (EN(2) && IN(pb + 0)) {
            REP_BEGIN(2) PHASE_IDS();
            pg8::Gemm g{(const pg8::bf16_t*)(a.ws + WS_H), (const pg8::bf16_t*)(a.ws + WS_WIN) + (size_t)l * INW * D, T, NP, D}; pg8::StaticOrder S; S.init(T, NP, G, bx);
            pg8::EpiBf16P E{(pg8::bf16_t*)(a.ws + WS_PROJ), NP};
            pg8::gemm_phase<pg8::EpiBf16P, pg8::StaticOrder, true, true>(lds + RING_OFF, g, S, E, tidp);
            for (int ch = bx; ch < NCHUNK; ch += G) gate_prep(a, l, lds, tidp, lanep, wavep, ch);
            REP_END(2) SEAM(pb + 0);
        }
        if (EN(3) && IN(pb + 1)) { REP_BEGIN(3) PHASE_IDS(); for (int un = bx; un < 256; un += G) gla_unit(a, lds, tidp, lanep, wavep, un); REP_END(3) SEAM(pb + 1); }
        if (EN(4) && IN(pb + 2)) { REP_BEGIN(4) PHASE_IDS(); for (int ch = bx; ch < NCHUNK; ch += G) mixpost_chunk(a, l, lanep, wavep, ch); REP_END(4) SEAM(pb + 2); }
        if (EN(5) && IN(pb + 3)) {
            REP_BEGIN(5) PHASE_IDS();
            pg8::Gemm g{(const pg8::bf16_t*)(a.ws + WS_Y), (const pg8::bf16_t*)(a.ws + WS_WOUT) + (size_t)l * D * D, T, D, D}; pg8::StaticOrder S; S.init(T, D, G, bx);
            pg8::EpiResid E{(float*)(a.ws + WS_Z), l == 0 ? a.in[0] : (const float*)(a.ws + WS_X), mod + (size_t)l * NB * 6 * D + 2 * D, ALPHA};
            pg8::gemm_phase<pg8::EpiResid, pg8::StaticOrder, true, true>(lds + RING_OFF, g, S, E, tidp);
            REP_END(5) SEAM(pb + 3);
        }
        if (EN(6) && IN(pb + 4)) { REP_BEGIN(6) PHASE_IDS(); for (int ch = bx; ch < NCHUNK; ch += G) ln1_chunk(a, l, lanep, wavep, ch); REP_END(6) SEAM(pb + 4); }
        if (EN(7) && IN(pb + 5)) {
            REP_BEGIN(7) PHASE_IDS();
            pg8::Gemm g{(const pg8::bf16_t*)(a.ws + WS_H2), (const pg8::bf16_t*)(a.ws + WS_WQ) + (size_t)l * D * D, T, D, D}; pg8::StaticOrder S; S.init(T, D, G, bx);
            pg8::EpiBf16P E{(pg8::bf16_t*)(a.ws + WS_Q), D};
            pg8::gemm_phase<pg8::EpiBf16P, pg8::StaticOrder, true, true>(lds + RING_OFF, g, S, E, tidp);
            REP_END(7) SEAM(pb + 5);
        }
#ifndef PEER_DBG
#define PEER_DBG 0
#endif
#ifndef L2PROBE
#define L2PROBE 0
#endif
        if (EN(8) && IN(pb + 6)) {
            REP_BEGIN(8)
            for (int ch = bx; ch < NCHUNK; ch += G) { { PHASE_IDS(); peer_retrieve(a, l, lds, lanep, wavep, ch); } __syncthreads(); { PHASE_IDS(); peer_experts(a, l, lds, lanep, wavep, ch); } __syncthreads(); }
            REP_END(8) SEAM(pb + 6);
        }
    }
#undef IN
#undef SEAM
}

extern "C" void kernel_launch(void* const* d_in, const int* in_sizes, int n_in, void* d_out, int out_size, void* d_ws, size_t ws_size, hipStream_t stream) {
    static int grid = 0;
    if (grid == 0) {
        if (n_in != 19 || in_sizes[0] != T * D || out_size != T * D || ws_size < WS_END) { fprintf(stderr, "kernel_launch: unexpected shapes / workspace (%d inputs, ws %zu); nothing launched\n", n_in, ws_size); grid = -1; return; }
        int dev = 0, cus = 0, per_cu = 0;
        if (hipGetDevice(&dev) != hipSuccess || hipDeviceGetAttribute(&cus, hipDeviceAttributeMultiprocessorCount, dev) != hipSuccess) { grid = -1; return; }
        if (hipFuncSetAttribute((const void*)mk_fwd, hipFuncAttributeMaxDynamicSharedMemorySize, LDS_BYTES) != hipSuccess) { fprintf(stderr, "kernel_launch: hipFuncSetAttribute failed\n"); grid = -1; return; }
        if (hipOccupancyMaxActiveBlocksPerMultiprocessor(&per_cu, (const void*)mk_fwd, NTHREADS, LDS_BYTES) != hipSuccess || per_cu < 1) fprintf(stderr, "kernel_launch: occupancy query reports %d\n", per_cu);
        (void)hipGetLastError();
        grid = cus;
    }
    if (grid < 0) return;
    if (hipMemsetAsync((char*)d_ws + WS_CTL, 0, CTL_ZERO_BYTES, stream) != hipSuccess) return;
    Args a{};
    for (int i = 0; i < 19; ++i) a.in[i] = (const float*)d_in[i];
    a.out = (float*)d_out; a.ws = (unsigned char*)d_ws;
#if MK_PER_PHASE
    for (int p = 0; p < NPHASES; ++p) { a.ph_lo = p; a.ph_hi = p + 1; hipLaunchKernelGGL(mk_fwd, dim3(grid), dim3(NTHREADS), LDS_BYTES, stream, a); }
#else
    a.ph_lo = 0; a.ph_hi = NPHASES;
    hipLaunchKernelGGL(mk_fwd, dim3(grid), dim3(NTHREADS), LDS_BYTES, stream, a);
#endif
}
```

```cpp
#include <hip/hip_runtime.h>
#include <cstdio>
#include <cstdint>
namespace pg8 {
#define PG8_LAS __attribute__((address_space(3)))
typedef unsigned short bf16_t;
typedef short bf16x8 __attribute__((ext_vector_type(8)));
typedef float f32x4 __attribute__((ext_vector_type(4)));
typedef unsigned u32x4 __attribute__((ext_vector_type(4)));
constexpr int BM = 256, BK = 64, HALF = 128, HTB = HALF * BK * 2  , STAGE_BYTES = 8 * HTB, NXCD = 8, WGM = 8;

__host__ __device__ __forceinline__ int lds_byte(int r, int c) { const int st = (r >> 4) * 2 + (c >> 5), rr = r & 15, cc = c & 31, ob = rr * 64 + cc * 2; return st * 1024 + (ob ^ (((ob >> 9) & 1) << 5)); }
__host__ __device__ __forceinline__ void stage_rc(int b, int& R, int& C) { const int st = b / 1024, sb = b % 1024, swz = sb ^ (((sb >> 9) & 1) << 5); R = (st >> 1) * 16 + swz / 64; C = (st & 1) * 32 + (swz % 64) / 2; }
__host__ __device__ __forceinline__ int perm32(int rho) { const int n = rho >> 4, i = rho & 15; return 8 * (i >> 2) + 4 * n + (i & 3); }

struct Unit { int pm, pn; };
struct Gemm { const bf16_t* A; const bf16_t* Bt; int M, N, K; };

struct StaticOrder {
    int nM, nN, nwg, G, c;
    __host__ __device__ void init(int M, int N, int G_, int c_) { nM = M / BM; nN = N / BM; nwg = nM * nN; G = G_; c = c_; }
    __host__ __device__ bool next(int i, Unit& u) const {
        const long L = (long)i * G + c; if (L >= nwg) return false;
        int wgid = (int)L; { const int q = nwg / NXCD, r = nwg % NXCD, xcd = wgid % NXCD, off = wgid / NXCD; wgid = (xcd < r ? xcd * (q + 1) : r * (q + 1) + (xcd - r) * q) + off; }
        const int nig = WGM * nN, gid = wgid / nig, fm = gid * WGM, gsz = (nM - fm) < WGM ? (nM - fm) : WGM;
        u.pm = fm + ((wgid % nig) % gsz); u.pn = (wgid % nig) / gsz; return true;
    }
    __device__ __forceinline__ void a_ready(const Unit&) const {}
    __device__ __forceinline__ void done(const Unit&) const {}
};
typedef __bf16 bf16x2_t __attribute__((ext_vector_type(2)));
__device__ __forceinline__ unsigned cvt_pk_bf16(float lo, float hi) { bf16x2_t r; r.x = (__bf16)lo; r.y = (__bf16)hi; return __builtin_bit_cast(unsigned, r); }
struct EpiBf16P {
    static constexpr bool PERM = true, AFTER_DRAIN = false;
    bf16_t* O; int ldc;
    __device__ __forceinline__ void operator()(const f32x4 (&acc)[2][2][4][2], const Unit& u, int wr, int wc, int fr, int fq) const {
        const int row0 = u.pm * BM + wr * 64 + fr, col0 = u.pn * BM + wc * 32 + 8 * fq;
#pragma unroll
        for (int ai = 0; ai < 2; ++ai)
#pragma unroll
            for (int m = 0; m < 4; ++m) { bf16_t* rowp = O + (size_t)(row0 + ai * HALF + m * 16) * ldc + col0;
#pragma unroll
                for (int bj = 0; bj < 2; ++bj) { const f32x4 v0 = acc[ai][bj][m][0], v1 = acc[ai][bj][m][1];
                    u32x4 w; w.x = cvt_pk_bf16(v0[0], v0[1]); w.y = cvt_pk_bf16(v0[2], v0[3]); w.z = cvt_pk_bf16(v1[0], v1[1]); w.w = cvt_pk_bf16(v1[2], v1[3]);
                    *(u32x4*)(rowp + bj * HALF) = w; } }
    }
};
struct EpiResid {
    static constexpr bool PERM = false, AFTER_DRAIN = false;
    float* Z; const float* X; const float* gate; float alpha;
    __device__ __forceinline__ void operator()(const f32x4 (&acc)[2][2][4][2], const Unit& u, int wr, int wc, int fr, int fq) const {
        const int row0 = u.pm * BM + wr * 64 + fr, col0 = u.pn * BM + wc * 32 + 4 * fq;
        const float* gb = gate + (size_t)(u.pm >> 3) * (6 * 2048) + col0;
        f32x4 gv[2][2];
#pragma unroll
        for (int bj = 0; bj < 2; ++bj)
#pragma unroll
            for (int n = 0; n < 2; ++n) gv[bj][n] = *(const f32x4*)(gb + bj * HALF + n * 16) + 1.0f;
#pragma unroll
        for (int ai = 0; ai < 2; ++ai)
#pragma unroll
            for (int m = 0; m < 4; ++m) { const size_t off = (size_t)(row0 + ai * HALF + m * 16) * 2048 + col0;
#pragma unroll
                for (int bj = 0; bj < 2; ++bj)
#pragma unroll
                    for (int n = 0; n < 2; ++n) { const f32x4 xv = *(const f32x4*)(X + off + bj * HALF + n * 16);
                        *(f32x4*)(Z + off + bj * HALF + n * 16) = xv * alpha + gv[bj][n] * acc[ai][bj][m][n]; }
                asm volatile("" ::: "memory"); }
    }
};
template <class Epi, class Sched, bool ALIGN_EPI = false, bool SP2 = false>
__device__ __forceinline__ void gemm_phase(PG8_LAS unsigned char* lds, const Gemm g, const Sched& S, const Epi& E, const int tid_in) {
    const int tid = tid_in, wid = __builtin_amdgcn_readfirstlane(tid >> 6), lane = tid & 63, wr = wid >> 2, wc = wid & 3, fr = lane & 15, fq = lane >> 4;
    const int K = g.K, nt = K / BK;
    unsigned voffA[2], voffB[2];
#pragma unroll
    for (int i = 0; i < 2; ++i) { int R, C; stage_rc(tid * 16 + i * 8192, R, C); const int Rb = Epi::PERM ? ((R & ~31) + perm32(R & 31)) : R;
        voffA[i] = (unsigned)(R * K + C) * 2u; voffB[i] = (unsigned)(Rb * K + C) * 2u; }
    const size_t kstep = (size_t)(BK * 2);
    const size_t hstep = (size_t)HALF * K * 2;
    const size_t tstep = 2 * hstep;
    const unsigned ldsw = (unsigned)wid * 1024u;
    const int aoff = lds_byte(wr * 64 + fr, fq * 8), boff = lds_byte(wc * 32 + fr, fq * 8);
#define PG8_SA(b, h) (((b) * 2 + (h)) * HTB)
#define PG8_SB(b, h) ((4 + (b) * 2 + (h)) * HTB)
#define PG8_STAGE(bufoff, gbase, voff) do { _Pragma("unroll") for (int _i = 0; _i < 2; ++_i) \
        __builtin_amdgcn_global_load_lds((const unsigned*)((const char*)(gbase) + (voff)[_i]), (PG8_LAS unsigned*)(lds + (bufoff) + ldsw + _i * 8192), 16, 0, 0); } while (0)
#define PG8_LDA(dst, b, h) do { _Pragma("unroll") for (int m = 0; m < 4; ++m) _Pragma("unroll") for (int k = 0; k < 2; ++k) dst[m][k] = *(const PG8_LAS bf16x8*)(lds + PG8_SA(b, h) + aoff + m * 2048 + k * 1024); } while (0)
#define PG8_LDB(dst, b, h) do { _Pragma("unroll") for (int n = 0; n < 2; ++n) _Pragma("unroll") for (int k = 0; k < 2; ++k) dst[n][k] = *(const PG8_LAS bf16x8*)(lds + PG8_SB(b, h) + boff + n * 2048 + k * 1024); } while (0)
#define PG8_MMA(ai, bj, At, Bt) do { __builtin_amdgcn_s_setprio(1); _Pragma("unroll") for (int m = 0; m < 4; ++m) _Pragma("unroll") for (int n = 0; n < 2; ++n) _Pragma("unroll") for (int k = 0; k < 2; ++k) \
        acc[ai][bj][m][n] = __builtin_amdgcn_mfma_f32_16x16x32_bf16(Bt[n][k], At[m][k], acc[ai][bj][m][n], 0, 0, 0); __builtin_amdgcn_s_setprio(0); } while (0)
#define PG8_WAIT_V(n) asm volatile("s_waitcnt vmcnt(" #n ")" ::: "memory")
#define PG8_WAIT_L(n) asm volatile("s_waitcnt lgkmcnt(" #n ")" ::: "memory")
#define PG8_BAR __builtin_amdgcn_s_barrier()
#define PG8_SCHED __builtin_amdgcn_sched_barrier(0)
    Unit cur, nxt; int ui = 0;
    if (!S.next(0, cur)) return;
    f32x4 acc[2][2][4][2];
#pragma unroll
    for (int a = 0; a < 2; ++a)
#pragma unroll
        for (int b = 0; b < 2; ++b)
#pragma unroll
            for (int m = 0; m < 4; ++m)
#pragma unroll
                for (int n = 0; n < 2; ++n) acc[a][b][m][n] = (f32x4){0.f, 0.f, 0.f, 0.f};
    bf16x8 At[4][2], B0[2][2], B1[2][2];
    const char* cA = (const char*)g.A + (size_t)cur.pm * tstep; const char* cB = (const char*)g.Bt + (size_t)cur.pn * tstep;
    S.a_ready(cur);
    if constexpr (SP2) {
        PG8_STAGE(PG8_SB(0, 0), cB, voffB); PG8_STAGE(PG8_SB(0, 1), cB + hstep, voffB); PG8_STAGE(PG8_SA(0, 0), cA, voffA); PG8_STAGE(PG8_SA(0, 1), cA + hstep, voffA);
        if (wr == 1) PG8_BAR;
        PG8_WAIT_V(2); PG8_BAR;
        PG8_STAGE(PG8_SB(1, 0), cB + kstep, voffB); PG8_STAGE(PG8_SA(1, 0), cA + kstep, voffA); PG8_STAGE(PG8_SB(1, 1), cB + hstep + kstep, voffB);
        PG8_WAIT_V(6); PG8_BAR;
    } else {
        PG8_STAGE(PG8_SB(0, 0), cB, voffB); PG8_STAGE(PG8_SA(0, 0), cA, voffA); PG8_STAGE(PG8_SB(0, 1), cB + hstep, voffB); PG8_STAGE(PG8_SA(0, 1), cA + hstep, voffA);
        if (wr == 1) PG8_BAR;
        PG8_WAIT_V(4); PG8_BAR;
        PG8_STAGE(PG8_SB(1, 0), cB + kstep, voffB); PG8_STAGE(PG8_SA(1, 0), cA + kstep, voffA); PG8_STAGE(PG8_SB(1, 1), cB + hstep + kstep, voffB);
        PG8_WAIT_V(6); PG8_BAR;
    }
    for (;;) {
        const bool has_next = S.next(ui + 1, nxt);
        const char* nA = has_next ? (const char*)g.A + (size_t)nxt.pm * tstep : cA; const char* nB = has_next ? (const char*)g.Bt + (size_t)nxt.pn * tstep : cB;
        for (int t = 0; t < nt; t += 2) {
            const bool last = (t == nt - 2);
            const char* a1 = cA + (size_t)(t + 1) * kstep;
            const char* a2 = last ? nA : cA + (size_t)(t + 2) * kstep; const char* b2 = last ? nB : cB + (size_t)(t + 2) * kstep;
            const char* a3 = a2 + kstep; const char* b3 = b2 + kstep;
            if (last && has_next) S.a_ready(nxt);
            if constexpr (SP2) {
            PG8_LDB(B0, 0, 0); PG8_LDB(B1, 0, 1); PG8_SCHED; PG8_LDA(At, 0, 0); PG8_STAGE(PG8_SA(1, 1), a1 + hstep, voffA);
            PG8_WAIT_V(8); PG8_WAIT_L(0); PG8_BAR; PG8_MMA(0, 0, At, B0); PG8_MMA(0, 1, At, B1); PG8_BAR; PG8_SCHED;
            PG8_LDA(At, 0, 1); PG8_STAGE(PG8_SB(0, 0), b2, voffB); PG8_STAGE(PG8_SB(0, 1), b2 + hstep, voffB); PG8_STAGE(PG8_SA(0, 0), a2, voffA);
            PG8_WAIT_V(8); PG8_WAIT_L(0); PG8_BAR; PG8_MMA(1, 0, At, B0); PG8_MMA(1, 1, At, B1); PG8_BAR; PG8_SCHED;
            PG8_LDB(B0, 1, 0); PG8_LDB(B1, 1, 1); PG8_SCHED; PG8_LDA(At, 1, 0); PG8_STAGE(PG8_SA(0, 1), a2 + hstep, voffA);
            PG8_WAIT_V(8); PG8_WAIT_L(0); PG8_BAR; PG8_MMA(0, 0, At, B0); PG8_MMA(0, 1, At, B1); PG8_BAR; PG8_SCHED;
            PG8_LDA(At, 1, 1); PG8_STAGE(PG8_SB(1, 0), b3, voffB); PG8_STAGE(PG8_SB(1, 1), b3 + hstep, voffB); PG8_STAGE(PG8_SA(1, 0), a3, voffA);
            PG8_WAIT_V(8); PG8_WAIT_L(0); PG8_BAR; PG8_MMA(1, 0, At, B0); PG8_MMA(1, 1, At, B1); PG8_BAR; PG8_SCHED;
            } else {
            PG8_LDB(B0, 0, 0); PG8_SCHED; PG8_LDA(At, 0, 0); PG8_STAGE(PG8_SA(1, 1), a1 + hstep, voffA);
            PG8_WAIT_L(8); PG8_BAR; PG8_WAIT_L(0); PG8_MMA(0, 0, At, B0); PG8_BAR; PG8_SCHED;
            PG8_LDB(B1, 0, 1); PG8_STAGE(PG8_SB(0, 0), b2, voffB);
            PG8_BAR; PG8_WAIT_L(0); PG8_MMA(0, 1, At, B1); PG8_BAR;
            PG8_LDA(At, 0, 1); PG8_STAGE(PG8_SA(0, 0), a2, voffA);
            PG8_BAR; PG8_WAIT_L(0); PG8_MMA(1, 0, At, B0); PG8_BAR; PG8_SCHED;
            PG8_STAGE(PG8_SB(0, 1), b2 + hstep, voffB);
            PG8_WAIT_V(6); PG8_BAR; PG8_MMA(1, 1, At, B1); PG8_BAR;
            PG8_LDB(B0, 1, 0); PG8_SCHED; PG8_LDA(At, 1, 0); PG8_STAGE(PG8_SA(0, 1), a2 + hstep, voffA);
            PG8_WAIT_L(8); PG8_BAR; PG8_WAIT_L(0); PG8_MMA(0, 0, At, B0); PG8_BAR; PG8_SCHED;
            PG8_LDB(B1, 1, 1); PG8_STAGE(PG8_SB(1, 0), b3, voffB);
            PG8_BAR; PG8_WAIT_L(0); PG8_MMA(0, 1, At, B1); PG8_BAR;
            PG8_LDA(At, 1, 1); PG8_STAGE(PG8_SA(1, 0), a3, voffA);
            PG8_BAR; PG8_WAIT_L(0); PG8_MMA(1, 0, At, B0); PG8_BAR; PG8_SCHED;
            PG8_STAGE(PG8_SB(1, 1), b3 + hstep, voffB);
            PG8_WAIT_V(6); PG8_BAR; PG8_MMA(1, 1, At, B1); PG8_BAR;
            }
        }
        if constexpr (ALIGN_EPI) { if (wr == 0) PG8_BAR; }
        if constexpr (!Epi::AFTER_DRAIN) { E(acc, cur, wr, wc, fr, fq); S.done(cur); }
        if (!has_next) break;
#pragma unroll
        for (int a = 0; a < 2; ++a)
#pragma unroll
            for (int b = 0; b < 2; ++b)
#pragma unroll
                for (int m = 0; m < 4; ++m)
#pragma unroll
                    for (int n = 0; n < 2; ++n) acc[a][b][m][n] = (f32x4){0.f, 0.f, 0.f, 0.f};
        cur = nxt; cA = nA; cB = nB; ++ui;
        if constexpr (ALIGN_EPI) { if (wr == 1) PG8_BAR; }
    }
    PG8_WAIT_V(0);
    if constexpr (!ALIGN_EPI) { if (wr == 0) PG8_BAR; }
    PG8_BAR;
    if constexpr (Epi::AFTER_DRAIN) { E.fused(acc, cur, wr, wc, fr, fq, lds, wid, lane); S.done(cur); }
#undef PG8_SA
#undef PG8_SB
#undef PG8_STAGE
#undef PG8_LDA
#undef PG8_LDB
#undef PG8_MMA
#undef PG8_WAIT_V
#undef PG8_WAIT_L
#undef PG8_BAR
#undef PG8_SCHED
}
}
#define XB_TMO      128
#define XB_XCNT(j)  (256  + 64 * (j))
#define XB_XSUB(j)  (1280 + 64 * (j))
#define XB_XGEN(j)  (2304 + 64 * (j))
#define XB_TOP      3328
#define XB_TOPGEN   3392
#define XCD_BAR_WORDS 3456
#define XB_SPIN_CAP (1u << 18)
#define LAS __attribute__((address_space(3)))

__device__ __forceinline__ unsigned xb_ld(unsigned* p)              { return __hip_atomic_load(p, __ATOMIC_RELAXED, __HIP_MEMORY_SCOPE_AGENT); }
__device__ __forceinline__ unsigned xb_add(unsigned* p, unsigned v) { return __hip_atomic_fetch_add(p, v, __ATOMIC_RELAXED, __HIP_MEMORY_SCOPE_AGENT); }
__device__ __forceinline__ unsigned xb_xcc_id() { return (unsigned)__builtin_amdgcn_s_getreg((3 << 11) | 20) & 0xFu; }
#define XB_SPIN(cond, bar) do { unsigned _sp = 0; while (cond) { __builtin_amdgcn_s_sleep(1); \
    if ((++_sp & 255u) == 0u) { if (xb_ld(&(bar)[XB_TMO])) break; if (_sp > XB_SPIN_CAP) { atomicAdd(&(bar)[XB_TMO], 1u); break; } } } } while (0)

struct XcdBarrier {
    unsigned* bar; unsigned x;
    volatile LAS unsigned* st;
};

__device__ __forceinline__ XcdBarrier xcd_barrier_post(unsigned* bar, volatile LAS unsigned* st) {
    XcdBarrier b; b.bar = bar; b.x = xb_xcc_id(); b.st = st;
    if (threadIdx.x == 0) (void)xb_add(&bar[XB_XCNT(b.x)], 1u);
    return b;
}
__device__ __forceinline__ void xcd_barrier_complete(unsigned* bar, unsigned x, unsigned& nloc, unsigned& nx) {
    const unsigned G = gridDim.x * gridDim.y * gridDim.z;
    unsigned sum, cnt, mine, sp = 0u;
    for (;;) {
        sum = 0u; cnt = 0u; mine = 0u;
#pragma unroll
        for (unsigned j = 0; j < 16; ++j) { const unsigned c = xb_ld(&bar[XB_XCNT(j)]); sum += c; cnt += (c > 0u) ? 1u : 0u; mine = (j == x) ? c : mine; }
        if (sum == G) break;
        __builtin_amdgcn_s_sleep(1);
        if ((++sp & 255u) == 0u) { if (xb_ld(&bar[XB_TMO])) break; if (sp > XB_SPIN_CAP) { atomicAdd(&bar[XB_TMO], 1u); break; } }
    }
    nloc = mine > 0u ? mine : 1u; nx = cnt > 0u ? cnt : 1u;
}

__device__ __forceinline__ void xcd_barrier(const XcdBarrier& b) {
    asm volatile("s_waitcnt vmcnt(0)" ::: "memory");
    __syncthreads();
    if (threadIdx.x == 0) {
        unsigned* bar = b.bar;
        __builtin_amdgcn_s_waitcnt(0);
        unsigned nloc = b.st[0], nx = b.st[1];
        if (nloc == 0u) { xcd_barrier_complete(bar, b.x, nloc, nx); b.st[0] = nloc; b.st[1] = nx; }
        const unsigned old = xb_add(&bar[XB_XSUB(b.x)], 1u);
        const unsigned gen = old / nloc;
        if (old + 1u == (gen + 1u) * nloc) {
            __builtin_amdgcn_fence(__ATOMIC_RELEASE, "agent");
            asm volatile("s_waitcnt vmcnt(0)" ::: "memory");
            const unsigned og = xb_add(&bar[XB_TOP], 1u);
            const unsigned tg = og / nx;
            if (og + 1u == (tg + 1u) * nx) xb_add(&bar[XB_TOPGEN], 1u);
            else XB_SPIN(xb_ld(&bar[XB_TOPGEN]) == tg, bar);
            __builtin_amdgcn_fence(__ATOMIC_ACQUIRE, "agent");
            xb_add(&bar[XB_XGEN(b.x)], 1u);
            asm volatile("s_waitcnt vmcnt(0)" ::: "memory");
        } else {
            XB_SPIN(xb_ld(&bar[XB_XGEN(b.x)]) == gen, bar);
            __builtin_amdgcn_fence(__ATOMIC_ACQUIRE, "agent");
            asm volatile("s_waitcnt vmcnt(0)" ::: "memory");
        }
    }
    __syncthreads();
}
constexpr int D = 2048, NB = 8, SEQ = 2048, NL = 4, T = NB * SEQ;
constexpr int NCH = SEQ / 64, NCHUNK = T / 64;
constexpr int GKW = 512, RANK = 16;
constexpr int INW = 6160, NP = 6144;
constexpr int NE = 16384;
constexpr float ALPHA = 1.6817928305074290f, EPS = 1e-5f;
constexpr int PQ = 0, PK = 512, PV = 1024, PR = 2048, PCB = 3072, PCC = 4096, PCH = 5120;
constexpr int NWAVES = 8, NTHREADS = 512;
constexpr int NPHASES = 2 + 7 * NL;

constexpr size_t MiB = 1u << 20;
constexpr size_t WS_CTL = 0, CTL_ZERO_BYTES = 1 * MiB;
constexpr size_t WS_MOD = 1 * MiB, WS_PART = 3 * MiB, WS_KEYS = 15 * MiB, WS_DTOT = 17 * MiB, WS_WIN = 18 * MiB, WS_WOUT = 115 * MiB, WS_WQ = 147 * MiB;
constexpr size_t WS_UT = 179 * MiB, WS_VT = 435 * MiB, WS_H = 691 * MiB, WS_PROJ = 755 * MiB, WS_E = 947 * MiB, WS_OGLA = 979 * MiB, WS_Y = 1043 * MiB;
constexpr size_t WS_Z = 1107 * MiB, WS_X1 = 1235 * MiB, WS_X = 1363 * MiB, WS_Q = 1491 * MiB, WS_H2 = 1555 * MiB, WS_HQ8 = 1619 * MiB, WS_END = 1651 * MiB;
constexpr size_t WS_SU = 17 * MiB + 512 * 1024, WS_SV = 17 * MiB + 768 * 1024, WS_HSC = 2 * MiB + 640 * 1024;
static_assert(WS_WIN + (size_t)NL * INW * D * 2 <= WS_WOUT && WS_PART + (size_t)NL * 8 * NB * 6 * D * 4 <= WS_KEYS && WS_MOD + (size_t)NL * NB * 6 * D * 4 <= WS_PART, "ws map");
constexpr int CW_BAR = 4096;

constexpr int RING_OFF = 0, RING_BYTES = 131072, LDSCTL_OFF = RING_BYTES, LDS_BYTES = 147456;

#define GAS __attribute__((address_space(1)))
typedef unsigned short bf16;
typedef unsigned v4u __attribute__((ext_vector_type(4)));
typedef unsigned v2u __attribute__((ext_vector_type(2)));
typedef float f32x4 __attribute__((ext_vector_type(4)));
typedef float f32x16 __attribute__((ext_vector_type(16)));
typedef short bf16x8 __attribute__((ext_vector_type(8)));
typedef __bf16 bf16x2v __attribute__((ext_vector_type(2)));
#define LDS_WAIT() asm volatile("s_waitcnt lgkmcnt(0)" ::: "memory")

__device__ __forceinline__ unsigned pk2(float lo, float hi) { return pg8::cvt_pk_bf16(lo, hi); }
__device__ __forceinline__ float dot2bf(unsigned w, unsigned x, float acc) { return __builtin_amdgcn_fdot2_f32_bf16(__builtin_bit_cast(bf16x2v, w), __builtin_bit_cast(bf16x2v, x), acc, false); }
__device__ __forceinline__ float bflo(unsigned u) { return __uint_as_float(u << 16); }
__device__ __forceinline__ float bfhi(unsigned u) { return __uint_as_float(u & 0xffff0000u); }
__device__ __forceinline__ float silu_f(float x) { return x / (1.0f + __expf(-x)); }
__device__ __forceinline__ float logsigmoid_f(float x) { return fminf(x, 0.0f) - log1pf(__expf(-fabsf(x))); }
__device__ __forceinline__ float gelu_tanh_f(float x) { const float u = 0.7978845608028654f * (x + 0.044715f * x * x * x); return 0.5f * x * (1.0f + tanhf(u)); }
__device__ __forceinline__ float wave_sum(float v) {
#pragma unroll
    for (int o = 1; o < 64; o <<= 1) v += __shfl_xor(v, o);
    return v;
}

struct Args { const float* in[19]; float* out; unsigned char* ws; int ph_lo, ph_hi; };

__device__ __forceinline__ void transpose_item(const float* W, int ldw, int col0, bf16* WTrows, int k0, int nvalid, LAS float* scr, int lane) {
    const int n = lane & 31;
#pragma unroll 8
    for (int i = 0; i < 32; ++i) { const int kk = 2 * i + (lane >> 5); scr[kk * 33 + n] = (n < nvalid) ? W[(size_t)(k0 + kk) * ldw + col0 + n] : 0.f; }
    LDS_WAIT(); asm volatile("" ::: "memory");
    const int c = lane & 7;
#pragma unroll
    for (int j = 0; j < 4; ++j) { const int nn = (lane >> 3) + 8 * j; const LAS float* s = scr + (8 * c) * 33 + nn;
        v4u o; o.x = pk2(s[0 * 33], s[1 * 33]); o.y = pk2(s[2 * 33], s[3 * 33]); o.z = pk2(s[4 * 33], s[5 * 33]); o.w = pk2(s[6 * 33], s[7 * 33]);
        if (nn < nvalid) *(v4u*)(WTrows + (size_t)nn * D + k0 + 8 * c) = o; }
    LDS_WAIT(); asm volatile("" ::: "memory");
}
__device__ __forceinline__ void cvt_stream(const float* src, bf16* dst, size_t n4, size_t i0, size_t stride) {
    for (size_t i = i0; i < n4; i += stride) { const f32x4 v = ((const f32x4*)src)[i]; v2u o; o.x = pk2(v.x, v.y); o.y = pk2(v.z, v.w); ((v2u*)dst)[i] = o; }
}
__device__ __forceinline__ void ph_prologue_a(const Args& a, LAS unsigned char* lds, int tid, int lane, int wave, int bx, int G) {
    const int gw = bx * NWAVES + wave, NGW = G * NWAVES;
    LAS float* cact = (LAS float*)lds;
    for (int i = tid; i < NB * D; i += NTHREADS) { const int b = i / D, d = i % D; cact[d * 8 + b] = silu_f(a.in[1][i]); }
    __syncthreads();
    float* part = (float*)(a.ws + WS_PART);
    for (int it = gw; it < NL * 8 * 48; it += NGW) {
        const int cg = it % 48, dr = (it / 48) % 8, l = it / 384;
        f32x4 acc[8];
#pragma unroll
        for (int b = 0; b < 8; ++b) acc[b] = (f32x4){0.f, 0.f, 0.f, 0.f};
        const float* w = a.in[2] + ((size_t)l * D + dr * 256) * (6 * D) + cg * 256 + lane * 4;
#pragma unroll 4
        for (int d = 0; d < 256; ++d) {
            const f32x4 wv = *(const f32x4*)(w + (size_t)d * (6 * D));
            const f32x4 c0 = *(const LAS f32x4*)(cact + (dr * 256 + d) * 8), c1 = *(const LAS f32x4*)(cact + (dr * 256 + d) * 8 + 4);
            acc[0] += wv * c0.x; acc[1] += wv * c0.y; acc[2] += wv * c0.z; acc[3] += wv * c0.w;
            acc[4] += wv * c1.x; acc[5] += wv * c1.y; acc[6] += wv * c1.z; acc[7] += wv * c1.w;
        }
#pragma unroll
        for (int b = 0; b < 8; ++b) *(f32x4*)(part + (((size_t)l * 8 + dr) * NB + b) * (6 * D) + cg * 256 + lane * 4) = acc[b];
    }
    __syncthreads();
    LAS float* scr = (LAS float*)(lds + wave * 8448);
    bf16* winT = (bf16*)(a.ws + WS_WIN); bf16* woutT = (bf16*)(a.ws + WS_WOUT); bf16* wqT = (bf16*)(a.ws + WS_WQ);
    constexpr int IPL = 6144 + 32 + 2048 + 2048;
    for (int it = gw; it < NL * IPL; it += NGW) {
        const int l = it / IPL; int r = it % IPL;
        if (r < 6144) { const int nb = r % 192, kb = r / 192, n0 = nb * 32;
            transpose_item(a.in[4] + (size_t)l * D * INW, INW, n0 < 3072 ? n0 : n0 + 16, winT + ((size_t)l * INW + n0) * D, kb * 64, 32, scr, lane); continue; }
        r -= 6144;
        if (r < 32) { transpose_item(a.in[4] + (size_t)l * D * INW, INW, 3072, winT + ((size_t)l * INW + NP) * D, r * 64, 16, scr, lane); continue; }
        r -= 32;
        if (r < 2048) { const int nb = r % 64, kb = r / 64; transpose_item(a.in[10] + (size_t)l * D * D, D, nb * 32, woutT + ((size_t)l * D + nb * 32) * D, kb * 64, 32, scr, lane); continue; }
        r -= 2048;
        { const int nb = r % 64, kb = r / 64; transpose_item(a.in[13] + (size_t)l * D * D, D, nb * 32, wqT + ((size_t)l * D + nb * 32) * D, kb * 64, 32, scr, lane); }
    }
    const size_t i0 = (size_t)bx * NTHREADS + tid, stride = (size_t)G * NTHREADS;
    cvt_stream(a.in[14], (bf16*)(a.ws + WS_KEYS), (size_t)NL * 8 * 2 * 128 * 128 / 4, i0, stride);
    for (int row = gw; row < 2 * NL * NE; row += NGW) {
        const int tbl = row / (NL * NE), r = row % (NL * NE);
        const float* src = (tbl ? a.in[16] : a.in[15]) + (size_t)r * D;
        f32x4 v[8]; float mx = 0.f;
#pragma unroll
        for (int c8 = 0; c8 < 8; ++c8) { v[c8] = *(const f32x4*)(src + (c8 * 64 + lane) * 4); mx = fmaxf(mx, fmaxf(fmaxf(fabsf(v[c8].x), fabsf(v[c8].y)), fmaxf(fabsf(v[c8].z), fabsf(v[c8].w)))); }
#pragma unroll
        for (int o = 1; o < 64; o <<= 1) mx = fmaxf(mx, __shfl_xor(mx, o));
        const float inv = mx > 0.f ? 127.0f / mx : 0.f; const int off = tbl ? 128 : 0;
        unsigned dw[8];
#pragma unroll
        for (int c8 = 0; c8 < 8; ++c8) { const int q0 = (int)__builtin_rintf(v[c8].x * inv) + off, q1 = (int)__builtin_rintf(v[c8].y * inv) + off, q2 = (int)__builtin_rintf(v[c8].z * inv) + off, q3 = (int)__builtin_rintf(v[c8].w * inv) + off;
            dw[c8] = (unsigned)(q0 & 255) | ((unsigned)(q1 & 255) << 8) | ((unsigned)(q2 & 255) << 16) | ((unsigned)(q3 & 255) << 24); }
        unsigned char* dst = a.ws + (tbl ? WS_VT : WS_UT) + (size_t)r * D;
        *(v4u*)(dst + lane * 16) = (v4u){dw[0], dw[1], dw[2], dw[3]}; *(v4u*)(dst + (64 + lane) * 16) = (v4u){dw[4], dw[5], dw[6], dw[7]};
        if (lane == 0) ((float*)(a.ws + (tbl ? WS_SV : WS_SU)))[r] = mx * (1.0f / 127.0f);
    }
}

__device__ __forceinline__ void ln_tail(const float (&z)[32], int t, int lane, const float* g, const float* bta, float* xout, const float* sh, const float* sc, bf16* hout, unsigned char* q8, float* q8s) {
    float s = 0.f;
#pragma unroll
    for (int i = 0; i < 32; ++i) s += z[i];
    const float mu = wave_sum(s) * (1.0f / D);
    float q = 0.f;
#pragma unroll
    for (int i = 0; i < 32; ++i) { const float d = z[i] - mu; q += d * d; }
    const float rs = rsqrtf(wave_sum(q) * (1.0f / D) + EPS);
    float hv[32]; float mx = 0.f;
#pragma unroll
    for (int c = 0; c < 8; ++c) { const int col = (c * 64 + lane) * 4;
        const f32x4 g0 = *(const f32x4*)(g + col), b0 = *(const f32x4*)(bta + col);
        f32x4 x0;
        x0.x = (z[c * 4 + 0] - mu) * rs * g0.x + b0.x; x0.y = (z[c * 4 + 1] - mu) * rs * g0.y + b0.y; x0.z = (z[c * 4 + 2] - mu) * rs * g0.z + b0.z; x0.w = (z[c * 4 + 3] - mu) * rs * g0.w + b0.w;
        if (xout) *(f32x4*)(xout + (size_t)t * D + col) = x0;
        if (hout) { const f32x4 s0 = *(const f32x4*)(sc + col), h0 = *(const f32x4*)(sh + col);
            hv[c * 4] = x0.x * (1.f + s0.x) + h0.x; hv[c * 4 + 1] = x0.y * (1.f + s0.y) + h0.y; hv[c * 4 + 2] = x0.z * (1.f + s0.z) + h0.z; hv[c * 4 + 3] = x0.w * (1.f + s0.w) + h0.w;
            v2u o; o.x = pk2(hv[c * 4], hv[c * 4 + 1]); o.y = pk2(hv[c * 4 + 2], hv[c * 4 + 3]);
            *(v2u*)(hout + (size_t)t * D + col) = o;
            if (q8) {
                hv[c * 4] = bflo(o.x); hv[c * 4 + 1] = bfhi(o.x); hv[c * 4 + 2] = bflo(o.y); hv[c * 4 + 3] = bfhi(o.y);
                mx = fmaxf(mx, fmaxf(fmaxf(fabsf(hv[c * 4]), fabsf(hv[c * 4 + 1])), fmaxf(fabsf(hv[c * 4 + 2]), fabsf(hv[c * 4 + 3])))); } }
    }
    if (q8) {
#pragma unroll
        for (int o = 1; o < 64; o <<= 1) mx = fmaxf(mx, __shfl_xor(mx, o));
        const float inv = mx > 0.f ? 127.0f / mx : 0.f;
        unsigned dw[8];
#pragma unroll
        for (int c = 0; c < 8; ++c) { const int q0 = (int)__builtin_rintf(hv[c * 4] * inv), q1 = (int)__builtin_rintf(hv[c * 4 + 1] * inv), q2 = (int)__builtin_rintf(hv[c * 4 + 2] * inv), q3 = (int)__builtin_rintf(hv[c * 4 + 3] * inv);
            dw[c] = (unsigned)(q0 & 255) | ((unsigned)(q1 & 255) << 8) | ((unsigned)(q2 & 255) << 16) | ((unsigned)(q3 & 255) << 24); }
        unsigned char* dst = q8 + (size_t)t * D;
        *(v4u*)(dst + lane * 16) = (v4u){dw[0], dw[1], dw[2], dw[3]}; *(v4u*)(dst + (64 + lane) * 16) = (v4u){dw[4], dw[5], dw[6], dw[7]};
        if (lane == 0) q8s[t] = mx * (1.0f / 127.0f);
    }
}

__device__ __forceinline__ void ph_prologue_b(const Args& a, LAS unsigned char* lds, int tid, int lane, int wave, int bx, int G) {
    const float* part = (const float*)(a.ws + WS_PART); float* mod = (float*)(a.ws + WS_MOD);
    for (int i = bx * NTHREADS + tid; i < NL * NB * 6 * D / 4; i += G * NTHREADS) {
        const int idx = i * 4, e = idx % (6 * D), b = (idx / (6 * D)) % NB, l = idx / (6 * D * NB);
        f32x4 s = *(const f32x4*)(a.in[3] + l * 6 * D + e);
#pragma unroll
        for (int dr = 0; dr < 8; ++dr) s += *(const f32x4*)(part + (((size_t)l * 8 + dr) * NB + b) * (6 * D) + e);
        *(f32x4*)(mod + idx) = s;
    }
    LAS float* msh = (LAS float*)lds;
    bf16* hbuf = (bf16*)(a.ws + WS_H);
    for (int ch = bx; ch < NCHUNK; ch += G) {
        const int b = ch / NCH;
        for (int i = tid; i < 1024; i += NTHREADS) { const int e = i * 4;
            f32x4 s = *(const f32x4*)(a.in[3] + e);
#pragma unroll
            for (int dr = 0; dr < 8; ++dr) s += *(const f32x4*)(part + (((size_t)0 * 8 + dr) * NB + b) * (6 * D) + e);
            *(LAS f32x4*)(msh + e) = s; }
        __syncthreads();
        for (int i = 0; i < 8; ++i) { const int t = ch * 64 + wave * 8 + i;
#pragma unroll
            for (int c = 0; c < 4; ++c) { const int col = (c * 64 + lane) * 8;
                const f32x4 x0 = *(const f32x4*)(a.in[0] + (size_t)t * D + col), x1 = *(const f32x4*)(a.in[0] + (size_t)t * D + col + 4);
                const f32x4 h0 = *(const LAS f32x4*)(msh + col), h1 = *(const LAS f32x4*)(msh + col + 4), s0 = *(const LAS f32x4*)(msh + 2048 + col), s1 = *(const LAS f32x4*)(msh + 2048 + col + 4);
                v4u o; o.x = pk2(x0.x * (1.f + s0.x) + h0.x, x0.y * (1.f + s0.y) + h0.y); o.y = pk2(x0.z * (1.f + s0.z) + h0.z, x0.w * (1.f + s0.w) + h0.w);
                o.z = pk2(x1.x * (1.f + s1.x) + h1.x, x1.y * (1.f + s1.y) + h1.y); o.w = pk2(x1.z * (1.f + s1.z) + h1.z, x1.w * (1.f + s1.w) + h1.w);
                *(v4u*)(hbuf + (size_t)t * D + col) = o; } }
        __syncthreads();
    }
}

__device__ __forceinline__ void gate_prep(const Args& a, int l, LAS unsigned char* lds, int tid, int lane, int wave, int ch) {
    const bf16* hbuf = (const bf16*)(a.ws + WS_H); const bf16* waT = (const bf16*)(a.ws + WS_WIN) + ((size_t)l * INW + NP) * D;
    float* Ebuf = (float*)(a.ws + WS_E); float* dtot = (float*)(a.ws + WS_DTOT);
    const int t0 = ch * 64, l15 = lane & 15, lq = lane >> 4, mt = wave & 3, kh = wave >> 2;
    f32x4 acc = (f32x4){0.f, 0.f, 0.f, 0.f};
    const bf16* hA = hbuf + (size_t)(t0 + 16 * mt + l15) * D + kh * 1024 + 8 * lq;
    const bf16* wB = waT + (size_t)l15 * D + kh * 1024 + 8 * lq;
#pragma unroll 8
    for (int ks = 0; ks < 32; ++ks) { const bf16x8 av = *(const bf16x8*)(hA + 32 * ks), bv = *(const bf16x8*)(wB + 32 * ks); acc = __builtin_amdgcn_mfma_f32_16x16x32_bf16(av, bv, acc, 0, 0, 0); }
    LAS float* alr = (LAS float*)lds;
#pragma unroll
    for (int r = 0; r < 4; ++r) alr[(kh * 64 + 16 * mt + 4 * lq + r) * 16 + l15] = acc[r];
    __syncthreads();
    const int col = tid;
    float wg[16];
#pragma unroll
    for (int r = 0; r < 16; ++r) wg[r] = a.in[5][((size_t)l * RANK + r) * GKW + col];
    const float bgc = a.in[6][l * GKW + col];
    float tot = 0.f;
    for (int j = 0; j < 64; ++j) { float lg = bgc;
#pragma unroll
        for (int r4 = 0; r4 < 4; ++r4) { const f32x4 p = *(const LAS f32x4*)(alr + j * 16 + r4 * 4), q = *(const LAS f32x4*)(alr + (64 + j) * 16 + r4 * 4);
            lg += (p.x + q.x) * wg[r4 * 4] + (p.y + q.y) * wg[r4 * 4 + 1] + (p.z + q.z) * wg[r4 * 4 + 2] + (p.w + q.w) * wg[r4 * 4 + 3]; }
        tot += logsigmoid_f(lg) * (1.0f / 16.0f); }
    float run = 0.f;
    for (int j = 0; j < 64; ++j) { float lg = bgc;
#pragma unroll
        for (int r4 = 0; r4 < 4; ++r4) { const f32x4 p = *(const LAS f32x4*)(alr + j * 16 + r4 * 4), q = *(const LAS f32x4*)(alr + (64 + j) * 16 + r4 * 4);
            lg += (p.x + q.x) * wg[r4 * 4] + (p.y + q.y) * wg[r4 * 4 + 1] + (p.z + q.z) * wg[r4 * 4 + 2] + (p.w + q.w) * wg[r4 * 4 + 3]; }
        run += logsigmoid_f(lg) * (1.0f / 16.0f);
        Ebuf[(size_t)(t0 + j) * GKW + col] = __expf(tot - run); }
    dtot[(size_t)ch * GKW + col] = __expf(tot);
    __syncthreads();
}

__device__ __forceinline__ void gla_unit(const Args& a, LAS unsigned char* lds, int tid, int lane, int wave, int un) {
    const bf16* proj = (const bf16*)(a.ws + WS_PROJ); const float* Ebuf = (const float*)(a.ws + WS_E); const float* dtot = (const float*)(a.ws + WS_DTOT); float* ogla = (float*)(a.ws + WS_OGLA);
    const int dvs = un & 7, hh = (un >> 3) & 3, b = un >> 5;
    LAS bf16* kdT = (LAS bf16*)lds;
    LAS bf16* vT = (LAS bf16*)(lds + 18432);
    LAS bf16* ST = (LAS bf16*)(lds + 18432 + 4608);
    const int l15 = lane & 15, lq = lane >> 4, jl = tid >> 3, d16 = (tid & 7) * 16, dv4 = (tid & 7) * 4, jt = (wave & 3) * 16, dvt = (wave >> 2) * 16;
    f32x4 S0 = (f32x4){0.f, 0.f, 0.f, 0.f}, S1 = (f32x4){0.f, 0.f, 0.f, 0.f};
    v4u kn[2]; f32x4 en[4]; v2u vn; bf16x8 qn[4], qc[4]; f32x4 dn, dc;
#define GLA_LOAD(c) do { const int t0c = b * SEQ + (c) * 64; const bf16* pr = proj + (size_t)(t0c + jl) * NP; \
        kn[0] = *(const v4u*)(pr + PK + hh * 128 + d16); kn[1] = *(const v4u*)(pr + PK + hh * 128 + d16 + 8); \
        _Pragma("unroll") for (int i_ = 0; i_ < 4; ++i_) en[i_] = *(const f32x4*)(Ebuf + (size_t)(t0c + jl) * GKW + hh * 128 + d16 + 4 * i_); \
        vn = *(const v2u*)(pr + PV + hh * 256 + dvs * 32 + dv4); \
        _Pragma("unroll") for (int ks_ = 0; ks_ < 4; ++ks_) qn[ks_] = *(const bf16x8*)(proj + (size_t)(t0c + jt + l15) * NP + PQ + hh * 128 + 32 * ks_ + 8 * lq); \
        dn = *(const f32x4*)(dtot + (size_t)(b * NCH + (c)) * GKW + hh * 128 + 16 * wave + 4 * lq); } while (0)
#define GLA_PREP() do { \
        _Pragma("unroll") for (int i_ = 0; i_ < 16; ++i_) { const unsigned w_ = kn[i_ >> 3][(i_ & 7) >> 1]; const float kf_ = (i_ & 1) ? bfhi(w_) : bflo(w_); \
            kdT[(d16 + i_) * 72 + jl] = (bf16)(pk2(kf_ * en[i_ >> 2][i_ & 3], 0.f) & 0xffffu); } \
        _Pragma("unroll") for (int i_ = 0; i_ < 4; ++i_) { const unsigned w_ = vn[i_ >> 1]; vT[(dv4 + i_) * 72 + jl] = (bf16)((i_ & 1) ? (w_ >> 16) : (w_ & 0xffffu)); } \
        _Pragma("unroll") for (int ks_ = 0; ks_ < 4; ++ks_) qc[ks_] = qn[ks_]; \
        dc = dn; } while (0)
    GLA_LOAD(0); GLA_PREP();
    __syncthreads();
    for (int c = 0; c < NCH; ++c) {
        if (c + 1 < NCH) GLA_LOAD(c + 1);
        S0 = S0 * dc; S1 = S1 * dc;
#pragma unroll
        for (int ks = 0; ks < 2; ++ks) {
            const bf16x8 A = *(const LAS bf16x8*)(kdT + (16 * wave + l15) * 72 + 32 * ks + 8 * lq);
            const bf16x8 B0 = *(const LAS bf16x8*)(vT + l15 * 72 + 32 * ks + 8 * lq), B1 = *(const LAS bf16x8*)(vT + (16 + l15) * 72 + 32 * ks + 8 * lq);
            S0 = __builtin_amdgcn_mfma_f32_16x16x32_bf16(A, B0, S0, 0, 0, 0); S1 = __builtin_amdgcn_mfma_f32_16x16x32_bf16(A, B1, S1, 0, 0, 0); }
        { v2u w0, w1; w0.x = pk2(S0.x, S0.y); w0.y = pk2(S0.z, S0.w); w1.x = pk2(S1.x, S1.y); w1.y = pk2(S1.z, S1.w);
          *(LAS v2u*)(ST + l15 * 136 + 16 * wave + 4 * lq) = w0; *(LAS v2u*)(ST + (16 + l15) * 136 + 16 * wave + 4 * lq) = w1; }
        __syncthreads();
        f32x4 O = (f32x4){0.f, 0.f, 0.f, 0.f};
#pragma unroll
        for (int ks = 0; ks < 4; ++ks) { const bf16x8 A = *(const LAS bf16x8*)(ST + (dvt + l15) * 136 + 32 * ks + 8 * lq); O = __builtin_amdgcn_mfma_f32_16x16x32_bf16(A, qc[ks], O, 0, 0, 0); }
        *(f32x4*)(ogla + (size_t)(b * SEQ + c * 64 + jt + l15) * 1024 + hh * 256 + dvs * 32 + dvt + 4 * lq) = O * 0.08838834764831845f;
        if (c + 1 < NCH) GLA_PREP();
        __syncthreads();
    }
#undef GLA_LOAD
#undef GLA_PREP
}

__device__ __forceinline__ void unpack16(const v4u& p0, const v4u& p1, float (&o)[16]) {
#pragma unroll
    for (int j = 0; j < 4; ++j) { o[2 * j] = bflo(p0[j]); o[2 * j + 1] = bfhi(p0[j]); o[8 + 2 * j] = bflo(p1[j]); o[8 + 2 * j + 1] = bfhi(p1[j]); }
}
__device__ __forceinline__ void mixpost_chunk(const Args& a, int l, int lane, int wave, int ch) {
    const bf16* proj = (const bf16*)(a.ws + WS_PROJ); const float* ogla = (const float*)(a.ws + WS_OGLA); bf16* ybuf = (bf16*)(a.ws + WS_Y);
    const int c0 = 16 * lane, tfirst = ch * 64 + wave * 8, sfirst = tfirst % SEQ;
    float gn[16], cw0[16], cw1[16], cw2[16], cn[16], u1[16], u2[16];
#pragma unroll
    for (int i = 0; i < 16; ++i) { gn[i] = a.in[7][l * 256 + ((c0 + i) & 255)]; cw0[i] = a.in[8][(size_t)l * 3072 + c0 + i]; cw1[i] = a.in[8][(size_t)l * 3072 + 1024 + c0 + i];
        cw2[i] = a.in[8][(size_t)l * 3072 + 2048 + c0 + i]; cn[i] = a.in[9][l * 1024 + c0 + i]; u1[i] = 0.f; u2[i] = 0.f; }
    if (sfirst >= 2) {
        float cc[16], chh[16];
        { const bf16* pr = proj + (size_t)(tfirst - 2) * NP; unpack16(*(const v4u*)(pr + PCC + c0), *(const v4u*)(pr + PCC + c0 + 8), cc); unpack16(*(const v4u*)(pr + PCH + c0), *(const v4u*)(pr + PCH + c0 + 8), chh); }
#pragma unroll
        for (int i = 0; i < 16; ++i) u2[i] = cc[i] * chh[i];
        { const bf16* pr = proj + (size_t)(tfirst - 1) * NP; unpack16(*(const v4u*)(pr + PCC + c0), *(const v4u*)(pr + PCC + c0 + 8), cc); unpack16(*(const v4u*)(pr + PCH + c0), *(const v4u*)(pr + PCH + c0 + 8), chh); }
#pragma unroll
        for (int i = 0; i < 16; ++i) u1[i] = cc[i] * chh[i];
    }
    for (int it = 0; it < 8; ++it) { const int t = tfirst + it; const bf16* pr = proj + (size_t)t * NP;
        float o[16], r[16], cb[16], cc[16], chh[16];
#pragma unroll
        for (int j = 0; j < 4; ++j) { const f32x4 v = *(const f32x4*)(ogla + (size_t)t * 1024 + c0 + 4 * j); o[4 * j] = v.x; o[4 * j + 1] = v.y; o[4 * j + 2] = v.z; o[4 * j + 3] = v.w; }
        unpack16(*(const v4u*)(pr + PR + c0), *(const v4u*)(pr + PR + c0 + 8), r);
        unpack16(*(const v4u*)(pr + PCB + c0), *(const v4u*)(pr + PCB + c0 + 8), cb);
        unpack16(*(const v4u*)(pr + PCC + c0), *(const v4u*)(pr + PCC + c0 + 8), cc);
        unpack16(*(const v4u*)(pr + PCH + c0), *(const v4u*)(pr + PCH + c0 + 8), chh);
        float ss = 0.f;
#pragma unroll
        for (int i = 0; i < 16; ++i) ss += o[i] * o[i];
        ss += __shfl_xor(ss, 1); ss += __shfl_xor(ss, 2); ss += __shfl_xor(ss, 4); ss += __shfl_xor(ss, 8);
        const float rg = rsqrtf(ss * (1.0f / 256.f) + EPS);
        float val[16]; float s2 = 0.f;
#pragma unroll
        for (int i = 0; i < 16; ++i) { const float u0 = cc[i] * chh[i]; val[i] = cb[i] * (cw0[i] * u2[i] + cw1[i] * u1[i] + cw2[i] * u0); s2 += val[i] * val[i]; u2[i] = u1[i]; u1[i] = u0; }
        const float rc = rsqrtf(wave_sum(s2) * (1.0f / 1024.f) + EPS);
        v4u y0, y1, y2, y3;
#pragma unroll
        for (int j = 0; j < 4; ++j) {
            y0[j] = pk2(o[2 * j] * rg * gn[2 * j] * silu_f(r[2 * j]), o[2 * j + 1] * rg * gn[2 * j + 1] * silu_f(r[2 * j + 1]));
            y1[j] = pk2(o[8 + 2 * j] * rg * gn[8 + 2 * j] * silu_f(r[8 + 2 * j]), o[9 + 2 * j] * rg * gn[9 + 2 * j] * silu_f(r[9 + 2 * j]));
            y2[j] = pk2(val[2 * j] * rc * cn[2 * j], val[2 * j + 1] * rc * cn[2 * j + 1]);
            y3[j] = pk2(val[8 + 2 * j] * rc * cn[8 + 2 * j], val[9 + 2 * j] * rc * cn[9 + 2 * j]); }
        bf16* yr = ybuf + (size_t)t * D;
        *(v4u*)(yr + c0) = y0; *(v4u*)(yr + c0 + 8) = y1; *(v4u*)(yr + 1024 + c0) = y2; *(v4u*)(yr + 1024 + c0 + 8) = y3;
    }
}

__device__ __forceinline__ void ln1_chunk(const Args& a, int l, int lane, int wave, int ch) {
    const float* zbuf = (const float*)(a.ws + WS_Z); const float* mod = (const float*)(a.ws + WS_MOD);
    const int b = ch / NCH; const float* mb = mod + ((size_t)l * NB + b) * 6 * D;
    for (int it = 0; it < 8; ++it) { const int t = ch * 64 + wave * 8 + it;
        float z[32];
#pragma unroll
        for (int c = 0; c < 8; ++c) { const f32x4 v0 = *(const f32x4*)(zbuf + (size_t)t * D + (c * 64 + lane) * 4); z[c * 4] = v0.x; z[c * 4 + 1] = v0.y; z[c * 4 + 2] = v0.z; z[c * 4 + 3] = v0.w; }
        ln_tail(z, t, lane, a.in[11] + (size_t)l * D, a.in[12] + (size_t)l * D, (float*)(a.ws + WS_X1), mb + 3 * D, mb + 4 * D, (bf16*)(a.ws + WS_H2), a.ws + WS_HQ8, (float*)(a.ws + WS_HSC));
    }
}

template <int N> __device__ __forceinline__ void bitonic_sort_desc(float (&v)[N]) {
#pragma unroll
    for (int k = 2; k <= N; k <<= 1)
#pragma unroll
        for (int j = k >> 1; j > 0; j >>= 1)
#pragma unroll
            for (int i = 0; i < N; ++i) { const int p = i ^ j; if (p > i) { const bool desc = ((i & k) == 0); const float x = v[i], y = v[p]; const float mx = fmaxf(x, y), mn = fminf(x, y); v[i] = desc ? mx : mn; v[p] = desc ? mn : mx; } }
}
__device__ __forceinline__ void merge_top16(float (&x)[16], const float (&y)[16]) {
#pragma unroll
    for (int i = 0; i < 16; ++i) x[i] = fmaxf(x[i], y[15 - i]);
#pragma unroll
    for (int j = 8; j > 0; j >>= 1)
#pragma unroll
        for (int i = 0; i < 16; ++i) { const int p = i ^ j; if (p > i) { const float u = x[i], w = x[p]; x[i] = fmaxf(u, w); x[p] = fminf(u, w); } }
}
__device__ __forceinline__ void ce_desc(float& ka, int& pa, float& kb, int& pb) { const bool sw = kb > ka; const float k0 = sw ? kb : ka, k1 = sw ? ka : kb; const int p0 = sw ? pb : pa, p1 = sw ? pa : pb; ka = k0; pa = p0; kb = k1; pb = p1; }
__device__ __forceinline__ void bitonic_sort_desc_kp(float (&k)[16], int (&p)[16]) {
#pragma unroll
    for (int kk = 2; kk <= 16; kk <<= 1)
#pragma unroll
        for (int j = kk >> 1; j > 0; j >>= 1)
#pragma unroll
            for (int i = 0; i < 16; ++i) { const int q = i ^ j; if (q > i) { if ((i & kk) == 0) ce_desc(k[i], p[i], k[q], p[q]); else ce_desc(k[q], p[q], k[i], p[i]); } }
}
__device__ __forceinline__ void merge_top16_kp(float (&k)[16], int (&p)[16], const float (&k2)[16], const int (&p2)[16]) {
#pragma unroll
    for (int i = 0; i < 16; ++i) { const bool sw = k2[15 - i] > k[i]; k[i] = sw ? k2[15 - i] : k[i]; p[i] = sw ? p2[15 - i] : p[i]; }
#pragma unroll
    for (int j = 8; j > 0; j >>= 1)
#pragma unroll
        for (int i = 0; i < 16; ++i) { const int q = i ^ j; if (q > i) ce_desc(k[i], p[i], k[q], p[q]); }
}
__device__ constexpr int cand_i(int s) { return s < 16 ? 0 : s < 24 ? 1 : s < 29 ? 2 : s < 33 ? 3 : s < 36 ? 4 : s < 38 ? 5 : s < 40 ? 6 : s < 42 ? 7 : s < 50 ? s - 34 : -1; }
__device__ constexpr int cand_j(int s) { return s < 16 ? s : s < 24 ? s - 16 : s < 29 ? s - 24 : s < 33 ? s - 29 : s < 36 ? s - 33 : s < 38 ? s - 36 : s < 40 ? s - 38 : s < 42 ? s - 40 : s < 50 ? 0 : -1; }

__device__ __forceinline__ void peer_retrieve(const Args& a, int l, LAS unsigned char* lds, int lane, int wave, int ch) {
    const bf16* qbuf = (const bf16*)(a.ws + WS_Q); const bf16* keys = (const bf16*)(a.ws + WS_KEYS) + ((size_t)(l * 8 + wave) * 2) * 128 * 128;
    LAS int* eg_e = (LAS int*)lds; LAS float* eg_g = (LAS float*)(lds + 32768);
    const int l31 = lane & 31, l5 = lane >> 5, h = wave, t0 = ch * 64;
    for (int tt = 0; tt < 2; ++tt) {
        float sv[2][16];
#pragma unroll
        for (int p = 0; p < 2; ++p) {
            f32x16 acc[4];
#pragma unroll
            for (int nt = 0; nt < 4; ++nt)
#pragma unroll
                for (int r = 0; r < 16; ++r) acc[nt][r] = 0.f;
            const bf16* qp = qbuf + (size_t)(t0 + 32 * tt + l31) * D + h * 256 + p * 128 + 8 * l5;
            const bf16* kp = keys + (size_t)(p * 128 + l31) * 128 + 8 * l5;
#pragma unroll 2
            for (int ks = 0; ks < 8; ++ks) { const bf16x8 bq = *(const bf16x8*)(qp + 16 * ks);
#pragma unroll
                for (int nt = 0; nt < 4; ++nt) { const bf16x8 ak = *(const bf16x8*)(kp + (size_t)(32 * nt) * 128 + 16 * ks); acc[nt] = __builtin_amdgcn_mfma_f32_32x32x16_bf16(ak, bq, acc[nt], 0, 0, 0); } }
            float v[4][16];
#pragma unroll
            for (int nt = 0; nt < 4; ++nt)
#pragma unroll
                for (int r = 0; r < 16; ++r) { const unsigned idx = 32u * nt + (r & 3) + 8u * (r >> 2) + 4u * l5; v[nt][r] = __uint_as_float((__float_as_uint(acc[nt][r]) & 0xffffff80u) | idx); }
#pragma unroll
            for (int nt = 0; nt < 4; ++nt) bitonic_sort_desc<16>(v[nt]);
            merge_top16(v[0], v[1]); merge_top16(v[2], v[3]); merge_top16(v[0], v[2]);
            float o[16];
#pragma unroll
            for (int i = 0; i < 16; ++i) o[i] = __shfl_xor(v[0][i], 32);
            merge_top16(v[0], o);
#pragma unroll
            for (int i = 0; i < 16; ++i) sv[p][i] = v[0][i];
        }
        LAS unsigned char* idxb = (LAS unsigned char*)(lds + 69632) + wave * 2048 + lane * 32;
        { v4u w0, w1;
#pragma unroll
          for (int q4 = 0; q4 < 4; ++q4) {
              w0[q4] = (__float_as_uint(sv[0][4 * q4]) & 127u) | ((__float_as_uint(sv[0][4 * q4 + 1]) & 127u) << 8) | ((__float_as_uint(sv[0][4 * q4 + 2]) & 127u) << 16) | ((__float_as_uint(sv[0][4 * q4 + 3]) & 127u) << 24);
              w1[q4] = (__float_as_uint(sv[1][4 * q4]) & 127u) | ((__float_as_uint(sv[1][4 * q4 + 1]) & 127u) << 8) | ((__float_as_uint(sv[1][4 * q4 + 2]) & 127u) << 16) | ((__float_as_uint(sv[1][4 * q4 + 3]) & 127u) << 24); }
          *(LAS v4u*)(idxb) = w0; *(LAS v4u*)(idxb + 16) = w1; }
        float ck[4][16];
#pragma unroll
        for (int s = 0; s < 64; ++s) {
            if (cand_i(s) >= 0) { const unsigned b0 = __float_as_uint(sv[0][cand_i(s) < 0 ? 0 : cand_i(s)]), b1 = __float_as_uint(sv[1][cand_j(s) < 0 ? 0 : cand_j(s)]);
                const float sum = __uint_as_float(b0 & 0xffffff80u) + __uint_as_float(b1 & 0xffffff80u);
                ck[s >> 4][s & 15] = __uint_as_float((__float_as_uint(sum) & 0xffffff00u) | (unsigned)((cand_i(s) < 0 ? 0 : cand_i(s)) * 16 + (cand_j(s) < 0 ? 0 : cand_j(s)))); }
            else ck[s >> 4][s & 15] = -3.0e38f; }
        bitonic_sort_desc<16>(ck[1]); bitonic_sort_desc<16>(ck[2]);
        merge_top16(ck[0], ck[1]); merge_top16(ck[2], ck[3]); merge_top16(ck[0], ck[2]);
        LDS_WAIT(); asm volatile("" ::: "memory");
        float ex[16]; int ce[16]; float den = 0.f;
        const float cmax = __uint_as_float(__float_as_uint(ck[0][0]) & 0xffffff00u);
#pragma unroll
        for (int i = 0; i < 16; ++i) { const unsigned bits = __float_as_uint(ck[0][i]); ex[i] = __expf(__uint_as_float(bits & 0xffffff00u) - cmax); den += ex[i];
            ce[i] = (int)idxb[(bits >> 4) & 15u] * 128 + (int)idxb[16 + (bits & 15u)]; }
        const float inv = 1.0f / den;
        if (l5 == 0) {
            const int base = (32 * tt + l31) * 128 + h * 16;
#pragma unroll
            for (int i4 = 0; i4 < 4; ++i4) { *(LAS v4u*)(eg_e + base + 4 * i4) = (v4u){(unsigned)ce[4 * i4], (unsigned)ce[4 * i4 + 1], (unsigned)ce[4 * i4 + 2], (unsigned)ce[4 * i4 + 3]};
                *(LAS f32x4*)(eg_g + base + 4 * i4) = (f32x4){ex[4 * i4] * inv, ex[4 * i4 + 1] * inv, ex[4 * i4 + 2] * inv, ex[4 * i4 + 3] * inv}; }
        }
        LDS_WAIT(); asm volatile("" ::: "memory");
    }
}

typedef unsigned char uc4 __attribute__((ext_vector_type(4)));
constexpr int NSLICE = 16, SLICE_SHIFT = 10;
__device__ __forceinline__ int sdot4i(unsigned w, unsigned x, int acc) { return __builtin_amdgcn_sdot4((int)w, (int)x, acc, false); }
__device__ __forceinline__ void fma_ub4(unsigned w, float s, float& y0, float& y1, float& y2, float& y3) { const uc4 b = __builtin_bit_cast(uc4, w); y0 += s * (float)b.x; y1 += s * (float)b.y; y2 += s * (float)b.z; y3 += s * (float)b.w; }
__device__ __forceinline__ void peer_tail(const Args& a, int l, int t, int lane, float (&y)[32], float wsum, const float* mb, const float* mbn, bool last) {
    const float* x1buf = (const float*)(a.ws + WS_X1);
    const float woff = 128.0f * wsum;
    float z[32];
#pragma unroll
    for (int c = 0; c < 8; ++c) { const int col = (c * 64 + lane) * 4;
        const f32x4 x0 = *(const f32x4*)(x1buf + (size_t)t * D + col), g0 = *(const f32x4*)(mb + 5 * D + col);
        z[c * 4] = ALPHA * x0.x + (1.f + g0.x) * (y[c * 4] - woff); z[c * 4 + 1] = ALPHA * x0.y + (1.f + g0.y) * (y[c * 4 + 1] - woff);
        z[c * 4 + 2] = ALPHA * x0.z + (1.f + g0.z) * (y[c * 4 + 2] - woff); z[c * 4 + 3] = ALPHA * x0.w + (1.f + g0.w) * (y[c * 4 + 3] - woff); }
    ln_tail(z, t, lane, a.in[17] + (size_t)l * D, a.in[18] + (size_t)l * D, last ? a.out : (float*)(a.ws + WS_X), mbn, mbn + D, last ? (bf16*)nullptr : (bf16*)(a.ws + WS_H), nullptr, nullptr);
}
__device__ __forceinline__ int wave_excl_scan(int v, int lane, int& total) {
    int x = v;
#pragma unroll
    for (int o = 1; o < 64; o <<= 1) { const int y = __shfl_up(x, o); if (lane >= o) x += y; }
    total = __shfl(x, 63);
    return x - v;
}
__device__ __forceinline__ void peer_experts(const Args& a, int l, LAS unsigned char* lds, int lane0, int wave, int ch) {
    const int lane = lane0;
    const float* mod = (const float*)(a.ws + WS_MOD);
    const unsigned char* ut = a.ws + WS_UT + (size_t)l * NE * D; const unsigned char* vt = a.ws + WS_VT + (size_t)l * NE * D; const unsigned char* hq8 = a.ws + WS_HQ8;
    const float* su = (const float*)(a.ws + WS_SU) + (size_t)l * NE; const float* sv = (const float*)(a.ws + WS_SV) + (size_t)l * NE; const float* hsc = (const float*)(a.ws + WS_HSC);
    const LAS int* eg_e = (const LAS int*)lds; const LAS float* eg_g = (const LAS float*)(lds + 32768);
    LAS unsigned short* se = (LAS unsigned short*)(lds + 65536); LAS float* sw = (LAS float*)(lds + 81920); LAS int* soff = (LAS int*)(lds + LDSCTL_OFF + 256);
    LAS unsigned short* flat = (LAS unsigned short*)(lds + LDSCTL_OFF + 4608) + wave * 512;
    LAS unsigned char* hql = lds + wave * 8192;
    const int b = ch / NCH; const bool last = (l == NL - 1);
    const float* mb = mod + ((size_t)l * NB + b) * 6 * D; const float* mbn = mod + ((size_t)(last ? l : l + 1) * NB + b) * 6 * D;
    for (int it = 0; it < 8; ++it) {
        const int tl = wave * 8 + it;
        const int e0 = eg_e[tl * 128 + lane], e1 = eg_e[tl * 128 + 64 + lane]; const float g0 = eg_g[tl * 128 + lane], g1 = eg_g[tl * 128 + 64 + lane];
        const int s0 = e0 >> SLICE_SHIFT, s1 = e1 >> SLICE_SHIFT;
        int run = 0, pos0 = 0, pos1 = 0;
#pragma unroll
        for (int s = 0; s < NSLICE; ++s) {
            const unsigned long long m0 = __ballot(s0 == s), m1 = __ballot(s1 == s);
            const int c0 = __popcll(m0), c1 = __popcll(m1);
            const int r0 = __builtin_amdgcn_mbcnt_hi((unsigned)(m0 >> 32), __builtin_amdgcn_mbcnt_lo((unsigned)m0, 0u)), r1 = __builtin_amdgcn_mbcnt_hi((unsigned)(m1 >> 32), __builtin_amdgcn_mbcnt_lo((unsigned)m1, 0u));
            if (s0 == s) pos0 = run + r0;
            if (s1 == s) pos1 = run + c0 + r1;
            if (lane == 0) soff[tl * 17 + s] = run;
            run += c0 + c1;
        }
        if (lane == 0) soff[tl * 17 + 16] = run;
        se[tl * 128 + pos0] = (unsigned short)e0; sw[tl * 128 + pos0] = g0; se[tl * 128 + pos1] = (unsigned short)e1; sw[tl * 128 + pos1] = g1;
    }
    __syncthreads();
    for (int half = 0; half < 2; ++half) {
        int laneL = lane0; asm volatile("" : "+v"(laneL)); const int lane = laneL;
        const int b5 = (lane >> 5) & 1, b4 = (lane >> 4) & 1, b3 = (lane >> 3) & 1;
        const int tl0 = wave * 8 + 4 * half;
        { const int itA = lane & 3, sA = lane >> 2, tlq = (tl0 + itA) * 17;
          const int baseA = soff[tlq + sA], nA = soff[tlq + sA + 1] - baseA; int tot;
          const int exA = wave_excl_scan(nA, lane, tot);
          for (int j = 0; j < nA; ++j) flat[exA + j] = (unsigned short)((itA << 7) | (baseA + j)); }
        float shsr[4];
#pragma unroll
        for (int it = 0; it < 4; ++it) { const int t = ch * 64 + tl0 + it; *(LAS v4u*)(hql + it * 2048 + lane * 16) = *(const v4u*)(hq8 + (size_t)t * D + lane * 16);
            *(LAS v4u*)(hql + it * 2048 + (64 + lane) * 16) = *(const v4u*)(hq8 + (size_t)t * D + (64 + lane) * 16); shsr[it] = hsc[t]; }
        LDS_WAIT(); asm volatile("" ::: "memory");
        v4u bufA[8][2], bufB[8][2];
#define PU_LOAD(buf, j_) do { _Pragma("unroll") for (int k_ = 0; k_ < 8; ++k_) { const int d_ = __builtin_amdgcn_readfirstlane((int)flat[(j_) * 8 + k_]); \
            const int e_ = __builtin_amdgcn_readfirstlane((int)se[(tl0 + (d_ >> 7)) * 128 + (d_ & 127)]); const unsigned char* row_ = ut + (size_t)e_ * D; \
            buf[k_][0] = *(const v4u*)(row_ + lane * 16); buf[k_][1] = *(const v4u*)(row_ + (64 + lane) * 16); } } while (0)
#define PU_COMP(buf, j_) do { float p_[8]; \
            _Pragma("unroll") for (int k_ = 0; k_ < 8; ++k_) { const int d_ = __builtin_amdgcn_readfirstlane((int)flat[(j_) * 8 + k_]); \
                const v4u h0_ = *(const LAS v4u*)(hql + (d_ >> 7) * 2048 + lane * 16), h1_ = *(const LAS v4u*)(hql + (d_ >> 7) * 2048 + (64 + lane) * 16); int acc_ = 0; \
                _Pragma("unroll") for (int q_ = 0; q_ < 4; ++q_) { acc_ = sdot4i(buf[k_][0][q_], h0_[q_], acc_); acc_ = sdot4i(buf[k_][1][q_], h1_[q_], acc_); } p_[k_] = (float)acc_; } \
            float q4_[4], r2_[2]; \
            _Pragma("unroll") for (int k_ = 0; k_ < 4; ++k_) { const float send_ = b5 ? p_[k_] : p_[k_ + 4], keep_ = b5 ? p_[k_ + 4] : p_[k_]; q4_[k_] = keep_ + __shfl_xor(send_, 32); } \
            _Pragma("unroll") for (int k_ = 0; k_ < 2; ++k_) { const float send_ = b4 ? q4_[k_] : q4_[k_ + 2], keep_ = b4 ? q4_[k_ + 2] : q4_[k_]; r2_[k_] = keep_ + __shfl_xor(send_, 16); } \
            float s1_; { const float send_ = b3 ? r2_[0] : r2_[1], keep_ = b3 ? r2_[1] : r2_[0]; s1_ = keep_ + __shfl_xor(send_, 8); } \
            s1_ += __shfl_xor(s1_, 4); s1_ += __shfl_xor(s1_, 2); s1_ += __shfl_xor(s1_, 1); \
            const int dd_ = (int)flat[(j_) * 8 + (lane >> 3)]; const int itd_ = dd_ >> 7, idx_ = (tl0 + itd_) * 128 + (dd_ & 127); \
            const int er_ = (int)se[idx_]; const float gt_ = sw[idx_]; \
            const float shs_ = itd_ == 0 ? shsr[0] : (itd_ == 1 ? shsr[1] : (itd_ == 2 ? shsr[2] : shsr[3])); \
            const float wgt_ = gt_ * gelu_tanh_f(s1_ * su[er_] * shs_) * sv[er_]; \
            LDS_WAIT(); asm volatile("" ::: "memory"); \
            if ((lane & 7) == 0) sw[idx_] = wgt_; } while (0)
        PU_LOAD(bufA, 0);
        for (int j = 0; j < 64; j += 2) {
            PU_LOAD(bufB, j + 1);
            PU_COMP(bufA, j);
            if (j + 2 < 64) PU_LOAD(bufA, j + 2);
            PU_COMP(bufB, j + 1);
        }
#undef PU_LOAD
#undef PU_COMP
        LDS_WAIT(); asm volatile("" ::: "memory");
    }
    for (int sub = 0; sub < 4; ++sub) {
        int laneL = lane0; asm volatile("" : "+v"(laneL)); const int lane = laneL;
        const int tl0 = wave * 8 + 2 * sub;
        { int nA = 0, baseA = 0; const int ab = lane & 1, sA = (lane >> 1) & 15, tlq = (tl0 + ab) * 17; int tot;
          if (lane < 32) { baseA = soff[tlq + sA]; nA = soff[tlq + sA + 1] - baseA; }
          const int exA = wave_excl_scan(nA, lane, tot);
          for (int j = 0; j < nA; ++j) flat[exA + j] = (unsigned short)((ab << 7) | (baseA + j)); }
        LDS_WAIT(); asm volatile("" ::: "memory");
        float yA[32], yB[32]; float wsA = 0.f, wsB = 0.f;
#pragma unroll
        for (int i = 0; i < 32; ++i) { yA[i] = 0.f; yB[i] = 0.f; }
        v4u bufA[4][2], bufB[4][2];
#define PV_LOAD(buf, j_) do { _Pragma("unroll") for (int k_ = 0; k_ < 4; ++k_) { const int d_ = __builtin_amdgcn_readfirstlane((int)flat[(j_) * 4 + k_]); \
            const int e_ = __builtin_amdgcn_readfirstlane((int)se[(tl0 + (d_ >> 7)) * 128 + (d_ & 127)]); const unsigned char* row_ = vt + (size_t)e_ * D; \
            buf[k_][0] = *(const v4u*)(row_ + lane * 16); buf[k_][1] = *(const v4u*)(row_ + (64 + lane) * 16); } } while (0)
#define PV_ROW(buf, k_, y_, ws_, wk_) do { ws_ += wk_; _Pragma("unroll") for (int c_ = 0; c_ < 2; ++c_) _Pragma("unroll") for (int q_ = 0; q_ < 4; ++q_) \
            fma_ub4(buf[k_][c_][q_], wk_, y_[(c_ * 4 + q_) * 4], y_[(c_ * 4 + q_) * 4 + 1], y_[(c_ * 4 + q_) * 4 + 2], y_[(c_ * 4 + q_) * 4 + 3]); } while (0)
#define PV_COMP(buf, j_) do { _Pragma("unroll") for (int k_ = 0; k_ < 4; ++k_) { const int d_ = __builtin_amdgcn_readfirstlane((int)flat[(j_) * 4 + k_]); \
            const float wk_ = sw[(tl0 + (d_ >> 7)) * 128 + (d_ & 127)]; \
            if ((d_ >> 7) == 0) PV_ROW(buf, k_, yA, wsA, wk_); else PV_ROW(buf, k_, yB, wsB, wk_); } } while (0)
        PV_LOAD(bufA, 0);
        for (int j = 0; j < 64; j += 2) {
            PV_LOAD(bufB, j + 1);
            PV_COMP(bufA, j);
            if (j + 2 < 64) PV_LOAD(bufA, j + 2);
            PV_COMP(bufB, j + 1);
        }
#undef PV_LOAD
#undef PV_ROW
#undef PV_COMP
        { int laneT = lane0; asm volatile("" : "+v"(laneT)); peer_tail(a, l, ch * 64 + tl0, laneT, yA, wsA, mb, mbn, last); }
        { int laneT = lane0; asm volatile("" : "+v"(laneT)); peer_tail(a, l, ch * 64 + tl0 + 1, laneT, yB, wsB, mb, mbn, last); }
    }
}

#ifndef MK_PER_PHASE
#define MK_PER_PHASE 0
#endif
__global__ void __launch_bounds__(NTHREADS, 2) mk_fwd(Args a) {
    extern __shared__ __attribute__((aligned(16))) unsigned char lds_raw[];
    LAS unsigned char* lds = (LAS unsigned char*)lds_raw;
    const int tid = threadIdx.x, lane = tid & 63, wave = __builtin_amdgcn_readfirstlane(tid >> 6), G = gridDim.x, bx = blockIdx.x;
    if (tid < 64) ((LAS unsigned*)(lds + LDSCTL_OFF))[tid] = 0u;
    __syncthreads();
    unsigned* ctl = (unsigned*)(a.ws + WS_CTL);
    XcdBarrier bar; bar.bar = ctl + CW_BAR; bar.x = 0; bar.st = nullptr;
    const bool use_bar = (a.ph_hi - a.ph_lo) > 1;
    if (use_bar) bar = xcd_barrier_post(ctl + CW_BAR, (volatile LAS unsigned*)(lds + LDSCTL_OFF));
    const int lo = a.ph_lo, hi = a.ph_hi;
#ifndef PH_MASK
#define PH_MASK 0x1ff
#endif
#define IN(k) (lo <= (k) && (k) < hi)
#define EN(b) ((PH_MASK >> (b)) & 1)
#ifndef REP_MASK
#define REP_MASK 0
#endif
#ifndef REP_EXTRA
#define REP_EXTRA 2
#endif
#define REPS(b) (1 + ((REP_MASK >> (b)) & 1) * REP_EXTRA)
#define REP_BEGIN(b) for (int rep_ = 0; rep_ < REPS(b); ++rep_) {
#define REP_END(b) if (rep_ + 1 < REPS(b)) xcd_barrier(bar); }
#define SEAM(k) do { if (IN((k) + 1)) xcd_barrier(bar); } while (0)
#define PHASE_IDS() int tidp = tid; asm volatile("" : "+v"(tidp)); const int lanep = tidp & 63, wavep = __builtin_amdgcn_readfirstlane(tidp >> 6); (void)lanep; (void)wavep
    if (EN(0) && IN(0)) { REP_BEGIN(0) PHASE_IDS(); ph_prologue_a(a, lds, tidp, lanep, wavep, bx, G); REP_END(0) SEAM(0); }
    if (EN(1) && IN(1)) { REP_BEGIN(1) PHASE_IDS(); ph_prologue_b(a, lds, tidp, lanep, wavep, bx, G); REP_END(1) SEAM(1); }
    for (int l = 0; l < NL; ++l) {
        const int pb = 2 + 7 * l;
        const float* mod = (const float*)(a.ws + WS_MOD);
        if (EN(2) && IN(pb + 0)) {
            REP_BEGIN(2) PHASE_IDS();
            pg8::Gemm g{(const pg8::bf16_t*)(a.ws + WS_H), (const pg8::bf16_t*)(a.ws + WS_WIN) + (size_t)l * INW * D, T, NP, D}; pg8::StaticOrder S; S.init(T, NP, G, bx);
            pg8::EpiBf16P E{(pg8::bf16_t*)(a.ws + WS_PROJ), NP};
            pg8::gemm_phase<pg8::EpiBf16P, pg8::StaticOrder, true, true>(lds + RING_OFF, g, S, E, tidp);
            for (int ch = bx; ch < NCHUNK; ch += G) gate_prep(a, l, lds, tidp, lanep, wavep, ch);
            REP_END(2) SEAM(pb + 0);
        }
        if (EN(3) && IN(pb + 1)) { REP_BEGIN(3) PHASE_IDS(); for (int un = bx; un < 256; un += G) gla_unit(a, lds, tidp, lanep, wavep, un); REP_END(3) SEAM(pb + 1); }
        if (EN(4) && IN(pb + 2)) { REP_BEGIN(4) PHASE_IDS(); for (int ch = bx; ch < NCHUNK; ch += G) mixpost_chunk(a, l, lanep, wavep, ch); REP_END(4) SEAM(pb + 2); }
        if (EN(5) && IN(pb + 3)) {
            REP_BEGIN(5) PHASE_IDS();
            pg8::Gemm g{(const pg8::bf16_t*)(a.ws + WS_Y), (const pg8::bf16_t*)(a.ws + WS_WOUT) + (size_t)l * D * D, T, D, D}; pg8::StaticOrder S; S.init(T, D, G, bx);
            pg8::EpiResid E{(float*)(a.ws + WS_Z), l == 0 ? a.in[0] : (const float*)(a.ws + WS_X), mod + (size_t)l * NB * 6 * D + 2 * D, ALPHA};
            pg8::gemm_phase<pg8::EpiResid, pg8::StaticOrder, true, true>(lds + RING_OFF, g, S, E, tidp);
            REP_END(5) SEAM(pb + 3);
        }
        if (EN(6) && IN(pb + 4)) { REP_BEGIN(6) PHASE_IDS(); for (int ch = bx; ch < NCHUNK; ch += G) ln1_chunk(a, l, lanep, wavep, ch); REP_END(6) SEAM(pb + 4); }
        if (EN(7) && IN(pb + 5)) {
            REP_BEGIN(7) PHASE_IDS();
            pg8::Gemm g{(const pg8::bf16_t*)(a.ws + WS_H2), (const pg8::bf16_t*)(a.ws + WS_WQ) + (size_t)l * D * D, T, D, D}; pg8::StaticOrder S; S.init(T, D, G, bx);
            pg8::EpiBf16P E{(pg8::bf16_t*)(a.ws + WS_Q), D};
            pg8::gemm_phase<pg8::EpiBf16P, pg8::StaticOrder, true, true>(lds + RING_OFF, g, S, E, tidp);
            REP_END(7) SEAM(pb + 5);
        }
#ifndef PEER_DBG
#define PEER_DBG 0
#endif
#ifndef L2PROBE
#define L2PROBE 0
#endif
        if (EN(8) && IN(pb + 6)) {
            REP_BEGIN(8)
            for (int ch = bx; ch < NCHUNK; ch += G) { { PHASE_IDS(); peer_retrieve(a, l, lds, lanep, wavep, ch); } __syncthreads(); { PHASE_IDS(); peer_experts(a, l, lds, lanep, wavep, ch); } __syncthreads(); }
            REP_END(8) SEAM(pb + 6);
        }
    }
#undef IN
#undef SEAM
}

extern "C" void kernel_launch(void* const* d_in, const int* in_sizes, int n_in, void* d_out, int out_size, void* d_ws, size_t ws_size, hipStream_t stream) {
    static int grid = 0;
    if (grid == 0) {
        if (n_in != 19 || in_sizes[0] != T * D || out_size != T * D || ws_size < WS_END) { fprintf(stderr, "kernel_launch: unexpected shapes / workspace (%d inputs, ws %zu); nothing launched\n", n_in, ws_size); grid = -1; return; }
        int dev = 0, cus = 0, per_cu = 0;
        if (hipGetDevice(&dev) != hipSuccess || hipDeviceGetAttribute(&cus, hipDeviceAttributeMultiprocessorCount, dev) != hipSuccess) { grid = -1; return; }
        if (hipFuncSetAttribute((const void*)mk_fwd, hipFuncAttributeMaxDynamicSharedMemorySize, LDS_BYTES) != hipSuccess) { fprintf(stderr, "kernel_launch: hipFuncSetAttribute failed\n"); grid = -1; return; }
        if (hipOccupancyMaxActiveBlocksPerMultiprocessor(&per_cu, (const void*)mk_fwd, NTHREADS, LDS_BYTES) != hipSuccess || per_cu < 1) fprintf(stderr, "kernel_launch: occupancy query reports %d\n", per_cu);
        (void)hipGetLastError();
        grid = cus;
    }
    if (grid < 0) return;
    if (hipMemsetAsync((char*)d_ws + WS_CTL, 0, CTL_ZERO_BYTES, stream) != hipSuccess) return;
    Args a{};
    for (int i = 0; i < 19; ++i) a.in[i] = (const float*)d_in[i];
    a.out = (float*)d_out; a.ws = (unsigned char*)d_ws;
#if MK_PER_PHASE
    for (int p = 0; p < NPHASES; ++p) { a.ph_lo = p; a.ph_hi = p + 1; hipLaunchKernelGGL(mk_fwd, dim3(grid), dim3(NTHREADS), LDS_BYTES, stream, a); }
#else
    a.ph_lo = 0; a.ph_hi = NPHASES;
    hipLaunchKernelGGL(mk_fwd, dim3(grid), dim3(NTHREADS), LDS_BYTES, stream, a);
#endif
}
```

```cpp
#include <hip/hip_runtime.h>
#include <cstdio>
#include <cstdint>
namespace pg8 {
#define PG8_LAS __attribute__((address_space(3)))
typedef unsigned short bf16_t;
typedef short bf16x8 __attribute__((ext_vector_type(8)));
typedef float f32x4 __attribute__((ext_vector_type(4)));
typedef unsigned u32x4 __attribute__((ext_vector_type(4)));
constexpr int BM = 256, BK = 64, HALF = 128, HTB = HALF * BK * 2  , STAGE_BYTES = 8 * HTB, NXCD = 8, WGM = 8;

__host__ __device__ __forceinline__ int lds_byte(int r, int c) { const int st = (r >> 4) * 2 + (c >> 5), rr = r & 15, cc = c & 31, ob = rr * 64 + cc * 2; return st * 1024 + (ob ^ (((ob >> 9) & 1) << 5)); }
__host__ __device__ __forceinline__ void stage_rc(int b, int& R, int& C) { const int st = b / 1024, sb = b % 1024, swz = sb ^ (((sb >> 9) & 1) << 5); R = (st >> 1) * 16 + swz / 64; C = (st & 1) * 32 + (swz % 64) / 2; }
__host__ __device__ __forceinline__ int perm32(int rho) { const int n = rho >> 4, i = rho & 15; return 8 * (i >> 2) + 4 * n + (i & 3); }

struct Unit { int pm, pn; };
struct Gemm { const bf16_t* A; const bf16_t* Bt; int M, N, K; };

struct StaticOrder {
    int nM, nN, nwg, G, c;
    __host__ __device__ void init(int M, int N, int G_, int c_) { nM = M / BM; nN = N / BM; nwg = nM * nN; G = G_; c = c_; }
    __host__ __device__ bool next(int i, Unit& u) const {
        const long L = (long)i * G + c; if (L >= nwg) return false;
        int wgid = (int)L; { const int q = nwg / NXCD, r = nwg % NXCD, xcd = wgid % NXCD, off = wgid / NXCD; wgid = (xcd < r ? xcd * (q + 1) : r * (q + 1) + (xcd - r) * q) + off; }
        const int nig = WGM * nN, gid = wgid / nig, fm = gid * WGM, gsz = (nM - fm) < WGM ? (nM - fm) : WGM;
        u.pm = fm + ((wgid % nig) % gsz); u.pn = (wgid % nig) / gsz; return true;
    }
    __device__ __forceinline__ void a_ready(const Unit&) const {}
    __device__ __forceinline__ void done(const Unit&) const {}
};
typedef __bf16 bf16x2_t __attribute__((ext_vector_type(2)));
__device__ __forceinline__ unsigned cvt_pk_bf16(float lo, float hi) { bf16x2_t r; r.x = (__bf16)lo; r.y = (__bf16)hi; return __builtin_bit_cast(unsigned, r); }
struct EpiBf16P {
    static constexpr bool PERM = true, AFTER_DRAIN = false;
    bf16_t* O; int ldc;
    __device__ __forceinline__ void operator()(const f32x4 (&acc)[2][2][4][2], const Unit& u, int wr, int wc, int fr, int fq) const {
        const int row0 = u.pm * BM + wr * 64 + fr, col0 = u.pn * BM + wc * 32 + 8 * fq;
#pragma unroll
        for (int ai = 0; ai < 2; ++ai)
#pragma unroll
            for (int m = 0; m < 4; ++m) { bf16_t* rowp = O + (size_t)(row0 + ai * HALF + m * 16) * ldc + col0;
#pragma unroll
                for (int bj = 0; bj < 2; ++bj) { const f32x4 v0 = acc[ai][bj][m][0], v1 = acc[ai][bj][m][1];
                    u32x4 w; w.x = cvt_pk_bf16(v0[0], v0[1]); w.y = cvt_pk_bf16(v0[2], v0[3]); w.z = cvt_pk_bf16(v1[0], v1[1]); w.w = cvt_pk_bf16(v1[2], v1[3]);
                    *(u32x4*)(rowp + bj * HALF) = w; } }
    }
};
struct EpiResid {
    static constexpr bool PERM = false, AFTER_DRAIN = false;
    float* Z; const float* X; const float* gate; float alpha;
    __device__ __forceinline__ void operator()(const f32x4 (&acc)[2][2][4][2], const Unit& u, int wr, int wc, int fr, int fq) const {
        const int row0 = u.pm * BM + wr * 64 + fr, col0 = u.pn * BM + wc * 32 + 4 * fq;
        const float* gb = gate + (size_t)(u.pm >> 3) * (6 * 2048) + col0;
        f32x4 gv[2][2];
#pragma unroll
        for (int bj = 0; bj < 2; ++bj)
#pragma unroll
            for (int n = 0; n < 2; ++n) gv[bj][n] = *(const f32x4*)(gb + bj * HALF + n * 16) + 1.0f;
#pragma unroll
        for (int ai = 0; ai < 2; ++ai)
#pragma unroll
            for (int m = 0; m < 4; ++m) { const size_t off = (size_t)(row0 + ai * HALF + m * 16) * 2048 + col0;
#pragma unroll
                for (int bj = 0; bj < 2; ++bj)
#pragma unroll
                    for (int n = 0; n < 2; ++n) { const f32x4 xv = *(const f32x4*)(X + off + bj * HALF + n * 16);
                        *(f32x4*)(Z + off + bj * HALF + n * 16) = xv * alpha + gv[bj][n] * acc[ai][bj][m][n]; }
                asm volatile("" ::: "memory"); }
    }
};
template <class Epi, class Sched, bool ALIGN_EPI = false, bool SP2 = false>
__device__ __forceinline__ void gemm_phase(PG8_LAS unsigned char* lds, const Gemm g, const Sched& S, const Epi& E, const int tid_in) {
    const int tid = tid_in, wid = __builtin_amdgcn_readfirstlane(tid >> 6), lane = tid & 63, wr = wid >> 2, wc = wid & 3, fr = lane & 15, fq = lane >> 4;
    const int K = g.K, nt = K / BK;
    unsigned voffA[2], voffB[2];
#pragma unroll
    for (int i = 0; i < 2; ++i) { int R, C; stage_rc(tid * 16 + i * 8192, R, C); const int Rb = Epi::PERM ? ((R & ~31) + perm32(R & 31)) : R;
        voffA[i] = (unsigned)(R * K + C) * 2u; voffB[i] = (unsigned)(Rb * K + C) * 2u; }
    const size_t kstep = (size_t)(BK * 2);
    const size_t hstep = (size_t)HALF * K * 2;
    const size_t tstep = 2 * hstep;
    const unsigned ldsw = (unsigned)wid * 1024u;
    const int aoff = lds_byte(wr * 64 + fr, fq * 8), boff = lds_byte(wc * 32 + fr, fq * 8);
#define PG8_SA(b, h) (((b) * 2 + (h)) * HTB)
#define PG8_SB(b, h) ((4 + (b) * 2 + (h)) * HTB)
#define PG8_STAGE(bufoff, gbase, voff) do { _Pragma("unroll") for (int _i = 0; _i < 2; ++_i) \
        __builtin_amdgcn_global_load_lds((const unsigned*)((const char*)(gbase) + (voff)[_i]), (PG8_LAS unsigned*)(lds + (bufoff) + ldsw + _i * 8192), 16, 0, 0); } while (0)
#define PG8_LDA(dst, b, h) do { _Pragma("unroll") for (int m = 0; m < 4; ++m) _Pragma("unroll") for (int k = 0; k < 2; ++k) dst[m][k] = *(const PG8_LAS bf16x8*)(lds + PG8_SA(b, h) + aoff + m * 2048 + k * 1024); } while (0)
#define PG8_LDB(dst, b, h) do { _Pragma("unroll") for (int n = 0; n < 2; ++n) _Pragma("unroll") for (int k = 0; k < 2; ++k) dst[n][k] = *(const PG8_LAS bf16x8*)(lds + PG8_SB(b, h) + boff + n * 2048 + k * 1024); } while (0)
#define PG8_MMA(ai, bj, At, Bt) do { __builtin_amdgcn_s_setprio(1); _Pragma("unroll") for (int m = 0; m < 4; ++m) _Pragma("unroll") for (int n = 0; n < 2; ++n) _Pragma("unroll") for (int k = 0; k < 2; ++k) \
        acc[ai][bj][m][n] = __builtin_amdgcn_mfma_f32_16x16x32_bf16(Bt[n][k], At[m][k], acc[ai][bj][m][n], 0, 0, 0); __builtin_amdgcn_s_setprio(0); } while (0)
#define PG8_WAIT_V(n) asm volatile("s_waitcnt vmcnt(" #n ")" ::: "memory")
#define PG8_WAIT_L(n) asm volatile("s_waitcnt lgkmcnt(" #n ")" ::: "memory")
#define PG8_BAR __builtin_amdgcn_s_barrier()
#define PG8_SCHED __builtin_amdgcn_sched_barrier(0)
    Unit cur, nxt; int ui = 0;
    if (!S.next(0, cur)) return;
    f32x4 acc[2][2][4][2];
#pragma unroll
    for (int a = 0; a < 2; ++a)
#pragma unroll
        for (int b = 0; b < 2; ++b)
#pragma unroll
            for (int m = 0; m < 4; ++m)
#pragma unroll
                for (int n = 0; n < 2; ++n) acc[a][b][m][n] = (f32x4){0.f, 0.f, 0.f, 0.f};
    bf16x8 At[4][2], B0[2][2], B1[2][2];
    const char* cA = (const char*)g.A + (size_t)cur.pm * tstep; const char* cB = (const char*)g.Bt + (size_t)cur.pn * tstep;
    S.a_ready(cur);
    if constexpr (SP2) {
        PG8_STAGE(PG8_SB(0, 0), cB, voffB); PG8_STAGE(PG8_SB(0, 1), cB + hstep, voffB); PG8_STAGE(PG8_SA(0, 0), cA, voffA); PG8_STAGE(PG8_SA(0, 1), cA + hstep, voffA);
        if (wr == 1) PG8_BAR;
        PG8_WAIT_V(2); PG8_BAR;
        PG8_STAGE(PG8_SB(1, 0), cB + kstep, voffB); PG8_STAGE(PG8_SA(1, 0), cA + kstep, voffA); PG8_STAGE(PG8_SB(1, 1), cB + hstep + kstep, voffB);
        PG8_WAIT_V(6); PG8_BAR;
    } else {
        PG8_STAGE(PG8_SB(0, 0), cB, voffB); PG8_STAGE(PG8_SA(0, 0), cA, voffA); PG8_STAGE(PG8_SB(0, 1), cB + hstep, voffB); PG8_STAGE(PG8_SA(0, 1), cA + hstep, voffA);
        if (wr == 1) PG8_BAR;
        PG8_WAIT_V(4); PG8_BAR;
        PG8_STAGE(PG8_SB(1, 0), cB + kstep, voffB); PG8_STAGE(PG8_SA(1, 0), cA + kstep, voffA); PG8_STAGE(PG8_SB(1, 1), cB + hstep + kstep, voffB);
        PG8_WAIT_V(6); PG8_BAR;
    }
    for (;;) {
        const bool has_next = S.next(ui + 1, nxt);
        const char* nA = has_next ? (const char*)g.A + (size_t)nxt.pm * tstep : cA; const char* nB = has_next ? (const char*)g.Bt + (size_t)nxt.pn * tstep : cB;
        for (int t = 0; t < nt; t += 2) {
            const bool last = (t == nt - 2);
            const char* a1 = cA + (size_t)(t + 1) * kstep;
            const char* a2 = last ? nA : cA + (size_t)(t + 2) * kstep; const char* b2 = last ? nB : cB + (size_t)(t + 2) * kstep;
            const char* a3 = a2 + kstep; const char* b3 = b2 + kstep;
            if (last && has_next) S.a_ready(nxt);
            if constexpr (SP2) {
            PG8_LDB(B0, 0, 0); PG8_LDB(B1, 0, 1); PG8_SCHED; PG8_LDA(At, 0, 0); PG8_STAGE(PG8_SA(1, 1), a1 + hstep, voffA);
            PG8_WAIT_V(8); PG8_WAIT_L(0); PG8_BAR; PG8_MMA(0, 0, At, B0); PG8_MMA(0, 1, At, B1); PG8_BAR; PG8_SCHED;
            PG8_LDA(At, 0, 1); PG8_STAGE(PG8_SB(0, 0), b2, voffB); PG8_STAGE(PG8_SB(0, 1), b2 + hstep, voffB); PG8_STAGE(PG8_SA(0, 0), a2, voffA);
            PG8_WAIT_V(8); PG8_WAIT_L(0); PG8_BAR; PG8_MMA(1, 0, At, B0); PG8_MMA(1, 1, At, B1); PG8_BAR; PG8_SCHED;
            PG8_LDB(B0, 1, 0); PG8_LDB(B1, 1, 1); PG8_SCHED; PG8_LDA(At, 1, 0); PG8_STAGE(PG8_SA(0, 1), a2 + hstep, voffA);
            PG8_WAIT_V(8); PG8_WAIT_L(0); PG8_BAR; PG8_MMA(0, 0, At, B0); PG8_MMA(0, 1, At, B1); PG8_BAR; PG8_SCHED;
            PG8_LDA(At, 1, 1); PG8_STAGE(PG8_SB(1, 0), b3, voffB); PG8_STAGE(PG8_SB(1, 1), b3 + hstep, voffB); PG8_STAGE(PG8_SA(1, 0), a3, voffA);
            PG8_WAIT_V(8); PG8_WAIT_L(0); PG8_BAR; PG8_MMA(1, 0, At, B0); PG8_MMA(1, 1, At, B1); PG8_BAR; PG8_SCHED;
            } else {
            PG8_LDB(B0, 0, 0); PG8_SCHED; PG8_LDA(At, 0, 0); PG8_STAGE(PG8_SA(1, 1), a1 + hstep, voffA);
            PG8_WAIT_L(8); PG8_BAR; PG8_WAIT_L(0); PG8_MMA(0, 0, At, B0); PG8_BAR; PG8_SCHED;
            PG8_LDB(B1, 0, 1); PG8_STAGE(PG8_SB(0, 0), b2, voffB);
            PG8_BAR; PG8_WAIT_L(0); PG8_MMA(0, 1, At, B1); PG8_BAR;
            PG8_LDA(At, 0, 1); PG8_STAGE(PG8_SA(0, 0), a2, voffA);
            PG8_BAR; PG8_WAIT_L(0); PG8_MMA(1, 0, At, B0); PG8_BAR; PG8_SCHED;
            PG8_STAGE(PG8_SB(0, 1), b2 + hstep, voffB);
            PG8_WAIT_V(6); PG8_BAR; PG8_MMA(1, 1, At, B1); PG8_BAR;
            PG8_LDB(B0, 1, 0); PG8_SCHED; PG8_LDA(At, 1, 0); PG8_STAGE(PG8_SA(0, 1), a2 + hstep, voffA);
            PG8_WAIT_L(8); PG8_BAR; PG8_WAIT_L(0); PG8_MMA(0, 0, At, B0); PG8_BAR; PG8_SCHED;
            PG8_LDB(B1, 1, 1); PG8_STAGE(PG8_SB(1, 0), b3, voffB);
            PG8_BAR; PG8_WAIT_L(0); PG8_MMA(0, 1, At, B1); PG8_BAR;
            PG8_LDA(At, 1, 1); PG8_STAGE(PG8_SA(1, 0), a3, voffA);
            PG8_BAR; PG8_WAIT_L(0); PG8_MMA(1, 0, At, B0); PG8_BAR; PG8_SCHED;
            PG8_STAGE(PG8_SB(1, 1), b3 + hstep, voffB);
            PG8_WAIT_V(6); PG8_BAR; PG8_MMA(1, 1, At, B1); PG8_BAR;
            }
        }
        if constexpr (ALIGN_EPI) { if (wr == 0) PG8_BAR; }
        if constexpr (!Epi::AFTER_DRAIN) { E(acc, cur, wr, wc, fr, fq); S.done(cur); }
        if (!has_next) break;
#pragma unroll
        for (int a = 0; a < 2; ++a)
#pragma unroll
            for (int b = 0; b < 2; ++b)
#pragma unroll
                for (int m = 0; m < 4; ++m)
#pragma unroll
                    for (int n = 0; n < 2; ++n) acc[a][b][m][n] = (f32x4){0.f, 0.f, 0.f, 0.f};
        cur = nxt; cA = nA; cB = nB; ++ui;
        if constexpr (ALIGN_EPI) { if (wr == 1) PG8_BAR; }
    }
    PG8_WAIT_V(0);
    if constexpr (!ALIGN_EPI) { if (wr == 0) PG8_BAR; }
    PG8_BAR;
    if constexpr (Epi::AFTER_DRAIN) { E.fused(acc, cur, wr, wc, fr, fq, lds, wid, lane); S.done(cur); }
#undef PG8_SA
#undef PG8_SB
#undef PG8_STAGE
#undef PG8_LDA
#undef PG8_LDB
#undef PG8_MMA
#undef PG8_WAIT_V
#undef PG8_WAIT_L
#undef PG8_BAR
#undef PG8_SCHED
}
}
#define XB_TMO      128
#define XB_XCNT(j)  (256  + 64 * (j))
#define XB_XSUB(j)  (1280 + 64 * (j))
#define XB_XGEN(j)  (2304 + 64 * (j))
#define XB_TOP      3328
#define XB_TOPGEN   3392
#define XCD_BAR_WORDS 3456
#define XB_SPIN_CAP (1u << 18)
#define LAS __attribute__((address_space(3)))

__device__ __forceinline__ unsigned xb_ld(unsigned* p)              { return __hip_atomic_load(p, __ATOMIC_RELAXED, __HIP_MEMORY_SCOPE_AGENT); }
__device__ __forceinline__ unsigned xb_add(unsigned* p, unsigned v) { return __hip_atomic_fetch_add(p, v, __ATOMIC_RELAXED, __HIP_MEMORY_SCOPE_AGENT); }
__device__ __forceinline__ unsigned xb_xcc_id() { return (unsigned)__builtin_amdgcn_s_getreg((3 << 11) | 20) & 0xFu; }
#define XB_SPIN(cond, bar) do { unsigned _sp = 0; while (cond) { __builtin_amdgcn_s_sleep(1); \
    if ((++_sp & 255u) == 0u) { if (xb_ld(&(bar)[XB_TMO])) break; if (_sp > XB_SPIN_CAP) { atomicAdd(&(bar)[XB_TMO], 1u); break; } } } } while (0)

struct XcdBarrier {
    unsigned* bar; unsigned x;
    volatile LAS unsigned* st;
};

__device__ __forceinline__ XcdBarrier xcd_barrier_post(unsigned* bar, volatile LAS unsigned* st) {
    XcdBarrier b; b.bar = bar; b.x = xb_xcc_id(); b.st = st;
    if (threadIdx.x == 0) (void)xb_add(&bar[XB_XCNT(b.x)], 1u);
    return b;
}
__device__ __forceinline__ void xcd_barrier_complete(unsigned* bar, unsigned x, unsigned& nloc, unsigned& nx) {
    const unsigned G = gridDim.x * gridDim.y * gridDim.z;
    unsigned sum, cnt, mine, sp = 0u;
    for (;;) {
        sum = 0u; cnt = 0u; mine = 0u;
#pragma unroll
        for (unsigned j = 0; j < 16; ++j) { const unsigned c = xb_ld(&bar[XB_XCNT(j)]); sum += c; cnt += (c > 0u) ? 1u : 0u; mine = (j == x) ? c : mine; }
        if (sum == G) break;
        __builtin_amdgcn_s_sleep(1);
        if ((++sp & 255u) == 0u) { if (xb_ld(&bar[XB_TMO])) break; if (sp > XB_SPIN_CAP) { atomicAdd(&bar[XB_TMO], 1u); break; } }
    }
    nloc = mine > 0u ? mine : 1u; nx = cnt > 0u ? cnt : 1u;
}

__device__ __forceinline__ void xcd_barrier(const XcdBarrier& b) {
    asm volatile("s_waitcnt vmcnt(0)" ::: "memory");
    __syncthreads();
    if (threadIdx.x == 0) {
        unsigned* bar = b.bar;
        __builtin_amdgcn_s_waitcnt(0);
        unsigned nloc = b.st[0], nx = b.st[1];
        if (nloc == 0u) { xcd_barrier_complete(bar, b.x, nloc, nx); b.st[0] = nloc; b.st[1] = nx; }
        const unsigned old = xb_add(&bar[XB_XSUB(b.x)], 1u);
        const unsigned gen = old / nloc;
        if (old + 1u == (gen + 1u) * nloc) {
            __builtin_amdgcn_fence(__ATOMIC_RELEASE, "agent");
            asm volatile("s_waitcnt vmcnt(0)" ::: "memory");
            const unsigned og = xb_add(&bar[XB_TOP], 1u);
            const unsigned tg = og / nx;
            if (og + 1u == (tg + 1u) * nx) xb_add(&bar[XB_TOPGEN], 1u);
            else XB_SPIN(xb_ld(&bar[XB_TOPGEN]) == tg, bar);
            __builtin_amdgcn_fence(__ATOMIC_ACQUIRE, "agent");
            xb_add(&bar[XB_XGEN(b.x)], 1u);
            asm volatile("s_waitcnt vmcnt(0)" ::: "memory");
        } else {
            XB_SPIN(xb_ld(&bar[XB_XGEN(b.x)]) == gen, bar);
            __builtin_amdgcn_fence(__ATOMIC_ACQUIRE, "agent");
            asm volatile("s_waitcnt vmcnt(0)" ::: "memory");
        }
    }
    __syncthreads();
}
constexpr int D = 2048, NB = 8, SEQ = 2048, NL = 4, T = NB * SEQ;
constexpr int NCH = SEQ / 64, NCHUNK = T / 64;
constexpr int GKW = 512, RANK = 16;
constexpr int INW = 6160, NP = 6144;
constexpr int NE = 16384;
constexpr float ALPHA = 1.6817928305074290f, EPS = 1e-5f;
constexpr int PQ = 0, PK = 512, PV = 1024, PR = 2048, PCB = 3072, PCC = 4096, PCH = 5120;
constexpr int NWAVES = 8, NTHREADS = 512;
constexpr int NPHASES = 2 + 7 * NL;

constexpr size_t MiB = 1u << 20;
constexpr size_t WS_CTL = 0, CTL_ZERO_BYTES = 1 * MiB;
constexpr size_t WS_MOD = 1 * MiB, WS_PART = 3 * MiB, WS_KEYS = 15 * MiB, WS_DTOT = 17 * MiB, WS_WIN = 18 * MiB, WS_WOUT = 115 * MiB, WS_WQ = 147 * MiB;
constexpr size_t WS_UT = 179 * MiB, WS_VT = 435 * MiB, WS_H = 691 * MiB, WS_PROJ = 755 * MiB, WS_E = 947 * MiB, WS_OGLA = 979 * MiB, WS_Y = 1043 * MiB;
constexpr size_t WS_Z = 1107 * MiB, WS_X1 = 1235 * MiB, WS_X = 1363 * MiB, WS_Q = 1491 * MiB, WS_H2 = 1555 * MiB, WS_HQ8 = 1619 * MiB, WS_END = 1651 * MiB;
constexpr size_t WS_SU = 17 * MiB + 512 * 1024, WS_SV = 17 * MiB + 768 * 1024, WS_HSC = 2 * MiB + 640 * 1024;
static_assert(WS_WIN + (size_t)NL * INW * D * 2 <= WS_WOUT && WS_PART + (size_t)NL * 8 * NB * 6 * D * 4 <= WS_KEYS && WS_MOD + (size_t)NL * NB * 6 * D * 4 <= WS_PART, "ws map");
constexpr int CW_BAR = 4096;

constexpr int RING_OFF = 0, RING_BYTES = 131072, LDSCTL_OFF = RING_BYTES, LDS_BYTES = 147456;

#define GAS __attribute__((address_space(1)))
typedef unsigned short bf16;
typedef unsigned v4u __attribute__((ext_vector_type(4)));
typedef unsigned v2u __attribute__((ext_vector_type(2)));
typedef float f32x4 __attribute__((ext_vector_type(4)));
typedef float f32x16 __attribute__((ext_vector_type(16)));
typedef short bf16x8 __attribute__((ext_vector_type(8)));
typedef __bf16 bf16x2v __attribute__((ext_vector_type(2)));
#define LDS_WAIT() asm volatile("s_waitcnt lgkmcnt(0)" ::: "memory")

__device__ __forceinline__ unsigned pk2(float lo, float hi) { return pg8::cvt_pk_bf16(lo, hi); }
__device__ __forceinline__ float dot2bf(unsigned w, unsigned x, float acc) { return __builtin_amdgcn_fdot2_f32_bf16(__builtin_bit_cast(bf16x2v, w), __builtin_bit_cast(bf16x2v, x), acc, false); }
__device__ __forceinline__ float bflo(unsigned u) { return __uint_as_float(u << 16); }
__device__ __forceinline__ float bfhi(unsigned u) { return __uint_as_float(u & 0xffff0000u); }
__device__ __forceinline__ float silu_f(float x) { return x / (1.0f + __expf(-x)); }
__device__ __forceinline__ float logsigmoid_f(float x) { return fminf(x, 0.0f) - log1pf(__expf(-fabsf(x))); }
__device__ __forceinline__ float gelu_tanh_f(float x) { const float u = 0.7978845608028654f * (x + 0.044715f * x * x * x); return 0.5f * x * (1.0f + tanhf(u)); }
__device__ __forceinline__ float wave_sum(float v) {
#pragma unroll
    for (int o = 1; o < 64; o <<= 1) v += __shfl_xor(v, o);
    return v;
}

struct Args { const float* in[19]; float* out; unsigned char* ws; int ph_lo, ph_hi; };

__device__ __forceinline__ void transpose_item(const float* W, int ldw, int col0, bf16* WTrows, int k0, int nvalid, LAS float* scr, int lane) {
    const int n = lane & 31;
#pragma unroll 8
    for (int i = 0; i < 32; ++i) { const int kk = 2 * i + (lane >> 5); scr[kk * 33 + n] = (n < nvalid) ? W[(size_t)(k0 + kk) * ldw + col0 + n] : 0.f; }
    LDS_WAIT(); asm volatile("" ::: "memory");
    const int c = lane & 7;
#pragma unroll
    for (int j = 0; j < 4; ++j) { const int nn = (lane >> 3) + 8 * j; const LAS float* s = scr + (8 * c) * 33 + nn;
        v4u o; o.x = pk2(s[0 * 33], s[1 * 33]); o.y = pk2(s[2 * 33], s[3 * 33]); o.z = pk2(s[4 * 33], s[5 * 33]); o.w = pk2(s[6 * 33], s[7 * 33]);
        if (nn < nvalid) *(v4u*)(WTrows + (size_t)nn * D + k0 + 8 * c) = o; }
    LDS_WAIT(); asm volatile("" ::: "memory");
}
__device__ __forceinline__ void cvt_stream(const float* src, bf16* dst, size_t n4, size_t i0, size_t stride) {
    for (size_t i = i0; i < n4; i += stride) { const f32x4 v = ((const f32x4*)src)[i]; v2u o; o.x = pk2(v.x, v.y); o.y = pk2(v.z, v.w); ((v2u*)dst)[i] = o; }
}
__device__ __forceinline__ void ph_prologue_a(const Args& a, LAS unsigned char* lds, int tid, int lane, int wave, int bx, int G) {
    const int gw = bx * NWAVES + wave, NGW = G * NWAVES;
    LAS float* cact = (LAS float*)lds;
    for (int i = tid; i < NB * D; i += NTHREADS) { const int b = i / D, d = i % D; cact[d * 8 + b] = silu_f(a.in[1][i]); }
    __syncthreads();
    float* part = (float*)(a.ws + WS_PART);
    for (int it = gw; it < NL * 8 * 48; it += NGW) {
        const int cg = it % 48, dr = (it / 48) % 8, l = it / 384;
        f32x4 acc[8];
#pragma unroll
        for (int b = 0; b < 8; ++b) acc[b] = (f32x4){0.f, 0.f, 0.f, 0.f};
        const float* w = a.in[2] + ((size_t)l * D + dr * 256) * (6 * D) + cg * 256 + lane * 4;
#pragma unroll 4
        for (int d = 0; d < 256; ++d) {
            const f32x4 wv = *(const f32x4*)(w + (size_t)d * (6 * D));
            const f32x4 c0 = *(const LAS f32x4*)(cact + (dr * 256 + d) * 8), c1 = *(const LAS f32x4*)(cact + (dr * 256 + d) * 8 + 4);
            acc[0] += wv * c0.x; acc[1] += wv * c0.y; acc[2] += wv * c0.z; acc[3] += wv * c0.w;
            acc[4] += wv * c1.x; acc[5] += wv * c1.y; acc[6] += wv * c1.z; acc[7] += wv * c1.w;
        }
#pragma unroll
        for (int b = 0; b < 8; ++b) *(f32x4*)(part + (((size_t)l * 8 + dr) * NB + b) * (6 * D) + cg * 256 + lane * 4) = acc[b];
    }
    __syncthreads();
    LAS float* scr = (LAS float*)(lds + wave * 8448);
    bf16* winT = (bf16*)(a.ws + WS_WIN); bf16* woutT = (bf16*)(a.ws + WS_WOUT); bf16* wqT = (bf16*)(a.ws + WS_WQ);
    constexpr int IPL = 6144 + 32 + 2048 + 2048;
    for (int it = gw; it < NL * IPL; it += NGW) {
        const int l = it / IPL; int r = it % IPL;
        if (r < 6144) { const int nb = r % 192, kb = r / 192, n0 = nb * 32;
            transpose_item(a.in[4] + (size_t)l * D * INW, INW, n0 < 3072 ? n0 : n0 + 16, winT + ((size_t)l * INW + n0) * D, kb * 64, 32, scr, lane); continue; }
        r -= 6144;
        if (r < 32) { transpose_item(a.in[4] + (size_t)l * D * INW, INW, 3072, winT + ((size_t)l * INW + NP) * D, r * 64, 16, scr, lane); continue; }
        r -= 32;
        if (r < 2048) { const int nb = r % 64, kb = r / 64; transpose_item(a.in[10] + (size_t)l * D * D, D, nb * 32, woutT + ((size_t)l * D + nb * 32) * D, kb * 64, 32, scr, lane); continue; }
        r -= 2048;
        { const int nb = r % 64, kb = r / 64; transpose_item(a.in[13] + (size_t)l * D * D, D, nb * 32, wqT + ((size_t)l * D + nb * 32) * D, kb * 64, 32, scr, lane); }
    }
    const size_t i0 = (size_t)bx * NTHREADS + tid, stride = (size_t)G * NTHREADS;
    cvt_stream(a.in[14], (bf16*)(a.ws + WS_KEYS), (size_t)NL * 8 * 2 * 128 * 128 / 4, i0, stride);
    for (int row = gw; row < 2 * NL * NE; row += NGW) {
        const int tbl = row / (NL * NE), r = row % (NL * NE);
        const float* src = (tbl ? a.in[16] : a.in[15]) + (size_t)r * D;
        f32x4 v[8]; float mx = 0.f;
#pragma unroll
        for (int c8 = 0; c8 < 8; ++c8) { v[c8] = *(const f32x4*)(src + (c8 * 64 + lane) * 4); mx = fmaxf(mx, fmaxf(fmaxf(fabsf(v[c8].x), fabsf(v[c8].y)), fmaxf(fabsf(v[c8].z), fabsf(v[c8].w)))); }
#pragma unroll
        for (int o = 1; o < 64; o <<= 1) mx = fmaxf(mx, __shfl_xor(mx, o));
        const float inv = mx > 0.f ? 127.0f / mx : 0.f; const int off = tbl ? 128 : 0;
        unsigned dw[8];
#pragma unroll
        for (int c8 = 0; c8 < 8; ++c8) { const int q0 = (int)__builtin_rintf(v[c8].x * inv) + off, q1 = (int)__builtin_rintf(v[c8].y * inv) + off, q2 = (int)__builtin_rintf(v[c8].z * inv) + off, q3 = (int)__builtin_rintf(v[c8].w * inv) + off;
            dw[c8] = (unsigned)(q0 & 255) | ((unsigned)(q1 & 255) << 8) | ((unsigned)(q2 & 255) << 16) | ((unsigned)(q3 & 255) << 24); }
        unsigned char* dst = a.ws + (tbl ? WS_VT : WS_UT) + (size_t)r * D;
        *(v4u*)(dst + lane * 16) = (v4u){dw[0], dw[1], dw[2], dw[3]}; *(v4u*)(dst + (64 + lane) * 16) = (v4u){dw[4], dw[5], dw[6], dw[7]};
        if (lane == 0) ((float*)(a.ws + (tbl ? WS_SV : WS_SU)))[r] = mx * (1.0f / 127.0f);
    }
}

__device__ __forceinline__ void ln_tail(const float (&z)[32], int t, int lane, const float* g, const float* bta, float* xout, const float* sh, const float* sc, bf16* hout, unsigned char* q8, float* q8s) {
    float s = 0.f;
#pragma unroll
    for (int i = 0; i < 32; ++i) s += z[i];
    const float mu = wave_sum(s) * (1.0f / D);
    float q = 0.f;
#pragma unroll
    for (int i = 0; i < 32; ++i) { const float d = z[i] - mu; q += d * d; }
    const float rs = rsqrtf(wave_sum(q) * (1.0f / D) + EPS);
    float hv[32]; float mx = 0.f;
#pragma unroll
    for (int c = 0; c < 8; ++c) { const int col = (c * 64 + lane) * 4;
        const f32x4 g0 = *(const f32x4*)(g + col), b0 = *(const f32x4*)(bta + col);
        f32x4 x0;
        x0.x = (z[c * 4 + 0] - mu) * rs * g0.x + b0.x; x0.y = (z[c * 4 + 1] - mu) * rs * g0.y + b0.y; x0.z = (z[c * 4 + 2] - mu) * rs * g0.z + b0.z; x0.w = (z[c * 4 + 3] - mu) * rs * g0.w + b0.w;
        if (xout) *(f32x4*)(xout + (size_t)t * D + col) = x0;
        if (hout) { const f32x4 s0 = *(const f32x4*)(sc + col), h0 = *(const f32x4*)(sh + col);
            hv[c * 4] = x0.x * (1.f + s0.x) + h0.x; hv[c * 4 + 1] = x0.y * (1.f + s0.y) + h0.y; hv[c * 4 + 2] = x0.z * (1.f + s0.z) + h0.z; hv[c * 4 + 3] = x0.w * (1.f + s0.w) + h0.w;
            v2u o; o.x = pk2(hv[c * 4], hv[c * 4 + 1]); o.y = pk2(hv[c * 4 + 2], hv[c * 4 + 3]);
            *(v2u*)(hout + (size_t)t * D + col) = o;
            if (q8) {
                hv[c * 4] = bflo(o.x); hv[c * 4 + 1] = bfhi(o.x); hv[c * 4 + 2] = bflo(o.y); hv[c * 4 + 3] = bfhi(o.y);
                mx = fmaxf(mx, fmaxf(fmaxf(fabsf(hv[c * 4]), fabsf(hv[c * 4 + 1])), fmaxf(fabsf(hv[c * 4 + 2]), fabsf(hv[c * 4 + 3])))); } }
    }
    if (q8) {
#pragma unroll
        for (int o = 1; o < 64; o <<= 1) mx = fmaxf(mx, __shfl_xor(mx, o));
        const float inv = mx > 0.f ? 127.0f / mx : 0.f;
        unsigned dw[8];
#pragma unroll
        for (int c = 0; c < 8; ++c) { const int q0 = (int)__builtin_rintf(hv[c * 4] * inv), q1 = (int)__builtin_rintf(hv[c * 4 + 1] * inv), q2 = (int)__builtin_rintf(hv[c * 4 + 2] * inv), q3 = (int)__builtin_rintf(hv[c * 4 + 3] * inv);
            dw[c] = (unsigned)(q0 & 255) | ((unsigned)(q1 & 255) << 8) | ((unsigned)(q2 & 255) << 16) | ((unsigned)(q3 & 255) << 24); }
        unsigned char* dst = q8 + (size_t)t * D;
        *(v4u*)(dst + lane * 16) = (v4u){dw[0], dw[1], dw[2], dw[3]}; *(v4u*)(dst + (64 + lane) * 16) = (v4u){dw[4], dw[5], dw[6], dw[7]};
        if (lane == 0) q8s[t] = mx * (1.0f / 127.0f);
    }
}

__device__ __forceinline__ void ph_prologue_b(const Args& a, LAS unsigned char* lds, int tid, int lane, int wave, int bx, int G) {
    const float* part = (const float*)(a.ws + WS_PART); float* mod = (float*)(a.ws + WS_MOD);
    for (int i = bx * NTHREADS + tid; i < NL * NB * 6 * D / 4; i += G * NTHREADS) {
        const int idx = i * 4, e = idx % (6 * D), b = (idx / (6 * D)) % NB, l = idx / (6 * D * NB);
        f32x4 s = *(const f32x4*)(a.in[3] + l * 6 * D + e);
#pragma unroll
        for (int dr = 0; dr < 8; ++dr) s += *(const f32x4*)(part + (((size_t)l * 8 + dr) * NB + b) * (6 * D) + e);
        *(f32x4*)(mod + idx) = s;
    }
    LAS float* msh = (LAS float*)lds;
    bf16* hbuf = (bf16*)(a.ws + WS_H);
    for (int ch = bx; ch < NCHUNK; ch += G) {
        const int b = ch / NCH;
        for (int i = tid; i < 1024; i += NTHREADS) { const int e = i * 4;
            f32x4 s = *(const f32x4*)(a.in[3] + e);
#pragma unroll
            for (int dr = 0; dr < 8; ++dr) s += *(const f32x4*)(part + (((size_t)0 * 8 + dr) * NB + b) * (6 * D) + e);
            *(LAS f32x4*)(msh + e) = s; }
        __syncthreads();
        for (int i = 0; i < 8; ++i) { const int t = ch * 64 + wave * 8 + i;
#pragma unroll
            for (int c = 0; c < 4; ++c) { const int col = (c * 64 + lane) * 8;
                const f32x4 x0 = *(const f32x4*)(a.in[0] + (size_t)t * D + col), x1 = *(const f32x4*)(a.in[0] + (size_t)t * D + col + 4);
                const f32x4 h0 = *(const LAS f32x4*)(msh + col), h1 = *(const LAS f32x4*)(msh + col + 4), s0 = *(const LAS f32x4*)(msh + 2048 + col), s1 = *(const LAS f32x4*)(msh + 2048 + col + 4);
                v4u o; o.x = pk2(x0.x * (1.f + s0.x) + h0.x, x0.y * (1.f + s0.y) + h0.y); o.y = pk2(x0.z * (1.f + s0.z) + h0.z, x0.w * (1.f + s0.w) + h0.w);
                o.z = pk2(x1.x * (1.f + s1.x) + h1.x, x1.y * (1.f + s1.y) + h1.y); o.w = pk2(x1.z * (1.f + s1.z) + h1.z, x1.w * (1.f + s1.w) + h1.w);
                *(v4u*)(hbuf + (size_t)t * D + col) = o; } }
        __syncthreads();
    }
}

__device__ __forceinline__ void gate_prep(const Args& a, int l, LAS unsigned char* lds, int tid, int lane, int wave, int ch) {
    const bf16* hbuf = (const bf16*)(a.ws + WS_H); const bf16* waT = (const bf16*)(a.ws + WS_WIN) + ((size_t)l * INW + NP) * D;
    float* Ebuf = (float*)(a.ws + WS_E); float* dtot = (float*)(a.ws + WS_DTOT);
    const int t0 = ch * 64, l15 = lane & 15, lq = lane >> 4, mt = wave & 3, kh = wave >> 2;
    f32x4 acc = (f32x4){0.f, 0.f, 0.f, 0.f};
    const bf16* hA = hbuf + (size_t)(t0 + 16 * mt + l15) * D + kh * 1024 + 8 * lq;
    const bf16* wB = waT + (size_t)l15 * D + kh * 1024 + 8 * lq;
#pragma unroll 8
    for (int ks = 0; ks < 32; ++ks) { const bf16x8 av = *(const bf16x8*)(hA + 32 * ks), bv = *(const bf16x8*)(wB + 32 * ks); acc = __builtin_amdgcn_mfma_f32_16x16x32_bf16(av, bv, acc, 0, 0, 0); }
    LAS float* alr = (LAS float*)lds;
#pragma unroll
    for (int r = 0; r < 4; ++r) alr[(kh * 64 + 16 * mt + 4 * lq + r) * 16 + l15] = acc[r];
    __syncthreads();
    const int col = tid;
    float wg[16];
#pragma unroll
    for (int r = 0; r < 16; ++r) wg[r] = a.in[5][((size_t)l * RANK + r) * GKW + col];
    const float bgc = a.in[6][l * GKW + col];
    float tot = 0.f;
    for (int j = 0; j < 64; ++j) { float lg = bgc;
#pragma unroll
        for (int r4 = 0; r4 < 4; ++r4) { const f32x4 p = *(const LAS f32x4*)(alr + j * 16 + r4 * 4), q = *(const LAS f32x4*)(alr + (64 + j) * 16 + r4 * 4);
            lg += (p.x + q.x) * wg[r4 * 4] + (p.y + q.y) * wg[r4 * 4 + 1] + (p.z + q.z) * wg[r4 * 4 + 2] + (p.w + q.w) * wg[r4 * 4 + 3]; }
        tot += logsigmoid_f(lg) * (1.0f / 16.0f); }
    float run = 0.f;
    for (int j = 0; j < 64; ++j) { float lg = bgc;
#pragma unroll
        for (int r4 = 0; r4 < 4; ++r4) { const f32x4 p = *(const LAS f32x4*)(alr + j * 16 + r4 * 4), q = *(const LAS f32x4*)(alr + (64 + j) * 16 + r4 * 4);
            lg += (p.x + q.x) * wg[r4 * 4] + (p.y + q.y) * wg[r4 * 4 + 1] + (p.z + q.z) * wg[r4 * 4 + 2] + (p.w + q.w) * wg[r4 * 4 + 3]; }
        run += logsigmoid_f(lg) * (1.0f / 16.0f);
        Ebuf[(size_t)(t0 + j) * GKW + col] = __expf(tot - run); }
    dtot[(size_t)ch * GKW + col] = __expf(tot);
    __syncthreads();
}

__device__ __forceinline__ void gla_unit(const Args& a, LAS unsigned char* lds, int tid, int lane, int wave, int un) {
    const bf16* proj = (const bf16*)(a.ws + WS_PROJ); const float* Ebuf = (const float*)(a.ws + WS_E); const float* dtot = (const float*)(a.ws + WS_DTOT); float* ogla = (float*)(a.ws + WS_OGLA);
    const int dvs = un & 7, hh = (un >> 3) & 3, b = un >> 5;
    LAS bf16* kdT = (LAS bf16*)lds;
    LAS bf16* vT = (LAS bf16*)(lds + 18432);
    LAS bf16* ST = (LAS bf16*)(lds + 18432 + 4608);
    const int l15 = lane & 15, lq = lane >> 4, jl = tid >> 3, d16 = (tid & 7) * 16, dv4 = (tid & 7) * 4, jt = (wave & 3) * 16, dvt = (wave >> 2) * 16;
    f32x4 S0 = (f32x4){0.f, 0.f, 0.f, 0.f}, S1 = (f32x4){0.f, 0.f, 0.f, 0.f};
    v4u kn0[2], kn1[2]; f32x4 en0[4], en1[4]; v2u vn0, vn1; bf16x8 qn0[4], qn1[4], qc[4]; f32x4 dn0, dn1, dc;
#define GLA_LOAD(c, kn, en, vn, qn, dn) do { const int t0c = b * SEQ + (c) * 64; const bf16* pr = proj + (size_t)(t0c + jl) * NP; \
        kn[0] = *(const v4u*)(pr + PK + hh * 128 + d16); kn[1] = *(const v4u*)(pr + PK + hh * 128 + d16 + 8); \
        _Pragma("unroll") for (int i_ = 0; i_ < 4; ++i_) en[i_] = *(const f32x4*)(Ebuf + (size_t)(t0c + jl) * GKW + hh * 128 + d16 + 4 * i_); \
        vn = *(const v2u*)(pr + PV + hh * 256 + dvs * 32 + dv4); \
        _Pragma("unroll") for (int ks_ = 0; ks_ < 4; ++ks_) qn[ks_] = *(const bf16x8*)(proj + (size_t)(t0c + jt + l15) * NP + PQ + hh * 128 + 32 * ks_ + 8 * lq); \
        dn = *(const f32x4*)(dtot + (size_t)(b * NCH + (c)) * GKW + hh * 128 + 16 * wave + 4 * lq); } while (0)
#define GLA_PREP(kn, en, vn, qn, dn) do { \
        _Pragma("unroll") for (int i_ = 0; i_ < 16; ++i_) { const unsigned w_ = kn[i_ >> 3][(i_ & 7) >> 1]; const float kf_ = (i_ & 1) ? bfhi(w_) : bflo(w_); \
            kdT[(d16 + i_) * 72 + jl] = (bf16)(pk2(kf_ * en[i_ >> 2][i_ & 3], 0.f) & 0xffffu); } \
        _Pragma("unroll") for (int i_ = 0; i_ < 4; ++i_) { const unsigned w_ = vn[i_ >> 1]; vT[(dv4 + i_) * 72 + jl] = (bf16)((i_ & 1) ? (w_ >> 16) : (w_ & 0xffffu)); } \
        _Pragma("unroll") for (int ks_ = 0; ks_ < 4; ++ks_) qc[ks_] = qn[ks_]; \
        dc = dn; } while (0)
#define GLA_BODY(c) do { \
        S0 = S0 * dc; S1 = S1 * dc; \
        _Pragma("unroll") for (int ks = 0; ks < 2; ++ks) { \
            const bf16x8 A_ = *(const LAS bf16x8*)(kdT + (16 * wave + l15) * 72 + 32 * ks + 8 * lq); \
            const bf16x8 B0_ = *(const LAS bf16x8*)(vT + l15 * 72 + 32 * ks + 8 * lq), B1_ = *(const LAS bf16x8*)(vT + (16 + l15) * 72 + 32 * ks + 8 * lq); \
            S0 = __builtin_amdgcn_mfma_f32_16x16x32_bf16(A_, B0_, S0, 0, 0, 0); S1 = __builtin_amdgcn_mfma_f32_16x16x32_bf16(A_, B1_, S1, 0, 0, 0); } \
        { v2u w0_, w1_; w0_.x = pk2(S0.x, S0.y); w0_.y = pk2(S0.z, S0.w); w1_.x = pk2(S1.x, S1.y); w1_.y = pk2(S1.z, S1.w); \
          *(LAS v2u*)(ST + l15 * 136 + 16 * wave + 4 * lq) = w0_; *(LAS v2u*)(ST + (16 + l15) * 136 + 16 * wave + 4 * lq) = w1_; } \
        __syncthreads(); \
        f32x4 O_ = (f32x4){0.f, 0.f, 0.f, 0.f}; \
        _Pragma("unroll") for (int ks = 0; ks < 4; ++ks) { const bf16x8 A_ = *(const LAS bf16x8*)(ST + (dvt + l15) * 136 + 32 * ks + 8 * lq); O_ = __builtin_amdgcn_mfma_f32_16x16x32_bf16(A_, qc[ks], O_, 0, 0, 0); } \
        *(f32x4*)(ogla + (size_t)(b * SEQ + (c) * 64 + jt + l15) * 1024 + hh * 256 + dvs * 32 + dvt + 4 * lq) = O_ * 0.08838834764831845f; } while (0)
    GLA_LOAD(0, kn0, en0, vn0, qn0, dn0); GLA_LOAD(1, kn1, en1, vn1, qn1, dn1);
    GLA_PREP(kn0, en0, vn0, qn0, dn0);
    __syncthreads();
    for (int c = 0; c < NCH; c += 2) {
        if (c + 2 < NCH) GLA_LOAD(c + 2, kn0, en0, vn0, qn0, dn0);
        GLA_BODY(c);
        GLA_PREP(kn1, en1, vn1, qn1, dn1);
        __syncthreads();
        if (c + 3 < NCH) GLA_LOAD(c + 3, kn1, en1, vn1, qn1, dn1);
        GLA_BODY(c + 1);
        if (c + 2 < NCH) GLA_PREP(kn0, en0, vn0, qn0, dn0);
        __syncthreads();
    }
#undef GLA_BODY
#undef GLA_LOAD
#undef GLA_PREP
}

__device__ __forceinline__ void unpack16(const v4u& p0, const v4u& p1, float (&o)[16]) {
#pragma unroll
    for (int j = 0; j < 4; ++j) { o[2 * j] = bflo(p0[j]); o[2 * j + 1] = bfhi(p0[j]); o[8 + 2 * j] = bflo(p1[j]); o[8 + 2 * j + 1] = bfhi(p1[j]); }
}
__device__ __forceinline__ void mixpost_chunk(const Args& a, int l, int lane, int wave, int ch) {
    const bf16* proj = (const bf16*)(a.ws + WS_PROJ); const float* ogla = (const float*)(a.ws + WS_OGLA); bf16* ybuf = (bf16*)(a.ws + WS_Y);
    const int c0 = 16 * lane, tfirst = ch * 64 + wave * 8, sfirst = tfirst % SEQ;
    float gn[16], cw0[16], cw1[16], cw2[16], cn[16], u1[16], u2[16];
#pragma unroll
    for (int i = 0; i < 16; ++i) { gn[i] = a.in[7][l * 256 + ((c0 + i) & 255)]; cw0[i] = a.in[8][(size_t)l * 3072 + c0 + i]; cw1[i] = a.in[8][(size_t)l * 3072 + 1024 + c0 + i];
        cw2[i] = a.in[8][(size_t)l * 3072 + 2048 + c0 + i]; cn[i] = a.in[9][l * 1024 + c0 + i]; u1[i] = 0.f; u2[i] = 0.f; }
    if (sfirst >= 2) {
        float cc[16], chh[16];
        { const bf16* pr = proj + (size_t)(tfirst - 2) * NP; unpack16(*(const v4u*)(pr + PCC + c0), *(const v4u*)(pr + PCC + c0 + 8), cc); unpack16(*(const v4u*)(pr + PCH + c0), *(const v4u*)(pr + PCH + c0 + 8), chh); }
#pragma unroll
        for (int i = 0; i < 16; ++i) u2[i] = cc[i] * chh[i];
        { const bf16* pr = proj + (size_t)(tfirst - 1) * NP; unpack16(*(const v4u*)(pr + PCC + c0), *(const v4u*)(pr + PCC + c0 + 8), cc); unpack16(*(const v4u*)(pr + PCH + c0), *(const v4u*)(pr + PCH + c0 + 8), chh); }
#pragma unroll
        for (int i = 0; i < 16; ++i) u1[i] = cc[i] * chh[i];
    }
#pragma unroll 2
    for (int it = 0; it < 8; ++it) { const int t = tfirst + it; const bf16* pr = proj + (size_t)t * NP;
        float o[16], r[16], cb[16], cc[16], chh[16];
#pragma unroll
        for (int j = 0; j < 4; ++j) { const f32x4 v = *(const f32x4*)(ogla + (size_t)t * 1024 + c0 + 4 * j); o[4 * j] = v.x; o[4 * j + 1] = v.y; o[4 * j + 2] = v.z; o[4 * j + 3] = v.w; }
        unpack16(*(const v4u*)(pr + PR + c0), *(const v4u*)(pr + PR + c0 + 8), r);
        unpack16(*(const v4u*)(pr + PCB + c0), *(const v4u*)(pr + PCB + c0 + 8), cb);
        unpack16(*(const v4u*)(pr + PCC + c0), *(const v4u*)(pr + PCC + c0 + 8), cc);
        unpack16(*(const v4u*)(pr + PCH + c0), *(const v4u*)(pr + PCH + c0 + 8), chh);
        float ss = 0.f;
#pragma unroll
        for (int i = 0; i < 16; ++i) ss += o[i] * o[i];
        ss += __shfl_xor(ss, 1); ss += __shfl_xor(ss, 2); ss += __shfl_xor(ss, 4); ss += __shfl_xor(ss, 8);
        const float rg = rsqrtf(ss * (1.0f / 256.f) + EPS);
        float val[16]; float s2 = 0.f;
#pragma unroll
        for (int i = 0; i < 16; ++i) { const float u0 = cc[i] * chh[i]; val[i] = cb[i] * (cw0[i] * u2[i] + cw1[i] * u1[i] + cw2[i] * u0); s2 += val[i] * val[i]; u2[i] = u1[i]; u1[i] = u0; }
        const float rc = rsqrtf(wave_sum(s2) * (1.0f / 1024.f) + EPS);
        v4u y0, y1, y2, y3;
#pragma unroll
        for (int j = 0; j < 4; ++j) {
            y0[j] = pk2(o[2 * j] * rg * gn[2 * j] * silu_f(r[2 * j]), o[2 * j + 1] * rg * gn[2 * j + 1] * silu_f(r[2 * j + 1]));
            y1[j] = pk2(o[8 + 2 * j] * rg * gn[8 + 2 * j] * silu_f(r[8 + 2 * j]), o[9 + 2 * j] * rg * gn[9 + 2 * j] * silu_f(r[9 + 2 * j]));
            y2[j] = pk2(val[2 * j] * rc * cn[2 * j], val[2 * j + 1] * rc * cn[2 * j + 1]);
            y3[j] = pk2(val[8 + 2 * j] * rc * cn[8 + 2 * j], val[9 + 2 * j] * rc * cn[9 + 2 * j]); }
        bf16* yr = ybuf + (size_t)t * D;
        *(v4u*)(yr + c0) = y0; *(v4u*)(yr + c0 + 8) = y1; *(v4u*)(yr + 1024 + c0) = y2; *(v4u*)(yr + 1024 + c0 + 8) = y3;
    }
}

__device__ __forceinline__ void ln1_chunk(const Args& a, int l, int lane, int wave, int ch) {
    const float* zbuf = (const float*)(a.ws + WS_Z); const float* mod = (const float*)(a.ws + WS_MOD);
    const int b = ch / NCH; const float* mb = mod + ((size_t)l * NB + b) * 6 * D;
#pragma unroll 2
    for (int it = 0; it < 8; ++it) { const int t = ch * 64 + wave * 8 + it;
        float z[32];
#pragma unroll
        for (int c = 0; c < 8; ++c) { const f32x4 v0 = *(const f32x4*)(zbuf + (size_t)t * D + (c * 64 + lane) * 4); z[c * 4] = v0.x; z[c * 4 + 1] = v0.y; z[c * 4 + 2] = v0.z; z[c * 4 + 3] = v0.w; }
        ln_tail(z, t, lane, a.in[11] + (size_t)l * D, a.in[12] + (size_t)l * D, (float*)(a.ws + WS_X1), mb + 3 * D, mb + 4 * D, (bf16*)(a.ws + WS_H2), a.ws + WS_HQ8, (float*)(a.ws + WS_HSC));
    }
}

template <int N> __device__ __forceinline__ void bitonic_sort_desc(float (&v)[N]) {
#pragma unroll
    for (int k = 2; k <= N; k <<= 1)
#pragma unroll
        for (int j = k >> 1; j > 0; j >>= 1)
#pragma unroll
            for (int i = 0; i < N; ++i) { const int p = i ^ j; if (p > i) { const bool desc = ((i & k) == 0); const float x = v[i], y = v[p]; const float mx = fmaxf(x, y), mn = fminf(x, y); v[i] = desc ? mx : mn; v[p] = desc ? mn : mx; } }
}
__device__ __forceinline__ void merge_top16(float (&x)[16], const float (&y)[16]) {
#pragma unroll
    for (int i = 0; i < 16; ++i) x[i] = fmaxf(x[i], y[15 - i]);
#pragma unroll
    for (int j = 8; j > 0; j >>= 1)
#pragma unroll
        for (int i = 0; i < 16; ++i) { const int p = i ^ j; if (p > i) { const float u = x[i], w = x[p]; x[i] = fmaxf(u, w); x[p] = fminf(u, w); } }
}
__device__ __forceinline__ void ce_desc(float& ka, int& pa, float& kb, int& pb) { const bool sw = kb > ka; const float k0 = sw ? kb : ka, k1 = sw ? ka : kb; const int p0 = sw ? pb : pa, p1 = sw ? pa : pb; ka = k0; pa = p0; kb = k1; pb = p1; }
__device__ __forceinline__ void bitonic_sort_desc_kp(float (&k)[16], int (&p)[16]) {
#pragma unroll
    for (int kk = 2; kk <= 16; kk <<= 1)
#pragma unroll
        for (int j = kk >> 1; j > 0; j >>= 1)
#pragma unroll
            for (int i = 0; i < 16; ++i) { const int q = i ^ j; if (q > i) { if ((i & kk) == 0) ce_desc(k[i], p[i], k[q], p[q]); else ce_desc(k[q], p[q], k[i], p[i]); } }
}
__device__ __forceinline__ void merge_top16_kp(float (&k)[16], int (&p)[16], const float (&k2)[16], const int (&p2)[16]) {
#pragma unroll
    for (int i = 0; i < 16; ++i) { const bool sw = k2[15 - i] > k[i]; k[i] = sw ? k2[15 - i] : k[i]; p[i] = sw ? p2[15 - i] : p[i]; }
#pragma unroll
    for (int j = 8; j > 0; j >>= 1)
#pragma unroll
        for (int i = 0; i < 16; ++i) { const int q = i ^ j; if (q > i) ce_desc(k[i], p[i], k[q], p[q]); }
}
__device__ constexpr int cand_i(int s) { return s < 16 ? 0 : s < 24 ? 1 : s < 29 ? 2 : s < 33 ? 3 : s < 36 ? 4 : s < 38 ? 5 : s < 40 ? 6 : s < 42 ? 7 : s < 50 ? s - 34 : -1; }
__device__ constexpr int cand_j(int s) { return s < 16 ? s : s < 24 ? s - 16 : s < 29 ? s - 24 : s < 33 ? s - 29 : s < 36 ? s - 33 : s < 38 ? s - 36 : s < 40 ? s - 38 : s < 42 ? s - 40 : s < 50 ? 0 : -1; }

__device__ __forceinline__ void peer_retrieve(const Args& a, int l, LAS unsigned char* lds, int lane, int wave, int ch) {
    const bf16* qbuf = (const bf16*)(a.ws + WS_Q); const bf16* keys = (const bf16*)(a.ws + WS_KEYS) + ((size_t)(l * 8 + wave) * 2) * 128 * 128;
    LAS int* eg_e = (LAS int*)lds; LAS float* eg_g = (LAS float*)(lds + 32768);
    const int l31 = lane & 31, l5 = lane >> 5, h = wave, t0 = ch * 64;
    for (int tt = 0; tt < 2; ++tt) {
        float sv[2][16];
#pragma unroll
        for (int p = 0; p < 2; ++p) {
            f32x16 acc[4];
#pragma unroll
            for (int nt = 0; nt < 4; ++nt)
#pragma unroll
                for (int r = 0; r < 16; ++r) acc[nt][r] = 0.f;
            const bf16* qp = qbuf + (size_t)(t0 + 32 * tt + l31) * D + h * 256 + p * 128 + 8 * l5;
            const bf16* kp = keys + (size_t)(p * 128 + l31) * 128 + 8 * l5;
#pragma unroll 2
            for (int ks = 0; ks < 8; ++ks) { const bf16x8 bq = *(const bf16x8*)(qp + 16 * ks);
#pragma unroll
                for (int nt = 0; nt < 4; ++nt) { const bf16x8 ak = *(const bf16x8*)(kp + (size_t)(32 * nt) * 128 + 16 * ks); acc[nt] = __builtin_amdgcn_mfma_f32_32x32x16_bf16(ak, bq, acc[nt], 0, 0, 0); } }
            float v[4][16];
#pragma unroll
            for (int nt = 0; nt < 4; ++nt)
#pragma unroll
                for (int r = 0; r < 16; ++r) { const unsigned idx = 32u * nt + (r & 3) + 8u * (r >> 2) + 4u * l5; v[nt][r] = __uint_as_float((__float_as_uint(acc[nt][r]) & 0xffffff80u) | idx); }
#pragma unroll
            for (int nt = 0; nt < 4; ++nt) bitonic_sort_desc<16>(v[nt]);
            merge_top16(v[0], v[1]); merge_top16(v[2], v[3]); merge_top16(v[0], v[2]);
            float o[16];
#pragma unroll
            for (int i = 0; i < 16; ++i) o[i] = __shfl_xor(v[0][i], 32);
            merge_top16(v[0], o);
#pragma unroll
            for (int i = 0; i < 16; ++i) sv[p][i] = v[0][i];
        }
        LAS unsigned char* idxb = (LAS unsigned char*)(lds + 69632) + wave * 2048 + lane * 32;
        { v4u w0, w1;
#pragma unroll
          for (int q4 = 0; q4 < 4; ++q4) {
              w0[q4] = (__float_as_uint(sv[0][4 * q4]) & 127u) | ((__float_as_uint(sv[0][4 * q4 + 1]) & 127u) << 8) | ((__float_as_uint(sv[0][4 * q4 + 2]) & 127u) << 16) | ((__float_as_uint(sv[0][4 * q4 + 3]) & 127u) << 24);
              w1[q4] = (__float_as_uint(sv[1][4 * q4]) & 127u) | ((__float_as_uint(sv[1][4 * q4 + 1]) & 127u) << 8) | ((__float_as_uint(sv[1][4 * q4 + 2]) & 127u) << 16) | ((__float_as_uint(sv[1][4 * q4 + 3]) & 127u) << 24); }
          *(LAS v4u*)(idxb) = w0; *(LAS v4u*)(idxb + 16) = w1; }
        float ck[4][16];
#pragma unroll
        for (int s = 0; s < 64; ++s) {
            if (cand_i(s) >= 0) { const unsigned b0 = __float_as_uint(sv[0][cand_i(s) < 0 ? 0 : cand_i(s)]), b1 = __float_as_uint(sv[1][cand_j(s) < 0 ? 0 : cand_j(s)]);
                const float sum = __uint_as_float(b0 & 0xffffff80u) + __uint_as_float(b1 & 0xffffff80u);
                ck[s >> 4][s & 15] = __uint_as_float((__float_as_uint(sum) & 0xffffff00u) | (unsigned)((cand_i(s) < 0 ? 0 : cand_i(s)) * 16 + (cand_j(s) < 0 ? 0 : cand_j(s)))); }
            else ck[s >> 4][s & 15] = -3.0e38f; }
        bitonic_sort_desc<16>(ck[1]); bitonic_sort_desc<16>(ck[2]);
        merge_top16(ck[0], ck[1]); merge_top16(ck[2], ck[3]); merge_top16(ck[0], ck[2]);
        LDS_WAIT(); asm volatile("" ::: "memory");
        float ex[16]; int ce[16]; float den = 0.f;
        const float cmax = __uint_as_float(__float_as_uint(ck[0][0]) & 0xffffff00u);
#pragma unroll
        for (int i = 0; i < 16; ++i) { const unsigned bits = __float_as_uint(ck[0][i]); ex[i] = __expf(__uint_as_float(bits & 0xffffff00u) - cmax); den += ex[i];
            ce[i] = (int)idxb[(bits >> 4) & 15u] * 128 + (int)idxb[16 + (bits & 15u)]; }
        const float inv = 1.0f / den;
        if (l5 == 0) {
            const int base = (32 * tt + l31) * 128 + h * 16;
#pragma unroll
            for (int i4 = 0; i4 < 4; ++i4) { *(LAS v4u*)(eg_e + base + 4 * i4) = (v4u){(unsigned)ce[4 * i4], (unsigned)ce[4 * i4 + 1], (unsigned)ce[4 * i4 + 2], (unsigned)ce[4 * i4 + 3]};
                *(LAS f32x4*)(eg_g + base + 4 * i4) = (f32x4){ex[4 * i4] * inv, ex[4 * i4 + 1] * inv, ex[4 * i4 + 2] * inv, ex[4 * i4 + 3] * inv}; }
        }
        LDS_WAIT(); asm volatile("" ::: "memory");
    }
}

typedef unsigned char uc4 __attribute__((ext_vector_type(4)));
constexpr int NSLICE = 16, SLICE_SHIFT = 10;
__device__ __forceinline__ int sdot4i(unsigned w, unsigned x, int acc) { return __builtin_amdgcn_sdot4((int)w, (int)x, acc, false); }
__device__ __forceinline__ void fma_ub4(unsigned w, float s, float& y0, float& y1, float& y2, float& y3) { const uc4 b = __builtin_bit_cast(uc4, w); y0 += s * (float)b.x; y1 += s * (float)b.y; y2 += s * (float)b.z; y3 += s * (float)b.w; }
__device__ __forceinline__ void peer_tail(const Args& a, int l, int t, int lane, const float* Yrow, const float* mb, const float* mbn, bool last) {
    const float* x1buf = (const float*)(a.ws + WS_X1);
    float z[32];
#pragma unroll
    for (int c = 0; c < 2; ++c)
#pragma unroll
        for (int k = 0; k < 4; ++k) { const int c8 = 4 * c + k, col = (c8 * 64 + lane) * 4;
            const f32x4 yv = *(const f32x4*)(Yrow + (c * 64 + lane) * 16 + 4 * k), x0 = *(const f32x4*)(x1buf + (size_t)t * D + col), g0 = *(const f32x4*)(mb + 5 * D + col);
            z[c8 * 4] = ALPHA * x0.x + (1.f + g0.x) * yv.x; z[c8 * 4 + 1] = ALPHA * x0.y + (1.f + g0.y) * yv.y; z[c8 * 4 + 2] = ALPHA * x0.z + (1.f + g0.z) * yv.z; z[c8 * 4 + 3] = ALPHA * x0.w + (1.f + g0.w) * yv.w; }
    ln_tail(z, t, lane, a.in[17] + (size_t)l * D, a.in[18] + (size_t)l * D, last ? a.out : (float*)(a.ws + WS_X), mbn, mbn + D, last ? (bf16*)nullptr : (bf16*)(a.ws + WS_H), nullptr, nullptr);
}
template <class TT, int M> __device__ __forceinline__ void treduce16(TT (&v)[16], int lane) {
    const bool c0 = (lane & M) != 0, c1 = (lane & (2 * M)) != 0, c2 = (lane & (4 * M)) != 0;
#pragma unroll
    for (int m = 0; m < 8; ++m) { const TT keep = c0 ? v[2 * m + 1] : v[2 * m], send = c0 ? v[2 * m] : v[2 * m + 1]; v[m] = keep + __shfl_xor(send, M); }
#pragma unroll
    for (int m = 0; m < 4; ++m) { const TT keep = c1 ? v[2 * m + 1] : v[2 * m], send = c1 ? v[2 * m] : v[2 * m + 1]; v[m] = keep + __shfl_xor(send, 2 * M); }
#pragma unroll
    for (int m = 0; m < 2; ++m) { const TT keep = c2 ? v[2 * m + 1] : v[2 * m], send = c2 ? v[2 * m] : v[2 * m + 1]; v[m] = keep + __shfl_xor(send, 4 * M); }
}
__device__ __forceinline__ void peer_experts(const Args& a, int l, LAS unsigned char* lds, int lane0, int wave, int ch) {
    const float* mod = (const float*)(a.ws + WS_MOD);
    const unsigned char* ut = a.ws + WS_UT + (size_t)l * NE * D; const unsigned char* vt = a.ws + WS_VT + (size_t)l * NE * D; const unsigned char* hq8 = a.ws + WS_HQ8;
    const float* su = (const float*)(a.ws + WS_SU) + (size_t)l * NE; const float* sv = (const float*)(a.ws + WS_SV) + (size_t)l * NE; const float* hsc = (const float*)(a.ws + WS_HSC);
    float* Ybuf = (float*)(a.ws + WS_Z);
    const LAS int* eg_e = (const LAS int*)lds; LAS float* sw = (LAS float*)(lds + 32768);
    LAS int* apart = (LAS int*)(lds + 65536); LAS float* wtotl = (LAS float*)(lds + LDSCTL_OFF + 256);
    const int b = ch / NCH; const bool last = (l == NL - 1);
    const float* mb = mod + ((size_t)l * NB + b) * 6 * D; const float* mbn = mod + ((size_t)(last ? l : l + 1) * NB + b) * 6 * D;
    const int tlw = wave * 8;
    { const int lane = lane0;
#pragma unroll
      for (int i = 0; i < 16; ++i) apart[tlw * 128 + i * 64 + lane] = 0; }
    LDS_WAIT(); asm volatile("" ::: "memory");
    {
        int laneL = lane0; asm volatile("" : "+v"(laneL)); const int lane = laneL;
        const int g = lane >> 3, l7 = lane & 7;
        v4u bufA[16], bufB[16], hA, hB;
#define CU_LOAD(buf, hh_, idx_) do { const int cs_ = (idx_) >> 3, tl_ = tlw + ((idx_) & 7); const unsigned coff_ = (unsigned)(cs_ * 128 + l7 * 16); \
            hh_ = *(const v4u*)(hq8 + (size_t)(ch * 64 + tl_) * D + coff_); \
            _Pragma("unroll") for (int i_ = 0; i_ < 16; ++i_) { const unsigned e_ = (unsigned)eg_e[tl_ * 128 + 8 * i_ + g]; buf[i_] = *(const v4u*)(ut + (size_t)(e_ * 2048u + coff_)); } } while (0)
#define CU_COMP(buf, hh_, idx_) do { const int tl_ = tlw + ((idx_) & 7); int acc_[16]; \
            _Pragma("unroll") for (int i_ = 0; i_ < 16; ++i_) { int s_ = 0; _Pragma("unroll") for (int q_ = 0; q_ < 4; ++q_) s_ = sdot4i(buf[i_][q_], hh_[q_], s_); acc_[i_] = s_; } \
            treduce16<int, 1>(acc_, lane); \
            apart[tl_ * 128 + 8 * l7 + g] += acc_[0]; apart[tl_ * 128 + 8 * (8 + l7) + g] += acc_[1]; } while (0)
        CU_LOAD(bufA, hA, 0);
        for (int idx = 0; idx < 128; idx += 2) {
            CU_LOAD(bufB, hB, idx + 1);
            CU_COMP(bufA, hA, idx);
            if (idx + 2 < 128) CU_LOAD(bufA, hA, idx + 2);
            CU_COMP(bufB, hB, idx + 1);
        }
#undef CU_LOAD
#undef CU_COMP
        LDS_WAIT(); asm volatile("" ::: "memory");
        for (int it = 0; it < 8; ++it) { const int tl = tlw + it; const float shs = hsc[ch * 64 + tl];
            const int e0 = eg_e[tl * 128 + lane], e1 = eg_e[tl * 128 + 64 + lane];
            const float w0 = sw[tl * 128 + lane] * gelu_tanh_f((float)apart[tl * 128 + lane] * su[e0] * shs) * sv[e0];
            const float w1 = sw[tl * 128 + 64 + lane] * gelu_tanh_f((float)apart[tl * 128 + 64 + lane] * su[e1] * shs) * sv[e1];
            sw[tl * 128 + lane] = w0; sw[tl * 128 + 64 + lane] = w1;
            const float ws = wave_sum(w0 + w1);
            if (lane == 0) wtotl[tl] = ws; }
        LDS_WAIT(); asm volatile("" ::: "memory");
    }
    {
        int laneL = lane0; asm volatile("" : "+v"(laneL)); const int lane = laneL;
        const int g = lane >> 3, l7 = lane & 7;
        v4u bufA[16], bufB[16];
#define CV_LOAD(buf, idx_) do { const int cs_ = (idx_) >> 3, tl_ = tlw + ((idx_) & 7); const unsigned coff_ = (unsigned)(cs_ * 128 + l7 * 16); \
            _Pragma("unroll") for (int i_ = 0; i_ < 16; ++i_) { const unsigned e_ = (unsigned)eg_e[tl_ * 128 + 8 * i_ + g]; buf[i_] = *(const v4u*)(vt + (size_t)(e_ * 2048u + coff_)); } } while (0)
#define CV_COMP(buf, idx_) do { const int cs_ = (idx_) >> 3, tl_ = tlw + ((idx_) & 7); float y_[16]; \
            _Pragma("unroll") for (int q_ = 0; q_ < 16; ++q_) y_[q_] = 0.f; \
            _Pragma("unroll") for (int i_ = 0; i_ < 16; ++i_) { const float wr_ = sw[tl_ * 128 + 8 * i_ + g]; \
                _Pragma("unroll") for (int q_ = 0; q_ < 4; ++q_) fma_ub4(buf[i_][q_], wr_, y_[4 * q_], y_[4 * q_ + 1], y_[4 * q_ + 2], y_[4 * q_ + 3]); } \
            treduce16<float, 8>(y_, lane); \
            const float woff_ = 128.0f * wtotl[tl_]; float* yr_ = Ybuf + (size_t)(ch * 64 + tl_) * D + cs_ * 128 + l7 * 16 + g; \
            yr_[0] = y_[0] - woff_; yr_[8] = y_[1] - woff_; } while (0)
        CV_LOAD(bufA, 0);
        for (int idx = 0; idx < 128; idx += 2) {
            CV_LOAD(bufB, idx + 1);
            CV_COMP(bufA, idx);
            if (idx + 2 < 128) CV_LOAD(bufA, idx + 2);
            CV_COMP(bufB, idx + 1);
        }
#undef CV_LOAD
#undef CV_COMP
    }
    asm volatile("s_waitcnt vmcnt(0)" ::: "memory");
    __builtin_amdgcn_fence(__ATOMIC_ACQUIRE, "agent");
    asm volatile("s_waitcnt vmcnt(0)" ::: "memory");
    for (int it = 0; it < 8; ++it) { int laneT = lane0; asm volatile("" : "+v"(laneT)); const int t = ch * 64 + tlw + it;
        peer_tail(a, l, t, laneT, Ybuf + (size_t)t * D, mb, mbn, last); }
}

#ifndef MK_PER_PHASE
#define MK_PER_PHASE 0
#endif
__global__ void __launch_bounds__(NTHREADS, 2) mk_fwd(Args a) {
    extern __shared__ __attribute__((aligned(16))) unsigned char lds_raw[];
    LAS unsigned char* lds = (LAS unsigned char*)lds_raw;
    const int tid = threadIdx.x, lane = tid & 63, wave = __builtin_amdgcn_readfirstlane(tid >> 6), G = gridDim.x, bx = blockIdx.x;
    if (tid < 64) ((LAS unsigned*)(lds + LDSCTL_OFF))[tid] = 0u;
    __syncthreads();
    unsigned* ctl = (unsigned*)(a.ws + WS_CTL);
    XcdBarrier bar; bar.bar = ctl + CW_BAR; bar.x = 0; bar.st = nullptr;
    const bool use_bar = (a.ph_hi - a.ph_lo) > 1;
    if (use_bar) bar = xcd_barrier_post(ctl + CW_BAR, (volatile LAS unsigned*)(lds + LDSCTL_OFF));
    const int lo = a.ph_lo, hi = a.ph_hi;
#ifndef PH_MASK
#define PH_MASK 0x1ff
#endif
#define IN(k) (lo <= (k) && (k) < hi)
#define EN(b) ((PH_MASK >> (b)) & 1)
#ifndef REP_MASK
#define REP_MASK 0
#endif
#ifndef REP_EXTRA
#define REP_EXTRA 2
#endif
#define REPS(b) (1 + ((REP_MASK >> (b)) & 1) * REP_EXTRA)
#define REP_BEGIN(b) for (int rep_ = 0; rep_ < REPS(b); ++rep_) {
#define REP_END(b) if (rep_ + 1 < REPS(b)) xcd_barrier(bar); }
#define SEAM(k) do { if (IN((k) + 1)) xcd_barrier(bar); } while (0)
#define PHASE_IDS() int tidp = tid; asm volatile("" : "+v"(tidp)); const int lanep = tidp & 63, wavep = __builtin_amdgcn_readfirstlane(tidp >> 6); (void)lanep; (void)wavep
    if (EN(0) && IN(0)) { REP_BEGIN(0) PHASE_IDS(); ph_prologue_a(a, lds, tidp, lanep, wavep, bx, G); REP_END(0) SEAM(0); }
    if (EN(1) && IN(1)) { REP_BEGIN(1) PHASE_IDS(); ph_prologue_b(a, lds, tidp, lanep, wavep, bx, G); REP_END(1) SEAM(1); }
    for (int l = 0; l < NL; ++l) {
        const int pb = 2 + 7 * l;
        const float* mod = (const float*)(a.ws + WS_MOD);
        if (EN(2) && IN(pb + 0)) {
            REP_BEGIN(2) PHASE_IDS();
            pg8::Gemm g{(const pg8::bf16_t*)(a.ws + WS_H), (const pg8::bf16_t*)(a.ws + WS_WIN) + (size_t)l * INW * D, T, NP, D}; pg8::StaticOrder S; S.init(T, NP, G, bx);
            pg8::EpiBf16P E{(pg8::bf16_t*)(a.ws + WS_PROJ), NP};
            pg8::gemm_phase<pg8::EpiBf16P, pg8::StaticOrder, true, true>(lds + RING_OFF, g, S, E, tidp);
            for (int ch = bx; ch < NCHUNK; ch += G) gate_prep(a, l, lds, tidp, lanep, wavep, ch);
            REP_END(2) SEAM(pb + 0);
        }
        if (EN(3) && IN(pb + 1)) { REP_BEGIN(3) PHASE_IDS(); for (int un = bx; un < 256; un += G) gla_unit(a, lds, tidp, lanep, wavep, un); REP_END(3) SEAM(pb + 1); }
        if (EN(4) && IN(pb + 2)) { REP_BEGIN(4) PHASE_IDS(); for (int ch = bx; ch < NCHUNK; ch += G) mixpost_chunk(a, l, lanep, wavep, ch); REP_END(4) SEAM(pb + 2); }
        if (EN(5) && IN(pb + 3)) {
            REP_BEGIN(5) PHASE_IDS();
            pg8::Gemm g{(const pg8::bf16_t*)(a.ws + WS_Y), (const pg8::bf16_t*)(a.ws + WS_WOUT) + (size_t)l * D * D, T, D, D}; pg8::StaticOrder S; S.init(T, D, G, bx);
            pg8::EpiResid E{(float*)(a.ws + WS_Z), l == 0 ? a.in[0] : (const float*)(a.ws + WS_X), mod + (size_t)l * NB * 6 * D + 2 * D, ALPHA};
            pg8::gemm_phase<pg8::EpiResid, pg8::StaticOrder, true, true>(lds + RING_OFF, g, S, E, tidp);
            REP_END(5) SEAM(pb + 3);
        }
        if (EN(6) && IN(pb + 4)) { REP_BEGIN(6) PHASE_IDS(); for (int ch = bx; ch < NCHUNK; ch += G) ln1_chunk(a, l, lanep, wavep, ch); REP_END(6) SEAM(pb + 4); }
        if (EN(7) && IN(pb + 5)) {
            REP_BEGIN(7) PHASE_IDS();
            pg8::Gemm g{(const pg8::bf16_t*)(a.ws + WS_H2), (const pg8::bf16_t*)(a.ws + WS_WQ) + (size_t)l * D * D, T, D, D}; pg8::StaticOrder S; S.init(T, D, G, bx);
            pg8::EpiBf16P E{(pg8::bf16_t*)(a.ws + WS_Q), D};
            pg8::gemm_phase<pg8::EpiBf16P, pg8::StaticOrder, true, true>(lds + RING_OFF, g, S, E, tidp);
            REP_END(7) SEAM(pb + 5);
        }
#ifndef PEER_DBG
#define PEER_DBG 0
#endif
#ifndef L2PROBE
#define L2PROBE 0
#endif
        if (EN(8) && IN(pb + 6)) {
            REP_BEGIN(8)
            for (int ch = bx; ch < NCHUNK; ch += G) { { PHASE_IDS(); peer_retrieve(a, l, lds, lanep, wavep, ch); } __syncthreads(); { PHASE_IDS(); peer_experts(a, l, lds, lanep, wavep, ch); } __syncthreads(); }
            REP_END(8) SEAM(pb + 6);
        }
    }
#undef IN
#undef SEAM
}

extern "C" void kernel_launch(void* const* d_in, const int* in_sizes, int n_in, void* d_out, int out_size, void* d_ws, size_t ws_size, hipStream_t stream) {
    static int grid = 0;
    if (grid == 0) {
        if (n_in != 19 || in_sizes[0] != T * D || out_size != T * D || ws_size < WS_END) { fprintf(stderr, "kernel_launch: unexpected shapes / workspace (%d inputs, ws %zu); nothing launched\n", n_in, ws_size); grid = -1; return; }
        int dev = 0, cus = 0, per_cu = 0;
        if (hipGetDevice(&dev) != hipSuccess || hipDeviceGetAttribute(&cus, hipDeviceAttributeMultiprocessorCount, dev) != hipSuccess) { grid = -1; return; }
        if (hipFuncSetAttribute((const void*)mk_fwd, hipFuncAttributeMaxDynamicSharedMemorySize, LDS_BYTES) != hipSuccess) { fprintf(stderr, "kernel_launch: hipFuncSetAttribute failed\n"); grid = -1; return; }
        if (hipOccupancyMaxActiveBlocksPerMultiprocessor(&per_cu, (const void*)mk_fwd, NTHREADS, LDS_BYTES) != hipSuccess || per_cu < 1) fprintf(stderr, "kernel_launch: occupancy query reports %d\n", per_cu);
        (void)hipGetLastError();
        grid = cus;
    }
    if (grid < 0) return;
    if (hipMemsetAsync((char*)d_ws + WS_CTL, 0, CTL_ZERO_BYTES, stream) != hipSuccess) return;
    Args a{};
    for (int i = 0; i < 19; ++i) a.in[i] = (const float*)d_in[i];
    a.out = (float*)d_out; a.ws = (unsigned char*)d_ws;
#if MK_PER_PHASE
    for (int p = 0; p < NPHASES; ++p) { a.ph_lo = p; a.ph_hi = p + 1; hipLaunchKernelGGL(mk_fwd, dim3(grid), dim3(NTHREADS), LDS_BYTES, stream, a); }
#else
    a.ph_lo = 0; a.ph_hi = NPHASES;
    hipLaunchKernelGGL(mk_fwd, dim3(grid), dim3(NTHREADS), LDS_BYTES, stream, a);
#endif
}
```

```cpp
#include <hip/hip_runtime.h>
#include <cstdio>
#include <cstdint>
namespace pg8 {
#define PG8_LAS __attribute__((address_space(3)))
typedef unsigned short bf16_t;
typedef short bf16x8 __attribute__((ext_vector_type(8)));
typedef float f32x4 __attribute__((ext_vector_type(4)));
typedef unsigned u32x4 __attribute__((ext_vector_type(4)));
constexpr int BM = 256, BK = 64, HALF = 128, HTB = HALF * BK * 2  , STAGE_BYTES = 8 * HTB, NXCD = 8, WGM = 8;

__host__ __device__ __forceinline__ int lds_byte(int r, int c) { const int st = (r >> 4) * 2 + (c >> 5), rr = r & 15, cc = c & 31, ob = rr * 64 + cc * 2; return st * 1024 + (ob ^ (((ob >> 9) & 1) << 5)); }
__host__ __device__ __forceinline__ void stage_rc(int b, int& R, int& C) { const int st = b / 1024, sb = b % 1024, swz = sb ^ (((sb >> 9) & 1) << 5); R = (st >> 1) * 16 + swz / 64; C = (st & 1) * 32 + (swz % 64) / 2; }
__host__ __device__ __forceinline__ int perm32(int rho) { const int n = rho >> 4, i = rho & 15; return 8 * (i >> 2) + 4 * n + (i & 3); }

struct Unit { int pm, pn; };
struct Gemm { const bf16_t* A; const bf16_t* Bt; int M, N, K; };

struct StaticOrder {
    int nM, nN, nwg, G, c;
    __host__ __device__ void init(int M, int N, int G_, int c_) { nM = M / BM; nN = N / BM; nwg = nM * nN; G = G_; c = c_; }
    __host__ __device__ bool next(int i, Unit& u) const {
        const long L = (long)i * G + c; if (L >= nwg) return false;
        int wgid = (int)L; { const int q = nwg / NXCD, r = nwg % NXCD, xcd = wgid % NXCD, off = wgid / NXCD; wgid = (xcd < r ? xcd * (q + 1) : r * (q + 1) + (xcd - r) * q) + off; }
        const int nig = WGM * nN, gid = wgid / nig, fm = gid * WGM, gsz = (nM - fm) < WGM ? (nM - fm) : WGM;
        u.pm = fm + ((wgid % nig) % gsz); u.pn = (wgid % nig) / gsz; return true;
    }
    __device__ __forceinline__ void a_ready(const Unit&) const {}
    __device__ __forceinline__ void done(const Unit&) const {}
};
typedef __bf16 bf16x2_t __attribute__((ext_vector_type(2)));
__device__ __forceinline__ unsigned cvt_pk_bf16(float lo, float hi) { bf16x2_t r; r.x = (__bf16)lo; r.y = (__bf16)hi; return __builtin_bit_cast(unsigned, r); }
struct EpiBf16P {
    static constexpr bool PERM = true, AFTER_DRAIN = false;
    bf16_t* O; int ldc;
    __device__ __forceinline__ void operator()(const f32x4 (&acc)[2][2][4][2], const Unit& u, int wr, int wc, int fr, int fq) const {
        const int row0 = u.pm * BM + wr * 64 + fr, col0 = u.pn * BM + wc * 32 + 8 * fq;
#pragma unroll
        for (int ai = 0; ai < 2; ++ai)
#pragma unroll
            for (int m = 0; m < 4; ++m) { bf16_t* rowp = O + (size_t)(row0 + ai * HALF + m * 16) * ldc + col0;
#pragma unroll
                for (int bj = 0; bj < 2; ++bj) { const f32x4 v0 = acc[ai][bj][m][0], v1 = acc[ai][bj][m][1];
                    u32x4 w; w.x = cvt_pk_bf16(v0[0], v0[1]); w.y = cvt_pk_bf16(v0[2], v0[3]); w.z = cvt_pk_bf16(v1[0], v1[1]); w.w = cvt_pk_bf16(v1[2], v1[3]);
                    *(u32x4*)(rowp + bj * HALF) = w; } }
    }
};
struct EpiResid {
    static constexpr bool PERM = false, AFTER_DRAIN = false;
    float* Z; const float* X; const float* gate; float alpha;
    __device__ __forceinline__ void operator()(const f32x4 (&acc)[2][2][4][2], const Unit& u, int wr, int wc, int fr, int fq) const {
        const int row0 = u.pm * BM + wr * 64 + fr, col0 = u.pn * BM + wc * 32 + 4 * fq;
        const float* gb = gate + (size_t)(u.pm >> 3) * (6 * 2048) + col0;
        f32x4 gv[2][2];
#pragma unroll
        for (int bj = 0; bj < 2; ++bj)
#pragma unroll
            for (int n = 0; n < 2; ++n) gv[bj][n] = *(const f32x4*)(gb + bj * HALF + n * 16) + 1.0f;
#pragma unroll
        for (int ai = 0; ai < 2; ++ai)
#pragma unroll
            for (int m = 0; m < 4; ++m) { const size_t off = (size_t)(row0 + ai * HALF + m * 16) * 2048 + col0;
#pragma unroll
                for (int bj = 0; bj < 2; ++bj)
#pragma unroll
                    for (int n = 0; n < 2; ++n) { const f32x4 xv = *(const f32x4*)(X + off + bj * HALF + n * 16);
                        *(f32x4*)(Z + off + bj * HALF + n * 16) = xv * alpha + gv[bj][n] * acc[ai][bj][m][n]; }
                asm volatile("" ::: "memory"); }
    }
};
template <class Epi, class Sched, bool ALIGN_EPI = false, bool SP2 = false>
__device__ __forceinline__ void gemm_phase(PG8_LAS unsigned char* lds, const Gemm g, const Sched& S, const Epi& E, const int tid_in) {
    const int tid = tid_in, wid = __builtin_amdgcn_readfirstlane(tid >> 6), lane = tid & 63, wr = wid >> 2, wc = wid & 3, fr = lane & 15, fq = lane >> 4;
    const int K = g.K, nt = K / BK;
    unsigned voffA[2], voffB[2];
#pragma unroll
    for (int i = 0; i < 2; ++i) { int R, C; stage_rc(tid * 16 + i * 8192, R, C); const int Rb = Epi::PERM ? ((R & ~31) + perm32(R & 31)) : R;
        voffA[i] = (unsigned)(R * K + C) * 2u; voffB[i] = (unsigned)(Rb * K + C) * 2u; }
    const size_t kstep = (size_t)(BK * 2);
    const size_t hstep = (size_t)HALF * K * 2;
    const size_t tstep = 2 * hstep;
    const unsigned ldsw = (unsigned)wid * 1024u;
    const int aoff = lds_byte(wr * 64 + fr, fq * 8), boff = lds_byte(wc * 32 + fr, fq * 8);
#define PG8_SA(b, h) (((b) * 2 + (h)) * HTB)
#define PG8_SB(b, h) ((4 + (b) * 2 + (h)) * HTB)
#define PG8_STAGE(bufoff, gbase, voff) do { _Pragma("unroll") for (int _i = 0; _i < 2; ++_i) \
        __builtin_amdgcn_global_load_lds((const unsigned*)((const char*)(gbase) + (voff)[_i]), (PG8_LAS unsigned*)(lds + (bufoff) + ldsw + _i * 8192), 16, 0, 0); } while (0)
#define PG8_LDA(dst, b, h) do { _Pragma("unroll") for (int m = 0; m < 4; ++m) _Pragma("unroll") for (int k = 0; k < 2; ++k) dst[m][k] = *(const PG8_LAS bf16x8*)(lds + PG8_SA(b, h) + aoff + m * 2048 + k * 1024); } while (0)
#define PG8_LDB(dst, b, h) do { _Pragma("unroll") for (int n = 0; n < 2; ++n) _Pragma("unroll") for (int k = 0; k < 2; ++k) dst[n][k] = *(const PG8_LAS bf16x8*)(lds + PG8_SB(b, h) + boff + n * 2048 + k * 1024); } while (0)
#define PG8_MMA(ai, bj, At, Bt) do { __builtin_amdgcn_s_setprio(1); _Pragma("unroll") for (int m = 0; m < 4; ++m) _Pragma("unroll") for (int n = 0; n < 2; ++n) _Pragma("unroll") for (int k = 0; k < 2; ++k) \
        acc[ai][bj][m][n] = __builtin_amdgcn_mfma_f32_16x16x32_bf16(Bt[n][k], At[m][k], acc[ai][bj][m][n], 0, 0, 0); __builtin_amdgcn_s_setprio(0); } while (0)
#define PG8_WAIT_V(n) asm volatile("s_waitcnt vmcnt(" #n ")" ::: "memory")
#define PG8_WAIT_L(n) asm volatile("s_waitcnt lgkmcnt(" #n ")" ::: "memory")
#define PG8_BAR __builtin_amdgcn_s_barrier()
#define PG8_SCHED __builtin_amdgcn_sched_barrier(0)
    Unit cur, nxt; int ui = 0;
    if (!S.next(0, cur)) return;
    f32x4 acc[2][2][4][2];
#pragma unroll
    for (int a = 0; a < 2; ++a)
#pragma unroll
        for (int b = 0; b < 2; ++b)
#pragma unroll
            for (int m = 0; m < 4; ++m)
#pragma unroll
                for (int n = 0; n < 2; ++n) acc[a][b][m][n] = (f32x4){0.f, 0.f, 0.f, 0.f};
    bf16x8 At[4][2], B0[2][2], B1[2][2];
    const char* cA = (const char*)g.A + (size_t)cur.pm * tstep; const char* cB = (const char*)g.Bt + (size_t)cur.pn * tstep;
    S.a_ready(cur);
    if constexpr (SP2) {
        PG8_STAGE(PG8_SB(0, 0), cB, voffB); PG8_STAGE(PG8_SB(0, 1), cB + hstep, voffB); PG8_STAGE(PG8_SA(0, 0), cA, voffA); PG8_STAGE(PG8_SA(0, 1), cA + hstep, voffA);
        if (wr == 1) PG8_BAR;
        PG8_WAIT_V(2); PG8_BAR;
        PG8_STAGE(PG8_SB(1, 0), cB + kstep, voffB); PG8_STAGE(PG8_SA(1, 0), cA + kstep, voffA); PG8_STAGE(PG8_SB(1, 1), cB + hstep + kstep, voffB);
        PG8_WAIT_V(6); PG8_BAR;
    } else {
        PG8_STAGE(PG8_SB(0, 0), cB, voffB); PG8_STAGE(PG8_SA(0, 0), cA, voffA); PG8_STAGE(PG8_SB(0, 1), cB + hstep, voffB); PG8_STAGE(PG8_SA(0, 1), cA + hstep, voffA);
        if (wr == 1) PG8_BAR;
        PG8_WAIT_V(4); PG8_BAR;
        PG8_STAGE(PG8_SB(1, 0), cB + kstep, voffB); PG8_STAGE(PG8_SA(1, 0), cA + kstep, voffA); PG8_STAGE(PG8_SB(1, 1), cB + hstep + kstep, voffB);
        PG8_WAIT_V(6); PG8_BAR;
    }
    for (;;) {
        const bool has_next = S.next(ui + 1, nxt);
        const char* nA = has_next ? (const char*)g.A + (size_t)nxt.pm * tstep : cA; const char* nB = has_next ? (const char*)g.Bt + (size_t)nxt.pn * tstep : cB;
        for (int t = 0; t < nt; t += 2) {
            const bool last = (t == nt - 2);
            const char* a1 = cA + (size_t)(t + 1) * kstep;
            const char* a2 = last ? nA : cA + (size_t)(t + 2) * kstep; const char* b2 = last ? nB : cB + (size_t)(t + 2) * kstep;
            const char* a3 = a2 + kstep; const char* b3 = b2 + kstep;
            if (last && has_next) S.a_ready(nxt);
            if constexpr (SP2) {
            PG8_LDB(B0, 0, 0); PG8_LDB(B1, 0, 1); PG8_SCHED; PG8_LDA(At, 0, 0); PG8_STAGE(PG8_SA(1, 1), a1 + hstep, voffA);
            PG8_WAIT_V(8); PG8_WAIT_L(0); PG8_BAR; PG8_MMA(0, 0, At, B0); PG8_MMA(0, 1, At, B1); PG8_BAR; PG8_SCHED;
            PG8_LDA(At, 0, 1); PG8_STAGE(PG8_SB(0, 0), b2, voffB); PG8_STAGE(PG8_SB(0, 1), b2 + hstep, voffB); PG8_STAGE(PG8_SA(0, 0), a2, voffA);
            PG8_WAIT_V(8); PG8_WAIT_L(0); PG8_BAR; PG8_MMA(1, 0, At, B0); PG8_MMA(1, 1, At, B1); PG8_BAR; PG8_SCHED;
            PG8_LDB(B0, 1, 0); PG8_LDB(B1, 1, 1); PG8_SCHED; PG8_LDA(At, 1, 0); PG8_STAGE(PG8_SA(0, 1), a2 + hstep, voffA);
            PG8_WAIT_V(8); PG8_WAIT_L(0); PG8_BAR; PG8_MMA(0, 0, At, B0); PG8_MMA(0, 1, At, B1); PG8_BAR; PG8_SCHED;
            PG8_LDA(At, 1, 1); PG8_STAGE(PG8_SB(1, 0), b3, voffB); PG8_STAGE(PG8_SB(1, 1), b3 + hstep, voffB); PG8_STAGE(PG8_SA(1, 0), a3, voffA);
            PG8_WAIT_V(8); PG8_WAIT_L(0); PG8_BAR; PG8_MMA(1, 0, At, B0); PG8_MMA(1, 1, At, B1); PG8_BAR; PG8_SCHED;
            } else {
            PG8_LDB(B0, 0, 0); PG8_SCHED; PG8_LDA(At, 0, 0); PG8_STAGE(PG8_SA(1, 1), a1 + hstep, voffA);
            PG8_WAIT_L(8); PG8_BAR; PG8_WAIT_L(0); PG8_MMA(0, 0, At, B0); PG8_BAR; PG8_SCHED;
            PG8_LDB(B1, 0, 1); PG8_STAGE(PG8_SB(0, 0), b2, voffB);
            PG8_BAR; PG8_WAIT_L(0); PG8_MMA(0, 1, At, B1); PG8_BAR;
            PG8_LDA(At, 0, 1); PG8_STAGE(PG8_SA(0, 0), a2, voffA);
            PG8_BAR; PG8_WAIT_L(0); PG8_MMA(1, 0, At, B0); PG8_BAR; PG8_SCHED;
            PG8_STAGE(PG8_SB(0, 1), b2 + hstep, voffB);
            PG8_WAIT_V(6); PG8_BAR; PG8_MMA(1, 1, At, B1); PG8_BAR;
            PG8_LDB(B0, 1, 0); PG8_SCHED; PG8_LDA(At, 1, 0); PG8_STAGE(PG8_SA(0, 1), a2 + hstep, voffA);
            PG8_WAIT_L(8); PG8_BAR; PG8_WAIT_L(0); PG8_MMA(0, 0, At, B0); PG8_BAR; PG8_SCHED;
            PG8_LDB(B1, 1, 1); PG8_STAGE(PG8_SB(1, 0), b3, voffB);
            PG8_BAR; PG8_WAIT_L(0); PG8_MMA(0, 1, At, B1); PG8_BAR;
            PG8_LDA(At, 1, 1); PG8_STAGE(PG8_SA(1, 0), a3, voffA);
            PG8_BAR; PG8_WAIT_L(0); PG8_MMA(1, 0, At, B0); PG8_BAR; PG8_SCHED;
            PG8_STAGE(PG8_SB(1, 1), b3 + hstep, voffB);
            PG8_WAIT_V(6); PG8_BAR; PG8_MMA(1, 1, At, B1); PG8_BAR;
            }
        }
        if constexpr (ALIGN_EPI) { if (wr == 0) PG8_BAR; }
        if constexpr (!Epi::AFTER_DRAIN) { E(acc, cur, wr, wc, fr, fq); S.done(cur); }
        if (!has_next) break;
#pragma unroll
        for (int a = 0; a < 2; ++a)
#pragma unroll
            for (int b = 0; b < 2; ++b)
#pragma unroll
                for (int m = 0; m < 4; ++m)
#pragma unroll
                    for (int n = 0; n < 2; ++n) acc[a][b][m][n] = (f32x4){0.f, 0.f, 0.f, 0.f};
        cur = nxt; cA = nA; cB = nB; ++ui;
        if constexpr (ALIGN_EPI) { if (wr == 1) PG8_BAR; }
    }
    PG8_WAIT_V(0);
    if constexpr (!ALIGN_EPI) { if (wr == 0) PG8_BAR; }
    PG8_BAR;
    if constexpr (Epi::AFTER_DRAIN) { E.fused(acc, cur, wr, wc, fr, fq, lds, wid, lane); S.done(cur); }
#undef PG8_SA
#undef PG8_SB
#undef PG8_STAGE
#undef PG8_LDA
#undef PG8_LDB
#undef PG8_MMA
#undef PG8_WAIT_V
#undef PG8_WAIT_L
#undef PG8_BAR
#undef PG8_SCHED
}
}
#define XB_TMO      128
#define XB_XCNT(j)  (256  + 64 * (j))
#define XB_XSUB(j)  (1280 + 64 * (j))
#define XB_XGEN(j)  (2304 + 64 * (j))
#define XB_TOP      3328
#define XB_TOPGEN   3392
#define XCD_BAR_WORDS 3456
#define XB_SPIN_CAP (1u << 18)
#define LAS __attribute__((address_space(3)))

__device__ __forceinline__ unsigned xb_ld(unsigned* p)              { return __hip_atomic_load(p, __ATOMIC_RELAXED, __HIP_MEMORY_SCOPE_AGENT); }
__device__ __forceinline__ unsigned xb_add(unsigned* p, unsigned v) { return __hip_atomic_fetch_add(p, v, __ATOMIC_RELAXED, __HIP_MEMORY_SCOPE_AGENT); }
__device__ __forceinline__ unsigned xb_xcc_id() { return (unsigned)__builtin_amdgcn_s_getreg((3 << 11) | 20) & 0xFu; }
#define XB_SPIN(cond, bar) do { unsigned _sp = 0; while (cond) { __builtin_amdgcn_s_sleep(1); \
    if ((++_sp & 255u) == 0u) { if (xb_ld(&(bar)[XB_TMO])) break; if (_sp > XB_SPIN_CAP) { atomicAdd(&(bar)[XB_TMO], 1u); break; } } } } while (0)

struct XcdBarrier {
    unsigned* bar; unsigned x;
    volatile LAS unsigned* st;
};

__device__ __forceinline__ XcdBarrier xcd_barrier_post(unsigned* bar, volatile LAS unsigned* st) {
    XcdBarrier b; b.bar = bar; b.x = xb_xcc_id(); b.st = st;
    if (threadIdx.x == 0) (void)xb_add(&bar[XB_XCNT(b.x)], 1u);
    return b;
}
__device__ __forceinline__ void xcd_barrier_complete(unsigned* bar, unsigned x, unsigned& nloc, unsigned& nx) {
    const unsigned G = gridDim.x * gridDim.y * gridDim.z;
    unsigned sum, cnt, mine, sp = 0u;
    for (;;) {
        sum = 0u; cnt = 0u; mine = 0u;
#pragma unroll
        for (unsigned j = 0; j < 16; ++j) { const unsigned c = xb_ld(&bar[XB_XCNT(j)]); sum += c; cnt += (c > 0u) ? 1u : 0u; mine = (j == x) ? c : mine; }
        if (sum == G) break;
        __builtin_amdgcn_s_sleep(1);
        if ((++sp & 255u) == 0u) { if (xb_ld(&bar[XB_TMO])) break; if (sp > XB_SPIN_CAP) { atomicAdd(&bar[XB_TMO], 1u); break; } }
    }
    nloc = mine > 0u ? mine : 1u; nx = cnt > 0u ? cnt : 1u;
}

__device__ __forceinline__ void xcd_barrier(const XcdBarrier& b) {
    asm volatile("s_waitcnt vmcnt(0)" ::: "memory");
    __syncthreads();
    if (threadIdx.x == 0) {
        unsigned* bar = b.bar;
        __builtin_amdgcn_s_waitcnt(0);
        unsigned nloc = b.st[0], nx = b.st[1];
        if (nloc == 0u) { xcd_barrier_complete(bar, b.x, nloc, nx); b.st[0] = nloc; b.st[1] = nx; }
        const unsigned old = xb_add(&bar[XB_XSUB(b.x)], 1u);
        const unsigned gen = old / nloc;
        if (old + 1u == (gen + 1u) * nloc) {
            __builtin_amdgcn_fence(__ATOMIC_RELEASE, "agent");
            asm volatile("s_waitcnt vmcnt(0)" ::: "memory");
            const unsigned og = xb_add(&bar[XB_TOP], 1u);
            const unsigned tg = og / nx;
            if (og + 1u == (tg + 1u) * nx) xb_add(&bar[XB_TOPGEN], 1u);
            else XB_SPIN(xb_ld(&bar[XB_TOPGEN]) == tg, bar);
            __builtin_amdgcn_fence(__ATOMIC_ACQUIRE, "agent");
            xb_add(&bar[XB_XGEN(b.x)], 1u);
            asm volatile("s_waitcnt vmcnt(0)" ::: "memory");
        } else {
            XB_SPIN(xb_ld(&bar[XB_XGEN(b.x)]) == gen, bar);
            __builtin_amdgcn_fence(__ATOMIC_ACQUIRE, "agent");
            asm volatile("s_waitcnt vmcnt(0)" ::: "memory");
        }
    }
    __syncthreads();
}
constexpr int D = 2048, NB = 8, SEQ = 2048, NL = 4, T = NB * SEQ;
constexpr int NCH = SEQ / 64, NCHUNK = T / 64;
constexpr int GKW = 512, RANK = 16;
constexpr int INW = 6160, NP = 6144;
constexpr int NE = 16384;
constexpr float ALPHA = 1.6817928305074290f, EPS = 1e-5f;
constexpr int PQ = 0, PK = 512, PV = 1024, PR = 2048, PCB = 3072, PCC = 4096, PCH = 5120;
constexpr int NWAVES = 8, NTHREADS = 512;
#ifndef TAB4
#define TAB4 0
#endif
constexpr int NPHASES = 2 + 7 * NL;

constexpr size_t MiB = 1u << 20;
constexpr size_t WS_CTL = 0, CTL_ZERO_BYTES = 1 * MiB;
constexpr size_t WS_MOD = 1 * MiB, WS_PART = 3 * MiB, WS_KEYS = 15 * MiB, WS_DTOT = 17 * MiB, WS_WIN = 18 * MiB, WS_WOUT = 115 * MiB, WS_WQ = 147 * MiB;
constexpr size_t WS_UT = 179 * MiB, WS_VT = 435 * MiB, WS_H = 691 * MiB, WS_PROJ = 755 * MiB, WS_E = 947 * MiB, WS_OGLA = 979 * MiB, WS_Y = 1043 * MiB;
constexpr size_t WS_Z = 1107 * MiB, WS_X1 = 1235 * MiB, WS_X = 1363 * MiB, WS_Q = 1491 * MiB, WS_H2 = 1555 * MiB, WS_HQ8 = 1619 * MiB, WS_END = 1651 * MiB;
constexpr size_t WS_SU = 17 * MiB + 512 * 1024, WS_SV = 17 * MiB + 768 * 1024, WS_HSC = 2 * MiB + 640 * 1024;
static_assert(WS_WIN + (size_t)NL * INW * D * 2 <= WS_WOUT && WS_PART + (size_t)NL * 8 * NB * 6 * D * 4 <= WS_KEYS && WS_MOD + (size_t)NL * NB * 6 * D * 4 <= WS_PART, "ws map");
constexpr int CW_BAR = 4096;

constexpr int RING_OFF = 0, RING_BYTES = 131072, LDSCTL_OFF = RING_BYTES, LDS_BYTES = 147456;

#define GAS __attribute__((address_space(1)))
typedef unsigned short bf16;
typedef unsigned v4u __attribute__((ext_vector_type(4)));
typedef unsigned v2u __attribute__((ext_vector_type(2)));
typedef float f32x4 __attribute__((ext_vector_type(4)));
typedef float f32x16 __attribute__((ext_vector_type(16)));
typedef short bf16x8 __attribute__((ext_vector_type(8)));
typedef __bf16 bf16x2v __attribute__((ext_vector_type(2)));
#define LDS_WAIT() asm volatile("s_waitcnt lgkmcnt(0)" ::: "memory")

__device__ __forceinline__ unsigned pk2(float lo, float hi) { return pg8::cvt_pk_bf16(lo, hi); }
__device__ __forceinline__ float dot2bf(unsigned w, unsigned x, float acc) { return __builtin_amdgcn_fdot2_f32_bf16(__builtin_bit_cast(bf16x2v, w), __builtin_bit_cast(bf16x2v, x), acc, false); }
__device__ __forceinline__ float bflo(unsigned u) { return __uint_as_float(u << 16); }
__device__ __forceinline__ float bfhi(unsigned u) { return __uint_as_float(u & 0xffff0000u); }
__device__ __forceinline__ float silu_f(float x) { return x / (1.0f + __expf(-x)); }
__device__ __forceinline__ float logsigmoid_f(float x) { return fminf(x, 0.0f) - log1pf(__expf(-fabsf(x))); }
__device__ __forceinline__ float gelu_tanh_f(float x) { const float u = 0.7978845608028654f * (x + 0.044715f * x * x * x); return 0.5f * x * (1.0f + tanhf(u)); }
__device__ __forceinline__ float wave_sum(float v) {
#pragma unroll
    for (int o = 1; o < 64; o <<= 1) v += __shfl_xor(v, o);
    return v;
}

struct Args { const float* in[19]; float* out; unsigned char* ws; int ph_lo, ph_hi; };

__device__ __forceinline__ void transpose_item(const float* W, int ldw, int col0, bf16* WTrows, int k0, int nvalid, LAS float* scr, int lane) {
    const int n = lane & 31;
    float tv[32];
#pragma unroll
    for (int i = 0; i < 32; ++i) { const int kk = 2 * i + (lane >> 5); tv[i] = (n < nvalid) ? W[(size_t)(k0 + kk) * ldw + col0 + n] : 0.f; }
#pragma unroll
    for (int i = 0; i < 32; ++i) { const int kk = 2 * i + (lane >> 5); scr[kk * 33 + n] = tv[i]; }
    LDS_WAIT(); asm volatile("" ::: "memory");
    const int c = lane & 7;
#pragma unroll
    for (int j = 0; j < 4; ++j) { const int nn = (lane >> 3) + 8 * j; const LAS float* s = scr + (8 * c) * 33 + nn;
        v4u o; o.x = pk2(s[0 * 33], s[1 * 33]); o.y = pk2(s[2 * 33], s[3 * 33]); o.z = pk2(s[4 * 33], s[5 * 33]); o.w = pk2(s[6 * 33], s[7 * 33]);
        if (nn < nvalid) *(v4u*)(WTrows + (size_t)nn * D + k0 + 8 * c) = o; }
    LDS_WAIT(); asm volatile("" ::: "memory");
}
__device__ __forceinline__ void cvt_stream(const float* src, bf16* dst, size_t n4, size_t i0, size_t stride) {
    for (size_t i = i0; i < n4; i += stride) { const f32x4 v = ((const f32x4*)src)[i]; v2u o; o.x = pk2(v.x, v.y); o.y = pk2(v.z, v.w); ((v2u*)dst)[i] = o; }
}
__device__ __forceinline__ void ph_prologue_a(const Args& a, LAS unsigned char* lds, int tid, int lane, int wave, int bx, int G) {
    const int gw = bx * NWAVES + wave, NGW = G * NWAVES;
    LAS float* cact = (LAS float*)lds;
    for (int i = tid; i < NB * D; i += NTHREADS) { const int b = i / D, d = i % D; cact[d * 8 + b] = silu_f(a.in[1][i]); }
    __syncthreads();
    float* part = (float*)(a.ws + WS_PART);
    for (int it = gw; it < NL * 8 * 48; it += NGW) {
        const int cg = it % 48, dr = (it / 48) % 8, l = it / 384;
        f32x4 acc[8];
#pragma unroll
        for (int b = 0; b < 8; ++b) acc[b] = (f32x4){0.f, 0.f, 0.f, 0.f};
        const float* w = a.in[2] + ((size_t)l * D + dr * 256) * (6 * D) + cg * 256 + lane * 4;
#pragma unroll 4
        for (int d = 0; d < 256; ++d) {
            const f32x4 wv = *(const f32x4*)(w + (size_t)d * (6 * D));
            const f32x4 c0 = *(const LAS f32x4*)(cact + (dr * 256 + d) * 8), c1 = *(const LAS f32x4*)(cact + (dr * 256 + d) * 8 + 4);
            acc[0] += wv * c0.x; acc[1] += wv * c0.y; acc[2] += wv * c0.z; acc[3] += wv * c0.w;
            acc[4] += wv * c1.x; acc[5] += wv * c1.y; acc[6] += wv * c1.z; acc[7] += wv * c1.w;
        }
#pragma unroll
        for (int b = 0; b < 8; ++b) *(f32x4*)(part + (((size_t)l * 8 + dr) * NB + b) * (6 * D) + cg * 256 + lane * 4) = acc[b];
    }
    __syncthreads();
    LAS float* scr = (LAS float*)(lds + wave * 8448);
    bf16* winT = (bf16*)(a.ws + WS_WIN); bf16* woutT = (bf16*)(a.ws + WS_WOUT); bf16* wqT = (bf16*)(a.ws + WS_WQ);
    constexpr int IPL = 6144 + 32 + 2048 + 2048;
    for (int it = gw; it < NL * IPL; it += NGW) {
        const int l = it / IPL; int r = it % IPL;
        if (r < 6144) { const int nb = r % 192, kb = r / 192, n0 = nb * 32;
            transpose_item(a.in[4] + (size_t)l * D * INW, INW, n0 < 3072 ? n0 : n0 + 16, winT + ((size_t)l * INW + n0) * D, kb * 64, 32, scr, lane); continue; }
        r -= 6144;
        if (r < 32) { transpose_item(a.in[4] + (size_t)l * D * INW, INW, 3072, winT + ((size_t)l * INW + NP) * D, r * 64, 16, scr, lane); continue; }
        r -= 32;
        if (r < 2048) { const int nb = r % 64, kb = r / 64; transpose_item(a.in[10] + (size_t)l * D * D, D, nb * 32, woutT + ((size_t)l * D + nb * 32) * D, kb * 64, 32, scr, lane); continue; }
        r -= 2048;
        { const int nb = r % 64, kb = r / 64; transpose_item(a.in[13] + (size_t)l * D * D, D, nb * 32, wqT + ((size_t)l * D + nb * 32) * D, kb * 64, 32, scr, lane); }
    }
    const size_t i0 = (size_t)bx * NTHREADS + tid, stride = (size_t)G * NTHREADS;
    cvt_stream(a.in[14], (bf16*)(a.ws + WS_KEYS), (size_t)NL * 8 * 2 * 128 * 128 / 4, i0, stride);
#if TAB4
    for (int row = gw; row < 2 * NL * NE; row += NGW) {
        const int tbl = row / (NL * NE), r = row % (NL * NE);
        const float* src = (tbl ? a.in[16] : a.in[15]) + (size_t)r * D;
        f32x4 v[8]; float mx = 0.f;
#pragma unroll
        for (int c8 = 0; c8 < 8; ++c8) { v[c8] = *(const f32x4*)(src + (c8 * 64 + lane) * 4); mx = fmaxf(mx, fmaxf(fmaxf(fabsf(v[c8].x), fabsf(v[c8].y)), fmaxf(fabsf(v[c8].z), fabsf(v[c8].w)))); }
        const unsigned sb = pk2(mx * (1.0f / 7.0f), 0.f) & 0xffffu; const float sc = bflo(sb);
        const float inv = sc > 0.f ? 1.0f / sc : 0.f;
        unsigned dw[4];
#pragma unroll
        for (int q = 0; q < 4; ++q) { unsigned w = 0;
            const float lo[4] = {v[2 * q].x, v[2 * q].y, v[2 * q].z, v[2 * q].w}, hi[4] = {v[2 * q + 1].x, v[2 * q + 1].y, v[2 * q + 1].z, v[2 * q + 1].w};
#pragma unroll
            for (int j = 0; j < 4; ++j) { int a0 = (int)__builtin_rintf(lo[j] * inv), a1 = (int)__builtin_rintf(hi[j] * inv); a0 = a0 < -7 ? -7 : (a0 > 7 ? 7 : a0); a1 = a1 < -7 ? -7 : (a1 > 7 ? 7 : a1);
                w |= ((unsigned)(a0 + 8) | ((unsigned)(a1 + 8) << 4)) << (8 * j); }
            dw[q] = w; }
        unsigned char* tb = a.ws + (tbl ? WS_VT : WS_UT);
        *(v4u*)(tb + (size_t)r * 1024 + lane * 16) = (v4u){dw[0], dw[1], dw[2], dw[3]};
        ((bf16*)(tb + 128 * MiB))[(size_t)r * 64 + lane] = (bf16)sb;
    }
#else
    for (int row = gw; row < 2 * NL * NE; row += NGW) {
        const int tbl = row / (NL * NE), r = row % (NL * NE);
        const float* src = (tbl ? a.in[16] : a.in[15]) + (size_t)r * D;
        f32x4 v[8]; float mx = 0.f;
#pragma unroll
        for (int c8 = 0; c8 < 8; ++c8) { v[c8] = *(const f32x4*)(src + (c8 * 64 + lane) * 4); mx = fmaxf(mx, fmaxf(fmaxf(fabsf(v[c8].x), fabsf(v[c8].y)), fmaxf(fabsf(v[c8].z), fabsf(v[c8].w)))); }
#pragma unroll
        for (int o = 1; o < 64; o <<= 1) mx = fmaxf(mx, __shfl_xor(mx, o));
        const float inv = mx > 0.f ? 127.0f / mx : 0.f; const int off = tbl ? 128 : 0;
        unsigned dw[8];
#pragma unroll
        for (int c8 = 0; c8 < 8; ++c8) { const int q0 = (int)__builtin_rintf(v[c8].x * inv) + off, q1 = (int)__builtin_rintf(v[c8].y * inv) + off, q2 = (int)__builtin_rintf(v[c8].z * inv) + off, q3 = (int)__builtin_rintf(v[c8].w * inv) + off;
            dw[c8] = (unsigned)(q0 & 255) | ((unsigned)(q1 & 255) << 8) | ((unsigned)(q2 & 255) << 16) | ((unsigned)(q3 & 255) << 24); }
        unsigned char* dst = a.ws + (tbl ? WS_VT : WS_UT) + (size_t)r * D;
        *(v4u*)(dst + lane * 16) = (v4u){dw[0], dw[1], dw[2], dw[3]}; *(v4u*)(dst + (64 + lane) * 16) = (v4u){dw[4], dw[5], dw[6], dw[7]};
        if (lane == 0) ((float*)(a.ws + (tbl ? WS_SV : WS_SU)))[r] = mx * (1.0f / 127.0f);
    }
#endif
}

__device__ __forceinline__ void ln_tail(const float (&z)[32], int t, int lane, const float* g, const float* bta, float* xout, const float* sh, const float* sc, bf16* hout, unsigned char* q8, float* q8s) {
    float s = 0.f;
#pragma unroll
    for (int i = 0; i < 32; ++i) s += z[i];
    const float mu = wave_sum(s) * (1.0f / D);
    float q = 0.f;
#pragma unroll
    for (int i = 0; i < 32; ++i) { const float d = z[i] - mu; q += d * d; }
    const float rs = rsqrtf(wave_sum(q) * (1.0f / D) + EPS);
    float hv[32]; float mx = 0.f;
#pragma unroll
    for (int c = 0; c < 8; ++c) { const int col = (c * 64 + lane) * 4;
        const f32x4 g0 = *(const f32x4*)(g + col), b0 = *(const f32x4*)(bta + col);
        f32x4 x0;
        x0.x = (z[c * 4 + 0] - mu) * rs * g0.x + b0.x; x0.y = (z[c * 4 + 1] - mu) * rs * g0.y + b0.y; x0.z = (z[c * 4 + 2] - mu) * rs * g0.z + b0.z; x0.w = (z[c * 4 + 3] - mu) * rs * g0.w + b0.w;
        if (xout) *(f32x4*)(xout + (size_t)t * D + col) = x0;
        if (hout) { const f32x4 s0 = *(const f32x4*)(sc + col), h0 = *(const f32x4*)(sh + col);
            hv[c * 4] = x0.x * (1.f + s0.x) + h0.x; hv[c * 4 + 1] = x0.y * (1.f + s0.y) + h0.y; hv[c * 4 + 2] = x0.z * (1.f + s0.z) + h0.z; hv[c * 4 + 3] = x0.w * (1.f + s0.w) + h0.w;
            v2u o; o.x = pk2(hv[c * 4], hv[c * 4 + 1]); o.y = pk2(hv[c * 4 + 2], hv[c * 4 + 3]);
            *(v2u*)(hout + (size_t)t * D + col) = o;
            if (q8) {
                hv[c * 4] = bflo(o.x); hv[c * 4 + 1] = bfhi(o.x); hv[c * 4 + 2] = bflo(o.y); hv[c * 4 + 3] = bfhi(o.y);
                mx = fmaxf(mx, fmaxf(fmaxf(fabsf(hv[c * 4]), fabsf(hv[c * 4 + 1])), fmaxf(fabsf(hv[c * 4 + 2]), fabsf(hv[c * 4 + 3])))); } }
    }
    if (q8) {
#pragma unroll
        for (int o = 1; o < 64; o <<= 1) mx = fmaxf(mx, __shfl_xor(mx, o));
        const float inv = mx > 0.f ? 127.0f / mx : 0.f;
        unsigned dw[8];
#pragma unroll
        for (int c = 0; c < 8; ++c) { const int q0 = (int)__builtin_rintf(hv[c * 4] * inv), q1 = (int)__builtin_rintf(hv[c * 4 + 1] * inv), q2 = (int)__builtin_rintf(hv[c * 4 + 2] * inv), q3 = (int)__builtin_rintf(hv[c * 4 + 3] * inv);
            dw[c] = (unsigned)(q0 & 255) | ((unsigned)(q1 & 255) << 8) | ((unsigned)(q2 & 255) << 16) | ((unsigned)(q3 & 255) << 24); }
        unsigned char* dst = q8 + (size_t)t * D;
#if TAB4
        *(v4u*)(dst + lane * 32) = (v4u){dw[0], dw[1], dw[2], dw[3]}; *(v4u*)(dst + lane * 32 + 16) = (v4u){dw[4], dw[5], dw[6], dw[7]};
#else
        *(v4u*)(dst + lane * 16) = (v4u){dw[0], dw[1], dw[2], dw[3]}; *(v4u*)(dst + (64 + lane) * 16) = (v4u){dw[4], dw[5], dw[6], dw[7]};
#endif
        if (lane == 0) q8s[t] = mx * (1.0f / 127.0f);
    }
}

__device__ __forceinline__ void ph_prologue_b(const Args& a, LAS unsigned char* lds, int tid, int lane, int wave, int bx, int G) {
    const float* part = (const float*)(a.ws + WS_PART); float* mod = (float*)(a.ws + WS_MOD);
    for (int i = bx * NTHREADS + tid; i < NL * NB * 6 * D / 4; i += G * NTHREADS) {
        const int idx = i * 4, e = idx % (6 * D), b = (idx / (6 * D)) % NB, l = idx / (6 * D * NB);
        f32x4 s = *(const f32x4*)(a.in[3] + l * 6 * D + e);
#pragma unroll
        for (int dr = 0; dr < 8; ++dr) s += *(const f32x4*)(part + (((size_t)l * 8 + dr) * NB + b) * (6 * D) + e);
        *(f32x4*)(mod + idx) = s;
    }
    LAS float* msh = (LAS float*)lds;
    bf16* hbuf = (bf16*)(a.ws + WS_H);
    for (int ch = bx; ch < NCHUNK; ch += G) {
        const int b = ch / NCH;
        for (int i = tid; i < 1024; i += NTHREADS) { const int e = i * 4;
            f32x4 s = *(const f32x4*)(a.in[3] + e);
#pragma unroll
            for (int dr = 0; dr < 8; ++dr) s += *(const f32x4*)(part + (((size_t)0 * 8 + dr) * NB + b) * (6 * D) + e);
            *(LAS f32x4*)(msh + e) = s; }
        __syncthreads();
        for (int i = 0; i < 8; ++i) { const int t = ch * 64 + wave * 8 + i;
#pragma unroll
            for (int c = 0; c < 4; ++c) { const int col = (c * 64 + lane) * 8;
                const f32x4 x0 = *(const f32x4*)(a.in[0] + (size_t)t * D + col), x1 = *(const f32x4*)(a.in[0] + (size_t)t * D + col + 4);
                const f32x4 h0 = *(const LAS f32x4*)(msh + col), h1 = *(const LAS f32x4*)(msh + col + 4), s0 = *(const LAS f32x4*)(msh + 2048 + col), s1 = *(const LAS f32x4*)(msh + 2048 + col + 4);
                v4u o; o.x = pk2(x0.x * (1.f + s0.x) + h0.x, x0.y * (1.f + s0.y) + h0.y); o.y = pk2(x0.z * (1.f + s0.z) + h0.z, x0.w * (1.f + s0.w) + h0.w);
                o.z = pk2(x1.x * (1.f + s1.x) + h1.x, x1.y * (1.f + s1.y) + h1.y); o.w = pk2(x1.z * (1.f + s1.z) + h1.z, x1.w * (1.f + s1.w) + h1.w);
                *(v4u*)(hbuf + (size_t)t * D + col) = o; } }
        __syncthreads();
    }
}

__device__ __forceinline__ void gate_prep(const Args& a, int l, LAS unsigned char* lds, int tid, int lane, int wave, int ch) {
    const bf16* hbuf = (const bf16*)(a.ws + WS_H); const bf16* waT = (const bf16*)(a.ws + WS_WIN) + ((size_t)l * INW + NP) * D;
    float* Ebuf = (float*)(a.ws + WS_E); float* dtot = (float*)(a.ws + WS_DTOT);
    const int t0 = ch * 64, l15 = lane & 15, lq = lane >> 4, mt = wave & 3, kh = wave >> 2;
    f32x4 acc = (f32x4){0.f, 0.f, 0.f, 0.f};
    const bf16* hA = hbuf + (size_t)(t0 + 16 * mt + l15) * D + kh * 1024 + 8 * lq;
    const bf16* wB = waT + (size_t)l15 * D + kh * 1024 + 8 * lq;
#pragma unroll 8
    for (int ks = 0; ks < 32; ++ks) { const bf16x8 av = *(const bf16x8*)(hA + 32 * ks), bv = *(const bf16x8*)(wB + 32 * ks); acc = __builtin_amdgcn_mfma_f32_16x16x32_bf16(av, bv, acc, 0, 0, 0); }
    LAS float* alr = (LAS float*)lds;
#pragma unroll
    for (int r = 0; r < 4; ++r) alr[(kh * 64 + 16 * mt + 4 * lq + r) * 16 + l15] = acc[r];
    __syncthreads();
    const int col = tid;
    float wg[16];
#pragma unroll
    for (int r = 0; r < 16; ++r) wg[r] = a.in[5][((size_t)l * RANK + r) * GKW + col];
    const float bgc = a.in[6][l * GKW + col];
    float tot = 0.f;
    for (int j = 0; j < 64; ++j) { float lg = bgc;
#pragma unroll
        for (int r4 = 0; r4 < 4; ++r4) { const f32x4 p = *(const LAS f32x4*)(alr + j * 16 + r4 * 4), q = *(const LAS f32x4*)(alr + (64 + j) * 16 + r4 * 4);
            lg += (p.x + q.x) * wg[r4 * 4] + (p.y + q.y) * wg[r4 * 4 + 1] + (p.z + q.z) * wg[r4 * 4 + 2] + (p.w + q.w) * wg[r4 * 4 + 3]; }
        tot += logsigmoid_f(lg) * (1.0f / 16.0f); }
    float run = 0.f;
    for (int j = 0; j < 64; ++j) { float lg = bgc;
#pragma unroll
        for (int r4 = 0; r4 < 4; ++r4) { const f32x4 p = *(const LAS f32x4*)(alr + j * 16 + r4 * 4), q = *(const LAS f32x4*)(alr + (64 + j) * 16 + r4 * 4);
            lg += (p.x + q.x) * wg[r4 * 4] + (p.y + q.y) * wg[r4 * 4 + 1] + (p.z + q.z) * wg[r4 * 4 + 2] + (p.w + q.w) * wg[r4 * 4 + 3]; }
        run += logsigmoid_f(lg) * (1.0f / 16.0f);
        Ebuf[(size_t)(t0 + j) * GKW + col] = __expf(tot - run); }
    dtot[(size_t)ch * GKW + col] = __expf(tot);
    __syncthreads();
}

__device__ __forceinline__ void gla_unit(const Args& a, LAS unsigned char* lds, int tid, int lane, int wave, int un) {
    const bf16* proj = (const bf16*)(a.ws + WS_PROJ); const float* Ebuf = (const float*)(a.ws + WS_E); const float* dtot = (const float*)(a.ws + WS_DTOT); bf16* ogla = (bf16*)(a.ws + WS_OGLA);
    const int dvs = un & 7, hh = (un >> 3) & 3, b = un >> 5;
    LAS bf16* kdT = (LAS bf16*)lds;
    LAS bf16* vT = (LAS bf16*)(lds + 18432);
    LAS bf16* ST = (LAS bf16*)(lds + 18432 + 4608);
    const int l15 = lane & 15, lq = lane >> 4, jl = tid >> 3, d16 = (tid & 7) * 16, dv4 = (tid & 7) * 4, jt = (wave & 3) * 16, dvt = (wave >> 2) * 16;
    f32x4 S0 = (f32x4){0.f, 0.f, 0.f, 0.f}, S1 = (f32x4){0.f, 0.f, 0.f, 0.f};
    v4u kn0[2], kn1[2]; f32x4 en0[4], en1[4]; v2u vn0, vn1; bf16x8 qn0[4], qn1[4], qc[4]; f32x4 dn0, dn1, dc;
#define GLA_LOAD(c, kn, en, vn, qn, dn) do { const int t0c = b * SEQ + (c) * 64; const bf16* pr = proj + (size_t)(t0c + jl) * NP; \
        kn[0] = *(const v4u*)(pr + PK + hh * 128 + d16); kn[1] = *(const v4u*)(pr + PK + hh * 128 + d16 + 8); \
        _Pragma("unroll") for (int i_ = 0; i_ < 4; ++i_) en[i_] = *(const f32x4*)(Ebuf + (size_t)(t0c + jl) * GKW + hh * 128 + d16 + 4 * i_); \
        vn = *(const v2u*)(pr + PV + hh * 256 + dvs * 32 + dv4); \
        _Pragma("unroll") for (int ks_ = 0; ks_ < 4; ++ks_) qn[ks_] = *(const bf16x8*)(proj + (size_t)(t0c + jt + l15) * NP + PQ + hh * 128 + 32 * ks_ + 8 * lq); \
        dn = *(const f32x4*)(dtot + (size_t)(b * NCH + (c)) * GKW + hh * 128 + 16 * wave + 4 * lq); } while (0)
#define GLA_PREP(kn, en, vn, qn, dn) do { \
        _Pragma("unroll") for (int i_ = 0; i_ < 16; ++i_) { const unsigned w_ = kn[i_ >> 3][(i_ & 7) >> 1]; const float kf_ = (i_ & 1) ? bfhi(w_) : bflo(w_); \
            kdT[(d16 + i_) * 72 + jl] = (bf16)(pk2(kf_ * en[i_ >> 2][i_ & 3], 0.f) & 0xffffu); } \
        _Pragma("unroll") for (int i_ = 0; i_ < 4; ++i_) { const unsigned w_ = vn[i_ >> 1]; vT[(dv4 + i_) * 72 + jl] = (bf16)((i_ & 1) ? (w_ >> 16) : (w_ & 0xffffu)); } \
        _Pragma("unroll") for (int ks_ = 0; ks_ < 4; ++ks_) qc[ks_] = qn[ks_]; \
        dc = dn; } while (0)
#define GLA_BODY(c) do { \
        S0 = S0 * dc; S1 = S1 * dc; \
        _Pragma("unroll") for (int ks = 0; ks < 2; ++ks) { \
            const bf16x8 A_ = *(const LAS bf16x8*)(kdT + (16 * wave + l15) * 72 + 32 * ks + 8 * lq); \
            const bf16x8 B0_ = *(const LAS bf16x8*)(vT + l15 * 72 + 32 * ks + 8 * lq), B1_ = *(const LAS bf16x8*)(vT + (16 + l15) * 72 + 32 * ks + 8 * lq); \
            S0 = __builtin_amdgcn_mfma_f32_16x16x32_bf16(A_, B0_, S0, 0, 0, 0); S1 = __builtin_amdgcn_mfma_f32_16x16x32_bf16(A_, B1_, S1, 0, 0, 0); } \
        { v2u w0_, w1_; w0_.x = pk2(S0.x, S0.y); w0_.y = pk2(S0.z, S0.w); w1_.x = pk2(S1.x, S1.y); w1_.y = pk2(S1.z, S1.w); \
          *(LAS v2u*)(ST + l15 * 136 + 16 * wave + 4 * lq) = w0_; *(LAS v2u*)(ST + (16 + l15) * 136 + 16 * wave + 4 * lq) = w1_; } \
        __syncthreads(); \
        f32x4 O_ = (f32x4){0.f, 0.f, 0.f, 0.f}; \
        _Pragma("unroll") for (int ks = 0; ks < 4; ++ks) { const bf16x8 A_ = *(const LAS bf16x8*)(ST + (dvt + l15) * 136 + 32 * ks + 8 * lq); O_ = __builtin_amdgcn_mfma_f32_16x16x32_bf16(A_, qc[ks], O_, 0, 0, 0); } \
        { const f32x4 Os_ = O_ * 0.08838834764831845f; v2u ob_; ob_.x = pk2(Os_.x, Os_.y); ob_.y = pk2(Os_.z, Os_.w); \
          *(v2u*)(ogla + (size_t)(b * SEQ + (c) * 64 + jt + l15) * 1024 + hh * 256 + dvs * 32 + dvt + 4 * lq) = ob_; } } while (0)
    GLA_LOAD(0, kn0, en0, vn0, qn0, dn0); GLA_LOAD(1, kn1, en1, vn1, qn1, dn1);
    GLA_PREP(kn0, en0, vn0, qn0, dn0);
    __syncthreads();
    for (int c = 0; c < NCH; c += 2) {
        if (c + 2 < NCH) GLA_LOAD(c + 2, kn0, en0, vn0, qn0, dn0);
        GLA_BODY(c);
        GLA_PREP(kn1, en1, vn1, qn1, dn1);
        __syncthreads();
        if (c + 3 < NCH) GLA_LOAD(c + 3, kn1, en1, vn1, qn1, dn1);
        GLA_BODY(c + 1);
        if (c + 2 < NCH) GLA_PREP(kn0, en0, vn0, qn0, dn0);
        __syncthreads();
    }
#undef GLA_BODY
#undef GLA_LOAD
#undef GLA_PREP
}

__device__ __forceinline__ void unpack16(const v4u& p0, const v4u& p1, float (&o)[16]) {
#pragma unroll
    for (int j = 0; j < 4; ++j) { o[2 * j] = bflo(p0[j]); o[2 * j + 1] = bfhi(p0[j]); o[8 + 2 * j] = bflo(p1[j]); o[8 + 2 * j + 1] = bfhi(p1[j]); }
}
__device__ __forceinline__ void mixpost_chunk(const Args& a, int l, int lane, int wave, int ch) {
    const bf16* proj = (const bf16*)(a.ws + WS_PROJ); const bf16* ogla = (const bf16*)(a.ws + WS_OGLA); bf16* ybuf = (bf16*)(a.ws + WS_Y);
    const int c0 = 16 * lane, tfirst = ch * 64 + wave * 8, sfirst = tfirst % SEQ;
    float gn[16], cw0[16], cw1[16], cw2[16], cn[16], u1[16], u2[16];
#pragma unroll
    for (int i = 0; i < 16; ++i) { gn[i] = a.in[7][l * 256 + ((c0 + i) & 255)]; cw0[i] = a.in[8][(size_t)l * 3072 + c0 + i]; cw1[i] = a.in[8][(size_t)l * 3072 + 1024 + c0 + i];
        cw2[i] = a.in[8][(size_t)l * 3072 + 2048 + c0 + i]; cn[i] = a.in[9][l * 1024 + c0 + i]; u1[i] = 0.f; u2[i] = 0.f; }
    if (sfirst >= 2) {
        float cc[16], chh[16];
        { const bf16* pr = proj + (size_t)(tfirst - 2) * NP; unpack16(*(const v4u*)(pr + PCC + c0), *(const v4u*)(pr + PCC + c0 + 8), cc); unpack16(*(const v4u*)(pr + PCH + c0), *(const v4u*)(pr + PCH + c0 + 8), chh); }
#pragma unroll
        for (int i = 0; i < 16; ++i) u2[i] = cc[i] * chh[i];
        { const bf16* pr = proj + (size_t)(tfirst - 1) * NP; unpack16(*(const v4u*)(pr + PCC + c0), *(const v4u*)(pr + PCC + c0 + 8), cc); unpack16(*(const v4u*)(pr + PCH + c0), *(const v4u*)(pr + PCH + c0 + 8), chh); }
#pragma unroll
        for (int i = 0; i < 16; ++i) u1[i] = cc[i] * chh[i];
    }
#pragma unroll 2
    for (int it = 0; it < 8; ++it) { const int t = tfirst + it; const bf16* pr = proj + (size_t)t * NP;
        float o[16], r[16], cb[16], cc[16], chh[16];
        unpack16(*(const v4u*)(ogla + (size_t)t * 1024 + c0), *(const v4u*)(ogla + (size_t)t * 1024 + c0 + 8), o);
        unpack16(*(const v4u*)(pr + PR + c0), *(const v4u*)(pr + PR + c0 + 8), r);
        unpack16(*(const v4u*)(pr + PCB + c0), *(const v4u*)(pr + PCB + c0 + 8), cb);
        unpack16(*(const v4u*)(pr + PCC + c0), *(const v4u*)(pr + PCC + c0 + 8), cc);
        unpack16(*(const v4u*)(pr + PCH + c0), *(const v4u*)(pr + PCH + c0 + 8), chh);
        float ss = 0.f;
#pragma unroll
        for (int i = 0; i < 16; ++i) ss += o[i] * o[i];
        ss += __shfl_xor(ss, 1); ss += __shfl_xor(ss, 2); ss += __shfl_xor(ss, 4); ss += __shfl_xor(ss, 8);
        const float rg = rsqrtf(ss * (1.0f / 256.f) + EPS);
        float val[16]; float s2 = 0.f;
#pragma unroll
        for (int i = 0; i < 16; ++i) { const float u0 = cc[i] * chh[i]; val[i] = cb[i] * (cw0[i] * u2[i] + cw1[i] * u1[i] + cw2[i] * u0); s2 += val[i] * val[i]; u2[i] = u1[i]; u1[i] = u0; }
        const float rc = rsqrtf(wave_sum(s2) * (1.0f / 1024.f) + EPS);
        v4u y0, y1, y2, y3;
#pragma unroll
        for (int j = 0; j < 4; ++j) {
            y0[j] = pk2(o[2 * j] * rg * gn[2 * j] * silu_f(r[2 * j]), o[2 * j + 1] * rg * gn[2 * j + 1] * silu_f(r[2 * j + 1]));
            y1[j] = pk2(o[8 + 2 * j] * rg * gn[8 + 2 * j] * silu_f(r[8 + 2 * j]), o[9 + 2 * j] * rg * gn[9 + 2 * j] * silu_f(r[9 + 2 * j]));
            y2[j] = pk2(val[2 * j] * rc * cn[2 * j], val[2 * j + 1] * rc * cn[2 * j + 1]);
            y3[j] = pk2(val[8 + 2 * j] * rc * cn[8 + 2 * j], val[9 + 2 * j] * rc * cn[9 + 2 * j]); }
        bf16* yr = ybuf + (size_t)t * D;
        *(v4u*)(yr + c0) = y0; *(v4u*)(yr + c0 + 8) = y1; *(v4u*)(yr + 1024 + c0) = y2; *(v4u*)(yr + 1024 + c0 + 8) = y3;
    }
}

__device__ __forceinline__ void ln1_chunk(const Args& a, int l, int lane, int wave, int ch) {
    const float* zbuf = (const float*)(a.ws + WS_Z); const float* mod = (const float*)(a.ws + WS_MOD);
    const int b = ch / NCH; const float* mb = mod + ((size_t)l * NB + b) * 6 * D;
#pragma unroll 2
    for (int it = 0; it < 8; ++it) { const int t = ch * 64 + wave * 8 + it;
        float z[32];
#pragma unroll
        for (int c = 0; c < 8; ++c) { const f32x4 v0 = *(const f32x4*)(zbuf + (size_t)t * D + (c * 64 + lane) * 4); z[c * 4] = v0.x; z[c * 4 + 1] = v0.y; z[c * 4 + 2] = v0.z; z[c * 4 + 3] = v0.w; }
        ln_tail(z, t, lane, a.in[11] + (size_t)l * D, a.in[12] + (size_t)l * D, (float*)(a.ws + WS_X1), mb + 3 * D, mb + 4 * D, (bf16*)(a.ws + WS_H2), a.ws + WS_HQ8, (float*)(a.ws + WS_HSC));
    }
}

template <int N> __device__ __forceinline__ void bitonic_sort_desc(float (&v)[N]) {
#pragma unroll
    for (int k = 2; k <= N; k <<= 1)
#pragma unroll
        for (int j = k >> 1; j > 0; j >>= 1)
#pragma unroll
            for (int i = 0; i < N; ++i) { const int p = i ^ j; if (p > i) { const bool desc = ((i & k) == 0); const float x = v[i], y = v[p]; const float mx = fmaxf(x, y), mn = fminf(x, y); v[i] = desc ? mx : mn; v[p] = desc ? mn : mx; } }
}
__device__ __forceinline__ void merge_top16(float (&x)[16], const float (&y)[16]) {
#pragma unroll
    for (int i = 0; i < 16; ++i) x[i] = fmaxf(x[i], y[15 - i]);
#pragma unroll
    for (int j = 8; j > 0; j >>= 1)
#pragma unroll
        for (int i = 0; i < 16; ++i) { const int p = i ^ j; if (p > i) { const float u = x[i], w = x[p]; x[i] = fmaxf(u, w); x[p] = fminf(u, w); } }
}
__device__ __forceinline__ void ce_desc(float& ka, int& pa, float& kb, int& pb) { const bool sw = kb > ka; const float k0 = sw ? kb : ka, k1 = sw ? ka : kb; const int p0 = sw ? pb : pa, p1 = sw ? pa : pb; ka = k0; pa = p0; kb = k1; pb = p1; }
__device__ __forceinline__ void bitonic_sort_desc_kp(float (&k)[16], int (&p)[16]) {
#pragma unroll
    for (int kk = 2; kk <= 16; kk <<= 1)
#pragma unroll
        for (int j = kk >> 1; j > 0; j >>= 1)
#pragma unroll
            for (int i = 0; i < 16; ++i) { const int q = i ^ j; if (q > i) { if ((i & kk) == 0) ce_desc(k[i], p[i], k[q], p[q]); else ce_desc(k[q], p[q], k[i], p[i]); } }
}
__device__ __forceinline__ void merge_top16_kp(float (&k)[16], int (&p)[16], const float (&k2)[16], const int (&p2)[16]) {
#pragma unroll
    for (int i = 0; i < 16; ++i) { const bool sw = k2[15 - i] > k[i]; k[i] = sw ? k2[15 - i] : k[i]; p[i] = sw ? p2[15 - i] : p[i]; }
#pragma unroll
    for (int j = 8; j > 0; j >>= 1)
#pragma unroll
        for (int i = 0; i < 16; ++i) { const int q = i ^ j; if (q > i) ce_desc(k[i], p[i], k[q], p[q]); }
}
__device__ constexpr int cand_i(int s) { return s < 16 ? 0 : s < 24 ? 1 : s < 29 ? 2 : s < 33 ? 3 : s < 36 ? 4 : s < 38 ? 5 : s < 40 ? 6 : s < 42 ? 7 : s < 50 ? s - 34 : -1; }
__device__ constexpr int cand_j(int s) { return s < 16 ? s : s < 24 ? s - 16 : s < 29 ? s - 24 : s < 33 ? s - 29 : s < 36 ? s - 33 : s < 38 ? s - 36 : s < 40 ? s - 38 : s < 42 ? s - 40 : s < 50 ? 0 : -1; }

__device__ __forceinline__ void peer_retrieve(const Args& a, int l, LAS unsigned char* lds, int lane, int wave, int ch) {
    const bf16* qbuf = (const bf16*)(a.ws + WS_Q); const bf16* keys = (const bf16*)(a.ws + WS_KEYS) + ((size_t)(l * 8 + wave) * 2) * 128 * 128;
    LAS int* eg_e = (LAS int*)lds; LAS float* eg_g = (LAS float*)(lds + 32768);
    const int l31 = lane & 31, l5 = lane >> 5, h = wave, t0 = ch * 64;
    for (int tt = 0; tt < 2; ++tt) {
        float sv[2][16];
#pragma unroll
        for (int p = 0; p < 2; ++p) {
            f32x16 acc[4];
#pragma unroll
            for (int nt = 0; nt < 4; ++nt)
#pragma unroll
                for (int r = 0; r < 16; ++r) acc[nt][r] = 0.f;
            const bf16* qp = qbuf + (size_t)(t0 + 32 * tt + l31) * D + h * 256 + p * 128 + 8 * l5;
            const bf16* kp = keys + (size_t)(p * 128 + l31) * 128 + 8 * l5;
#pragma unroll 2
            for (int ks = 0; ks < 8; ++ks) { const bf16x8 bq = *(const bf16x8*)(qp + 16 * ks);
#pragma unroll
                for (int nt = 0; nt < 4; ++nt) { const bf16x8 ak = *(const bf16x8*)(kp + (size_t)(32 * nt) * 128 + 16 * ks); acc[nt] = __builtin_amdgcn_mfma_f32_32x32x16_bf16(ak, bq, acc[nt], 0, 0, 0); } }
            float v[4][16];
#pragma unroll
            for (int nt = 0; nt < 4; ++nt)
#pragma unroll
                for (int r = 0; r < 16; ++r) { const unsigned idx = 32u * nt + (r & 3) + 8u * (r >> 2) + 4u * l5; v[nt][r] = __uint_as_float((__float_as_uint(acc[nt][r]) & 0xffffff80u) | idx); }
#pragma unroll
            for (int nt = 0; nt < 4; ++nt) bitonic_sort_desc<16>(v[nt]);
            merge_top16(v[0], v[1]); merge_top16(v[2], v[3]); merge_top16(v[0], v[2]);
            float o[16];
#pragma unroll
            for (int i = 0; i < 16; ++i) o[i] = __shfl_xor(v[0][i], 32);
            merge_top16(v[0], o);
#pragma unroll
            for (int i = 0; i < 16; ++i) sv[p][i] = v[0][i];
        }
        LAS unsigned char* idxb = (LAS unsigned char*)(lds + 69632) + wave * 2048 + lane * 32;
        { v4u w0, w1;
#pragma unroll
          for (int q4 = 0; q4 < 4; ++q4) {
              w0[q4] = (__float_as_uint(sv[0][4 * q4]) & 127u) | ((__float_as_uint(sv[0][4 * q4 + 1]) & 127u) << 8) | ((__float_as_uint(sv[0][4 * q4 + 2]) & 127u) << 16) | ((__float_as_uint(sv[0][4 * q4 + 3]) & 127u) << 24);
              w1[q4] = (__float_as_uint(sv[1][4 * q4]) & 127u) | ((__float_as_uint(sv[1][4 * q4 + 1]) & 127u) << 8) | ((__float_as_uint(sv[1][4 * q4 + 2]) & 127u) << 16) | ((__float_as_uint(sv[1][4 * q4 + 3]) & 127u) << 24); }
          *(LAS v4u*)(idxb) = w0; *(LAS v4u*)(idxb + 16) = w1; }
        float ck[4][16];
#pragma unroll
        for (int s = 0; s < 64; ++s) {
            if (cand_i(s) >= 0) { const unsigned b0 = __float_as_uint(sv[0][cand_i(s) < 0 ? 0 : cand_i(s)]), b1 = __float_as_uint(sv[1][cand_j(s) < 0 ? 0 : cand_j(s)]);
                const float sum = __uint_as_float(b0 & 0xffffff80u) + __uint_as_float(b1 & 0xffffff80u);
                ck[s >> 4][s & 15] = __uint_as_float((__float_as_uint(sum) & 0xffffff00u) | (unsigned)((cand_i(s) < 0 ? 0 : cand_i(s)) * 16 + (cand_j(s) < 0 ? 0 : cand_j(s)))); }
            else ck[s >> 4][s & 15] = -3.0e38f; }
        bitonic_sort_desc<16>(ck[1]); bitonic_sort_desc<16>(ck[2]);
        merge_top16(ck[0], ck[1]); merge_top16(ck[2], ck[3]); merge_top16(ck[0], ck[2]);
        LDS_WAIT(); asm volatile("" ::: "memory");
        float ex[16]; int ce[16]; float den = 0.f;
        const float cmax = __uint_as_float(__float_as_uint(ck[0][0]) & 0xffffff00u);
#pragma unroll
        for (int i = 0; i < 16; ++i) { const unsigned bits = __float_as_uint(ck[0][i]); ex[i] = __expf(__uint_as_float(bits & 0xffffff00u) - cmax); den += ex[i];
            ce[i] = (int)idxb[(bits >> 4) & 15u] * 128 + (int)idxb[16 + (bits & 15u)]; }
        const float inv = 1.0f / den;
        if (l5 == 0) {
            const int base = (32 * tt + l31) * 128 + h * 16;
#pragma unroll
            for (int i4 = 0; i4 < 4; ++i4) { *(LAS v4u*)(eg_e + base + 4 * i4) = (v4u){(unsigned)ce[4 * i4], (unsigned)ce[4 * i4 + 1], (unsigned)ce[4 * i4 + 2], (unsigned)ce[4 * i4 + 3]};
                *(LAS f32x4*)(eg_g + base + 4 * i4) = (f32x4){ex[4 * i4] * inv, ex[4 * i4 + 1] * inv, ex[4 * i4 + 2] * inv, ex[4 * i4 + 3] * inv}; }
        }
        LDS_WAIT(); asm volatile("" ::: "memory");
    }
}

typedef unsigned char uc4 __attribute__((ext_vector_type(4)));
constexpr int NSLICE = 16, SLICE_SHIFT = 10;
__device__ __forceinline__ int sdot4i(unsigned w, unsigned x, int acc) { return __builtin_amdgcn_sdot4((int)w, (int)x, acc, false); }
__device__ __forceinline__ void fma_ub4(unsigned w, float s, float& y0, float& y1, float& y2, float& y3) { const uc4 b = __builtin_bit_cast(uc4, w); y0 += s * (float)b.x; y1 += s * (float)b.y; y2 += s * (float)b.z; y3 += s * (float)b.w; }
#if TAB4
__device__ __forceinline__ void peer_tail(const Args& a, int l, int t, int lane, const float* Yrow, const float* mb, const float* mbn, bool last) {
    const float* x1buf = (const float*)(a.ws + WS_X1);
    float z[32];
#pragma unroll
    for (int c8 = 0; c8 < 8; ++c8) { const int col = (c8 * 64 + lane) * 4;
        const f32x4 yv = *(const f32x4*)(Yrow + lane * 32 + 4 * c8), x0 = *(const f32x4*)(x1buf + (size_t)t * D + col), g0 = *(const f32x4*)(mb + 5 * D + col);
        z[c8 * 4] = ALPHA * x0.x + (1.f + g0.x) * yv.x; z[c8 * 4 + 1] = ALPHA * x0.y + (1.f + g0.y) * yv.y; z[c8 * 4 + 2] = ALPHA * x0.z + (1.f + g0.z) * yv.z; z[c8 * 4 + 3] = ALPHA * x0.w + (1.f + g0.w) * yv.w; }
    ln_tail(z, t, lane, a.in[17] + (size_t)l * D, a.in[18] + (size_t)l * D, last ? a.out : (float*)(a.ws + WS_X), mbn, mbn + D, last ? (bf16*)nullptr : (bf16*)(a.ws + WS_H), nullptr, nullptr);
}
template <class TT, int N, int M> __device__ __forceinline__ void treduce(TT (&v)[N], int lane) {
    const bool c0 = (lane & M) != 0, c1 = (lane & (2 * M)) != 0, c2 = (lane & (4 * M)) != 0;
#pragma unroll
    for (int m = 0; m < N / 2; ++m) { const TT keep = c0 ? v[2 * m + 1] : v[2 * m], send = c0 ? v[2 * m] : v[2 * m + 1]; v[m] = keep + __shfl_xor(send, M); }
#pragma unroll
    for (int m = 0; m < N / 4; ++m) { const TT keep = c1 ? v[2 * m + 1] : v[2 * m], send = c1 ? v[2 * m] : v[2 * m + 1]; v[m] = keep + __shfl_xor(send, 2 * M); }
#pragma unroll
    for (int m = 0; m < N / 8; ++m) { const TT keep = c2 ? v[2 * m + 1] : v[2 * m], send = c2 ? v[2 * m] : v[2 * m + 1]; v[m] = keep + __shfl_xor(send, 4 * M); }
}
__device__ __forceinline__ void peer_experts(const Args& a, int l, LAS unsigned char* lds, int lane0, int wave, int ch) {
    const float* mod = (const float*)(a.ws + WS_MOD);
    const unsigned char* ut = a.ws + WS_UT + (size_t)l * NE * 1024; const unsigned char* vt = a.ws + WS_VT + (size_t)l * NE * 1024; const unsigned char* hq8 = a.ws + WS_HQ8;
    const bf16* us = (const bf16*)(a.ws + WS_UT + 128 * MiB) + (size_t)l * NE * 64; const bf16* vs = (const bf16*)(a.ws + WS_VT + 128 * MiB) + (size_t)l * NE * 64; const float* hsc = (const float*)(a.ws + WS_HSC);
    float* Ybuf = (float*)(a.ws + WS_Z);
    const LAS int* eg_e = (const LAS int*)lds; LAS float* sw = (LAS float*)(lds + 32768);
    LAS float* apart = (LAS float*)(lds + 65536);
    const int b = ch / NCH; const bool last = (l == NL - 1);
    const float* mb = mod + ((size_t)l * NB + b) * 6 * D; const float* mbn = mod + ((size_t)(last ? l : l + 1) * NB + b) * 6 * D;
    const int tlw = wave * 8;
    { const int lane = lane0;
#pragma unroll
      for (int i = 0; i < 16; ++i) apart[tlw * 128 + i * 64 + lane] = 0.f; }
    LDS_WAIT(); asm volatile("" ::: "memory");
    {
        int laneL = lane0; asm volatile("" : "+v"(laneL)); const int lane = laneL;
        const int g = lane >> 3, l7 = lane & 7;
        v4u bufA[8], bufB[8]; unsigned short scA[8], scB[8]; v4u hA0, hA1, hN0, hN1; float accv[16];
#define CU_LOAD(buf, sc_, hidx_) do { const int cs_ = (hidx_) >> 4, tl_ = tlw + (((hidx_) >> 1) & 7), hf_ = (hidx_) & 1; const unsigned seg_ = (unsigned)(cs_ * 8 + l7); \
            _Pragma("unroll") for (int i_ = 0; i_ < 8; ++i_) { const unsigned e_ = (unsigned)eg_e[tl_ * 128 + 8 * (8 * hf_ + i_) + g]; buf[i_] = *(const v4u*)(ut + (size_t)(e_ * 1024u + seg_ * 16u)); sc_[i_] = us[(size_t)(e_ * 64u + seg_)]; } } while (0)
#define CU_HLOAD(hidx_) do { const int cs_ = (hidx_) >> 4, tl_ = tlw + (((hidx_) >> 1) & 7); const unsigned char* hp_ = hq8 + (size_t)(ch * 64 + tl_) * D + (cs_ * 8 + l7) * 32; hN0 = *(const v4u*)hp_; hN1 = *(const v4u*)(hp_ + 16); } while (0)
#define CU_COMP(buf, sc_, hf_) do { int hs_ = 0; \
            _Pragma("unroll") for (int q_ = 0; q_ < 4; ++q_) { hs_ = sdot4i(hA0[q_], 0x01010101u, hs_); hs_ = sdot4i(hA1[q_], 0x01010101u, hs_); } \
            _Pragma("unroll") for (int i_ = 0; i_ < 8; ++i_) { int s_ = 0; \
                _Pragma("unroll") for (int q_ = 0; q_ < 4; ++q_) { const unsigned w_ = buf[i_][q_]; const unsigned he_ = q_ < 2 ? hA0[2 * q_] : hA1[2 * q_ - 4], ho_ = q_ < 2 ? hA0[2 * q_ + 1] : hA1[2 * q_ - 3]; \
                    s_ = sdot4i(w_ & 0x0f0f0f0fu, he_, s_); s_ = sdot4i((w_ >> 4) & 0x0f0f0f0fu, ho_, s_); } \
                accv[8 * (hf_) + i_] = bflo((unsigned)sc_[i_]) * (float)(s_ - 8 * hs_); } } while (0)
        CU_LOAD(bufA, scA, 0); CU_HLOAD(0);
        for (int hidx = 0; hidx < 128; hidx += 2) {
            CU_LOAD(bufB, scB, hidx + 1);
            hA0 = hN0; hA1 = hN1; if (hidx + 2 < 128) CU_HLOAD(hidx + 2);
            CU_COMP(bufA, scA, 0);
            if (hidx + 2 < 128) CU_LOAD(bufA, scA, hidx + 2);
            CU_COMP(bufB, scB, 1);
            treduce<float, 16, 1>(accv, lane);
            { const int tl_ = tlw + ((hidx >> 1) & 7); apart[tl_ * 128 + 8 * l7 + g] += accv[0]; apart[tl_ * 128 + 8 * (8 + l7) + g] += accv[1]; }
        }
#undef CU_LOAD
#undef CU_HLOAD
#undef CU_COMP
        LDS_WAIT(); asm volatile("" ::: "memory");
        for (int it = 0; it < 8; ++it) { const int tl = tlw + it; const float shs = hsc[ch * 64 + tl];
            const float w0 = sw[tl * 128 + lane] * gelu_tanh_f(apart[tl * 128 + lane] * shs), w1 = sw[tl * 128 + 64 + lane] * gelu_tanh_f(apart[tl * 128 + 64 + lane] * shs);
            sw[tl * 128 + lane] = w0; sw[tl * 128 + 64 + lane] = w1; }
        LDS_WAIT(); asm volatile("" ::: "memory");
    }
    {
        int laneL = lane0; asm volatile("" : "+v"(laneL)); const int lane = laneL;
        const int g = lane >> 3, l7 = lane & 7;
        v4u bufA[8], bufB[8]; unsigned short scA[8], scB[8]; float y[32]; float offs;
#define CV_LOAD(buf, sc_, hidx_) do { const int cs_ = (hidx_) >> 4, tl_ = tlw + (((hidx_) >> 1) & 7), hf_ = (hidx_) & 1; const unsigned seg_ = (unsigned)(cs_ * 8 + l7); \
            _Pragma("unroll") for (int i_ = 0; i_ < 8; ++i_) { const unsigned e_ = (unsigned)eg_e[tl_ * 128 + 8 * (8 * hf_ + i_) + g]; buf[i_] = *(const v4u*)(vt + (size_t)(e_ * 1024u + seg_ * 16u)); sc_[i_] = vs[(size_t)(e_ * 64u + seg_)]; } } while (0)
#define CV_COMP(buf, sc_, hidx_) do { const int tl_ = tlw + (((hidx_) >> 1) & 7), hf_ = (hidx_) & 1; \
            _Pragma("unroll") for (int i_ = 0; i_ < 8; ++i_) { const float ws_ = sw[tl_ * 128 + 8 * (8 * hf_ + i_) + g] * bflo((unsigned)sc_[i_]); offs += ws_; \
                _Pragma("unroll") for (int q_ = 0; q_ < 4; ++q_) { const unsigned w_ = buf[i_][q_]; \
                    fma_ub4(w_ & 0x0f0f0f0fu, ws_, y[8 * q_], y[8 * q_ + 1], y[8 * q_ + 2], y[8 * q_ + 3]); fma_ub4((w_ >> 4) & 0x0f0f0f0fu, ws_, y[8 * q_ + 4], y[8 * q_ + 5], y[8 * q_ + 6], y[8 * q_ + 7]); } } } while (0)
        CV_LOAD(bufA, scA, 0);
        for (int hidx = 0; hidx < 128; hidx += 2) {
            CV_LOAD(bufB, scB, hidx + 1);
#pragma unroll
            for (int q = 0; q < 32; ++q) y[q] = 0.f;
            offs = 0.f;
            CV_COMP(bufA, scA, hidx);
            if (hidx + 2 < 128) CV_LOAD(bufA, scA, hidx + 2);
            CV_COMP(bufB, scB, hidx + 1);
            treduce<float, 32, 8>(y, lane);
            offs += __shfl_xor(offs, 8); offs += __shfl_xor(offs, 16); offs += __shfl_xor(offs, 32);
            { const int cs_ = hidx >> 4, tl_ = tlw + ((hidx >> 1) & 7); float* yr_ = Ybuf + (size_t)(ch * 64 + tl_) * D + (cs_ * 8 + l7) * 32 + g; const float o8_ = 8.0f * offs;
              yr_[0] = y[0] - o8_; yr_[8] = y[1] - o8_; yr_[16] = y[2] - o8_; yr_[24] = y[3] - o8_; }
        }
#undef CV_LOAD
#undef CV_COMP
    }
    asm volatile("s_waitcnt vmcnt(0)" ::: "memory");
    __builtin_amdgcn_fence(__ATOMIC_ACQUIRE, "agent");
    asm volatile("s_waitcnt vmcnt(0)" ::: "memory");
    for (int it = 0; it < 8; ++it) { int laneT = lane0; asm volatile("" : "+v"(laneT)); const int t = ch * 64 + tlw + it;
        peer_tail(a, l, t, laneT, Ybuf + (size_t)t * D, mb, mbn, last); }
}
#else
__device__ __forceinline__ void peer_tail(const Args& a, int l, int t, int lane, const float* Yrow, const float* mb, const float* mbn, bool last) {
    const float* x1buf = (const float*)(a.ws + WS_X1);
    float z[32];
#pragma unroll
    for (int c = 0; c < 2; ++c)
#pragma unroll
        for (int k = 0; k < 4; ++k) { const int c8 = 4 * c + k, col = (c8 * 64 + lane) * 4;
            const v2u yb = *(const v2u*)((const bf16*)Yrow + (c * 64 + lane) * 16 + 4 * k); const f32x4 yv = (f32x4){bflo(yb.x), bfhi(yb.x), bflo(yb.y), bfhi(yb.y)};
            const f32x4 x0 = *(const f32x4*)(x1buf + (size_t)t * D + col), g0 = *(const f32x4*)(mb + 5 * D + col);
            z[c8 * 4] = ALPHA * x0.x + (1.f + g0.x) * yv.x; z[c8 * 4 + 1] = ALPHA * x0.y + (1.f + g0.y) * yv.y; z[c8 * 4 + 2] = ALPHA * x0.z + (1.f + g0.z) * yv.z; z[c8 * 4 + 3] = ALPHA * x0.w + (1.f + g0.w) * yv.w; }
    ln_tail(z, t, lane, a.in[17] + (size_t)l * D, a.in[18] + (size_t)l * D, last ? a.out : (float*)(a.ws + WS_X), mbn, mbn + D, last ? (bf16*)nullptr : (bf16*)(a.ws + WS_H), nullptr, nullptr);
}
template <class TT, int M> __device__ __forceinline__ void treduce16(TT (&v)[16], int lane) {
    const bool c0 = (lane & M) != 0, c1 = (lane & (2 * M)) != 0, c2 = (lane & (4 * M)) != 0;
#pragma unroll
    for (int m = 0; m < 8; ++m) { const TT keep = c0 ? v[2 * m + 1] : v[2 * m], send = c0 ? v[2 * m] : v[2 * m + 1]; v[m] = keep + __shfl_xor(send, M); }
#pragma unroll
    for (int m = 0; m < 4; ++m) { const TT keep = c1 ? v[2 * m + 1] : v[2 * m], send = c1 ? v[2 * m] : v[2 * m + 1]; v[m] = keep + __shfl_xor(send, 2 * M); }
#pragma unroll
    for (int m = 0; m < 2; ++m) { const TT keep = c2 ? v[2 * m + 1] : v[2 * m], send = c2 ? v[2 * m] : v[2 * m + 1]; v[m] = keep + __shfl_xor(send, 4 * M); }
}
__device__ __forceinline__ void peer_experts(const Args& a, int l, LAS unsigned char* lds, int lane0, int wave, int ch) {
    const float* mod = (const float*)(a.ws + WS_MOD);
    const unsigned char* ut = a.ws + WS_UT + (size_t)l * NE * D; const unsigned char* vt = a.ws + WS_VT + (size_t)l * NE * D; const unsigned char* hq8 = a.ws + WS_HQ8;
    const float* su = (const float*)(a.ws + WS_SU) + (size_t)l * NE; const float* sv = (const float*)(a.ws + WS_SV) + (size_t)l * NE; const float* hsc = (const float*)(a.ws + WS_HSC);
    float* Ybuf = (float*)(a.ws + WS_Z);
    const LAS int* eg_e = (const LAS int*)lds; LAS float* sw = (LAS float*)(lds + 32768);
    LAS int* apart = (LAS int*)(lds + 65536); LAS float* wtotl = (LAS float*)(lds + LDSCTL_OFF + 256);
    const int b = ch / NCH; const bool last = (l == NL - 1);
    const float* mb = mod + ((size_t)l * NB + b) * 6 * D; const float* mbn = mod + ((size_t)(last ? l : l + 1) * NB + b) * 6 * D;
    const int tlw = wave * 8;
    { const int lane = lane0;
#pragma unroll
      for (int i = 0; i < 16; ++i) apart[tlw * 128 + i * 64 + lane] = 0; }
    LDS_WAIT(); asm volatile("" ::: "memory");
    {
        int laneL = lane0; asm volatile("" : "+v"(laneL)); const int lane = laneL;
        const int g = lane >> 3, l7 = lane & 7;
        v4u bufA[16], bufB[16], hA, hB;
#define CU_LOAD(buf, hh_, idx_) do { const int cs_ = (idx_) >> 3, tl_ = tlw + ((idx_) & 7); const unsigned coff_ = (unsigned)(cs_ * 128 + l7 * 16); \
            hh_ = *(const v4u*)(hq8 + (size_t)(ch * 64 + tl_) * D + coff_); \
            _Pragma("unroll") for (int i_ = 0; i_ < 16; ++i_) { const unsigned e_ = (unsigned)eg_e[tl_ * 128 + 8 * i_ + g]; buf[i_] = *(const v4u*)(ut + (size_t)(e_ * 2048u + coff_)); } } while (0)
#define CU_COMP(buf, hh_, idx_) do { const int tl_ = tlw + ((idx_) & 7); int acc_[16]; \
            _Pragma("unroll") for (int i_ = 0; i_ < 16; ++i_) { int s_ = 0; _Pragma("unroll") for (int q_ = 0; q_ < 4; ++q_) s_ = sdot4i(buf[i_][q_], hh_[q_], s_); acc_[i_] = s_; } \
            treduce16<int, 1>(acc_, lane); \
            apart[tl_ * 128 + 8 * l7 + g] += acc_[0]; apart[tl_ * 128 + 8 * (8 + l7) + g] += acc_[1]; } while (0)
        CU_LOAD(bufA, hA, 0);
        for (int idx = 0; idx < 128; idx += 2) {
            CU_LOAD(bufB, hB, idx + 1);
            CU_COMP(bufA, hA, idx);
            if (idx + 2 < 128) CU_LOAD(bufA, hA, idx + 2);
            CU_COMP(bufB, hB, idx + 1);
        }
#undef CU_LOAD
#undef CU_COMP
        LDS_WAIT(); asm volatile("" ::: "memory");
        for (int it = 0; it < 8; ++it) { const int tl = tlw + it; const float shs = hsc[ch * 64 + tl];
            const int e0 = eg_e[tl * 128 + lane], e1 = eg_e[tl * 128 + 64 + lane];
            const float w0 = sw[tl * 128 + lane] * gelu_tanh_f((float)apart[tl * 128 + lane] * su[e0] * shs) * sv[e0];
            const float w1 = sw[tl * 128 + 64 + lane] * gelu_tanh_f((float)apart[tl * 128 + 64 + lane] * su[e1] * shs) * sv[e1];
            sw[tl * 128 + lane] = w0; sw[tl * 128 + 64 + lane] = w1;
            const float ws = wave_sum(w0 + w1);
            if (lane == 0) wtotl[tl] = ws; }
        LDS_WAIT(); asm volatile("" ::: "memory");
    }
    {
        int laneL = lane0; asm volatile("" : "+v"(laneL)); const int lane = laneL;
        const int g = lane >> 3, l7 = lane & 7;
        v4u bufA[16], bufB[16];
#define CV_LOAD(buf, idx_) do { const int cs_ = (idx_) >> 3, tl_ = tlw + ((idx_) & 7); const unsigned coff_ = (unsigned)(cs_ * 128 + l7 * 16); \
            _Pragma("unroll") for (int i_ = 0; i_ < 16; ++i_) { const unsigned e_ = (unsigned)eg_e[tl_ * 128 + 8 * i_ + g]; buf[i_] = *(const v4u*)(vt + (size_t)(e_ * 2048u + coff_)); } } while (0)
#define CV_COMP(buf, idx_) do { const int cs_ = (idx_) >> 3, tl_ = tlw + ((idx_) & 7); float y_[16]; \
            _Pragma("unroll") for (int q_ = 0; q_ < 16; ++q_) y_[q_] = 0.f; \
            _Pragma("unroll") for (int i_ = 0; i_ < 16; ++i_) { const float wr_ = sw[tl_ * 128 + 8 * i_ + g]; \
                _Pragma("unroll") for (int q_ = 0; q_ < 4; ++q_) fma_ub4(buf[i_][q_], wr_, y_[4 * q_], y_[4 * q_ + 1], y_[4 * q_ + 2], y_[4 * q_ + 3]); } \
            treduce16<float, 8>(y_, lane); \
            const float woff_ = 128.0f * wtotl[tl_]; bf16* yr_ = (bf16*)Ybuf + (size_t)(ch * 64 + tl_) * D + cs_ * 128 + l7 * 16 + g; \
            yr_[0] = (bf16)(pk2(y_[0] - woff_, 0.f) & 0xffffu); yr_[8] = (bf16)(pk2(y_[1] - woff_, 0.f) & 0xffffu); } while (0)
        CV_LOAD(bufA, 0);
        for (int idx = 0; idx < 128; idx += 2) {
            CV_LOAD(bufB, idx + 1);
            CV_COMP(bufA, idx);
            if (idx + 2 < 128) CV_LOAD(bufA, idx + 2);
            CV_COMP(bufB, idx + 1);
        }
#undef CV_LOAD
#undef CV_COMP
    }
    asm volatile("s_waitcnt vmcnt(0)" ::: "memory");
    __builtin_amdgcn_fence(__ATOMIC_ACQUIRE, "agent");
    asm volatile("s_waitcnt vmcnt(0)" ::: "memory");
    for (int it = 0; it < 8; ++it) { int laneT = lane0; asm volatile("" : "+v"(laneT)); const int t = ch * 64 + tlw + it;
        peer_tail(a, l, t, laneT, (const float*)((const bf16*)Ybuf + (size_t)t * D), mb, mbn, last); }
}

#endif

#ifndef MK_PER_PHASE
#define MK_PER_PHASE 0
#endif
__global__ void __launch_bounds__(NTHREADS, 2) mk_fwd(Args a) {
    extern __shared__ __attribute__((aligned(16))) unsigned char lds_raw[];
    LAS unsigned char* lds = (LAS unsigned char*)lds_raw;
    const int tid = threadIdx.x, lane = tid & 63, wave = __builtin_amdgcn_readfirstlane(tid >> 6), G = gridDim.x, bx = blockIdx.x;
    if (tid < 64) ((LAS unsigned*)(lds + LDSCTL_OFF))[tid] = 0u;
    __syncthreads();
    unsigned* ctl = (unsigned*)(a.ws + WS_CTL);
    XcdBarrier bar; bar.bar = ctl + CW_BAR; bar.x = 0; bar.st = nullptr;
    const bool use_bar = (a.ph_hi - a.ph_lo) > 1;
    if (use_bar) bar = xcd_barrier_post(ctl + CW_BAR, (volatile LAS unsigned*)(lds + LDSCTL_OFF));
    const int lo = a.ph_lo, hi = a.ph_hi;
#ifndef PH_MASK
#define PH_MASK 0x1ff
#endif
#define IN(k) (lo <= (k) && (k) < hi)
#define EN(b) ((PH_MASK >> (b)) & 1)
#ifndef REP_MASK
#define REP_MASK 0
#endif
#ifndef REP_EXTRA
#define REP_EXTRA 2
#endif
#define REPS(b) (1 + ((REP_MASK >> (b)) & 1) * REP_EXTRA)
#define REP_BEGIN(b) for (int rep_ = 0; rep_ < REPS(b); ++rep_) {
#define REP_END(b) if (rep_ + 1 < REPS(b)) xcd_barrier(bar); }
#define SEAM(k) do { if (IN((k) + 1)) xcd_barrier(bar); } while (0)
#define PHASE_IDS() int tidp = tid; asm volatile("" : "+v"(tidp)); const int lanep = tidp & 63, wavep = __builtin_amdgcn_readfirstlane(tidp >> 6); (void)lanep; (void)wavep
    if (EN(0) && IN(0)) { REP_BEGIN(0) PHASE_IDS(); ph_prologue_a(a, lds, tidp, lanep, wavep, bx, G); REP_END(0) SEAM(0); }
    if (EN(1) && IN(1)) { REP_BEGIN(1) PHASE_IDS(); ph_prologue_b(a, lds, tidp, lanep, wavep, bx, G); REP_END(1) SEAM(1); }
    for (int l = 0; l < NL; ++l) {
        const int pb = 2 + 7 * l;
        const float* mod = (const float*)(a.ws + WS_MOD);
        if (EN(2) && IN(pb + 0)) {
            REP_BEGIN(2) PHASE_IDS();
            pg8::Gemm g{(const pg8::bf16_t*)(a.ws + WS_H), (const pg8::bf16_t*)(a.ws + WS_WIN) + (size_t)l * INW * D, T, NP, D}; pg8::StaticOrder S; S.init(T, NP, G, bx);
            pg8::EpiBf16P E{(pg8::bf16_t*)(a.ws + WS_PROJ), NP};
            pg8::gemm_phase<pg8::EpiBf16P, pg8::StaticOrder, true, true>(lds + RING_OFF, g, S, E, tidp);
            for (int ch = bx; ch < NCHUNK; ch += G) gate_prep(a, l, lds, tidp, lanep, wavep, ch);
            REP_END(2) SEAM(pb + 0);
        }
        if (EN(3) && IN(pb + 1)) { REP_BEGIN(3) PHASE_IDS(); for (int un = bx; un < 256; un += G) gla_unit(a, lds, tidp, lanep, wavep, un); REP_END(3) SEAM(pb + 1); }
        if (EN(4) && IN(pb + 2)) { REP_BEGIN(4) PHASE_IDS(); for (int ch = bx; ch < NCHUNK; ch += G) mixpost_chunk(a, l, lanep, wavep, ch); REP_END(4) SEAM(pb + 2); }
        if (EN(5) && IN(pb + 3)) {
            REP_BEGIN(5) PHASE_IDS();
            pg8::Gemm g{(const pg8::bf16_t*)(a.ws + WS_Y), (const pg8::bf16_t*)(a.ws + WS_WOUT) + (size_t)l * D * D, T, D, D}; pg8::StaticOrder S; S.init(T, D, G, bx);
            pg8::EpiResid E{(float*)(a.ws + WS_Z), l == 0 ? a.in[0] : (const float*)(a.ws + WS_X), mod + (size_t)l * NB * 6 * D + 2 * D, ALPHA};
            pg8::gemm_phase<pg8::EpiResid, pg8::StaticOrder, true, true>(lds + RING_OFF, g, S, E, tidp);
            REP_END(5) SEAM(pb + 3);
        }
        if (EN(6) && IN(pb + 4)) { REP_BEGIN(6) PHASE_IDS(); for (int ch = bx; ch < NCHUNK; ch += G) ln1_chunk(a, l, lanep, wavep, ch); REP_END(6) SEAM(pb + 4); }
        if (EN(7) && IN(pb + 5)) {
            REP_BEGIN(7) PHASE_IDS();
            pg8::Gemm g{(const pg8::bf16_t*)(a.ws + WS_H2), (const pg8::bf16_t*)(a.ws + WS_WQ) + (size_t)l * D * D, T, D, D}; pg8::StaticOrder S; S.init(T, D, G, bx);
            pg8::EpiBf16P E{(pg8::bf16_t*)(a.ws + WS_Q), D};
            pg8::gemm_phase<pg8::EpiBf16P, pg8::StaticOrder, true, true>(lds + RING_OFF, g, S, E, tidp);
            REP_END(7) SEAM(pb + 5);
        }
#ifndef PEER_DBG
#define PEER_DBG 0
#endif
#ifndef PE_REP_R
#define PE_REP_R 1
#endif
#ifndef L2PROBE
#define L2PROBE 0
#endif
        if (EN(8) && IN(pb + 6)) {
            REP_BEGIN(8)
            for (int ch = bx; ch < NCHUNK; ch += G) { for (int repr_ = 0; repr_ < PE_REP_R; ++repr_) { PHASE_IDS(); peer_retrieve(a, l, lds, lanep, wavep, ch); __syncthreads(); } __syncthreads(); { PHASE_IDS(); peer_experts(a, l, lds, lanep, wavep, ch); } __syncthreads(); }
            REP_END(8) SEAM(pb + 6);
        }
    }
#undef IN
#undef SEAM
}

extern "C" void kernel_launch(void* const* d_in, const int* in_sizes, int n_in, void* d_out, int out_size, void* d_ws, size_t ws_size, hipStream_t stream) {
    static int grid = 0;
    if (grid == 0) {
        if (n_in != 19 || in_sizes[0] != T * D || out_size != T * D || ws_size < WS_END) { fprintf(stderr, "kernel_launch: unexpected shapes / workspace (%d inputs, ws %zu); nothing launched\n", n_in, ws_size); grid = -1; return; }
        int dev = 0, cus = 0, per_cu = 0;
        if (hipGetDevice(&dev) != hipSuccess || hipDeviceGetAttribute(&cus, hipDeviceAttributeMultiprocessorCount, dev) != hipSuccess) { grid = -1; return; }
        if (hipFuncSetAttribute((const void*)mk_fwd, hipFuncAttributeMaxDynamicSharedMemorySize, LDS_BYTES) != hipSuccess) { fprintf(stderr, "kernel_launch: hipFuncSetAttribute failed\n"); grid = -1; return; }
        if (hipOccupancyMaxActiveBlocksPerMultiprocessor(&per_cu, (const void*)mk_fwd, NTHREADS, LDS_BYTES) != hipSuccess || per_cu < 1) fprintf(stderr, "kernel_launch: occupancy query reports %d\n", per_cu);
        (void)hipGetLastError();
        grid = cus;
    }
    if (grid < 0) return;
    if (hipMemsetAsync((char*)d_ws + WS_CTL, 0, CTL_ZERO_BYTES, stream) != hipSuccess) return;
    Args a{};
    for (int i = 0; i < 19; ++i) a.in[i] = (const float*)d_in[i];
    a.out = (float*)d_out; a.ws = (unsigned char*)d_ws;
#if MK_PER_PHASE
    for (int p = 0; p < NPHASES; ++p) { a.ph_lo = p; a.ph_hi = p + 1; hipLaunchKernelGGL(mk_fwd, dim3(grid), dim3(NTHREADS), LDS_BYTES, stream, a); }
#else
    a.ph_lo = 0; a.ph_hi = NPHASES;
    hipLaunchKernelGGL(mk_fwd, dim3(grid), dim3(NTHREADS), LDS_BYTES, stream, a);
#endif
}
```

```cpp
#include <hip/hip_runtime.h>
#include <cstdio>
#include <cstdint>
namespace pg8 {
#define PG8_LAS __attribute__((address_space(3)))
typedef unsigned short bf16_t;
typedef short bf16x8 __attribute__((ext_vector_type(8)));
typedef float f32x4 __attribute__((ext_vector_type(4)));
typedef unsigned u32x4 __attribute__((ext_vector_type(4)));
constexpr int BM = 256, BK = 64, HALF = 128, HTB = HALF * BK * 2  , STAGE_BYTES = 8 * HTB, NXCD = 8, WGM = 8;

__host__ __device__ __forceinline__ int lds_byte(int r, int c) { const int st = (r >> 4) * 2 + (c >> 5), rr = r & 15, cc = c & 31, ob = rr * 64 + cc * 2; return st * 1024 + (ob ^ (((ob >> 9) & 1) << 5)); }
__host__ __device__ __forceinline__ void stage_rc(int b, int& R, int& C) { const int st = b / 1024, sb = b % 1024, swz = sb ^ (((sb >> 9) & 1) << 5); R = (st >> 1) * 16 + swz / 64; C = (st & 1) * 32 + (swz % 64) / 2; }
__host__ __device__ __forceinline__ int perm32(int rho) { const int n = rho >> 4, i = rho & 15; return 8 * (i >> 2) + 4 * n + (i & 3); }

struct Unit { int pm, pn; };
struct Gemm { const bf16_t* A; const bf16_t* Bt; int M, N, K; };

struct StaticOrder {
    int nM, nN, nwg, G, c;
    __host__ __device__ void init(int M, int N, int G_, int c_) { nM = M / BM; nN = N / BM; nwg = nM * nN; G = G_; c = c_; }
    __host__ __device__ bool next(int i, Unit& u) const {
        const long L = (long)i * G + c; if (L >= nwg) return false;
        int wgid = (int)L; { const int q = nwg / NXCD, r = nwg % NXCD, xcd = wgid % NXCD, off = wgid / NXCD; wgid = (xcd < r ? xcd * (q + 1) : r * (q + 1) + (xcd - r) * q) + off; }
        const int nig = WGM * nN, gid = wgid / nig, fm = gid * WGM, gsz = (nM - fm) < WGM ? (nM - fm) : WGM;
        u.pm = fm + ((wgid % nig) % gsz); u.pn = (wgid % nig) / gsz; return true;
    }
    __device__ __forceinline__ void a_ready(const Unit&) const {}
    __device__ __forceinline__ void done(const Unit&) const {}
};
typedef __bf16 bf16x2_t __attribute__((ext_vector_type(2)));
__device__ __forceinline__ unsigned cvt_pk_bf16(float lo, float hi) { bf16x2_t r; r.x = (__bf16)lo; r.y = (__bf16)hi; return __builtin_bit_cast(unsigned, r); }
struct EpiBf16P {
    static constexpr bool PERM = true, AFTER_DRAIN = false;
    bf16_t* O; int ldc;
    __device__ __forceinline__ void operator()(const f32x4 (&acc)[2][2][4][2], const Unit& u, int wr, int wc, int fr, int fq) const {
        const int row0 = u.pm * BM + wr * 64 + fr, col0 = u.pn * BM + wc * 32 + 8 * fq;
#pragma unroll
        for (int ai = 0; ai < 2; ++ai)
#pragma unroll
            for (int m = 0; m < 4; ++m) { bf16_t* rowp = O + (size_t)(row0 + ai * HALF + m * 16) * ldc + col0;
#pragma unroll
                for (int bj = 0; bj < 2; ++bj) { const f32x4 v0 = acc[ai][bj][m][0], v1 = acc[ai][bj][m][1];
                    u32x4 w; w.x = cvt_pk_bf16(v0[0], v0[1]); w.y = cvt_pk_bf16(v0[2], v0[3]); w.z = cvt_pk_bf16(v1[0], v1[1]); w.w = cvt_pk_bf16(v1[2], v1[3]);
                    *(u32x4*)(rowp + bj * HALF) = w; } }
    }
};
struct EpiResid {
    static constexpr bool PERM = false, AFTER_DRAIN = false;
    float* Z; const float* X; const float* gate; float alpha;
    __device__ __forceinline__ void operator()(const f32x4 (&acc)[2][2][4][2], const Unit& u, int wr, int wc, int fr, int fq) const {
        const int row0 = u.pm * BM + wr * 64 + fr, col0 = u.pn * BM + wc * 32 + 4 * fq;
        const float* gb = gate + (size_t)(u.pm >> 3) * (6 * 2048) + col0;
        f32x4 gv[2][2];
#pragma unroll
        for (int bj = 0; bj < 2; ++bj)
#pragma unroll
            for (int n = 0; n < 2; ++n) gv[bj][n] = *(const f32x4*)(gb + bj * HALF + n * 16) + 1.0f;
#pragma unroll
        for (int ai = 0; ai < 2; ++ai)
#pragma unroll
            for (int m = 0; m < 4; ++m) { const size_t off = (size_t)(row0 + ai * HALF + m * 16) * 2048 + col0;
#pragma unroll
                for (int bj = 0; bj < 2; ++bj)
#pragma unroll
                    for (int n = 0; n < 2; ++n) { const f32x4 xv = *(const f32x4*)(X + off + bj * HALF + n * 16);
                        *(f32x4*)(Z + off + bj * HALF + n * 16) = xv * alpha + gv[bj][n] * acc[ai][bj][m][n]; }
                asm volatile("" ::: "memory"); }
    }
};
template <class Epi, class Sched, bool ALIGN_EPI = false, bool SP2 = false>
__device__ __forceinline__ void gemm_phase(PG8_LAS unsigned char* lds, const Gemm g, const Sched& S, const Epi& E, const int tid_in) {
    const int tid = tid_in, wid = __builtin_amdgcn_readfirstlane(tid >> 6), lane = tid & 63, wr = wid >> 2, wc = wid & 3, fr = lane & 15, fq = lane >> 4;
    const int K = g.K, nt = K / BK;
    unsigned voffA[2], voffB[2];
#pragma unroll
    for (int i = 0; i < 2; ++i) { int R, C; stage_rc(tid * 16 + i * 8192, R, C); const int Rb = Epi::PERM ? ((R & ~31) + perm32(R & 31)) : R;
        voffA[i] = (unsigned)(R * K + C) * 2u; voffB[i] = (unsigned)(Rb * K + C) * 2u; }
    const size_t kstep = (size_t)(BK * 2);
    const size_t hstep = (size_t)HALF * K * 2;
    const size_t tstep = 2 * hstep;
    const unsigned ldsw = (unsigned)wid * 1024u;
    const int aoff = lds_byte(wr * 64 + fr, fq * 8), boff = lds_byte(wc * 32 + fr, fq * 8);
#define PG8_SA(b, h) (((b) * 2 + (h)) * HTB)
#define PG8_SB(b, h) ((4 + (b) * 2 + (h)) * HTB)
#define PG8_STAGE(bufoff, gbase, voff) do { _Pragma("unroll") for (int _i = 0; _i < 2; ++_i) \
        __builtin_amdgcn_global_load_lds((const unsigned*)((const char*)(gbase) + (voff)[_i]), (PG8_LAS unsigned*)(lds + (bufoff) + ldsw + _i * 8192), 16, 0, 0); } while (0)
#define PG8_LDA(dst, b, h) do { _Pragma("unroll") for (int m = 0; m < 4; ++m) _Pragma("unroll") for (int k = 0; k < 2; ++k) dst[m][k] = *(const PG8_LAS bf16x8*)(lds + PG8_SA(b, h) + aoff + m * 2048 + k * 1024); } while (0)
#define PG8_LDB(dst, b, h) do { _Pragma("unroll") for (int n = 0; n < 2; ++n) _Pragma("unroll") for (int k = 0; k < 2; ++k) dst[n][k] = *(const PG8_LAS bf16x8*)(lds + PG8_SB(b, h) + boff + n * 2048 + k * 1024); } while (0)
#define PG8_MMA(ai, bj, At, Bt) do { __builtin_amdgcn_s_setprio(1); _Pragma("unroll") for (int m = 0; m < 4; ++m) _Pragma("unroll") for (int n = 0; n < 2; ++n) _Pragma("unroll") for (int k = 0; k < 2; ++k) \
        acc[ai][bj][m][n] = __builtin_amdgcn_mfma_f32_16x16x32_bf16(Bt[n][k], At[m][k], acc[ai][bj][m][n], 0, 0, 0); __builtin_amdgcn_s_setprio(0); } while (0)
#define PG8_WAIT_V(n) asm volatile("s_waitcnt vmcnt(" #n ")" ::: "memory")
#define PG8_WAIT_L(n) asm volatile("s_waitcnt lgkmcnt(" #n ")" ::: "memory")
#define PG8_BAR __builtin_amdgcn_s_barrier()
#define PG8_SCHED __builtin_amdgcn_sched_barrier(0)
    Unit cur, nxt; int ui = 0;
    if (!S.next(0, cur)) return;
    f32x4 acc[2][2][4][2];
#pragma unroll
    for (int a = 0; a < 2; ++a)
#pragma unroll
        for (int b = 0; b < 2; ++b)
#pragma unroll
            for (int m = 0; m < 4; ++m)
#pragma unroll
                for (int n = 0; n < 2; ++n) acc[a][b][m][n] = (f32x4){0.f, 0.f, 0.f, 0.f};
    bf16x8 At[4][2], B0[2][2], B1[2][2];
    const char* cA = (const char*)g.A + (size_t)cur.pm * tstep; const char* cB = (const char*)g.Bt + (size_t)cur.pn * tstep;
    S.a_ready(cur);
    if constexpr (SP2) {
        PG8_STAGE(PG8_SB(0, 0), cB, voffB); PG8_STAGE(PG8_SB(0, 1), cB + hstep, voffB); PG8_STAGE(PG8_SA(0, 0), cA, voffA); PG8_STAGE(PG8_SA(0, 1), cA + hstep, voffA);
        if (wr == 1) PG8_BAR;
        PG8_WAIT_V(2); PG8_BAR;
        PG8_STAGE(PG8_SB(1, 0), cB + kstep, voffB); PG8_STAGE(PG8_SA(1, 0), cA + kstep, voffA); PG8_STAGE(PG8_SB(1, 1), cB + hstep + kstep, voffB);
        PG8_WAIT_V(6); PG8_BAR;
    } else {
        PG8_STAGE(PG8_SB(0, 0), cB, voffB); PG8_STAGE(PG8_SA(0, 0), cA, voffA); PG8_STAGE(PG8_SB(0, 1), cB + hstep, voffB); PG8_STAGE(PG8_SA(0, 1), cA + hstep, voffA);
        if (wr == 1) PG8_BAR;
        PG8_WAIT_V(4); PG8_BAR;
        PG8_STAGE(PG8_SB(1, 0), cB + kstep, voffB); PG8_STAGE(PG8_SA(1, 0), cA + kstep, voffA); PG8_STAGE(PG8_SB(1, 1), cB + hstep + kstep, voffB);
        PG8_WAIT_V(6); PG8_BAR;
    }
    for (;;) {
        const bool has_next = S.next(ui + 1, nxt);
        const char* nA = has_next ? (const char*)g.A + (size_t)nxt.pm * tstep : cA; const char* nB = has_next ? (const char*)g.Bt + (size_t)nxt.pn * tstep : cB;
        for (int t = 0; t < nt; t += 2) {
            const bool last = (t == nt - 2);
            const char* a1 = cA + (size_t)(t + 1) * kstep;
            const char* a2 = last ? nA : cA + (size_t)(t + 2) * kstep; const char* b2 = last ? nB : cB + (size_t)(t + 2) * kstep;
            const char* a3 = a2 + kstep; const char* b3 = b2 + kstep;
            if (last && has_next) S.a_ready(nxt);
            if constexpr (SP2) {
            PG8_LDB(B0, 0, 0); PG8_LDB(B1, 0, 1); PG8_SCHED; PG8_LDA(At, 0, 0); PG8_STAGE(PG8_SA(1, 1), a1 + hstep, voffA);
            PG8_WAIT_V(8); PG8_WAIT_L(0); PG8_BAR; PG8_MMA(0, 0, At, B0); PG8_MMA(0, 1, At, B1); PG8_BAR; PG8_SCHED;
            PG8_LDA(At, 0, 1); PG8_STAGE(PG8_SB(0, 0), b2, voffB); PG8_STAGE(PG8_SB(0, 1), b2 + hstep, voffB); PG8_STAGE(PG8_SA(0, 0), a2, voffA);
            PG8_WAIT_V(8); PG8_WAIT_L(0); PG8_BAR; PG8_MMA(1, 0, At, B0); PG8_MMA(1, 1, At, B1); PG8_BAR; PG8_SCHED;
            PG8_LDB(B0, 1, 0); PG8_LDB(B1, 1, 1); PG8_SCHED; PG8_LDA(At, 1, 0); PG8_STAGE(PG8_SA(0, 1), a2 + hstep, voffA);
            PG8_WAIT_V(8); PG8_WAIT_L(0); PG8_BAR; PG8_MMA(0, 0, At, B0); PG8_MMA(0, 1, At, B1); PG8_BAR; PG8_SCHED;
            PG8_LDA(At, 1, 1); PG8_STAGE(PG8_SB(1, 0), b3, voffB); PG8_STAGE(PG8_SB(1, 1), b3 + hstep, voffB); PG8_STAGE(PG8_SA(1, 0), a3, voffA);
            PG8_WAIT_V(8); PG8_WAIT_L(0); PG8_BAR; PG8_MMA(1, 0, At, B0); PG8_MMA(1, 1, At, B1); PG8_BAR; PG8_SCHED;
            } else {
            PG8_LDB(B0, 0, 0); PG8_SCHED; PG8_LDA(At, 0, 0); PG8_STAGE(PG8_SA(1, 1), a1 + hstep, voffA);
            PG8_WAIT_L(8); PG8_BAR; PG8_WAIT_L(0); PG8_MMA(0, 0, At, B0); PG8_BAR; PG8_SCHED;
            PG8_LDB(B1, 0, 1); PG8_STAGE(PG8_SB(0, 0), b2, voffB);
            PG8_BAR; PG8_WAIT_L(0); PG8_MMA(0, 1, At, B1); PG8_BAR;
            PG8_LDA(At, 0, 1); PG8_STAGE(PG8_SA(0, 0), a2, voffA);
            PG8_BAR; PG8_WAIT_L(0); PG8_MMA(1, 0, At, B0); PG8_BAR; PG8_SCHED;
            PG8_STAGE(PG8_SB(0, 1), b2 + hstep, voffB);
            PG8_WAIT_V(6); PG8_BAR; PG8_MMA(1, 1, At, B1); PG8_BAR;
            PG8_LDB(B0, 1, 0); PG8_SCHED; PG8_LDA(At, 1, 0); PG8_STAGE(PG8_SA(0, 1), a2 + hstep, voffA);
            PG8_WAIT_L(8); PG8_BAR; PG8_WAIT_L(0); PG8_MMA(0, 0, At, B0); PG8_BAR; PG8_SCHED;
            PG8_LDB(B1, 1, 1); PG8_STAGE(PG8_SB(1, 0), b3, voffB);
            PG8_BAR; PG8_WAIT_L(0); PG8_MMA(0, 1, At, B1); PG8_BAR;
            PG8_LDA(At, 1, 1); PG8_STAGE(PG8_SA(1, 0), a3, voffA);
            PG8_BAR; PG8_WAIT_L(0); PG8_MMA(1, 0, At, B0); PG8_BAR; PG8_SCHED;
            PG8_STAGE(PG8_SB(1, 1), b3 + hstep, voffB);
            PG8_WAIT_V(6); PG8_BAR; PG8_MMA(1, 1, At, B1); PG8_BAR;
            }
        }
        if constexpr (ALIGN_EPI) { if (wr == 0) PG8_BAR; }
        if constexpr (!Epi::AFTER_DRAIN) { E(acc, cur, wr, wc, fr, fq); S.done(cur); }
        if (!has_next) break;
#pragma unroll
        for (int a = 0; a < 2; ++a)
#pragma unroll
            for (int b = 0; b < 2; ++b)
#pragma unroll
                for (int m = 0; m < 4; ++m)
#pragma unroll
                    for (int n = 0; n < 2; ++n) acc[a][b][m][n] = (f32x4){0.f, 0.f, 0.f, 0.f};
        cur = nxt; cA = nA; cB = nB; ++ui;
        if constexpr (ALIGN_EPI) { if (wr == 1) PG8_BAR; }
    }
    PG8_WAIT_V(0);
    if constexpr (!ALIGN_EPI) { if (wr == 0) PG8_BAR; }
    PG8_BAR;
    if constexpr (Epi::AFTER_DRAIN) { E.fused(acc, cur, wr, wc, fr, fq, lds, wid, lane); S.done(cur); }
#undef PG8_SA
#undef PG8_SB
#undef PG8_STAGE
#undef PG8_LDA
#undef PG8_LDB
#undef PG8_MMA
#undef PG8_WAIT_V
#undef PG8_WAIT_L
#undef PG8_BAR
#undef PG8_SCHED
}
}
#define XB_TMO      128
#define XB_XCNT(j)  (256  + 64 * (j))
#define XB_XSUB(j)  (1280 + 64 * (j))
#define XB_XGEN(j)  (2304 + 64 * (j))
#define XB_TOP      3328
#define XB_TOPGEN   3392
#define XCD_BAR_WORDS 3456
#define XB_SPIN_CAP (1u << 18)
#define LAS __attribute__((address_space(3)))

__device__ __forceinline__ unsigned xb_ld(unsigned* p)              { return __hip_atomic_load(p, __ATOMIC_RELAXED, __HIP_MEMORY_SCOPE_AGENT); }
__device__ __forceinline__ unsigned xb_add(unsigned* p, unsigned v) { return __hip_atomic_fetch_add(p, v, __ATOMIC_RELAXED, __HIP_MEMORY_SCOPE_AGENT); }
__device__ __forceinline__ unsigned xb_xcc_id() { return (unsigned)__builtin_amdgcn_s_getreg((3 << 11) | 20) & 0xFu; }
#define XB_SPIN(cond, bar) do { unsigned _sp = 0; while (cond) { __builtin_amdgcn_s_sleep(1); \
    if ((++_sp & 255u) == 0u) { if (xb_ld(&(bar)[XB_TMO])) break; if (_sp > XB_SPIN_CAP) { atomicAdd(&(bar)[XB_TMO], 1u); break; } } } } while (0)

struct XcdBarrier {
    unsigned* bar; unsigned x;
    volatile LAS unsigned* st;
};

__device__ __forceinline__ XcdBarrier xcd_barrier_post(unsigned* bar, volatile LAS unsigned* st) {
    XcdBarrier b; b.bar = bar; b.x = xb_xcc_id(); b.st = st;
    if (threadIdx.x == 0) (void)xb_add(&bar[XB_XCNT(b.x)], 1u);
    return b;
}
__device__ __forceinline__ void xcd_barrier_complete(unsigned* bar, unsigned x, unsigned& nloc, unsigned& nx) {
    const unsigned G = gridDim.x * gridDim.y * gridDim.z;
    unsigned sum, cnt, mine, sp = 0u;
    for (;;) {
        sum = 0u; cnt = 0u; mine = 0u;
#pragma unroll
        for (unsigned j = 0; j < 16; ++j) { const unsigned c = xb_ld(&bar[XB_XCNT(j)]); sum += c; cnt += (c > 0u) ? 1u : 0u; mine = (j == x) ? c : mine; }
        if (sum == G) break;
        __builtin_amdgcn_s_sleep(1);
        if ((++sp & 255u) == 0u) { if (xb_ld(&bar[XB_TMO])) break; if (sp > XB_SPIN_CAP) { atomicAdd(&bar[XB_TMO], 1u); break; } }
    }
    nloc = mine > 0u ? mine : 1u; nx = cnt > 0u ? cnt : 1u;
}

__device__ __forceinline__ void xcd_barrier(const XcdBarrier& b) {
    asm volatile("s_waitcnt vmcnt(0)" ::: "memory");
    __syncthreads();
    if (threadIdx.x == 0) {
        unsigned* bar = b.bar;
        __builtin_amdgcn_s_waitcnt(0);
        unsigned nloc = b.st[0], nx = b.st[1];
        if (nloc == 0u) { xcd_barrier_complete(bar, b.x, nloc, nx); b.st[0] = nloc; b.st[1] = nx; }
        const unsigned old = xb_add(&bar[XB_XSUB(b.x)], 1u);
        const unsigned gen = old / nloc;
        if (old + 1u == (gen + 1u) * nloc) {
            __builtin_amdgcn_fence(__ATOMIC_RELEASE, "agent");
            asm volatile("s_waitcnt vmcnt(0)" ::: "memory");
            const unsigned og = xb_add(&bar[XB_TOP], 1u);
            const unsigned tg = og / nx;
            if (og + 1u == (tg + 1u) * nx) xb_add(&bar[XB_TOPGEN], 1u);
            else XB_SPIN(xb_ld(&bar[XB_TOPGEN]) == tg, bar);
            __builtin_amdgcn_fence(__ATOMIC_ACQUIRE, "agent");
            xb_add(&bar[XB_XGEN(b.x)], 1u);
            asm volatile("s_waitcnt vmcnt(0)" ::: "memory");
        } else {
            XB_SPIN(xb_ld(&bar[XB_XGEN(b.x)]) == gen, bar);
            __builtin_amdgcn_fence(__ATOMIC_ACQUIRE, "agent");
            asm volatile("s_waitcnt vmcnt(0)" ::: "memory");
        }
    }
    __syncthreads();
}
constexpr int D = 2048, NB = 8, SEQ = 2048, NL = 4, T = NB * SEQ;
constexpr int NCH = SEQ / 64, NCHUNK = T / 64;
constexpr int GKW = 512, RANK = 16;
constexpr int INW = 6160, NP = 6144;
constexpr int NE = 16384;
constexpr float ALPHA = 1.6817928305074290f, EPS = 1e-5f;
constexpr int PQ = 0, PK = 512, PV = 1024, PR = 2048, PCB = 3072, PCC = 4096, PCH = 5120;
constexpr int NWAVES = 8, NTHREADS = 512;
#ifndef TAB4
#define TAB4 0
#endif
constexpr int NPHASES = 2 + 7 * NL;

constexpr size_t MiB = 1u << 20;
constexpr size_t WS_CTL = 0, CTL_ZERO_BYTES = 1 * MiB;
constexpr size_t WS_MOD = 1 * MiB, WS_PART = 3 * MiB, WS_KEYS = 15 * MiB, WS_DTOT = 17 * MiB, WS_WIN = 18 * MiB, WS_WOUT = 115 * MiB, WS_WQ = 147 * MiB;
constexpr size_t WS_UT = 179 * MiB, WS_VT = 435 * MiB, WS_H = 691 * MiB, WS_PROJ = 755 * MiB, WS_E = 947 * MiB, WS_OGLA = 979 * MiB, WS_Y = 1043 * MiB;
constexpr size_t WS_Z = 1107 * MiB, WS_X1 = 1235 * MiB, WS_X = 1363 * MiB, WS_Q = 1491 * MiB, WS_H2 = 1555 * MiB, WS_HQ8 = 1619 * MiB, WS_END = 1651 * MiB;
constexpr size_t WS_SU = 17 * MiB + 512 * 1024, WS_SV = 17 * MiB + 768 * 1024, WS_HSC = 2 * MiB + 640 * 1024;
static_assert(WS_WIN + (size_t)NL * INW * D * 2 <= WS_WOUT && WS_PART + (size_t)NL * 8 * NB * 6 * D * 4 <= WS_KEYS && WS_MOD + (size_t)NL * NB * 6 * D * 4 <= WS_PART, "ws map");
constexpr int CW_BAR = 4096;

constexpr int RING_OFF = 0, RING_BYTES = 131072, LDSCTL_OFF = RING_BYTES, LDS_BYTES = 147456;

#define GAS __attribute__((address_space(1)))
typedef unsigned short bf16;
typedef unsigned v4u __attribute__((ext_vector_type(4)));
typedef unsigned v2u __attribute__((ext_vector_type(2)));
typedef float f32x4 __attribute__((ext_vector_type(4)));
typedef float f32x16 __attribute__((ext_vector_type(16)));
typedef short bf16x8 __attribute__((ext_vector_type(8)));
typedef __bf16 bf16x2v __attribute__((ext_vector_type(2)));
#define LDS_WAIT() asm volatile("s_waitcnt lgkmcnt(0)" ::: "memory")

__device__ __forceinline__ unsigned pk2(float lo, float hi) { return pg8::cvt_pk_bf16(lo, hi); }
__device__ __forceinline__ float dot2bf(unsigned w, unsigned x, float acc) { return __builtin_amdgcn_fdot2_f32_bf16(__builtin_bit_cast(bf16x2v, w), __builtin_bit_cast(bf16x2v, x), acc, false); }
__device__ __forceinline__ float bflo(unsigned u) { return __uint_as_float(u << 16); }
__device__ __forceinline__ float bfhi(unsigned u) { return __uint_as_float(u & 0xffff0000u); }
__device__ __forceinline__ float silu_f(float x) { return x / (1.0f + __expf(-x)); }
__device__ __forceinline__ float logsigmoid_f(float x) { return fminf(x, 0.0f) - log1pf(__expf(-fabsf(x))); }
__device__ __forceinline__ float gelu_tanh_f(float x) { const float u = 0.7978845608028654f * (x + 0.044715f * x * x * x); return 0.5f * x * (1.0f + tanhf(u)); }
__device__ __forceinline__ float wave_sum(float v) {
#pragma unroll
    for (int o = 1; o < 64; o <<= 1) v += __shfl_xor(v, o);
    return v;
}

struct Args { const float* in[19]; float* out; unsigned char* ws; int ph_lo, ph_hi; };

__device__ __forceinline__ void transpose_item(const float* W, int ldw, int col0, bf16* WTrows, int k0, int nvalid, LAS float* scr, int lane) {
    const int n = lane & 31;
    float tv[32];
#pragma unroll
    for (int i = 0; i < 32; ++i) { const int kk = 2 * i + (lane >> 5); tv[i] = (n < nvalid) ? W[(size_t)(k0 + kk) * ldw + col0 + n] : 0.f; }
#pragma unroll
    for (int i = 0; i < 32; ++i) { const int kk = 2 * i + (lane >> 5); scr[kk * 33 + n] = tv[i]; }
    LDS_WAIT(); asm volatile("" ::: "memory");
    const int c = lane & 7;
#pragma unroll
    for (int j = 0; j < 4; ++j) { const int nn = (lane >> 3) + 8 * j; const LAS float* s = scr + (8 * c) * 33 + nn;
        v4u o; o.x = pk2(s[0 * 33], s[1 * 33]); o.y = pk2(s[2 * 33], s[3 * 33]); o.z = pk2(s[4 * 33], s[5 * 33]); o.w = pk2(s[6 * 33], s[7 * 33]);
        if (nn < nvalid) *(v4u*)(WTrows + (size_t)nn * D + k0 + 8 * c) = o; }
    LDS_WAIT(); asm volatile("" ::: "memory");
}
__device__ __forceinline__ void cvt_stream(const float* src, bf16* dst, size_t n4, size_t i0, size_t stride) {
    for (size_t i = i0; i < n4; i += stride) { const f32x4 v = ((const f32x4*)src)[i]; v2u o; o.x = pk2(v.x, v.y); o.y = pk2(v.z, v.w); ((v2u*)dst)[i] = o; }
}
__device__ __forceinline__ void ph_prologue_a(const Args& a, LAS unsigned char* lds, int tid, int lane, int wave, int bx, int G) {
    const int gw = bx * NWAVES + wave, NGW = G * NWAVES;
    LAS float* cact = (LAS float*)lds;
    for (int i = tid; i < NB * D; i += NTHREADS) { const int b = i / D, d = i % D; cact[d * 8 + b] = silu_f(a.in[1][i]); }
    __syncthreads();
    float* part = (float*)(a.ws + WS_PART);
    for (int it = gw; it < NL * 8 * 48; it += NGW) {
        const int cg = it % 48, dr = (it / 48) % 8, l = it / 384;
        f32x4 acc[8];
#pragma unroll
        for (int b = 0; b < 8; ++b) acc[b] = (f32x4){0.f, 0.f, 0.f, 0.f};
        const float* w = a.in[2] + ((size_t)l * D + dr * 256) * (6 * D) + cg * 256 + lane * 4;
#pragma unroll 4
        for (int d = 0; d < 256; ++d) {
            const f32x4 wv = *(const f32x4*)(w + (size_t)d * (6 * D));
            const f32x4 c0 = *(const LAS f32x4*)(cact + (dr * 256 + d) * 8), c1 = *(const LAS f32x4*)(cact + (dr * 256 + d) * 8 + 4);
            acc[0] += wv * c0.x; acc[1] += wv * c0.y; acc[2] += wv * c0.z; acc[3] += wv * c0.w;
            acc[4] += wv * c1.x; acc[5] += wv * c1.y; acc[6] += wv * c1.z; acc[7] += wv * c1.w;
        }
#pragma unroll
        for (int b = 0; b < 8; ++b) *(f32x4*)(part + (((size_t)l * 8 + dr) * NB + b) * (6 * D) + cg * 256 + lane * 4) = acc[b];
    }
    __syncthreads();
    LAS float* scr = (LAS float*)(lds + wave * 8448);
    bf16* winT = (bf16*)(a.ws + WS_WIN); bf16* woutT = (bf16*)(a.ws + WS_WOUT); bf16* wqT = (bf16*)(a.ws + WS_WQ);
    constexpr int IPL = 6144 + 32 + 2048 + 2048;
    for (int it = gw; it < NL * IPL; it += NGW) {
        const int l = it / IPL; int r = it % IPL;
        if (r < 6144) { const int nb = r % 192, kb = r / 192, n0 = nb * 32;
            transpose_item(a.in[4] + (size_t)l * D * INW, INW, n0 < 3072 ? n0 : n0 + 16, winT + ((size_t)l * INW + n0) * D, kb * 64, 32, scr, lane); continue; }
        r -= 6144;
        if (r < 32) { transpose_item(a.in[4] + (size_t)l * D * INW, INW, 3072, winT + ((size_t)l * INW + NP) * D, r * 64, 16, scr, lane); continue; }
        r -= 32;
        if (r < 2048) { const int nb = r % 64, kb = r / 64; transpose_item(a.in[10] + (size_t)l * D * D, D, nb * 32, woutT + ((size_t)l * D + nb * 32) * D, kb * 64, 32, scr, lane); continue; }
        r -= 2048;
        { const int nb = r % 64, kb = r / 64; transpose_item(a.in[13] + (size_t)l * D * D, D, nb * 32, wqT + ((size_t)l * D + nb * 32) * D, kb * 64, 32, scr, lane); }
    }
    const size_t i0 = (size_t)bx * NTHREADS + tid, stride = (size_t)G * NTHREADS;
    cvt_stream(a.in[14], (bf16*)(a.ws + WS_KEYS), (size_t)NL * 8 * 2 * 128 * 128 / 4, i0, stride);
#if TAB4
    for (int row = gw; row < 2 * NL * NE; row += NGW) {
        const int tbl = row / (NL * NE), r = row % (NL * NE);
        const float* src = (tbl ? a.in[16] : a.in[15]) + (size_t)r * D;
        f32x4 v[8]; float mx = 0.f;
#pragma unroll
        for (int c8 = 0; c8 < 8; ++c8) { v[c8] = *(const f32x4*)(src + (c8 * 64 + lane) * 4); mx = fmaxf(mx, fmaxf(fmaxf(fabsf(v[c8].x), fabsf(v[c8].y)), fmaxf(fabsf(v[c8].z), fabsf(v[c8].w)))); }
        const unsigned sb = pk2(mx * (1.0f / 7.0f), 0.f) & 0xffffu; const float sc = bflo(sb);
        const float inv = sc > 0.f ? 1.0f / sc : 0.f;
        unsigned dw[4];
#pragma unroll
        for (int q = 0; q < 4; ++q) { unsigned w = 0;
            const float lo[4] = {v[2 * q].x, v[2 * q].y, v[2 * q].z, v[2 * q].w}, hi[4] = {v[2 * q + 1].x, v[2 * q + 1].y, v[2 * q + 1].z, v[2 * q + 1].w};
#pragma unroll
            for (int j = 0; j < 4; ++j) { int a0 = (int)__builtin_rintf(lo[j] * inv), a1 = (int)__builtin_rintf(hi[j] * inv); a0 = a0 < -7 ? -7 : (a0 > 7 ? 7 : a0); a1 = a1 < -7 ? -7 : (a1 > 7 ? 7 : a1);
                w |= ((unsigned)(a0 + 8) | ((unsigned)(a1 + 8) << 4)) << (8 * j); }
            dw[q] = w; }
        unsigned char* tb = a.ws + (tbl ? WS_VT : WS_UT);
        *(v4u*)(tb + (size_t)r * 1024 + lane * 16) = (v4u){dw[0], dw[1], dw[2], dw[3]};
        ((bf16*)(tb + 128 * MiB))[(size_t)r * 64 + lane] = (bf16)sb;
    }
#else
    for (int row = gw; row < 2 * NL * NE; row += NGW) {
        const int tbl = row / (NL * NE), r = row % (NL * NE);
        const float* src = (tbl ? a.in[16] : a.in[15]) + (size_t)r * D;
        f32x4 v[8]; float mx = 0.f;
#pragma unroll
        for (int c8 = 0; c8 < 8; ++c8) { v[c8] = *(const f32x4*)(src + (c8 * 64 + lane) * 4); mx = fmaxf(mx, fmaxf(fmaxf(fabsf(v[c8].x), fabsf(v[c8].y)), fmaxf(fabsf(v[c8].z), fabsf(v[c8].w)))); }
#pragma unroll
        for (int o = 1; o < 64; o <<= 1) mx = fmaxf(mx, __shfl_xor(mx, o));
        const float inv = mx > 0.f ? 127.0f / mx : 0.f; const int off = tbl ? 128 : 0;
        unsigned dw[8];
#pragma unroll
        for (int c8 = 0; c8 < 8; ++c8) { const int q0 = (int)__builtin_rintf(v[c8].x * inv) + off, q1 = (int)__builtin_rintf(v[c8].y * inv) + off, q2 = (int)__builtin_rintf(v[c8].z * inv) + off, q3 = (int)__builtin_rintf(v[c8].w * inv) + off;
            dw[c8] = (unsigned)(q0 & 255) | ((unsigned)(q1 & 255) << 8) | ((unsigned)(q2 & 255) << 16) | ((unsigned)(q3 & 255) << 24); }
        unsigned char* dst = a.ws + (tbl ? WS_VT : WS_UT) + (size_t)r * D;
        *(v4u*)(dst + lane * 16) = (v4u){dw[0], dw[1], dw[2], dw[3]}; *(v4u*)(dst + (64 + lane) * 16) = (v4u){dw[4], dw[5], dw[6], dw[7]};
        if (lane == 0) ((float*)(a.ws + (tbl ? WS_SV : WS_SU)))[r] = mx * (1.0f / 127.0f);
    }
#endif
}

__device__ __forceinline__ void ln_tail(const float (&z)[32], int t, int lane, const float* g, const float* bta, float* xout, const float* sh, const float* sc, bf16* hout, unsigned char* q8, float* q8s) {
    float s = 0.f;
#pragma unroll
    for (int i = 0; i < 32; ++i) s += z[i];
    const float mu = wave_sum(s) * (1.0f / D);
    float q = 0.f;
#pragma unroll
    for (int i = 0; i < 32; ++i) { const float d = z[i] - mu; q += d * d; }
    const float rs = rsqrtf(wave_sum(q) * (1.0f / D) + EPS);
    float hv[32]; float mx = 0.f;
#pragma unroll
    for (int c = 0; c < 8; ++c) { const int col = (c * 64 + lane) * 4;
        const f32x4 g0 = *(const f32x4*)(g + col), b0 = *(const f32x4*)(bta + col);
        f32x4 x0;
        x0.x = (z[c * 4 + 0] - mu) * rs * g0.x + b0.x; x0.y = (z[c * 4 + 1] - mu) * rs * g0.y + b0.y; x0.z = (z[c * 4 + 2] - mu) * rs * g0.z + b0.z; x0.w = (z[c * 4 + 3] - mu) * rs * g0.w + b0.w;
        if (xout) *(f32x4*)(xout + (size_t)t * D + col) = x0;
        if (hout) { const f32x4 s0 = *(const f32x4*)(sc + col), h0 = *(const f32x4*)(sh + col);
            hv[c * 4] = x0.x * (1.f + s0.x) + h0.x; hv[c * 4 + 1] = x0.y * (1.f + s0.y) + h0.y; hv[c * 4 + 2] = x0.z * (1.f + s0.z) + h0.z; hv[c * 4 + 3] = x0.w * (1.f + s0.w) + h0.w;
            v2u o; o.x = pk2(hv[c * 4], hv[c * 4 + 1]); o.y = pk2(hv[c * 4 + 2], hv[c * 4 + 3]);
            *(v2u*)(hout + (size_t)t * D + col) = o;
            if (q8) {
                hv[c * 4] = bflo(o.x); hv[c * 4 + 1] = bfhi(o.x); hv[c * 4 + 2] = bflo(o.y); hv[c * 4 + 3] = bfhi(o.y);
                mx = fmaxf(mx, fmaxf(fmaxf(fabsf(hv[c * 4]), fabsf(hv[c * 4 + 1])), fmaxf(fabsf(hv[c * 4 + 2]), fabsf(hv[c * 4 + 3])))); } }
    }
    if (q8) {
#pragma unroll
        for (int o = 1; o < 64; o <<= 1) mx = fmaxf(mx, __shfl_xor(mx, o));
        const float inv = mx > 0.f ? 127.0f / mx : 0.f;
        unsigned dw[8];
#pragma unroll
        for (int c = 0; c < 8; ++c) { const int q0 = (int)__builtin_rintf(hv[c * 4] * inv), q1 = (int)__builtin_rintf(hv[c * 4 + 1] * inv), q2 = (int)__builtin_rintf(hv[c * 4 + 2] * inv), q3 = (int)__builtin_rintf(hv[c * 4 + 3] * inv);
            dw[c] = (unsigned)(q0 & 255) | ((unsigned)(q1 & 255) << 8) | ((unsigned)(q2 & 255) << 16) | ((unsigned)(q3 & 255) << 24); }
        unsigned char* dst = q8 + (size_t)t * D;
#if TAB4
        *(v4u*)(dst + lane * 32) = (v4u){dw[0], dw[1], dw[2], dw[3]}; *(v4u*)(dst + lane * 32 + 16) = (v4u){dw[4], dw[5], dw[6], dw[7]};
#else
        *(v4u*)(dst + lane * 16) = (v4u){dw[0], dw[1], dw[2], dw[3]}; *(v4u*)(dst + (64 + lane) * 16) = (v4u){dw[4], dw[5], dw[6], dw[7]};
#endif
        if (lane == 0) q8s[t] = mx * (1.0f / 127.0f);
    }
}

__device__ __forceinline__ void ph_prologue_b(const Args& a, LAS unsigned char* lds, int tid, int lane, int wave, int bx, int G) {
    const float* part = (const float*)(a.ws + WS_PART); float* mod = (float*)(a.ws + WS_MOD);
    for (int i = bx * NTHREADS + tid; i < NL * NB * 6 * D / 4; i += G * NTHREADS) {
        const int idx = i * 4, e = idx % (6 * D), b = (idx / (6 * D)) % NB, l = idx / (6 * D * NB);
        f32x4 s = *(const f32x4*)(a.in[3] + l * 6 * D + e);
#pragma unroll
        for (int dr = 0; dr < 8; ++dr) s += *(const f32x4*)(part + (((size_t)l * 8 + dr) * NB + b) * (6 * D) + e);
        *(f32x4*)(mod + idx) = s;
    }
    LAS float* msh = (LAS float*)lds;
    bf16* hbuf = (bf16*)(a.ws + WS_H);
    for (int ch = bx; ch < NCHUNK; ch += G) {
        const int b = ch / NCH;
        for (int i = tid; i < 1024; i += NTHREADS) { const int e = i * 4;
            f32x4 s = *(const f32x4*)(a.in[3] + e);
#pragma unroll
            for (int dr = 0; dr < 8; ++dr) s += *(const f32x4*)(part + (((size_t)0 * 8 + dr) * NB + b) * (6 * D) + e);
            *(LAS f32x4*)(msh + e) = s; }
        __syncthreads();
        for (int i = 0; i < 8; ++i) { const int t = ch * 64 + wave * 8 + i;
#pragma unroll
            for (int c = 0; c < 4; ++c) { const int col = (c * 64 + lane) * 8;
                const f32x4 x0 = *(const f32x4*)(a.in[0] + (size_t)t * D + col), x1 = *(const f32x4*)(a.in[0] + (size_t)t * D + col + 4);
                const f32x4 h0 = *(const LAS f32x4*)(msh + col), h1 = *(const LAS f32x4*)(msh + col + 4), s0 = *(const LAS f32x4*)(msh + 2048 + col), s1 = *(const LAS f32x4*)(msh + 2048 + col + 4);
                v4u o; o.x = pk2(x0.x * (1.f + s0.x) + h0.x, x0.y * (1.f + s0.y) + h0.y); o.y = pk2(x0.z * (1.f + s0.z) + h0.z, x0.w * (1.f + s0.w) + h0.w);
                o.z = pk2(x1.x * (1.f + s1.x) + h1.x, x1.y * (1.f + s1.y) + h1.y); o.w = pk2(x1.z * (1.f + s1.z) + h1.z, x1.w * (1.f + s1.w) + h1.w);
                *(v4u*)(hbuf + (size_t)t * D + col) = o; } }
        __syncthreads();
    }
}

__device__ __forceinline__ void gate_prep(const Args& a, int l, LAS unsigned char* lds, int tid, int lane, int wave, int ch) {
    const bf16* hbuf = (const bf16*)(a.ws + WS_H); const bf16* waT = (const bf16*)(a.ws + WS_WIN) + ((size_t)l * INW + NP) * D;
    float* Ebuf = (float*)(a.ws + WS_E); float* dtot = (float*)(a.ws + WS_DTOT);
    const int t0 = ch * 64, l15 = lane & 15, lq = lane >> 4, mt = wave & 3, kh = wave >> 2;
    f32x4 acc = (f32x4){0.f, 0.f, 0.f, 0.f};
    const bf16* hA = hbuf + (size_t)(t0 + 16 * mt + l15) * D + kh * 1024 + 8 * lq;
    const bf16* wB = waT + (size_t)l15 * D + kh * 1024 + 8 * lq;
#pragma unroll 8
    for (int ks = 0; ks < 32; ++ks) { const bf16x8 av = *(const bf16x8*)(hA + 32 * ks), bv = *(const bf16x8*)(wB + 32 * ks); acc = __builtin_amdgcn_mfma_f32_16x16x32_bf16(av, bv, acc, 0, 0, 0); }
    LAS float* alr = (LAS float*)lds;
#pragma unroll
    for (int r = 0; r < 4; ++r) alr[(kh * 64 + 16 * mt + 4 * lq + r) * 16 + l15] = acc[r];
    __syncthreads();
    const int col = tid;
    float wg[16];
#pragma unroll
    for (int r = 0; r < 16; ++r) wg[r] = a.in[5][((size_t)l * RANK + r) * GKW + col];
    const float bgc = a.in[6][l * GKW + col];
    float tot = 0.f;
    for (int j = 0; j < 64; ++j) { float lg = bgc;
#pragma unroll
        for (int r4 = 0; r4 < 4; ++r4) { const f32x4 p = *(const LAS f32x4*)(alr + j * 16 + r4 * 4), q = *(const LAS f32x4*)(alr + (64 + j) * 16 + r4 * 4);
            lg += (p.x + q.x) * wg[r4 * 4] + (p.y + q.y) * wg[r4 * 4 + 1] + (p.z + q.z) * wg[r4 * 4 + 2] + (p.w + q.w) * wg[r4 * 4 + 3]; }
        tot += logsigmoid_f(lg) * (1.0f / 16.0f); }
    float run = 0.f;
    for (int j = 0; j < 64; ++j) { float lg = bgc;
#pragma unroll
        for (int r4 = 0; r4 < 4; ++r4) { const f32x4 p = *(const LAS f32x4*)(alr + j * 16 + r4 * 4), q = *(const LAS f32x4*)(alr + (64 + j) * 16 + r4 * 4);
            lg += (p.x + q.x) * wg[r4 * 4] + (p.y + q.y) * wg[r4 * 4 + 1] + (p.z + q.z) * wg[r4 * 4 + 2] + (p.w + q.w) * wg[r4 * 4 + 3]; }
        run += logsigmoid_f(lg) * (1.0f / 16.0f);
        Ebuf[(size_t)(t0 + j) * GKW + col] = __expf(tot - run); }
    dtot[(size_t)ch * GKW + col] = __expf(tot);
    __syncthreads();
}

__device__ __forceinline__ void gla_unit(const Args& a, LAS unsigned char* lds, int tid, int lane, int wave, int un) {
    const bf16* proj = (const bf16*)(a.ws + WS_PROJ); const float* Ebuf = (const float*)(a.ws + WS_E); const float* dtot = (const float*)(a.ws + WS_DTOT); bf16* ogla = (bf16*)(a.ws + WS_OGLA);
    const int pair_ = (un & 7) * 4 + (un >> 6), dvs = (un >> 3) & 7, hh = pair_ & 3, b = pair_ >> 2;
    LAS bf16* kdT = (LAS bf16*)lds;
    LAS bf16* vT = (LAS bf16*)(lds + 18432);
    LAS bf16* ST = (LAS bf16*)(lds + 18432 + 4608);
    const int l15 = lane & 15, lq = lane >> 4, jl = tid >> 3, d16 = (tid & 7) * 16, dv4 = (tid & 7) * 4, jt = (wave & 3) * 16, dvt = (wave >> 2) * 16;
#define GLA_BAR() do { asm volatile("s_waitcnt lgkmcnt(0)" ::: "memory"); __builtin_amdgcn_s_barrier(); asm volatile("" ::: "memory"); } while (0)
    f32x4 S0 = (f32x4){0.f, 0.f, 0.f, 0.f}, S1 = (f32x4){0.f, 0.f, 0.f, 0.f};
    v4u kn0[2], kn1[2]; f32x4 en0[4], en1[4]; v2u vn0, vn1; bf16x8 qn0[4], qn1[4], qc[4]; f32x4 dn0, dn1, dc;
#define GLA_LOAD(c, kn, en, vn, qn, dn) do { const int t0c = b * SEQ + (c) * 64; const bf16* pr = proj + (size_t)(t0c + jl) * NP; \
        kn[0] = *(const v4u*)(pr + PK + hh * 128 + d16); kn[1] = *(const v4u*)(pr + PK + hh * 128 + d16 + 8); \
        _Pragma("unroll") for (int i_ = 0; i_ < 4; ++i_) en[i_] = *(const f32x4*)(Ebuf + (size_t)(t0c + jl) * GKW + hh * 128 + d16 + 4 * i_); \
        vn = *(const v2u*)(pr + PV + hh * 256 + dvs * 32 + dv4); \
        _Pragma("unroll") for (int ks_ = 0; ks_ < 4; ++ks_) qn[ks_] = *(const bf16x8*)(proj + (size_t)(t0c + jt + l15) * NP + PQ + hh * 128 + 32 * ks_ + 8 * lq); \
        dn = *(const f32x4*)(dtot + (size_t)(b * NCH + (c)) * GKW + hh * 128 + 16 * wave + 4 * lq); } while (0)
#define GLA_PREP(kn, en, vn, qn, dn) do { \
        _Pragma("unroll") for (int i_ = 0; i_ < 16; ++i_) { const unsigned w_ = kn[i_ >> 3][(i_ & 7) >> 1]; const float kf_ = (i_ & 1) ? bfhi(w_) : bflo(w_); \
            kdT[(d16 + i_) * 72 + ((((jl >> 3) ^ (d16 >> 4)) & 7) << 3) + (jl & 7)] = (bf16)(pk2(kf_ * en[i_ >> 2][i_ & 3], 0.f) & 0xffffu); } \
        _Pragma("unroll") for (int i_ = 0; i_ < 4; ++i_) { const unsigned w_ = vn[i_ >> 1]; vT[(dv4 + i_) * 72 + jl] = (bf16)((i_ & 1) ? (w_ >> 16) : (w_ & 0xffffu)); } \
        _Pragma("unroll") for (int ks_ = 0; ks_ < 4; ++ks_) qc[ks_] = qn[ks_]; \
        dc = dn; } while (0)
#define GLA_BODY(c) do { \
        S0 = S0 * dc; S1 = S1 * dc; \
        _Pragma("unroll") for (int ks = 0; ks < 2; ++ks) { \
            const bf16x8 A_ = *(const LAS bf16x8*)(kdT + (16 * wave + l15) * 72 + ((((4 * ks + lq) ^ wave) & 7) << 3)); \
            const bf16x8 B0_ = *(const LAS bf16x8*)(vT + l15 * 72 + 32 * ks + 8 * lq), B1_ = *(const LAS bf16x8*)(vT + (16 + l15) * 72 + 32 * ks + 8 * lq); \
            S0 = __builtin_amdgcn_mfma_f32_16x16x32_bf16(A_, B0_, S0, 0, 0, 0); S1 = __builtin_amdgcn_mfma_f32_16x16x32_bf16(A_, B1_, S1, 0, 0, 0); } \
        { v2u w0_, w1_; w0_.x = pk2(S0.x, S0.y); w0_.y = pk2(S0.z, S0.w); w1_.x = pk2(S1.x, S1.y); w1_.y = pk2(S1.z, S1.w); \
          *(LAS v2u*)(ST + l15 * 136 + 16 * wave + 4 * lq) = w0_; *(LAS v2u*)(ST + (16 + l15) * 136 + 16 * wave + 4 * lq) = w1_; } \
        GLA_BAR(); \
        f32x4 O_ = (f32x4){0.f, 0.f, 0.f, 0.f}; \
        _Pragma("unroll") for (int ks = 0; ks < 4; ++ks) { const bf16x8 A_ = *(const LAS bf16x8*)(ST + (dvt + l15) * 136 + 32 * ks + 8 * lq); O_ = __builtin_amdgcn_mfma_f32_16x16x32_bf16(A_, qc[ks], O_, 0, 0, 0); } \
        { const f32x4 Os_ = O_ * 0.08838834764831845f; v2u ob_; ob_.x = pk2(Os_.x, Os_.y); ob_.y = pk2(Os_.z, Os_.w); \
          *(v2u*)(ogla + (size_t)(b * SEQ + (c) * 64 + jt + l15) * 1024 + hh * 256 + dvs * 32 + dvt + 4 * lq) = ob_; } } while (0)
    GLA_LOAD(0, kn0, en0, vn0, qn0, dn0); GLA_LOAD(1, kn1, en1, vn1, qn1, dn1);
    GLA_PREP(kn0, en0, vn0, qn0, dn0);
    GLA_BAR();
    for (int c = 0; c < NCH; c += 2) {
        { const int cn_ = c + 2 < NCH ? c + 2 : NCH - 1; GLA_LOAD(cn_, kn0, en0, vn0, qn0, dn0); }
        GLA_BODY(c);
        GLA_PREP(kn1, en1, vn1, qn1, dn1);
        GLA_BAR();
        { const int cn_ = c + 3 < NCH ? c + 3 : NCH - 1; GLA_LOAD(cn_, kn1, en1, vn1, qn1, dn1); }
        GLA_BODY(c + 1);
        GLA_PREP(kn0, en0, vn0, qn0, dn0);
        GLA_BAR();
    }
#undef GLA_BODY
#undef GLA_BAR
#undef GLA_LOAD
#undef GLA_PREP
}

__device__ __forceinline__ void unpack16(const v4u& p0, const v4u& p1, float (&o)[16]) {
#pragma unroll
    for (int j = 0; j < 4; ++j) { o[2 * j] = bflo(p0[j]); o[2 * j + 1] = bfhi(p0[j]); o[8 + 2 * j] = bflo(p1[j]); o[8 + 2 * j + 1] = bfhi(p1[j]); }
}
__device__ __forceinline__ void mixpost_chunk(const Args& a, int l, int lane, int wave, int ch) {
    const bf16* proj = (const bf16*)(a.ws + WS_PROJ); const bf16* ogla = (const bf16*)(a.ws + WS_OGLA); bf16* ybuf = (bf16*)(a.ws + WS_Y);
    const int c0 = 16 * lane, tfirst = ch * 64 + wave * 8, sfirst = tfirst % SEQ;
    float gn[16], cw0[16], cw1[16], cw2[16], cn[16], u1[16], u2[16];
#pragma unroll
    for (int i = 0; i < 16; ++i) { gn[i] = a.in[7][l * 256 + ((c0 + i) & 255)]; cw0[i] = a.in[8][(size_t)l * 3072 + c0 + i]; cw1[i] = a.in[8][(size_t)l * 3072 + 1024 + c0 + i];
        cw2[i] = a.in[8][(size_t)l * 3072 + 2048 + c0 + i]; cn[i] = a.in[9][l * 1024 + c0 + i]; u1[i] = 0.f; u2[i] = 0.f; }
    if (sfirst >= 2) {
        float cc[16], chh[16];
        { const bf16* pr = proj + (size_t)(tfirst - 2) * NP; unpack16(*(const v4u*)(pr + PCC + c0), *(const v4u*)(pr + PCC + c0 + 8), cc); unpack16(*(const v4u*)(pr + PCH + c0), *(const v4u*)(pr + PCH + c0 + 8), chh); }
#pragma unroll
        for (int i = 0; i < 16; ++i) u2[i] = cc[i] * chh[i];
        { const bf16* pr = proj + (size_t)(tfirst - 1) * NP; unpack16(*(const v4u*)(pr + PCC + c0), *(const v4u*)(pr + PCC + c0 + 8), cc); unpack16(*(const v4u*)(pr + PCH + c0), *(const v4u*)(pr + PCH + c0 + 8), chh); }
#pragma unroll
        for (int i = 0; i < 16; ++i) u1[i] = cc[i] * chh[i];
    }
#pragma unroll 2
    for (int it = 0; it < 8; ++it) { const int t = tfirst + it; const bf16* pr = proj + (size_t)t * NP;
        float o[16], r[16], cb[16], cc[16], chh[16];
        unpack16(*(const v4u*)(ogla + (size_t)t * 1024 + c0), *(const v4u*)(ogla + (size_t)t * 1024 + c0 + 8), o);
        unpack16(*(const v4u*)(pr + PR + c0), *(const v4u*)(pr + PR + c0 + 8), r);
        unpack16(*(const v4u*)(pr + PCB + c0), *(const v4u*)(pr + PCB + c0 + 8), cb);
        unpack16(*(const v4u*)(pr + PCC + c0), *(const v4u*)(pr + PCC + c0 + 8), cc);
        unpack16(*(const v4u*)(pr + PCH + c0), *(const v4u*)(pr + PCH + c0 + 8), chh);
        float ss = 0.f;
#pragma unroll
        for (int i = 0; i < 16; ++i) ss += o[i] * o[i];
        ss += __shfl_xor(ss, 1); ss += __shfl_xor(ss, 2); ss += __shfl_xor(ss, 4); ss += __shfl_xor(ss, 8);
        const float rg = rsqrtf(ss * (1.0f / 256.f) + EPS);
        float val[16]; float s2 = 0.f;
#pragma unroll
        for (int i = 0; i < 16; ++i) { const float u0 = cc[i] * chh[i]; val[i] = cb[i] * (cw0[i] * u2[i] + cw1[i] * u1[i] + cw2[i] * u0); s2 += val[i] * val[i]; u2[i] = u1[i]; u1[i] = u0; }
        const float rc = rsqrtf(wave_sum(s2) * (1.0f / 1024.f) + EPS);
        v4u y0, y1, y2, y3;
#pragma unroll
        for (int j = 0; j < 4; ++j) {
            y0[j] = pk2(o[2 * j] * rg * gn[2 * j] * silu_f(r[2 * j]), o[2 * j + 1] * rg * gn[2 * j + 1] * silu_f(r[2 * j + 1]));
            y1[j] = pk2(o[8 + 2 * j] * rg * gn[8 + 2 * j] * silu_f(r[8 + 2 * j]), o[9 + 2 * j] * rg * gn[9 + 2 * j] * silu_f(r[9 + 2 * j]));
            y2[j] = pk2(val[2 * j] * rc * cn[2 * j], val[2 * j + 1] * rc * cn[2 * j + 1]);
            y3[j] = pk2(val[8 + 2 * j] * rc * cn[8 + 2 * j], val[9 + 2 * j] * rc * cn[9 + 2 * j]); }
        bf16* yr = ybuf + (size_t)t * D;
        *(v4u*)(yr + c0) = y0; *(v4u*)(yr + c0 + 8) = y1; *(v4u*)(yr + 1024 + c0) = y2; *(v4u*)(yr + 1024 + c0 + 8) = y3;
    }
}

__device__ __forceinline__ void ln1_chunk(const Args& a, int l, int lane, int wave, int ch) {
    const float* zbuf = (const float*)(a.ws + WS_Z); const float* mod = (const float*)(a.ws + WS_MOD);
    const int b = ch / NCH; const float* mb = mod + ((size_t)l * NB + b) * 6 * D;
#pragma unroll 2
    for (int it = 0; it < 8; ++it) { const int t = ch * 64 + wave * 8 + it;
        float z[32];
#pragma unroll
        for (int c = 0; c < 8; ++c) { const f32x4 v0 = *(const f32x4*)(zbuf + (size_t)t * D + (c * 64 + lane) * 4); z[c * 4] = v0.x; z[c * 4 + 1] = v0.y; z[c * 4 + 2] = v0.z; z[c * 4 + 3] = v0.w; }
        ln_tail(z, t, lane, a.in[11] + (size_t)l * D, a.in[12] + (size_t)l * D, (float*)(a.ws + WS_X1), mb + 3 * D, mb + 4 * D, (bf16*)(a.ws + WS_H2), a.ws + WS_HQ8, (float*)(a.ws + WS_HSC));
    }
}

template <int N> __device__ __forceinline__ void bitonic_sort_desc(float (&v)[N]) {
#pragma unroll
    for (int k = 2; k <= N; k <<= 1)
#pragma unroll
        for (int j = k >> 1; j > 0; j >>= 1)
#pragma unroll
            for (int i = 0; i < N; ++i) { const int p = i ^ j; if (p > i) { const bool desc = ((i & k) == 0); const float x = v[i], y = v[p]; const float mx = fmaxf(x, y), mn = fminf(x, y); v[i] = desc ? mx : mn; v[p] = desc ? mn : mx; } }
}
__device__ __forceinline__ void merge_top16(float (&x)[16], const float (&y)[16]) {
#pragma unroll
    for (int i = 0; i < 16; ++i) x[i] = fmaxf(x[i], y[15 - i]);
#pragma unroll
    for (int j = 8; j > 0; j >>= 1)
#pragma unroll
        for (int i = 0; i < 16; ++i) { const int p = i ^ j; if (p > i) { const float u = x[i], w = x[p]; x[i] = fmaxf(u, w); x[p] = fminf(u, w); } }
}
__device__ __forceinline__ void ce_desc(float& ka, int& pa, float& kb, int& pb) { const bool sw = kb > ka; const float k0 = sw ? kb : ka, k1 = sw ? ka : kb; const int p0 = sw ? pb : pa, p1 = sw ? pa : pb; ka = k0; pa = p0; kb = k1; pb = p1; }
__device__ __forceinline__ void bitonic_sort_desc_kp(float (&k)[16], int (&p)[16]) {
#pragma unroll
    for (int kk = 2; kk <= 16; kk <<= 1)
#pragma unroll
        for (int j = kk >> 1; j > 0; j >>= 1)
#pragma unroll
            for (int i = 0; i < 16; ++i) { const int q = i ^ j; if (q > i) { if ((i & kk) == 0) ce_desc(k[i], p[i], k[q], p[q]); else ce_desc(k[q], p[q], k[i], p[i]); } }
}
__device__ __forceinline__ void merge_top16_kp(float (&k)[16], int (&p)[16], const float (&k2)[16], const int (&p2)[16]) {
#pragma unroll
    for (int i = 0; i < 16; ++i) { const bool sw = k2[15 - i] > k[i]; k[i] = sw ? k2[15 - i] : k[i]; p[i] = sw ? p2[15 - i] : p[i]; }
#pragma unroll
    for (int j = 8; j > 0; j >>= 1)
#pragma unroll
        for (int i = 0; i < 16; ++i) { const int q = i ^ j; if (q > i) ce_desc(k[i], p[i], k[q], p[q]); }
}
__device__ constexpr int cand_i(int s) { return s < 16 ? 0 : s < 24 ? 1 : s < 29 ? 2 : s < 33 ? 3 : s < 36 ? 4 : s < 38 ? 5 : s < 40 ? 6 : s < 42 ? 7 : s < 50 ? s - 34 : -1; }
__device__ constexpr int cand_j(int s) { return s < 16 ? s : s < 24 ? s - 16 : s < 29 ? s - 24 : s < 33 ? s - 29 : s < 36 ? s - 33 : s < 38 ? s - 36 : s < 40 ? s - 38 : s < 42 ? s - 40 : s < 50 ? 0 : -1; }

__device__ __forceinline__ void peer_retrieve(const Args& a, int l, LAS unsigned char* lds, int lane, int wave, int ch) {
    const bf16* qbuf = (const bf16*)(a.ws + WS_Q); const bf16* keys = (const bf16*)(a.ws + WS_KEYS) + ((size_t)(l * 8 + wave) * 2) * 128 * 128;
    LAS int* eg_e = (LAS int*)lds; LAS float* eg_g = (LAS float*)(lds + 32768);
    const int l31 = lane & 31, l5 = lane >> 5, h = wave, t0 = ch * 64;
    for (int tt = 0; tt < 2; ++tt) {
        float sv[2][16];
#pragma unroll
        for (int p = 0; p < 2; ++p) {
            f32x16 acc[4];
#pragma unroll
            for (int nt = 0; nt < 4; ++nt)
#pragma unroll
                for (int r = 0; r < 16; ++r) acc[nt][r] = 0.f;
            const bf16* qp = qbuf + (size_t)(t0 + 32 * tt + l31) * D + h * 256 + p * 128 + 8 * l5;
            const bf16* kp = keys + (size_t)(p * 128 + l31) * 128 + 8 * l5;
#pragma unroll 2
            for (int ks = 0; ks < 8; ++ks) { const bf16x8 bq = *(const bf16x8*)(qp + 16 * ks);
#pragma unroll
                for (int nt = 0; nt < 4; ++nt) { const bf16x8 ak = *(const bf16x8*)(kp + (size_t)(32 * nt) * 128 + 16 * ks); acc[nt] = __builtin_amdgcn_mfma_f32_32x32x16_bf16(ak, bq, acc[nt], 0, 0, 0); } }
            float v[4][16];
#pragma unroll
            for (int nt = 0; nt < 4; ++nt)
#pragma unroll
                for (int r = 0; r < 16; ++r) { const unsigned idx = 32u * nt + (r & 3) + 8u * (r >> 2) + 4u * l5; v[nt][r] = __uint_as_float((__float_as_uint(acc[nt][r]) & 0xffffff80u) | idx); }
#pragma unroll
            for (int nt = 0; nt < 4; ++nt) bitonic_sort_desc<16>(v[nt]);
            merge_top16(v[0], v[1]); merge_top16(v[2], v[3]); merge_top16(v[0], v[2]);
            float o[16];
#pragma unroll
            for (int i = 0; i < 16; ++i) o[i] = __shfl_xor(v[0][i], 32);
            merge_top16(v[0], o);
#pragma unroll
            for (int i = 0; i < 16; ++i) sv[p][i] = v[0][i];
        }
        LAS unsigned char* idxb = (LAS unsigned char*)(lds + 69632) + wave * 2048 + lane * 32;
        { v4u w0, w1;
#pragma unroll
          for (int q4 = 0; q4 < 4; ++q4) {
              w0[q4] = (__float_as_uint(sv[0][4 * q4]) & 127u) | ((__float_as_uint(sv[0][4 * q4 + 1]) & 127u) << 8) | ((__float_as_uint(sv[0][4 * q4 + 2]) & 127u) << 16) | ((__float_as_uint(sv[0][4 * q4 + 3]) & 127u) << 24);
              w1[q4] = (__float_as_uint(sv[1][4 * q4]) & 127u) | ((__float_as_uint(sv[1][4 * q4 + 1]) & 127u) << 8) | ((__float_as_uint(sv[1][4 * q4 + 2]) & 127u) << 16) | ((__float_as_uint(sv[1][4 * q4 + 3]) & 127u) << 24); }
          *(LAS v4u*)(idxb) = w0; *(LAS v4u*)(idxb + 16) = w1; }
        float ck[4][16];
#pragma unroll
        for (int s = 0; s < 64; ++s) {
            if (cand_i(s) >= 0) { const unsigned b0 = __float_as_uint(sv[0][cand_i(s) < 0 ? 0 : cand_i(s)]), b1 = __float_as_uint(sv[1][cand_j(s) < 0 ? 0 : cand_j(s)]);
                const float sum = __uint_as_float(b0 & 0xffffff80u) + __uint_as_float(b1 & 0xffffff80u);
                ck[s >> 4][s & 15] = __uint_as_float((__float_as_uint(sum) & 0xffffff00u) | (unsigned)((cand_i(s) < 0 ? 0 : cand_i(s)) * 16 + (cand_j(s) < 0 ? 0 : cand_j(s)))); }
            else ck[s >> 4][s & 15] = -3.0e38f; }
        bitonic_sort_desc<16>(ck[1]); bitonic_sort_desc<16>(ck[2]);
        merge_top16(ck[0], ck[1]); merge_top16(ck[2], ck[3]); merge_top16(ck[0], ck[2]);
        LDS_WAIT(); asm volatile("" ::: "memory");
        float ex[16]; int ce[16]; float den = 0.f;
        const float cmax = __uint_as_float(__float_as_uint(ck[0][0]) & 0xffffff00u);
#pragma unroll
        for (int i = 0; i < 16; ++i) { const unsigned bits = __float_as_uint(ck[0][i]); ex[i] = __expf(__uint_as_float(bits & 0xffffff00u) - cmax); den += ex[i];
            ce[i] = (int)idxb[(bits >> 4) & 15u] * 128 + (int)idxb[16 + (bits & 15u)]; }
        const float inv = 1.0f / den;
        if (l5 == 0) {
            const int base = (32 * tt + l31) * 128 + h * 16;
#pragma unroll
            for (int i4 = 0; i4 < 4; ++i4) { *(LAS v4u*)(eg_e + base + 4 * i4) = (v4u){(unsigned)ce[4 * i4], (unsigned)ce[4 * i4 + 1], (unsigned)ce[4 * i4 + 2], (unsigned)ce[4 * i4 + 3]};
                *(LAS f32x4*)(eg_g + base + 4 * i4) = (f32x4){ex[4 * i4] * inv, ex[4 * i4 + 1] * inv, ex[4 * i4 + 2] * inv, ex[4 * i4 + 3] * inv}; }
        }
        LDS_WAIT(); asm volatile("" ::: "memory");
    }
}

typedef unsigned char uc4 __attribute__((ext_vector_type(4)));
constexpr int NSLICE = 16, SLICE_SHIFT = 10;
__device__ __forceinline__ int sdot4i(unsigned w, unsigned x, int acc) { return __builtin_amdgcn_sdot4((int)w, (int)x, acc, false); }
__device__ __forceinline__ void fma_ub4(unsigned w, float s, float& y0, float& y1, float& y2, float& y3) { const uc4 b = __builtin_bit_cast(uc4, w); y0 += s * (float)b.x; y1 += s * (float)b.y; y2 += s * (float)b.z; y3 += s * (float)b.w; }
#if TAB4
__device__ __forceinline__ void peer_tail(const Args& a, int l, int t, int lane, const float* Yrow, const float* mb, const float* mbn, bool last) {
    const float* x1buf = (const float*)(a.ws + WS_X1);
    float z[32];
#pragma unroll
    for (int c8 = 0; c8 < 8; ++c8) { const int col = (c8 * 64 + lane) * 4;
        const f32x4 yv = *(const f32x4*)(Yrow + lane * 32 + 4 * c8), x0 = *(const f32x4*)(x1buf + (size_t)t * D + col), g0 = *(const f32x4*)(mb + 5 * D + col);
        z[c8 * 4] = ALPHA * x0.x + (1.f + g0.x) * yv.x; z[c8 * 4 + 1] = ALPHA * x0.y + (1.f + g0.y) * yv.y; z[c8 * 4 + 2] = ALPHA * x0.z + (1.f + g0.z) * yv.z; z[c8 * 4 + 3] = ALPHA * x0.w + (1.f + g0.w) * yv.w; }
    ln_tail(z, t, lane, a.in[17] + (size_t)l * D, a.in[18] + (size_t)l * D, last ? a.out : (float*)(a.ws + WS_X), mbn, mbn + D, last ? (bf16*)nullptr : (bf16*)(a.ws + WS_H), nullptr, nullptr);
}
template <class TT, int N, int M> __device__ __forceinline__ void treduce(TT (&v)[N], int lane) {
    const bool c0 = (lane & M) != 0, c1 = (lane & (2 * M)) != 0, c2 = (lane & (4 * M)) != 0;
#pragma unroll
    for (int m = 0; m < N / 2; ++m) { const TT keep = c0 ? v[2 * m + 1] : v[2 * m], send = c0 ? v[2 * m] : v[2 * m + 1]; v[m] = keep + __shfl_xor(send, M); }
#pragma unroll
    for (int m = 0; m < N / 4; ++m) { const TT keep = c1 ? v[2 * m + 1] : v[2 * m], send = c1 ? v[2 * m] : v[2 * m + 1]; v[m] = keep + __shfl_xor(send, 2 * M); }
#pragma unroll
    for (int m = 0; m < N / 8; ++m) { const TT keep = c2 ? v[2 * m + 1] : v[2 * m], send = c2 ? v[2 * m] : v[2 * m + 1]; v[m] = keep + __shfl_xor(send, 4 * M); }
}
__device__ __forceinline__ void peer_experts(const Args& a, int l, LAS unsigned char* lds, int lane0, int wave, int ch) {
    const float* mod = (const float*)(a.ws + WS_MOD);
    const unsigned char* ut = a.ws + WS_UT + (size_t)l * NE * 1024; const unsigned char* vt = a.ws + WS_VT + (size_t)l * NE * 1024; const unsigned char* hq8 = a.ws + WS_HQ8;
    const bf16* us = (const bf16*)(a.ws + WS_UT + 128 * MiB) + (size_t)l * NE * 64; const bf16* vs = (const bf16*)(a.ws + WS_VT + 128 * MiB) + (size_t)l * NE * 64; const float* hsc = (const float*)(a.ws + WS_HSC);
    float* Ybuf = (float*)(a.ws + WS_Z);
    const LAS int* eg_e = (const LAS int*)lds; LAS float* sw = (LAS float*)(lds + 32768);
    LAS float* apart = (LAS float*)(lds + 65536);
    const int b = ch / NCH; const bool last = (l == NL - 1);
    const float* mb = mod + ((size_t)l * NB + b) * 6 * D; const float* mbn = mod + ((size_t)(last ? l : l + 1) * NB + b) * 6 * D;
    const int tlw = wave * 8;
    { const int lane = lane0;
#pragma unroll
      for (int i = 0; i < 16; ++i) apart[tlw * 128 + i * 64 + lane] = 0.f; }
    LDS_WAIT(); asm volatile("" ::: "memory");
    {
        int laneL = lane0; asm volatile("" : "+v"(laneL)); const int lane = laneL;
        const int g = lane >> 3, l7 = lane & 7;
        v4u bufA[8], bufB[8]; unsigned short scA[8], scB[8]; v4u hA0, hA1, hN0, hN1; float accv[16];
#define CU_LOAD(buf, sc_, hidx_) do { const int cs_ = (hidx_) >> 4, tl_ = tlw + (((hidx_) >> 1) & 7), hf_ = (hidx_) & 1; const unsigned seg_ = (unsigned)(cs_ * 8 + l7); \
            _Pragma("unroll") for (int i_ = 0; i_ < 8; ++i_) { const unsigned e_ = (unsigned)eg_e[tl_ * 128 + 8 * (8 * hf_ + i_) + g]; buf[i_] = *(const v4u*)(ut + (size_t)(e_ * 1024u + seg_ * 16u)); sc_[i_] = us[(size_t)(e_ * 64u + seg_)]; } } while (0)
#define CU_HLOAD(hidx_) do { const int cs_ = (hidx_) >> 4, tl_ = tlw + (((hidx_) >> 1) & 7); const unsigned char* hp_ = hq8 + (size_t)(ch * 64 + tl_) * D + (cs_ * 8 + l7) * 32; hN0 = *(const v4u*)hp_; hN1 = *(const v4u*)(hp_ + 16); } while (0)
#define CU_COMP(buf, sc_, hf_) do { int hs_ = 0; \
            _Pragma("unroll") for (int q_ = 0; q_ < 4; ++q_) { hs_ = sdot4i(hA0[q_], 0x01010101u, hs_); hs_ = sdot4i(hA1[q_], 0x01010101u, hs_); } \
            _Pragma("unroll") for (int i_ = 0; i_ < 8; ++i_) { int s_ = 0; \
                _Pragma("unroll") for (int q_ = 0; q_ < 4; ++q_) { const unsigned w_ = buf[i_][q_]; const unsigned he_ = q_ < 2 ? hA0[2 * q_] : hA1[2 * q_ - 4], ho_ = q_ < 2 ? hA0[2 * q_ + 1] : hA1[2 * q_ - 3]; \
                    s_ = sdot4i(w_ & 0x0f0f0f0fu, he_, s_); s_ = sdot4i((w_ >> 4) & 0x0f0f0f0fu, ho_, s_); } \
                accv[8 * (hf_) + i_] = bflo((unsigned)sc_[i_]) * (float)(s_ - 8 * hs_); } } while (0)
        CU_LOAD(bufA, scA, 0); CU_HLOAD(0);
        for (int hidx = 0; hidx < 128; hidx += 2) {
            CU_LOAD(bufB, scB, hidx + 1);
            hA0 = hN0; hA1 = hN1; if (hidx + 2 < 128) CU_HLOAD(hidx + 2);
            CU_COMP(bufA, scA, 0);
            if (hidx + 2 < 128) CU_LOAD(bufA, scA, hidx + 2);
            CU_COMP(bufB, scB, 1);
            treduce<float, 16, 1>(accv, lane);
            { const int tl_ = tlw + ((hidx >> 1) & 7); apart[tl_ * 128 + 8 * l7 + g] += accv[0]; apart[tl_ * 128 + 8 * (8 + l7) + g] += accv[1]; }
        }
#undef CU_LOAD
#undef CU_HLOAD
#undef CU_COMP
        LDS_WAIT(); asm volatile("" ::: "memory");
        for (int it = 0; it < 8; ++it) { const int tl = tlw + it; const float shs = hsc[ch * 64 + tl];
            const float w0 = sw[tl * 128 + lane] * gelu_tanh_f(apart[tl * 128 + lane] * shs), w1 = sw[tl * 128 + 64 + lane] * gelu_tanh_f(apart[tl * 128 + 64 + lane] * shs);
            sw[tl * 128 + lane] = w0; sw[tl * 128 + 64 + lane] = w1; }
        LDS_WAIT(); asm volatile("" ::: "memory");
    }
    {
        int laneL = lane0; asm volatile("" : "+v"(laneL)); const int lane = laneL;
        const int g = lane >> 3, l7 = lane & 7;
        v4u bufA[8], bufB[8]; unsigned short scA[8], scB[8]; float y[32]; float offs;
#define CV_LOAD(buf, sc_, hidx_) do { const int cs_ = (hidx_) >> 4, tl_ = tlw + (((hidx_) >> 1) & 7), hf_ = (hidx_) & 1; const unsigned seg_ = (unsigned)(cs_ * 8 + l7); \
            _Pragma("unroll") for (int i_ = 0; i_ < 8; ++i_) { const unsigned e_ = (unsigned)eg_e[tl_ * 128 + 8 * (8 * hf_ + i_) + g]; buf[i_] = *(const v4u*)(vt + (size_t)(e_ * 1024u + seg_ * 16u)); sc_[i_] = vs[(size_t)(e_ * 64u + seg_)]; } } while (0)
#define CV_COMP(buf, sc_, hidx_) do { const int tl_ = tlw + (((hidx_) >> 1) & 7), hf_ = (hidx_) & 1; \
            _Pragma("unroll") for (int i_ = 0; i_ < 8; ++i_) { const float ws_ = sw[tl_ * 128 + 8 * (8 * hf_ + i_) + g] * bflo((unsigned)sc_[i_]); offs += ws_; \
                _Pragma("unroll") for (int q_ = 0; q_ < 4; ++q_) { const unsigned w_ = buf[i_][q_]; \
                    fma_ub4(w_ & 0x0f0f0f0fu, ws_, y[8 * q_], y[8 * q_ + 1], y[8 * q_ + 2], y[8 * q_ + 3]); fma_ub4((w_ >> 4) & 0x0f0f0f0fu, ws_, y[8 * q_ + 4], y[8 * q_ + 5], y[8 * q_ + 6], y[8 * q_ + 7]); } } } while (0)
        CV_LOAD(bufA, scA, 0);
        for (int hidx = 0; hidx < 128; hidx += 2) {
            CV_LOAD(bufB, scB, hidx + 1);
#pragma unroll
            for (int q = 0; q < 32; ++q) y[q] = 0.f;
            offs = 0.f;
            CV_COMP(bufA, scA, hidx);
            if (hidx + 2 < 128) CV_LOAD(bufA, scA, hidx + 2);
            CV_COMP(bufB, scB, hidx + 1);
            treduce<float, 32, 8>(y, lane);
            offs += __shfl_xor(offs, 8); offs += __shfl_xor(offs, 16); offs += __shfl_xor(offs, 32);
            { const int cs_ = hidx >> 4, tl_ = tlw + ((hidx >> 1) & 7); float* yr_ = Ybuf + (size_t)(ch * 64 + tl_) * D + (cs_ * 8 + l7) * 32 + g; const float o8_ = 8.0f * offs;
              yr_[0] = y[0] - o8_; yr_[8] = y[1] - o8_; yr_[16] = y[2] - o8_; yr_[24] = y[3] - o8_; }
        }
#undef CV_LOAD
#undef CV_COMP
    }
    asm volatile("s_waitcnt vmcnt(0)" ::: "memory");
    __builtin_amdgcn_fence(__ATOMIC_ACQUIRE, "agent");
    asm volatile("s_waitcnt vmcnt(0)" ::: "memory");
    for (int it = 0; it < 8; ++it) { int laneT = lane0; asm volatile("" : "+v"(laneT)); const int t = ch * 64 + tlw + it;
        peer_tail(a, l, t, laneT, Ybuf + (size_t)t * D, mb, mbn, last); }
}
#else
__device__ __forceinline__ void peer_tail(const Args& a, int l, int t, int lane, const float* Yrow, const float* mb, const float* mbn, bool last) {
    const float* x1buf = (const float*)(a.ws + WS_X1);
    float z[32];
#pragma unroll
    for (int c = 0; c < 2; ++c)
#pragma unroll
        for (int k = 0; k < 4; ++k) { const int c8 = 4 * c + k, col = (c8 * 64 + lane) * 4;
            const v2u yb = *(const v2u*)((const bf16*)Yrow + (c * 64 + lane) * 16 + 4 * k); const f32x4 yv = (f32x4){bflo(yb.x), bfhi(yb.x), bflo(yb.y), bfhi(yb.y)};
            const f32x4 x0 = *(const f32x4*)(x1buf + (size_t)t * D + col), g0 = *(const f32x4*)(mb + 5 * D + col);
            z[c8 * 4] = ALPHA * x0.x + (1.f + g0.x) * yv.x; z[c8 * 4 + 1] = ALPHA * x0.y + (1.f + g0.y) * yv.y; z[c8 * 4 + 2] = ALPHA * x0.z + (1.f + g0.z) * yv.z; z[c8 * 4 + 3] = ALPHA * x0.w + (1.f + g0.w) * yv.w; }
    ln_tail(z, t, lane, a.in[17] + (size_t)l * D, a.in[18] + (size_t)l * D, last ? a.out : (float*)(a.ws + WS_X), mbn, mbn + D, last ? (bf16*)nullptr : (bf16*)(a.ws + WS_H), nullptr, nullptr);
}
template <class TT, int M> __device__ __forceinline__ void treduce16(TT (&v)[16], int lane) {
    const bool c0 = (lane & M) != 0, c1 = (lane & (2 * M)) != 0, c2 = (lane & (4 * M)) != 0;
#pragma unroll
    for (int m = 0; m < 8; ++m) { const TT keep = c0 ? v[2 * m + 1] : v[2 * m], send = c0 ? v[2 * m] : v[2 * m + 1]; v[m] = keep + __shfl_xor(send, M); }
#pragma unroll
    for (int m = 0; m < 4; ++m) { const TT keep = c1 ? v[2 * m + 1] : v[2 * m], send = c1 ? v[2 * m] : v[2 * m + 1]; v[m] = keep + __shfl_xor(send, 2 * M); }
#pragma unroll
    for (int m = 0; m < 2; ++m) { const TT keep = c2 ? v[2 * m + 1] : v[2 * m], send = c2 ? v[2 * m] : v[2 * m + 1]; v[m] = keep + __shfl_xor(send, 4 * M); }
}
__device__ __forceinline__ void peer_experts(const Args& a, int l, LAS unsigned char* lds, int lane0, int wave, int ch) {
    const float* mod = (const float*)(a.ws + WS_MOD);
    const unsigned char* ut = a.ws + WS_UT + (size_t)l * NE * D; const unsigned char* vt = a.ws + WS_VT + (size_t)l * NE * D; const unsigned char* hq8 = a.ws + WS_HQ8;
    const float* su = (const float*)(a.ws + WS_SU) + (size_t)l * NE; const float* sv = (const float*)(a.ws + WS_SV) + (size_t)l * NE; const float* hsc = (const float*)(a.ws + WS_HSC);
    float* Ybuf = (float*)(a.ws + WS_Z);
    const LAS int* eg_e = (const LAS int*)lds; LAS float* sw = (LAS float*)(lds + 32768);
    LAS int* apart = (LAS int*)(lds + 65536); LAS float* wtotl = (LAS float*)(lds + LDSCTL_OFF + 256);
    const int b = ch / NCH; const bool last = (l == NL - 1);
    const float* mb = mod + ((size_t)l * NB + b) * 6 * D; const float* mbn = mod + ((size_t)(last ? l : l + 1) * NB + b) * 6 * D;
    const int tlw = wave * 8;
    { const int lane = lane0;
#pragma unroll
      for (int i = 0; i < 16; ++i) apart[tlw * 128 + i * 64 + lane] = 0; }
    LDS_WAIT(); asm volatile("" ::: "memory");
    {
        int laneL = lane0; asm volatile("" : "+v"(laneL)); const int lane = laneL;
        const int g = lane >> 3, l7 = lane & 7;
        v4u bufA[16], bufB[16], hA, hB;
#define CU_LOAD(buf, hh_, idx_) do { const int cs_ = (idx_) >> 3, tl_ = tlw + ((idx_) & 7); const unsigned coff_ = (unsigned)(cs_ * 128 + l7 * 16); \
            hh_ = *(const v4u*)(hq8 + (size_t)(ch * 64 + tl_) * D + coff_); \
            _Pragma("unroll") for (int i_ = 0; i_ < 16; ++i_) { const unsigned e_ = (unsigned)eg_e[tl_ * 128 + 8 * i_ + g]; buf[i_] = *(const v4u*)(ut + (size_t)(e_ * 2048u + coff_)); } } while (0)
#define CU_COMP(buf, hh_, idx_) do { const int tl_ = tlw + ((idx_) & 7); int acc_[16]; \
            _Pragma("unroll") for (int i_ = 0; i_ < 16; ++i_) { int s_ = 0; _Pragma("unroll") for (int q_ = 0; q_ < 4; ++q_) s_ = sdot4i(buf[i_][q_], hh_[q_], s_); acc_[i_] = s_; } \
            treduce16<int, 1>(acc_, lane); \
            apart[tl_ * 128 + 8 * l7 + g] += acc_[0]; apart[tl_ * 128 + 8 * (8 + l7) + g] += acc_[1]; } while (0)
        CU_LOAD(bufA, hA, 0);
        for (int idx = 0; idx < 128; idx += 2) {
            CU_LOAD(bufB, hB, idx + 1);
            CU_COMP(bufA, hA, idx);
            if (idx + 2 < 128) CU_LOAD(bufA, hA, idx + 2);
            CU_COMP(bufB, hB, idx + 1);
        }
#undef CU_LOAD
#undef CU_COMP
        LDS_WAIT(); asm volatile("" ::: "memory");
        for (int it = 0; it < 8; ++it) { const int tl = tlw + it; const float shs = hsc[ch * 64 + tl];
            const int e0 = eg_e[tl * 128 + lane], e1 = eg_e[tl * 128 + 64 + lane];
            const float w0 = sw[tl * 128 + lane] * gelu_tanh_f((float)apart[tl * 128 + lane] * su[e0] * shs) * sv[e0];
            const float w1 = sw[tl * 128 + 64 + lane] * gelu_tanh_f((float)apart[tl * 128 + 64 + lane] * su[e1] * shs) * sv[e1];
            sw[tl * 128 + lane] = w0; sw[tl * 128 + 64 + lane] = w1;
            const float ws = wave_sum(w0 + w1);
            if (lane == 0) wtotl[tl] = ws; }
        LDS_WAIT(); asm volatile("" ::: "memory");
    }
    {
        int laneL = lane0; asm volatile("" : "+v"(laneL)); const int lane = laneL;
        const int g = lane >> 3, l7 = lane & 7;
        v4u bufA[16], bufB[16];
#define CV_LOAD(buf, idx_) do { const int cs_ = (idx_) >> 3, tl_ = tlw + ((idx_) & 7); const unsigned coff_ = (unsigned)(cs_ * 128 + l7 * 16); \
            _Pragma("unroll") for (int i_ = 0; i_ < 16; ++i_) { const unsigned e_ = (unsigned)eg_e[tl_ * 128 + 8 * i_ + g]; buf[i_] = *(const v4u*)(vt + (size_t)(e_ * 2048u + coff_)); } } while (0)
#define CV_COMP(buf, idx_) do { const int cs_ = (idx_) >> 3, tl_ = tlw + ((idx_) & 7); float y_[16]; \
            _Pragma("unroll") for (int q_ = 0; q_ < 16; ++q_) y_[q_] = 0.f; \
            _Pragma("unroll") for (int i_ = 0; i_ < 16; ++i_) { const float wr_ = sw[tl_ * 128 + 8 * i_ + g]; \
                _Pragma("unroll") for (int q_ = 0; q_ < 4; ++q_) fma_ub4(buf[i_][q_], wr_, y_[4 * q_], y_[4 * q_ + 1], y_[4 * q_ + 2], y_[4 * q_ + 3]); } \
            treduce16<float, 8>(y_, lane); \
            const float woff_ = 128.0f * wtotl[tl_]; bf16* yr_ = (bf16*)Ybuf + (size_t)(ch * 64 + tl_) * D + cs_ * 128 + l7 * 16 + g; \
            yr_[0] = (bf16)(pk2(y_[0] - woff_, 0.f) & 0xffffu); yr_[8] = (bf16)(pk2(y_[1] - woff_, 0.f) & 0xffffu); } while (0)
        CV_LOAD(bufA, 0);
        for (int idx = 0; idx < 128; idx += 2) {
            CV_LOAD(bufB, idx + 1);
            CV_COMP(bufA, idx);
            if (idx + 2 < 128) CV_LOAD(bufA, idx + 2);
            CV_COMP(bufB, idx + 1);
        }
#undef CV_LOAD
#undef CV_COMP
    }
    asm volatile("s_waitcnt vmcnt(0)" ::: "memory");
    __builtin_amdgcn_fence(__ATOMIC_ACQUIRE, "agent");
    asm volatile("s_waitcnt vmcnt(0)" ::: "memory");
    for (int it = 0; it < 8; ++it) { int laneT = lane0; asm volatile("" : "+v"(laneT)); const int t = ch * 64 + tlw + it;
        peer_tail(a, l, t, laneT, (const float*)((const bf16*)Ybuf + (size_t)t * D), mb, mbn, last); }
}

#endif

#ifndef MK_PER_PHASE
#define MK_PER_PHASE 0
#endif
__global__ void __launch_bounds__(NTHREADS, 2) mk_fwd(Args a) {
    extern __shared__ __attribute__((aligned(16))) unsigned char lds_raw[];
    LAS unsigned char* lds = (LAS unsigned char*)lds_raw;
    const int tid = threadIdx.x, lane = tid & 63, wave = __builtin_amdgcn_readfirstlane(tid >> 6), G = gridDim.x, bx = blockIdx.x;
    if (tid < 64) ((LAS unsigned*)(lds + LDSCTL_OFF))[tid] = 0u;
    __syncthreads();
    unsigned* ctl = (unsigned*)(a.ws + WS_CTL);
    XcdBarrier bar; bar.bar = ctl + CW_BAR; bar.x = 0; bar.st = nullptr;
    const bool use_bar = (a.ph_hi - a.ph_lo) > 1;
    if (use_bar) bar = xcd_barrier_post(ctl + CW_BAR, (volatile LAS unsigned*)(lds + LDSCTL_OFF));
    const int lo = a.ph_lo, hi = a.ph_hi;
#ifndef PH_MASK
#define PH_MASK 0x1ff
#endif
#define IN(k) (lo <= (k) && (k) < hi)
#define EN(b) ((PH_MASK >> (b)) & 1)
#ifndef REP_MASK
#define REP_MASK 0
#endif
#ifndef REP_EXTRA
#define REP_EXTRA 2
#endif
#define REPS(b) (1 + ((REP_MASK >> (b)) & 1) * REP_EXTRA)
#define REP_BEGIN(b) for (int rep_ = 0; rep_ < REPS(b); ++rep_) {
#define REP_END(b) if (rep_ + 1 < REPS(b)) xcd_barrier(bar); }
#define SEAM(k) do { if (IN((k) + 1)) xcd_barrier(bar); } while (0)
#define PHASE_IDS() int tidp = tid; asm volatile("" : "+v"(tidp)); const int lanep = tidp & 63, wavep = __builtin_amdgcn_readfirstlane(tidp >> 6); (void)lanep; (void)wavep
    if (EN(0) && IN(0)) { REP_BEGIN(0) PHASE_IDS(); ph_prologue_a(a, lds, tidp, lanep, wavep, bx, G); REP_END(0) SEAM(0); }
    if (EN(1) && IN(1)) { REP_BEGIN(1) PHASE_IDS(); ph_prologue_b(a, lds, tidp, lanep, wavep, bx, G); REP_END(1) SEAM(1); }
    for (int l = 0; l < NL; ++l) {
        const int pb = 2 + 7 * l;
        const float* mod = (const float*)(a.ws + WS_MOD);
        if (EN(2) && IN(pb + 0)) {
            REP_BEGIN(2) PHASE_IDS();
            pg8::Gemm g{(const pg8::bf16_t*)(a.ws + WS_H), (const pg8::bf16_t*)(a.ws + WS_WIN) + (size_t)l * INW * D, T, NP, D}; pg8::StaticOrder S; S.init(T, NP, G, bx);
            pg8::EpiBf16P E{(pg8::bf16_t*)(a.ws + WS_PROJ), NP};
            pg8::gemm_phase<pg8::EpiBf16P, pg8::StaticOrder, true, true>(lds + RING_OFF, g, S, E, tidp);
            for (int ch = bx; ch < NCHUNK; ch += G) gate_prep(a, l, lds, tidp, lanep, wavep, ch);
            REP_END(2) SEAM(pb + 0);
        }
        if (EN(3) && IN(pb + 1)) { REP_BEGIN(3) PHASE_IDS(); for (int un = bx; un < 256; un += G) gla_unit(a, lds, tidp, lanep, wavep, un); REP_END(3) SEAM(pb + 1); }
        if (EN(4) && IN(pb + 2)) { REP_BEGIN(4) PHASE_IDS(); for (int ch = bx; ch < NCHUNK; ch += G) mixpost_chunk(a, l, lanep, wavep, ch); REP_END(4) SEAM(pb + 2); }
        if (EN(5) && IN(pb + 3)) {
            REP_BEGIN(5) PHASE_IDS();
            pg8::Gemm g{(const pg8::bf16_t*)(a.ws + WS_Y), (const pg8::bf16_t*)(a.ws + WS_WOUT) + (size_t)l * D * D, T, D, D}; pg8::StaticOrder S; S.init(T, D, G, bx);
            pg8::EpiResid E{(float*)(a.ws + WS_Z), l == 0 ? a.in[0] : (const float*)(a.ws + WS_X), mod + (size_t)l * NB * 6 * D + 2 * D, ALPHA};
            pg8::gemm_phase<pg8::EpiResid, pg8::StaticOrder, true, true>(lds + RING_OFF, g, S, E, tidp);
            REP_END(5) SEAM(pb + 3);
        }
        if (EN(6) && IN(pb + 4)) { REP_BEGIN(6) PHASE_IDS(); for (int ch = bx; ch < NCHUNK; ch += G) ln1_chunk(a, l, lanep, wavep, ch); REP_END(6) SEAM(pb + 4); }
        if (EN(7) && IN(pb + 5)) {
            REP_BEGIN(7) PHASE_IDS();
            pg8::Gemm g{(const pg8::bf16_t*)(a.ws + WS_H2), (const pg8::bf16_t*)(a.ws + WS_WQ) + (size_t)l * D * D, T, D, D}; pg8::StaticOrder S; S.init(T, D, G, bx);
            pg8::EpiBf16P E{(pg8::bf16_t*)(a.ws + WS_Q), D};
            pg8::gemm_phase<pg8::EpiBf16P, pg8::StaticOrder, true, true>(lds + RING_OFF, g, S, E, tidp);
            REP_END(7) SEAM(pb + 5);
        }
#ifndef PEER_DBG
#define PEER_DBG 0
#endif
#ifndef PE_REP_R
#define PE_REP_R 1
#endif
#ifndef L2PROBE
#define L2PROBE 0
#endif
        if (EN(8) && IN(pb + 6)) {
            REP_BEGIN(8)
            for (int ch = bx; ch < NCHUNK; ch += G) { for (int repr_ = 0; repr_ < PE_REP_R; ++repr_) { PHASE_IDS(); peer_retrieve(a, l, lds, lanep, wavep, ch); __syncthreads(); } __syncthreads(); { PHASE_IDS(); peer_experts(a, l, lds, lanep, wavep, ch); } __syncthreads(); }
            REP_END(8) SEAM(pb + 6);
        }
    }
#undef IN
#undef SEAM
}

extern "C" void kernel_launch(void* const* d_in, const int* in_sizes, int n_in, void* d_out, int out_size, void* d_ws, size_t ws_size, hipStream_t stream) {
    static int grid = 0;
    if (grid == 0) {
        if (n_in != 19 || in_sizes[0] != T * D || out_size != T * D || ws_size < WS_END) { fprintf(stderr, "kernel_launch: unexpected shapes / workspace (%d inputs, ws %zu); nothing launched\n", n_in, ws_size); grid = -1; return; }
        int dev = 0, cus = 0, per_cu = 0;
        if (hipGetDevice(&dev) != hipSuccess || hipDeviceGetAttribute(&cus, hipDeviceAttributeMultiprocessorCount, dev) != hipSuccess) { grid = -1; return; }
        if (hipFuncSetAttribute((const void*)mk_fwd, hipFuncAttributeMaxDynamicSharedMemorySize, LDS_BYTES) != hipSuccess) { fprintf(stderr, "kernel_launch: hipFuncSetAttribute failed\n"); grid = -1; return; }
        if (hipOccupancyMaxActiveBlocksPerMultiprocessor(&per_cu, (const void*)mk_fwd, NTHREADS, LDS_BYTES) != hipSuccess || per_cu < 1) fprintf(stderr, "kernel_launch: occupancy query reports %d\n", per_cu);
        (void)hipGetLastError();
        grid = cus;
    }
    if (grid < 0) return;
    if (hipMemsetAsync((char*)d_ws + WS_CTL, 0, CTL_ZERO_BYTES, stream) != hipSuccess) return;
    Args a{};
    for (int i = 0; i < 19; ++i) a.in[i] = (const float*)d_in[i];
    a.out = (float*)d_out; a.ws = (unsigned char*)d_ws;
#if MK_PER_PHASE
    for (int p = 0; p < NPHASES; ++p) { a.ph_lo = p; a.ph_hi = p + 1; hipLaunchKernelGGL(mk_fwd, dim3(grid), dim3(NTHREADS), LDS_BYTES, stream, a); }
#else
    a.ph_lo = 0; a.ph_hi = NPHASES;
    hipLaunchKernelGGL(mk_fwd, dim3(grid), dim3(NTHREADS), LDS_BYTES, stream, a);
#endif
}
```

```cpp
#include <hip/hip_runtime.h>
#include <cstdio>
#include <cstdint>
namespace pg8 {
#define PG8_LAS __attribute__((address_space(3)))
typedef unsigned short bf16_t;
typedef short bf16x8 __attribute__((ext_vector_type(8)));
typedef float f32x4 __attribute__((ext_vector_type(4)));
typedef unsigned u32x4 __attribute__((ext_vector_type(4)));
constexpr int BM = 256, BK = 64, HALF = 128, HTB = HALF * BK * 2  , STAGE_BYTES = 8 * HTB, NXCD = 8, WGM = 8;

__host__ __device__ __forceinline__ int lds_byte(int r, int c) { const int st = (r >> 4) * 2 + (c >> 5), rr = r & 15, cc = c & 31, ob = rr * 64 + cc * 2; return st * 1024 + (ob ^ (((ob >> 9) & 1) << 5)); }
__host__ __device__ __forceinline__ void stage_rc(int b, int& R, int& C) { const int st = b / 1024, sb = b % 1024, swz = sb ^ (((sb >> 9) & 1) << 5); R = (st >> 1) * 16 + swz / 64; C = (st & 1) * 32 + (swz % 64) / 2; }
__host__ __device__ __forceinline__ int perm32(int rho) { const int n = rho >> 4, i = rho & 15; return 8 * (i >> 2) + 4 * n + (i & 3); }

struct Unit { int pm, pn; };
struct Gemm { const bf16_t* A; const bf16_t* Bt; int M, N, K; };

struct StaticOrder {
    int nM, nN, nwg, G, c;
    __host__ __device__ void init(int M, int N, int G_, int c_) { nM = M / BM; nN = N / BM; nwg = nM * nN; G = G_; c = c_; }
    __host__ __device__ bool next(int i, Unit& u) const {
        const long L = (long)i * G + c; if (L >= nwg) return false;
        int wgid = (int)L; { const int q = nwg / NXCD, r = nwg % NXCD, xcd = wgid % NXCD, off = wgid / NXCD; wgid = (xcd < r ? xcd * (q + 1) : r * (q + 1) + (xcd - r) * q) + off; }
        const int nig = WGM * nN, gid = wgid / nig, fm = gid * WGM, gsz = (nM - fm) < WGM ? (nM - fm) : WGM;
        u.pm = fm + ((wgid % nig) % gsz); u.pn = (wgid % nig) / gsz; return true;
    }
    __device__ __forceinline__ void a_ready(const Unit&) const {}
    __device__ __forceinline__ void done(const Unit&) const {}
};
typedef __bf16 bf16x2_t __attribute__((ext_vector_type(2)));
__device__ __forceinline__ unsigned cvt_pk_bf16(float lo, float hi) { bf16x2_t r; r.x = (__bf16)lo; r.y = (__bf16)hi; return __builtin_bit_cast(unsigned, r); }
struct EpiBf16P {
    static constexpr bool PERM = true, AFTER_DRAIN = false;
    bf16_t* O; int ldc;
    __device__ __forceinline__ void operator()(const f32x4 (&acc)[2][2][4][2], const Unit& u, int wr, int wc, int fr, int fq) const {
        const int row0 = u.pm * BM + wr * 64 + fr, col0 = u.pn * BM + wc * 32 + 8 * fq;
#pragma unroll
        for (int ai = 0; ai < 2; ++ai)
#pragma unroll
            for (int m = 0; m < 4; ++m) { bf16_t* rowp = O + (size_t)(row0 + ai * HALF + m * 16) * ldc + col0;
#pragma unroll
                for (int bj = 0; bj < 2; ++bj) { const f32x4 v0 = acc[ai][bj][m][0], v1 = acc[ai][bj][m][1];
                    u32x4 w; w.x = cvt_pk_bf16(v0[0], v0[1]); w.y = cvt_pk_bf16(v0[2], v0[3]); w.z = cvt_pk_bf16(v1[0], v1[1]); w.w = cvt_pk_bf16(v1[2], v1[3]);
                    *(u32x4*)(rowp + bj * HALF) = w; } }
    }
};
struct EpiResid {
    static constexpr bool PERM = false, AFTER_DRAIN = false;
    float* Z; const float* X; const float* gate; float alpha;
    __device__ __forceinline__ void operator()(const f32x4 (&acc)[2][2][4][2], const Unit& u, int wr, int wc, int fr, int fq) const {
        const int row0 = u.pm * BM + wr * 64 + fr, col0 = u.pn * BM + wc * 32 + 4 * fq;
        const float* gb = gate + (size_t)(u.pm >> 3) * (6 * 2048) + col0;
        f32x4 gv[2][2];
#pragma unroll
        for (int bj = 0; bj < 2; ++bj)
#pragma unroll
            for (int n = 0; n < 2; ++n) gv[bj][n] = *(const f32x4*)(gb + bj * HALF + n * 16) + 1.0f;
#pragma unroll
        for (int ai = 0; ai < 2; ++ai)
#pragma unroll
            for (int m = 0; m < 4; ++m) { const size_t off = (size_t)(row0 + ai * HALF + m * 16) * 2048 + col0;
#pragma unroll
                for (int bj = 0; bj < 2; ++bj)
#pragma unroll
                    for (int n = 0; n < 2; ++n) { const f32x4 xv = *(const f32x4*)(X + off + bj * HALF + n * 16);
                        *(f32x4*)(Z + off + bj * HALF + n * 16) = xv * alpha + gv[bj][n] * acc[ai][bj][m][n]; }
                asm volatile("" ::: "memory"); }
    }
};
template <class Epi, class Sched, bool ALIGN_EPI = false, bool SP2 = false>
__device__ __forceinline__ void gemm_phase(PG8_LAS unsigned char* lds, const Gemm g, const Sched& S, const Epi& E, const int tid_in) {
    const int tid = tid_in, wid = __builtin_amdgcn_readfirstlane(tid >> 6), lane = tid & 63, wr = wid >> 2, wc = wid & 3, fr = lane & 15, fq = lane >> 4;
    const int K = g.K, nt = K / BK;
    unsigned voffA[2], voffB[2];
#pragma unroll
    for (int i = 0; i < 2; ++i) { int R, C; stage_rc(tid * 16 + i * 8192, R, C); const int Rb = Epi::PERM ? ((R & ~31) + perm32(R & 31)) : R;
        voffA[i] = (unsigned)(R * K + C) * 2u; voffB[i] = (unsigned)(Rb * K + C) * 2u; }
    const size_t kstep = (size_t)(BK * 2);
    const size_t hstep = (size_t)HALF * K * 2;
    const size_t tstep = 2 * hstep;
    const unsigned ldsw = (unsigned)wid * 1024u;
    const int aoff = lds_byte(wr * 64 + fr, fq * 8), boff = lds_byte(wc * 32 + fr, fq * 8);
#define PG8_SA(b, h) (((b) * 2 + (h)) * HTB)
#define PG8_SB(b, h) ((4 + (b) * 2 + (h)) * HTB)
#define PG8_STAGE(bufoff, gbase, voff) do { _Pragma("unroll") for (int _i = 0; _i < 2; ++_i) \
        __builtin_amdgcn_global_load_lds((const unsigned*)((const char*)(gbase) + (voff)[_i]), (PG8_LAS unsigned*)(lds + (bufoff) + ldsw + _i * 8192), 16, 0, 0); } while (0)
#define PG8_LDA(dst, b, h) do { _Pragma("unroll") for (int m = 0; m < 4; ++m) _Pragma("unroll") for (int k = 0; k < 2; ++k) dst[m][k] = *(const PG8_LAS bf16x8*)(lds + PG8_SA(b, h) + aoff + m * 2048 + k * 1024); } while (0)
#define PG8_LDB(dst, b, h) do { _Pragma("unroll") for (int n = 0; n < 2; ++n) _Pragma("unroll") for (int k = 0; k < 2; ++k) dst[n][k] = *(const PG8_LAS bf16x8*)(lds + PG8_SB(b, h) + boff + n * 2048 + k * 1024); } while (0)
#define PG8_MMA(ai, bj, At, Bt) do { __builtin_amdgcn_s_setprio(1); _Pragma("unroll") for (int m = 0; m < 4; ++m) _Pragma("unroll") for (int n = 0; n < 2; ++n) _Pragma("unroll") for (int k = 0; k < 2; ++k) \
        acc[ai][bj][m][n] = __builtin_amdgcn_mfma_f32_16x16x32_bf16(Bt[n][k], At[m][k], acc[ai][bj][m][n], 0, 0, 0); __builtin_amdgcn_s_setprio(0); } while (0)
#define PG8_WAIT_V(n) asm volatile("s_waitcnt vmcnt(" #n ")" ::: "memory")
#define PG8_WAIT_L(n) asm volatile("s_waitcnt lgkmcnt(" #n ")" ::: "memory")
#define PG8_BAR __builtin_amdgcn_s_barrier()
#define PG8_SCHED __builtin_amdgcn_sched_barrier(0)
    Unit cur, nxt; int ui = 0;
    if (!S.next(0, cur)) return;
    f32x4 acc[2][2][4][2];
#pragma unroll
    for (int a = 0; a < 2; ++a)
#pragma unroll
        for (int b = 0; b < 2; ++b)
#pragma unroll
            for (int m = 0; m < 4; ++m)
#pragma unroll
                for (int n = 0; n < 2; ++n) acc[a][b][m][n] = (f32x4){0.f, 0.f, 0.f, 0.f};
    bf16x8 At[4][2], B0[2][2], B1[2][2];
    const char* cA = (const char*)g.A + (size_t)cur.pm * tstep; const char* cB = (const char*)g.Bt + (size_t)cur.pn * tstep;
    S.a_ready(cur);
    if constexpr (SP2) {
        PG8_STAGE(PG8_SB(0, 0), cB, voffB); PG8_STAGE(PG8_SB(0, 1), cB + hstep, voffB); PG8_STAGE(PG8_SA(0, 0), cA, voffA); PG8_STAGE(PG8_SA(0, 1), cA + hstep, voffA);
        if (wr == 1) PG8_BAR;
        PG8_WAIT_V(2); PG8_BAR;
        PG8_STAGE(PG8_SB(1, 0), cB + kstep, voffB); PG8_STAGE(PG8_SA(1, 0), cA + kstep, voffA); PG8_STAGE(PG8_SB(1, 1), cB + hstep + kstep, voffB);
        PG8_WAIT_V(6); PG8_BAR;
    } else {
        PG8_STAGE(PG8_SB(0, 0), cB, voffB); PG8_STAGE(PG8_SA(0, 0), cA, voffA); PG8_STAGE(PG8_SB(0, 1), cB + hstep, voffB); PG8_STAGE(PG8_SA(0, 1), cA + hstep, voffA);
        if (wr == 1) PG8_BAR;
        PG8_WAIT_V(4); PG8_BAR;
        PG8_STAGE(PG8_SB(1, 0), cB + kstep, voffB); PG8_STAGE(PG8_SA(1, 0), cA + kstep, voffA); PG8_STAGE(PG8_SB(1, 1), cB + hstep + kstep, voffB);
        PG8_WAIT_V(6); PG8_BAR;
    }
    for (;;) {
        const bool has_next = S.next(ui + 1, nxt);
        const char* nA = has_next ? (const char*)g.A + (size_t)nxt.pm * tstep : cA; const char* nB = has_next ? (const char*)g.Bt + (size_t)nxt.pn * tstep : cB;
        for (int t = 0; t < nt; t += 2) {
            const bool last = (t == nt - 2);
            const char* a1 = cA + (size_t)(t + 1) * kstep;
            const char* a2 = last ? nA : cA + (size_t)(t + 2) * kstep; const char* b2 = last ? nB : cB + (size_t)(t + 2) * kstep;
            const char* a3 = a2 + kstep; const char* b3 = b2 + kstep;
            if (last && has_next) S.a_ready(nxt);
            if constexpr (SP2) {
            PG8_LDB(B0, 0, 0); PG8_LDB(B1, 0, 1); PG8_SCHED; PG8_LDA(At, 0, 0); PG8_STAGE(PG8_SA(1, 1), a1 + hstep, voffA);
            PG8_WAIT_V(8); PG8_WAIT_L(0); PG8_BAR; PG8_MMA(0, 0, At, B0); PG8_MMA(0, 1, At, B1); PG8_BAR; PG8_SCHED;
            PG8_LDA(At, 0, 1); PG8_STAGE(PG8_SB(0, 0), b2, voffB); PG8_STAGE(PG8_SB(0, 1), b2 + hstep, voffB); PG8_STAGE(PG8_SA(0, 0), a2, voffA);
            PG8_WAIT_V(8); PG8_WAIT_L(0); PG8_BAR; PG8_MMA(1, 0, At, B0); PG8_MMA(1, 1, At, B1); PG8_BAR; PG8_SCHED;
            PG8_LDB(B0, 1, 0); PG8_LDB(B1, 1, 1); PG8_SCHED; PG8_LDA(At, 1, 0); PG8_STAGE(PG8_SA(0, 1), a2 + hstep, voffA);
            PG8_WAIT_V(8); PG8_WAIT_L(0); PG8_BAR; PG8_MMA(0, 0, At, B0); PG8_MMA(0, 1, At, B1); PG8_BAR; PG8_SCHED;
            PG8_LDA(At, 1, 1); PG8_STAGE(PG8_SB(1, 0), b3, voffB); PG8_STAGE(PG8_SB(1, 1), b3 + hstep, voffB); PG8_STAGE(PG8_SA(1, 0), a3, voffA);
            PG8_WAIT_V(8); PG8_WAIT_L(0); PG8_BAR; PG8_MMA(1, 0, At, B0); PG8_MMA(1, 1, At, B1); PG8_BAR; PG8_SCHED;
            } else {
            PG8_LDB(B0, 0, 0); PG8_SCHED; PG8_LDA(At, 0, 0); PG8_STAGE(PG8_SA(1, 1), a1 + hstep, voffA);
            PG8_WAIT_L(8); PG8_BAR; PG8_WAIT_L(0); PG8_MMA(0, 0, At, B0); PG8_BAR; PG8_SCHED;
            PG8_LDB(B1, 0, 1); PG8_STAGE(PG8_SB(0, 0), b2, voffB);
            PG8_BAR; PG8_WAIT_L(0); PG8_MMA(0, 1, At, B1); PG8_BAR;
            PG8_LDA(At, 0, 1); PG8_STAGE(PG8_SA(0, 0), a2, voffA);
            PG8_BAR; PG8_WAIT_L(0); PG8_MMA(1, 0, At, B0); PG8_BAR; PG8_SCHED;
            PG8_STAGE(PG8_SB(0, 1), b2 + hstep, voffB);
            PG8_WAIT_V(6); PG8_BAR; PG8_MMA(1, 1, At, B1); PG8_BAR;
            PG8_LDB(B0, 1, 0); PG8_SCHED; PG8_LDA(At, 1, 0); PG8_STAGE(PG8_SA(0, 1), a2 + hstep, voffA);
            PG8_WAIT_L(8); PG8_BAR; PG8_WAIT_L(0); PG8_MMA(0, 0, At, B0); PG8_BAR; PG8_SCHED;
            PG8_LDB(B1, 1, 1); PG8_STAGE(PG8_SB(1, 0), b3, voffB);
            PG8_BAR; PG8_WAIT_L(0); PG8_MMA(0, 1, At, B1); PG8_BAR;
            PG8_LDA(At, 1, 1); PG8_STAGE(PG8_SA(1, 0), a3, voffA);
            PG8_BAR; PG8_WAIT_L(0); PG8_MMA(1, 0, At, B0); PG8_BAR; PG8_SCHED;
            PG8_STAGE(PG8_SB(1, 1), b3 + hstep, voffB);
            PG8_WAIT_V(6); PG8_BAR; PG8_MMA(1, 1, At, B1); PG8_BAR;
            }
        }
        if constexpr (ALIGN_EPI) { if (wr == 0) PG8_BAR; }
        if constexpr (!Epi::AFTER_DRAIN) { E(acc, cur, wr, wc, fr, fq); S.done(cur); }
        if (!has_next) break;
#pragma unroll
        for (int a = 0; a < 2; ++a)
#pragma unroll
            for (int b = 0; b < 2; ++b)
#pragma unroll
                for (int m = 0; m < 4; ++m)
#pragma unroll
                    for (int n = 0; n < 2; ++n) acc[a][b][m][n] = (f32x4){0.f, 0.f, 0.f, 0.f};
        cur = nxt; cA = nA; cB = nB; ++ui;
        if constexpr (ALIGN_EPI) { if (wr == 1) PG8_BAR; }
    }
    PG8_WAIT_V(0);
    if constexpr (!ALIGN_EPI) { if (wr == 0) PG8_BAR; }
    PG8_BAR;
    if constexpr (Epi::AFTER_DRAIN) { E.fused(acc, cur, wr, wc, fr, fq, lds, wid, lane); S.done(cur); }
#undef PG8_SA
#undef PG8_SB
#undef PG8_STAGE
#undef PG8_LDA
#undef PG8_LDB
#undef PG8_MMA
#undef PG8_WAIT_V
#undef PG8_WAIT_L
#undef PG8_BAR
#undef PG8_SCHED
}
}
#define XB_TMO      128
#define XB_XCNT(j)  (256  + 64 * (j))
#define XB_XSUB(j)  (1280 + 64 * (j))
#define XB_XGEN(j)  (2304 + 64 * (j))
#define XB_TOP      3328
#define XB_TOPGEN   3392
#define XCD_BAR_WORDS 3456
#define XB_SPIN_CAP (1u << 18)
#define LAS __attribute__((address_space(3)))

__device__ __forceinline__ unsigned xb_ld(unsigned* p)              { return __hip_atomic_load(p, __ATOMIC_RELAXED, __HIP_MEMORY_SCOPE_AGENT); }
__device__ __forceinline__ unsigned xb_add(unsigned* p, unsigned v) { return __hip_atomic_fetch_add(p, v, __ATOMIC_RELAXED, __HIP_MEMORY_SCOPE_AGENT); }
__device__ __forceinline__ unsigned xb_xcc_id() { return (unsigned)__builtin_amdgcn_s_getreg((3 << 11) | 20) & 0xFu; }
#define XB_SPIN(cond, bar) do { unsigned _sp = 0; while (cond) { __builtin_amdgcn_s_sleep(1); \
    if ((++_sp & 255u) == 0u) { if (xb_ld(&(bar)[XB_TMO])) break; if (_sp > XB_SPIN_CAP) { atomicAdd(&(bar)[XB_TMO], 1u); break; } } } } while (0)

struct XcdBarrier {
    unsigned* bar; unsigned x;
    volatile LAS unsigned* st;
};

__device__ __forceinline__ XcdBarrier xcd_barrier_post(unsigned* bar, volatile LAS unsigned* st) {
    XcdBarrier b; b.bar = bar; b.x = xb_xcc_id(); b.st = st;
    if (threadIdx.x == 0) (void)xb_add(&bar[XB_XCNT(b.x)], 1u);
    return b;
}
__device__ __forceinline__ void xcd_barrier_complete(unsigned* bar, unsigned x, unsigned& nloc, unsigned& nx) {
    const unsigned G = gridDim.x * gridDim.y * gridDim.z;
    unsigned sum, cnt, mine, sp = 0u;
    for (;;) {
        sum = 0u; cnt = 0u; mine = 0u;
#pragma unroll
        for (unsigned j = 0; j < 16; ++j) { const unsigned c = xb_ld(&bar[XB_XCNT(j)]); sum += c; cnt += (c > 0u) ? 1u : 0u; mine = (j == x) ? c : mine; }
        if (sum == G) break;
        __builtin_amdgcn_s_sleep(1);
        if ((++sp & 255u) == 0u) { if (xb_ld(&bar[XB_TMO])) break; if (sp > XB_SPIN_CAP) { atomicAdd(&bar[XB_TMO], 1u); break; } }
    }
    nloc = mine > 0u ? mine : 1u; nx = cnt > 0u ? cnt : 1u;
}

__device__ __forceinline__ void xcd_barrier(const XcdBarrier& b) {
    asm volatile("s_waitcnt vmcnt(0)" ::: "memory");
    __syncthreads();
    if (threadIdx.x == 0) {
        unsigned* bar = b.bar;
        __builtin_amdgcn_s_waitcnt(0);
        unsigned nloc = b.st[0], nx = b.st[1];
        if (nloc == 0u) { xcd_barrier_complete(bar, b.x, nloc, nx); b.st[0] = nloc; b.st[1] = nx; }
        const unsigned old = xb_add(&bar[XB_XSUB(b.x)], 1u);
        const unsigned gen = old / nloc;
        if (old + 1u == (gen + 1u) * nloc) {
            __builtin_amdgcn_fence(__ATOMIC_RELEASE, "agent");
            asm volatile("s_waitcnt vmcnt(0)" ::: "memory");
            const unsigned og = xb_add(&bar[XB_TOP], 1u);
            const unsigned tg = og / nx;
            if (og + 1u == (tg + 1u) * nx) xb_add(&bar[XB_TOPGEN], 1u);
            else XB_SPIN(xb_ld(&bar[XB_TOPGEN]) == tg, bar);
            __builtin_amdgcn_fence(__ATOMIC_ACQUIRE, "agent");
            xb_add(&bar[XB_XGEN(b.x)], 1u);
            asm volatile("s_waitcnt vmcnt(0)" ::: "memory");
        } else {
            XB_SPIN(xb_ld(&bar[XB_XGEN(b.x)]) == gen, bar);
            __builtin_amdgcn_fence(__ATOMIC_ACQUIRE, "agent");
            asm volatile("s_waitcnt vmcnt(0)" ::: "memory");
        }
    }
    __syncthreads();
}
constexpr int D = 2048, NB = 8, SEQ = 2048, NL = 4, T = NB * SEQ;
constexpr int NCH = SEQ / 64, NCHUNK = T / 64;
constexpr int GKW = 512, RANK = 16;
constexpr int INW = 6160, NP = 6144;
constexpr int NE = 16384;
constexpr float ALPHA = 1.6817928305074290f, EPS = 1e-5f;
constexpr int PQ = 0, PK = 512, PV = 1024, PR = 2048, PCB = 3072, PCC = 4096, PCH = 5120;
constexpr int NWAVES = 8, NTHREADS = 512;
#ifndef TAB4
#define TAB4 1
#endif
constexpr int NPHASES = 2 + 7 * NL;

constexpr size_t MiB = 1u << 20;
constexpr size_t WS_CTL = 0, CTL_ZERO_BYTES = 1 * MiB;
constexpr size_t WS_MOD = 1 * MiB, WS_PART = 3 * MiB, WS_KEYS = 15 * MiB, WS_DTOT = 17 * MiB, WS_WIN = 18 * MiB, WS_WOUT = 115 * MiB, WS_WQ = 147 * MiB;
constexpr size_t WS_UT = 179 * MiB, WS_VT = 435 * MiB, WS_H = 691 * MiB, WS_PROJ = 755 * MiB, WS_E = 947 * MiB, WS_OGLA = 979 * MiB, WS_Y = 1043 * MiB;
constexpr size_t WS_Z = 1107 * MiB, WS_X1 = 1235 * MiB, WS_X = 1363 * MiB, WS_Q = 1491 * MiB, WS_H2 = 1555 * MiB, WS_HQ8 = 1619 * MiB, WS_END = 1659 * MiB;
constexpr size_t WS_SU = 17 * MiB + 512 * 1024, WS_SV = 17 * MiB + 768 * 1024, WS_HSC = 2 * MiB + 640 * 1024;
static_assert(WS_WIN + (size_t)NL * INW * D * 2 <= WS_WOUT && WS_PART + (size_t)NL * 8 * NB * 6 * D * 4 <= WS_KEYS && WS_MOD + (size_t)NL * NB * 6 * D * 4 <= WS_PART, "ws map");
constexpr int CW_BAR = 4096;

constexpr int RING_OFF = 0, RING_BYTES = 131072, LDSCTL_OFF = RING_BYTES, LDS_BYTES = 147456;

#define GAS __attribute__((address_space(1)))
typedef unsigned short bf16;
typedef unsigned v4u __attribute__((ext_vector_type(4)));
typedef unsigned v2u __attribute__((ext_vector_type(2)));
typedef float f32x4 __attribute__((ext_vector_type(4)));
typedef float f32x16 __attribute__((ext_vector_type(16)));
typedef short bf16x8 __attribute__((ext_vector_type(8)));
typedef __bf16 bf16x2v __attribute__((ext_vector_type(2)));
#define LDS_WAIT() asm volatile("s_waitcnt lgkmcnt(0)" ::: "memory")

__device__ __forceinline__ unsigned pk2(float lo, float hi) { return pg8::cvt_pk_bf16(lo, hi); }
__device__ __forceinline__ float dot2bf(unsigned w, unsigned x, float acc) { return __builtin_amdgcn_fdot2_f32_bf16(__builtin_bit_cast(bf16x2v, w), __builtin_bit_cast(bf16x2v, x), acc, false); }
__device__ __forceinline__ float bflo(unsigned u) { return __uint_as_float(u << 16); }
__device__ __forceinline__ float bfhi(unsigned u) { return __uint_as_float(u & 0xffff0000u); }
__device__ __forceinline__ float silu_f(float x) { return x / (1.0f + __expf(-x)); }
__device__ __forceinline__ float logsigmoid_f(float x) { return fminf(x, 0.0f) - log1pf(__expf(-fabsf(x))); }
__device__ __forceinline__ float gelu_tanh_f(float x) { const float u = 0.7978845608028654f * (x + 0.044715f * x * x * x); return 0.5f * x * (1.0f + tanhf(u)); }
__device__ __forceinline__ float wave_sum(float v) {
#pragma unroll
    for (int o = 1; o < 64; o <<= 1) v += __shfl_xor(v, o);
    return v;
}

struct Args { const float* in[19]; float* out; unsigned char* ws; int ph_lo, ph_hi; };

__device__ __forceinline__ void transpose_item(const float* W, int ldw, int col0, bf16* WTrows, int k0, int nvalid, LAS float* scr, int lane) {
    const int n = lane & 31;
    float tv[32];
#pragma unroll
    for (int i = 0; i < 32; ++i) { const int kk = 2 * i + (lane >> 5); tv[i] = (n < nvalid) ? W[(size_t)(k0 + kk) * ldw + col0 + n] : 0.f; }
#pragma unroll
    for (int i = 0; i < 32; ++i) { const int kk = 2 * i + (lane >> 5); scr[kk * 33 + n] = tv[i]; }
    LDS_WAIT(); asm volatile("" ::: "memory");
    const int c = lane & 7;
#pragma unroll
    for (int j = 0; j < 4; ++j) { const int nn = (lane >> 3) + 8 * j; const LAS float* s = scr + (8 * c) * 33 + nn;
        v4u o; o.x = pk2(s[0 * 33], s[1 * 33]); o.y = pk2(s[2 * 33], s[3 * 33]); o.z = pk2(s[4 * 33], s[5 * 33]); o.w = pk2(s[6 * 33], s[7 * 33]);
        if (nn < nvalid) *(v4u*)(WTrows + (size_t)nn * D + k0 + 8 * c) = o; }
    LDS_WAIT(); asm volatile("" ::: "memory");
}
__device__ __forceinline__ void cvt_stream(const float* src, bf16* dst, size_t n4, size_t i0, size_t stride) {
    for (size_t i = i0; i < n4; i += stride) { const f32x4 v = ((const f32x4*)src)[i]; v2u o; o.x = pk2(v.x, v.y); o.y = pk2(v.z, v.w); ((v2u*)dst)[i] = o; }
}
__device__ __forceinline__ void ph_prologue_a(const Args& a, LAS unsigned char* lds, int tid, int lane, int wave, int bx, int G) {
    const int gw = bx * NWAVES + wave, NGW = G * NWAVES;
    LAS float* cact = (LAS float*)lds;
    for (int i = tid; i < NB * D; i += NTHREADS) { const int b = i / D, d = i % D; cact[d * 8 + b] = silu_f(a.in[1][i]); }
    __syncthreads();
    float* part = (float*)(a.ws + WS_PART);
    for (int it = gw; it < NL * 8 * 48; it += NGW) {
        const int cg = it % 48, dr = (it / 48) % 8, l = it / 384;
        f32x4 acc[8];
#pragma unroll
        for (int b = 0; b < 8; ++b) acc[b] = (f32x4){0.f, 0.f, 0.f, 0.f};
        const float* w = a.in[2] + ((size_t)l * D + dr * 256) * (6 * D) + cg * 256 + lane * 4;
#pragma unroll 4
        for (int d = 0; d < 256; ++d) {
            const f32x4 wv = *(const f32x4*)(w + (size_t)d * (6 * D));
            const f32x4 c0 = *(const LAS f32x4*)(cact + (dr * 256 + d) * 8), c1 = *(const LAS f32x4*)(cact + (dr * 256 + d) * 8 + 4);
            acc[0] += wv * c0.x; acc[1] += wv * c0.y; acc[2] += wv * c0.z; acc[3] += wv * c0.w;
            acc[4] += wv * c1.x; acc[5] += wv * c1.y; acc[6] += wv * c1.z; acc[7] += wv * c1.w;
        }
#pragma unroll
        for (int b = 0; b < 8; ++b) *(f32x4*)(part + (((size_t)l * 8 + dr) * NB + b) * (6 * D) + cg * 256 + lane * 4) = acc[b];
    }
    __syncthreads();
    LAS float* scr = (LAS float*)(lds + wave * 8448);
    bf16* winT = (bf16*)(a.ws + WS_WIN); bf16* woutT = (bf16*)(a.ws + WS_WOUT); bf16* wqT = (bf16*)(a.ws + WS_WQ);
    constexpr int IPL = 6144 + 32 + 2048 + 2048;
    for (int it = gw; it < NL * IPL; it += NGW) {
        const int l = it / IPL; int r = it % IPL;
        if (r < 6144) { const int nb = r % 192, kb = r / 192, n0 = nb * 32;
            transpose_item(a.in[4] + (size_t)l * D * INW, INW, n0 < 3072 ? n0 : n0 + 16, winT + ((size_t)l * INW + n0) * D, kb * 64, 32, scr, lane); continue; }
        r -= 6144;
        if (r < 32) { transpose_item(a.in[4] + (size_t)l * D * INW, INW, 3072, winT + ((size_t)l * INW + NP) * D, r * 64, 16, scr, lane); continue; }
        r -= 32;
        if (r < 2048) { const int nb = r % 64, kb = r / 64; transpose_item(a.in[10] + (size_t)l * D * D, D, nb * 32, woutT + ((size_t)l * D + nb * 32) * D, kb * 64, 32, scr, lane); continue; }
        r -= 2048;
        { const int nb = r % 64, kb = r / 64; transpose_item(a.in[13] + (size_t)l * D * D, D, nb * 32, wqT + ((size_t)l * D + nb * 32) * D, kb * 64, 32, scr, lane); }
    }
    const size_t i0 = (size_t)bx * NTHREADS + tid, stride = (size_t)G * NTHREADS;
    cvt_stream(a.in[14], (bf16*)(a.ws + WS_KEYS), (size_t)NL * 8 * 2 * 128 * 128 / 4, i0, stride);
#if TAB4
    __syncthreads();
    { LAS float* rowst = (LAS float*)(lds + wave * 8192);
      for (int row = gw; row < 2 * NL * NE; row += NGW) {
        const int tbl = row / (NL * NE), r = row % (NL * NE);
        const float* src = (tbl ? a.in[16] : a.in[15]) + (size_t)r * D;
#pragma unroll
        for (int c8 = 0; c8 < 8; ++c8) *(LAS f32x4*)(rowst + (c8 * 64 + lane) * 4) = *(const f32x4*)(src + (c8 * 64 + lane) * 4);
        LDS_WAIT(); asm volatile("" ::: "memory");
        unsigned char* tb = a.ws + (tbl ? WS_VT : WS_UT) + (size_t)r * 1152;
#pragma unroll
        for (int pass = 0; pass < 2; ++pass) { const int slot = lane + 64 * pass;
            if (slot < 72) { const int col0 = (slot >> 3) * 240 + (slot & 7) * 30;
                float x[30]; float mx = 0.f;
#pragma unroll
                for (int k = 0; k < 30; ++k) { x[k] = (col0 + k < D) ? rowst[col0 + k] : 0.f; mx = fmaxf(mx, fabsf(x[k])); }
                int code = 0; float inv = 0.f;
                if (mx > 0.f) { code = (int)ceilf(8.0f * log2f(mx * (1.0f / 7.0f))) + 128; code = code < 0 ? 0 : (code > 255 ? 255 : code); inv = __builtin_amdgcn_exp2f(16.0f - (float)code * 0.125f); }
                unsigned dw[4] = {0u, 0u, 0u, 0u};
#pragma unroll
                for (int kb = 0; kb < 15; ++kb) { int a0 = (int)__builtin_rintf(x[2 * kb] * inv), a1 = (int)__builtin_rintf(x[2 * kb + 1] * inv);
                    a0 = a0 < -7 ? -7 : (a0 > 7 ? 7 : a0); a1 = a1 < -7 ? -7 : (a1 > 7 ? 7 : a1);
                    dw[kb >> 2] |= ((unsigned)(a0 + 8) | ((unsigned)(a1 + 8) << 4)) << (8 * (kb & 3)); }
                dw[3] |= (unsigned)code << 24;
                *(v4u*)(tb + slot * 16) = (v4u){dw[0], dw[1], dw[2], dw[3]}; } }
        LDS_WAIT(); asm volatile("" ::: "memory");
      } }
#else
    for (int row = gw; row < 2 * NL * NE; row += NGW) {
        const int tbl = row / (NL * NE), r = row % (NL * NE);
        const float* src = (tbl ? a.in[16] : a.in[15]) + (size_t)r * D;
        f32x4 v[8]; float mx = 0.f;
#pragma unroll
        for (int c8 = 0; c8 < 8; ++c8) { v[c8] = *(const f32x4*)(src + (c8 * 64 + lane) * 4); mx = fmaxf(mx, fmaxf(fmaxf(fabsf(v[c8].x), fabsf(v[c8].y)), fmaxf(fabsf(v[c8].z), fabsf(v[c8].w)))); }
#pragma unroll
        for (int o = 1; o < 64; o <<= 1) mx = fmaxf(mx, __shfl_xor(mx, o));
        const float inv = mx > 0.f ? 127.0f / mx : 0.f; const int off = tbl ? 128 : 0;
        unsigned dw[8];
#pragma unroll
        for (int c8 = 0; c8 < 8; ++c8) { const int q0 = (int)__builtin_rintf(v[c8].x * inv) + off, q1 = (int)__builtin_rintf(v[c8].y * inv) + off, q2 = (int)__builtin_rintf(v[c8].z * inv) + off, q3 = (int)__builtin_rintf(v[c8].w * inv) + off;
            dw[c8] = (unsigned)(q0 & 255) | ((unsigned)(q1 & 255) << 8) | ((unsigned)(q2 & 255) << 16) | ((unsigned)(q3 & 255) << 24); }
        unsigned char* dst = a.ws + (tbl ? WS_VT : WS_UT) + (size_t)r * D;
        *(v4u*)(dst + lane * 16) = (v4u){dw[0], dw[1], dw[2], dw[3]}; *(v4u*)(dst + (64 + lane) * 16) = (v4u){dw[4], dw[5], dw[6], dw[7]};
        if (lane == 0) ((float*)(a.ws + (tbl ? WS_SV : WS_SU)))[r] = mx * (1.0f / 127.0f);
    }
#endif
}

__device__ __forceinline__ void ln_tail(const float (&z)[32], int t, int lane, const float* g, const float* bta, float* xout, const float* sh, const float* sc, bf16* hout, unsigned char* q8, float* q8s, LAS unsigned char* q8stage = nullptr) {
    float s = 0.f;
#pragma unroll
    for (int i = 0; i < 32; ++i) s += z[i];
    const float mu = wave_sum(s) * (1.0f / D);
    float q = 0.f;
#pragma unroll
    for (int i = 0; i < 32; ++i) { const float d = z[i] - mu; q += d * d; }
    const float rs = rsqrtf(wave_sum(q) * (1.0f / D) + EPS);
    float hv[32]; float mx = 0.f;
#pragma unroll
    for (int c = 0; c < 8; ++c) { const int col = (c * 64 + lane) * 4;
        const f32x4 g0 = *(const f32x4*)(g + col), b0 = *(const f32x4*)(bta + col);
        f32x4 x0;
        x0.x = (z[c * 4 + 0] - mu) * rs * g0.x + b0.x; x0.y = (z[c * 4 + 1] - mu) * rs * g0.y + b0.y; x0.z = (z[c * 4 + 2] - mu) * rs * g0.z + b0.z; x0.w = (z[c * 4 + 3] - mu) * rs * g0.w + b0.w;
        if (xout) *(f32x4*)(xout + (size_t)t * D + col) = x0;
        if (hout) { const f32x4 s0 = *(const f32x4*)(sc + col), h0 = *(const f32x4*)(sh + col);
            hv[c * 4] = x0.x * (1.f + s0.x) + h0.x; hv[c * 4 + 1] = x0.y * (1.f + s0.y) + h0.y; hv[c * 4 + 2] = x0.z * (1.f + s0.z) + h0.z; hv[c * 4 + 3] = x0.w * (1.f + s0.w) + h0.w;
            v2u o; o.x = pk2(hv[c * 4], hv[c * 4 + 1]); o.y = pk2(hv[c * 4 + 2], hv[c * 4 + 3]);
            *(v2u*)(hout + (size_t)t * D + col) = o;
            if (q8) {
                hv[c * 4] = bflo(o.x); hv[c * 4 + 1] = bfhi(o.x); hv[c * 4 + 2] = bflo(o.y); hv[c * 4 + 3] = bfhi(o.y);
                mx = fmaxf(mx, fmaxf(fmaxf(fabsf(hv[c * 4]), fabsf(hv[c * 4 + 1])), fmaxf(fabsf(hv[c * 4 + 2]), fabsf(hv[c * 4 + 3])))); } }
    }
    if (q8) {
#pragma unroll
        for (int o = 1; o < 64; o <<= 1) mx = fmaxf(mx, __shfl_xor(mx, o));
        const float inv = mx > 0.f ? 127.0f / mx : 0.f;
        unsigned dw[8];
#pragma unroll
        for (int c = 0; c < 8; ++c) { const int q0 = (int)__builtin_rintf(hv[c * 4] * inv), q1 = (int)__builtin_rintf(hv[c * 4 + 1] * inv), q2 = (int)__builtin_rintf(hv[c * 4 + 2] * inv), q3 = (int)__builtin_rintf(hv[c * 4 + 3] * inv);
            dw[c] = (unsigned)(q0 & 255) | ((unsigned)(q1 & 255) << 8) | ((unsigned)(q2 & 255) << 16) | ((unsigned)(q3 & 255) << 24); }
#if TAB4
        { LAS unsigned* st32 = (LAS unsigned*)q8stage; LAS unsigned char* st8 = (LAS unsigned char*)q8stage;
#pragma unroll
          for (int i = 0; i < 9; ++i) st32[lane + 64 * i] = 0u;
          LDS_WAIT(); asm volatile("" ::: "memory");
#pragma unroll
          for (int c = 0; c < 8; ++c)
#pragma unroll
              for (int j = 0; j < 4; ++j) { const int col = (c * 64 + lane) * 4 + j, u = col / 240, r = col - u * 240, l7 = r / 30, k = r - l7 * 30;
                  st8[(u * 8 + l7) * 32 + (k >> 3) * 8 + (k & 1) * 4 + ((k & 7) >> 1)] = (unsigned char)((dw[c] >> (8 * j)) & 255u); }
          LDS_WAIT(); asm volatile("" ::: "memory");
          unsigned* d32 = (unsigned*)(q8 + (size_t)t * 2304);
#pragma unroll
          for (int i = 0; i < 9; ++i) d32[lane + 64 * i] = st32[lane + 64 * i];
          LDS_WAIT(); asm volatile("" ::: "memory"); }
#else
        unsigned char* dst = q8 + (size_t)t * D;
        *(v4u*)(dst + lane * 16) = (v4u){dw[0], dw[1], dw[2], dw[3]}; *(v4u*)(dst + (64 + lane) * 16) = (v4u){dw[4], dw[5], dw[6], dw[7]};
#endif
        if (lane == 0) q8s[t] = mx * (1.0f / 127.0f);
    }
}

__device__ __forceinline__ void ph_prologue_b(const Args& a, LAS unsigned char* lds, int tid, int lane, int wave, int bx, int G) {
    const float* part = (const float*)(a.ws + WS_PART); float* mod = (float*)(a.ws + WS_MOD);
    for (int i = bx * NTHREADS + tid; i < NL * NB * 6 * D / 4; i += G * NTHREADS) {
        const int idx = i * 4, e = idx % (6 * D), b = (idx / (6 * D)) % NB, l = idx / (6 * D * NB);
        f32x4 s = *(const f32x4*)(a.in[3] + l * 6 * D + e);
#pragma unroll
        for (int dr = 0; dr < 8; ++dr) s += *(const f32x4*)(part + (((size_t)l * 8 + dr) * NB + b) * (6 * D) + e);
        *(f32x4*)(mod + idx) = s;
    }
    LAS float* msh = (LAS float*)lds;
    bf16* hbuf = (bf16*)(a.ws + WS_H);
    for (int ch = bx; ch < NCHUNK; ch += G) {
        const int b = ch / NCH;
        for (int i = tid; i < 1024; i += NTHREADS) { const int e = i * 4;
            f32x4 s = *(const f32x4*)(a.in[3] + e);
#pragma unroll
            for (int dr = 0; dr < 8; ++dr) s += *(const f32x4*)(part + (((size_t)0 * 8 + dr) * NB + b) * (6 * D) + e);
            *(LAS f32x4*)(msh + e) = s; }
        __syncthreads();
        for (int i = 0; i < 8; ++i) { const int t = ch * 64 + wave * 8 + i;
#pragma unroll
            for (int c = 0; c < 4; ++c) { const int col = (c * 64 + lane) * 8;
                const f32x4 x0 = *(const f32x4*)(a.in[0] + (size_t)t * D + col), x1 = *(const f32x4*)(a.in[0] + (size_t)t * D + col + 4);
                const f32x4 h0 = *(const LAS f32x4*)(msh + col), h1 = *(const LAS f32x4*)(msh + col + 4), s0 = *(const LAS f32x4*)(msh + 2048 + col), s1 = *(const LAS f32x4*)(msh + 2048 + col + 4);
                v4u o; o.x = pk2(x0.x * (1.f + s0.x) + h0.x, x0.y * (1.f + s0.y) + h0.y); o.y = pk2(x0.z * (1.f + s0.z) + h0.z, x0.w * (1.f + s0.w) + h0.w);
                o.z = pk2(x1.x * (1.f + s1.x) + h1.x, x1.y * (1.f + s1.y) + h1.y); o.w = pk2(x1.z * (1.f + s1.z) + h1.z, x1.w * (1.f + s1.w) + h1.w);
                *(v4u*)(hbuf + (size_t)t * D + col) = o; } }
        __syncthreads();
    }
}

__device__ __forceinline__ void gate_prep(const Args& a, int l, LAS unsigned char* lds, int tid, int lane, int wave, int ch) {
    const bf16* hbuf = (const bf16*)(a.ws + WS_H); const bf16* waT = (const bf16*)(a.ws + WS_WIN) + ((size_t)l * INW + NP) * D;
    float* Ebuf = (float*)(a.ws + WS_E); float* dtot = (float*)(a.ws + WS_DTOT);
    const int t0 = ch * 64, l15 = lane & 15, lq = lane >> 4, mt = wave & 3, kh = wave >> 2;
    f32x4 acc = (f32x4){0.f, 0.f, 0.f, 0.f};
    const bf16* hA = hbuf + (size_t)(t0 + 16 * mt + l15) * D + kh * 1024 + 8 * lq;
    const bf16* wB = waT + (size_t)l15 * D + kh * 1024 + 8 * lq;
#pragma unroll 8
    for (int ks = 0; ks < 32; ++ks) { const bf16x8 av = *(const bf16x8*)(hA + 32 * ks), bv = *(const bf16x8*)(wB + 32 * ks); acc = __builtin_amdgcn_mfma_f32_16x16x32_bf16(av, bv, acc, 0, 0, 0); }
    LAS float* alr = (LAS float*)lds;
#pragma unroll
    for (int r = 0; r < 4; ++r) alr[(kh * 64 + 16 * mt + 4 * lq + r) * 16 + l15] = acc[r];
    __syncthreads();
    const int col = tid;
    float wg[16];
#pragma unroll
    for (int r = 0; r < 16; ++r) wg[r] = a.in[5][((size_t)l * RANK + r) * GKW + col];
    const float bgc = a.in[6][l * GKW + col];
    float tot = 0.f;
    for (int j = 0; j < 64; ++j) { float lg = bgc;
#pragma unroll
        for (int r4 = 0; r4 < 4; ++r4) { const f32x4 p = *(const LAS f32x4*)(alr + j * 16 + r4 * 4), q = *(const LAS f32x4*)(alr + (64 + j) * 16 + r4 * 4);
            lg += (p.x + q.x) * wg[r4 * 4] + (p.y + q.y) * wg[r4 * 4 + 1] + (p.z + q.z) * wg[r4 * 4 + 2] + (p.w + q.w) * wg[r4 * 4 + 3]; }
        tot += logsigmoid_f(lg) * (1.0f / 16.0f); }
    float run = 0.f;
    for (int j = 0; j < 64; ++j) { float lg = bgc;
#pragma unroll
        for (int r4 = 0; r4 < 4; ++r4) { const f32x4 p = *(const LAS f32x4*)(alr + j * 16 + r4 * 4), q = *(const LAS f32x4*)(alr + (64 + j) * 16 + r4 * 4);
            lg += (p.x + q.x) * wg[r4 * 4] + (p.y + q.y) * wg[r4 * 4 + 1] + (p.z + q.z) * wg[r4 * 4 + 2] + (p.w + q.w) * wg[r4 * 4 + 3]; }
        run += logsigmoid_f(lg) * (1.0f / 16.0f);
        Ebuf[(size_t)(t0 + j) * GKW + col] = __expf(tot - run); }
    dtot[(size_t)ch * GKW + col] = __expf(tot);
    __syncthreads();
}

__device__ __forceinline__ void gla_unit(const Args& a, LAS unsigned char* lds, int tid, int lane, int wave, int un) {
    const bf16* proj = (const bf16*)(a.ws + WS_PROJ); const float* Ebuf = (const float*)(a.ws + WS_E); const float* dtot = (const float*)(a.ws + WS_DTOT); bf16* ogla = (bf16*)(a.ws + WS_OGLA);
    const int pair_ = (un & 7) * 4 + (un >> 6), dvs = (un >> 3) & 7, hh = pair_ & 3, b = pair_ >> 2;
    LAS bf16* kdT = (LAS bf16*)lds;
    LAS bf16* vT = (LAS bf16*)(lds + 18432);
    LAS bf16* ST = (LAS bf16*)(lds + 18432 + 4608);
    const int l15 = lane & 15, lq = lane >> 4, jl = tid >> 3, d16 = (tid & 7) * 16, dv4 = (tid & 7) * 4, jt = (wave & 3) * 16, dvt = (wave >> 2) * 16;
#define GLA_BAR() do { asm volatile("s_waitcnt lgkmcnt(0)" ::: "memory"); __builtin_amdgcn_s_barrier(); asm volatile("" ::: "memory"); } while (0)
    f32x4 S0 = (f32x4){0.f, 0.f, 0.f, 0.f}, S1 = (f32x4){0.f, 0.f, 0.f, 0.f};
    v4u kn0[2], kn1[2]; f32x4 en0[4], en1[4]; v2u vn0, vn1; bf16x8 qn0[4], qn1[4], qc[4]; f32x4 dn0, dn1, dc;
#define GLA_LOAD(c, kn, en, vn, qn, dn) do { const int t0c = b * SEQ + (c) * 64; const bf16* pr = proj + (size_t)(t0c + jl) * NP; \
        kn[0] = *(const v4u*)(pr + PK + hh * 128 + d16); kn[1] = *(const v4u*)(pr + PK + hh * 128 + d16 + 8); \
        _Pragma("unroll") for (int i_ = 0; i_ < 4; ++i_) en[i_] = *(const f32x4*)(Ebuf + (size_t)(t0c + jl) * GKW + hh * 128 + d16 + 4 * i_); \
        vn = *(const v2u*)(pr + PV + hh * 256 + dvs * 32 + dv4); \
        _Pragma("unroll") for (int ks_ = 0; ks_ < 4; ++ks_) qn[ks_] = *(const bf16x8*)(proj + (size_t)(t0c + jt + l15) * NP + PQ + hh * 128 + 32 * ks_ + 8 * lq); \
        dn = *(const f32x4*)(dtot + (size_t)(b * NCH + (c)) * GKW + hh * 128 + 16 * wave + 4 * lq); } while (0)
#define GLA_PREP(kn, en, vn, qn, dn) do { \
        _Pragma("unroll") for (int i_ = 0; i_ < 16; ++i_) { const unsigned w_ = kn[i_ >> 3][(i_ & 7) >> 1]; const float kf_ = (i_ & 1) ? bfhi(w_) : bflo(w_); \
            kdT[(d16 + i_) * 72 + ((((jl >> 3) ^ (d16 >> 4)) & 7) << 3) + (jl & 7)] = (bf16)(pk2(kf_ * en[i_ >> 2][i_ & 3], 0.f) & 0xffffu); } \
        _Pragma("unroll") for (int i_ = 0; i_ < 4; ++i_) { const unsigned w_ = vn[i_ >> 1]; vT[(dv4 + i_) * 72 + jl] = (bf16)((i_ & 1) ? (w_ >> 16) : (w_ & 0xffffu)); } \
        _Pragma("unroll") for (int ks_ = 0; ks_ < 4; ++ks_) qc[ks_] = qn[ks_]; \
        dc = dn; } while (0)
#define GLA_BODY(c) do { \
        S0 = S0 * dc; S1 = S1 * dc; \
        _Pragma("unroll") for (int ks = 0; ks < 2; ++ks) { \
            const bf16x8 A_ = *(const LAS bf16x8*)(kdT + (16 * wave + l15) * 72 + ((((4 * ks + lq) ^ wave) & 7) << 3)); \
            const bf16x8 B0_ = *(const LAS bf16x8*)(vT + l15 * 72 + 32 * ks + 8 * lq), B1_ = *(const LAS bf16x8*)(vT + (16 + l15) * 72 + 32 * ks + 8 * lq); \
            S0 = __builtin_amdgcn_mfma_f32_16x16x32_bf16(A_, B0_, S0, 0, 0, 0); S1 = __builtin_amdgcn_mfma_f32_16x16x32_bf16(A_, B1_, S1, 0, 0, 0); } \
        { v2u w0_, w1_; w0_.x = pk2(S0.x, S0.y); w0_.y = pk2(S0.z, S0.w); w1_.x = pk2(S1.x, S1.y); w1_.y = pk2(S1.z, S1.w); \
          *(LAS v2u*)(ST + l15 * 136 + 16 * wave + 4 * lq) = w0_; *(LAS v2u*)(ST + (16 + l15) * 136 + 16 * wave + 4 * lq) = w1_; } \
        GLA_BAR(); \
        f32x4 O_ = (f32x4){0.f, 0.f, 0.f, 0.f}; \
        _Pragma("unroll") for (int ks = 0; ks < 4; ++ks) { const bf16x8 A_ = *(const LAS bf16x8*)(ST + (dvt + l15) * 136 + 32 * ks + 8 * lq); O_ = __builtin_amdgcn_mfma_f32_16x16x32_bf16(A_, qc[ks], O_, 0, 0, 0); } \
        { const f32x4 Os_ = O_ * 0.08838834764831845f; v2u ob_; ob_.x = pk2(Os_.x, Os_.y); ob_.y = pk2(Os_.z, Os_.w); \
          *(v2u*)(ogla + (size_t)(b * SEQ + (c) * 64 + jt + l15) * 1024 + hh * 256 + dvs * 32 + dvt + 4 * lq) = ob_; } } while (0)
    GLA_LOAD(0, kn0, en0, vn0, qn0, dn0); GLA_LOAD(1, kn1, en1, vn1, qn1, dn1);
    GLA_PREP(kn0, en0, vn0, qn0, dn0);
    GLA_BAR();
    for (int c = 0; c < NCH; c += 2) {
        { const int cn_ = c + 2 < NCH ? c + 2 : NCH - 1; GLA_LOAD(cn_, kn0, en0, vn0, qn0, dn0); }
        GLA_BODY(c);
        GLA_PREP(kn1, en1, vn1, qn1, dn1);
        GLA_BAR();
        { const int cn_ = c + 3 < NCH ? c + 3 : NCH - 1; GLA_LOAD(cn_, kn1, en1, vn1, qn1, dn1); }
        GLA_BODY(c + 1);
        GLA_PREP(kn0, en0, vn0, qn0, dn0);
        GLA_BAR();
    }
#undef GLA_BODY
#undef GLA_BAR
#undef GLA_LOAD
#undef GLA_PREP
}

__device__ __forceinline__ void unpack16(const v4u& p0, const v4u& p1, float (&o)[16]) {
#pragma unroll
    for (int j = 0; j < 4; ++j) { o[2 * j] = bflo(p0[j]); o[2 * j + 1] = bfhi(p0[j]); o[8 + 2 * j] = bflo(p1[j]); o[8 + 2 * j + 1] = bfhi(p1[j]); }
}
__device__ __forceinline__ void mixpost_chunk(const Args& a, int l, int lane, int wave, int ch) {
    const bf16* proj = (const bf16*)(a.ws + WS_PROJ); const bf16* ogla = (const bf16*)(a.ws + WS_OGLA); bf16* ybuf = (bf16*)(a.ws + WS_Y);
    const int c0 = 16 * lane, tfirst = ch * 64 + wave * 8, sfirst = tfirst % SEQ;
    float gn[16], cw0[16], cw1[16], cw2[16], cn[16], u1[16], u2[16];
#pragma unroll
    for (int i = 0; i < 16; ++i) { gn[i] = a.in[7][l * 256 + ((c0 + i) & 255)]; cw0[i] = a.in[8][(size_t)l * 3072 + c0 + i]; cw1[i] = a.in[8][(size_t)l * 3072 + 1024 + c0 + i];
        cw2[i] = a.in[8][(size_t)l * 3072 + 2048 + c0 + i]; cn[i] = a.in[9][l * 1024 + c0 + i]; u1[i] = 0.f; u2[i] = 0.f; }
    if (sfirst >= 2) {
        float cc[16], chh[16];
        { const bf16* pr = proj + (size_t)(tfirst - 2) * NP; unpack16(*(const v4u*)(pr + PCC + c0), *(const v4u*)(pr + PCC + c0 + 8), cc); unpack16(*(const v4u*)(pr + PCH + c0), *(const v4u*)(pr + PCH + c0 + 8), chh); }
#pragma unroll
        for (int i = 0; i < 16; ++i) u2[i] = cc[i] * chh[i];
        { const bf16* pr = proj + (size_t)(tfirst - 1) * NP; unpack16(*(const v4u*)(pr + PCC + c0), *(const v4u*)(pr + PCC + c0 + 8), cc); unpack16(*(const v4u*)(pr + PCH + c0), *(const v4u*)(pr + PCH + c0 + 8), chh); }
#pragma unroll
        for (int i = 0; i < 16; ++i) u1[i] = cc[i] * chh[i];
    }
#pragma unroll 2
    for (int it = 0; it < 8; ++it) { const int t = tfirst + it; const bf16* pr = proj + (size_t)t * NP;
        float o[16], r[16], cb[16], cc[16], chh[16];
        unpack16(*(const v4u*)(ogla + (size_t)t * 1024 + c0), *(const v4u*)(ogla + (size_t)t * 1024 + c0 + 8), o);
        unpack16(*(const v4u*)(pr + PR + c0), *(const v4u*)(pr + PR + c0 + 8), r);
        unpack16(*(const v4u*)(pr + PCB + c0), *(const v4u*)(pr + PCB + c0 + 8), cb);
        unpack16(*(const v4u*)(pr + PCC + c0), *(const v4u*)(pr + PCC + c0 + 8), cc);
        unpack16(*(const v4u*)(pr + PCH + c0), *(const v4u*)(pr + PCH + c0 + 8), chh);
        float ss = 0.f;
#pragma unroll
        for (int i = 0; i < 16; ++i) ss += o[i] * o[i];
        ss += __shfl_xor(ss, 1); ss += __shfl_xor(ss, 2); ss += __shfl_xor(ss, 4); ss += __shfl_xor(ss, 8);
        const float rg = rsqrtf(ss * (1.0f / 256.f) + EPS);
        float val[16]; float s2 = 0.f;
#pragma unroll
        for (int i = 0; i < 16; ++i) { const float u0 = cc[i] * chh[i]; val[i] = cb[i] * (cw0[i] * u2[i] + cw1[i] * u1[i] + cw2[i] * u0); s2 += val[i] * val[i]; u2[i] = u1[i]; u1[i] = u0; }
        const float rc = rsqrtf(wave_sum(s2) * (1.0f / 1024.f) + EPS);
        v4u y0, y1, y2, y3;
#pragma unroll
        for (int j = 0; j < 4; ++j) {
            y0[j] = pk2(o[2 * j] * rg * gn[2 * j] * silu_f(r[2 * j]), o[2 * j + 1] * rg * gn[2 * j + 1] * silu_f(r[2 * j + 1]));
            y1[j] = pk2(o[8 + 2 * j] * rg * gn[8 + 2 * j] * silu_f(r[8 + 2 * j]), o[9 + 2 * j] * rg * gn[9 + 2 * j] * silu_f(r[9 + 2 * j]));
            y2[j] = pk2(val[2 * j] * rc * cn[2 * j], val[2 * j + 1] * rc * cn[2 * j + 1]);
            y3[j] = pk2(val[8 + 2 * j] * rc * cn[8 + 2 * j], val[9 + 2 * j] * rc * cn[9 + 2 * j]); }
        bf16* yr = ybuf + (size_t)t * D;
        *(v4u*)(yr + c0) = y0; *(v4u*)(yr + c0 + 8) = y1; *(v4u*)(yr + 1024 + c0) = y2; *(v4u*)(yr + 1024 + c0 + 8) = y3;
    }
}

__device__ __forceinline__ void ln1_chunk(const Args& a, int l, LAS unsigned char* lds, int lane, int wave, int ch) {
    const float* zbuf = (const float*)(a.ws + WS_Z); const float* mod = (const float*)(a.ws + WS_MOD);
    const int b = ch / NCH; const float* mb = mod + ((size_t)l * NB + b) * 6 * D;
#pragma unroll 2
    for (int it = 0; it < 8; ++it) { const int t = ch * 64 + wave * 8 + it;
        float z[32];
#pragma unroll
        for (int c = 0; c < 8; ++c) { const f32x4 v0 = *(const f32x4*)(zbuf + (size_t)t * D + (c * 64 + lane) * 4); z[c * 4] = v0.x; z[c * 4 + 1] = v0.y; z[c * 4 + 2] = v0.z; z[c * 4 + 3] = v0.w; }
        ln_tail(z, t, lane, a.in[11] + (size_t)l * D, a.in[12] + (size_t)l * D, (float*)(a.ws + WS_X1), mb + 3 * D, mb + 4 * D, (bf16*)(a.ws + WS_H2), a.ws + WS_HQ8, (float*)(a.ws + WS_HSC), lds + wave * 2304);
    }
}

template <int N> __device__ __forceinline__ void bitonic_sort_desc(float (&v)[N]) {
#pragma unroll
    for (int k = 2; k <= N; k <<= 1)
#pragma unroll
        for (int j = k >> 1; j > 0; j >>= 1)
#pragma unroll
            for (int i = 0; i < N; ++i) { const int p = i ^ j; if (p > i) { const bool desc = ((i & k) == 0); const float x = v[i], y = v[p]; const float mx = fmaxf(x, y), mn = fminf(x, y); v[i] = desc ? mx : mn; v[p] = desc ? mn : mx; } }
}
__device__ __forceinline__ void merge_top16(float (&x)[16], const float (&y)[16]) {
#pragma unroll
    for (int i = 0; i < 16; ++i) x[i] = fmaxf(x[i], y[15 - i]);
#pragma unroll
    for (int j = 8; j > 0; j >>= 1)
#pragma unroll
        for (int i = 0; i < 16; ++i) { const int p = i ^ j; if (p > i) { const float u = x[i], w = x[p]; x[i] = fmaxf(u, w); x[p] = fminf(u, w); } }
}
__device__ __forceinline__ void ce_desc(float& ka, int& pa, float& kb, int& pb) { const bool sw = kb > ka; const float k0 = sw ? kb : ka, k1 = sw ? ka : kb; const int p0 = sw ? pb : pa, p1 = sw ? pa : pb; ka = k0; pa = p0; kb = k1; pb = p1; }
__device__ __forceinline__ void bitonic_sort_desc_kp(float (&k)[16], int (&p)[16]) {
#pragma unroll
    for (int kk = 2; kk <= 16; kk <<= 1)
#pragma unroll
        for (int j = kk >> 1; j > 0; j >>= 1)
#pragma unroll
            for (int i = 0; i < 16; ++i) { const int q = i ^ j; if (q > i) { if ((i & kk) == 0) ce_desc(k[i], p[i], k[q], p[q]); else ce_desc(k[q], p[q], k[i], p[i]); } }
}
__device__ __forceinline__ void merge_top16_kp(float (&k)[16], int (&p)[16], const float (&k2)[16], const int (&p2)[16]) {
#pragma unroll
    for (int i = 0; i < 16; ++i) { const bool sw = k2[15 - i] > k[i]; k[i] = sw ? k2[15 - i] : k[i]; p[i] = sw ? p2[15 - i] : p[i]; }
#pragma unroll
    for (int j = 8; j > 0; j >>= 1)
#pragma unroll
        for (int i = 0; i < 16; ++i) { const int q = i ^ j; if (q > i) ce_desc(k[i], p[i], k[q], p[q]); }
}
__device__ constexpr int cand_i(int s) { return s < 16 ? 0 : s < 24 ? 1 : s < 29 ? 2 : s < 33 ? 3 : s < 36 ? 4 : s < 38 ? 5 : s < 40 ? 6 : s < 42 ? 7 : s < 50 ? s - 34 : -1; }
__device__ constexpr int cand_j(int s) { return s < 16 ? s : s < 24 ? s - 16 : s < 29 ? s - 24 : s < 33 ? s - 29 : s < 36 ? s - 33 : s < 38 ? s - 36 : s < 40 ? s - 38 : s < 42 ? s - 40 : s < 50 ? 0 : -1; }

__device__ __forceinline__ void peer_retrieve(const Args& a, int l, LAS unsigned char* lds, int lane, int wave, int ch) {
    const bf16* qbuf = (const bf16*)(a.ws + WS_Q); const bf16* keys = (const bf16*)(a.ws + WS_KEYS) + ((size_t)(l * 8 + wave) * 2) * 128 * 128;
    LAS int* eg_e = (LAS int*)lds; LAS float* eg_g = (LAS float*)(lds + 32768);
    const int l31 = lane & 31, l5 = lane >> 5, h = wave, t0 = ch * 64;
    for (int tt = 0; tt < 2; ++tt) {
        float sv[2][16];
#pragma unroll
        for (int p = 0; p < 2; ++p) {
            f32x16 acc[4];
#pragma unroll
            for (int nt = 0; nt < 4; ++nt)
#pragma unroll
                for (int r = 0; r < 16; ++r) acc[nt][r] = 0.f;
            const bf16* qp = qbuf + (size_t)(t0 + 32 * tt + l31) * D + h * 256 + p * 128 + 8 * l5;
            const bf16* kp = keys + (size_t)(p * 128 + l31) * 128 + 8 * l5;
#pragma unroll 2
            for (int ks = 0; ks < 8; ++ks) { const bf16x8 bq = *(const bf16x8*)(qp + 16 * ks);
#pragma unroll
                for (int nt = 0; nt < 4; ++nt) { const bf16x8 ak = *(const bf16x8*)(kp + (size_t)(32 * nt) * 128 + 16 * ks); acc[nt] = __builtin_amdgcn_mfma_f32_32x32x16_bf16(ak, bq, acc[nt], 0, 0, 0); } }
            float v[4][16];
#pragma unroll
            for (int nt = 0; nt < 4; ++nt)
#pragma unroll
                for (int r = 0; r < 16; ++r) { const unsigned idx = 32u * nt + (r & 3) + 8u * (r >> 2) + 4u * l5; v[nt][r] = __uint_as_float((__float_as_uint(acc[nt][r]) & 0xffffff80u) | idx); }
#pragma unroll
            for (int nt = 0; nt < 4; ++nt) bitonic_sort_desc<16>(v[nt]);
            merge_top16(v[0], v[1]); merge_top16(v[2], v[3]); merge_top16(v[0], v[2]);
            float o[16];
#pragma unroll
            for (int i = 0; i < 16; ++i) o[i] = __shfl_xor(v[0][i], 32);
            merge_top16(v[0], o);
#pragma unroll
            for (int i = 0; i < 16; ++i) sv[p][i] = v[0][i];
        }
        LAS unsigned char* idxb = (LAS unsigned char*)(lds + 69632) + wave * 2048 + lane * 32;
        { v4u w0, w1;
#pragma unroll
          for (int q4 = 0; q4 < 4; ++q4) {
              w0[q4] = (__float_as_uint(sv[0][4 * q4]) & 127u) | ((__float_as_uint(sv[0][4 * q4 + 1]) & 127u) << 8) | ((__float_as_uint(sv[0][4 * q4 + 2]) & 127u) << 16) | ((__float_as_uint(sv[0][4 * q4 + 3]) & 127u) << 24);
              w1[q4] = (__float_as_uint(sv[1][4 * q4]) & 127u) | ((__float_as_uint(sv[1][4 * q4 + 1]) & 127u) << 8) | ((__float_as_uint(sv[1][4 * q4 + 2]) & 127u) << 16) | ((__float_as_uint(sv[1][4 * q4 + 3]) & 127u) << 24); }
          *(LAS v4u*)(idxb) = w0; *(LAS v4u*)(idxb + 16) = w1; }
        float ck[4][16];
#pragma unroll
        for (int s = 0; s < 64; ++s) {
            if (cand_i(s) >= 0) { const unsigned b0 = __float_as_uint(sv[0][cand_i(s) < 0 ? 0 : cand_i(s)]), b1 = __float_as_uint(sv[1][cand_j(s) < 0 ? 0 : cand_j(s)]);
                const float sum = __uint_as_float(b0 & 0xffffff80u) + __uint_as_float(b1 & 0xffffff80u);
                ck[s >> 4][s & 15] = __uint_as_float((__float_as_uint(sum) & 0xffffff00u) | (unsigned)((cand_i(s) < 0 ? 0 : cand_i(s)) * 16 + (cand_j(s) < 0 ? 0 : cand_j(s)))); }
            else ck[s >> 4][s & 15] = -3.0e38f; }
        bitonic_sort_desc<16>(ck[1]); bitonic_sort_desc<16>(ck[2]);
        merge_top16(ck[0], ck[1]); merge_top16(ck[2], ck[3]); merge_top16(ck[0], ck[2]);
        LDS_WAIT(); asm volatile("" ::: "memory");
        float ex[16]; int ce[16]; float den = 0.f;
        const float cmax = __uint_as_float(__float_as_uint(ck[0][0]) & 0xffffff00u);
#pragma unroll
        for (int i = 0; i < 16; ++i) { const unsigned bits = __float_as_uint(ck[0][i]); ex[i] = __expf(__uint_as_float(bits & 0xffffff00u) - cmax); den += ex[i];
            ce[i] = (int)idxb[(bits >> 4) & 15u] * 128 + (int)idxb[16 + (bits & 15u)]; }
        const float inv = 1.0f / den;
        if (l5 == 0) {
            const int base = (32 * tt + l31) * 128 + h * 16;
#pragma unroll
            for (int i4 = 0; i4 < 4; ++i4) { *(LAS v4u*)(eg_e + base + 4 * i4) = (v4u){(unsigned)ce[4 * i4], (unsigned)ce[4 * i4 + 1], (unsigned)ce[4 * i4 + 2], (unsigned)ce[4 * i4 + 3]};
                *(LAS f32x4*)(eg_g + base + 4 * i4) = (f32x4){ex[4 * i4] * inv, ex[4 * i4 + 1] * inv, ex[4 * i4 + 2] * inv, ex[4 * i4 + 3] * inv}; }
        }
        LDS_WAIT(); asm volatile("" ::: "memory");
    }
}

typedef unsigned char uc4 __attribute__((ext_vector_type(4)));
constexpr int NSLICE = 16, SLICE_SHIFT = 10;
__device__ __forceinline__ int sdot4i(unsigned w, unsigned x, int acc) { return __builtin_amdgcn_sdot4((int)w, (int)x, acc, false); }
__device__ __forceinline__ void fma_ub4(unsigned w, float s, float& y0, float& y1, float& y2, float& y3) { const uc4 b = __builtin_bit_cast(uc4, w); y0 += s * (float)b.x; y1 += s * (float)b.y; y2 += s * (float)b.z; y3 += s * (float)b.w; }
#if TAB4
__device__ __forceinline__ void peer_tail(const Args& a, int l, int t, int lane, const bf16* Yrow, const float* mb, const float* mbn, bool last) {
    const float* x1buf = (const float*)(a.ws + WS_X1);
    float z[32];
#pragma unroll
    for (int c8 = 0; c8 < 8; ++c8) { const int col = (c8 * 64 + lane) * 4;
        const v2u yb = *(const v2u*)(Yrow + col); const f32x4 yv = (f32x4){bflo(yb.x), bfhi(yb.x), bflo(yb.y), bfhi(yb.y)};
        const f32x4 x0 = *(const f32x4*)(x1buf + (size_t)t * D + col), g0 = *(const f32x4*)(mb + 5 * D + col);
        z[c8 * 4] = ALPHA * x0.x + (1.f + g0.x) * yv.x; z[c8 * 4 + 1] = ALPHA * x0.y + (1.f + g0.y) * yv.y; z[c8 * 4 + 2] = ALPHA * x0.z + (1.f + g0.z) * yv.z; z[c8 * 4 + 3] = ALPHA * x0.w + (1.f + g0.w) * yv.w; }
    ln_tail(z, t, lane, a.in[17] + (size_t)l * D, a.in[18] + (size_t)l * D, last ? a.out : (float*)(a.ws + WS_X), mbn, mbn + D, last ? (bf16*)nullptr : (bf16*)(a.ws + WS_H), nullptr, nullptr);
}
template <class TT, int N, int M> __device__ __forceinline__ void treduce(TT (&v)[N], int lane) {
    const bool c0 = (lane & M) != 0, c1 = (lane & (2 * M)) != 0, c2 = (lane & (4 * M)) != 0;
#pragma unroll
    for (int m = 0; m < N / 2; ++m) { const TT keep = c0 ? v[2 * m + 1] : v[2 * m], send = c0 ? v[2 * m] : v[2 * m + 1]; v[m] = keep + __shfl_xor(send, M); }
#pragma unroll
    for (int m = 0; m < N / 4; ++m) { const TT keep = c1 ? v[2 * m + 1] : v[2 * m], send = c1 ? v[2 * m] : v[2 * m + 1]; v[m] = keep + __shfl_xor(send, 2 * M); }
#pragma unroll
    for (int m = 0; m < N / 8; ++m) { const TT keep = c2 ? v[2 * m + 1] : v[2 * m], send = c2 ? v[2 * m] : v[2 * m + 1]; v[m] = keep + __shfl_xor(send, 4 * M); }
}
__device__ __forceinline__ void tr4x4(unsigned a, unsigned b, unsigned c, unsigned d, unsigned& t0, unsigned& t1, unsigned& t2, unsigned& t3) {
    const unsigned x0 = __builtin_amdgcn_perm(b, a, 0x05010400u), x1 = __builtin_amdgcn_perm(b, a, 0x07030602u), y0 = __builtin_amdgcn_perm(d, c, 0x05010400u), y1 = __builtin_amdgcn_perm(d, c, 0x07030602u);
    t0 = __builtin_amdgcn_perm(y0, x0, 0x05040100u); t1 = __builtin_amdgcn_perm(y0, x0, 0x07060302u); t2 = __builtin_amdgcn_perm(y1, x1, 0x05040100u); t3 = __builtin_amdgcn_perm(y1, x1, 0x07060302u);
}
__device__ __forceinline__ float slot_scale(unsigned w3) { return __builtin_amdgcn_exp2f((float)(w3 >> 24) * 0.125f - 16.0f); }
__device__ __forceinline__ void peer_experts(const Args& a, int l, LAS unsigned char* lds, int lane0, int wave, int ch) {
    const float* mod = (const float*)(a.ws + WS_MOD);
    const unsigned char* ut = a.ws + WS_UT + (size_t)l * NE * 1152; const unsigned char* vt = a.ws + WS_VT + (size_t)l * NE * 1152; const unsigned char* hq8 = a.ws + WS_HQ8;
    const float* hsc = (const float*)(a.ws + WS_HSC);
    bf16* Ybuf = (bf16*)(a.ws + WS_Z);
    const LAS int* eg_e = (const LAS int*)lds; LAS float* sw = (LAS float*)(lds + 32768);
    LAS float* apart = (LAS float*)(lds + 65536);
    const int b = ch / NCH; const bool last = (l == NL - 1);
    const float* mb = mod + ((size_t)l * NB + b) * 6 * D; const float* mbn = mod + ((size_t)(last ? l : l + 1) * NB + b) * 6 * D;
    const int tlw = wave * 8;
    { const int lane = lane0;
#pragma unroll
      for (int i = 0; i < 16; ++i) apart[tlw * 128 + i * 64 + lane] = 0.f; }
    LDS_WAIT(); asm volatile("" ::: "memory");
    {
        int laneL = lane0; asm volatile("" : "+v"(laneL)); const int lane = laneL;
        const int g = lane >> 3, l7 = lane & 7;
        v4u bufA[16], bufB[16], hA0, hA1, hB0, hB1;
#define CU_LOAD(buf, h0_, h1_, idx_) do { const int u_ = (idx_) >> 3, tl_ = tlw + ((idx_) & 7); const unsigned soff_ = (unsigned)(u_ * 128 + l7 * 16); \
            const unsigned char* hp_ = hq8 + (size_t)(ch * 64 + tl_) * 2304 + (u_ * 8 + l7) * 32; h0_ = *(const v4u*)hp_; h1_ = *(const v4u*)(hp_ + 16); \
            _Pragma("unroll") for (int i_ = 0; i_ < 16; ++i_) { const unsigned e_ = (unsigned)eg_e[tl_ * 128 + 8 * i_ + g]; buf[i_] = *(const v4u*)(ut + (size_t)(e_ * 1152u + soff_)); } } while (0)
#define CU_COMP(buf, h0_, h1_, idx_) do { const int tl_ = tlw + ((idx_) & 7); int hs_ = 0; float accv_[16]; \
            _Pragma("unroll") for (int q_ = 0; q_ < 4; ++q_) { hs_ = sdot4i(h0_[q_], 0x01010101u, hs_); hs_ = sdot4i(h1_[q_], 0x01010101u, hs_); } \
            _Pragma("unroll") for (int i_ = 0; i_ < 16; ++i_) { int s_ = 0; \
                _Pragma("unroll") for (int d_ = 0; d_ < 4; ++d_) { const unsigned w_ = buf[i_][d_]; const unsigned he_ = d_ < 2 ? h0_[2 * d_] : h1_[2 * d_ - 4], ho_ = d_ < 2 ? h0_[2 * d_ + 1] : h1_[2 * d_ - 3]; \
                    s_ = sdot4i(w_ & 0x0f0f0f0fu, he_, s_); s_ = sdot4i((w_ >> 4) & 0x0f0f0f0fu, ho_, s_); } \
                accv_[i_] = slot_scale(buf[i_][3]) * (float)(s_ - 8 * hs_); } \
            treduce<float, 16, 1>(accv_, lane); \
            apart[tl_ * 128 + 8 * l7 + g] += accv_[0]; apart[tl_ * 128 + 8 * (8 + l7) + g] += accv_[1]; } while (0)
        CU_LOAD(bufA, hA0, hA1, 0);
        for (int idx = 0; idx < 72; idx += 2) {
            CU_LOAD(bufB, hB0, hB1, idx + 1);
            CU_COMP(bufA, hA0, hA1, idx);
            { const int nx_ = idx + 2 < 72 ? idx + 2 : 71; CU_LOAD(bufA, hA0, hA1, nx_); }
            CU_COMP(bufB, hB0, hB1, idx + 1);
        }
#undef CU_LOAD
#undef CU_COMP
        LDS_WAIT(); asm volatile("" ::: "memory");
        for (int it = 0; it < 8; ++it) { const int tl = tlw + it; const float shs = hsc[ch * 64 + tl];
            const float w0 = sw[tl * 128 + lane] * gelu_tanh_f(apart[tl * 128 + lane] * shs), w1 = sw[tl * 128 + 64 + lane] * gelu_tanh_f(apart[tl * 128 + 64 + lane] * shs);
            sw[tl * 128 + lane] = w0; sw[tl * 128 + 64 + lane] = w1; }
        LDS_WAIT(); asm volatile("" ::: "memory");
    }
    {
        int laneL = lane0; asm volatile("" : "+v"(laneL)); const int lane = laneL;
        const int g = lane >> 3, l7 = lane & 7;
        v4u bufA[16], bufB[16];
#define CV_LOAD(buf, idx_) do { const int u_ = (idx_) >> 3, tl_ = tlw + ((idx_) & 7); const unsigned soff_ = (unsigned)(u_ * 128 + l7 * 16); \
            _Pragma("unroll") for (int i_ = 0; i_ < 16; ++i_) { const unsigned e_ = (unsigned)eg_e[tl_ * 128 + 8 * i_ + g]; buf[i_] = *(const v4u*)(vt + (size_t)(e_ * 1152u + soff_)); } } while (0)
#define CV_COMP(buf, idx_) do { const int u_ = (idx_) >> 3, tl_ = tlw + ((idx_) & 7); \
            float wf_[16]; float wmx_ = 0.f; \
            _Pragma("unroll") for (int i_ = 0; i_ < 16; ++i_) { wf_[i_] = sw[tl_ * 128 + 8 * i_ + g] * slot_scale(buf[i_][3]); wmx_ = fmaxf(wmx_, fabsf(wf_[i_])); } \
            wmx_ = fmaxf(wmx_, __shfl_xor(wmx_, 8)); wmx_ = fmaxf(wmx_, __shfl_xor(wmx_, 16)); wmx_ = fmaxf(wmx_, __shfl_xor(wmx_, 32));     \
            const float winv_ = wmx_ > 0.f ? 127.0f / wmx_ : 0.f, wsc_ = wmx_ * (1.0f / 127.0f); \
            unsigned wq4_[4]; int wsum_ = 0; \
            _Pragma("unroll") for (int gp_ = 0; gp_ < 4; ++gp_) { const int q0_ = (int)__builtin_rintf(wf_[4 * gp_] * winv_), q1_ = (int)__builtin_rintf(wf_[4 * gp_ + 1] * winv_), q2_ = (int)__builtin_rintf(wf_[4 * gp_ + 2] * winv_), q3_ = (int)__builtin_rintf(wf_[4 * gp_ + 3] * winv_); \
                wsum_ += (q0_ + q1_) + (q2_ + q3_); wq4_[gp_] = (unsigned)(q0_ & 255) | ((unsigned)(q1_ & 255) << 8) | ((unsigned)(q2_ & 255) << 16) | ((unsigned)(q3_ & 255) << 24); } \
            int yi_[32]; \
            _Pragma("unroll") for (int q_ = 0; q_ < 32; ++q_) yi_[q_] = 0; \
            _Pragma("unroll") for (int gp_ = 0; gp_ < 4; ++gp_) { \
                _Pragma("unroll") for (int d_ = 0; d_ < 4; ++d_) { const unsigned A_ = buf[4 * gp_][d_], B_ = buf[4 * gp_ + 1][d_], C_ = buf[4 * gp_ + 2][d_], D_ = buf[4 * gp_ + 3][d_]; \
                    unsigned t0_, t1_, t2_, t3_; \
                    tr4x4(A_ & 0x0f0f0f0fu, B_ & 0x0f0f0f0fu, C_ & 0x0f0f0f0fu, D_ & 0x0f0f0f0fu, t0_, t1_, t2_, t3_); \
                    yi_[8 * d_] = sdot4i(t0_, wq4_[gp_], yi_[8 * d_]); yi_[8 * d_ + 2] = sdot4i(t1_, wq4_[gp_], yi_[8 * d_ + 2]); yi_[8 * d_ + 4] = sdot4i(t2_, wq4_[gp_], yi_[8 * d_ + 4]); yi_[8 * d_ + 6] = sdot4i(t3_, wq4_[gp_], yi_[8 * d_ + 6]); \
                    tr4x4((A_ >> 4) & 0x0f0f0f0fu, (B_ >> 4) & 0x0f0f0f0fu, (C_ >> 4) & 0x0f0f0f0fu, (D_ >> 4) & 0x0f0f0f0fu, t0_, t1_, t2_, t3_); \
                    yi_[8 * d_ + 1] = sdot4i(t0_, wq4_[gp_], yi_[8 * d_ + 1]); yi_[8 * d_ + 3] = sdot4i(t1_, wq4_[gp_], yi_[8 * d_ + 3]); yi_[8 * d_ + 5] = sdot4i(t2_, wq4_[gp_], yi_[8 * d_ + 5]); yi_[8 * d_ + 7] = sdot4i(t3_, wq4_[gp_], yi_[8 * d_ + 7]); } } \
            _Pragma("unroll") for (int q_ = 0; q_ < 32; ++q_) yi_[q_] -= 8 * wsum_; \
            treduce<int, 32, 8>(yi_, lane); \
            float y_[4]; \
            _Pragma("unroll") for (int q_ = 0; q_ < 4; ++q_) y_[q_] = wsc_ * (float)yi_[q_]; \
            { const int colb_ = u_ * 240 + l7 * 30 + g; bf16* yr_ = Ybuf + (size_t)(ch * 64 + tl_) * D + colb_; \
              _Pragma("unroll") for (int m_ = 0; m_ < 4; ++m_) if (8 * m_ + g < 30 && colb_ + 8 * m_ < D) yr_[8 * m_] = (bf16)(pk2(y_[m_], 0.f) & 0xffffu); } } while (0)
        CV_LOAD(bufA, 0);
        for (int idx = 0; idx < 72; idx += 2) {
            CV_LOAD(bufB, idx + 1);
            CV_COMP(bufA, idx);
            { const int nx_ = idx + 2 < 72 ? idx + 2 : 71; CV_LOAD(bufA, nx_); }
            CV_COMP(bufB, idx + 1);
        }
#undef CV_LOAD
#undef CV_COMP
    }
    asm volatile("s_waitcnt vmcnt(0)" ::: "memory");
    __builtin_amdgcn_fence(__ATOMIC_ACQUIRE, "agent");
    asm volatile("s_waitcnt vmcnt(0)" ::: "memory");
    for (int it = 0; it < 8; ++it) { int laneT = lane0; asm volatile("" : "+v"(laneT)); const int t = ch * 64 + tlw + it;
        peer_tail(a, l, t, laneT, Ybuf + (size_t)t * D, mb, mbn, last); }
}
#else
__device__ __forceinline__ void peer_tail(const Args& a, int l, int t, int lane, const float* Yrow, const float* mb, const float* mbn, bool last) {
    const float* x1buf = (const float*)(a.ws + WS_X1);
    float z[32];
#pragma unroll
    for (int c = 0; c < 2; ++c)
#pragma unroll
        for (int k = 0; k < 4; ++k) { const int c8 = 4 * c + k, col = (c8 * 64 + lane) * 4;
            const v2u yb = *(const v2u*)((const bf16*)Yrow + (c * 64 + lane) * 16 + 4 * k); const f32x4 yv = (f32x4){bflo(yb.x), bfhi(yb.x), bflo(yb.y), bfhi(yb.y)};
            const f32x4 x0 = *(const f32x4*)(x1buf + (size_t)t * D + col), g0 = *(const f32x4*)(mb + 5 * D + col);
            z[c8 * 4] = ALPHA * x0.x + (1.f + g0.x) * yv.x; z[c8 * 4 + 1] = ALPHA * x0.y + (1.f + g0.y) * yv.y; z[c8 * 4 + 2] = ALPHA * x0.z + (1.f + g0.z) * yv.z; z[c8 * 4 + 3] = ALPHA * x0.w + (1.f + g0.w) * yv.w; }
    ln_tail(z, t, lane, a.in[17] + (size_t)l * D, a.in[18] + (size_t)l * D, last ? a.out : (float*)(a.ws + WS_X), mbn, mbn + D, last ? (bf16*)nullptr : (bf16*)(a.ws + WS_H), nullptr, nullptr);
}
template <class TT, int M> __device__ __forceinline__ void treduce16(TT (&v)[16], int lane) {
    const bool c0 = (lane & M) != 0, c1 = (lane & (2 * M)) != 0, c2 = (lane & (4 * M)) != 0;
#pragma unroll
    for (int m = 0; m < 8; ++m) { const TT keep = c0 ? v[2 * m + 1] : v[2 * m], send = c0 ? v[2 * m] : v[2 * m + 1]; v[m] = keep + __shfl_xor(send, M); }
#pragma unroll
    for (int m = 0; m < 4; ++m) { const TT keep = c1 ? v[2 * m + 1] : v[2 * m], send = c1 ? v[2 * m] : v[2 * m + 1]; v[m] = keep + __shfl_xor(send, 2 * M); }
#pragma unroll
    for (int m = 0; m < 2; ++m) { const TT keep = c2 ? v[2 * m + 1] : v[2 * m], send = c2 ? v[2 * m] : v[2 * m + 1]; v[m] = keep + __shfl_xor(send, 4 * M); }
}
__device__ __forceinline__ void peer_experts(const Args& a, int l, LAS unsigned char* lds, int lane0, int wave, int ch) {
    const float* mod = (const float*)(a.ws + WS_MOD);
    const unsigned char* ut = a.ws + WS_UT + (size_t)l * NE * D; const unsigned char* vt = a.ws + WS_VT + (size_t)l * NE * D; const unsigned char* hq8 = a.ws + WS_HQ8;
    const float* su = (const float*)(a.ws + WS_SU) + (size_t)l * NE; const float* sv = (const float*)(a.ws + WS_SV) + (size_t)l * NE; const float* hsc = (const float*)(a.ws + WS_HSC);
    float* Ybuf = (float*)(a.ws + WS_Z);
    const LAS int* eg_e = (const LAS int*)lds; LAS float* sw = (LAS float*)(lds + 32768);
    LAS int* apart = (LAS int*)(lds + 65536); LAS float* wtotl = (LAS float*)(lds + LDSCTL_OFF + 256);
    const int b = ch / NCH; const bool last = (l == NL - 1);
    const float* mb = mod + ((size_t)l * NB + b) * 6 * D; const float* mbn = mod + ((size_t)(last ? l : l + 1) * NB + b) * 6 * D;
    const int tlw = wave * 8;
    { const int lane = lane0;
#pragma unroll
      for (int i = 0; i < 16; ++i) apart[tlw * 128 + i * 64 + lane] = 0; }
    LDS_WAIT(); asm volatile("" ::: "memory");
    {
        int laneL = lane0; asm volatile("" : "+v"(laneL)); const int lane = laneL;
        const int g = lane >> 3, l7 = lane & 7;
        v4u bufA[16], bufB[16], hA, hB;
#define CU_LOAD(buf, hh_, idx_) do { const int cs_ = (idx_) >> 3, tl_ = tlw + ((idx_) & 7); const unsigned coff_ = (unsigned)(cs_ * 128 + l7 * 16); \
            hh_ = *(const v4u*)(hq8 + (size_t)(ch * 64 + tl_) * D + coff_); \
            _Pragma("unroll") for (int i_ = 0; i_ < 16; ++i_) { const unsigned e_ = (unsigned)eg_e[tl_ * 128 + 8 * i_ + g]; buf[i_] = *(const v4u*)(ut + (size_t)(e_ * 2048u + coff_)); } } while (0)
#define CU_COMP(buf, hh_, idx_) do { const int tl_ = tlw + ((idx_) & 7); int acc_[16]; \
            _Pragma("unroll") for (int i_ = 0; i_ < 16; ++i_) { int s_ = 0; _Pragma("unroll") for (int q_ = 0; q_ < 4; ++q_) s_ = sdot4i(buf[i_][q_], hh_[q_], s_); acc_[i_] = s_; } \
            treduce16<int, 1>(acc_, lane); \
            apart[tl_ * 128 + 8 * l7 + g] += acc_[0]; apart[tl_ * 128 + 8 * (8 + l7) + g] += acc_[1]; } while (0)
        CU_LOAD(bufA, hA, 0);
        for (int idx = 0; idx < 128; idx += 2) {
            CU_LOAD(bufB, hB, idx + 1);
            CU_COMP(bufA, hA, idx);
            if (idx + 2 < 128) CU_LOAD(bufA, hA, idx + 2);
            CU_COMP(bufB, hB, idx + 1);
        }
#undef CU_LOAD
#undef CU_COMP
        LDS_WAIT(); asm volatile("" ::: "memory");
        for (int it = 0; it < 8; ++it) { const int tl = tlw + it; const float shs = hsc[ch * 64 + tl];
            const int e0 = eg_e[tl * 128 + lane], e1 = eg_e[tl * 128 + 64 + lane];
            const float w0 = sw[tl * 128 + lane] * gelu_tanh_f((float)apart[tl * 128 + lane] * su[e0] * shs) * sv[e0];
            const float w1 = sw[tl * 128 + 64 + lane] * gelu_tanh_f((float)apart[tl * 128 + 64 + lane] * su[e1] * shs) * sv[e1];
            sw[tl * 128 + lane] = w0; sw[tl * 128 + 64 + lane] = w1;
            const float ws = wave_sum(w0 + w1);
            if (lane == 0) wtotl[tl] = ws; }
        LDS_WAIT(); asm volatile("" ::: "memory");
    }
    {
        int laneL = lane0; asm volatile("" : "+v"(laneL)); const int lane = laneL;
        const int g = lane >> 3, l7 = lane & 7;
        v4u bufA[16], bufB[16];
#define CV_LOAD(buf, idx_) do { const int cs_ = (idx_) >> 3, tl_ = tlw + ((idx_) & 7); const unsigned coff_ = (unsigned)(cs_ * 128 + l7 * 16); \
            _Pragma("unroll") for (int i_ = 0; i_ < 16; ++i_) { const unsigned e_ = (unsigned)eg_e[tl_ * 128 + 8 * i_ + g]; buf[i_] = *(const v4u*)(vt + (size_t)(e_ * 2048u + coff_)); } } while (0)
#define CV_COMP(buf, idx_) do { const int cs_ = (idx_) >> 3, tl_ = tlw + ((idx_) & 7); float y_[16]; \
            _Pragma("unroll") for (int q_ = 0; q_ < 16; ++q_) y_[q_] = 0.f; \
            _Pragma("unroll") for (int i_ = 0; i_ < 16; ++i_) { const float wr_ = sw[tl_ * 128 + 8 * i_ + g]; \
                _Pragma("unroll") for (int q_ = 0; q_ < 4; ++q_) fma_ub4(buf[i_][q_], wr_, y_[4 * q_], y_[4 * q_ + 1], y_[4 * q_ + 2], y_[4 * q_ + 3]); } \
            treduce16<float, 8>(y_, lane); \
            const float woff_ = 128.0f * wtotl[tl_]; bf16* yr_ = (bf16*)Ybuf + (size_t)(ch * 64 + tl_) * D + cs_ * 128 + l7 * 16 + g; \
            yr_[0] = (bf16)(pk2(y_[0] - woff_, 0.f) & 0xffffu); yr_[8] = (bf16)(pk2(y_[1] - woff_, 0.f) & 0xffffu); } while (0)
        CV_LOAD(bufA, 0);
        for (int idx = 0; idx < 128; idx += 2) {
            CV_LOAD(bufB, idx + 1);
            CV_COMP(bufA, idx);
            if (idx + 2 < 128) CV_LOAD(bufA, idx + 2);
            CV_COMP(bufB, idx + 1);
        }
#undef CV_LOAD
#undef CV_COMP
    }
    asm volatile("s_waitcnt vmcnt(0)" ::: "memory");
    __builtin_amdgcn_fence(__ATOMIC_ACQUIRE, "agent");
    asm volatile("s_waitcnt vmcnt(0)" ::: "memory");
    for (int it = 0; it < 8; ++it) { int laneT = lane0; asm volatile("" : "+v"(laneT)); const int t = ch * 64 + tlw + it;
        peer_tail(a, l, t, laneT, (const float*)((const bf16*)Ybuf + (size_t)t * D), mb, mbn, last); }
}

#endif

#ifndef MK_PER_PHASE
#define MK_PER_PHASE 0
#endif
__global__ void __launch_bounds__(NTHREADS, 2) mk_fwd(Args a) {
    extern __shared__ __attribute__((aligned(16))) unsigned char lds_raw[];
    LAS unsigned char* lds = (LAS unsigned char*)lds_raw;
    const int tid = threadIdx.x, lane = tid & 63, wave = __builtin_amdgcn_readfirstlane(tid >> 6), G = gridDim.x, bx = blockIdx.x;
    if (tid < 64) ((LAS unsigned*)(lds + LDSCTL_OFF))[tid] = 0u;
    __syncthreads();
    unsigned* ctl = (unsigned*)(a.ws + WS_CTL);
    XcdBarrier bar; bar.bar = ctl + CW_BAR; bar.x = 0; bar.st = nullptr;
    const bool use_bar = (a.ph_hi - a.ph_lo) > 1;
    if (use_bar) bar = xcd_barrier_post(ctl + CW_BAR, (volatile LAS unsigned*)(lds + LDSCTL_OFF));
    const int lo = a.ph_lo, hi = a.ph_hi;
#ifndef PH_MASK
#define PH_MASK 0x1ff
#endif
#define IN(k) (lo <= (k) && (k) < hi)
#define EN(b) ((PH_MASK >> (b)) & 1)
#ifndef REP_MASK
#define REP_MASK 0
#endif
#ifndef REP_EXTRA
#define REP_EXTRA 2
#endif
#define REPS(b) (1 + ((REP_MASK >> (b)) & 1) * REP_EXTRA)
#define REP_BEGIN(b) for (int rep_ = 0; rep_ < REPS(b); ++rep_) {
#define REP_END(b) if (rep_ + 1 < REPS(b)) xcd_barrier(bar); }
#define SEAM(k) do { if (IN((k) + 1)) xcd_barrier(bar); } while (0)
#define PHASE_IDS() int tidp = tid; asm volatile("" : "+v"(tidp)); const int lanep = tidp & 63, wavep = __builtin_amdgcn_readfirstlane(tidp >> 6); (void)lanep; (void)wavep
    if (EN(0) && IN(0)) { REP_BEGIN(0) PHASE_IDS(); ph_prologue_a(a, lds, tidp, lanep, wavep, bx, G); REP_END(0) SEAM(0); }
    if (EN(1) && IN(1)) { REP_BEGIN(1) PHASE_IDS(); ph_prologue_b(a, lds, tidp, lanep, wavep, bx, G); REP_END(1) SEAM(1); }
    for (int l = 0; l < NL; ++l) {
        const int pb = 2 + 7 * l;
        const float* mod = (const float*)(a.ws + WS_MOD);
        if (EN(2) && IN(pb + 0)) {
            REP_BEGIN(2) PHASE_IDS();
            pg8::Gemm g{(const pg8::bf16_t*)(a.ws + WS_H), (const pg8::bf16_t*)(a.ws + WS_WIN) + (size_t)l * INW * D, T, NP, D}; pg8::StaticOrder S; S.init(T, NP, G, bx);
            pg8::EpiBf16P E{(pg8::bf16_t*)(a.ws + WS_PROJ), NP};
            pg8::gemm_phase<pg8::EpiBf16P, pg8::StaticOrder, true, true>(lds + RING_OFF, g, S, E, tidp);
            for (int ch = bx; ch < NCHUNK; ch += G) gate_prep(a, l, lds, tidp, lanep, wavep, ch);
            REP_END(2) SEAM(pb + 0);
        }
        if (EN(3) && IN(pb + 1)) { REP_BEGIN(3) PHASE_IDS(); for (int un = bx; un < 256; un += G) gla_unit(a, lds, tidp, lanep, wavep, un); REP_END(3) SEAM(pb + 1); }
        if (EN(4) && IN(pb + 2)) { REP_BEGIN(4) PHASE_IDS(); for (int ch = bx; ch < NCHUNK; ch += G) mixpost_chunk(a, l, lanep, wavep, ch); REP_END(4) SEAM(pb + 2); }
        if (EN(5) && IN(pb + 3)) {
            REP_BEGIN(5) PHASE_IDS();
            pg8::Gemm g{(const pg8::bf16_t*)(a.ws + WS_Y), (const pg8::bf16_t*)(a.ws + WS_WOUT) + (size_t)l * D * D, T, D, D}; pg8::StaticOrder S; S.init(T, D, G, bx);
            pg8::EpiResid E{(float*)(a.ws + WS_Z), l == 0 ? a.in[0] : (const float*)(a.ws + WS_X), mod + (size_t)l * NB * 6 * D + 2 * D, ALPHA};
            pg8::gemm_phase<pg8::EpiResid, pg8::StaticOrder, true, true>(lds + RING_OFF, g, S, E, tidp);
            REP_END(5) SEAM(pb + 3);
        }
        if (EN(6) && IN(pb + 4)) { REP_BEGIN(6) PHASE_IDS(); for (int ch = bx; ch < NCHUNK; ch += G) ln1_chunk(a, l, lds, lanep, wavep, ch); REP_END(6) SEAM(pb + 4); }
        if (EN(7) && IN(pb + 5)) {
            REP_BEGIN(7) PHASE_IDS();
            pg8::Gemm g{(const pg8::bf16_t*)(a.ws + WS_H2), (const pg8::bf16_t*)(a.ws + WS_WQ) + (size_t)l * D * D, T, D, D}; pg8::StaticOrder S; S.init(T, D, G, bx);
            pg8::EpiBf16P E{(pg8::bf16_t*)(a.ws + WS_Q), D};
            pg8::gemm_phase<pg8::EpiBf16P, pg8::StaticOrder, true, true>(lds + RING_OFF, g, S, E, tidp);
            REP_END(7) SEAM(pb + 5);
        }
#ifndef PEER_DBG
#define PEER_DBG 0
#endif
#ifndef PE_REP_R
#define PE_REP_R 1
#endif
#ifndef L2PROBE
#define L2PROBE 0
#endif
        if (EN(8) && IN(pb + 6)) {
            REP_BEGIN(8)
            for (int ch = bx; ch < NCHUNK; ch += G) { for (int repr_ = 0; repr_ < PE_REP_R; ++repr_) { PHASE_IDS(); peer_retrieve(a, l, lds, lanep, wavep, ch); __syncthreads(); } __syncthreads(); { PHASE_IDS(); peer_experts(a, l, lds, lanep, wavep, ch); } __syncthreads(); }
            REP_END(8) SEAM(pb + 6);
        }
    }
#undef IN
#undef SEAM
}

extern "C" void kernel_launch(void* const* d_in, const int* in_sizes, int n_in, void* d_out, int out_size, void* d_ws, size_t ws_size, hipStream_t stream) {
    static int grid = 0;
    if (grid == 0) {
        if (n_in != 19 || in_sizes[0] != T * D || out_size != T * D || ws_size < WS_END) { fprintf(stderr, "kernel_launch: unexpected shapes / workspace (%d inputs, ws %zu); nothing launched\n", n_in, ws_size); grid = -1; return; }
        int dev = 0, cus = 0, per_cu = 0;
        if (hipGetDevice(&dev) != hipSuccess || hipDeviceGetAttribute(&cus, hipDeviceAttributeMultiprocessorCount, dev) != hipSuccess) { grid = -1; return; }
        if (hipFuncSetAttribute((const void*)mk_fwd, hipFuncAttributeMaxDynamicSharedMemorySize, LDS_BYTES) != hipSuccess) { fprintf(stderr, "kernel_launch: hipFuncSetAttribute failed\n"); grid = -1; return; }
        if (hipOccupancyMaxActiveBlocksPerMultiprocessor(&per_cu, (const void*)mk_fwd, NTHREADS, LDS_BYTES) != hipSuccess || per_cu < 1) fprintf(stderr, "kernel_launch: occupancy query reports %d\n", per_cu);
        (void)hipGetLastError();
        grid = cus;
    }
    if (grid < 0) return;
    if (hipMemsetAsync((char*)d_ws + WS_CTL, 0, CTL_ZERO_BYTES, stream) != hipSuccess) return;
    Args a{};
    for (int i = 0; i < 19; ++i) a.in[i] = (const float*)d_in[i];
    a.out = (float*)d_out; a.ws = (unsigned char*)d_ws;
#if MK_PER_PHASE
    for (int p = 0; p < NPHASES; ++p) { a.ph_lo = p; a.ph_hi = p + 1; hipLaunchKernelGGL(mk_fwd, dim3(grid), dim3(NTHREADS), LDS_BYTES, stream, a); }
#else
    a.ph_lo = 0; a.ph_hi = NPHASES;
    hipLaunchKernelGGL(mk_fwd, dim3(grid), dim3(NTHREADS), LDS_BYTES, stream, a);
#endif
}
```

```cpp
#include <hip/hip_runtime.h>
#include <cstdio>
#include <cstdint>
namespace pg8 {
#define PG8_LAS __attribute__((address_space(3)))
typedef unsigned short bf16_t;
typedef short bf16x8 __attribute__((ext_vector_type(8)));
typedef float f32x4 __attribute__((ext_vector_type(4)));
typedef unsigned u32x4 __attribute__((ext_vector_type(4)));
constexpr int BM = 256, BK = 64, HALF = 128, HTB = HALF * BK * 2  , STAGE_BYTES = 8 * HTB, NXCD = 8, WGM = 8;

__host__ __device__ __forceinline__ int lds_byte(int r, int c) { const int st = (r >> 4) * 2 + (c >> 5), rr = r & 15, cc = c & 31, ob = rr * 64 + cc * 2; return st * 1024 + (ob ^ (((ob >> 9) & 1) << 5)); }
__host__ __device__ __forceinline__ void stage_rc(int b, int& R, int& C) { const int st = b / 1024, sb = b % 1024, swz = sb ^ (((sb >> 9) & 1) << 5); R = (st >> 1) * 16 + swz / 64; C = (st & 1) * 32 + (swz % 64) / 2; }
__host__ __device__ __forceinline__ int perm32(int rho) { const int n = rho >> 4, i = rho & 15; return 8 * (i >> 2) + 4 * n + (i & 3); }

struct Unit { int pm, pn; };
struct Gemm { const bf16_t* A; const bf16_t* Bt; int M, N, K; };

struct StaticOrder {
    int nM, nN, nwg, G, c;
    __host__ __device__ void init(int M, int N, int G_, int c_) { nM = M / BM; nN = N / BM; nwg = nM * nN; G = G_; c = c_; }
    __host__ __device__ bool next(int i, Unit& u) const {
        const long L = (long)i * G + c; if (L >= nwg) return false;
        int wgid = (int)L; { const int q = nwg / NXCD, r = nwg % NXCD, xcd = wgid % NXCD, off = wgid / NXCD; wgid = (xcd < r ? xcd * (q + 1) : r * (q + 1) + (xcd - r) * q) + off; }
        const int nig = WGM * nN, gid = wgid / nig, fm = gid * WGM, gsz = (nM - fm) < WGM ? (nM - fm) : WGM;
        u.pm = fm + ((wgid % nig) % gsz); u.pn = (wgid % nig) / gsz; return true;
    }
    __device__ __forceinline__ void a_ready(const Unit&) const {}
    __device__ __forceinline__ void done(const Unit&) const {}
};
typedef __bf16 bf16x2_t __attribute__((ext_vector_type(2)));
__device__ __forceinline__ unsigned cvt_pk_bf16(float lo, float hi) { bf16x2_t r; r.x = (__bf16)lo; r.y = (__bf16)hi; return __builtin_bit_cast(unsigned, r); }
struct EpiBf16P {
    static constexpr bool PERM = true, AFTER_DRAIN = false;
    bf16_t* O; int ldc;
    __device__ __forceinline__ void operator()(const f32x4 (&acc)[2][2][4][2], const Unit& u, int wr, int wc, int fr, int fq) const {
        const int row0 = u.pm * BM + wr * 64 + fr, col0 = u.pn * BM + wc * 32 + 8 * fq;
#pragma unroll
        for (int ai = 0; ai < 2; ++ai)
#pragma unroll
            for (int m = 0; m < 4; ++m) { bf16_t* rowp = O + (size_t)(row0 + ai * HALF + m * 16) * ldc + col0;
#pragma unroll
                for (int bj = 0; bj < 2; ++bj) { const f32x4 v0 = acc[ai][bj][m][0], v1 = acc[ai][bj][m][1];
                    u32x4 w; w.x = cvt_pk_bf16(v0[0], v0[1]); w.y = cvt_pk_bf16(v0[2], v0[3]); w.z = cvt_pk_bf16(v1[0], v1[1]); w.w = cvt_pk_bf16(v1[2], v1[3]);
                    *(u32x4*)(rowp + bj * HALF) = w; } }
    }
};
struct EpiResid {
    static constexpr bool PERM = false, AFTER_DRAIN = false;
    float* Z; const float* X; const float* gate; float alpha;
    __device__ __forceinline__ void operator()(const f32x4 (&acc)[2][2][4][2], const Unit& u, int wr, int wc, int fr, int fq) const {
        const int row0 = u.pm * BM + wr * 64 + fr, col0 = u.pn * BM + wc * 32 + 4 * fq;
        const float* gb = gate + (size_t)(u.pm >> 3) * (6 * 2048) + col0;
        f32x4 gv[2][2];
#pragma unroll
        for (int bj = 0; bj < 2; ++bj)
#pragma unroll
            for (int n = 0; n < 2; ++n) gv[bj][n] = *(const f32x4*)(gb + bj * HALF + n * 16) + 1.0f;
#pragma unroll
        for (int ai = 0; ai < 2; ++ai)
#pragma unroll
            for (int m = 0; m < 4; ++m) { const size_t off = (size_t)(row0 + ai * HALF + m * 16) * 2048 + col0;
#pragma unroll
                for (int bj = 0; bj < 2; ++bj)
#pragma unroll
                    for (int n = 0; n < 2; ++n) { const f32x4 xv = *(const f32x4*)(X + off + bj * HALF + n * 16);
                        *(f32x4*)(Z + off + bj * HALF + n * 16) = xv * alpha + gv[bj][n] * acc[ai][bj][m][n]; }
                asm volatile("" ::: "memory"); }
    }
};
template <class Epi, class Sched, bool ALIGN_EPI = false, bool SP2 = false>
__device__ __forceinline__ void gemm_phase(PG8_LAS unsigned char* lds, const Gemm g, const Sched& S, const Epi& E, const int tid_in) {
    const int tid = tid_in, wid = __builtin_amdgcn_readfirstlane(tid >> 6), lane = tid & 63, wr = wid >> 2, wc = wid & 3, fr = lane & 15, fq = lane >> 4;
    const int K = g.K, nt = K / BK;
    unsigned voffA[2], voffB[2];
#pragma unroll
    for (int i = 0; i < 2; ++i) { int R, C; stage_rc(tid * 16 + i * 8192, R, C); const int Rb = Epi::PERM ? ((R & ~31) + perm32(R & 31)) : R;
        voffA[i] = (unsigned)(R * K + C) * 2u; voffB[i] = (unsigned)(Rb * K + C) * 2u; }
    const size_t kstep = (size_t)(BK * 2);
    const size_t hstep = (size_t)HALF * K * 2;
    const size_t tstep = 2 * hstep;
    const unsigned ldsw = (unsigned)wid * 1024u;
    const int aoff = lds_byte(wr * 64 + fr, fq * 8), boff = lds_byte(wc * 32 + fr, fq * 8);
#define PG8_SA(b, h) (((b) * 2 + (h)) * HTB)
#define PG8_SB(b, h) ((4 + (b) * 2 + (h)) * HTB)
#define PG8_STAGE(bufoff, gbase, voff) do { _Pragma("unroll") for (int _i = 0; _i < 2; ++_i) \
        __builtin_amdgcn_global_load_lds((const unsigned*)((const char*)(gbase) + (voff)[_i]), (PG8_LAS unsigned*)(lds + (bufoff) + ldsw + _i * 8192), 16, 0, 0); } while (0)
#define PG8_LDA(dst, b, h) do { _Pragma("unroll") for (int m = 0; m < 4; ++m) _Pragma("unroll") for (int k = 0; k < 2; ++k) dst[m][k] = *(const PG8_LAS bf16x8*)(lds + PG8_SA(b, h) + aoff + m * 2048 + k * 1024); } while (0)
#define PG8_LDB(dst, b, h) do { _Pragma("unroll") for (int n = 0; n < 2; ++n) _Pragma("unroll") for (int k = 0; k < 2; ++k) dst[n][k] = *(const PG8_LAS bf16x8*)(lds + PG8_SB(b, h) + boff + n * 2048 + k * 1024); } while (0)
#define PG8_MMA(ai, bj, At, Bt) do { __builtin_amdgcn_s_setprio(1); _Pragma("unroll") for (int m = 0; m < 4; ++m) _Pragma("unroll") for (int n = 0; n < 2; ++n) _Pragma("unroll") for (int k = 0; k < 2; ++k) \
        acc[ai][bj][m][n] = __builtin_amdgcn_mfma_f32_16x16x32_bf16(Bt[n][k], At[m][k], acc[ai][bj][m][n], 0, 0, 0); __builtin_amdgcn_s_setprio(0); } while (0)
#define PG8_WAIT_V(n) asm volatile("s_waitcnt vmcnt(" #n ")" ::: "memory")
#define PG8_WAIT_L(n) asm volatile("s_waitcnt lgkmcnt(" #n ")" ::: "memory")
#define PG8_BAR __builtin_amdgcn_s_barrier()
#define PG8_SCHED __builtin_amdgcn_sched_barrier(0)
    Unit cur, nxt; int ui = 0;
    if (!S.next(0, cur)) return;
    f32x4 acc[2][2][4][2];
#pragma unroll
    for (int a = 0; a < 2; ++a)
#pragma unroll
        for (int b = 0; b < 2; ++b)
#pragma unroll
            for (int m = 0; m < 4; ++m)
#pragma unroll
                for (int n = 0; n < 2; ++n) acc[a][b][m][n] = (f32x4){0.f, 0.f, 0.f, 0.f};
    bf16x8 At[4][2], B0[2][2], B1[2][2];
    const char* cA = (const char*)g.A + (size_t)cur.pm * tstep; const char* cB = (const char*)g.Bt + (size_t)cur.pn * tstep;
    S.a_ready(cur);
    if constexpr (SP2) {
        PG8_STAGE(PG8_SB(0, 0), cB, voffB); PG8_STAGE(PG8_SB(0, 1), cB + hstep, voffB); PG8_STAGE(PG8_SA(0, 0), cA, voffA); PG8_STAGE(PG8_SA(0, 1), cA + hstep, voffA);
        if (wr == 1) PG8_BAR;
        PG8_WAIT_V(2); PG8_BAR;
        PG8_STAGE(PG8_SB(1, 0), cB + kstep, voffB); PG8_STAGE(PG8_SA(1, 0), cA + kstep, voffA); PG8_STAGE(PG8_SB(1, 1), cB + hstep + kstep, voffB);
        PG8_WAIT_V(6); PG8_BAR;
    } else {
        PG8_STAGE(PG8_SB(0, 0), cB, voffB); PG8_STAGE(PG8_SA(0, 0), cA, voffA); PG8_STAGE(PG8_SB(0, 1), cB + hstep, voffB); PG8_STAGE(PG8_SA(0, 1), cA + hstep, voffA);
        if (wr == 1) PG8_BAR;
        PG8_WAIT_V(4); PG8_BAR;
        PG8_STAGE(PG8_SB(1, 0), cB + kstep, voffB); PG8_STAGE(PG8_SA(1, 0), cA + kstep, voffA); PG8_STAGE(PG8_SB(1, 1), cB + hstep + kstep, voffB);
        PG8_WAIT_V(6); PG8_BAR;
    }
    for (;;) {
        const bool has_next = S.next(ui + 1, nxt);
        const char* nA = has_next ? (const char*)g.A + (size_t)nxt.pm * tstep : cA; const char* nB = has_next ? (const char*)g.Bt + (size_t)nxt.pn * tstep : cB;
        for (int t = 0; t < nt; t += 2) {
            const bool last = (t == nt - 2);
            const char* a1 = cA + (size_t)(t + 1) * kstep;
            const char* a2 = last ? nA : cA + (size_t)(t + 2) * kstep; const char* b2 = last ? nB : cB + (size_t)(t + 2) * kstep;
            const char* a3 = a2 + kstep; const char* b3 = b2 + kstep;
            if (last && has_next) S.a_ready(nxt);
            if constexpr (SP2) {
            PG8_LDB(B0, 0, 0); PG8_LDB(B1, 0, 1); PG8_SCHED; PG8_LDA(At, 0, 0); PG8_STAGE(PG8_SA(1, 1), a1 + hstep, voffA);
            PG8_WAIT_V(8); PG8_WAIT_L(0); PG8_BAR; PG8_MMA(0, 0, At, B0); PG8_MMA(0, 1, At, B1); PG8_BAR; PG8_SCHED;
            PG8_LDA(At, 0, 1); PG8_STAGE(PG8_SB(0, 0), b2, voffB); PG8_STAGE(PG8_SB(0, 1), b2 + hstep, voffB); PG8_STAGE(PG8_SA(0, 0), a2, voffA);
            PG8_WAIT_V(8); PG8_WAIT_L(0); PG8_BAR; PG8_MMA(1, 0, At, B0); PG8_MMA(1, 1, At, B1); PG8_BAR; PG8_SCHED;
            PG8_LDB(B0, 1, 0); PG8_LDB(B1, 1, 1); PG8_SCHED; PG8_LDA(At, 1, 0); PG8_STAGE(PG8_SA(0, 1), a2 + hstep, voffA);
            PG8_WAIT_V(8); PG8_WAIT_L(0); PG8_BAR; PG8_MMA(0, 0, At, B0); PG8_MMA(0, 1, At, B1); PG8_BAR; PG8_SCHED;
            PG8_LDA(At, 1, 1); PG8_STAGE(PG8_SB(1, 0), b3, voffB); PG8_STAGE(PG8_SB(1, 1), b3 + hstep, voffB); PG8_STAGE(PG8_SA(1, 0), a3, voffA);
            PG8_WAIT_V(8); PG8_WAIT_L(0); PG8_BAR; PG8_MMA(1, 0, At, B0); PG8_MMA(1, 1, At, B1); PG8_BAR; PG8_SCHED;
            } else {
            PG8_LDB(B0, 0, 0); PG8_SCHED; PG8_LDA(At, 0, 0); PG8_STAGE(PG8_SA(1, 1), a1 + hstep, voffA);
            PG8_WAIT_L(8); PG8_BAR; PG8_WAIT_L(0); PG8_MMA(0, 0, At, B0); PG8_BAR; PG8_SCHED;
            PG8_LDB(B1, 0, 1); PG8_STAGE(PG8_SB(0, 0), b2, voffB);
            PG8_BAR; PG8_WAIT_L(0); PG8_MMA(0, 1, At, B1); PG8_BAR;
            PG8_LDA(At, 0, 1); PG8_STAGE(PG8_SA(0, 0), a2, voffA);
            PG8_BAR; PG8_WAIT_L(0); PG8_MMA(1, 0, At, B0); PG8_BAR; PG8_SCHED;
            PG8_STAGE(PG8_SB(0, 1), b2 + hstep, voffB);
            PG8_WAIT_V(6); PG8_BAR; PG8_MMA(1, 1, At, B1); PG8_BAR;
            PG8_LDB(B0, 1, 0); PG8_SCHED; PG8_LDA(At, 1, 0); PG8_STAGE(PG8_SA(0, 1), a2 + hstep, voffA);
            PG8_WAIT_L(8); PG8_BAR; PG8_WAIT_L(0); PG8_MMA(0, 0, At, B0); PG8_BAR; PG8_SCHED;
            PG8_LDB(B1, 1, 1); PG8_STAGE(PG8_SB(1, 0), b3, voffB);
            PG8_BAR; PG8_WAIT_L(0); PG8_MMA(0, 1, At, B1); PG8_BAR;
            PG8_LDA(At, 1, 1); PG8_STAGE(PG8_SA(1, 0), a3, voffA);
            PG8_BAR; PG8_WAIT_L(0); PG8_MMA(1, 0, At, B0); PG8_BAR; PG8_SCHED;
            PG8_STAGE(PG8_SB(1, 1), b3 + hstep, voffB);
            PG8_WAIT_V(6); PG8_BAR; PG8_MMA(1, 1, At, B1); PG8_BAR;
            }
        }
        if constexpr (ALIGN_EPI) { if (wr == 0) PG8_BAR; }
        if constexpr (!Epi::AFTER_DRAIN) { E(acc, cur, wr, wc, fr, fq); S.done(cur); }
        if (!has_next) break;
#pragma unroll
        for (int a = 0; a < 2; ++a)
#pragma unroll
            for (int b = 0; b < 2; ++b)
#pragma unroll
                for (int m = 0; m < 4; ++m)
#pragma unroll
                    for (int n = 0; n < 2; ++n) acc[a][b][m][n] = (f32x4){0.f, 0.f, 0.f, 0.f};
        cur = nxt; cA = nA; cB = nB; ++ui;
        if constexpr (ALIGN_EPI) { if (wr == 1) PG8_BAR; }
    }
    PG8_WAIT_V(0);
    if constexpr (!ALIGN_EPI) { if (wr == 0) PG8_BAR; }
    PG8_BAR;
    if constexpr (Epi::AFTER_DRAIN) { E.fused(acc, cur, wr, wc, fr, fq, lds, wid, lane); S.done(cur); }
#undef PG8_SA
#undef PG8_SB
#undef PG8_STAGE
#undef PG8_LDA
#undef PG8_LDB
#undef PG8_MMA
#undef PG8_WAIT_V
#undef PG8_WAIT_L
#undef PG8_BAR
#undef PG8_SCHED
}
}
#define XB_TMO      128
#define XB_XCNT(j)  (256  + 64 * (j))
#define XB_XSUB(j)  (1280 + 64 * (j))
#define XB_XGEN(j)  (2304 + 64 * (j))
#define XB_TOP      3328
#define XB_TOPGEN   3392
#define XCD_BAR_WORDS 3456
#define XB_SPIN_CAP (1u << 18)
#define LAS __attribute__((address_space(3)))

__device__ __forceinline__ unsigned xb_ld(unsigned* p)              { return __hip_atomic_load(p, __ATOMIC_RELAXED, __HIP_MEMORY_SCOPE_AGENT); }
__device__ __forceinline__ unsigned xb_add(unsigned* p, unsigned v) { return __hip_atomic_fetch_add(p, v, __ATOMIC_RELAXED, __HIP_MEMORY_SCOPE_AGENT); }
__device__ __forceinline__ unsigned xb_xcc_id() { return (unsigned)__builtin_amdgcn_s_getreg((3 << 11) | 20) & 0xFu; }
#define XB_SPIN(cond, bar) do { unsigned _sp = 0; while (cond) { __builtin_amdgcn_s_sleep(1); \
    if ((++_sp & 255u) == 0u) { if (xb_ld(&(bar)[XB_TMO])) break; if (_sp > XB_SPIN_CAP) { atomicAdd(&(bar)[XB_TMO], 1u); break; } } } } while (0)

struct XcdBarrier {
    unsigned* bar; unsigned x;
    volatile LAS unsigned* st;
};

__device__ __forceinline__ XcdBarrier xcd_barrier_post(unsigned* bar, volatile LAS unsigned* st) {
    XcdBarrier b; b.bar = bar; b.x = xb_xcc_id(); b.st = st;
    if (threadIdx.x == 0) (void)xb_add(&bar[XB_XCNT(b.x)], 1u);
    return b;
}
__device__ __forceinline__ void xcd_barrier_complete(unsigned* bar, unsigned x, unsigned& nloc, unsigned& nx) {
    const unsigned G = gridDim.x * gridDim.y * gridDim.z;
    unsigned sum, cnt, mine, sp = 0u;
    for (;;) {
        sum = 0u; cnt = 0u; mine = 0u;
#pragma unroll
        for (unsigned j = 0; j < 16; ++j) { const unsigned c = xb_ld(&bar[XB_XCNT(j)]); sum += c; cnt += (c > 0u) ? 1u : 0u; mine = (j == x) ? c : mine; }
        if (sum == G) break;
        __builtin_amdgcn_s_sleep(1);
        if ((++sp & 255u) == 0u) { if (xb_ld(&bar[XB_TMO])) break; if (sp > XB_SPIN_CAP) { atomicAdd(&bar[XB_TMO], 1u); break; } }
    }
    nloc = mine > 0u ? mine : 1u; nx = cnt > 0u ? cnt : 1u;
}

__device__ __forceinline__ void xcd_barrier(const XcdBarrier& b) {
    asm volatile("s_waitcnt vmcnt(0)" ::: "memory");
    __syncthreads();
    if (threadIdx.x == 0) {
        unsigned* bar = b.bar;
        __builtin_amdgcn_s_waitcnt(0);
        unsigned nloc = b.st[0], nx = b.st[1];
        if (nloc == 0u) { xcd_barrier_complete(bar, b.x, nloc, nx); b.st[0] = nloc; b.st[1] = nx; }
        const unsigned old = xb_add(&bar[XB_XSUB(b.x)], 1u);
        const unsigned gen = old / nloc;
        if (old + 1u == (gen + 1u) * nloc) {
            __builtin_amdgcn_fence(__ATOMIC_RELEASE, "agent");
            asm volatile("s_waitcnt vmcnt(0)" ::: "memory");
            const unsigned og = xb_add(&bar[XB_TOP], 1u);
            const unsigned tg = og / nx;
            if (og + 1u == (tg + 1u) * nx) xb_add(&bar[XB_TOPGEN], 1u);
            else XB_SPIN(xb_ld(&bar[XB_TOPGEN]) == tg, bar);
            __builtin_amdgcn_fence(__ATOMIC_ACQUIRE, "agent");
            xb_add(&bar[XB_XGEN(b.x)], 1u);
            asm volatile("s_waitcnt vmcnt(0)" ::: "memory");
        } else {
            XB_SPIN(xb_ld(&bar[XB_XGEN(b.x)]) == gen, bar);
            __builtin_amdgcn_fence(__ATOMIC_ACQUIRE, "agent");
            asm volatile("s_waitcnt vmcnt(0)" ::: "memory");
        }
    }
    __syncthreads();
}
constexpr int D = 2048, NB = 8, SEQ = 2048, NL = 4, T = NB * SEQ;
constexpr int NCH = SEQ / 64, NCHUNK = T / 64;
constexpr int GKW = 512, RANK = 16;
constexpr int INW = 6160, NP = 6144;
constexpr int NE = 16384;
constexpr float ALPHA = 1.6817928305074290f, EPS = 1e-5f;
constexpr int PQ = 0, PK = 512, PV = 1024, PR = 2048, PCB = 3072, PCC = 4096, PCH = 5120;
constexpr int NWAVES = 8, NTHREADS = 512;
#ifndef TAB4
#define TAB4 1
#endif
constexpr int NPHASES = 2 + 7 * NL;

constexpr size_t MiB = 1u << 20;
constexpr size_t WS_CTL = 0, CTL_ZERO_BYTES = 1 * MiB;
constexpr size_t WS_MOD = 1 * MiB, WS_PART = 3 * MiB, WS_KEYS = 15 * MiB, WS_DTOT = 17 * MiB, WS_WIN = 18 * MiB, WS_WOUT = 115 * MiB, WS_WQ = 147 * MiB;
constexpr size_t WS_UT = 179 * MiB, WS_VT = 435 * MiB, WS_H = 691 * MiB, WS_PROJ = 755 * MiB, WS_E = 947 * MiB, WS_OGLA = 979 * MiB, WS_Y = 1043 * MiB;
constexpr size_t WS_Z = 1107 * MiB, WS_X1 = 1235 * MiB, WS_X = 1363 * MiB, WS_Q = 1491 * MiB, WS_H2 = 1555 * MiB, WS_HQ8 = 1619 * MiB, WS_END = 1659 * MiB;
constexpr size_t WS_SU = 17 * MiB + 512 * 1024, WS_SV = 17 * MiB + 768 * 1024, WS_HSC = 2 * MiB + 640 * 1024;
static_assert(WS_WIN + (size_t)NL * INW * D * 2 <= WS_WOUT && WS_PART + (size_t)NL * 8 * NB * 6 * D * 4 <= WS_KEYS && WS_MOD + (size_t)NL * NB * 6 * D * 4 <= WS_PART, "ws map");
constexpr int CW_BAR = 4096;

constexpr int RING_OFF = 0, RING_BYTES = 131072, LDSCTL_OFF = RING_BYTES, LDS_BYTES = 147456;

#define GAS __attribute__((address_space(1)))
typedef unsigned short bf16;
typedef unsigned v4u __attribute__((ext_vector_type(4)));
typedef unsigned v2u __attribute__((ext_vector_type(2)));
typedef float f32x4 __attribute__((ext_vector_type(4)));
typedef float f32x16 __attribute__((ext_vector_type(16)));
typedef short bf16x8 __attribute__((ext_vector_type(8)));
typedef __bf16 bf16x2v __attribute__((ext_vector_type(2)));
#define LDS_WAIT() asm volatile("s_waitcnt lgkmcnt(0)" ::: "memory")

__device__ __forceinline__ unsigned pk2(float lo, float hi) { return pg8::cvt_pk_bf16(lo, hi); }
__device__ __forceinline__ float dot2bf(unsigned w, unsigned x, float acc) { return __builtin_amdgcn_fdot2_f32_bf16(__builtin_bit_cast(bf16x2v, w), __builtin_bit_cast(bf16x2v, x), acc, false); }
__device__ __forceinline__ float bflo(unsigned u) { return __uint_as_float(u << 16); }
__device__ __forceinline__ float bfhi(unsigned u) { return __uint_as_float(u & 0xffff0000u); }
__device__ __forceinline__ float silu_f(float x) { return x / (1.0f + __expf(-x)); }
__device__ __forceinline__ float logsigmoid_f(float x) { return fminf(x, 0.0f) - log1pf(__expf(-fabsf(x))); }
__device__ __forceinline__ float gelu_tanh_f(float x) { const float u = 0.7978845608028654f * (x + 0.044715f * x * x * x); return 0.5f * x * (1.0f + tanhf(u)); }
__device__ __forceinline__ float wave_sum(float v) {
#pragma unroll
    for (int o = 1; o < 64; o <<= 1) v += __shfl_xor(v, o);
    return v;
}

struct Args { const float* in[19]; float* out; unsigned char* ws; int ph_lo, ph_hi; };

__device__ __forceinline__ void transpose_item(const float* W, int ldw, int col0, bf16* WTrows, int k0, int nvalid, LAS float* scr, int lane) {
    const int n = lane & 31;
    float tv[32];
#pragma unroll
    for (int i = 0; i < 32; ++i) { const int kk = 2 * i + (lane >> 5); tv[i] = (n < nvalid) ? W[(size_t)(k0 + kk) * ldw + col0 + n] : 0.f; }
#pragma unroll
    for (int i = 0; i < 32; ++i) { const int kk = 2 * i + (lane >> 5); scr[kk * 33 + n] = tv[i]; }
    LDS_WAIT(); asm volatile("" ::: "memory");
    const int c = lane & 7;
#pragma unroll
    for (int j = 0; j < 4; ++j) { const int nn = (lane >> 3) + 8 * j; const LAS float* s = scr + (8 * c) * 33 + nn;
        v4u o; o.x = pk2(s[0 * 33], s[1 * 33]); o.y = pk2(s[2 * 33], s[3 * 33]); o.z = pk2(s[4 * 33], s[5 * 33]); o.w = pk2(s[6 * 33], s[7 * 33]);
        if (nn < nvalid) *(v4u*)(WTrows + (size_t)nn * D + k0 + 8 * c) = o; }
    LDS_WAIT(); asm volatile("" ::: "memory");
}
__device__ __forceinline__ void cvt_stream(const float* src, bf16* dst, size_t n4, size_t i0, size_t stride) {
    for (size_t i = i0; i < n4; i += stride) { const f32x4 v = ((const f32x4*)src)[i]; v2u o; o.x = pk2(v.x, v.y); o.y = pk2(v.z, v.w); ((v2u*)dst)[i] = o; }
}
__device__ __forceinline__ void ph_prologue_a(const Args& a, LAS unsigned char* lds, int tid, int lane, int wave, int bx, int G) {
    const int gw = bx * NWAVES + wave, NGW = G * NWAVES;
    LAS float* cact = (LAS float*)lds;
    for (int i = tid; i < NB * D; i += NTHREADS) { const int b = i / D, d = i % D; cact[d * 8 + b] = silu_f(a.in[1][i]); }
    __syncthreads();
    float* part = (float*)(a.ws + WS_PART);
    for (int it = gw; it < NL * 8 * 48; it += NGW) {
        const int cg = it % 48, dr = (it / 48) % 8, l = it / 384;
        f32x4 acc[8];
#pragma unroll
        for (int b = 0; b < 8; ++b) acc[b] = (f32x4){0.f, 0.f, 0.f, 0.f};
        const float* w = a.in[2] + ((size_t)l * D + dr * 256) * (6 * D) + cg * 256 + lane * 4;
#pragma unroll 4
        for (int d = 0; d < 256; ++d) {
            const f32x4 wv = *(const f32x4*)(w + (size_t)d * (6 * D));
            const f32x4 c0 = *(const LAS f32x4*)(cact + (dr * 256 + d) * 8), c1 = *(const LAS f32x4*)(cact + (dr * 256 + d) * 8 + 4);
            acc[0] += wv * c0.x; acc[1] += wv * c0.y; acc[2] += wv * c0.z; acc[3] += wv * c0.w;
            acc[4] += wv * c1.x; acc[5] += wv * c1.y; acc[6] += wv * c1.z; acc[7] += wv * c1.w;
        }
#pragma unroll
        for (int b = 0; b < 8; ++b) *(f32x4*)(part + (((size_t)l * 8 + dr) * NB + b) * (6 * D) + cg * 256 + lane * 4) = acc[b];
    }
    __syncthreads();
    LAS float* scr = (LAS float*)(lds + wave * 8448);
    bf16* winT = (bf16*)(a.ws + WS_WIN); bf16* woutT = (bf16*)(a.ws + WS_WOUT); bf16* wqT = (bf16*)(a.ws + WS_WQ);
    constexpr int IPL = 6144 + 32 + 2048 + 2048;
    for (int it = gw; it < NL * IPL; it += NGW) {
        const int l = it / IPL; int r = it % IPL;
        if (r < 6144) { const int nb = r % 192, kb = r / 192, n0 = nb * 32;
            transpose_item(a.in[4] + (size_t)l * D * INW, INW, n0 < 3072 ? n0 : n0 + 16, winT + ((size_t)l * INW + n0) * D, kb * 64, 32, scr, lane); continue; }
        r -= 6144;
        if (r < 32) { transpose_item(a.in[4] + (size_t)l * D * INW, INW, 3072, winT + ((size_t)l * INW + NP) * D, r * 64, 16, scr, lane); continue; }
        r -= 32;
        if (r < 2048) { const int nb = r % 64, kb = r / 64; transpose_item(a.in[10] + (size_t)l * D * D, D, nb * 32, woutT + ((size_t)l * D + nb * 32) * D, kb * 64, 32, scr, lane); continue; }
        r -= 2048;
        { const int nb = r % 64, kb = r / 64; transpose_item(a.in[13] + (size_t)l * D * D, D, nb * 32, wqT + ((size_t)l * D + nb * 32) * D, kb * 64, 32, scr, lane); }
    }
    const size_t i0 = (size_t)bx * NTHREADS + tid, stride = (size_t)G * NTHREADS;
    cvt_stream(a.in[14], (bf16*)(a.ws + WS_KEYS), (size_t)NL * 8 * 2 * 128 * 128 / 4, i0, stride);
#if TAB4
    __syncthreads();
    { LAS float* rowst = (LAS float*)(lds + wave * 8192);
      for (int row = gw; row < 2 * NL * NE; row += NGW) {
        const int tbl = row / (NL * NE), r = row % (NL * NE);
        const float* src = (tbl ? a.in[16] : a.in[15]) + (size_t)r * D;
#pragma unroll
        for (int c8 = 0; c8 < 8; ++c8) *(LAS f32x4*)(rowst + (c8 * 64 + lane) * 4) = *(const f32x4*)(src + (c8 * 64 + lane) * 4);
        LDS_WAIT(); asm volatile("" ::: "memory");
        unsigned char* tb = a.ws + (tbl ? WS_VT : WS_UT) + (size_t)r * 1152;
#pragma unroll
        for (int pass = 0; pass < 2; ++pass) { const int slot = lane + 64 * pass;
            if (slot < 72) { const int col0 = (slot >> 3) * 240 + (slot & 7) * 30;
                float x[30]; float mx = 0.f;
#pragma unroll
                for (int k = 0; k < 30; ++k) { x[k] = (col0 + k < D) ? rowst[col0 + k] : 0.f; mx = fmaxf(mx, fabsf(x[k])); }
                int code = 0; float inv = 0.f;
                if (mx > 0.f) { code = (int)ceilf(8.0f * log2f(mx * (1.0f / 7.0f))) + 128; code = code < 0 ? 0 : (code > 255 ? 255 : code); inv = __builtin_amdgcn_exp2f(16.0f - (float)code * 0.125f); }
                unsigned dw[4] = {0u, 0u, 0u, 0u};
#pragma unroll
                for (int kb = 0; kb < 15; ++kb) { int a0 = (int)__builtin_rintf(x[2 * kb] * inv), a1 = (int)__builtin_rintf(x[2 * kb + 1] * inv);
                    a0 = a0 < -7 ? -7 : (a0 > 7 ? 7 : a0); a1 = a1 < -7 ? -7 : (a1 > 7 ? 7 : a1);
                    dw[kb >> 2] |= ((unsigned)(a0 + 8) | ((unsigned)(a1 + 8) << 4)) << (8 * (kb & 3)); }
                dw[3] |= (unsigned)code << 24;
                *(v4u*)(tb + slot * 16) = (v4u){dw[0], dw[1], dw[2], dw[3]}; } }
        LDS_WAIT(); asm volatile("" ::: "memory");
      } }
#else
    for (int row = gw; row < 2 * NL * NE; row += NGW) {
        const int tbl = row / (NL * NE), r = row % (NL * NE);
        const float* src = (tbl ? a.in[16] : a.in[15]) + (size_t)r * D;
        f32x4 v[8]; float mx = 0.f;
#pragma unroll
        for (int c8 = 0; c8 < 8; ++c8) { v[c8] = *(const f32x4*)(src + (c8 * 64 + lane) * 4); mx = fmaxf(mx, fmaxf(fmaxf(fabsf(v[c8].x), fabsf(v[c8].y)), fmaxf(fabsf(v[c8].z), fabsf(v[c8].w)))); }
#pragma unroll
        for (int o = 1; o < 64; o <<= 1) mx = fmaxf(mx, __shfl_xor(mx, o));
        const float inv = mx > 0.f ? 127.0f / mx : 0.f; const int off = tbl ? 128 : 0;
        unsigned dw[8];
#pragma unroll
        for (int c8 = 0; c8 < 8; ++c8) { const int q0 = (int)__builtin_rintf(v[c8].x * inv) + off, q1 = (int)__builtin_rintf(v[c8].y * inv) + off, q2 = (int)__builtin_rintf(v[c8].z * inv) + off, q3 = (int)__builtin_rintf(v[c8].w * inv) + off;
            dw[c8] = (unsigned)(q0 & 255) | ((unsigned)(q1 & 255) << 8) | ((unsigned)(q2 & 255) << 16) | ((unsigned)(q3 & 255) << 24); }
        unsigned char* dst = a.ws + (tbl ? WS_VT : WS_UT) + (size_t)r * D;
        *(v4u*)(dst + lane * 16) = (v4u){dw[0], dw[1], dw[2], dw[3]}; *(v4u*)(dst + (64 + lane) * 16) = (v4u){dw[4], dw[5], dw[6], dw[7]};
        if (lane == 0) ((float*)(a.ws + (tbl ? WS_SV : WS_SU)))[r] = mx * (1.0f / 127.0f);
    }
#endif
}

__device__ __forceinline__ void ln_tail(const float (&z)[32], int t, int lane, const float* g, const float* bta, float* xout, const float* sh, const float* sc, bf16* hout, unsigned char* q8, float* q8s, LAS unsigned char* q8stage = nullptr) {
    float s = 0.f;
#pragma unroll
    for (int i = 0; i < 32; ++i) s += z[i];
    const float mu = wave_sum(s) * (1.0f / D);
    float q = 0.f;
#pragma unroll
    for (int i = 0; i < 32; ++i) { const float d = z[i] - mu; q += d * d; }
    const float rs = rsqrtf(wave_sum(q) * (1.0f / D) + EPS);
    float hv[32]; float mx = 0.f;
#pragma unroll
    for (int c = 0; c < 8; ++c) { const int col = (c * 64 + lane) * 4;
        const f32x4 g0 = *(const f32x4*)(g + col), b0 = *(const f32x4*)(bta + col);
        f32x4 x0;
        x0.x = (z[c * 4 + 0] - mu) * rs * g0.x + b0.x; x0.y = (z[c * 4 + 1] - mu) * rs * g0.y + b0.y; x0.z = (z[c * 4 + 2] - mu) * rs * g0.z + b0.z; x0.w = (z[c * 4 + 3] - mu) * rs * g0.w + b0.w;
        if (xout) *(f32x4*)(xout + (size_t)t * D + col) = x0;
        if (hout) { const f32x4 s0 = *(const f32x4*)(sc + col), h0 = *(const f32x4*)(sh + col);
            hv[c * 4] = x0.x * (1.f + s0.x) + h0.x; hv[c * 4 + 1] = x0.y * (1.f + s0.y) + h0.y; hv[c * 4 + 2] = x0.z * (1.f + s0.z) + h0.z; hv[c * 4 + 3] = x0.w * (1.f + s0.w) + h0.w;
            v2u o; o.x = pk2(hv[c * 4], hv[c * 4 + 1]); o.y = pk2(hv[c * 4 + 2], hv[c * 4 + 3]);
            *(v2u*)(hout + (size_t)t * D + col) = o;
            if (q8) {
                hv[c * 4] = bflo(o.x); hv[c * 4 + 1] = bfhi(o.x); hv[c * 4 + 2] = bflo(o.y); hv[c * 4 + 3] = bfhi(o.y);
                mx = fmaxf(mx, fmaxf(fmaxf(fabsf(hv[c * 4]), fabsf(hv[c * 4 + 1])), fmaxf(fabsf(hv[c * 4 + 2]), fabsf(hv[c * 4 + 3])))); } }
    }
    if (q8) {
#pragma unroll
        for (int o = 1; o < 64; o <<= 1) mx = fmaxf(mx, __shfl_xor(mx, o));
        const float qmax_ = TAB4 ? 119.0f : 127.0f;
        const float inv = mx > 0.f ? qmax_ / mx : 0.f;
        unsigned dw[8];
#pragma unroll
        for (int c = 0; c < 8; ++c) { const int q0 = (int)__builtin_rintf(hv[c * 4] * inv), q1 = (int)__builtin_rintf(hv[c * 4 + 1] * inv), q2 = (int)__builtin_rintf(hv[c * 4 + 2] * inv), q3 = (int)__builtin_rintf(hv[c * 4 + 3] * inv);
            dw[c] = (unsigned)(q0 & 255) | ((unsigned)(q1 & 255) << 8) | ((unsigned)(q2 & 255) << 16) | ((unsigned)(q3 & 255) << 24); }
#if TAB4
        { LAS unsigned* st32 = (LAS unsigned*)q8stage; LAS unsigned char* st8 = (LAS unsigned char*)q8stage;
#pragma unroll
          for (int i = 0; i < 9; ++i) st32[lane + 64 * i] = 0u;
          LDS_WAIT(); asm volatile("" ::: "memory");
#pragma unroll
          for (int c = 0; c < 8; ++c)
#pragma unroll
              for (int jp = 0; jp < 2; ++jp) { const int col = (c * 64 + lane) * 4 + 2 * jp, u = col / 240, r = col - u * 240, l7 = r / 30, k = r - l7 * 30;
                  const int q0 = (int)(signed char)((dw[c] >> (16 * jp)) & 255u), q1 = (int)(signed char)((dw[c] >> (16 * jp + 8)) & 255u);
                  const int l0 = ((q0 + 8) & 15) - 8, l1 = ((q1 + 8) & 15) - 8, h0 = (q0 - l0) >> 4, h1 = (q1 - l1) >> 4;
                  LAS unsigned char* sp = st8 + (u * 8 + l7) * 32 + (k >> 1);
                  sp[0] = (unsigned char)((l0 & 15) | ((l1 & 15) << 4)); sp[16] = (unsigned char)((h0 & 15) | ((h1 & 15) << 4)); }
          LDS_WAIT(); asm volatile("" ::: "memory");
          unsigned* d32 = (unsigned*)(q8 + (size_t)t * 2304);
#pragma unroll
          for (int i = 0; i < 9; ++i) d32[lane + 64 * i] = st32[lane + 64 * i];
          LDS_WAIT(); asm volatile("" ::: "memory"); }
#else
        unsigned char* dst = q8 + (size_t)t * D;
        *(v4u*)(dst + lane * 16) = (v4u){dw[0], dw[1], dw[2], dw[3]}; *(v4u*)(dst + (64 + lane) * 16) = (v4u){dw[4], dw[5], dw[6], dw[7]};
#endif
        if (lane == 0) q8s[t] = mx / qmax_;
    }
}

__device__ __forceinline__ void ph_prologue_b(const Args& a, LAS unsigned char* lds, int tid, int lane, int wave, int bx, int G) {
    const float* part = (const float*)(a.ws + WS_PART); float* mod = (float*)(a.ws + WS_MOD);
    for (int i = bx * NTHREADS + tid; i < NL * NB * 6 * D / 4; i += G * NTHREADS) {
        const int idx = i * 4, e = idx % (6 * D), b = (idx / (6 * D)) % NB, l = idx / (6 * D * NB);
        f32x4 s = *(const f32x4*)(a.in[3] + l * 6 * D + e);
#pragma unroll
        for (int dr = 0; dr < 8; ++dr) s += *(const f32x4*)(part + (((size_t)l * 8 + dr) * NB + b) * (6 * D) + e);
        *(f32x4*)(mod + idx) = s;
    }
    LAS float* msh = (LAS float*)lds;
    bf16* hbuf = (bf16*)(a.ws + WS_H);
    for (int ch = bx; ch < NCHUNK; ch += G) {
        const int b = ch / NCH;
        for (int i = tid; i < 1024; i += NTHREADS) { const int e = i * 4;
            f32x4 s = *(const f32x4*)(a.in[3] + e);
#pragma unroll
            for (int dr = 0; dr < 8; ++dr) s += *(const f32x4*)(part + (((size_t)0 * 8 + dr) * NB + b) * (6 * D) + e);
            *(LAS f32x4*)(msh + e) = s; }
        __syncthreads();
        for (int i = 0; i < 8; ++i) { const int t = ch * 64 + wave * 8 + i;
#pragma unroll
            for (int c = 0; c < 4; ++c) { const int col = (c * 64 + lane) * 8;
                const f32x4 x0 = *(const f32x4*)(a.in[0] + (size_t)t * D + col), x1 = *(const f32x4*)(a.in[0] + (size_t)t * D + col + 4);
                const f32x4 h0 = *(const LAS f32x4*)(msh + col), h1 = *(const LAS f32x4*)(msh + col + 4), s0 = *(const LAS f32x4*)(msh + 2048 + col), s1 = *(const LAS f32x4*)(msh + 2048 + col + 4);
                v4u o; o.x = pk2(x0.x * (1.f + s0.x) + h0.x, x0.y * (1.f + s0.y) + h0.y); o.y = pk2(x0.z * (1.f + s0.z) + h0.z, x0.w * (1.f + s0.w) + h0.w);
                o.z = pk2(x1.x * (1.f + s1.x) + h1.x, x1.y * (1.f + s1.y) + h1.y); o.w = pk2(x1.z * (1.f + s1.z) + h1.z, x1.w * (1.f + s1.w) + h1.w);
                *(v4u*)(hbuf + (size_t)t * D + col) = o; } }
        __syncthreads();
    }
}

__device__ __forceinline__ void gate_prep(const Args& a, int l, LAS unsigned char* lds, int tid, int lane, int wave, int ch) {
    const bf16* hbuf = (const bf16*)(a.ws + WS_H); const bf16* waT = (const bf16*)(a.ws + WS_WIN) + ((size_t)l * INW + NP) * D;
    float* Ebuf = (float*)(a.ws + WS_E); float* dtot = (float*)(a.ws + WS_DTOT);
    const int t0 = ch * 64, l15 = lane & 15, lq = lane >> 4, mt = wave & 3, kh = wave >> 2;
    f32x4 acc = (f32x4){0.f, 0.f, 0.f, 0.f};
    const bf16* hA = hbuf + (size_t)(t0 + 16 * mt + l15) * D + kh * 1024 + 8 * lq;
    const bf16* wB = waT + (size_t)l15 * D + kh * 1024 + 8 * lq;
#pragma unroll 8
    for (int ks = 0; ks < 32; ++ks) { const bf16x8 av = *(const bf16x8*)(hA + 32 * ks), bv = *(const bf16x8*)(wB + 32 * ks); acc = __builtin_amdgcn_mfma_f32_16x16x32_bf16(av, bv, acc, 0, 0, 0); }
    LAS float* alr = (LAS float*)lds;
#pragma unroll
    for (int r = 0; r < 4; ++r) alr[(kh * 64 + 16 * mt + 4 * lq + r) * 16 + l15] = acc[r];
    __syncthreads();
    const int col = tid;
    float wg[16];
#pragma unroll
    for (int r = 0; r < 16; ++r) wg[r] = a.in[5][((size_t)l * RANK + r) * GKW + col];
    const float bgc = a.in[6][l * GKW + col];
    float tot = 0.f;
    for (int j = 0; j < 64; ++j) { float lg = bgc;
#pragma unroll
        for (int r4 = 0; r4 < 4; ++r4) { const f32x4 p = *(const LAS f32x4*)(alr + j * 16 + r4 * 4), q = *(const LAS f32x4*)(alr + (64 + j) * 16 + r4 * 4);
            lg += (p.x + q.x) * wg[r4 * 4] + (p.y + q.y) * wg[r4 * 4 + 1] + (p.z + q.z) * wg[r4 * 4 + 2] + (p.w + q.w) * wg[r4 * 4 + 3]; }
        tot += logsigmoid_f(lg) * (1.0f / 16.0f); }
    float run = 0.f;
    for (int j = 0; j < 64; ++j) { float lg = bgc;
#pragma unroll
        for (int r4 = 0; r4 < 4; ++r4) { const f32x4 p = *(const LAS f32x4*)(alr + j * 16 + r4 * 4), q = *(const LAS f32x4*)(alr + (64 + j) * 16 + r4 * 4);
            lg += (p.x + q.x) * wg[r4 * 4] + (p.y + q.y) * wg[r4 * 4 + 1] + (p.z + q.z) * wg[r4 * 4 + 2] + (p.w + q.w) * wg[r4 * 4 + 3]; }
        run += logsigmoid_f(lg) * (1.0f / 16.0f);
        Ebuf[(size_t)(t0 + j) * GKW + col] = __expf(tot - run); }
    dtot[(size_t)ch * GKW + col] = __expf(tot);
    __syncthreads();
}

__device__ __forceinline__ void gla_unit(const Args& a, LAS unsigned char* lds, int tid, int lane, int wave, int un) {
    const bf16* proj = (const bf16*)(a.ws + WS_PROJ); const float* Ebuf = (const float*)(a.ws + WS_E); const float* dtot = (const float*)(a.ws + WS_DTOT); bf16* ogla = (bf16*)(a.ws + WS_OGLA);
    const int pair_ = (un & 7) * 4 + (un >> 6), dvs = (un >> 3) & 7, hh = pair_ & 3, b = pair_ >> 2;
    LAS bf16* kdT = (LAS bf16*)lds;
    LAS bf16* vT = (LAS bf16*)(lds + 18432);
    LAS bf16* ST = (LAS bf16*)(lds + 18432 + 4608);
    const int l15 = lane & 15, lq = lane >> 4, jl = tid >> 3, d16 = (tid & 7) * 16, dv4 = (tid & 7) * 4, jt = (wave & 3) * 16, dvt = (wave >> 2) * 16;
#define GLA_BAR() do { asm volatile("s_waitcnt lgkmcnt(0)" ::: "memory"); __builtin_amdgcn_s_barrier(); asm volatile("" ::: "memory"); } while (0)
    f32x4 S0 = (f32x4){0.f, 0.f, 0.f, 0.f}, S1 = (f32x4){0.f, 0.f, 0.f, 0.f};
    v4u kn0[2], kn1[2]; f32x4 en0[4], en1[4]; v2u vn0, vn1; bf16x8 qn0[4], qn1[4], qc[4]; f32x4 dn0, dn1, dc;
#define GLA_LOAD(c, kn, en, vn, qn, dn) do { const int t0c = b * SEQ + (c) * 64; const bf16* pr = proj + (size_t)(t0c + jl) * NP; \
        kn[0] = *(const v4u*)(pr + PK + hh * 128 + d16); kn[1] = *(const v4u*)(pr + PK + hh * 128 + d16 + 8); \
        _Pragma("unroll") for (int i_ = 0; i_ < 4; ++i_) en[i_] = *(const f32x4*)(Ebuf + (size_t)(t0c + jl) * GKW + hh * 128 + d16 + 4 * i_); \
        vn = *(const v2u*)(pr + PV + hh * 256 + dvs * 32 + dv4); \
        _Pragma("unroll") for (int ks_ = 0; ks_ < 4; ++ks_) qn[ks_] = *(const bf16x8*)(proj + (size_t)(t0c + jt + l15) * NP + PQ + hh * 128 + 32 * ks_ + 8 * lq); \
        dn = *(const f32x4*)(dtot + (size_t)(b * NCH + (c)) * GKW + hh * 128 + 16 * wave + 4 * lq); } while (0)
#define GLA_PREP(kn, en, vn, qn, dn) do { \
        _Pragma("unroll") for (int i_ = 0; i_ < 16; ++i_) { const unsigned w_ = kn[i_ >> 3][(i_ & 7) >> 1]; const float kf_ = (i_ & 1) ? bfhi(w_) : bflo(w_); \
            kdT[(d16 + i_) * 72 + ((((jl >> 3) ^ (d16 >> 4)) & 7) << 3) + (jl & 7)] = (bf16)(pk2(kf_ * en[i_ >> 2][i_ & 3], 0.f) & 0xffffu); } \
        _Pragma("unroll") for (int i_ = 0; i_ < 4; ++i_) { const unsigned w_ = vn[i_ >> 1]; vT[(dv4 + i_) * 72 + jl] = (bf16)((i_ & 1) ? (w_ >> 16) : (w_ & 0xffffu)); } \
        _Pragma("unroll") for (int ks_ = 0; ks_ < 4; ++ks_) qc[ks_] = qn[ks_]; \
        dc = dn; } while (0)
#define GLA_BODY(c) do { \
        S0 = S0 * dc; S1 = S1 * dc; \
        _Pragma("unroll") for (int ks = 0; ks < 2; ++ks) { \
            const bf16x8 A_ = *(const LAS bf16x8*)(kdT + (16 * wave + l15) * 72 + ((((4 * ks + lq) ^ wave) & 7) << 3)); \
            const bf16x8 B0_ = *(const LAS bf16x8*)(vT + l15 * 72 + 32 * ks + 8 * lq), B1_ = *(const LAS bf16x8*)(vT + (16 + l15) * 72 + 32 * ks + 8 * lq); \
            S0 = __builtin_amdgcn_mfma_f32_16x16x32_bf16(A_, B0_, S0, 0, 0, 0); S1 = __builtin_amdgcn_mfma_f32_16x16x32_bf16(A_, B1_, S1, 0, 0, 0); } \
        { v2u w0_, w1_; w0_.x = pk2(S0.x, S0.y); w0_.y = pk2(S0.z, S0.w); w1_.x = pk2(S1.x, S1.y); w1_.y = pk2(S1.z, S1.w); \
          *(LAS v2u*)(ST + l15 * 136 + 16 * wave + 4 * lq) = w0_; *(LAS v2u*)(ST + (16 + l15) * 136 + 16 * wave + 4 * lq) = w1_; } \
        GLA_BAR(); \
        f32x4 O_ = (f32x4){0.f, 0.f, 0.f, 0.f}; \
        _Pragma("unroll") for (int ks = 0; ks < 4; ++ks) { const bf16x8 A_ = *(const LAS bf16x8*)(ST + (dvt + l15) * 136 + 32 * ks + 8 * lq); O_ = __builtin_amdgcn_mfma_f32_16x16x32_bf16(A_, qc[ks], O_, 0, 0, 0); } \
        { const f32x4 Os_ = O_ * 0.08838834764831845f; v2u ob_; ob_.x = pk2(Os_.x, Os_.y); ob_.y = pk2(Os_.z, Os_.w); \
          *(v2u*)(ogla + (size_t)(b * SEQ + (c) * 64 + jt + l15) * 1024 + hh * 256 + dvs * 32 + dvt + 4 * lq) = ob_; } } while (0)
    GLA_LOAD(0, kn0, en0, vn0, qn0, dn0); GLA_LOAD(1, kn1, en1, vn1, qn1, dn1);
    GLA_PREP(kn0, en0, vn0, qn0, dn0);
    GLA_BAR();
    for (int c = 0; c < NCH; c += 2) {
        { const int cn_ = c + 2 < NCH ? c + 2 : NCH - 1; GLA_LOAD(cn_, kn0, en0, vn0, qn0, dn0); }
        GLA_BODY(c);
        GLA_PREP(kn1, en1, vn1, qn1, dn1);
        GLA_BAR();
        { const int cn_ = c + 3 < NCH ? c + 3 : NCH - 1; GLA_LOAD(cn_, kn1, en1, vn1, qn1, dn1); }
        GLA_BODY(c + 1);
        GLA_PREP(kn0, en0, vn0, qn0, dn0);
        GLA_BAR();
    }
#undef GLA_BODY
#undef GLA_BAR
#undef GLA_LOAD
#undef GLA_PREP
}

__device__ __forceinline__ void unpack16(const v4u& p0, const v4u& p1, float (&o)[16]) {
#pragma unroll
    for (int j = 0; j < 4; ++j) { o[2 * j] = bflo(p0[j]); o[2 * j + 1] = bfhi(p0[j]); o[8 + 2 * j] = bflo(p1[j]); o[8 + 2 * j + 1] = bfhi(p1[j]); }
}
__device__ __forceinline__ void mixpost_chunk(const Args& a, int l, int lane, int wave, int ch) {
    const bf16* proj = (const bf16*)(a.ws + WS_PROJ); const bf16* ogla = (const bf16*)(a.ws + WS_OGLA); bf16* ybuf = (bf16*)(a.ws + WS_Y);
    const int c0 = 16 * lane, tfirst = ch * 64 + wave * 8, sfirst = tfirst % SEQ;
    float gn[16], cw0[16], cw1[16], cw2[16], cn[16], u1[16], u2[16];
#pragma unroll
    for (int i = 0; i < 16; ++i) { gn[i] = a.in[7][l * 256 + ((c0 + i) & 255)]; cw0[i] = a.in[8][(size_t)l * 3072 + c0 + i]; cw1[i] = a.in[8][(size_t)l * 3072 + 1024 + c0 + i];
        cw2[i] = a.in[8][(size_t)l * 3072 + 2048 + c0 + i]; cn[i] = a.in[9][l * 1024 + c0 + i]; u1[i] = 0.f; u2[i] = 0.f; }
    if (sfirst >= 2) {
        float cc[16], chh[16];
        { const bf16* pr = proj + (size_t)(tfirst - 2) * NP; unpack16(*(const v4u*)(pr + PCC + c0), *(const v4u*)(pr + PCC + c0 + 8), cc); unpack16(*(const v4u*)(pr + PCH + c0), *(const v4u*)(pr + PCH + c0 + 8), chh); }
#pragma unroll
        for (int i = 0; i < 16; ++i) u2[i] = cc[i] * chh[i];
        { const bf16* pr = proj + (size_t)(tfirst - 1) * NP; unpack16(*(const v4u*)(pr + PCC + c0), *(const v4u*)(pr + PCC + c0 + 8), cc); unpack16(*(const v4u*)(pr + PCH + c0), *(const v4u*)(pr + PCH + c0 + 8), chh); }
#pragma unroll
        for (int i = 0; i < 16; ++i) u1[i] = cc[i] * chh[i];
    }
#pragma unroll 2
    for (int it = 0; it < 8; ++it) { const int t = tfirst + it; const bf16* pr = proj + (size_t)t * NP;
        float o[16], r[16], cb[16], cc[16], chh[16];
        unpack16(*(const v4u*)(ogla + (size_t)t * 1024 + c0), *(const v4u*)(ogla + (size_t)t * 1024 + c0 + 8), o);
        unpack16(*(const v4u*)(pr + PR + c0), *(const v4u*)(pr + PR + c0 + 8), r);
        unpack16(*(const v4u*)(pr + PCB + c0), *(const v4u*)(pr + PCB + c0 + 8), cb);
        unpack16(*(const v4u*)(pr + PCC + c0), *(const v4u*)(pr + PCC + c0 + 8), cc);
        unpack16(*(const v4u*)(pr + PCH + c0), *(const v4u*)(pr + PCH + c0 + 8), chh);
        float ss = 0.f;
#pragma unroll
        for (int i = 0; i < 16; ++i) ss += o[i] * o[i];
        ss += __shfl_xor(ss, 1); ss += __shfl_xor(ss, 2); ss += __shfl_xor(ss, 4); ss += __shfl_xor(ss, 8);
        const float rg = rsqrtf(ss * (1.0f / 256.f) + EPS);
        float val[16]; float s2 = 0.f;
#pragma unroll
        for (int i = 0; i < 16; ++i) { const float u0 = cc[i] * chh[i]; val[i] = cb[i] * (cw0[i] * u2[i] + cw1[i] * u1[i] + cw2[i] * u0); s2 += val[i] * val[i]; u2[i] = u1[i]; u1[i] = u0; }
        const float rc = rsqrtf(wave_sum(s2) * (1.0f / 1024.f) + EPS);
        v4u y0, y1, y2, y3;
#pragma unroll
        for (int j = 0; j < 4; ++j) {
            y0[j] = pk2(o[2 * j] * rg * gn[2 * j] * silu_f(r[2 * j]), o[2 * j + 1] * rg * gn[2 * j + 1] * silu_f(r[2 * j + 1]));
            y1[j] = pk2(o[8 + 2 * j] * rg * gn[8 + 2 * j] * silu_f(r[8 + 2 * j]), o[9 + 2 * j] * rg * gn[9 + 2 * j] * silu_f(r[9 + 2 * j]));
            y2[j] = pk2(val[2 * j] * rc * cn[2 * j], val[2 * j + 1] * rc * cn[2 * j + 1]);
            y3[j] = pk2(val[8 + 2 * j] * rc * cn[8 + 2 * j], val[9 + 2 * j] * rc * cn[9 + 2 * j]); }
        bf16* yr = ybuf + (size_t)t * D;
        *(v4u*)(yr + c0) = y0; *(v4u*)(yr + c0 + 8) = y1; *(v4u*)(yr + 1024 + c0) = y2; *(v4u*)(yr + 1024 + c0 + 8) = y3;
    }
}

__device__ __forceinline__ void ln1_chunk(const Args& a, int l, LAS unsigned char* lds, int lane, int wave, int ch) {
    const float* zbuf = (const float*)(a.ws + WS_Z); const float* mod = (const float*)(a.ws + WS_MOD);
    const int b = ch / NCH; const float* mb = mod + ((size_t)l * NB + b) * 6 * D;
#pragma unroll 2
    for (int it = 0; it < 8; ++it) { const int t = ch * 64 + wave * 8 + it;
        float z[32];
#pragma unroll
        for (int c = 0; c < 8; ++c) { const f32x4 v0 = *(const f32x4*)(zbuf + (size_t)t * D + (c * 64 + lane) * 4); z[c * 4] = v0.x; z[c * 4 + 1] = v0.y; z[c * 4 + 2] = v0.z; z[c * 4 + 3] = v0.w; }
        ln_tail(z, t, lane, a.in[11] + (size_t)l * D, a.in[12] + (size_t)l * D, (float*)(a.ws + WS_X1), mb + 3 * D, mb + 4 * D, (bf16*)(a.ws + WS_H2), a.ws + WS_HQ8, (float*)(a.ws + WS_HSC), lds + wave * 2304);
    }
}

template <int N> __device__ __forceinline__ void bitonic_sort_desc(float (&v)[N]) {
#pragma unroll
    for (int k = 2; k <= N; k <<= 1)
#pragma unroll
        for (int j = k >> 1; j > 0; j >>= 1)
#pragma unroll
            for (int i = 0; i < N; ++i) { const int p = i ^ j; if (p > i) { const bool desc = ((i & k) == 0); const float x = v[i], y = v[p]; const float mx = fmaxf(x, y), mn = fminf(x, y); v[i] = desc ? mx : mn; v[p] = desc ? mn : mx; } }
}
__device__ __forceinline__ void merge_top16(float (&x)[16], const float (&y)[16]) {
#pragma unroll
    for (int i = 0; i < 16; ++i) x[i] = fmaxf(x[i], y[15 - i]);
#pragma unroll
    for (int j = 8; j > 0; j >>= 1)
#pragma unroll
        for (int i = 0; i < 16; ++i) { const int p = i ^ j; if (p > i) { const float u = x[i], w = x[p]; x[i] = fmaxf(u, w); x[p] = fminf(u, w); } }
}
__device__ __forceinline__ void ce_desc(float& ka, int& pa, float& kb, int& pb) { const bool sw = kb > ka; const float k0 = sw ? kb : ka, k1 = sw ? ka : kb; const int p0 = sw ? pb : pa, p1 = sw ? pa : pb; ka = k0; pa = p0; kb = k1; pb = p1; }
__device__ __forceinline__ void bitonic_sort_desc_kp(float (&k)[16], int (&p)[16]) {
#pragma unroll
    for (int kk = 2; kk <= 16; kk <<= 1)
#pragma unroll
        for (int j = kk >> 1; j > 0; j >>= 1)
#pragma unroll
            for (int i = 0; i < 16; ++i) { const int q = i ^ j; if (q > i) { if ((i & kk) == 0) ce_desc(k[i], p[i], k[q], p[q]); else ce_desc(k[q], p[q], k[i], p[i]); } }
}
__device__ __forceinline__ void merge_top16_kp(float (&k)[16], int (&p)[16], const float (&k2)[16], const int (&p2)[16]) {
#pragma unroll
    for (int i = 0; i < 16; ++i) { const bool sw = k2[15 - i] > k[i]; k[i] = sw ? k2[15 - i] : k[i]; p[i] = sw ? p2[15 - i] : p[i]; }
#pragma unroll
    for (int j = 8; j > 0; j >>= 1)
#pragma unroll
        for (int i = 0; i < 16; ++i) { const int q = i ^ j; if (q > i) ce_desc(k[i], p[i], k[q], p[q]); }
}
__device__ constexpr int cand_i(int s) { return s < 16 ? 0 : s < 24 ? 1 : s < 29 ? 2 : s < 33 ? 3 : s < 36 ? 4 : s < 38 ? 5 : s < 40 ? 6 : s < 42 ? 7 : s < 50 ? s - 34 : -1; }
__device__ constexpr int cand_j(int s) { return s < 16 ? s : s < 24 ? s - 16 : s < 29 ? s - 24 : s < 33 ? s - 29 : s < 36 ? s - 33 : s < 38 ? s - 36 : s < 40 ? s - 38 : s < 42 ? s - 40 : s < 50 ? 0 : -1; }

__device__ __forceinline__ void peer_retrieve(const Args& a, int l, LAS unsigned char* lds, int lane, int wave, int ch) {
    const bf16* qbuf = (const bf16*)(a.ws + WS_Q); const bf16* keys = (const bf16*)(a.ws + WS_KEYS) + ((size_t)(l * 8 + wave) * 2) * 128 * 128;
    LAS int* eg_e = (LAS int*)lds; LAS float* eg_g = (LAS float*)(lds + 32768);
    const int l31 = lane & 31, l5 = lane >> 5, h = wave, t0 = ch * 64;
    for (int tt = 0; tt < 2; ++tt) {
        float sv[2][16];
#pragma unroll
        for (int p = 0; p < 2; ++p) {
            f32x16 acc[4];
#pragma unroll
            for (int nt = 0; nt < 4; ++nt)
#pragma unroll
                for (int r = 0; r < 16; ++r) acc[nt][r] = 0.f;
            const bf16* qp = qbuf + (size_t)(t0 + 32 * tt + l31) * D + h * 256 + p * 128 + 8 * l5;
            const bf16* kp = keys + (size_t)(p * 128 + l31) * 128 + 8 * l5;
#pragma unroll 2
            for (int ks = 0; ks < 8; ++ks) { const bf16x8 bq = *(const bf16x8*)(qp + 16 * ks);
#pragma unroll
                for (int nt = 0; nt < 4; ++nt) { const bf16x8 ak = *(const bf16x8*)(kp + (size_t)(32 * nt) * 128 + 16 * ks); acc[nt] = __builtin_amdgcn_mfma_f32_32x32x16_bf16(ak, bq, acc[nt], 0, 0, 0); } }
            float v[4][16];
#pragma unroll
            for (int nt = 0; nt < 4; ++nt)
#pragma unroll
                for (int r = 0; r < 16; ++r) { const unsigned idx = 32u * nt + (r & 3) + 8u * (r >> 2) + 4u * l5; v[nt][r] = __uint_as_float((__float_as_uint(acc[nt][r]) & 0xffffff80u) | idx); }
#pragma unroll
            for (int nt = 0; nt < 4; ++nt) bitonic_sort_desc<16>(v[nt]);
            merge_top16(v[0], v[1]); merge_top16(v[2], v[3]); merge_top16(v[0], v[2]);
            float o[16];
#pragma unroll
            for (int i = 0; i < 16; ++i) o[i] = __shfl_xor(v[0][i], 32);
            merge_top16(v[0], o);
#pragma unroll
            for (int i = 0; i < 16; ++i) sv[p][i] = v[0][i];
        }
        LAS unsigned char* idxb = (LAS unsigned char*)(lds + 69632) + wave * 2048 + lane * 32;
        { v4u w0, w1;
#pragma unroll
          for (int q4 = 0; q4 < 4; ++q4) {
              w0[q4] = (__float_as_uint(sv[0][4 * q4]) & 127u) | ((__float_as_uint(sv[0][4 * q4 + 1]) & 127u) << 8) | ((__float_as_uint(sv[0][4 * q4 + 2]) & 127u) << 16) | ((__float_as_uint(sv[0][4 * q4 + 3]) & 127u) << 24);
              w1[q4] = (__float_as_uint(sv[1][4 * q4]) & 127u) | ((__float_as_uint(sv[1][4 * q4 + 1]) & 127u) << 8) | ((__float_as_uint(sv[1][4 * q4 + 2]) & 127u) << 16) | ((__float_as_uint(sv[1][4 * q4 + 3]) & 127u) << 24); }
          *(LAS v4u*)(idxb) = w0; *(LAS v4u*)(idxb + 16) = w1; }
        float ck[4][16];
#pragma unroll
        for (int s = 0; s < 64; ++s) {
            if (cand_i(s) >= 0) { const unsigned b0 = __float_as_uint(sv[0][cand_i(s) < 0 ? 0 : cand_i(s)]), b1 = __float_as_uint(sv[1][cand_j(s) < 0 ? 0 : cand_j(s)]);
                const float sum = __uint_as_float(b0 & 0xffffff80u) + __uint_as_float(b1 & 0xffffff80u);
                ck[s >> 4][s & 15] = __uint_as_float((__float_as_uint(sum) & 0xffffff00u) | (unsigned)((cand_i(s) < 0 ? 0 : cand_i(s)) * 16 + (cand_j(s) < 0 ? 0 : cand_j(s)))); }
            else ck[s >> 4][s & 15] = -3.0e38f; }
        bitonic_sort_desc<16>(ck[1]); bitonic_sort_desc<16>(ck[2]);
        merge_top16(ck[0], ck[1]); merge_top16(ck[2], ck[3]); merge_top16(ck[0], ck[2]);
        LDS_WAIT(); asm volatile("" ::: "memory");
        float ex[16]; int ce[16]; float den = 0.f;
        const float cmax = __uint_as_float(__float_as_uint(ck[0][0]) & 0xffffff00u);
#pragma unroll
        for (int i = 0; i < 16; ++i) { const unsigned bits = __float_as_uint(ck[0][i]); ex[i] = __expf(__uint_as_float(bits & 0xffffff00u) - cmax); den += ex[i];
            ce[i] = (int)idxb[(bits >> 4) & 15u] * 128 + (int)idxb[16 + (bits & 15u)]; }
        const float inv = 1.0f / den;
        if (l5 == 0) {
            const int base = (32 * tt + l31) * 128 + h * 16;
#pragma unroll
            for (int i4 = 0; i4 < 4; ++i4) { *(LAS v4u*)(eg_e + base + 4 * i4) = (v4u){(unsigned)ce[4 * i4], (unsigned)ce[4 * i4 + 1], (unsigned)ce[4 * i4 + 2], (unsigned)ce[4 * i4 + 3]};
                *(LAS f32x4*)(eg_g + base + 4 * i4) = (f32x4){ex[4 * i4] * inv, ex[4 * i4 + 1] * inv, ex[4 * i4 + 2] * inv, ex[4 * i4 + 3] * inv}; }
        }
        LDS_WAIT(); asm volatile("" ::: "memory");
    }
}

typedef unsigned char uc4 __attribute__((ext_vector_type(4)));
constexpr int NSLICE = 16, SLICE_SHIFT = 10;
__device__ __forceinline__ int sdot4i(unsigned w, unsigned x, int acc) { return __builtin_amdgcn_sdot4((int)w, (int)x, acc, false); }
__device__ __forceinline__ void fma_ub4(unsigned w, float s, float& y0, float& y1, float& y2, float& y3) { const uc4 b = __builtin_bit_cast(uc4, w); y0 += s * (float)b.x; y1 += s * (float)b.y; y2 += s * (float)b.z; y3 += s * (float)b.w; }
#if TAB4
__device__ __forceinline__ void peer_tail(const Args& a, int l, int t, int lane, const bf16* Yrow, const float* mb, const float* mbn, bool last) {
    const float* x1buf = (const float*)(a.ws + WS_X1);
    float z[32];
#pragma unroll
    for (int c8 = 0; c8 < 8; ++c8) { const int col = (c8 * 64 + lane) * 4;
        const v2u yb = *(const v2u*)(Yrow + col); const f32x4 yv = (f32x4){bflo(yb.x), bfhi(yb.x), bflo(yb.y), bfhi(yb.y)};
        const f32x4 x0 = *(const f32x4*)(x1buf + (size_t)t * D + col), g0 = *(const f32x4*)(mb + 5 * D + col);
        z[c8 * 4] = ALPHA * x0.x + (1.f + g0.x) * yv.x; z[c8 * 4 + 1] = ALPHA * x0.y + (1.f + g0.y) * yv.y; z[c8 * 4 + 2] = ALPHA * x0.z + (1.f + g0.z) * yv.z; z[c8 * 4 + 3] = ALPHA * x0.w + (1.f + g0.w) * yv.w; }
    ln_tail(z, t, lane, a.in[17] + (size_t)l * D, a.in[18] + (size_t)l * D, last ? a.out : (float*)(a.ws + WS_X), mbn, mbn + D, last ? (bf16*)nullptr : (bf16*)(a.ws + WS_H), nullptr, nullptr);
}
template <class TT, int N, int M> __device__ __forceinline__ void treduce(TT (&v)[N], int lane) {
    const bool c0 = (lane & M) != 0, c1 = (lane & (2 * M)) != 0, c2 = (lane & (4 * M)) != 0;
#pragma unroll
    for (int m = 0; m < N / 2; ++m) { const TT keep = c0 ? v[2 * m + 1] : v[2 * m], send = c0 ? v[2 * m] : v[2 * m + 1]; v[m] = keep + __shfl_xor(send, M); }
#pragma unroll
    for (int m = 0; m < N / 4; ++m) { const TT keep = c1 ? v[2 * m + 1] : v[2 * m], send = c1 ? v[2 * m] : v[2 * m + 1]; v[m] = keep + __shfl_xor(send, 2 * M); }
#pragma unroll
    for (int m = 0; m < N / 8; ++m) { const TT keep = c2 ? v[2 * m + 1] : v[2 * m], send = c2 ? v[2 * m] : v[2 * m + 1]; v[m] = keep + __shfl_xor(send, 4 * M); }
}
__device__ __forceinline__ void tr4x4(unsigned a, unsigned b, unsigned c, unsigned d, unsigned& t0, unsigned& t1, unsigned& t2, unsigned& t3) {
    const unsigned x0 = __builtin_amdgcn_perm(b, a, 0x05010400u), x1 = __builtin_amdgcn_perm(b, a, 0x07030602u), y0 = __builtin_amdgcn_perm(d, c, 0x05010400u), y1 = __builtin_amdgcn_perm(d, c, 0x07030602u);
    t0 = __builtin_amdgcn_perm(y0, x0, 0x05040100u); t1 = __builtin_amdgcn_perm(y0, x0, 0x07060302u); t2 = __builtin_amdgcn_perm(y1, x1, 0x05040100u); t3 = __builtin_amdgcn_perm(y1, x1, 0x07060302u);
}
__device__ __forceinline__ int sdot8i(unsigned w, unsigned x, int acc) { return __builtin_amdgcn_sdot8((int)w, (int)x, acc, false); }
__device__ __forceinline__ float slot_scale(unsigned w3) { return __builtin_amdgcn_exp2f((float)(w3 >> 24) * 0.125f - 16.0f); }
__device__ __forceinline__ void peer_experts(const Args& a, int l, LAS unsigned char* lds, int lane0, int wave, int ch) {
    const float* mod = (const float*)(a.ws + WS_MOD);
    const unsigned char* ut = a.ws + WS_UT + (size_t)l * NE * 1152; const unsigned char* vt = a.ws + WS_VT + (size_t)l * NE * 1152; const unsigned char* hq8 = a.ws + WS_HQ8;
    const float* hsc = (const float*)(a.ws + WS_HSC);
    bf16* Ybuf = (bf16*)(a.ws + WS_Z);
    const LAS int* eg_e = (const LAS int*)lds; LAS float* sw = (LAS float*)(lds + 32768);
    LAS float* apart = (LAS float*)(lds + 65536);
    const int b = ch / NCH; const bool last = (l == NL - 1);
    const float* mb = mod + ((size_t)l * NB + b) * 6 * D; const float* mbn = mod + ((size_t)(last ? l : l + 1) * NB + b) * 6 * D;
    const int tlw = wave * 8;
    { const int lane = lane0;
#pragma unroll
      for (int i = 0; i < 16; ++i) apart[tlw * 128 + i * 64 + lane] = 0.f; }
    LDS_WAIT(); asm volatile("" ::: "memory");
    {
        int laneL = lane0; asm volatile("" : "+v"(laneL)); const int lane = laneL;
        const int g = lane >> 3, l7 = lane & 7;
        v4u bufA[16], bufB[16], hA0, hA1, hB0, hB1;
#define CU_LOAD(buf, h0_, h1_, idx_) do { const int u_ = (idx_) >> 3, tl_ = tlw + ((idx_) & 7); const unsigned soff_ = (unsigned)(u_ * 128 + l7 * 16); \
            const unsigned char* hp_ = hq8 + (size_t)(ch * 64 + tl_) * 2304 + (u_ * 8 + l7) * 32; h0_ = *(const v4u*)hp_; h1_ = *(const v4u*)(hp_ + 16); \
            _Pragma("unroll") for (int i_ = 0; i_ < 16; ++i_) { const unsigned e_ = (unsigned)eg_e[tl_ * 128 + 8 * i_ + g]; buf[i_] = *(const v4u*)(ut + (size_t)(e_ * 1152u + soff_)); } } while (0)
#define CU_COMP(buf, h0_, h1_, idx_) do { const int tl_ = tlw + ((idx_) & 7); float accv_[16]; \
            _Pragma("unroll") for (int i_ = 0; i_ < 16; ++i_) { int sl_ = 0, sh_ = 0; \
                _Pragma("unroll") for (int d_ = 0; d_ < 4; ++d_) { const unsigned x_ = buf[i_][d_] ^ 0x88888888u; sl_ = sdot8i(x_, h0_[d_], sl_); sh_ = sdot8i(x_, h1_[d_], sh_); } \
                accv_[i_] = slot_scale(buf[i_][3]) * (float)(16 * sh_ + sl_); } \
            treduce<float, 16, 1>(accv_, lane); \
            apart[tl_ * 128 + 8 * l7 + g] += accv_[0]; apart[tl_ * 128 + 8 * (8 + l7) + g] += accv_[1]; } while (0)
        CU_LOAD(bufA, hA0, hA1, 0);
        for (int idx = 0; idx < 72; idx += 2) {
            CU_LOAD(bufB, hB0, hB1, idx + 1);
            CU_COMP(bufA, hA0, hA1, idx);
            { const int nx_ = idx + 2 < 72 ? idx + 2 : 71; CU_LOAD(bufA, hA0, hA1, nx_); }
            CU_COMP(bufB, hB0, hB1, idx + 1);
        }
#undef CU_LOAD
#undef CU_COMP
        LDS_WAIT(); asm volatile("" ::: "memory");
        for (int it = 0; it < 8; ++it) { const int tl = tlw + it; const float shs = hsc[ch * 64 + tl];
            const float w0 = sw[tl * 128 + lane] * gelu_tanh_f(apart[tl * 128 + lane] * shs), w1 = sw[tl * 128 + 64 + lane] * gelu_tanh_f(apart[tl * 128 + 64 + lane] * shs);
            sw[tl * 128 + lane] = w0; sw[tl * 128 + 64 + lane] = w1; }
        LDS_WAIT(); asm volatile("" ::: "memory");
    }
    {
        int laneL = lane0; asm volatile("" : "+v"(laneL)); const int lane = laneL;
        const int g = lane >> 3, l7 = lane & 7;
        v4u bufA[16], bufB[16];
#define CV_LOAD(buf, idx_) do { const int u_ = (idx_) >> 3, tl_ = tlw + ((idx_) & 7); const unsigned soff_ = (unsigned)(u_ * 128 + l7 * 16); \
            _Pragma("unroll") for (int i_ = 0; i_ < 16; ++i_) { const unsigned e_ = (unsigned)eg_e[tl_ * 128 + 8 * i_ + g]; buf[i_] = *(const v4u*)(vt + (size_t)(e_ * 1152u + soff_)); } } while (0)
#define CV_COMP(buf, idx_) do { const int u_ = (idx_) >> 3, tl_ = tlw + ((idx_) & 7); \
            float wf_[16]; float wmx_ = 0.f; \
            _Pragma("unroll") for (int i_ = 0; i_ < 16; ++i_) { wf_[i_] = sw[tl_ * 128 + 8 * i_ + g] * slot_scale(buf[i_][3]); wmx_ = fmaxf(wmx_, fabsf(wf_[i_])); } \
            wmx_ = fmaxf(wmx_, __shfl_xor(wmx_, 8)); wmx_ = fmaxf(wmx_, __shfl_xor(wmx_, 16)); wmx_ = fmaxf(wmx_, __shfl_xor(wmx_, 32));     \
            const float winv_ = wmx_ > 0.f ? 127.0f / wmx_ : 0.f, wsc_ = wmx_ * (1.0f / 127.0f); \
            unsigned wq4_[4]; int wsum_ = 0; \
            _Pragma("unroll") for (int gp_ = 0; gp_ < 4; ++gp_) { const int q0_ = (int)__builtin_rintf(wf_[4 * gp_] * winv_), q1_ = (int)__builtin_rintf(wf_[4 * gp_ + 1] * winv_), q2_ = (int)__builtin_rintf(wf_[4 * gp_ + 2] * winv_), q3_ = (int)__builtin_rintf(wf_[4 * gp_ + 3] * winv_); \
                wsum_ += (q0_ + q1_) + (q2_ + q3_); wq4_[gp_] = (unsigned)(q0_ & 255) | ((unsigned)(q1_ & 255) << 8) | ((unsigned)(q2_ & 255) << 16) | ((unsigned)(q3_ & 255) << 24); } \
            int yi_[32]; \
            _Pragma("unroll") for (int q_ = 0; q_ < 32; ++q_) yi_[q_] = 0; \
            _Pragma("unroll") for (int gp_ = 0; gp_ < 4; ++gp_) { \
                _Pragma("unroll") for (int d_ = 0; d_ < 4; ++d_) { const unsigned A_ = buf[4 * gp_][d_], B_ = buf[4 * gp_ + 1][d_], C_ = buf[4 * gp_ + 2][d_], D_ = buf[4 * gp_ + 3][d_]; \
                    unsigned t0_, t1_, t2_, t3_; \
                    tr4x4(A_ & 0x0f0f0f0fu, B_ & 0x0f0f0f0fu, C_ & 0x0f0f0f0fu, D_ & 0x0f0f0f0fu, t0_, t1_, t2_, t3_); \
                    yi_[8 * d_] = sdot4i(t0_, wq4_[gp_], yi_[8 * d_]); yi_[8 * d_ + 2] = sdot4i(t1_, wq4_[gp_], yi_[8 * d_ + 2]); yi_[8 * d_ + 4] = sdot4i(t2_, wq4_[gp_], yi_[8 * d_ + 4]); yi_[8 * d_ + 6] = sdot4i(t3_, wq4_[gp_], yi_[8 * d_ + 6]); \
                    tr4x4((A_ >> 4) & 0x0f0f0f0fu, (B_ >> 4) & 0x0f0f0f0fu, (C_ >> 4) & 0x0f0f0f0fu, (D_ >> 4) & 0x0f0f0f0fu, t0_, t1_, t2_, t3_); \
                    yi_[8 * d_ + 1] = sdot4i(t0_, wq4_[gp_], yi_[8 * d_ + 1]); yi_[8 * d_ + 3] = sdot4i(t1_, wq4_[gp_], yi_[8 * d_ + 3]); yi_[8 * d_ + 5] = sdot4i(t2_, wq4_[gp_], yi_[8 * d_ + 5]); yi_[8 * d_ + 7] = sdot4i(t3_, wq4_[gp_], yi_[8 * d_ + 7]); } } \
            _Pragma("unroll") for (int q_ = 0; q_ < 32; ++q_) yi_[q_] -= 8 * wsum_; \
            treduce<int, 32, 8>(yi_, lane); \
            float y_[4]; \
            _Pragma("unroll") for (int q_ = 0; q_ < 4; ++q_) y_[q_] = wsc_ * (float)yi_[q_]; \
            { const int colb_ = u_ * 240 + l7 * 30 + g; bf16* yr_ = Ybuf + (size_t)(ch * 64 + tl_) * D + colb_; \
              _Pragma("unroll") for (int m_ = 0; m_ < 4; ++m_) if (8 * m_ + g < 30 && colb_ + 8 * m_ < D) yr_[8 * m_] = (bf16)(pk2(y_[m_], 0.f) & 0xffffu); } } while (0)
        CV_LOAD(bufA, 0);
        for (int idx = 0; idx < 72; idx += 2) {
            CV_LOAD(bufB, idx + 1);
            CV_COMP(bufA, idx);
            { const int nx_ = idx + 2 < 72 ? idx + 2 : 71; CV_LOAD(bufA, nx_); }
            CV_COMP(bufB, idx + 1);
        }
#undef CV_LOAD
#undef CV_COMP
    }
    asm volatile("s_waitcnt vmcnt(0)" ::: "memory");
    __builtin_amdgcn_fence(__ATOMIC_ACQUIRE, "agent");
    asm volatile("s_waitcnt vmcnt(0)" ::: "memory");
    for (int it = 0; it < 8; ++it) { int laneT = lane0; asm volatile("" : "+v"(laneT)); const int t = ch * 64 + tlw + it;
        peer_tail(a, l, t, laneT, Ybuf + (size_t)t * D, mb, mbn, last); }
}
#else
__device__ __forceinline__ void peer_tail(const Args& a, int l, int t, int lane, const float* Yrow, const float* mb, const float* mbn, bool last) {
    const float* x1buf = (const float*)(a.ws + WS_X1);
    float z[32];
#pragma unroll
    for (int c = 0; c < 2; ++c)
#pragma unroll
        for (int k = 0; k < 4; ++k) { const int c8 = 4 * c + k, col = (c8 * 64 + lane) * 4;
            const v2u yb = *(const v2u*)((const bf16*)Yrow + (c * 64 + lane) * 16 + 4 * k); const f32x4 yv = (f32x4){bflo(yb.x), bfhi(yb.x), bflo(yb.y), bfhi(yb.y)};
            const f32x4 x0 = *(const f32x4*)(x1buf + (size_t)t * D + col), g0 = *(const f32x4*)(mb + 5 * D + col);
            z[c8 * 4] = ALPHA * x0.x + (1.f + g0.x) * yv.x; z[c8 * 4 + 1] = ALPHA * x0.y + (1.f + g0.y) * yv.y; z[c8 * 4 + 2] = ALPHA * x0.z + (1.f + g0.z) * yv.z; z[c8 * 4 + 3] = ALPHA * x0.w + (1.f + g0.w) * yv.w; }
    ln_tail(z, t, lane, a.in[17] + (size_t)l * D, a.in[18] + (size_t)l * D, last ? a.out : (float*)(a.ws + WS_X), mbn, mbn + D, last ? (bf16*)nullptr : (bf16*)(a.ws + WS_H), nullptr, nullptr);
}
template <class TT, int M> __device__ __forceinline__ void treduce16(TT (&v)[16], int lane) {
    const bool c0 = (lane & M) != 0, c1 = (lane & (2 * M)) != 0, c2 = (lane & (4 * M)) != 0;
#pragma unroll
    for (int m = 0; m < 8; ++m) { const TT keep = c0 ? v[2 * m + 1] : v[2 * m], send = c0 ? v[2 * m] : v[2 * m + 1]; v[m] = keep + __shfl_xor(send, M); }
#pragma unroll
    for (int m = 0; m < 4; ++m) { const TT keep = c1 ? v[2 * m + 1] : v[2 * m], send = c1 ? v[2 * m] : v[2 * m + 1]; v[m] = keep + __shfl_xor(send, 2 * M); }
#pragma unroll
    for (int m = 0; m < 2; ++m) { const TT keep = c2 ? v[2 * m + 1] : v[2 * m], send = c2 ? v[2 * m] : v[2 * m + 1]; v[m] = keep + __shfl_xor(send, 4 * M); }
}
__device__ __forceinline__ void peer_experts(const Args& a, int l, LAS unsigned char* lds, int lane0, int wave, int ch) {
    const float* mod = (const float*)(a.ws + WS_MOD);
    const unsigned char* ut = a.ws + WS_UT + (size_t)l * NE * D; const unsigned char* vt = a.ws + WS_VT + (size_t)l * NE * D; const unsigned char* hq8 = a.ws + WS_HQ8;
    const float* su = (const float*)(a.ws + WS_SU) + (size_t)l * NE; const float* sv = (const float*)(a.ws + WS_SV) + (size_t)l * NE; const float* hsc = (const float*)(a.ws + WS_HSC);
    float* Ybuf = (float*)(a.ws + WS_Z);
    const LAS int* eg_e = (const LAS int*)lds; LAS float* sw = (LAS float*)(lds + 32768);
    LAS int* apart = (LAS int*)(lds + 65536); LAS float* wtotl = (LAS float*)(lds + LDSCTL_OFF + 256);
    const int b = ch / NCH; const bool last = (l == NL - 1);
    const float* mb = mod + ((size_t)l * NB + b) * 6 * D; const float* mbn = mod + ((size_t)(last ? l : l + 1) * NB + b) * 6 * D;
    const int tlw = wave * 8;
    { const int lane = lane0;
#pragma unroll
      for (int i = 0; i < 16; ++i) apart[tlw * 128 + i * 64 + lane] = 0; }
    LDS_WAIT(); asm volatile("" ::: "memory");
    {
        int laneL = lane0; asm volatile("" : "+v"(laneL)); const int lane = laneL;
        const int g = lane >> 3, l7 = lane & 7;
        v4u bufA[16], bufB[16], hA, hB;
#define CU_LOAD(buf, hh_, idx_) do { const int cs_ = (idx_) >> 3, tl_ = tlw + ((idx_) & 7); const unsigned coff_ = (unsigned)(cs_ * 128 + l7 * 16); \
            hh_ = *(const v4u*)(hq8 + (size_t)(ch * 64 + tl_) * D + coff_); \
            _Pragma("unroll") for (int i_ = 0; i_ < 16; ++i_) { const unsigned e_ = (unsigned)eg_e[tl_ * 128 + 8 * i_ + g]; buf[i_] = *(const v4u*)(ut + (size_t)(e_ * 2048u + coff_)); } } while (0)
#define CU_COMP(buf, hh_, idx_) do { const int tl_ = tlw + ((idx_) & 7); int acc_[16]; \
            _Pragma("unroll") for (int i_ = 0; i_ < 16; ++i_) { int s_ = 0; _Pragma("unroll") for (int q_ = 0; q_ < 4; ++q_) s_ = sdot4i(buf[i_][q_], hh_[q_], s_); acc_[i_] = s_; } \
            treduce16<int, 1>(acc_, lane); \
            apart[tl_ * 128 + 8 * l7 + g] += acc_[0]; apart[tl_ * 128 + 8 * (8 + l7) + g] += acc_[1]; } while (0)
        CU_LOAD(bufA, hA, 0);
        for (int idx = 0; idx < 128; idx += 2) {
            CU_LOAD(bufB, hB, idx + 1);
            CU_COMP(bufA, hA, idx);
            if (idx + 2 < 128) CU_LOAD(bufA, hA, idx + 2);
            CU_COMP(bufB, hB, idx + 1);
        }
#undef CU_LOAD
#undef CU_COMP
        LDS_WAIT(); asm volatile("" ::: "memory");
        for (int it = 0; it < 8; ++it) { const int tl = tlw + it; const float shs = hsc[ch * 64 + tl];
            const int e0 = eg_e[tl * 128 + lane], e1 = eg_e[tl * 128 + 64 + lane];
            const float w0 = sw[tl * 128 + lane] * gelu_tanh_f((float)apart[tl * 128 + lane] * su[e0] * shs) * sv[e0];
            const float w1 = sw[tl * 128 + 64 + lane] * gelu_tanh_f((float)apart[tl * 128 + 64 + lane] * su[e1] * shs) * sv[e1];
            sw[tl * 128 + lane] = w0; sw[tl * 128 + 64 + lane] = w1;
            const float ws = wave_sum(w0 + w1);
            if (lane == 0) wtotl[tl] = ws; }
        LDS_WAIT(); asm volatile("" ::: "memory");
    }
    {
        int laneL = lane0; asm volatile("" : "+v"(laneL)); const int lane = laneL;
        const int g = lane >> 3, l7 = lane & 7;
        v4u bufA[16], bufB[16];
#define CV_LOAD(buf, idx_) do { const int cs_ = (idx_) >> 3, tl_ = tlw + ((idx_) & 7); const unsigned coff_ = (unsigned)(cs_ * 128 + l7 * 16); \
            _Pragma("unroll") for (int i_ = 0; i_ < 16; ++i_) { const unsigned e_ = (unsigned)eg_e[tl_ * 128 + 8 * i_ + g]; buf[i_] = *(const v4u*)(vt + (size_t)(e_ * 2048u + coff_)); } } while (0)
#define CV_COMP(buf, idx_) do { const int cs_ = (idx_) >> 3, tl_ = tlw + ((idx_) & 7); float y_[16]; \
            _Pragma("unroll") for (int q_ = 0; q_ < 16; ++q_) y_[q_] = 0.f; \
            _Pragma("unroll") for (int i_ = 0; i_ < 16; ++i_) { const float wr_ = sw[tl_ * 128 + 8 * i_ + g]; \
                _Pragma("unroll") for (int q_ = 0; q_ < 4; ++q_) fma_ub4(buf[i_][q_], wr_, y_[4 * q_], y_[4 * q_ + 1], y_[4 * q_ + 2], y_[4 * q_ + 3]); } \
            treduce16<float, 8>(y_, lane); \
            const float woff_ = 128.0f * wtotl[tl_]; bf16* yr_ = (bf16*)Ybuf + (size_t)(ch * 64 + tl_) * D + cs_ * 128 + l7 * 16 + g; \
            yr_[0] = (bf16)(pk2(y_[0] - woff_, 0.f) & 0xffffu); yr_[8] = (bf16)(pk2(y_[1] - woff_, 0.f) & 0xffffu); } while (0)
        CV_LOAD(bufA, 0);
        for (int idx = 0; idx < 128; idx += 2) {
            CV_LOAD(bufB, idx + 1);
            CV_COMP(bufA, idx);
            if (idx + 2 < 128) CV_LOAD(bufA, idx + 2);
            CV_COMP(bufB, idx + 1);
        }
#undef CV_LOAD
#undef CV_COMP
    }
    asm volatile("s_waitcnt vmcnt(0)" ::: "memory");
    __builtin_amdgcn_fence(__ATOMIC_ACQUIRE, "agent");
    asm volatile("s_waitcnt vmcnt(0)" ::: "memory");
    for (int it = 0; it < 8; ++it) { int laneT = lane0; asm volatile("" : "+v"(laneT)); const int t = ch * 64 + tlw + it;
        peer_tail(a, l, t, laneT, (const float*)((const bf16*)Ybuf + (size_t)t * D), mb, mbn, last); }
}

#endif

#ifndef MK_PER_PHASE
#define MK_PER_PHASE 0
#endif
__global__ void __launch_bounds__(NTHREADS, 2) mk_fwd(Args a) {
    extern __shared__ __attribute__((aligned(16))) unsigned char lds_raw[];
    LAS unsigned char* lds = (LAS unsigned char*)lds_raw;
    const int tid = threadIdx.x, lane = tid & 63, wave = __builtin_amdgcn_readfirstlane(tid >> 6), G = gridDim.x, bx = blockIdx.x;
    if (tid < 64) ((LAS unsigned*)(lds + LDSCTL_OFF))[tid] = 0u;
    __syncthreads();
    unsigned* ctl = (unsigned*)(a.ws + WS_CTL);
    XcdBarrier bar; bar.bar = ctl + CW_BAR; bar.x = 0; bar.st = nullptr;
    const bool use_bar = (a.ph_hi - a.ph_lo) > 1;
    if (use_bar) bar = xcd_barrier_post(ctl + CW_BAR, (volatile LAS unsigned*)(lds + LDSCTL_OFF));
    const int lo = a.ph_lo, hi = a.ph_hi;
#ifndef PH_MASK
#define PH_MASK 0x1ff
#endif
#define IN(k) (lo <= (k) && (k) < hi)
#define EN(b) ((PH_MASK >> (b)) & 1)
#ifndef REP_MASK
#define REP_MASK 0
#endif
#ifndef REP_EXTRA
#define REP_EXTRA 2
#endif
#define REPS(b) (1 + ((REP_MASK >> (b)) & 1) * REP_EXTRA)
#define REP_BEGIN(b) for (int rep_ = 0; rep_ < REPS(b); ++rep_) {
#define REP_END(b) if (rep_ + 1 < REPS(b)) xcd_barrier(bar); }
#define SEAM(k) do { if (IN((k) + 1)) xcd_barrier(bar); } while (0)
#define PHASE_IDS() int tidp = tid; asm volatile("" : "+v"(tidp)); const int lanep = tidp & 63, wavep = __builtin_amdgcn_readfirstlane(tidp >> 6); (void)lanep; (void)wavep
    if (EN(0) && IN(0)) { REP_BEGIN(0) PHASE_IDS(); ph_prologue_a(a, lds, tidp, lanep, wavep, bx, G); REP_END(0) SEAM(0); }
    if (EN(1) && IN(1)) { REP_BEGIN(1) PHASE_IDS(); ph_prologue_b(a, lds, tidp, lanep, wavep, bx, G); REP_END(1) SEAM(1); }
    for (int l = 0; l < NL; ++l) {
        const int pb = 2 + 7 * l;
        const float* mod = (const float*)(a.ws + WS_MOD);
        if (EN(2) && IN(pb + 0)) {
            REP_BEGIN(2) PHASE_IDS();
            pg8::Gemm g{(const pg8::bf16_t*)(a.ws + WS_H), (const pg8::bf16_t*)(a.ws + WS_WIN) + (size_t)l * INW * D, T, NP, D}; pg8::StaticOrder S; S.init(T, NP, G, bx);
            pg8::EpiBf16P E{(pg8::bf16_t*)(a.ws + WS_PROJ), NP};
            pg8::gemm_phase<pg8::EpiBf16P, pg8::StaticOrder, true, true>(lds + RING_OFF, g, S, E, tidp);
            for (int ch = bx; ch < NCHUNK; ch += G) gate_prep(a, l, lds, tidp, lanep, wavep, ch);
            REP_END(2) SEAM(pb + 0);
        }
        if (EN(3) && IN(pb + 1)) { REP_BEGIN(3) PHASE_IDS(); for (int un = bx; un < 256; un += G) gla_unit(a, lds, tidp, lanep, wavep, un); REP_END(3) SEAM(pb + 1); }
        if (EN(4) && IN(pb + 2)) { REP_BEGIN(4) PHASE_IDS(); for (int ch = bx; ch < NCHUNK; ch += G) mixpost_chunk(a, l, lanep, wavep, ch); REP_END(4) SEAM(pb + 2); }
        if (EN(5) && IN(pb + 3)) {
            REP_BEGIN(5) PHASE_IDS();
            pg8::Gemm g{(const pg8::bf16_t*)(a.ws + WS_Y), (const pg8::bf16_t*)(a.ws + WS_WOUT) + (size_t)l * D * D, T, D, D}; pg8::StaticOrder S; S.init(T, D, G, bx);
            pg8::EpiResid E{(float*)(a.ws + WS_Z), l == 0 ? a.in[0] : (const float*)(a.ws + WS_X), mod + (size_t)l * NB * 6 * D + 2 * D, ALPHA};
            pg8::gemm_phase<pg8::EpiResid, pg8::StaticOrder, true, true>(lds + RING_OFF, g, S, E, tidp);
            REP_END(5) SEAM(pb + 3);
        }
        if (EN(6) && IN(pb + 4)) { REP_BEGIN(6) PHASE_IDS(); for (int ch = bx; ch < NCHUNK; ch += G) ln1_chunk(a, l, lds, lanep, wavep, ch); REP_END(6) SEAM(pb + 4); }
        if (EN(7) && IN(pb + 5)) {
            REP_BEGIN(7) PHASE_IDS();
            pg8::Gemm g{(const pg8::bf16_t*)(a.ws + WS_H2), (const pg8::bf16_t*)(a.ws + WS_WQ) + (size_t)l * D * D, T, D, D}; pg8::StaticOrder S; S.init(T, D, G, bx);
            pg8::EpiBf16P E{(pg8::bf16_t*)(a.ws + WS_Q), D};
            pg8::gemm_phase<pg8::EpiBf16P, pg8::StaticOrder, true, true>(lds + RING_OFF, g, S, E, tidp);
            REP_END(7) SEAM(pb + 5);
        }
#ifndef PEER_DBG
#define PEER_DBG 0
#endif
#ifndef PE_REP_R
#define PE_REP_R 1
#endif
#ifndef L2PROBE
#define L2PROBE 0
#endif
        if (EN(8) && IN(pb + 6)) {
            REP_BEGIN(8)
            for (int ch = bx; ch < NCHUNK; ch += G) { for (int repr_ = 0; repr_ < PE_REP_R; ++repr_) { PHASE_IDS(); peer_retrieve(a, l, lds, lanep, wavep, ch); __syncthreads(); } __syncthreads(); { PHASE_IDS(); peer_experts(a, l, lds, lanep, wavep, ch); } __syncthreads(); }
            REP_END(8) SEAM(pb + 6);
        }
    }
#undef IN
#undef SEAM
}

extern "C" void kernel_launch(void* const* d_in, const int* in_sizes, int n_in, void* d_out, int out_size, void* d_ws, size_t ws_size, hipStream_t stream) {
    static int grid = 0;
    if (grid == 0) {
        if (n_in != 19 || in_sizes[0] != T * D || out_size != T * D || ws_size < WS_END) { fprintf(stderr, "kernel_launch: unexpected shapes / workspace (%d inputs, ws %zu); nothing launched\n", n_in, ws_size); grid = -1; return; }
        int dev = 0, cus = 0, per_cu = 0;
        if (hipGetDevice(&dev) != hipSuccess || hipDeviceGetAttribute(&cus, hipDeviceAttributeMultiprocessorCount, dev) != hipSuccess) { grid = -1; return; }
        if (hipFuncSetAttribute((const void*)mk_fwd, hipFuncAttributeMaxDynamicSharedMemorySize, LDS_BYTES) != hipSuccess) { fprintf(stderr, "kernel_launch: hipFuncSetAttribute failed\n"); grid = -1; return; }
        if (hipOccupancyMaxActiveBlocksPerMultiprocessor(&per_cu, (const void*)mk_fwd, NTHREADS, LDS_BYTES) != hipSuccess || per_cu < 1) fprintf(stderr, "kernel_launch: occupancy query reports %d\n", per_cu);
        (void)hipGetLastError();
        grid = cus;
    }
    if (grid < 0) return;
    if (hipMemsetAsync((char*)d_ws + WS_CTL, 0, CTL_ZERO_BYTES, stream) != hipSuccess) return;
    Args a{};
    for (int i = 0; i < 19; ++i) a.in[i] = (const float*)d_in[i];
    a.out = (float*)d_out; a.ws = (unsigned char*)d_ws;
#if MK_PER_PHASE
    for (int p = 0; p < NPHASES; ++p) { a.ph_lo = p; a.ph_hi = p + 1; hipLaunchKernelGGL(mk_fwd, dim3(grid), dim3(NTHREADS), LDS_BYTES, stream, a); }
#else
    a.ph_lo = 0; a.ph_hi = NPHASES;
    hipLaunchKernelGGL(mk_fwd, dim3(grid), dim3(NTHREADS), LDS_BYTES, stream, a);
#endif
}
```

```cpp
#include <hip/hip_runtime.h>
#include <cstdio>
#include <cstdint>
namespace pg8 {
#define PG8_LAS __attribute__((address_space(3)))
typedef unsigned short bf16_t;
typedef short bf16x8 __attribute__((ext_vector_type(8)));
typedef float f32x4 __attribute__((ext_vector_type(4)));
typedef unsigned u32x4 __attribute__((ext_vector_type(4)));
constexpr int BM = 256, BK = 64, HALF = 128, HTB = HALF * BK * 2  , STAGE_BYTES = 8 * HTB, NXCD = 8, WGM = 8;

__host__ __device__ __forceinline__ int lds_byte(int r, int c) { const int st = (r >> 4) * 2 + (c >> 5), rr = r & 15, cc = c & 31, ob = rr * 64 + cc * 2; return st * 1024 + (ob ^ (((ob >> 9) & 1) << 5)); }
__host__ __device__ __forceinline__ void stage_rc(int b, int& R, int& C) { const int st = b / 1024, sb = b % 1024, swz = sb ^ (((sb >> 9) & 1) << 5); R = (st >> 1) * 16 + swz / 64; C = (st & 1) * 32 + (swz % 64) / 2; }
__host__ __device__ __forceinline__ int perm32(int rho) { const int n = rho >> 4, i = rho & 15; return 8 * (i >> 2) + 4 * n + (i & 3); }

struct Unit { int pm, pn; };
struct Gemm { const bf16_t* A; const bf16_t* Bt; int M, N, K; };

struct StaticOrder {
    int nM, nN, nwg, G, c;
    __host__ __device__ void init(int M, int N, int G_, int c_) { nM = M / BM; nN = N / BM; nwg = nM * nN; G = G_; c = c_; }
    __host__ __device__ bool next(int i, Unit& u) const {
        const long L = (long)i * G + c; if (L >= nwg) return false;
        int wgid = (int)L; { const int q = nwg / NXCD, r = nwg % NXCD, xcd = wgid % NXCD, off = wgid / NXCD; wgid = (xcd < r ? xcd * (q + 1) : r * (q + 1) + (xcd - r) * q) + off; }
        const int nig = WGM * nN, gid = wgid / nig, fm = gid * WGM, gsz = (nM - fm) < WGM ? (nM - fm) : WGM;
        u.pm = fm + ((wgid % nig) % gsz); u.pn = (wgid % nig) / gsz; return true;
    }
    __device__ __forceinline__ void a_ready(const Unit&) const {}
    __device__ __forceinline__ void done(const Unit&) const {}
};
typedef __bf16 bf16x2_t __attribute__((ext_vector_type(2)));
__device__ __forceinline__ unsigned cvt_pk_bf16(float lo, float hi) { bf16x2_t r; r.x = (__bf16)lo; r.y = (__bf16)hi; return __builtin_bit_cast(unsigned, r); }
struct EpiBf16P {
    static constexpr bool PERM = true, AFTER_DRAIN = false;
    bf16_t* O; int ldc;
    __device__ __forceinline__ void operator()(const f32x4 (&acc)[2][2][4][2], const Unit& u, int wr, int wc, int fr, int fq) const {
        const int row0 = u.pm * BM + wr * 64 + fr, col0 = u.pn * BM + wc * 32 + 8 * fq;
#pragma unroll
        for (int ai = 0; ai < 2; ++ai)
#pragma unroll
            for (int m = 0; m < 4; ++m) { bf16_t* rowp = O + (size_t)(row0 + ai * HALF + m * 16) * ldc + col0;
#pragma unroll
                for (int bj = 0; bj < 2; ++bj) { const f32x4 v0 = acc[ai][bj][m][0], v1 = acc[ai][bj][m][1];
                    u32x4 w; w.x = cvt_pk_bf16(v0[0], v0[1]); w.y = cvt_pk_bf16(v0[2], v0[3]); w.z = cvt_pk_bf16(v1[0], v1[1]); w.w = cvt_pk_bf16(v1[2], v1[3]);
                    *(u32x4*)(rowp + bj * HALF) = w; } }
    }
};
struct EpiResid {
    static constexpr bool PERM = false, AFTER_DRAIN = false;
    float* Z; const float* X; const float* gate; float alpha;
    __device__ __forceinline__ void operator()(const f32x4 (&acc)[2][2][4][2], const Unit& u, int wr, int wc, int fr, int fq) const {
        const int row0 = u.pm * BM + wr * 64 + fr, col0 = u.pn * BM + wc * 32 + 4 * fq;
        const float* gb = gate + (size_t)(u.pm >> 3) * (6 * 2048) + col0;
        f32x4 gv[2][2];
#pragma unroll
        for (int bj = 0; bj < 2; ++bj)
#pragma unroll
            for (int n = 0; n < 2; ++n) gv[bj][n] = *(const f32x4*)(gb + bj * HALF + n * 16) + 1.0f;
#pragma unroll
        for (int ai = 0; ai < 2; ++ai)
#pragma unroll
            for (int m = 0; m < 4; ++m) { const size_t off = (size_t)(row0 + ai * HALF + m * 16) * 2048 + col0;
#pragma unroll
                for (int bj = 0; bj < 2; ++bj)
#pragma unroll
                    for (int n = 0; n < 2; ++n) { const f32x4 xv = *(const f32x4*)(X + off + bj * HALF + n * 16);
                        *(f32x4*)(Z + off + bj * HALF + n * 16) = xv * alpha + gv[bj][n] * acc[ai][bj][m][n]; }
                asm volatile("" ::: "memory"); }
    }
};
template <class Epi, class Sched, bool ALIGN_EPI = false, bool SP2 = false>
__device__ __forceinline__ void gemm_phase(PG8_LAS unsigned char* lds, const Gemm g, const Sched& S, const Epi& E, const int tid_in) {
    const int tid = tid_in, wid = __builtin_amdgcn_readfirstlane(tid >> 6), lane = tid & 63, wr = wid >> 2, wc = wid & 3, fr = lane & 15, fq = lane >> 4;
    const int K = g.K, nt = K / BK;
    unsigned voffA[2], voffB[2];
#pragma unroll
    for (int i = 0; i < 2; ++i) { int R, C; stage_rc(tid * 16 + i * 8192, R, C); const int Rb = Epi::PERM ? ((R & ~31) + perm32(R & 31)) : R;
        voffA[i] = (unsigned)(R * K + C) * 2u; voffB[i] = (unsigned)(Rb * K + C) * 2u; }
    const size_t kstep = (size_t)(BK * 2);
    const size_t hstep = (size_t)HALF * K * 2;
    const size_t tstep = 2 * hstep;
    const unsigned ldsw = (unsigned)wid * 1024u;
    const int aoff = lds_byte(wr * 64 + fr, fq * 8), boff = lds_byte(wc * 32 + fr, fq * 8);
#define PG8_SA(b, h) (((b) * 2 + (h)) * HTB)
#define PG8_SB(b, h) ((4 + (b) * 2 + (h)) * HTB)
#define PG8_STAGE(bufoff, gbase, voff) do { _Pragma("unroll") for (int _i = 0; _i < 2; ++_i) \
        __builtin_amdgcn_global_load_lds((const unsigned*)((const char*)(gbase) + (voff)[_i]), (PG8_LAS unsigned*)(lds + (bufoff) + ldsw + _i * 8192), 16, 0, 0); } while (0)
#define PG8_LDA(dst, b, h) do { _Pragma("unroll") for (int m = 0; m < 4; ++m) _Pragma("unroll") for (int k = 0; k < 2; ++k) dst[m][k] = *(const PG8_LAS bf16x8*)(lds + PG8_SA(b, h) + aoff + m * 2048 + k * 1024); } while (0)
#define PG8_LDB(dst, b, h) do { _Pragma("unroll") for (int n = 0; n < 2; ++n) _Pragma("unroll") for (int k = 0; k < 2; ++k) dst[n][k] = *(const PG8_LAS bf16x8*)(lds + PG8_SB(b, h) + boff + n * 2048 + k * 1024); } while (0)
#define PG8_MMA(ai, bj, At, Bt) do { __builtin_amdgcn_s_setprio(1); _Pragma("unroll") for (int m = 0; m < 4; ++m) _Pragma("unroll") for (int n = 0; n < 2; ++n) _Pragma("unroll") for (int k = 0; k < 2; ++k) \
        acc[ai][bj][m][n] = __builtin_amdgcn_mfma_f32_16x16x32_bf16(Bt[n][k], At[m][k], acc[ai][bj][m][n], 0, 0, 0); __builtin_amdgcn_s_setprio(0); } while (0)
#define PG8_WAIT_V(n) asm volatile("s_waitcnt vmcnt(" #n ")" ::: "memory")
#define PG8_WAIT_L(n) asm volatile("s_waitcnt lgkmcnt(" #n ")" ::: "memory")
#define PG8_BAR __builtin_amdgcn_s_barrier()
#define PG8_SCHED __builtin_amdgcn_sched_barrier(0)
    Unit cur, nxt; int ui = 0;
    if (!S.next(0, cur)) return;
    f32x4 acc[2][2][4][2];
#pragma unroll
    for (int a = 0; a < 2; ++a)
#pragma unroll
        for (int b = 0; b < 2; ++b)
#pragma unroll
            for (int m = 0; m < 4; ++m)
#pragma unroll
                for (int n = 0; n < 2; ++n) acc[a][b][m][n] = (f32x4){0.f, 0.f, 0.f, 0.f};
    bf16x8 At[4][2], B0[2][2], B1[2][2];
    const char* cA = (const char*)g.A + (size_t)cur.pm * tstep; const char* cB = (const char*)g.Bt + (size_t)cur.pn * tstep;
    S.a_ready(cur);
    if constexpr (SP2) {
        PG8_STAGE(PG8_SB(0, 0), cB, voffB); PG8_STAGE(PG8_SB(0, 1), cB + hstep, voffB); PG8_STAGE(PG8_SA(0, 0), cA, voffA); PG8_STAGE(PG8_SA(0, 1), cA + hstep, voffA);
        if (wr == 1) PG8_BAR;
        PG8_WAIT_V(2); PG8_BAR;
        PG8_STAGE(PG8_SB(1, 0), cB + kstep, voffB); PG8_STAGE(PG8_SA(1, 0), cA + kstep, voffA); PG8_STAGE(PG8_SB(1, 1), cB + hstep + kstep, voffB);
        PG8_WAIT_V(6); PG8_BAR;
    } else {
        PG8_STAGE(PG8_SB(0, 0), cB, voffB); PG8_STAGE(PG8_SA(0, 0), cA, voffA); PG8_STAGE(PG8_SB(0, 1), cB + hstep, voffB); PG8_STAGE(PG8_SA(0, 1), cA + hstep, voffA);
        if (wr == 1) PG8_BAR;
        PG8_WAIT_V(4); PG8_BAR;
        PG8_STAGE(PG8_SB(1, 0), cB + kstep, voffB); PG8_STAGE(PG8_SA(1, 0), cA + kstep, voffA); PG8_STAGE(PG8_SB(1, 1), cB + hstep + kstep, voffB);
        PG8_WAIT_V(6); PG8_BAR;
    }
    for (;;) {
        const bool has_next = S.next(ui + 1, nxt);
        const char* nA = has_next ? (const char*)g.A + (size_t)nxt.pm * tstep : cA; const char* nB = has_next ? (const char*)g.Bt + (size_t)nxt.pn * tstep : cB;
        for (int t = 0; t < nt; t += 2) {
            const bool last = (t == nt - 2);
            const char* a1 = cA + (size_t)(t + 1) * kstep;
            const char* a2 = last ? nA : cA + (size_t)(t + 2) * kstep; const char* b2 = last ? nB : cB + (size_t)(t + 2) * kstep;
            const char* a3 = a2 + kstep; const char* b3 = b2 + kstep;
            if (last && has_next) S.a_ready(nxt);
            if constexpr (SP2) {
            PG8_LDB(B0, 0, 0); PG8_LDB(B1, 0, 1); PG8_SCHED; PG8_LDA(At, 0, 0); PG8_STAGE(PG8_SA(1, 1), a1 + hstep, voffA);
            PG8_WAIT_V(8); PG8_WAIT_L(0); PG8_BAR; PG8_MMA(0, 0, At, B0); PG8_MMA(0, 1, At, B1); PG8_BAR; PG8_SCHED;
            PG8_LDA(At, 0, 1); PG8_STAGE(PG8_SB(0, 0), b2, voffB); PG8_STAGE(PG8_SB(0, 1), b2 + hstep, voffB); PG8_STAGE(PG8_SA(0, 0), a2, voffA);
            PG8_WAIT_V(8); PG8_WAIT_L(0); PG8_BAR; PG8_MMA(1, 0, At, B0); PG8_MMA(1, 1, At, B1); PG8_BAR; PG8_SCHED;
            PG8_LDB(B0, 1, 0); PG8_LDB(B1, 1, 1); PG8_SCHED; PG8_LDA(At, 1, 0); PG8_STAGE(PG8_SA(0, 1), a2 + hstep, voffA);
            PG8_WAIT_V(8); PG8_WAIT_L(0); PG8_BAR; PG8_MMA(0, 0, At, B0); PG8_MMA(0, 1, At, B1); PG8_BAR; PG8_SCHED;
            PG8_LDA(At, 1, 1); PG8_STAGE(PG8_SB(1, 0), b3, voffB); PG8_STAGE(PG8_SB(1, 1), b3 + hstep, voffB); PG8_STAGE(PG8_SA(1, 0), a3, voffA);
            PG8_WAIT_V(8); PG8_WAIT_L(0); PG8_BAR; PG8_MMA(1, 0, At, B0); PG8_MMA(1, 1, At, B1); PG8_BAR; PG8_SCHED;
            } else {
            PG8_LDB(B0, 0, 0); PG8_SCHED; PG8_LDA(At, 0, 0); PG8_STAGE(PG8_SA(1, 1), a1 + hstep, voffA);
            PG8_WAIT_L(8); PG8_BAR; PG8_WAIT_L(0); PG8_MMA(0, 0, At, B0); PG8_BAR; PG8_SCHED;
            PG8_LDB(B1, 0, 1); PG8_STAGE(PG8_SB(0, 0), b2, voffB);
            PG8_BAR; PG8_WAIT_L(0); PG8_MMA(0, 1, At, B1); PG8_BAR;
            PG8_LDA(At, 0, 1); PG8_STAGE(PG8_SA(0, 0), a2, voffA);
            PG8_BAR; PG8_WAIT_L(0); PG8_MMA(1, 0, At, B0); PG8_BAR; PG8_SCHED;
            PG8_STAGE(PG8_SB(0, 1), b2 + hstep, voffB);
            PG8_WAIT_V(6); PG8_BAR; PG8_MMA(1, 1, At, B1); PG8_BAR;
            PG8_LDB(B0, 1, 0); PG8_SCHED; PG8_LDA(At, 1, 0); PG8_STAGE(PG8_SA(0, 1), a2 + hstep, voffA);
            PG8_WAIT_L(8); PG8_BAR; PG8_WAIT_L(0); PG8_MMA(0, 0, At, B0); PG8_BAR; PG8_SCHED;
            PG8_LDB(B1, 1, 1); PG8_STAGE(PG8_SB(1, 0), b3, voffB);
            PG8_BAR; PG8_WAIT_L(0); PG8_MMA(0, 1, At, B1); PG8_BAR;
            PG8_LDA(At, 1, 1); PG8_STAGE(PG8_SA(1, 0), a3, voffA);
            PG8_BAR; PG8_WAIT_L(0); PG8_MMA(1, 0, At, B0); PG8_BAR; PG8_SCHED;
            PG8_STAGE(PG8_SB(1, 1), b3 + hstep, voffB);
            PG8_WAIT_V(6); PG8_BAR; PG8_MMA(1, 1, At, B1); PG8_BAR;
            }
        }
        if constexpr (ALIGN_EPI) { if (wr == 0) PG8_BAR; }
        if constexpr (!Epi::AFTER_DRAIN) { E(acc, cur, wr, wc, fr, fq); S.done(cur); }
        if (!has_next) break;
#pragma unroll
        for (int a = 0; a < 2; ++a)
#pragma unroll
            for (int b = 0; b < 2; ++b)
#pragma unroll
                for (int m = 0; m < 4; ++m)
#pragma unroll
                    for (int n = 0; n < 2; ++n) acc[a][b][m][n] = (f32x4){0.f, 0.f, 0.f, 0.f};
        cur = nxt; cA = nA; cB = nB; ++ui;
        if constexpr (ALIGN_EPI) { if (wr == 1) PG8_BAR; }
    }
    PG8_WAIT_V(0);
    if constexpr (!ALIGN_EPI) { if (wr == 0) PG8_BAR; }
    PG8_BAR;
    if constexpr (Epi::AFTER_DRAIN) { E.fused(acc, cur, wr, wc, fr, fq, lds, wid, lane); S.done(cur); }
#undef PG8_SA
#undef PG8_SB
#undef PG8_STAGE
#undef PG8_LDA
#undef PG8_LDB
#undef PG8_MMA
#undef PG8_WAIT_V
#undef PG8_WAIT_L
#undef PG8_BAR
#undef PG8_SCHED
}
}
#define XB_TMO      128
#define XB_XCNT(j)  (256  + 64 * (j))
#define XB_XSUB(j)  (1280 + 64 * (j))
#define XB_XGEN(j)  (2304 + 64 * (j))
#define XB_TOP      3328
#define XB_TOPGEN   3392
#define XCD_BAR_WORDS 3456
#define XB_SPIN_CAP (1u << 18)
#define LAS __attribute__((address_space(3)))

__device__ __forceinline__ unsigned xb_ld(unsigned* p)              { return __hip_atomic_load(p, __ATOMIC_RELAXED, __HIP_MEMORY_SCOPE_AGENT); }
__device__ __forceinline__ unsigned xb_add(unsigned* p, unsigned v) { return __hip_atomic_fetch_add(p, v, __ATOMIC_RELAXED, __HIP_MEMORY_SCOPE_AGENT); }
__device__ __forceinline__ unsigned xb_xcc_id() { return (unsigned)__builtin_amdgcn_s_getreg((3 << 11) | 20) & 0xFu; }
#define XB_SPIN(cond, bar) do { unsigned _sp = 0; while (cond) { __builtin_amdgcn_s_sleep(1); \
    if ((++_sp & 255u) == 0u) { if (xb_ld(&(bar)[XB_TMO])) break; if (_sp > XB_SPIN_CAP) { atomicAdd(&(bar)[XB_TMO], 1u); break; } } } } while (0)

struct XcdBarrier {
    unsigned* bar; unsigned x;
    volatile LAS unsigned* st;
};

__device__ __forceinline__ XcdBarrier xcd_barrier_post(unsigned* bar, volatile LAS unsigned* st) {
    XcdBarrier b; b.bar = bar; b.x = xb_xcc_id(); b.st = st;
    if (threadIdx.x == 0) (void)xb_add(&bar[XB_XCNT(b.x)], 1u);
    return b;
}
__device__ __forceinline__ void xcd_barrier_complete(unsigned* bar, unsigned x, unsigned& nloc, unsigned& nx) {
    const unsigned G = gridDim.x * gridDim.y * gridDim.z;
    unsigned sum, cnt, mine, sp = 0u;
    for (;;) {
        sum = 0u; cnt = 0u; mine = 0u;
#pragma unroll
        for (unsigned j = 0; j < 16; ++j) { const unsigned c = xb_ld(&bar[XB_XCNT(j)]); sum += c; cnt += (c > 0u) ? 1u : 0u; mine = (j == x) ? c : mine; }
        if (sum == G) break;
        __builtin_amdgcn_s_sleep(1);
        if ((++sp & 255u) == 0u) { if (xb_ld(&bar[XB_TMO])) break; if (sp > XB_SPIN_CAP) { atomicAdd(&bar[XB_TMO], 1u); break; } }
    }
    nloc = mine > 0u ? mine : 1u; nx = cnt > 0u ? cnt : 1u;
}

__device__ __forceinline__ void xcd_barrier(const XcdBarrier& b) {
    asm volatile("s_waitcnt vmcnt(0)" ::: "memory");
    __syncthreads();
    if (threadIdx.x == 0) {
        unsigned* bar = b.bar;
        __builtin_amdgcn_s_waitcnt(0);
        unsigned nloc = b.st[0], nx = b.st[1];
        if (nloc == 0u) { xcd_barrier_complete(bar, b.x, nloc, nx); b.st[0] = nloc; b.st[1] = nx; }
        const unsigned old = xb_add(&bar[XB_XSUB(b.x)], 1u);
        const unsigned gen = old / nloc;
        if (old + 1u == (gen + 1u) * nloc) {
            __builtin_amdgcn_fence(__ATOMIC_RELEASE, "agent");
            asm volatile("s_waitcnt vmcnt(0)" ::: "memory");
            const unsigned og = xb_add(&bar[XB_TOP], 1u);
            const unsigned tg = og / nx;
            if (og + 1u == (tg + 1u) * nx) xb_add(&bar[XB_TOPGEN], 1u);
            else XB_SPIN(xb_ld(&bar[XB_TOPGEN]) == tg, bar);
            __builtin_amdgcn_fence(__ATOMIC_ACQUIRE, "agent");
            xb_add(&bar[XB_XGEN(b.x)], 1u);
            asm volatile("s_waitcnt vmcnt(0)" ::: "memory");
        } else {
            XB_SPIN(xb_ld(&bar[XB_XGEN(b.x)]) == gen, bar);
            __builtin_amdgcn_fence(__ATOMIC_ACQUIRE, "agent");
            asm volatile("s_waitcnt vmcnt(0)" ::: "memory");
        }
    }
    __syncthreads();
}
constexpr int D = 2048, NB = 8, SEQ = 2048, NL = 4, T = NB * SEQ;
constexpr int NCH = SEQ / 64, NCHUNK = T / 64;
constexpr int GKW = 512, RANK = 16;
constexpr int INW = 6160, NP = 6144;
constexpr int NE = 16384;
constexpr float ALPHA = 1.6817928305074290f, EPS = 1e-5f;
constexpr int PQ = 0, PK = 512, PV = 1024, PR = 2048, PCB = 3072, PCC = 4096, PCH = 5120;
constexpr int NWAVES = 8, NTHREADS = 512;
#ifndef TAB4
#define TAB4 1
#endif
constexpr int NPHASES = 2 + 7 * NL;

constexpr size_t MiB = 1u << 20;
constexpr size_t WS_CTL = 0, CTL_ZERO_BYTES = 1 * MiB;
constexpr size_t WS_MOD = 1 * MiB, WS_PART = 3 * MiB, WS_KEYS = 15 * MiB, WS_DTOT = 17 * MiB, WS_WIN = 18 * MiB, WS_WOUT = 115 * MiB, WS_WQ = 147 * MiB;
constexpr size_t WS_UT = 179 * MiB, WS_VT = 435 * MiB, WS_H = 691 * MiB, WS_PROJ = 755 * MiB, WS_E = 947 * MiB, WS_OGLA = 979 * MiB, WS_Y = 1043 * MiB;
constexpr size_t WS_Z = 1107 * MiB, WS_X1 = 1235 * MiB, WS_X = 1363 * MiB, WS_Q = 1491 * MiB, WS_H2 = 1555 * MiB, WS_HQ8 = 1619 * MiB, WS_END = 1659 * MiB;
constexpr size_t WS_SU = 17 * MiB + 512 * 1024, WS_SV = 17 * MiB + 768 * 1024, WS_HSC = 2 * MiB + 640 * 1024;
static_assert(WS_WIN + (size_t)NL * INW * D * 2 <= WS_WOUT && WS_PART + (size_t)NL * 8 * NB * 6 * D * 4 <= WS_KEYS && WS_MOD + (size_t)NL * NB * 6 * D * 4 <= WS_PART, "ws map");
constexpr int CW_BAR = 4096;

constexpr int RING_OFF = 0, RING_BYTES = 131072, LDSCTL_OFF = RING_BYTES, LDS_BYTES = 147456;

#define GAS __attribute__((address_space(1)))
typedef unsigned short bf16;
typedef unsigned v4u __attribute__((ext_vector_type(4)));
typedef unsigned v2u __attribute__((ext_vector_type(2)));
typedef float f32x4 __attribute__((ext_vector_type(4)));
typedef float f32x16 __attribute__((ext_vector_type(16)));
typedef short bf16x8 __attribute__((ext_vector_type(8)));
typedef __bf16 bf16x2v __attribute__((ext_vector_type(2)));
#define LDS_WAIT() asm volatile("s_waitcnt lgkmcnt(0)" ::: "memory")

__device__ __forceinline__ unsigned pk2(float lo, float hi) { return pg8::cvt_pk_bf16(lo, hi); }
__device__ __forceinline__ float dot2bf(unsigned w, unsigned x, float acc) { return __builtin_amdgcn_fdot2_f32_bf16(__builtin_bit_cast(bf16x2v, w), __builtin_bit_cast(bf16x2v, x), acc, false); }
__device__ __forceinline__ float bflo(unsigned u) { return __uint_as_float(u << 16); }
__device__ __forceinline__ float bfhi(unsigned u) { return __uint_as_float(u & 0xffff0000u); }
__device__ __forceinline__ float silu_f(float x) { return x / (1.0f + __expf(-x)); }
__device__ __forceinline__ float logsigmoid_f(float x) { return fminf(x, 0.0f) - log1pf(__expf(-fabsf(x))); }
__device__ __forceinline__ float gelu_tanh_f(float x) { const float u = 0.7978845608028654f * (x + 0.044715f * x * x * x); return 0.5f * x * (1.0f + tanhf(u)); }
__device__ __forceinline__ float wave_sum(float v) {
#pragma unroll
    for (int o = 1; o < 64; o <<= 1) v += __shfl_xor(v, o);
    return v;
}

struct Args { const float* in[19]; float* out; unsigned char* ws; int ph_lo, ph_hi; };

__device__ __forceinline__ void transpose_item(const float* W, int ldw, int col0, bf16* WTrows, int k0, int nvalid, LAS float* scr, int lane) {
    const int n = lane & 31;
    float tv[32];
#pragma unroll
    for (int i = 0; i < 32; ++i) { const int kk = 2 * i + (lane >> 5); tv[i] = (n < nvalid) ? W[(size_t)(k0 + kk) * ldw + col0 + n] : 0.f; }
#pragma unroll
    for (int i = 0; i < 32; ++i) { const int kk = 2 * i + (lane >> 5); scr[kk * 33 + n] = tv[i]; }
    LDS_WAIT(); asm volatile("" ::: "memory");
    const int c = lane & 7;
#pragma unroll
    for (int j = 0; j < 4; ++j) { const int nn = (lane >> 3) + 8 * j; const LAS float* s = scr + (8 * c) * 33 + nn;
        v4u o; o.x = pk2(s[0 * 33], s[1 * 33]); o.y = pk2(s[2 * 33], s[3 * 33]); o.z = pk2(s[4 * 33], s[5 * 33]); o.w = pk2(s[6 * 33], s[7 * 33]);
        if (nn < nvalid) *(v4u*)(WTrows + (size_t)nn * D + k0 + 8 * c) = o; }
    LDS_WAIT(); asm volatile("" ::: "memory");
}
__device__ __forceinline__ void cvt_stream(const float* src, bf16* dst, size_t n4, size_t i0, size_t stride) {
    for (size_t i = i0; i < n4; i += stride) { const f32x4 v = ((const f32x4*)src)[i]; v2u o; o.x = pk2(v.x, v.y); o.y = pk2(v.z, v.w); ((v2u*)dst)[i] = o; }
}
__device__ __forceinline__ void ph_prologue_a(const Args& a, LAS unsigned char* lds, int tid, int lane, int wave, int bx, int G) {
    const int gw = bx * NWAVES + wave, NGW = G * NWAVES;
    LAS float* cact = (LAS float*)lds;
    for (int i = tid; i < NB * D; i += NTHREADS) { const int b = i / D, d = i % D; cact[d * 8 + b] = silu_f(a.in[1][i]); }
    __syncthreads();
    float* part = (float*)(a.ws + WS_PART);
    for (int it = gw; it < NL * 8 * 48; it += NGW) {
        const int cg = it % 48, dr = (it / 48) % 8, l = it / 384;
        f32x4 acc[8];
#pragma unroll
        for (int b = 0; b < 8; ++b) acc[b] = (f32x4){0.f, 0.f, 0.f, 0.f};
        const float* w = a.in[2] + ((size_t)l * D + dr * 256) * (6 * D) + cg * 256 + lane * 4;
#pragma unroll 4
        for (int d = 0; d < 256; ++d) {
            const f32x4 wv = *(const f32x4*)(w + (size_t)d * (6 * D));
            const f32x4 c0 = *(const LAS f32x4*)(cact + (dr * 256 + d) * 8), c1 = *(const LAS f32x4*)(cact + (dr * 256 + d) * 8 + 4);
            acc[0] += wv * c0.x; acc[1] += wv * c0.y; acc[2] += wv * c0.z; acc[3] += wv * c0.w;
            acc[4] += wv * c1.x; acc[5] += wv * c1.y; acc[6] += wv * c1.z; acc[7] += wv * c1.w;
        }
#pragma unroll
        for (int b = 0; b < 8; ++b) *(f32x4*)(part + (((size_t)l * 8 + dr) * NB + b) * (6 * D) + cg * 256 + lane * 4) = acc[b];
    }
    __syncthreads();
    LAS float* scr = (LAS float*)(lds + wave * 8448);
    bf16* winT = (bf16*)(a.ws + WS_WIN); bf16* woutT = (bf16*)(a.ws + WS_WOUT); bf16* wqT = (bf16*)(a.ws + WS_WQ);
    constexpr int IPL = 6144 + 32 + 2048 + 2048;
    for (int it = gw; it < NL * IPL; it += NGW) {
        const int l = it / IPL; int r = it % IPL;
        if (r < 6144) { const int nb = r % 192, kb = r / 192, n0 = nb * 32;
            transpose_item(a.in[4] + (size_t)l * D * INW, INW, n0 < 3072 ? n0 : n0 + 16, winT + ((size_t)l * INW + n0) * D, kb * 64, 32, scr, lane); continue; }
        r -= 6144;
        if (r < 32) { transpose_item(a.in[4] + (size_t)l * D * INW, INW, 3072, winT + ((size_t)l * INW + NP) * D, r * 64, 16, scr, lane); continue; }
        r -= 32;
        if (r < 2048) { const int nb = r % 64, kb = r / 64; transpose_item(a.in[10] + (size_t)l * D * D, D, nb * 32, woutT + ((size_t)l * D + nb * 32) * D, kb * 64, 32, scr, lane); continue; }
        r -= 2048;
        { const int nb = r % 64, kb = r / 64; transpose_item(a.in[13] + (size_t)l * D * D, D, nb * 32, wqT + ((size_t)l * D + nb * 32) * D, kb * 64, 32, scr, lane); }
    }
    const size_t i0 = (size_t)bx * NTHREADS + tid, stride = (size_t)G * NTHREADS;
    cvt_stream(a.in[14], (bf16*)(a.ws + WS_KEYS), (size_t)NL * 8 * 2 * 128 * 128 / 4, i0, stride);
#if TAB4
    __syncthreads();
    { LAS float* rowst = (LAS float*)(lds + wave * 8192);
      for (int row = gw; row < 2 * NL * NE; row += NGW) {
        const int tbl = row / (NL * NE), r = row % (NL * NE);
        const float* src = (tbl ? a.in[16] : a.in[15]) + (size_t)r * D;
#pragma unroll
        for (int c8 = 0; c8 < 8; ++c8) *(LAS f32x4*)(rowst + (c8 * 64 + lane) * 4) = *(const f32x4*)(src + (c8 * 64 + lane) * 4);
        LDS_WAIT(); asm volatile("" ::: "memory");
        unsigned char* tb = a.ws + (tbl ? WS_VT : WS_UT) + (size_t)r * 1152;
#pragma unroll
        for (int pass = 0; pass < 2; ++pass) { const int slot = lane + 64 * pass;
            if (slot < 72) { const int col0 = (slot >> 3) * 240 + (slot & 7) * 30;
                float x[30]; float mx = 0.f;
#pragma unroll
                for (int k = 0; k < 30; ++k) { x[k] = (col0 + k < D) ? rowst[col0 + k] : 0.f; mx = fmaxf(mx, fabsf(x[k])); }
                int code = 0; float inv = 0.f;
                if (mx > 0.f) { code = (int)ceilf(8.0f * log2f(mx * (1.0f / 7.0f))) + 128; code = code < 0 ? 0 : (code > 255 ? 255 : code); inv = __builtin_amdgcn_exp2f(16.0f - (float)code * 0.125f); }
                unsigned dw[4] = {0u, 0u, 0u, 0u};
#pragma unroll
                for (int kb = 0; kb < 15; ++kb) { int a0 = (int)__builtin_rintf(x[2 * kb] * inv), a1 = (int)__builtin_rintf(x[2 * kb + 1] * inv);
                    a0 = a0 < -7 ? -7 : (a0 > 7 ? 7 : a0); a1 = a1 < -7 ? -7 : (a1 > 7 ? 7 : a1);
                    dw[kb >> 2] |= ((unsigned)(a0 + 8) | ((unsigned)(a1 + 8) << 4)) << (8 * (kb & 3)); }
                dw[3] |= (unsigned)code << 24;
                *(v4u*)(tb + slot * 16) = (v4u){dw[0], dw[1], dw[2], dw[3]}; } }
        LDS_WAIT(); asm volatile("" ::: "memory");
      } }
#else
    for (int row = gw; row < 2 * NL * NE; row += NGW) {
        const int tbl = row / (NL * NE), r = row % (NL * NE);
        const float* src = (tbl ? a.in[16] : a.in[15]) + (size_t)r * D;
        f32x4 v[8]; float mx = 0.f;
#pragma unroll
        for (int c8 = 0; c8 < 8; ++c8) { v[c8] = *(const f32x4*)(src + (c8 * 64 + lane) * 4); mx = fmaxf(mx, fmaxf(fmaxf(fabsf(v[c8].x), fabsf(v[c8].y)), fmaxf(fabsf(v[c8].z), fabsf(v[c8].w)))); }
#pragma unroll
        for (int o = 1; o < 64; o <<= 1) mx = fmaxf(mx, __shfl_xor(mx, o));
        const float inv = mx > 0.f ? 127.0f / mx : 0.f; const int off = tbl ? 128 : 0;
        unsigned dw[8];
#pragma unroll
        for (int c8 = 0; c8 < 8; ++c8) { const int q0 = (int)__builtin_rintf(v[c8].x * inv) + off, q1 = (int)__builtin_rintf(v[c8].y * inv) + off, q2 = (int)__builtin_rintf(v[c8].z * inv) + off, q3 = (int)__builtin_rintf(v[c8].w * inv) + off;
            dw[c8] = (unsigned)(q0 & 255) | ((unsigned)(q1 & 255) << 8) | ((unsigned)(q2 & 255) << 16) | ((unsigned)(q3 & 255) << 24); }
        unsigned char* dst = a.ws + (tbl ? WS_VT : WS_UT) + (size_t)r * D;
        *(v4u*)(dst + lane * 16) = (v4u){dw[0], dw[1], dw[2], dw[3]}; *(v4u*)(dst + (64 + lane) * 16) = (v4u){dw[4], dw[5], dw[6], dw[7]};
        if (lane == 0) ((float*)(a.ws + (tbl ? WS_SV : WS_SU)))[r] = mx * (1.0f / 127.0f);
    }
#endif
}

__device__ __forceinline__ void ln_tail(const float (&z)[32], int t, int lane, const float* g, const float* bta, float* xout, const float* sh, const float* sc, bf16* hout, unsigned char* q8, float* q8s, LAS unsigned char* q8stage = nullptr) {
    float s = 0.f;
#pragma unroll
    for (int i = 0; i < 32; ++i) s += z[i];
    const float mu = wave_sum(s) * (1.0f / D);
    float q = 0.f;
#pragma unroll
    for (int i = 0; i < 32; ++i) { const float d = z[i] - mu; q += d * d; }
    const float rs = rsqrtf(wave_sum(q) * (1.0f / D) + EPS);
    float hv[32]; float mx = 0.f;
#pragma unroll
    for (int c = 0; c < 8; ++c) { const int col = (c * 64 + lane) * 4;
        const f32x4 g0 = *(const f32x4*)(g + col), b0 = *(const f32x4*)(bta + col);
        f32x4 x0;
        x0.x = (z[c * 4 + 0] - mu) * rs * g0.x + b0.x; x0.y = (z[c * 4 + 1] - mu) * rs * g0.y + b0.y; x0.z = (z[c * 4 + 2] - mu) * rs * g0.z + b0.z; x0.w = (z[c * 4 + 3] - mu) * rs * g0.w + b0.w;
        if (xout) *(f32x4*)(xout + (size_t)t * D + col) = x0;
        if (hout) { const f32x4 s0 = *(const f32x4*)(sc + col), h0 = *(const f32x4*)(sh + col);
            hv[c * 4] = x0.x * (1.f + s0.x) + h0.x; hv[c * 4 + 1] = x0.y * (1.f + s0.y) + h0.y; hv[c * 4 + 2] = x0.z * (1.f + s0.z) + h0.z; hv[c * 4 + 3] = x0.w * (1.f + s0.w) + h0.w;
            v2u o; o.x = pk2(hv[c * 4], hv[c * 4 + 1]); o.y = pk2(hv[c * 4 + 2], hv[c * 4 + 3]);
            *(v2u*)(hout + (size_t)t * D + col) = o;
            if (q8) {
                hv[c * 4] = bflo(o.x); hv[c * 4 + 1] = bfhi(o.x); hv[c * 4 + 2] = bflo(o.y); hv[c * 4 + 3] = bfhi(o.y);
                mx = fmaxf(mx, fmaxf(fmaxf(fabsf(hv[c * 4]), fabsf(hv[c * 4 + 1])), fmaxf(fabsf(hv[c * 4 + 2]), fabsf(hv[c * 4 + 3])))); } }
    }
    if (q8) {
#pragma unroll
        for (int o = 1; o < 64; o <<= 1) mx = fmaxf(mx, __shfl_xor(mx, o));
        const float qmax_ = TAB4 ? 119.0f : 127.0f;
        const float inv = mx > 0.f ? qmax_ / mx : 0.f;
        unsigned dw[8];
#pragma unroll
        for (int c = 0; c < 8; ++c) { const int q0 = (int)__builtin_rintf(hv[c * 4] * inv), q1 = (int)__builtin_rintf(hv[c * 4 + 1] * inv), q2 = (int)__builtin_rintf(hv[c * 4 + 2] * inv), q3 = (int)__builtin_rintf(hv[c * 4 + 3] * inv);
            dw[c] = (unsigned)(q0 & 255) | ((unsigned)(q1 & 255) << 8) | ((unsigned)(q2 & 255) << 16) | ((unsigned)(q3 & 255) << 24); }
#if TAB4
        { LAS unsigned* st32 = (LAS unsigned*)q8stage; LAS unsigned char* st8 = (LAS unsigned char*)q8stage;
#pragma unroll
          for (int i = 0; i < 9; ++i) st32[lane + 64 * i] = 0u;
          LDS_WAIT(); asm volatile("" ::: "memory");
#pragma unroll
          for (int c = 0; c < 8; ++c)
#pragma unroll
              for (int jp = 0; jp < 2; ++jp) { const int col = (c * 64 + lane) * 4 + 2 * jp, u = col / 240, r = col - u * 240, l7 = r / 30, k = r - l7 * 30;
                  const int q0 = (int)(signed char)((dw[c] >> (16 * jp)) & 255u), q1 = (int)(signed char)((dw[c] >> (16 * jp + 8)) & 255u);
                  const int l0 = ((q0 + 8) & 15) - 8, l1 = ((q1 + 8) & 15) - 8, h0 = (q0 - l0) >> 4, h1 = (q1 - l1) >> 4;
                  LAS unsigned char* sp = st8 + (u * 8 + l7) * 32 + (k >> 1);
                  sp[0] = (unsigned char)((l0 & 15) | ((l1 & 15) << 4)); sp[16] = (unsigned char)((h0 & 15) | ((h1 & 15) << 4)); }
          LDS_WAIT(); asm volatile("" ::: "memory");
          unsigned* d32 = (unsigned*)(q8 + (size_t)t * 2304);
#pragma unroll
          for (int i = 0; i < 9; ++i) d32[lane + 64 * i] = st32[lane + 64 * i];
          LDS_WAIT(); asm volatile("" ::: "memory"); }
#else
        unsigned char* dst = q8 + (size_t)t * D;
        *(v4u*)(dst + lane * 16) = (v4u){dw[0], dw[1], dw[2], dw[3]}; *(v4u*)(dst + (64 + lane) * 16) = (v4u){dw[4], dw[5], dw[6], dw[7]};
#endif
        if (lane == 0) q8s[t] = mx / qmax_;
    }
}

__device__ __forceinline__ void ph_prologue_b(const Args& a, LAS unsigned char* lds, int tid, int lane, int wave, int bx, int G) {
    const float* part = (const float*)(a.ws + WS_PART); float* mod = (float*)(a.ws + WS_MOD);
    for (int i = bx * NTHREADS + tid; i < NL * NB * 6 * D / 4; i += G * NTHREADS) {
        const int idx = i * 4, e = idx % (6 * D), b = (idx / (6 * D)) % NB, l = idx / (6 * D * NB);
        f32x4 s = *(const f32x4*)(a.in[3] + l * 6 * D + e);
#pragma unroll
        for (int dr = 0; dr < 8; ++dr) s += *(const f32x4*)(part + (((size_t)l * 8 + dr) * NB + b) * (6 * D) + e);
        *(f32x4*)(mod + idx) = s;
    }
    LAS float* msh = (LAS float*)lds;
    bf16* hbuf = (bf16*)(a.ws + WS_H);
    for (int ch = bx; ch < NCHUNK; ch += G) {
        const int b = ch / NCH;
        for (int i = tid; i < 1024; i += NTHREADS) { const int e = i * 4;
            f32x4 s = *(const f32x4*)(a.in[3] + e);
#pragma unroll
            for (int dr = 0; dr < 8; ++dr) s += *(const f32x4*)(part + (((size_t)0 * 8 + dr) * NB + b) * (6 * D) + e);
            *(LAS f32x4*)(msh + e) = s; }
        __syncthreads();
        for (int i = 0; i < 8; ++i) { const int t = ch * 64 + wave * 8 + i;
#pragma unroll
            for (int c = 0; c < 4; ++c) { const int col = (c * 64 + lane) * 8;
                const f32x4 x0 = *(const f32x4*)(a.in[0] + (size_t)t * D + col), x1 = *(const f32x4*)(a.in[0] + (size_t)t * D + col + 4);
                const f32x4 h0 = *(const LAS f32x4*)(msh + col), h1 = *(const LAS f32x4*)(msh + col + 4), s0 = *(const LAS f32x4*)(msh + 2048 + col), s1 = *(const LAS f32x4*)(msh + 2048 + col + 4);
                v4u o; o.x = pk2(x0.x * (1.f + s0.x) + h0.x, x0.y * (1.f + s0.y) + h0.y); o.y = pk2(x0.z * (1.f + s0.z) + h0.z, x0.w * (1.f + s0.w) + h0.w);
                o.z = pk2(x1.x * (1.f + s1.x) + h1.x, x1.y * (1.f + s1.y) + h1.y); o.w = pk2(x1.z * (1.f + s1.z) + h1.z, x1.w * (1.f + s1.w) + h1.w);
                *(v4u*)(hbuf + (size_t)t * D + col) = o; } }
        __syncthreads();
    }
}

__device__ __forceinline__ void gate_prep(const Args& a, int l, LAS unsigned char* lds, int tid, int lane, int wave, int ch) {
    const bf16* hbuf = (const bf16*)(a.ws + WS_H); const bf16* waT = (const bf16*)(a.ws + WS_WIN) + ((size_t)l * INW + NP) * D;
    float* Ebuf = (float*)(a.ws + WS_E); float* dtot = (float*)(a.ws + WS_DTOT);
    const int t0 = ch * 64, l15 = lane & 15, lq = lane >> 4, mt = wave & 3, kh = wave >> 2;
    f32x4 acc = (f32x4){0.f, 0.f, 0.f, 0.f};
    const bf16* hA = hbuf + (size_t)(t0 + 16 * mt + l15) * D + kh * 1024 + 8 * lq;
    const bf16* wB = waT + (size_t)l15 * D + kh * 1024 + 8 * lq;
#pragma unroll 8
    for (int ks = 0; ks < 32; ++ks) { const bf16x8 av = *(const bf16x8*)(hA + 32 * ks), bv = *(const bf16x8*)(wB + 32 * ks); acc = __builtin_amdgcn_mfma_f32_16x16x32_bf16(av, bv, acc, 0, 0, 0); }
    LAS float* alr = (LAS float*)lds;
#pragma unroll
    for (int r = 0; r < 4; ++r) alr[(kh * 64 + 16 * mt + 4 * lq + r) * 16 + l15] = acc[r];
    __syncthreads();
    const int col = tid;
    float wg[16];
#pragma unroll
    for (int r = 0; r < 16; ++r) wg[r] = a.in[5][((size_t)l * RANK + r) * GKW + col];
    const float bgc = a.in[6][l * GKW + col];
    float tot = 0.f;
    for (int j = 0; j < 64; ++j) { float lg = bgc;
#pragma unroll
        for (int r4 = 0; r4 < 4; ++r4) { const f32x4 p = *(const LAS f32x4*)(alr + j * 16 + r4 * 4), q = *(const LAS f32x4*)(alr + (64 + j) * 16 + r4 * 4);
            lg += (p.x + q.x) * wg[r4 * 4] + (p.y + q.y) * wg[r4 * 4 + 1] + (p.z + q.z) * wg[r4 * 4 + 2] + (p.w + q.w) * wg[r4 * 4 + 3]; }
        tot += logsigmoid_f(lg) * (1.0f / 16.0f); }
    float run = 0.f;
    for (int j = 0; j < 64; ++j) { float lg = bgc;
#pragma unroll
        for (int r4 = 0; r4 < 4; ++r4) { const f32x4 p = *(const LAS f32x4*)(alr + j * 16 + r4 * 4), q = *(const LAS f32x4*)(alr + (64 + j) * 16 + r4 * 4);
            lg += (p.x + q.x) * wg[r4 * 4] + (p.y + q.y) * wg[r4 * 4 + 1] + (p.z + q.z) * wg[r4 * 4 + 2] + (p.w + q.w) * wg[r4 * 4 + 3]; }
        run += logsigmoid_f(lg) * (1.0f / 16.0f);
        Ebuf[(size_t)(t0 + j) * GKW + col] = __expf(tot - run); }
    dtot[(size_t)ch * GKW + col] = __expf(tot);
    __syncthreads();
}

__device__ __forceinline__ void gla_unit(const Args& a, LAS unsigned char* lds, int tid, int lane, int wave, int un) {
    const bf16* proj = (const bf16*)(a.ws + WS_PROJ); const float* Ebuf = (const float*)(a.ws + WS_E); const float* dtot = (const float*)(a.ws + WS_DTOT); bf16* ogla = (bf16*)(a.ws + WS_OGLA);
    const int pair_ = (un & 7) * 4 + (un >> 6), dvs = (un >> 3) & 7, hh = pair_ & 3, b = pair_ >> 2;
    LAS bf16* kdT = (LAS bf16*)lds;
    LAS bf16* vT = (LAS bf16*)(lds + 18432);
    LAS bf16* ST = (LAS bf16*)(lds + 18432 + 4608);
    const int l15 = lane & 15, lq = lane >> 4, jl = tid >> 3, d16 = (tid & 7) * 16, dv4 = (tid & 7) * 4, jt = (wave & 3) * 16, dvt = (wave >> 2) * 16;
#define GLA_BAR() do { asm volatile("s_waitcnt lgkmcnt(0)" ::: "memory"); __builtin_amdgcn_s_barrier(); asm volatile("" ::: "memory"); } while (0)
    f32x4 S0 = (f32x4){0.f, 0.f, 0.f, 0.f}, S1 = (f32x4){0.f, 0.f, 0.f, 0.f};
    v4u kn0[2], kn1[2]; f32x4 en0[4], en1[4]; v2u vn0, vn1; bf16x8 qn0[4], qn1[4], qc[4]; f32x4 dn0, dn1, dc;
#define GLA_LOAD(c, kn, en, vn, qn, dn) do { const int t0c = b * SEQ + (c) * 64; const bf16* pr = proj + (size_t)(t0c + jl) * NP; \
        kn[0] = *(const v4u*)(pr + PK + hh * 128 + d16); kn[1] = *(const v4u*)(pr + PK + hh * 128 + d16 + 8); \
        _Pragma("unroll") for (int i_ = 0; i_ < 4; ++i_) en[i_] = *(const f32x4*)(Ebuf + (size_t)(t0c + jl) * GKW + hh * 128 + d16 + 4 * i_); \
        vn = *(const v2u*)(pr + PV + hh * 256 + dvs * 32 + dv4); \
        _Pragma("unroll") for (int ks_ = 0; ks_ < 4; ++ks_) qn[ks_] = *(const bf16x8*)(proj + (size_t)(t0c + jt + l15) * NP + PQ + hh * 128 + 32 * ks_ + 8 * lq); \
        dn = *(const f32x4*)(dtot + (size_t)(b * NCH + (c)) * GKW + hh * 128 + 16 * wave + 4 * lq); } while (0)
#define GLA_PREP(kn, en, vn, qn, dn) do { \
        _Pragma("unroll") for (int i_ = 0; i_ < 16; ++i_) { const unsigned w_ = kn[i_ >> 3][(i_ & 7) >> 1]; const float kf_ = (i_ & 1) ? bfhi(w_) : bflo(w_); \
            kdT[(d16 + i_) * 72 + ((((jl >> 3) ^ (d16 >> 4)) & 7) << 3) + (jl & 7)] = (bf16)(pk2(kf_ * en[i_ >> 2][i_ & 3], 0.f) & 0xffffu); } \
        _Pragma("unroll") for (int i_ = 0; i_ < 4; ++i_) { const unsigned w_ = vn[i_ >> 1]; vT[(dv4 + i_) * 72 + jl] = (bf16)((i_ & 1) ? (w_ >> 16) : (w_ & 0xffffu)); } \
        _Pragma("unroll") for (int ks_ = 0; ks_ < 4; ++ks_) qc[ks_] = qn[ks_]; \
        dc = dn; } while (0)
#define GLA_BODY(c) do { \
        S0 = S0 * dc; S1 = S1 * dc; \
        _Pragma("unroll") for (int ks = 0; ks < 2; ++ks) { \
            const bf16x8 A_ = *(const LAS bf16x8*)(kdT + (16 * wave + l15) * 72 + ((((4 * ks + lq) ^ wave) & 7) << 3)); \
            const bf16x8 B0_ = *(const LAS bf16x8*)(vT + l15 * 72 + 32 * ks + 8 * lq), B1_ = *(const LAS bf16x8*)(vT + (16 + l15) * 72 + 32 * ks + 8 * lq); \
            S0 = __builtin_amdgcn_mfma_f32_16x16x32_bf16(A_, B0_, S0, 0, 0, 0); S1 = __builtin_amdgcn_mfma_f32_16x16x32_bf16(A_, B1_, S1, 0, 0, 0); } \
        { v2u w0_, w1_; w0_.x = pk2(S0.x, S0.y); w0_.y = pk2(S0.z, S0.w); w1_.x = pk2(S1.x, S1.y); w1_.y = pk2(S1.z, S1.w); \
          *(LAS v2u*)(ST + l15 * 136 + 16 * wave + 4 * lq) = w0_; *(LAS v2u*)(ST + (16 + l15) * 136 + 16 * wave + 4 * lq) = w1_; } \
        GLA_BAR(); \
        f32x4 O_ = (f32x4){0.f, 0.f, 0.f, 0.f}; \
        _Pragma("unroll") for (int ks = 0; ks < 4; ++ks) { const bf16x8 A_ = *(const LAS bf16x8*)(ST + (dvt + l15) * 136 + 32 * ks + 8 * lq); O_ = __builtin_amdgcn_mfma_f32_16x16x32_bf16(A_, qc[ks], O_, 0, 0, 0); } \
        { const f32x4 Os_ = O_ * 0.08838834764831845f; v2u ob_; ob_.x = pk2(Os_.x, Os_.y); ob_.y = pk2(Os_.z, Os_.w); \
          *(v2u*)(ogla + (size_t)(b * SEQ + (c) * 64 + jt + l15) * 1024 + hh * 256 + dvs * 32 + dvt + 4 * lq) = ob_; } } while (0)
    GLA_LOAD(0, kn0, en0, vn0, qn0, dn0); GLA_LOAD(1, kn1, en1, vn1, qn1, dn1);
    GLA_PREP(kn0, en0, vn0, qn0, dn0);
    GLA_BAR();
    for (int c = 0; c < NCH; c += 2) {
        { const int cn_ = c + 2 < NCH ? c + 2 : NCH - 1; GLA_LOAD(cn_, kn0, en0, vn0, qn0, dn0); }
        GLA_BODY(c);
        GLA_PREP(kn1, en1, vn1, qn1, dn1);
        GLA_BAR();
        { const int cn_ = c + 3 < NCH ? c + 3 : NCH - 1; GLA_LOAD(cn_, kn1, en1, vn1, qn1, dn1); }
        GLA_BODY(c + 1);
        GLA_PREP(kn0, en0, vn0, qn0, dn0);
        GLA_BAR();
    }
#undef GLA_BODY
#undef GLA_BAR
#undef GLA_LOAD
#undef GLA_PREP
}

__device__ __forceinline__ void unpack16(const v4u& p0, const v4u& p1, float (&o)[16]) {
#pragma unroll
    for (int j = 0; j < 4; ++j) { o[2 * j] = bflo(p0[j]); o[2 * j + 1] = bfhi(p0[j]); o[8 + 2 * j] = bflo(p1[j]); o[8 + 2 * j + 1] = bfhi(p1[j]); }
}
__device__ __forceinline__ void mixpost_chunk(const Args& a, int l, int lane, int wave, int ch) {
    const bf16* proj = (const bf16*)(a.ws + WS_PROJ); const bf16* ogla = (const bf16*)(a.ws + WS_OGLA); bf16* ybuf = (bf16*)(a.ws + WS_Y);
    const int c0 = 16 * lane, tfirst = ch * 64 + wave * 8, sfirst = tfirst % SEQ;
    float gn[16], cw0[16], cw1[16], cw2[16], cn[16], u1[16], u2[16];
#pragma unroll
    for (int i = 0; i < 16; ++i) { gn[i] = a.in[7][l * 256 + ((c0 + i) & 255)]; cw0[i] = a.in[8][(size_t)l * 3072 + c0 + i]; cw1[i] = a.in[8][(size_t)l * 3072 + 1024 + c0 + i];
        cw2[i] = a.in[8][(size_t)l * 3072 + 2048 + c0 + i]; cn[i] = a.in[9][l * 1024 + c0 + i]; u1[i] = 0.f; u2[i] = 0.f; }
    if (sfirst >= 2) {
        float cc[16], chh[16];
        { const bf16* pr = proj + (size_t)(tfirst - 2) * NP; unpack16(*(const v4u*)(pr + PCC + c0), *(const v4u*)(pr + PCC + c0 + 8), cc); unpack16(*(const v4u*)(pr + PCH + c0), *(const v4u*)(pr + PCH + c0 + 8), chh); }
#pragma unroll
        for (int i = 0; i < 16; ++i) u2[i] = cc[i] * chh[i];
        { const bf16* pr = proj + (size_t)(tfirst - 1) * NP; unpack16(*(const v4u*)(pr + PCC + c0), *(const v4u*)(pr + PCC + c0 + 8), cc); unpack16(*(const v4u*)(pr + PCH + c0), *(const v4u*)(pr + PCH + c0 + 8), chh); }
#pragma unroll
        for (int i = 0; i < 16; ++i) u1[i] = cc[i] * chh[i];
    }
#pragma unroll 2
    for (int it = 0; it < 8; ++it) { const int t = tfirst + it; const bf16* pr = proj + (size_t)t * NP;
        float o[16], r[16], cb[16], cc[16], chh[16];
        unpack16(*(const v4u*)(ogla + (size_t)t * 1024 + c0), *(const v4u*)(ogla + (size_t)t * 1024 + c0 + 8), o);
        unpack16(*(const v4u*)(pr + PR + c0), *(const v4u*)(pr + PR + c0 + 8), r);
        unpack16(*(const v4u*)(pr + PCB + c0), *(const v4u*)(pr + PCB + c0 + 8), cb);
        unpack16(*(const v4u*)(pr + PCC + c0), *(const v4u*)(pr + PCC + c0 + 8), cc);
        unpack16(*(const v4u*)(pr + PCH + c0), *(const v4u*)(pr + PCH + c0 + 8), chh);
        float ss = 0.f;
#pragma unroll
        for (int i = 0; i < 16; ++i) ss += o[i] * o[i];
        ss += __shfl_xor(ss, 1); ss += __shfl_xor(ss, 2); ss += __shfl_xor(ss, 4); ss += __shfl_xor(ss, 8);
        const float rg = rsqrtf(ss * (1.0f / 256.f) + EPS);
        float val[16]; float s2 = 0.f;
#pragma unroll
        for (int i = 0; i < 16; ++i) { const float u0 = cc[i] * chh[i]; val[i] = cb[i] * (cw0[i] * u2[i] + cw1[i] * u1[i] + cw2[i] * u0); s2 += val[i] * val[i]; u2[i] = u1[i]; u1[i] = u0; }
        const float rc = rsqrtf(wave_sum(s2) * (1.0f / 1024.f) + EPS);
        v4u y0, y1, y2, y3;
#pragma unroll
        for (int j = 0; j < 4; ++j) {
            y0[j] = pk2(o[2 * j] * rg * gn[2 * j] * silu_f(r[2 * j]), o[2 * j + 1] * rg * gn[2 * j + 1] * silu_f(r[2 * j + 1]));
            y1[j] = pk2(o[8 + 2 * j] * rg * gn[8 + 2 * j] * silu_f(r[8 + 2 * j]), o[9 + 2 * j] * rg * gn[9 + 2 * j] * silu_f(r[9 + 2 * j]));
            y2[j] = pk2(val[2 * j] * rc * cn[2 * j], val[2 * j + 1] * rc * cn[2 * j + 1]);
            y3[j] = pk2(val[8 + 2 * j] * rc * cn[8 + 2 * j], val[9 + 2 * j] * rc * cn[9 + 2 * j]); }
        bf16* yr = ybuf + (size_t)t * D;
        *(v4u*)(yr + c0) = y0; *(v4u*)(yr + c0 + 8) = y1; *(v4u*)(yr + 1024 + c0) = y2; *(v4u*)(yr + 1024 + c0 + 8) = y3;
    }
}

__device__ __forceinline__ void ln1_chunk(const Args& a, int l, LAS unsigned char* lds, int lane, int wave, int ch) {
    const float* zbuf = (const float*)(a.ws + WS_Z); const float* mod = (const float*)(a.ws + WS_MOD);
    const int b = ch / NCH; const float* mb = mod + ((size_t)l * NB + b) * 6 * D;
#pragma unroll 2
    for (int it = 0; it < 8; ++it) { const int t = ch * 64 + wave * 8 + it;
        float z[32];
#pragma unroll
        for (int c = 0; c < 8; ++c) { const f32x4 v0 = *(const f32x4*)(zbuf + (size_t)t * D + (c * 64 + lane) * 4); z[c * 4] = v0.x; z[c * 4 + 1] = v0.y; z[c * 4 + 2] = v0.z; z[c * 4 + 3] = v0.w; }
        ln_tail(z, t, lane, a.in[11] + (size_t)l * D, a.in[12] + (size_t)l * D, (float*)(a.ws + WS_X1), mb + 3 * D, mb + 4 * D, (bf16*)(a.ws + WS_H2), a.ws + WS_HQ8, (float*)(a.ws + WS_HSC), lds + wave * 2304);
    }
}

template <int N> __device__ __forceinline__ void bitonic_sort_desc(float (&v)[N]) {
#pragma unroll
    for (int k = 2; k <= N; k <<= 1)
#pragma unroll
        for (int j = k >> 1; j > 0; j >>= 1)
#pragma unroll
            for (int i = 0; i < N; ++i) { const int p = i ^ j; if (p > i) { const bool desc = ((i & k) == 0); const float x = v[i], y = v[p]; const float mx = fmaxf(x, y), mn = fminf(x, y); v[i] = desc ? mx : mn; v[p] = desc ? mn : mx; } }
}
__device__ __forceinline__ void merge_top16(float (&x)[16], const float (&y)[16]) {
#pragma unroll
    for (int i = 0; i < 16; ++i) x[i] = fmaxf(x[i], y[15 - i]);
#pragma unroll
    for (int j = 8; j > 0; j >>= 1)
#pragma unroll
        for (int i = 0; i < 16; ++i) { const int p = i ^ j; if (p > i) { const float u = x[i], w = x[p]; x[i] = fmaxf(u, w); x[p] = fminf(u, w); } }
}
__device__ __forceinline__ void ce_desc(float& ka, int& pa, float& kb, int& pb) { const bool sw = kb > ka; const float k0 = sw ? kb : ka, k1 = sw ? ka : kb; const int p0 = sw ? pb : pa, p1 = sw ? pa : pb; ka = k0; pa = p0; kb = k1; pb = p1; }
__device__ __forceinline__ void bitonic_sort_desc_kp(float (&k)[16], int (&p)[16]) {
#pragma unroll
    for (int kk = 2; kk <= 16; kk <<= 1)
#pragma unroll
        for (int j = kk >> 1; j > 0; j >>= 1)
#pragma unroll
            for (int i = 0; i < 16; ++i) { const int q = i ^ j; if (q > i) { if ((i & kk) == 0) ce_desc(k[i], p[i], k[q], p[q]); else ce_desc(k[q], p[q], k[i], p[i]); } }
}
__device__ __forceinline__ void merge_top16_kp(float (&k)[16], int (&p)[16], const float (&k2)[16], const int (&p2)[16]) {
#pragma unroll
    for (int i = 0; i < 16; ++i) { const bool sw = k2[15 - i] > k[i]; k[i] = sw ? k2[15 - i] : k[i]; p[i] = sw ? p2[15 - i] : p[i]; }
#pragma unroll
    for (int j = 8; j > 0; j >>= 1)
#pragma unroll
        for (int i = 0; i < 16; ++i) { const int q = i ^ j; if (q > i) ce_desc(k[i], p[i], k[q], p[q]); }
}
__device__ constexpr int cand_i(int s) { return s < 16 ? 0 : s < 24 ? 1 : s < 29 ? 2 : s < 33 ? 3 : s < 36 ? 4 : s < 38 ? 5 : s < 40 ? 6 : s < 42 ? 7 : s < 50 ? s - 34 : -1; }
__device__ constexpr int cand_j(int s) { return s < 16 ? s : s < 24 ? s - 16 : s < 29 ? s - 24 : s < 33 ? s - 29 : s < 36 ? s - 33 : s < 38 ? s - 36 : s < 40 ? s - 38 : s < 42 ? s - 40 : s < 50 ? 0 : -1; }

__device__ __forceinline__ void peer_retrieve(const Args& a, int l, LAS unsigned char* lds, int lane, int wave, int ch) {
    const bf16* qbuf = (const bf16*)(a.ws + WS_Q); const bf16* keys = (const bf16*)(a.ws + WS_KEYS) + ((size_t)(l * 8 + wave) * 2) * 128 * 128;
    LAS int* eg_e = (LAS int*)lds; LAS float* eg_g = (LAS float*)(lds + 32768);
    const int l31 = lane & 31, l5 = lane >> 5, h = wave, t0 = ch * 64;
    for (int tt = 0; tt < 2; ++tt) {
        float sv[2][16];
#pragma unroll
        for (int p = 0; p < 2; ++p) {
            f32x16 acc[4];
#pragma unroll
            for (int nt = 0; nt < 4; ++nt)
#pragma unroll
                for (int r = 0; r < 16; ++r) acc[nt][r] = 0.f;
            const bf16* qp = qbuf + (size_t)(t0 + 32 * tt + l31) * D + h * 256 + p * 128 + 8 * l5;
            const bf16* kp = keys + (size_t)(p * 128 + l31) * 128 + 8 * l5;
#pragma unroll 2
            for (int ks = 0; ks < 8; ++ks) { const bf16x8 bq = *(const bf16x8*)(qp + 16 * ks);
#pragma unroll
                for (int nt = 0; nt < 4; ++nt) { const bf16x8 ak = *(const bf16x8*)(kp + (size_t)(32 * nt) * 128 + 16 * ks); acc[nt] = __builtin_amdgcn_mfma_f32_32x32x16_bf16(ak, bq, acc[nt], 0, 0, 0); } }
            float v[4][16];
#pragma unroll
            for (int nt = 0; nt < 4; ++nt)
#pragma unroll
                for (int r = 0; r < 16; ++r) { const unsigned idx = 32u * nt + (r & 3) + 8u * (r >> 2) + 4u * l5; v[nt][r] = __uint_as_float((__float_as_uint(acc[nt][r]) & 0xffffff80u) | idx); }
#pragma unroll
            for (int nt = 0; nt < 4; ++nt) bitonic_sort_desc<16>(v[nt]);
            merge_top16(v[0], v[1]); merge_top16(v[2], v[3]); merge_top16(v[0], v[2]);
            float o[16];
#pragma unroll
            for (int i = 0; i < 16; ++i) o[i] = __shfl_xor(v[0][i], 32);
            merge_top16(v[0], o);
#pragma unroll
            for (int i = 0; i < 16; ++i) sv[p][i] = v[0][i];
        }
        LAS unsigned char* idxb = (LAS unsigned char*)(lds + 69632) + wave * 2048 + lane * 32;
        { v4u w0, w1;
#pragma unroll
          for (int q4 = 0; q4 < 4; ++q4) {
              w0[q4] = (__float_as_uint(sv[0][4 * q4]) & 127u) | ((__float_as_uint(sv[0][4 * q4 + 1]) & 127u) << 8) | ((__float_as_uint(sv[0][4 * q4 + 2]) & 127u) << 16) | ((__float_as_uint(sv[0][4 * q4 + 3]) & 127u) << 24);
              w1[q4] = (__float_as_uint(sv[1][4 * q4]) & 127u) | ((__float_as_uint(sv[1][4 * q4 + 1]) & 127u) << 8) | ((__float_as_uint(sv[1][4 * q4 + 2]) & 127u) << 16) | ((__float_as_uint(sv[1][4 * q4 + 3]) & 127u) << 24); }
          *(LAS v4u*)(idxb) = w0; *(LAS v4u*)(idxb + 16) = w1; }
        float ck[4][16];
#pragma unroll
        for (int s = 0; s < 64; ++s) {
            if (cand_i(s) >= 0) { const unsigned b0 = __float_as_uint(sv[0][cand_i(s) < 0 ? 0 : cand_i(s)]), b1 = __float_as_uint(sv[1][cand_j(s) < 0 ? 0 : cand_j(s)]);
                const float sum = __uint_as_float(b0 & 0xffffff80u) + __uint_as_float(b1 & 0xffffff80u);
                ck[s >> 4][s & 15] = __uint_as_float((__float_as_uint(sum) & 0xffffff00u) | (unsigned)((cand_i(s) < 0 ? 0 : cand_i(s)) * 16 + (cand_j(s) < 0 ? 0 : cand_j(s)))); }
            else ck[s >> 4][s & 15] = -3.0e38f; }
        bitonic_sort_desc<16>(ck[1]); bitonic_sort_desc<16>(ck[2]);
        merge_top16(ck[0], ck[1]); merge_top16(ck[2], ck[3]); merge_top16(ck[0], ck[2]);
        LDS_WAIT(); asm volatile("" ::: "memory");
        float ex[16]; int ce[16]; float den = 0.f;
        const float cmax = __uint_as_float(__float_as_uint(ck[0][0]) & 0xffffff00u);
#pragma unroll
        for (int i = 0; i < 16; ++i) { const unsigned bits = __float_as_uint(ck[0][i]); ex[i] = __expf(__uint_as_float(bits & 0xffffff00u) - cmax); den += ex[i];
            ce[i] = (int)idxb[(bits >> 4) & 15u] * 128 + (int)idxb[16 + (bits & 15u)]; }
        const float inv = 1.0f / den;
        if (l5 == 0) {
            const int base = (32 * tt + l31) * 128 + h * 16;
#pragma unroll
            for (int i4 = 0; i4 < 4; ++i4) { *(LAS v4u*)(eg_e + base + 4 * i4) = (v4u){(unsigned)ce[4 * i4], (unsigned)ce[4 * i4 + 1], (unsigned)ce[4 * i4 + 2], (unsigned)ce[4 * i4 + 3]};
                *(LAS f32x4*)(eg_g + base + 4 * i4) = (f32x4){ex[4 * i4] * inv, ex[4 * i4 + 1] * inv, ex[4 * i4 + 2] * inv, ex[4 * i4 + 3] * inv}; }
        }
        LDS_WAIT(); asm volatile("" ::: "memory");
    }
}

typedef unsigned char uc4 __attribute__((ext_vector_type(4)));
constexpr int NSLICE = 16, SLICE_SHIFT = 10;
__device__ __forceinline__ int sdot4i(unsigned w, unsigned x, int acc) { return __builtin_amdgcn_sdot4((int)w, (int)x, acc, false); }
__device__ __forceinline__ void fma_ub4(unsigned w, float s, float& y0, float& y1, float& y2, float& y3) { const uc4 b = __builtin_bit_cast(uc4, w); y0 += s * (float)b.x; y1 += s * (float)b.y; y2 += s * (float)b.z; y3 += s * (float)b.w; }
#if TAB4
__device__ __forceinline__ void peer_tail(const Args& a, int l, int t, int lane, const bf16* Yrow, const float* mb, const float* mbn, bool last) {
    const float* x1buf = (const float*)(a.ws + WS_X1);
    float z[32];
#pragma unroll
    for (int c8 = 0; c8 < 8; ++c8) { const int col = (c8 * 64 + lane) * 4;
        const v2u yb = *(const v2u*)(Yrow + col); const f32x4 yv = (f32x4){bflo(yb.x), bfhi(yb.x), bflo(yb.y), bfhi(yb.y)};
        const f32x4 x0 = *(const f32x4*)(x1buf + (size_t)t * D + col), g0 = *(const f32x4*)(mb + 5 * D + col);
        z[c8 * 4] = ALPHA * x0.x + (1.f + g0.x) * yv.x; z[c8 * 4 + 1] = ALPHA * x0.y + (1.f + g0.y) * yv.y; z[c8 * 4 + 2] = ALPHA * x0.z + (1.f + g0.z) * yv.z; z[c8 * 4 + 3] = ALPHA * x0.w + (1.f + g0.w) * yv.w; }
    ln_tail(z, t, lane, a.in[17] + (size_t)l * D, a.in[18] + (size_t)l * D, last ? a.out : (float*)(a.ws + WS_X), mbn, mbn + D, last ? (bf16*)nullptr : (bf16*)(a.ws + WS_H), nullptr, nullptr);
}
template <class TT, int N, int M> __device__ __forceinline__ void treduce(TT (&v)[N], int lane) {
    const bool c0 = (lane & M) != 0, c1 = (lane & (2 * M)) != 0, c2 = (lane & (4 * M)) != 0;
#pragma unroll
    for (int m = 0; m < N / 2; ++m) { const TT keep = c0 ? v[2 * m + 1] : v[2 * m], send = c0 ? v[2 * m] : v[2 * m + 1]; v[m] = keep + __shfl_xor(send, M); }
#pragma unroll
    for (int m = 0; m < N / 4; ++m) { const TT keep = c1 ? v[2 * m + 1] : v[2 * m], send = c1 ? v[2 * m] : v[2 * m + 1]; v[m] = keep + __shfl_xor(send, 2 * M); }
#pragma unroll
    for (int m = 0; m < N / 8; ++m) { const TT keep = c2 ? v[2 * m + 1] : v[2 * m], send = c2 ? v[2 * m] : v[2 * m + 1]; v[m] = keep + __shfl_xor(send, 4 * M); }
}
__device__ __forceinline__ void tr4x4(unsigned a, unsigned b, unsigned c, unsigned d, unsigned& t0, unsigned& t1, unsigned& t2, unsigned& t3) {
    const unsigned x0 = __builtin_amdgcn_perm(b, a, 0x05010400u), x1 = __builtin_amdgcn_perm(b, a, 0x07030602u), y0 = __builtin_amdgcn_perm(d, c, 0x05010400u), y1 = __builtin_amdgcn_perm(d, c, 0x07030602u);
    t0 = __builtin_amdgcn_perm(y0, x0, 0x05040100u); t1 = __builtin_amdgcn_perm(y0, x0, 0x07060302u); t2 = __builtin_amdgcn_perm(y1, x1, 0x05040100u); t3 = __builtin_amdgcn_perm(y1, x1, 0x07060302u);
}
__device__ __forceinline__ int sdot8i(unsigned w, unsigned x, int acc) { return __builtin_amdgcn_sdot8((int)w, (int)x, acc, false); }
__device__ __forceinline__ float slot_scale(unsigned w3) { return __builtin_amdgcn_exp2f((float)(w3 >> 24) * 0.125f - 16.0f); }
__device__ __forceinline__ void peer_experts(const Args& a, int l, LAS unsigned char* lds, int lane0, int wave, int ch) {
    const float* mod = (const float*)(a.ws + WS_MOD);
    const unsigned char* ut = a.ws + WS_UT + (size_t)l * NE * 1152; const unsigned char* vt = a.ws + WS_VT + (size_t)l * NE * 1152; const unsigned char* hq8 = a.ws + WS_HQ8;
    const float* hsc = (const float*)(a.ws + WS_HSC);
    bf16* Ybuf = (bf16*)(a.ws + WS_Z);
    const LAS int* eg_e = (const LAS int*)lds; LAS float* sw = (LAS float*)(lds + 32768);
    LAS float* apart = (LAS float*)(lds + 65536);
    const int b = ch / NCH; const bool last = (l == NL - 1);
    const float* mb = mod + ((size_t)l * NB + b) * 6 * D; const float* mbn = mod + ((size_t)(last ? l : l + 1) * NB + b) * 6 * D;
    const int tlw = wave * 8;
    { const int lane = lane0;
#pragma unroll
      for (int i = 0; i < 16; ++i) apart[tlw * 128 + i * 64 + lane] = 0.f; }
    LDS_WAIT(); asm volatile("" ::: "memory");
    {
        int laneL = lane0; asm volatile("" : "+v"(laneL)); const int lane = laneL;
        const int g = lane >> 3, l7 = lane & 7;
        v4u bufA[16], bufB[16], hA0, hA1, hB0, hB1;
#define CU_LOAD(buf, h0_, h1_, idx_) do { const int u_ = (idx_) >> 3, tl_ = tlw + ((idx_) & 7); const unsigned soff_ = (unsigned)(u_ * 128 + l7 * 16); \
            const unsigned char* hp_ = hq8 + (size_t)(ch * 64 + tl_) * 2304 + (u_ * 8 + l7) * 32; h0_ = *(const v4u*)hp_; h1_ = *(const v4u*)(hp_ + 16); \
            _Pragma("unroll") for (int i_ = 0; i_ < 16; ++i_) { const unsigned e_ = (unsigned)eg_e[tl_ * 128 + 8 * i_ + g]; buf[i_] = *(const v4u*)(ut + (size_t)(e_ * 1152u + soff_)); } } while (0)
#define CU_COMP(buf, h0_, h1_, idx_) do { const int tl_ = tlw + ((idx_) & 7); float accv_[16]; \
            _Pragma("unroll") for (int i_ = 0; i_ < 16; ++i_) { int sl_ = 0, sh_ = 0; \
                _Pragma("unroll") for (int d_ = 0; d_ < 4; ++d_) { const unsigned x_ = buf[i_][d_] ^ 0x88888888u; sl_ = sdot8i(x_, h0_[d_], sl_); sh_ = sdot8i(x_, h1_[d_], sh_); } \
                accv_[i_] = slot_scale(buf[i_][3]) * (float)(16 * sh_ + sl_); } \
            treduce<float, 16, 1>(accv_, lane); \
            apart[tl_ * 128 + 8 * l7 + g] += accv_[0]; apart[tl_ * 128 + 8 * (8 + l7) + g] += accv_[1]; } while (0)
        CU_LOAD(bufA, hA0, hA1, 0);
        for (int idx = 0; idx < 72; idx += 2) {
            CU_LOAD(bufB, hB0, hB1, idx + 1);
            CU_COMP(bufA, hA0, hA1, idx);
            { const int nx_ = idx + 2 < 72 ? idx + 2 : 71; CU_LOAD(bufA, hA0, hA1, nx_); }
            CU_COMP(bufB, hB0, hB1, idx + 1);
        }
#undef CU_LOAD
#undef CU_COMP
        LDS_WAIT(); asm volatile("" ::: "memory");
        for (int it = 0; it < 8; ++it) { const int tl = tlw + it; const float shs = hsc[ch * 64 + tl];
            const float w0 = sw[tl * 128 + lane] * gelu_tanh_f(apart[tl * 128 + lane] * shs), w1 = sw[tl * 128 + 64 + lane] * gelu_tanh_f(apart[tl * 128 + 64 + lane] * shs);
            sw[tl * 128 + lane] = w0; sw[tl * 128 + 64 + lane] = w1; }
        LDS_WAIT(); asm volatile("" ::: "memory");
    }
    {
        int laneL = lane0; asm volatile("" : "+v"(laneL)); const int lane = laneL;
        const int g = lane >> 3, l7 = lane & 7;
        v4u bufA[16], bufB[16];
#define CV_LOAD(buf, idx_) do { const int u_ = (idx_) >> 3, tl_ = tlw + ((idx_) & 7); const unsigned soff_ = (unsigned)(u_ * 128 + l7 * 16); \
            _Pragma("unroll") for (int i_ = 0; i_ < 16; ++i_) { const unsigned e_ = (unsigned)eg_e[tl_ * 128 + 8 * i_ + g]; buf[i_] = *(const v4u*)(vt + (size_t)(e_ * 1152u + soff_)); } } while (0)
#define CV_COMP(buf, idx_) do { const int u_ = (idx_) >> 3, tl_ = tlw + ((idx_) & 7); \
            float wf_[16]; float wmx_ = 0.f; \
            _Pragma("unroll") for (int i_ = 0; i_ < 16; ++i_) { wf_[i_] = sw[tl_ * 128 + 8 * i_ + g] * slot_scale(buf[i_][3]); wmx_ = fmaxf(wmx_, fabsf(wf_[i_])); } \
            wmx_ = fmaxf(wmx_, __shfl_xor(wmx_, 8)); wmx_ = fmaxf(wmx_, __shfl_xor(wmx_, 16)); wmx_ = fmaxf(wmx_, __shfl_xor(wmx_, 32));     \
            const float winv_ = wmx_ > 0.f ? 127.0f / wmx_ : 0.f, wsc_ = wmx_ * (1.0f / 127.0f); \
              \
            unsigned wq4_[4]; int wsum_ = 0; \
            _Pragma("unroll") for (int gp_ = 0; gp_ < 4; ++gp_) { \
                const unsigned m0_ = __float_as_uint(wf_[4 * gp_] * winv_ + 12582912.0f), m1_ = __float_as_uint(wf_[4 * gp_ + 1] * winv_ + 12582912.0f), m2_ = __float_as_uint(wf_[4 * gp_ + 2] * winv_ + 12582912.0f), m3_ = __float_as_uint(wf_[4 * gp_ + 3] * winv_ + 12582912.0f); \
                wq4_[gp_] = __builtin_amdgcn_perm(__builtin_amdgcn_perm(m3_, m2_, 0x0c0c0400u), __builtin_amdgcn_perm(m1_, m0_, 0x0c0c0400u), 0x05040100u); \
                wsum_ = sdot4i(wq4_[gp_], 0x01010101u, wsum_); } \
            int yi_[32]; \
            _Pragma("unroll") for (int q_ = 0; q_ < 32; ++q_) yi_[q_] = 0; \
            _Pragma("unroll") for (int gp_ = 0; gp_ < 4; ++gp_) { \
                _Pragma("unroll") for (int d_ = 0; d_ < 4; ++d_) { const unsigned A_ = buf[4 * gp_][d_], B_ = buf[4 * gp_ + 1][d_], C_ = buf[4 * gp_ + 2][d_], D_ = buf[4 * gp_ + 3][d_]; \
                    unsigned t0_, t1_, t2_, t3_; \
                    tr4x4(A_ & 0x0f0f0f0fu, B_ & 0x0f0f0f0fu, C_ & 0x0f0f0f0fu, D_ & 0x0f0f0f0fu, t0_, t1_, t2_, t3_); \
                    yi_[8 * d_] = sdot4i(t0_, wq4_[gp_], yi_[8 * d_]); yi_[8 * d_ + 2] = sdot4i(t1_, wq4_[gp_], yi_[8 * d_ + 2]); yi_[8 * d_ + 4] = sdot4i(t2_, wq4_[gp_], yi_[8 * d_ + 4]); yi_[8 * d_ + 6] = sdot4i(t3_, wq4_[gp_], yi_[8 * d_ + 6]); \
                    tr4x4((A_ >> 4) & 0x0f0f0f0fu, (B_ >> 4) & 0x0f0f0f0fu, (C_ >> 4) & 0x0f0f0f0fu, (D_ >> 4) & 0x0f0f0f0fu, t0_, t1_, t2_, t3_); \
                    yi_[8 * d_ + 1] = sdot4i(t0_, wq4_[gp_], yi_[8 * d_ + 1]); yi_[8 * d_ + 3] = sdot4i(t1_, wq4_[gp_], yi_[8 * d_ + 3]); yi_[8 * d_ + 5] = sdot4i(t2_, wq4_[gp_], yi_[8 * d_ + 5]); yi_[8 * d_ + 7] = sdot4i(t3_, wq4_[gp_], yi_[8 * d_ + 7]); } } \
            treduce<int, 32, 8>(yi_, lane); \
            wsum_ += __shfl_xor(wsum_, 8); wsum_ += __shfl_xor(wsum_, 16); wsum_ += __shfl_xor(wsum_, 32);     \
            float y_[4]; \
            _Pragma("unroll") for (int q_ = 0; q_ < 4; ++q_) y_[q_] = wsc_ * (float)(yi_[q_] - 8 * wsum_); \
            { const int colb_ = u_ * 240 + l7 * 30 + g; bf16* yr_ = Ybuf + (size_t)(ch * 64 + tl_) * D + colb_; \
              _Pragma("unroll") for (int m_ = 0; m_ < 4; ++m_) if (8 * m_ + g < 30 && colb_ + 8 * m_ < D) yr_[8 * m_] = (bf16)(pk2(y_[m_], 0.f) & 0xffffu); } } while (0)
        CV_LOAD(bufA, 0);
        for (int idx = 0; idx < 72; idx += 2) {
            CV_LOAD(bufB, idx + 1);
            CV_COMP(bufA, idx);
            { const int nx_ = idx + 2 < 72 ? idx + 2 : 71; CV_LOAD(bufA, nx_); }
            CV_COMP(bufB, idx + 1);
        }
#undef CV_LOAD
#undef CV_COMP
    }
    asm volatile("s_waitcnt vmcnt(0)" ::: "memory");
    __builtin_amdgcn_fence(__ATOMIC_ACQUIRE, "agent");
    asm volatile("s_waitcnt vmcnt(0)" ::: "memory");
    for (int it = 0; it < 8; ++it) { int laneT = lane0; asm volatile("" : "+v"(laneT)); const int t = ch * 64 + tlw + it;
        peer_tail(a, l, t, laneT, Ybuf + (size_t)t * D, mb, mbn, last); }
}
#else
__device__ __forceinline__ void peer_tail(const Args& a, int l, int t, int lane, const float* Yrow, const float* mb, const float* mbn, bool last) {
    const float* x1buf = (const float*)(a.ws + WS_X1);
    float z[32];
#pragma unroll
    for (int c = 0; c < 2; ++c)
#pragma unroll
        for (int k = 0; k < 4; ++k) { const int c8 = 4 * c + k, col = (c8 * 64 + lane) * 4;
            const v2u yb = *(const v2u*)((const bf16*)Yrow + (c * 64 + lane) * 16 + 4 * k); const f32x4 yv = (f32x4){bflo(yb.x), bfhi(yb.x), bflo(yb.y), bfhi(yb.y)};
            const f32x4 x0 = *(const f32x4*)(x1buf + (size_t)t * D + col), g0 = *(const f32x4*)(mb + 5 * D + col);
            z[c8 * 4] = ALPHA * x0.x + (1.f + g0.x) * yv.x; z[c8 * 4 + 1] = ALPHA * x0.y + (1.f + g0.y) * yv.y; z[c8 * 4 + 2] = ALPHA * x0.z + (1.f + g0.z) * yv.z; z[c8 * 4 + 3] = ALPHA * x0.w + (1.f + g0.w) * yv.w; }
    ln_tail(z, t, lane, a.in[17] + (size_t)l * D, a.in[18] + (size_t)l * D, last ? a.out : (float*)(a.ws + WS_X), mbn, mbn + D, last ? (bf16*)nullptr : (bf16*)(a.ws + WS_H), nullptr, nullptr);
}
template <class TT, int M> __device__ __forceinline__ void treduce16(TT (&v)[16], int lane) {
    const bool c0 = (lane & M) != 0, c1 = (lane & (2 * M)) != 0, c2 = (lane & (4 * M)) != 0;
#pragma unroll
    for (int m = 0; m < 8; ++m) { const TT keep = c0 ? v[2 * m + 1] : v[2 * m], send = c0 ? v[2 * m] : v[2 * m + 1]; v[m] = keep + __shfl_xor(send, M); }
#pragma unroll
    for (int m = 0; m < 4; ++m) { const TT keep = c1 ? v[2 * m + 1] : v[2 * m], send = c1 ? v[2 * m] : v[2 * m + 1]; v[m] = keep + __shfl_xor(send, 2 * M); }
#pragma unroll
    for (int m = 0; m < 2; ++m) { const TT keep = c2 ? v[2 * m + 1] : v[2 * m], send = c2 ? v[2 * m] : v[2 * m + 1]; v[m] = keep + __shfl_xor(send, 4 * M); }
}
__device__ __forceinline__ void peer_experts(const Args& a, int l, LAS unsigned char* lds, int lane0, int wave, int ch) {
    const float* mod = (const float*)(a.ws + WS_MOD);
    const unsigned char* ut = a.ws + WS_UT + (size_t)l * NE * D; const unsigned char* vt = a.ws + WS_VT + (size_t)l * NE * D; const unsigned char* hq8 = a.ws + WS_HQ8;
    const float* su = (const float*)(a.ws + WS_SU) + (size_t)l * NE; const float* sv = (const float*)(a.ws + WS_SV) + (size_t)l * NE; const float* hsc = (const float*)(a.ws + WS_HSC);
    float* Ybuf = (float*)(a.ws + WS_Z);
    const LAS int* eg_e = (const LAS int*)lds; LAS float* sw = (LAS float*)(lds + 32768);
    LAS int* apart = (LAS int*)(lds + 65536); LAS float* wtotl = (LAS float*)(lds + LDSCTL_OFF + 256);
    const int b = ch / NCH; const bool last = (l == NL - 1);
    const float* mb = mod + ((size_t)l * NB + b) * 6 * D; const float* mbn = mod + ((size_t)(last ? l : l + 1) * NB + b) * 6 * D;
    const int tlw = wave * 8;
    { const int lane = lane0;
#pragma unroll
      for (int i = 0; i < 16; ++i) apart[tlw * 128 + i * 64 + lane] = 0; }
    LDS_WAIT(); asm volatile("" ::: "memory");
    {
        int laneL = lane0; asm volatile("" : "+v"(laneL)); const int lane = laneL;
        const int g = lane >> 3, l7 = lane & 7;
        v4u bufA[16], bufB[16], hA, hB;
#define CU_LOAD(buf, hh_, idx_) do { const int cs_ = (idx_) >> 3, tl_ = tlw + ((idx_) & 7); const unsigned coff_ = (unsigned)(cs_ * 128 + l7 * 16); \
            hh_ = *(const v4u*)(hq8 + (size_t)(ch * 64 + tl_) * D + coff_); \
            _Pragma("unroll") for (int i_ = 0; i_ < 16; ++i_) { const unsigned e_ = (unsigned)eg_e[tl_ * 128 + 8 * i_ + g]; buf[i_] = *(const v4u*)(ut + (size_t)(e_ * 2048u + coff_)); } } while (0)
#define CU_COMP(buf, hh_, idx_) do { const int tl_ = tlw + ((idx_) & 7); int acc_[16]; \
            _Pragma("unroll") for (int i_ = 0; i_ < 16; ++i_) { int s_ = 0; _Pragma("unroll") for (int q_ = 0; q_ < 4; ++q_) s_ = sdot4i(buf[i_][q_], hh_[q_], s_); acc_[i_] = s_; } \
            treduce16<int, 1>(acc_, lane); \
            apart[tl_ * 128 + 8 * l7 + g] += acc_[0]; apart[tl_ * 128 + 8 * (8 + l7) + g] += acc_[1]; } while (0)
        CU_LOAD(bufA, hA, 0);
        for (int idx = 0; idx < 128; idx += 2) {
            CU_LOAD(bufB, hB, idx + 1);
            CU_COMP(bufA, hA, idx);
            if (idx + 2 < 128) CU_LOAD(bufA, hA, idx + 2);
            CU_COMP(bufB, hB, idx + 1);
        }
#undef CU_LOAD
#undef CU_COMP
        LDS_WAIT(); asm volatile("" ::: "memory");
        for (int it = 0; it < 8; ++it) { const int tl = tlw + it; const float shs = hsc[ch * 64 + tl];
            const int e0 = eg_e[tl * 128 + lane], e1 = eg_e[tl * 128 + 64 + lane];
            const float w0 = sw[tl * 128 + lane] * gelu_tanh_f((float)apart[tl * 128 + lane] * su[e0] * shs) * sv[e0];
            const float w1 = sw[tl * 128 + 64 + lane] * gelu_tanh_f((float)apart[tl * 128 + 64 + lane] * su[e1] * shs) * sv[e1];
            sw[tl * 128 + lane] = w0; sw[tl * 128 + 64 + lane] = w1;
            const float ws = wave_sum(w0 + w1);
            if (lane == 0) wtotl[tl] = ws; }
        LDS_WAIT(); asm volatile("" ::: "memory");
    }
    {
        int laneL = lane0; asm volatile("" : "+v"(laneL)); const int lane = laneL;
        const int g = lane >> 3, l7 = lane & 7;
        v4u bufA[16], bufB[16];
#define CV_LOAD(buf, idx_) do { const int cs_ = (idx_) >> 3, tl_ = tlw + ((idx_) & 7); const unsigned coff_ = (unsigned)(cs_ * 128 + l7 * 16); \
            _Pragma("unroll") for (int i_ = 0; i_ < 16; ++i_) { const unsigned e_ = (unsigned)eg_e[tl_ * 128 + 8 * i_ + g]; buf[i_] = *(const v4u*)(vt + (size_t)(e_ * 2048u + coff_)); } } while (0)
#define CV_COMP(buf, idx_) do { const int cs_ = (idx_) >> 3, tl_ = tlw + ((idx_) & 7); float y_[16]; \
            _Pragma("unroll") for (int q_ = 0; q_ < 16; ++q_) y_[q_] = 0.f; \
            _Pragma("unroll") for (int i_ = 0; i_ < 16; ++i_) { const float wr_ = sw[tl_ * 128 + 8 * i_ + g]; \
                _Pragma("unroll") for (int q_ = 0; q_ < 4; ++q_) fma_ub4(buf[i_][q_], wr_, y_[4 * q_], y_[4 * q_ + 1], y_[4 * q_ + 2], y_[4 * q_ + 3]); } \
            treduce16<float, 8>(y_, lane); \
            const float woff_ = 128.0f * wtotl[tl_]; bf16* yr_ = (bf16*)Ybuf + (size_t)(ch * 64 + tl_) * D + cs_ * 128 + l7 * 16 + g; \
            yr_[0] = (bf16)(pk2(y_[0] - woff_, 0.f) & 0xffffu); yr_[8] = (bf16)(pk2(y_[1] - woff_, 0.f) & 0xffffu); } while (0)
        CV_LOAD(bufA, 0);
        for (int idx = 0; idx < 128; idx += 2) {
            CV_LOAD(bufB, idx + 1);
            CV_COMP(bufA, idx);
            if (idx + 2 < 128) CV_LOAD(bufA, idx + 2);
            CV_COMP(bufB, idx + 1);
        }
#undef CV_LOAD
#undef CV_COMP
    }
    asm volatile("s_waitcnt vmcnt(0)" ::: "memory");
    __builtin_amdgcn_fence(__ATOMIC_ACQUIRE, "agent");
    asm volatile("s_waitcnt vmcnt(0)" ::: "memory");
    for (int it = 0; it < 8; ++it) { int laneT = lane0; asm volatile("" : "+v"(laneT)); const int t = ch * 64 + tlw + it;
        peer_tail(a, l, t, laneT, (const float*)((const bf16*)Ybuf + (size_t)t * D), mb, mbn, last); }
}

#endif

#ifndef MK_PER_PHASE
#define MK_PER_PHASE 0
#endif
__global__ void __launch_bounds__(NTHREADS, 2) mk_fwd(Args a) {
    extern __shared__ __attribute__((aligned(16))) unsigned char lds_raw[];
    LAS unsigned char* lds = (LAS unsigned char*)lds_raw;
    const int tid = threadIdx.x, lane = tid & 63, wave = __builtin_amdgcn_readfirstlane(tid >> 6), G = gridDim.x, bx = blockIdx.x;
    if (tid < 64) ((LAS unsigned*)(lds + LDSCTL_OFF))[tid] = 0u;
    __syncthreads();
    unsigned* ctl = (unsigned*)(a.ws + WS_CTL);
    XcdBarrier bar; bar.bar = ctl + CW_BAR; bar.x = 0; bar.st = nullptr;
    const bool use_bar = (a.ph_hi - a.ph_lo) > 1;
    if (use_bar) bar = xcd_barrier_post(ctl + CW_BAR, (volatile LAS unsigned*)(lds + LDSCTL_OFF));
    const int lo = a.ph_lo, hi = a.ph_hi;
#ifndef PH_MASK
#define PH_MASK 0x1ff
#endif
#define IN(k) (lo <= (k) && (k) < hi)
#define EN(b) ((PH_MASK >> (b)) & 1)
#ifndef REP_MASK
#define REP_MASK 0
#endif
#ifndef REP_EXTRA
#define REP_EXTRA 2
#endif
#define REPS(b) (1 + ((REP_MASK >> (b)) & 1) * REP_EXTRA)
#define REP_BEGIN(b) for (int rep_ = 0; rep_ < REPS(b); ++rep_) {
#define REP_END(b) if (rep_ + 1 < REPS(b)) xcd_barrier(bar); }
#define SEAM(k) do { if (IN((k) + 1)) xcd_barrier(bar); } while (0)
#define PHASE_IDS() int tidp = tid; asm volatile("" : "+v"(tidp)); const int lanep = tidp & 63, wavep = __builtin_amdgcn_readfirstlane(tidp >> 6); (void)lanep; (void)wavep
    if (EN(0) && IN(0)) { REP_BEGIN(0) PHASE_IDS(); ph_prologue_a(a, lds, tidp, lanep, wavep, bx, G); REP_END(0) SEAM(0); }
    if (EN(1) && IN(1)) { REP_BEGIN(1) PHASE_IDS(); ph_prologue_b(a, lds, tidp, lanep, wavep, bx, G); REP_END(1) SEAM(1); }
    for (int l = 0; l < NL; ++l) {
        const int pb = 2 + 7 * l;
        const float* mod = (const float*)(a.ws + WS_MOD);
        if (EN(2) && IN(pb + 0)) {
            REP_BEGIN(2) PHASE_IDS();
            pg8::Gemm g{(const pg8::bf16_t*)(a.ws + WS_H), (const pg8::bf16_t*)(a.ws + WS_WIN) + (size_t)l * INW * D, T, NP, D}; pg8::StaticOrder S; S.init(T, NP, G, bx);
            pg8::EpiBf16P E{(pg8::bf16_t*)(a.ws + WS_PROJ), NP};
            pg8::gemm_phase<pg8::EpiBf16P, pg8::StaticOrder, true, true>(lds + RING_OFF, g, S, E, tidp);
            for (int ch = bx; ch < NCHUNK; ch += G) gate_prep(a, l, lds, tidp, lanep, wavep, ch);
            REP_END(2) SEAM(pb + 0);
        }
        if (EN(3) && IN(pb + 1)) { REP_BEGIN(3) PHASE_IDS(); for (int un = bx; un < 256; un += G) gla_unit(a, lds, tidp, lanep, wavep, un); REP_END(3) SEAM(pb + 1); }
        if (EN(4) && IN(pb + 2)) { REP_BEGIN(4) PHASE_IDS(); for (int ch = bx; ch < NCHUNK; ch += G) mixpost_chunk(a, l, lanep, wavep, ch); REP_END(4) SEAM(pb + 2); }
        if (EN(5) && IN(pb + 3)) {
            REP_BEGIN(5) PHASE_IDS();
            pg8::Gemm g{(const pg8::bf16_t*)(a.ws + WS_Y), (const pg8::bf16_t*)(a.ws + WS_WOUT) + (size_t)l * D * D, T, D, D}; pg8::StaticOrder S; S.init(T, D, G, bx);
            pg8::EpiResid E{(float*)(a.ws + WS_Z), l == 0 ? a.in[0] : (const float*)(a.ws + WS_X), mod + (size_t)l * NB * 6 * D + 2 * D, ALPHA};
            pg8::gemm_phase<pg8::EpiResid, pg8::StaticOrder, true, true>(lds + RING_OFF, g, S, E, tidp);
            REP_END(5) SEAM(pb + 3);
        }
        if (EN(6) && IN(pb + 4)) { REP_BEGIN(6) PHASE_IDS(); for (int ch = bx; ch < NCHUNK; ch += G) ln1_chunk(a, l, lds, lanep, wavep, ch); REP_END(6) SEAM(pb + 4); }
        if (EN(7) && IN(pb + 5)) {
            REP_BEGIN(7) PHASE_IDS();
            pg8::Gemm g{(const pg8::bf16_t*)(a.ws + WS_H2), (const pg8::bf16_t*)(a.ws + WS_WQ) + (size_t)l * D * D, T, D, D}; pg8::StaticOrder S; S.init(T, D, G, bx);
            pg8::EpiBf16P E{(pg8::bf16_t*)(a.ws + WS_Q), D};
            pg8::gemm_phase<pg8::EpiBf16P, pg8::StaticOrder, true, true>(lds + RING_OFF, g, S, E, tidp);
            REP_END(7) SEAM(pb + 5);
        }
#ifndef PEER_DBG
#define PEER_DBG 0
#endif
#ifndef PE_REP_R
#define PE_REP_R 1
#endif
#ifndef L2PROBE
#define L2PROBE 0
#endif
        if (EN(8) && IN(pb + 6)) {
            REP_BEGIN(8)
            for (int ch = bx; ch < NCHUNK; ch += G) { for (int repr_ = 0; repr_ < PE_REP_R; ++repr_) { PHASE_IDS(); peer_retrieve(a, l, lds, lanep, wavep, ch); __syncthreads(); } __syncthreads(); { PHASE_IDS(); peer_experts(a, l, lds, lanep, wavep, ch); } __syncthreads(); }
            REP_END(8) SEAM(pb + 6);
        }
    }
#undef IN
#undef SEAM
}

extern "C" void kernel_launch(void* const* d_in, const int* in_sizes, int n_in, void* d_out, int out_size, void* d_ws, size_t ws_size, hipStream_t stream) {
    static int grid = 0;
    if (grid == 0) {
        if (n_in != 19 || in_sizes[0] != T * D || out_size != T * D || ws_size < WS_END) { fprintf(stderr, "kernel_launch: unexpected shapes / workspace (%d inputs, ws %zu); nothing launched\n", n_in, ws_size); grid = -1; return; }
        int dev = 0, cus = 0, per_cu = 0;
        if (hipGetDevice(&dev) != hipSuccess || hipDeviceGetAttribute(&cus, hipDeviceAttributeMultiprocessorCount, dev) != hipSuccess) { grid = -1; return; }
        if (hipFuncSetAttribute((const void*)mk_fwd, hipFuncAttributeMaxDynamicSharedMemorySize, LDS_BYTES) != hipSuccess) { fprintf(stderr, "kernel_launch: hipFuncSetAttribute failed\n"); grid = -1; return; }
        if (hipOccupancyMaxActiveBlocksPerMultiprocessor(&per_cu, (const void*)mk_fwd, NTHREADS, LDS_BYTES) != hipSuccess || per_cu < 1) fprintf(stderr, "kernel_launch: occupancy query reports %d\n", per_cu);
        (void)hipGetLastError();
        grid = cus;
    }
    if (grid < 0) return;
    if (hipMemsetAsync((char*)d_ws + WS_CTL, 0, CTL_ZERO_BYTES, stream) != hipSuccess) return;
    Args a{};
    for (int i = 0; i < 19; ++i) a.in[i] = (const float*)d_in[i];
    a.out = (float*)d_out; a.ws = (unsigned char*)d_ws;
#if MK_PER_PHASE
    for (int p = 0; p < NPHASES; ++p) { a.ph_lo = p; a.ph_hi = p + 1; hipLaunchKernelGGL(mk_fwd, dim3(grid), dim3(NTHREADS), LDS_BYTES, stream, a); }
#else
    a.ph_lo = 0; a.ph_hi = NPHASES;
    hipLaunchKernelGGL(mk_fwd, dim3(grid), dim3(NTHREADS), LDS_BYTES, stream, a);
#endif
}
```

```cpp
#include <hip/hip_runtime.h>
#include <cstdio>
#include <cstdint>
namespace pg8 {
#define PG8_LAS __attribute__((address_space(3)))
typedef unsigned short bf16_t;
typedef short bf16x8 __attribute__((ext_vector_type(8)));
typedef float f32x4 __attribute__((ext_vector_type(4)));
typedef unsigned u32x4 __attribute__((ext_vector_type(4)));
constexpr int BM = 256, BK = 64, HALF = 128, HTB = HALF * BK * 2  , STAGE_BYTES = 8 * HTB, NXCD = 8, WGM = 8;

__host__ __device__ __forceinline__ int lds_byte(int r, int c) { const int st = (r >> 4) * 2 + (c >> 5), rr = r & 15, cc = c & 31, ob = rr * 64 + cc * 2; return st * 1024 + (ob ^ (((ob >> 9) & 1) << 5)); }
__host__ __device__ __forceinline__ void stage_rc(int b, int& R, int& C) { const int st = b / 1024, sb = b % 1024, swz = sb ^ (((sb >> 9) & 1) << 5); R = (st >> 1) * 16 + swz / 64; C = (st & 1) * 32 + (swz % 64) / 2; }
__host__ __device__ __forceinline__ int perm32(int rho) { const int n = rho >> 4, i = rho & 15; return 8 * (i >> 2) + 4 * n + (i & 3); }

struct Unit { int pm, pn; };
struct Gemm { const bf16_t* A; const bf16_t* Bt; int M, N, K; };

struct StaticOrder {
    int nM, nN, nwg, G, c;
    __host__ __device__ void init(int M, int N, int G_, int c_) { nM = M / BM; nN = N / BM; nwg = nM * nN; G = G_; c = c_; }
    __host__ __device__ bool next(int i, Unit& u) const {
        const long L = (long)i * G + c; if (L >= nwg) return false;
        int wgid = (int)L; { const int q = nwg / NXCD, r = nwg % NXCD, xcd = wgid % NXCD, off = wgid / NXCD; wgid = (xcd < r ? xcd * (q + 1) : r * (q + 1) + (xcd - r) * q) + off; }
        const int nig = WGM * nN, gid = wgid / nig, fm = gid * WGM, gsz = (nM - fm) < WGM ? (nM - fm) : WGM;
        u.pm = fm + ((wgid % nig) % gsz); u.pn = (wgid % nig) / gsz; return true;
    }
    __device__ __forceinline__ void a_ready(const Unit&) const {}
    __device__ __forceinline__ void done(const Unit&) const {}
};
typedef __bf16 bf16x2_t __attribute__((ext_vector_type(2)));
__device__ __forceinline__ unsigned cvt_pk_bf16(float lo, float hi) { bf16x2_t r; r.x = (__bf16)lo; r.y = (__bf16)hi; return __builtin_bit_cast(unsigned, r); }
struct EpiBf16P {
    static constexpr bool PERM = true, AFTER_DRAIN = false;
    bf16_t* O; int ldc;
    __device__ __forceinline__ void operator()(const f32x4 (&acc)[2][2][4][2], const Unit& u, int wr, int wc, int fr, int fq) const {
        const int row0 = u.pm * BM + wr * 64 + fr, col0 = u.pn * BM + wc * 32 + 8 * fq;
#pragma unroll
        for (int ai = 0; ai < 2; ++ai)
#pragma unroll
            for (int m = 0; m < 4; ++m) { bf16_t* rowp = O + (size_t)(row0 + ai * HALF + m * 16) * ldc + col0;
#pragma unroll
                for (int bj = 0; bj < 2; ++bj) { const f32x4 v0 = acc[ai][bj][m][0], v1 = acc[ai][bj][m][1];
                    u32x4 w; w.x = cvt_pk_bf16(v0[0], v0[1]); w.y = cvt_pk_bf16(v0[2], v0[3]); w.z = cvt_pk_bf16(v1[0], v1[1]); w.w = cvt_pk_bf16(v1[2], v1[3]);
                    *(u32x4*)(rowp + bj * HALF) = w; } }
    }
};
struct EpiResid {
    static constexpr bool PERM = false, AFTER_DRAIN = false;
    float* Z; const float* X; const float* gate; float alpha;
    __device__ __forceinline__ void operator()(const f32x4 (&acc)[2][2][4][2], const Unit& u, int wr, int wc, int fr, int fq) const {
        const int row0 = u.pm * BM + wr * 64 + fr, col0 = u.pn * BM + wc * 32 + 4 * fq;
        const float* gb = gate + (size_t)(u.pm >> 3) * (6 * 2048) + col0;
        f32x4 gv[2][2];
#pragma unroll
        for (int bj = 0; bj < 2; ++bj)
#pragma unroll
            for (int n = 0; n < 2; ++n) gv[bj][n] = *(const f32x4*)(gb + bj * HALF + n * 16) + 1.0f;
#pragma unroll
        for (int ai = 0; ai < 2; ++ai)
#pragma unroll
            for (int m = 0; m < 4; ++m) { const size_t off = (size_t)(row0 + ai * HALF + m * 16) * 2048 + col0;
#pragma unroll
                for (int bj = 0; bj < 2; ++bj)
#pragma unroll
                    for (int n = 0; n < 2; ++n) { const f32x4 xv = *(const f32x4*)(X + off + bj * HALF + n * 16);
                        *(f32x4*)(Z + off + bj * HALF + n * 16) = xv * alpha + gv[bj][n] * acc[ai][bj][m][n]; }
                asm volatile("" ::: "memory"); }
    }
};
template <class Epi, class Sched, bool ALIGN_EPI = false, bool SP2 = false>
__device__ __forceinline__ void gemm_phase(PG8_LAS unsigned char* lds, const Gemm g, const Sched& S, const Epi& E, const int tid_in) {
    const int tid = tid_in, wid = __builtin_amdgcn_readfirstlane(tid >> 6), lane = tid & 63, wr = wid >> 2, wc = wid & 3, fr = lane & 15, fq = lane >> 4;
    const int K = g.K, nt = K / BK;
    unsigned voffA[2], voffB[2];
#pragma unroll
    for (int i = 0; i < 2; ++i) { int R, C; stage_rc(tid * 16 + i * 8192, R, C); const int Rb = Epi::PERM ? ((R & ~31) + perm32(R & 31)) : R;
        voffA[i] = (unsigned)(R * K + C) * 2u; voffB[i] = (unsigned)(Rb * K + C) * 2u; }
    const size_t kstep = (size_t)(BK * 2);
    const size_t hstep = (size_t)HALF * K * 2;
    const size_t tstep = 2 * hstep;
    const unsigned ldsw = (unsigned)wid * 1024u;
    const int aoff = lds_byte(wr * 64 + fr, fq * 8), boff = lds_byte(wc * 32 + fr, fq * 8);
#define PG8_SA(b, h) (((b) * 2 + (h)) * HTB)
#define PG8_SB(b, h) ((4 + (b) * 2 + (h)) * HTB)
#define PG8_STAGE(bufoff, gbase, voff) do { _Pragma("unroll") for (int _i = 0; _i < 2; ++_i) \
        __builtin_amdgcn_global_load_lds((const unsigned*)((const char*)(gbase) + (voff)[_i]), (PG8_LAS unsigned*)(lds + (bufoff) + ldsw + _i * 8192), 16, 0, 0); } while (0)
#define PG8_LDA(dst, b, h) do { _Pragma("unroll") for (int m = 0; m < 4; ++m) _Pragma("unroll") for (int k = 0; k < 2; ++k) dst[m][k] = *(const PG8_LAS bf16x8*)(lds + PG8_SA(b, h) + aoff + m * 2048 + k * 1024); } while (0)
#define PG8_LDB(dst, b, h) do { _Pragma("unroll") for (int n = 0; n < 2; ++n) _Pragma("unroll") for (int k = 0; k < 2; ++k) dst[n][k] = *(const PG8_LAS bf16x8*)(lds + PG8_SB(b, h) + boff + n * 2048 + k * 1024); } while (0)
#define PG8_MMA(ai, bj, At, Bt) do { __builtin_amdgcn_s_setprio(1); _Pragma("unroll") for (int m = 0; m < 4; ++m) _Pragma("unroll") for (int n = 0; n < 2; ++n) _Pragma("unroll") for (int k = 0; k < 2; ++k) \
        acc[ai][bj][m][n] = __builtin_amdgcn_mfma_f32_16x16x32_bf16(Bt[n][k], At[m][k], acc[ai][bj][m][n], 0, 0, 0); __builtin_amdgcn_s_setprio(0); } while (0)
#define PG8_WAIT_V(n) asm volatile("s_waitcnt vmcnt(" #n ")" ::: "memory")
#define PG8_WAIT_L(n) asm volatile("s_waitcnt lgkmcnt(" #n ")" ::: "memory")
#define PG8_BAR __builtin_amdgcn_s_barrier()
#define PG8_SCHED __builtin_amdgcn_sched_barrier(0)
    Unit cur, nxt; int ui = 0;
    if (!S.next(0, cur)) return;
    f32x4 acc[2][2][4][2];
#pragma unroll
    for (int a = 0; a < 2; ++a)
#pragma unroll
        for (int b = 0; b < 2; ++b)
#pragma unroll
            for (int m = 0; m < 4; ++m)
#pragma unroll
                for (int n = 0; n < 2; ++n) acc[a][b][m][n] = (f32x4){0.f, 0.f, 0.f, 0.f};
    bf16x8 At[4][2], B0[2][2], B1[2][2];
    const char* cA = (const char*)g.A + (size_t)cur.pm * tstep; const char* cB = (const char*)g.Bt + (size_t)cur.pn * tstep;
    S.a_ready(cur);
    if constexpr (SP2) {
        PG8_STAGE(PG8_SB(0, 0), cB, voffB); PG8_STAGE(PG8_SB(0, 1), cB + hstep, voffB); PG8_STAGE(PG8_SA(0, 0), cA, voffA); PG8_STAGE(PG8_SA(0, 1), cA + hstep, voffA);
        if (wr == 1) PG8_BAR;
        PG8_WAIT_V(2); PG8_BAR;
        PG8_STAGE(PG8_SB(1, 0), cB + kstep, voffB); PG8_STAGE(PG8_SA(1, 0), cA + kstep, voffA); PG8_STAGE(PG8_SB(1, 1), cB + hstep + kstep, voffB);
        PG8_WAIT_V(6); PG8_BAR;
    } else {
        PG8_STAGE(PG8_SB(0, 0), cB, voffB); PG8_STAGE(PG8_SA(0, 0), cA, voffA); PG8_STAGE(PG8_SB(0, 1), cB + hstep, voffB); PG8_STAGE(PG8_SA(0, 1), cA + hstep, voffA);
        if (wr == 1) PG8_BAR;
        PG8_WAIT_V(4); PG8_BAR;
        PG8_STAGE(PG8_SB(1, 0), cB + kstep, voffB); PG8_STAGE(PG8_SA(1, 0), cA + kstep, voffA); PG8_STAGE(PG8_SB(1, 1), cB + hstep + kstep, voffB);
        PG8_WAIT_V(6); PG8_BAR;
    }
    for (;;) {
        const bool has_next = S.next(ui + 1, nxt);
        const char* nA = has_next ? (const char*)g.A + (size_t)nxt.pm * tstep : cA; const char* nB = has_next ? (const char*)g.Bt + (size_t)nxt.pn * tstep : cB;
        for (int t = 0; t < nt; t += 2) {
            const bool last = (t == nt - 2);
            const char* a1 = cA + (size_t)(t + 1) * kstep;
            const char* a2 = last ? nA : cA + (size_t)(t + 2) * kstep; const char* b2 = last ? nB : cB + (size_t)(t + 2) * kstep;
            const char* a3 = a2 + kstep; const char* b3 = b2 + kstep;
            if (last && has_next) S.a_ready(nxt);
            if constexpr (SP2) {
            PG8_LDB(B0, 0, 0); PG8_LDB(B1, 0, 1); PG8_SCHED; PG8_LDA(At, 0, 0); PG8_STAGE(PG8_SA(1, 1), a1 + hstep, voffA);
            PG8_WAIT_V(8); PG8_WAIT_L(0); PG8_BAR; PG8_MMA(0, 0, At, B0); PG8_MMA(0, 1, At, B1); PG8_BAR; PG8_SCHED;
            PG8_LDA(At, 0, 1); PG8_STAGE(PG8_SB(0, 0), b2, voffB); PG8_STAGE(PG8_SB(0, 1), b2 + hstep, voffB); PG8_STAGE(PG8_SA(0, 0), a2, voffA);
            PG8_WAIT_V(8); PG8_WAIT_L(0); PG8_BAR; PG8_MMA(1, 0, At, B0); PG8_MMA(1, 1, At, B1); PG8_BAR; PG8_SCHED;
            PG8_LDB(B0, 1, 0); PG8_LDB(B1, 1, 1); PG8_SCHED; PG8_LDA(At, 1, 0); PG8_STAGE(PG8_SA(0, 1), a2 + hstep, voffA);
            PG8_WAIT_V(8); PG8_WAIT_L(0); PG8_BAR; PG8_MMA(0, 0, At, B0); PG8_MMA(0, 1, At, B1); PG8_BAR; PG8_SCHED;
            PG8_LDA(At, 1, 1); PG8_STAGE(PG8_SB(1, 0), b3, voffB); PG8_STAGE(PG8_SB(1, 1), b3 + hstep, voffB); PG8_STAGE(PG8_SA(1, 0), a3, voffA);
            PG8_WAIT_V(8); PG8_WAIT_L(0); PG8_BAR; PG8_MMA(1, 0, At, B0); PG8_MMA(1, 1, At, B1); PG8_BAR; PG8_SCHED;
            } else {
            PG8_LDB(B0, 0, 0); PG8_SCHED; PG8_LDA(At, 0, 0); PG8_STAGE(PG8_SA(1, 1), a1 + hstep, voffA);
            PG8_WAIT_L(8); PG8_BAR; PG8_WAIT_L(0); PG8_MMA(0, 0, At, B0); PG8_BAR; PG8_SCHED;
            PG8_LDB(B1, 0, 1); PG8_STAGE(PG8_SB(0, 0), b2, voffB);
            PG8_BAR; PG8_WAIT_L(0); PG8_MMA(0, 1, At, B1); PG8_BAR;
            PG8_LDA(At, 0, 1); PG8_STAGE(PG8_SA(0, 0), a2, voffA);
            PG8_BAR; PG8_WAIT_L(0); PG8_MMA(1, 0, At, B0); PG8_BAR; PG8_SCHED;
            PG8_STAGE(PG8_SB(0, 1), b2 + hstep, voffB);
            PG8_WAIT_V(6); PG8_BAR; PG8_MMA(1, 1, At, B1); PG8_BAR;
            PG8_LDB(B0, 1, 0); PG8_SCHED; PG8_LDA(At, 1, 0); PG8_STAGE(PG8_SA(0, 1), a2 + hstep, voffA);
            PG8_WAIT_L(8); PG8_BAR; PG8_WAIT_L(0); PG8_MMA(0, 0, At, B0); PG8_BAR; PG8_SCHED;
            PG8_LDB(B1, 1, 1); PG8_STAGE(PG8_SB(1, 0), b3, voffB);
            PG8_BAR; PG8_WAIT_L(0); PG8_MMA(0, 1, At, B1); PG8_BAR;
            PG8_LDA(At, 1, 1); PG8_STAGE(PG8_SA(1, 0), a3, voffA);
            PG8_BAR; PG8_WAIT_L(0); PG8_MMA(1, 0, At, B0); PG8_BAR; PG8_SCHED;
            PG8_STAGE(PG8_SB(1, 1), b3 + hstep, voffB);
            PG8_WAIT_V(6); PG8_BAR; PG8_MMA(1, 1, At, B1); PG8_BAR;
            }
        }
        if constexpr (ALIGN_EPI) { if (wr == 0) PG8_BAR; }
        if constexpr (!Epi::AFTER_DRAIN) { E(acc, cur, wr, wc, fr, fq); S.done(cur); }
        if (!has_next) break;
#pragma unroll
        for (int a = 0; a < 2; ++a)
#pragma unroll
            for (int b = 0; b < 2; ++b)
#pragma unroll
                for (int m = 0; m < 4; ++m)
#pragma unroll
                    for (int n = 0; n < 2; ++n) acc[a][b][m][n] = (f32x4){0.f, 0.f, 0.f, 0.f};
        cur = nxt; cA = nA; cB = nB; ++ui;
        if constexpr (ALIGN_EPI) { if (wr == 1) PG8_BAR; }
    }
    PG8_WAIT_V(0);
    if constexpr (!ALIGN_EPI) { if (wr == 0) PG8_BAR; }
    PG8_BAR;
    if constexpr (Epi::AFTER_DRAIN) { E.fused(acc, cur, wr, wc, fr, fq, lds, wid, lane); S.done(cur); }
#undef PG8_SA
#undef PG8_SB
#undef PG8_STAGE
#undef PG8_LDA
#undef PG8_LDB
#undef PG8_MMA
#undef PG8_WAIT_V
#undef PG8_WAIT_L
#undef PG8_BAR
#undef PG8_SCHED
}
}
#define XB_TMO      128
#define XB_XCNT(j)  (256  + 64 * (j))
#define XB_XSUB(j)  (1280 + 64 * (j))
#define XB_XGEN(j)  (2304 + 64 * (j))
#define XB_TOP      3328
#define XB_TOPGEN   3392
#define XCD_BAR_WORDS 3456
#define XB_SPIN_CAP (1u << 18)
#define LAS __attribute__((address_space(3)))

__device__ __forceinline__ unsigned xb_ld(unsigned* p)              { return __hip_atomic_load(p, __ATOMIC_RELAXED, __HIP_MEMORY_SCOPE_AGENT); }
__device__ __forceinline__ unsigned xb_add(unsigned* p, unsigned v) { return __hip_atomic_fetch_add(p, v, __ATOMIC_RELAXED, __HIP_MEMORY_SCOPE_AGENT); }
__device__ __forceinline__ unsigned xb_xcc_id() { return (unsigned)__builtin_amdgcn_s_getreg((3 << 11) | 20) & 0xFu; }
#define XB_SPIN(cond, bar) do { unsigned _sp = 0; while (cond) { __builtin_amdgcn_s_sleep(1); \
    if ((++_sp & 255u) == 0u) { if (xb_ld(&(bar)[XB_TMO])) break; if (_sp > XB_SPIN_CAP) { atomicAdd(&(bar)[XB_TMO], 1u); break; } } } } while (0)

struct XcdBarrier {
    unsigned* bar; unsigned x;
    volatile LAS unsigned* st;
};

__device__ __forceinline__ XcdBarrier xcd_barrier_post(unsigned* bar, volatile LAS unsigned* st) {
    XcdBarrier b; b.bar = bar; b.x = xb_xcc_id(); b.st = st;
    if (threadIdx.x == 0) (void)xb_add(&bar[XB_XCNT(b.x)], 1u);
    return b;
}
__device__ __forceinline__ void xcd_barrier_complete(unsigned* bar, unsigned x, unsigned& nloc, unsigned& nx) {
    const unsigned G = gridDim.x * gridDim.y * gridDim.z;
    unsigned sum, cnt, mine, sp = 0u;
    for (;;) {
        sum = 0u; cnt = 0u; mine = 0u;
#pragma unroll
        for (unsigned j = 0; j < 16; ++j) { const unsigned c = xb_ld(&bar[XB_XCNT(j)]); sum += c; cnt += (c > 0u) ? 1u : 0u; mine = (j == x) ? c : mine; }
        if (sum == G) break;
        __builtin_amdgcn_s_sleep(1);
        if ((++sp & 255u) == 0u) { if (xb_ld(&bar[XB_TMO])) break; if (sp > XB_SPIN_CAP) { atomicAdd(&bar[XB_TMO], 1u); break; } }
    }
    nloc = mine > 0u ? mine : 1u; nx = cnt > 0u ? cnt : 1u;
}

__device__ __forceinline__ void xcd_barrier(const XcdBarrier& b) {
    asm volatile("s_waitcnt vmcnt(0)" ::: "memory");
    __syncthreads();
    if (threadIdx.x == 0) {
        unsigned* bar = b.bar;
        __builtin_amdgcn_s_waitcnt(0);
        unsigned nloc = b.st[0], nx = b.st[1];
        if (nloc == 0u) { xcd_barrier_complete(bar, b.x, nloc, nx); b.st[0] = nloc; b.st[1] = nx; }
        const unsigned old = xb_add(&bar[XB_XSUB(b.x)], 1u);
        const unsigned gen = old / nloc;
        if (old + 1u == (gen + 1u) * nloc) {
            __builtin_amdgcn_fence(__ATOMIC_RELEASE, "agent");
            asm volatile("s_waitcnt vmcnt(0)" ::: "memory");
            const unsigned og = xb_add(&bar[XB_TOP], 1u);
            const unsigned tg = og / nx;
            if (og + 1u == (tg + 1u) * nx) xb_add(&bar[XB_TOPGEN], 1u);
            else XB_SPIN(xb_ld(&bar[XB_TOPGEN]) == tg, bar);
            __builtin_amdgcn_fence(__ATOMIC_ACQUIRE, "agent");
            xb_add(&bar[XB_XGEN(b.x)], 1u);
            asm volatile("s_waitcnt vmcnt(0)" ::: "memory");
        } else {
            XB_SPIN(xb_ld(&bar[XB_XGEN(b.x)]) == gen, bar);
            __builtin_amdgcn_fence(__ATOMIC_ACQUIRE, "agent");
            asm volatile("s_waitcnt vmcnt(0)" ::: "memory");
        }
    }
    __syncthreads();
}
constexpr int D = 2048, NB = 8, SEQ = 2048, NL = 4, T = NB * SEQ;
constexpr int NCH = SEQ / 64, NCHUNK = T / 64;
constexpr int GKW = 512, RANK = 16;
constexpr int INW = 6160, NP = 6144;
constexpr int NE = 16384;
constexpr float ALPHA = 1.6817928305074290f, EPS = 1e-5f;
constexpr int PQ = 0, PK = 512, PV = 1024, PR = 2048, PCB = 3072, PCC = 4096, PCH = 5120;
constexpr int NWAVES = 8, NTHREADS = 512;
#ifndef TAB4
#define TAB4 1
#endif
constexpr int NPHASES = 2 + 7 * NL;

constexpr size_t MiB = 1u << 20;
constexpr size_t WS_CTL = 0, CTL_ZERO_BYTES = 1 * MiB;
constexpr size_t WS_MOD = 1 * MiB, WS_PART = 3 * MiB, WS_KEYS = 15 * MiB, WS_DTOT = 17 * MiB, WS_WIN = 18 * MiB, WS_WOUT = 115 * MiB, WS_WQ = 147 * MiB;
constexpr size_t WS_UT = 179 * MiB, WS_VT = 435 * MiB, WS_H = 691 * MiB, WS_PROJ = 755 * MiB, WS_E = 947 * MiB, WS_OGLA = 979 * MiB, WS_Y = 1043 * MiB;
constexpr size_t WS_Z = 1107 * MiB, WS_X1 = 1235 * MiB, WS_X = 1363 * MiB, WS_Q = 1491 * MiB, WS_H2 = 1555 * MiB, WS_HQ8 = 1619 * MiB, WS_END = 1659 * MiB;
constexpr size_t WS_SU = 17 * MiB + 512 * 1024, WS_SV = 17 * MiB + 768 * 1024, WS_HSC = 2 * MiB + 640 * 1024;
static_assert(WS_WIN + (size_t)NL * INW * D * 2 <= WS_WOUT && WS_PART + (size_t)NL * 8 * NB * 6 * D * 4 <= WS_KEYS && WS_MOD + (size_t)NL * NB * 6 * D * 4 <= WS_PART, "ws map");
constexpr int CW_BAR = 4096;

constexpr int RING_OFF = 0, RING_BYTES = 131072, LDSCTL_OFF = RING_BYTES, LDS_BYTES = 147456;

#define GAS __attribute__((address_space(1)))
typedef unsigned short bf16;
typedef unsigned v4u __attribute__((ext_vector_type(4)));
typedef unsigned v2u __attribute__((ext_vector_type(2)));
typedef float f32x4 __attribute__((ext_vector_type(4)));
typedef float f32x16 __attribute__((ext_vector_type(16)));
typedef short bf16x8 __attribute__((ext_vector_type(8)));
typedef __bf16 bf16x2v __attribute__((ext_vector_type(2)));
#define LDS_WAIT() asm volatile("s_waitcnt lgkmcnt(0)" ::: "memory")

__device__ __forceinline__ unsigned pk2(float lo, float hi) { return pg8::cvt_pk_bf16(lo, hi); }
__device__ __forceinline__ float dot2bf(unsigned w, unsigned x, float acc) { return __builtin_amdgcn_fdot2_f32_bf16(__builtin_bit_cast(bf16x2v, w), __builtin_bit_cast(bf16x2v, x), acc, false); }
__device__ __forceinline__ float bflo(unsigned u) { return __uint_as_float(u << 16); }
__device__ __forceinline__ float bfhi(unsigned u) { return __uint_as_float(u & 0xffff0000u); }
__device__ __forceinline__ float silu_f(float x) { return x / (1.0f + __expf(-x)); }
__device__ __forceinline__ float logsigmoid_f(float x) { return fminf(x, 0.0f) - log1pf(__expf(-fabsf(x))); }
__device__ __forceinline__ float gelu_tanh_f(float x) { const float u = 0.7978845608028654f * (x + 0.044715f * x * x * x); return 0.5f * x * (1.0f + tanhf(u)); }
__device__ __forceinline__ float wave_sum(float v) {
#pragma unroll
    for (int o = 1; o < 64; o <<= 1) v += __shfl_xor(v, o);
    return v;
}

struct Args { const float* in[19]; float* out; unsigned char* ws; int ph_lo, ph_hi; };

__device__ __forceinline__ void transpose_item(const float* W, int ldw, int col0, bf16* WTrows, int k0, int nvalid, LAS float* scr, int lane) {
    const int n = lane & 31;
    float tv[32];
#pragma unroll
    for (int i = 0; i < 32; ++i) { const int kk = 2 * i + (lane >> 5); tv[i] = (n < nvalid) ? W[(size_t)(k0 + kk) * ldw + col0 + n] : 0.f; }
#pragma unroll
    for (int i = 0; i < 32; ++i) { const int kk = 2 * i + (lane >> 5); scr[kk * 33 + n] = tv[i]; }
    LDS_WAIT(); asm volatile("" ::: "memory");
    const int c = lane & 7;
#pragma unroll
    for (int j = 0; j < 4; ++j) { const int nn = (lane >> 3) + 8 * j; const LAS float* s = scr + (8 * c) * 33 + nn;
        v4u o; o.x = pk2(s[0 * 33], s[1 * 33]); o.y = pk2(s[2 * 33], s[3 * 33]); o.z = pk2(s[4 * 33], s[5 * 33]); o.w = pk2(s[6 * 33], s[7 * 33]);
        if (nn < nvalid) *(v4u*)(WTrows + (size_t)nn * D + k0 + 8 * c) = o; }
    LDS_WAIT(); asm volatile("" ::: "memory");
}
__device__ __forceinline__ void cvt_stream(const float* src, bf16* dst, size_t n4, size_t i0, size_t stride) {
    for (size_t i = i0; i < n4; i += stride) { const f32x4 v = ((const f32x4*)src)[i]; v2u o; o.x = pk2(v.x, v.y); o.y = pk2(v.z, v.w); ((v2u*)dst)[i] = o; }
}
__device__ __forceinline__ void ph_prologue_a(const Args& a, LAS unsigned char* lds, int tid, int lane, int wave, int bx, int G) {
    const int gw = bx * NWAVES + wave, NGW = G * NWAVES;
    LAS float* cact = (LAS float*)lds;
    for (int i = tid; i < NB * D; i += NTHREADS) { const int b = i / D, d = i % D; cact[d * 8 + b] = silu_f(a.in[1][i]); }
    __syncthreads();
    float* part = (float*)(a.ws + WS_PART);
    for (int it = gw; it < NL * 8 * 48; it += NGW) {
        const int cg = it % 48, dr = (it / 48) % 8, l = it / 384;
        f32x4 acc[8];
#pragma unroll
        for (int b = 0; b < 8; ++b) acc[b] = (f32x4){0.f, 0.f, 0.f, 0.f};
        const float* w = a.in[2] + ((size_t)l * D + dr * 256) * (6 * D) + cg * 256 + lane * 4;
#pragma unroll 4
        for (int d = 0; d < 256; ++d) {
            const f32x4 wv = *(const f32x4*)(w + (size_t)d * (6 * D));
            const f32x4 c0 = *(const LAS f32x4*)(cact + (dr * 256 + d) * 8), c1 = *(const LAS f32x4*)(cact + (dr * 256 + d) * 8 + 4);
            acc[0] += wv * c0.x; acc[1] += wv * c0.y; acc[2] += wv * c0.z; acc[3] += wv * c0.w;
            acc[4] += wv * c1.x; acc[5] += wv * c1.y; acc[6] += wv * c1.z; acc[7] += wv * c1.w;
        }
#pragma unroll
        for (int b = 0; b < 8; ++b) *(f32x4*)(part + (((size_t)l * 8 + dr) * NB + b) * (6 * D) + cg * 256 + lane * 4) = acc[b];
    }
    __syncthreads();
    LAS float* scr = (LAS float*)(lds + wave * 8448);
    bf16* winT = (bf16*)(a.ws + WS_WIN); bf16* woutT = (bf16*)(a.ws + WS_WOUT); bf16* wqT = (bf16*)(a.ws + WS_WQ);
    constexpr int IPL = 6144 + 32 + 2048 + 2048;
    for (int it = gw; it < NL * IPL; it += NGW) {
        const int l = it / IPL; int r = it % IPL;
        if (r < 6144) { const int nb = r % 192, kb = r / 192, n0 = nb * 32;
            transpose_item(a.in[4] + (size_t)l * D * INW, INW, n0 < 3072 ? n0 : n0 + 16, winT + ((size_t)l * INW + n0) * D, kb * 64, 32, scr, lane); continue; }
        r -= 6144;
        if (r < 32) { transpose_item(a.in[4] + (size_t)l * D * INW, INW, 3072, winT + ((size_t)l * INW + NP) * D, r * 64, 16, scr, lane); continue; }
        r -= 32;
        if (r < 2048) { const int nb = r % 64, kb = r / 64; transpose_item(a.in[10] + (size_t)l * D * D, D, nb * 32, woutT + ((size_t)l * D + nb * 32) * D, kb * 64, 32, scr, lane); continue; }
        r -= 2048;
        { const int nb = r % 64, kb = r / 64; transpose_item(a.in[13] + (size_t)l * D * D, D, nb * 32, wqT + ((size_t)l * D + nb * 32) * D, kb * 64, 32, scr, lane); }
    }
    const size_t i0 = (size_t)bx * NTHREADS + tid, stride = (size_t)G * NTHREADS;
    cvt_stream(a.in[14], (bf16*)(a.ws + WS_KEYS), (size_t)NL * 8 * 2 * 128 * 128 / 4, i0, stride);
#if TAB4
    __syncthreads();
    { LAS float* rowst = (LAS float*)(lds + wave * 8192);
      for (int row = gw; row < 2 * NL * NE; row += NGW) {
        const int tbl = row / (NL * NE), r = row % (NL * NE);
        const float* src = (tbl ? a.in[16] : a.in[15]) + (size_t)r * D;
#pragma unroll
        for (int c8 = 0; c8 < 8; ++c8) *(LAS f32x4*)(rowst + (c8 * 64 + lane) * 4) = *(const f32x4*)(src + (c8 * 64 + lane) * 4);
        LDS_WAIT(); asm volatile("" ::: "memory");
        unsigned char* tb = a.ws + (tbl ? WS_VT : WS_UT) + (size_t)r * 1152;
#pragma unroll
        for (int pass = 0; pass < 2; ++pass) { const int slot = lane + 64 * pass;
            if (slot < 72) { const int col0 = (slot >> 3) * 240 + (slot & 7) * 30;
                float x[30]; float mx = 0.f;
#pragma unroll
                for (int k = 0; k < 30; ++k) { x[k] = (col0 + k < D) ? rowst[col0 + k] : 0.f; mx = fmaxf(mx, fabsf(x[k])); }
                int code = 0; float inv = 0.f;
                if (mx > 0.f) { code = (int)ceilf(8.0f * log2f(mx * (1.0f / 7.0f))) + 128; code = code < 0 ? 0 : (code > 255 ? 255 : code); inv = __builtin_amdgcn_exp2f(16.0f - (float)code * 0.125f); }
                unsigned dw[4] = {0u, 0u, 0u, 0u};
#pragma unroll
                for (int kb = 0; kb < 15; ++kb) { int a0 = (int)__builtin_rintf(x[2 * kb] * inv), a1 = (int)__builtin_rintf(x[2 * kb + 1] * inv);
                    a0 = a0 < -7 ? -7 : (a0 > 7 ? 7 : a0); a1 = a1 < -7 ? -7 : (a1 > 7 ? 7 : a1);
                    dw[kb >> 2] |= ((unsigned)(a0 + 8) | ((unsigned)(a1 + 8) << 4)) << (8 * (kb & 3)); }
                dw[3] |= (unsigned)code << 24;
                *(v4u*)(tb + slot * 16) = (v4u){dw[0], dw[1], dw[2], dw[3]}; } }
        LDS_WAIT(); asm volatile("" ::: "memory");
      } }
#else
    for (int row = gw; row < 2 * NL * NE; row += NGW) {
        const int tbl = row / (NL * NE), r = row % (NL * NE);
        const float* src = (tbl ? a.in[16] : a.in[15]) + (size_t)r * D;
        f32x4 v[8]; float mx = 0.f;
#pragma unroll
        for (int c8 = 0; c8 < 8; ++c8) { v[c8] = *(const f32x4*)(src + (c8 * 64 + lane) * 4); mx = fmaxf(mx, fmaxf(fmaxf(fabsf(v[c8].x), fabsf(v[c8].y)), fmaxf(fabsf(v[c8].z), fabsf(v[c8].w)))); }
#pragma unroll
        for (int o = 1; o < 64; o <<= 1) mx = fmaxf(mx, __shfl_xor(mx, o));
        const float inv = mx > 0.f ? 127.0f / mx : 0.f; const int off = tbl ? 128 : 0;
        unsigned dw[8];
#pragma unroll
        for (int c8 = 0; c8 < 8; ++c8) { const int q0 = (int)__builtin_rintf(v[c8].x * inv) + off, q1 = (int)__builtin_rintf(v[c8].y * inv) + off, q2 = (int)__builtin_rintf(v[c8].z * inv) + off, q3 = (int)__builtin_rintf(v[c8].w * inv) + off;
            dw[c8] = (unsigned)(q0 & 255) | ((unsigned)(q1 & 255) << 8) | ((unsigned)(q2 & 255) << 16) | ((unsigned)(q3 & 255) << 24); }
        unsigned char* dst = a.ws + (tbl ? WS_VT : WS_UT) + (size_t)r * D;
        *(v4u*)(dst + lane * 16) = (v4u){dw[0], dw[1], dw[2], dw[3]}; *(v4u*)(dst + (64 + lane) * 16) = (v4u){dw[4], dw[5], dw[6], dw[7]};
        if (lane == 0) ((float*)(a.ws + (tbl ? WS_SV : WS_SU)))[r] = mx * (1.0f / 127.0f);
    }
#endif
}

__device__ __forceinline__ void ln_tail(const float (&z)[32], int t, int lane, const float* g, const float* bta, float* xout, const float* sh, const float* sc, bf16* hout, unsigned char* q8, float* q8s, LAS unsigned char* q8stage = nullptr) {
    float s = 0.f;
#pragma unroll
    for (int i = 0; i < 32; ++i) s += z[i];
    const float mu = wave_sum(s) * (1.0f / D);
    float q = 0.f;
#pragma unroll
    for (int i = 0; i < 32; ++i) { const float d = z[i] - mu; q += d * d; }
    const float rs = rsqrtf(wave_sum(q) * (1.0f / D) + EPS);
    float hv[32]; float mx = 0.f;
#pragma unroll
    for (int c = 0; c < 8; ++c) { const int col = (c * 64 + lane) * 4;
        const f32x4 g0 = *(const f32x4*)(g + col), b0 = *(const f32x4*)(bta + col);
        f32x4 x0;
        x0.x = (z[c * 4 + 0] - mu) * rs * g0.x + b0.x; x0.y = (z[c * 4 + 1] - mu) * rs * g0.y + b0.y; x0.z = (z[c * 4 + 2] - mu) * rs * g0.z + b0.z; x0.w = (z[c * 4 + 3] - mu) * rs * g0.w + b0.w;
        if (xout) *(f32x4*)(xout + (size_t)t * D + col) = x0;
        if (hout) { const f32x4 s0 = *(const f32x4*)(sc + col), h0 = *(const f32x4*)(sh + col);
            hv[c * 4] = x0.x * (1.f + s0.x) + h0.x; hv[c * 4 + 1] = x0.y * (1.f + s0.y) + h0.y; hv[c * 4 + 2] = x0.z * (1.f + s0.z) + h0.z; hv[c * 4 + 3] = x0.w * (1.f + s0.w) + h0.w;
            v2u o; o.x = pk2(hv[c * 4], hv[c * 4 + 1]); o.y = pk2(hv[c * 4 + 2], hv[c * 4 + 3]);
            *(v2u*)(hout + (size_t)t * D + col) = o;
            if (q8) {
                hv[c * 4] = bflo(o.x); hv[c * 4 + 1] = bfhi(o.x); hv[c * 4 + 2] = bflo(o.y); hv[c * 4 + 3] = bfhi(o.y);
                mx = fmaxf(mx, fmaxf(fmaxf(fabsf(hv[c * 4]), fabsf(hv[c * 4 + 1])), fmaxf(fabsf(hv[c * 4 + 2]), fabsf(hv[c * 4 + 3])))); } }
    }
    if (q8) {
#pragma unroll
        for (int o = 1; o < 64; o <<= 1) mx = fmaxf(mx, __shfl_xor(mx, o));
        const float qmax_ = TAB4 ? 119.0f : 127.0f;
        const float inv = mx > 0.f ? qmax_ / mx : 0.f;
        unsigned dw[8];
#pragma unroll
        for (int c = 0; c < 8; ++c) { const int q0 = (int)__builtin_rintf(hv[c * 4] * inv), q1 = (int)__builtin_rintf(hv[c * 4 + 1] * inv), q2 = (int)__builtin_rintf(hv[c * 4 + 2] * inv), q3 = (int)__builtin_rintf(hv[c * 4 + 3] * inv);
            dw[c] = (unsigned)(q0 & 255) | ((unsigned)(q1 & 255) << 8) | ((unsigned)(q2 & 255) << 16) | ((unsigned)(q3 & 255) << 24); }
#if TAB4
        { LAS unsigned* st32 = (LAS unsigned*)q8stage; LAS unsigned char* st8 = (LAS unsigned char*)q8stage;
#pragma unroll
          for (int i = 0; i < 9; ++i) st32[lane + 64 * i] = 0u;
          LDS_WAIT(); asm volatile("" ::: "memory");
#pragma unroll
          for (int c = 0; c < 8; ++c)
#pragma unroll
              for (int jp = 0; jp < 2; ++jp) { const int col = (c * 64 + lane) * 4 + 2 * jp, u = col / 240, r = col - u * 240, l7 = r / 30, k = r - l7 * 30;
                  const int q0 = (int)(signed char)((dw[c] >> (16 * jp)) & 255u), q1 = (int)(signed char)((dw[c] >> (16 * jp + 8)) & 255u);
                  const int l0 = ((q0 + 8) & 15) - 8, l1 = ((q1 + 8) & 15) - 8, h0 = (q0 - l0) >> 4, h1 = (q1 - l1) >> 4;
                  LAS unsigned char* sp = st8 + (u * 8 + l7) * 32 + (k >> 1);
                  sp[0] = (unsigned char)((l0 & 15) | ((l1 & 15) << 4)); sp[16] = (unsigned char)((h0 & 15) | ((h1 & 15) << 4)); }
          LDS_WAIT(); asm volatile("" ::: "memory");
          unsigned* d32 = (unsigned*)(q8 + (size_t)t * 2304);
#pragma unroll
          for (int i = 0; i < 9; ++i) d32[lane + 64 * i] = st32[lane + 64 * i];
          LDS_WAIT(); asm volatile("" ::: "memory"); }
#else
        unsigned char* dst = q8 + (size_t)t * D;
        *(v4u*)(dst + lane * 16) = (v4u){dw[0], dw[1], dw[2], dw[3]}; *(v4u*)(dst + (64 + lane) * 16) = (v4u){dw[4], dw[5], dw[6], dw[7]};
#endif
        if (lane == 0) q8s[t] = mx / qmax_;
    }
}

__device__ __forceinline__ void ph_prologue_b(const Args& a, LAS unsigned char* lds, int tid, int lane, int wave, int bx, int G) {
    const float* part = (const float*)(a.ws + WS_PART); float* mod = (float*)(a.ws + WS_MOD);
    for (int i = bx * NTHREADS + tid; i < NL * NB * 6 * D / 4; i += G * NTHREADS) {
        const int idx = i * 4, e = idx % (6 * D), b = (idx / (6 * D)) % NB, l = idx / (6 * D * NB);
        f32x4 s = *(const f32x4*)(a.in[3] + l * 6 * D + e);
#pragma unroll
        for (int dr = 0; dr < 8; ++dr) s += *(const f32x4*)(part + (((size_t)l * 8 + dr) * NB + b) * (6 * D) + e);
        *(f32x4*)(mod + idx) = s;
    }
    LAS float* msh = (LAS float*)lds;
    bf16* hbuf = (bf16*)(a.ws + WS_H);
    for (int ch = bx; ch < NCHUNK; ch += G) {
        const int b = ch / NCH;
        for (int i = tid; i < 1024; i += NTHREADS) { const int e = i * 4;
            f32x4 s = *(const f32x4*)(a.in[3] + e);
#pragma unroll
            for (int dr = 0; dr < 8; ++dr) s += *(const f32x4*)(part + (((size_t)0 * 8 + dr) * NB + b) * (6 * D) + e);
            *(LAS f32x4*)(msh + e) = s; }
        __syncthreads();
        for (int i = 0; i < 8; ++i) { const int t = ch * 64 + wave * 8 + i;
#pragma unroll
            for (int c = 0; c < 4; ++c) { const int col = (c * 64 + lane) * 8;
                const f32x4 x0 = *(const f32x4*)(a.in[0] + (size_t)t * D + col), x1 = *(const f32x4*)(a.in[0] + (size_t)t * D + col + 4);
                const f32x4 h0 = *(const LAS f32x4*)(msh + col), h1 = *(const LAS f32x4*)(msh + col + 4), s0 = *(const LAS f32x4*)(msh + 2048 + col), s1 = *(const LAS f32x4*)(msh + 2048 + col + 4);
                v4u o; o.x = pk2(x0.x * (1.f + s0.x) + h0.x, x0.y * (1.f + s0.y) + h0.y); o.y = pk2(x0.z * (1.f + s0.z) + h0.z, x0.w * (1.f + s0.w) + h0.w);
                o.z = pk2(x1.x * (1.f + s1.x) + h1.x, x1.y * (1.f + s1.y) + h1.y); o.w = pk2(x1.z * (1.f + s1.z) + h1.z, x1.w * (1.f + s1.w) + h1.w);
                *(v4u*)(hbuf + (size_t)t * D + col) = o; } }
        __syncthreads();
    }
}

__device__ __forceinline__ void gate_prep(const Args& a, int l, LAS unsigned char* lds, int tid, int lane, int wave, int ch) {
    const bf16* hbuf = (const bf16*)(a.ws + WS_H); const bf16* waT = (const bf16*)(a.ws + WS_WIN) + ((size_t)l * INW + NP) * D;
    float* Ebuf = (float*)(a.ws + WS_E); float* dtot = (float*)(a.ws + WS_DTOT);
    const int t0 = ch * 64, l15 = lane & 15, lq = lane >> 4, mt = wave & 3, kh = wave >> 2;
    f32x4 acc = (f32x4){0.f, 0.f, 0.f, 0.f};
    const bf16* hA = hbuf + (size_t)(t0 + 16 * mt + l15) * D + kh * 1024 + 8 * lq;
    const bf16* wB = waT + (size_t)l15 * D + kh * 1024 + 8 * lq;
#pragma unroll 8
    for (int ks = 0; ks < 32; ++ks) { const bf16x8 av = *(const bf16x8*)(hA + 32 * ks), bv = *(const bf16x8*)(wB + 32 * ks); acc = __builtin_amdgcn_mfma_f32_16x16x32_bf16(av, bv, acc, 0, 0, 0); }
    LAS float* alr = (LAS float*)lds;
#pragma unroll
    for (int r = 0; r < 4; ++r) alr[(kh * 64 + 16 * mt + 4 * lq + r) * 16 + l15] = acc[r];
    __syncthreads();
    const int col = tid;
    float wg[16];
#pragma unroll
    for (int r = 0; r < 16; ++r) wg[r] = a.in[5][((size_t)l * RANK + r) * GKW + col];
    const float bgc = a.in[6][l * GKW + col];
    float tot = 0.f;
    for (int j = 0; j < 64; ++j) { float lg = bgc;
#pragma unroll
        for (int r4 = 0; r4 < 4; ++r4) { const f32x4 p = *(const LAS f32x4*)(alr + j * 16 + r4 * 4), q = *(const LAS f32x4*)(alr + (64 + j) * 16 + r4 * 4);
            lg += (p.x + q.x) * wg[r4 * 4] + (p.y + q.y) * wg[r4 * 4 + 1] + (p.z + q.z) * wg[r4 * 4 + 2] + (p.w + q.w) * wg[r4 * 4 + 3]; }
        tot += logsigmoid_f(lg) * (1.0f / 16.0f); }
    float run = 0.f;
    for (int j = 0; j < 64; ++j) { float lg = bgc;
#pragma unroll
        for (int r4 = 0; r4 < 4; ++r4) { const f32x4 p = *(const LAS f32x4*)(alr + j * 16 + r4 * 4), q = *(const LAS f32x4*)(alr + (64 + j) * 16 + r4 * 4);
            lg += (p.x + q.x) * wg[r4 * 4] + (p.y + q.y) * wg[r4 * 4 + 1] + (p.z + q.z) * wg[r4 * 4 + 2] + (p.w + q.w) * wg[r4 * 4 + 3]; }
        run += logsigmoid_f(lg) * (1.0f / 16.0f);
        Ebuf[(size_t)(t0 + j) * GKW + col] = __expf(tot - run); }
    dtot[(size_t)ch * GKW + col] = __expf(tot);
    __syncthreads();
}

__device__ __forceinline__ void gla_unit(const Args& a, LAS unsigned char* lds, int tid, int lane, int wave, int un) {
    const bf16* proj = (const bf16*)(a.ws + WS_PROJ); const float* Ebuf = (const float*)(a.ws + WS_E); const float* dtot = (const float*)(a.ws + WS_DTOT); bf16* ogla = (bf16*)(a.ws + WS_OGLA);
    const int pair_ = (un & 7) * 4 + (un >> 6), dvs = (un >> 3) & 7, hh = pair_ & 3, b = pair_ >> 2;
    LAS bf16* kdT = (LAS bf16*)lds;
    LAS bf16* vT = (LAS bf16*)(lds + 18432);
    LAS bf16* ST = (LAS bf16*)(lds + 18432 + 4608);
    const int l15 = lane & 15, lq = lane >> 4, jl = tid >> 3, d16 = (tid & 7) * 16, dv4 = (tid & 7) * 4, jt = (wave & 3) * 16, dvt = (wave >> 2) * 16;
#define GLA_BAR() do { asm volatile("s_waitcnt lgkmcnt(0)" ::: "memory"); __builtin_amdgcn_s_barrier(); asm volatile("" ::: "memory"); } while (0)
    f32x4 S0 = (f32x4){0.f, 0.f, 0.f, 0.f}, S1 = (f32x4){0.f, 0.f, 0.f, 0.f};
    v4u kn0[2], kn1[2]; f32x4 en0[4], en1[4]; v2u vn0, vn1; bf16x8 qn0[4], qn1[4], qc[4]; f32x4 dn0, dn1, dc;
#define GLA_LOAD(c, kn, en, vn, qn, dn) do { const int t0c = b * SEQ + (c) * 64; const bf16* pr = proj + (size_t)(t0c + jl) * NP; \
        kn[0] = *(const v4u*)(pr + PK + hh * 128 + d16); kn[1] = *(const v4u*)(pr + PK + hh * 128 + d16 + 8); \
        _Pragma("unroll") for (int i_ = 0; i_ < 4; ++i_) en[i_] = *(const f32x4*)(Ebuf + (size_t)(t0c + jl) * GKW + hh * 128 + d16 + 4 * i_); \
        vn = *(const v2u*)(pr + PV + hh * 256 + dvs * 32 + dv4); \
        _Pragma("unroll") for (int ks_ = 0; ks_ < 4; ++ks_) qn[ks_] = *(const bf16x8*)(proj + (size_t)(t0c + jt + l15) * NP + PQ + hh * 128 + 32 * ks_ + 8 * lq); \
        dn = *(const f32x4*)(dtot + (size_t)(b * NCH + (c)) * GKW + hh * 128 + 16 * wave + 4 * lq); } while (0)
#define GLA_PREP(kn, en, vn, qn, dn) do { \
        _Pragma("unroll") for (int i_ = 0; i_ < 16; ++i_) { const unsigned w_ = kn[i_ >> 3][(i_ & 7) >> 1]; const float kf_ = (i_ & 1) ? bfhi(w_) : bflo(w_); \
            kdT[(d16 + i_) * 72 + ((((jl >> 3) ^ (d16 >> 4)) & 7) << 3) + (jl & 7)] = (bf16)(pk2(kf_ * en[i_ >> 2][i_ & 3], 0.f) & 0xffffu); } \
        _Pragma("unroll") for (int i_ = 0; i_ < 4; ++i_) { const unsigned w_ = vn[i_ >> 1]; vT[(dv4 + i_) * 72 + jl] = (bf16)((i_ & 1) ? (w_ >> 16) : (w_ & 0xffffu)); } \
        _Pragma("unroll") for (int ks_ = 0; ks_ < 4; ++ks_) qc[ks_] = qn[ks_]; \
        dc = dn; } while (0)
#define GLA_BODY(c) do { \
        S0 = S0 * dc; S1 = S1 * dc; \
        _Pragma("unroll") for (int ks = 0; ks < 2; ++ks) { \
            const bf16x8 A_ = *(const LAS bf16x8*)(kdT + (16 * wave + l15) * 72 + ((((4 * ks + lq) ^ wave) & 7) << 3)); \
            const bf16x8 B0_ = *(const LAS bf16x8*)(vT + l15 * 72 + 32 * ks + 8 * lq), B1_ = *(const LAS bf16x8*)(vT + (16 + l15) * 72 + 32 * ks + 8 * lq); \
            S0 = __builtin_amdgcn_mfma_f32_16x16x32_bf16(A_, B0_, S0, 0, 0, 0); S1 = __builtin_amdgcn_mfma_f32_16x16x32_bf16(A_, B1_, S1, 0, 0, 0); } \
        { v2u w0_, w1_; w0_.x = pk2(S0.x, S0.y); w0_.y = pk2(S0.z, S0.w); w1_.x = pk2(S1.x, S1.y); w1_.y = pk2(S1.z, S1.w); \
          *(LAS v2u*)(ST + l15 * 136 + 16 * wave + 4 * lq) = w0_; *(LAS v2u*)(ST + (16 + l15) * 136 + 16 * wave + 4 * lq) = w1_; } \
        GLA_BAR(); \
        f32x4 O_ = (f32x4){0.f, 0.f, 0.f, 0.f}; \
        _Pragma("unroll") for (int ks = 0; ks < 4; ++ks) { const bf16x8 A_ = *(const LAS bf16x8*)(ST + (dvt + l15) * 136 + 32 * ks + 8 * lq); O_ = __builtin_amdgcn_mfma_f32_16x16x32_bf16(A_, qc[ks], O_, 0, 0, 0); } \
        { const f32x4 Os_ = O_ * 0.08838834764831845f; v2u ob_; ob_.x = pk2(Os_.x, Os_.y); ob_.y = pk2(Os_.z, Os_.w); \
          *(v2u*)(ogla + (size_t)(b * SEQ + (c) * 64 + jt + l15) * 1024 + hh * 256 + dvs * 32 + dvt + 4 * lq) = ob_; } } while (0)
    GLA_LOAD(0, kn0, en0, vn0, qn0, dn0); GLA_LOAD(1, kn1, en1, vn1, qn1, dn1);
    GLA_PREP(kn0, en0, vn0, qn0, dn0);
    GLA_BAR();
    for (int c = 0; c < NCH; c += 2) {
        { const int cn_ = c + 2 < NCH ? c + 2 : NCH - 1; GLA_LOAD(cn_, kn0, en0, vn0, qn0, dn0); }
        GLA_BODY(c);
        GLA_PREP(kn1, en1, vn1, qn1, dn1);
        GLA_BAR();
        { const int cn_ = c + 3 < NCH ? c + 3 : NCH - 1; GLA_LOAD(cn_, kn1, en1, vn1, qn1, dn1); }
        GLA_BODY(c + 1);
        GLA_PREP(kn0, en0, vn0, qn0, dn0);
        GLA_BAR();
    }
#undef GLA_BODY
#undef GLA_BAR
#undef GLA_LOAD
#undef GLA_PREP
}

__device__ __forceinline__ void unpack16(const v4u& p0, const v4u& p1, float (&o)[16]) {
#pragma unroll
    for (int j = 0; j < 4; ++j) { o[2 * j] = bflo(p0[j]); o[2 * j + 1] = bfhi(p0[j]); o[8 + 2 * j] = bflo(p1[j]); o[8 + 2 * j + 1] = bfhi(p1[j]); }
}
__device__ __forceinline__ void mixpost_chunk(const Args& a, int l, int lane, int wave, int ch) {
    const bf16* proj = (const bf16*)(a.ws + WS_PROJ); const bf16* ogla = (const bf16*)(a.ws + WS_OGLA); bf16* ybuf = (bf16*)(a.ws + WS_Y);
    const int c0 = 16 * lane, tfirst = ch * 64 + wave * 8, sfirst = tfirst % SEQ;
    float gn[16], cw0[16], cw1[16], cw2[16], cn[16], u1[16], u2[16];
#pragma unroll
    for (int i = 0; i < 16; ++i) { gn[i] = a.in[7][l * 256 + ((c0 + i) & 255)]; cw0[i] = a.in[8][(size_t)l * 3072 + c0 + i]; cw1[i] = a.in[8][(size_t)l * 3072 + 1024 + c0 + i];
        cw2[i] = a.in[8][(size_t)l * 3072 + 2048 + c0 + i]; cn[i] = a.in[9][l * 1024 + c0 + i]; u1[i] = 0.f; u2[i] = 0.f; }
    if (sfirst >= 2) {
        float cc[16], chh[16];
        { const bf16* pr = proj + (size_t)(tfirst - 2) * NP; unpack16(*(const v4u*)(pr + PCC + c0), *(const v4u*)(pr + PCC + c0 + 8), cc); unpack16(*(const v4u*)(pr + PCH + c0), *(const v4u*)(pr + PCH + c0 + 8), chh); }
#pragma unroll
        for (int i = 0; i < 16; ++i) u2[i] = cc[i] * chh[i];
        { const bf16* pr = proj + (size_t)(tfirst - 1) * NP; unpack16(*(const v4u*)(pr + PCC + c0), *(const v4u*)(pr + PCC + c0 + 8), cc); unpack16(*(const v4u*)(pr + PCH + c0), *(const v4u*)(pr + PCH + c0 + 8), chh); }
#pragma unroll
        for (int i = 0; i < 16; ++i) u1[i] = cc[i] * chh[i];
    }
#pragma unroll 2
    for (int it = 0; it < 8; ++it) { const int t = tfirst + it; const bf16* pr = proj + (size_t)t * NP;
        float o[16], r[16], cb[16], cc[16], chh[16];
        unpack16(*(const v4u*)(ogla + (size_t)t * 1024 + c0), *(const v4u*)(ogla + (size_t)t * 1024 + c0 + 8), o);
        unpack16(*(const v4u*)(pr + PR + c0), *(const v4u*)(pr + PR + c0 + 8), r);
        unpack16(*(const v4u*)(pr + PCB + c0), *(const v4u*)(pr + PCB + c0 + 8), cb);
        unpack16(*(const v4u*)(pr + PCC + c0), *(const v4u*)(pr + PCC + c0 + 8), cc);
        unpack16(*(const v4u*)(pr + PCH + c0), *(const v4u*)(pr + PCH + c0 + 8), chh);
        float ss = 0.f;
#pragma unroll
        for (int i = 0; i < 16; ++i) ss += o[i] * o[i];
        ss += __shfl_xor(ss, 1); ss += __shfl_xor(ss, 2); ss += __shfl_xor(ss, 4); ss += __shfl_xor(ss, 8);
        const float rg = rsqrtf(ss * (1.0f / 256.f) + EPS);
        float val[16]; float s2 = 0.f;
#pragma unroll
        for (int i = 0; i < 16; ++i) { const float u0 = cc[i] * chh[i]; val[i] = cb[i] * (cw0[i] * u2[i] + cw1[i] * u1[i] + cw2[i] * u0); s2 += val[i] * val[i]; u2[i] = u1[i]; u1[i] = u0; }
        const float rc = rsqrtf(wave_sum(s2) * (1.0f / 1024.f) + EPS);
        v4u y0, y1, y2, y3;
#pragma unroll
        for (int j = 0; j < 4; ++j) {
            y0[j] = pk2(o[2 * j] * rg * gn[2 * j] * silu_f(r[2 * j]), o[2 * j + 1] * rg * gn[2 * j + 1] * silu_f(r[2 * j + 1]));
            y1[j] = pk2(o[8 + 2 * j] * rg * gn[8 + 2 * j] * silu_f(r[8 + 2 * j]), o[9 + 2 * j] * rg * gn[9 + 2 * j] * silu_f(r[9 + 2 * j]));
            y2[j] = pk2(val[2 * j] * rc * cn[2 * j], val[2 * j + 1] * rc * cn[2 * j + 1]);
            y3[j] = pk2(val[8 + 2 * j] * rc * cn[8 + 2 * j], val[9 + 2 * j] * rc * cn[9 + 2 * j]); }
        bf16* yr = ybuf + (size_t)t * D;
        *(v4u*)(yr + c0) = y0; *(v4u*)(yr + c0 + 8) = y1; *(v4u*)(yr + 1024 + c0) = y2; *(v4u*)(yr + 1024 + c0 + 8) = y3;
    }
}

__device__ __forceinline__ void ln1_chunk(const Args& a, int l, LAS unsigned char* lds, int lane, int wave, int ch) {
    const float* zbuf = (const float*)(a.ws + WS_Z); const float* mod = (const float*)(a.ws + WS_MOD);
    const int b = ch / NCH; const float* mb = mod + ((size_t)l * NB + b) * 6 * D;
#pragma unroll 2
    for (int it = 0; it < 8; ++it) { const int t = ch * 64 + wave * 8 + it;
        float z[32];
#pragma unroll
        for (int c = 0; c < 8; ++c) { const f32x4 v0 = *(const f32x4*)(zbuf + (size_t)t * D + (c * 64 + lane) * 4); z[c * 4] = v0.x; z[c * 4 + 1] = v0.y; z[c * 4 + 2] = v0.z; z[c * 4 + 3] = v0.w; }
        ln_tail(z, t, lane, a.in[11] + (size_t)l * D, a.in[12] + (size_t)l * D, (float*)(a.ws + WS_X1), mb + 3 * D, mb + 4 * D, (bf16*)(a.ws + WS_H2), a.ws + WS_HQ8, (float*)(a.ws + WS_HSC), lds + wave * 2304);
    }
}

template <int N> __device__ __forceinline__ void bitonic_sort_desc(float (&v)[N]) {
#pragma unroll
    for (int k = 2; k <= N; k <<= 1)
#pragma unroll
        for (int j = k >> 1; j > 0; j >>= 1)
#pragma unroll
            for (int i = 0; i < N; ++i) { const int p = i ^ j; if (p > i) { const bool desc = ((i & k) == 0); const float x = v[i], y = v[p]; const float mx = fmaxf(x, y), mn = fminf(x, y); v[i] = desc ? mx : mn; v[p] = desc ? mn : mx; } }
}
__device__ __forceinline__ void merge_top16(float (&x)[16], const float (&y)[16]) {
#pragma unroll
    for (int i = 0; i < 16; ++i) x[i] = fmaxf(x[i], y[15 - i]);
#pragma unroll
    for (int j = 8; j > 0; j >>= 1)
#pragma unroll
        for (int i = 0; i < 16; ++i) { const int p = i ^ j; if (p > i) { const float u = x[i], w = x[p]; x[i] = fmaxf(u, w); x[p] = fminf(u, w); } }
}
__device__ __forceinline__ void ce_desc(float& ka, int& pa, float& kb, int& pb) { const bool sw = kb > ka; const float k0 = sw ? kb : ka, k1 = sw ? ka : kb; const int p0 = sw ? pb : pa, p1 = sw ? pa : pb; ka = k0; pa = p0; kb = k1; pb = p1; }
__device__ __forceinline__ void bitonic_sort_desc_kp(float (&k)[16], int (&p)[16]) {
#pragma unroll
    for (int kk = 2; kk <= 16; kk <<= 1)
#pragma unroll
        for (int j = kk >> 1; j > 0; j >>= 1)
#pragma unroll
            for (int i = 0; i < 16; ++i) { const int q = i ^ j; if (q > i) { if ((i & kk) == 0) ce_desc(k[i], p[i], k[q], p[q]); else ce_desc(k[q], p[q], k[i], p[i]); } }
}
__device__ __forceinline__ void merge_top16_kp(float (&k)[16], int (&p)[16], const float (&k2)[16], const int (&p2)[16]) {
#pragma unroll
    for (int i = 0; i < 16; ++i) { const bool sw = k2[15 - i] > k[i]; k[i] = sw ? k2[15 - i] : k[i]; p[i] = sw ? p2[15 - i] : p[i]; }
#pragma unroll
    for (int j = 8; j > 0; j >>= 1)
#pragma unroll
        for (int i = 0; i < 16; ++i) { const int q = i ^ j; if (q > i) ce_desc(k[i], p[i], k[q], p[q]); }
}
__device__ constexpr int cand_i(int s) { return s < 16 ? 0 : s < 24 ? 1 : s < 29 ? 2 : s < 33 ? 3 : s < 36 ? 4 : s < 38 ? 5 : s < 40 ? 6 : s < 42 ? 7 : s < 50 ? s - 34 : -1; }
__device__ constexpr int cand_j(int s) { return s < 16 ? s : s < 24 ? s - 16 : s < 29 ? s - 24 : s < 33 ? s - 29 : s < 36 ? s - 33 : s < 38 ? s - 36 : s < 40 ? s - 38 : s < 42 ? s - 40 : s < 50 ? 0 : -1; }

__device__ __forceinline__ void peer_retrieve(const Args& a, int l, LAS unsigned char* lds, int lane, int wave, int ch) {
    const bf16* qbuf = (const bf16*)(a.ws + WS_Q); const bf16* keys = (const bf16*)(a.ws + WS_KEYS) + ((size_t)(l * 8 + wave) * 2) * 128 * 128;
    LAS int* eg_e = (LAS int*)lds; LAS float* eg_g = (LAS float*)(lds + 32768);
    const int l31 = lane & 31, l5 = lane >> 5, h = wave, t0 = ch * 64;
    for (int tt = 0; tt < 2; ++tt) {
        float sv[2][16];
#pragma unroll
        for (int p = 0; p < 2; ++p) {
            f32x16 acc[4];
#pragma unroll
            for (int nt = 0; nt < 4; ++nt)
#pragma unroll
                for (int r = 0; r < 16; ++r) acc[nt][r] = 0.f;
            const bf16* qp = qbuf + (size_t)(t0 + 32 * tt + l31) * D + h * 256 + p * 128 + 8 * l5;
            const bf16* kp = keys + (size_t)(p * 128 + l31) * 128 + 8 * l5;
#pragma unroll 2
            for (int ks = 0; ks < 8; ++ks) { const bf16x8 bq = *(const bf16x8*)(qp + 16 * ks);
#pragma unroll
                for (int nt = 0; nt < 4; ++nt) { const bf16x8 ak = *(const bf16x8*)(kp + (size_t)(32 * nt) * 128 + 16 * ks); acc[nt] = __builtin_amdgcn_mfma_f32_32x32x16_bf16(ak, bq, acc[nt], 0, 0, 0); } }
            float v[4][16];
#pragma unroll
            for (int nt = 0; nt < 4; ++nt)
#pragma unroll
                for (int r = 0; r < 16; ++r) { const unsigned idx = 32u * nt + (r & 3) + 8u * (r >> 2) + 4u * l5; v[nt][r] = __uint_as_float((__float_as_uint(acc[nt][r]) & 0xffffff80u) | idx); }
#pragma unroll
            for (int nt = 0; nt < 4; ++nt) bitonic_sort_desc<16>(v[nt]);
            merge_top16(v[0], v[1]); merge_top16(v[2], v[3]); merge_top16(v[0], v[2]);
            float o[16];
#pragma unroll
            for (int i = 0; i < 16; ++i) o[i] = __shfl_xor(v[0][i], 32);
            merge_top16(v[0], o);
#pragma unroll
            for (int i = 0; i < 16; ++i) sv[p][i] = v[0][i];
        }
        LAS unsigned char* idxb = (LAS unsigned char*)(lds + 69632) + wave * 2048 + lane * 32;
        { v4u w0, w1;
#pragma unroll
          for (int q4 = 0; q4 < 4; ++q4) {
              w0[q4] = (__float_as_uint(sv[0][4 * q4]) & 127u) | ((__float_as_uint(sv[0][4 * q4 + 1]) & 127u) << 8) | ((__float_as_uint(sv[0][4 * q4 + 2]) & 127u) << 16) | ((__float_as_uint(sv[0][4 * q4 + 3]) & 127u) << 24);
              w1[q4] = (__float_as_uint(sv[1][4 * q4]) & 127u) | ((__float_as_uint(sv[1][4 * q4 + 1]) & 127u) << 8) | ((__float_as_uint(sv[1][4 * q4 + 2]) & 127u) << 16) | ((__float_as_uint(sv[1][4 * q4 + 3]) & 127u) << 24); }
          *(LAS v4u*)(idxb) = w0; *(LAS v4u*)(idxb + 16) = w1; }
        float ck[4][16];
#pragma unroll
        for (int s = 0; s < 64; ++s) {
            if (cand_i(s) >= 0) { const unsigned b0 = __float_as_uint(sv[0][cand_i(s) < 0 ? 0 : cand_i(s)]), b1 = __float_as_uint(sv[1][cand_j(s) < 0 ? 0 : cand_j(s)]);
                const float sum = __uint_as_float(b0 & 0xffffff80u) + __uint_as_float(b1 & 0xffffff80u);
                ck[s >> 4][s & 15] = __uint_as_float((__float_as_uint(sum) & 0xffffff00u) | (unsigned)((cand_i(s) < 0 ? 0 : cand_i(s)) * 16 + (cand_j(s) < 0 ? 0 : cand_j(s)))); }
            else ck[s >> 4][s & 15] = -3.0e38f; }
        bitonic_sort_desc<16>(ck[1]); bitonic_sort_desc<16>(ck[2]);
        merge_top16(ck[0], ck[1]); merge_top16(ck[2], ck[3]); merge_top16(ck[0], ck[2]);
        LDS_WAIT(); asm volatile("" ::: "memory");
        float ex[16]; int ce[16]; float den = 0.f;
        const float cmax = __uint_as_float(__float_as_uint(ck[0][0]) & 0xffffff00u);
#pragma unroll
        for (int i = 0; i < 16; ++i) { const unsigned bits = __float_as_uint(ck[0][i]); ex[i] = __expf(__uint_as_float(bits & 0xffffff00u) - cmax); den += ex[i];
            ce[i] = (int)idxb[(bits >> 4) & 15u] * 128 + (int)idxb[16 + (bits & 15u)]; }
        const float inv = 1.0f / den;
        if (l5 == 0) {
            const int base = (32 * tt + l31) * 128 + h * 16;
#pragma unroll
            for (int i4 = 0; i4 < 4; ++i4) { *(LAS v4u*)(eg_e + base + 4 * i4) = (v4u){(unsigned)ce[4 * i4], (unsigned)ce[4 * i4 + 1], (unsigned)ce[4 * i4 + 2], (unsigned)ce[4 * i4 + 3]};
                *(LAS f32x4*)(eg_g + base + 4 * i4) = (f32x4){ex[4 * i4] * inv, ex[4 * i4 + 1] * inv, ex[4 * i4 + 2] * inv, ex[4 * i4 + 3] * inv}; }
        }
        LDS_WAIT(); asm volatile("" ::: "memory");
    }
}

typedef unsigned char uc4 __attribute__((ext_vector_type(4)));
constexpr int NSLICE = 16, SLICE_SHIFT = 10;
__device__ __forceinline__ int sdot4i(unsigned w, unsigned x, int acc) { return __builtin_amdgcn_sdot4((int)w, (int)x, acc, false); }
__device__ __forceinline__ void fma_ub4(unsigned w, float s, float& y0, float& y1, float& y2, float& y3) { const uc4 b = __builtin_bit_cast(uc4, w); y0 += s * (float)b.x; y1 += s * (float)b.y; y2 += s * (float)b.z; y3 += s * (float)b.w; }
#if TAB4
__device__ __forceinline__ void peer_tail(const Args& a, int l, int t, int lane, const bf16* Yrow, const float* mb, const float* mbn, bool last) {
    const float* x1buf = (const float*)(a.ws + WS_X1);
    float z[32];
#pragma unroll
    for (int c8 = 0; c8 < 8; ++c8) { const int col = (c8 * 64 + lane) * 4;
        const v2u yb = *(const v2u*)(Yrow + col); const f32x4 yv = (f32x4){bflo(yb.x), bfhi(yb.x), bflo(yb.y), bfhi(yb.y)};
        const f32x4 x0 = *(const f32x4*)(x1buf + (size_t)t * D + col), g0 = *(const f32x4*)(mb + 5 * D + col);
        z[c8 * 4] = ALPHA * x0.x + (1.f + g0.x) * yv.x; z[c8 * 4 + 1] = ALPHA * x0.y + (1.f + g0.y) * yv.y; z[c8 * 4 + 2] = ALPHA * x0.z + (1.f + g0.z) * yv.z; z[c8 * 4 + 3] = ALPHA * x0.w + (1.f + g0.w) * yv.w; }
    ln_tail(z, t, lane, a.in[17] + (size_t)l * D, a.in[18] + (size_t)l * D, last ? a.out : (float*)(a.ws + WS_X), mbn, mbn + D, last ? (bf16*)nullptr : (bf16*)(a.ws + WS_H), nullptr, nullptr);
}
template <class TT, int N, int M> __device__ __forceinline__ void treduce(TT (&v)[N], int lane) {
    const bool c0 = (lane & M) != 0, c1 = (lane & (2 * M)) != 0, c2 = (lane & (4 * M)) != 0;
#pragma unroll
    for (int m = 0; m < N / 2; ++m) { const TT keep = c0 ? v[2 * m + 1] : v[2 * m], send = c0 ? v[2 * m] : v[2 * m + 1]; v[m] = keep + __shfl_xor(send, M); }
#pragma unroll
    for (int m = 0; m < N / 4; ++m) { const TT keep = c1 ? v[2 * m + 1] : v[2 * m], send = c1 ? v[2 * m] : v[2 * m + 1]; v[m] = keep + __shfl_xor(send, 2 * M); }
#pragma unroll
    for (int m = 0; m < N / 8; ++m) { const TT keep = c2 ? v[2 * m + 1] : v[2 * m], send = c2 ? v[2 * m] : v[2 * m + 1]; v[m] = keep + __shfl_xor(send, 4 * M); }
}
__device__ __forceinline__ void tr4x4(unsigned a, unsigned b, unsigned c, unsigned d, unsigned& t0, unsigned& t1, unsigned& t2, unsigned& t3) {
    const unsigned x0 = __builtin_amdgcn_perm(b, a, 0x05010400u), x1 = __builtin_amdgcn_perm(b, a, 0x07030602u), y0 = __builtin_amdgcn_perm(d, c, 0x05010400u), y1 = __builtin_amdgcn_perm(d, c, 0x07030602u);
    t0 = __builtin_amdgcn_perm(y0, x0, 0x05040100u); t1 = __builtin_amdgcn_perm(y0, x0, 0x07060302u); t2 = __builtin_amdgcn_perm(y1, x1, 0x05040100u); t3 = __builtin_amdgcn_perm(y1, x1, 0x07060302u);
}
__device__ __forceinline__ int sdot8i(unsigned w, unsigned x, int acc) { return __builtin_amdgcn_sdot8((int)w, (int)x, acc, false); }
__device__ __forceinline__ float slot_scale(unsigned w3) { return __builtin_amdgcn_exp2f((float)(w3 >> 24) * 0.125f - 16.0f); }
__device__ __forceinline__ void peer_experts(const Args& a, int l, LAS unsigned char* lds, int lane0, int wave, int ch) {
    const float* mod = (const float*)(a.ws + WS_MOD);
    const unsigned char* ut = a.ws + WS_UT + (size_t)l * NE * 1152; const unsigned char* vt = a.ws + WS_VT + (size_t)l * NE * 1152; const unsigned char* hq8 = a.ws + WS_HQ8;
    const float* hsc = (const float*)(a.ws + WS_HSC);
    bf16* Ybuf = (bf16*)(a.ws + WS_Z);
    const LAS int* eg_e = (const LAS int*)lds; LAS float* sw = (LAS float*)(lds + 32768);
    LAS float* apart = (LAS float*)(lds + 65536);
    const int b = ch / NCH; const bool last = (l == NL - 1);
    const float* mb = mod + ((size_t)l * NB + b) * 6 * D; const float* mbn = mod + ((size_t)(last ? l : l + 1) * NB + b) * 6 * D;
    const int tlw = wave * 8;
    { const int lane = lane0;
#pragma unroll
      for (int i = 0; i < 16; ++i) apart[tlw * 128 + i * 64 + lane] = 0.f; }
    LDS_WAIT(); asm volatile("" ::: "memory");
    {
        int laneL = lane0; asm volatile("" : "+v"(laneL)); const int lane = laneL;
        const int g = lane >> 3, l7 = lane & 7;
        v4u bufA[16], bufB[16], hA0, hA1, hB0, hB1;
#define CU_LOAD(buf, h0_, h1_, idx_) do { const int u_ = (idx_) >> 3, tl_ = tlw + ((idx_) & 7); const unsigned soff_ = (unsigned)(u_ * 128 + l7 * 16); \
            const unsigned char* hp_ = hq8 + (size_t)(ch * 64 + tl_) * 2304 + (u_ * 8 + l7) * 32; h0_ = *(const v4u*)hp_; h1_ = *(const v4u*)(hp_ + 16); \
            _Pragma("unroll") for (int i_ = 0; i_ < 16; ++i_) { const unsigned e_ = (unsigned)eg_e[tl_ * 128 + 8 * i_ + g]; buf[i_] = *(const v4u*)(ut + (size_t)(e_ * 1152u + soff_)); } } while (0)
#define CU_COMP(buf, h0_, h1_, idx_) do { const int tl_ = tlw + ((idx_) & 7); float accv_[16]; \
            _Pragma("unroll") for (int i_ = 0; i_ < 16; ++i_) { int sl_ = 0, sh_ = 0; \
                _Pragma("unroll") for (int d_ = 0; d_ < 4; ++d_) { const unsigned x_ = buf[i_][d_] ^ 0x88888888u; sl_ = sdot8i(x_, h0_[d_], sl_); sh_ = sdot8i(x_, h1_[d_], sh_); } \
                accv_[i_] = slot_scale(buf[i_][3]) * (float)(16 * sh_ + sl_); } \
            treduce<float, 16, 1>(accv_, lane); \
            apart[tl_ * 128 + 8 * l7 + g] += accv_[0]; apart[tl_ * 128 + 8 * (8 + l7) + g] += accv_[1]; } while (0)
        CU_LOAD(bufA, hA0, hA1, 0);
        for (int idx = 0; idx < 72; idx += 2) {
            CU_LOAD(bufB, hB0, hB1, idx + 1);
            CU_COMP(bufA, hA0, hA1, idx);
            { const int nx_ = idx + 2 < 72 ? idx + 2 : 71; CU_LOAD(bufA, hA0, hA1, nx_); }
            CU_COMP(bufB, hB0, hB1, idx + 1);
        }
#undef CU_LOAD
#undef CU_COMP
        LDS_WAIT(); asm volatile("" ::: "memory");
        for (int it = 0; it < 8; ++it) { const int tl = tlw + it; const float shs = hsc[ch * 64 + tl];
            const float w0 = sw[tl * 128 + lane] * gelu_tanh_f(apart[tl * 128 + lane] * shs), w1 = sw[tl * 128 + 64 + lane] * gelu_tanh_f(apart[tl * 128 + 64 + lane] * shs);
            sw[tl * 128 + lane] = w0; sw[tl * 128 + 64 + lane] = w1; }
        LDS_WAIT(); asm volatile("" ::: "memory");
    }
    {
        int laneL = lane0; asm volatile("" : "+v"(laneL)); const int lane = laneL;
        const int g = lane >> 3, l7 = lane & 7;
        v4u bufA[16], bufB[16];
#define CV_LOAD(buf, idx_) do { const int u_ = (idx_) >> 3, tl_ = tlw + ((idx_) & 7); const unsigned soff_ = (unsigned)(u_ * 128 + l7 * 16); \
            _Pragma("unroll") for (int i_ = 0; i_ < 16; ++i_) { const unsigned e_ = (unsigned)eg_e[tl_ * 128 + 8 * i_ + g]; buf[i_] = *(const v4u*)(vt + (size_t)(e_ * 1152u + soff_)); } } while (0)
#define CV_COMP(buf, idx_) do { const int u_ = (idx_) >> 3, tl_ = tlw + ((idx_) & 7); \
            float wf_[16]; float wmx_ = 0.f; \
            _Pragma("unroll") for (int i_ = 0; i_ < 16; ++i_) { wf_[i_] = sw[tl_ * 128 + 8 * i_ + g] * slot_scale(buf[i_][3]); wmx_ = fmaxf(wmx_, fabsf(wf_[i_])); } \
            wmx_ = fmaxf(wmx_, __shfl_xor(wmx_, 8)); wmx_ = fmaxf(wmx_, __shfl_xor(wmx_, 16)); wmx_ = fmaxf(wmx_, __shfl_xor(wmx_, 32));     \
            const float winv_ = wmx_ > 0.f ? 127.0f / wmx_ : 0.f, wsc_ = wmx_ * (1.0f / 127.0f); \
              \
            unsigned wq4_[4]; int wsum_ = 0; \
            _Pragma("unroll") for (int gp_ = 0; gp_ < 4; ++gp_) { \
                const unsigned m0_ = __float_as_uint(wf_[4 * gp_] * winv_ + 12582912.0f), m1_ = __float_as_uint(wf_[4 * gp_ + 1] * winv_ + 12582912.0f), m2_ = __float_as_uint(wf_[4 * gp_ + 2] * winv_ + 12582912.0f), m3_ = __float_as_uint(wf_[4 * gp_ + 3] * winv_ + 12582912.0f); \
                wq4_[gp_] = __builtin_amdgcn_perm(__builtin_amdgcn_perm(m3_, m2_, 0x0c0c0400u), __builtin_amdgcn_perm(m1_, m0_, 0x0c0c0400u), 0x05040100u); \
                wsum_ = sdot4i(wq4_[gp_], 0x01010101u, wsum_); } \
            int yi_[32]; \
            _Pragma("unroll") for (int q_ = 0; q_ < 32; ++q_) yi_[q_] = 0; \
            _Pragma("unroll") for (int gp_ = 0; gp_ < 4; ++gp_) { \
                _Pragma("unroll") for (int d_ = 0; d_ < 4; ++d_) { const unsigned A_ = buf[4 * gp_][d_], B_ = buf[4 * gp_ + 1][d_], C_ = buf[4 * gp_ + 2][d_], D_ = buf[4 * gp_ + 3][d_]; \
                    unsigned t0_, t1_, t2_, t3_; \
                    tr4x4(A_, B_, C_, D_, t0_, t1_, t2_, t3_);     \
                    yi_[8 * d_]     = sdot4i(t0_ & 0x0f0f0f0fu, wq4_[gp_], yi_[8 * d_]);     yi_[8 * d_ + 1] = sdot4i((t0_ >> 4) & 0x0f0f0f0fu, wq4_[gp_], yi_[8 * d_ + 1]); \
                    yi_[8 * d_ + 2] = sdot4i(t1_ & 0x0f0f0f0fu, wq4_[gp_], yi_[8 * d_ + 2]); yi_[8 * d_ + 3] = sdot4i((t1_ >> 4) & 0x0f0f0f0fu, wq4_[gp_], yi_[8 * d_ + 3]); \
                    yi_[8 * d_ + 4] = sdot4i(t2_ & 0x0f0f0f0fu, wq4_[gp_], yi_[8 * d_ + 4]); yi_[8 * d_ + 5] = sdot4i((t2_ >> 4) & 0x0f0f0f0fu, wq4_[gp_], yi_[8 * d_ + 5]); \
                    yi_[8 * d_ + 6] = sdot4i(t3_ & 0x0f0f0f0fu, wq4_[gp_], yi_[8 * d_ + 6]); yi_[8 * d_ + 7] = sdot4i((t3_ >> 4) & 0x0f0f0f0fu, wq4_[gp_], yi_[8 * d_ + 7]); } } \
            treduce<int, 32, 8>(yi_, lane); \
            wsum_ += __shfl_xor(wsum_, 8); wsum_ += __shfl_xor(wsum_, 16); wsum_ += __shfl_xor(wsum_, 32);     \
            float y_[4]; \
            _Pragma("unroll") for (int q_ = 0; q_ < 4; ++q_) y_[q_] = wsc_ * (float)(yi_[q_] - 8 * wsum_); \
            { const int colb_ = u_ * 240 + l7 * 30 + g; bf16* yr_ = Ybuf + (size_t)(ch * 64 + tl_) * D + colb_; \
              _Pragma("unroll") for (int m_ = 0; m_ < 4; ++m_) if (8 * m_ + g < 30 && colb_ + 8 * m_ < D) yr_[8 * m_] = (bf16)(pk2(y_[m_], 0.f) & 0xffffu); } } while (0)
        CV_LOAD(bufA, 0);
        for (int idx = 0; idx < 72; idx += 2) {
            CV_LOAD(bufB, idx + 1);
            CV_COMP(bufA, idx);
            { const int nx_ = idx + 2 < 72 ? idx + 2 : 71; CV_LOAD(bufA, nx_); }
            CV_COMP(bufB, idx + 1);
        }
#undef CV_LOAD
#undef CV_COMP
    }
    asm volatile("s_waitcnt vmcnt(0)" ::: "memory");
    __builtin_amdgcn_fence(__ATOMIC_ACQUIRE, "agent");
    asm volatile("s_waitcnt vmcnt(0)" ::: "memory");
    for (int it = 0; it < 8; ++it) { int laneT = lane0; asm volatile("" : "+v"(laneT)); const int t = ch * 64 + tlw + it;
        peer_tail(a, l, t, laneT, Ybuf + (size_t)t * D, mb, mbn, last); }
}
#else
__device__ __forceinline__ void peer_tail(const Args& a, int l, int t, int lane, const float* Yrow, const float* mb, const float* mbn, bool last) {
    const float* x1buf = (const float*)(a.ws + WS_X1);
    float z[32];
#pragma unroll
    for (int c = 0; c < 2; ++c)
#pragma unroll
        for (int k = 0; k < 4; ++k) { const int c8 = 4 * c + k, col = (c8 * 64 + lane) * 4;
            const v2u yb = *(const v2u*)((const bf16*)Yrow + (c * 64 + lane) * 16 + 4 * k); const f32x4 yv = (f32x4){bflo(yb.x), bfhi(yb.x), bflo(yb.y), bfhi(yb.y)};
            const f32x4 x0 = *(const f32x4*)(x1buf + (size_t)t * D + col), g0 = *(const f32x4*)(mb + 5 * D + col);
            z[c8 * 4] = ALPHA * x0.x + (1.f + g0.x) * yv.x; z[c8 * 4 + 1] = ALPHA * x0.y + (1.f + g0.y) * yv.y; z[c8 * 4 + 2] = ALPHA * x0.z + (1.f + g0.z) * yv.z; z[c8 * 4 + 3] = ALPHA * x0.w + (1.f + g0.w) * yv.w; }
    ln_tail(z, t, lane, a.in[17] + (size_t)l * D, a.in[18] + (size_t)l * D, last ? a.out : (float*)(a.ws + WS_X), mbn, mbn + D, last ? (bf16*)nullptr : (bf16*)(a.ws + WS_H), nullptr, nullptr);
}
template <class TT, int M> __device__ __forceinline__ void treduce16(TT (&v)[16], int lane) {
    const bool c0 = (lane & M) != 0, c1 = (lane & (2 * M)) != 0, c2 = (lane & (4 * M)) != 0;
#pragma unroll
    for (int m = 0; m < 8; ++m) { const TT keep = c0 ? v[2 * m + 1] : v[2 * m], send = c0 ? v[2 * m] : v[2 * m + 1]; v[m] = keep + __shfl_xor(send, M); }
#pragma unroll
    for (int m = 0; m < 4; ++m) { const TT keep = c1 ? v[2 * m + 1] : v[2 * m], send = c1 ? v[2 * m] : v[2 * m + 1]; v[m] = keep + __shfl_xor(send, 2 * M); }
#pragma unroll
    for (int m = 0; m < 2; ++m) { const TT keep = c2 ? v[2 * m + 1] : v[2 * m], send = c2 ? v[2 * m] : v[2 * m + 1]; v[m] = keep + __shfl_xor(send, 4 * M); }
}
__device__ __forceinline__ void peer_experts(const Args& a, int l, LAS unsigned char* lds, int lane0, int wave, int ch) {
    const float* mod = (const float*)(a.ws + WS_MOD);
    const unsigned char* ut = a.ws + WS_UT + (size_t)l * NE * D; const unsigned char* vt = a.ws + WS_VT + (size_t)l * NE * D; const unsigned char* hq8 = a.ws + WS_HQ8;
    const float* su = (const float*)(a.ws + WS_SU) + (size_t)l * NE; const float* sv = (const float*)(a.ws + WS_SV) + (size_t)l * NE; const float* hsc = (const float*)(a.ws + WS_HSC);
    float* Ybuf = (float*)(a.ws + WS_Z);
    const LAS int* eg_e = (const LAS int*)lds; LAS float* sw = (LAS float*)(lds + 32768);
    LAS int* apart = (LAS int*)(lds + 65536); LAS float* wtotl = (LAS float*)(lds + LDSCTL_OFF + 256);
    const int b = ch / NCH; const bool last = (l == NL - 1);
    const float* mb = mod + ((size_t)l * NB + b) * 6 * D; const float* mbn = mod + ((size_t)(last ? l : l + 1) * NB + b) * 6 * D;
    const int tlw = wave * 8;
    { const int lane = lane0;
#pragma unroll
      for (int i = 0; i < 16; ++i) apart[tlw * 128 + i * 64 + lane] = 0; }
    LDS_WAIT(); asm volatile("" ::: "memory");
    {
        int laneL = lane0; asm volatile("" : "+v"(laneL)); const int lane = laneL;
        const int g = lane >> 3, l7 = lane & 7;
        v4u bufA[16], bufB[16], hA, hB;
#define CU_LOAD(buf, hh_, idx_) do { const int cs_ = (idx_) >> 3, tl_ = tlw + ((idx_) & 7); const unsigned coff_ = (unsigned)(cs_ * 128 + l7 * 16); \
            hh_ = *(const v4u*)(hq8 + (size_t)(ch * 64 + tl_) * D + coff_); \
            _Pragma("unroll") for (int i_ = 0; i_ < 16; ++i_) { const unsigned e_ = (unsigned)eg_e[tl_ * 128 + 8 * i_ + g]; buf[i_] = *(const v4u*)(ut + (size_t)(e_ * 2048u + coff_)); } } while (0)
#define CU_COMP(buf, hh_, idx_) do { const int tl_ = tlw + ((idx_) & 7); int acc_[16]; \
            _Pragma("unroll") for (int i_ = 0; i_ < 16; ++i_) { int s_ = 0; _Pragma("unroll") for (int q_ = 0; q_ < 4; ++q_) s_ = sdot4i(buf[i_][q_], hh_[q_], s_); acc_[i_] = s_; } \
            treduce16<int, 1>(acc_, lane); \
            apart[tl_ * 128 + 8 * l7 + g] += acc_[0]; apart[tl_ * 128 + 8 * (8 + l7) + g] += acc_[1]; } while (0)
        CU_LOAD(bufA, hA, 0);
        for (int idx = 0; idx < 128; idx += 2) {
            CU_LOAD(bufB, hB, idx + 1);
            CU_COMP(bufA, hA, idx);
            if (idx + 2 < 128) CU_LOAD(bufA, hA, idx + 2);
            CU_COMP(bufB, hB, idx + 1);
        }
#undef CU_LOAD
#undef CU_COMP
        LDS_WAIT(); asm volatile("" ::: "memory");
        for (int it = 0; it < 8; ++it) { const int tl = tlw + it; const float shs = hsc[ch * 64 + tl];
            const int e0 = eg_e[tl * 128 + lane], e1 = eg_e[tl * 128 + 64 + lane];
            const float w0 = sw[tl * 128 + lane] * gelu_tanh_f((float)apart[tl * 128 + lane] * su[e0] * shs) * sv[e0];
            const float w1 = sw[tl * 128 + 64 + lane] * gelu_tanh_f((float)apart[tl * 128 + 64 + lane] * su[e1] * shs) * sv[e1];
            sw[tl * 128 + lane] = w0; sw[tl * 128 + 64 + lane] = w1;
            const float ws = wave_sum(w0 + w1);
            if (lane == 0) wtotl[tl] = ws; }
        LDS_WAIT(); asm volatile("" ::: "memory");
    }
    {
        int laneL = lane0; asm volatile("" : "+v"(laneL)); const int lane = laneL;
        const int g = lane >> 3, l7 = lane & 7;
        v4u bufA[16], bufB[16];
#define CV_LOAD(buf, idx_) do { const int cs_ = (idx_) >> 3, tl_ = tlw + ((idx_) & 7); const unsigned coff_ = (unsigned)(cs_ * 128 + l7 * 16); \
            _Pragma("unroll") for (int i_ = 0; i_ < 16; ++i_) { const unsigned e_ = (unsigned)eg_e[tl_ * 128 + 8 * i_ + g]; buf[i_] = *(const v4u*)(vt + (size_t)(e_ * 2048u + coff_)); } } while (0)
#define CV_COMP(buf, idx_) do { const int cs_ = (idx_) >> 3, tl_ = tlw + ((idx_) & 7); float y_[16]; \
            _Pragma("unroll") for (int q_ = 0; q_ < 16; ++q_) y_[q_] = 0.f; \
            _Pragma("unroll") for (int i_ = 0; i_ < 16; ++i_) { const float wr_ = sw[tl_ * 128 + 8 * i_ + g]; \
                _Pragma("unroll") for (int q_ = 0; q_ < 4; ++q_) fma_ub4(buf[i_][q_], wr_, y_[4 * q_], y_[4 * q_ + 1], y_[4 * q_ + 2], y_[4 * q_ + 3]); } \
            treduce16<float, 8>(y_, lane); \
            const float woff_ = 128.0f * wtotl[tl_]; bf16* yr_ = (bf16*)Ybuf + (size_t)(ch * 64 + tl_) * D + cs_ * 128 + l7 * 16 + g; \
            yr_[0] = (bf16)(pk2(y_[0] - woff_, 0.f) & 0xffffu); yr_[8] = (bf16)(pk2(y_[1] - woff_, 0.f) & 0xffffu); } while (0)
        CV_LOAD(bufA, 0);
        for (int idx = 0; idx < 128; idx += 2) {
            CV_LOAD(bufB, idx + 1);
            CV_COMP(bufA, idx);
            if (idx + 2 < 128) CV_LOAD(bufA, idx + 2);
            CV_COMP(bufB, idx + 1);
        }
#undef CV_LOAD
#undef CV_COMP
    }
    asm volatile("s_waitcnt vmcnt(0)" ::: "memory");
    __builtin_amdgcn_fence(__ATOMIC_ACQUIRE, "agent");
    asm volatile("s_waitcnt vmcnt(0)" ::: "memory");
    for (int it = 0; it < 8; ++it) { int laneT = lane0; asm volatile("" : "+v"(laneT)); const int t = ch * 64 + tlw + it;
        peer_tail(a, l, t, laneT, (const float*)((const bf16*)Ybuf + (size_t)t * D), mb, mbn, last); }
}

#endif

#ifndef MK_PER_PHASE
#define MK_PER_PHASE 0
#endif
__global__ void __launch_bounds__(NTHREADS, 2) mk_fwd(Args a) {
    extern __shared__ __attribute__((aligned(16))) unsigned char lds_raw[];
    LAS unsigned char* lds = (LAS unsigned char*)lds_raw;
    const int tid = threadIdx.x, lane = tid & 63, wave = __builtin_amdgcn_readfirstlane(tid >> 6), G = gridDim.x, bx = blockIdx.x;
    if (tid < 64) ((LAS unsigned*)(lds + LDSCTL_OFF))[tid] = 0u;
    __syncthreads();
    unsigned* ctl = (unsigned*)(a.ws + WS_CTL);
    XcdBarrier bar; bar.bar = ctl + CW_BAR; bar.x = 0; bar.st = nullptr;
    const bool use_bar = (a.ph_hi - a.ph_lo) > 1;
    if (use_bar) bar = xcd_barrier_post(ctl + CW_BAR, (volatile LAS unsigned*)(lds + LDSCTL_OFF));
    const int lo = a.ph_lo, hi = a.ph_hi;
#ifndef PH_MASK
#define PH_MASK 0x1ff
#endif
#define IN(k) (lo <= (k) && (k) < hi)
#define EN(b) ((PH_MASK >> (b)) & 1)
#ifndef REP_MASK
#define REP_MASK 0
#endif
#ifndef REP_EXTRA
#define REP_EXTRA 2
#endif
#define REPS(b) (1 + ((REP_MASK >> (b)) & 1) * REP_EXTRA)
#define REP_BEGIN(b) for (int rep_ = 0; rep_ < REPS(b); ++rep_) {
#define REP_END(b) if (rep_ + 1 < REPS(b)) xcd_barrier(bar); }
#define SEAM(k) do { if (IN((k) + 1)) xcd_barrier(bar); } while (0)
#define PHASE_IDS() int tidp = tid; asm volatile("" : "+v"(tidp)); const int lanep = tidp & 63, wavep = __builtin_amdgcn_readfirstlane(tidp >> 6); (void)lanep; (void)wavep
    if (EN(0) && IN(0)) { REP_BEGIN(0) PHASE_IDS(); ph_prologue_a(a, lds, tidp, lanep, wavep, bx, G); REP_END(0) SEAM(0); }
    if (EN(1) && IN(1)) { REP_BEGIN(1) PHASE_IDS(); ph_prologue_b(a, lds, tidp, lanep, wavep, bx, G); REP_END(1) SEAM(1); }
    for (int l = 0; l < NL; ++l) {
        const int pb = 2 + 7 * l;
        const float* mod = (const float*)(a.ws + WS_MOD);
        if (EN(2) && IN(pb + 0)) {
            REP_BEGIN(2) PHASE_IDS();
            pg8::Gemm g{(const pg8::bf16_t*)(a.ws + WS_H), (const pg8::bf16_t*)(a.ws + WS_WIN) + (size_t)l * INW * D, T, NP, D}; pg8::StaticOrder S; S.init(T, NP, G, bx);
            pg8::EpiBf16P E{(pg8::bf16_t*)(a.ws + WS_PROJ), NP};
            pg8::gemm_phase<pg8::EpiBf16P, pg8::StaticOrder, true, true>(lds + RING_OFF, g, S, E, tidp);
            for (int ch = bx; ch < NCHUNK; ch += G) gate_prep(a, l, lds, tidp, lanep, wavep, ch);
            REP_END(2) SEAM(pb + 0);
        }
        if (EN(3) && IN(pb + 1)) { REP_BEGIN(3) PHASE_IDS(); for (int un = bx; un < 256; un += G) gla_unit(a, lds, tidp, lanep, wavep, un); REP_END(3) SEAM(pb + 1); }
        if (EN(4) && IN(pb + 2)) { REP_BEGIN(4) PHASE_IDS(); for (int ch = bx; ch < NCHUNK; ch += G) mixpost_chunk(a, l, lanep, wavep, ch); REP_END(4) SEAM(pb + 2); }
        if (EN(5) && IN(pb + 3)) {
            REP_BEGIN(5) PHASE_IDS();
            pg8::Gemm g{(const pg8::bf16_t*)(a.ws + WS_Y), (const pg8::bf16_t*)(a.ws + WS_WOUT) + (size_t)l * D * D, T, D, D}; pg8::StaticOrder S; S.init(T, D, G, bx);
            pg8::EpiResid E{(float*)(a.ws + WS_Z), l == 0 ? a.in[0] : (const float*)(a.ws + WS_X), mod + (size_t)l * NB * 6 * D + 2 * D, ALPHA};
            pg8::gemm_phase<pg8::EpiResid, pg8::StaticOrder, true, true>(lds + RING_OFF, g, S, E, tidp);
            REP_END(5) SEAM(pb + 3);
        }
        if (EN(6) && IN(pb + 4)) { REP_BEGIN(6) PHASE_IDS(); for (int ch = bx; ch < NCHUNK; ch += G) ln1_chunk(a, l, lds, lanep, wavep, ch); REP_END(6) SEAM(pb + 4); }
        if (EN(7) && IN(pb + 5)) {
            REP_BEGIN(7) PHASE_IDS();
            pg8::Gemm g{(const pg8::bf16_t*)(a.ws + WS_H2), (const pg8::bf16_t*)(a.ws + WS_WQ) + (size_t)l * D * D, T, D, D}; pg8::StaticOrder S; S.init(T, D, G, bx);
            pg8::EpiBf16P E{(pg8::bf16_t*)(a.ws + WS_Q), D};
            pg8::gemm_phase<pg8::EpiBf16P, pg8::StaticOrder, true, true>(lds + RING_OFF, g, S, E, tidp);
            REP_END(7) SEAM(pb + 5);
        }
#ifndef PEER_DBG
#define PEER_DBG 0
#endif
#ifndef PE_REP_R
#define PE_REP_R 1
#endif
#ifndef L2PROBE
#define L2PROBE 0
#endif
        if (EN(8) && IN(pb + 6)) {
            REP_BEGIN(8)
            for (int ch = bx; ch < NCHUNK; ch += G) { for (int repr_ = 0; repr_ < PE_REP_R; ++repr_) { PHASE_IDS(); peer_retrieve(a, l, lds, lanep, wavep, ch); __syncthreads(); } __syncthreads(); { PHASE_IDS(); peer_experts(a, l, lds, lanep, wavep, ch); } __syncthreads(); }
            REP_END(8) SEAM(pb + 6);
        }
    }
#undef IN
#undef SEAM
}

extern "C" void kernel_launch(void* const* d_in, const int* in_sizes, int n_in, void* d_out, int out_size, void* d_ws, size_t ws_size, hipStream_t stream) {
    static int grid = 0;
    if (grid == 0) {
        if (n_in != 19 || in_sizes[0] != T * D || out_size != T * D || ws_size < WS_END) { fprintf(stderr, "kernel_launch: unexpected shapes / workspace (%d inputs, ws %zu); nothing launched\n", n_in, ws_size); grid = -1; return; }
        int dev = 0, cus = 0, per_cu = 0;
        if (hipGetDevice(&dev) != hipSuccess || hipDeviceGetAttribute(&cus, hipDeviceAttributeMultiprocessorCount, dev) != hipSuccess) { grid = -1; return; }
        if (hipFuncSetAttribute((const void*)mk_fwd, hipFuncAttributeMaxDynamicSharedMemorySize, LDS_BYTES) != hipSuccess) { fprintf(stderr, "kernel_launch: hipFuncSetAttribute failed\n"); grid = -1; return; }
        if (hipOccupancyMaxActiveBlocksPerMultiprocessor(&per_cu, (const void*)mk_fwd, NTHREADS, LDS_BYTES) != hipSuccess || per_cu < 1) fprintf(stderr, "kernel_launch: occupancy query reports %d\n", per_cu);
        (void)hipGetLastError();
        grid = cus;
    }
    if (grid < 0) return;
    if (hipMemsetAsync((char*)d_ws + WS_CTL, 0, CTL_ZERO_BYTES, stream) != hipSuccess) return;
    Args a{};
    for (int i = 0; i < 19; ++i) a.in[i] = (const float*)d_in[i];
    a.out = (float*)d_out; a.ws = (unsigned char*)d_ws;
#if MK_PER_PHASE
    for (int p = 0; p < NPHASES; ++p) { a.ph_lo = p; a.ph_hi = p + 1; hipLaunchKernelGGL(mk_fwd, dim3(grid), dim3(NTHREADS), LDS_BYTES, stream, a); }
#else
    a.ph_lo = 0; a.ph_hi = NPHASES;
    hipLaunchKernelGGL(mk_fwd, dim3(grid), dim3(NTHREADS), LDS_BYTES, stream, a);
#endif
}
```

```cpp
#include <hip/hip_runtime.h>
#include <cstdio>
#include <cstdint>
namespace pg8 {
#define PG8_LAS __attribute__((address_space(3)))
typedef unsigned short bf16_t;
typedef short bf16x8 __attribute__((ext_vector_type(8)));
typedef float f32x4 __attribute__((ext_vector_type(4)));
typedef unsigned u32x4 __attribute__((ext_vector_type(4)));
constexpr int BM = 256, BK = 64, HALF = 128, HTB = HALF * BK * 2  , STAGE_BYTES = 8 * HTB, NXCD = 8, WGM = 8;

__host__ __device__ __forceinline__ int lds_byte(int r, int c) { const int st = (r >> 4) * 2 + (c >> 5), rr = r & 15, cc = c & 31, ob = rr * 64 + cc * 2; return st * 1024 + (ob ^ (((ob >> 9) & 1) << 5)); }
__host__ __device__ __forceinline__ void stage_rc(int b, int& R, int& C) { const int st = b / 1024, sb = b % 1024, swz = sb ^ (((sb >> 9) & 1) << 5); R = (st >> 1) * 16 + swz / 64; C = (st & 1) * 32 + (swz % 64) / 2; }
__host__ __device__ __forceinline__ int perm32(int rho) { const int n = rho >> 4, i = rho & 15; return 8 * (i >> 2) + 4 * n + (i & 3); }

struct Unit { int pm, pn; };
struct Gemm { const bf16_t* A; const bf16_t* Bt; int M, N, K; };

struct StaticOrder {
    int nM, nN, nwg, G, c;
    __host__ __device__ void init(int M, int N, int G_, int c_) { nM = M / BM; nN = N / BM; nwg = nM * nN; G = G_; c = c_; }
    __host__ __device__ bool next(int i, Unit& u) const {
        const long L = (long)i * G + c; if (L >= nwg) return false;
        int wgid = (int)L; { const int q = nwg / NXCD, r = nwg % NXCD, xcd = wgid % NXCD, off = wgid / NXCD; wgid = (xcd < r ? xcd * (q + 1) : r * (q + 1) + (xcd - r) * q) + off; }
        const int nig = WGM * nN, gid = wgid / nig, fm = gid * WGM, gsz = (nM - fm) < WGM ? (nM - fm) : WGM;
        u.pm = fm + ((wgid % nig) % gsz); u.pn = (wgid % nig) / gsz; return true;
    }
    __device__ __forceinline__ void a_ready(const Unit&) const {}
    __device__ __forceinline__ void done(const Unit&) const {}
};
typedef __bf16 bf16x2_t __attribute__((ext_vector_type(2)));
__device__ __forceinline__ unsigned cvt_pk_bf16(float lo, float hi) { bf16x2_t r; r.x = (__bf16)lo; r.y = (__bf16)hi; return __builtin_bit_cast(unsigned, r); }
struct EpiBf16P {
    static constexpr bool PERM = true, AFTER_DRAIN = false;
    bf16_t* O; int ldc;
    __device__ __forceinline__ void operator()(const f32x4 (&acc)[2][2][4][2], const Unit& u, int wr, int wc, int fr, int fq) const {
        const int row0 = u.pm * BM + wr * 64 + fr, col0 = u.pn * BM + wc * 32 + 8 * fq;
#pragma unroll
        for (int ai = 0; ai < 2; ++ai)
#pragma unroll
            for (int m = 0; m < 4; ++m) { bf16_t* rowp = O + (size_t)(row0 + ai * HALF + m * 16) * ldc + col0;
#pragma unroll
                for (int bj = 0; bj < 2; ++bj) { const f32x4 v0 = acc[ai][bj][m][0], v1 = acc[ai][bj][m][1];
                    u32x4 w; w.x = cvt_pk_bf16(v0[0], v0[1]); w.y = cvt_pk_bf16(v0[2], v0[3]); w.z = cvt_pk_bf16(v1[0], v1[1]); w.w = cvt_pk_bf16(v1[2], v1[3]);
                    *(u32x4*)(rowp + bj * HALF) = w; } }
    }
};
struct EpiResid {
    static constexpr bool PERM = false, AFTER_DRAIN = false;
    float* Z; const float* X; const float* gate; float alpha;
    __device__ __forceinline__ void operator()(const f32x4 (&acc)[2][2][4][2], const Unit& u, int wr, int wc, int fr, int fq) const {
        const int row0 = u.pm * BM + wr * 64 + fr, col0 = u.pn * BM + wc * 32 + 4 * fq;
        const float* gb = gate + (size_t)(u.pm >> 3) * (6 * 2048) + col0;
        f32x4 gv[2][2];
#pragma unroll
        for (int bj = 0; bj < 2; ++bj)
#pragma unroll
            for (int n = 0; n < 2; ++n) gv[bj][n] = *(const f32x4*)(gb + bj * HALF + n * 16) + 1.0f;
#pragma unroll
        for (int ai = 0; ai < 2; ++ai)
#pragma unroll
            for (int m = 0; m < 4; ++m) { const size_t off = (size_t)(row0 + ai * HALF + m * 16) * 2048 + col0;
#pragma unroll
                for (int bj = 0; bj < 2; ++bj)
#pragma unroll
                    for (int n = 0; n < 2; ++n) { const f32x4 xv = *(const f32x4*)(X + off + bj * HALF + n * 16);
                        *(f32x4*)(Z + off + bj * HALF + n * 16) = xv * alpha + gv[bj][n] * acc[ai][bj][m][n]; }
                asm volatile("" ::: "memory"); }
    }
};
template <class Epi, class Sched, bool ALIGN_EPI = false, bool SP2 = false>
__device__ __forceinline__ void gemm_phase(PG8_LAS unsigned char* lds, const Gemm g, const Sched& S, const Epi& E, const int tid_in) {
    const int tid = tid_in, wid = __builtin_amdgcn_readfirstlane(tid >> 6), lane = tid & 63, wr = wid >> 2, wc = wid & 3, fr = lane & 15, fq = lane >> 4;
    const int K = g.K, nt = K / BK;
    unsigned voffA[2], voffB[2];
#pragma unroll
    for (int i = 0; i < 2; ++i) { int R, C; stage_rc(tid * 16 + i * 8192, R, C); const int Rb = Epi::PERM ? ((R & ~31) + perm32(R & 31)) : R;
        voffA[i] = (unsigned)(R * K + C) * 2u; voffB[i] = (unsigned)(Rb * K + C) * 2u; }
    const size_t kstep = (size_t)(BK * 2);
    const size_t hstep = (size_t)HALF * K * 2;
    const size_t tstep = 2 * hstep;
    const unsigned ldsw = (unsigned)wid * 1024u;
    const int aoff = lds_byte(wr * 64 + fr, fq * 8), boff = lds_byte(wc * 32 + fr, fq * 8);
#define PG8_SA(b, h) (((b) * 2 + (h)) * HTB)
#define PG8_SB(b, h) ((4 + (b) * 2 + (h)) * HTB)
#define PG8_STAGE(bufoff, gbase, voff) do { _Pragma("unroll") for (int _i = 0; _i < 2; ++_i) \
        __builtin_amdgcn_global_load_lds((const unsigned*)((const char*)(gbase) + (voff)[_i]), (PG8_LAS unsigned*)(lds + (bufoff) + ldsw + _i * 8192), 16, 0, 0); } while (0)
#define PG8_LDA(dst, b, h) do { _Pragma("unroll") for (int m = 0; m < 4; ++m) _Pragma("unroll") for (int k = 0; k < 2; ++k) dst[m][k] = *(const PG8_LAS bf16x8*)(lds + PG8_SA(b, h) + aoff + m * 2048 + k * 1024); } while (0)
#define PG8_LDB(dst, b, h) do { _Pragma("unroll") for (int n = 0; n < 2; ++n) _Pragma("unroll") for (int k = 0; k < 2; ++k) dst[n][k] = *(const PG8_LAS bf16x8*)(lds + PG8_SB(b, h) + boff + n * 2048 + k * 1024); } while (0)
#define PG8_MMA(ai, bj, At, Bt) do { __builtin_amdgcn_s_setprio(1); _Pragma("unroll") for (int m = 0; m < 4; ++m) _Pragma("unroll") for (int n = 0; n < 2; ++n) _Pragma("unroll") for (int k = 0; k < 2; ++k) \
        acc[ai][bj][m][n] = __builtin_amdgcn_mfma_f32_16x16x32_bf16(Bt[n][k], At[m][k], acc[ai][bj][m][n], 0, 0, 0); __builtin_amdgcn_s_setprio(0); } while (0)
#define PG8_WAIT_V(n) asm volatile("s_waitcnt vmcnt(" #n ")" ::: "memory")
#define PG8_WAIT_L(n) asm volatile("s_waitcnt lgkmcnt(" #n ")" ::: "memory")
#define PG8_BAR __builtin_amdgcn_s_barrier()
#define PG8_SCHED __builtin_amdgcn_sched_barrier(0)
    Unit cur, nxt; int ui = 0;
    if (!S.next(0, cur)) return;
    f32x4 acc[2][2][4][2];
#pragma unroll
    for (int a = 0; a < 2; ++a)
#pragma unroll
        for (int b = 0; b < 2; ++b)
#pragma unroll
            for (int m = 0; m < 4; ++m)
#pragma unroll
                for (int n = 0; n < 2; ++n) acc[a][b][m][n] = (f32x4){0.f, 0.f, 0.f, 0.f};
    bf16x8 At[4][2], B0[2][2], B1[2][2];
    const char* cA = (const char*)g.A + (size_t)cur.pm * tstep; const char* cB = (const char*)g.Bt + (size_t)cur.pn * tstep;
    S.a_ready(cur);
    if constexpr (SP2) {
        PG8_STAGE(PG8_SB(0, 0), cB, voffB); PG8_STAGE(PG8_SB(0, 1), cB + hstep, voffB); PG8_STAGE(PG8_SA(0, 0), cA, voffA); PG8_STAGE(PG8_SA(0, 1), cA + hstep, voffA);
        if (wr == 1) PG8_BAR;
        PG8_WAIT_V(2); PG8_BAR;
        PG8_STAGE(PG8_SB(1, 0), cB + kstep, voffB); PG8_STAGE(PG8_SA(1, 0), cA + kstep, voffA); PG8_STAGE(PG8_SB(1, 1), cB + hstep + kstep, voffB);
        PG8_WAIT_V(6); PG8_BAR;
    } else {
        PG8_STAGE(PG8_SB(0, 0), cB, voffB); PG8_STAGE(PG8_SA(0, 0), cA, voffA); PG8_STAGE(PG8_SB(0, 1), cB + hstep, voffB); PG8_STAGE(PG8_SA(0, 1), cA + hstep, voffA);
        if (wr == 1) PG8_BAR;
        PG8_WAIT_V(4); PG8_BAR;
        PG8_STAGE(PG8_SB(1, 0), cB + kstep, voffB); PG8_STAGE(PG8_SA(1, 0), cA + kstep, voffA); PG8_STAGE(PG8_SB(1, 1), cB + hstep + kstep, voffB);
        PG8_WAIT_V(6); PG8_BAR;
    }
    for (;;) {
        const bool has_next = S.next(ui + 1, nxt);
        const char* nA = has_next ? (const char*)g.A + (size_t)nxt.pm * tstep : cA; const char* nB = has_next ? (const char*)g.Bt + (size_t)nxt.pn * tstep : cB;
        for (int t = 0; t < nt; t += 2) {
            const bool last = (t == nt - 2);
            const char* a1 = cA + (size_t)(t + 1) * kstep;
            const char* a2 = last ? nA : cA + (size_t)(t + 2) * kstep; const char* b2 = last ? nB : cB + (size_t)(t + 2) * kstep;
            const char* a3 = a2 + kstep; const char* b3 = b2 + kstep;
            if (last && has_next) S.a_ready(nxt);
            if constexpr (SP2) {
            PG8_LDB(B0, 0, 0); PG8_LDB(B1, 0, 1); PG8_SCHED; PG8_LDA(At, 0, 0); PG8_STAGE(PG8_SA(1, 1), a1 + hstep, voffA);
            PG8_WAIT_V(8); PG8_WAIT_L(0); PG8_BAR; PG8_MMA(0, 0, At, B0); PG8_MMA(0, 1, At, B1); PG8_BAR; PG8_SCHED;
            PG8_LDA(At, 0, 1); PG8_STAGE(PG8_SB(0, 0), b2, voffB); PG8_STAGE(PG8_SB(0, 1), b2 + hstep, voffB); PG8_STAGE(PG8_SA(0, 0), a2, voffA);
            PG8_WAIT_V(8); PG8_WAIT_L(0); PG8_BAR; PG8_MMA(1, 0, At, B0); PG8_MMA(1, 1, At, B1); PG8_BAR; PG8_SCHED;
            PG8_LDB(B0, 1, 0); PG8_LDB(B1, 1, 1); PG8_SCHED; PG8_LDA(At, 1, 0); PG8_STAGE(PG8_SA(0, 1), a2 + hstep, voffA);
            PG8_WAIT_V(8); PG8_WAIT_L(0); PG8_BAR; PG8_MMA(0, 0, At, B0); PG8_MMA(0, 1, At, B1); PG8_BAR; PG8_SCHED;
            PG8_LDA(At, 1, 1); PG8_STAGE(PG8_SB(1, 0), b3, voffB); PG8_STAGE(PG8_SB(1, 1), b3 + hstep, voffB); PG8_STAGE(PG8_SA(1, 0), a3, voffA);
            PG8_WAIT_V(8); PG8_WAIT_L(0); PG8_BAR; PG8_MMA(1, 0, At, B0); PG8_MMA(1, 1, At, B1); PG8_BAR; PG8_SCHED;
            } else {
            PG8_LDB(B0, 0, 0); PG8_SCHED; PG8_LDA(At, 0, 0); PG8_STAGE(PG8_SA(1, 1), a1 + hstep, voffA);
            PG8_WAIT_L(8); PG8_BAR; PG8_WAIT_L(0); PG8_MMA(0, 0, At, B0); PG8_BAR; PG8_SCHED;
            PG8_LDB(B1, 0, 1); PG8_STAGE(PG8_SB(0, 0), b2, voffB);
            PG8_BAR; PG8_WAIT_L(0); PG8_MMA(0, 1, At, B1); PG8_BAR;
            PG8_LDA(At, 0, 1); PG8_STAGE(PG8_SA(0, 0), a2, voffA);
            PG8_BAR; PG8_WAIT_L(0); PG8_MMA(1, 0, At, B0); PG8_BAR; PG8_SCHED;
            PG8_STAGE(PG8_SB(0, 1), b2 + hstep, voffB);
            PG8_WAIT_V(6); PG8_BAR; PG8_MMA(1, 1, At, B1); PG8_BAR;
            PG8_LDB(B0, 1, 0); PG8_SCHED; PG8_LDA(At, 1, 0); PG8_STAGE(PG8_SA(0, 1), a2 + hstep, voffA);
            PG8_WAIT_L(8); PG8_BAR; PG8_WAIT_L(0); PG8_MMA(0, 0, At, B0); PG8_BAR; PG8_SCHED;
            PG8_LDB(B1, 1, 1); PG8_STAGE(PG8_SB(1, 0), b3, voffB);
            PG8_BAR; PG8_WAIT_L(0); PG8_MMA(0, 1, At, B1); PG8_BAR;
            PG8_LDA(At, 1, 1); PG8_STAGE(PG8_SA(1, 0), a3, voffA);
            PG8_BAR; PG8_WAIT_L(0); PG8_MMA(1, 0, At, B0); PG8_BAR; PG8_SCHED;
            PG8_STAGE(PG8_SB(1, 1), b3 + hstep, voffB);
            PG8_WAIT_V(6); PG8_BAR; PG8_MMA(1, 1, At, B1); PG8_BAR;
            }
        }
        if constexpr (ALIGN_EPI) { if (wr == 0) PG8_BAR; }
        if constexpr (!Epi::AFTER_DRAIN) { E(acc, cur, wr, wc, fr, fq); S.done(cur); }
        if (!has_next) break;
#pragma unroll
        for (int a = 0; a < 2; ++a)
#pragma unroll
            for (int b = 0; b < 2; ++b)
#pragma unroll
                for (int m = 0; m < 4; ++m)
#pragma unroll
                    for (int n = 0; n < 2; ++n) acc[a][b][m][n] = (f32x4){0.f, 0.f, 0.f, 0.f};
        cur = nxt; cA = nA; cB = nB; ++ui;
        if constexpr (ALIGN_EPI) { if (wr == 1) PG8_BAR; }
    }
    PG8_WAIT_V(0);
    if constexpr (!ALIGN_EPI) { if (wr == 0) PG8_BAR; }
    PG8_BAR;
    if constexpr (Epi::AFTER_DRAIN) { E.fused(acc, cur, wr, wc, fr, fq, lds, wid, lane); S.done(cur); }
#undef PG8_SA
#undef PG8_SB
#undef PG8_STAGE
#undef PG8_LDA
#undef PG8_LDB
#undef PG8_MMA
#undef PG8_WAIT_V
#undef PG8_WAIT_L
#undef PG8_BAR
#undef PG8_SCHED
}
}
#define XB_TMO      128
#define XB_XCNT(j)  (256  + 64 * (j))
#define XB_XSUB(j)  (1280 + 64 * (j))
#define XB_XGEN(j)  (2304 + 64 * (j))
#define XB_TOP      3328
#define XB_TOPGEN   3392
#define XCD_BAR_WORDS 3456
#define XB_SPIN_CAP (1u << 18)
#define LAS __attribute__((address_space(3)))

__device__ __forceinline__ unsigned xb_ld(unsigned* p)              { return __hip_atomic_load(p, __ATOMIC_RELAXED, __HIP_MEMORY_SCOPE_AGENT); }
__device__ __forceinline__ unsigned xb_add(unsigned* p, unsigned v) { return __hip_atomic_fetch_add(p, v, __ATOMIC_RELAXED, __HIP_MEMORY_SCOPE_AGENT); }
__device__ __forceinline__ unsigned xb_xcc_id() { return (unsigned)__builtin_amdgcn_s_getreg((3 << 11) | 20) & 0xFu; }
#define XB_SPIN(cond, bar) do { unsigned _sp = 0; while (cond) { __builtin_amdgcn_s_sleep(1); \
    if ((++_sp & 255u) == 0u) { if (xb_ld(&(bar)[XB_TMO])) break; if (_sp > XB_SPIN_CAP) { atomicAdd(&(bar)[XB_TMO], 1u); break; } } } } while (0)

struct XcdBarrier {
    unsigned* bar; unsigned x;
    volatile LAS unsigned* st;
};

__device__ __forceinline__ XcdBarrier xcd_barrier_post(unsigned* bar, volatile LAS unsigned* st) {
    XcdBarrier b; b.bar = bar; b.x = xb_xcc_id(); b.st = st;
    if (threadIdx.x == 0) (void)xb_add(&bar[XB_XCNT(b.x)], 1u);
    return b;
}
__device__ __forceinline__ void xcd_barrier_complete(unsigned* bar, unsigned x, unsigned& nloc, unsigned& nx) {
    const unsigned G = gridDim.x * gridDim.y * gridDim.z;
    unsigned sum, cnt, mine, sp = 0u;
    for (;;) {
        sum = 0u; cnt = 0u; mine = 0u;
#pragma unroll
        for (unsigned j = 0; j < 16; ++j) { const unsigned c = xb_ld(&bar[XB_XCNT(j)]); sum += c; cnt += (c > 0u) ? 1u : 0u; mine = (j == x) ? c : mine; }
        if (sum == G) break;
        __builtin_amdgcn_s_sleep(1);
        if ((++sp & 255u) == 0u) { if (xb_ld(&bar[XB_TMO])) break; if (sp > XB_SPIN_CAP) { atomicAdd(&bar[XB_TMO], 1u); break; } }
    }
    nloc = mine > 0u ? mine : 1u; nx = cnt > 0u ? cnt : 1u;
}

__device__ __forceinline__ void xcd_barrier(const XcdBarrier& b) {
    asm volatile("s_waitcnt vmcnt(0)" ::: "memory");
    __syncthreads();
    if (threadIdx.x == 0) {
        unsigned* bar = b.bar;
        __builtin_amdgcn_s_waitcnt(0);
        unsigned nloc = b.st[0], nx = b.st[1];
        if (nloc == 0u) { xcd_barrier_complete(bar, b.x, nloc, nx); b.st[0] = nloc; b.st[1] = nx; }
        const unsigned old = xb_add(&bar[XB_XSUB(b.x)], 1u);
        const unsigned gen = old / nloc;
        if (old + 1u == (gen + 1u) * nloc) {
            __builtin_amdgcn_fence(__ATOMIC_RELEASE, "agent");
            asm volatile("s_waitcnt vmcnt(0)" ::: "memory");
            const unsigned og = xb_add(&bar[XB_TOP], 1u);
            const unsigned tg = og / nx;
            if (og + 1u == (tg + 1u) * nx) xb_add(&bar[XB_TOPGEN], 1u);
            else XB_SPIN(xb_ld(&bar[XB_TOPGEN]) == tg, bar);
            __builtin_amdgcn_fence(__ATOMIC_ACQUIRE, "agent");
            xb_add(&bar[XB_XGEN(b.x)], 1u);
            asm volatile("s_waitcnt vmcnt(0)" ::: "memory");
        } else {
            XB_SPIN(xb_ld(&bar[XB_XGEN(b.x)]) == gen, bar);
            __builtin_amdgcn_fence(__ATOMIC_ACQUIRE, "agent");
            asm volatile("s_waitcnt vmcnt(0)" ::: "memory");
        }
    }
    __syncthreads();
}
constexpr int D = 2048, NB = 8, SEQ = 2048, NL = 4, T = NB * SEQ;
constexpr int NCH = SEQ / 64, NCHUNK = T / 64;
constexpr int GKW = 512, RANK = 16;
constexpr int INW = 6160, NP = 6144;
constexpr int NE = 16384;
constexpr float ALPHA = 1.6817928305074290f, EPS = 1e-5f;
constexpr int PQ = 0, PK = 512, PV = 1024, PR = 2048, PCB = 3072, PCC = 4096, PCH = 5120;
constexpr int NWAVES = 8, NTHREADS = 512;
#ifndef TAB4
#define TAB4 1
#endif
constexpr int NPHASES = 2 + 7 * NL;

constexpr size_t MiB = 1u << 20;
constexpr size_t WS_CTL = 0, CTL_ZERO_BYTES = 1 * MiB;
constexpr size_t WS_MOD = 1 * MiB, WS_PART = 3 * MiB, WS_KEYS = 15 * MiB, WS_DTOT = 17 * MiB, WS_WIN = 18 * MiB, WS_WOUT = 115 * MiB, WS_WQ = 147 * MiB;
constexpr size_t WS_UT = 179 * MiB, WS_VT = 435 * MiB, WS_H = 691 * MiB, WS_PROJ = 755 * MiB, WS_E = 947 * MiB, WS_OGLA = 979 * MiB, WS_Y = 1043 * MiB;
constexpr size_t WS_Z = 1107 * MiB, WS_X1 = 1235 * MiB, WS_X = 1363 * MiB, WS_Q = 1491 * MiB, WS_H2 = 1555 * MiB, WS_HQ8 = 1619 * MiB, WS_END = 1659 * MiB;
constexpr size_t WS_SU = 17 * MiB + 512 * 1024, WS_SV = 17 * MiB + 768 * 1024, WS_HSC = 2 * MiB + 640 * 1024;
static_assert(WS_WIN + (size_t)NL * INW * D * 2 <= WS_WOUT && WS_PART + (size_t)NL * 8 * NB * 6 * D * 4 <= WS_KEYS && WS_MOD + (size_t)NL * NB * 6 * D * 4 <= WS_PART, "ws map");
constexpr int CW_BAR = 4096;

constexpr int RING_OFF = 0, RING_BYTES = 131072, LDSCTL_OFF = RING_BYTES, LDS_BYTES = 147456;

#define GAS __attribute__((address_space(1)))
typedef unsigned short bf16;
typedef unsigned v4u __attribute__((ext_vector_type(4)));
typedef unsigned v2u __attribute__((ext_vector_type(2)));
typedef float f32x4 __attribute__((ext_vector_type(4)));
typedef float f32x16 __attribute__((ext_vector_type(16)));
typedef short bf16x8 __attribute__((ext_vector_type(8)));
typedef __bf16 bf16x2v __attribute__((ext_vector_type(2)));
#define LDS_WAIT() asm volatile("s_waitcnt lgkmcnt(0)" ::: "memory")

__device__ __forceinline__ unsigned pk2(float lo, float hi) { return pg8::cvt_pk_bf16(lo, hi); }
__device__ __forceinline__ float dot2bf(unsigned w, unsigned x, float acc) { return __builtin_amdgcn_fdot2_f32_bf16(__builtin_bit_cast(bf16x2v, w), __builtin_bit_cast(bf16x2v, x), acc, false); }
__device__ __forceinline__ float bflo(unsigned u) { return __uint_as_float(u << 16); }
__device__ __forceinline__ float bfhi(unsigned u) { return __uint_as_float(u & 0xffff0000u); }
__device__ __forceinline__ float silu_f(float x) { return x / (1.0f + __expf(-x)); }
__device__ __forceinline__ float logsigmoid_f(float x) { return fminf(x, 0.0f) - log1pf(__expf(-fabsf(x))); }
__device__ __forceinline__ float gelu_tanh_f(float x) { const float u = 0.7978845608028654f * (x + 0.044715f * x * x * x); return 0.5f * x * (1.0f + tanhf(u)); }
__device__ __forceinline__ float wave_sum(float v) {
#pragma unroll
    for (int o = 1; o < 64; o <<= 1) v += __shfl_xor(v, o);
    return v;
}

struct Args { const float* in[19]; float* out; unsigned char* ws; int ph_lo, ph_hi; };

__device__ __forceinline__ void transpose_item(const float* W, int ldw, int col0, bf16* WTrows, int k0, int nvalid, LAS float* scr, int lane) {
    const int n = lane & 31;
    float tv[32];
#pragma unroll
    for (int i = 0; i < 32; ++i) { const int kk = 2 * i + (lane >> 5); tv[i] = (n < nvalid) ? W[(size_t)(k0 + kk) * ldw + col0 + n] : 0.f; }
#pragma unroll
    for (int i = 0; i < 32; ++i) { const int kk = 2 * i + (lane >> 5); scr[kk * 33 + n] = tv[i]; }
    LDS_WAIT(); asm volatile("" ::: "memory");
    const int c = lane & 7;
#pragma unroll
    for (int j = 0; j < 4; ++j) { const int nn = (lane >> 3) + 8 * j; const LAS float* s = scr + (8 * c) * 33 + nn;
        v4u o; o.x = pk2(s[0 * 33], s[1 * 33]); o.y = pk2(s[2 * 33], s[3 * 33]); o.z = pk2(s[4 * 33], s[5 * 33]); o.w = pk2(s[6 * 33], s[7 * 33]);
        if (nn < nvalid) *(v4u*)(WTrows + (size_t)nn * D + k0 + 8 * c) = o; }
    LDS_WAIT(); asm volatile("" ::: "memory");
}
__device__ __forceinline__ void cvt_stream(const float* src, bf16* dst, size_t n4, size_t i0, size_t stride) {
    for (size_t i = i0; i < n4; i += stride) { const f32x4 v = ((const f32x4*)src)[i]; v2u o; o.x = pk2(v.x, v.y); o.y = pk2(v.z, v.w); ((v2u*)dst)[i] = o; }
}
__device__ __forceinline__ void ph_prologue_a(const Args& a, LAS unsigned char* lds, int tid, int lane, int wave, int bx, int G) {
    const int gw = bx * NWAVES + wave, NGW = G * NWAVES;
    LAS float* cact = (LAS float*)lds;
    for (int i = tid; i < NB * D; i += NTHREADS) { const int b = i / D, d = i % D; cact[d * 8 + b] = silu_f(a.in[1][i]); }
    __syncthreads();
    float* part = (float*)(a.ws + WS_PART);
    for (int it = gw; it < NL * 8 * 48; it += NGW) {
        const int cg = it % 48, dr = (it / 48) % 8, l = it / 384;
        f32x4 acc[8];
#pragma unroll
        for (int b = 0; b < 8; ++b) acc[b] = (f32x4){0.f, 0.f, 0.f, 0.f};
        const float* w = a.in[2] + ((size_t)l * D + dr * 256) * (6 * D) + cg * 256 + lane * 4;
#pragma unroll 4
        for (int d = 0; d < 256; ++d) {
            const f32x4 wv = *(const f32x4*)(w + (size_t)d * (6 * D));
            const f32x4 c0 = *(const LAS f32x4*)(cact + (dr * 256 + d) * 8), c1 = *(const LAS f32x4*)(cact + (dr * 256 + d) * 8 + 4);
            acc[0] += wv * c0.x; acc[1] += wv * c0.y; acc[2] += wv * c0.z; acc[3] += wv * c0.w;
            acc[4] += wv * c1.x; acc[5] += wv * c1.y; acc[6] += wv * c1.z; acc[7] += wv * c1.w;
        }
#pragma unroll
        for (int b = 0; b < 8; ++b) *(f32x4*)(part + (((size_t)l * 8 + dr) * NB + b) * (6 * D) + cg * 256 + lane * 4) = acc[b];
    }
    __syncthreads();
    LAS float* scr = (LAS float*)(lds + wave * 8448);
    bf16* winT = (bf16*)(a.ws + WS_WIN); bf16* woutT = (bf16*)(a.ws + WS_WOUT); bf16* wqT = (bf16*)(a.ws + WS_WQ);
    constexpr int IPL = 6144 + 32 + 2048 + 2048;
    for (int it = gw; it < NL * IPL; it += NGW) {
        const int l = it / IPL; int r = it % IPL;
        if (r < 6144) { const int nb = r % 192, kb = r / 192, n0 = nb * 32;
            transpose_item(a.in[4] + (size_t)l * D * INW, INW, n0 < 3072 ? n0 : n0 + 16, winT + ((size_t)l * INW + n0) * D, kb * 64, 32, scr, lane); continue; }
        r -= 6144;
        if (r < 32) { transpose_item(a.in[4] + (size_t)l * D * INW, INW, 3072, winT + ((size_t)l * INW + NP) * D, r * 64, 16, scr, lane); continue; }
        r -= 32;
        if (r < 2048) { const int nb = r % 64, kb = r / 64; transpose_item(a.in[10] + (size_t)l * D * D, D, nb * 32, woutT + ((size_t)l * D + nb * 32) * D, kb * 64, 32, scr, lane); continue; }
        r -= 2048;
        { const int nb = r % 64, kb = r / 64; transpose_item(a.in[13] + (size_t)l * D * D, D, nb * 32, wqT + ((size_t)l * D + nb * 32) * D, kb * 64, 32, scr, lane); }
    }
    const size_t i0 = (size_t)bx * NTHREADS + tid, stride = (size_t)G * NTHREADS;
    cvt_stream(a.in[14], (bf16*)(a.ws + WS_KEYS), (size_t)NL * 8 * 2 * 128 * 128 / 4, i0, stride);
#if TAB4
    __syncthreads();
    { LAS float* rowst = (LAS float*)(lds + wave * 8192);
      for (int row = gw; row < 2 * NL * NE; row += NGW) {
        const int tbl = row / (NL * NE), r = row % (NL * NE);
        const float* src = (tbl ? a.in[16] : a.in[15]) + (size_t)r * D;
#pragma unroll
        for (int c8 = 0; c8 < 8; ++c8) *(LAS f32x4*)(rowst + (c8 * 64 + lane) * 4) = *(const f32x4*)(src + (c8 * 64 + lane) * 4);
        LDS_WAIT(); asm volatile("" ::: "memory");
        unsigned char* tb = a.ws + (tbl ? WS_VT : WS_UT) + (size_t)r * 1152;
#pragma unroll
        for (int pass = 0; pass < 2; ++pass) { const int slot = lane + 64 * pass;
            if (slot < 72) { const int col0 = (slot >> 3) * 240 + (slot & 7) * 30;
                float x[30]; float mx = 0.f;
#pragma unroll
                for (int k = 0; k < 30; ++k) { x[k] = (col0 + k < D) ? rowst[col0 + k] : 0.f; mx = fmaxf(mx, fabsf(x[k])); }
                int code = 0; float inv = 0.f;
                if (mx > 0.f) { code = (int)ceilf(8.0f * log2f(mx * (1.0f / 7.0f))) + 128; code = code < 0 ? 0 : (code > 255 ? 255 : code); inv = __builtin_amdgcn_exp2f(16.0f - (float)code * 0.125f); }
                unsigned dw[4] = {0u, 0u, 0u, 0u};
#pragma unroll
                for (int kb = 0; kb < 15; ++kb) { int a0 = (int)__builtin_rintf(x[2 * kb] * inv), a1 = (int)__builtin_rintf(x[2 * kb + 1] * inv);
                    a0 = a0 < -7 ? -7 : (a0 > 7 ? 7 : a0); a1 = a1 < -7 ? -7 : (a1 > 7 ? 7 : a1);
                    dw[kb >> 2] |= ((unsigned)(a0 + 8) | ((unsigned)(a1 + 8) << 4)) << (8 * (kb & 3)); }
                dw[3] |= (unsigned)code << 24;
                *(v4u*)(tb + slot * 16) = (v4u){dw[0], dw[1], dw[2], dw[3]}; } }
        LDS_WAIT(); asm volatile("" ::: "memory");
      } }
#else
    for (int row = gw; row < 2 * NL * NE; row += NGW) {
        const int tbl = row / (NL * NE), r = row % (NL * NE);
        const float* src = (tbl ? a.in[16] : a.in[15]) + (size_t)r * D;
        f32x4 v[8]; float mx = 0.f;
#pragma unroll
        for (int c8 = 0; c8 < 8; ++c8) { v[c8] = *(const f32x4*)(src + (c8 * 64 + lane) * 4); mx = fmaxf(mx, fmaxf(fmaxf(fabsf(v[c8].x), fabsf(v[c8].y)), fmaxf(fabsf(v[c8].z), fabsf(v[c8].w)))); }
#pragma unroll
        for (int o = 1; o < 64; o <<= 1) mx = fmaxf(mx, __shfl_xor(mx, o));
        const float inv = mx > 0.f ? 127.0f / mx : 0.f; const int off = tbl ? 128 : 0;
        unsigned dw[8];
#pragma unroll
        for (int c8 = 0; c8 < 8; ++c8) { const int q0 = (int)__builtin_rintf(v[c8].x * inv) + off, q1 = (int)__builtin_rintf(v[c8].y * inv) + off, q2 = (int)__builtin_rintf(v[c8].z * inv) + off, q3 = (int)__builtin_rintf(v[c8].w * inv) + off;
            dw[c8] = (unsigned)(q0 & 255) | ((unsigned)(q1 & 255) << 8) | ((unsigned)(q2 & 255) << 16) | ((unsigned)(q3 & 255) << 24); }
        unsigned char* dst = a.ws + (tbl ? WS_VT : WS_UT) + (size_t)r * D;
        *(v4u*)(dst + lane * 16) = (v4u){dw[0], dw[1], dw[2], dw[3]}; *(v4u*)(dst + (64 + lane) * 16) = (v4u){dw[4], dw[5], dw[6], dw[7]};
        if (lane == 0) ((float*)(a.ws + (tbl ? WS_SV : WS_SU)))[r] = mx * (1.0f / 127.0f);
    }
#endif
}

__device__ __forceinline__ void ln_tail(const float (&z)[32], int t, int lane, const float* g, const float* bta, float* xout, const float* sh, const float* sc, bf16* hout, unsigned char* q8, float* q8s, LAS unsigned char* q8stage = nullptr) {
    float s = 0.f;
#pragma unroll
    for (int i = 0; i < 32; ++i) s += z[i];
    const float mu = wave_sum(s) * (1.0f / D);
    float q = 0.f;
#pragma unroll
    for (int i = 0; i < 32; ++i) { const float d = z[i] - mu; q += d * d; }
    const float rs = rsqrtf(wave_sum(q) * (1.0f / D) + EPS);
    float hv[32]; float mx = 0.f;
#pragma unroll
    for (int c = 0; c < 8; ++c) { const int col = (c * 64 + lane) * 4;
        const f32x4 g0 = *(const f32x4*)(g + col), b0 = *(const f32x4*)(bta + col);
        f32x4 x0;
        x0.x = (z[c * 4 + 0] - mu) * rs * g0.x + b0.x; x0.y = (z[c * 4 + 1] - mu) * rs * g0.y + b0.y; x0.z = (z[c * 4 + 2] - mu) * rs * g0.z + b0.z; x0.w = (z[c * 4 + 3] - mu) * rs * g0.w + b0.w;
        if (xout) *(f32x4*)(xout + (size_t)t * D + col) = x0;
        if (hout) { const f32x4 s0 = *(const f32x4*)(sc + col), h0 = *(const f32x4*)(sh + col);
            hv[c * 4] = x0.x * (1.f + s0.x) + h0.x; hv[c * 4 + 1] = x0.y * (1.f + s0.y) + h0.y; hv[c * 4 + 2] = x0.z * (1.f + s0.z) + h0.z; hv[c * 4 + 3] = x0.w * (1.f + s0.w) + h0.w;
            v2u o; o.x = pk2(hv[c * 4], hv[c * 4 + 1]); o.y = pk2(hv[c * 4 + 2], hv[c * 4 + 3]);
            *(v2u*)(hout + (size_t)t * D + col) = o;
            if (q8) {
                hv[c * 4] = bflo(o.x); hv[c * 4 + 1] = bfhi(o.x); hv[c * 4 + 2] = bflo(o.y); hv[c * 4 + 3] = bfhi(o.y);
                mx = fmaxf(mx, fmaxf(fmaxf(fabsf(hv[c * 4]), fabsf(hv[c * 4 + 1])), fmaxf(fabsf(hv[c * 4 + 2]), fabsf(hv[c * 4 + 3])))); } }
    }
    if (q8) {
#pragma unroll
        for (int o = 1; o < 64; o <<= 1) mx = fmaxf(mx, __shfl_xor(mx, o));
        const float qmax_ = TAB4 ? 119.0f : 127.0f;
        const float inv = mx > 0.f ? qmax_ / mx : 0.f;
        unsigned dw[8];
#pragma unroll
        for (int c = 0; c < 8; ++c) { const int q0 = (int)__builtin_rintf(hv[c * 4] * inv), q1 = (int)__builtin_rintf(hv[c * 4 + 1] * inv), q2 = (int)__builtin_rintf(hv[c * 4 + 2] * inv), q3 = (int)__builtin_rintf(hv[c * 4 + 3] * inv);
            dw[c] = (unsigned)(q0 & 255) | ((unsigned)(q1 & 255) << 8) | ((unsigned)(q2 & 255) << 16) | ((unsigned)(q3 & 255) << 24); }
#if TAB4
        { LAS unsigned* st32 = (LAS unsigned*)q8stage; LAS unsigned char* st8 = (LAS unsigned char*)q8stage;
#pragma unroll
          for (int i = 0; i < 9; ++i) st32[lane + 64 * i] = 0u;
          LDS_WAIT(); asm volatile("" ::: "memory");
#pragma unroll
          for (int c = 0; c < 8; ++c)
#pragma unroll
              for (int jp = 0; jp < 2; ++jp) { const int col = (c * 64 + lane) * 4 + 2 * jp, u = col / 240, r = col - u * 240, l7 = r / 30, k = r - l7 * 30;
                  const int q0 = (int)(signed char)((dw[c] >> (16 * jp)) & 255u), q1 = (int)(signed char)((dw[c] >> (16 * jp + 8)) & 255u);
                  const int l0 = ((q0 + 8) & 15) - 8, l1 = ((q1 + 8) & 15) - 8, h0 = (q0 - l0) >> 4, h1 = (q1 - l1) >> 4;
                  LAS unsigned char* sp = st8 + (u * 8 + l7) * 32 + (k >> 1);
                  sp[0] = (unsigned char)((l0 & 15) | ((l1 & 15) << 4)); sp[16] = (unsigned char)((h0 & 15) | ((h1 & 15) << 4)); }
          LDS_WAIT(); asm volatile("" ::: "memory");
          unsigned* d32 = (unsigned*)(q8 + (size_t)t * 2304);
#pragma unroll
          for (int i = 0; i < 9; ++i) d32[lane + 64 * i] = st32[lane + 64 * i];
          LDS_WAIT(); asm volatile("" ::: "memory"); }
#else
        unsigned char* dst = q8 + (size_t)t * D;
        *(v4u*)(dst + lane * 16) = (v4u){dw[0], dw[1], dw[2], dw[3]}; *(v4u*)(dst + (64 + lane) * 16) = (v4u){dw[4], dw[5], dw[6], dw[7]};
#endif
        if (lane == 0) q8s[t] = mx / qmax_;
    }
}

__device__ __forceinline__ void ph_prologue_b(const Args& a, LAS unsigned char* lds, int tid, int lane, int wave, int bx, int G) {
    const float* part = (const float*)(a.ws + WS_PART); float* mod = (float*)(a.ws + WS_MOD);
    for (int i = bx * NTHREADS + tid; i < NL * NB * 6 * D / 4; i += G * NTHREADS) {
        const int idx = i * 4, e = idx % (6 * D), b = (idx / (6 * D)) % NB, l = idx / (6 * D * NB);
        f32x4 s = *(const f32x4*)(a.in[3] + l * 6 * D + e);
#pragma unroll
        for (int dr = 0; dr < 8; ++dr) s += *(const f32x4*)(part + (((size_t)l * 8 + dr) * NB + b) * (6 * D) + e);
        *(f32x4*)(mod + idx) = s;
    }
    LAS float* msh = (LAS float*)lds;
    bf16* hbuf = (bf16*)(a.ws + WS_H);
    for (int ch = bx; ch < NCHUNK; ch += G) {
        const int b = ch / NCH;
        for (int i = tid; i < 1024; i += NTHREADS) { const int e = i * 4;
            f32x4 s = *(const f32x4*)(a.in[3] + e);
#pragma unroll
            for (int dr = 0; dr < 8; ++dr) s += *(const f32x4*)(part + (((size_t)0 * 8 + dr) * NB + b) * (6 * D) + e);
            *(LAS f32x4*)(msh + e) = s; }
        __syncthreads();
        for (int i = 0; i < 8; ++i) { const int t = ch * 64 + wave * 8 + i;
#pragma unroll
            for (int c = 0; c < 4; ++c) { const int col = (c * 64 + lane) * 8;
                const f32x4 x0 = *(const f32x4*)(a.in[0] + (size_t)t * D + col), x1 = *(const f32x4*)(a.in[0] + (size_t)t * D + col + 4);
                const f32x4 h0 = *(const LAS f32x4*)(msh + col), h1 = *(const LAS f32x4*)(msh + col + 4), s0 = *(const LAS f32x4*)(msh + 2048 + col), s1 = *(const LAS f32x4*)(msh + 2048 + col + 4);
                v4u o; o.x = pk2(x0.x * (1.f + s0.x) + h0.x, x0.y * (1.f + s0.y) + h0.y); o.y = pk2(x0.z * (1.f + s0.z) + h0.z, x0.w * (1.f + s0.w) + h0.w);
                o.z = pk2(x1.x * (1.f + s1.x) + h1.x, x1.y * (1.f + s1.y) + h1.y); o.w = pk2(x1.z * (1.f + s1.z) + h1.z, x1.w * (1.f + s1.w) + h1.w);
                *(v4u*)(hbuf + (size_t)t * D + col) = o; } }
        __syncthreads();
    }
}

__device__ __forceinline__ void gate_prep(const Args& a, int l, LAS unsigned char* lds, int tid, int lane, int wave, int ch) {
    const bf16* hbuf = (const bf16*)(a.ws + WS_H); const bf16* waT = (const bf16*)(a.ws + WS_WIN) + ((size_t)l * INW + NP) * D;
    bf16* Ebuf = (bf16*)(a.ws + WS_E); float* dtot = (float*)(a.ws + WS_DTOT);
    const int t0 = ch * 64, l15 = lane & 15, lq = lane >> 4, mt = wave & 3, kh = wave >> 2;
    f32x4 acc = (f32x4){0.f, 0.f, 0.f, 0.f};
    const bf16* hA = hbuf + (size_t)(t0 + 16 * mt + l15) * D + kh * 1024 + 8 * lq;
    const bf16* wB = waT + (size_t)l15 * D + kh * 1024 + 8 * lq;
#pragma unroll 8
    for (int ks = 0; ks < 32; ++ks) { const bf16x8 av = *(const bf16x8*)(hA + 32 * ks), bv = *(const bf16x8*)(wB + 32 * ks); acc = __builtin_amdgcn_mfma_f32_16x16x32_bf16(av, bv, acc, 0, 0, 0); }
    LAS float* alr = (LAS float*)lds;
#pragma unroll
    for (int r = 0; r < 4; ++r) alr[(kh * 64 + 16 * mt + 4 * lq + r) * 16 + l15] = acc[r];
    __syncthreads();
    const int col = tid;
    float wg[16];
#pragma unroll
    for (int r = 0; r < 16; ++r) wg[r] = a.in[5][((size_t)l * RANK + r) * GKW + col];
    const float bgc = a.in[6][l * GKW + col];
    float tot = 0.f;
    for (int j = 0; j < 64; ++j) { float lg = bgc;
#pragma unroll
        for (int r4 = 0; r4 < 4; ++r4) { const f32x4 p = *(const LAS f32x4*)(alr + j * 16 + r4 * 4), q = *(const LAS f32x4*)(alr + (64 + j) * 16 + r4 * 4);
            lg += (p.x + q.x) * wg[r4 * 4] + (p.y + q.y) * wg[r4 * 4 + 1] + (p.z + q.z) * wg[r4 * 4 + 2] + (p.w + q.w) * wg[r4 * 4 + 3]; }
        tot += logsigmoid_f(lg) * (1.0f / 16.0f); }
    float run = 0.f;
    for (int j = 0; j < 64; ++j) { float lg = bgc;
#pragma unroll
        for (int r4 = 0; r4 < 4; ++r4) { const f32x4 p = *(const LAS f32x4*)(alr + j * 16 + r4 * 4), q = *(const LAS f32x4*)(alr + (64 + j) * 16 + r4 * 4);
            lg += (p.x + q.x) * wg[r4 * 4] + (p.y + q.y) * wg[r4 * 4 + 1] + (p.z + q.z) * wg[r4 * 4 + 2] + (p.w + q.w) * wg[r4 * 4 + 3]; }
        run += logsigmoid_f(lg) * (1.0f / 16.0f);
        Ebuf[(size_t)(t0 + j) * GKW + col] = (bf16)(pk2(__expf(tot - run), 0.f) & 0xffffu); }
    dtot[(size_t)ch * GKW + col] = __expf(tot);
    __syncthreads();
}

__device__ __forceinline__ void gla_unit(const Args& a, LAS unsigned char* lds, int tid, int lane, int wave, int un) {
    const bf16* proj = (const bf16*)(a.ws + WS_PROJ); const bf16* Ebuf = (const bf16*)(a.ws + WS_E); const float* dtot = (const float*)(a.ws + WS_DTOT); bf16* ogla = (bf16*)(a.ws + WS_OGLA);
    const int pair_ = (un & 7) * 4 + (un >> 6), dvs = (un >> 3) & 7, hh = pair_ & 3, b = pair_ >> 2;
    LAS bf16* kdT = (LAS bf16*)lds;
    LAS bf16* vT = (LAS bf16*)(lds + 18432);
    LAS bf16* ST = (LAS bf16*)(lds + 18432 + 4608);
    const int l15 = lane & 15, lq = lane >> 4, jl = tid >> 3, c0 = tid & 7, dv4 = (tid & 7) * 4, jt = (wave & 3) * 16, dvt = (wave >> 2) * 16;
#define GLA_BAR() do { asm volatile("s_waitcnt lgkmcnt(0)" ::: "memory"); __builtin_amdgcn_s_barrier(); asm volatile("" ::: "memory"); } while (0)
    f32x4 S0 = (f32x4){0.f, 0.f, 0.f, 0.f}, S1 = (f32x4){0.f, 0.f, 0.f, 0.f};
    v4u kn0[2], kn1[2], en0[2], en1[2]; v2u vn0, vn1; bf16x8 qn0[4], qn1[4], qc[4]; f32x4 dn0, dn1, dc;
#define GLA_LOAD(c, kn, en, vn, qn, dn) do { const int t0c = b * SEQ + (c) * 64; const bf16* pr = proj + (size_t)(t0c + jl) * NP; \
          \
        kn[0] = *(const v4u*)(pr + PK + hh * 128 + 8 * c0); kn[1] = *(const v4u*)(pr + PK + hh * 128 + 64 + 8 * c0); \
        en[0] = *(const v4u*)(Ebuf + (size_t)(t0c + jl) * GKW + hh * 128 + 8 * c0); en[1] = *(const v4u*)(Ebuf + (size_t)(t0c + jl) * GKW + hh * 128 + 64 + 8 * c0); \
        vn = *(const v2u*)(pr + PV + hh * 256 + dvs * 32 + dv4); \
        _Pragma("unroll") for (int ks_ = 0; ks_ < 4; ++ks_) qn[ks_] = *(const bf16x8*)(proj + (size_t)(t0c + jt + l15) * NP + PQ + hh * 128 + 32 * ks_ + 8 * lq); \
        dn = *(const f32x4*)(dtot + (size_t)(b * NCH + (c)) * GKW + hh * 128 + 16 * wave + 4 * lq); } while (0)
#define GLA_PREP(kn, en, vn, qn, dn) do { \
        _Pragma("unroll") for (int h_ = 0; h_ < 2; ++h_) _Pragma("unroll") for (int i_ = 0; i_ < 8; ++i_) { const unsigned w_ = kn[h_][i_ >> 1], e_ = en[h_][i_ >> 1]; \
            const float kf_ = (i_ & 1) ? bfhi(w_) : bflo(w_), ef_ = (i_ & 1) ? bfhi(e_) : bflo(e_); \
            kdT[(64 * h_ + 8 * c0 + i_) * 72 + ((((jl >> 3) ^ c0) & 7) << 3) + (jl & 7)] = (bf16)(pk2(kf_ * ef_, 0.f) & 0xffffu); }     \
        _Pragma("unroll") for (int i_ = 0; i_ < 4; ++i_) { const unsigned w_ = vn[i_ >> 1]; vT[(dv4 + i_) * 72 + jl] = (bf16)((i_ & 1) ? (w_ >> 16) : (w_ & 0xffffu)); } \
        _Pragma("unroll") for (int ks_ = 0; ks_ < 4; ++ks_) qc[ks_] = qn[ks_]; \
        dc = dn; } while (0)
#define GLA_BODY(c) do { \
        S0 = S0 * dc; S1 = S1 * dc; \
        _Pragma("unroll") for (int ks = 0; ks < 2; ++ks) { \
            const bf16x8 A_ = *(const LAS bf16x8*)(kdT + (16 * wave + l15) * 72 + ((((4 * ks + lq) ^ (2 * wave + (l15 >> 3))) & 7) << 3)); \
            const bf16x8 B0_ = *(const LAS bf16x8*)(vT + l15 * 72 + 32 * ks + 8 * lq), B1_ = *(const LAS bf16x8*)(vT + (16 + l15) * 72 + 32 * ks + 8 * lq); \
            S0 = __builtin_amdgcn_mfma_f32_16x16x32_bf16(A_, B0_, S0, 0, 0, 0); S1 = __builtin_amdgcn_mfma_f32_16x16x32_bf16(A_, B1_, S1, 0, 0, 0); } \
        { v2u w0_, w1_; w0_.x = pk2(S0.x, S0.y); w0_.y = pk2(S0.z, S0.w); w1_.x = pk2(S1.x, S1.y); w1_.y = pk2(S1.z, S1.w); \
          *(LAS v2u*)(ST + l15 * 136 + 16 * wave + 4 * lq) = w0_; *(LAS v2u*)(ST + (16 + l15) * 136 + 16 * wave + 4 * lq) = w1_; } \
        GLA_BAR(); \
        f32x4 O_ = (f32x4){0.f, 0.f, 0.f, 0.f}; \
        _Pragma("unroll") for (int ks = 0; ks < 4; ++ks) { const bf16x8 A_ = *(const LAS bf16x8*)(ST + (dvt + l15) * 136 + 32 * ks + 8 * lq); O_ = __builtin_amdgcn_mfma_f32_16x16x32_bf16(A_, qc[ks], O_, 0, 0, 0); } \
        { const f32x4 Os_ = O_ * 0.08838834764831845f; v2u ob_; ob_.x = pk2(Os_.x, Os_.y); ob_.y = pk2(Os_.z, Os_.w); \
          *(v2u*)(ogla + (size_t)(b * SEQ + (c) * 64 + jt + l15) * 1024 + hh * 256 + dvs * 32 + dvt + 4 * lq) = ob_; } } while (0)
    GLA_LOAD(0, kn0, en0, vn0, qn0, dn0); GLA_LOAD(1, kn1, en1, vn1, qn1, dn1);
    GLA_PREP(kn0, en0, vn0, qn0, dn0);
    GLA_BAR();
    for (int c = 0; c < NCH; c += 2) {
        { const int cn_ = c + 2 < NCH ? c + 2 : NCH - 1; GLA_LOAD(cn_, kn0, en0, vn0, qn0, dn0); }
        GLA_BODY(c);
        GLA_PREP(kn1, en1, vn1, qn1, dn1);
        GLA_BAR();
        { const int cn_ = c + 3 < NCH ? c + 3 : NCH - 1; GLA_LOAD(cn_, kn1, en1, vn1, qn1, dn1); }
        GLA_BODY(c + 1);
        GLA_PREP(kn0, en0, vn0, qn0, dn0);
        GLA_BAR();
    }
#undef GLA_BODY
#undef GLA_BAR
#undef GLA_LOAD
#undef GLA_PREP
}

__device__ __forceinline__ void unpack16(const v4u& p0, const v4u& p1, float (&o)[16]) {
#pragma unroll
    for (int j = 0; j < 4; ++j) { o[2 * j] = bflo(p0[j]); o[2 * j + 1] = bfhi(p0[j]); o[8 + 2 * j] = bflo(p1[j]); o[8 + 2 * j + 1] = bfhi(p1[j]); }
}
__device__ __forceinline__ void mixpost_chunk(const Args& a, int l, int lane, int wave, int ch) {
    const bf16* proj = (const bf16*)(a.ws + WS_PROJ); const bf16* ogla = (const bf16*)(a.ws + WS_OGLA); bf16* ybuf = (bf16*)(a.ws + WS_Y);
    const int c0 = 16 * lane, tfirst = ch * 64 + wave * 8, sfirst = tfirst % SEQ;
    float gn[16], cw0[16], cw1[16], cw2[16], cn[16], u1[16], u2[16];
#pragma unroll
    for (int i = 0; i < 16; ++i) { gn[i] = a.in[7][l * 256 + ((c0 + i) & 255)]; cw0[i] = a.in[8][(size_t)l * 3072 + c0 + i]; cw1[i] = a.in[8][(size_t)l * 3072 + 1024 + c0 + i];
        cw2[i] = a.in[8][(size_t)l * 3072 + 2048 + c0 + i]; cn[i] = a.in[9][l * 1024 + c0 + i]; u1[i] = 0.f; u2[i] = 0.f; }
    if (sfirst >= 2) {
        float cc[16], chh[16];
        { const bf16* pr = proj + (size_t)(tfirst - 2) * NP; unpack16(*(const v4u*)(pr + PCC + c0), *(const v4u*)(pr + PCC + c0 + 8), cc); unpack16(*(const v4u*)(pr + PCH + c0), *(const v4u*)(pr + PCH + c0 + 8), chh); }
#pragma unroll
        for (int i = 0; i < 16; ++i) u2[i] = cc[i] * chh[i];
        { const bf16* pr = proj + (size_t)(tfirst - 1) * NP; unpack16(*(const v4u*)(pr + PCC + c0), *(const v4u*)(pr + PCC + c0 + 8), cc); unpack16(*(const v4u*)(pr + PCH + c0), *(const v4u*)(pr + PCH + c0 + 8), chh); }
#pragma unroll
        for (int i = 0; i < 16; ++i) u1[i] = cc[i] * chh[i];
    }
#pragma unroll 2
    for (int it = 0; it < 8; ++it) { const int t = tfirst + it; const bf16* pr = proj + (size_t)t * NP;
        float o[16], r[16], cb[16], cc[16], chh[16];
        unpack16(*(const v4u*)(ogla + (size_t)t * 1024 + c0), *(const v4u*)(ogla + (size_t)t * 1024 + c0 + 8), o);
        unpack16(*(const v4u*)(pr + PR + c0), *(const v4u*)(pr + PR + c0 + 8), r);
        unpack16(*(const v4u*)(pr + PCB + c0), *(const v4u*)(pr + PCB + c0 + 8), cb);
        unpack16(*(const v4u*)(pr + PCC + c0), *(const v4u*)(pr + PCC + c0 + 8), cc);
        unpack16(*(const v4u*)(pr + PCH + c0), *(const v4u*)(pr + PCH + c0 + 8), chh);
        float ss = 0.f;
#pragma unroll
        for (int i = 0; i < 16; ++i) ss += o[i] * o[i];
        ss += __shfl_xor(ss, 1); ss += __shfl_xor(ss, 2); ss += __shfl_xor(ss, 4); ss += __shfl_xor(ss, 8);
        const float rg = rsqrtf(ss * (1.0f / 256.f) + EPS);
        float val[16]; float s2 = 0.f;
#pragma unroll
        for (int i = 0; i < 16; ++i) { const float u0 = cc[i] * chh[i]; val[i] = cb[i] * (cw0[i] * u2[i] + cw1[i] * u1[i] + cw2[i] * u0); s2 += val[i] * val[i]; u2[i] = u1[i]; u1[i] = u0; }
        const float rc = rsqrtf(wave_sum(s2) * (1.0f / 1024.f) + EPS);
        v4u y0, y1, y2, y3;
#pragma unroll
        for (int j = 0; j < 4; ++j) {
            y0[j] = pk2(o[2 * j] * rg * gn[2 * j] * silu_f(r[2 * j]), o[2 * j + 1] * rg * gn[2 * j + 1] * silu_f(r[2 * j + 1]));
            y1[j] = pk2(o[8 + 2 * j] * rg * gn[8 + 2 * j] * silu_f(r[8 + 2 * j]), o[9 + 2 * j] * rg * gn[9 + 2 * j] * silu_f(r[9 + 2 * j]));
            y2[j] = pk2(val[2 * j] * rc * cn[2 * j], val[2 * j + 1] * rc * cn[2 * j + 1]);
            y3[j] = pk2(val[8 + 2 * j] * rc * cn[8 + 2 * j], val[9 + 2 * j] * rc * cn[9 + 2 * j]); }
        bf16* yr = ybuf + (size_t)t * D;
        *(v4u*)(yr + c0) = y0; *(v4u*)(yr + c0 + 8) = y1; *(v4u*)(yr + 1024 + c0) = y2; *(v4u*)(yr + 1024 + c0 + 8) = y3;
    }
}

__device__ __forceinline__ void ln1_chunk(const Args& a, int l, LAS unsigned char* lds, int lane, int wave, int ch) {
    const float* zbuf = (const float*)(a.ws + WS_Z); const float* mod = (const float*)(a.ws + WS_MOD);
    const int b = ch / NCH; const float* mb = mod + ((size_t)l * NB + b) * 6 * D;
#pragma unroll 2
    for (int it = 0; it < 8; ++it) { const int t = ch * 64 + wave * 8 + it;
        float z[32];
#pragma unroll
        for (int c = 0; c < 8; ++c) { const f32x4 v0 = *(const f32x4*)(zbuf + (size_t)t * D + (c * 64 + lane) * 4); z[c * 4] = v0.x; z[c * 4 + 1] = v0.y; z[c * 4 + 2] = v0.z; z[c * 4 + 3] = v0.w; }
        ln_tail(z, t, lane, a.in[11] + (size_t)l * D, a.in[12] + (size_t)l * D, (float*)(a.ws + WS_X1), mb + 3 * D, mb + 4 * D, (bf16*)(a.ws + WS_H2), a.ws + WS_HQ8, (float*)(a.ws + WS_HSC), lds + wave * 2304);
    }
}

template <int N> __device__ __forceinline__ void bitonic_sort_desc(float (&v)[N]) {
#pragma unroll
    for (int k = 2; k <= N; k <<= 1)
#pragma unroll
        for (int j = k >> 1; j > 0; j >>= 1)
#pragma unroll
            for (int i = 0; i < N; ++i) { const int p = i ^ j; if (p > i) { const bool desc = ((i & k) == 0); const float x = v[i], y = v[p]; const float mx = fmaxf(x, y), mn = fminf(x, y); v[i] = desc ? mx : mn; v[p] = desc ? mn : mx; } }
}
__device__ __forceinline__ void merge_top16(float (&x)[16], const float (&y)[16]) {
#pragma unroll
    for (int i = 0; i < 16; ++i) x[i] = fmaxf(x[i], y[15 - i]);
#pragma unroll
    for (int j = 8; j > 0; j >>= 1)
#pragma unroll
        for (int i = 0; i < 16; ++i) { const int p = i ^ j; if (p > i) { const float u = x[i], w = x[p]; x[i] = fmaxf(u, w); x[p] = fminf(u, w); } }
}
__device__ __forceinline__ void ce_desc(float& ka, int& pa, float& kb, int& pb) { const bool sw = kb > ka; const float k0 = sw ? kb : ka, k1 = sw ? ka : kb; const int p0 = sw ? pb : pa, p1 = sw ? pa : pb; ka = k0; pa = p0; kb = k1; pb = p1; }
__device__ __forceinline__ void bitonic_sort_desc_kp(float (&k)[16], int (&p)[16]) {
#pragma unroll
    for (int kk = 2; kk <= 16; kk <<= 1)
#pragma unroll
        for (int j = kk >> 1; j > 0; j >>= 1)
#pragma unroll
            for (int i = 0; i < 16; ++i) { const int q = i ^ j; if (q > i) { if ((i & kk) == 0) ce_desc(k[i], p[i], k[q], p[q]); else ce_desc(k[q], p[q], k[i], p[i]); } }
}
__device__ __forceinline__ void merge_top16_kp(float (&k)[16], int (&p)[16], const float (&k2)[16], const int (&p2)[16]) {
#pragma unroll
    for (int i = 0; i < 16; ++i) { const bool sw = k2[15 - i] > k[i]; k[i] = sw ? k2[15 - i] : k[i]; p[i] = sw ? p2[15 - i] : p[i]; }
#pragma unroll
    for (int j = 8; j > 0; j >>= 1)
#pragma unroll
        for (int i = 0; i < 16; ++i) { const int q = i ^ j; if (q > i) ce_desc(k[i], p[i], k[q], p[q]); }
}
__device__ constexpr int cand_i(int s) { return s < 16 ? 0 : s < 24 ? 1 : s < 29 ? 2 : s < 33 ? 3 : s < 36 ? 4 : s < 38 ? 5 : s < 40 ? 6 : s < 42 ? 7 : s < 50 ? s - 34 : -1; }
__device__ constexpr int cand_j(int s) { return s < 16 ? s : s < 24 ? s - 16 : s < 29 ? s - 24 : s < 33 ? s - 29 : s < 36 ? s - 33 : s < 38 ? s - 36 : s < 40 ? s - 38 : s < 42 ? s - 40 : s < 50 ? 0 : -1; }

__device__ __forceinline__ void peer_retrieve(const Args& a, int l, LAS unsigned char* lds, int lane, int wave, int ch) {
    const bf16* qbuf = (const bf16*)(a.ws + WS_Q); const bf16* keys = (const bf16*)(a.ws + WS_KEYS) + ((size_t)(l * 8 + wave) * 2) * 128 * 128;
    LAS int* eg_e = (LAS int*)lds; LAS float* eg_g = (LAS float*)(lds + 32768);
    const int l31 = lane & 31, l5 = lane >> 5, h = wave, t0 = ch * 64;
    for (int tt = 0; tt < 2; ++tt) {
        float sv[2][16];
#pragma unroll
        for (int p = 0; p < 2; ++p) {
            f32x16 acc[4];
#pragma unroll
            for (int nt = 0; nt < 4; ++nt)
#pragma unroll
                for (int r = 0; r < 16; ++r) acc[nt][r] = 0.f;
            const bf16* qp = qbuf + (size_t)(t0 + 32 * tt + l31) * D + h * 256 + p * 128 + 8 * l5;
            const bf16* kp = keys + (size_t)(p * 128 + l31) * 128 + 8 * l5;
#pragma unroll 2
            for (int ks = 0; ks < 8; ++ks) { const bf16x8 bq = *(const bf16x8*)(qp + 16 * ks);
#pragma unroll
                for (int nt = 0; nt < 4; ++nt) { const bf16x8 ak = *(const bf16x8*)(kp + (size_t)(32 * nt) * 128 + 16 * ks); acc[nt] = __builtin_amdgcn_mfma_f32_32x32x16_bf16(ak, bq, acc[nt], 0, 0, 0); } }
            float v[4][16];
#pragma unroll
            for (int nt = 0; nt < 4; ++nt)
#pragma unroll
                for (int r = 0; r < 16; ++r) { const unsigned idx = 32u * nt + (r & 3) + 8u * (r >> 2) + 4u * l5; v[nt][r] = __uint_as_float((__float_as_uint(acc[nt][r]) & 0xffffff80u) | idx); }
#pragma unroll
            for (int nt = 0; nt < 4; ++nt) bitonic_sort_desc<16>(v[nt]);
            merge_top16(v[0], v[1]); merge_top16(v[2], v[3]); merge_top16(v[0], v[2]);
            float o[16];
#pragma unroll
            for (int i = 0; i < 16; ++i) o[i] = __shfl_xor(v[0][i], 32);
            merge_top16(v[0], o);
#pragma unroll
            for (int i = 0; i < 16; ++i) sv[p][i] = v[0][i];
        }
        LAS unsigned char* idxb = (LAS unsigned char*)(lds + 69632) + wave * 2048 + lane * 32;
        { v4u w0, w1;
#pragma unroll
          for (int q4 = 0; q4 < 4; ++q4) {
              w0[q4] = (__float_as_uint(sv[0][4 * q4]) & 127u) | ((__float_as_uint(sv[0][4 * q4 + 1]) & 127u) << 8) | ((__float_as_uint(sv[0][4 * q4 + 2]) & 127u) << 16) | ((__float_as_uint(sv[0][4 * q4 + 3]) & 127u) << 24);
              w1[q4] = (__float_as_uint(sv[1][4 * q4]) & 127u) | ((__float_as_uint(sv[1][4 * q4 + 1]) & 127u) << 8) | ((__float_as_uint(sv[1][4 * q4 + 2]) & 127u) << 16) | ((__float_as_uint(sv[1][4 * q4 + 3]) & 127u) << 24); }
          *(LAS v4u*)(idxb) = w0; *(LAS v4u*)(idxb + 16) = w1; }
        float ck[4][16];
#pragma unroll
        for (int s = 0; s < 64; ++s) {
            if (cand_i(s) >= 0) { const unsigned b0 = __float_as_uint(sv[0][cand_i(s) < 0 ? 0 : cand_i(s)]), b1 = __float_as_uint(sv[1][cand_j(s) < 0 ? 0 : cand_j(s)]);
                const float sum = __uint_as_float(b0 & 0xffffff80u) + __uint_as_float(b1 & 0xffffff80u);
                ck[s >> 4][s & 15] = __uint_as_float((__float_as_uint(sum) & 0xffffff00u) | (unsigned)((cand_i(s) < 0 ? 0 : cand_i(s)) * 16 + (cand_j(s) < 0 ? 0 : cand_j(s)))); }
            else ck[s >> 4][s & 15] = -3.0e38f; }
        bitonic_sort_desc<16>(ck[1]); bitonic_sort_desc<16>(ck[2]);
        merge_top16(ck[0], ck[1]); merge_top16(ck[2], ck[3]); merge_top16(ck[0], ck[2]);
        LDS_WAIT(); asm volatile("" ::: "memory");
        float ex[16]; int ce[16]; float den = 0.f;
        const float cmax = __uint_as_float(__float_as_uint(ck[0][0]) & 0xffffff00u);
#pragma unroll
        for (int i = 0; i < 16; ++i) { const unsigned bits = __float_as_uint(ck[0][i]); ex[i] = __expf(__uint_as_float(bits & 0xffffff00u) - cmax); den += ex[i];
            ce[i] = (int)idxb[(bits >> 4) & 15u] * 128 + (int)idxb[16 + (bits & 15u)]; }
        const float inv = 1.0f / den;
        if (l5 == 0) {
            const int base = (32 * tt + l31) * 128 + h * 16;
#pragma unroll
            for (int i4 = 0; i4 < 4; ++i4) { *(LAS v4u*)(eg_e + base + 4 * i4) = (v4u){(unsigned)ce[4 * i4], (unsigned)ce[4 * i4 + 1], (unsigned)ce[4 * i4 + 2], (unsigned)ce[4 * i4 + 3]};
                *(LAS f32x4*)(eg_g + base + 4 * i4) = (f32x4){ex[4 * i4] * inv, ex[4 * i4 + 1] * inv, ex[4 * i4 + 2] * inv, ex[4 * i4 + 3] * inv}; }
        }
        LDS_WAIT(); asm volatile("" ::: "memory");
    }
}

typedef unsigned char uc4 __attribute__((ext_vector_type(4)));
constexpr int NSLICE = 16, SLICE_SHIFT = 10;
__device__ __forceinline__ int sdot4i(unsigned w, unsigned x, int acc) { return __builtin_amdgcn_sdot4((int)w, (int)x, acc, false); }
__device__ __forceinline__ void fma_ub4(unsigned w, float s, float& y0, float& y1, float& y2, float& y3) { const uc4 b = __builtin_bit_cast(uc4, w); y0 += s * (float)b.x; y1 += s * (float)b.y; y2 += s * (float)b.z; y3 += s * (float)b.w; }
#if TAB4
__device__ __forceinline__ void peer_tail(const Args& a, int l, int t, int lane, const bf16* Yrow, const float* mb, const float* mbn, bool last) {
    const float* x1buf = (const float*)(a.ws + WS_X1);
    float z[32];
#pragma unroll
    for (int c8 = 0; c8 < 8; ++c8) { const int col = (c8 * 64 + lane) * 4;
        const v2u yb = *(const v2u*)(Yrow + col); const f32x4 yv = (f32x4){bflo(yb.x), bfhi(yb.x), bflo(yb.y), bfhi(yb.y)};
        const f32x4 x0 = *(const f32x4*)(x1buf + (size_t)t * D + col), g0 = *(const f32x4*)(mb + 5 * D + col);
        z[c8 * 4] = ALPHA * x0.x + (1.f + g0.x) * yv.x; z[c8 * 4 + 1] = ALPHA * x0.y + (1.f + g0.y) * yv.y; z[c8 * 4 + 2] = ALPHA * x0.z + (1.f + g0.z) * yv.z; z[c8 * 4 + 3] = ALPHA * x0.w + (1.f + g0.w) * yv.w; }
    ln_tail(z, t, lane, a.in[17] + (size_t)l * D, a.in[18] + (size_t)l * D, last ? a.out : (float*)(a.ws + WS_X), mbn, mbn + D, last ? (bf16*)nullptr : (bf16*)(a.ws + WS_H), nullptr, nullptr);
}
template <class TT, int N, int M> __device__ __forceinline__ void treduce(TT (&v)[N], int lane) {
    const bool c0 = (lane & M) != 0, c1 = (lane & (2 * M)) != 0, c2 = (lane & (4 * M)) != 0;
#pragma unroll
    for (int m = 0; m < N / 2; ++m) { const TT keep = c0 ? v[2 * m + 1] : v[2 * m], send = c0 ? v[2 * m] : v[2 * m + 1]; v[m] = keep + __shfl_xor(send, M); }
#pragma unroll
    for (int m = 0; m < N / 4; ++m) { const TT keep = c1 ? v[2 * m + 1] : v[2 * m], send = c1 ? v[2 * m] : v[2 * m + 1]; v[m] = keep + __shfl_xor(send, 2 * M); }
#pragma unroll
    for (int m = 0; m < N / 8; ++m) { const TT keep = c2 ? v[2 * m + 1] : v[2 * m], send = c2 ? v[2 * m] : v[2 * m + 1]; v[m] = keep + __shfl_xor(send, 4 * M); }
}
__device__ __forceinline__ void tr4x4(unsigned a, unsigned b, unsigned c, unsigned d, unsigned& t0, unsigned& t1, unsigned& t2, unsigned& t3) {
    const unsigned x0 = __builtin_amdgcn_perm(b, a, 0x05010400u), x1 = __builtin_amdgcn_perm(b, a, 0x07030602u), y0 = __builtin_amdgcn_perm(d, c, 0x05010400u), y1 = __builtin_amdgcn_perm(d, c, 0x07030602u);
    t0 = __builtin_amdgcn_perm(y0, x0, 0x05040100u); t1 = __builtin_amdgcn_perm(y0, x0, 0x07060302u); t2 = __builtin_amdgcn_perm(y1, x1, 0x05040100u); t3 = __builtin_amdgcn_perm(y1, x1, 0x07060302u);
}
__device__ __forceinline__ int sdot8i(unsigned w, unsigned x, int acc) { return __builtin_amdgcn_sdot8((int)w, (int)x, acc, false); }
__device__ __forceinline__ float slot_scale(unsigned w3) { return __builtin_amdgcn_exp2f((float)(w3 >> 24) * 0.125f - 16.0f); }
__device__ __forceinline__ void peer_experts(const Args& a, int l, LAS unsigned char* lds, int lane0, int wave, int ch) {
    const float* mod = (const float*)(a.ws + WS_MOD);
    const unsigned char* ut = a.ws + WS_UT + (size_t)l * NE * 1152; const unsigned char* vt = a.ws + WS_VT + (size_t)l * NE * 1152; const unsigned char* hq8 = a.ws + WS_HQ8;
    const float* hsc = (const float*)(a.ws + WS_HSC);
    bf16* Ybuf = (bf16*)(a.ws + WS_Z);
    const LAS int* eg_e = (const LAS int*)lds; LAS float* sw = (LAS float*)(lds + 32768);
    LAS float* apart = (LAS float*)(lds + 65536);
    const int b = ch / NCH; const bool last = (l == NL - 1);
    const float* mb = mod + ((size_t)l * NB + b) * 6 * D; const float* mbn = mod + ((size_t)(last ? l : l + 1) * NB + b) * 6 * D;
    const int tlw = wave * 8;
    { const int lane = lane0;
#pragma unroll
      for (int i = 0; i < 16; ++i) apart[tlw * 128 + i * 64 + lane] = 0.f; }
    LDS_WAIT(); asm volatile("" ::: "memory");
    {
        int laneL = lane0; asm volatile("" : "+v"(laneL)); const int lane = laneL;
        const int g = lane >> 3, l7 = lane & 7;
        v4u bufA[16], bufB[16], hA0, hA1, hB0, hB1;
#define CU_LOAD(buf, h0_, h1_, idx_) do { const int u_ = (idx_) >> 3, tl_ = tlw + ((idx_) & 7); const unsigned soff_ = (unsigned)(u_ * 128 + l7 * 16); \
            const unsigned char* hp_ = hq8 + (size_t)(ch * 64 + tl_) * 2304 + (u_ * 8 + l7) * 32; h0_ = *(const v4u*)hp_; h1_ = *(const v4u*)(hp_ + 16); \
            _Pragma("unroll") for (int i_ = 0; i_ < 16; ++i_) { const unsigned e_ = (unsigned)eg_e[tl_ * 128 + 8 * i_ + g]; buf[i_] = *(const v4u*)(ut + (size_t)(e_ * 1152u + soff_)); } } while (0)
#define CU_COMP(buf, h0_, h1_, idx_) do { const int tl_ = tlw + ((idx_) & 7); float accv_[16]; \
            _Pragma("unroll") for (int i_ = 0; i_ < 16; ++i_) { int sl_ = 0, sh_ = 0; \
                _Pragma("unroll") for (int d_ = 0; d_ < 4; ++d_) { const unsigned x_ = buf[i_][d_] ^ 0x88888888u; sl_ = sdot8i(x_, h0_[d_], sl_); sh_ = sdot8i(x_, h1_[d_], sh_); } \
                accv_[i_] = slot_scale(buf[i_][3]) * (float)(16 * sh_ + sl_); } \
            treduce<float, 16, 1>(accv_, lane); \
            apart[tl_ * 128 + 8 * l7 + g] += accv_[0]; apart[tl_ * 128 + 8 * (8 + l7) + g] += accv_[1]; } while (0)
        CU_LOAD(bufA, hA0, hA1, 0);
        for (int idx = 0; idx < 72; idx += 2) {
            CU_LOAD(bufB, hB0, hB1, idx + 1);
            CU_COMP(bufA, hA0, hA1, idx);
            { const int nx_ = idx + 2 < 72 ? idx + 2 : 71; CU_LOAD(bufA, hA0, hA1, nx_); }
            CU_COMP(bufB, hB0, hB1, idx + 1);
        }
#undef CU_LOAD
#undef CU_COMP
        LDS_WAIT(); asm volatile("" ::: "memory");
        for (int it = 0; it < 8; ++it) { const int tl = tlw + it; const float shs = hsc[ch * 64 + tl];
            const float w0 = sw[tl * 128 + lane] * gelu_tanh_f(apart[tl * 128 + lane] * shs), w1 = sw[tl * 128 + 64 + lane] * gelu_tanh_f(apart[tl * 128 + 64 + lane] * shs);
            sw[tl * 128 + lane] = w0; sw[tl * 128 + 64 + lane] = w1; }
        LDS_WAIT(); asm volatile("" ::: "memory");
    }
    {
        int laneL = lane0; asm volatile("" : "+v"(laneL)); const int lane = laneL;
        const int g = lane >> 3, l7 = lane & 7;
        v4u bufA[16], bufB[16];
#define CV_LOAD(buf, idx_) do { const int u_ = (idx_) >> 3, tl_ = tlw + ((idx_) & 7); const unsigned soff_ = (unsigned)(u_ * 128 + l7 * 16); \
            _Pragma("unroll") for (int i_ = 0; i_ < 16; ++i_) { const unsigned e_ = (unsigned)eg_e[tl_ * 128 + 8 * i_ + g]; buf[i_] = *(const v4u*)(vt + (size_t)(e_ * 1152u + soff_)); } } while (0)
#define CV_COMP(buf, idx_) do { const int u_ = (idx_) >> 3, tl_ = tlw + ((idx_) & 7); \
            float wf_[16]; float wmx_ = 0.f; \
            _Pragma("unroll") for (int i_ = 0; i_ < 16; ++i_) { wf_[i_] = sw[tl_ * 128 + 8 * i_ + g] * slot_scale(buf[i_][3]); wmx_ = fmaxf(wmx_, fabsf(wf_[i_])); } \
            wmx_ = fmaxf(wmx_, __shfl_xor(wmx_, 8)); wmx_ = fmaxf(wmx_, __shfl_xor(wmx_, 16)); wmx_ = fmaxf(wmx_, __shfl_xor(wmx_, 32));     \
            const float winv_ = wmx_ > 0.f ? 127.0f / wmx_ : 0.f, wsc_ = wmx_ * (1.0f / 127.0f); \
              \
            unsigned wq4_[4]; int wsum_ = 0; \
            _Pragma("unroll") for (int gp_ = 0; gp_ < 4; ++gp_) { \
                const unsigned m0_ = __float_as_uint(wf_[4 * gp_] * winv_ + 12582912.0f), m1_ = __float_as_uint(wf_[4 * gp_ + 1] * winv_ + 12582912.0f), m2_ = __float_as_uint(wf_[4 * gp_ + 2] * winv_ + 12582912.0f), m3_ = __float_as_uint(wf_[4 * gp_ + 3] * winv_ + 12582912.0f); \
                wq4_[gp_] = __builtin_amdgcn_perm(__builtin_amdgcn_perm(m3_, m2_, 0x0c0c0400u), __builtin_amdgcn_perm(m1_, m0_, 0x0c0c0400u), 0x05040100u); \
                wsum_ = sdot4i(wq4_[gp_], 0x01010101u, wsum_); } \
            int yi_[32]; \
            _Pragma("unroll") for (int q_ = 0; q_ < 32; ++q_) yi_[q_] = 0; \
            _Pragma("unroll") for (int gp_ = 0; gp_ < 4; ++gp_) { \
                _Pragma("unroll") for (int d_ = 0; d_ < 4; ++d_) { const unsigned A_ = buf[4 * gp_][d_], B_ = buf[4 * gp_ + 1][d_], C_ = buf[4 * gp_ + 2][d_], D_ = buf[4 * gp_ + 3][d_]; \
                    unsigned t0_, t1_, t2_, t3_; \
                    tr4x4(A_, B_, C_, D_, t0_, t1_, t2_, t3_);     \
                    yi_[8 * d_]     = sdot4i(t0_ & 0x0f0f0f0fu, wq4_[gp_], yi_[8 * d_]);     yi_[8 * d_ + 1] = sdot4i((t0_ >> 4) & 0x0f0f0f0fu, wq4_[gp_], yi_[8 * d_ + 1]); \
                    yi_[8 * d_ + 2] = sdot4i(t1_ & 0x0f0f0f0fu, wq4_[gp_], yi_[8 * d_ + 2]); yi_[8 * d_ + 3] = sdot4i((t1_ >> 4) & 0x0f0f0f0fu, wq4_[gp_], yi_[8 * d_ + 3]); \
                    yi_[8 * d_ + 4] = sdot4i(t2_ & 0x0f0f0f0fu, wq4_[gp_], yi_[8 * d_ + 4]); yi_[8 * d_ + 5] = sdot4i((t2_ >> 4) & 0x0f0f0f0fu, wq4_[gp_], yi_[8 * d_ + 5]); \
                    yi_[8 * d_ + 6] = sdot4i(t3_ & 0x0f0f0f0fu, wq4_[gp_], yi_[8 * d_ + 6]); yi_[8 * d_ + 7] = sdot4i((t3_ >> 4) & 0x0f0f0f0fu, wq4_[gp_], yi_[8 * d_ + 7]); } } \
            treduce<int, 32, 8>(yi_, lane); \
            wsum_ += __shfl_xor(wsum_, 8); wsum_ += __shfl_xor(wsum_, 16); wsum_ += __shfl_xor(wsum_, 32);     \
            float y_[4]; \
            _Pragma("unroll") for (int q_ = 0; q_ < 4; ++q_) y_[q_] = wsc_ * (float)(yi_[q_] - 8 * wsum_); \
            { const int colb_ = u_ * 240 + l7 * 30 + g; bf16* yr_ = Ybuf + (size_t)(ch * 64 + tl_) * D + colb_; \
              _Pragma("unroll") for (int m_ = 0; m_ < 4; ++m_) if (8 * m_ + g < 30 && colb_ + 8 * m_ < D) yr_[8 * m_] = (bf16)(pk2(y_[m_], 0.f) & 0xffffu); } } while (0)
        CV_LOAD(bufA, 0);
        for (int idx = 0; idx < 72; idx += 2) {
            CV_LOAD(bufB, idx + 1);
            CV_COMP(bufA, idx);
            { const int nx_ = idx + 2 < 72 ? idx + 2 : 71; CV_LOAD(bufA, nx_); }
            CV_COMP(bufB, idx + 1);
        }
#undef CV_LOAD
#undef CV_COMP
    }
    asm volatile("s_waitcnt vmcnt(0)" ::: "memory");
    __builtin_amdgcn_fence(__ATOMIC_ACQUIRE, "agent");
    asm volatile("s_waitcnt vmcnt(0)" ::: "memory");
    for (int it = 0; it < 8; ++it) { int laneT = lane0; asm volatile("" : "+v"(laneT)); const int t = ch * 64 + tlw + it;
        peer_tail(a, l, t, laneT, Ybuf + (size_t)t * D, mb, mbn, last); }
}
#else
__device__ __forceinline__ void peer_tail(const Args& a, int l, int t, int lane, const float* Yrow, const float* mb, const float* mbn, bool last) {
    const float* x1buf = (const float*)(a.ws + WS_X1);
    float z[32];
#pragma unroll
    for (int c = 0; c < 2; ++c)
#pragma unroll
        for (int k = 0; k < 4; ++k) { const int c8 = 4 * c + k, col = (c8 * 64 + lane) * 4;
            const v2u yb = *(const v2u*)((const bf16*)Yrow + (c * 64 + lane) * 16 + 4 * k); const f32x4 yv = (f32x4){bflo(yb.x), bfhi(yb.x), bflo(yb.y), bfhi(yb.y)};
            const f32x4 x0 = *(const f32x4*)(x1buf + (size_t)t * D + col), g0 = *(const f32x4*)(mb + 5 * D + col);
            z[c8 * 4] = ALPHA * x0.x + (1.f + g0.x) * yv.x; z[c8 * 4 + 1] = ALPHA * x0.y + (1.f + g0.y) * yv.y; z[c8 * 4 + 2] = ALPHA * x0.z + (1.f + g0.z) * yv.z; z[c8 * 4 + 3] = ALPHA * x0.w + (1.f + g0.w) * yv.w; }
    ln_tail(z, t, lane, a.in[17] + (size_t)l * D, a.in[18] + (size_t)l * D, last ? a.out : (float*)(a.ws + WS_X), mbn, mbn + D, last ? (bf16*)nullptr : (bf16*)(a.ws + WS_H), nullptr, nullptr);
}
template <class TT, int M> __device__ __forceinline__ void treduce16(TT (&v)[16], int lane) {
    const bool c0 = (lane & M) != 0, c1 = (lane & (2 * M)) != 0, c2 = (lane & (4 * M)) != 0;
#pragma unroll
    for (int m = 0; m < 8; ++m) { const TT keep = c0 ? v[2 * m + 1] : v[2 * m], send = c0 ? v[2 * m] : v[2 * m + 1]; v[m] = keep + __shfl_xor(send, M); }
#pragma unroll
    for (int m = 0; m < 4; ++m) { const TT keep = c1 ? v[2 * m + 1] : v[2 * m], send = c1 ? v[2 * m] : v[2 * m + 1]; v[m] = keep + __shfl_xor(send, 2 * M); }
#pragma unroll
    for (int m = 0; m < 2; ++m) { const TT keep = c2 ? v[2 * m + 1] : v[2 * m], send = c2 ? v[2 * m] : v[2 * m + 1]; v[m] = keep + __shfl_xor(send, 4 * M); }
}
__device__ __forceinline__ void peer_experts(const Args& a, int l, LAS unsigned char* lds, int lane0, int wave, int ch) {
    const float* mod = (const float*)(a.ws + WS_MOD);
    const unsigned char* ut = a.ws + WS_UT + (size_t)l * NE * D; const unsigned char* vt = a.ws + WS_VT + (size_t)l * NE * D; const unsigned char* hq8 = a.ws + WS_HQ8;
    const float* su = (const float*)(a.ws + WS_SU) + (size_t)l * NE; const float* sv = (const float*)(a.ws + WS_SV) + (size_t)l * NE; const float* hsc = (const float*)(a.ws + WS_HSC);
    float* Ybuf = (float*)(a.ws + WS_Z);
    const LAS int* eg_e = (const LAS int*)lds; LAS float* sw = (LAS float*)(lds + 32768);
    LAS int* apart = (LAS int*)(lds + 65536); LAS float* wtotl = (LAS float*)(lds + LDSCTL_OFF + 256);
    const int b = ch / NCH; const bool last = (l == NL - 1);
    const float* mb = mod + ((size_t)l * NB + b) * 6 * D; const float* mbn = mod + ((size_t)(last ? l : l + 1) * NB + b) * 6 * D;
    const int tlw = wave * 8;
    { const int lane = lane0;
#pragma unroll
      for (int i = 0; i < 16; ++i) apart[tlw * 128 + i * 64 + lane] = 0; }
    LDS_WAIT(); asm volatile("" ::: "memory");
    {
        int laneL = lane0; asm volatile("" : "+v"(laneL)); const int lane = laneL;
        const int g = lane >> 3, l7 = lane & 7;
        v4u bufA[16], bufB[16], hA, hB;
#define CU_LOAD(buf, hh_, idx_) do { const int cs_ = (idx_) >> 3, tl_ = tlw + ((idx_) & 7); const unsigned coff_ = (unsigned)(cs_ * 128 + l7 * 16); \
            hh_ = *(const v4u*)(hq8 + (size_t)(ch * 64 + tl_) * D + coff_); \
            _Pragma("unroll") for (int i_ = 0; i_ < 16; ++i_) { const unsigned e_ = (unsigned)eg_e[tl_ * 128 + 8 * i_ + g]; buf[i_] = *(const v4u*)(ut + (size_t)(e_ * 2048u + coff_)); } } while (0)
#define CU_COMP(buf, hh_, idx_) do { const int tl_ = tlw + ((idx_) & 7); int acc_[16]; \
            _Pragma("unroll") for (int i_ = 0; i_ < 16; ++i_) { int s_ = 0; _Pragma("unroll") for (int q_ = 0; q_ < 4; ++q_) s_ = sdot4i(buf[i_][q_], hh_[q_], s_); acc_[i_] = s_; } \
            treduce16<int, 1>(acc_, lane); \
            apart[tl_ * 128 + 8 * l7 + g] += acc_[0]; apart[tl_ * 128 + 8 * (8 + l7) + g] += acc_[1]; } while (0)
        CU_LOAD(bufA, hA, 0);
        for (int idx = 0; idx < 128; idx += 2) {
            CU_LOAD(bufB, hB, idx + 1);
            CU_COMP(bufA, hA, idx);
            if (idx + 2 < 128) CU_LOAD(bufA, hA, idx + 2);
            CU_COMP(bufB, hB, idx + 1);
        }
#undef CU_LOAD
#undef CU_COMP
        LDS_WAIT(); asm volatile("" ::: "memory");
        for (int it = 0; it < 8; ++it) { const int tl = tlw + it; const float shs = hsc[ch * 64 + tl];
            const int e0 = eg_e[tl * 128 + lane], e1 = eg_e[tl * 128 + 64 + lane];
            const float w0 = sw[tl * 128 + lane] * gelu_tanh_f((float)apart[tl * 128 + lane] * su[e0] * shs) * sv[e0];
            const float w1 = sw[tl * 128 + 64 + lane] * gelu_tanh_f((float)apart[tl * 128 + 64 + lane] * su[e1] * shs) * sv[e1];
            sw[tl * 128 + lane] = w0; sw[tl * 128 + 64 + lane] = w1;
            const float ws = wave_sum(w0 + w1);
            if (lane == 0) wtotl[tl] = ws; }
        LDS_WAIT(); asm volatile("" ::: "memory");
    }
    {
        int laneL = lane0; asm volatile("" : "+v"(laneL)); const int lane = laneL;
        const int g = lane >> 3, l7 = lane & 7;
        v4u bufA[16], bufB[16];
#define CV_LOAD(buf, idx_) do { const int cs_ = (idx_) >> 3, tl_ = tlw + ((idx_) & 7); const unsigned coff_ = (unsigned)(cs_ * 128 + l7 * 16); \
            _Pragma("unroll") for (int i_ = 0; i_ < 16; ++i_) { const unsigned e_ = (unsigned)eg_e[tl_ * 128 + 8 * i_ + g]; buf[i_] = *(const v4u*)(vt + (size_t)(e_ * 2048u + coff_)); } } while (0)
#define CV_COMP(buf, idx_) do { const int cs_ = (idx_) >> 3, tl_ = tlw + ((idx_) & 7); float y_[16]; \
            _Pragma("unroll") for (int q_ = 0; q_ < 16; ++q_) y_[q_] = 0.f; \
            _Pragma("unroll") for (int i_ = 0; i_ < 16; ++i_) { const float wr_ = sw[tl_ * 128 + 8 * i_ + g]; \
                _Pragma("unroll") for (int q_ = 0; q_ < 4; ++q_) fma_ub4(buf[i_][q_], wr_, y_[4 * q_], y_[4 * q_ + 1], y_[4 * q_ + 2], y_[4 * q_ + 3]); } \
            treduce16<float, 8>(y_, lane); \
            const float woff_ = 128.0f * wtotl[tl_]; bf16* yr_ = (bf16*)Ybuf + (size_t)(ch * 64 + tl_) * D + cs_ * 128 + l7 * 16 + g; \
            yr_[0] = (bf16)(pk2(y_[0] - woff_, 0.f) & 0xffffu); yr_[8] = (bf16)(pk2(y_[1] - woff_, 0.f) & 0xffffu); } while (0)
        CV_LOAD(bufA, 0);
        for (int idx = 0; idx < 128; idx += 2) {
            CV_LOAD(bufB, idx + 1);
            CV_COMP(bufA, idx);
            if (idx + 2 < 128) CV_LOAD(bufA, idx + 2);
            CV_COMP(bufB, idx + 1);
        }
#undef CV_LOAD
#undef CV_COMP
    }
    asm volatile("s_waitcnt vmcnt(0)" ::: "memory");
    __builtin_amdgcn_fence(__ATOMIC_ACQUIRE, "agent");
    asm volatile("s_waitcnt vmcnt(0)" ::: "memory");
    for (int it = 0; it < 8; ++it) { int laneT = lane0; asm volatile("" : "+v"(laneT)); const int t = ch * 64 + tlw + it;
        peer_tail(a, l, t, laneT, (const float*)((const bf16*)Ybuf + (size_t)t * D), mb, mbn, last); }
}

#endif

#ifndef MK_PER_PHASE
#define MK_PER_PHASE 0
#endif
__global__ void __launch_bounds__(NTHREADS, 2) mk_fwd(Args a) {
    extern __shared__ __attribute__((aligned(16))) unsigned char lds_raw[];
    LAS unsigned char* lds = (LAS unsigned char*)lds_raw;
    const int tid = threadIdx.x, lane = tid & 63, wave = __builtin_amdgcn_readfirstlane(tid >> 6), G = gridDim.x, bx = blockIdx.x;
    if (tid < 64) ((LAS unsigned*)(lds + LDSCTL_OFF))[tid] = 0u;
    __syncthreads();
    unsigned* ctl = (unsigned*)(a.ws + WS_CTL);
    XcdBarrier bar; bar.bar = ctl + CW_BAR; bar.x = 0; bar.st = nullptr;
    const bool use_bar = (a.ph_hi - a.ph_lo) > 1;
    if (use_bar) bar = xcd_barrier_post(ctl + CW_BAR, (volatile LAS unsigned*)(lds + LDSCTL_OFF));
    const int lo = a.ph_lo, hi = a.ph_hi;
#ifndef PH_MASK
#define PH_MASK 0x1ff
#endif
#define IN(k) (lo <= (k) && (k) < hi)
#define EN(b) ((PH_MASK >> (b)) & 1)
#ifndef REP_MASK
#define REP_MASK 0
#endif
#ifndef REP_EXTRA
#define REP_EXTRA 2
#endif
#define REPS(b) (1 + ((REP_MASK >> (b)) & 1) * REP_EXTRA)
#define REP_BEGIN(b) for (int rep_ = 0; rep_ < REPS(b); ++rep_) {
#define REP_END(b) if (rep_ + 1 < REPS(b)) xcd_barrier(bar); }
#define SEAM(k) do { if (IN((k) + 1)) xcd_barrier(bar); } while (0)
#define PHASE_IDS() int tidp = tid; asm volatile("" : "+v"(tidp)); const int lanep = tidp & 63, wavep = __builtin_amdgcn_readfirstlane(tidp >> 6); (void)lanep; (void)wavep
    if (EN(0) && IN(0)) { REP_BEGIN(0) PHASE_IDS(); ph_prologue_a(a, lds, tidp, lanep, wavep, bx, G); REP_END(0) SEAM(0); }
    if (EN(1) && IN(1)) { REP_BEGIN(1) PHASE_IDS(); ph_prologue_b(a, lds, tidp, lanep, wavep, bx, G); REP_END(1) SEAM(1); }
    for (int l = 0; l < NL; ++l) {
        const int pb = 2 + 7 * l;
        const float* mod = (const float*)(a.ws + WS_MOD);
        if (EN(2) && IN(pb + 0)) {
            REP_BEGIN(2) PHASE_IDS();
            pg8::Gemm g{(const pg8::bf16_t*)(a.ws + WS_H), (const pg8::bf16_t*)(a.ws + WS_WIN) + (size_t)l * INW * D, T, NP, D}; pg8::StaticOrder S; S.init(T, NP, G, bx);
            pg8::EpiBf16P E{(pg8::bf16_t*)(a.ws + WS_PROJ), NP};
            pg8::gemm_phase<pg8::EpiBf16P, pg8::StaticOrder, true, true>(lds + RING_OFF, g, S, E, tidp);
            for (int ch = bx; ch < NCHUNK; ch += G) gate_prep(a, l, lds, tidp, lanep, wavep, ch);
            REP_END(2) SEAM(pb + 0);
        }
        if (EN(3) && IN(pb + 1)) { REP_BEGIN(3) PHASE_IDS(); for (int un = bx; un < 256; un += G) gla_unit(a, lds, tidp, lanep, wavep, un); REP_END(3) SEAM(pb + 1); }
        if (EN(4) && IN(pb + 2)) { REP_BEGIN(4) PHASE_IDS(); for (int ch = bx; ch < NCHUNK; ch += G) mixpost_chunk(a, l, lanep, wavep, ch); REP_END(4) SEAM(pb + 2); }
        if (EN(5) && IN(pb + 3)) {
            REP_BEGIN(5) PHASE_IDS();
            pg8::Gemm g{(const pg8::bf16_t*)(a.ws + WS_Y), (const pg8::bf16_t*)(a.ws + WS_WOUT) + (size_t)l * D * D, T, D, D}; pg8::StaticOrder S; S.init(T, D, G, bx);
            pg8::EpiResid E{(float*)(a.ws + WS_Z), l == 0 ? a.in[0] : (const float*)(a.ws + WS_X), mod + (size_t)l * NB * 6 * D + 2 * D, ALPHA};
            pg8::gemm_phase<pg8::EpiResid, pg8::StaticOrder, true, true>(lds + RING_OFF, g, S, E, tidp);
            REP_END(5) SEAM(pb + 3);
        }
        if (EN(6) && IN(pb + 4)) { REP_BEGIN(6) PHASE_IDS(); for (int ch = bx; ch < NCHUNK; ch += G) ln1_chunk(a, l, lds, lanep, wavep, ch); REP_END(6) SEAM(pb + 4); }
        if (EN(7) && IN(pb + 5)) {
            REP_BEGIN(7) PHASE_IDS();
            pg8::Gemm g{(const pg8::bf16_t*)(a.ws + WS_H2), (const pg8::bf16_t*)(a.ws + WS_WQ) + (size_t)l * D * D, T, D, D}; pg8::StaticOrder S; S.init(T, D, G, bx);
            pg8::EpiBf16P E{(pg8::bf16_t*)(a.ws + WS_Q), D};
            pg8::gemm_phase<pg8::EpiBf16P, pg8::StaticOrder, true, true>(lds + RING_OFF, g, S, E, tidp);
            REP_END(7) SEAM(pb + 5);
        }
#ifndef PEER_DBG
#define PEER_DBG 0
#endif
#ifndef PE_REP_R
#define PE_REP_R 1
#endif
#ifndef L2PROBE
#define L2PROBE 0
#endif
        if (EN(8) && IN(pb + 6)) {
            REP_BEGIN(8)
            for (int ch = bx; ch < NCHUNK; ch += G) { for (int repr_ = 0; repr_ < PE_REP_R; ++repr_) { PHASE_IDS(); peer_retrieve(a, l, lds, lanep, wavep, ch); __syncthreads(); } __syncthreads(); { PHASE_IDS(); peer_experts(a, l, lds, lanep, wavep, ch); } __syncthreads(); }
            REP_END(8) SEAM(pb + 6);
        }
    }
#undef IN
#undef SEAM
}

extern "C" void kernel_launch(void* const* d_in, const int* in_sizes, int n_in, void* d_out, int out_size, void* d_ws, size_t ws_size, hipStream_t stream) {
    static int grid = 0;
    if (grid == 0) {
        if (n_in != 19 || in_sizes[0] != T * D || out_size != T * D || ws_size < WS_END) { fprintf(stderr, "kernel_launch: unexpected shapes / workspace (%d inputs, ws %zu); nothing launched\n", n_in, ws_size); grid = -1; return; }
        int dev = 0, cus = 0, per_cu = 0;
        if (hipGetDevice(&dev) != hipSuccess || hipDeviceGetAttribute(&cus, hipDeviceAttributeMultiprocessorCount, dev) != hipSuccess) { grid = -1; return; }
        if (hipFuncSetAttribute((const void*)mk_fwd, hipFuncAttributeMaxDynamicSharedMemorySize, LDS_BYTES) != hipSuccess) { fprintf(stderr, "kernel_launch: hipFuncSetAttribute failed\n"); grid = -1; return; }
        if (hipOccupancyMaxActiveBlocksPerMultiprocessor(&per_cu, (const void*)mk_fwd, NTHREADS, LDS_BYTES) != hipSuccess || per_cu < 1) fprintf(stderr, "kernel_launch: occupancy query reports %d\n", per_cu);
        (void)hipGetLastError();
        grid = cus;
    }
    if (grid < 0) return;
    if (hipMemsetAsync((char*)d_ws + WS_CTL, 0, CTL_ZERO_BYTES, stream) != hipSuccess) return;
    Args a{};
    for (int i = 0; i < 19; ++i) a.in[i] = (const float*)d_in[i];
    a.out = (float*)d_out; a.ws = (unsigned char*)d_ws;
#if MK_PER_PHASE
    for (int p = 0; p < NPHASES; ++p) { a.ph_lo = p; a.ph_hi = p + 1; hipLaunchKernelGGL(mk_fwd, dim3(grid), dim3(NTHREADS), LDS_BYTES, stream, a); }
#else
    a.ph_lo = 0; a.ph_hi = NPHASES;
    hipLaunchKernelGGL(mk_fwd, dim3(grid), dim3(NTHREADS), LDS_BYTES, stream, a);
#endif
}
```

```cpp
#include <hip/hip_runtime.h>
#include <cstdio>
#include <cstdint>
namespace pg8 {
#define PG8_LAS __attribute__((address_space(3)))
typedef unsigned short bf16_t;
typedef short bf16x8 __attribute__((ext_vector_type(8)));
typedef float f32x4 __attribute__((ext_vector_type(4)));
typedef unsigned u32x4 __attribute__((ext_vector_type(4)));
constexpr int BM = 256, BK = 64, HALF = 128, HTB = HALF * BK * 2  , STAGE_BYTES = 8 * HTB, NXCD = 8, WGM = 8;

__host__ __device__ __forceinline__ int lds_byte(int r, int c) { const int st = (r >> 4) * 2 + (c >> 5), rr = r & 15, cc = c & 31, ob = rr * 64 + cc * 2; return st * 1024 + (ob ^ (((ob >> 9) & 1) << 5)); }
__host__ __device__ __forceinline__ void stage_rc(int b, int& R, int& C) { const int st = b / 1024, sb = b % 1024, swz = sb ^ (((sb >> 9) & 1) << 5); R = (st >> 1) * 16 + swz / 64; C = (st & 1) * 32 + (swz % 64) / 2; }
__host__ __device__ __forceinline__ int perm32(int rho) { const int n = rho >> 4, i = rho & 15; return 8 * (i >> 2) + 4 * n + (i & 3); }

struct Unit { int pm, pn; };
struct Gemm { const bf16_t* A; const bf16_t* Bt; int M, N, K; };

struct StaticOrder {
    int nM, nN, nwg, G, c, wgm;
    __host__ __device__ void init(int M, int N, int G_, int c_, int wgm_ = WGM) { nM = M / BM; nN = N / BM; nwg = nM * nN; G = G_; c = c_; wgm = wgm_; }
    __host__ __device__ bool next(int i, Unit& u) const {
        const long L = (long)i * G + c; if (L >= nwg) return false;
        int wgid = (int)L; { const int q = nwg / NXCD, r = nwg % NXCD, xcd = wgid % NXCD, off = wgid / NXCD; wgid = (xcd < r ? xcd * (q + 1) : r * (q + 1) + (xcd - r) * q) + off; }
        const int nig = wgm * nN, gid = wgid / nig, fm = gid * wgm, gsz = (nM - fm) < wgm ? (nM - fm) : wgm;
        u.pm = fm + ((wgid % nig) % gsz); u.pn = (wgid % nig) / gsz; return true;
    }
    __device__ __forceinline__ void a_ready(const Unit&) const {}
    __device__ __forceinline__ void done(const Unit&) const {}
};
typedef __bf16 bf16x2_t __attribute__((ext_vector_type(2)));
__device__ __forceinline__ unsigned cvt_pk_bf16(float lo, float hi) { bf16x2_t r; r.x = (__bf16)lo; r.y = (__bf16)hi; return __builtin_bit_cast(unsigned, r); }
struct EpiBf16P {
    static constexpr bool PERM = true, AFTER_DRAIN = false;
    bf16_t* O; int ldc;
    __device__ __forceinline__ void operator()(const f32x4 (&acc)[2][2][4][2], const Unit& u, int wr, int wc, int fr, int fq) const {
        const int row0 = u.pm * BM + wr * 64 + fr, col0 = u.pn * BM + wc * 32 + 8 * fq;
#pragma unroll
        for (int ai = 0; ai < 2; ++ai)
#pragma unroll
            for (int m = 0; m < 4; ++m) { bf16_t* rowp = O + (size_t)(row0 + ai * HALF + m * 16) * ldc + col0;
#pragma unroll
                for (int bj = 0; bj < 2; ++bj) { const f32x4 v0 = acc[ai][bj][m][0], v1 = acc[ai][bj][m][1];
                    u32x4 w; w.x = cvt_pk_bf16(v0[0], v0[1]); w.y = cvt_pk_bf16(v0[2], v0[3]); w.z = cvt_pk_bf16(v1[0], v1[1]); w.w = cvt_pk_bf16(v1[2], v1[3]);
                    *(u32x4*)(rowp + bj * HALF) = w; } }
    }
};
struct EpiResid {
    static constexpr bool PERM = false, AFTER_DRAIN = false;
    float* Z; const float* X; const float* gate; float alpha;
    __device__ __forceinline__ void operator()(const f32x4 (&acc)[2][2][4][2], const Unit& u, int wr, int wc, int fr, int fq) const {
        const int row0 = u.pm * BM + wr * 64 + fr, col0 = u.pn * BM + wc * 32 + 4 * fq;
        const float* gb = gate + (size_t)(u.pm >> 3) * (6 * 2048) + col0;
        f32x4 gv[2][2];
#pragma unroll
        for (int bj = 0; bj < 2; ++bj)
#pragma unroll
            for (int n = 0; n < 2; ++n) gv[bj][n] = *(const f32x4*)(gb + bj * HALF + n * 16) + 1.0f;
#pragma unroll
        for (int ai = 0; ai < 2; ++ai)
#pragma unroll
            for (int m = 0; m < 4; ++m) { const size_t off = (size_t)(row0 + ai * HALF + m * 16) * 2048 + col0;
#pragma unroll
                for (int bj = 0; bj < 2; ++bj)
#pragma unroll
                    for (int n = 0; n < 2; ++n) { const f32x4 xv = *(const f32x4*)(X + off + bj * HALF + n * 16);
                        *(f32x4*)(Z + off + bj * HALF + n * 16) = xv * alpha + gv[bj][n] * acc[ai][bj][m][n]; }
                asm volatile("" ::: "memory"); }
    }
};
template <class Epi, class Sched, bool ALIGN_EPI = false, bool SP2 = false>
__device__ __forceinline__ void gemm_phase(PG8_LAS unsigned char* lds, const Gemm g, const Sched& S, const Epi& E, const int tid_in) {
    const int tid = tid_in, wid = __builtin_amdgcn_readfirstlane(tid >> 6), lane = tid & 63, wr = wid >> 2, wc = wid & 3, fr = lane & 15, fq = lane >> 4;
    const int K = g.K, nt = K / BK;
    unsigned voffA[2], voffB[2];
#pragma unroll
    for (int i = 0; i < 2; ++i) { int R, C; stage_rc(tid * 16 + i * 8192, R, C); const int Rb = Epi::PERM ? ((R & ~31) + perm32(R & 31)) : R;
        voffA[i] = (unsigned)(R * K + C) * 2u; voffB[i] = (unsigned)(Rb * K + C) * 2u; }
    const size_t kstep = (size_t)(BK * 2);
    const size_t hstep = (size_t)HALF * K * 2;
    const size_t tstep = 2 * hstep;
    const unsigned ldsw = (unsigned)wid * 1024u;
    const int aoff = lds_byte(wr * 64 + fr, fq * 8), boff = lds_byte(wc * 32 + fr, fq * 8);
#define PG8_SA(b, h) (((b) * 2 + (h)) * HTB)
#define PG8_SB(b, h) ((4 + (b) * 2 + (h)) * HTB)
#define PG8_STAGE(bufoff, gbase, voff) do { _Pragma("unroll") for (int _i = 0; _i < 2; ++_i) \
        __builtin_amdgcn_global_load_lds((const unsigned*)((const char*)(gbase) + (voff)[_i]), (PG8_LAS unsigned*)(lds + (bufoff) + ldsw + _i * 8192), 16, 0, 0); } while (0)
#define PG8_LDA(dst, b, h) do { _Pragma("unroll") for (int m = 0; m < 4; ++m) _Pragma("unroll") for (int k = 0; k < 2; ++k) dst[m][k] = *(const PG8_LAS bf16x8*)(lds + PG8_SA(b, h) + aoff + m * 2048 + k * 1024); } while (0)
#define PG8_LDB(dst, b, h) do { _Pragma("unroll") for (int n = 0; n < 2; ++n) _Pragma("unroll") for (int k = 0; k < 2; ++k) dst[n][k] = *(const PG8_LAS bf16x8*)(lds + PG8_SB(b, h) + boff + n * 2048 + k * 1024); } while (0)
#define PG8_MMA(ai, bj, At, Bt) do { __builtin_amdgcn_s_setprio(1); _Pragma("unroll") for (int m = 0; m < 4; ++m) _Pragma("unroll") for (int n = 0; n < 2; ++n) _Pragma("unroll") for (int k = 0; k < 2; ++k) \
        acc[ai][bj][m][n] = __builtin_amdgcn_mfma_f32_16x16x32_bf16(Bt[n][k], At[m][k], acc[ai][bj][m][n], 0, 0, 0); __builtin_amdgcn_s_setprio(0); } while (0)
#define PG8_WAIT_V(n) asm volatile("s_waitcnt vmcnt(" #n ")" ::: "memory")
#define PG8_WAIT_L(n) asm volatile("s_waitcnt lgkmcnt(" #n ")" ::: "memory")
#define PG8_BAR __builtin_amdgcn_s_barrier()
#define PG8_SCHED __builtin_amdgcn_sched_barrier(0)
    Unit cur, nxt; int ui = 0;
    if (!S.next(0, cur)) return;
    f32x4 acc[2][2][4][2];
#pragma unroll
    for (int a = 0; a < 2; ++a)
#pragma unroll
        for (int b = 0; b < 2; ++b)
#pragma unroll
            for (int m = 0; m < 4; ++m)
#pragma unroll
                for (int n = 0; n < 2; ++n) acc[a][b][m][n] = (f32x4){0.f, 0.f, 0.f, 0.f};
    bf16x8 At[4][2], B0[2][2], B1[2][2];
    const char* cA = (const char*)g.A + (size_t)cur.pm * tstep; const char* cB = (const char*)g.Bt + (size_t)cur.pn * tstep;
    S.a_ready(cur);
    if constexpr (SP2) {
        PG8_STAGE(PG8_SB(0, 0), cB, voffB); PG8_STAGE(PG8_SB(0, 1), cB + hstep, voffB); PG8_STAGE(PG8_SA(0, 0), cA, voffA); PG8_STAGE(PG8_SA(0, 1), cA + hstep, voffA);
        if (wr == 1) PG8_BAR;
        PG8_WAIT_V(2); PG8_BAR;
        PG8_STAGE(PG8_SB(1, 0), cB + kstep, voffB); PG8_STAGE(PG8_SA(1, 0), cA + kstep, voffA); PG8_STAGE(PG8_SB(1, 1), cB + hstep + kstep, voffB);
        PG8_WAIT_V(6); PG8_BAR;
    } else {
        PG8_STAGE(PG8_SB(0, 0), cB, voffB); PG8_STAGE(PG8_SA(0, 0), cA, voffA); PG8_STAGE(PG8_SB(0, 1), cB + hstep, voffB); PG8_STAGE(PG8_SA(0, 1), cA + hstep, voffA);
        if (wr == 1) PG8_BAR;
        PG8_WAIT_V(4); PG8_BAR;
        PG8_STAGE(PG8_SB(1, 0), cB + kstep, voffB); PG8_STAGE(PG8_SA(1, 0), cA + kstep, voffA); PG8_STAGE(PG8_SB(1, 1), cB + hstep + kstep, voffB);
        PG8_WAIT_V(6); PG8_BAR;
    }
    for (;;) {
        const bool has_next = S.next(ui + 1, nxt);
        const char* nA = has_next ? (const char*)g.A + (size_t)nxt.pm * tstep : cA; const char* nB = has_next ? (const char*)g.Bt + (size_t)nxt.pn * tstep : cB;
        for (int t = 0; t < nt; t += 2) {
            const bool last = (t == nt - 2);
            const char* a1 = cA + (size_t)(t + 1) * kstep;
            const char* a2 = last ? nA : cA + (size_t)(t + 2) * kstep; const char* b2 = last ? nB : cB + (size_t)(t + 2) * kstep;
            const char* a3 = a2 + kstep; const char* b3 = b2 + kstep;
            if (last && has_next) S.a_ready(nxt);
            if constexpr (SP2) {
            PG8_LDB(B0, 0, 0); PG8_LDB(B1, 0, 1); PG8_SCHED; PG8_LDA(At, 0, 0); PG8_STAGE(PG8_SA(1, 1), a1 + hstep, voffA);
            PG8_WAIT_V(8); PG8_WAIT_L(0); PG8_BAR; PG8_MMA(0, 0, At, B0); PG8_MMA(0, 1, At, B1); PG8_BAR; PG8_SCHED;
            PG8_LDA(At, 0, 1); PG8_STAGE(PG8_SB(0, 0), b2, voffB); PG8_STAGE(PG8_SB(0, 1), b2 + hstep, voffB); PG8_STAGE(PG8_SA(0, 0), a2, voffA);
            PG8_WAIT_V(8); PG8_WAIT_L(0); PG8_BAR; PG8_MMA(1, 0, At, B0); PG8_MMA(1, 1, At, B1); PG8_BAR; PG8_SCHED;
            PG8_LDB(B0, 1, 0); PG8_LDB(B1, 1, 1); PG8_SCHED; PG8_LDA(At, 1, 0); PG8_STAGE(PG8_SA(0, 1), a2 + hstep, voffA);
            PG8_WAIT_V(8); PG8_WAIT_L(0); PG8_BAR; PG8_MMA(0, 0, At, B0); PG8_MMA(0, 1, At, B1); PG8_BAR; PG8_SCHED;
            PG8_LDA(At, 1, 1); PG8_STAGE(PG8_SB(1, 0), b3, voffB); PG8_STAGE(PG8_SB(1, 1), b3 + hstep, voffB); PG8_STAGE(PG8_SA(1, 0), a3, voffA);
            PG8_WAIT_V(8); PG8_WAIT_L(0); PG8_BAR; PG8_MMA(1, 0, At, B0); PG8_MMA(1, 1, At, B1); PG8_BAR; PG8_SCHED;
            } else {
            PG8_LDB(B0, 0, 0); PG8_SCHED; PG8_LDA(At, 0, 0); PG8_STAGE(PG8_SA(1, 1), a1 + hstep, voffA);
            PG8_WAIT_L(8); PG8_BAR; PG8_WAIT_L(0); PG8_MMA(0, 0, At, B0); PG8_BAR; PG8_SCHED;
            PG8_LDB(B1, 0, 1); PG8_STAGE(PG8_SB(0, 0), b2, voffB);
            PG8_BAR; PG8_WAIT_L(0); PG8_MMA(0, 1, At, B1); PG8_BAR;
            PG8_LDA(At, 0, 1); PG8_STAGE(PG8_SA(0, 0), a2, voffA);
            PG8_BAR; PG8_WAIT_L(0); PG8_MMA(1, 0, At, B0); PG8_BAR; PG8_SCHED;
            PG8_STAGE(PG8_SB(0, 1), b2 + hstep, voffB);
            PG8_WAIT_V(6); PG8_BAR; PG8_MMA(1, 1, At, B1); PG8_BAR;
            PG8_LDB(B0, 1, 0); PG8_SCHED; PG8_LDA(At, 1, 0); PG8_STAGE(PG8_SA(0, 1), a2 + hstep, voffA);
            PG8_WAIT_L(8); PG8_BAR; PG8_WAIT_L(0); PG8_MMA(0, 0, At, B0); PG8_BAR; PG8_SCHED;
            PG8_LDB(B1, 1, 1); PG8_STAGE(PG8_SB(1, 0), b3, voffB);
            PG8_BAR; PG8_WAIT_L(0); PG8_MMA(0, 1, At, B1); PG8_BAR;
            PG8_LDA(At, 1, 1); PG8_STAGE(PG8_SA(1, 0), a3, voffA);
            PG8_BAR; PG8_WAIT_L(0); PG8_MMA(1, 0, At, B0); PG8_BAR; PG8_SCHED;
            PG8_STAGE(PG8_SB(1, 1), b3 + hstep, voffB);
            PG8_WAIT_V(6); PG8_BAR; PG8_MMA(1, 1, At, B1); PG8_BAR;
            }
        }
        if constexpr (ALIGN_EPI) { if (wr == 0) PG8_BAR; }
        if constexpr (!Epi::AFTER_DRAIN) { E(acc, cur, wr, wc, fr, fq); S.done(cur); }
        if (!has_next) break;
#pragma unroll
        for (int a = 0; a < 2; ++a)
#pragma unroll
            for (int b = 0; b < 2; ++b)
#pragma unroll
                for (int m = 0; m < 4; ++m)
#pragma unroll
                    for (int n = 0; n < 2; ++n) acc[a][b][m][n] = (f32x4){0.f, 0.f, 0.f, 0.f};
        cur = nxt; cA = nA; cB = nB; ++ui;
        if constexpr (ALIGN_EPI) { if (wr == 1) PG8_BAR; }
    }
    PG8_WAIT_V(0);
    if constexpr (!ALIGN_EPI) { if (wr == 0) PG8_BAR; }
    PG8_BAR;
    if constexpr (Epi::AFTER_DRAIN) { E.fused(acc, cur, wr, wc, fr, fq, lds, wid, lane); S.done(cur); }
#undef PG8_SA
#undef PG8_SB
#undef PG8_STAGE
#undef PG8_LDA
#undef PG8_LDB
#undef PG8_MMA
#undef PG8_WAIT_V
#undef PG8_WAIT_L
#undef PG8_BAR
#undef PG8_SCHED
}
}
#define XB_TMO      128
#define XB_XCNT(j)  (256  + 64 * (j))
#define XB_XSUB(j)  (1280 + 64 * (j))
#define XB_XGEN(j)  (2304 + 64 * (j))
#define XB_TOP      3328
#define XB_TOPGEN   3392
#define XCD_BAR_WORDS 3456
#define XB_SPIN_CAP (1u << 18)
#define LAS __attribute__((address_space(3)))

__device__ __forceinline__ unsigned xb_ld(unsigned* p)              { return __hip_atomic_load(p, __ATOMIC_RELAXED, __HIP_MEMORY_SCOPE_AGENT); }
__device__ __forceinline__ unsigned xb_add(unsigned* p, unsigned v) { return __hip_atomic_fetch_add(p, v, __ATOMIC_RELAXED, __HIP_MEMORY_SCOPE_AGENT); }
__device__ __forceinline__ unsigned xb_xcc_id() { return (unsigned)__builtin_amdgcn_s_getreg((3 << 11) | 20) & 0xFu; }
#define XB_SPIN(cond, bar) do { unsigned _sp = 0; while (cond) { __builtin_amdgcn_s_sleep(1); \
    if ((++_sp & 255u) == 0u) { if (xb_ld(&(bar)[XB_TMO])) break; if (_sp > XB_SPIN_CAP) { atomicAdd(&(bar)[XB_TMO], 1u); break; } } } } while (0)

struct XcdBarrier {
    unsigned* bar; unsigned x;
    volatile LAS unsigned* st;
};

__device__ __forceinline__ XcdBarrier xcd_barrier_post(unsigned* bar, volatile LAS unsigned* st) {
    XcdBarrier b; b.bar = bar; b.x = xb_xcc_id(); b.st = st;
    if (threadIdx.x == 0) (void)xb_add(&bar[XB_XCNT(b.x)], 1u);
    return b;
}
__device__ __forceinline__ void xcd_barrier_complete(unsigned* bar, unsigned x, unsigned& nloc, unsigned& nx) {
    const unsigned G = gridDim.x * gridDim.y * gridDim.z;
    unsigned sum, cnt, mine, sp = 0u;
    for (;;) {
        sum = 0u; cnt = 0u; mine = 0u;
#pragma unroll
        for (unsigned j = 0; j < 16; ++j) { const unsigned c = xb_ld(&bar[XB_XCNT(j)]); sum += c; cnt += (c > 0u) ? 1u : 0u; mine = (j == x) ? c : mine; }
        if (sum == G) break;
        __builtin_amdgcn_s_sleep(1);
        if ((++sp & 255u) == 0u) { if (xb_ld(&bar[XB_TMO])) break; if (sp > XB_SPIN_CAP) { atomicAdd(&bar[XB_TMO], 1u); break; } }
    }
    nloc = mine > 0u ? mine : 1u; nx = cnt > 0u ? cnt : 1u;
}

__device__ __forceinline__ void xcd_barrier(const XcdBarrier& b) {
    asm volatile("s_waitcnt vmcnt(0)" ::: "memory");
    __syncthreads();
    if (threadIdx.x == 0) {
        unsigned* bar = b.bar;
        __builtin_amdgcn_s_waitcnt(0);
        unsigned nloc = b.st[0], nx = b.st[1];
        if (nloc == 0u) { xcd_barrier_complete(bar, b.x, nloc, nx); b.st[0] = nloc; b.st[1] = nx; }
        const unsigned old = xb_add(&bar[XB_XSUB(b.x)], 1u);
        const unsigned gen = old / nloc;
        if (old + 1u == (gen + 1u) * nloc) {
            __builtin_amdgcn_fence(__ATOMIC_RELEASE, "agent");
            asm volatile("s_waitcnt vmcnt(0)" ::: "memory");
            const unsigned og = xb_add(&bar[XB_TOP], 1u);
            const unsigned tg = og / nx;
            if (og + 1u == (tg + 1u) * nx) xb_add(&bar[XB_TOPGEN], 1u);
            else XB_SPIN(xb_ld(&bar[XB_TOPGEN]) == tg, bar);
            __builtin_amdgcn_fence(__ATOMIC_ACQUIRE, "agent");
            xb_add(&bar[XB_XGEN(b.x)], 1u);
            asm volatile("s_waitcnt vmcnt(0)" ::: "memory");
        } else {
            XB_SPIN(xb_ld(&bar[XB_XGEN(b.x)]) == gen, bar);
            __builtin_amdgcn_fence(__ATOMIC_ACQUIRE, "agent");
            asm volatile("s_waitcnt vmcnt(0)" ::: "memory");
        }
    }
    __syncthreads();
}
constexpr int D = 2048, NB = 8, SEQ = 2048, NL = 4, T = NB * SEQ;
constexpr int NCH = SEQ / 64, NCHUNK = T / 64;
constexpr int GKW = 512, RANK = 16;
constexpr int INW = 6160, NP = 6144;
constexpr int NE = 16384;
constexpr float ALPHA = 1.6817928305074290f, EPS = 1e-5f;
constexpr int PQ = 0, PK = 512, PV = 1024, PR = 2048, PCB = 3072, PCC = 4096, PCH = 5120;
constexpr int NWAVES = 8, NTHREADS = 512;
#ifndef WGM_IN
#define WGM_IN 4
#endif
#ifndef WGM_OUT
#define WGM_OUT 4
#endif
#ifndef WGM_WQ
#define WGM_WQ 4
#endif
#ifndef TAB4
#define TAB4 1
#endif
constexpr int NPHASES = 2 + 7 * NL;

constexpr size_t MiB = 1u << 20;
constexpr size_t WS_CTL = 0, CTL_ZERO_BYTES = 1 * MiB;
constexpr size_t WS_MOD = 1 * MiB, WS_PART = 3 * MiB, WS_KEYS = 15 * MiB, WS_DTOT = 17 * MiB, WS_WIN = 18 * MiB, WS_WOUT = 115 * MiB, WS_WQ = 147 * MiB;
constexpr size_t WS_UT = 179 * MiB, WS_VT = 435 * MiB, WS_H = 691 * MiB, WS_PROJ = 755 * MiB, WS_E = 947 * MiB, WS_OGLA = 979 * MiB, WS_Y = 1043 * MiB;
constexpr size_t WS_Z = 1107 * MiB, WS_X1 = 1235 * MiB, WS_X = 1363 * MiB, WS_Q = 1491 * MiB, WS_H2 = 1555 * MiB, WS_HQ8 = 1619 * MiB, WS_END = 1659 * MiB;
constexpr size_t WS_SU = 17 * MiB + 512 * 1024, WS_SV = 17 * MiB + 768 * 1024, WS_HSC = 2 * MiB + 640 * 1024;
static_assert(WS_WIN + (size_t)NL * INW * D * 2 <= WS_WOUT && WS_PART + (size_t)NL * 8 * NB * 6 * D * 4 <= WS_KEYS && WS_MOD + (size_t)NL * NB * 6 * D * 4 <= WS_PART, "ws map");
constexpr int CW_BAR = 4096;

constexpr int RING_OFF = 0, RING_BYTES = 131072, LDSCTL_OFF = RING_BYTES, LDS_BYTES = 147456;

#define GAS __attribute__((address_space(1)))
typedef unsigned short bf16;
typedef unsigned v4u __attribute__((ext_vector_type(4)));
typedef unsigned v2u __attribute__((ext_vector_type(2)));
typedef float f32x4 __attribute__((ext_vector_type(4)));
typedef float f32x16 __attribute__((ext_vector_type(16)));
typedef short bf16x8 __attribute__((ext_vector_type(8)));
typedef __bf16 bf16x2v __attribute__((ext_vector_type(2)));
#define LDS_WAIT() asm volatile("s_waitcnt lgkmcnt(0)" ::: "memory")

__device__ __forceinline__ unsigned pk2(float lo, float hi) { return pg8::cvt_pk_bf16(lo, hi); }
__device__ __forceinline__ float dot2bf(unsigned w, unsigned x, float acc) { return __builtin_amdgcn_fdot2_f32_bf16(__builtin_bit_cast(bf16x2v, w), __builtin_bit_cast(bf16x2v, x), acc, false); }
__device__ __forceinline__ float bflo(unsigned u) { return __uint_as_float(u << 16); }
__device__ __forceinline__ float bfhi(unsigned u) { return __uint_as_float(u & 0xffff0000u); }
__device__ __forceinline__ float silu_f(float x) { return x / (1.0f + __expf(-x)); }
__device__ __forceinline__ float logsigmoid_f(float x) { return fminf(x, 0.0f) - log1pf(__expf(-fabsf(x))); }
__device__ __forceinline__ float gelu_tanh_f(float x) { const float u = 0.7978845608028654f * (x + 0.044715f * x * x * x); return 0.5f * x * (1.0f + tanhf(u)); }
__device__ __forceinline__ float wave_sum(float v) {
#pragma unroll
    for (int o = 1; o < 64; o <<= 1) v += __shfl_xor(v, o);
    return v;
}

struct Args { const float* in[19]; float* out; unsigned char* ws; int ph_lo, ph_hi; };

__device__ __forceinline__ void transpose_item(const float* W, int ldw, int col0, bf16* WTrows, int k0, int nvalid, LAS float* scr, int lane) {
    const int n = lane & 31;
    float tv[32];
#pragma unroll
    for (int i = 0; i < 32; ++i) { const int kk = 2 * i + (lane >> 5); tv[i] = (n < nvalid) ? W[(size_t)(k0 + kk) * ldw + col0 + n] : 0.f; }
#pragma unroll
    for (int i = 0; i < 32; ++i) { const int kk = 2 * i + (lane >> 5); scr[kk * 33 + n] = tv[i]; }
    LDS_WAIT(); asm volatile("" ::: "memory");
    const int c = lane & 7;
#pragma unroll
    for (int j = 0; j < 4; ++j) { const int nn = (lane >> 3) + 8 * j; const LAS float* s = scr + (8 * c) * 33 + nn;
        v4u o; o.x = pk2(s[0 * 33], s[1 * 33]); o.y = pk2(s[2 * 33], s[3 * 33]); o.z = pk2(s[4 * 33], s[5 * 33]); o.w = pk2(s[6 * 33], s[7 * 33]);
        if (nn < nvalid) *(v4u*)(WTrows + (size_t)nn * D + k0 + 8 * c) = o; }
    LDS_WAIT(); asm volatile("" ::: "memory");
}
__device__ __forceinline__ void cvt_stream(const float* src, bf16* dst, size_t n4, size_t i0, size_t stride) {
    for (size_t i = i0; i < n4; i += stride) { const f32x4 v = ((const f32x4*)src)[i]; v2u o; o.x = pk2(v.x, v.y); o.y = pk2(v.z, v.w); ((v2u*)dst)[i] = o; }
}
__device__ __forceinline__ void ph_prologue_a(const Args& a, LAS unsigned char* lds, int tid, int lane, int wave, int bx, int G) {
    const int gw = bx * NWAVES + wave, NGW = G * NWAVES;
    LAS float* cact = (LAS float*)lds;
    for (int i = tid; i < NB * D; i += NTHREADS) { const int b = i / D, d = i % D; cact[d * 8 + b] = silu_f(a.in[1][i]); }
    __syncthreads();
    float* part = (float*)(a.ws + WS_PART);
    for (int it = gw; it < NL * 8 * 48; it += NGW) {
        const int cg = it % 48, dr = (it / 48) % 8, l = it / 384;
        f32x4 acc[8];
#pragma unroll
        for (int b = 0; b < 8; ++b) acc[b] = (f32x4){0.f, 0.f, 0.f, 0.f};
        const float* w = a.in[2] + ((size_t)l * D + dr * 256) * (6 * D) + cg * 256 + lane * 4;
#pragma unroll 4
        for (int d = 0; d < 256; ++d) {
            const f32x4 wv = *(const f32x4*)(w + (size_t)d * (6 * D));
            const f32x4 c0 = *(const LAS f32x4*)(cact + (dr * 256 + d) * 8), c1 = *(const LAS f32x4*)(cact + (dr * 256 + d) * 8 + 4);
            acc[0] += wv * c0.x; acc[1] += wv * c0.y; acc[2] += wv * c0.z; acc[3] += wv * c0.w;
            acc[4] += wv * c1.x; acc[5] += wv * c1.y; acc[6] += wv * c1.z; acc[7] += wv * c1.w;
        }
#pragma unroll
        for (int b = 0; b < 8; ++b) *(f32x4*)(part + (((size_t)l * 8 + dr) * NB + b) * (6 * D) + cg * 256 + lane * 4) = acc[b];
    }
    __syncthreads();
    LAS float* scr = (LAS float*)(lds + wave * 8448);
    bf16* winT = (bf16*)(a.ws + WS_WIN); bf16* woutT = (bf16*)(a.ws + WS_WOUT); bf16* wqT = (bf16*)(a.ws + WS_WQ);
    constexpr int IPL = 6144 + 32 + 2048 + 2048;
    for (int it = gw; it < NL * IPL; it += NGW) {
        const int l = it / IPL; int r = it % IPL;
        if (r < 6144) { const int nb = r % 192, kb = r / 192, n0 = nb * 32;
            transpose_item(a.in[4] + (size_t)l * D * INW, INW, n0 < 3072 ? n0 : n0 + 16, winT + ((size_t)l * INW + n0) * D, kb * 64, 32, scr, lane); continue; }
        r -= 6144;
        if (r < 32) { transpose_item(a.in[4] + (size_t)l * D * INW, INW, 3072, winT + ((size_t)l * INW + NP) * D, r * 64, 16, scr, lane); continue; }
        r -= 32;
        if (r < 2048) { const int nb = r % 64, kb = r / 64; transpose_item(a.in[10] + (size_t)l * D * D, D, nb * 32, woutT + ((size_t)l * D + nb * 32) * D, kb * 64, 32, scr, lane); continue; }
        r -= 2048;
        { const int nb = r % 64, kb = r / 64; transpose_item(a.in[13] + (size_t)l * D * D, D, nb * 32, wqT + ((size_t)l * D + nb * 32) * D, kb * 64, 32, scr, lane); }
    }
    const size_t i0 = (size_t)bx * NTHREADS + tid, stride = (size_t)G * NTHREADS;
    cvt_stream(a.in[14], (bf16*)(a.ws + WS_KEYS), (size_t)NL * 8 * 2 * 128 * 128 / 4, i0, stride);
#if TAB4
    __syncthreads();
    { LAS float* rowst = (LAS float*)(lds + wave * 8192);
      for (int row = gw; row < 2 * NL * NE; row += NGW) {
        const int tbl = row / (NL * NE), r = row % (NL * NE);
        const float* src = (tbl ? a.in[16] : a.in[15]) + (size_t)r * D;
#pragma unroll
        for (int c8 = 0; c8 < 8; ++c8) *(LAS f32x4*)(rowst + (c8 * 64 + lane) * 4) = *(const f32x4*)(src + (c8 * 64 + lane) * 4);
        LDS_WAIT(); asm volatile("" ::: "memory");
        unsigned char* tb = a.ws + (tbl ? WS_VT : WS_UT) + (size_t)r * 1152;
#pragma unroll
        for (int pass = 0; pass < 2; ++pass) { const int slot = lane + 64 * pass;
            if (slot < 72) { const int col0 = (slot >> 3) * 240 + (slot & 7) * 30;
                float x[30]; float mx = 0.f;
#pragma unroll
                for (int k = 0; k < 30; ++k) { x[k] = (col0 + k < D) ? rowst[col0 + k] : 0.f; mx = fmaxf(mx, fabsf(x[k])); }
                int code = 0; float inv = 0.f;
                if (mx > 0.f) { code = (int)ceilf(8.0f * log2f(mx * (1.0f / 7.0f))) + 128; code = code < 0 ? 0 : (code > 255 ? 255 : code); inv = __builtin_amdgcn_exp2f(16.0f - (float)code * 0.125f); }
                unsigned dw[4] = {0u, 0u, 0u, 0u};
#pragma unroll
                for (int kb = 0; kb < 15; ++kb) { int a0 = (int)__builtin_rintf(x[2 * kb] * inv), a1 = (int)__builtin_rintf(x[2 * kb + 1] * inv);
                    a0 = a0 < -7 ? -7 : (a0 > 7 ? 7 : a0); a1 = a1 < -7 ? -7 : (a1 > 7 ? 7 : a1);
                    dw[kb >> 2] |= ((unsigned)(a0 + 8) | ((unsigned)(a1 + 8) << 4)) << (8 * (kb & 3)); }
                dw[3] |= (unsigned)code << 24;
                *(v4u*)(tb + slot * 16) = (v4u){dw[0], dw[1], dw[2], dw[3]}; } }
        LDS_WAIT(); asm volatile("" ::: "memory");
      } }
#else
    for (int row = gw; row < 2 * NL * NE; row += NGW) {
        const int tbl = row / (NL * NE), r = row % (NL * NE);
        const float* src = (tbl ? a.in[16] : a.in[15]) + (size_t)r * D;
        f32x4 v[8]; float mx = 0.f;
#pragma unroll
        for (int c8 = 0; c8 < 8; ++c8) { v[c8] = *(const f32x4*)(src + (c8 * 64 + lane) * 4); mx = fmaxf(mx, fmaxf(fmaxf(fabsf(v[c8].x), fabsf(v[c8].y)), fmaxf(fabsf(v[c8].z), fabsf(v[c8].w)))); }
#pragma unroll
        for (int o = 1; o < 64; o <<= 1) mx = fmaxf(mx, __shfl_xor(mx, o));
        const float inv = mx > 0.f ? 127.0f / mx : 0.f; const int off = tbl ? 128 : 0;
        unsigned dw[8];
#pragma unroll
        for (int c8 = 0; c8 < 8; ++c8) { const int q0 = (int)__builtin_rintf(v[c8].x * inv) + off, q1 = (int)__builtin_rintf(v[c8].y * inv) + off, q2 = (int)__builtin_rintf(v[c8].z * inv) + off, q3 = (int)__builtin_rintf(v[c8].w * inv) + off;
            dw[c8] = (unsigned)(q0 & 255) | ((unsigned)(q1 & 255) << 8) | ((unsigned)(q2 & 255) << 16) | ((unsigned)(q3 & 255) << 24); }
        unsigned char* dst = a.ws + (tbl ? WS_VT : WS_UT) + (size_t)r * D;
        *(v4u*)(dst + lane * 16) = (v4u){dw[0], dw[1], dw[2], dw[3]}; *(v4u*)(dst + (64 + lane) * 16) = (v4u){dw[4], dw[5], dw[6], dw[7]};
        if (lane == 0) ((float*)(a.ws + (tbl ? WS_SV : WS_SU)))[r] = mx * (1.0f / 127.0f);
    }
#endif
}

__device__ __forceinline__ void ln_tail(const float (&z)[32], int t, int lane, const float* g, const float* bta, float* xout, const float* sh, const float* sc, bf16* hout, unsigned char* q8, float* q8s, LAS unsigned char* q8stage = nullptr) {
    float s = 0.f;
#pragma unroll
    for (int i = 0; i < 32; ++i) s += z[i];
    const float mu = wave_sum(s) * (1.0f / D);
    float q = 0.f;
#pragma unroll
    for (int i = 0; i < 32; ++i) { const float d = z[i] - mu; q += d * d; }
    const float rs = rsqrtf(wave_sum(q) * (1.0f / D) + EPS);
    float hv[32]; float mx = 0.f;
#pragma unroll
    for (int c = 0; c < 8; ++c) { const int col = (c * 64 + lane) * 4;
        const f32x4 g0 = *(const f32x4*)(g + col), b0 = *(const f32x4*)(bta + col);
        f32x4 x0;
        x0.x = (z[c * 4 + 0] - mu) * rs * g0.x + b0.x; x0.y = (z[c * 4 + 1] - mu) * rs * g0.y + b0.y; x0.z = (z[c * 4 + 2] - mu) * rs * g0.z + b0.z; x0.w = (z[c * 4 + 3] - mu) * rs * g0.w + b0.w;
        if (xout) *(f32x4*)(xout + (size_t)t * D + col) = x0;
        if (hout) { const f32x4 s0 = *(const f32x4*)(sc + col), h0 = *(const f32x4*)(sh + col);
            hv[c * 4] = x0.x * (1.f + s0.x) + h0.x; hv[c * 4 + 1] = x0.y * (1.f + s0.y) + h0.y; hv[c * 4 + 2] = x0.z * (1.f + s0.z) + h0.z; hv[c * 4 + 3] = x0.w * (1.f + s0.w) + h0.w;
            v2u o; o.x = pk2(hv[c * 4], hv[c * 4 + 1]); o.y = pk2(hv[c * 4 + 2], hv[c * 4 + 3]);
            *(v2u*)(hout + (size_t)t * D + col) = o;
            if (q8) {
                hv[c * 4] = bflo(o.x); hv[c * 4 + 1] = bfhi(o.x); hv[c * 4 + 2] = bflo(o.y); hv[c * 4 + 3] = bfhi(o.y);
                mx = fmaxf(mx, fmaxf(fmaxf(fabsf(hv[c * 4]), fabsf(hv[c * 4 + 1])), fmaxf(fabsf(hv[c * 4 + 2]), fabsf(hv[c * 4 + 3])))); } }
    }
    if (q8) {
#pragma unroll
        for (int o = 1; o < 64; o <<= 1) mx = fmaxf(mx, __shfl_xor(mx, o));
        const float qmax_ = TAB4 ? 119.0f : 127.0f;
        const float inv = mx > 0.f ? qmax_ / mx : 0.f;
        unsigned dw[8];
#pragma unroll
        for (int c = 0; c < 8; ++c) { const int q0 = (int)__builtin_rintf(hv[c * 4] * inv), q1 = (int)__builtin_rintf(hv[c * 4 + 1] * inv), q2 = (int)__builtin_rintf(hv[c * 4 + 2] * inv), q3 = (int)__builtin_rintf(hv[c * 4 + 3] * inv);
            dw[c] = (unsigned)(q0 & 255) | ((unsigned)(q1 & 255) << 8) | ((unsigned)(q2 & 255) << 16) | ((unsigned)(q3 & 255) << 24); }
#if TAB4
        { LAS unsigned* st32 = (LAS unsigned*)q8stage; LAS unsigned char* st8 = (LAS unsigned char*)q8stage;
#pragma unroll
          for (int i = 0; i < 9; ++i) st32[lane + 64 * i] = 0u;
          LDS_WAIT(); asm volatile("" ::: "memory");
#pragma unroll
          for (int c = 0; c < 8; ++c)
#pragma unroll
              for (int jp = 0; jp < 2; ++jp) { const int col = (c * 64 + lane) * 4 + 2 * jp, u = col / 240, r = col - u * 240, l7 = r / 30, k = r - l7 * 30;
                  const int q0 = (int)(signed char)((dw[c] >> (16 * jp)) & 255u), q1 = (int)(signed char)((dw[c] >> (16 * jp + 8)) & 255u);
                  const int l0 = ((q0 + 8) & 15) - 8, l1 = ((q1 + 8) & 15) - 8, h0 = (q0 - l0) >> 4, h1 = (q1 - l1) >> 4;
                  LAS unsigned char* sp = st8 + (u * 8 + l7) * 32 + (k >> 1);
                  sp[0] = (unsigned char)((l0 & 15) | ((l1 & 15) << 4)); sp[16] = (unsigned char)((h0 & 15) | ((h1 & 15) << 4)); }
          LDS_WAIT(); asm volatile("" ::: "memory");
          unsigned* d32 = (unsigned*)(q8 + (size_t)t * 2304);
#pragma unroll
          for (int i = 0; i < 9; ++i) d32[lane + 64 * i] = st32[lane + 64 * i];
          LDS_WAIT(); asm volatile("" ::: "memory"); }
#else
        unsigned char* dst = q8 + (size_t)t * D;
        *(v4u*)(dst + lane * 16) = (v4u){dw[0], dw[1], dw[2], dw[3]}; *(v4u*)(dst + (64 + lane) * 16) = (v4u){dw[4], dw[5], dw[6], dw[7]};
#endif
        if (lane == 0) q8s[t] = mx / qmax_;
    }
}

__device__ __forceinline__ void ph_prologue_b(const Args& a, LAS unsigned char* lds, int tid, int lane, int wave, int bx, int G) {
    const float* part = (const float*)(a.ws + WS_PART); float* mod = (float*)(a.ws + WS_MOD);
    for (int i = bx * NTHREADS + tid; i < NL * NB * 6 * D / 4; i += G * NTHREADS) {
        const int idx = i * 4, e = idx % (6 * D), b = (idx / (6 * D)) % NB, l = idx / (6 * D * NB);
        f32x4 s = *(const f32x4*)(a.in[3] + l * 6 * D + e);
#pragma unroll
        for (int dr = 0; dr < 8; ++dr) s += *(const f32x4*)(part + (((size_t)l * 8 + dr) * NB + b) * (6 * D) + e);
        *(f32x4*)(mod + idx) = s;
    }
    LAS float* msh = (LAS float*)lds;
    bf16* hbuf = (bf16*)(a.ws + WS_H);
    for (int ch = bx; ch < NCHUNK; ch += G) {
        const int b = ch / NCH;
        for (int i = tid; i < 1024; i += NTHREADS) { const int e = i * 4;
            f32x4 s = *(const f32x4*)(a.in[3] + e);
#pragma unroll
            for (int dr = 0; dr < 8; ++dr) s += *(const f32x4*)(part + (((size_t)0 * 8 + dr) * NB + b) * (6 * D) + e);
            *(LAS f32x4*)(msh + e) = s; }
        __syncthreads();
        for (int i = 0; i < 8; ++i) { const int t = ch * 64 + wave * 8 + i;
#pragma unroll
            for (int c = 0; c < 4; ++c) { const int col = (c * 64 + lane) * 8;
                const f32x4 x0 = *(const f32x4*)(a.in[0] + (size_t)t * D + col), x1 = *(const f32x4*)(a.in[0] + (size_t)t * D + col + 4);
                const f32x4 h0 = *(const LAS f32x4*)(msh + col), h1 = *(const LAS f32x4*)(msh + col + 4), s0 = *(const LAS f32x4*)(msh + 2048 + col), s1 = *(const LAS f32x4*)(msh + 2048 + col + 4);
                v4u o; o.x = pk2(x0.x * (1.f + s0.x) + h0.x, x0.y * (1.f + s0.y) + h0.y); o.y = pk2(x0.z * (1.f + s0.z) + h0.z, x0.w * (1.f + s0.w) + h0.w);
                o.z = pk2(x1.x * (1.f + s1.x) + h1.x, x1.y * (1.f + s1.y) + h1.y); o.w = pk2(x1.z * (1.f + s1.z) + h1.z, x1.w * (1.f + s1.w) + h1.w);
                *(v4u*)(hbuf + (size_t)t * D + col) = o; } }
        __syncthreads();
    }
}

__device__ __forceinline__ void gate_prep(const Args& a, int l, LAS unsigned char* lds, int tid, int lane, int wave, int ch) {
    const bf16* hbuf = (const bf16*)(a.ws + WS_H); const bf16* waT = (const bf16*)(a.ws + WS_WIN) + ((size_t)l * INW + NP) * D;
    bf16* Ebuf = (bf16*)(a.ws + WS_E); float* dtot = (float*)(a.ws + WS_DTOT);
    const int t0 = ch * 64, l15 = lane & 15, lq = lane >> 4, mt = wave & 3, kh = wave >> 2;
    f32x4 acc = (f32x4){0.f, 0.f, 0.f, 0.f};
    const bf16* hA = hbuf + (size_t)(t0 + 16 * mt + l15) * D + kh * 1024 + 8 * lq;
    const bf16* wB = waT + (size_t)l15 * D + kh * 1024 + 8 * lq;
#pragma unroll 8
    for (int ks = 0; ks < 32; ++ks) { const bf16x8 av = *(const bf16x8*)(hA + 32 * ks), bv = *(const bf16x8*)(wB + 32 * ks); acc = __builtin_amdgcn_mfma_f32_16x16x32_bf16(av, bv, acc, 0, 0, 0); }
    LAS float* alr = (LAS float*)lds;
#pragma unroll
    for (int r = 0; r < 4; ++r) alr[(kh * 64 + 16 * mt + 4 * lq + r) * 16 + l15] = acc[r];
    __syncthreads();
    const int col = tid;
    float wg[16];
#pragma unroll
    for (int r = 0; r < 16; ++r) wg[r] = a.in[5][((size_t)l * RANK + r) * GKW + col];
    const float bgc = a.in[6][l * GKW + col];
    float tot = 0.f;
    for (int j = 0; j < 64; ++j) { float lg = bgc;
#pragma unroll
        for (int r4 = 0; r4 < 4; ++r4) { const f32x4 p = *(const LAS f32x4*)(alr + j * 16 + r4 * 4), q = *(const LAS f32x4*)(alr + (64 + j) * 16 + r4 * 4);
            lg += (p.x + q.x) * wg[r4 * 4] + (p.y + q.y) * wg[r4 * 4 + 1] + (p.z + q.z) * wg[r4 * 4 + 2] + (p.w + q.w) * wg[r4 * 4 + 3]; }
        tot += logsigmoid_f(lg) * (1.0f / 16.0f); }
    float run = 0.f;
    for (int j = 0; j < 64; ++j) { float lg = bgc;
#pragma unroll
        for (int r4 = 0; r4 < 4; ++r4) { const f32x4 p = *(const LAS f32x4*)(alr + j * 16 + r4 * 4), q = *(const LAS f32x4*)(alr + (64 + j) * 16 + r4 * 4);
            lg += (p.x + q.x) * wg[r4 * 4] + (p.y + q.y) * wg[r4 * 4 + 1] + (p.z + q.z) * wg[r4 * 4 + 2] + (p.w + q.w) * wg[r4 * 4 + 3]; }
        run += logsigmoid_f(lg) * (1.0f / 16.0f);
        Ebuf[(size_t)(t0 + j) * GKW + col] = (bf16)(pk2(__expf(tot - run), 0.f) & 0xffffu); }
    dtot[(size_t)ch * GKW + col] = __expf(tot);
    __syncthreads();
}

__device__ __forceinline__ void gla_unit(const Args& a, LAS unsigned char* lds, int tid, int lane, int wave, int un) {
    const bf16* proj = (const bf16*)(a.ws + WS_PROJ); const bf16* Ebuf = (const bf16*)(a.ws + WS_E); const float* dtot = (const float*)(a.ws + WS_DTOT); bf16* ogla = (bf16*)(a.ws + WS_OGLA);
    const int pair_ = (un & 7) * 4 + (un >> 6), dvs = (un >> 3) & 7, hh = pair_ & 3, b = pair_ >> 2;
    LAS bf16* kdT = (LAS bf16*)lds;
    LAS bf16* vT = (LAS bf16*)(lds + 18432);
    LAS bf16* ST = (LAS bf16*)(lds + 18432 + 4608);
    const int l15 = lane & 15, lq = lane >> 4, jl = tid >> 3, c0 = tid & 7, dv4 = (tid & 7) * 4, jt = (wave & 3) * 16, dvt = (wave >> 2) * 16;
#define GLA_BAR() do { asm volatile("s_waitcnt lgkmcnt(0)" ::: "memory"); __builtin_amdgcn_s_barrier(); asm volatile("" ::: "memory"); } while (0)
    f32x4 S0 = (f32x4){0.f, 0.f, 0.f, 0.f}, S1 = (f32x4){0.f, 0.f, 0.f, 0.f};
    v4u kn0[2], kn1[2], en0[2], en1[2]; v2u vn0, vn1; bf16x8 qn0[4], qn1[4], qc[4]; f32x4 dn0, dn1, dc;
#define GLA_LOAD(c, kn, en, vn, qn, dn) do { const int t0c = b * SEQ + (c) * 64; const bf16* pr = proj + (size_t)(t0c + jl) * NP; \
          \
        kn[0] = *(const v4u*)(pr + PK + hh * 128 + 8 * c0); kn[1] = *(const v4u*)(pr + PK + hh * 128 + 64 + 8 * c0); \
        en[0] = *(const v4u*)(Ebuf + (size_t)(t0c + jl) * GKW + hh * 128 + 8 * c0); en[1] = *(const v4u*)(Ebuf + (size_t)(t0c + jl) * GKW + hh * 128 + 64 + 8 * c0); \
        vn = *(const v2u*)(pr + PV + hh * 256 + dvs * 32 + dv4); \
        _Pragma("unroll") for (int ks_ = 0; ks_ < 4; ++ks_) qn[ks_] = *(const bf16x8*)(proj + (size_t)(t0c + jt + l15) * NP + PQ + hh * 128 + 32 * ks_ + 8 * lq); \
        dn = *(const f32x4*)(dtot + (size_t)(b * NCH + (c)) * GKW + hh * 128 + 16 * wave + 4 * lq); } while (0)
#define GLA_PREP(kn, en, vn, qn, dn) do { \
        _Pragma("unroll") for (int h_ = 0; h_ < 2; ++h_) _Pragma("unroll") for (int i_ = 0; i_ < 8; ++i_) { const unsigned w_ = kn[h_][i_ >> 1], e_ = en[h_][i_ >> 1]; \
            const float kf_ = (i_ & 1) ? bfhi(w_) : bflo(w_), ef_ = (i_ & 1) ? bfhi(e_) : bflo(e_); \
            kdT[(64 * h_ + 8 * c0 + i_) * 72 + ((((jl >> 3) ^ c0) & 7) << 3) + (jl & 7)] = (bf16)(pk2(kf_ * ef_, 0.f) & 0xffffu); }     \
        _Pragma("unroll") for (int i_ = 0; i_ < 4; ++i_) { const unsigned w_ = vn[i_ >> 1]; vT[(dv4 + i_) * 72 + jl] = (bf16)((i_ & 1) ? (w_ >> 16) : (w_ & 0xffffu)); } \
        _Pragma("unroll") for (int ks_ = 0; ks_ < 4; ++ks_) qc[ks_] = qn[ks_]; \
        dc = dn; } while (0)
#define GLA_BODY(c) do { \
        S0 = S0 * dc; S1 = S1 * dc; \
        _Pragma("unroll") for (int ks = 0; ks < 2; ++ks) { \
            const bf16x8 A_ = *(const LAS bf16x8*)(kdT + (16 * wave + l15) * 72 + ((((4 * ks + lq) ^ (2 * wave + (l15 >> 3))) & 7) << 3)); \
            const bf16x8 B0_ = *(const LAS bf16x8*)(vT + l15 * 72 + 32 * ks + 8 * lq), B1_ = *(const LAS bf16x8*)(vT + (16 + l15) * 72 + 32 * ks + 8 * lq); \
            S0 = __builtin_amdgcn_mfma_f32_16x16x32_bf16(A_, B0_, S0, 0, 0, 0); S1 = __builtin_amdgcn_mfma_f32_16x16x32_bf16(A_, B1_, S1, 0, 0, 0); } \
        { v2u w0_, w1_; w0_.x = pk2(S0.x, S0.y); w0_.y = pk2(S0.z, S0.w); w1_.x = pk2(S1.x, S1.y); w1_.y = pk2(S1.z, S1.w); \
          *(LAS v2u*)(ST + l15 * 136 + 16 * wave + 4 * lq) = w0_; *(LAS v2u*)(ST + (16 + l15) * 136 + 16 * wave + 4 * lq) = w1_; } \
        GLA_BAR(); \
        f32x4 O_ = (f32x4){0.f, 0.f, 0.f, 0.f}; \
        _Pragma("unroll") for (int ks = 0; ks < 4; ++ks) { const bf16x8 A_ = *(const LAS bf16x8*)(ST + (dvt + l15) * 136 + 32 * ks + 8 * lq); O_ = __builtin_amdgcn_mfma_f32_16x16x32_bf16(A_, qc[ks], O_, 0, 0, 0); } \
        { const f32x4 Os_ = O_ * 0.08838834764831845f; v2u ob_; ob_.x = pk2(Os_.x, Os_.y); ob_.y = pk2(Os_.z, Os_.w); \
          *(v2u*)(ogla + (size_t)(b * SEQ + (c) * 64 + jt + l15) * 1024 + hh * 256 + dvs * 32 + dvt + 4 * lq) = ob_; } } while (0)
    GLA_LOAD(0, kn0, en0, vn0, qn0, dn0); GLA_LOAD(1, kn1, en1, vn1, qn1, dn1);
    GLA_PREP(kn0, en0, vn0, qn0, dn0);
    GLA_BAR();
    for (int c = 0; c < NCH; c += 2) {
        { const int cn_ = c + 2 < NCH ? c + 2 : NCH - 1; GLA_LOAD(cn_, kn0, en0, vn0, qn0, dn0); }
        GLA_BODY(c);
        GLA_PREP(kn1, en1, vn1, qn1, dn1);
        GLA_BAR();
        { const int cn_ = c + 3 < NCH ? c + 3 : NCH - 1; GLA_LOAD(cn_, kn1, en1, vn1, qn1, dn1); }
        GLA_BODY(c + 1);
        GLA_PREP(kn0, en0, vn0, qn0, dn0);
        GLA_BAR();
    }
#undef GLA_BODY
#undef GLA_BAR
#undef GLA_LOAD
#undef GLA_PREP
}

__device__ __forceinline__ void unpack16(const v4u& p0, const v4u& p1, float (&o)[16]) {
#pragma unroll
    for (int j = 0; j < 4; ++j) { o[2 * j] = bflo(p0[j]); o[2 * j + 1] = bfhi(p0[j]); o[8 + 2 * j] = bflo(p1[j]); o[8 + 2 * j + 1] = bfhi(p1[j]); }
}
__device__ __forceinline__ void mixpost_chunk(const Args& a, int l, int lane, int wave, int ch) {
    const bf16* proj = (const bf16*)(a.ws + WS_PROJ); const bf16* ogla = (const bf16*)(a.ws + WS_OGLA); bf16* ybuf = (bf16*)(a.ws + WS_Y);
    const int c0 = 16 * lane, tfirst = ch * 64 + wave * 8, sfirst = tfirst % SEQ;
    float gn[16], cw0[16], cw1[16], cw2[16], cn[16], u1[16], u2[16];
#pragma unroll
    for (int i = 0; i < 16; ++i) { gn[i] = a.in[7][l * 256 + ((c0 + i) & 255)]; cw0[i] = a.in[8][(size_t)l * 3072 + c0 + i]; cw1[i] = a.in[8][(size_t)l * 3072 + 1024 + c0 + i];
        cw2[i] = a.in[8][(size_t)l * 3072 + 2048 + c0 + i]; cn[i] = a.in[9][l * 1024 + c0 + i]; u1[i] = 0.f; u2[i] = 0.f; }
    if (sfirst >= 2) {
        float cc[16], chh[16];
        { const bf16* pr = proj + (size_t)(tfirst - 2) * NP; unpack16(*(const v4u*)(pr + PCC + c0), *(const v4u*)(pr + PCC + c0 + 8), cc); unpack16(*(const v4u*)(pr + PCH + c0), *(const v4u*)(pr + PCH + c0 + 8), chh); }
#pragma unroll
        for (int i = 0; i < 16; ++i) u2[i] = cc[i] * chh[i];
        { const bf16* pr = proj + (size_t)(tfirst - 1) * NP; unpack16(*(const v4u*)(pr + PCC + c0), *(const v4u*)(pr + PCC + c0 + 8), cc); unpack16(*(const v4u*)(pr + PCH + c0), *(const v4u*)(pr + PCH + c0 + 8), chh); }
#pragma unroll
        for (int i = 0; i < 16; ++i) u1[i] = cc[i] * chh[i];
    }
#pragma unroll 2
    for (int it = 0; it < 8; ++it) { const int t = tfirst + it; const bf16* pr = proj + (size_t)t * NP;
        float o[16], r[16], cb[16], cc[16], chh[16];
        unpack16(*(const v4u*)(ogla + (size_t)t * 1024 + c0), *(const v4u*)(ogla + (size_t)t * 1024 + c0 + 8), o);
        unpack16(*(const v4u*)(pr + PR + c0), *(const v4u*)(pr + PR + c0 + 8), r);
        unpack16(*(const v4u*)(pr + PCB + c0), *(const v4u*)(pr + PCB + c0 + 8), cb);
        unpack16(*(const v4u*)(pr + PCC + c0), *(const v4u*)(pr + PCC + c0 + 8), cc);
        unpack16(*(const v4u*)(pr + PCH + c0), *(const v4u*)(pr + PCH + c0 + 8), chh);
        float ss = 0.f;
#pragma unroll
        for (int i = 0; i < 16; ++i) ss += o[i] * o[i];
        ss += __shfl_xor(ss, 1); ss += __shfl_xor(ss, 2); ss += __shfl_xor(ss, 4); ss += __shfl_xor(ss, 8);
        const float rg = rsqrtf(ss * (1.0f / 256.f) + EPS);
        float val[16]; float s2 = 0.f;
#pragma unroll
        for (int i = 0; i < 16; ++i) { const float u0 = cc[i] * chh[i]; val[i] = cb[i] * (cw0[i] * u2[i] + cw1[i] * u1[i] + cw2[i] * u0); s2 += val[i] * val[i]; u2[i] = u1[i]; u1[i] = u0; }
        const float rc = rsqrtf(wave_sum(s2) * (1.0f / 1024.f) + EPS);
        v4u y0, y1, y2, y3;
#pragma unroll
        for (int j = 0; j < 4; ++j) {
            y0[j] = pk2(o[2 * j] * rg * gn[2 * j] * silu_f(r[2 * j]), o[2 * j + 1] * rg * gn[2 * j + 1] * silu_f(r[2 * j + 1]));
            y1[j] = pk2(o[8 + 2 * j] * rg * gn[8 + 2 * j] * silu_f(r[8 + 2 * j]), o[9 + 2 * j] * rg * gn[9 + 2 * j] * silu_f(r[9 + 2 * j]));
            y2[j] = pk2(val[2 * j] * rc * cn[2 * j], val[2 * j + 1] * rc * cn[2 * j + 1]);
            y3[j] = pk2(val[8 + 2 * j] * rc * cn[8 + 2 * j], val[9 + 2 * j] * rc * cn[9 + 2 * j]); }
        bf16* yr = ybuf + (size_t)t * D;
        *(v4u*)(yr + c0) = y0; *(v4u*)(yr + c0 + 8) = y1; *(v4u*)(yr + 1024 + c0) = y2; *(v4u*)(yr + 1024 + c0 + 8) = y3;
    }
}

__device__ __forceinline__ void ln1_chunk(const Args& a, int l, LAS unsigned char* lds, int lane, int wave, int ch) {
    const float* zbuf = (const float*)(a.ws + WS_Z); const float* mod = (const float*)(a.ws + WS_MOD);
    const int b = ch / NCH; const float* mb = mod + ((size_t)l * NB + b) * 6 * D;
#pragma unroll 2
    for (int it = 0; it < 8; ++it) { const int t = ch * 64 + wave * 8 + it;
        float z[32];
#pragma unroll
        for (int c = 0; c < 8; ++c) { const f32x4 v0 = *(const f32x4*)(zbuf + (size_t)t * D + (c * 64 + lane) * 4); z[c * 4] = v0.x; z[c * 4 + 1] = v0.y; z[c * 4 + 2] = v0.z; z[c * 4 + 3] = v0.w; }
        ln_tail(z, t, lane, a.in[11] + (size_t)l * D, a.in[12] + (size_t)l * D, (float*)(a.ws + WS_X1), mb + 3 * D, mb + 4 * D, (bf16*)(a.ws + WS_H2), a.ws + WS_HQ8, (float*)(a.ws + WS_HSC), lds + wave * 2304);
    }
}

template <int N> __device__ __forceinline__ void bitonic_sort_desc(float (&v)[N]) {
#pragma unroll
    for (int k = 2; k <= N; k <<= 1)
#pragma unroll
        for (int j = k >> 1; j > 0; j >>= 1)
#pragma unroll
            for (int i = 0; i < N; ++i) { const int p = i ^ j; if (p > i) { const bool desc = ((i & k) == 0); const float x = v[i], y = v[p]; const float mx = fmaxf(x, y), mn = fminf(x, y); v[i] = desc ? mx : mn; v[p] = desc ? mn : mx; } }
}
__device__ __forceinline__ void merge_top16(float (&x)[16], const float (&y)[16]) {
#pragma unroll
    for (int i = 0; i < 16; ++i) x[i] = fmaxf(x[i], y[15 - i]);
#pragma unroll
    for (int j = 8; j > 0; j >>= 1)
#pragma unroll
        for (int i = 0; i < 16; ++i) { const int p = i ^ j; if (p > i) { const float u = x[i], w = x[p]; x[i] = fmaxf(u, w); x[p] = fminf(u, w); } }
}
__device__ __forceinline__ void ce_desc(float& ka, int& pa, float& kb, int& pb) { const bool sw = kb > ka; const float k0 = sw ? kb : ka, k1 = sw ? ka : kb; const int p0 = sw ? pb : pa, p1 = sw ? pa : pb; ka = k0; pa = p0; kb = k1; pb = p1; }
__device__ __forceinline__ void bitonic_sort_desc_kp(float (&k)[16], int (&p)[16]) {
#pragma unroll
    for (int kk = 2; kk <= 16; kk <<= 1)
#pragma unroll
        for (int j = kk >> 1; j > 0; j >>= 1)
#pragma unroll
            for (int i = 0; i < 16; ++i) { const int q = i ^ j; if (q > i) { if ((i & kk) == 0) ce_desc(k[i], p[i], k[q], p[q]); else ce_desc(k[q], p[q], k[i], p[i]); } }
}
__device__ __forceinline__ void merge_top16_kp(float (&k)[16], int (&p)[16], const float (&k2)[16], const int (&p2)[16]) {
#pragma unroll
    for (int i = 0; i < 16; ++i) { const bool sw = k2[15 - i] > k[i]; k[i] = sw ? k2[15 - i] : k[i]; p[i] = sw ? p2[15 - i] : p[i]; }
#pragma unroll
    for (int j = 8; j > 0; j >>= 1)
#pragma unroll
        for (int i = 0; i < 16; ++i) { const int q = i ^ j; if (q > i) ce_desc(k[i], p[i], k[q], p[q]); }
}
__device__ constexpr int cand_i(int s) { return s < 16 ? 0 : s < 24 ? 1 : s < 29 ? 2 : s < 33 ? 3 : s < 36 ? 4 : s < 38 ? 5 : s < 40 ? 6 : s < 42 ? 7 : s < 50 ? s - 34 : -1; }
__device__ constexpr int cand_j(int s) { return s < 16 ? s : s < 24 ? s - 16 : s < 29 ? s - 24 : s < 33 ? s - 29 : s < 36 ? s - 33 : s < 38 ? s - 36 : s < 40 ? s - 38 : s < 42 ? s - 40 : s < 50 ? 0 : -1; }

__device__ __forceinline__ void peer_retrieve(const Args& a, int l, LAS unsigned char* lds, int lane, int wave, int ch) {
    const bf16* qbuf = (const bf16*)(a.ws + WS_Q); const bf16* keys = (const bf16*)(a.ws + WS_KEYS) + ((size_t)(l * 8 + wave) * 2) * 128 * 128;
    LAS int* eg_e = (LAS int*)lds; LAS float* eg_g = (LAS float*)(lds + 32768);
    const int l31 = lane & 31, l5 = lane >> 5, h = wave, t0 = ch * 64;
    for (int tt = 0; tt < 2; ++tt) {
        float sv[2][16];
#pragma unroll
        for (int p = 0; p < 2; ++p) {
            f32x16 acc[4];
#pragma unroll
            for (int nt = 0; nt < 4; ++nt)
#pragma unroll
                for (int r = 0; r < 16; ++r) acc[nt][r] = 0.f;
            const bf16* qp = qbuf + (size_t)(t0 + 32 * tt + l31) * D + h * 256 + p * 128 + 8 * l5;
            const bf16* kp = keys + (size_t)(p * 128 + l31) * 128 + 8 * l5;
#pragma unroll 2
            for (int ks = 0; ks < 8; ++ks) { const bf16x8 bq = *(const bf16x8*)(qp + 16 * ks);
#pragma unroll
                for (int nt = 0; nt < 4; ++nt) { const bf16x8 ak = *(const bf16x8*)(kp + (size_t)(32 * nt) * 128 + 16 * ks); acc[nt] = __builtin_amdgcn_mfma_f32_32x32x16_bf16(ak, bq, acc[nt], 0, 0, 0); } }
            float v[4][16];
#pragma unroll
            for (int nt = 0; nt < 4; ++nt)
#pragma unroll
                for (int r = 0; r < 16; ++r) { const unsigned idx = 32u * nt + (r & 3) + 8u * (r >> 2) + 4u * l5; v[nt][r] = __uint_as_float((__float_as_uint(acc[nt][r]) & 0xffffff80u) | idx); }
#pragma unroll
            for (int nt = 0; nt < 4; ++nt) bitonic_sort_desc<16>(v[nt]);
            merge_top16(v[0], v[1]); merge_top16(v[2], v[3]); merge_top16(v[0], v[2]);
            float o[16];
#pragma unroll
            for (int i = 0; i < 16; ++i) o[i] = __shfl_xor(v[0][i], 32);
            merge_top16(v[0], o);
#pragma unroll
            for (int i = 0; i < 16; ++i) sv[p][i] = v[0][i];
        }
        LAS unsigned char* idxb = (LAS unsigned char*)(lds + 69632) + wave * 2048 + lane * 32;
        { v4u w0, w1;
#pragma unroll
          for (int q4 = 0; q4 < 4; ++q4) {
              w0[q4] = (__float_as_uint(sv[0][4 * q4]) & 127u) | ((__float_as_uint(sv[0][4 * q4 + 1]) & 127u) << 8) | ((__float_as_uint(sv[0][4 * q4 + 2]) & 127u) << 16) | ((__float_as_uint(sv[0][4 * q4 + 3]) & 127u) << 24);
              w1[q4] = (__float_as_uint(sv[1][4 * q4]) & 127u) | ((__float_as_uint(sv[1][4 * q4 + 1]) & 127u) << 8) | ((__float_as_uint(sv[1][4 * q4 + 2]) & 127u) << 16) | ((__float_as_uint(sv[1][4 * q4 + 3]) & 127u) << 24); }
          *(LAS v4u*)(idxb) = w0; *(LAS v4u*)(idxb + 16) = w1; }
        float ck[4][16];
#pragma unroll
        for (int s = 0; s < 64; ++s) {
            if (cand_i(s) >= 0) { const unsigned b0 = __float_as_uint(sv[0][cand_i(s) < 0 ? 0 : cand_i(s)]), b1 = __float_as_uint(sv[1][cand_j(s) < 0 ? 0 : cand_j(s)]);
                const float sum = __uint_as_float(b0 & 0xffffff80u) + __uint_as_float(b1 & 0xffffff80u);
                ck[s >> 4][s & 15] = __uint_as_float((__float_as_uint(sum) & 0xffffff00u) | (unsigned)((cand_i(s) < 0 ? 0 : cand_i(s)) * 16 + (cand_j(s) < 0 ? 0 : cand_j(s)))); }
            else ck[s >> 4][s & 15] = -3.0e38f; }
        bitonic_sort_desc<16>(ck[1]); bitonic_sort_desc<16>(ck[2]);
        merge_top16(ck[0], ck[1]); merge_top16(ck[2], ck[3]); merge_top16(ck[0], ck[2]);
        LDS_WAIT(); asm volatile("" ::: "memory");
        float ex[16]; int ce[16]; float den = 0.f;
        const float cmax = __uint_as_float(__float_as_uint(ck[0][0]) & 0xffffff00u);
#pragma unroll
        for (int i = 0; i < 16; ++i) { const unsigned bits = __float_as_uint(ck[0][i]); ex[i] = __expf(__uint_as_float(bits & 0xffffff00u) - cmax); den += ex[i];
            ce[i] = (int)idxb[(bits >> 4) & 15u] * 128 + (int)idxb[16 + (bits & 15u)]; }
        const float inv = 1.0f / den;
        if (l5 == 0) {
            const int base = (32 * tt + l31) * 128 + h * 16;
#pragma unroll
            for (int i4 = 0; i4 < 4; ++i4) { *(LAS v4u*)(eg_e + base + 4 * i4) = (v4u){(unsigned)ce[4 * i4], (unsigned)ce[4 * i4 + 1], (unsigned)ce[4 * i4 + 2], (unsigned)ce[4 * i4 + 3]};
                *(LAS f32x4*)(eg_g + base + 4 * i4) = (f32x4){ex[4 * i4] * inv, ex[4 * i4 + 1] * inv, ex[4 * i4 + 2] * inv, ex[4 * i4 + 3] * inv}; }
        }
        LDS_WAIT(); asm volatile("" ::: "memory");
    }
}

typedef unsigned char uc4 __attribute__((ext_vector_type(4)));
constexpr int NSLICE = 16, SLICE_SHIFT = 10;
__device__ __forceinline__ int sdot4i(unsigned w, unsigned x, int acc) { return __builtin_amdgcn_sdot4((int)w, (int)x, acc, false); }
__device__ __forceinline__ void fma_ub4(unsigned w, float s, float& y0, float& y1, float& y2, float& y3) { const uc4 b = __builtin_bit_cast(uc4, w); y0 += s * (float)b.x; y1 += s * (float)b.y; y2 += s * (float)b.z; y3 += s * (float)b.w; }
#if TAB4
__device__ __forceinline__ void peer_tail(const Args& a, int l, int t, int lane, const bf16* Yrow, const float* mb, const float* mbn, bool last) {
    const float* x1buf = (const float*)(a.ws + WS_X1);
    float z[32];
#pragma unroll
    for (int c8 = 0; c8 < 8; ++c8) { const int col = (c8 * 64 + lane) * 4;
        const v2u yb = *(const v2u*)(Yrow + col); const f32x4 yv = (f32x4){bflo(yb.x), bfhi(yb.x), bflo(yb.y), bfhi(yb.y)};
        const f32x4 x0 = *(const f32x4*)(x1buf + (size_t)t * D + col), g0 = *(const f32x4*)(mb + 5 * D + col);
        z[c8 * 4] = ALPHA * x0.x + (1.f + g0.x) * yv.x; z[c8 * 4 + 1] = ALPHA * x0.y + (1.f + g0.y) * yv.y; z[c8 * 4 + 2] = ALPHA * x0.z + (1.f + g0.z) * yv.z; z[c8 * 4 + 3] = ALPHA * x0.w + (1.f + g0.w) * yv.w; }
    ln_tail(z, t, lane, a.in[17] + (size_t)l * D, a.in[18] + (size_t)l * D, last ? a.out : (float*)(a.ws + WS_X), mbn, mbn + D, last ? (bf16*)nullptr : (bf16*)(a.ws + WS_H), nullptr, nullptr);
}
template <class TT, int N, int M> __device__ __forceinline__ void treduce(TT (&v)[N], int lane) {
    const bool c0 = (lane & M) != 0, c1 = (lane & (2 * M)) != 0, c2 = (lane & (4 * M)) != 0;
#pragma unroll
    for (int m = 0; m < N / 2; ++m) { const TT keep = c0 ? v[2 * m + 1] : v[2 * m], send = c0 ? v[2 * m] : v[2 * m + 1]; v[m] = keep + __shfl_xor(send, M); }
#pragma unroll
    for (int m = 0; m < N / 4; ++m) { const TT keep = c1 ? v[2 * m + 1] : v[2 * m], send = c1 ? v[2 * m] : v[2 * m + 1]; v[m] = keep + __shfl_xor(send, 2 * M); }
#pragma unroll
    for (int m = 0; m < N / 8; ++m) { const TT keep = c2 ? v[2 * m + 1] : v[2 * m], send = c2 ? v[2 * m] : v[2 * m + 1]; v[m] = keep + __shfl_xor(send, 4 * M); }
}
__device__ __forceinline__ void tr4x4(unsigned a, unsigned b, unsigned c, unsigned d, unsigned& t0, unsigned& t1, unsigned& t2, unsigned& t3) {
    const unsigned x0 = __builtin_amdgcn_perm(b, a, 0x05010400u), x1 = __builtin_amdgcn_perm(b, a, 0x07030602u), y0 = __builtin_amdgcn_perm(d, c, 0x05010400u), y1 = __builtin_amdgcn_perm(d, c, 0x07030602u);
    t0 = __builtin_amdgcn_perm(y0, x0, 0x05040100u); t1 = __builtin_amdgcn_perm(y0, x0, 0x07060302u); t2 = __builtin_amdgcn_perm(y1, x1, 0x05040100u); t3 = __builtin_amdgcn_perm(y1, x1, 0x07060302u);
}
__device__ __forceinline__ int sdot8i(unsigned w, unsigned x, int acc) { return __builtin_amdgcn_sdot8((int)w, (int)x, acc, false); }
__device__ __forceinline__ float slot_scale(unsigned w3) { return __builtin_amdgcn_exp2f((float)(w3 >> 24) * 0.125f - 16.0f); }
__device__ __forceinline__ void peer_experts(const Args& a, int l, LAS unsigned char* lds, int lane0, int wave, int ch) {
    const float* mod = (const float*)(a.ws + WS_MOD);
    const unsigned char* ut = a.ws + WS_UT + (size_t)l * NE * 1152; const unsigned char* vt = a.ws + WS_VT + (size_t)l * NE * 1152; const unsigned char* hq8 = a.ws + WS_HQ8;
    const float* hsc = (const float*)(a.ws + WS_HSC);
    bf16* Ybuf = (bf16*)(a.ws + WS_Z);
    const LAS int* eg_e = (const LAS int*)lds; LAS float* sw = (LAS float*)(lds + 32768);
    LAS float* apart = (LAS float*)(lds + 65536);
    const int b = ch / NCH; const bool last = (l == NL - 1);
    const float* mb = mod + ((size_t)l * NB + b) * 6 * D; const float* mbn = mod + ((size_t)(last ? l : l + 1) * NB + b) * 6 * D;
    const int tlw = wave * 8;
    { const int lane = lane0;
#pragma unroll
      for (int i = 0; i < 16; ++i) apart[tlw * 128 + i * 64 + lane] = 0.f; }
    LDS_WAIT(); asm volatile("" ::: "memory");
    {
        int laneL = lane0; asm volatile("" : "+v"(laneL)); const int lane = laneL;
        const int g = lane >> 3, l7 = lane & 7;
        v4u bufA[16], bufB[16], hA0, hA1, hB0, hB1;
#define CU_LOAD(buf, h0_, h1_, idx_) do { const int u_ = (idx_) >> 3, tl_ = tlw + ((idx_) & 7); const unsigned soff_ = (unsigned)(u_ * 128 + l7 * 16); \
            const unsigned char* hp_ = hq8 + (size_t)(ch * 64 + tl_) * 2304 + (u_ * 8 + l7) * 32; h0_ = *(const v4u*)hp_; h1_ = *(const v4u*)(hp_ + 16); \
            _Pragma("unroll") for (int i_ = 0; i_ < 16; ++i_) { const unsigned e_ = (unsigned)eg_e[tl_ * 128 + 8 * i_ + g]; buf[i_] = *(const v4u*)(ut + (size_t)(e_ * 1152u + soff_)); } } while (0)
#define CU_COMP(buf, h0_, h1_, idx_) do { const int tl_ = tlw + ((idx_) & 7); float accv_[16]; \
            _Pragma("unroll") for (int i_ = 0; i_ < 16; ++i_) { int sl_ = 0, sh_ = 0; \
                _Pragma("unroll") for (int d_ = 0; d_ < 4; ++d_) { const unsigned x_ = buf[i_][d_] ^ 0x88888888u; sl_ = sdot8i(x_, h0_[d_], sl_); sh_ = sdot8i(x_, h1_[d_], sh_); } \
                accv_[i_] = slot_scale(buf[i_][3]) * (float)(16 * sh_ + sl_); } \
            treduce<float, 16, 1>(accv_, lane); \
            apart[tl_ * 128 + 8 * l7 + g] += accv_[0]; apart[tl_ * 128 + 8 * (8 + l7) + g] += accv_[1]; } while (0)
        CU_LOAD(bufA, hA0, hA1, 0);
        for (int idx = 0; idx < 72; idx += 2) {
            CU_LOAD(bufB, hB0, hB1, idx + 1);
            CU_COMP(bufA, hA0, hA1, idx);
            { const int nx_ = idx + 2 < 72 ? idx + 2 : 71; CU_LOAD(bufA, hA0, hA1, nx_); }
            CU_COMP(bufB, hB0, hB1, idx + 1);
        }
#undef CU_LOAD
#undef CU_COMP
        LDS_WAIT(); asm volatile("" ::: "memory");
        for (int it = 0; it < 8; ++it) { const int tl = tlw + it; const float shs = hsc[ch * 64 + tl];
            const float w0 = sw[tl * 128 + lane] * gelu_tanh_f(apart[tl * 128 + lane] * shs), w1 = sw[tl * 128 + 64 + lane] * gelu_tanh_f(apart[tl * 128 + 64 + lane] * shs);
            sw[tl * 128 + lane] = w0; sw[tl * 128 + 64 + lane] = w1; }
        LDS_WAIT(); asm volatile("" ::: "memory");
    }
    {
        int laneL = lane0; asm volatile("" : "+v"(laneL)); const int lane = laneL;
        const int g = lane >> 3, l7 = lane & 7;
        v4u bufA[16], bufB[16];
#define CV_LOAD(buf, idx_) do { const int u_ = (idx_) >> 3, tl_ = tlw + ((idx_) & 7); const unsigned soff_ = (unsigned)(u_ * 128 + l7 * 16); \
            _Pragma("unroll") for (int i_ = 0; i_ < 16; ++i_) { const unsigned e_ = (unsigned)eg_e[tl_ * 128 + 8 * i_ + g]; buf[i_] = *(const v4u*)(vt + (size_t)(e_ * 1152u + soff_)); } } while (0)
#define CV_COMP(buf, idx_) do { const int u_ = (idx_) >> 3, tl_ = tlw + ((idx_) & 7); \
            float wf_[16]; float wmx_ = 0.f; \
            _Pragma("unroll") for (int i_ = 0; i_ < 16; ++i_) { wf_[i_] = sw[tl_ * 128 + 8 * i_ + g] * slot_scale(buf[i_][3]); wmx_ = fmaxf(wmx_, fabsf(wf_[i_])); } \
            wmx_ = fmaxf(wmx_, __shfl_xor(wmx_, 8)); wmx_ = fmaxf(wmx_, __shfl_xor(wmx_, 16)); wmx_ = fmaxf(wmx_, __shfl_xor(wmx_, 32));     \
            const float winv_ = wmx_ > 0.f ? 127.0f / wmx_ : 0.f, wsc_ = wmx_ * (1.0f / 127.0f); \
              \
            unsigned wq4_[4]; int wsum_ = 0; \
            _Pragma("unroll") for (int gp_ = 0; gp_ < 4; ++gp_) { \
                const unsigned m0_ = __float_as_uint(wf_[4 * gp_] * winv_ + 12582912.0f), m1_ = __float_as_uint(wf_[4 * gp_ + 1] * winv_ + 12582912.0f), m2_ = __float_as_uint(wf_[4 * gp_ + 2] * winv_ + 12582912.0f), m3_ = __float_as_uint(wf_[4 * gp_ + 3] * winv_ + 12582912.0f); \
                wq4_[gp_] = __builtin_amdgcn_perm(__builtin_amdgcn_perm(m3_, m2_, 0x0c0c0400u), __builtin_amdgcn_perm(m1_, m0_, 0x0c0c0400u), 0x05040100u); \
                wsum_ = sdot4i(wq4_[gp_], 0x01010101u, wsum_); } \
            int yi_[32]; \
            _Pragma("unroll") for (int q_ = 0; q_ < 32; ++q_) yi_[q_] = 0; \
            _Pragma("unroll") for (int gp_ = 0; gp_ < 4; ++gp_) { \
                _Pragma("unroll") for (int d_ = 0; d_ < 4; ++d_) { const unsigned A_ = buf[4 * gp_][d_], B_ = buf[4 * gp_ + 1][d_], C_ = buf[4 * gp_ + 2][d_], D_ = buf[4 * gp_ + 3][d_]; \
                    unsigned t0_, t1_, t2_, t3_; \
                    tr4x4(A_, B_, C_, D_, t0_, t1_, t2_, t3_);     \
                    yi_[8 * d_]     = sdot4i(t0_ & 0x0f0f0f0fu, wq4_[gp_], yi_[8 * d_]);     yi_[8 * d_ + 1] = sdot4i((t0_ >> 4) & 0x0f0f0f0fu, wq4_[gp_], yi_[8 * d_ + 1]); \
                    yi_[8 * d_ + 2] = sdot4i(t1_ & 0x0f0f0f0fu, wq4_[gp_], yi_[8 * d_ + 2]); yi_[8 * d_ + 3] = sdot4i((t1_ >> 4) & 0x0f0f0f0fu, wq4_[gp_], yi_[8 * d_ + 3]); \
                    yi_[8 * d_ + 4] = sdot4i(t2_ & 0x0f0f0f0fu, wq4_[gp_], yi_[8 * d_ + 4]); yi_[8 * d_ + 5] = sdot4i((t2_ >> 4) & 0x0f0f0f0fu, wq4_[gp_], yi_[8 * d_ + 5]); \
                    yi_[8 * d_ + 6] = sdot4i(t3_ & 0x0f0f0f0fu, wq4_[gp_], yi_[8 * d_ + 6]); yi_[8 * d_ + 7] = sdot4i((t3_ >> 4) & 0x0f0f0f0fu, wq4_[gp_], yi_[8 * d_ + 7]); } } \
            treduce<int, 32, 8>(yi_, lane); \
            wsum_ += __shfl_xor(wsum_, 8); wsum_ += __shfl_xor(wsum_, 16); wsum_ += __shfl_xor(wsum_, 32);     \
            float y_[4]; \
            _Pragma("unroll") for (int q_ = 0; q_ < 4; ++q_) y_[q_] = wsc_ * (float)(yi_[q_] - 8 * wsum_); \
            { const int colb_ = u_ * 240 + l7 * 30 + g; bf16* yr_ = Ybuf + (size_t)(ch * 64 + tl_) * D + colb_; \
              _Pragma("unroll") for (int m_ = 0; m_ < 4; ++m_) if (8 * m_ + g < 30 && colb_ + 8 * m_ < D) yr_[8 * m_] = (bf16)(pk2(y_[m_], 0.f) & 0xffffu); } } while (0)
        CV_LOAD(bufA, 0);
        for (int idx = 0; idx < 72; idx += 2) {
            CV_LOAD(bufB, idx + 1);
            CV_COMP(bufA, idx);
            { const int nx_ = idx + 2 < 72 ? idx + 2 : 71; CV_LOAD(bufA, nx_); }
            CV_COMP(bufB, idx + 1);
        }
#undef CV_LOAD
#undef CV_COMP
    }
    asm volatile("s_waitcnt vmcnt(0)" ::: "memory");
    __builtin_amdgcn_fence(__ATOMIC_ACQUIRE, "agent");
    asm volatile("s_waitcnt vmcnt(0)" ::: "memory");
    for (int it = 0; it < 8; ++it) { int laneT = lane0; asm volatile("" : "+v"(laneT)); const int t = ch * 64 + tlw + it;
        peer_tail(a, l, t, laneT, Ybuf + (size_t)t * D, mb, mbn, last); }
}
#else
__device__ __forceinline__ void peer_tail(const Args& a, int l, int t, int lane, const float* Yrow, const float* mb, const float* mbn, bool last) {
    const float* x1buf = (const float*)(a.ws + WS_X1);
    float z[32];
#pragma unroll
    for (int c = 0; c < 2; ++c)
#pragma unroll
        for (int k = 0; k < 4; ++k) { const int c8 = 4 * c + k, col = (c8 * 64 + lane) * 4;
            const v2u yb = *(const v2u*)((const bf16*)Yrow + (c * 64 + lane) * 16 + 4 * k); const f32x4 yv = (f32x4){bflo(yb.x), bfhi(yb.x), bflo(yb.y), bfhi(yb.y)};
            const f32x4 x0 = *(const f32x4*)(x1buf + (size_t)t * D + col), g0 = *(const f32x4*)(mb + 5 * D + col);
            z[c8 * 4] = ALPHA * x0.x + (1.f + g0.x) * yv.x; z[c8 * 4 + 1] = ALPHA * x0.y + (1.f + g0.y) * yv.y; z[c8 * 4 + 2] = ALPHA * x0.z + (1.f + g0.z) * yv.z; z[c8 * 4 + 3] = ALPHA * x0.w + (1.f + g0.w) * yv.w; }
    ln_tail(z, t, lane, a.in[17] + (size_t)l * D, a.in[18] + (size_t)l * D, last ? a.out : (float*)(a.ws + WS_X), mbn, mbn + D, last ? (bf16*)nullptr : (bf16*)(a.ws + WS_H), nullptr, nullptr);
}
template <class TT, int M> __device__ __forceinline__ void treduce16(TT (&v)[16], int lane) {
    const bool c0 = (lane & M) != 0, c1 = (lane & (2 * M)) != 0, c2 = (lane & (4 * M)) != 0;
#pragma unroll
    for (int m = 0; m < 8; ++m) { const TT keep = c0 ? v[2 * m + 1] : v[2 * m], send = c0 ? v[2 * m] : v[2 * m + 1]; v[m] = keep + __shfl_xor(send, M); }
#pragma unroll
    for (int m = 0; m < 4; ++m) { const TT keep = c1 ? v[2 * m + 1] : v[2 * m], send = c1 ? v[2 * m] : v[2 * m + 1]; v[m] = keep + __shfl_xor(send, 2 * M); }
#pragma unroll
    for (int m = 0; m < 2; ++m) { const TT keep = c2 ? v[2 * m + 1] : v[2 * m], send = c2 ? v[2 * m] : v[2 * m + 1]; v[m] = keep + __shfl_xor(send, 4 * M); }
}
__device__ __forceinline__ void peer_experts(const Args& a, int l, LAS unsigned char* lds, int lane0, int wave, int ch) {
    const float* mod = (const float*)(a.ws + WS_MOD);
    const unsigned char* ut = a.ws + WS_UT + (size_t)l * NE * D; const unsigned char* vt = a.ws + WS_VT + (size_t)l * NE * D; const unsigned char* hq8 = a.ws + WS_HQ8;
    const float* su = (const float*)(a.ws + WS_SU) + (size_t)l * NE; const float* sv = (const float*)(a.ws + WS_SV) + (size_t)l * NE; const float* hsc = (const float*)(a.ws + WS_HSC);
    float* Ybuf = (float*)(a.ws + WS_Z);
    const LAS int* eg_e = (const LAS int*)lds; LAS float* sw = (LAS float*)(lds + 32768);
    LAS int* apart = (LAS int*)(lds + 65536); LAS float* wtotl = (LAS float*)(lds + LDSCTL_OFF + 256);
    const int b = ch / NCH; const bool last = (l == NL - 1);
    const float* mb = mod + ((size_t)l * NB + b) * 6 * D; const float* mbn = mod + ((size_t)(last ? l : l + 1) * NB + b) * 6 * D;
    const int tlw = wave * 8;
    { const int lane = lane0;
#pragma unroll
      for (int i = 0; i < 16; ++i) apart[tlw * 128 + i * 64 + lane] = 0; }
    LDS_WAIT(); asm volatile("" ::: "memory");
    {
        int laneL = lane0; asm volatile("" : "+v"(laneL)); const int lane = laneL;
        const int g = lane >> 3, l7 = lane & 7;
        v4u bufA[16], bufB[16], hA, hB;
#define CU_LOAD(buf, hh_, idx_) do { const int cs_ = (idx_) >> 3, tl_ = tlw + ((idx_) & 7); const unsigned coff_ = (unsigned)(cs_ * 128 + l7 * 16); \
            hh_ = *(const v4u*)(hq8 + (size_t)(ch * 64 + tl_) * D + coff_); \
            _Pragma("unroll") for (int i_ = 0; i_ < 16; ++i_) { const unsigned e_ = (unsigned)eg_e[tl_ * 128 + 8 * i_ + g]; buf[i_] = *(const v4u*)(ut + (size_t)(e_ * 2048u + coff_)); } } while (0)
#define CU_COMP(buf, hh_, idx_) do { const int tl_ = tlw + ((idx_) & 7); int acc_[16]; \
            _Pragma("unroll") for (int i_ = 0; i_ < 16; ++i_) { int s_ = 0; _Pragma("unroll") for (int q_ = 0; q_ < 4; ++q_) s_ = sdot4i(buf[i_][q_], hh_[q_], s_); acc_[i_] = s_; } \
            treduce16<int, 1>(acc_, lane); \
            apart[tl_ * 128 + 8 * l7 + g] += acc_[0]; apart[tl_ * 128 + 8 * (8 + l7) + g] += acc_[1]; } while (0)
        CU_LOAD(bufA, hA, 0);
        for (int idx = 0; idx < 128; idx += 2) {
            CU_LOAD(bufB, hB, idx + 1);
            CU_COMP(bufA, hA, idx);
            if (idx + 2 < 128) CU_LOAD(bufA, hA, idx + 2);
            CU_COMP(bufB, hB, idx + 1);
        }
#undef CU_LOAD
#undef CU_COMP
        LDS_WAIT(); asm volatile("" ::: "memory");
        for (int it = 0; it < 8; ++it) { const int tl = tlw + it; const float shs = hsc[ch * 64 + tl];
            const int e0 = eg_e[tl * 128 + lane], e1 = eg_e[tl * 128 + 64 + lane];
            const float w0 = sw[tl * 128 + lane] * gelu_tanh_f((float)apart[tl * 128 + lane] * su[e0] * shs) * sv[e0];
            const float w1 = sw[tl * 128 + 64 + lane] * gelu_tanh_f((float)apart[tl * 128 + 64 + lane] * su[e1] * shs) * sv[e1];
            sw[tl * 128 + lane] = w0; sw[tl * 128 + 64 + lane] = w1;
            const float ws = wave_sum(w0 + w1);
            if (lane == 0) wtotl[tl] = ws; }
        LDS_WAIT(); asm volatile("" ::: "memory");
    }
    {
        int laneL = lane0; asm volatile("" : "+v"(laneL)); const int lane = laneL;
        const int g = lane >> 3, l7 = lane & 7;
        v4u bufA[16], bufB[16];
#define CV_LOAD(buf, idx_) do { const int cs_ = (idx_) >> 3, tl_ = tlw + ((idx_) & 7); const unsigned coff_ = (unsigned)(cs_ * 128 + l7 * 16); \
            _Pragma("unroll") for (int i_ = 0; i_ < 16; ++i_) { const unsigned e_ = (unsigned)eg_e[tl_ * 128 + 8 * i_ + g]; buf[i_] = *(const v4u*)(vt + (size_t)(e_ * 2048u + coff_)); } } while (0)
#define CV_COMP(buf, idx_) do { const int cs_ = (idx_) >> 3, tl_ = tlw + ((idx_) & 7); float y_[16]; \
            _Pragma("unroll") for (int q_ = 0; q_ < 16; ++q_) y_[q_] = 0.f; \
            _Pragma("unroll") for (int i_ = 0; i_ < 16; ++i_) { const float wr_ = sw[tl_ * 128 + 8 * i_ + g]; \
                _Pragma("unroll") for (int q_ = 0; q_ < 4; ++q_) fma_ub4(buf[i_][q_], wr_, y_[4 * q_], y_[4 * q_ + 1], y_[4 * q_ + 2], y_[4 * q_ + 3]); } \
            treduce16<float, 8>(y_, lane); \
            const float woff_ = 128.0f * wtotl[tl_]; bf16* yr_ = (bf16*)Ybuf + (size_t)(ch * 64 + tl_) * D + cs_ * 128 + l7 * 16 + g; \
            yr_[0] = (bf16)(pk2(y_[0] - woff_, 0.f) & 0xffffu); yr_[8] = (bf16)(pk2(y_[1] - woff_, 0.f) & 0xffffu); } while (0)
        CV_LOAD(bufA, 0);
        for (int idx = 0; idx < 128; idx += 2) {
            CV_LOAD(bufB, idx + 1);
            CV_COMP(bufA, idx);
            if (idx + 2 < 128) CV_LOAD(bufA, idx + 2);
            CV_COMP(bufB, idx + 1);
        }
#undef CV_LOAD
#undef CV_COMP
    }
    asm volatile("s_waitcnt vmcnt(0)" ::: "memory");
    __builtin_amdgcn_fence(__ATOMIC_ACQUIRE, "agent");
    asm volatile("s_waitcnt vmcnt(0)" ::: "memory");
    for (int it = 0; it < 8; ++it) { int laneT = lane0; asm volatile("" : "+v"(laneT)); const int t = ch * 64 + tlw + it;
        peer_tail(a, l, t, laneT, (const float*)((const bf16*)Ybuf + (size_t)t * D), mb, mbn, last); }
}

#endif

#ifndef MK_PER_PHASE
#define MK_PER_PHASE 0
#endif
__global__ void __launch_bounds__(NTHREADS, 2) mk_fwd(Args a) {
    extern __shared__ __attribute__((aligned(16))) unsigned char lds_raw[];
    LAS unsigned char* lds = (LAS unsigned char*)lds_raw;
    const int tid = threadIdx.x, lane = tid & 63, wave = __builtin_amdgcn_readfirstlane(tid >> 6), G = gridDim.x, bx = blockIdx.x;
    if (tid < 64) ((LAS unsigned*)(lds + LDSCTL_OFF))[tid] = 0u;
    __syncthreads();
    unsigned* ctl = (unsigned*)(a.ws + WS_CTL);
    XcdBarrier bar; bar.bar = ctl + CW_BAR; bar.x = 0; bar.st = nullptr;
    const bool use_bar = (a.ph_hi - a.ph_lo) > 1;
    if (use_bar) bar = xcd_barrier_post(ctl + CW_BAR, (volatile LAS unsigned*)(lds + LDSCTL_OFF));
    const int lo = a.ph_lo, hi = a.ph_hi;
#ifndef PH_MASK
#define PH_MASK 0x1ff
#endif
#define IN(k) (lo <= (k) && (k) < hi)
#define EN(b) ((PH_MASK >> (b)) & 1)
#ifndef REP_MASK
#define REP_MASK 0
#endif
#ifndef REP_EXTRA
#define REP_EXTRA 2
#endif
#define REPS(b) (1 + ((REP_MASK >> (b)) & 1) * REP_EXTRA)
#define REP_BEGIN(b) for (int rep_ = 0; rep_ < REPS(b); ++rep_) {
#define REP_END(b) if (rep_ + 1 < REPS(b)) xcd_barrier(bar); }
#define SEAM(k) do { if (IN((k) + 1)) xcd_barrier(bar); } while (0)
#define PHASE_IDS() int tidp = tid; asm volatile("" : "+v"(tidp)); const int lanep = tidp & 63, wavep = __builtin_amdgcn_readfirstlane(tidp >> 6); (void)lanep; (void)wavep
    if (EN(0) && IN(0)) { REP_BEGIN(0) PHASE_IDS(); ph_prologue_a(a, lds, tidp, lanep, wavep, bx, G); REP_END(0) SEAM(0); }
    if (EN(1) && IN(1)) { REP_BEGIN(1) PHASE_IDS(); ph_prologue_b(a, lds, tidp, lanep, wavep, bx, G); REP_END(1) SEAM(1); }
    for (int l = 0; l < NL; ++l) {
        const int pb = 2 + 7 * l;
        const float* mod = (const float*)(a.ws + WS_MOD);
        if (EN(2) && IN(pb + 0)) {
            REP_BEGIN(2) PHASE_IDS();
            pg8::Gemm g{(const pg8::bf16_t*)(a.ws + WS_H), (const pg8::bf16_t*)(a.ws + WS_WIN) + (size_t)l * INW * D, T, NP, D}; pg8::StaticOrder S; S.init(T, NP, G, bx, WGM_IN);
            pg8::EpiBf16P E{(pg8::bf16_t*)(a.ws + WS_PROJ), NP};
            pg8::gemm_phase<pg8::EpiBf16P, pg8::StaticOrder, true, true>(lds + RING_OFF, g, S, E, tidp);
            for (int ch = bx; ch < NCHUNK; ch += G) gate_prep(a, l, lds, tidp, lanep, wavep, ch);
            REP_END(2) SEAM(pb + 0);
        }
        if (EN(3) && IN(pb + 1)) { REP_BEGIN(3) PHASE_IDS(); for (int un = bx; un < 256; un += G) gla_unit(a, lds, tidp, lanep, wavep, un); REP_END(3) SEAM(pb + 1); }
        if (EN(4) && IN(pb + 2)) { REP_BEGIN(4) PHASE_IDS(); for (int ch = bx; ch < NCHUNK; ch += G) mixpost_chunk(a, l, lanep, wavep, ch); REP_END(4) SEAM(pb + 2); }
        if (EN(5) && IN(pb + 3)) {
            REP_BEGIN(5) PHASE_IDS();
            pg8::Gemm g{(const pg8::bf16_t*)(a.ws + WS_Y), (const pg8::bf16_t*)(a.ws + WS_WOUT) + (size_t)l * D * D, T, D, D}; pg8::StaticOrder S; S.init(T, D, G, bx, WGM_OUT);
            pg8::EpiResid E{(float*)(a.ws + WS_Z), l == 0 ? a.in[0] : (const float*)(a.ws + WS_X), mod + (size_t)l * NB * 6 * D + 2 * D, ALPHA};
            pg8::gemm_phase<pg8::EpiResid, pg8::StaticOrder, true, true>(lds + RING_OFF, g, S, E, tidp);
            REP_END(5) SEAM(pb + 3);
        }
        if (EN(6) && IN(pb + 4)) { REP_BEGIN(6) PHASE_IDS(); for (int ch = bx; ch < NCHUNK; ch += G) ln1_chunk(a, l, lds, lanep, wavep, ch); REP_END(6) SEAM(pb + 4); }
        if (EN(7) && IN(pb + 5)) {
            REP_BEGIN(7) PHASE_IDS();
            pg8::Gemm g{(const pg8::bf16_t*)(a.ws + WS_H2), (const pg8::bf16_t*)(a.ws + WS_WQ) + (size_t)l * D * D, T, D, D}; pg8::StaticOrder S; S.init(T, D, G, bx, WGM_WQ);
            pg8::EpiBf16P E{(pg8::bf16_t*)(a.ws + WS_Q), D};
            pg8::gemm_phase<pg8::EpiBf16P, pg8::StaticOrder, true, true>(lds + RING_OFF, g, S, E, tidp);
            REP_END(7) SEAM(pb + 5);
        }
#ifndef PEER_DBG
#define PEER_DBG 0
#endif
#ifndef PE_REP_R
#define PE_REP_R 1
#endif
#ifndef L2PROBE
#define L2PROBE 0
#endif
        if (EN(8) && IN(pb + 6)) {
            REP_BEGIN(8)
            for (int ch = bx; ch < NCHUNK; ch += G) { for (int repr_ = 0; repr_ < PE_REP_R; ++repr_) { PHASE_IDS(); peer_retrieve(a, l, lds, lanep, wavep, ch); __syncthreads(); } __syncthreads(); { PHASE_IDS(); peer_experts(a, l, lds, lanep, wavep, ch); } __syncthreads(); }
            REP_END(8) SEAM(pb + 6);
        }
    }
#undef IN
#undef SEAM
}

extern "C" void kernel_launch(void* const* d_in, const int* in_sizes, int n_in, void* d_out, int out_size, void* d_ws, size_t ws_size, hipStream_t stream) {
    static int grid = 0;
    if (grid == 0) {
        if (n_in != 19 || in_sizes[0] != T * D || out_size != T * D || ws_size < WS_END) { fprintf(stderr, "kernel_launch: unexpected shapes / workspace (%d inputs, ws %zu); nothing launched\n", n_in, ws_size); grid = -1; return; }
        int dev = 0, cus = 0, per_cu = 0;
        if (hipGetDevice(&dev) != hipSuccess || hipDeviceGetAttribute(&cus, hipDeviceAttributeMultiprocessorCount, dev) != hipSuccess) { grid = -1; return; }
        if (hipFuncSetAttribute((const void*)mk_fwd, hipFuncAttributeMaxDynamicSharedMemorySize, LDS_BYTES) != hipSuccess) { fprintf(stderr, "kernel_launch: hipFuncSetAttribute failed\n"); grid = -1; return; }
        if (hipOccupancyMaxActiveBlocksPerMultiprocessor(&per_cu, (const void*)mk_fwd, NTHREADS, LDS_BYTES) != hipSuccess || per_cu < 1) fprintf(stderr, "kernel_launch: occupancy query reports %d\n", per_cu);
        (void)hipGetLastError();
        grid = cus;
    }
    if (grid < 0) return;
    if (hipMemsetAsync((char*)d_ws + WS_CTL, 0, CTL_ZERO_BYTES, stream) != hipSuccess) return;
    Args a{};
    for (int i = 0; i < 19; ++i) a.in[i] = (const float*)d_in[i];
    a.out = (float*)d_out; a.ws = (unsigned char*)d_ws;
#if MK_PER_PHASE
    for (int p = 0; p < NPHASES; ++p) { a.ph_lo = p; a.ph_hi = p + 1; hipLaunchKernelGGL(mk_fwd, dim3(grid), dim3(NTHREADS), LDS_BYTES, stream, a); }
#else
    a.ph_lo = 0; a.ph_hi = NPHASES;
    hipLaunchKernelGGL(mk_fwd, dim3(grid), dim3(NTHREADS), LDS_BYTES, stream, a);
#endif
}
```

```cpp
#include <hip/hip_runtime.h>
#include <cstdio>
#include <cstdint>
namespace pg8 {
#define PG8_LAS __attribute__((address_space(3)))
typedef unsigned short bf16_t;
typedef short bf16x8 __attribute__((ext_vector_type(8)));
typedef float f32x4 __attribute__((ext_vector_type(4)));
typedef unsigned u32x4 __attribute__((ext_vector_type(4)));
constexpr int BM = 256, BK = 64, HALF = 128, HTB = HALF * BK * 2  , STAGE_BYTES = 8 * HTB, NXCD = 8, WGM = 8;

__host__ __device__ __forceinline__ int lds_byte(int r, int c) { const int st = (r >> 4) * 2 + (c >> 5), rr = r & 15, cc = c & 31, ob = rr * 64 + cc * 2; return st * 1024 + (ob ^ (((ob >> 9) & 1) << 5)); }
__host__ __device__ __forceinline__ void stage_rc(int b, int& R, int& C) { const int st = b / 1024, sb = b % 1024, swz = sb ^ (((sb >> 9) & 1) << 5); R = (st >> 1) * 16 + swz / 64; C = (st & 1) * 32 + (swz % 64) / 2; }
__host__ __device__ __forceinline__ int perm32(int rho) { const int n = rho >> 4, i = rho & 15; return 8 * (i >> 2) + 4 * n + (i & 3); }

struct Unit { int pm, pn; };
struct Gemm { const bf16_t* A; const bf16_t* Bt; int M, N, K; };

struct StaticOrder {
    int nM, nN, nwg, G, c, wgm;
    __host__ __device__ void init(int M, int N, int G_, int c_, int wgm_ = WGM) { nM = M / BM; nN = N / BM; nwg = nM * nN; G = G_; c = c_; wgm = wgm_; }
    __host__ __device__ bool next(int i, Unit& u) const {
        const long L = (long)i * G + c; if (L >= nwg) return false;
        int wgid = (int)L; { const int q = nwg / NXCD, r = nwg % NXCD, xcd = wgid % NXCD, off = wgid / NXCD; wgid = (xcd < r ? xcd * (q + 1) : r * (q + 1) + (xcd - r) * q) + off; }
        const int nig = wgm * nN, gid = wgid / nig, fm = gid * wgm, gsz = (nM - fm) < wgm ? (nM - fm) : wgm;
        u.pm = fm + ((wgid % nig) % gsz); u.pn = (wgid % nig) / gsz; return true;
    }
    __device__ __forceinline__ void a_ready(const Unit&) const {}
    __device__ __forceinline__ void done(const Unit&) const {}
};
typedef __bf16 bf16x2_t __attribute__((ext_vector_type(2)));
__device__ __forceinline__ unsigned cvt_pk_bf16(float lo, float hi) { bf16x2_t r; r.x = (__bf16)lo; r.y = (__bf16)hi; return __builtin_bit_cast(unsigned, r); }
struct EpiBf16P {
    static constexpr bool PERM = true, AFTER_DRAIN = false;
    bf16_t* O; int ldc;
    __device__ __forceinline__ void operator()(const f32x4 (&acc)[2][2][4][2], const Unit& u, int wr, int wc, int fr, int fq) const {
        const int row0 = u.pm * BM + wr * 64 + fr, col0 = u.pn * BM + wc * 32 + 8 * fq;
#pragma unroll
        for (int ai = 0; ai < 2; ++ai)
#pragma unroll
            for (int m = 0; m < 4; ++m) { bf16_t* rowp = O + (size_t)(row0 + ai * HALF + m * 16) * ldc + col0;
#pragma unroll
                for (int bj = 0; bj < 2; ++bj) { const f32x4 v0 = acc[ai][bj][m][0], v1 = acc[ai][bj][m][1];
                    u32x4 w; w.x = cvt_pk_bf16(v0[0], v0[1]); w.y = cvt_pk_bf16(v0[2], v0[3]); w.z = cvt_pk_bf16(v1[0], v1[1]); w.w = cvt_pk_bf16(v1[2], v1[3]);
                    *(u32x4*)(rowp + bj * HALF) = w; } }
    }
};
struct EpiResid {
    static constexpr bool PERM = false, AFTER_DRAIN = false;
    float* Z; const float* X; const float* gate; float alpha;
    __device__ __forceinline__ void operator()(const f32x4 (&acc)[2][2][4][2], const Unit& u, int wr, int wc, int fr, int fq) const {
        const int row0 = u.pm * BM + wr * 64 + fr, col0 = u.pn * BM + wc * 32 + 4 * fq;
        const float* gb = gate + (size_t)(u.pm >> 3) * (6 * 2048) + col0;
        f32x4 gv[2][2];
#pragma unroll
        for (int bj = 0; bj < 2; ++bj)
#pragma unroll
            for (int n = 0; n < 2; ++n) gv[bj][n] = *(const f32x4*)(gb + bj * HALF + n * 16) + 1.0f;
#pragma unroll
        for (int ai = 0; ai < 2; ++ai)
#pragma unroll
            for (int m = 0; m < 4; ++m) { const size_t off = (size_t)(row0 + ai * HALF + m * 16) * 2048 + col0;
#pragma unroll
                for (int bj = 0; bj < 2; ++bj)
#pragma unroll
                    for (int n = 0; n < 2; ++n) { const f32x4 xv = *(const f32x4*)(X + off + bj * HALF + n * 16);
                        *(f32x4*)(Z + off + bj * HALF + n * 16) = xv * alpha + gv[bj][n] * acc[ai][bj][m][n]; }
                asm volatile("" ::: "memory"); }
    }
};
template <class Epi, class Sched, bool ALIGN_EPI = false, bool SP2 = false>
__device__ __forceinline__ void gemm_phase(PG8_LAS unsigned char* lds, const Gemm g, const Sched& S, const Epi& E, const int tid_in) {
    const int tid = tid_in, wid = __builtin_amdgcn_readfirstlane(tid >> 6), lane = tid & 63, wr = wid >> 2, wc = wid & 3, fr = lane & 15, fq = lane >> 4;
    const int K = g.K, nt = K / BK;
    unsigned voffA[2], voffB[2];
#pragma unroll
    for (int i = 0; i < 2; ++i) { int R, C; stage_rc(tid * 16 + i * 8192, R, C); const int Rb = Epi::PERM ? ((R & ~31) + perm32(R & 31)) : R;
        voffA[i] = (unsigned)(R * K + C) * 2u; voffB[i] = (unsigned)(Rb * K + C) * 2u; }
    const size_t kstep = (size_t)(BK * 2);
    const size_t hstep = (size_t)HALF * K * 2;
    const size_t tstep = 2 * hstep;
    const unsigned ldsw = (unsigned)wid * 1024u;
    const int aoff = lds_byte(wr * 64 + fr, fq * 8), boff = lds_byte(wc * 32 + fr, fq * 8);
#define PG8_SA(b, h) (((b) * 2 + (h)) * HTB)
#define PG8_SB(b, h) ((4 + (b) * 2 + (h)) * HTB)
#define PG8_STAGE(bufoff, gbase, voff) do { _Pragma("unroll") for (int _i = 0; _i < 2; ++_i) \
        __builtin_amdgcn_global_load_lds((const unsigned*)((const char*)(gbase) + (voff)[_i]), (PG8_LAS unsigned*)(lds + (bufoff) + ldsw + _i * 8192), 16, 0, 0); } while (0)
#define PG8_LDA(dst, b, h) do { _Pragma("unroll") for (int m = 0; m < 4; ++m) _Pragma("unroll") for (int k = 0; k < 2; ++k) dst[m][k] = *(const PG8_LAS bf16x8*)(lds + PG8_SA(b, h) + aoff + m * 2048 + k * 1024); } while (0)
#define PG8_LDB(dst, b, h) do { _Pragma("unroll") for (int n = 0; n < 2; ++n) _Pragma("unroll") for (int k = 0; k < 2; ++k) dst[n][k] = *(const PG8_LAS bf16x8*)(lds + PG8_SB(b, h) + boff + n * 2048 + k * 1024); } while (0)
#define PG8_MMA(ai, bj, At, Bt) do { __builtin_amdgcn_s_setprio(1); _Pragma("unroll") for (int m = 0; m < 4; ++m) _Pragma("unroll") for (int n = 0; n < 2; ++n) _Pragma("unroll") for (int k = 0; k < 2; ++k) \
        acc[ai][bj][m][n] = __builtin_amdgcn_mfma_f32_16x16x32_bf16(Bt[n][k], At[m][k], acc[ai][bj][m][n], 0, 0, 0); __builtin_amdgcn_s_setprio(0); } while (0)
#define PG8_WAIT_V(n) asm volatile("s_waitcnt vmcnt(" #n ")" ::: "memory")
#define PG8_WAIT_L(n) asm volatile("s_waitcnt lgkmcnt(" #n ")" ::: "memory")
#define PG8_BAR __builtin_amdgcn_s_barrier()
#define PG8_SCHED __builtin_amdgcn_sched_barrier(0)
    Unit cur, nxt; int ui = 0;
    if (!S.next(0, cur)) return;
    f32x4 acc[2][2][4][2];
#pragma unroll
    for (int a = 0; a < 2; ++a)
#pragma unroll
        for (int b = 0; b < 2; ++b)
#pragma unroll
            for (int m = 0; m < 4; ++m)
#pragma unroll
                for (int n = 0; n < 2; ++n) acc[a][b][m][n] = (f32x4){0.f, 0.f, 0.f, 0.f};
    bf16x8 At[4][2], B0[2][2], B1[2][2];
    const char* cA = (const char*)g.A + (size_t)cur.pm * tstep; const char* cB = (const char*)g.Bt + (size_t)cur.pn * tstep;
    S.a_ready(cur);
    if constexpr (SP2) {
        PG8_STAGE(PG8_SB(0, 0), cB, voffB); PG8_STAGE(PG8_SB(0, 1), cB + hstep, voffB); PG8_STAGE(PG8_SA(0, 0), cA, voffA); PG8_STAGE(PG8_SA(0, 1), cA + hstep, voffA);
        if (wr == 1) PG8_BAR;
        PG8_WAIT_V(2); PG8_BAR;
        PG8_STAGE(PG8_SB(1, 0), cB + kstep, voffB); PG8_STAGE(PG8_SA(1, 0), cA + kstep, voffA); PG8_STAGE(PG8_SB(1, 1), cB + hstep + kstep, voffB);
        PG8_WAIT_V(6); PG8_BAR;
    } else {
        PG8_STAGE(PG8_SB(0, 0), cB, voffB); PG8_STAGE(PG8_SA(0, 0), cA, voffA); PG8_STAGE(PG8_SB(0, 1), cB + hstep, voffB); PG8_STAGE(PG8_SA(0, 1), cA + hstep, voffA);
        if (wr == 1) PG8_BAR;
        PG8_WAIT_V(4); PG8_BAR;
        PG8_STAGE(PG8_SB(1, 0), cB + kstep, voffB); PG8_STAGE(PG8_SA(1, 0), cA + kstep, voffA); PG8_STAGE(PG8_SB(1, 1), cB + hstep + kstep, voffB);
        PG8_WAIT_V(6); PG8_BAR;
    }
    for (;;) {
        const bool has_next = S.next(ui + 1, nxt);
        const char* nA = has_next ? (const char*)g.A + (size_t)nxt.pm * tstep : cA; const char* nB = has_next ? (const char*)g.Bt + (size_t)nxt.pn * tstep : cB;
        for (int t = 0; t < nt; t += 2) {
            const bool last = (t == nt - 2);
            const char* a1 = cA + (size_t)(t + 1) * kstep;
            const char* a2 = last ? nA : cA + (size_t)(t + 2) * kstep; const char* b2 = last ? nB : cB + (size_t)(t + 2) * kstep;
            const char* a3 = a2 + kstep; const char* b3 = b2 + kstep;
            if (last && has_next) S.a_ready(nxt);
            if constexpr (SP2) {
            PG8_LDB(B0, 0, 0); PG8_LDB(B1, 0, 1); PG8_SCHED; PG8_LDA(At, 0, 0); PG8_STAGE(PG8_SA(1, 1), a1 + hstep, voffA);
            PG8_WAIT_V(8); PG8_WAIT_L(0); PG8_BAR; PG8_MMA(0, 0, At, B0); PG8_MMA(0, 1, At, B1); PG8_BAR; PG8_SCHED;
            PG8_LDA(At, 0, 1); PG8_STAGE(PG8_SB(0, 0), b2, voffB); PG8_STAGE(PG8_SB(0, 1), b2 + hstep, voffB); PG8_STAGE(PG8_SA(0, 0), a2, voffA);
            PG8_WAIT_V(8); PG8_WAIT_L(0); PG8_BAR; PG8_MMA(1, 0, At, B0); PG8_MMA(1, 1, At, B1); PG8_BAR; PG8_SCHED;
            PG8_LDB(B0, 1, 0); PG8_LDB(B1, 1, 1); PG8_SCHED; PG8_LDA(At, 1, 0); PG8_STAGE(PG8_SA(0, 1), a2 + hstep, voffA);
            PG8_WAIT_V(8); PG8_WAIT_L(0); PG8_BAR; PG8_MMA(0, 0, At, B0); PG8_MMA(0, 1, At, B1); PG8_BAR; PG8_SCHED;
            PG8_LDA(At, 1, 1); PG8_STAGE(PG8_SB(1, 0), b3, voffB); PG8_STAGE(PG8_SB(1, 1), b3 + hstep, voffB); PG8_STAGE(PG8_SA(1, 0), a3, voffA);
            PG8_WAIT_V(8); PG8_WAIT_L(0); PG8_BAR; PG8_MMA(1, 0, At, B0); PG8_MMA(1, 1, At, B1); PG8_BAR; PG8_SCHED;
            } else {
            PG8_LDB(B0, 0, 0); PG8_SCHED; PG8_LDA(At, 0, 0); PG8_STAGE(PG8_SA(1, 1), a1 + hstep, voffA);
            PG8_WAIT_L(8); PG8_BAR; PG8_WAIT_L(0); PG8_MMA(0, 0, At, B0); PG8_BAR; PG8_SCHED;
            PG8_LDB(B1, 0, 1); PG8_STAGE(PG8_SB(0, 0), b2, voffB);
            PG8_BAR; PG8_WAIT_L(0); PG8_MMA(0, 1, At, B1); PG8_BAR;
            PG8_LDA(At, 0, 1); PG8_STAGE(PG8_SA(0, 0), a2, voffA);
            PG8_BAR; PG8_WAIT_L(0); PG8_MMA(1, 0, At, B0); PG8_BAR; PG8_SCHED;
            PG8_STAGE(PG8_SB(0, 1), b2 + hstep, voffB);
            PG8_WAIT_V(6); PG8_BAR; PG8_MMA(1, 1, At, B1); PG8_BAR;
            PG8_LDB(B0, 1, 0); PG8_SCHED; PG8_LDA(At, 1, 0); PG8_STAGE(PG8_SA(0, 1), a2 + hstep, voffA);
            PG8_WAIT_L(8); PG8_BAR; PG8_WAIT_L(0); PG8_MMA(0, 0, At, B0); PG8_BAR; PG8_SCHED;
            PG8_LDB(B1, 1, 1); PG8_STAGE(PG8_SB(1, 0), b3, voffB);
            PG8_BAR; PG8_WAIT_L(0); PG8_MMA(0, 1, At, B1); PG8_BAR;
            PG8_LDA(At, 1, 1); PG8_STAGE(PG8_SA(1, 0), a3, voffA);
            PG8_BAR; PG8_WAIT_L(0); PG8_MMA(1, 0, At, B0); PG8_BAR; PG8_SCHED;
            PG8_STAGE(PG8_SB(1, 1), b3 + hstep, voffB);
            PG8_WAIT_V(6); PG8_BAR; PG8_MMA(1, 1, At, B1); PG8_BAR;
            }
        }
        if constexpr (ALIGN_EPI) { if (wr == 0) PG8_BAR; }
        if constexpr (!Epi::AFTER_DRAIN) { E(acc, cur, wr, wc, fr, fq); S.done(cur); }
        if (!has_next) break;
#pragma unroll
        for (int a = 0; a < 2; ++a)
#pragma unroll
            for (int b = 0; b < 2; ++b)
#pragma unroll
                for (int m = 0; m < 4; ++m)
#pragma unroll
                    for (int n = 0; n < 2; ++n) acc[a][b][m][n] = (f32x4){0.f, 0.f, 0.f, 0.f};
        cur = nxt; cA = nA; cB = nB; ++ui;
        if constexpr (ALIGN_EPI) { if (wr == 1) PG8_BAR; }
    }
    PG8_WAIT_V(0);
    if constexpr (!ALIGN_EPI) { if (wr == 0) PG8_BAR; }
    PG8_BAR;
    if constexpr (Epi::AFTER_DRAIN) { E.fused(acc, cur, wr, wc, fr, fq, lds, wid, lane); S.done(cur); }
#undef PG8_SA
#undef PG8_SB
#undef PG8_STAGE
#undef PG8_LDA
#undef PG8_LDB
#undef PG8_MMA
#undef PG8_WAIT_V
#undef PG8_WAIT_L
#undef PG8_BAR
#undef PG8_SCHED
}
}
#define XB_TMO      128
#define XB_XCNT(j)  (256  + 64 * (j))
#define XB_XSUB(j)  (1280 + 64 * (j))
#define XB_XGEN(j)  (2304 + 64 * (j))
#define XB_TOP      3328
#define XB_TOPGEN   3392
#define XCD_BAR_WORDS 3456
#define XB_SPIN_CAP (1u << 18)
#define LAS __attribute__((address_space(3)))

__device__ __forceinline__ unsigned xb_ld(unsigned* p)              { return __hip_atomic_load(p, __ATOMIC_RELAXED, __HIP_MEMORY_SCOPE_AGENT); }
__device__ __forceinline__ unsigned xb_add(unsigned* p, unsigned v) { return __hip_atomic_fetch_add(p, v, __ATOMIC_RELAXED, __HIP_MEMORY_SCOPE_AGENT); }
__device__ __forceinline__ unsigned xb_xcc_id() { return (unsigned)__builtin_amdgcn_s_getreg((3 << 11) | 20) & 0xFu; }
#define XB_SPIN(cond, bar) do { unsigned _sp = 0; while (cond) { __builtin_amdgcn_s_sleep(1); \
    if ((++_sp & 255u) == 0u) { if (xb_ld(&(bar)[XB_TMO])) break; if (_sp > XB_SPIN_CAP) { atomicAdd(&(bar)[XB_TMO], 1u); break; } } } } while (0)

struct XcdBarrier {
    unsigned* bar; unsigned x;
    volatile LAS unsigned* st;
};

__device__ __forceinline__ XcdBarrier xcd_barrier_post(unsigned* bar, volatile LAS unsigned* st) {
    XcdBarrier b; b.bar = bar; b.x = xb_xcc_id(); b.st = st;
    if (threadIdx.x == 0) (void)xb_add(&bar[XB_XCNT(b.x)], 1u);
    return b;
}
__device__ __forceinline__ void xcd_barrier_complete(unsigned* bar, unsigned x, unsigned& nloc, unsigned& nx) {
    const unsigned G = gridDim.x * gridDim.y * gridDim.z;
    unsigned sum, cnt, mine, sp = 0u;
    for (;;) {
        sum = 0u; cnt = 0u; mine = 0u;
#pragma unroll
        for (unsigned j = 0; j < 16; ++j) { const unsigned c = xb_ld(&bar[XB_XCNT(j)]); sum += c; cnt += (c > 0u) ? 1u : 0u; mine = (j == x) ? c : mine; }
        if (sum == G) break;
        __builtin_amdgcn_s_sleep(1);
        if ((++sp & 255u) == 0u) { if (xb_ld(&bar[XB_TMO])) break; if (sp > XB_SPIN_CAP) { atomicAdd(&bar[XB_TMO], 1u); break; } }
    }
    nloc = mine > 0u ? mine : 1u; nx = cnt > 0u ? cnt : 1u;
}

__device__ __forceinline__ void xcd_barrier(const XcdBarrier& b) {
    asm volatile("s_waitcnt vmcnt(0)" ::: "memory");
    __syncthreads();
    if (threadIdx.x == 0) {
        unsigned* bar = b.bar;
        __builtin_amdgcn_s_waitcnt(0);
        unsigned nloc = b.st[0], nx = b.st[1];
        if (nloc == 0u) { xcd_barrier_complete(bar, b.x, nloc, nx); b.st[0] = nloc; b.st[1] = nx; }
        const unsigned old = xb_add(&bar[XB_XSUB(b.x)], 1u);
        const unsigned gen = old / nloc;
        if (old + 1u == (gen + 1u) * nloc) {
            __builtin_amdgcn_fence(__ATOMIC_RELEASE, "agent");
            asm volatile("s_waitcnt vmcnt(0)" ::: "memory");
            const unsigned og = xb_add(&bar[XB_TOP], 1u);
            const unsigned tg = og / nx;
            if (og + 1u == (tg + 1u) * nx) xb_add(&bar[XB_TOPGEN], 1u);
            else XB_SPIN(xb_ld(&bar[XB_TOPGEN]) == tg, bar);
            __builtin_amdgcn_fence(__ATOMIC_ACQUIRE, "agent");
            xb_add(&bar[XB_XGEN(b.x)], 1u);
            asm volatile("s_waitcnt vmcnt(0)" ::: "memory");
        } else {
            XB_SPIN(xb_ld(&bar[XB_XGEN(b.x)]) == gen, bar);
            __builtin_amdgcn_fence(__ATOMIC_ACQUIRE, "agent");
            asm volatile("s_waitcnt vmcnt(0)" ::: "memory");
        }
    }
    __syncthreads();
}
constexpr int D = 2048, NB = 8, SEQ = 2048, NL = 4, T = NB * SEQ;
constexpr int NCH = SEQ / 64, NCHUNK = T / 64;
constexpr int GKW = 512, RANK = 16;
constexpr int INW = 6160, NP = 6144;
constexpr int NE = 16384;
constexpr float ALPHA = 1.6817928305074290f, EPS = 1e-5f;
constexpr int PQ = 0, PK = 512, PV = 1024, PR = 2048, PCB = 3072, PCC = 4096, PCH = 5120;
constexpr int NWAVES = 8, NTHREADS = 512;
#ifndef WGM_IN
#define WGM_IN 4
#endif
#ifndef WGM_OUT
#define WGM_OUT 4
#endif
#ifndef WGM_WQ
#define WGM_WQ 4
#endif
#ifndef TAB4
#define TAB4 1
#endif
constexpr int NPHASES = 2 + 7 * NL;

constexpr size_t MiB = 1u << 20;
constexpr size_t WS_CTL = 0, CTL_ZERO_BYTES = 1 * MiB;
constexpr size_t WS_MOD = 1 * MiB, WS_PART = 3 * MiB, WS_KEYS = 15 * MiB, WS_DTOT = 17 * MiB, WS_WIN = 18 * MiB, WS_WOUT = 115 * MiB, WS_WQ = 147 * MiB;
constexpr size_t WS_UT = 179 * MiB, WS_VT = 435 * MiB, WS_H = 691 * MiB, WS_PROJ = 755 * MiB, WS_E = 947 * MiB, WS_OGLA = 979 * MiB, WS_Y = 1043 * MiB;
constexpr size_t WS_Z = 1107 * MiB, WS_X1 = 1235 * MiB, WS_X = 1363 * MiB, WS_Q = 1491 * MiB, WS_H2 = 1555 * MiB, WS_HQ8 = 1619 * MiB, WS_END = 1659 * MiB;
constexpr size_t WS_SU = 17 * MiB + 512 * 1024, WS_SV = 17 * MiB + 768 * 1024, WS_HSC = 2 * MiB + 640 * 1024;
static_assert(WS_WIN + (size_t)NL * INW * D * 2 <= WS_WOUT && WS_PART + (size_t)NL * 8 * NB * 6 * D * 4 <= WS_KEYS && WS_MOD + (size_t)NL * NB * 6 * D * 4 <= WS_PART, "ws map");
constexpr int CW_BAR = 4096;

constexpr int RING_OFF = 0, RING_BYTES = 131072, LDSCTL_OFF = RING_BYTES, LDS_BYTES = 147456;

#define GAS __attribute__((address_space(1)))
typedef unsigned short bf16;
typedef unsigned v4u __attribute__((ext_vector_type(4)));
typedef unsigned v2u __attribute__((ext_vector_type(2)));
typedef float f32x4 __attribute__((ext_vector_type(4)));
typedef float f32x16 __attribute__((ext_vector_type(16)));
typedef short bf16x8 __attribute__((ext_vector_type(8)));
typedef __bf16 bf16x2v __attribute__((ext_vector_type(2)));
#define LDS_WAIT() asm volatile("s_waitcnt lgkmcnt(0)" ::: "memory")

__device__ __forceinline__ unsigned pk2(float lo, float hi) { return pg8::cvt_pk_bf16(lo, hi); }
__device__ __forceinline__ float dot2bf(unsigned w, unsigned x, float acc) { return __builtin_amdgcn_fdot2_f32_bf16(__builtin_bit_cast(bf16x2v, w), __builtin_bit_cast(bf16x2v, x), acc, false); }
__device__ __forceinline__ float bflo(unsigned u) { return __uint_as_float(u << 16); }
__device__ __forceinline__ float bfhi(unsigned u) { return __uint_as_float(u & 0xffff0000u); }
__device__ __forceinline__ float silu_f(float x) { return x / (1.0f + __expf(-x)); }
__device__ __forceinline__ float logsigmoid_f(float x) { return fminf(x, 0.0f) - log1pf(__expf(-fabsf(x))); }
__device__ __forceinline__ float gelu_tanh_f(float x) { const float u = 0.7978845608028654f * (x + 0.044715f * x * x * x); return 0.5f * x * (1.0f + tanhf(u)); }
__device__ __forceinline__ float wave_sum(float v) {
#pragma unroll
    for (int o = 1; o < 64; o <<= 1) v += __shfl_xor(v, o);
    return v;
}

struct Args { const float* in[19]; float* out; unsigned char* ws; int ph_lo, ph_hi; };

__device__ __forceinline__ void transpose_item(const float* W, int ldw, int col0, bf16* WTrows, int k0, int nvalid, LAS float* scr, int lane) {
    const int n = lane & 31;
    float tv[32];
#pragma unroll
    for (int i = 0; i < 32; ++i) { const int kk = 2 * i + (lane >> 5); tv[i] = (n < nvalid) ? W[(size_t)(k0 + kk) * ldw + col0 + n] : 0.f; }
#pragma unroll
    for (int i = 0; i < 32; ++i) { const int kk = 2 * i + (lane >> 5); scr[kk * 33 + n] = tv[i]; }
    LDS_WAIT(); asm volatile("" ::: "memory");
    const int c = lane & 7;
#pragma unroll
    for (int j = 0; j < 4; ++j) { const int nn = (lane >> 3) + 8 * j; const LAS float* s = scr + (8 * c) * 33 + nn;
        v4u o; o.x = pk2(s[0 * 33], s[1 * 33]); o.y = pk2(s[2 * 33], s[3 * 33]); o.z = pk2(s[4 * 33], s[5 * 33]); o.w = pk2(s[6 * 33], s[7 * 33]);
        if (nn < nvalid) *(v4u*)(WTrows + (size_t)nn * D + k0 + 8 * c) = o; }
    LDS_WAIT(); asm volatile("" ::: "memory");
}
__device__ __forceinline__ void cvt_stream(const float* src, bf16* dst, size_t n4, size_t i0, size_t stride) {
    for (size_t i = i0; i < n4; i += stride) { const f32x4 v = ((const f32x4*)src)[i]; v2u o; o.x = pk2(v.x, v.y); o.y = pk2(v.z, v.w); ((v2u*)dst)[i] = o; }
}
__device__ __forceinline__ void ph_prologue_a(const Args& a, LAS unsigned char* lds, int tid, int lane, int wave, int bx, int G) {
    const int gw = bx * NWAVES + wave, NGW = G * NWAVES;
    LAS float* cact = (LAS float*)lds;
    for (int i = tid; i < NB * D; i += NTHREADS) { const int b = i / D, d = i % D; cact[d * 8 + b] = silu_f(a.in[1][i]); }
    __syncthreads();
    float* part = (float*)(a.ws + WS_PART);
    for (int it = gw; it < NL * 8 * 48; it += NGW) {
        const int cg = it % 48, dr = (it / 48) % 8, l = it / 384;
        f32x4 acc[8];
#pragma unroll
        for (int b = 0; b < 8; ++b) acc[b] = (f32x4){0.f, 0.f, 0.f, 0.f};
        const float* w = a.in[2] + ((size_t)l * D + dr * 256) * (6 * D) + cg * 256 + lane * 4;
#pragma unroll 4
        for (int d = 0; d < 256; ++d) {
            const f32x4 wv = *(const f32x4*)(w + (size_t)d * (6 * D));
            const f32x4 c0 = *(const LAS f32x4*)(cact + (dr * 256 + d) * 8), c1 = *(const LAS f32x4*)(cact + (dr * 256 + d) * 8 + 4);
            acc[0] += wv * c0.x; acc[1] += wv * c0.y; acc[2] += wv * c0.z; acc[3] += wv * c0.w;
            acc[4] += wv * c1.x; acc[5] += wv * c1.y; acc[6] += wv * c1.z; acc[7] += wv * c1.w;
        }
#pragma unroll
        for (int b = 0; b < 8; ++b) *(f32x4*)(part + (((size_t)l * 8 + dr) * NB + b) * (6 * D) + cg * 256 + lane * 4) = acc[b];
    }
    __syncthreads();
    LAS float* scr = (LAS float*)(lds + wave * 8448);
    bf16* winT = (bf16*)(a.ws + WS_WIN); bf16* woutT = (bf16*)(a.ws + WS_WOUT); bf16* wqT = (bf16*)(a.ws + WS_WQ);
    constexpr int IPL = 6144 + 32 + 2048 + 2048;
    for (int it = gw; it < NL * IPL; it += NGW) {
        const int l = it / IPL; int r = it % IPL;
        if (r < 6144) { const int nb = r % 192, kb = r / 192, n0 = nb * 32;
            transpose_item(a.in[4] + (size_t)l * D * INW, INW, n0 < 3072 ? n0 : n0 + 16, winT + ((size_t)l * INW + n0) * D, kb * 64, 32, scr, lane); continue; }
        r -= 6144;
        if (r < 32) { transpose_item(a.in[4] + (size_t)l * D * INW, INW, 3072, winT + ((size_t)l * INW + NP) * D, r * 64, 16, scr, lane); continue; }
        r -= 32;
        if (r < 2048) { const int nb = r % 64, kb = r / 64; transpose_item(a.in[10] + (size_t)l * D * D, D, nb * 32, woutT + ((size_t)l * D + nb * 32) * D, kb * 64, 32, scr, lane); continue; }
        r -= 2048;
        { const int nb = r % 64, kb = r / 64; transpose_item(a.in[13] + (size_t)l * D * D, D, nb * 32, wqT + ((size_t)l * D + nb * 32) * D, kb * 64, 32, scr, lane); }
    }
    const size_t i0 = (size_t)bx * NTHREADS + tid, stride = (size_t)G * NTHREADS;
    cvt_stream(a.in[14], (bf16*)(a.ws + WS_KEYS), (size_t)NL * 8 * 2 * 128 * 128 / 4, i0, stride);
#if TAB4
    __syncthreads();
    { LAS float* rowst = (LAS float*)(lds + wave * 8192);
      f32x4 vnx[8];
      if (gw < 2 * NL * NE) { const int tbl0 = gw / (NL * NE), r0 = gw % (NL * NE); const float* s0 = (tbl0 ? a.in[16] : a.in[15]) + (size_t)r0 * D;
#pragma unroll
          for (int c8 = 0; c8 < 8; ++c8) vnx[c8] = *(const f32x4*)(s0 + (c8 * 64 + lane) * 4); }
      for (int row = gw; row < 2 * NL * NE; row += NGW) {
        const int tbl = row / (NL * NE), r = row % (NL * NE);
#pragma unroll
        for (int c8 = 0; c8 < 8; ++c8) *(LAS f32x4*)(rowst + (c8 * 64 + lane) * 4) = vnx[c8];
        { const int rown = row + NGW < 2 * NL * NE ? row + NGW : row; const int tbln = rown / (NL * NE), rn = rown % (NL * NE); const float* sn = (tbln ? a.in[16] : a.in[15]) + (size_t)rn * D;
#pragma unroll
          for (int c8 = 0; c8 < 8; ++c8) vnx[c8] = *(const f32x4*)(sn + (c8 * 64 + lane) * 4); }
        LDS_WAIT(); asm volatile("" ::: "memory");
        unsigned char* tb = a.ws + (tbl ? WS_VT : WS_UT) + (size_t)r * 1152;
#pragma unroll
        for (int pass = 0; pass < 2; ++pass) { const int slot = lane + 64 * pass;
            if (slot < 72) { const int col0 = (slot >> 3) * 240 + (slot & 7) * 30;
                float x[30]; float mx = 0.f;
#pragma unroll
                for (int k = 0; k < 30; ++k) { x[k] = (col0 + k < D) ? rowst[col0 + k] : 0.f; mx = fmaxf(mx, fabsf(x[k])); }
                int code = 0; float inv = 0.f;
                if (mx > 0.f) { code = (int)ceilf(8.0f * log2f(mx * (1.0f / 7.0f))) + 128; code = code < 0 ? 0 : (code > 255 ? 255 : code); inv = __builtin_amdgcn_exp2f(16.0f - (float)code * 0.125f); }
                unsigned dw[4] = {0u, 0u, 0u, 0u};
#pragma unroll
                for (int kb = 0; kb < 15; ++kb) { int a0 = (int)__builtin_rintf(x[2 * kb] * inv), a1 = (int)__builtin_rintf(x[2 * kb + 1] * inv);
                    a0 = a0 < -7 ? -7 : (a0 > 7 ? 7 : a0); a1 = a1 < -7 ? -7 : (a1 > 7 ? 7 : a1);
                    dw[kb >> 2] |= ((unsigned)(a0 + 8) | ((unsigned)(a1 + 8) << 4)) << (8 * (kb & 3)); }
                dw[3] |= (unsigned)code << 24;
                *(v4u*)(tb + slot * 16) = (v4u){dw[0], dw[1], dw[2], dw[3]}; } }
        LDS_WAIT(); asm volatile("" ::: "memory");
      } }
#else
    for (int row = gw; row < 2 * NL * NE; row += NGW) {
        const int tbl = row / (NL * NE), r = row % (NL * NE);
        const float* src = (tbl ? a.in[16] : a.in[15]) + (size_t)r * D;
        f32x4 v[8]; float mx = 0.f;
#pragma unroll
        for (int c8 = 0; c8 < 8; ++c8) { v[c8] = *(const f32x4*)(src + (c8 * 64 + lane) * 4); mx = fmaxf(mx, fmaxf(fmaxf(fabsf(v[c8].x), fabsf(v[c8].y)), fmaxf(fabsf(v[c8].z), fabsf(v[c8].w)))); }
#pragma unroll
        for (int o = 1; o < 64; o <<= 1) mx = fmaxf(mx, __shfl_xor(mx, o));
        const float inv = mx > 0.f ? 127.0f / mx : 0.f; const int off = tbl ? 128 : 0;
        unsigned dw[8];
#pragma unroll
        for (int c8 = 0; c8 < 8; ++c8) { const int q0 = (int)__builtin_rintf(v[c8].x * inv) + off, q1 = (int)__builtin_rintf(v[c8].y * inv) + off, q2 = (int)__builtin_rintf(v[c8].z * inv) + off, q3 = (int)__builtin_rintf(v[c8].w * inv) + off;
            dw[c8] = (unsigned)(q0 & 255) | ((unsigned)(q1 & 255) << 8) | ((unsigned)(q2 & 255) << 16) | ((unsigned)(q3 & 255) << 24); }
        unsigned char* dst = a.ws + (tbl ? WS_VT : WS_UT) + (size_t)r * D;
        *(v4u*)(dst + lane * 16) = (v4u){dw[0], dw[1], dw[2], dw[3]}; *(v4u*)(dst + (64 + lane) * 16) = (v4u){dw[4], dw[5], dw[6], dw[7]};
        if (lane == 0) ((float*)(a.ws + (tbl ? WS_SV : WS_SU)))[r] = mx * (1.0f / 127.0f);
    }
#endif
}

__device__ __forceinline__ void ln_tail(const float (&z)[32], int t, int lane, const float* g, const float* bta, float* xout, const float* sh, const float* sc, bf16* hout, unsigned char* q8, float* q8s, LAS unsigned char* q8stage = nullptr) {
    float s = 0.f;
#pragma unroll
    for (int i = 0; i < 32; ++i) s += z[i];
    const float mu = wave_sum(s) * (1.0f / D);
    float q = 0.f;
#pragma unroll
    for (int i = 0; i < 32; ++i) { const float d = z[i] - mu; q += d * d; }
    const float rs = rsqrtf(wave_sum(q) * (1.0f / D) + EPS);
    float hv[32]; float mx = 0.f;
#pragma unroll
    for (int c = 0; c < 8; ++c) { const int col = (c * 64 + lane) * 4;
        const f32x4 g0 = *(const f32x4*)(g + col), b0 = *(const f32x4*)(bta + col);
        f32x4 x0;
        x0.x = (z[c * 4 + 0] - mu) * rs * g0.x + b0.x; x0.y = (z[c * 4 + 1] - mu) * rs * g0.y + b0.y; x0.z = (z[c * 4 + 2] - mu) * rs * g0.z + b0.z; x0.w = (z[c * 4 + 3] - mu) * rs * g0.w + b0.w;
        if (xout) *(f32x4*)(xout + (size_t)t * D + col) = x0;
        if (hout) { const f32x4 s0 = *(const f32x4*)(sc + col), h0 = *(const f32x4*)(sh + col);
            hv[c * 4] = x0.x * (1.f + s0.x) + h0.x; hv[c * 4 + 1] = x0.y * (1.f + s0.y) + h0.y; hv[c * 4 + 2] = x0.z * (1.f + s0.z) + h0.z; hv[c * 4 + 3] = x0.w * (1.f + s0.w) + h0.w;
            v2u o; o.x = pk2(hv[c * 4], hv[c * 4 + 1]); o.y = pk2(hv[c * 4 + 2], hv[c * 4 + 3]);
            *(v2u*)(hout + (size_t)t * D + col) = o;
            if (q8) {
                hv[c * 4] = bflo(o.x); hv[c * 4 + 1] = bfhi(o.x); hv[c * 4 + 2] = bflo(o.y); hv[c * 4 + 3] = bfhi(o.y);
                mx = fmaxf(mx, fmaxf(fmaxf(fabsf(hv[c * 4]), fabsf(hv[c * 4 + 1])), fmaxf(fabsf(hv[c * 4 + 2]), fabsf(hv[c * 4 + 3])))); } }
    }
    if (q8) {
#pragma unroll
        for (int o = 1; o < 64; o <<= 1) mx = fmaxf(mx, __shfl_xor(mx, o));
        const float qmax_ = TAB4 ? 119.0f : 127.0f;
        const float inv = mx > 0.f ? qmax_ / mx : 0.f;
        unsigned dw[8];
#pragma unroll
        for (int c = 0; c < 8; ++c) { const int q0 = (int)__builtin_rintf(hv[c * 4] * inv), q1 = (int)__builtin_rintf(hv[c * 4 + 1] * inv), q2 = (int)__builtin_rintf(hv[c * 4 + 2] * inv), q3 = (int)__builtin_rintf(hv[c * 4 + 3] * inv);
            dw[c] = (unsigned)(q0 & 255) | ((unsigned)(q1 & 255) << 8) | ((unsigned)(q2 & 255) << 16) | ((unsigned)(q3 & 255) << 24); }
#if TAB4
        { LAS unsigned* st32 = (LAS unsigned*)q8stage; LAS unsigned char* st8 = (LAS unsigned char*)q8stage;
#pragma unroll
          for (int i = 0; i < 9; ++i) st32[lane + 64 * i] = 0u;
          LDS_WAIT(); asm volatile("" ::: "memory");
#pragma unroll
          for (int c = 0; c < 8; ++c)
#pragma unroll
              for (int jp = 0; jp < 2; ++jp) { const int col = (c * 64 + lane) * 4 + 2 * jp, u = col / 240, r = col - u * 240, l7 = r / 30, k = r - l7 * 30;
                  const int q0 = (int)(signed char)((dw[c] >> (16 * jp)) & 255u), q1 = (int)(signed char)((dw[c] >> (16 * jp + 8)) & 255u);
                  const int l0 = ((q0 + 8) & 15) - 8, l1 = ((q1 + 8) & 15) - 8, h0 = (q0 - l0) >> 4, h1 = (q1 - l1) >> 4;
                  LAS unsigned char* sp = st8 + (u * 8 + l7) * 32 + (k >> 1);
                  sp[0] = (unsigned char)((l0 & 15) | ((l1 & 15) << 4)); sp[16] = (unsigned char)((h0 & 15) | ((h1 & 15) << 4)); }
          LDS_WAIT(); asm volatile("" ::: "memory");
          unsigned* d32 = (unsigned*)(q8 + (size_t)t * 2304);
#pragma unroll
          for (int i = 0; i < 9; ++i) d32[lane + 64 * i] = st32[lane + 64 * i];
          LDS_WAIT(); asm volatile("" ::: "memory"); }
#else
        unsigned char* dst = q8 + (size_t)t * D;
        *(v4u*)(dst + lane * 16) = (v4u){dw[0], dw[1], dw[2], dw[3]}; *(v4u*)(dst + (64 + lane) * 16) = (v4u){dw[4], dw[5], dw[6], dw[7]};
#endif
        if (lane == 0) q8s[t] = mx / qmax_;
    }
}

__device__ __forceinline__ void ph_prologue_b(const Args& a, LAS unsigned char* lds, int tid, int lane, int wave, int bx, int G) {
    const float* part = (const float*)(a.ws + WS_PART); float* mod = (float*)(a.ws + WS_MOD);
    for (int i = bx * NTHREADS + tid; i < NL * NB * 6 * D / 4; i += G * NTHREADS) {
        const int idx = i * 4, e = idx % (6 * D), b = (idx / (6 * D)) % NB, l = idx / (6 * D * NB);
        f32x4 s = *(const f32x4*)(a.in[3] + l * 6 * D + e);
#pragma unroll
        for (int dr = 0; dr < 8; ++dr) s += *(const f32x4*)(part + (((size_t)l * 8 + dr) * NB + b) * (6 * D) + e);
        *(f32x4*)(mod + idx) = s;
    }
    LAS float* msh = (LAS float*)lds;
    bf16* hbuf = (bf16*)(a.ws + WS_H);
    for (int ch = bx; ch < NCHUNK; ch += G) {
        const int b = ch / NCH;
        for (int i = tid; i < 1024; i += NTHREADS) { const int e = i * 4;
            f32x4 s = *(const f32x4*)(a.in[3] + e);
#pragma unroll
            for (int dr = 0; dr < 8; ++dr) s += *(const f32x4*)(part + (((size_t)0 * 8 + dr) * NB + b) * (6 * D) + e);
            *(LAS f32x4*)(msh + e) = s; }
        __syncthreads();
        for (int i = 0; i < 8; ++i) { const int t = ch * 64 + wave * 8 + i;
#pragma unroll
            for (int c = 0; c < 4; ++c) { const int col = (c * 64 + lane) * 8;
                const f32x4 x0 = *(const f32x4*)(a.in[0] + (size_t)t * D + col), x1 = *(const f32x4*)(a.in[0] + (size_t)t * D + col + 4);
                const f32x4 h0 = *(const LAS f32x4*)(msh + col), h1 = *(const LAS f32x4*)(msh + col + 4), s0 = *(const LAS f32x4*)(msh + 2048 + col), s1 = *(const LAS f32x4*)(msh + 2048 + col + 4);
                v4u o; o.x = pk2(x0.x * (1.f + s0.x) + h0.x, x0.y * (1.f + s0.y) + h0.y); o.y = pk2(x0.z * (1.f + s0.z) + h0.z, x0.w * (1.f + s0.w) + h0.w);
                o.z = pk2(x1.x * (1.f + s1.x) + h1.x, x1.y * (1.f + s1.y) + h1.y); o.w = pk2(x1.z * (1.f + s1.z) + h1.z, x1.w * (1.f + s1.w) + h1.w);
                *(v4u*)(hbuf + (size_t)t * D + col) = o; } }
        __syncthreads();
    }
}

__device__ __forceinline__ void gate_prep(const Args& a, int l, LAS unsigned char* lds, int tid, int lane, int wave, int ch) {
    const bf16* hbuf = (const bf16*)(a.ws + WS_H); const bf16* waT = (const bf16*)(a.ws + WS_WIN) + ((size_t)l * INW + NP) * D;
    bf16* Ebuf = (bf16*)(a.ws + WS_E); float* dtot = (float*)(a.ws + WS_DTOT);
    const int t0 = ch * 64, l15 = lane & 15, lq = lane >> 4, mt = wave & 3, kh = wave >> 2;
    f32x4 acc = (f32x4){0.f, 0.f, 0.f, 0.f};
    const bf16* hA = hbuf + (size_t)(t0 + 16 * mt + l15) * D + kh * 1024 + 8 * lq;
    const bf16* wB = waT + (size_t)l15 * D + kh * 1024 + 8 * lq;
#pragma unroll 8
    for (int ks = 0; ks < 32; ++ks) { const bf16x8 av = *(const bf16x8*)(hA + 32 * ks), bv = *(const bf16x8*)(wB + 32 * ks); acc = __builtin_amdgcn_mfma_f32_16x16x32_bf16(av, bv, acc, 0, 0, 0); }
    LAS float* alr = (LAS float*)lds;
#pragma unroll
    for (int r = 0; r < 4; ++r) alr[(kh * 64 + 16 * mt + 4 * lq + r) * 16 + l15] = acc[r];
    __syncthreads();
    const int col = tid;
    float wg[16];
#pragma unroll
    for (int r = 0; r < 16; ++r) wg[r] = a.in[5][((size_t)l * RANK + r) * GKW + col];
    const float bgc = a.in[6][l * GKW + col];
    float tot = 0.f;
    for (int j = 0; j < 64; ++j) { float lg = bgc;
#pragma unroll
        for (int r4 = 0; r4 < 4; ++r4) { const f32x4 p = *(const LAS f32x4*)(alr + j * 16 + r4 * 4), q = *(const LAS f32x4*)(alr + (64 + j) * 16 + r4 * 4);
            lg += (p.x + q.x) * wg[r4 * 4] + (p.y + q.y) * wg[r4 * 4 + 1] + (p.z + q.z) * wg[r4 * 4 + 2] + (p.w + q.w) * wg[r4 * 4 + 3]; }
        tot += logsigmoid_f(lg) * (1.0f / 16.0f); }
    float run = 0.f;
    for (int j = 0; j < 64; ++j) { float lg = bgc;
#pragma unroll
        for (int r4 = 0; r4 < 4; ++r4) { const f32x4 p = *(const LAS f32x4*)(alr + j * 16 + r4 * 4), q = *(const LAS f32x4*)(alr + (64 + j) * 16 + r4 * 4);
            lg += (p.x + q.x) * wg[r4 * 4] + (p.y + q.y) * wg[r4 * 4 + 1] + (p.z + q.z) * wg[r4 * 4 + 2] + (p.w + q.w) * wg[r4 * 4 + 3]; }
        run += logsigmoid_f(lg) * (1.0f / 16.0f);
        Ebuf[(size_t)(t0 + j) * GKW + col] = (bf16)(pk2(__expf(tot - run), 0.f) & 0xffffu); }
    dtot[(size_t)ch * GKW + col] = __expf(tot);
    __syncthreads();
}

__device__ __forceinline__ void gla_unit(const Args& a, LAS unsigned char* lds, int tid, int lane, int wave, int un) {
    const bf16* proj = (const bf16*)(a.ws + WS_PROJ); const bf16* Ebuf = (const bf16*)(a.ws + WS_E); const float* dtot = (const float*)(a.ws + WS_DTOT); bf16* ogla = (bf16*)(a.ws + WS_OGLA);
    const int pair_ = (un & 7) * 4 + (un >> 6), dvs = (un >> 3) & 7, hh = pair_ & 3, b = pair_ >> 2;
    LAS bf16* kdT = (LAS bf16*)lds;
    LAS bf16* vT = (LAS bf16*)(lds + 18432);
    LAS bf16* ST = (LAS bf16*)(lds + 18432 + 4608);
    const int l15 = lane & 15, lq = lane >> 4, jl = tid >> 3, c0 = tid & 7, dv4 = (tid & 7) * 4, jt = (wave & 3) * 16, dvt = (wave >> 2) * 16;
#define GLA_BAR() do { asm volatile("s_waitcnt lgkmcnt(0)" ::: "memory"); __builtin_amdgcn_s_barrier(); asm volatile("" ::: "memory"); } while (0)
    f32x4 S0 = (f32x4){0.f, 0.f, 0.f, 0.f}, S1 = (f32x4){0.f, 0.f, 0.f, 0.f};
    v4u kn0[2], kn1[2], en0[2], en1[2]; v2u vn0, vn1; bf16x8 qn0[4], qn1[4], qc[4]; f32x4 dn0, dn1, dc;
#define GLA_LOAD(c, kn, en, vn, qn, dn) do { const int t0c = b * SEQ + (c) * 64; const bf16* pr = proj + (size_t)(t0c + jl) * NP; \
          \
        kn[0] = *(const v4u*)(pr + PK + hh * 128 + 8 * c0); kn[1] = *(const v4u*)(pr + PK + hh * 128 + 64 + 8 * c0); \
        en[0] = *(const v4u*)(Ebuf + (size_t)(t0c + jl) * GKW + hh * 128 + 8 * c0); en[1] = *(const v4u*)(Ebuf + (size_t)(t0c + jl) * GKW + hh * 128 + 64 + 8 * c0); \
        vn = *(const v2u*)(pr + PV + hh * 256 + dvs * 32 + dv4); \
        _Pragma("unroll") for (int ks_ = 0; ks_ < 4; ++ks_) qn[ks_] = *(const bf16x8*)(proj + (size_t)(t0c + jt + l15) * NP + PQ + hh * 128 + 32 * ks_ + 8 * lq); \
        dn = *(const f32x4*)(dtot + (size_t)(b * NCH + (c)) * GKW + hh * 128 + 16 * wave + 4 * lq); } while (0)
#define GLA_PREP(kn, en, vn, qn, dn) do { \
        _Pragma("unroll") for (int h_ = 0; h_ < 2; ++h_) _Pragma("unroll") for (int i_ = 0; i_ < 8; ++i_) { const unsigned w_ = kn[h_][i_ >> 1], e_ = en[h_][i_ >> 1]; \
            const float kf_ = (i_ & 1) ? bfhi(w_) : bflo(w_), ef_ = (i_ & 1) ? bfhi(e_) : bflo(e_); \
            kdT[(64 * h_ + 8 * c0 + i_) * 72 + ((((jl >> 3) ^ c0) & 7) << 3) + (jl & 7)] = (bf16)(pk2(kf_ * ef_, 0.f) & 0xffffu); }     \
        _Pragma("unroll") for (int i_ = 0; i_ < 4; ++i_) { const unsigned w_ = vn[i_ >> 1]; vT[(dv4 + i_) * 72 + jl] = (bf16)((i_ & 1) ? (w_ >> 16) : (w_ & 0xffffu)); } \
        _Pragma("unroll") for (int ks_ = 0; ks_ < 4; ++ks_) qc[ks_] = qn[ks_]; \
        dc = dn; } while (0)
#define GLA_BODY(c) do { \
        S0 = S0 * dc; S1 = S1 * dc; \
        _Pragma("unroll") for (int ks = 0; ks < 2; ++ks) { \
            const bf16x8 A_ = *(const LAS bf16x8*)(kdT + (16 * wave + l15) * 72 + ((((4 * ks + lq) ^ (2 * wave + (l15 >> 3))) & 7) << 3)); \
            const bf16x8 B0_ = *(const LAS bf16x8*)(vT + l15 * 72 + 32 * ks + 8 * lq), B1_ = *(const LAS bf16x8*)(vT + (16 + l15) * 72 + 32 * ks + 8 * lq); \
            S0 = __builtin_amdgcn_mfma_f32_16x16x32_bf16(A_, B0_, S0, 0, 0, 0); S1 = __builtin_amdgcn_mfma_f32_16x16x32_bf16(A_, B1_, S1, 0, 0, 0); } \
        { v2u w0_, w1_; w0_.x = pk2(S0.x, S0.y); w0_.y = pk2(S0.z, S0.w); w1_.x = pk2(S1.x, S1.y); w1_.y = pk2(S1.z, S1.w); \
          *(LAS v2u*)(ST + l15 * 136 + 16 * wave + 4 * lq) = w0_; *(LAS v2u*)(ST + (16 + l15) * 136 + 16 * wave + 4 * lq) = w1_; } \
        GLA_BAR(); \
        f32x4 O_ = (f32x4){0.f, 0.f, 0.f, 0.f}; \
        _Pragma("unroll") for (int ks = 0; ks < 4; ++ks) { const bf16x8 A_ = *(const LAS bf16x8*)(ST + (dvt + l15) * 136 + 32 * ks + 8 * lq); O_ = __builtin_amdgcn_mfma_f32_16x16x32_bf16(A_, qc[ks], O_, 0, 0, 0); } \
        { const f32x4 Os_ = O_ * 0.08838834764831845f; v2u ob_; ob_.x = pk2(Os_.x, Os_.y); ob_.y = pk2(Os_.z, Os_.w); \
          *(v2u*)(ogla + (size_t)(b * SEQ + (c) * 64 + jt + l15) * 1024 + hh * 256 + dvs * 32 + dvt + 4 * lq) = ob_; } } while (0)
    GLA_LOAD(0, kn0, en0, vn0, qn0, dn0); GLA_LOAD(1, kn1, en1, vn1, qn1, dn1);
    GLA_PREP(kn0, en0, vn0, qn0, dn0);
    GLA_BAR();
    for (int c = 0; c < NCH; c += 2) {
        { const int cn_ = c + 2 < NCH ? c + 2 : NCH - 1; GLA_LOAD(cn_, kn0, en0, vn0, qn0, dn0); }
        GLA_BODY(c);
        GLA_PREP(kn1, en1, vn1, qn1, dn1);
        GLA_BAR();
        { const int cn_ = c + 3 < NCH ? c + 3 : NCH - 1; GLA_LOAD(cn_, kn1, en1, vn1, qn1, dn1); }
        GLA_BODY(c + 1);
        GLA_PREP(kn0, en0, vn0, qn0, dn0);
        GLA_BAR();
    }
#undef GLA_BODY
#undef GLA_BAR
#undef GLA_LOAD
#undef GLA_PREP
}

__device__ __forceinline__ void unpack16(const v4u& p0, const v4u& p1, float (&o)[16]) {
#pragma unroll
    for (int j = 0; j < 4; ++j) { o[2 * j] = bflo(p0[j]); o[2 * j + 1] = bfhi(p0[j]); o[8 + 2 * j] = bflo(p1[j]); o[8 + 2 * j + 1] = bfhi(p1[j]); }
}
__device__ __forceinline__ void mixpost_chunk(const Args& a, int l, int lane, int wave, int ch) {
    const bf16* proj = (const bf16*)(a.ws + WS_PROJ); const bf16* ogla = (const bf16*)(a.ws + WS_OGLA); bf16* ybuf = (bf16*)(a.ws + WS_Y);
    const int c0 = 16 * lane, tfirst = ch * 64 + wave * 8, sfirst = tfirst % SEQ;
    float gn[16], cw0[16], cw1[16], cw2[16], cn[16], u1[16], u2[16];
#pragma unroll
    for (int i = 0; i < 16; ++i) { gn[i] = a.in[7][l * 256 + ((c0 + i) & 255)]; cw0[i] = a.in[8][(size_t)l * 3072 + c0 + i]; cw1[i] = a.in[8][(size_t)l * 3072 + 1024 + c0 + i];
        cw2[i] = a.in[8][(size_t)l * 3072 + 2048 + c0 + i]; cn[i] = a.in[9][l * 1024 + c0 + i]; u1[i] = 0.f; u2[i] = 0.f; }
    if (sfirst >= 2) {
        float cc[16], chh[16];
        { const bf16* pr = proj + (size_t)(tfirst - 2) * NP; unpack16(*(const v4u*)(pr + PCC + c0), *(const v4u*)(pr + PCC + c0 + 8), cc); unpack16(*(const v4u*)(pr + PCH + c0), *(const v4u*)(pr + PCH + c0 + 8), chh); }
#pragma unroll
        for (int i = 0; i < 16; ++i) u2[i] = cc[i] * chh[i];
        { const bf16* pr = proj + (size_t)(tfirst - 1) * NP; unpack16(*(const v4u*)(pr + PCC + c0), *(const v4u*)(pr + PCC + c0 + 8), cc); unpack16(*(const v4u*)(pr + PCH + c0), *(const v4u*)(pr + PCH + c0 + 8), chh); }
#pragma unroll
        for (int i = 0; i < 16; ++i) u1[i] = cc[i] * chh[i];
    }
#pragma unroll 2
    for (int it = 0; it < 8; ++it) { const int t = tfirst + it; const bf16* pr = proj + (size_t)t * NP;
        float o[16], r[16], cb[16], cc[16], chh[16];
        unpack16(*(const v4u*)(ogla + (size_t)t * 1024 + c0), *(const v4u*)(ogla + (size_t)t * 1024 + c0 + 8), o);
        unpack16(*(const v4u*)(pr + PR + c0), *(const v4u*)(pr + PR + c0 + 8), r);
        unpack16(*(const v4u*)(pr + PCB + c0), *(const v4u*)(pr + PCB + c0 + 8), cb);
        unpack16(*(const v4u*)(pr + PCC + c0), *(const v4u*)(pr + PCC + c0 + 8), cc);
        unpack16(*(const v4u*)(pr + PCH + c0), *(const v4u*)(pr + PCH + c0 + 8), chh);
        float ss = 0.f;
#pragma unroll
        for (int i = 0; i < 16; ++i) ss += o[i] * o[i];
        ss += __shfl_xor(ss, 1); ss += __shfl_xor(ss, 2); ss += __shfl_xor(ss, 4); ss += __shfl_xor(ss, 8);
        const float rg = rsqrtf(ss * (1.0f / 256.f) + EPS);
        float val[16]; float s2 = 0.f;
#pragma unroll
        for (int i = 0; i < 16; ++i) { const float u0 = cc[i] * chh[i]; val[i] = cb[i] * (cw0[i] * u2[i] + cw1[i] * u1[i] + cw2[i] * u0); s2 += val[i] * val[i]; u2[i] = u1[i]; u1[i] = u0; }
        const float rc = rsqrtf(wave_sum(s2) * (1.0f / 1024.f) + EPS);
        v4u y0, y1, y2, y3;
#pragma unroll
        for (int j = 0; j < 4; ++j) {
            y0[j] = pk2(o[2 * j] * rg * gn[2 * j] * silu_f(r[2 * j]), o[2 * j + 1] * rg * gn[2 * j + 1] * silu_f(r[2 * j + 1]));
            y1[j] = pk2(o[8 + 2 * j] * rg * gn[8 + 2 * j] * silu_f(r[8 + 2 * j]), o[9 + 2 * j] * rg * gn[9 + 2 * j] * silu_f(r[9 + 2 * j]));
            y2[j] = pk2(val[2 * j] * rc * cn[2 * j], val[2 * j + 1] * rc * cn[2 * j + 1]);
            y3[j] = pk2(val[8 + 2 * j] * rc * cn[8 + 2 * j], val[9 + 2 * j] * rc * cn[9 + 2 * j]); }
        bf16* yr = ybuf + (size_t)t * D;
        *(v4u*)(yr + c0) = y0; *(v4u*)(yr + c0 + 8) = y1; *(v4u*)(yr + 1024 + c0) = y2; *(v4u*)(yr + 1024 + c0 + 8) = y3;
    }
}

__device__ __forceinline__ void ln1_chunk(const Args& a, int l, LAS unsigned char* lds, int lane, int wave, int ch) {
    const float* zbuf = (const float*)(a.ws + WS_Z); const float* mod = (const float*)(a.ws + WS_MOD);
    const int b = ch / NCH; const float* mb = mod + ((size_t)l * NB + b) * 6 * D;
#pragma unroll 2
    for (int it = 0; it < 8; ++it) { const int t = ch * 64 + wave * 8 + it;
        float z[32];
#pragma unroll
        for (int c = 0; c < 8; ++c) { const f32x4 v0 = *(const f32x4*)(zbuf + (size_t)t * D + (c * 64 + lane) * 4); z[c * 4] = v0.x; z[c * 4 + 1] = v0.y; z[c * 4 + 2] = v0.z; z[c * 4 + 3] = v0.w; }
        ln_tail(z, t, lane, a.in[11] + (size_t)l * D, a.in[12] + (size_t)l * D, (float*)(a.ws + WS_X1), mb + 3 * D, mb + 4 * D, (bf16*)(a.ws + WS_H2), a.ws + WS_HQ8, (float*)(a.ws + WS_HSC), lds + wave * 2304);
    }
}

template <int N> __device__ __forceinline__ void bitonic_sort_desc(float (&v)[N]) {
#pragma unroll
    for (int k = 2; k <= N; k <<= 1)
#pragma unroll
        for (int j = k >> 1; j > 0; j >>= 1)
#pragma unroll
            for (int i = 0; i < N; ++i) { const int p = i ^ j; if (p > i) { const bool desc = ((i & k) == 0); const float x = v[i], y = v[p]; const float mx = fmaxf(x, y), mn = fminf(x, y); v[i] = desc ? mx : mn; v[p] = desc ? mn : mx; } }
}
__device__ __forceinline__ void merge_top16(float (&x)[16], const float (&y)[16]) {
#pragma unroll
    for (int i = 0; i < 16; ++i) x[i] = fmaxf(x[i], y[15 - i]);
#pragma unroll
    for (int j = 8; j > 0; j >>= 1)
#pragma unroll
        for (int i = 0; i < 16; ++i) { const int p = i ^ j; if (p > i) { const float u = x[i], w = x[p]; x[i] = fmaxf(u, w); x[p] = fminf(u, w); } }
}
__device__ __forceinline__ void ce_desc(float& ka, int& pa, float& kb, int& pb) { const bool sw = kb > ka; const float k0 = sw ? kb : ka, k1 = sw ? ka : kb; const int p0 = sw ? pb : pa, p1 = sw ? pa : pb; ka = k0; pa = p0; kb = k1; pb = p1; }
__device__ __forceinline__ void bitonic_sort_desc_kp(float (&k)[16], int (&p)[16]) {
#pragma unroll
    for (int kk = 2; kk <= 16; kk <<= 1)
#pragma unroll
        for (int j = kk >> 1; j > 0; j >>= 1)
#pragma unroll
            for (int i = 0; i < 16; ++i) { const int q = i ^ j; if (q > i) { if ((i & kk) == 0) ce_desc(k[i], p[i], k[q], p[q]); else ce_desc(k[q], p[q], k[i], p[i]); } }
}
__device__ __forceinline__ void merge_top16_kp(float (&k)[16], int (&p)[16], const float (&k2)[16], const int (&p2)[16]) {
#pragma unroll
    for (int i = 0; i < 16; ++i) { const bool sw = k2[15 - i] > k[i]; k[i] = sw ? k2[15 - i] : k[i]; p[i] = sw ? p2[15 - i] : p[i]; }
#pragma unroll
    for (int j = 8; j > 0; j >>= 1)
#pragma unroll
        for (int i = 0; i < 16; ++i) { const int q = i ^ j; if (q > i) ce_desc(k[i], p[i], k[q], p[q]); }
}
__device__ constexpr int cand_i(int s) { return s < 16 ? 0 : s < 24 ? 1 : s < 29 ? 2 : s < 33 ? 3 : s < 36 ? 4 : s < 38 ? 5 : s < 40 ? 6 : s < 42 ? 7 : s < 50 ? s - 34 : -1; }
__device__ constexpr int cand_j(int s) { return s < 16 ? s : s < 24 ? s - 16 : s < 29 ? s - 24 : s < 33 ? s - 29 : s < 36 ? s - 33 : s < 38 ? s - 36 : s < 40 ? s - 38 : s < 42 ? s - 40 : s < 50 ? 0 : -1; }

__device__ __forceinline__ void peer_retrieve(const Args& a, int l, LAS unsigned char* lds, int lane, int wave, int ch) {
    const bf16* qbuf = (const bf16*)(a.ws + WS_Q); const bf16* keys = (const bf16*)(a.ws + WS_KEYS) + ((size_t)(l * 8 + wave) * 2) * 128 * 128;
    LAS int* eg_e = (LAS int*)lds; LAS float* eg_g = (LAS float*)(lds + 32768);
    const int l31 = lane & 31, l5 = lane >> 5, h = wave, t0 = ch * 64;
    for (int tt = 0; tt < 2; ++tt) {
        float sv[2][16];
#pragma unroll
        for (int p = 0; p < 2; ++p) {
            f32x16 acc[4];
#pragma unroll
            for (int nt = 0; nt < 4; ++nt)
#pragma unroll
                for (int r = 0; r < 16; ++r) acc[nt][r] = 0.f;
            const bf16* qp = qbuf + (size_t)(t0 + 32 * tt + l31) * D + h * 256 + p * 128 + 8 * l5;
            const bf16* kp = keys + (size_t)(p * 128 + l31) * 128 + 8 * l5;
#pragma unroll 2
            for (int ks = 0; ks < 8; ++ks) { const bf16x8 bq = *(const bf16x8*)(qp + 16 * ks);
#pragma unroll
                for (int nt = 0; nt < 4; ++nt) { const bf16x8 ak = *(const bf16x8*)(kp + (size_t)(32 * nt) * 128 + 16 * ks); acc[nt] = __builtin_amdgcn_mfma_f32_32x32x16_bf16(ak, bq, acc[nt], 0, 0, 0); } }
            float v[4][16];
#pragma unroll
            for (int nt = 0; nt < 4; ++nt)
#pragma unroll
                for (int r = 0; r < 16; ++r) { const unsigned idx = 32u * nt + (r & 3) + 8u * (r >> 2) + 4u * l5; v[nt][r] = __uint_as_float((__float_as_uint(acc[nt][r]) & 0xffffff80u) | idx); }
#pragma unroll
            for (int nt = 0; nt < 4; ++nt) bitonic_sort_desc<16>(v[nt]);
            merge_top16(v[0], v[1]); merge_top16(v[2], v[3]); merge_top16(v[0], v[2]);
            float o[16];
#pragma unroll
            for (int i = 0; i < 16; ++i) o[i] = __shfl_xor(v[0][i], 32);
            merge_top16(v[0], o);
#pragma unroll
            for (int i = 0; i < 16; ++i) sv[p][i] = v[0][i];
        }
        LAS unsigned char* idxb = (LAS unsigned char*)(lds + 69632) + wave * 2048 + lane * 32;
        { v4u w0, w1;
#pragma unroll
          for (int q4 = 0; q4 < 4; ++q4) {
              w0[q4] = (__float_as_uint(sv[0][4 * q4]) & 127u) | ((__float_as_uint(sv[0][4 * q4 + 1]) & 127u) << 8) | ((__float_as_uint(sv[0][4 * q4 + 2]) & 127u) << 16) | ((__float_as_uint(sv[0][4 * q4 + 3]) & 127u) << 24);
              w1[q4] = (__float_as_uint(sv[1][4 * q4]) & 127u) | ((__float_as_uint(sv[1][4 * q4 + 1]) & 127u) << 8) | ((__float_as_uint(sv[1][4 * q4 + 2]) & 127u) << 16) | ((__float_as_uint(sv[1][4 * q4 + 3]) & 127u) << 24); }
          *(LAS v4u*)(idxb) = w0; *(LAS v4u*)(idxb + 16) = w1; }
        float ck[4][16];
#pragma unroll
        for (int s = 0; s < 64; ++s) {
            if (cand_i(s) >= 0) { const unsigned b0 = __float_as_uint(sv[0][cand_i(s) < 0 ? 0 : cand_i(s)]), b1 = __float_as_uint(sv[1][cand_j(s) < 0 ? 0 : cand_j(s)]);
                const float sum = __uint_as_float(b0 & 0xffffff80u) + __uint_as_float(b1 & 0xffffff80u);
                ck[s >> 4][s & 15] = __uint_as_float((__float_as_uint(sum) & 0xffffff00u) | (unsigned)((cand_i(s) < 0 ? 0 : cand_i(s)) * 16 + (cand_j(s) < 0 ? 0 : cand_j(s)))); }
            else ck[s >> 4][s & 15] = -3.0e38f; }
        bitonic_sort_desc<16>(ck[1]); bitonic_sort_desc<16>(ck[2]);
        merge_top16(ck[0], ck[1]); merge_top16(ck[2], ck[3]); merge_top16(ck[0], ck[2]);
        LDS_WAIT(); asm volatile("" ::: "memory");
        float ex[16]; int ce[16]; float den = 0.f;
        const float cmax = __uint_as_float(__float_as_uint(ck[0][0]) & 0xffffff00u);
#pragma unroll
        for (int i = 0; i < 16; ++i) { const unsigned bits = __float_as_uint(ck[0][i]); ex[i] = __expf(__uint_as_float(bits & 0xffffff00u) - cmax); den += ex[i];
            ce[i] = (int)idxb[(bits >> 4) & 15u] * 128 + (int)idxb[16 + (bits & 15u)]; }
        const float inv = 1.0f / den;
        if (l5 == 0) {
            const int base = (32 * tt + l31) * 128 + h * 16;
#pragma unroll
            for (int i4 = 0; i4 < 4; ++i4) { *(LAS v4u*)(eg_e + base + 4 * i4) = (v4u){(unsigned)ce[4 * i4], (unsigned)ce[4 * i4 + 1], (unsigned)ce[4 * i4 + 2], (unsigned)ce[4 * i4 + 3]};
                *(LAS f32x4*)(eg_g + base + 4 * i4) = (f32x4){ex[4 * i4] * inv, ex[4 * i4 + 1] * inv, ex[4 * i4 + 2] * inv, ex[4 * i4 + 3] * inv}; }
        }
        LDS_WAIT(); asm volatile("" ::: "memory");
    }
}

typedef unsigned char uc4 __attribute__((ext_vector_type(4)));
constexpr int NSLICE = 16, SLICE_SHIFT = 10;
__device__ __forceinline__ int sdot4i(unsigned w, unsigned x, int acc) { return __builtin_amdgcn_sdot4((int)w, (int)x, acc, false); }
__device__ __forceinline__ void fma_ub4(unsigned w, float s, float& y0, float& y1, float& y2, float& y3) { const uc4 b = __builtin_bit_cast(uc4, w); y0 += s * (float)b.x; y1 += s * (float)b.y; y2 += s * (float)b.z; y3 += s * (float)b.w; }
#if TAB4
__device__ __forceinline__ void peer_tail(const Args& a, int l, int t, int lane, const bf16* Yrow, const float* mb, const float* mbn, bool last) {
    const float* x1buf = (const float*)(a.ws + WS_X1);
    float z[32];
#pragma unroll
    for (int c8 = 0; c8 < 8; ++c8) { const int col = (c8 * 64 + lane) * 4;
        const v2u yb = *(const v2u*)(Yrow + col); const f32x4 yv = (f32x4){bflo(yb.x), bfhi(yb.x), bflo(yb.y), bfhi(yb.y)};
        const f32x4 x0 = *(const f32x4*)(x1buf + (size_t)t * D + col), g0 = *(const f32x4*)(mb + 5 * D + col);
        z[c8 * 4] = ALPHA * x0.x + (1.f + g0.x) * yv.x; z[c8 * 4 + 1] = ALPHA * x0.y + (1.f + g0.y) * yv.y; z[c8 * 4 + 2] = ALPHA * x0.z + (1.f + g0.z) * yv.z; z[c8 * 4 + 3] = ALPHA * x0.w + (1.f + g0.w) * yv.w; }
    ln_tail(z, t, lane, a.in[17] + (size_t)l * D, a.in[18] + (size_t)l * D, last ? a.out : (float*)(a.ws + WS_X), mbn, mbn + D, last ? (bf16*)nullptr : (bf16*)(a.ws + WS_H), nullptr, nullptr);
}
template <class TT, int N, int M> __device__ __forceinline__ void treduce(TT (&v)[N], int lane) {
    const bool c0 = (lane & M) != 0, c1 = (lane & (2 * M)) != 0, c2 = (lane & (4 * M)) != 0;
#pragma unroll
    for (int m = 0; m < N / 2; ++m) { const TT keep = c0 ? v[2 * m + 1] : v[2 * m], send = c0 ? v[2 * m] : v[2 * m + 1]; v[m] = keep + __shfl_xor(send, M); }
#pragma unroll
    for (int m = 0; m < N / 4; ++m) { const TT keep = c1 ? v[2 * m + 1] : v[2 * m], send = c1 ? v[2 * m] : v[2 * m + 1]; v[m] = keep + __shfl_xor(send, 2 * M); }
#pragma unroll
    for (int m = 0; m < N / 8; ++m) { const TT keep = c2 ? v[2 * m + 1] : v[2 * m], send = c2 ? v[2 * m] : v[2 * m + 1]; v[m] = keep + __shfl_xor(send, 4 * M); }
}
__device__ __forceinline__ void tr4x4(unsigned a, unsigned b, unsigned c, unsigned d, unsigned& t0, unsigned& t1, unsigned& t2, unsigned& t3) {
    const unsigned x0 = __builtin_amdgcn_perm(b, a, 0x05010400u), x1 = __builtin_amdgcn_perm(b, a, 0x07030602u), y0 = __builtin_amdgcn_perm(d, c, 0x05010400u), y1 = __builtin_amdgcn_perm(d, c, 0x07030602u);
    t0 = __builtin_amdgcn_perm(y0, x0, 0x05040100u); t1 = __builtin_amdgcn_perm(y0, x0, 0x07060302u); t2 = __builtin_amdgcn_perm(y1, x1, 0x05040100u); t3 = __builtin_amdgcn_perm(y1, x1, 0x07060302u);
}
__device__ __forceinline__ int sdot8i(unsigned w, unsigned x, int acc) { return __builtin_amdgcn_sdot8((int)w, (int)x, acc, false); }
__device__ __forceinline__ float slot_scale(unsigned w3) { return __builtin_amdgcn_exp2f((float)(w3 >> 24) * 0.125f - 16.0f); }
__device__ __forceinline__ void peer_experts(const Args& a, int l, LAS unsigned char* lds, int lane0, int wave, int ch) {
    const float* mod = (const float*)(a.ws + WS_MOD);
    const unsigned char* ut = a.ws + WS_UT + (size_t)l * NE * 1152; const unsigned char* vt = a.ws + WS_VT + (size_t)l * NE * 1152; const unsigned char* hq8 = a.ws + WS_HQ8;
    const float* hsc = (const float*)(a.ws + WS_HSC);
    bf16* Ybuf = (bf16*)(a.ws + WS_Z);
    const LAS int* eg_e = (const LAS int*)lds; LAS float* sw = (LAS float*)(lds + 32768);
    LAS float* apart = (LAS float*)(lds + 65536);
    const int b = ch / NCH; const bool last = (l == NL - 1);
    const float* mb = mod + ((size_t)l * NB + b) * 6 * D; const float* mbn = mod + ((size_t)(last ? l : l + 1) * NB + b) * 6 * D;
    const int tlw = wave * 8;
    { const int lane = lane0;
#pragma unroll
      for (int i = 0; i < 16; ++i) apart[tlw * 128 + i * 64 + lane] = 0.f; }
    LDS_WAIT(); asm volatile("" ::: "memory");
    {
        int laneL = lane0; asm volatile("" : "+v"(laneL)); const int lane = laneL;
        const int g = lane >> 3, l7 = lane & 7;
        v4u bufA[16], bufB[16], hA0, hA1, hB0, hB1;
#define CU_LOAD(buf, h0_, h1_, idx_) do { const int u_ = (idx_) >> 3, tl_ = tlw + ((idx_) & 7); const unsigned soff_ = (unsigned)(u_ * 128 + l7 * 16); \
            const unsigned char* hp_ = hq8 + (size_t)(ch * 64 + tl_) * 2304 + (u_ * 8 + l7) * 32; h0_ = *(const v4u*)hp_; h1_ = *(const v4u*)(hp_ + 16); \
            _Pragma("unroll") for (int i_ = 0; i_ < 16; ++i_) { const unsigned e_ = (unsigned)eg_e[tl_ * 128 + 8 * i_ + g]; buf[i_] = *(const v4u*)(ut + (size_t)(e_ * 1152u + soff_)); } } while (0)
#define CU_COMP(buf, h0_, h1_, idx_) do { const int tl_ = tlw + ((idx_) & 7); float accv_[16]; \
            _Pragma("unroll") for (int i_ = 0; i_ < 16; ++i_) { int sl_ = 0, sh_ = 0; \
                _Pragma("unroll") for (int d_ = 0; d_ < 4; ++d_) { const unsigned x_ = buf[i_][d_] ^ 0x88888888u; sl_ = sdot8i(x_, h0_[d_], sl_); sh_ = sdot8i(x_, h1_[d_], sh_); } \
                accv_[i_] = slot_scale(buf[i_][3]) * (float)(16 * sh_ + sl_); } \
            treduce<float, 16, 1>(accv_, lane); \
            apart[tl_ * 128 + 8 * l7 + g] += accv_[0]; apart[tl_ * 128 + 8 * (8 + l7) + g] += accv_[1]; } while (0)
        CU_LOAD(bufA, hA0, hA1, 0);
        for (int idx = 0; idx < 72; idx += 2) {
            CU_LOAD(bufB, hB0, hB1, idx + 1);
            CU_COMP(bufA, hA0, hA1, idx);
            { const int nx_ = idx + 2 < 72 ? idx + 2 : 71; CU_LOAD(bufA, hA0, hA1, nx_); }
            CU_COMP(bufB, hB0, hB1, idx + 1);
        }
#undef CU_LOAD
#undef CU_COMP
        LDS_WAIT(); asm volatile("" ::: "memory");
        for (int it = 0; it < 8; ++it) { const int tl = tlw + it; const float shs = hsc[ch * 64 + tl];
            const float w0 = sw[tl * 128 + lane] * gelu_tanh_f(apart[tl * 128 + lane] * shs), w1 = sw[tl * 128 + 64 + lane] * gelu_tanh_f(apart[tl * 128 + 64 + lane] * shs);
            sw[tl * 128 + lane] = w0; sw[tl * 128 + 64 + lane] = w1; }
        LDS_WAIT(); asm volatile("" ::: "memory");
    }
    {
        int laneL = lane0; asm volatile("" : "+v"(laneL)); const int lane = laneL;
        const int g = lane >> 3, l7 = lane & 7;
        v4u bufA[16], bufB[16];
#define CV_LOAD(buf, idx_) do { const int u_ = (idx_) >> 3, tl_ = tlw + ((idx_) & 7); const unsigned soff_ = (unsigned)(u_ * 128 + l7 * 16); \
            _Pragma("unroll") for (int i_ = 0; i_ < 16; ++i_) { const unsigned e_ = (unsigned)eg_e[tl_ * 128 + 8 * i_ + g]; buf[i_] = *(const v4u*)(vt + (size_t)(e_ * 1152u + soff_)); } } while (0)
#define CV_COMP(buf, idx_) do { const int u_ = (idx_) >> 3, tl_ = tlw + ((idx_) & 7); \
            float wf_[16]; float wmx_ = 0.f; \
            _Pragma("unroll") for (int i_ = 0; i_ < 16; ++i_) { wf_[i_] = sw[tl_ * 128 + 8 * i_ + g] * slot_scale(buf[i_][3]); wmx_ = fmaxf(wmx_, fabsf(wf_[i_])); } \
            wmx_ = fmaxf(wmx_, __shfl_xor(wmx_, 8)); wmx_ = fmaxf(wmx_, __shfl_xor(wmx_, 16)); wmx_ = fmaxf(wmx_, __shfl_xor(wmx_, 32));     \
            const float winv_ = wmx_ > 0.f ? 127.0f / wmx_ : 0.f, wsc_ = wmx_ * (1.0f / 127.0f); \
              \
            unsigned wq4_[4]; int wsum_ = 0; \
            _Pragma("unroll") for (int gp_ = 0; gp_ < 4; ++gp_) { \
                const unsigned m0_ = __float_as_uint(wf_[4 * gp_] * winv_ + 12582912.0f), m1_ = __float_as_uint(wf_[4 * gp_ + 1] * winv_ + 12582912.0f), m2_ = __float_as_uint(wf_[4 * gp_ + 2] * winv_ + 12582912.0f), m3_ = __float_as_uint(wf_[4 * gp_ + 3] * winv_ + 12582912.0f); \
                wq4_[gp_] = __builtin_amdgcn_perm(__builtin_amdgcn_perm(m3_, m2_, 0x0c0c0400u), __builtin_amdgcn_perm(m1_, m0_, 0x0c0c0400u), 0x05040100u); \
                wsum_ = sdot4i(wq4_[gp_], 0x01010101u, wsum_); } \
            int yi_[32]; \
            _Pragma("unroll") for (int q_ = 0; q_ < 32; ++q_) yi_[q_] = 0; \
            _Pragma("unroll") for (int gp_ = 0; gp_ < 4; ++gp_) { \
                _Pragma("unroll") for (int d_ = 0; d_ < 4; ++d_) { const unsigned A_ = buf[4 * gp_][d_], B_ = buf[4 * gp_ + 1][d_], C_ = buf[4 * gp_ + 2][d_], D_ = buf[4 * gp_ + 3][d_]; \
                    unsigned t0_, t1_, t2_, t3_; \
                    tr4x4(A_, B_, C_, D_, t0_, t1_, t2_, t3_);     \
                    yi_[8 * d_]     = sdot4i(t0_ & 0x0f0f0f0fu, wq4_[gp_], yi_[8 * d_]);     yi_[8 * d_ + 1] = sdot4i((t0_ >> 4) & 0x0f0f0f0fu, wq4_[gp_], yi_[8 * d_ + 1]); \
                    yi_[8 * d_ + 2] = sdot4i(t1_ & 0x0f0f0f0fu, wq4_[gp_], yi_[8 * d_ + 2]); yi_[8 * d_ + 3] = sdot4i((t1_ >> 4) & 0x0f0f0f0fu, wq4_[gp_], yi_[8 * d_ + 3]); \
                    yi_[8 * d_ + 4] = sdot4i(t2_ & 0x0f0f0f0fu, wq4_[gp_], yi_[8 * d_ + 4]); yi_[8 * d_ + 5] = sdot4i((t2_ >> 4) & 0x0f0f0f0fu, wq4_[gp_], yi_[8 * d_ + 5]); \
                    yi_[8 * d_ + 6] = sdot4i(t3_ & 0x0f0f0f0fu, wq4_[gp_], yi_[8 * d_ + 6]); yi_[8 * d_ + 7] = sdot4i((t3_ >> 4) & 0x0f0f0f0fu, wq4_[gp_], yi_[8 * d_ + 7]); } } \
            treduce<int, 32, 8>(yi_, lane); \
            wsum_ += __shfl_xor(wsum_, 8); wsum_ += __shfl_xor(wsum_, 16); wsum_ += __shfl_xor(wsum_, 32);     \
            float y_[4]; \
            _Pragma("unroll") for (int q_ = 0; q_ < 4; ++q_) y_[q_] = wsc_ * (float)(yi_[q_] - 8 * wsum_); \
            { const int colb_ = u_ * 240 + l7 * 30 + g; bf16* yr_ = Ybuf + (size_t)(ch * 64 + tl_) * D + colb_; \
              _Pragma("unroll") for (int m_ = 0; m_ < 4; ++m_) if (8 * m_ + g < 30 && colb_ + 8 * m_ < D) yr_[8 * m_] = (bf16)(pk2(y_[m_], 0.f) & 0xffffu); } } while (0)
        CV_LOAD(bufA, 0);
        for (int idx = 0; idx < 72; idx += 2) {
            CV_LOAD(bufB, idx + 1);
            CV_COMP(bufA, idx);
            { const int nx_ = idx + 2 < 72 ? idx + 2 : 71; CV_LOAD(bufA, nx_); }
            CV_COMP(bufB, idx + 1);
        }
#undef CV_LOAD
#undef CV_COMP
    }
    asm volatile("s_waitcnt vmcnt(0)" ::: "memory");
    __builtin_amdgcn_fence(__ATOMIC_ACQUIRE, "agent");
    asm volatile("s_waitcnt vmcnt(0)" ::: "memory");
    for (int it = 0; it < 8; ++it) { int laneT = lane0; asm volatile("" : "+v"(laneT)); const int t = ch * 64 + tlw + it;
        peer_tail(a, l, t, laneT, Ybuf + (size_t)t * D, mb, mbn, last); }
}
#else
__device__ __forceinline__ void peer_tail(const Args& a, int l, int t, int lane, const float* Yrow, const float* mb, const float* mbn, bool last) {
    const float* x1buf = (const float*)(a.ws + WS_X1);
    float z[32];
#pragma unroll
    for (int c = 0; c < 2; ++c)
#pragma unroll
        for (int k = 0; k < 4; ++k) { const int c8 = 4 * c + k, col = (c8 * 64 + lane) * 4;
            const v2u yb = *(const v2u*)((const bf16*)Yrow + (c * 64 + lane) * 16 + 4 * k); const f32x4 yv = (f32x4){bflo(yb.x), bfhi(yb.x), bflo(yb.y), bfhi(yb.y)};
            const f32x4 x0 = *(const f32x4*)(x1buf + (size_t)t * D + col), g0 = *(const f32x4*)(mb + 5 * D + col);
            z[c8 * 4] = ALPHA * x0.x + (1.f + g0.x) * yv.x; z[c8 * 4 + 1] = ALPHA * x0.y + (1.f + g0.y) * yv.y; z[c8 * 4 + 2] = ALPHA * x0.z + (1.f + g0.z) * yv.z; z[c8 * 4 + 3] = ALPHA * x0.w + (1.f + g0.w) * yv.w; }
    ln_tail(z, t, lane, a.in[17] + (size_t)l * D, a.in[18] + (size_t)l * D, last ? a.out : (float*)(a.ws + WS_X), mbn, mbn + D, last ? (bf16*)nullptr : (bf16*)(a.ws + WS_H), nullptr, nullptr);
}
template <class TT, int M> __device__ __forceinline__ void treduce16(TT (&v)[16], int lane) {
    const bool c0 = (lane & M) != 0, c1 = (lane & (2 * M)) != 0, c2 = (lane & (4 * M)) != 0;
#pragma unroll
    for (int m = 0; m < 8; ++m) { const TT keep = c0 ? v[2 * m + 1] : v[2 * m], send = c0 ? v[2 * m] : v[2 * m + 1]; v[m] = keep + __shfl_xor(send, M); }
#pragma unroll
    for (int m = 0; m < 4; ++m) { const TT keep = c1 ? v[2 * m + 1] : v[2 * m], send = c1 ? v[2 * m] : v[2 * m + 1]; v[m] = keep + __shfl_xor(send, 2 * M); }
#pragma unroll
    for (int m = 0; m < 2; ++m) { const TT keep = c2 ? v[2 * m + 1] : v[2 * m], send = c2 ? v[2 * m] : v[2 * m + 1]; v[m] = keep + __shfl_xor(send, 4 * M); }
}
__device__ __forceinline__ void peer_experts(const Args& a, int l, LAS unsigned char* lds, int lane0, int wave, int ch) {
    const float* mod = (const float*)(a.ws + WS_MOD);
    const unsigned char* ut = a.ws + WS_UT + (size_t)l * NE * D; const unsigned char* vt = a.ws + WS_VT + (size_t)l * NE * D; const unsigned char* hq8 = a.ws + WS_HQ8;
    const float* su = (const float*)(a.ws + WS_SU) + (size_t)l * NE; const float* sv = (const float*)(a.ws + WS_SV) + (size_t)l * NE; const float* hsc = (const float*)(a.ws + WS_HSC);
    float* Ybuf = (float*)(a.ws + WS_Z);
    const LAS int* eg_e = (const LAS int*)lds; LAS float* sw = (LAS float*)(lds + 32768);
    LAS int* apart = (LAS int*)(lds + 65536); LAS float* wtotl = (LAS float*)(lds + LDSCTL_OFF + 256);
    const int b = ch / NCH; const bool last = (l == NL - 1);
    const float* mb = mod + ((size_t)l * NB + b) * 6 * D; const float* mbn = mod + ((size_t)(last ? l : l + 1) * NB + b) * 6 * D;
    const int tlw = wave * 8;
    { const int lane = lane0;
#pragma unroll
      for (int i = 0; i < 16; ++i) apart[tlw * 128 + i * 64 + lane] = 0; }
    LDS_WAIT(); asm volatile("" ::: "memory");
    {
        int laneL = lane0; asm volatile("" : "+v"(laneL)); const int lane = laneL;
        const int g = lane >> 3, l7 = lane & 7;
        v4u bufA[16], bufB[16], hA, hB;
#define CU_LOAD(buf, hh_, idx_) do { const int cs_ = (idx_) >> 3, tl_ = tlw + ((idx_) & 7); const unsigned coff_ = (unsigned)(cs_ * 128 + l7 * 16); \
            hh_ = *(const v4u*)(hq8 + (size_t)(ch * 64 + tl_) * D + coff_); \
            _Pragma("unroll") for (int i_ = 0; i_ < 16; ++i_) { const unsigned e_ = (unsigned)eg_e[tl_ * 128 + 8 * i_ + g]; buf[i_] = *(const v4u*)(ut + (size_t)(e_ * 2048u + coff_)); } } while (0)
#define CU_COMP(buf, hh_, idx_) do { const int tl_ = tlw + ((idx_) & 7); int acc_[16]; \
            _Pragma("unroll") for (int i_ = 0; i_ < 16; ++i_) { int s_ = 0; _Pragma("unroll") for (int q_ = 0; q_ < 4; ++q_) s_ = sdot4i(buf[i_][q_], hh_[q_], s_); acc_[i_] = s_; } \
            treduce16<int, 1>(acc_, lane); \
            apart[tl_ * 128 + 8 * l7 + g] += acc_[0]; apart[tl_ * 128 + 8 * (8 + l7) + g] += acc_[1]; } while (0)
        CU_LOAD(bufA, hA, 0);
        for (int idx = 0; idx < 128; idx += 2) {
            CU_LOAD(bufB, hB, idx + 1);
            CU_COMP(bufA, hA, idx);
            if (idx + 2 < 128) CU_LOAD(bufA, hA, idx + 2);
            CU_COMP(bufB, hB, idx + 1);
        }
#undef CU_LOAD
#undef CU_COMP
        LDS_WAIT(); asm volatile("" ::: "memory");
        for (int it = 0; it < 8; ++it) { const int tl = tlw + it; const float shs = hsc[ch * 64 + tl];
            const int e0 = eg_e[tl * 128 + lane], e1 = eg_e[tl * 128 + 64 + lane];
            const float w0 = sw[tl * 128 + lane] * gelu_tanh_f((float)apart[tl * 128 + lane] * su[e0] * shs) * sv[e0];
            const float w1 = sw[tl * 128 + 64 + lane] * gelu_tanh_f((float)apart[tl * 128 + 64 + lane] * su[e1] * shs) * sv[e1];
            sw[tl * 128 + lane] = w0; sw[tl * 128 + 64 + lane] = w1;
            const float ws = wave_sum(w0 + w1);
            if (lane == 0) wtotl[tl] = ws; }
        LDS_WAIT(); asm volatile("" ::: "memory");
    }
    {
        int laneL = lane0; asm volatile("" : "+v"(laneL)); const int lane = laneL;
        const int g = lane >> 3, l7 = lane & 7;
        v4u bufA[16], bufB[16];
#define CV_LOAD(buf, idx_) do { const int cs_ = (idx_) >> 3, tl_ = tlw + ((idx_) & 7); const unsigned coff_ = (unsigned)(cs_ * 128 + l7 * 16); \
            _Pragma("unroll") for (int i_ = 0; i_ < 16; ++i_) { const unsigned e_ = (unsigned)eg_e[tl_ * 128 + 8 * i_ + g]; buf[i_] = *(const v4u*)(vt + (size_t)(e_ * 2048u + coff_)); } } while (0)
#define CV_COMP(buf, idx_) do { const int cs_ = (idx_) >> 3, tl_ = tlw + ((idx_) & 7); float y_[16]; \
            _Pragma("unroll") for (int q_ = 0; q_ < 16; ++q_) y_[q_] = 0.f; \
            _Pragma("unroll") for (int i_ = 0; i_ < 16; ++i_) { const float wr_ = sw[tl_ * 128 + 8 * i_ + g]; \
                _Pragma("unroll") for (int q_ = 0; q_ < 4; ++q_) fma_ub4(buf[i_][q_], wr_, y_[4 * q_], y_[4 * q_ + 1], y_[4 * q_ + 2], y_[4 * q_ + 3]); } \
            treduce16<float, 8>(y_, lane); \
            const float woff_ = 128.0f * wtotl[tl_]; bf16* yr_ = (bf16*)Ybuf + (size_t)(ch * 64 + tl_) * D + cs_ * 128 + l7 * 16 + g; \
            yr_[0] = (bf16)(pk2(y_[0] - woff_, 0.f) & 0xffffu); yr_[8] = (bf16)(pk2(y_[1] - woff_, 0.f) & 0xffffu); } while (0)
        CV_LOAD(bufA, 0);
        for (int idx = 0; idx < 128; idx += 2) {
            CV_LOAD(bufB, idx + 1);
            CV_COMP(bufA, idx);
            if (idx + 2 < 128) CV_LOAD(bufA, idx + 2);
            CV_COMP(bufB, idx + 1);
        }
#undef CV_LOAD
#undef CV_COMP
    }
    asm volatile("s_waitcnt vmcnt(0)" ::: "memory");
    __builtin_amdgcn_fence(__ATOMIC_ACQUIRE, "agent");
    asm volatile("s_waitcnt vmcnt(0)" ::: "memory");
    for (int it = 0; it < 8; ++it) { int laneT = lane0; asm volatile("" : "+v"(laneT)); const int t = ch * 64 + tlw + it;
        peer_tail(a, l, t, laneT, (const float*)((const bf16*)Ybuf + (size_t)t * D), mb, mbn, last); }
}

#endif

#ifndef MK_PER_PHASE
#define MK_PER_PHASE 0
#endif
__global__ void __launch_bounds__(NTHREADS, 2) mk_fwd(Args a) {
    extern __shared__ __attribute__((aligned(16))) unsigned char lds_raw[];
    LAS unsigned char* lds = (LAS unsigned char*)lds_raw;
    const int tid = threadIdx.x, lane = tid & 63, wave = __builtin_amdgcn_readfirstlane(tid >> 6), G = gridDim.x, bx = blockIdx.x;
    if (tid < 64) ((LAS unsigned*)(lds + LDSCTL_OFF))[tid] = 0u;
    __syncthreads();
    unsigned* ctl = (unsigned*)(a.ws + WS_CTL);
    XcdBarrier bar; bar.bar = ctl + CW_BAR; bar.x = 0; bar.st = nullptr;
    const bool use_bar = (a.ph_hi - a.ph_lo) > 1;
    if (use_bar) bar = xcd_barrier_post(ctl + CW_BAR, (volatile LAS unsigned*)(lds + LDSCTL_OFF));
    const int lo = a.ph_lo, hi = a.ph_hi;
#ifndef PH_MASK
#define PH_MASK 0x1ff
#endif
#define IN(k) (lo <= (k) && (k) < hi)
#define EN(b) ((PH_MASK >> (b)) & 1)
#ifndef REP_MASK
#define REP_MASK 0
#endif
#ifndef REP_EXTRA
#define REP_EXTRA 2
#endif
#define REPS(b) (1 + ((REP_MASK >> (b)) & 1) * REP_EXTRA)
#define REP_BEGIN(b) for (int rep_ = 0; rep_ < REPS(b); ++rep_) {
#define REP_END(b) if (rep_ + 1 < REPS(b)) xcd_barrier(bar); }
#define SEAM(k) do { if (IN((k) + 1)) xcd_barrier(bar); } while (0)
#define PHASE_IDS() int tidp = tid; asm volatile("" : "+v"(tidp)); const int lanep = tidp & 63, wavep = __builtin_amdgcn_readfirstlane(tidp >> 6); (void)lanep; (void)wavep
    if (EN(0) && IN(0)) { REP_BEGIN(0) PHASE_IDS(); ph_prologue_a(a, lds, tidp, lanep, wavep, bx, G); REP_END(0) SEAM(0); }
    if (EN(1) && IN(1)) { REP_BEGIN(1) PHASE_IDS(); ph_prologue_b(a, lds, tidp, lanep, wavep, bx, G); REP_END(1) SEAM(1); }
    for (int l = 0; l < NL; ++l) {
        const int pb = 2 + 7 * l;
        const float* mod = (const float*)(a.ws + WS_MOD);
        if (EN(2) && IN(pb + 0)) {
            REP_BEGIN(2) PHASE_IDS();
            pg8::Gemm g{(const pg8::bf16_t*)(a.ws + WS_H), (const pg8::bf16_t*)(a.ws + WS_WIN) + (size_t)l * INW * D, T, NP, D}; pg8::StaticOrder S; S.init(T, NP, G, bx, WGM_IN);
            pg8::EpiBf16P E{(pg8::bf16_t*)(a.ws + WS_PROJ), NP};
            pg8::gemm_phase<pg8::EpiBf16P, pg8::StaticOrder, true, true>(lds + RING_OFF, g, S, E, tidp);
            for (int ch = bx; ch < NCHUNK; ch += G) gate_prep(a, l, lds, tidp, lanep, wavep, ch);
            REP_END(2) SEAM(pb + 0);
        }
        if (EN(3) && IN(pb + 1)) { REP_BEGIN(3) PHASE_IDS(); for (int un = bx; un < 256; un += G) gla_unit(a, lds, tidp, lanep, wavep, un); REP_END(3) SEAM(pb + 1); }
        if (EN(4) && IN(pb + 2)) { REP_BEGIN(4) PHASE_IDS(); for (int ch = bx; ch < NCHUNK; ch += G) mixpost_chunk(a, l, lanep, wavep, ch); REP_END(4) SEAM(pb + 2); }
        if (EN(5) && IN(pb + 3)) {
            REP_BEGIN(5) PHASE_IDS();
            pg8::Gemm g{(const pg8::bf16_t*)(a.ws + WS_Y), (const pg8::bf16_t*)(a.ws + WS_WOUT) + (size_t)l * D * D, T, D, D}; pg8::StaticOrder S; S.init(T, D, G, bx, WGM_OUT);
            pg8::EpiResid E{(float*)(a.ws + WS_Z), l == 0 ? a.in[0] : (const float*)(a.ws + WS_X), mod + (size_t)l * NB * 6 * D + 2 * D, ALPHA};
            pg8::gemm_phase<pg8::EpiResid, pg8::StaticOrder, true, true>(lds + RING_OFF, g, S, E, tidp);
            REP_END(5) SEAM(pb + 3);
        }
        if (EN(6) && IN(pb + 4)) { REP_BEGIN(6) PHASE_IDS(); for (int ch = bx; ch < NCHUNK; ch += G) ln1_chunk(a, l, lds, lanep, wavep, ch); REP_END(6) SEAM(pb + 4); }
        if (EN(7) && IN(pb + 5)) {
            REP_BEGIN(7) PHASE_IDS();
            pg8::Gemm g{(const pg8::bf16_t*)(a.ws + WS_H2), (const pg8::bf16_t*)(a.ws + WS_WQ) + (size_t)l * D * D, T, D, D}; pg8::StaticOrder S; S.init(T, D, G, bx, WGM_WQ);
            pg8::EpiBf16P E{(pg8::bf16_t*)(a.ws + WS_Q), D};
            pg8::gemm_phase<pg8::EpiBf16P, pg8::StaticOrder, true, true>(lds + RING_OFF, g, S, E, tidp);
            REP_END(7) SEAM(pb + 5);
        }
#ifndef PEER_DBG
#define PEER_DBG 0
#endif
#ifndef PE_REP_R
#define PE_REP_R 1
#endif
#ifndef L2PROBE
#define L2PROBE 0
#endif
        if (EN(8) && IN(pb + 6)) {
            REP_BEGIN(8)
            for (int ch = bx; ch < NCHUNK; ch += G) { for (int repr_ = 0; repr_ < PE_REP_R; ++repr_) { PHASE_IDS(); peer_retrieve(a, l, lds, lanep, wavep, ch); __syncthreads(); } __syncthreads(); { PHASE_IDS(); peer_experts(a, l, lds, lanep, wavep, ch); } __syncthreads(); }
            REP_END(8) SEAM(pb + 6);
        }
    }
#undef IN
#undef SEAM
}

extern "C" void kernel_launch(void* const* d_in, const int* in_sizes, int n_in, void* d_out, int out_size, void* d_ws, size_t ws_size, hipStream_t stream) {
    static int grid = 0;
    if (grid == 0) {
        if (n_in != 19 || in_sizes[0] != T * D || out_size != T * D || ws_size < WS_END) { fprintf(stderr, "kernel_launch: unexpected shapes / workspace (%d inputs, ws %zu); nothing launched\n", n_in, ws_size); grid = -1; return; }
        int dev = 0, cus = 0, per_cu = 0;
        if (hipGetDevice(&dev) != hipSuccess || hipDeviceGetAttribute(&cus, hipDeviceAttributeMultiprocessorCount, dev) != hipSuccess) { grid = -1; return; }
        if (hipFuncSetAttribute((const void*)mk_fwd, hipFuncAttributeMaxDynamicSharedMemorySize, LDS_BYTES) != hipSuccess) { fprintf(stderr, "kernel_launch: hipFuncSetAttribute failed\n"); grid = -1; return; }
        if (hipOccupancyMaxActiveBlocksPerMultiprocessor(&per_cu, (const void*)mk_fwd, NTHREADS, LDS_BYTES) != hipSuccess || per_cu < 1) fprintf(stderr, "kernel_launch: occupancy query reports %d\n", per_cu);
        (void)hipGetLastError();
        grid = cus;
    }
    if (grid < 0) return;
    if (hipMemsetAsync((char*)d_ws + WS_CTL, 0, CTL_ZERO_BYTES, stream) != hipSuccess) return;
    Args a{};
    for (int i = 0; i < 19; ++i) a.in[i] = (const float*)d_in[i];
    a.out = (float*)d_out; a.ws = (unsigned char*)d_ws;
#if MK_PER_PHASE
    for (int p = 0; p < NPHASES; ++p) { a.ph_lo = p; a.ph_hi = p + 1; hipLaunchKernelGGL(mk_fwd, dim3(grid), dim3(NTHREADS), LDS_BYTES, stream, a); }
#else
    a.ph_lo = 0; a.ph_hi = NPHASES;
    hipLaunchKernelGGL(mk_fwd, dim3(grid), dim3(NTHREADS), LDS_BYTES, stream, a);
#endif
}
```

```cpp
#include <hip/hip_runtime.h>
#include <cstdio>
#include <cstdint>
namespace pg8 {
#define PG8_LAS __attribute__((address_space(3)))
typedef unsigned short bf16_t;
typedef short bf16x8 __attribute__((ext_vector_type(8)));
typedef float f32x4 __attribute__((ext_vector_type(4)));
typedef unsigned u32x4 __attribute__((ext_vector_type(4)));
typedef int i32x4 __attribute__((ext_vector_type(4)));
constexpr int BM = 256, BK = 64, HALF = 128, HTB = HALF * BK * 2  , STAGE_BYTES = 8 * HTB, NXCD = 8, WGM = 8;

__host__ __device__ __forceinline__ int lds_byte(int r, int c) { const int st = (r >> 4) * 2 + (c >> 5), rr = r & 15, cc = c & 31, ob = rr * 64 + cc * 2; return st * 1024 + (ob ^ (((ob >> 9) & 1) << 5)); }
__host__ __device__ __forceinline__ void stage_rc(int b, int& R, int& C) { const int st = b / 1024, sb = b % 1024, swz = sb ^ (((sb >> 9) & 1) << 5); R = (st >> 1) * 16 + swz / 64; C = (st & 1) * 32 + (swz % 64) / 2; }
__host__ __device__ __forceinline__ int perm32(int rho) { const int n = rho >> 4, i = rho & 15; return 8 * (i >> 2) + 4 * n + (i & 3); }

struct Unit { int pm, pn; };
struct Gemm { const bf16_t* A; const bf16_t* Bt; int M, N, K; };

struct StaticOrder {
    int nM, nN, nwg, G, c, wgm;
    __host__ __device__ void init(int M, int N, int G_, int c_, int wgm_ = WGM) { nM = M / BM; nN = N / BM; nwg = nM * nN; G = G_; c = c_; wgm = wgm_; }
    __host__ __device__ bool next(int i, Unit& u) const {
        const long L = (long)i * G + c; if (L >= nwg) return false;
        int wgid = (int)L; { const int q = nwg / NXCD, r = nwg % NXCD, xcd = wgid % NXCD, off = wgid / NXCD; wgid = (xcd < r ? xcd * (q + 1) : r * (q + 1) + (xcd - r) * q) + off; }
        const int nig = wgm * nN, gid = wgid / nig, fm = gid * wgm, gsz = (nM - fm) < wgm ? (nM - fm) : wgm;
        u.pm = fm + ((wgid % nig) % gsz); u.pn = (wgid % nig) / gsz; return true;
    }
    __device__ __forceinline__ void a_ready(const Unit&) const {}
    __device__ __forceinline__ void done(const Unit&) const {}
};
typedef __bf16 bf16x2_t __attribute__((ext_vector_type(2)));
__device__ __forceinline__ unsigned cvt_pk_bf16(float lo, float hi) { bf16x2_t r; r.x = (__bf16)lo; r.y = (__bf16)hi; return __builtin_bit_cast(unsigned, r); }
struct EpiBf16P {
    static constexpr bool PERM = true, AFTER_DRAIN = false;
    bf16_t* O; int ldc;
    __device__ __forceinline__ void operator()(const f32x4 (&acc)[2][2][4][2], const Unit& u, int wr, int wc, int fr, int fq) const {
        const int row0 = u.pm * BM + wr * 64 + fr, col0 = u.pn * BM + wc * 32 + 8 * fq;
#pragma unroll
        for (int ai = 0; ai < 2; ++ai)
#pragma unroll
            for (int m = 0; m < 4; ++m) { bf16_t* rowp = O + (size_t)(row0 + ai * HALF + m * 16) * ldc + col0;
#pragma unroll
                for (int bj = 0; bj < 2; ++bj) { const f32x4 v0 = acc[ai][bj][m][0], v1 = acc[ai][bj][m][1];
                    u32x4 w; w.x = cvt_pk_bf16(v0[0], v0[1]); w.y = cvt_pk_bf16(v0[2], v0[3]); w.z = cvt_pk_bf16(v1[0], v1[1]); w.w = cvt_pk_bf16(v1[2], v1[3]);
                    *(u32x4*)(rowp + bj * HALF) = w; } }
    }
};
struct EpiResid {
    static constexpr bool PERM = false, AFTER_DRAIN = false;
    float* Z; const float* X; const float* gate; float alpha;
    __device__ __forceinline__ void operator()(const f32x4 (&acc)[2][2][4][2], const Unit& u, int wr, int wc, int fr, int fq) const {
        const int row0 = u.pm * BM + wr * 64 + fr, col0 = u.pn * BM + wc * 32 + 4 * fq;
        const float* gb = gate + (size_t)(u.pm >> 3) * (6 * 2048) + col0;
        f32x4 gv[2][2];
#pragma unroll
        for (int bj = 0; bj < 2; ++bj)
#pragma unroll
            for (int n = 0; n < 2; ++n) gv[bj][n] = *(const f32x4*)(gb + bj * HALF + n * 16) + 1.0f;
#pragma unroll
        for (int ai = 0; ai < 2; ++ai)
#pragma unroll
            for (int m = 0; m < 4; ++m) { const size_t off = (size_t)(row0 + ai * HALF + m * 16) * 2048 + col0;
#pragma unroll
                for (int bj = 0; bj < 2; ++bj)
#pragma unroll
                    for (int n = 0; n < 2; ++n) { const f32x4 xv = *(const f32x4*)(X + off + bj * HALF + n * 16);
                        *(f32x4*)(Z + off + bj * HALF + n * 16) = xv * alpha + gv[bj][n] * acc[ai][bj][m][n]; }
                asm volatile("" ::: "memory"); }
    }
};
__device__ __forceinline__ f32x4 acc_i2f(const f32x4 v) { const i32x4 iv = __builtin_bit_cast(i32x4, v); return __builtin_convertvector(iv, f32x4); }
struct EpiBf16PS {
    static constexpr bool PERM = true, AFTER_DRAIN = false;
    bf16_t* O; int ldc; const float* sa; const float* sb;
    __device__ __forceinline__ void operator()(const f32x4 (&acc)[2][2][4][2], const Unit& u, int wr, int wc, int fr, int fq) const {
        const int row0 = u.pm * BM + wr * 64 + fr, col0 = u.pn * BM + wc * 32 + 8 * fq;
        f32x4 sbv[2][2];
#pragma unroll
        for (int bj = 0; bj < 2; ++bj)
#pragma unroll
            for (int n = 0; n < 2; ++n) sbv[bj][n] = *(const f32x4*)(sb + col0 + bj * HALF + 4 * n);
#pragma unroll
        for (int ai = 0; ai < 2; ++ai)
#pragma unroll
            for (int m = 0; m < 4; ++m) { const int row = row0 + ai * HALF + m * 16; bf16_t* rowp = O + (size_t)row * ldc + col0; const float sar = sa[row];
#pragma unroll
                for (int bj = 0; bj < 2; ++bj) { const f32x4 v0 = acc_i2f(acc[ai][bj][m][0]) * (sbv[bj][0] * sar), v1 = acc_i2f(acc[ai][bj][m][1]) * (sbv[bj][1] * sar);
                    u32x4 w; w.x = cvt_pk_bf16(v0[0], v0[1]); w.y = cvt_pk_bf16(v0[2], v0[3]); w.z = cvt_pk_bf16(v1[0], v1[1]); w.w = cvt_pk_bf16(v1[2], v1[3]);
                    *(u32x4*)(rowp + bj * HALF) = w; } }
    }
};
struct EpiResidS {
    static constexpr bool PERM = false, AFTER_DRAIN = false;
    float* Z; const float* X; const float* gate; const float* sa; const float* sb; float alpha;
    __device__ __forceinline__ void operator()(const f32x4 (&acc)[2][2][4][2], const Unit& u, int wr, int wc, int fr, int fq) const {
        const int row0 = u.pm * BM + wr * 64 + fr, col0 = u.pn * BM + wc * 32 + 4 * fq;
        const float* gb = gate + (size_t)(u.pm >> 3) * (6 * 2048) + col0;
        f32x4 gv[2][2];
#pragma unroll
        for (int bj = 0; bj < 2; ++bj)
#pragma unroll
            for (int n = 0; n < 2; ++n) gv[bj][n] = (*(const f32x4*)(gb + bj * HALF + n * 16) + 1.0f) * *(const f32x4*)(sb + col0 + bj * HALF + n * 16);
#pragma unroll
        for (int ai = 0; ai < 2; ++ai)
#pragma unroll
            for (int m = 0; m < 4; ++m) { const int row = row0 + ai * HALF + m * 16; const size_t off = (size_t)row * 2048 + col0; const float sar = sa[row];
#pragma unroll
                for (int bj = 0; bj < 2; ++bj)
#pragma unroll
                    for (int n = 0; n < 2; ++n) { const f32x4 xv = *(const f32x4*)(X + off + bj * HALF + n * 16);
                        *(f32x4*)(Z + off + bj * HALF + n * 16) = xv * alpha + (gv[bj][n] * sar) * acc_i2f(acc[ai][bj][m][n]); }
                asm volatile("" ::: "memory"); }
    }
};
template <class Epi, class Sched, bool ALIGN_EPI = false, bool SP2 = false, bool I8 = false>
__device__ __forceinline__ void gemm_phase(PG8_LAS unsigned char* lds, const Gemm g, const Sched& S, const Epi& E, const int tid_in) {
    const int tid = tid_in, wid = __builtin_amdgcn_readfirstlane(tid >> 6), lane = tid & 63, wr = wid >> 2, wc = wid & 3, fr = lane & 15, fq = lane >> 4;
    const int K = g.K, nt = K / BK;
    unsigned voffA[2], voffB[2];
#pragma unroll
    for (int i = 0; i < 2; ++i) { int R, C; stage_rc(tid * 16 + i * 8192, R, C); const int Rb = Epi::PERM ? ((R & ~31) + perm32(R & 31)) : R;
        voffA[i] = (unsigned)(R * K + C) * 2u; voffB[i] = (unsigned)(Rb * K + C) * 2u; }
    const size_t kstep = (size_t)(BK * 2);
    const size_t hstep = (size_t)HALF * K * 2;
    const size_t tstep = 2 * hstep;
    const unsigned ldsw = (unsigned)wid * 1024u;
    const int aoff = lds_byte(wr * 64 + fr, fq * 8), boff = lds_byte(wc * 32 + fr, fq * 8);
#define PG8_SA(b, h) (((b) * 2 + (h)) * HTB)
#define PG8_SB(b, h) ((4 + (b) * 2 + (h)) * HTB)
#define PG8_STAGE(bufoff, gbase, voff) do { _Pragma("unroll") for (int _i = 0; _i < 2; ++_i) \
        __builtin_amdgcn_global_load_lds((const unsigned*)((const char*)(gbase) + (voff)[_i]), (PG8_LAS unsigned*)(lds + (bufoff) + ldsw + _i * 8192), 16, 0, 0); } while (0)
#define PG8_LDA(dst, b, h) do { _Pragma("unroll") for (int m = 0; m < 4; ++m) _Pragma("unroll") for (int k = 0; k < 2; ++k) dst[m][k] = *(const PG8_LAS bf16x8*)(lds + PG8_SA(b, h) + aoff + m * 2048 + k * 1024); } while (0)
#define PG8_LDB(dst, b, h) do { _Pragma("unroll") for (int n = 0; n < 2; ++n) _Pragma("unroll") for (int k = 0; k < 2; ++k) dst[n][k] = *(const PG8_LAS bf16x8*)(lds + PG8_SB(b, h) + boff + n * 2048 + k * 1024); } while (0)
#define PG8_MMA(ai, bj, At, Bt) do { __builtin_amdgcn_s_setprio(1); _Pragma("unroll") for (int m = 0; m < 4; ++m) _Pragma("unroll") for (int n = 0; n < 2; ++n) _Pragma("unroll") for (int k = 0; k < 2; ++k) \
        { if constexpr (I8) acc[ai][bj][m][n] = __builtin_bit_cast(f32x4, __builtin_amdgcn_mfma_i32_16x16x64_i8(__builtin_bit_cast(i32x4, Bt[n][k]), __builtin_bit_cast(i32x4, At[m][k]), __builtin_bit_cast(i32x4, acc[ai][bj][m][n]), 0, 0, 0)); \
          else acc[ai][bj][m][n] = __builtin_amdgcn_mfma_f32_16x16x32_bf16(Bt[n][k], At[m][k], acc[ai][bj][m][n], 0, 0, 0); } __builtin_amdgcn_s_setprio(0); } while (0)
#define PG8_WAIT_V(n) asm volatile("s_waitcnt vmcnt(" #n ")" ::: "memory")
#define PG8_WAIT_L(n) asm volatile("s_waitcnt lgkmcnt(" #n ")" ::: "memory")
#define PG8_BAR __builtin_amdgcn_s_barrier()
#define PG8_SCHED __builtin_amdgcn_sched_barrier(0)
    Unit cur, nxt; int ui = 0;
    if (!S.next(0, cur)) return;
    f32x4 acc[2][2][4][2];
#pragma unroll
    for (int a = 0; a < 2; ++a)
#pragma unroll
        for (int b = 0; b < 2; ++b)
#pragma unroll
            for (int m = 0; m < 4; ++m)
#pragma unroll
                for (int n = 0; n < 2; ++n) acc[a][b][m][n] = (f32x4){0.f, 0.f, 0.f, 0.f};
    bf16x8 At[4][2], B0[2][2], B1[2][2];
    const char* cA = (const char*)g.A + (size_t)cur.pm * tstep; const char* cB = (const char*)g.Bt + (size_t)cur.pn * tstep;
    S.a_ready(cur);
    if constexpr (SP2) {
        PG8_STAGE(PG8_SB(0, 0), cB, voffB); PG8_STAGE(PG8_SB(0, 1), cB + hstep, voffB); PG8_STAGE(PG8_SA(0, 0), cA, voffA); PG8_STAGE(PG8_SA(0, 1), cA + hstep, voffA);
        if (wr == 1) PG8_BAR;
        PG8_WAIT_V(2); PG8_BAR;
        PG8_STAGE(PG8_SB(1, 0), cB + kstep, voffB); PG8_STAGE(PG8_SA(1, 0), cA + kstep, voffA); PG8_STAGE(PG8_SB(1, 1), cB + hstep + kstep, voffB);
        PG8_WAIT_V(6); PG8_BAR;
    } else {
        PG8_STAGE(PG8_SB(0, 0), cB, voffB); PG8_STAGE(PG8_SA(0, 0), cA, voffA); PG8_STAGE(PG8_SB(0, 1), cB + hstep, voffB); PG8_STAGE(PG8_SA(0, 1), cA + hstep, voffA);
        if (wr == 1) PG8_BAR;
        PG8_WAIT_V(4); PG8_BAR;
        PG8_STAGE(PG8_SB(1, 0), cB + kstep, voffB); PG8_STAGE(PG8_SA(1, 0), cA + kstep, voffA); PG8_STAGE(PG8_SB(1, 1), cB + hstep + kstep, voffB);
        PG8_WAIT_V(6); PG8_BAR;
    }
    for (;;) {
        const bool has_next = S.next(ui + 1, nxt);
        const char* nA = has_next ? (const char*)g.A + (size_t)nxt.pm * tstep : cA; const char* nB = has_next ? (const char*)g.Bt + (size_t)nxt.pn * tstep : cB;
        for (int t = 0; t < nt; t += 2) {
            const bool last = (t == nt - 2);
            const char* a1 = cA + (size_t)(t + 1) * kstep;
            const char* a2 = last ? nA : cA + (size_t)(t + 2) * kstep; const char* b2 = last ? nB : cB + (size_t)(t + 2) * kstep;
            const char* a3 = a2 + kstep; const char* b3 = b2 + kstep;
            if (last && has_next) S.a_ready(nxt);
            if constexpr (SP2) {
            PG8_LDB(B0, 0, 0); PG8_LDB(B1, 0, 1); PG8_SCHED; PG8_LDA(At, 0, 0); PG8_STAGE(PG8_SA(1, 1), a1 + hstep, voffA);
            PG8_WAIT_V(8); PG8_WAIT_L(0); PG8_BAR; PG8_MMA(0, 0, At, B0); PG8_MMA(0, 1, At, B1); PG8_BAR; PG8_SCHED;
            PG8_LDA(At, 0, 1); PG8_STAGE(PG8_SB(0, 0), b2, voffB); PG8_STAGE(PG8_SB(0, 1), b2 + hstep, voffB); PG8_STAGE(PG8_SA(0, 0), a2, voffA);
            PG8_WAIT_V(8); PG8_WAIT_L(0); PG8_BAR; PG8_MMA(1, 0, At, B0); PG8_MMA(1, 1, At, B1); PG8_BAR; PG8_SCHED;
            PG8_LDB(B0, 1, 0); PG8_LDB(B1, 1, 1); PG8_SCHED; PG8_LDA(At, 1, 0); PG8_STAGE(PG8_SA(0, 1), a2 + hstep, voffA);
            PG8_WAIT_V(8); PG8_WAIT_L(0); PG8_BAR; PG8_MMA(0, 0, At, B0); PG8_MMA(0, 1, At, B1); PG8_BAR; PG8_SCHED;
            PG8_LDA(At, 1, 1); PG8_STAGE(PG8_SB(1, 0), b3, voffB); PG8_STAGE(PG8_SB(1, 1), b3 + hstep, voffB); PG8_STAGE(PG8_SA(1, 0), a3, voffA);
            PG8_WAIT_V(8); PG8_WAIT_L(0); PG8_BAR; PG8_MMA(1, 0, At, B0); PG8_MMA(1, 1, At, B1); PG8_BAR; PG8_SCHED;
            } else {
            PG8_LDB(B0, 0, 0); PG8_SCHED; PG8_LDA(At, 0, 0); PG8_STAGE(PG8_SA(1, 1), a1 + hstep, voffA);
            PG8_WAIT_L(8); PG8_BAR; PG8_WAIT_L(0); PG8_MMA(0, 0, At, B0); PG8_BAR; PG8_SCHED;
            PG8_LDB(B1, 0, 1); PG8_STAGE(PG8_SB(0, 0), b2, voffB);
            PG8_BAR; PG8_WAIT_L(0); PG8_MMA(0, 1, At, B1); PG8_BAR;
            PG8_LDA(At, 0, 1); PG8_STAGE(PG8_SA(0, 0), a2, voffA);
            PG8_BAR; PG8_WAIT_L(0); PG8_MMA(1, 0, At, B0); PG8_BAR; PG8_SCHED;
            PG8_STAGE(PG8_SB(0, 1), b2 + hstep, voffB);
            PG8_WAIT_V(6); PG8_BAR; PG8_MMA(1, 1, At, B1); PG8_BAR;
            PG8_LDB(B0, 1, 0); PG8_SCHED; PG8_LDA(At, 1, 0); PG8_STAGE(PG8_SA(0, 1), a2 + hstep, voffA);
            PG8_WAIT_L(8); PG8_BAR; PG8_WAIT_L(0); PG8_MMA(0, 0, At, B0); PG8_BAR; PG8_SCHED;
            PG8_LDB(B1, 1, 1); PG8_STAGE(PG8_SB(1, 0), b3, voffB);
            PG8_BAR; PG8_WAIT_L(0); PG8_MMA(0, 1, At, B1); PG8_BAR;
            PG8_LDA(At, 1, 1); PG8_STAGE(PG8_SA(1, 0), a3, voffA);
            PG8_BAR; PG8_WAIT_L(0); PG8_MMA(1, 0, At, B0); PG8_BAR; PG8_SCHED;
            PG8_STAGE(PG8_SB(1, 1), b3 + hstep, voffB);
            PG8_WAIT_V(6); PG8_BAR; PG8_MMA(1, 1, At, B1); PG8_BAR;
            }
        }
        if constexpr (ALIGN_EPI) { if (wr == 0) PG8_BAR; }
        if constexpr (!Epi::AFTER_DRAIN) { E(acc, cur, wr, wc, fr, fq); S.done(cur); }
        if (!has_next) break;
#pragma unroll
        for (int a = 0; a < 2; ++a)
#pragma unroll
            for (int b = 0; b < 2; ++b)
#pragma unroll
                for (int m = 0; m < 4; ++m)
#pragma unroll
                    for (int n = 0; n < 2; ++n) acc[a][b][m][n] = (f32x4){0.f, 0.f, 0.f, 0.f};
        cur = nxt; cA = nA; cB = nB; ++ui;
        if constexpr (ALIGN_EPI) { if (wr == 1) PG8_BAR; }
    }
    PG8_WAIT_V(0);
    if constexpr (!ALIGN_EPI) { if (wr == 0) PG8_BAR; }
    PG8_BAR;
    if constexpr (Epi::AFTER_DRAIN) { E.fused(acc, cur, wr, wc, fr, fq, lds, wid, lane); S.done(cur); }
#undef PG8_SA
#undef PG8_SB
#undef PG8_STAGE
#undef PG8_LDA
#undef PG8_LDB
#undef PG8_MMA
#undef PG8_WAIT_V
#undef PG8_WAIT_L
#undef PG8_BAR
#undef PG8_SCHED
}
}
#define XB_TMO      128
#define XB_XCNT(j)  (256  + 64 * (j))
#define XB_XSUB(j)  (1280 + 64 * (j))
#define XB_XGEN(j)  (2304 + 64 * (j))
#define XB_TOP      3328
#define XB_TOPGEN   3392
#define XCD_BAR_WORDS 3456
#define XB_SPIN_CAP (1u << 18)
#define LAS __attribute__((address_space(3)))

__device__ __forceinline__ unsigned xb_ld(unsigned* p)              { return __hip_atomic_load(p, __ATOMIC_RELAXED, __HIP_MEMORY_SCOPE_AGENT); }
__device__ __forceinline__ unsigned xb_add(unsigned* p, unsigned v) { return __hip_atomic_fetch_add(p, v, __ATOMIC_RELAXED, __HIP_MEMORY_SCOPE_AGENT); }
__device__ __forceinline__ unsigned xb_xcc_id() { return (unsigned)__builtin_amdgcn_s_getreg((3 << 11) | 20) & 0xFu; }
#define XB_SPIN(cond, bar) do { unsigned _sp = 0; while (cond) { __builtin_amdgcn_s_sleep(1); \
    if ((++_sp & 255u) == 0u) { if (xb_ld(&(bar)[XB_TMO])) break; if (_sp > XB_SPIN_CAP) { atomicAdd(&(bar)[XB_TMO], 1u); break; } } } } while (0)

struct XcdBarrier {
    unsigned* bar; unsigned x;
    volatile LAS unsigned* st;
};

__device__ __forceinline__ XcdBarrier xcd_barrier_post(unsigned* bar, volatile LAS unsigned* st) {
    XcdBarrier b; b.bar = bar; b.x = xb_xcc_id(); b.st = st;
    if (threadIdx.x == 0) (void)xb_add(&bar[XB_XCNT(b.x)], 1u);
    return b;
}
__device__ __forceinline__ void xcd_barrier_complete(unsigned* bar, unsigned x, unsigned& nloc, unsigned& nx) {
    const unsigned G = gridDim.x * gridDim.y * gridDim.z;
    unsigned sum, cnt, mine, sp = 0u;
    for (;;) {
        sum = 0u; cnt = 0u; mine = 0u;
#pragma unroll
        for (unsigned j = 0; j < 16; ++j) { const unsigned c = xb_ld(&bar[XB_XCNT(j)]); sum += c; cnt += (c > 0u) ? 1u : 0u; mine = (j == x) ? c : mine; }
        if (sum == G) break;
        __builtin_amdgcn_s_sleep(1);
        if ((++sp & 255u) == 0u) { if (xb_ld(&bar[XB_TMO])) break; if (sp > XB_SPIN_CAP) { atomicAdd(&bar[XB_TMO], 1u); break; } }
    }
    nloc = mine > 0u ? mine : 1u; nx = cnt > 0u ? cnt : 1u;
}

__device__ __forceinline__ void xcd_barrier(const XcdBarrier& b) {
    asm volatile("s_waitcnt vmcnt(0)" ::: "memory");
    __syncthreads();
    if (threadIdx.x == 0) {
        unsigned* bar = b.bar;
        __builtin_amdgcn_s_waitcnt(0);
        unsigned nloc = b.st[0], nx = b.st[1];
        if (nloc == 0u) { xcd_barrier_complete(bar, b.x, nloc, nx); b.st[0] = nloc; b.st[1] = nx; }
        const unsigned old = xb_add(&bar[XB_XSUB(b.x)], 1u);
        const unsigned gen = old / nloc;
        if (old + 1u == (gen + 1u) * nloc) {
            __builtin_amdgcn_fence(__ATOMIC_RELEASE, "agent");
            asm volatile("s_waitcnt vmcnt(0)" ::: "memory");
            const unsigned og = xb_add(&bar[XB_TOP], 1u);
            const unsigned tg = og / nx;
            if (og + 1u == (tg + 1u) * nx) xb_add(&bar[XB_TOPGEN], 1u);
            else XB_SPIN(xb_ld(&bar[XB_TOPGEN]) == tg, bar);
            __builtin_amdgcn_fence(__ATOMIC_ACQUIRE, "agent");
            xb_add(&bar[XB_XGEN(b.x)], 1u);
            asm volatile("s_waitcnt vmcnt(0)" ::: "memory");
        } else {
            XB_SPIN(xb_ld(&bar[XB_XGEN(b.x)]) == gen, bar);
            __builtin_amdgcn_fence(__ATOMIC_ACQUIRE, "agent");
            asm volatile("s_waitcnt vmcnt(0)" ::: "memory");
        }
    }
    __syncthreads();
}
constexpr int D = 2048, NB = 8, SEQ = 2048, NL = 4, T = NB * SEQ;
constexpr int NCH = SEQ / 64, NCHUNK = T / 64;
constexpr int GKW = 512, RANK = 16;
constexpr int INW = 6160, NP = 6144;
constexpr int NE = 16384;
constexpr float ALPHA = 1.6817928305074290f, EPS = 1e-5f;
constexpr int PQ = 0, PK = 512, PV = 1024, PR = 2048, PCB = 3072, PCC = 4096, PCH = 5120;
constexpr int NWAVES = 8, NTHREADS = 512;
#ifndef WGM_IN
#define WGM_IN 4
#endif
#ifndef WGM_OUT
#define WGM_OUT 4
#endif
#ifndef WGM_WQ
#define WGM_WQ 4
#endif
#ifndef TAB4
#define TAB4 1
#endif
constexpr int NPHASES = 2 + 7 * NL;

constexpr size_t MiB = 1u << 20;
constexpr size_t WS_CTL = 0, CTL_ZERO_BYTES = 1 * MiB;
constexpr size_t WS_MOD = 1 * MiB, WS_PART = 3 * MiB, WS_KEYS = 15 * MiB, WS_DTOT = 17 * MiB, WS_WIN = 18 * MiB, WS_WOUT = 115 * MiB, WS_WQ = 147 * MiB;
constexpr size_t WS_UT = 179 * MiB, WS_VT = 435 * MiB, WS_H = 691 * MiB, WS_PROJ = 755 * MiB, WS_E = 947 * MiB, WS_OGLA = 979 * MiB, WS_Y = 1043 * MiB;
constexpr size_t WS_Z = 1107 * MiB, WS_X1 = 1235 * MiB, WS_X = 1363 * MiB, WS_Q = 1491 * MiB, WS_H2 = 1555 * MiB, WS_HQ8 = 1619 * MiB, WS_H8 = 1659 * MiB, WS_WIN8 = 1691 * MiB, WS_WOUT8 = 1739 * MiB, WS_WQ8 = 1755 * MiB, WS_Y8 = 1771 * MiB, WS_H28 = 1803 * MiB, WS_END = 1835 * MiB;
constexpr size_t WS_SU = 17 * MiB + 512 * 1024, WS_SV = 17 * MiB + 768 * 1024, WS_HSC = 2 * MiB + 640 * 1024;
static_assert(WS_WIN + (size_t)NL * INW * D * 2 <= WS_WOUT && WS_PART + (size_t)NL * 8 * NB * 6 * D * 4 <= WS_KEYS && WS_MOD + (size_t)NL * NB * 6 * D * 4 <= WS_PART, "ws map");
constexpr size_t WS_SAH = WS_SU, WS_SAY = WS_SU + 65536, WS_SB = WS_SV; constexpr int SBL = NP + 2 * D;
constexpr int CW_BAR = 4096;

constexpr int RING_OFF = 0, RING_BYTES = 131072, LDSCTL_OFF = RING_BYTES, LDS_BYTES = 147456;

#define GAS __attribute__((address_space(1)))
typedef unsigned short bf16;
typedef unsigned v4u __attribute__((ext_vector_type(4)));
typedef unsigned v2u __attribute__((ext_vector_type(2)));
typedef float f32x4 __attribute__((ext_vector_type(4)));
typedef float f32x16 __attribute__((ext_vector_type(16)));
typedef short bf16x8 __attribute__((ext_vector_type(8)));
typedef __bf16 bf16x2v __attribute__((ext_vector_type(2)));
#define LDS_WAIT() asm volatile("s_waitcnt lgkmcnt(0)" ::: "memory")

__device__ __forceinline__ unsigned pk2(float lo, float hi) { return pg8::cvt_pk_bf16(lo, hi); }
__device__ __forceinline__ float dot2bf(unsigned w, unsigned x, float acc) { return __builtin_amdgcn_fdot2_f32_bf16(__builtin_bit_cast(bf16x2v, w), __builtin_bit_cast(bf16x2v, x), acc, false); }
__device__ __forceinline__ float bflo(unsigned u) { return __uint_as_float(u << 16); }
__device__ __forceinline__ float bfhi(unsigned u) { return __uint_as_float(u & 0xffff0000u); }
__device__ __forceinline__ float silu_f(float x) { return x / (1.0f + __expf(-x)); }
__device__ __forceinline__ float logsigmoid_f(float x) { return fminf(x, 0.0f) - log1pf(__expf(-fabsf(x))); }
__device__ __forceinline__ float gelu_tanh_f(float x) { const float u = 0.7978845608028654f * (x + 0.044715f * x * x * x); return 0.5f * x * (1.0f + tanhf(u)); }
__device__ __forceinline__ unsigned pack_i8(float a, float b, float c, float d) {
    const int q0 = (int)__builtin_rintf(a), q1 = (int)__builtin_rintf(b), q2 = (int)__builtin_rintf(c), q3 = (int)__builtin_rintf(d);
    return (unsigned)(q0 & 255) | ((unsigned)(q1 & 255) << 8) | ((unsigned)(q2 & 255) << 16) | ((unsigned)(q3 & 255) << 24); }
__device__ __forceinline__ float wave_sum(float v) {
#pragma unroll
    for (int o = 1; o < 64; o <<= 1) v += __shfl_xor(v, o);
    return v;
}

struct Args { const float* in[19]; float* out; unsigned char* ws; int ph_lo, ph_hi; };

__device__ __forceinline__ void transpose_item(const float* W, int ldw, int col0, bf16* WTrows, int k0, int nvalid, LAS float* scr, int lane) {
    const int n = lane & 31;
    float tv[32];
#pragma unroll
    for (int i = 0; i < 32; ++i) { const int kk = 2 * i + (lane >> 5); tv[i] = (n < nvalid) ? W[(size_t)(k0 + kk) * ldw + col0 + n] : 0.f; }
#pragma unroll
    for (int i = 0; i < 32; ++i) { const int kk = 2 * i + (lane >> 5); scr[kk * 33 + n] = tv[i]; }
    LDS_WAIT(); asm volatile("" ::: "memory");
    const int c = lane & 7;
#pragma unroll
    for (int j = 0; j < 4; ++j) { const int nn = (lane >> 3) + 8 * j; const LAS float* s = scr + (8 * c) * 33 + nn;
        v4u o; o.x = pk2(s[0 * 33], s[1 * 33]); o.y = pk2(s[2 * 33], s[3 * 33]); o.z = pk2(s[4 * 33], s[5 * 33]); o.w = pk2(s[6 * 33], s[7 * 33]);
        if (nn < nvalid) *(v4u*)(WTrows + (size_t)nn * D + k0 + 8 * c) = o; }
    LDS_WAIT(); asm volatile("" ::: "memory");
}
__device__ __forceinline__ void cvt_stream(const float* src, bf16* dst, size_t n4, size_t i0, size_t stride) {
    for (size_t i = i0; i < n4; i += stride) { const f32x4 v = ((const f32x4*)src)[i]; v2u o; o.x = pk2(v.x, v.y); o.y = pk2(v.z, v.w); ((v2u*)dst)[i] = o; }
}
__device__ __forceinline__ void ph_prologue_a(const Args& a, LAS unsigned char* lds, int tid, int lane, int wave, int bx, int G) {
    const int gw = bx * NWAVES + wave, NGW = G * NWAVES;
    LAS float* cact = (LAS float*)lds;
    for (int i = tid; i < NB * D; i += NTHREADS) { const int b = i / D, d = i % D; cact[d * 8 + b] = silu_f(a.in[1][i]); }
    __syncthreads();
    float* part = (float*)(a.ws + WS_PART);
    for (int it = gw; it < NL * 8 * 48; it += NGW) {
        const int cg = it % 48, dr = (it / 48) % 8, l = it / 384;
        f32x4 acc[8];
#pragma unroll
        for (int b = 0; b < 8; ++b) acc[b] = (f32x4){0.f, 0.f, 0.f, 0.f};
        const float* w = a.in[2] + ((size_t)l * D + dr * 256) * (6 * D) + cg * 256 + lane * 4;
#pragma unroll 4
        for (int d = 0; d < 256; ++d) {
            const f32x4 wv = *(const f32x4*)(w + (size_t)d * (6 * D));
            const f32x4 c0 = *(const LAS f32x4*)(cact + (dr * 256 + d) * 8), c1 = *(const LAS f32x4*)(cact + (dr * 256 + d) * 8 + 4);
            acc[0] += wv * c0.x; acc[1] += wv * c0.y; acc[2] += wv * c0.z; acc[3] += wv * c0.w;
            acc[4] += wv * c1.x; acc[5] += wv * c1.y; acc[6] += wv * c1.z; acc[7] += wv * c1.w;
        }
#pragma unroll
        for (int b = 0; b < 8; ++b) *(f32x4*)(part + (((size_t)l * 8 + dr) * NB + b) * (6 * D) + cg * 256 + lane * 4) = acc[b];
    }
    __syncthreads();
    LAS float* scr = (LAS float*)(lds + wave * 8448);
    bf16* winT = (bf16*)(a.ws + WS_WIN); bf16* woutT = (bf16*)(a.ws + WS_WOUT); bf16* wqT = (bf16*)(a.ws + WS_WQ);
    constexpr int IPL = 6144 + 32 + 2048 + 2048;
    for (int it = gw; it < NL * IPL; it += NGW) {
        const int l = it / IPL; int r = it % IPL;
        if (r < 6144) { const int nb = r % 192, kb = r / 192, n0 = nb * 32;
            transpose_item(a.in[4] + (size_t)l * D * INW, INW, n0 < 3072 ? n0 : n0 + 16, winT + ((size_t)l * INW + n0) * D, kb * 64, 32, scr, lane); continue; }
        r -= 6144;
        if (r < 32) { transpose_item(a.in[4] + (size_t)l * D * INW, INW, 3072, winT + ((size_t)l * INW + NP) * D, r * 64, 16, scr, lane); continue; }
        r -= 32;
        if (r < 2048) { const int nb = r % 64, kb = r / 64; transpose_item(a.in[10] + (size_t)l * D * D, D, nb * 32, woutT + ((size_t)l * D + nb * 32) * D, kb * 64, 32, scr, lane); continue; }
        r -= 2048;
        { const int nb = r % 64, kb = r / 64; transpose_item(a.in[13] + (size_t)l * D * D, D, nb * 32, wqT + ((size_t)l * D + nb * 32) * D, kb * 64, 32, scr, lane); }
    }
    const size_t i0 = (size_t)bx * NTHREADS + tid, stride = (size_t)G * NTHREADS;
    cvt_stream(a.in[14], (bf16*)(a.ws + WS_KEYS), (size_t)NL * 8 * 2 * 128 * 128 / 4, i0, stride);
#if TAB4
    __syncthreads();
    { LAS float* rowst = (LAS float*)(lds + wave * 8192);
      f32x4 vnx[8];
      if (gw < 2 * NL * NE) { const int tbl0 = gw / (NL * NE), r0 = gw % (NL * NE); const float* s0 = (tbl0 ? a.in[16] : a.in[15]) + (size_t)r0 * D;
#pragma unroll
          for (int c8 = 0; c8 < 8; ++c8) vnx[c8] = *(const f32x4*)(s0 + (c8 * 64 + lane) * 4); }
      for (int row = gw; row < 2 * NL * NE; row += NGW) {
        const int tbl = row / (NL * NE), r = row % (NL * NE);
#pragma unroll
        for (int c8 = 0; c8 < 8; ++c8) *(LAS f32x4*)(rowst + (c8 * 64 + lane) * 4) = vnx[c8];
        { const int rown = row + NGW < 2 * NL * NE ? row + NGW : row; const int tbln = rown / (NL * NE), rn = rown % (NL * NE); const float* sn = (tbln ? a.in[16] : a.in[15]) + (size_t)rn * D;
#pragma unroll
          for (int c8 = 0; c8 < 8; ++c8) vnx[c8] = *(const f32x4*)(sn + (c8 * 64 + lane) * 4); }
        LDS_WAIT(); asm volatile("" ::: "memory");
        unsigned char* tb = a.ws + (tbl ? WS_VT : WS_UT) + (size_t)r * 1152;
#pragma unroll
        for (int pass = 0; pass < 2; ++pass) { const int slot = lane + 64 * pass;
            if (slot < 72) { const int col0 = (slot >> 3) * 240 + (slot & 7) * 30;
                float x[30]; float mx = 0.f;
#pragma unroll
                for (int k = 0; k < 30; ++k) { x[k] = (col0 + k < D) ? rowst[col0 + k] : 0.f; mx = fmaxf(mx, fabsf(x[k])); }
                int code = 0; float inv = 0.f;
                if (mx > 0.f) { code = (int)ceilf(8.0f * log2f(mx * (1.0f / 7.0f))) + 128; code = code < 0 ? 0 : (code > 255 ? 255 : code); inv = __builtin_amdgcn_exp2f(16.0f - (float)code * 0.125f); }
                unsigned dw[4] = {0u, 0u, 0u, 0u};
#pragma unroll
                for (int kb = 0; kb < 15; ++kb) { int a0 = (int)__builtin_rintf(x[2 * kb] * inv), a1 = (int)__builtin_rintf(x[2 * kb + 1] * inv);
                    a0 = a0 < -7 ? -7 : (a0 > 7 ? 7 : a0); a1 = a1 < -7 ? -7 : (a1 > 7 ? 7 : a1);
                    dw[kb >> 2] |= ((unsigned)(a0 + 8) | ((unsigned)(a1 + 8) << 4)) << (8 * (kb & 3)); }
                dw[3] |= (unsigned)code << 24;
                *(v4u*)(tb + slot * 16) = (v4u){dw[0], dw[1], dw[2], dw[3]}; } }
        LDS_WAIT(); asm volatile("" ::: "memory");
      } }
#else
    for (int row = gw; row < 2 * NL * NE; row += NGW) {
        const int tbl = row / (NL * NE), r = row % (NL * NE);
        const float* src = (tbl ? a.in[16] : a.in[15]) + (size_t)r * D;
        f32x4 v[8]; float mx = 0.f;
#pragma unroll
        for (int c8 = 0; c8 < 8; ++c8) { v[c8] = *(const f32x4*)(src + (c8 * 64 + lane) * 4); mx = fmaxf(mx, fmaxf(fmaxf(fabsf(v[c8].x), fabsf(v[c8].y)), fmaxf(fabsf(v[c8].z), fabsf(v[c8].w)))); }
#pragma unroll
        for (int o = 1; o < 64; o <<= 1) mx = fmaxf(mx, __shfl_xor(mx, o));
        const float inv = mx > 0.f ? 127.0f / mx : 0.f; const int off = tbl ? 128 : 0;
        unsigned dw[8];
#pragma unroll
        for (int c8 = 0; c8 < 8; ++c8) { const int q0 = (int)__builtin_rintf(v[c8].x * inv) + off, q1 = (int)__builtin_rintf(v[c8].y * inv) + off, q2 = (int)__builtin_rintf(v[c8].z * inv) + off, q3 = (int)__builtin_rintf(v[c8].w * inv) + off;
            dw[c8] = (unsigned)(q0 & 255) | ((unsigned)(q1 & 255) << 8) | ((unsigned)(q2 & 255) << 16) | ((unsigned)(q3 & 255) << 24); }
        unsigned char* dst = a.ws + (tbl ? WS_VT : WS_UT) + (size_t)r * D;
        *(v4u*)(dst + lane * 16) = (v4u){dw[0], dw[1], dw[2], dw[3]}; *(v4u*)(dst + (64 + lane) * 16) = (v4u){dw[4], dw[5], dw[6], dw[7]};
        if (lane == 0) ((float*)(a.ws + (tbl ? WS_SV : WS_SU)))[r] = mx * (1.0f / 127.0f);
    }
#endif
}

__device__ __forceinline__ void ln_tail(const float (&z)[32], int t, int lane, const float* g, const float* bta, float* xout, const float* sh, const float* sc, bf16* hout, unsigned char* q8, float* q8s, LAS unsigned char* q8stage = nullptr, unsigned char* a8 = nullptr, float* a8s = nullptr) {
    float s = 0.f;
#pragma unroll
    for (int i = 0; i < 32; ++i) s += z[i];
    const float mu = wave_sum(s) * (1.0f / D);
    float q = 0.f;
#pragma unroll
    for (int i = 0; i < 32; ++i) { const float d = z[i] - mu; q += d * d; }
    const float rs = rsqrtf(wave_sum(q) * (1.0f / D) + EPS);
    float hv[32]; float mx = 0.f;
#pragma unroll
    for (int c = 0; c < 8; ++c) { const int col = (c * 64 + lane) * 4;
        const f32x4 g0 = *(const f32x4*)(g + col), b0 = *(const f32x4*)(bta + col);
        f32x4 x0;
        x0.x = (z[c * 4 + 0] - mu) * rs * g0.x + b0.x; x0.y = (z[c * 4 + 1] - mu) * rs * g0.y + b0.y; x0.z = (z[c * 4 + 2] - mu) * rs * g0.z + b0.z; x0.w = (z[c * 4 + 3] - mu) * rs * g0.w + b0.w;
        if (xout) *(f32x4*)(xout + (size_t)t * D + col) = x0;
        if (hout || q8 || a8) { const f32x4 s0 = *(const f32x4*)(sc + col), h0 = *(const f32x4*)(sh + col);
            hv[c * 4] = x0.x * (1.f + s0.x) + h0.x; hv[c * 4 + 1] = x0.y * (1.f + s0.y) + h0.y; hv[c * 4 + 2] = x0.z * (1.f + s0.z) + h0.z; hv[c * 4 + 3] = x0.w * (1.f + s0.w) + h0.w;
            if (hout) { v2u o; o.x = pk2(hv[c * 4], hv[c * 4 + 1]); o.y = pk2(hv[c * 4 + 2], hv[c * 4 + 3]);
                *(v2u*)(hout + (size_t)t * D + col) = o; }
            if (q8 || a8) mx = fmaxf(mx, fmaxf(fmaxf(fabsf(hv[c * 4]), fabsf(hv[c * 4 + 1])), fmaxf(fabsf(hv[c * 4 + 2]), fabsf(hv[c * 4 + 3])))); }
    }
    if (q8 || a8) {
#pragma unroll
        for (int o = 1; o < 64; o <<= 1) mx = fmaxf(mx, __shfl_xor(mx, o));
        const float qmax_ = (q8 && TAB4) ? 119.0f : 127.0f;
        const float inv = mx > 0.f ? qmax_ / mx : 0.f;
        unsigned dw[8];
#pragma unroll
        for (int c = 0; c < 8; ++c) { const int q0 = (int)__builtin_rintf(hv[c * 4] * inv), q1 = (int)__builtin_rintf(hv[c * 4 + 1] * inv), q2 = (int)__builtin_rintf(hv[c * 4 + 2] * inv), q3 = (int)__builtin_rintf(hv[c * 4 + 3] * inv);
            dw[c] = (unsigned)(q0 & 255) | ((unsigned)(q1 & 255) << 8) | ((unsigned)(q2 & 255) << 16) | ((unsigned)(q3 & 255) << 24); }
        if (a8) {
#pragma unroll
            for (int c = 0; c < 8; ++c) *(unsigned*)(a8 + (size_t)t * D + (c * 64 + lane) * 4) = dw[c];
            if (a8s && lane == 0) a8s[t] = mx / qmax_; }
        if (q8) {
#if TAB4
        { LAS unsigned* st32 = (LAS unsigned*)q8stage; LAS unsigned char* st8 = (LAS unsigned char*)q8stage;
#pragma unroll
          for (int i = 0; i < 9; ++i) st32[lane + 64 * i] = 0u;
          LDS_WAIT(); asm volatile("" ::: "memory");
#pragma unroll
          for (int c = 0; c < 8; ++c)
#pragma unroll
              for (int jp = 0; jp < 2; ++jp) { const int col = (c * 64 + lane) * 4 + 2 * jp, u = col / 240, r = col - u * 240, l7 = r / 30, k = r - l7 * 30;
                  const int q0 = (int)(signed char)((dw[c] >> (16 * jp)) & 255u), q1 = (int)(signed char)((dw[c] >> (16 * jp + 8)) & 255u);
                  const int l0 = ((q0 + 8) & 15) - 8, l1 = ((q1 + 8) & 15) - 8, h0 = (q0 - l0) >> 4, h1 = (q1 - l1) >> 4;
                  LAS unsigned char* sp = st8 + (u * 8 + l7) * 32 + (k >> 1);
                  sp[0] = (unsigned char)((l0 & 15) | ((l1 & 15) << 4)); sp[16] = (unsigned char)((h0 & 15) | ((h1 & 15) << 4)); }
          LDS_WAIT(); asm volatile("" ::: "memory");
          unsigned* d32 = (unsigned*)(q8 + (size_t)t * 2304);
#pragma unroll
          for (int i = 0; i < 9; ++i) d32[lane + 64 * i] = st32[lane + 64 * i];
          LDS_WAIT(); asm volatile("" ::: "memory"); }
#else
        unsigned char* dst = q8 + (size_t)t * D;
        *(v4u*)(dst + lane * 16) = (v4u){dw[0], dw[1], dw[2], dw[3]}; *(v4u*)(dst + (64 + lane) * 16) = (v4u){dw[4], dw[5], dw[6], dw[7]};
#endif
        if (lane == 0) q8s[t] = mx / qmax_; }
    }
}

__device__ __forceinline__ void ph_prologue_b(const Args& a, LAS unsigned char* lds, int tid, int lane, int wave, int bx, int G) {
    const float* part = (const float*)(a.ws + WS_PART); float* mod = (float*)(a.ws + WS_MOD);
    for (int i = bx * NTHREADS + tid; i < NL * NB * 6 * D / 4; i += G * NTHREADS) {
        const int idx = i * 4, e = idx % (6 * D), b = (idx / (6 * D)) % NB, l = idx / (6 * D * NB);
        f32x4 s = *(const f32x4*)(a.in[3] + l * 6 * D + e);
#pragma unroll
        for (int dr = 0; dr < 8; ++dr) s += *(const f32x4*)(part + (((size_t)l * 8 + dr) * NB + b) * (6 * D) + e);
        *(f32x4*)(mod + idx) = s;
    }
    LAS float* msh = (LAS float*)lds;
    bf16* hbuf = (bf16*)(a.ws + WS_H);
    for (int ch = bx; ch < NCHUNK; ch += G) {
        const int b = ch / NCH;
        for (int i = tid; i < 1024; i += NTHREADS) { const int e = i * 4;
            f32x4 s = *(const f32x4*)(a.in[3] + e);
#pragma unroll
            for (int dr = 0; dr < 8; ++dr) s += *(const f32x4*)(part + (((size_t)0 * 8 + dr) * NB + b) * (6 * D) + e);
            *(LAS f32x4*)(msh + e) = s; }
        __syncthreads();
        for (int i = 0; i < 8; ++i) { const int t = ch * 64 + wave * 8 + i;
            float hv[32]; float mx = 0.f;
#pragma unroll
            for (int c = 0; c < 4; ++c) { const int col = (c * 64 + lane) * 8;
                const f32x4 x0 = *(const f32x4*)(a.in[0] + (size_t)t * D + col), x1 = *(const f32x4*)(a.in[0] + (size_t)t * D + col + 4);
                const f32x4 h0 = *(const LAS f32x4*)(msh + col), h1 = *(const LAS f32x4*)(msh + col + 4), s0 = *(const LAS f32x4*)(msh + 2048 + col), s1 = *(const LAS f32x4*)(msh + 2048 + col + 4);
#pragma unroll
                for (int j = 0; j < 4; ++j) { hv[c * 8 + j] = x0[j] * (1.f + s0[j]) + h0[j]; hv[c * 8 + 4 + j] = x1[j] * (1.f + s1[j]) + h1[j]; }
                v4u o; o.x = pk2(hv[c * 8], hv[c * 8 + 1]); o.y = pk2(hv[c * 8 + 2], hv[c * 8 + 3]); o.z = pk2(hv[c * 8 + 4], hv[c * 8 + 5]); o.w = pk2(hv[c * 8 + 6], hv[c * 8 + 7]);
                *(v4u*)(hbuf + (size_t)t * D + col) = o;
#pragma unroll
                for (int j = 0; j < 8; ++j) mx = fmaxf(mx, fabsf(hv[c * 8 + j])); }
#pragma unroll
            for (int o = 1; o < 64; o <<= 1) mx = fmaxf(mx, __shfl_xor(mx, o));
            const float inv = mx > 0.f ? 127.0f / mx : 0.f;
#pragma unroll
            for (int c = 0; c < 4; ++c) { v2u o;
                o.x = pack_i8(hv[c * 8] * inv, hv[c * 8 + 1] * inv, hv[c * 8 + 2] * inv, hv[c * 8 + 3] * inv); o.y = pack_i8(hv[c * 8 + 4] * inv, hv[c * 8 + 5] * inv, hv[c * 8 + 6] * inv, hv[c * 8 + 7] * inv);
                *(v2u*)(a.ws + WS_H8 + (size_t)t * D + (c * 64 + lane) * 8) = o; }
            if (lane == 0) ((float*)(a.ws + WS_SAH))[t] = mx * (1.0f / 127.0f); }
        __syncthreads();
    }
    { const int gw = bx * NWAVES + wave, NGW = G * NWAVES;
      for (int row = gw; row < NL * SBL; row += NGW) { const int l = row / SBL, r = row % SBL;
          const bf16* src; unsigned char* dst;
          if (r < NP) { src = (const bf16*)(a.ws + WS_WIN) + ((size_t)l * INW + r) * D; dst = a.ws + WS_WIN8 + ((size_t)l * NP + r) * D; }
          else if (r < NP + D) { src = (const bf16*)(a.ws + WS_WOUT) + ((size_t)l * D + (r - NP)) * D; dst = a.ws + WS_WOUT8 + ((size_t)l * D + (r - NP)) * D; }
          else { src = (const bf16*)(a.ws + WS_WQ) + ((size_t)l * D + (r - NP - D)) * D; dst = a.ws + WS_WQ8 + ((size_t)l * D + (r - NP - D)) * D; }
          v4u w[4]; float mx = 0.f;
#pragma unroll
          for (int c = 0; c < 4; ++c) w[c] = *(const v4u*)(src + (c * 64 + lane) * 8);
#pragma unroll
          for (int c = 0; c < 4; ++c)
#pragma unroll
              for (int j = 0; j < 4; ++j) mx = fmaxf(mx, fmaxf(fabsf(bflo(w[c][j])), fabsf(bfhi(w[c][j]))));
#pragma unroll
          for (int o = 1; o < 64; o <<= 1) mx = fmaxf(mx, __shfl_xor(mx, o));
          const float inv = mx > 0.f ? 127.0f / mx : 0.f;
#pragma unroll
          for (int c = 0; c < 4; ++c) { v2u o;
              o.x = pack_i8(bflo(w[c][0]) * inv, bfhi(w[c][0]) * inv, bflo(w[c][1]) * inv, bfhi(w[c][1]) * inv); o.y = pack_i8(bflo(w[c][2]) * inv, bfhi(w[c][2]) * inv, bflo(w[c][3]) * inv, bfhi(w[c][3]) * inv);
              *(v2u*)(dst + (c * 64 + lane) * 8) = o; }
          if (lane == 0) ((float*)(a.ws + WS_SB))[row] = mx * (1.0f / 127.0f); } }
}

__device__ __forceinline__ void gate_prep(const Args& a, int l, LAS unsigned char* lds, int tid, int lane, int wave, int ch) {
    const bf16* hbuf = (const bf16*)(a.ws + WS_H); const bf16* waT = (const bf16*)(a.ws + WS_WIN) + ((size_t)l * INW + NP) * D;
    bf16* Ebuf = (bf16*)(a.ws + WS_E); float* dtot = (float*)(a.ws + WS_DTOT);
    const int t0 = ch * 64, l15 = lane & 15, lq = lane >> 4, mt = wave & 3, kh = wave >> 2;
    f32x4 acc = (f32x4){0.f, 0.f, 0.f, 0.f};
    const bf16* hA = hbuf + (size_t)(t0 + 16 * mt + l15) * D + kh * 1024 + 8 * lq;
    const bf16* wB = waT + (size_t)l15 * D + kh * 1024 + 8 * lq;
#pragma unroll 8
    for (int ks = 0; ks < 32; ++ks) { const bf16x8 av = *(const bf16x8*)(hA + 32 * ks), bv = *(const bf16x8*)(wB + 32 * ks); acc = __builtin_amdgcn_mfma_f32_16x16x32_bf16(av, bv, acc, 0, 0, 0); }
    LAS float* alr = (LAS float*)lds;
#pragma unroll
    for (int r = 0; r < 4; ++r) alr[(kh * 64 + 16 * mt + 4 * lq + r) * 16 + l15] = acc[r];
    __syncthreads();
    const int col = tid;
    float wg[16];
#pragma unroll
    for (int r = 0; r < 16; ++r) wg[r] = a.in[5][((size_t)l * RANK + r) * GKW + col];
    const float bgc = a.in[6][l * GKW + col];
    float tot = 0.f;
    for (int j = 0; j < 64; ++j) { float lg = bgc;
#pragma unroll
        for (int r4 = 0; r4 < 4; ++r4) { const f32x4 p = *(const LAS f32x4*)(alr + j * 16 + r4 * 4), q = *(const LAS f32x4*)(alr + (64 + j) * 16 + r4 * 4);
            lg += (p.x + q.x) * wg[r4 * 4] + (p.y + q.y) * wg[r4 * 4 + 1] + (p.z + q.z) * wg[r4 * 4 + 2] + (p.w + q.w) * wg[r4 * 4 + 3]; }
        tot += logsigmoid_f(lg) * (1.0f / 16.0f); }
    float run = 0.f;
    for (int j = 0; j < 64; ++j) { float lg = bgc;
#pragma unroll
        for (int r4 = 0; r4 < 4; ++r4) { const f32x4 p = *(const LAS f32x4*)(alr + j * 16 + r4 * 4), q = *(const LAS f32x4*)(alr + (64 + j) * 16 + r4 * 4);
            lg += (p.x + q.x) * wg[r4 * 4] + (p.y + q.y) * wg[r4 * 4 + 1] + (p.z + q.z) * wg[r4 * 4 + 2] + (p.w + q.w) * wg[r4 * 4 + 3]; }
        run += logsigmoid_f(lg) * (1.0f / 16.0f);
        Ebuf[(size_t)(t0 + j) * GKW + col] = (bf16)(pk2(__expf(tot - run), 0.f) & 0xffffu); }
    dtot[(size_t)ch * GKW + col] = __expf(tot);
    __syncthreads();
}

__device__ __forceinline__ void gla_unit(const Args& a, LAS unsigned char* lds, int tid, int lane, int wave, int un) {
    const bf16* proj = (const bf16*)(a.ws + WS_PROJ); const bf16* Ebuf = (const bf16*)(a.ws + WS_E); const float* dtot = (const float*)(a.ws + WS_DTOT); bf16* ogla = (bf16*)(a.ws + WS_OGLA);
    const int pair_ = (un & 7) * 4 + (un >> 6), dvs = (un >> 3) & 7, hh = pair_ & 3, b = pair_ >> 2;
    LAS bf16* kdT = (LAS bf16*)lds;
    LAS bf16* vT = (LAS bf16*)(lds + 18432);
    LAS bf16* ST = (LAS bf16*)(lds + 18432 + 4608);
    const int l15 = lane & 15, lq = lane >> 4, jl = tid >> 3, c0 = tid & 7, dv4 = (tid & 7) * 4, jt = (wave & 3) * 16, dvt = (wave >> 2) * 16;
#define GLA_BAR() do { asm volatile("s_waitcnt lgkmcnt(0)" ::: "memory"); __builtin_amdgcn_s_barrier(); asm volatile("" ::: "memory"); } while (0)
    f32x4 S0 = (f32x4){0.f, 0.f, 0.f, 0.f}, S1 = (f32x4){0.f, 0.f, 0.f, 0.f};
    v4u kn0[2], kn1[2], en0[2], en1[2]; v2u vn0, vn1; bf16x8 qn0[4], qn1[4], qc[4]; f32x4 dn0, dn1, dc;
#define GLA_LOAD(c, kn, en, vn, qn, dn) do { const int t0c = b * SEQ + (c) * 64; const bf16* pr = proj + (size_t)(t0c + jl) * NP; \
          \
        kn[0] = *(const v4u*)(pr + PK + hh * 128 + 8 * c0); kn[1] = *(const v4u*)(pr + PK + hh * 128 + 64 + 8 * c0); \
        en[0] = *(const v4u*)(Ebuf + (size_t)(t0c + jl) * GKW + hh * 128 + 8 * c0); en[1] = *(const v4u*)(Ebuf + (size_t)(t0c + jl) * GKW + hh * 128 + 64 + 8 * c0); \
        vn = *(const v2u*)(pr + PV + hh * 256 + dvs * 32 + dv4); \
        _Pragma("unroll") for (int ks_ = 0; ks_ < 4; ++ks_) qn[ks_] = *(const bf16x8*)(proj + (size_t)(t0c + jt + l15) * NP + PQ + hh * 128 + 32 * ks_ + 8 * lq); \
        dn = *(const f32x4*)(dtot + (size_t)(b * NCH + (c)) * GKW + hh * 128 + 16 * wave + 4 * lq); } while (0)
#define GLA_PREP(kn, en, vn, qn, dn) do { \
        _Pragma("unroll") for (int h_ = 0; h_ < 2; ++h_) _Pragma("unroll") for (int i_ = 0; i_ < 8; ++i_) { const unsigned w_ = kn[h_][i_ >> 1], e_ = en[h_][i_ >> 1]; \
            const float kf_ = (i_ & 1) ? bfhi(w_) : bflo(w_), ef_ = (i_ & 1) ? bfhi(e_) : bflo(e_); \
            kdT[(64 * h_ + 8 * c0 + i_) * 72 + ((((jl >> 3) ^ c0) & 7) << 3) + (jl & 7)] = (bf16)(pk2(kf_ * ef_, 0.f) & 0xffffu); }     \
        _Pragma("unroll") for (int i_ = 0; i_ < 4; ++i_) { const unsigned w_ = vn[i_ >> 1]; vT[(dv4 + i_) * 72 + jl] = (bf16)((i_ & 1) ? (w_ >> 16) : (w_ & 0xffffu)); } \
        _Pragma("unroll") for (int ks_ = 0; ks_ < 4; ++ks_) qc[ks_] = qn[ks_]; \
        dc = dn; } while (0)
#define GLA_BODY(c) do { \
        S0 = S0 * dc; S1 = S1 * dc; \
        _Pragma("unroll") for (int ks = 0; ks < 2; ++ks) { \
            const bf16x8 A_ = *(const LAS bf16x8*)(kdT + (16 * wave + l15) * 72 + ((((4 * ks + lq) ^ (2 * wave + (l15 >> 3))) & 7) << 3)); \
            const bf16x8 B0_ = *(const LAS bf16x8*)(vT + l15 * 72 + 32 * ks + 8 * lq), B1_ = *(const LAS bf16x8*)(vT + (16 + l15) * 72 + 32 * ks + 8 * lq); \
            S0 = __builtin_amdgcn_mfma_f32_16x16x32_bf16(A_, B0_, S0, 0, 0, 0); S1 = __builtin_amdgcn_mfma_f32_16x16x32_bf16(A_, B1_, S1, 0, 0, 0); } \
        { v2u w0_, w1_; w0_.x = pk2(S0.x, S0.y); w0_.y = pk2(S0.z, S0.w); w1_.x = pk2(S1.x, S1.y); w1_.y = pk2(S1.z, S1.w); \
          *(LAS v2u*)(ST + l15 * 136 + 16 * wave + 4 * lq) = w0_; *(LAS v2u*)(ST + (16 + l15) * 136 + 16 * wave + 4 * lq) = w1_; } \
        GLA_BAR(); \
        f32x4 O_ = (f32x4){0.f, 0.f, 0.f, 0.f}; \
        _Pragma("unroll") for (int ks = 0; ks < 4; ++ks) { const bf16x8 A_ = *(const LAS bf16x8*)(ST + (dvt + l15) * 136 + 32 * ks + 8 * lq); O_ = __builtin_amdgcn_mfma_f32_16x16x32_bf16(A_, qc[ks], O_, 0, 0, 0); } \
        { const f32x4 Os_ = O_ * 0.08838834764831845f; v2u ob_; ob_.x = pk2(Os_.x, Os_.y); ob_.y = pk2(Os_.z, Os_.w); \
          *(v2u*)(ogla + (size_t)(b * SEQ + (c) * 64 + jt + l15) * 1024 + hh * 256 + dvs * 32 + dvt + 4 * lq) = ob_; } } while (0)
    GLA_LOAD(0, kn0, en0, vn0, qn0, dn0); GLA_LOAD(1, kn1, en1, vn1, qn1, dn1);
    GLA_PREP(kn0, en0, vn0, qn0, dn0);
    GLA_BAR();
    for (int c = 0; c < NCH; c += 2) {
        { const int cn_ = c + 2 < NCH ? c + 2 : NCH - 1; GLA_LOAD(cn_, kn0, en0, vn0, qn0, dn0); }
        GLA_BODY(c);
        GLA_PREP(kn1, en1, vn1, qn1, dn1);
        GLA_BAR();
        { const int cn_ = c + 3 < NCH ? c + 3 : NCH - 1; GLA_LOAD(cn_, kn1, en1, vn1, qn1, dn1); }
        GLA_BODY(c + 1);
        GLA_PREP(kn0, en0, vn0, qn0, dn0);
        GLA_BAR();
    }
#undef GLA_BODY
#undef GLA_BAR
#undef GLA_LOAD
#undef GLA_PREP
}

__device__ __forceinline__ void unpack16(const v4u& p0, const v4u& p1, float (&o)[16]) {
#pragma unroll
    for (int j = 0; j < 4; ++j) { o[2 * j] = bflo(p0[j]); o[2 * j + 1] = bfhi(p0[j]); o[8 + 2 * j] = bflo(p1[j]); o[8 + 2 * j + 1] = bfhi(p1[j]); }
}
__device__ __forceinline__ void mixpost_chunk(const Args& a, int l, int lane, int wave, int ch) {
    const bf16* proj = (const bf16*)(a.ws + WS_PROJ); const bf16* ogla = (const bf16*)(a.ws + WS_OGLA);
    const int c0 = 16 * lane, tfirst = ch * 64 + wave * 8, sfirst = tfirst % SEQ;
    float gn[16], cw0[16], cw1[16], cw2[16], cn[16], u1[16], u2[16];
#pragma unroll
    for (int i = 0; i < 16; ++i) { gn[i] = a.in[7][l * 256 + ((c0 + i) & 255)]; cw0[i] = a.in[8][(size_t)l * 3072 + c0 + i]; cw1[i] = a.in[8][(size_t)l * 3072 + 1024 + c0 + i];
        cw2[i] = a.in[8][(size_t)l * 3072 + 2048 + c0 + i]; cn[i] = a.in[9][l * 1024 + c0 + i]; u1[i] = 0.f; u2[i] = 0.f; }
    if (sfirst >= 2) {
        float cc[16], chh[16];
        { const bf16* pr = proj + (size_t)(tfirst - 2) * NP; unpack16(*(const v4u*)(pr + PCC + c0), *(const v4u*)(pr + PCC + c0 + 8), cc); unpack16(*(const v4u*)(pr + PCH + c0), *(const v4u*)(pr + PCH + c0 + 8), chh); }
#pragma unroll
        for (int i = 0; i < 16; ++i) u2[i] = cc[i] * chh[i];
        { const bf16* pr = proj + (size_t)(tfirst - 1) * NP; unpack16(*(const v4u*)(pr + PCC + c0), *(const v4u*)(pr + PCC + c0 + 8), cc); unpack16(*(const v4u*)(pr + PCH + c0), *(const v4u*)(pr + PCH + c0 + 8), chh); }
#pragma unroll
        for (int i = 0; i < 16; ++i) u1[i] = cc[i] * chh[i];
    }
#pragma unroll 2
    for (int it = 0; it < 8; ++it) { const int t = tfirst + it; const bf16* pr = proj + (size_t)t * NP;
        float o[16], r[16], cb[16], cc[16], chh[16];
        unpack16(*(const v4u*)(ogla + (size_t)t * 1024 + c0), *(const v4u*)(ogla + (size_t)t * 1024 + c0 + 8), o);
        unpack16(*(const v4u*)(pr + PR + c0), *(const v4u*)(pr + PR + c0 + 8), r);
        unpack16(*(const v4u*)(pr + PCB + c0), *(const v4u*)(pr + PCB + c0 + 8), cb);
        unpack16(*(const v4u*)(pr + PCC + c0), *(const v4u*)(pr + PCC + c0 + 8), cc);
        unpack16(*(const v4u*)(pr + PCH + c0), *(const v4u*)(pr + PCH + c0 + 8), chh);
        float ss = 0.f;
#pragma unroll
        for (int i = 0; i < 16; ++i) ss += o[i] * o[i];
        ss += __shfl_xor(ss, 1); ss += __shfl_xor(ss, 2); ss += __shfl_xor(ss, 4); ss += __shfl_xor(ss, 8);
        const float rg = rsqrtf(ss * (1.0f / 256.f) + EPS);
        float val[16]; float s2 = 0.f;
#pragma unroll
        for (int i = 0; i < 16; ++i) { const float u0 = cc[i] * chh[i]; val[i] = cb[i] * (cw0[i] * u2[i] + cw1[i] * u1[i] + cw2[i] * u0); s2 += val[i] * val[i]; u2[i] = u1[i]; u1[i] = u0; }
        const float rc = rsqrtf(wave_sum(s2) * (1.0f / 1024.f) + EPS);
        float ya[16], yb[16]; float mx = 0.f;
#pragma unroll
        for (int i = 0; i < 16; ++i) { ya[i] = o[i] * rg * gn[i] * silu_f(r[i]); yb[i] = val[i] * rc * cn[i]; mx = fmaxf(mx, fmaxf(fabsf(ya[i]), fabsf(yb[i]))); }
#pragma unroll
        for (int o_ = 1; o_ < 64; o_ <<= 1) mx = fmaxf(mx, __shfl_xor(mx, o_));
        const float inv = mx > 0.f ? 127.0f / mx : 0.f;
        v4u y0, y1;
#pragma unroll
        for (int j = 0; j < 4; ++j) { y0[j] = pack_i8(ya[4 * j] * inv, ya[4 * j + 1] * inv, ya[4 * j + 2] * inv, ya[4 * j + 3] * inv); y1[j] = pack_i8(yb[4 * j] * inv, yb[4 * j + 1] * inv, yb[4 * j + 2] * inv, yb[4 * j + 3] * inv); }
        unsigned char* yr = a.ws + WS_Y8 + (size_t)t * D;
        *(v4u*)(yr + c0) = y0; *(v4u*)(yr + 1024 + c0) = y1;
        if (lane == 0) ((float*)(a.ws + WS_SAY))[t] = mx * (1.0f / 127.0f);
    }
}

__device__ __forceinline__ void ln1_chunk(const Args& a, int l, LAS unsigned char* lds, int lane, int wave, int ch) {
    const float* zbuf = (const float*)(a.ws + WS_Z); const float* mod = (const float*)(a.ws + WS_MOD);
    const int b = ch / NCH; const float* mb = mod + ((size_t)l * NB + b) * 6 * D;
#pragma unroll 2
    for (int it = 0; it < 8; ++it) { const int t = ch * 64 + wave * 8 + it;
        float z[32];
#pragma unroll
        for (int c = 0; c < 8; ++c) { const f32x4 v0 = *(const f32x4*)(zbuf + (size_t)t * D + (c * 64 + lane) * 4); z[c * 4] = v0.x; z[c * 4 + 1] = v0.y; z[c * 4 + 2] = v0.z; z[c * 4 + 3] = v0.w; }
        ln_tail(z, t, lane, a.in[11] + (size_t)l * D, a.in[12] + (size_t)l * D, (float*)(a.ws + WS_X1), mb + 3 * D, mb + 4 * D, (bf16*)nullptr, a.ws + WS_HQ8, (float*)(a.ws + WS_HSC), lds + wave * 2304, a.ws + WS_H28, nullptr);
    }
}

template <int N> __device__ __forceinline__ void bitonic_sort_desc(float (&v)[N]) {
#pragma unroll
    for (int k = 2; k <= N; k <<= 1)
#pragma unroll
        for (int j = k >> 1; j > 0; j >>= 1)
#pragma unroll
            for (int i = 0; i < N; ++i) { const int p = i ^ j; if (p > i) { const bool desc = ((i & k) == 0); const float x = v[i], y = v[p]; const float mx = fmaxf(x, y), mn = fminf(x, y); v[i] = desc ? mx : mn; v[p] = desc ? mn : mx; } }
}
__device__ __forceinline__ void merge_top16(float (&x)[16], const float (&y)[16]) {
#pragma unroll
    for (int i = 0; i < 16; ++i) x[i] = fmaxf(x[i], y[15 - i]);
#pragma unroll
    for (int j = 8; j > 0; j >>= 1)
#pragma unroll
        for (int i = 0; i < 16; ++i) { const int p = i ^ j; if (p > i) { const float u = x[i], w = x[p]; x[i] = fmaxf(u, w); x[p] = fminf(u, w); } }
}
__device__ __forceinline__ void ce_desc(float& ka, int& pa, float& kb, int& pb) { const bool sw = kb > ka; const float k0 = sw ? kb : ka, k1 = sw ? ka : kb; const int p0 = sw ? pb : pa, p1 = sw ? pa : pb; ka = k0; pa = p0; kb = k1; pb = p1; }
__device__ __forceinline__ void bitonic_sort_desc_kp(float (&k)[16], int (&p)[16]) {
#pragma unroll
    for (int kk = 2; kk <= 16; kk <<= 1)
#pragma unroll
        for (int j = kk >> 1; j > 0; j >>= 1)
#pragma unroll
            for (int i = 0; i < 16; ++i) { const int q = i ^ j; if (q > i) { if ((i & kk) == 0) ce_desc(k[i], p[i], k[q], p[q]); else ce_desc(k[q], p[q], k[i], p[i]); } }
}
__device__ __forceinline__ void merge_top16_kp(float (&k)[16], int (&p)[16], const float (&k2)[16], const int (&p2)[16]) {
#pragma unroll
    for (int i = 0; i < 16; ++i) { const bool sw = k2[15 - i] > k[i]; k[i] = sw ? k2[15 - i] : k[i]; p[i] = sw ? p2[15 - i] : p[i]; }
#pragma unroll
    for (int j = 8; j > 0; j >>= 1)
#pragma unroll
        for (int i = 0; i < 16; ++i) { const int q = i ^ j; if (q > i) ce_desc(k[i], p[i], k[q], p[q]); }
}
__device__ constexpr int cand_i(int s) { return s < 16 ? 0 : s < 24 ? 1 : s < 29 ? 2 : s < 33 ? 3 : s < 36 ? 4 : s < 38 ? 5 : s < 40 ? 6 : s < 42 ? 7 : s < 50 ? s - 34 : -1; }
__device__ constexpr int cand_j(int s) { return s < 16 ? s : s < 24 ? s - 16 : s < 29 ? s - 24 : s < 33 ? s - 29 : s < 36 ? s - 33 : s < 38 ? s - 36 : s < 40 ? s - 38 : s < 42 ? s - 40 : s < 50 ? 0 : -1; }

__device__ __forceinline__ void peer_retrieve(const Args& a, int l, LAS unsigned char* lds, int lane, int wave, int ch) {
    const bf16* qbuf = (const bf16*)(a.ws + WS_Q); const bf16* keys = (const bf16*)(a.ws + WS_KEYS) + ((size_t)(l * 8 + wave) * 2) * 128 * 128;
    LAS int* eg_e = (LAS int*)lds; LAS float* eg_g = (LAS float*)(lds + 32768);
    const int l31 = lane & 31, l5 = lane >> 5, h = wave, t0 = ch * 64;
    for (int tt = 0; tt < 2; ++tt) {
        float sv[2][16];
#pragma unroll
        for (int p = 0; p < 2; ++p) {
            f32x16 acc[4];
#pragma unroll
            for (int nt = 0; nt < 4; ++nt)
#pragma unroll
                for (int r = 0; r < 16; ++r) acc[nt][r] = 0.f;
            const bf16* qp = qbuf + (size_t)(t0 + 32 * tt + l31) * D + h * 256 + p * 128 + 8 * l5;
            const bf16* kp = keys + (size_t)(p * 128 + l31) * 128 + 8 * l5;
#pragma unroll 2
            for (int ks = 0; ks < 8; ++ks) { const bf16x8 bq = *(const bf16x8*)(qp + 16 * ks);
#pragma unroll
                for (int nt = 0; nt < 4; ++nt) { const bf16x8 ak = *(const bf16x8*)(kp + (size_t)(32 * nt) * 128 + 16 * ks); acc[nt] = __builtin_amdgcn_mfma_f32_32x32x16_bf16(ak, bq, acc[nt], 0, 0, 0); } }
            float v[4][16];
#pragma unroll
            for (int nt = 0; nt < 4; ++nt)
#pragma unroll
                for (int r = 0; r < 16; ++r) { const unsigned idx = 32u * nt + (r & 3) + 8u * (r >> 2) + 4u * l5; v[nt][r] = __uint_as_float((__float_as_uint(acc[nt][r]) & 0xffffff80u) | idx); }
#pragma unroll
            for (int nt = 0; nt < 4; ++nt) bitonic_sort_desc<16>(v[nt]);
            merge_top16(v[0], v[1]); merge_top16(v[2], v[3]); merge_top16(v[0], v[2]);
            float o[16];
#pragma unroll
            for (int i = 0; i < 16; ++i) o[i] = __shfl_xor(v[0][i], 32);
            merge_top16(v[0], o);
#pragma unroll
            for (int i = 0; i < 16; ++i) sv[p][i] = v[0][i];
        }
        LAS unsigned char* idxb = (LAS unsigned char*)(lds + 69632) + wave * 2048 + lane * 32;
        { v4u w0, w1;
#pragma unroll
          for (int q4 = 0; q4 < 4; ++q4) {
              w0[q4] = (__float_as_uint(sv[0][4 * q4]) & 127u) | ((__float_as_uint(sv[0][4 * q4 + 1]) & 127u) << 8) | ((__float_as_uint(sv[0][4 * q4 + 2]) & 127u) << 16) | ((__float_as_uint(sv[0][4 * q4 + 3]) & 127u) << 24);
              w1[q4] = (__float_as_uint(sv[1][4 * q4]) & 127u) | ((__float_as_uint(sv[1][4 * q4 + 1]) & 127u) << 8) | ((__float_as_uint(sv[1][4 * q4 + 2]) & 127u) << 16) | ((__float_as_uint(sv[1][4 * q4 + 3]) & 127u) << 24); }
          *(LAS v4u*)(idxb) = w0; *(LAS v4u*)(idxb + 16) = w1; }
        float ck[4][16];
#pragma unroll
        for (int s = 0; s < 64; ++s) {
            if (cand_i(s) >= 0) { const unsigned b0 = __float_as_uint(sv[0][cand_i(s) < 0 ? 0 : cand_i(s)]), b1 = __float_as_uint(sv[1][cand_j(s) < 0 ? 0 : cand_j(s)]);
                const float sum = __uint_as_float(b0 & 0xffffff80u) + __uint_as_float(b1 & 0xffffff80u);
                ck[s >> 4][s & 15] = __uint_as_float((__float_as_uint(sum) & 0xffffff00u) | (unsigned)((cand_i(s) < 0 ? 0 : cand_i(s)) * 16 + (cand_j(s) < 0 ? 0 : cand_j(s)))); }
            else ck[s >> 4][s & 15] = -3.0e38f; }
        bitonic_sort_desc<16>(ck[1]); bitonic_sort_desc<16>(ck[2]);
        merge_top16(ck[0], ck[1]); merge_top16(ck[2], ck[3]); merge_top16(ck[0], ck[2]);
        LDS_WAIT(); asm volatile("" ::: "memory");
        float ex[16]; int ce[16]; float den = 0.f;
        const float cmax = __uint_as_float(__float_as_uint(ck[0][0]) & 0xffffff00u);
#pragma unroll
        for (int i = 0; i < 16; ++i) { const unsigned bits = __float_as_uint(ck[0][i]); ex[i] = __expf(__uint_as_float(bits & 0xffffff00u) - cmax); den += ex[i];
            ce[i] = (int)idxb[(bits >> 4) & 15u] * 128 + (int)idxb[16 + (bits & 15u)]; }
        const float inv = 1.0f / den;
        if (l5 == 0) {
            const int base = (32 * tt + l31) * 128 + h * 16;
#pragma unroll
            for (int i4 = 0; i4 < 4; ++i4) { *(LAS v4u*)(eg_e + base + 4 * i4) = (v4u){(unsigned)ce[4 * i4], (unsigned)ce[4 * i4 + 1], (unsigned)ce[4 * i4 + 2], (unsigned)ce[4 * i4 + 3]};
                *(LAS f32x4*)(eg_g + base + 4 * i4) = (f32x4){ex[4 * i4] * inv, ex[4 * i4 + 1] * inv, ex[4 * i4 + 2] * inv, ex[4 * i4 + 3] * inv}; }
        }
        LDS_WAIT(); asm volatile("" ::: "memory");
    }
}

typedef unsigned char uc4 __attribute__((ext_vector_type(4)));
constexpr int NSLICE = 16, SLICE_SHIFT = 10;
__device__ __forceinline__ int sdot4i(unsigned w, unsigned x, int acc) { return __builtin_amdgcn_sdot4((int)w, (int)x, acc, false); }
__device__ __forceinline__ void fma_ub4(unsigned w, float s, float& y0, float& y1, float& y2, float& y3) { const uc4 b = __builtin_bit_cast(uc4, w); y0 += s * (float)b.x; y1 += s * (float)b.y; y2 += s * (float)b.z; y3 += s * (float)b.w; }
#if TAB4
__device__ __forceinline__ void peer_tail(const Args& a, int l, int t, int lane, const bf16* Yrow, const float* mb, const float* mbn, bool last) {
    const float* x1buf = (const float*)(a.ws + WS_X1);
    float z[32];
#pragma unroll
    for (int c8 = 0; c8 < 8; ++c8) { const int col = (c8 * 64 + lane) * 4;
        const v2u yb = *(const v2u*)(Yrow + col); const f32x4 yv = (f32x4){bflo(yb.x), bfhi(yb.x), bflo(yb.y), bfhi(yb.y)};
        const f32x4 x0 = *(const f32x4*)(x1buf + (size_t)t * D + col), g0 = *(const f32x4*)(mb + 5 * D + col);
        z[c8 * 4] = ALPHA * x0.x + (1.f + g0.x) * yv.x; z[c8 * 4 + 1] = ALPHA * x0.y + (1.f + g0.y) * yv.y; z[c8 * 4 + 2] = ALPHA * x0.z + (1.f + g0.z) * yv.z; z[c8 * 4 + 3] = ALPHA * x0.w + (1.f + g0.w) * yv.w; }
    ln_tail(z, t, lane, a.in[17] + (size_t)l * D, a.in[18] + (size_t)l * D, last ? a.out : (float*)(a.ws + WS_X), mbn, mbn + D, last ? (bf16*)nullptr : (bf16*)(a.ws + WS_H), nullptr, nullptr, nullptr, last ? (unsigned char*)nullptr : a.ws + WS_H8, (float*)(a.ws + WS_SAH));
}
template <class TT, int N, int M> __device__ __forceinline__ void treduce(TT (&v)[N], int lane) {
    const bool c0 = (lane & M) != 0, c1 = (lane & (2 * M)) != 0, c2 = (lane & (4 * M)) != 0;
#pragma unroll
    for (int m = 0; m < N / 2; ++m) { const TT keep = c0 ? v[2 * m + 1] : v[2 * m], send = c0 ? v[2 * m] : v[2 * m + 1]; v[m] = keep + __shfl_xor(send, M); }
#pragma unroll
    for (int m = 0; m < N / 4; ++m) { const TT keep = c1 ? v[2 * m + 1] : v[2 * m], send = c1 ? v[2 * m] : v[2 * m + 1]; v[m] = keep + __shfl_xor(send, 2 * M); }
#pragma unroll
    for (int m = 0; m < N / 8; ++m) { const TT keep = c2 ? v[2 * m + 1] : v[2 * m], send = c2 ? v[2 * m] : v[2 * m + 1]; v[m] = keep + __shfl_xor(send, 4 * M); }
}
__device__ __forceinline__ void tr4x4(unsigned a, unsigned b, unsigned c, unsigned d, unsigned& t0, unsigned& t1, unsigned& t2, unsigned& t3) {
    const unsigned x0 = __builtin_amdgcn_perm(b, a, 0x05010400u), x1 = __builtin_amdgcn_perm(b, a, 0x07030602u), y0 = __builtin_amdgcn_perm(d, c, 0x05010400u), y1 = __builtin_amdgcn_perm(d, c, 0x07030602u);
    t0 = __builtin_amdgcn_perm(y0, x0, 0x05040100u); t1 = __builtin_amdgcn_perm(y0, x0, 0x07060302u); t2 = __builtin_amdgcn_perm(y1, x1, 0x05040100u); t3 = __builtin_amdgcn_perm(y1, x1, 0x07060302u);
}
__device__ __forceinline__ int sdot8i(unsigned w, unsigned x, int acc) { return __builtin_amdgcn_sdot8((int)w, (int)x, acc, false); }
__device__ __forceinline__ float slot_scale(unsigned w3) { return __builtin_amdgcn_exp2f((float)(w3 >> 24) * 0.125f - 16.0f); }
__device__ __forceinline__ void peer_experts(const Args& a, int l, LAS unsigned char* lds, int lane0, int wave, int ch) {
    const float* mod = (const float*)(a.ws + WS_MOD);
    const unsigned char* ut = a.ws + WS_UT + (size_t)l * NE * 1152; const unsigned char* vt = a.ws + WS_VT + (size_t)l * NE * 1152; const unsigned char* hq8 = a.ws + WS_HQ8;
    const float* hsc = (const float*)(a.ws + WS_HSC);
    bf16* Ybuf = (bf16*)(a.ws + WS_Z);
    const LAS int* eg_e = (const LAS int*)lds; LAS float* sw = (LAS float*)(lds + 32768);
    LAS float* apart = (LAS float*)(lds + 65536);
    const int b = ch / NCH; const bool last = (l == NL - 1);
    const float* mb = mod + ((size_t)l * NB + b) * 6 * D; const float* mbn = mod + ((size_t)(last ? l : l + 1) * NB + b) * 6 * D;
    const int tlw = wave * 8;
    { const int lane = lane0;
#pragma unroll
      for (int i = 0; i < 16; ++i) apart[tlw * 128 + i * 64 + lane] = 0.f; }
    LDS_WAIT(); asm volatile("" ::: "memory");
    {
        int laneL = lane0; asm volatile("" : "+v"(laneL)); const int lane = laneL;
        const int g = lane >> 3, l7 = lane & 7;
        v4u bufA[16], bufB[16], hA0, hA1, hB0, hB1;
#define CU_LOAD(buf, h0_, h1_, idx_) do { const int u_ = (idx_) >> 3, tl_ = tlw + ((idx_) & 7); const unsigned soff_ = (unsigned)(u_ * 128 + l7 * 16); \
            const unsigned char* hp_ = hq8 + (size_t)(ch * 64 + tl_) * 2304 + (u_ * 8 + l7) * 32; h0_ = *(const v4u*)hp_; h1_ = *(const v4u*)(hp_ + 16); \
            _Pragma("unroll") for (int i_ = 0; i_ < 16; ++i_) { const unsigned e_ = (unsigned)eg_e[tl_ * 128 + 8 * i_ + g]; buf[i_] = *(const v4u*)(ut + (size_t)(e_ * 1152u + soff_)); } } while (0)
#define CU_COMP(buf, h0_, h1_, idx_) do { const int tl_ = tlw + ((idx_) & 7); float accv_[16]; \
            _Pragma("unroll") for (int i_ = 0; i_ < 16; ++i_) { int sl_ = 0, sh_ = 0; \
                _Pragma("unroll") for (int d_ = 0; d_ < 4; ++d_) { const unsigned x_ = buf[i_][d_] ^ 0x88888888u; sl_ = sdot8i(x_, h0_[d_], sl_); sh_ = sdot8i(x_, h1_[d_], sh_); } \
                accv_[i_] = slot_scale(buf[i_][3]) * (float)(16 * sh_ + sl_); } \
            treduce<float, 16, 1>(accv_, lane); \
            apart[tl_ * 128 + 8 * l7 + g] += accv_[0]; apart[tl_ * 128 + 8 * (8 + l7) + g] += accv_[1]; } while (0)
        CU_LOAD(bufA, hA0, hA1, 0);
        for (int idx = 0; idx < 72; idx += 2) {
            CU_LOAD(bufB, hB0, hB1, idx + 1);
            CU_COMP(bufA, hA0, hA1, idx);
            { const int nx_ = idx + 2 < 72 ? idx + 2 : 71; CU_LOAD(bufA, hA0, hA1, nx_); }
            CU_COMP(bufB, hB0, hB1, idx + 1);
        }
#undef CU_LOAD
#undef CU_COMP
        LDS_WAIT(); asm volatile("" ::: "memory");
        for (int it = 0; it < 8; ++it) { const int tl = tlw + it; const float shs = hsc[ch * 64 + tl];
            const float w0 = sw[tl * 128 + lane] * gelu_tanh_f(apart[tl * 128 + lane] * shs), w1 = sw[tl * 128 + 64 + lane] * gelu_tanh_f(apart[tl * 128 + 64 + lane] * shs);
            sw[tl * 128 + lane] = w0; sw[tl * 128 + 64 + lane] = w1; }
        LDS_WAIT(); asm volatile("" ::: "memory");
    }
    {
        int laneL = lane0; asm volatile("" : "+v"(laneL)); const int lane = laneL;
        const int g = lane >> 3, l7 = lane & 7;
        v4u bufA[16], bufB[16];
#define CV_LOAD(buf, idx_) do { const int u_ = (idx_) >> 3, tl_ = tlw + ((idx_) & 7); const unsigned soff_ = (unsigned)(u_ * 128 + l7 * 16); \
            _Pragma("unroll") for (int i_ = 0; i_ < 16; ++i_) { const unsigned e_ = (unsigned)eg_e[tl_ * 128 + 8 * i_ + g]; buf[i_] = *(const v4u*)(vt + (size_t)(e_ * 1152u + soff_)); } } while (0)
#define CV_COMP(buf, idx_) do { const int u_ = (idx_) >> 3, tl_ = tlw + ((idx_) & 7); \
            float wf_[16]; float wmx_ = 0.f; \
            _Pragma("unroll") for (int i_ = 0; i_ < 16; ++i_) { wf_[i_] = sw[tl_ * 128 + 8 * i_ + g] * slot_scale(buf[i_][3]); wmx_ = fmaxf(wmx_, fabsf(wf_[i_])); } \
            wmx_ = fmaxf(wmx_, __shfl_xor(wmx_, 8)); wmx_ = fmaxf(wmx_, __shfl_xor(wmx_, 16)); wmx_ = fmaxf(wmx_, __shfl_xor(wmx_, 32));     \
            const float winv_ = wmx_ > 0.f ? 127.0f / wmx_ : 0.f, wsc_ = wmx_ * (1.0f / 127.0f); \
              \
            unsigned wq4_[4]; int wsum_ = 0; \
            _Pragma("unroll") for (int gp_ = 0; gp_ < 4; ++gp_) { \
                const unsigned m0_ = __float_as_uint(wf_[4 * gp_] * winv_ + 12582912.0f), m1_ = __float_as_uint(wf_[4 * gp_ + 1] * winv_ + 12582912.0f), m2_ = __float_as_uint(wf_[4 * gp_ + 2] * winv_ + 12582912.0f), m3_ = __float_as_uint(wf_[4 * gp_ + 3] * winv_ + 12582912.0f); \
                wq4_[gp_] = __builtin_amdgcn_perm(__builtin_amdgcn_perm(m3_, m2_, 0x0c0c0400u), __builtin_amdgcn_perm(m1_, m0_, 0x0c0c0400u), 0x05040100u); \
                wsum_ = sdot4i(wq4_[gp_], 0x01010101u, wsum_); } \
            int yi_[32]; \
            _Pragma("unroll") for (int q_ = 0; q_ < 32; ++q_) yi_[q_] = 0; \
            _Pragma("unroll") for (int gp_ = 0; gp_ < 4; ++gp_) { \
                _Pragma("unroll") for (int d_ = 0; d_ < 4; ++d_) { const unsigned A_ = buf[4 * gp_][d_], B_ = buf[4 * gp_ + 1][d_], C_ = buf[4 * gp_ + 2][d_], D_ = buf[4 * gp_ + 3][d_]; \
                    unsigned t0_, t1_, t2_, t3_; \
                    tr4x4(A_, B_, C_, D_, t0_, t1_, t2_, t3_);     \
                    yi_[8 * d_]     = sdot4i(t0_ & 0x0f0f0f0fu, wq4_[gp_], yi_[8 * d_]);     yi_[8 * d_ + 1] = sdot4i((t0_ >> 4) & 0x0f0f0f0fu, wq4_[gp_], yi_[8 * d_ + 1]); \
                    yi_[8 * d_ + 2] = sdot4i(t1_ & 0x0f0f0f0fu, wq4_[gp_], yi_[8 * d_ + 2]); yi_[8 * d_ + 3] = sdot4i((t1_ >> 4) & 0x0f0f0f0fu, wq4_[gp_], yi_[8 * d_ + 3]); \
                    yi_[8 * d_ + 4] = sdot4i(t2_ & 0x0f0f0f0fu, wq4_[gp_], yi_[8 * d_ + 4]); yi_[8 * d_ + 5] = sdot4i((t2_ >> 4) & 0x0f0f0f0fu, wq4_[gp_], yi_[8 * d_ + 5]); \
                    yi_[8 * d_ + 6] = sdot4i(t3_ & 0x0f0f0f0fu, wq4_[gp_], yi_[8 * d_ + 6]); yi_[8 * d_ + 7] = sdot4i((t3_ >> 4) & 0x0f0f0f0fu, wq4_[gp_], yi_[8 * d_ + 7]); } } \
            treduce<int, 32, 8>(yi_, lane); \
            wsum_ += __shfl_xor(wsum_, 8); wsum_ += __shfl_xor(wsum_, 16); wsum_ += __shfl_xor(wsum_, 32);     \
            float y_[4]; \
            _Pragma("unroll") for (int q_ = 0; q_ < 4; ++q_) y_[q_] = wsc_ * (float)(yi_[q_] - 8 * wsum_); \
            { const int colb_ = u_ * 240 + l7 * 30 + g; bf16* yr_ = Ybuf + (size_t)(ch * 64 + tl_) * D + colb_; \
              _Pragma("unroll") for (int m_ = 0; m_ < 4; ++m_) if (8 * m_ + g < 30 && colb_ + 8 * m_ < D) yr_[8 * m_] = (bf16)(pk2(y_[m_], 0.f) & 0xffffu); } } while (0)
        CV_LOAD(bufA, 0);
        for (int idx = 0; idx < 72; idx += 2) {
            CV_LOAD(bufB, idx + 1);
            CV_COMP(bufA, idx);
            { const int nx_ = idx + 2 < 72 ? idx + 2 : 71; CV_LOAD(bufA, nx_); }
            CV_COMP(bufB, idx + 1);
        }
#undef CV_LOAD
#undef CV_COMP
    }
    asm volatile("s_waitcnt vmcnt(0)" ::: "memory");
    __builtin_amdgcn_fence(__ATOMIC_ACQUIRE, "agent");
    asm volatile("s_waitcnt vmcnt(0)" ::: "memory");
    for (int it = 0; it < 8; ++it) { int laneT = lane0; asm volatile("" : "+v"(laneT)); const int t = ch * 64 + tlw + it;
        peer_tail(a, l, t, laneT, Ybuf + (size_t)t * D, mb, mbn, last); }
}
#else
__device__ __forceinline__ void peer_tail(const Args& a, int l, int t, int lane, const float* Yrow, const float* mb, const float* mbn, bool last) {
    const float* x1buf = (const float*)(a.ws + WS_X1);
    float z[32];
#pragma unroll
    for (int c = 0; c < 2; ++c)
#pragma unroll
        for (int k = 0; k < 4; ++k) { const int c8 = 4 * c + k, col = (c8 * 64 + lane) * 4;
            const v2u yb = *(const v2u*)((const bf16*)Yrow + (c * 64 + lane) * 16 + 4 * k); const f32x4 yv = (f32x4){bflo(yb.x), bfhi(yb.x), bflo(yb.y), bfhi(yb.y)};
            const f32x4 x0 = *(const f32x4*)(x1buf + (size_t)t * D + col), g0 = *(const f32x4*)(mb + 5 * D + col);
            z[c8 * 4] = ALPHA * x0.x + (1.f + g0.x) * yv.x; z[c8 * 4 + 1] = ALPHA * x0.y + (1.f + g0.y) * yv.y; z[c8 * 4 + 2] = ALPHA * x0.z + (1.f + g0.z) * yv.z; z[c8 * 4 + 3] = ALPHA * x0.w + (1.f + g0.w) * yv.w; }
    ln_tail(z, t, lane, a.in[17] + (size_t)l * D, a.in[18] + (size_t)l * D, last ? a.out : (float*)(a.ws + WS_X), mbn, mbn + D, last ? (bf16*)nullptr : (bf16*)(a.ws + WS_H), nullptr, nullptr, nullptr, last ? (unsigned char*)nullptr : a.ws + WS_H8, (float*)(a.ws + WS_SAH));
}
template <class TT, int M> __device__ __forceinline__ void treduce16(TT (&v)[16], int lane) {
    const bool c0 = (lane & M) != 0, c1 = (lane & (2 * M)) != 0, c2 = (lane & (4 * M)) != 0;
#pragma unroll
    for (int m = 0; m < 8; ++m) { const TT keep = c0 ? v[2 * m + 1] : v[2 * m], send = c0 ? v[2 * m] : v[2 * m + 1]; v[m] = keep + __shfl_xor(send, M); }
#pragma unroll
    for (int m = 0; m < 4; ++m) { const TT keep = c1 ? v[2 * m + 1] : v[2 * m], send = c1 ? v[2 * m] : v[2 * m + 1]; v[m] = keep + __shfl_xor(send, 2 * M); }
#pragma unroll
    for (int m = 0; m < 2; ++m) { const TT keep = c2 ? v[2 * m + 1] : v[2 * m], send = c2 ? v[2 * m] : v[2 * m + 1]; v[m] = keep + __shfl_xor(send, 4 * M); }
}
__device__ __forceinline__ void peer_experts(const Args& a, int l, LAS unsigned char* lds, int lane0, int wave, int ch) {
    const float* mod = (const float*)(a.ws + WS_MOD);
    const unsigned char* ut = a.ws + WS_UT + (size_t)l * NE * D; const unsigned char* vt = a.ws + WS_VT + (size_t)l * NE * D; const unsigned char* hq8 = a.ws + WS_HQ8;
    const float* su = (const float*)(a.ws + WS_SU) + (size_t)l * NE; const float* sv = (const float*)(a.ws + WS_SV) + (size_t)l * NE; const float* hsc = (const float*)(a.ws + WS_HSC);
    float* Ybuf = (float*)(a.ws + WS_Z);
    const LAS int* eg_e = (const LAS int*)lds; LAS float* sw = (LAS float*)(lds + 32768);
    LAS int* apart = (LAS int*)(lds + 65536); LAS float* wtotl = (LAS float*)(lds + LDSCTL_OFF + 256);
    const int b = ch / NCH; const bool last = (l == NL - 1);
    const float* mb = mod + ((size_t)l * NB + b) * 6 * D; const float* mbn = mod + ((size_t)(last ? l : l + 1) * NB + b) * 6 * D;
    const int tlw = wave * 8;
    { const int lane = lane0;
#pragma unroll
      for (int i = 0; i < 16; ++i) apart[tlw * 128 + i * 64 + lane] = 0; }
    LDS_WAIT(); asm volatile("" ::: "memory");
    {
        int laneL = lane0; asm volatile("" : "+v"(laneL)); const int lane = laneL;
        const int g = lane >> 3, l7 = lane & 7;
        v4u bufA[16], bufB[16], hA, hB;
#define CU_LOAD(buf, hh_, idx_) do { const int cs_ = (idx_) >> 3, tl_ = tlw + ((idx_) & 7); const unsigned coff_ = (unsigned)(cs_ * 128 + l7 * 16); \
            hh_ = *(const v4u*)(hq8 + (size_t)(ch * 64 + tl_) * D + coff_); \
            _Pragma("unroll") for (int i_ = 0; i_ < 16; ++i_) { const unsigned e_ = (unsigned)eg_e[tl_ * 128 + 8 * i_ + g]; buf[i_] = *(const v4u*)(ut + (size_t)(e_ * 2048u + coff_)); } } while (0)
#define CU_COMP(buf, hh_, idx_) do { const int tl_ = tlw + ((idx_) & 7); int acc_[16]; \
            _Pragma("unroll") for (int i_ = 0; i_ < 16; ++i_) { int s_ = 0; _Pragma("unroll") for (int q_ = 0; q_ < 4; ++q_) s_ = sdot4i(buf[i_][q_], hh_[q_], s_); acc_[i_] = s_; } \
            treduce16<int, 1>(acc_, lane); \
            apart[tl_ * 128 + 8 * l7 + g] += acc_[0]; apart[tl_ * 128 + 8 * (8 + l7) + g] += acc_[1]; } while (0)
        CU_LOAD(bufA, hA, 0);
        for (int idx = 0; idx < 128; idx += 2) {
            CU_LOAD(bufB, hB, idx + 1);
            CU_COMP(bufA, hA, idx);
            if (idx + 2 < 128) CU_LOAD(bufA, hA, idx + 2);
            CU_COMP(bufB, hB, idx + 1);
        }
#undef CU_LOAD
#undef CU_COMP
        LDS_WAIT(); asm volatile("" ::: "memory");
        for (int it = 0; it < 8; ++it) { const int tl = tlw + it; const float shs = hsc[ch * 64 + tl];
            const int e0 = eg_e[tl * 128 + lane], e1 = eg_e[tl * 128 + 64 + lane];
            const float w0 = sw[tl * 128 + lane] * gelu_tanh_f((float)apart[tl * 128 + lane] * su[e0] * shs) * sv[e0];
            const float w1 = sw[tl * 128 + 64 + lane] * gelu_tanh_f((float)apart[tl * 128 + 64 + lane] * su[e1] * shs) * sv[e1];
            sw[tl * 128 + lane] = w0; sw[tl * 128 + 64 + lane] = w1;
            const float ws = wave_sum(w0 + w1);
            if (lane == 0) wtotl[tl] = ws; }
        LDS_WAIT(); asm volatile("" ::: "memory");
    }
    {
        int laneL = lane0; asm volatile("" : "+v"(laneL)); const int lane = laneL;
        const int g = lane >> 3, l7 = lane & 7;
        v4u bufA[16], bufB[16];
#define CV_LOAD(buf, idx_) do { const int cs_ = (idx_) >> 3, tl_ = tlw + ((idx_) & 7); const unsigned coff_ = (unsigned)(cs_ * 128 + l7 * 16); \
            _Pragma("unroll") for (int i_ = 0; i_ < 16; ++i_) { const unsigned e_ = (unsigned)eg_e[tl_ * 128 + 8 * i_ + g]; buf[i_] = *(const v4u*)(vt + (size_t)(e_ * 2048u + coff_)); } } while (0)
#define CV_COMP(buf, idx_) do { const int cs_ = (idx_) >> 3, tl_ = tlw + ((idx_) & 7); float y_[16]; \
            _Pragma("unroll") for (int q_ = 0; q_ < 16; ++q_) y_[q_] = 0.f; \
            _Pragma("unroll") for (int i_ = 0; i_ < 16; ++i_) { const float wr_ = sw[tl_ * 128 + 8 * i_ + g]; \
                _Pragma("unroll") for (int q_ = 0; q_ < 4; ++q_) fma_ub4(buf[i_][q_], wr_, y_[4 * q_], y_[4 * q_ + 1], y_[4 * q_ + 2], y_[4 * q_ + 3]); } \
            treduce16<float, 8>(y_, lane); \
            const float woff_ = 128.0f * wtotl[tl_]; bf16* yr_ = (bf16*)Ybuf + (size_t)(ch * 64 + tl_) * D + cs_ * 128 + l7 * 16 + g; \
            yr_[0] = (bf16)(pk2(y_[0] - woff_, 0.f) & 0xffffu); yr_[8] = (bf16)(pk2(y_[1] - woff_, 0.f) & 0xffffu); } while (0)
        CV_LOAD(bufA, 0);
        for (int idx = 0; idx < 128; idx += 2) {
            CV_LOAD(bufB, idx + 1);
            CV_COMP(bufA, idx);
            if (idx + 2 < 128) CV_LOAD(bufA, idx + 2);
            CV_COMP(bufB, idx + 1);
        }
#undef CV_LOAD
#undef CV_COMP
    }
    asm volatile("s_waitcnt vmcnt(0)" ::: "memory");
    __builtin_amdgcn_fence(__ATOMIC_ACQUIRE, "agent");
    asm volatile("s_waitcnt vmcnt(0)" ::: "memory");
    for (int it = 0; it < 8; ++it) { int laneT = lane0; asm volatile("" : "+v"(laneT)); const int t = ch * 64 + tlw + it;
        peer_tail(a, l, t, laneT, (const float*)((const bf16*)Ybuf + (size_t)t * D), mb, mbn, last); }
}

#endif

#ifndef MK_PER_PHASE
#define MK_PER_PHASE 0
#endif
__global__ void __launch_bounds__(NTHREADS, 2) mk_fwd(Args a) {
    extern __shared__ __attribute__((aligned(16))) unsigned char lds_raw[];
    LAS unsigned char* lds = (LAS unsigned char*)lds_raw;
    const int tid = threadIdx.x, lane = tid & 63, wave = __builtin_amdgcn_readfirstlane(tid >> 6), G = gridDim.x, bx = blockIdx.x;
    if (tid < 64) ((LAS unsigned*)(lds + LDSCTL_OFF))[tid] = 0u;
    __syncthreads();
    unsigned* ctl = (unsigned*)(a.ws + WS_CTL);
    XcdBarrier bar; bar.bar = ctl + CW_BAR; bar.x = 0; bar.st = nullptr;
    const bool use_bar = (a.ph_hi - a.ph_lo) > 1;
    if (use_bar) bar = xcd_barrier_post(ctl + CW_BAR, (volatile LAS unsigned*)(lds + LDSCTL_OFF));
    const int lo = a.ph_lo, hi = a.ph_hi;
#ifndef PH_MASK
#define PH_MASK 0x1ff
#endif
#define IN(k) (lo <= (k) && (k) < hi)
#define EN(b) ((PH_MASK >> (b)) & 1)
#ifndef REP_MASK
#define REP_MASK 0
#endif
#ifndef REP_EXTRA
#define REP_EXTRA 2
#endif
#define REPS(b) (1 + ((REP_MASK >> (b)) & 1) * REP_EXTRA)
#define REP_BEGIN(b) for (int rep_ = 0; rep_ < REPS(b); ++rep_) {
#define REP_END(b) if (rep_ + 1 < REPS(b)) xcd_barrier(bar); }
#define SEAM(k) do { if (IN((k) + 1)) xcd_barrier(bar); } while (0)
#define PHASE_IDS() int tidp = tid; asm volatile("" : "+v"(tidp)); const int lanep = tidp & 63, wavep = __builtin_amdgcn_readfirstlane(tidp >> 6); (void)lanep; (void)wavep
    if (EN(0) && IN(0)) { REP_BEGIN(0) PHASE_IDS(); ph_prologue_a(a, lds, tidp, lanep, wavep, bx, G); REP_END(0) SEAM(0); }
    if (EN(1) && IN(1)) { REP_BEGIN(1) PHASE_IDS(); ph_prologue_b(a, lds, tidp, lanep, wavep, bx, G); REP_END(1) SEAM(1); }
    for (int l = 0; l < NL; ++l) {
        const int pb = 2 + 7 * l;
        const float* mod = (const float*)(a.ws + WS_MOD);
        if (EN(2) && IN(pb + 0)) {
            REP_BEGIN(2) PHASE_IDS();
            pg8::Gemm g{(const pg8::bf16_t*)(a.ws + WS_H8), (const pg8::bf16_t*)(a.ws + WS_WIN8 + (size_t)l * NP * D), T, NP, D / 2}; pg8::StaticOrder S; S.init(T, NP, G, bx, WGM_IN);
            pg8::EpiBf16PS E{(pg8::bf16_t*)(a.ws + WS_PROJ), NP, (const float*)(a.ws + WS_SAH), (const float*)(a.ws + WS_SB) + l * SBL};
            pg8::gemm_phase<pg8::EpiBf16PS, pg8::StaticOrder, true, true, true>(lds + RING_OFF, g, S, E, tidp);
            for (int ch = bx; ch < NCHUNK; ch += G) gate_prep(a, l, lds, tidp, lanep, wavep, ch);
            REP_END(2) SEAM(pb + 0);
        }
        if (EN(3) && IN(pb + 1)) { REP_BEGIN(3) PHASE_IDS(); for (int un = bx; un < 256; un += G) gla_unit(a, lds, tidp, lanep, wavep, un); REP_END(3) SEAM(pb + 1); }
        if (EN(4) && IN(pb + 2)) { REP_BEGIN(4) PHASE_IDS(); for (int ch = bx; ch < NCHUNK; ch += G) mixpost_chunk(a, l, lanep, wavep, ch); REP_END(4) SEAM(pb + 2); }
        if (EN(5) && IN(pb + 3)) {
            REP_BEGIN(5) PHASE_IDS();
            pg8::Gemm g{(const pg8::bf16_t*)(a.ws + WS_Y8), (const pg8::bf16_t*)(a.ws + WS_WOUT8 + (size_t)l * D * D), T, D, D / 2}; pg8::StaticOrder S; S.init(T, D, G, bx, WGM_OUT);
            pg8::EpiResidS E{(float*)(a.ws + WS_Z), l == 0 ? a.in[0] : (const float*)(a.ws + WS_X), mod + (size_t)l * NB * 6 * D + 2 * D, (const float*)(a.ws + WS_SAY), (const float*)(a.ws + WS_SB) + l * SBL + NP, ALPHA};
            pg8::gemm_phase<pg8::EpiResidS, pg8::StaticOrder, true, true, true>(lds + RING_OFF, g, S, E, tidp);
            REP_END(5) SEAM(pb + 3);
        }
        if (EN(6) && IN(pb + 4)) { REP_BEGIN(6) PHASE_IDS(); for (int ch = bx; ch < NCHUNK; ch += G) ln1_chunk(a, l, lds, lanep, wavep, ch); REP_END(6) SEAM(pb + 4); }
        if (EN(7) && IN(pb + 5)) {
            REP_BEGIN(7) PHASE_IDS();
            pg8::Gemm g{(const pg8::bf16_t*)(a.ws + WS_H28), (const pg8::bf16_t*)(a.ws + WS_WQ8 + (size_t)l * D * D), T, D, D / 2}; pg8::StaticOrder S; S.init(T, D, G, bx, WGM_WQ);
            pg8::EpiBf16PS E{(pg8::bf16_t*)(a.ws + WS_Q), D, (const float*)(a.ws + WS_HSC), (const float*)(a.ws + WS_SB) + l * SBL + NP + D};
            pg8::gemm_phase<pg8::EpiBf16PS, pg8::StaticOrder, true, true, true>(lds + RING_OFF, g, S, E, tidp);
            REP_END(7) SEAM(pb + 5);
        }
#ifndef PEER_DBG
#define PEER_DBG 0
#endif
#ifndef PE_REP_R
#define PE_REP_R 1
#endif
#ifndef L2PROBE
#define L2PROBE 0
#endif
        if (EN(8) && IN(pb + 6)) {
            REP_BEGIN(8)
            for (int ch = bx; ch < NCHUNK; ch += G) { for (int repr_ = 0; repr_ < PE_REP_R; ++repr_) { PHASE_IDS(); peer_retrieve(a, l, lds, lanep, wavep, ch); __syncthreads(); } __syncthreads(); { PHASE_IDS(); peer_experts(a, l, lds, lanep, wavep, ch); } __syncthreads(); }
            REP_END(8) SEAM(pb + 6);
        }
    }
#undef IN
#undef SEAM
}

extern "C" void kernel_launch(void* const* d_in, const int* in_sizes, int n_in, void* d_out, int out_size, void* d_ws, size_t ws_size, hipStream_t stream) {
    static int grid = 0;
    if (grid == 0) {
        if (n_in != 19 || in_sizes[0] != T * D || out_size != T * D || ws_size < WS_END) { fprintf(stderr, "kernel_launch: unexpected shapes / workspace (%d inputs, ws %zu); nothing launched\n", n_in, ws_size); grid = -1; return; }
        int dev = 0, cus = 0, per_cu = 0;
        if (hipGetDevice(&dev) != hipSuccess || hipDeviceGetAttribute(&cus, hipDeviceAttributeMultiprocessorCount, dev) != hipSuccess) { grid = -1; return; }
        if (hipFuncSetAttribute((const void*)mk_fwd, hipFuncAttributeMaxDynamicSharedMemorySize, LDS_BYTES) != hipSuccess) { fprintf(stderr, "kernel_launch: hipFuncSetAttribute failed\n"); grid = -1; return; }
        if (hipOccupancyMaxActiveBlocksPerMultiprocessor(&per_cu, (const void*)mk_fwd, NTHREADS, LDS_BYTES) != hipSuccess || per_cu < 1) fprintf(stderr, "kernel_launch: occupancy query reports %d\n", per_cu);
        (void)hipGetLastError();
        grid = cus;
    }
    if (grid < 0) return;
    if (hipMemsetAsync((char*)d_ws + WS_CTL, 0, CTL_ZERO_BYTES, stream) != hipSuccess) return;
    Args a{};
    for (int i = 0; i < 19; ++i) a.in[i] = (const float*)d_in[i];
    a.out = (float*)d_out; a.ws = (unsigned char*)d_ws;
#if MK_PER_PHASE
    for (int p = 0; p < NPHASES; ++p) { a.ph_lo = p; a.ph_hi = p + 1; hipLaunchKernelGGL(mk_fwd, dim3(grid), dim3(NTHREADS), LDS_BYTES, stream, a); }
#else
    a.ph_lo = 0; a.ph_hi = NPHASES;
    hipLaunchKernelGGL(mk_fwd, dim3(grid), dim3(NTHREADS), LDS_BYTES, stream, a);
#endif
}
```

```cpp
#include <hip/hip_runtime.h>
#include <cstdio>
#include <cstdint>
namespace pg8 {
#define PG8_LAS __attribute__((address_space(3)))
typedef unsigned short bf16_t;
typedef short bf16x8 __attribute__((ext_vector_type(8)));
typedef float f32x4 __attribute__((ext_vector_type(4)));
typedef unsigned u32x4 __attribute__((ext_vector_type(4)));
typedef int i32x4 __attribute__((ext_vector_type(4)));
constexpr int BM = 256, BK = 64, HALF = 128, HTB = HALF * BK * 2  , STAGE_BYTES = 8 * HTB, NXCD = 8, WGM = 8;

__host__ __device__ __forceinline__ int lds_byte(int r, int c) { const int st = (r >> 4) * 2 + (c >> 5), rr = r & 15, cc = c & 31, ob = rr * 64 + cc * 2; return st * 1024 + (ob ^ (((ob >> 9) & 1) << 5)); }
__host__ __device__ __forceinline__ void stage_rc(int b, int& R, int& C) { const int st = b / 1024, sb = b % 1024, swz = sb ^ (((sb >> 9) & 1) << 5); R = (st >> 1) * 16 + swz / 64; C = (st & 1) * 32 + (swz % 64) / 2; }
__host__ __device__ __forceinline__ int perm32(int rho) { const int n = rho >> 4, i = rho & 15; return 8 * (i >> 2) + 4 * n + (i & 3); }

struct Unit { int pm, pn; };
struct Gemm { const bf16_t* A; const bf16_t* Bt; int M, N, K; };

struct StaticOrder {
    int nM, nN, nwg, G, c, wgm, krot;
    __host__ __device__ void init(int M, int N, int G_, int c_, int wgm_ = WGM, int krot_ = 0) { nM = M / BM; nN = N / BM; nwg = nM * nN; G = G_; c = c_; wgm = wgm_; krot = krot_; }
    __host__ __device__ bool next(int i, Unit& u) const {
        const long L = (long)i * G + c; if (L >= nwg) return false;
        int wgid = (int)L; { const int q = nwg / NXCD, r = nwg % NXCD, xcd = wgid % NXCD, off = wgid / NXCD; wgid = (xcd < r ? xcd * (q + 1) : r * (q + 1) + (xcd - r) * q) + off; }
        const int nig = wgm * nN, gid = wgid / nig, fm = gid * wgm, gsz = (nM - fm) < wgm ? (nM - fm) : wgm;
        u.pm = fm + ((wgid % nig) % gsz); u.pn = (wgid % nig) / gsz; return true;
    }
    __device__ __forceinline__ void a_ready(const Unit&) const {}
    __device__ __forceinline__ void done(const Unit&) const {}
};
typedef __bf16 bf16x2_t __attribute__((ext_vector_type(2)));
__device__ __forceinline__ unsigned cvt_pk_bf16(float lo, float hi) { bf16x2_t r; r.x = (__bf16)lo; r.y = (__bf16)hi; return __builtin_bit_cast(unsigned, r); }
struct EpiBf16P {
    static constexpr bool PERM = true, AFTER_DRAIN = false;
    bf16_t* O; int ldc;
    __device__ __forceinline__ void operator()(const f32x4 (&acc)[2][2][4][2], const Unit& u, int wr, int wc, int fr, int fq) const {
        const int row0 = u.pm * BM + wr * 64 + fr, col0 = u.pn * BM + wc * 32 + 8 * fq;
#pragma unroll
        for (int ai = 0; ai < 2; ++ai)
#pragma unroll
            for (int m = 0; m < 4; ++m) { bf16_t* rowp = O + (size_t)(row0 + ai * HALF + m * 16) * ldc + col0;
#pragma unroll
                for (int bj = 0; bj < 2; ++bj) { const f32x4 v0 = acc[ai][bj][m][0], v1 = acc[ai][bj][m][1];
                    u32x4 w; w.x = cvt_pk_bf16(v0[0], v0[1]); w.y = cvt_pk_bf16(v0[2], v0[3]); w.z = cvt_pk_bf16(v1[0], v1[1]); w.w = cvt_pk_bf16(v1[2], v1[3]);
                    *(u32x4*)(rowp + bj * HALF) = w; } }
    }
};
struct EpiResid {
    static constexpr bool PERM = false, AFTER_DRAIN = false;
    float* Z; const float* X; const float* gate; float alpha;
    __device__ __forceinline__ void operator()(const f32x4 (&acc)[2][2][4][2], const Unit& u, int wr, int wc, int fr, int fq) const {
        const int row0 = u.pm * BM + wr * 64 + fr, col0 = u.pn * BM + wc * 32 + 4 * fq;
        const float* gb = gate + (size_t)(u.pm >> 3) * (6 * 2048) + col0;
        f32x4 gv[2][2];
#pragma unroll
        for (int bj = 0; bj < 2; ++bj)
#pragma unroll
            for (int n = 0; n < 2; ++n) gv[bj][n] = *(const f32x4*)(gb + bj * HALF + n * 16) + 1.0f;
#pragma unroll
        for (int ai = 0; ai < 2; ++ai)
#pragma unroll
            for (int m = 0; m < 4; ++m) { const size_t off = (size_t)(row0 + ai * HALF + m * 16) * 2048 + col0;
#pragma unroll
                for (int bj = 0; bj < 2; ++bj)
#pragma unroll
                    for (int n = 0; n < 2; ++n) { const f32x4 xv = *(const f32x4*)(X + off + bj * HALF + n * 16);
                        *(f32x4*)(Z + off + bj * HALF + n * 16) = xv * alpha + gv[bj][n] * acc[ai][bj][m][n]; }
                asm volatile("" ::: "memory"); }
    }
};
#ifndef PG8_NT
#define PG8_NT 0
#endif
#if PG8_NT
#define PG8_ST(TY, p, v) __builtin_nontemporal_store((v), (TY*)(p))
#else
#define PG8_ST(TY, p, v) (*(TY*)(p) = (v))
#endif
__device__ __forceinline__ f32x4 acc_i2f(const f32x4 v) { const i32x4 iv = __builtin_bit_cast(i32x4, v); return __builtin_convertvector(iv, f32x4); }
struct EpiBf16PS {
    static constexpr bool PERM = true, AFTER_DRAIN = false;
    bf16_t* O; int ldc; const float* sa; const float* sb;
    __device__ __forceinline__ void operator()(const f32x4 (&acc)[2][2][4][2], const Unit& u, int wr, int wc, int fr, int fq) const {
        const int row0 = u.pm * BM + wr * 64 + fr, col0 = u.pn * BM + wc * 32 + 8 * fq;
        f32x4 sbv[2][2];
#pragma unroll
        for (int bj = 0; bj < 2; ++bj)
#pragma unroll
            for (int n = 0; n < 2; ++n) sbv[bj][n] = *(const f32x4*)(sb + col0 + bj * HALF + 4 * n);
#pragma unroll
        for (int ai = 0; ai < 2; ++ai)
#pragma unroll
            for (int m = 0; m < 4; ++m) { const int row = row0 + ai * HALF + m * 16; bf16_t* rowp = O + (size_t)row * ldc + col0; const float sar = sa[row];
#pragma unroll
                for (int bj = 0; bj < 2; ++bj) { const f32x4 v0 = acc_i2f(acc[ai][bj][m][0]) * (sbv[bj][0] * sar), v1 = acc_i2f(acc[ai][bj][m][1]) * (sbv[bj][1] * sar);
                    u32x4 w; w.x = cvt_pk_bf16(v0[0], v0[1]); w.y = cvt_pk_bf16(v0[2], v0[3]); w.z = cvt_pk_bf16(v1[0], v1[1]); w.w = cvt_pk_bf16(v1[2], v1[3]);
                    PG8_ST(u32x4, rowp + bj * HALF, w); } }
    }
};
struct EpiResidS {
    static constexpr bool PERM = false, AFTER_DRAIN = false;
    float* Z; const float* X; const float* gate; const float* sa; const float* sb; float alpha;
    __device__ __forceinline__ void operator()(const f32x4 (&acc)[2][2][4][2], const Unit& u, int wr, int wc, int fr, int fq) const {
        const int row0 = u.pm * BM + wr * 64 + fr, col0 = u.pn * BM + wc * 32 + 4 * fq;
        const float* gb = gate + (size_t)(u.pm >> 3) * (6 * 2048) + col0;
        f32x4 gv[2][2];
#pragma unroll
        for (int bj = 0; bj < 2; ++bj)
#pragma unroll
            for (int n = 0; n < 2; ++n) gv[bj][n] = (*(const f32x4*)(gb + bj * HALF + n * 16) + 1.0f) * *(const f32x4*)(sb + col0 + bj * HALF + n * 16);
#pragma unroll
        for (int ai = 0; ai < 2; ++ai)
#pragma unroll
            for (int m = 0; m < 4; ++m) { const int row = row0 + ai * HALF + m * 16; const size_t off = (size_t)row * 2048 + col0; const float sar = sa[row];
#pragma unroll
                for (int bj = 0; bj < 2; ++bj)
#pragma unroll
                    for (int n = 0; n < 2; ++n) { const f32x4 xv = *(const f32x4*)(X + off + bj * HALF + n * 16);
                        PG8_ST(f32x4, Z + off + bj * HALF + n * 16, xv * alpha + (gv[bj][n] * sar) * acc_i2f(acc[ai][bj][m][n])); }
                asm volatile("" ::: "memory"); }
    }
};
template <bool XB, bool ZB> struct EpiResidS16 {
    static constexpr bool PERM = true, AFTER_DRAIN = false;
    void* Z; const void* X; const float* gate; const float* sa; const float* sb; float alpha;
    __device__ __forceinline__ void operator()(const f32x4 (&acc)[2][2][4][2], const Unit& u, int wr, int wc, int fr, int fq) const {
        const int row0 = u.pm * BM + wr * 64 + fr, col0 = u.pn * BM + wc * 32 + 8 * fq;
        const float* gb = gate + (size_t)(u.pm >> 3) * (6 * 2048) + col0;
        f32x4 gv[2][2];
#pragma unroll
        for (int bj = 0; bj < 2; ++bj)
#pragma unroll
            for (int n = 0; n < 2; ++n) gv[bj][n] = (*(const f32x4*)(gb + bj * HALF + 4 * n) + 1.0f) * *(const f32x4*)(sb + col0 + bj * HALF + 4 * n);
#pragma unroll
        for (int ai = 0; ai < 2; ++ai)
#pragma unroll
            for (int m = 0; m < 4; ++m) { const int row = row0 + ai * HALF + m * 16; const size_t off = (size_t)row * 2048 + col0; const float sar = sa[row];
#pragma unroll
                for (int bj = 0; bj < 2; ++bj) { f32x4 x0, x1;
                    if constexpr (XB) { const u32x4 xw = *(const u32x4*)((const bf16_t*)X + off + bj * HALF);
                        x0 = (f32x4){__uint_as_float(xw.x << 16), __uint_as_float(xw.x & 0xffff0000u), __uint_as_float(xw.y << 16), __uint_as_float(xw.y & 0xffff0000u)};
                        x1 = (f32x4){__uint_as_float(xw.z << 16), __uint_as_float(xw.z & 0xffff0000u), __uint_as_float(xw.w << 16), __uint_as_float(xw.w & 0xffff0000u)}; }
                    else { x0 = *(const f32x4*)((const float*)X + off + bj * HALF); x1 = *(const f32x4*)((const float*)X + off + bj * HALF + 4); }
                    const f32x4 v0 = x0 * alpha + (gv[bj][0] * sar) * acc_i2f(acc[ai][bj][m][0]), v1 = x1 * alpha + (gv[bj][1] * sar) * acc_i2f(acc[ai][bj][m][1]);
                    if constexpr (ZB) { u32x4 w; w.x = cvt_pk_bf16(v0[0], v0[1]); w.y = cvt_pk_bf16(v0[2], v0[3]); w.z = cvt_pk_bf16(v1[0], v1[1]); w.w = cvt_pk_bf16(v1[2], v1[3]);
                        PG8_ST(u32x4, (bf16_t*)Z + off + bj * HALF, w); }
                    else { PG8_ST(f32x4, (float*)Z + off + bj * HALF, v0); PG8_ST(f32x4, (float*)Z + off + bj * HALF + 4, v1); } }
                asm volatile("" ::: "memory"); }
    }
};
template <class Epi, class Sched, bool ALIGN_EPI = false, bool SP2 = false, bool I8 = false>
__device__ __forceinline__ void gemm_phase(PG8_LAS unsigned char* lds, const Gemm g, const Sched& S, const Epi& E, const int tid_in) {
    const int tid = tid_in, wid = __builtin_amdgcn_readfirstlane(tid >> 6), lane = tid & 63, wr = wid >> 2, wc = wid & 3, fr = lane & 15, fq = lane >> 4;
    const int K = g.K, nt = K / BK;
    const int krot = ((nt & (nt - 1)) == 0) ? (S.krot & (nt - 1)) : 0;
#define PG8_KOFS(t) ((size_t)(((t) + krot) & (nt - 1)) * kstep)
    unsigned voffA[2], voffB[2];
#pragma unroll
    for (int i = 0; i < 2; ++i) { int R, C; stage_rc(tid * 16 + i * 8192, R, C); const int Rb = Epi::PERM ? ((R & ~31) + perm32(R & 31)) : R;
        voffA[i] = (unsigned)(R * K + C) * 2u; voffB[i] = (unsigned)(Rb * K + C) * 2u; }
    const size_t kstep = (size_t)(BK * 2);
    const size_t hstep = (size_t)HALF * K * 2;
    const size_t tstep = 2 * hstep;
    const unsigned ldsw = (unsigned)wid * 1024u;
    const int aoff = lds_byte(wr * 64 + fr, fq * 8), boff = lds_byte(wc * 32 + fr, fq * 8);
#define PG8_SA(b, h) (((b) * 2 + (h)) * HTB)
#define PG8_SB(b, h) ((4 + (b) * 2 + (h)) * HTB)
#define PG8_STAGE(bufoff, gbase, voff) do { _Pragma("unroll") for (int _i = 0; _i < 2; ++_i) \
        __builtin_amdgcn_global_load_lds((const unsigned*)((const char*)(gbase) + (voff)[_i]), (PG8_LAS unsigned*)(lds + (bufoff) + ldsw + _i * 8192), 16, 0, 0); } while (0)
#define PG8_LDA(dst, b, h) do { _Pragma("unroll") for (int m = 0; m < 4; ++m) _Pragma("unroll") for (int k = 0; k < 2; ++k) dst[m][k] = *(const PG8_LAS bf16x8*)(lds + PG8_SA(b, h) + aoff + m * 2048 + k * 1024); } while (0)
#define PG8_LDB(dst, b, h) do { _Pragma("unroll") for (int n = 0; n < 2; ++n) _Pragma("unroll") for (int k = 0; k < 2; ++k) dst[n][k] = *(const PG8_LAS bf16x8*)(lds + PG8_SB(b, h) + boff + n * 2048 + k * 1024); } while (0)
#define PG8_MMA(ai, bj, At, Bt) do { __builtin_amdgcn_s_setprio(1); _Pragma("unroll") for (int m = 0; m < 4; ++m) _Pragma("unroll") for (int n = 0; n < 2; ++n) _Pragma("unroll") for (int k = 0; k < 2; ++k) \
        { if constexpr (I8) acc[ai][bj][m][n] = __builtin_bit_cast(f32x4, __builtin_amdgcn_mfma_i32_16x16x64_i8(__builtin_bit_cast(i32x4, Bt[n][k]), __builtin_bit_cast(i32x4, At[m][k]), __builtin_bit_cast(i32x4, acc[ai][bj][m][n]), 0, 0, 0)); \
          else acc[ai][bj][m][n] = __builtin_amdgcn_mfma_f32_16x16x32_bf16(Bt[n][k], At[m][k], acc[ai][bj][m][n], 0, 0, 0); } __builtin_amdgcn_s_setprio(0); } while (0)
#define PG8_WAIT_V(n) asm volatile("s_waitcnt vmcnt(" #n ")" ::: "memory")
#define PG8_WAIT_L(n) asm volatile("s_waitcnt lgkmcnt(" #n ")" ::: "memory")
#define PG8_BAR __builtin_amdgcn_s_barrier()
#define PG8_SCHED __builtin_amdgcn_sched_barrier(0)
    Unit cur, nxt; int ui = 0;
    if (!S.next(0, cur)) return;
    f32x4 acc[2][2][4][2];
#pragma unroll
    for (int a = 0; a < 2; ++a)
#pragma unroll
        for (int b = 0; b < 2; ++b)
#pragma unroll
            for (int m = 0; m < 4; ++m)
#pragma unroll
                for (int n = 0; n < 2; ++n) acc[a][b][m][n] = (f32x4){0.f, 0.f, 0.f, 0.f};
    bf16x8 At[4][2], B0[2][2], B1[2][2];
    const char* cA = (const char*)g.A + (size_t)cur.pm * tstep; const char* cB = (const char*)g.Bt + (size_t)cur.pn * tstep;
    S.a_ready(cur);
    if constexpr (SP2) {
        PG8_STAGE(PG8_SB(0, 0), cB + PG8_KOFS(0), voffB); PG8_STAGE(PG8_SB(0, 1), cB + hstep + PG8_KOFS(0), voffB); PG8_STAGE(PG8_SA(0, 0), cA + PG8_KOFS(0), voffA); PG8_STAGE(PG8_SA(0, 1), cA + hstep + PG8_KOFS(0), voffA);
        if (wr == 1) PG8_BAR;
        PG8_WAIT_V(2); PG8_BAR;
        PG8_STAGE(PG8_SB(1, 0), cB + PG8_KOFS(1), voffB); PG8_STAGE(PG8_SA(1, 0), cA + PG8_KOFS(1), voffA); PG8_STAGE(PG8_SB(1, 1), cB + hstep + PG8_KOFS(1), voffB);
        PG8_WAIT_V(6); PG8_BAR;
    } else {
        PG8_STAGE(PG8_SB(0, 0), cB + PG8_KOFS(0), voffB); PG8_STAGE(PG8_SA(0, 0), cA + PG8_KOFS(0), voffA); PG8_STAGE(PG8_SB(0, 1), cB + hstep + PG8_KOFS(0), voffB); PG8_STAGE(PG8_SA(0, 1), cA + hstep + PG8_KOFS(0), voffA);
        if (wr == 1) PG8_BAR;
        PG8_WAIT_V(4); PG8_BAR;
        PG8_STAGE(PG8_SB(1, 0), cB + PG8_KOFS(1), voffB); PG8_STAGE(PG8_SA(1, 0), cA + PG8_KOFS(1), voffA); PG8_STAGE(PG8_SB(1, 1), cB + hstep + PG8_KOFS(1), voffB);
        PG8_WAIT_V(6); PG8_BAR;
    }
    for (;;) {
        const bool has_next = S.next(ui + 1, nxt);
        const char* nA = has_next ? (const char*)g.A + (size_t)nxt.pm * tstep : cA; const char* nB = has_next ? (const char*)g.Bt + (size_t)nxt.pn * tstep : cB;
#ifdef PG8_KREP
        for (int kr_ = 0; kr_ < PG8_KREP; ++kr_) {
        if (kr_) {
#pragma unroll
        for (int a = 0; a < 2; ++a)
#pragma unroll
            for (int b = 0; b < 2; ++b)
#pragma unroll
                for (int m = 0; m < 4; ++m)
#pragma unroll
                    for (int n = 0; n < 2; ++n) acc[a][b][m][n] = (f32x4){0.f, 0.f, 0.f, 0.f}; }
        const char* nA_ = (kr_ + 1 < PG8_KREP) ? cA : nA; const char* nB_ = (kr_ + 1 < PG8_KREP) ? cB : nB;
#else
        const char* nA_ = nA; const char* nB_ = nB;
#endif
        for (int t = 0; t < nt; t += 2) {
            const bool last = (t == nt - 2);
            const char* a1 = cA + PG8_KOFS(t + 1);
            const char* a2 = (last ? nA_ : cA) + PG8_KOFS(t + 2); const char* b2 = (last ? nB_ : cB) + PG8_KOFS(t + 2);
            const char* a3 = (last ? nA_ : cA) + PG8_KOFS(t + 3); const char* b3 = (last ? nB_ : cB) + PG8_KOFS(t + 3);
            if (last && has_next) S.a_ready(nxt);
            if constexpr (SP2) {
            PG8_LDB(B0, 0, 0); PG8_LDB(B1, 0, 1); PG8_SCHED; PG8_LDA(At, 0, 0); PG8_STAGE(PG8_SA(1, 1), a1 + hstep, voffA);
            PG8_WAIT_V(8); PG8_WAIT_L(0); PG8_BAR; PG8_MMA(0, 0, At, B0); PG8_MMA(0, 1, At, B1); PG8_BAR; PG8_SCHED;
            PG8_LDA(At, 0, 1); PG8_STAGE(PG8_SB(0, 0), b2, voffB); PG8_STAGE(PG8_SB(0, 1), b2 + hstep, voffB); PG8_STAGE(PG8_SA(0, 0), a2, voffA);
            PG8_WAIT_V(8); PG8_WAIT_L(0); PG8_BAR; PG8_MMA(1, 0, At, B0); PG8_MMA(1, 1, At, B1); PG8_BAR; PG8_SCHED;
            PG8_LDB(B0, 1, 0); PG8_LDB(B1, 1, 1); PG8_SCHED; PG8_LDA(At, 1, 0); PG8_STAGE(PG8_SA(0, 1), a2 + hstep, voffA);
            PG8_WAIT_V(8); PG8_WAIT_L(0); PG8_BAR; PG8_MMA(0, 0, At, B0); PG8_MMA(0, 1, At, B1); PG8_BAR; PG8_SCHED;
            PG8_LDA(At, 1, 1); PG8_STAGE(PG8_SB(1, 0), b3, voffB); PG8_STAGE(PG8_SB(1, 1), b3 + hstep, voffB); PG8_STAGE(PG8_SA(1, 0), a3, voffA);
            PG8_WAIT_V(8); PG8_WAIT_L(0); PG8_BAR; PG8_MMA(1, 0, At, B0); PG8_MMA(1, 1, At, B1); PG8_BAR; PG8_SCHED;
            } else {
            PG8_LDB(B0, 0, 0); PG8_SCHED; PG8_LDA(At, 0, 0); PG8_STAGE(PG8_SA(1, 1), a1 + hstep, voffA);
            PG8_WAIT_L(8); PG8_BAR; PG8_WAIT_L(0); PG8_MMA(0, 0, At, B0); PG8_BAR; PG8_SCHED;
            PG8_LDB(B1, 0, 1); PG8_STAGE(PG8_SB(0, 0), b2, voffB);
            PG8_BAR; PG8_WAIT_L(0); PG8_MMA(0, 1, At, B1); PG8_BAR;
            PG8_LDA(At, 0, 1); PG8_STAGE(PG8_SA(0, 0), a2, voffA);
            PG8_BAR; PG8_WAIT_L(0); PG8_MMA(1, 0, At, B0); PG8_BAR; PG8_SCHED;
            PG8_STAGE(PG8_SB(0, 1), b2 + hstep, voffB);
            PG8_WAIT_V(6); PG8_BAR; PG8_MMA(1, 1, At, B1); PG8_BAR;
            PG8_LDB(B0, 1, 0); PG8_SCHED; PG8_LDA(At, 1, 0); PG8_STAGE(PG8_SA(0, 1), a2 + hstep, voffA);
            PG8_WAIT_L(8); PG8_BAR; PG8_WAIT_L(0); PG8_MMA(0, 0, At, B0); PG8_BAR; PG8_SCHED;
            PG8_LDB(B1, 1, 1); PG8_STAGE(PG8_SB(1, 0), b3, voffB);
            PG8_BAR; PG8_WAIT_L(0); PG8_MMA(0, 1, At, B1); PG8_BAR;
            PG8_LDA(At, 1, 1); PG8_STAGE(PG8_SA(1, 0), a3, voffA);
            PG8_BAR; PG8_WAIT_L(0); PG8_MMA(1, 0, At, B0); PG8_BAR; PG8_SCHED;
            PG8_STAGE(PG8_SB(1, 1), b3 + hstep, voffB);
            PG8_WAIT_V(6); PG8_BAR; PG8_MMA(1, 1, At, B1); PG8_BAR;
            }
        }
#ifdef PG8_KREP
        }
#endif
        if constexpr (ALIGN_EPI) { if (wr == 0) PG8_BAR; }
#ifdef PG8_EPI2
        if constexpr (!Epi::AFTER_DRAIN) { E(acc, cur, wr, wc, fr, fq); asm volatile("" ::: "memory"); }
#endif
        if constexpr (!Epi::AFTER_DRAIN) { E(acc, cur, wr, wc, fr, fq); S.done(cur); }
        if (!has_next) break;
#pragma unroll
        for (int a = 0; a < 2; ++a)
#pragma unroll
            for (int b = 0; b < 2; ++b)
#pragma unroll
                for (int m = 0; m < 4; ++m)
#pragma unroll
                    for (int n = 0; n < 2; ++n) acc[a][b][m][n] = (f32x4){0.f, 0.f, 0.f, 0.f};
        cur = nxt; cA = nA; cB = nB; ++ui;
        if constexpr (ALIGN_EPI) { if (wr == 1) PG8_BAR; }
    }
    PG8_WAIT_V(0);
    if constexpr (!ALIGN_EPI) { if (wr == 0) PG8_BAR; }
    PG8_BAR;
    if constexpr (Epi::AFTER_DRAIN) { E.fused(acc, cur, wr, wc, fr, fq, lds, wid, lane); S.done(cur); }
#undef PG8_SA
#undef PG8_SB
#undef PG8_STAGE
#undef PG8_LDA
#undef PG8_LDB
#undef PG8_MMA
#undef PG8_WAIT_V
#undef PG8_WAIT_L
#undef PG8_BAR
#undef PG8_SCHED
#undef PG8_KOFS
}
}
#define XB_TMO      128
#define XB_XCNT(j)  (256  + 64 * (j))
#define XB_XSUB(j)  (1280 + 64 * (j))
#define XB_XGEN(j)  (2304 + 64 * (j))
#define XB_TOP      3328
#define XB_TOPGEN   3392
#define XCD_BAR_WORDS 3456
#define XB_SPIN_CAP (1u << 18)
#define LAS __attribute__((address_space(3)))

__device__ __forceinline__ unsigned xb_ld(unsigned* p)              { return __hip_atomic_load(p, __ATOMIC_RELAXED, __HIP_MEMORY_SCOPE_AGENT); }
__device__ __forceinline__ unsigned xb_add(unsigned* p, unsigned v) { return __hip_atomic_fetch_add(p, v, __ATOMIC_RELAXED, __HIP_MEMORY_SCOPE_AGENT); }
__device__ __forceinline__ unsigned xb_xcc_id() { return (unsigned)__builtin_amdgcn_s_getreg((3 << 11) | 20) & 0xFu; }
#define XB_SPIN(cond, bar) do { unsigned _sp = 0; while (cond) { __builtin_amdgcn_s_sleep(1); \
    if ((++_sp & 255u) == 0u) { if (xb_ld(&(bar)[XB_TMO])) break; if (_sp > XB_SPIN_CAP) { atomicAdd(&(bar)[XB_TMO], 1u); break; } } } } while (0)

struct XcdBarrier {
    unsigned* bar; unsigned x;
    volatile LAS unsigned* st;
};

__device__ __forceinline__ XcdBarrier xcd_barrier_post(unsigned* bar, volatile LAS unsigned* st) {
    XcdBarrier b; b.bar = bar; b.x = xb_xcc_id(); b.st = st;
    if (threadIdx.x == 0) (void)xb_add(&bar[XB_XCNT(b.x)], 1u);
    return b;
}
__device__ __forceinline__ void xcd_barrier_complete(unsigned* bar, unsigned x, unsigned& nloc, unsigned& nx) {
    const unsigned G = gridDim.x * gridDim.y * gridDim.z;
    unsigned sum, cnt, mine, sp = 0u;
    for (;;) {
        sum = 0u; cnt = 0u; mine = 0u;
#pragma unroll
        for (unsigned j = 0; j < 16; ++j) { const unsigned c = xb_ld(&bar[XB_XCNT(j)]); sum += c; cnt += (c > 0u) ? 1u : 0u; mine = (j == x) ? c : mine; }
        if (sum == G) break;
        __builtin_amdgcn_s_sleep(1);
        if ((++sp & 255u) == 0u) { if (xb_ld(&bar[XB_TMO])) break; if (sp > XB_SPIN_CAP) { atomicAdd(&bar[XB_TMO], 1u); break; } }
    }
    nloc = mine > 0u ? mine : 1u; nx = cnt > 0u ? cnt : 1u;
}

__device__ __forceinline__ void xcd_barrier(const XcdBarrier& b) {
    asm volatile("s_waitcnt vmcnt(0)" ::: "memory");
    __syncthreads();
    if (threadIdx.x == 0) {
        unsigned* bar = b.bar;
        __builtin_amdgcn_s_waitcnt(0);
        unsigned nloc = b.st[0], nx = b.st[1];
        if (nloc == 0u) { xcd_barrier_complete(bar, b.x, nloc, nx); b.st[0] = nloc; b.st[1] = nx; }
        const unsigned old = xb_add(&bar[XB_XSUB(b.x)], 1u);
        const unsigned gen = old / nloc;
        if (old + 1u == (gen + 1u) * nloc) {
            __builtin_amdgcn_fence(__ATOMIC_RELEASE, "agent");
            asm volatile("s_waitcnt vmcnt(0)" ::: "memory");
            const unsigned og = xb_add(&bar[XB_TOP], 1u);
            const unsigned tg = og / nx;
            if (og + 1u == (tg + 1u) * nx) xb_add(&bar[XB_TOPGEN], 1u);
            else XB_SPIN(xb_ld(&bar[XB_TOPGEN]) == tg, bar);
            __builtin_amdgcn_fence(__ATOMIC_ACQUIRE, "agent");
            xb_add(&bar[XB_XGEN(b.x)], 1u);
            asm volatile("s_waitcnt vmcnt(0)" ::: "memory");
        } else {
            XB_SPIN(xb_ld(&bar[XB_XGEN(b.x)]) == gen, bar);
            __builtin_amdgcn_fence(__ATOMIC_ACQUIRE, "agent");
            asm volatile("s_waitcnt vmcnt(0)" ::: "memory");
        }
    }
    __syncthreads();
}
constexpr int D = 2048, NB = 8, SEQ = 2048, NL = 4, T = NB * SEQ;
constexpr int NCH = SEQ / 64, NCHUNK = T / 64;
constexpr int GKW = 512, RANK = 16;
constexpr int INW = 6160, NP = 6144;
constexpr int NE = 16384;
constexpr float ALPHA = 1.6817928305074290f, EPS = 1e-5f;
constexpr int PQ = 0, PK = 512, PV = 1024, PR = 2048, PCB = 3072, PCC = 4096, PCH = 5120;
constexpr int NWAVES = 8, NTHREADS = 512;
#ifndef WGM_IN
#define WGM_IN 4
#endif
#ifndef WGM_OUT
#define WGM_OUT 4
#endif
#ifndef WGM_WQ
#define WGM_WQ 4
#endif
#ifndef TAB4
#define TAB4 1
#endif
constexpr int NPHASES = 2 + 7 * NL;

constexpr size_t MiB = 1u << 20;
constexpr size_t WS_CTL = 0, CTL_ZERO_BYTES = 1 * MiB;
constexpr size_t WS_MOD = 1 * MiB, WS_PART = 3 * MiB, WS_KEYS = 15 * MiB, WS_DTOT = 17 * MiB, WS_WIN = 18 * MiB, WS_WOUT = 115 * MiB, WS_WQ = 147 * MiB;
constexpr size_t WS_UT = 179 * MiB, WS_VT = 435 * MiB, WS_H = 691 * MiB, WS_PROJ = 755 * MiB, WS_E = 947 * MiB, WS_OGLA = 979 * MiB, WS_Y = 1043 * MiB;
constexpr size_t WS_Z = 1107 * MiB, WS_X1 = 1235 * MiB, WS_X = 1363 * MiB, WS_Q = 1491 * MiB, WS_H2 = 1555 * MiB, WS_HQ8 = 1619 * MiB, WS_H8 = 1659 * MiB, WS_WIN8 = 1691 * MiB, WS_WOUT8 = 1739 * MiB, WS_WQ8 = 1755 * MiB, WS_Y8 = 1771 * MiB, WS_H28 = 1803 * MiB, WS_END = 1835 * MiB;
constexpr size_t WS_SU = 17 * MiB + 512 * 1024, WS_SV = 17 * MiB + 768 * 1024, WS_HSC = 2 * MiB + 640 * 1024;
static_assert(WS_WIN + (size_t)NL * INW * D * 2 <= WS_WOUT && WS_PART + (size_t)NL * 8 * NB * 6 * D * 4 <= WS_KEYS && WS_MOD + (size_t)NL * NB * 6 * D * 4 <= WS_PART, "ws map");
constexpr size_t WS_SAH = WS_SU, WS_SAY = WS_SU + 65536, WS_SB = WS_SV; constexpr int SBL = NP + 2 * D;
#ifndef KROT_A
#define KROT_A 0
#endif
#ifndef KROT_B
#define KROT_B 0
#endif
#define KROT(c) (KROT_A * (((c) >> 3) & 3) + KROT_B * ((c) >> 5))
#ifndef RES16
#define RES16 1
#endif
#ifndef RES16_X
#define RES16_X RES16
#endif
#ifndef RES16_Z
#define RES16_Z RES16
#endif
#ifndef RES16_X1
#define RES16_X1 RES16
#endif
#ifndef I8_WQ
#define I8_WQ 1
#endif
#ifndef I8_IN
#define I8_IN 1
#endif
#ifndef I8_OUT
#define I8_OUT 1
#endif
constexpr int CW_BAR = 4096;

constexpr int RING_OFF = 0, RING_BYTES = 131072, LDSCTL_OFF = RING_BYTES, LDS_BYTES = 147456;

#define GAS __attribute__((address_space(1)))
typedef unsigned short bf16;
typedef unsigned v4u __attribute__((ext_vector_type(4)));
typedef unsigned v2u __attribute__((ext_vector_type(2)));
typedef float f32x4 __attribute__((ext_vector_type(4)));
typedef float f32x16 __attribute__((ext_vector_type(16)));
typedef short bf16x8 __attribute__((ext_vector_type(8)));
typedef __bf16 bf16x2v __attribute__((ext_vector_type(2)));
#define LDS_WAIT() asm volatile("s_waitcnt lgkmcnt(0)" ::: "memory")

__device__ __forceinline__ unsigned pk2(float lo, float hi) { return pg8::cvt_pk_bf16(lo, hi); }
__device__ __forceinline__ float dot2bf(unsigned w, unsigned x, float acc) { return __builtin_amdgcn_fdot2_f32_bf16(__builtin_bit_cast(bf16x2v, w), __builtin_bit_cast(bf16x2v, x), acc, false); }
__device__ __forceinline__ float bflo(unsigned u) { return __uint_as_float(u << 16); }
__device__ __forceinline__ float bfhi(unsigned u) { return __uint_as_float(u & 0xffff0000u); }
__device__ __forceinline__ float silu_f(float x) { return x / (1.0f + __expf(-x)); }
__device__ __forceinline__ float logsigmoid_f(float x) { return fminf(x, 0.0f) - log1pf(__expf(-fabsf(x))); }
__device__ __forceinline__ float gelu_tanh_f(float x) { const float u = 0.7978845608028654f * (x + 0.044715f * x * x * x); return 0.5f * x * (1.0f + tanhf(u)); }
__device__ __forceinline__ unsigned pack_i8(float a, float b, float c, float d) {
    const int q0 = (int)__builtin_rintf(a), q1 = (int)__builtin_rintf(b), q2 = (int)__builtin_rintf(c), q3 = (int)__builtin_rintf(d);
    return (unsigned)(q0 & 255) | ((unsigned)(q1 & 255) << 8) | ((unsigned)(q2 & 255) << 16) | ((unsigned)(q3 & 255) << 24); }
__device__ __forceinline__ float wave_sum(float v) {
#pragma unroll
    for (int o = 1; o < 64; o <<= 1) v += __shfl_xor(v, o);
    return v;
}

struct Args { const float* in[19]; float* out; unsigned char* ws; int ph_lo, ph_hi; };

__device__ __forceinline__ void transpose_item(const float* W, int ldw, int col0, bf16* WTrows, int k0, int nvalid, LAS float* scr, int lane) {
    const int n = lane & 31;
    float tv[32];
#pragma unroll
    for (int i = 0; i < 32; ++i) { const int kk = 2 * i + (lane >> 5); tv[i] = (n < nvalid) ? W[(size_t)(k0 + kk) * ldw + col0 + n] : 0.f; }
#pragma unroll
    for (int i = 0; i < 32; ++i) { const int kk = 2 * i + (lane >> 5); scr[kk * 33 + n] = tv[i]; }
    LDS_WAIT(); asm volatile("" ::: "memory");
    const int c = lane & 7;
#pragma unroll
    for (int j = 0; j < 4; ++j) { const int nn = (lane >> 3) + 8 * j; const LAS float* s = scr + (8 * c) * 33 + nn;
        v4u o; o.x = pk2(s[0 * 33], s[1 * 33]); o.y = pk2(s[2 * 33], s[3 * 33]); o.z = pk2(s[4 * 33], s[5 * 33]); o.w = pk2(s[6 * 33], s[7 * 33]);
        if (nn < nvalid) *(v4u*)(WTrows + (size_t)nn * D + k0 + 8 * c) = o; }
    LDS_WAIT(); asm volatile("" ::: "memory");
}
__device__ __forceinline__ void cvt_stream(const float* src, bf16* dst, size_t n4, size_t i0, size_t stride) {
    for (size_t i = i0; i < n4; i += stride) { const f32x4 v = ((const f32x4*)src)[i]; v2u o; o.x = pk2(v.x, v.y); o.y = pk2(v.z, v.w); ((v2u*)dst)[i] = o; }
}
__device__ __forceinline__ void ph_prologue_a(const Args& a, LAS unsigned char* lds, int tid, int lane, int wave, int bx, int G) {
    const int gw = bx * NWAVES + wave, NGW = G * NWAVES;
    LAS float* cact = (LAS float*)lds;
    for (int i = tid; i < NB * D; i += NTHREADS) { const int b = i / D, d = i % D; cact[d * 8 + b] = silu_f(a.in[1][i]); }
    __syncthreads();
    float* part = (float*)(a.ws + WS_PART);
    for (int it = gw; it < NL * 8 * 48; it += NGW) {
        const int cg = it % 48, dr = (it / 48) % 8, l = it / 384;
        f32x4 acc[8];
#pragma unroll
        for (int b = 0; b < 8; ++b) acc[b] = (f32x4){0.f, 0.f, 0.f, 0.f};
        const float* w = a.in[2] + ((size_t)l * D + dr * 256) * (6 * D) + cg * 256 + lane * 4;
#pragma unroll 4
        for (int d = 0; d < 256; ++d) {
            const f32x4 wv = *(const f32x4*)(w + (size_t)d * (6 * D));
            const f32x4 c0 = *(const LAS f32x4*)(cact + (dr * 256 + d) * 8), c1 = *(const LAS f32x4*)(cact + (dr * 256 + d) * 8 + 4);
            acc[0] += wv * c0.x; acc[1] += wv * c0.y; acc[2] += wv * c0.z; acc[3] += wv * c0.w;
            acc[4] += wv * c1.x; acc[5] += wv * c1.y; acc[6] += wv * c1.z; acc[7] += wv * c1.w;
        }
#pragma unroll
        for (int b = 0; b < 8; ++b) *(f32x4*)(part + (((size_t)l * 8 + dr) * NB + b) * (6 * D) + cg * 256 + lane * 4) = acc[b];
    }
    __syncthreads();
    LAS float* scr = (LAS float*)(lds + wave * 8448);
    bf16* winT = (bf16*)(a.ws + WS_WIN); bf16* woutT = (bf16*)(a.ws + WS_WOUT); bf16* wqT = (bf16*)(a.ws + WS_WQ);
    constexpr int IPL = 6144 + 32 + 2048 + 2048;
    for (int it = gw; it < NL * IPL; it += NGW) {
        const int l = it / IPL; int r = it % IPL;
        if (r < 6144) { const int nb = r % 192, kb = r / 192, n0 = nb * 32;
            transpose_item(a.in[4] + (size_t)l * D * INW, INW, n0 < 3072 ? n0 : n0 + 16, winT + ((size_t)l * INW + n0) * D, kb * 64, 32, scr, lane); continue; }
        r -= 6144;
        if (r < 32) { transpose_item(a.in[4] + (size_t)l * D * INW, INW, 3072, winT + ((size_t)l * INW + NP) * D, r * 64, 16, scr, lane); continue; }
        r -= 32;
        if (r < 2048) { const int nb = r % 64, kb = r / 64; transpose_item(a.in[10] + (size_t)l * D * D, D, nb * 32, woutT + ((size_t)l * D + nb * 32) * D, kb * 64, 32, scr, lane); continue; }
        r -= 2048;
        { const int nb = r % 64, kb = r / 64; transpose_item(a.in[13] + (size_t)l * D * D, D, nb * 32, wqT + ((size_t)l * D + nb * 32) * D, kb * 64, 32, scr, lane); }
    }
    const size_t i0 = (size_t)bx * NTHREADS + tid, stride = (size_t)G * NTHREADS;
    cvt_stream(a.in[14], (bf16*)(a.ws + WS_KEYS), (size_t)NL * 8 * 2 * 128 * 128 / 4, i0, stride);
#if TAB4
    __syncthreads();
    { LAS float* rowst = (LAS float*)(lds + wave * 8192);
      f32x4 vnx[8];
      if (gw < 2 * NL * NE) { const int tbl0 = gw / (NL * NE), r0 = gw % (NL * NE); const float* s0 = (tbl0 ? a.in[16] : a.in[15]) + (size_t)r0 * D;
#pragma unroll
          for (int c8 = 0; c8 < 8; ++c8) vnx[c8] = *(const f32x4*)(s0 + (c8 * 64 + lane) * 4); }
      for (int row = gw; row < 2 * NL * NE; row += NGW) {
        const int tbl = row / (NL * NE), r = row % (NL * NE);
#pragma unroll
        for (int c8 = 0; c8 < 8; ++c8) *(LAS f32x4*)(rowst + (c8 * 64 + lane) * 4) = vnx[c8];
        { const int rown = row + NGW < 2 * NL * NE ? row + NGW : row; const int tbln = rown / (NL * NE), rn = rown % (NL * NE); const float* sn = (tbln ? a.in[16] : a.in[15]) + (size_t)rn * D;
#pragma unroll
          for (int c8 = 0; c8 < 8; ++c8) vnx[c8] = *(const f32x4*)(sn + (c8 * 64 + lane) * 4); }
        LDS_WAIT(); asm volatile("" ::: "memory");
        unsigned char* tb = a.ws + (tbl ? WS_VT : WS_UT) + (size_t)r * 1152;
#pragma unroll
        for (int pass = 0; pass < 2; ++pass) { const int slot = lane + 64 * pass;
            if (slot < 72) { const int col0 = (slot >> 3) * 240 + (slot & 7) * 30;
                float x[30]; float mx = 0.f;
#pragma unroll
                for (int k = 0; k < 30; ++k) { x[k] = (col0 + k < D) ? rowst[col0 + k] : 0.f; mx = fmaxf(mx, fabsf(x[k])); }
                int code = 0; float inv = 0.f;
                if (mx > 0.f) { code = (int)ceilf(8.0f * log2f(mx * (1.0f / 7.0f))) + 128; code = code < 0 ? 0 : (code > 255 ? 255 : code); inv = __builtin_amdgcn_exp2f(16.0f - (float)code * 0.125f); }
                unsigned dw[4] = {0u, 0u, 0u, 0u};
#pragma unroll
                for (int kb = 0; kb < 15; ++kb) { int a0 = (int)__builtin_rintf(x[2 * kb] * inv), a1 = (int)__builtin_rintf(x[2 * kb + 1] * inv);
                    a0 = a0 < -7 ? -7 : (a0 > 7 ? 7 : a0); a1 = a1 < -7 ? -7 : (a1 > 7 ? 7 : a1);
                    dw[kb >> 2] |= ((unsigned)(a0 + 8) | ((unsigned)(a1 + 8) << 4)) << (8 * (kb & 3)); }
                dw[3] |= (unsigned)code << 24;
                *(v4u*)(tb + slot * 16) = (v4u){dw[0], dw[1], dw[2], dw[3]}; } }
        LDS_WAIT(); asm volatile("" ::: "memory");
      } }
#else
    for (int row = gw; row < 2 * NL * NE; row += NGW) {
        const int tbl = row / (NL * NE), r = row % (NL * NE);
        const float* src = (tbl ? a.in[16] : a.in[15]) + (size_t)r * D;
        f32x4 v[8]; float mx = 0.f;
#pragma unroll
        for (int c8 = 0; c8 < 8; ++c8) { v[c8] = *(const f32x4*)(src + (c8 * 64 + lane) * 4); mx = fmaxf(mx, fmaxf(fmaxf(fabsf(v[c8].x), fabsf(v[c8].y)), fmaxf(fabsf(v[c8].z), fabsf(v[c8].w)))); }
#pragma unroll
        for (int o = 1; o < 64; o <<= 1) mx = fmaxf(mx, __shfl_xor(mx, o));
        const float inv = mx > 0.f ? 127.0f / mx : 0.f; const int off = tbl ? 128 : 0;
        unsigned dw[8];
#pragma unroll
        for (int c8 = 0; c8 < 8; ++c8) { const int q0 = (int)__builtin_rintf(v[c8].x * inv) + off, q1 = (int)__builtin_rintf(v[c8].y * inv) + off, q2 = (int)__builtin_rintf(v[c8].z * inv) + off, q3 = (int)__builtin_rintf(v[c8].w * inv) + off;
            dw[c8] = (unsigned)(q0 & 255) | ((unsigned)(q1 & 255) << 8) | ((unsigned)(q2 & 255) << 16) | ((unsigned)(q3 & 255) << 24); }
        unsigned char* dst = a.ws + (tbl ? WS_VT : WS_UT) + (size_t)r * D;
        *(v4u*)(dst + lane * 16) = (v4u){dw[0], dw[1], dw[2], dw[3]}; *(v4u*)(dst + (64 + lane) * 16) = (v4u){dw[4], dw[5], dw[6], dw[7]};
        if (lane == 0) ((float*)(a.ws + (tbl ? WS_SV : WS_SU)))[r] = mx * (1.0f / 127.0f);
    }
#endif
}

__device__ __forceinline__ void ln_tail(const float (&z)[32], int t, int lane, const float* g, const float* bta, float* xout, const float* sh, const float* sc, bf16* hout, unsigned char* q8, float* q8s, LAS unsigned char* q8stage = nullptr, unsigned char* a8 = nullptr, float* a8s = nullptr, bf16* xb = nullptr) {
    float s = 0.f;
#pragma unroll
    for (int i = 0; i < 32; ++i) s += z[i];
    const float mu = wave_sum(s) * (1.0f / D);
    float q = 0.f;
#pragma unroll
    for (int i = 0; i < 32; ++i) { const float d = z[i] - mu; q += d * d; }
    const float rs = rsqrtf(wave_sum(q) * (1.0f / D) + EPS);
    float hv[32]; float mx = 0.f;
#pragma unroll
    for (int c = 0; c < 8; ++c) { const int col = (c * 64 + lane) * 4;
        const f32x4 g0 = *(const f32x4*)(g + col), b0 = *(const f32x4*)(bta + col);
        f32x4 x0;
        x0.x = (z[c * 4 + 0] - mu) * rs * g0.x + b0.x; x0.y = (z[c * 4 + 1] - mu) * rs * g0.y + b0.y; x0.z = (z[c * 4 + 2] - mu) * rs * g0.z + b0.z; x0.w = (z[c * 4 + 3] - mu) * rs * g0.w + b0.w;
        if (xb) { v2u o; o.x = pk2(x0.x, x0.y); o.y = pk2(x0.z, x0.w); *(v2u*)(xb + (size_t)t * D + col) = o; }
        else if (xout) *(f32x4*)(xout + (size_t)t * D + col) = x0;
        if (hout || q8 || a8) { const f32x4 s0 = *(const f32x4*)(sc + col), h0 = *(const f32x4*)(sh + col);
            hv[c * 4] = x0.x * (1.f + s0.x) + h0.x; hv[c * 4 + 1] = x0.y * (1.f + s0.y) + h0.y; hv[c * 4 + 2] = x0.z * (1.f + s0.z) + h0.z; hv[c * 4 + 3] = x0.w * (1.f + s0.w) + h0.w;
            if (hout) { v2u o; o.x = pk2(hv[c * 4], hv[c * 4 + 1]); o.y = pk2(hv[c * 4 + 2], hv[c * 4 + 3]);
                *(v2u*)(hout + (size_t)t * D + col) = o; }
            if (q8 || a8) mx = fmaxf(mx, fmaxf(fmaxf(fabsf(hv[c * 4]), fabsf(hv[c * 4 + 1])), fmaxf(fabsf(hv[c * 4 + 2]), fabsf(hv[c * 4 + 3])))); }
    }
    if (q8 || a8) {
#pragma unroll
        for (int o = 1; o < 64; o <<= 1) mx = fmaxf(mx, __shfl_xor(mx, o));
        const float qmax_ = (q8 && TAB4) ? 119.0f : 127.0f;
        const float inv = mx > 0.f ? qmax_ / mx : 0.f;
        unsigned dw[8];
#pragma unroll
        for (int c = 0; c < 8; ++c) { const int q0 = (int)__builtin_rintf(hv[c * 4] * inv), q1 = (int)__builtin_rintf(hv[c * 4 + 1] * inv), q2 = (int)__builtin_rintf(hv[c * 4 + 2] * inv), q3 = (int)__builtin_rintf(hv[c * 4 + 3] * inv);
            dw[c] = (unsigned)(q0 & 255) | ((unsigned)(q1 & 255) << 8) | ((unsigned)(q2 & 255) << 16) | ((unsigned)(q3 & 255) << 24); }
        if (a8) {
#pragma unroll
            for (int c = 0; c < 8; ++c) *(unsigned*)(a8 + (size_t)t * D + (c * 64 + lane) * 4) = dw[c];
            if (a8s && lane == 0) a8s[t] = mx / qmax_; }
        if (q8) {
#if TAB4
        { LAS unsigned* st32 = (LAS unsigned*)q8stage; LAS unsigned char* st8 = (LAS unsigned char*)q8stage;
#pragma unroll
          for (int i = 0; i < 9; ++i) st32[lane + 64 * i] = 0u;
          LDS_WAIT(); asm volatile("" ::: "memory");
#pragma unroll
          for (int c = 0; c < 8; ++c)
#pragma unroll
              for (int jp = 0; jp < 2; ++jp) { const int col = (c * 64 + lane) * 4 + 2 * jp, u = col / 240, r = col - u * 240, l7 = r / 30, k = r - l7 * 30;
                  const int q0 = (int)(signed char)((dw[c] >> (16 * jp)) & 255u), q1 = (int)(signed char)((dw[c] >> (16 * jp + 8)) & 255u);
                  const int l0 = ((q0 + 8) & 15) - 8, l1 = ((q1 + 8) & 15) - 8, h0 = (q0 - l0) >> 4, h1 = (q1 - l1) >> 4;
                  LAS unsigned char* sp = st8 + (u * 8 + l7) * 32 + (k >> 1);
                  sp[0] = (unsigned char)((l0 & 15) | ((l1 & 15) << 4)); sp[16] = (unsigned char)((h0 & 15) | ((h1 & 15) << 4)); }
          LDS_WAIT(); asm volatile("" ::: "memory");
          unsigned* d32 = (unsigned*)(q8 + (size_t)t * 2304);
#pragma unroll
          for (int i = 0; i < 9; ++i) d32[lane + 64 * i] = st32[lane + 64 * i];
          LDS_WAIT(); asm volatile("" ::: "memory"); }
#else
        unsigned char* dst = q8 + (size_t)t * D;
        *(v4u*)(dst + lane * 16) = (v4u){dw[0], dw[1], dw[2], dw[3]}; *(v4u*)(dst + (64 + lane) * 16) = (v4u){dw[4], dw[5], dw[6], dw[7]};
#endif
        if (lane == 0) q8s[t] = mx / qmax_; }
    }
}

__device__ __forceinline__ void ph_prologue_b(const Args& a, LAS unsigned char* lds, int tid, int lane, int wave, int bx, int G) {
    const float* part = (const float*)(a.ws + WS_PART); float* mod = (float*)(a.ws + WS_MOD);
    for (int i = bx * NTHREADS + tid; i < NL * NB * 6 * D / 4; i += G * NTHREADS) {
        const int idx = i * 4, e = idx % (6 * D), b = (idx / (6 * D)) % NB, l = idx / (6 * D * NB);
        f32x4 s = *(const f32x4*)(a.in[3] + l * 6 * D + e);
#pragma unroll
        for (int dr = 0; dr < 8; ++dr) s += *(const f32x4*)(part + (((size_t)l * 8 + dr) * NB + b) * (6 * D) + e);
        *(f32x4*)(mod + idx) = s;
    }
    LAS float* msh = (LAS float*)lds;
    bf16* hbuf = (bf16*)(a.ws + WS_H);
    for (int ch = bx; ch < NCHUNK; ch += G) {
        const int b = ch / NCH;
        for (int i = tid; i < 1024; i += NTHREADS) { const int e = i * 4;
            f32x4 s = *(const f32x4*)(a.in[3] + e);
#pragma unroll
            for (int dr = 0; dr < 8; ++dr) s += *(const f32x4*)(part + (((size_t)0 * 8 + dr) * NB + b) * (6 * D) + e);
            *(LAS f32x4*)(msh + e) = s; }
        __syncthreads();
        for (int i = 0; i < 8; ++i) { const int t = ch * 64 + wave * 8 + i;
            float hv[32]; float mx = 0.f;
#pragma unroll
            for (int c = 0; c < 4; ++c) { const int col = (c * 64 + lane) * 8;
                const f32x4 x0 = *(const f32x4*)(a.in[0] + (size_t)t * D + col), x1 = *(const f32x4*)(a.in[0] + (size_t)t * D + col + 4);
                const f32x4 h0 = *(const LAS f32x4*)(msh + col), h1 = *(const LAS f32x4*)(msh + col + 4), s0 = *(const LAS f32x4*)(msh + 2048 + col), s1 = *(const LAS f32x4*)(msh + 2048 + col + 4);
#pragma unroll
                for (int j = 0; j < 4; ++j) { hv[c * 8 + j] = x0[j] * (1.f + s0[j]) + h0[j]; hv[c * 8 + 4 + j] = x1[j] * (1.f + s1[j]) + h1[j]; }
                v4u o; o.x = pk2(hv[c * 8], hv[c * 8 + 1]); o.y = pk2(hv[c * 8 + 2], hv[c * 8 + 3]); o.z = pk2(hv[c * 8 + 4], hv[c * 8 + 5]); o.w = pk2(hv[c * 8 + 6], hv[c * 8 + 7]);
                *(v4u*)(hbuf + (size_t)t * D + col) = o;
#if RES16_X
                { v4u xo; xo.x = pk2(x0.x, x0.y); xo.y = pk2(x0.z, x0.w); xo.z = pk2(x1.x, x1.y); xo.w = pk2(x1.z, x1.w); *(v4u*)((bf16*)(a.ws + WS_X) + (size_t)t * D + col) = xo; }
#endif
#pragma unroll
                for (int j = 0; j < 8; ++j) mx = fmaxf(mx, fabsf(hv[c * 8 + j])); }
#pragma unroll
            for (int o = 1; o < 64; o <<= 1) mx = fmaxf(mx, __shfl_xor(mx, o));
            const float inv = mx > 0.f ? 127.0f / mx : 0.f;
#pragma unroll
            for (int c = 0; c < 4; ++c) { v2u o;
                o.x = pack_i8(hv[c * 8] * inv, hv[c * 8 + 1] * inv, hv[c * 8 + 2] * inv, hv[c * 8 + 3] * inv); o.y = pack_i8(hv[c * 8 + 4] * inv, hv[c * 8 + 5] * inv, hv[c * 8 + 6] * inv, hv[c * 8 + 7] * inv);
                *(v2u*)(a.ws + WS_H8 + (size_t)t * D + (c * 64 + lane) * 8) = o; }
            if (lane == 0) ((float*)(a.ws + WS_SAH))[t] = mx * (1.0f / 127.0f); }
        __syncthreads();
    }
    { const int gw = bx * NWAVES + wave, NGW = G * NWAVES;
      for (int row = gw; row < NL * SBL; row += NGW) { const int l = row / SBL, r = row % SBL;
          const bf16* src; unsigned char* dst;
          if (r < NP) { src = (const bf16*)(a.ws + WS_WIN) + ((size_t)l * INW + r) * D; dst = a.ws + WS_WIN8 + ((size_t)l * NP + r) * D; }
          else if (r < NP + D) { src = (const bf16*)(a.ws + WS_WOUT) + ((size_t)l * D + (r - NP)) * D; dst = a.ws + WS_WOUT8 + ((size_t)l * D + (r - NP)) * D; }
          else { src = (const bf16*)(a.ws + WS_WQ) + ((size_t)l * D + (r - NP - D)) * D; dst = a.ws + WS_WQ8 + ((size_t)l * D + (r - NP - D)) * D; }
          v4u w[4]; float mx = 0.f;
#pragma unroll
          for (int c = 0; c < 4; ++c) w[c] = *(const v4u*)(src + (c * 64 + lane) * 8);
#pragma unroll
          for (int c = 0; c < 4; ++c)
#pragma unroll
              for (int j = 0; j < 4; ++j) mx = fmaxf(mx, fmaxf(fabsf(bflo(w[c][j])), fabsf(bfhi(w[c][j]))));
#pragma unroll
          for (int o = 1; o < 64; o <<= 1) mx = fmaxf(mx, __shfl_xor(mx, o));
          const float inv = mx > 0.f ? 127.0f / mx : 0.f;
#pragma unroll
          for (int c = 0; c < 4; ++c) { v2u o;
              o.x = pack_i8(bflo(w[c][0]) * inv, bfhi(w[c][0]) * inv, bflo(w[c][1]) * inv, bfhi(w[c][1]) * inv); o.y = pack_i8(bflo(w[c][2]) * inv, bfhi(w[c][2]) * inv, bflo(w[c][3]) * inv, bfhi(w[c][3]) * inv);
              *(v2u*)(dst + (c * 64 + lane) * 8) = o; }
          if (lane == 0) ((float*)(a.ws + WS_SB))[row] = mx * (1.0f / 127.0f); } }
}

__device__ __forceinline__ void gate_prep(const Args& a, int l, LAS unsigned char* lds, int tid, int lane, int wave, int ch) {
    const bf16* hbuf = (const bf16*)(a.ws + WS_H); const bf16* waT = (const bf16*)(a.ws + WS_WIN) + ((size_t)l * INW + NP) * D;
    bf16* Ebuf = (bf16*)(a.ws + WS_E); float* dtot = (float*)(a.ws + WS_DTOT);
    const int t0 = ch * 64, l15 = lane & 15, lq = lane >> 4, mt = wave & 3, kh = wave >> 2;
    f32x4 acc = (f32x4){0.f, 0.f, 0.f, 0.f};
    const bf16* hA = hbuf + (size_t)(t0 + 16 * mt + l15) * D + kh * 1024 + 8 * lq;
    const bf16* wB = waT + (size_t)l15 * D + kh * 1024 + 8 * lq;
#pragma unroll 8
    for (int ks = 0; ks < 32; ++ks) { const bf16x8 av = *(const bf16x8*)(hA + 32 * ks), bv = *(const bf16x8*)(wB + 32 * ks); acc = __builtin_amdgcn_mfma_f32_16x16x32_bf16(av, bv, acc, 0, 0, 0); }
    LAS float* alr = (LAS float*)lds;
#pragma unroll
    for (int r = 0; r < 4; ++r) alr[(kh * 64 + 16 * mt + 4 * lq + r) * 16 + l15] = acc[r];
    __syncthreads();
    const int col = tid;
    float wg[16];
#pragma unroll
    for (int r = 0; r < 16; ++r) wg[r] = a.in[5][((size_t)l * RANK + r) * GKW + col];
    const float bgc = a.in[6][l * GKW + col];
    float tot = 0.f;
    for (int j = 0; j < 64; ++j) { float lg = bgc;
#pragma unroll
        for (int r4 = 0; r4 < 4; ++r4) { const f32x4 p = *(const LAS f32x4*)(alr + j * 16 + r4 * 4), q = *(const LAS f32x4*)(alr + (64 + j) * 16 + r4 * 4);
            lg += (p.x + q.x) * wg[r4 * 4] + (p.y + q.y) * wg[r4 * 4 + 1] + (p.z + q.z) * wg[r4 * 4 + 2] + (p.w + q.w) * wg[r4 * 4 + 3]; }
        tot += logsigmoid_f(lg) * (1.0f / 16.0f); }
    float run = 0.f;
    for (int j = 0; j < 64; ++j) { float lg = bgc;
#pragma unroll
        for (int r4 = 0; r4 < 4; ++r4) { const f32x4 p = *(const LAS f32x4*)(alr + j * 16 + r4 * 4), q = *(const LAS f32x4*)(alr + (64 + j) * 16 + r4 * 4);
            lg += (p.x + q.x) * wg[r4 * 4] + (p.y + q.y) * wg[r4 * 4 + 1] + (p.z + q.z) * wg[r4 * 4 + 2] + (p.w + q.w) * wg[r4 * 4 + 3]; }
        run += logsigmoid_f(lg) * (1.0f / 16.0f);
        Ebuf[(size_t)(t0 + j) * GKW + col] = (bf16)(pk2(__expf(tot - run), 0.f) & 0xffffu); }
    dtot[(size_t)ch * GKW + col] = __expf(tot);
    __syncthreads();
}

__device__ __forceinline__ void gla_unit(const Args& a, LAS unsigned char* lds, int tid, int lane, int wave, int un) {
    const bf16* proj = (const bf16*)(a.ws + WS_PROJ); const bf16* Ebuf = (const bf16*)(a.ws + WS_E); const float* dtot = (const float*)(a.ws + WS_DTOT); bf16* ogla = (bf16*)(a.ws + WS_OGLA);
    const int pair_ = (un & 7) * 4 + (un >> 6), dvs = (un >> 3) & 7, hh = pair_ & 3, b = pair_ >> 2;
    LAS bf16* kdT = (LAS bf16*)lds;
    LAS bf16* vT = (LAS bf16*)(lds + 18432);
    LAS bf16* ST = (LAS bf16*)(lds + 18432 + 4608);
    const int l15 = lane & 15, lq = lane >> 4, jl = tid >> 3, c0 = tid & 7, dv4 = (tid & 7) * 4, jt = (wave & 3) * 16, dvt = (wave >> 2) * 16;
#define GLA_BAR() do { asm volatile("s_waitcnt lgkmcnt(0)" ::: "memory"); __builtin_amdgcn_s_barrier(); asm volatile("" ::: "memory"); } while (0)
    f32x4 S0 = (f32x4){0.f, 0.f, 0.f, 0.f}, S1 = (f32x4){0.f, 0.f, 0.f, 0.f};
    v4u kn0[2], kn1[2], en0[2], en1[2]; v2u vn0, vn1; bf16x8 qn0[4], qn1[4], qc[4]; f32x4 dn0, dn1, dc;
#define GLA_LOAD(c, kn, en, vn, qn, dn) do { const int t0c = b * SEQ + (c) * 64; const bf16* pr = proj + (size_t)(t0c + jl) * NP; \
          \
        kn[0] = *(const v4u*)(pr + PK + hh * 128 + 8 * c0); kn[1] = *(const v4u*)(pr + PK + hh * 128 + 64 + 8 * c0); \
        en[0] = *(const v4u*)(Ebuf + (size_t)(t0c + jl) * GKW + hh * 128 + 8 * c0); en[1] = *(const v4u*)(Ebuf + (size_t)(t0c + jl) * GKW + hh * 128 + 64 + 8 * c0); \
        vn = *(const v2u*)(pr + PV + hh * 256 + dvs * 32 + dv4); \
        _Pragma("unroll") for (int ks_ = 0; ks_ < 4; ++ks_) qn[ks_] = *(const bf16x8*)(proj + (size_t)(t0c + jt + l15) * NP + PQ + hh * 128 + 32 * ks_ + 8 * lq); \
        dn = *(const f32x4*)(dtot + (size_t)(b * NCH + (c)) * GKW + hh * 128 + 16 * wave + 4 * lq); } while (0)
#define GLA_PREP(kn, en, vn, qn, dn) do { \
        _Pragma("unroll") for (int h_ = 0; h_ < 2; ++h_) _Pragma("unroll") for (int i_ = 0; i_ < 8; ++i_) { const unsigned w_ = kn[h_][i_ >> 1], e_ = en[h_][i_ >> 1]; \
            const float kf_ = (i_ & 1) ? bfhi(w_) : bflo(w_), ef_ = (i_ & 1) ? bfhi(e_) : bflo(e_); \
            kdT[(64 * h_ + 8 * c0 + i_) * 72 + ((((jl >> 3) ^ c0) & 7) << 3) + (jl & 7)] = (bf16)(pk2(kf_ * ef_, 0.f) & 0xffffu); }     \
        _Pragma("unroll") for (int i_ = 0; i_ < 4; ++i_) { const unsigned w_ = vn[i_ >> 1]; vT[(dv4 + i_) * 72 + jl] = (bf16)((i_ & 1) ? (w_ >> 16) : (w_ & 0xffffu)); } \
        _Pragma("unroll") for (int ks_ = 0; ks_ < 4; ++ks_) qc[ks_] = qn[ks_]; \
        dc = dn; } while (0)
#define GLA_BODY(c) do { \
        S0 = S0 * dc; S1 = S1 * dc; \
        _Pragma("unroll") for (int ks = 0; ks < 2; ++ks) { \
            const bf16x8 A_ = *(const LAS bf16x8*)(kdT + (16 * wave + l15) * 72 + ((((4 * ks + lq) ^ (2 * wave + (l15 >> 3))) & 7) << 3)); \
            const bf16x8 B0_ = *(const LAS bf16x8*)(vT + l15 * 72 + 32 * ks + 8 * lq), B1_ = *(const LAS bf16x8*)(vT + (16 + l15) * 72 + 32 * ks + 8 * lq); \
            S0 = __builtin_amdgcn_mfma_f32_16x16x32_bf16(A_, B0_, S0, 0, 0, 0); S1 = __builtin_amdgcn_mfma_f32_16x16x32_bf16(A_, B1_, S1, 0, 0, 0); } \
        { v2u w0_, w1_; w0_.x = pk2(S0.x, S0.y); w0_.y = pk2(S0.z, S0.w); w1_.x = pk2(S1.x, S1.y); w1_.y = pk2(S1.z, S1.w); \
          *(LAS v2u*)(ST + l15 * 136 + 16 * wave + 4 * lq) = w0_; *(LAS v2u*)(ST + (16 + l15) * 136 + 16 * wave + 4 * lq) = w1_; } \
        GLA_BAR(); \
        f32x4 O_ = (f32x4){0.f, 0.f, 0.f, 0.f}; \
        _Pragma("unroll") for (int ks = 0; ks < 4; ++ks) { const bf16x8 A_ = *(const LAS bf16x8*)(ST + (dvt + l15) * 136 + 32 * ks + 8 * lq); O_ = __builtin_amdgcn_mfma_f32_16x16x32_bf16(A_, qc[ks], O_, 0, 0, 0); } \
        { const f32x4 Os_ = O_ * 0.08838834764831845f; v2u ob_; ob_.x = pk2(Os_.x, Os_.y); ob_.y = pk2(Os_.z, Os_.w); \
          *(v2u*)(ogla + (size_t)(b * SEQ + (c) * 64 + jt + l15) * 1024 + hh * 256 + dvs * 32 + dvt + 4 * lq) = ob_; } } while (0)
    GLA_LOAD(0, kn0, en0, vn0, qn0, dn0); GLA_LOAD(1, kn1, en1, vn1, qn1, dn1);
    GLA_PREP(kn0, en0, vn0, qn0, dn0);
    GLA_BAR();
    for (int c = 0; c < NCH; c += 2) {
        { const int cn_ = c + 2 < NCH ? c + 2 : NCH - 1; GLA_LOAD(cn_, kn0, en0, vn0, qn0, dn0); }
        GLA_BODY(c);
        GLA_PREP(kn1, en1, vn1, qn1, dn1);
        GLA_BAR();
        { const int cn_ = c + 3 < NCH ? c + 3 : NCH - 1; GLA_LOAD(cn_, kn1, en1, vn1, qn1, dn1); }
        GLA_BODY(c + 1);
        GLA_PREP(kn0, en0, vn0, qn0, dn0);
        GLA_BAR();
    }
#undef GLA_BODY
#undef GLA_BAR
#undef GLA_LOAD
#undef GLA_PREP
}

__device__ __forceinline__ void unpack16(const v4u& p0, const v4u& p1, float (&o)[16]) {
#pragma unroll
    for (int j = 0; j < 4; ++j) { o[2 * j] = bflo(p0[j]); o[2 * j + 1] = bfhi(p0[j]); o[8 + 2 * j] = bflo(p1[j]); o[8 + 2 * j + 1] = bfhi(p1[j]); }
}
__device__ __forceinline__ void mixpost_chunk(const Args& a, int l, int lane, int wave, int ch) {
    const bf16* proj = (const bf16*)(a.ws + WS_PROJ); const bf16* ogla = (const bf16*)(a.ws + WS_OGLA);
    const int c0 = 16 * lane, tfirst = ch * 64 + wave * 8, sfirst = tfirst % SEQ;
    float gn[16], cw0[16], cw1[16], cw2[16], cn[16], u1[16], u2[16];
#pragma unroll
    for (int i = 0; i < 16; ++i) { gn[i] = a.in[7][l * 256 + ((c0 + i) & 255)]; cw0[i] = a.in[8][(size_t)l * 3072 + c0 + i]; cw1[i] = a.in[8][(size_t)l * 3072 + 1024 + c0 + i];
        cw2[i] = a.in[8][(size_t)l * 3072 + 2048 + c0 + i]; cn[i] = a.in[9][l * 1024 + c0 + i]; u1[i] = 0.f; u2[i] = 0.f; }
    if (sfirst >= 2) {
        float cc[16], chh[16];
        { const bf16* pr = proj + (size_t)(tfirst - 2) * NP; unpack16(*(const v4u*)(pr + PCC + c0), *(const v4u*)(pr + PCC + c0 + 8), cc); unpack16(*(const v4u*)(pr + PCH + c0), *(const v4u*)(pr + PCH + c0 + 8), chh); }
#pragma unroll
        for (int i = 0; i < 16; ++i) u2[i] = cc[i] * chh[i];
        { const bf16* pr = proj + (size_t)(tfirst - 1) * NP; unpack16(*(const v4u*)(pr + PCC + c0), *(const v4u*)(pr + PCC + c0 + 8), cc); unpack16(*(const v4u*)(pr + PCH + c0), *(const v4u*)(pr + PCH + c0 + 8), chh); }
#pragma unroll
        for (int i = 0; i < 16; ++i) u1[i] = cc[i] * chh[i];
    }
#pragma unroll 2
    for (int it = 0; it < 8; ++it) { const int t = tfirst + it; const bf16* pr = proj + (size_t)t * NP;
        float o[16], r[16], cb[16], cc[16], chh[16];
        unpack16(*(const v4u*)(ogla + (size_t)t * 1024 + c0), *(const v4u*)(ogla + (size_t)t * 1024 + c0 + 8), o);
        unpack16(*(const v4u*)(pr + PR + c0), *(const v4u*)(pr + PR + c0 + 8), r);
        unpack16(*(const v4u*)(pr + PCB + c0), *(const v4u*)(pr + PCB + c0 + 8), cb);
        unpack16(*(const v4u*)(pr + PCC + c0), *(const v4u*)(pr + PCC + c0 + 8), cc);
        unpack16(*(const v4u*)(pr + PCH + c0), *(const v4u*)(pr + PCH + c0 + 8), chh);
        float ss = 0.f;
#pragma unroll
        for (int i = 0; i < 16; ++i) ss += o[i] * o[i];
        ss += __shfl_xor(ss, 1); ss += __shfl_xor(ss, 2); ss += __shfl_xor(ss, 4); ss += __shfl_xor(ss, 8);
        const float rg = rsqrtf(ss * (1.0f / 256.f) + EPS);
        float val[16]; float s2 = 0.f;
#pragma unroll
        for (int i = 0; i < 16; ++i) { const float u0 = cc[i] * chh[i]; val[i] = cb[i] * (cw0[i] * u2[i] + cw1[i] * u1[i] + cw2[i] * u0); s2 += val[i] * val[i]; u2[i] = u1[i]; u1[i] = u0; }
        const float rc = rsqrtf(wave_sum(s2) * (1.0f / 1024.f) + EPS);
        float ya[16], yb[16]; float mx = 0.f;
#pragma unroll
        for (int i = 0; i < 16; ++i) { ya[i] = o[i] * rg * gn[i] * silu_f(r[i]); yb[i] = val[i] * rc * cn[i]; mx = fmaxf(mx, fmaxf(fabsf(ya[i]), fabsf(yb[i]))); }
#pragma unroll
        for (int o_ = 1; o_ < 64; o_ <<= 1) mx = fmaxf(mx, __shfl_xor(mx, o_));
        const float inv = mx > 0.f ? 127.0f / mx : 0.f;
        v4u y0, y1;
#pragma unroll
        for (int j = 0; j < 4; ++j) { y0[j] = pack_i8(ya[4 * j] * inv, ya[4 * j + 1] * inv, ya[4 * j + 2] * inv, ya[4 * j + 3] * inv); y1[j] = pack_i8(yb[4 * j] * inv, yb[4 * j + 1] * inv, yb[4 * j + 2] * inv, yb[4 * j + 3] * inv); }
        unsigned char* yr = a.ws + WS_Y8 + (size_t)t * D;
        *(v4u*)(yr + c0) = y0; *(v4u*)(yr + 1024 + c0) = y1;
#if !I8_OUT
        { v4u b0, b1, b2, b3;
#pragma unroll
          for (int j = 0; j < 4; ++j) { b0[j] = pk2(ya[2 * j], ya[2 * j + 1]); b1[j] = pk2(ya[8 + 2 * j], ya[9 + 2 * j]); b2[j] = pk2(yb[2 * j], yb[2 * j + 1]); b3[j] = pk2(yb[8 + 2 * j], yb[9 + 2 * j]); }
          bf16* ybr = (bf16*)(a.ws + WS_Y) + (size_t)t * D;
          *(v4u*)(ybr + c0) = b0; *(v4u*)(ybr + c0 + 8) = b1; *(v4u*)(ybr + 1024 + c0) = b2; *(v4u*)(ybr + 1024 + c0 + 8) = b3; }
#endif
        if (lane == 0) ((float*)(a.ws + WS_SAY))[t] = mx * (1.0f / 127.0f);
    }
}

__device__ __forceinline__ void ln1_chunk(const Args& a, int l, LAS unsigned char* lds, int lane, int wave, int ch) {
    const float* zbuf = (const float*)(a.ws + WS_Z); const float* mod = (const float*)(a.ws + WS_MOD);
    const int b = ch / NCH; const float* mb = mod + ((size_t)l * NB + b) * 6 * D;
#pragma unroll 2
    for (int it = 0; it < 8; ++it) { const int t = ch * 64 + wave * 8 + it;
        float z[32];
#pragma unroll
#if RES16_Z
        for (int c = 0; c < 8; ++c) { const v2u v0 = *(const v2u*)((const bf16*)zbuf + (size_t)t * D + (c * 64 + lane) * 4); z[c * 4] = bflo(v0.x); z[c * 4 + 1] = bfhi(v0.x); z[c * 4 + 2] = bflo(v0.y); z[c * 4 + 3] = bfhi(v0.y); }
#else
        for (int c = 0; c < 8; ++c) { const f32x4 v0 = *(const f32x4*)(zbuf + (size_t)t * D + (c * 64 + lane) * 4); z[c * 4] = v0.x; z[c * 4 + 1] = v0.y; z[c * 4 + 2] = v0.z; z[c * 4 + 3] = v0.w; }
#endif
        ln_tail(z, t, lane, a.in[11] + (size_t)l * D, a.in[12] + (size_t)l * D, RES16_X1 ? (float*)nullptr : (float*)(a.ws + WS_X1), mb + 3 * D, mb + 4 * D, I8_WQ ? (bf16*)nullptr : (bf16*)(a.ws + WS_H2), a.ws + WS_HQ8, (float*)(a.ws + WS_HSC), lds + wave * 2304, I8_WQ ? a.ws + WS_H28 : (unsigned char*)nullptr, nullptr, RES16_X1 ? (bf16*)(a.ws + WS_X1) : (bf16*)nullptr);
    }
}

template <int N> __device__ __forceinline__ void bitonic_sort_desc(float (&v)[N]) {
#pragma unroll
    for (int k = 2; k <= N; k <<= 1)
#pragma unroll
        for (int j = k >> 1; j > 0; j >>= 1)
#pragma unroll
            for (int i = 0; i < N; ++i) { const int p = i ^ j; if (p > i) { const bool desc = ((i & k) == 0); const float x = v[i], y = v[p]; const float mx = fmaxf(x, y), mn = fminf(x, y); v[i] = desc ? mx : mn; v[p] = desc ? mn : mx; } }
}
__device__ __forceinline__ void merge_top16(float (&x)[16], const float (&y)[16]) {
#pragma unroll
    for (int i = 0; i < 16; ++i) x[i] = fmaxf(x[i], y[15 - i]);
#pragma unroll
    for (int j = 8; j > 0; j >>= 1)
#pragma unroll
        for (int i = 0; i < 16; ++i) { const int p = i ^ j; if (p > i) { const float u = x[i], w = x[p]; x[i] = fmaxf(u, w); x[p] = fminf(u, w); } }
}
__device__ __forceinline__ void ce_desc(float& ka, int& pa, float& kb, int& pb) { const bool sw = kb > ka; const float k0 = sw ? kb : ka, k1 = sw ? ka : kb; const int p0 = sw ? pb : pa, p1 = sw ? pa : pb; ka = k0; pa = p0; kb = k1; pb = p1; }
__device__ __forceinline__ void bitonic_sort_desc_kp(float (&k)[16], int (&p)[16]) {
#pragma unroll
    for (int kk = 2; kk <= 16; kk <<= 1)
#pragma unroll
        for (int j = kk >> 1; j > 0; j >>= 1)
#pragma unroll
            for (int i = 0; i < 16; ++i) { const int q = i ^ j; if (q > i) { if ((i & kk) == 0) ce_desc(k[i], p[i], k[q], p[q]); else ce_desc(k[q], p[q], k[i], p[i]); } }
}
__device__ __forceinline__ void merge_top16_kp(float (&k)[16], int (&p)[16], const float (&k2)[16], const int (&p2)[16]) {
#pragma unroll
    for (int i = 0; i < 16; ++i) { const bool sw = k2[15 - i] > k[i]; k[i] = sw ? k2[15 - i] : k[i]; p[i] = sw ? p2[15 - i] : p[i]; }
#pragma unroll
    for (int j = 8; j > 0; j >>= 1)
#pragma unroll
        for (int i = 0; i < 16; ++i) { const int q = i ^ j; if (q > i) ce_desc(k[i], p[i], k[q], p[q]); }
}
__device__ constexpr int cand_i(int s) { return s < 16 ? 0 : s < 24 ? 1 : s < 29 ? 2 : s < 33 ? 3 : s < 36 ? 4 : s < 38 ? 5 : s < 40 ? 6 : s < 42 ? 7 : s < 50 ? s - 34 : -1; }
__device__ constexpr int cand_j(int s) { return s < 16 ? s : s < 24 ? s - 16 : s < 29 ? s - 24 : s < 33 ? s - 29 : s < 36 ? s - 33 : s < 38 ? s - 36 : s < 40 ? s - 38 : s < 42 ? s - 40 : s < 50 ? 0 : -1; }

__device__ __forceinline__ void peer_retrieve(const Args& a, int l, LAS unsigned char* lds, int lane, int wave, int ch) {
    const bf16* qbuf = (const bf16*)(a.ws + WS_Q); const bf16* keys = (const bf16*)(a.ws + WS_KEYS) + ((size_t)(l * 8 + wave) * 2) * 128 * 128;
    LAS int* eg_e = (LAS int*)lds; LAS float* eg_g = (LAS float*)(lds + 32768);
    const int l31 = lane & 31, l5 = lane >> 5, h = wave, t0 = ch * 64;
    for (int tt = 0; tt < 2; ++tt) {
        float sv[2][16];
#pragma unroll
        for (int p = 0; p < 2; ++p) {
            f32x16 acc[4];
#pragma unroll
            for (int nt = 0; nt < 4; ++nt)
#pragma unroll
                for (int r = 0; r < 16; ++r) acc[nt][r] = 0.f;
            const bf16* qp = qbuf + (size_t)(t0 + 32 * tt + l31) * D + h * 256 + p * 128 + 8 * l5;
            const bf16* kp = keys + (size_t)(p * 128 + l31) * 128 + 8 * l5;
#pragma unroll 2
            for (int ks = 0; ks < 8; ++ks) { const bf16x8 bq = *(const bf16x8*)(qp + 16 * ks);
#pragma unroll
                for (int nt = 0; nt < 4; ++nt) { const bf16x8 ak = *(const bf16x8*)(kp + (size_t)(32 * nt) * 128 + 16 * ks); acc[nt] = __builtin_amdgcn_mfma_f32_32x32x16_bf16(ak, bq, acc[nt], 0, 0, 0); } }
            float v[4][16];
#pragma unroll
            for (int nt = 0; nt < 4; ++nt)
#pragma unroll
                for (int r = 0; r < 16; ++r) { const unsigned idx = 32u * nt + (r & 3) + 8u * (r >> 2) + 4u * l5; v[nt][r] = __uint_as_float((__float_as_uint(acc[nt][r]) & 0xffffff80u) | idx); }
#pragma unroll
            for (int nt = 0; nt < 4; ++nt) bitonic_sort_desc<16>(v[nt]);
            merge_top16(v[0], v[1]); merge_top16(v[2], v[3]); merge_top16(v[0], v[2]);
            float o[16];
#pragma unroll
            for (int i = 0; i < 16; ++i) o[i] = __shfl_xor(v[0][i], 32);
            merge_top16(v[0], o);
#pragma unroll
            for (int i = 0; i < 16; ++i) sv[p][i] = v[0][i];
        }
        LAS unsigned char* idxb = (LAS unsigned char*)(lds + 69632) + wave * 2048 + lane * 32;
        { v4u w0, w1;
#pragma unroll
          for (int q4 = 0; q4 < 4; ++q4) {
              w0[q4] = (__float_as_uint(sv[0][4 * q4]) & 127u) | ((__float_as_uint(sv[0][4 * q4 + 1]) & 127u) << 8) | ((__float_as_uint(sv[0][4 * q4 + 2]) & 127u) << 16) | ((__float_as_uint(sv[0][4 * q4 + 3]) & 127u) << 24);
              w1[q4] = (__float_as_uint(sv[1][4 * q4]) & 127u) | ((__float_as_uint(sv[1][4 * q4 + 1]) & 127u) << 8) | ((__float_as_uint(sv[1][4 * q4 + 2]) & 127u) << 16) | ((__float_as_uint(sv[1][4 * q4 + 3]) & 127u) << 24); }
          *(LAS v4u*)(idxb) = w0; *(LAS v4u*)(idxb + 16) = w1; }
        float ck[4][16];
#pragma unroll
        for (int s = 0; s < 64; ++s) {
            if (cand_i(s) >= 0) { const unsigned b0 = __float_as_uint(sv[0][cand_i(s) < 0 ? 0 : cand_i(s)]), b1 = __float_as_uint(sv[1][cand_j(s) < 0 ? 0 : cand_j(s)]);
                const float sum = __uint_as_float(b0 & 0xffffff80u) + __uint_as_float(b1 & 0xffffff80u);
                ck[s >> 4][s & 15] = __uint_as_float((__float_as_uint(sum) & 0xffffff00u) | (unsigned)((cand_i(s) < 0 ? 0 : cand_i(s)) * 16 + (cand_j(s) < 0 ? 0 : cand_j(s)))); }
            else ck[s >> 4][s & 15] = -3.0e38f; }
        bitonic_sort_desc<16>(ck[1]); bitonic_sort_desc<16>(ck[2]);
        merge_top16(ck[0], ck[1]); merge_top16(ck[2], ck[3]); merge_top16(ck[0], ck[2]);
        LDS_WAIT(); asm volatile("" ::: "memory");
        float ex[16]; int ce[16]; float den = 0.f;
        const float cmax = __uint_as_float(__float_as_uint(ck[0][0]) & 0xffffff00u);
#pragma unroll
        for (int i = 0; i < 16; ++i) { const unsigned bits = __float_as_uint(ck[0][i]); ex[i] = __expf(__uint_as_float(bits & 0xffffff00u) - cmax); den += ex[i];
            ce[i] = (int)idxb[(bits >> 4) & 15u] * 128 + (int)idxb[16 + (bits & 15u)]; }
        const float inv = 1.0f / den;
        if (l5 == 0) {
            const int base = (32 * tt + l31) * 128 + h * 16;
#pragma unroll
            for (int i4 = 0; i4 < 4; ++i4) { *(LAS v4u*)(eg_e + base + 4 * i4) = (v4u){(unsigned)ce[4 * i4], (unsigned)ce[4 * i4 + 1], (unsigned)ce[4 * i4 + 2], (unsigned)ce[4 * i4 + 3]};
                *(LAS f32x4*)(eg_g + base + 4 * i4) = (f32x4){ex[4 * i4] * inv, ex[4 * i4 + 1] * inv, ex[4 * i4 + 2] * inv, ex[4 * i4 + 3] * inv}; }
        }
        LDS_WAIT(); asm volatile("" ::: "memory");
    }
}

typedef unsigned char uc4 __attribute__((ext_vector_type(4)));
constexpr int NSLICE = 16, SLICE_SHIFT = 10;
__device__ __forceinline__ int sdot4i(unsigned w, unsigned x, int acc) { return __builtin_amdgcn_sdot4((int)w, (int)x, acc, false); }
__device__ __forceinline__ void fma_ub4(unsigned w, float s, float& y0, float& y1, float& y2, float& y3) { const uc4 b = __builtin_bit_cast(uc4, w); y0 += s * (float)b.x; y1 += s * (float)b.y; y2 += s * (float)b.z; y3 += s * (float)b.w; }
#if TAB4
__device__ __forceinline__ void peer_tail(const Args& a, int l, int t, int lane, const bf16* Yrow, const float* mb, const float* mbn, bool last) {
    const float* x1buf = (const float*)(a.ws + WS_X1);
    float z[32];
#pragma unroll
    for (int c8 = 0; c8 < 8; ++c8) { const int col = (c8 * 64 + lane) * 4;
        const v2u yb = *(const v2u*)(Yrow + col); const f32x4 yv = (f32x4){bflo(yb.x), bfhi(yb.x), bflo(yb.y), bfhi(yb.y)};
#if RES16_X1
        const v2u xb_ = *(const v2u*)((const bf16*)x1buf + (size_t)t * D + col); const f32x4 x0 = (f32x4){bflo(xb_.x), bfhi(xb_.x), bflo(xb_.y), bfhi(xb_.y)}, g0 = *(const f32x4*)(mb + 5 * D + col);
#else
        const f32x4 x0 = *(const f32x4*)(x1buf + (size_t)t * D + col), g0 = *(const f32x4*)(mb + 5 * D + col);
#endif
        z[c8 * 4] = ALPHA * x0.x + (1.f + g0.x) * yv.x; z[c8 * 4 + 1] = ALPHA * x0.y + (1.f + g0.y) * yv.y; z[c8 * 4 + 2] = ALPHA * x0.z + (1.f + g0.z) * yv.z; z[c8 * 4 + 3] = ALPHA * x0.w + (1.f + g0.w) * yv.w; }
    ln_tail(z, t, lane, a.in[17] + (size_t)l * D, a.in[18] + (size_t)l * D, last ? a.out : (RES16_X ? (float*)nullptr : (float*)(a.ws + WS_X)), mbn, mbn + D, last ? (bf16*)nullptr : (bf16*)(a.ws + WS_H), nullptr, nullptr, nullptr, last ? (unsigned char*)nullptr : a.ws + WS_H8, (float*)(a.ws + WS_SAH), (RES16_X && !last) ? (bf16*)(a.ws + WS_X) : (bf16*)nullptr);
}
template <class TT, int N, int M> __device__ __forceinline__ void treduce(TT (&v)[N], int lane) {
    const bool c0 = (lane & M) != 0, c1 = (lane & (2 * M)) != 0, c2 = (lane & (4 * M)) != 0;
#pragma unroll
    for (int m = 0; m < N / 2; ++m) { const TT keep = c0 ? v[2 * m + 1] : v[2 * m], send = c0 ? v[2 * m] : v[2 * m + 1]; v[m] = keep + __shfl_xor(send, M); }
#pragma unroll
    for (int m = 0; m < N / 4; ++m) { const TT keep = c1 ? v[2 * m + 1] : v[2 * m], send = c1 ? v[2 * m] : v[2 * m + 1]; v[m] = keep + __shfl_xor(send, 2 * M); }
#pragma unroll
    for (int m = 0; m < N / 8; ++m) { const TT keep = c2 ? v[2 * m + 1] : v[2 * m], send = c2 ? v[2 * m] : v[2 * m + 1]; v[m] = keep + __shfl_xor(send, 4 * M); }
}
__device__ __forceinline__ void tr4x4(unsigned a, unsigned b, unsigned c, unsigned d, unsigned& t0, unsigned& t1, unsigned& t2, unsigned& t3) {
    const unsigned x0 = __builtin_amdgcn_perm(b, a, 0x05010400u), x1 = __builtin_amdgcn_perm(b, a, 0x07030602u), y0 = __builtin_amdgcn_perm(d, c, 0x05010400u), y1 = __builtin_amdgcn_perm(d, c, 0x07030602u);
    t0 = __builtin_amdgcn_perm(y0, x0, 0x05040100u); t1 = __builtin_amdgcn_perm(y0, x0, 0x07060302u); t2 = __builtin_amdgcn_perm(y1, x1, 0x05040100u); t3 = __builtin_amdgcn_perm(y1, x1, 0x07060302u);
}
__device__ __forceinline__ int sdot8i(unsigned w, unsigned x, int acc) { return __builtin_amdgcn_sdot8((int)w, (int)x, acc, false); }
__device__ __forceinline__ float slot_scale(unsigned w3) { return __builtin_amdgcn_exp2f((float)(w3 >> 24) * 0.125f - 16.0f); }
__device__ __forceinline__ void peer_experts(const Args& a, int l, LAS unsigned char* lds, int lane0, int wave, int ch) {
    const float* mod = (const float*)(a.ws + WS_MOD);
    const unsigned char* ut = a.ws + WS_UT + (size_t)l * NE * 1152; const unsigned char* vt = a.ws + WS_VT + (size_t)l * NE * 1152; const unsigned char* hq8 = a.ws + WS_HQ8;
    const float* hsc = (const float*)(a.ws + WS_HSC);
    bf16* Ybuf = (bf16*)(a.ws + WS_Z);
    const LAS int* eg_e = (const LAS int*)lds; LAS float* sw = (LAS float*)(lds + 32768);
    LAS float* apart = (LAS float*)(lds + 65536);
    const int b = ch / NCH; const bool last = (l == NL - 1);
    const float* mb = mod + ((size_t)l * NB + b) * 6 * D; const float* mbn = mod + ((size_t)(last ? l : l + 1) * NB + b) * 6 * D;
    const int tlw = wave * 8;
    { const int lane = lane0;
#pragma unroll
      for (int i = 0; i < 16; ++i) apart[tlw * 128 + i * 64 + lane] = 0.f; }
    LDS_WAIT(); asm volatile("" ::: "memory");
    {
        int laneL = lane0; asm volatile("" : "+v"(laneL)); const int lane = laneL;
        const int g = lane >> 3, l7 = lane & 7;
        v4u bufA[16], bufB[16], hA0, hA1, hB0, hB1;
#define CU_LOAD(buf, h0_, h1_, idx_) do { const int u_ = (idx_) >> 3, tl_ = tlw + ((idx_) & 7); const unsigned soff_ = (unsigned)(u_ * 128 + l7 * 16); \
            const unsigned char* hp_ = hq8 + (size_t)(ch * 64 + tl_) * 2304 + (u_ * 8 + l7) * 32; h0_ = *(const v4u*)hp_; h1_ = *(const v4u*)(hp_ + 16); \
            _Pragma("unroll") for (int i_ = 0; i_ < 16; ++i_) { const unsigned e_ = (unsigned)eg_e[tl_ * 128 + 8 * i_ + g]; buf[i_] = *(const v4u*)(ut + (size_t)(e_ * 1152u + soff_)); } } while (0)
#define CU_COMP(buf, h0_, h1_, idx_) do { const int tl_ = tlw + ((idx_) & 7); float accv_[16]; \
            _Pragma("unroll") for (int i_ = 0; i_ < 16; ++i_) { int sl_ = 0, sh_ = 0; \
                _Pragma("unroll") for (int d_ = 0; d_ < 4; ++d_) { const unsigned x_ = buf[i_][d_] ^ 0x88888888u; sl_ = sdot8i(x_, h0_[d_], sl_); sh_ = sdot8i(x_, h1_[d_], sh_); } \
                accv_[i_] = slot_scale(buf[i_][3]) * (float)(16 * sh_ + sl_); } \
            treduce<float, 16, 1>(accv_, lane); \
            apart[tl_ * 128 + 8 * l7 + g] += accv_[0]; apart[tl_ * 128 + 8 * (8 + l7) + g] += accv_[1]; } while (0)
        CU_LOAD(bufA, hA0, hA1, 0);
        for (int idx = 0; idx < 72; idx += 2) {
            CU_LOAD(bufB, hB0, hB1, idx + 1);
            CU_COMP(bufA, hA0, hA1, idx);
            { const int nx_ = idx + 2 < 72 ? idx + 2 : 71; CU_LOAD(bufA, hA0, hA1, nx_); }
            CU_COMP(bufB, hB0, hB1, idx + 1);
        }
#undef CU_LOAD
#undef CU_COMP
        LDS_WAIT(); asm volatile("" ::: "memory");
        for (int it = 0; it < 8; ++it) { const int tl = tlw + it; const float shs = hsc[ch * 64 + tl];
            const float w0 = sw[tl * 128 + lane] * gelu_tanh_f(apart[tl * 128 + lane] * shs), w1 = sw[tl * 128 + 64 + lane] * gelu_tanh_f(apart[tl * 128 + 64 + lane] * shs);
            sw[tl * 128 + lane] = w0; sw[tl * 128 + 64 + lane] = w1; }
        LDS_WAIT(); asm volatile("" ::: "memory");
    }
    {
        int laneL = lane0; asm volatile("" : "+v"(laneL)); const int lane = laneL;
        const int g = lane >> 3, l7 = lane & 7;
        v4u bufA[16], bufB[16];
#define CV_LOAD(buf, idx_) do { const int u_ = (idx_) >> 3, tl_ = tlw + ((idx_) & 7); const unsigned soff_ = (unsigned)(u_ * 128 + l7 * 16); \
            _Pragma("unroll") for (int i_ = 0; i_ < 16; ++i_) { const unsigned e_ = (unsigned)eg_e[tl_ * 128 + 8 * i_ + g]; buf[i_] = *(const v4u*)(vt + (size_t)(e_ * 1152u + soff_)); } } while (0)
#define CV_COMP(buf, idx_) do { const int u_ = (idx_) >> 3, tl_ = tlw + ((idx_) & 7); \
            float wf_[16]; float wmx_ = 0.f; \
            _Pragma("unroll") for (int i_ = 0; i_ < 16; ++i_) { wf_[i_] = sw[tl_ * 128 + 8 * i_ + g] * slot_scale(buf[i_][3]); wmx_ = fmaxf(wmx_, fabsf(wf_[i_])); } \
            wmx_ = fmaxf(wmx_, __shfl_xor(wmx_, 8)); wmx_ = fmaxf(wmx_, __shfl_xor(wmx_, 16)); wmx_ = fmaxf(wmx_, __shfl_xor(wmx_, 32));     \
            const float winv_ = wmx_ > 0.f ? 127.0f / wmx_ : 0.f, wsc_ = wmx_ * (1.0f / 127.0f); \
              \
            unsigned wq4_[4]; int wsum_ = 0; \
            _Pragma("unroll") for (int gp_ = 0; gp_ < 4; ++gp_) { \
                const unsigned m0_ = __float_as_uint(wf_[4 * gp_] * winv_ + 12582912.0f), m1_ = __float_as_uint(wf_[4 * gp_ + 1] * winv_ + 12582912.0f), m2_ = __float_as_uint(wf_[4 * gp_ + 2] * winv_ + 12582912.0f), m3_ = __float_as_uint(wf_[4 * gp_ + 3] * winv_ + 12582912.0f); \
                wq4_[gp_] = __builtin_amdgcn_perm(__builtin_amdgcn_perm(m3_, m2_, 0x0c0c0400u), __builtin_amdgcn_perm(m1_, m0_, 0x0c0c0400u), 0x05040100u); \
                wsum_ = sdot4i(wq4_[gp_], 0x01010101u, wsum_); } \
            int yi_[32]; \
            _Pragma("unroll") for (int q_ = 0; q_ < 32; ++q_) yi_[q_] = 0; \
            _Pragma("unroll") for (int gp_ = 0; gp_ < 4; ++gp_) { \
                _Pragma("unroll") for (int d_ = 0; d_ < 4; ++d_) { const unsigned A_ = buf[4 * gp_][d_], B_ = buf[4 * gp_ + 1][d_], C_ = buf[4 * gp_ + 2][d_], D_ = buf[4 * gp_ + 3][d_]; \
                    unsigned t0_, t1_, t2_, t3_; \
                    tr4x4(A_, B_, C_, D_, t0_, t1_, t2_, t3_);     \
                    yi_[8 * d_]     = sdot4i(t0_ & 0x0f0f0f0fu, wq4_[gp_], yi_[8 * d_]);     yi_[8 * d_ + 1] = sdot4i((t0_ >> 4) & 0x0f0f0f0fu, wq4_[gp_], yi_[8 * d_ + 1]); \
                    yi_[8 * d_ + 2] = sdot4i(t1_ & 0x0f0f0f0fu, wq4_[gp_], yi_[8 * d_ + 2]); yi_[8 * d_ + 3] = sdot4i((t1_ >> 4) & 0x0f0f0f0fu, wq4_[gp_], yi_[8 * d_ + 3]); \
                    yi_[8 * d_ + 4] = sdot4i(t2_ & 0x0f0f0f0fu, wq4_[gp_], yi_[8 * d_ + 4]); yi_[8 * d_ + 5] = sdot4i((t2_ >> 4) & 0x0f0f0f0fu, wq4_[gp_], yi_[8 * d_ + 5]); \
                    yi_[8 * d_ + 6] = sdot4i(t3_ & 0x0f0f0f0fu, wq4_[gp_], yi_[8 * d_ + 6]); yi_[8 * d_ + 7] = sdot4i((t3_ >> 4) & 0x0f0f0f0fu, wq4_[gp_], yi_[8 * d_ + 7]); } } \
            treduce<int, 32, 8>(yi_, lane); \
            wsum_ += __shfl_xor(wsum_, 8); wsum_ += __shfl_xor(wsum_, 16); wsum_ += __shfl_xor(wsum_, 32);     \
            float y_[4]; \
            _Pragma("unroll") for (int q_ = 0; q_ < 4; ++q_) y_[q_] = wsc_ * (float)(yi_[q_] - 8 * wsum_); \
            { const int colb_ = u_ * 240 + l7 * 30 + g; bf16* yr_ = Ybuf + (size_t)(ch * 64 + tl_) * D + colb_; \
              _Pragma("unroll") for (int m_ = 0; m_ < 4; ++m_) if (8 * m_ + g < 30 && colb_ + 8 * m_ < D) yr_[8 * m_] = (bf16)(pk2(y_[m_], 0.f) & 0xffffu); } } while (0)
        CV_LOAD(bufA, 0);
        for (int idx = 0; idx < 72; idx += 2) {
            CV_LOAD(bufB, idx + 1);
            CV_COMP(bufA, idx);
            { const int nx_ = idx + 2 < 72 ? idx + 2 : 71; CV_LOAD(bufA, nx_); }
            CV_COMP(bufB, idx + 1);
        }
#undef CV_LOAD
#undef CV_COMP
    }
    asm volatile("s_waitcnt vmcnt(0)" ::: "memory");
    __builtin_amdgcn_fence(__ATOMIC_ACQUIRE, "agent");
    asm volatile("s_waitcnt vmcnt(0)" ::: "memory");
    for (int it = 0; it < 8; ++it) { int laneT = lane0; asm volatile("" : "+v"(laneT)); const int t = ch * 64 + tlw + it;
        peer_tail(a, l, t, laneT, Ybuf + (size_t)t * D, mb, mbn, last); }
}
#else
__device__ __forceinline__ void peer_tail(const Args& a, int l, int t, int lane, const float* Yrow, const float* mb, const float* mbn, bool last) {
    const float* x1buf = (const float*)(a.ws + WS_X1);
    float z[32];
#pragma unroll
    for (int c = 0; c < 2; ++c)
#pragma unroll
        for (int k = 0; k < 4; ++k) { const int c8 = 4 * c + k, col = (c8 * 64 + lane) * 4;
            const v2u yb = *(const v2u*)((const bf16*)Yrow + (c * 64 + lane) * 16 + 4 * k); const f32x4 yv = (f32x4){bflo(yb.x), bfhi(yb.x), bflo(yb.y), bfhi(yb.y)};
#if RES16_X1
            const v2u xb_ = *(const v2u*)((const bf16*)x1buf + (size_t)t * D + col); const f32x4 x0 = (f32x4){bflo(xb_.x), bfhi(xb_.x), bflo(xb_.y), bfhi(xb_.y)}, g0 = *(const f32x4*)(mb + 5 * D + col);
#else
            const f32x4 x0 = *(const f32x4*)(x1buf + (size_t)t * D + col), g0 = *(const f32x4*)(mb + 5 * D + col);
#endif
            z[c8 * 4] = ALPHA * x0.x + (1.f + g0.x) * yv.x; z[c8 * 4 + 1] = ALPHA * x0.y + (1.f + g0.y) * yv.y; z[c8 * 4 + 2] = ALPHA * x0.z + (1.f + g0.z) * yv.z; z[c8 * 4 + 3] = ALPHA * x0.w + (1.f + g0.w) * yv.w; }
    ln_tail(z, t, lane, a.in[17] + (size_t)l * D, a.in[18] + (size_t)l * D, last ? a.out : (RES16_X ? (float*)nullptr : (float*)(a.ws + WS_X)), mbn, mbn + D, last ? (bf16*)nullptr : (bf16*)(a.ws + WS_H), nullptr, nullptr, nullptr, last ? (unsigned char*)nullptr : a.ws + WS_H8, (float*)(a.ws + WS_SAH), (RES16_X && !last) ? (bf16*)(a.ws + WS_X) : (bf16*)nullptr);
}
template <class TT, int M> __device__ __forceinline__ void treduce16(TT (&v)[16], int lane) {
    const bool c0 = (lane & M) != 0, c1 = (lane & (2 * M)) != 0, c2 = (lane & (4 * M)) != 0;
#pragma unroll
    for (int m = 0; m < 8; ++m) { const TT keep = c0 ? v[2 * m + 1] : v[2 * m], send = c0 ? v[2 * m] : v[2 * m + 1]; v[m] = keep + __shfl_xor(send, M); }
#pragma unroll
    for (int m = 0; m < 4; ++m) { const TT keep = c1 ? v[2 * m + 1] : v[2 * m], send = c1 ? v[2 * m] : v[2 * m + 1]; v[m] = keep + __shfl_xor(send, 2 * M); }
#pragma unroll
    for (int m = 0; m < 2; ++m) { const TT keep = c2 ? v[2 * m + 1] : v[2 * m], send = c2 ? v[2 * m] : v[2 * m + 1]; v[m] = keep + __shfl_xor(send, 4 * M); }
}
__device__ __forceinline__ void peer_experts(const Args& a, int l, LAS unsigned char* lds, int lane0, int wave, int ch) {
    const float* mod = (const float*)(a.ws + WS_MOD);
    const unsigned char* ut = a.ws + WS_UT + (size_t)l * NE * D; const unsigned char* vt = a.ws + WS_VT + (size_t)l * NE * D; const unsigned char* hq8 = a.ws + WS_HQ8;
    const float* su = (const float*)(a.ws + WS_SU) + (size_t)l * NE; const float* sv = (const float*)(a.ws + WS_SV) + (size_t)l * NE; const float* hsc = (const float*)(a.ws + WS_HSC);
    float* Ybuf = (float*)(a.ws + WS_Z);
    const LAS int* eg_e = (const LAS int*)lds; LAS float* sw = (LAS float*)(lds + 32768);
    LAS int* apart = (LAS int*)(lds + 65536); LAS float* wtotl = (LAS float*)(lds + LDSCTL_OFF + 256);
    const int b = ch / NCH; const bool last = (l == NL - 1);
    const float* mb = mod + ((size_t)l * NB + b) * 6 * D; const float* mbn = mod + ((size_t)(last ? l : l + 1) * NB + b) * 6 * D;
    const int tlw = wave * 8;
    { const int lane = lane0;
#pragma unroll
      for (int i = 0; i < 16; ++i) apart[tlw * 128 + i * 64 + lane] = 0; }
    LDS_WAIT(); asm volatile("" ::: "memory");
    {
        int laneL = lane0; asm volatile("" : "+v"(laneL)); const int lane = laneL;
        const int g = lane >> 3, l7 = lane & 7;
        v4u bufA[16], bufB[16], hA, hB;
#define CU_LOAD(buf, hh_, idx_) do { const int cs_ = (idx_) >> 3, tl_ = tlw + ((idx_) & 7); const unsigned coff_ = (unsigned)(cs_ * 128 + l7 * 16); \
            hh_ = *(const v4u*)(hq8 + (size_t)(ch * 64 + tl_) * D + coff_); \
            _Pragma("unroll") for (int i_ = 0; i_ < 16; ++i_) { const unsigned e_ = (unsigned)eg_e[tl_ * 128 + 8 * i_ + g]; buf[i_] = *(const v4u*)(ut + (size_t)(e_ * 2048u + coff_)); } } while (0)
#define CU_COMP(buf, hh_, idx_) do { const int tl_ = tlw + ((idx_) & 7); int acc_[16]; \
            _Pragma("unroll") for (int i_ = 0; i_ < 16; ++i_) { int s_ = 0; _Pragma("unroll") for (int q_ = 0; q_ < 4; ++q_) s_ = sdot4i(buf[i_][q_], hh_[q_], s_); acc_[i_] = s_; } \
            treduce16<int, 1>(acc_, lane); \
            apart[tl_ * 128 + 8 * l7 + g] += acc_[0]; apart[tl_ * 128 + 8 * (8 + l7) + g] += acc_[1]; } while (0)
        CU_LOAD(bufA, hA, 0);
        for (int idx = 0; idx < 128; idx += 2) {
            CU_LOAD(bufB, hB, idx + 1);
            CU_COMP(bufA, hA, idx);
            if (idx + 2 < 128) CU_LOAD(bufA, hA, idx + 2);
            CU_COMP(bufB, hB, idx + 1);
        }
#undef CU_LOAD
#undef CU_COMP
        LDS_WAIT(); asm volatile("" ::: "memory");
        for (int it = 0; it < 8; ++it) { const int tl = tlw + it; const float shs = hsc[ch * 64 + tl];
            const int e0 = eg_e[tl * 128 + lane], e1 = eg_e[tl * 128 + 64 + lane];
            const float w0 = sw[tl * 128 + lane] * gelu_tanh_f((float)apart[tl * 128 + lane] * su[e0] * shs) * sv[e0];
            const float w1 = sw[tl * 128 + 64 + lane] * gelu_tanh_f((float)apart[tl * 128 + 64 + lane] * su[e1] * shs) * sv[e1];
            sw[tl * 128 + lane] = w0; sw[tl * 128 + 64 + lane] = w1;
            const float ws = wave_sum(w0 + w1);
            if (lane == 0) wtotl[tl] = ws; }
        LDS_WAIT(); asm volatile("" ::: "memory");
    }
    {
        int laneL = lane0; asm volatile("" : "+v"(laneL)); const int lane = laneL;
        const int g = lane >> 3, l7 = lane & 7;
        v4u bufA[16], bufB[16];
#define CV_LOAD(buf, idx_) do { const int cs_ = (idx_) >> 3, tl_ = tlw + ((idx_) & 7); const unsigned coff_ = (unsigned)(cs_ * 128 + l7 * 16); \
            _Pragma("unroll") for (int i_ = 0; i_ < 16; ++i_) { const unsigned e_ = (unsigned)eg_e[tl_ * 128 + 8 * i_ + g]; buf[i_] = *(const v4u*)(vt + (size_t)(e_ * 2048u + coff_)); } } while (0)
#define CV_COMP(buf, idx_) do { const int cs_ = (idx_) >> 3, tl_ = tlw + ((idx_) & 7); float y_[16]; \
            _Pragma("unroll") for (int q_ = 0; q_ < 16; ++q_) y_[q_] = 0.f; \
            _Pragma("unroll") for (int i_ = 0; i_ < 16; ++i_) { const float wr_ = sw[tl_ * 128 + 8 * i_ + g]; \
                _Pragma("unroll") for (int q_ = 0; q_ < 4; ++q_) fma_ub4(buf[i_][q_], wr_, y_[4 * q_], y_[4 * q_ + 1], y_[4 * q_ + 2], y_[4 * q_ + 3]); } \
            treduce16<float, 8>(y_, lane); \
            const float woff_ = 128.0f * wtotl[tl_]; bf16* yr_ = (bf16*)Ybuf + (size_t)(ch * 64 + tl_) * D + cs_ * 128 + l7 * 16 + g; \
            yr_[0] = (bf16)(pk2(y_[0] - woff_, 0.f) & 0xffffu); yr_[8] = (bf16)(pk2(y_[1] - woff_, 0.f) & 0xffffu); } while (0)
        CV_LOAD(bufA, 0);
        for (int idx = 0; idx < 128; idx += 2) {
            CV_LOAD(bufB, idx + 1);
            CV_COMP(bufA, idx);
            if (idx + 2 < 128) CV_LOAD(bufA, idx + 2);
            CV_COMP(bufB, idx + 1);
        }
#undef CV_LOAD
#undef CV_COMP
    }
    asm volatile("s_waitcnt vmcnt(0)" ::: "memory");
    __builtin_amdgcn_fence(__ATOMIC_ACQUIRE, "agent");
    asm volatile("s_waitcnt vmcnt(0)" ::: "memory");
    for (int it = 0; it < 8; ++it) { int laneT = lane0; asm volatile("" : "+v"(laneT)); const int t = ch * 64 + tlw + it;
        peer_tail(a, l, t, laneT, (const float*)((const bf16*)Ybuf + (size_t)t * D), mb, mbn, last); }
}

#endif

#ifndef MK_PER_PHASE
#define MK_PER_PHASE 0
#endif
__global__ void __launch_bounds__(NTHREADS, 2) mk_fwd(Args a) {
    extern __shared__ __attribute__((aligned(16))) unsigned char lds_raw[];
    LAS unsigned char* lds = (LAS unsigned char*)lds_raw;
    const int tid = threadIdx.x, lane = tid & 63, wave = __builtin_amdgcn_readfirstlane(tid >> 6), G = gridDim.x, bx = blockIdx.x;
    if (tid < 64) ((LAS unsigned*)(lds + LDSCTL_OFF))[tid] = 0u;
    __syncthreads();
    unsigned* ctl = (unsigned*)(a.ws + WS_CTL);
    XcdBarrier bar; bar.bar = ctl + CW_BAR; bar.x = 0; bar.st = nullptr;
    const bool use_bar = (a.ph_hi - a.ph_lo) > 1;
    if (use_bar) bar = xcd_barrier_post(ctl + CW_BAR, (volatile LAS unsigned*)(lds + LDSCTL_OFF));
    const int lo = a.ph_lo, hi = a.ph_hi;
#ifndef PH_MASK
#define PH_MASK 0x1ff
#endif
#define IN(k) (lo <= (k) && (k) < hi)
#define EN(b) ((PH_MASK >> (b)) & 1)
#ifndef REP_MASK
#define REP_MASK 0
#endif
#ifndef REP_EXTRA
#define REP_EXTRA 2
#endif
#define REPS(b) (1 + ((REP_MASK >> (b)) & 1) * REP_EXTRA)
#define REP_BEGIN(b) for (int rep_ = 0; rep_ < REPS(b); ++rep_) {
#define REP_END(b) if (rep_ + 1 < REPS(b)) xcd_barrier(bar); }
#define SEAM(k) do { if (IN((k) + 1)) xcd_barrier(bar); } while (0)
#define PHASE_IDS() int tidp = tid; asm volatile("" : "+v"(tidp)); const int lanep = tidp & 63, wavep = __builtin_amdgcn_readfirstlane(tidp >> 6); (void)lanep; (void)wavep
    if (EN(0) && IN(0)) { REP_BEGIN(0) PHASE_IDS(); ph_prologue_a(a, lds, tidp, lanep, wavep, bx, G); REP_END(0) SEAM(0); }
    if (EN(1) && IN(1)) { REP_BEGIN(1) PHASE_IDS(); ph_prologue_b(a, lds, tidp, lanep, wavep, bx, G); REP_END(1) SEAM(1); }
    for (int l = 0; l < NL; ++l) {
        const int pb = 2 + 7 * l;
        const float* mod = (const float*)(a.ws + WS_MOD);
        if (EN(2) && IN(pb + 0)) {
            REP_BEGIN(2) PHASE_IDS();
#if I8_IN
            pg8::Gemm g{(const pg8::bf16_t*)(a.ws + WS_H8), (const pg8::bf16_t*)(a.ws + WS_WIN8 + (size_t)l * NP * D), T, NP, D / 2}; pg8::StaticOrder S; S.init(T, NP, G, bx, WGM_IN, KROT(bx));
            pg8::EpiBf16PS E{(pg8::bf16_t*)(a.ws + WS_PROJ), NP, (const float*)(a.ws + WS_SAH), (const float*)(a.ws + WS_SB) + l * SBL};
            pg8::gemm_phase<pg8::EpiBf16PS, pg8::StaticOrder, true, true, true>(lds + RING_OFF, g, S, E, tidp);
#else
            pg8::Gemm g{(const pg8::bf16_t*)(a.ws + WS_H), (const pg8::bf16_t*)(a.ws + WS_WIN) + (size_t)l * INW * D, T, NP, D}; pg8::StaticOrder S; S.init(T, NP, G, bx, WGM_IN, KROT(bx));
            pg8::EpiBf16P E{(pg8::bf16_t*)(a.ws + WS_PROJ), NP};
            pg8::gemm_phase<pg8::EpiBf16P, pg8::StaticOrder, true, true>(lds + RING_OFF, g, S, E, tidp);
#endif
            for (int ch = bx; ch < NCHUNK; ch += G) gate_prep(a, l, lds, tidp, lanep, wavep, ch);
            REP_END(2) SEAM(pb + 0);
        }
        if (EN(3) && IN(pb + 1)) { REP_BEGIN(3) PHASE_IDS(); for (int un = bx; un < 256; un += G) gla_unit(a, lds, tidp, lanep, wavep, un); REP_END(3) SEAM(pb + 1); }
        if (EN(4) && IN(pb + 2)) { REP_BEGIN(4) PHASE_IDS(); for (int ch = bx; ch < NCHUNK; ch += G) mixpost_chunk(a, l, lanep, wavep, ch); REP_END(4) SEAM(pb + 2); }
        if (EN(5) && IN(pb + 3)) {
            REP_BEGIN(5) PHASE_IDS();
#if I8_OUT
            pg8::Gemm g{(const pg8::bf16_t*)(a.ws + WS_Y8), (const pg8::bf16_t*)(a.ws + WS_WOUT8 + (size_t)l * D * D), T, D, D / 2}; pg8::StaticOrder S; S.init(T, D, G, bx, WGM_OUT, KROT(bx));
#if RES16_X || RES16_Z
            pg8::EpiResidS16<(RES16_X != 0), (RES16_Z != 0)> E{(void*)(a.ws + WS_Z), (RES16_X || l > 0) ? (const void*)(a.ws + WS_X) : (const void*)a.in[0], mod + (size_t)l * NB * 6 * D + 2 * D, (const float*)(a.ws + WS_SAY), (const float*)(a.ws + WS_SB) + l * SBL + NP, ALPHA};
            pg8::gemm_phase<pg8::EpiResidS16<(RES16_X != 0), (RES16_Z != 0)>, pg8::StaticOrder, true, true, true>(lds + RING_OFF, g, S, E, tidp);
#else
            pg8::EpiResidS E{(float*)(a.ws + WS_Z), l == 0 ? a.in[0] : (const float*)(a.ws + WS_X), mod + (size_t)l * NB * 6 * D + 2 * D, (const float*)(a.ws + WS_SAY), (const float*)(a.ws + WS_SB) + l * SBL + NP, ALPHA};
            pg8::gemm_phase<pg8::EpiResidS, pg8::StaticOrder, true, true, true>(lds + RING_OFF, g, S, E, tidp);
#endif
#else
            pg8::Gemm g{(const pg8::bf16_t*)(a.ws + WS_Y), (const pg8::bf16_t*)(a.ws + WS_WOUT) + (size_t)l * D * D, T, D, D}; pg8::StaticOrder S; S.init(T, D, G, bx, WGM_OUT, KROT(bx));
            pg8::EpiResid E{(float*)(a.ws + WS_Z), l == 0 ? a.in[0] : (const float*)(a.ws + WS_X), mod + (size_t)l * NB * 6 * D + 2 * D, ALPHA};
            pg8::gemm_phase<pg8::EpiResid, pg8::StaticOrder, true, true>(lds + RING_OFF, g, S, E, tidp);
#endif
            REP_END(5) SEAM(pb + 3);
        }
        if (EN(6) && IN(pb + 4)) { REP_BEGIN(6) PHASE_IDS(); for (int ch = bx; ch < NCHUNK; ch += G) ln1_chunk(a, l, lds, lanep, wavep, ch); REP_END(6) SEAM(pb + 4); }
        if (EN(7) && IN(pb + 5)) {
            REP_BEGIN(7) PHASE_IDS();
#if I8_WQ
            pg8::Gemm g{(const pg8::bf16_t*)(a.ws + WS_H28), (const pg8::bf16_t*)(a.ws + WS_WQ8 + (size_t)l * D * D), T, D, D / 2}; pg8::StaticOrder S; S.init(T, D, G, bx, WGM_WQ, KROT(bx));
            pg8::EpiBf16PS E{(pg8::bf16_t*)(a.ws + WS_Q), D, (const float*)(a.ws + WS_HSC), (const float*)(a.ws + WS_SB) + l * SBL + NP + D};
            pg8::gemm_phase<pg8::EpiBf16PS, pg8::StaticOrder, true, true, true>(lds + RING_OFF, g, S, E, tidp);
#else
            pg8::Gemm g{(const pg8::bf16_t*)(a.ws + WS_H2), (const pg8::bf16_t*)(a.ws + WS_WQ) + (size_t)l * D * D, T, D, D}; pg8::StaticOrder S; S.init(T, D, G, bx, WGM_WQ, KROT(bx));
            pg8::EpiBf16P E{(pg8::bf16_t*)(a.ws + WS_Q), D};
            pg8::gemm_phase<pg8::EpiBf16P, pg8::StaticOrder, true, true>(lds + RING_OFF, g, S, E, tidp);
#endif
            REP_END(7) SEAM(pb + 5);
        }
#ifndef PEER_DBG
#define PEER_DBG 0
#endif
#ifndef PE_REP_R
#define PE_REP_R 1
#endif
#ifndef L2PROBE
#define L2PROBE 0
#endif
        if (EN(8) && IN(pb + 6)) {
            REP_BEGIN(8)
            for (int ch = bx; ch < NCHUNK; ch += G) { for (int repr_ = 0; repr_ < PE_REP_R; ++repr_) { PHASE_IDS(); peer_retrieve(a, l, lds, lanep, wavep, ch); __syncthreads(); } __syncthreads(); { PHASE_IDS(); peer_experts(a, l, lds, lanep, wavep, ch); } __syncthreads(); }
            REP_END(8) SEAM(pb + 6);
        }
    }
#undef IN
#undef SEAM
}

extern "C" void kernel_launch(void* const* d_in, const int* in_sizes, int n_in, void* d_out, int out_size, void* d_ws, size_t ws_size, hipStream_t stream) {
    static int grid = 0;
    if (grid == 0) {
        if (n_in != 19 || in_sizes[0] != T * D || out_size != T * D || ws_size < WS_END) { fprintf(stderr, "kernel_launch: unexpected shapes / workspace (%d inputs, ws %zu); nothing launched\n", n_in, ws_size); grid = -1; return; }
        int dev = 0, cus = 0, per_cu = 0;
        if (hipGetDevice(&dev) != hipSuccess || hipDeviceGetAttribute(&cus, hipDeviceAttributeMultiprocessorCount, dev) != hipSuccess) { grid = -1; return; }
        if (hipFuncSetAttribute((const void*)mk_fwd, hipFuncAttributeMaxDynamicSharedMemorySize, LDS_BYTES) != hipSuccess) { fprintf(stderr, "kernel_launch: hipFuncSetAttribute failed\n"); grid = -1; return; }
        if (hipOccupancyMaxActiveBlocksPerMultiprocessor(&per_cu, (const void*)mk_fwd, NTHREADS, LDS_BYTES) != hipSuccess || per_cu < 1) fprintf(stderr, "kernel_launch: occupancy query reports %d\n", per_cu);
        (void)hipGetLastError();
        grid = cus;
    }
    if (grid < 0) return;
    if (hipMemsetAsync((char*)d_ws + WS_CTL, 0, CTL_ZERO_BYTES, stream) != hipSuccess) return;
    Args a{};
    for (int i = 0; i < 19; ++i) a.in[i] = (const float*)d_in[i];
    a.out = (float*)d_out; a.ws = (unsigned char*)d_ws;
#if MK_PER_PHASE
    for (int p = 0; p < NPHASES; ++p) { a.ph_lo = p; a.ph_hi = p + 1; hipLaunchKernelGGL(mk_fwd, dim3(grid), dim3(NTHREADS), LDS_BYTES, stream, a); }
#else
    a.ph_lo = 0; a.ph_hi = NPHASES;
    hipLaunchKernelGGL(mk_fwd, dim3(grid), dim3(NTHREADS), LDS_BYTES, stream, a);
#endif
}
```

```cpp
#include <hip/hip_runtime.h>
#include <cstdio>
#include <cstdint>
namespace pg8 {
#define PG8_LAS __attribute__((address_space(3)))
typedef unsigned short bf16_t;
typedef short bf16x8 __attribute__((ext_vector_type(8)));
typedef float f32x4 __attribute__((ext_vector_type(4)));
typedef unsigned u32x4 __attribute__((ext_vector_type(4)));
typedef int i32x4 __attribute__((ext_vector_type(4)));
constexpr int BM = 256, BK = 64, HALF = 128, HTB = HALF * BK * 2  , STAGE_BYTES = 8 * HTB, NXCD = 8, WGM = 8;

__host__ __device__ __forceinline__ int lds_byte(int r, int c) { const int st = (r >> 4) * 2 + (c >> 5), rr = r & 15, cc = c & 31, ob = rr * 64 + cc * 2; return st * 1024 + (ob ^ (((ob >> 9) & 1) << 5)); }
__host__ __device__ __forceinline__ void stage_rc(int b, int& R, int& C) { const int st = b / 1024, sb = b % 1024, swz = sb ^ (((sb >> 9) & 1) << 5); R = (st >> 1) * 16 + swz / 64; C = (st & 1) * 32 + (swz % 64) / 2; }
__host__ __device__ __forceinline__ int perm32(int rho) { const int n = rho >> 4, i = rho & 15; return 8 * (i >> 2) + 4 * n + (i & 3); }

struct Unit { int pm, pn; };
struct Gemm { const bf16_t* A; const bf16_t* Bt; int M, N, K; };

struct StaticOrder {
    int nM, nN, nwg, G, c, wgm, krot;
    __host__ __device__ void init(int M, int N, int G_, int c_, int wgm_ = WGM, int krot_ = 0) { nM = M / BM; nN = N / BM; nwg = nM * nN; G = G_; c = c_; wgm = wgm_; krot = krot_; }
    __host__ __device__ bool next(int i, Unit& u) const {
        const long L = (long)i * G + c; if (L >= nwg) return false;
        int wgid = (int)L; { const int q = nwg / NXCD, r = nwg % NXCD, xcd = wgid % NXCD, off = wgid / NXCD; wgid = (xcd < r ? xcd * (q + 1) : r * (q + 1) + (xcd - r) * q) + off; }
        const int nig = wgm * nN, gid = wgid / nig, fm = gid * wgm, gsz = (nM - fm) < wgm ? (nM - fm) : wgm;
        u.pm = fm + ((wgid % nig) % gsz); u.pn = (wgid % nig) / gsz; return true;
    }
    __device__ __forceinline__ void a_ready(const Unit&) const {}
    __device__ __forceinline__ void done(const Unit&) const {}
};
typedef __bf16 bf16x2_t __attribute__((ext_vector_type(2)));
__device__ __forceinline__ unsigned cvt_pk_bf16(float lo, float hi) { bf16x2_t r; r.x = (__bf16)lo; r.y = (__bf16)hi; return __builtin_bit_cast(unsigned, r); }
struct EpiBf16P {
    static constexpr bool PERM = true, AFTER_DRAIN = false;
    bf16_t* O; int ldc;
    __device__ __forceinline__ void operator()(const f32x4 (&acc)[2][2][4][2], const Unit& u, int wr, int wc, int fr, int fq) const {
        const int row0 = u.pm * BM + wr * 64 + fr, col0 = u.pn * BM + wc * 32 + 8 * fq;
#pragma unroll
        for (int ai = 0; ai < 2; ++ai)
#pragma unroll
            for (int m = 0; m < 4; ++m) { bf16_t* rowp = O + (size_t)(row0 + ai * HALF + m * 16) * ldc + col0;
#pragma unroll
                for (int bj = 0; bj < 2; ++bj) { const f32x4 v0 = acc[ai][bj][m][0], v1 = acc[ai][bj][m][1];
                    u32x4 w; w.x = cvt_pk_bf16(v0[0], v0[1]); w.y = cvt_pk_bf16(v0[2], v0[3]); w.z = cvt_pk_bf16(v1[0], v1[1]); w.w = cvt_pk_bf16(v1[2], v1[3]);
                    *(u32x4*)(rowp + bj * HALF) = w; } }
    }
};
struct EpiResid {
    static constexpr bool PERM = false, AFTER_DRAIN = false;
    float* Z; const float* X; const float* gate; float alpha;
    __device__ __forceinline__ void operator()(const f32x4 (&acc)[2][2][4][2], const Unit& u, int wr, int wc, int fr, int fq) const {
        const int row0 = u.pm * BM + wr * 64 + fr, col0 = u.pn * BM + wc * 32 + 4 * fq;
        const float* gb = gate + (size_t)(u.pm >> 3) * (6 * 2048) + col0;
        f32x4 gv[2][2];
#pragma unroll
        for (int bj = 0; bj < 2; ++bj)
#pragma unroll
            for (int n = 0; n < 2; ++n) gv[bj][n] = *(const f32x4*)(gb + bj * HALF + n * 16) + 1.0f;
#pragma unroll
        for (int ai = 0; ai < 2; ++ai)
#pragma unroll
            for (int m = 0; m < 4; ++m) { const size_t off = (size_t)(row0 + ai * HALF + m * 16) * 2048 + col0;
#pragma unroll
                for (int bj = 0; bj < 2; ++bj)
#pragma unroll
                    for (int n = 0; n < 2; ++n) { const f32x4 xv = *(const f32x4*)(X + off + bj * HALF + n * 16);
                        *(f32x4*)(Z + off + bj * HALF + n * 16) = xv * alpha + gv[bj][n] * acc[ai][bj][m][n]; }
                asm volatile("" ::: "memory"); }
    }
};
#ifndef PG8_NT
#define PG8_NT 0
#endif
#if PG8_NT
#define PG8_ST(TY, p, v) __builtin_nontemporal_store((v), (TY*)(p))
#else
#define PG8_ST(TY, p, v) (*(TY*)(p) = (v))
#endif
__device__ __forceinline__ f32x4 acc_i2f(const f32x4 v) { const i32x4 iv = __builtin_bit_cast(i32x4, v); return __builtin_convertvector(iv, f32x4); }
struct EpiBf16PS {
    static constexpr bool PERM = true, AFTER_DRAIN = false;
    bf16_t* O; int ldc; const float* sa; const float* sb;
    __device__ __forceinline__ void operator()(const f32x4 (&acc)[2][2][4][2], const Unit& u, int wr, int wc, int fr, int fq) const {
        const int row0 = u.pm * BM + wr * 64 + fr, col0 = u.pn * BM + wc * 32 + 8 * fq;
        f32x4 sbv[2][2];
#pragma unroll
        for (int bj = 0; bj < 2; ++bj)
#pragma unroll
            for (int n = 0; n < 2; ++n) sbv[bj][n] = *(const f32x4*)(sb + col0 + bj * HALF + 4 * n);
#pragma unroll
        for (int ai = 0; ai < 2; ++ai)
#pragma unroll
            for (int m = 0; m < 4; ++m) { const int row = row0 + ai * HALF + m * 16; bf16_t* rowp = O + (size_t)row * ldc + col0; const float sar = sa[row];
#pragma unroll
                for (int bj = 0; bj < 2; ++bj) { const f32x4 v0 = acc_i2f(acc[ai][bj][m][0]) * (sbv[bj][0] * sar), v1 = acc_i2f(acc[ai][bj][m][1]) * (sbv[bj][1] * sar);
                    u32x4 w; w.x = cvt_pk_bf16(v0[0], v0[1]); w.y = cvt_pk_bf16(v0[2], v0[3]); w.z = cvt_pk_bf16(v1[0], v1[1]); w.w = cvt_pk_bf16(v1[2], v1[3]);
                    PG8_ST(u32x4, rowp + bj * HALF, w); } }
    }
};
struct EpiResidS {
    static constexpr bool PERM = false, AFTER_DRAIN = false;
    float* Z; const float* X; const float* gate; const float* sa; const float* sb; float alpha;
    __device__ __forceinline__ void operator()(const f32x4 (&acc)[2][2][4][2], const Unit& u, int wr, int wc, int fr, int fq) const {
        const int row0 = u.pm * BM + wr * 64 + fr, col0 = u.pn * BM + wc * 32 + 4 * fq;
        const float* gb = gate + (size_t)(u.pm >> 3) * (6 * 2048) + col0;
        f32x4 gv[2][2];
#pragma unroll
        for (int bj = 0; bj < 2; ++bj)
#pragma unroll
            for (int n = 0; n < 2; ++n) gv[bj][n] = (*(const f32x4*)(gb + bj * HALF + n * 16) + 1.0f) * *(const f32x4*)(sb + col0 + bj * HALF + n * 16);
#pragma unroll
        for (int ai = 0; ai < 2; ++ai)
#pragma unroll
            for (int m = 0; m < 4; ++m) { const int row = row0 + ai * HALF + m * 16; const size_t off = (size_t)row * 2048 + col0; const float sar = sa[row];
#pragma unroll
                for (int bj = 0; bj < 2; ++bj)
#pragma unroll
                    for (int n = 0; n < 2; ++n) { const f32x4 xv = *(const f32x4*)(X + off + bj * HALF + n * 16);
                        PG8_ST(f32x4, Z + off + bj * HALF + n * 16, xv * alpha + (gv[bj][n] * sar) * acc_i2f(acc[ai][bj][m][n])); }
                asm volatile("" ::: "memory"); }
    }
};
template <bool XB, bool ZB> struct EpiResidS16 {
    static constexpr bool PERM = true, AFTER_DRAIN = false;
    void* Z; const void* X; const float* gate; const float* sa; const float* sb; float alpha;
    __device__ __forceinline__ void operator()(const f32x4 (&acc)[2][2][4][2], const Unit& u, int wr, int wc, int fr, int fq) const {
        const int row0 = u.pm * BM + wr * 64 + fr, col0 = u.pn * BM + wc * 32 + 8 * fq;
        const float* gb = gate + (size_t)(u.pm >> 3) * (6 * 2048) + col0;
        f32x4 gv[2][2];
#pragma unroll
        for (int bj = 0; bj < 2; ++bj)
#pragma unroll
            for (int n = 0; n < 2; ++n) gv[bj][n] = (*(const f32x4*)(gb + bj * HALF + 4 * n) + 1.0f) * *(const f32x4*)(sb + col0 + bj * HALF + 4 * n);
#pragma unroll
        for (int ai = 0; ai < 2; ++ai)
#pragma unroll
            for (int m = 0; m < 4; ++m) { const int row = row0 + ai * HALF + m * 16; const size_t off = (size_t)row * 2048 + col0; const float sar = sa[row];
#pragma unroll
                for (int bj = 0; bj < 2; ++bj) { f32x4 x0, x1;
                    if constexpr (XB) { const u32x4 xw = *(const u32x4*)((const bf16_t*)X + off + bj * HALF);
                        x0 = (f32x4){__uint_as_float(xw.x << 16), __uint_as_float(xw.x & 0xffff0000u), __uint_as_float(xw.y << 16), __uint_as_float(xw.y & 0xffff0000u)};
                        x1 = (f32x4){__uint_as_float(xw.z << 16), __uint_as_float(xw.z & 0xffff0000u), __uint_as_float(xw.w << 16), __uint_as_float(xw.w & 0xffff0000u)}; }
                    else { x0 = *(const f32x4*)((const float*)X + off + bj * HALF); x1 = *(const f32x4*)((const float*)X + off + bj * HALF + 4); }
                    const f32x4 v0 = x0 * alpha + (gv[bj][0] * sar) * acc_i2f(acc[ai][bj][m][0]), v1 = x1 * alpha + (gv[bj][1] * sar) * acc_i2f(acc[ai][bj][m][1]);
                    if constexpr (ZB) { u32x4 w; w.x = cvt_pk_bf16(v0[0], v0[1]); w.y = cvt_pk_bf16(v0[2], v0[3]); w.z = cvt_pk_bf16(v1[0], v1[1]); w.w = cvt_pk_bf16(v1[2], v1[3]);
                        PG8_ST(u32x4, (bf16_t*)Z + off + bj * HALF, w); }
                    else { PG8_ST(f32x4, (float*)Z + off + bj * HALF, v0); PG8_ST(f32x4, (float*)Z + off + bj * HALF + 4, v1); } }
                asm volatile("" ::: "memory"); }
    }
};
template <class Epi, class Sched, bool ALIGN_EPI = false, bool SP2 = false, bool I8 = false>
__device__ __forceinline__ void gemm_phase(PG8_LAS unsigned char* lds, const Gemm g, const Sched& S, const Epi& E, const int tid_in) {
    const int tid = tid_in, wid = __builtin_amdgcn_readfirstlane(tid >> 6), lane = tid & 63, wr = wid >> 2, wc = wid & 3, fr = lane & 15, fq = lane >> 4;
    const int K = g.K, nt = K / BK;
    const int krot = ((nt & (nt - 1)) == 0) ? (S.krot & (nt - 1)) : 0;
#define PG8_KOFS(t) ((size_t)(((t) + krot) & (nt - 1)) * kstep)
    unsigned voffA[2], voffB[2];
#pragma unroll
    for (int i = 0; i < 2; ++i) { int R, C; stage_rc(tid * 16 + i * 8192, R, C); const int Rb = Epi::PERM ? ((R & ~31) + perm32(R & 31)) : R;
        voffA[i] = (unsigned)(R * K + C) * 2u; voffB[i] = (unsigned)(Rb * K + C) * 2u; }
    const size_t kstep = (size_t)(BK * 2);
    const size_t hstep = (size_t)HALF * K * 2;
    const size_t tstep = 2 * hstep;
    const unsigned ldsw = (unsigned)wid * 1024u;
    const int aoff = lds_byte(wr * 64 + fr, fq * 8), boff = lds_byte(wc * 32 + fr, fq * 8);
#define PG8_SA(b, h) (((b) * 2 + (h)) * HTB)
#define PG8_SB(b, h) ((4 + (b) * 2 + (h)) * HTB)
#define PG8_STAGE(bufoff, gbase, voff) do { _Pragma("unroll") for (int _i = 0; _i < 2; ++_i) \
        __builtin_amdgcn_global_load_lds((const unsigned*)((const char*)(gbase) + (voff)[_i]), (PG8_LAS unsigned*)(lds + (bufoff) + ldsw + _i * 8192), 16, 0, 0); } while (0)
#define PG8_LDA(dst, b, h) do { _Pragma("unroll") for (int m = 0; m < 4; ++m) _Pragma("unroll") for (int k = 0; k < 2; ++k) dst[m][k] = *(const PG8_LAS bf16x8*)(lds + PG8_SA(b, h) + aoff + m * 2048 + k * 1024); } while (0)
#define PG8_LDB(dst, b, h) do { _Pragma("unroll") for (int n = 0; n < 2; ++n) _Pragma("unroll") for (int k = 0; k < 2; ++k) dst[n][k] = *(const PG8_LAS bf16x8*)(lds + PG8_SB(b, h) + boff + n * 2048 + k * 1024); } while (0)
#define PG8_MMA(ai, bj, At, Bt) do { __builtin_amdgcn_s_setprio(1); _Pragma("unroll") for (int m = 0; m < 4; ++m) _Pragma("unroll") for (int n = 0; n < 2; ++n) _Pragma("unroll") for (int k = 0; k < 2; ++k) \
        { if constexpr (I8) acc[ai][bj][m][n] = __builtin_bit_cast(f32x4, __builtin_amdgcn_mfma_i32_16x16x64_i8(__builtin_bit_cast(i32x4, Bt[n][k]), __builtin_bit_cast(i32x4, At[m][k]), __builtin_bit_cast(i32x4, acc[ai][bj][m][n]), 0, 0, 0)); \
          else acc[ai][bj][m][n] = __builtin_amdgcn_mfma_f32_16x16x32_bf16(Bt[n][k], At[m][k], acc[ai][bj][m][n], 0, 0, 0); } __builtin_amdgcn_s_setprio(0); } while (0)
#define PG8_WAIT_V(n) asm volatile("s_waitcnt vmcnt(" #n ")" ::: "memory")
#define PG8_WAIT_L(n) asm volatile("s_waitcnt lgkmcnt(" #n ")" ::: "memory")
#define PG8_BAR __builtin_amdgcn_s_barrier()
#define PG8_SCHED __builtin_amdgcn_sched_barrier(0)
    Unit cur, nxt; int ui = 0;
    if (!S.next(0, cur)) return;
    f32x4 acc[2][2][4][2];
#pragma unroll
    for (int a = 0; a < 2; ++a)
#pragma unroll
        for (int b = 0; b < 2; ++b)
#pragma unroll
            for (int m = 0; m < 4; ++m)
#pragma unroll
                for (int n = 0; n < 2; ++n) acc[a][b][m][n] = (f32x4){0.f, 0.f, 0.f, 0.f};
    bf16x8 At[4][2], B0[2][2], B1[2][2];
    const char* cA = (const char*)g.A + (size_t)cur.pm * tstep; const char* cB = (const char*)g.Bt + (size_t)cur.pn * tstep;
    S.a_ready(cur);
    if constexpr (SP2) {
        PG8_STAGE(PG8_SB(0, 0), cB + PG8_KOFS(0), voffB); PG8_STAGE(PG8_SB(0, 1), cB + hstep + PG8_KOFS(0), voffB); PG8_STAGE(PG8_SA(0, 0), cA + PG8_KOFS(0), voffA); PG8_STAGE(PG8_SA(0, 1), cA + hstep + PG8_KOFS(0), voffA);
        if (wr == 1) PG8_BAR;
        PG8_WAIT_V(2); PG8_BAR;
        PG8_STAGE(PG8_SB(1, 0), cB + PG8_KOFS(1), voffB); PG8_STAGE(PG8_SA(1, 0), cA + PG8_KOFS(1), voffA); PG8_STAGE(PG8_SB(1, 1), cB + hstep + PG8_KOFS(1), voffB);
        PG8_WAIT_V(6); PG8_BAR;
    } else {
        PG8_STAGE(PG8_SB(0, 0), cB + PG8_KOFS(0), voffB); PG8_STAGE(PG8_SA(0, 0), cA + PG8_KOFS(0), voffA); PG8_STAGE(PG8_SB(0, 1), cB + hstep + PG8_KOFS(0), voffB); PG8_STAGE(PG8_SA(0, 1), cA + hstep + PG8_KOFS(0), voffA);
        if (wr == 1) PG8_BAR;
        PG8_WAIT_V(4); PG8_BAR;
        PG8_STAGE(PG8_SB(1, 0), cB + PG8_KOFS(1), voffB); PG8_STAGE(PG8_SA(1, 0), cA + PG8_KOFS(1), voffA); PG8_STAGE(PG8_SB(1, 1), cB + hstep + PG8_KOFS(1), voffB);
        PG8_WAIT_V(6); PG8_BAR;
    }
    for (;;) {
        const bool has_next = S.next(ui + 1, nxt);
        const char* nA = has_next ? (const char*)g.A + (size_t)nxt.pm * tstep : cA; const char* nB = has_next ? (const char*)g.Bt + (size_t)nxt.pn * tstep : cB;
#ifdef PG8_KREP
        for (int kr_ = 0; kr_ < PG8_KREP; ++kr_) {
        if (kr_) {
#pragma unroll
        for (int a = 0; a < 2; ++a)
#pragma unroll
            for (int b = 0; b < 2; ++b)
#pragma unroll
                for (int m = 0; m < 4; ++m)
#pragma unroll
                    for (int n = 0; n < 2; ++n) acc[a][b][m][n] = (f32x4){0.f, 0.f, 0.f, 0.f}; }
        const char* nA_ = (kr_ + 1 < PG8_KREP) ? cA : nA; const char* nB_ = (kr_ + 1 < PG8_KREP) ? cB : nB;
#else
        const char* nA_ = nA; const char* nB_ = nB;
#endif
        for (int t = 0; t < nt; t += 2) {
            const bool last = (t == nt - 2);
            const char* a1 = cA + PG8_KOFS(t + 1);
            const char* a2 = (last ? nA_ : cA) + PG8_KOFS(t + 2); const char* b2 = (last ? nB_ : cB) + PG8_KOFS(t + 2);
            const char* a3 = (last ? nA_ : cA) + PG8_KOFS(t + 3); const char* b3 = (last ? nB_ : cB) + PG8_KOFS(t + 3);
            if (last && has_next) S.a_ready(nxt);
            if constexpr (SP2) {
            PG8_LDB(B0, 0, 0); PG8_LDB(B1, 0, 1); PG8_SCHED; PG8_LDA(At, 0, 0); PG8_STAGE(PG8_SA(1, 1), a1 + hstep, voffA);
            PG8_WAIT_V(8); PG8_WAIT_L(0); PG8_BAR; PG8_MMA(0, 0, At, B0); PG8_MMA(0, 1, At, B1); PG8_BAR; PG8_SCHED;
            PG8_LDA(At, 0, 1); PG8_STAGE(PG8_SB(0, 0), b2, voffB); PG8_STAGE(PG8_SB(0, 1), b2 + hstep, voffB); PG8_STAGE(PG8_SA(0, 0), a2, voffA);
            PG8_WAIT_V(8); PG8_WAIT_L(0); PG8_BAR; PG8_MMA(1, 0, At, B0); PG8_MMA(1, 1, At, B1); PG8_BAR; PG8_SCHED;
            PG8_LDB(B0, 1, 0); PG8_LDB(B1, 1, 1); PG8_SCHED; PG8_LDA(At, 1, 0); PG8_STAGE(PG8_SA(0, 1), a2 + hstep, voffA);
            PG8_WAIT_V(8); PG8_WAIT_L(0); PG8_BAR; PG8_MMA(0, 0, At, B0); PG8_MMA(0, 1, At, B1); PG8_BAR; PG8_SCHED;
            PG8_LDA(At, 1, 1); PG8_STAGE(PG8_SB(1, 0), b3, voffB); PG8_STAGE(PG8_SB(1, 1), b3 + hstep, voffB); PG8_STAGE(PG8_SA(1, 0), a3, voffA);
            PG8_WAIT_V(8); PG8_WAIT_L(0); PG8_BAR; PG8_MMA(1, 0, At, B0); PG8_MMA(1, 1, At, B1); PG8_BAR; PG8_SCHED;
            } else {
            PG8_LDB(B0, 0, 0); PG8_SCHED; PG8_LDA(At, 0, 0); PG8_STAGE(PG8_SA(1, 1), a1 + hstep, voffA);
            PG8_WAIT_L(8); PG8_BAR; PG8_WAIT_L(0); PG8_MMA(0, 0, At, B0); PG8_BAR; PG8_SCHED;
            PG8_LDB(B1, 0, 1); PG8_STAGE(PG8_SB(0, 0), b2, voffB);
            PG8_BAR; PG8_WAIT_L(0); PG8_MMA(0, 1, At, B1); PG8_BAR;
            PG8_LDA(At, 0, 1); PG8_STAGE(PG8_SA(0, 0), a2, voffA);
            PG8_BAR; PG8_WAIT_L(0); PG8_MMA(1, 0, At, B0); PG8_BAR; PG8_SCHED;
            PG8_STAGE(PG8_SB(0, 1), b2 + hstep, voffB);
            PG8_WAIT_V(6); PG8_BAR; PG8_MMA(1, 1, At, B1); PG8_BAR;
            PG8_LDB(B0, 1, 0); PG8_SCHED; PG8_LDA(At, 1, 0); PG8_STAGE(PG8_SA(0, 1), a2 + hstep, voffA);
            PG8_WAIT_L(8); PG8_BAR; PG8_WAIT_L(0); PG8_MMA(0, 0, At, B0); PG8_BAR; PG8_SCHED;
            PG8_LDB(B1, 1, 1); PG8_STAGE(PG8_SB(1, 0), b3, voffB);
            PG8_BAR; PG8_WAIT_L(0); PG8_MMA(0, 1, At, B1); PG8_BAR;
            PG8_LDA(At, 1, 1); PG8_STAGE(PG8_SA(1, 0), a3, voffA);
            PG8_BAR; PG8_WAIT_L(0); PG8_MMA(1, 0, At, B0); PG8_BAR; PG8_SCHED;
            PG8_STAGE(PG8_SB(1, 1), b3 + hstep, voffB);
            PG8_WAIT_V(6); PG8_BAR; PG8_MMA(1, 1, At, B1); PG8_BAR;
            }
        }
#ifdef PG8_KREP
        }
#endif
        if constexpr (ALIGN_EPI) { if (wr == 0) PG8_BAR; }
#ifdef PG8_EPI2
        if constexpr (!Epi::AFTER_DRAIN) { E(acc, cur, wr, wc, fr, fq); asm volatile("" ::: "memory"); }
#endif
        if constexpr (!Epi::AFTER_DRAIN) { E(acc, cur, wr, wc, fr, fq); S.done(cur); }
        if (!has_next) break;
#pragma unroll
        for (int a = 0; a < 2; ++a)
#pragma unroll
            for (int b = 0; b < 2; ++b)
#pragma unroll
                for (int m = 0; m < 4; ++m)
#pragma unroll
                    for (int n = 0; n < 2; ++n) acc[a][b][m][n] = (f32x4){0.f, 0.f, 0.f, 0.f};
        cur = nxt; cA = nA; cB = nB; ++ui;
        if constexpr (ALIGN_EPI) { if (wr == 1) PG8_BAR; }
    }
    PG8_WAIT_V(0);
    if constexpr (!ALIGN_EPI) { if (wr == 0) PG8_BAR; }
    PG8_BAR;
    if constexpr (Epi::AFTER_DRAIN) { E.fused(acc, cur, wr, wc, fr, fq, lds, wid, lane); S.done(cur); }
#undef PG8_SA
#undef PG8_SB
#undef PG8_STAGE
#undef PG8_LDA
#undef PG8_LDB
#undef PG8_MMA
#undef PG8_WAIT_V
#undef PG8_WAIT_L
#undef PG8_BAR
#undef PG8_SCHED
#undef PG8_KOFS
}
}
#define XB_TMO      128
#define XB_XCNT(j)  (256  + 64 * (j))
#define XB_XSUB(j)  (1280 + 64 * (j))
#define XB_XGEN(j)  (2304 + 64 * (j))
#define XB_TOP      3328
#define XB_TOPGEN   3392
#define XCD_BAR_WORDS 3456
#define XB_SPIN_CAP (1u << 18)
#define LAS __attribute__((address_space(3)))

__device__ __forceinline__ unsigned xb_ld(unsigned* p)              { return __hip_atomic_load(p, __ATOMIC_RELAXED, __HIP_MEMORY_SCOPE_AGENT); }
__device__ __forceinline__ unsigned xb_add(unsigned* p, unsigned v) { return __hip_atomic_fetch_add(p, v, __ATOMIC_RELAXED, __HIP_MEMORY_SCOPE_AGENT); }
__device__ __forceinline__ unsigned xb_xcc_id() { return (unsigned)__builtin_amdgcn_s_getreg((3 << 11) | 20) & 0xFu; }
#define XB_SPIN(cond, bar) do { unsigned _sp = 0; while (cond) { __builtin_amdgcn_s_sleep(1); \
    if ((++_sp & 255u) == 0u) { if (xb_ld(&(bar)[XB_TMO])) break; if (_sp > XB_SPIN_CAP) { atomicAdd(&(bar)[XB_TMO], 1u); break; } } } } while (0)

struct XcdBarrier {
    unsigned* bar; unsigned x;
    volatile LAS unsigned* st;
};

__device__ __forceinline__ XcdBarrier xcd_barrier_post(unsigned* bar, volatile LAS unsigned* st) {
    XcdBarrier b; b.bar = bar; b.x = xb_xcc_id(); b.st = st;
    if (threadIdx.x == 0) (void)xb_add(&bar[XB_XCNT(b.x)], 1u);
    return b;
}
__device__ __forceinline__ void xcd_barrier_complete(unsigned* bar, unsigned x, unsigned& nloc, unsigned& nx) {
    const unsigned G = gridDim.x * gridDim.y * gridDim.z;
    unsigned sum, cnt, mine, sp = 0u;
    for (;;) {
        sum = 0u; cnt = 0u; mine = 0u;
#pragma unroll
        for (unsigned j = 0; j < 16; ++j) { const unsigned c = xb_ld(&bar[XB_XCNT(j)]); sum += c; cnt += (c > 0u) ? 1u : 0u; mine = (j == x) ? c : mine; }
        if (sum == G) break;
        __builtin_amdgcn_s_sleep(1);
        if ((++sp & 255u) == 0u) { if (xb_ld(&bar[XB_TMO])) break; if (sp > XB_SPIN_CAP) { atomicAdd(&bar[XB_TMO], 1u); break; } }
    }
    nloc = mine > 0u ? mine : 1u; nx = cnt > 0u ? cnt : 1u;
}

__device__ __forceinline__ void xcd_barrier(const XcdBarrier& b) {
    asm volatile("s_waitcnt vmcnt(0)" ::: "memory");
    __syncthreads();
    if (threadIdx.x == 0) {
        unsigned* bar = b.bar;
        __builtin_amdgcn_s_waitcnt(0);
        unsigned nloc = b.st[0], nx = b.st[1];
        if (nloc == 0u) { xcd_barrier_complete(bar, b.x, nloc, nx); b.st[0] = nloc; b.st[1] = nx; }
        const unsigned old = xb_add(&bar[XB_XSUB(b.x)], 1u);
        const unsigned gen = old / nloc;
        if (old + 1u == (gen + 1u) * nloc) {
            __builtin_amdgcn_fence(__ATOMIC_RELEASE, "agent");
            asm volatile("s_waitcnt vmcnt(0)" ::: "memory");
            const unsigned og = xb_add(&bar[XB_TOP], 1u);
            const unsigned tg = og / nx;
            if (og + 1u == (tg + 1u) * nx) xb_add(&bar[XB_TOPGEN], 1u);
            else XB_SPIN(xb_ld(&bar[XB_TOPGEN]) == tg, bar);
            __builtin_amdgcn_fence(__ATOMIC_ACQUIRE, "agent");
            xb_add(&bar[XB_XGEN(b.x)], 1u);
            asm volatile("s_waitcnt vmcnt(0)" ::: "memory");
        } else {
            XB_SPIN(xb_ld(&bar[XB_XGEN(b.x)]) == gen, bar);
            __builtin_amdgcn_fence(__ATOMIC_ACQUIRE, "agent");
            asm volatile("s_waitcnt vmcnt(0)" ::: "memory");
        }
    }
    __syncthreads();
}
constexpr int D = 2048, NB = 8, SEQ = 2048, NL = 4, T = NB * SEQ;
constexpr int NCH = SEQ / 64, NCHUNK = T / 64;
constexpr int GKW = 512, RANK = 16;
constexpr int INW = 6160, NP = 6144;
constexpr int NE = 16384;
constexpr float ALPHA = 1.6817928305074290f, EPS = 1e-5f;
constexpr int PQ = 0, PK = 512, PV = 1024, PR = 2048, PCB = 3072, PCC = 4096, PCH = 5120;
constexpr int NWAVES = 8, NTHREADS = 512;
#ifndef WGM_IN
#define WGM_IN 4
#endif
#ifndef WGM_OUT
#define WGM_OUT 4
#endif
#ifndef WGM_WQ
#define WGM_WQ 4
#endif
#ifndef TAB4
#define TAB4 1
#endif
constexpr int NPHASES = 2 + 7 * NL;

constexpr size_t MiB = 1u << 20;
constexpr size_t WS_CTL = 0, CTL_ZERO_BYTES = 1 * MiB;
constexpr size_t WS_MOD = 1 * MiB, WS_PART = 3 * MiB, WS_KEYS = 15 * MiB, WS_DTOT = 17 * MiB, WS_WIN = 18 * MiB, WS_WOUT = 115 * MiB, WS_WQ = 147 * MiB;
constexpr size_t WS_UT = 179 * MiB, WS_VT = 435 * MiB, WS_H = 691 * MiB, WS_PROJ = 755 * MiB, WS_E = 947 * MiB, WS_OGLA = 979 * MiB, WS_Y = 1043 * MiB;
constexpr size_t WS_Z = 1107 * MiB, WS_X1 = 1235 * MiB, WS_X = 1363 * MiB, WS_Q = 1491 * MiB, WS_H2 = 1555 * MiB, WS_HQ8 = 1619 * MiB, WS_H8 = 1659 * MiB, WS_WIN8 = 1691 * MiB, WS_WOUT8 = 1739 * MiB, WS_WQ8 = 1755 * MiB, WS_Y8 = 1771 * MiB, WS_H28 = 1803 * MiB, WS_END = 1835 * MiB;
constexpr size_t WS_SU = 17 * MiB + 512 * 1024, WS_SV = 17 * MiB + 768 * 1024, WS_HSC = 2 * MiB + 640 * 1024;
static_assert(WS_WIN + (size_t)NL * INW * D * 2 <= WS_WOUT && WS_PART + (size_t)NL * 8 * NB * 6 * D * 4 <= WS_KEYS && WS_MOD + (size_t)NL * NB * 6 * D * 4 <= WS_PART, "ws map");
constexpr size_t WS_SAH = WS_SU, WS_SAY = WS_SU + 65536, WS_SB = WS_SV; constexpr int SBL = NP + 2 * D;
constexpr size_t WS_SBA = WS_SB + (size_t)NL * SBL * 4, WS_ALR8 = WS_SU + 131072;
#ifndef KROT_A
#define KROT_A 0
#endif
#ifndef KROT_B
#define KROT_B 0
#endif
#define KROT(c) (KROT_A * (((c) >> 3) & 3) + KROT_B * ((c) >> 5))
#ifndef RES16
#define RES16 1
#endif
#ifndef RES16_X
#define RES16_X RES16
#endif
#ifndef RES16_Z
#define RES16_Z RES16
#endif
#ifndef RES16_X1
#define RES16_X1 RES16
#endif
#ifndef I8_GATE
#define I8_GATE 1
#endif
#ifndef I8_WQ
#define I8_WQ 1
#endif
#ifndef I8_IN
#define I8_IN 1
#endif
#ifndef I8_OUT
#define I8_OUT 1
#endif
constexpr int CW_BAR = 4096;

constexpr int RING_OFF = 0, RING_BYTES = 131072, LDSCTL_OFF = RING_BYTES, LDS_BYTES = 147456;

#define GAS __attribute__((address_space(1)))
typedef unsigned short bf16;
typedef unsigned v4u __attribute__((ext_vector_type(4)));
typedef unsigned v2u __attribute__((ext_vector_type(2)));
typedef int v4i __attribute__((ext_vector_type(4)));
typedef float f32x4 __attribute__((ext_vector_type(4)));
typedef float f32x16 __attribute__((ext_vector_type(16)));
typedef short bf16x8 __attribute__((ext_vector_type(8)));
typedef __bf16 bf16x2v __attribute__((ext_vector_type(2)));
#define LDS_WAIT() asm volatile("s_waitcnt lgkmcnt(0)" ::: "memory")

__device__ __forceinline__ unsigned pk2(float lo, float hi) { return pg8::cvt_pk_bf16(lo, hi); }
__device__ __forceinline__ float dot2bf(unsigned w, unsigned x, float acc) { return __builtin_amdgcn_fdot2_f32_bf16(__builtin_bit_cast(bf16x2v, w), __builtin_bit_cast(bf16x2v, x), acc, false); }
__device__ __forceinline__ float bflo(unsigned u) { return __uint_as_float(u << 16); }
__device__ __forceinline__ float bfhi(unsigned u) { return __uint_as_float(u & 0xffff0000u); }
__device__ __forceinline__ float silu_f(float x) { return x / (1.0f + __expf(-x)); }
__device__ __forceinline__ float logsigmoid_f(float x) { return fminf(x, 0.0f) - log1pf(__expf(-fabsf(x))); }
__device__ __forceinline__ float gelu_tanh_f(float x) { const float u = 0.7978845608028654f * (x + 0.044715f * x * x * x); return 0.5f * x * (1.0f + tanhf(u)); }
__device__ __forceinline__ unsigned pack_i8(float a, float b, float c, float d) {
    const int q0 = (int)__builtin_rintf(a), q1 = (int)__builtin_rintf(b), q2 = (int)__builtin_rintf(c), q3 = (int)__builtin_rintf(d);
    return (unsigned)(q0 & 255) | ((unsigned)(q1 & 255) << 8) | ((unsigned)(q2 & 255) << 16) | ((unsigned)(q3 & 255) << 24); }
__device__ __forceinline__ float wave_sum(float v) {
#pragma unroll
    for (int o = 1; o < 64; o <<= 1) v += __shfl_xor(v, o);
    return v;
}

struct Args { const float* in[19]; float* out; unsigned char* ws; int ph_lo, ph_hi; };

__device__ __forceinline__ void transpose_item(const float* W, int ldw, int col0, bf16* WTrows, int k0, int nvalid, LAS float* scr, int lane) {
    const int n = lane & 31;
    float tv[32];
#pragma unroll
    for (int i = 0; i < 32; ++i) { const int kk = 2 * i + (lane >> 5); tv[i] = (n < nvalid) ? W[(size_t)(k0 + kk) * ldw + col0 + n] : 0.f; }
#pragma unroll
    for (int i = 0; i < 32; ++i) { const int kk = 2 * i + (lane >> 5); scr[kk * 33 + n] = tv[i]; }
    LDS_WAIT(); asm volatile("" ::: "memory");
    const int c = lane & 7;
#pragma unroll
    for (int j = 0; j < 4; ++j) { const int nn = (lane >> 3) + 8 * j; const LAS float* s = scr + (8 * c) * 33 + nn;
        v4u o; o.x = pk2(s[0 * 33], s[1 * 33]); o.y = pk2(s[2 * 33], s[3 * 33]); o.z = pk2(s[4 * 33], s[5 * 33]); o.w = pk2(s[6 * 33], s[7 * 33]);
        if (nn < nvalid) *(v4u*)(WTrows + (size_t)nn * D + k0 + 8 * c) = o; }
    LDS_WAIT(); asm volatile("" ::: "memory");
}
__device__ __forceinline__ void cvt_stream(const float* src, bf16* dst, size_t n4, size_t i0, size_t stride) {
    for (size_t i = i0; i < n4; i += stride) { const f32x4 v = ((const f32x4*)src)[i]; v2u o; o.x = pk2(v.x, v.y); o.y = pk2(v.z, v.w); ((v2u*)dst)[i] = o; }
}
__device__ __forceinline__ void ph_prologue_a(const Args& a, LAS unsigned char* lds, int tid, int lane, int wave, int bx, int G) {
    const int gw = bx * NWAVES + wave, NGW = G * NWAVES;
    LAS float* cact = (LAS float*)lds;
    for (int i = tid; i < NB * D; i += NTHREADS) { const int b = i / D, d = i % D; cact[d * 8 + b] = silu_f(a.in[1][i]); }
    __syncthreads();
    float* part = (float*)(a.ws + WS_PART);
    for (int it = gw; it < NL * 8 * 48; it += NGW) {
        const int cg = it % 48, dr = (it / 48) % 8, l = it / 384;
        f32x4 acc[8];
#pragma unroll
        for (int b = 0; b < 8; ++b) acc[b] = (f32x4){0.f, 0.f, 0.f, 0.f};
        const float* w = a.in[2] + ((size_t)l * D + dr * 256) * (6 * D) + cg * 256 + lane * 4;
#pragma unroll 4
        for (int d = 0; d < 256; ++d) {
            const f32x4 wv = *(const f32x4*)(w + (size_t)d * (6 * D));
            const f32x4 c0 = *(const LAS f32x4*)(cact + (dr * 256 + d) * 8), c1 = *(const LAS f32x4*)(cact + (dr * 256 + d) * 8 + 4);
            acc[0] += wv * c0.x; acc[1] += wv * c0.y; acc[2] += wv * c0.z; acc[3] += wv * c0.w;
            acc[4] += wv * c1.x; acc[5] += wv * c1.y; acc[6] += wv * c1.z; acc[7] += wv * c1.w;
        }
#pragma unroll
        for (int b = 0; b < 8; ++b) *(f32x4*)(part + (((size_t)l * 8 + dr) * NB + b) * (6 * D) + cg * 256 + lane * 4) = acc[b];
    }
    __syncthreads();
    LAS float* scr = (LAS float*)(lds + wave * 8448);
    bf16* winT = (bf16*)(a.ws + WS_WIN); bf16* woutT = (bf16*)(a.ws + WS_WOUT); bf16* wqT = (bf16*)(a.ws + WS_WQ);
    constexpr int IPL = 6144 + 32 + 2048 + 2048;
    for (int it = gw; it < NL * IPL; it += NGW) {
        const int l = it / IPL; int r = it % IPL;
        if (r < 6144) { const int nb = r % 192, kb = r / 192, n0 = nb * 32;
            transpose_item(a.in[4] + (size_t)l * D * INW, INW, n0 < 3072 ? n0 : n0 + 16, winT + ((size_t)l * INW + n0) * D, kb * 64, 32, scr, lane); continue; }
        r -= 6144;
        if (r < 32) { transpose_item(a.in[4] + (size_t)l * D * INW, INW, 3072, winT + ((size_t)l * INW + NP) * D, r * 64, 16, scr, lane); continue; }
        r -= 32;
        if (r < 2048) { const int nb = r % 64, kb = r / 64; transpose_item(a.in[10] + (size_t)l * D * D, D, nb * 32, woutT + ((size_t)l * D + nb * 32) * D, kb * 64, 32, scr, lane); continue; }
        r -= 2048;
        { const int nb = r % 64, kb = r / 64; transpose_item(a.in[13] + (size_t)l * D * D, D, nb * 32, wqT + ((size_t)l * D + nb * 32) * D, kb * 64, 32, scr, lane); }
    }
    const size_t i0 = (size_t)bx * NTHREADS + tid, stride = (size_t)G * NTHREADS;
    cvt_stream(a.in[14], (bf16*)(a.ws + WS_KEYS), (size_t)NL * 8 * 2 * 128 * 128 / 4, i0, stride);
#if TAB4
    __syncthreads();
    { LAS float* rowst = (LAS float*)(lds + wave * 8192);
      f32x4 vnx[8];
      if (gw < 2 * NL * NE) { const int tbl0 = gw / (NL * NE), r0 = gw % (NL * NE); const float* s0 = (tbl0 ? a.in[16] : a.in[15]) + (size_t)r0 * D;
#pragma unroll
          for (int c8 = 0; c8 < 8; ++c8) vnx[c8] = *(const f32x4*)(s0 + (c8 * 64 + lane) * 4); }
      for (int row = gw; row < 2 * NL * NE; row += NGW) {
        const int tbl = row / (NL * NE), r = row % (NL * NE);
#pragma unroll
        for (int c8 = 0; c8 < 8; ++c8) *(LAS f32x4*)(rowst + (c8 * 64 + lane) * 4) = vnx[c8];
        { const int rown = row + NGW < 2 * NL * NE ? row + NGW : row; const int tbln = rown / (NL * NE), rn = rown % (NL * NE); const float* sn = (tbln ? a.in[16] : a.in[15]) + (size_t)rn * D;
#pragma unroll
          for (int c8 = 0; c8 < 8; ++c8) vnx[c8] = *(const f32x4*)(sn + (c8 * 64 + lane) * 4); }
        LDS_WAIT(); asm volatile("" ::: "memory");
        unsigned char* tb = a.ws + (tbl ? WS_VT : WS_UT) + (size_t)r * 1152;
#pragma unroll
        for (int pass = 0; pass < 2; ++pass) { const int slot = lane + 64 * pass;
            if (slot < 72) { const int col0 = (slot >> 3) * 240 + (slot & 7) * 30;
                float x[30]; float mx = 0.f;
#pragma unroll
                for (int k = 0; k < 30; ++k) { x[k] = (col0 + k < D) ? rowst[col0 + k] : 0.f; mx = fmaxf(mx, fabsf(x[k])); }
                int code = 0; float inv = 0.f;
                if (mx > 0.f) { code = (int)ceilf(8.0f * log2f(mx * (1.0f / 7.0f))) + 128; code = code < 0 ? 0 : (code > 255 ? 255 : code); inv = __builtin_amdgcn_exp2f(16.0f - (float)code * 0.125f); }
                unsigned dw[4] = {0u, 0u, 0u, 0u};
#pragma unroll
                for (int kb = 0; kb < 15; ++kb) { int a0 = (int)__builtin_rintf(x[2 * kb] * inv), a1 = (int)__builtin_rintf(x[2 * kb + 1] * inv);
                    a0 = a0 < -7 ? -7 : (a0 > 7 ? 7 : a0); a1 = a1 < -7 ? -7 : (a1 > 7 ? 7 : a1);
                    dw[kb >> 2] |= ((unsigned)(a0 + 8) | ((unsigned)(a1 + 8) << 4)) << (8 * (kb & 3)); }
                dw[3] |= (unsigned)code << 24;
                *(v4u*)(tb + slot * 16) = (v4u){dw[0], dw[1], dw[2], dw[3]}; } }
        LDS_WAIT(); asm volatile("" ::: "memory");
      } }
#else
    for (int row = gw; row < 2 * NL * NE; row += NGW) {
        const int tbl = row / (NL * NE), r = row % (NL * NE);
        const float* src = (tbl ? a.in[16] : a.in[15]) + (size_t)r * D;
        f32x4 v[8]; float mx = 0.f;
#pragma unroll
        for (int c8 = 0; c8 < 8; ++c8) { v[c8] = *(const f32x4*)(src + (c8 * 64 + lane) * 4); mx = fmaxf(mx, fmaxf(fmaxf(fabsf(v[c8].x), fabsf(v[c8].y)), fmaxf(fabsf(v[c8].z), fabsf(v[c8].w)))); }
#pragma unroll
        for (int o = 1; o < 64; o <<= 1) mx = fmaxf(mx, __shfl_xor(mx, o));
        const float inv = mx > 0.f ? 127.0f / mx : 0.f; const int off = tbl ? 128 : 0;
        unsigned dw[8];
#pragma unroll
        for (int c8 = 0; c8 < 8; ++c8) { const int q0 = (int)__builtin_rintf(v[c8].x * inv) + off, q1 = (int)__builtin_rintf(v[c8].y * inv) + off, q2 = (int)__builtin_rintf(v[c8].z * inv) + off, q3 = (int)__builtin_rintf(v[c8].w * inv) + off;
            dw[c8] = (unsigned)(q0 & 255) | ((unsigned)(q1 & 255) << 8) | ((unsigned)(q2 & 255) << 16) | ((unsigned)(q3 & 255) << 24); }
        unsigned char* dst = a.ws + (tbl ? WS_VT : WS_UT) + (size_t)r * D;
        *(v4u*)(dst + lane * 16) = (v4u){dw[0], dw[1], dw[2], dw[3]}; *(v4u*)(dst + (64 + lane) * 16) = (v4u){dw[4], dw[5], dw[6], dw[7]};
        if (lane == 0) ((float*)(a.ws + (tbl ? WS_SV : WS_SU)))[r] = mx * (1.0f / 127.0f);
    }
#endif
}

__device__ __forceinline__ void ln_tail(const float (&z)[32], int t, int lane, const float* g, const float* bta, float* xout, const float* sh, const float* sc, bf16* hout, unsigned char* q8, float* q8s, LAS unsigned char* q8stage = nullptr, unsigned char* a8 = nullptr, float* a8s = nullptr, bf16* xb = nullptr) {
    float s = 0.f;
#pragma unroll
    for (int i = 0; i < 32; ++i) s += z[i];
    const float mu = wave_sum(s) * (1.0f / D);
    float q = 0.f;
#pragma unroll
    for (int i = 0; i < 32; ++i) { const float d = z[i] - mu; q += d * d; }
    const float rs = rsqrtf(wave_sum(q) * (1.0f / D) + EPS);
    float hv[32]; float mx = 0.f;
#pragma unroll
    for (int c = 0; c < 8; ++c) { const int col = (c * 64 + lane) * 4;
        const f32x4 g0 = *(const f32x4*)(g + col), b0 = *(const f32x4*)(bta + col);
        f32x4 x0;
        x0.x = (z[c * 4 + 0] - mu) * rs * g0.x + b0.x; x0.y = (z[c * 4 + 1] - mu) * rs * g0.y + b0.y; x0.z = (z[c * 4 + 2] - mu) * rs * g0.z + b0.z; x0.w = (z[c * 4 + 3] - mu) * rs * g0.w + b0.w;
        if (xb) { v2u o; o.x = pk2(x0.x, x0.y); o.y = pk2(x0.z, x0.w); *(v2u*)(xb + (size_t)t * D + col) = o; }
        else if (xout) *(f32x4*)(xout + (size_t)t * D + col) = x0;
        if (hout || q8 || a8) { const f32x4 s0 = *(const f32x4*)(sc + col), h0 = *(const f32x4*)(sh + col);
            hv[c * 4] = x0.x * (1.f + s0.x) + h0.x; hv[c * 4 + 1] = x0.y * (1.f + s0.y) + h0.y; hv[c * 4 + 2] = x0.z * (1.f + s0.z) + h0.z; hv[c * 4 + 3] = x0.w * (1.f + s0.w) + h0.w;
            if (hout) { v2u o; o.x = pk2(hv[c * 4], hv[c * 4 + 1]); o.y = pk2(hv[c * 4 + 2], hv[c * 4 + 3]);
                *(v2u*)(hout + (size_t)t * D + col) = o; }
            if (q8 || a8) mx = fmaxf(mx, fmaxf(fmaxf(fabsf(hv[c * 4]), fabsf(hv[c * 4 + 1])), fmaxf(fabsf(hv[c * 4 + 2]), fabsf(hv[c * 4 + 3])))); }
    }
    if (q8 || a8) {
#pragma unroll
        for (int o = 1; o < 64; o <<= 1) mx = fmaxf(mx, __shfl_xor(mx, o));
        const float qmax_ = (q8 && TAB4) ? 119.0f : 127.0f;
        const float inv = mx > 0.f ? qmax_ / mx : 0.f;
        unsigned dw[8];
#pragma unroll
        for (int c = 0; c < 8; ++c) { const int q0 = (int)__builtin_rintf(hv[c * 4] * inv), q1 = (int)__builtin_rintf(hv[c * 4 + 1] * inv), q2 = (int)__builtin_rintf(hv[c * 4 + 2] * inv), q3 = (int)__builtin_rintf(hv[c * 4 + 3] * inv);
            dw[c] = (unsigned)(q0 & 255) | ((unsigned)(q1 & 255) << 8) | ((unsigned)(q2 & 255) << 16) | ((unsigned)(q3 & 255) << 24); }
        if (a8) {
#pragma unroll
            for (int c = 0; c < 8; ++c) *(unsigned*)(a8 + (size_t)t * D + (c * 64 + lane) * 4) = dw[c];
            if (a8s && lane == 0) a8s[t] = mx / qmax_; }
        if (q8) {
#if TAB4
        { LAS unsigned* st32 = (LAS unsigned*)q8stage; LAS unsigned char* st8 = (LAS unsigned char*)q8stage;
#pragma unroll
          for (int i = 0; i < 9; ++i) st32[lane + 64 * i] = 0u;
          LDS_WAIT(); asm volatile("" ::: "memory");
#pragma unroll
          for (int c = 0; c < 8; ++c)
#pragma unroll
              for (int jp = 0; jp < 2; ++jp) { const int col = (c * 64 + lane) * 4 + 2 * jp, u = col / 240, r = col - u * 240, l7 = r / 30, k = r - l7 * 30;
                  const int q0 = (int)(signed char)((dw[c] >> (16 * jp)) & 255u), q1 = (int)(signed char)((dw[c] >> (16 * jp + 8)) & 255u);
                  const int l0 = ((q0 + 8) & 15) - 8, l1 = ((q1 + 8) & 15) - 8, h0 = (q0 - l0) >> 4, h1 = (q1 - l1) >> 4;
                  LAS unsigned char* sp = st8 + (u * 8 + l7) * 32 + (k >> 1);
                  sp[0] = (unsigned char)((l0 & 15) | ((l1 & 15) << 4)); sp[16] = (unsigned char)((h0 & 15) | ((h1 & 15) << 4)); }
          LDS_WAIT(); asm volatile("" ::: "memory");
          unsigned* d32 = (unsigned*)(q8 + (size_t)t * 2304);
#pragma unroll
          for (int i = 0; i < 9; ++i) d32[lane + 64 * i] = st32[lane + 64 * i];
          LDS_WAIT(); asm volatile("" ::: "memory"); }
#else
        unsigned char* dst = q8 + (size_t)t * D;
        *(v4u*)(dst + lane * 16) = (v4u){dw[0], dw[1], dw[2], dw[3]}; *(v4u*)(dst + (64 + lane) * 16) = (v4u){dw[4], dw[5], dw[6], dw[7]};
#endif
        if (lane == 0) q8s[t] = mx / qmax_; }
    }
}

__device__ __forceinline__ void ph_prologue_b(const Args& a, LAS unsigned char* lds, int tid, int lane, int wave, int bx, int G) {
    const float* part = (const float*)(a.ws + WS_PART); float* mod = (float*)(a.ws + WS_MOD);
    for (int i = bx * NTHREADS + tid; i < NL * NB * 6 * D / 4; i += G * NTHREADS) {
        const int idx = i * 4, e = idx % (6 * D), b = (idx / (6 * D)) % NB, l = idx / (6 * D * NB);
        f32x4 s = *(const f32x4*)(a.in[3] + l * 6 * D + e);
#pragma unroll
        for (int dr = 0; dr < 8; ++dr) s += *(const f32x4*)(part + (((size_t)l * 8 + dr) * NB + b) * (6 * D) + e);
        *(f32x4*)(mod + idx) = s;
    }
    LAS float* msh = (LAS float*)lds;
    bf16* hbuf = (bf16*)(a.ws + WS_H);
    for (int ch = bx; ch < NCHUNK; ch += G) {
        const int b = ch / NCH;
        for (int i = tid; i < 1024; i += NTHREADS) { const int e = i * 4;
            f32x4 s = *(const f32x4*)(a.in[3] + e);
#pragma unroll
            for (int dr = 0; dr < 8; ++dr) s += *(const f32x4*)(part + (((size_t)0 * 8 + dr) * NB + b) * (6 * D) + e);
            *(LAS f32x4*)(msh + e) = s; }
        __syncthreads();
        for (int i = 0; i < 8; ++i) { const int t = ch * 64 + wave * 8 + i;
            float hv[32]; float mx = 0.f;
#pragma unroll
            for (int c = 0; c < 4; ++c) { const int col = (c * 64 + lane) * 8;
                const f32x4 x0 = *(const f32x4*)(a.in[0] + (size_t)t * D + col), x1 = *(const f32x4*)(a.in[0] + (size_t)t * D + col + 4);
                const f32x4 h0 = *(const LAS f32x4*)(msh + col), h1 = *(const LAS f32x4*)(msh + col + 4), s0 = *(const LAS f32x4*)(msh + 2048 + col), s1 = *(const LAS f32x4*)(msh + 2048 + col + 4);
#pragma unroll
                for (int j = 0; j < 4; ++j) { hv[c * 8 + j] = x0[j] * (1.f + s0[j]) + h0[j]; hv[c * 8 + 4 + j] = x1[j] * (1.f + s1[j]) + h1[j]; }
                v4u o; o.x = pk2(hv[c * 8], hv[c * 8 + 1]); o.y = pk2(hv[c * 8 + 2], hv[c * 8 + 3]); o.z = pk2(hv[c * 8 + 4], hv[c * 8 + 5]); o.w = pk2(hv[c * 8 + 6], hv[c * 8 + 7]);
#if !I8_GATE
                *(v4u*)(hbuf + (size_t)t * D + col) = o;
#endif
#if RES16_X
                { v4u xo; xo.x = pk2(x0.x, x0.y); xo.y = pk2(x0.z, x0.w); xo.z = pk2(x1.x, x1.y); xo.w = pk2(x1.z, x1.w); *(v4u*)((bf16*)(a.ws + WS_X) + (size_t)t * D + col) = xo; }
#endif
#pragma unroll
                for (int j = 0; j < 8; ++j) mx = fmaxf(mx, fabsf(hv[c * 8 + j])); }
#pragma unroll
            for (int o = 1; o < 64; o <<= 1) mx = fmaxf(mx, __shfl_xor(mx, o));
            const float inv = mx > 0.f ? 127.0f / mx : 0.f;
#pragma unroll
            for (int c = 0; c < 4; ++c) { v2u o;
                o.x = pack_i8(hv[c * 8] * inv, hv[c * 8 + 1] * inv, hv[c * 8 + 2] * inv, hv[c * 8 + 3] * inv); o.y = pack_i8(hv[c * 8 + 4] * inv, hv[c * 8 + 5] * inv, hv[c * 8 + 6] * inv, hv[c * 8 + 7] * inv);
                *(v2u*)(a.ws + WS_H8 + (size_t)t * D + (c * 64 + lane) * 8) = o; }
            if (lane == 0) ((float*)(a.ws + WS_SAH))[t] = mx * (1.0f / 127.0f); }
        __syncthreads();
    }
    { const int gw = bx * NWAVES + wave, NGW = G * NWAVES;
      for (int row = gw; row < NL * (SBL + 16); row += NGW) { const int l = row / (SBL + 16), r = row % (SBL + 16);
          const bf16* src; unsigned char* dst; float* sdst;
          if (r < NP) { src = (const bf16*)(a.ws + WS_WIN) + ((size_t)l * INW + r) * D; dst = a.ws + WS_WIN8 + ((size_t)l * NP + r) * D; sdst = (float*)(a.ws + WS_SB) + l * SBL + r; }
          else if (r < NP + D) { src = (const bf16*)(a.ws + WS_WOUT) + ((size_t)l * D + (r - NP)) * D; dst = a.ws + WS_WOUT8 + ((size_t)l * D + (r - NP)) * D; sdst = (float*)(a.ws + WS_SB) + l * SBL + r; }
          else if (r < SBL) { src = (const bf16*)(a.ws + WS_WQ) + ((size_t)l * D + (r - NP - D)) * D; dst = a.ws + WS_WQ8 + ((size_t)l * D + (r - NP - D)) * D; sdst = (float*)(a.ws + WS_SB) + l * SBL + r; }
          else { src = (const bf16*)(a.ws + WS_WIN) + ((size_t)l * INW + NP + (r - SBL)) * D; dst = a.ws + WS_ALR8 + ((size_t)l * 16 + (r - SBL)) * D; sdst = (float*)(a.ws + WS_SBA) + l * 16 + (r - SBL); }
          v4u w[4]; float mx = 0.f;
#pragma unroll
          for (int c = 0; c < 4; ++c) w[c] = *(const v4u*)(src + (c * 64 + lane) * 8);
#pragma unroll
          for (int c = 0; c < 4; ++c)
#pragma unroll
              for (int j = 0; j < 4; ++j) mx = fmaxf(mx, fmaxf(fabsf(bflo(w[c][j])), fabsf(bfhi(w[c][j]))));
#pragma unroll
          for (int o = 1; o < 64; o <<= 1) mx = fmaxf(mx, __shfl_xor(mx, o));
          const float inv = mx > 0.f ? 127.0f / mx : 0.f;
#pragma unroll
          for (int c = 0; c < 4; ++c) { v2u o;
              o.x = pack_i8(bflo(w[c][0]) * inv, bfhi(w[c][0]) * inv, bflo(w[c][1]) * inv, bfhi(w[c][1]) * inv); o.y = pack_i8(bflo(w[c][2]) * inv, bfhi(w[c][2]) * inv, bflo(w[c][3]) * inv, bfhi(w[c][3]) * inv);
              *(v2u*)(dst + (c * 64 + lane) * 8) = o; }
          if (lane == 0) *sdst = mx * (1.0f / 127.0f); } }
}

__device__ __forceinline__ void gate_prep(const Args& a, int l, LAS unsigned char* lds, int tid, int lane, int wave, int ch) {
    const bf16* hbuf = (const bf16*)(a.ws + WS_H); const bf16* waT = (const bf16*)(a.ws + WS_WIN) + ((size_t)l * INW + NP) * D;
    bf16* Ebuf = (bf16*)(a.ws + WS_E); float* dtot = (float*)(a.ws + WS_DTOT);
    const int t0 = ch * 64, l15 = lane & 15, lq = lane >> 4, mt = wave & 3, kh = wave >> 2;
    LAS float* alr = (LAS float*)(lds + LDSCTL_OFF + 1024);
#if I8_GATE
    { v4i acc = (v4i){0, 0, 0, 0};
      const unsigned char* hA = a.ws + WS_H8 + (size_t)(t0 + 16 * mt + l15) * D + kh * 1024 + 16 * lq;
      const unsigned char* wB = a.ws + WS_ALR8 + ((size_t)l * 16 + l15) * D + kh * 1024 + 16 * lq;
#pragma unroll 8
      for (int ks = 0; ks < 16; ++ks) { const v4i av = *(const v4i*)(hA + 64 * ks), bv = *(const v4i*)(wB + 64 * ks); acc = __builtin_amdgcn_mfma_i32_16x16x64_i8(av, bv, acc, 0, 0, 0); }
      const float sw = ((const float*)(a.ws + WS_SBA))[l * 16 + l15];
#pragma unroll
      for (int r = 0; r < 4; ++r) { const int tl = 16 * mt + 4 * lq + r; alr[(kh * 64 + tl) * 16 + l15] = (float)acc[r] * (sw * ((const float*)(a.ws + WS_SAH))[t0 + tl]); } }
#else
    f32x4 acc = (f32x4){0.f, 0.f, 0.f, 0.f};
    const bf16* hA = hbuf + (size_t)(t0 + 16 * mt + l15) * D + kh * 1024 + 8 * lq;
    const bf16* wB = waT + (size_t)l15 * D + kh * 1024 + 8 * lq;
#pragma unroll 8
    for (int ks = 0; ks < 32; ++ks) { const bf16x8 av = *(const bf16x8*)(hA + 32 * ks), bv = *(const bf16x8*)(wB + 32 * ks); acc = __builtin_amdgcn_mfma_f32_16x16x32_bf16(av, bv, acc, 0, 0, 0); }
#pragma unroll
    for (int r = 0; r < 4; ++r) alr[(kh * 64 + 16 * mt + 4 * lq + r) * 16 + l15] = acc[r];
#endif
    __syncthreads();
    const int col = tid;
    float wg[16];
#pragma unroll
    for (int r = 0; r < 16; ++r) wg[r] = a.in[5][((size_t)l * RANK + r) * GKW + col];
    const float bgc = a.in[6][l * GKW + col];
    float tot = 0.f;
    LAS float* lac = (LAS float*)lds;
    for (int j = 0; j < 64; ++j) { float lg = bgc;
#pragma unroll
        for (int r4 = 0; r4 < 4; ++r4) { const f32x4 p = *(const LAS f32x4*)(alr + j * 16 + r4 * 4), q = *(const LAS f32x4*)(alr + (64 + j) * 16 + r4 * 4);
            lg += (p.x + q.x) * wg[r4 * 4] + (p.y + q.y) * wg[r4 * 4 + 1] + (p.z + q.z) * wg[r4 * 4 + 2] + (p.w + q.w) * wg[r4 * 4 + 3]; }
        const float la = logsigmoid_f(lg) * (1.0f / 16.0f); lac[j * GKW + col] = la; tot += la; }
    float run = 0.f;
    for (int j = 0; j < 64; ++j) { run += lac[j * GKW + col];
        Ebuf[(size_t)(t0 + j) * GKW + col] = (bf16)(pk2(__expf(tot - run), 0.f) & 0xffffu); }
    dtot[(size_t)ch * GKW + col] = __expf(tot);
    __syncthreads();
}

__device__ __forceinline__ void gla_unit(const Args& a, LAS unsigned char* lds, int tid, int lane, int wave, int un) {
    const bf16* proj = (const bf16*)(a.ws + WS_PROJ); const bf16* Ebuf = (const bf16*)(a.ws + WS_E); const float* dtot = (const float*)(a.ws + WS_DTOT); bf16* ogla = (bf16*)(a.ws + WS_OGLA);
    const int pair_ = (un & 7) * 4 + (un >> 6), dvs = (un >> 3) & 7, hh = pair_ & 3, b = pair_ >> 2;
    LAS bf16* kdT = (LAS bf16*)lds;
    LAS bf16* vT = (LAS bf16*)(lds + 18432);
    LAS bf16* ST = (LAS bf16*)(lds + 18432 + 4608);
    const int l15 = lane & 15, lq = lane >> 4, jl = tid >> 3, c0 = tid & 7, dv4 = (tid & 7) * 4, jt = (wave & 3) * 16, dvt = (wave >> 2) * 16;
#define GLA_BAR() do { asm volatile("s_waitcnt lgkmcnt(0)" ::: "memory"); __builtin_amdgcn_s_barrier(); asm volatile("" ::: "memory"); } while (0)
    f32x4 S0 = (f32x4){0.f, 0.f, 0.f, 0.f}, S1 = (f32x4){0.f, 0.f, 0.f, 0.f};
    v4u kn0[2], kn1[2], en0[2], en1[2]; v2u vn0, vn1; bf16x8 qn0[4], qn1[4], qc[4]; f32x4 dn0, dn1, dc;
#define GLA_LOAD(c, kn, en, vn, qn, dn) do { const int t0c = b * SEQ + (c) * 64; const bf16* pr = proj + (size_t)(t0c + jl) * NP; \
          \
        kn[0] = *(const v4u*)(pr + PK + hh * 128 + 8 * c0); kn[1] = *(const v4u*)(pr + PK + hh * 128 + 64 + 8 * c0); \
        en[0] = *(const v4u*)(Ebuf + (size_t)(t0c + jl) * GKW + hh * 128 + 8 * c0); en[1] = *(const v4u*)(Ebuf + (size_t)(t0c + jl) * GKW + hh * 128 + 64 + 8 * c0); \
        vn = *(const v2u*)(pr + PV + hh * 256 + dvs * 32 + dv4); \
        _Pragma("unroll") for (int ks_ = 0; ks_ < 4; ++ks_) qn[ks_] = *(const bf16x8*)(proj + (size_t)(t0c + jt + l15) * NP + PQ + hh * 128 + 32 * ks_ + 8 * lq); \
        dn = *(const f32x4*)(dtot + (size_t)(b * NCH + (c)) * GKW + hh * 128 + 16 * wave + 4 * lq); } while (0)
#define GLA_PREP(kn, en, vn, qn, dn) do { \
        _Pragma("unroll") for (int h_ = 0; h_ < 2; ++h_) _Pragma("unroll") for (int i_ = 0; i_ < 8; ++i_) { const unsigned w_ = kn[h_][i_ >> 1], e_ = en[h_][i_ >> 1]; \
            const float kf_ = (i_ & 1) ? bfhi(w_) : bflo(w_), ef_ = (i_ & 1) ? bfhi(e_) : bflo(e_); \
            kdT[(64 * h_ + 8 * c0 + i_) * 72 + ((((jl >> 3) ^ c0) & 7) << 3) + (jl & 7)] = (bf16)(pk2(kf_ * ef_, 0.f) & 0xffffu); }     \
        _Pragma("unroll") for (int i_ = 0; i_ < 4; ++i_) { const unsigned w_ = vn[i_ >> 1]; vT[(dv4 + i_) * 72 + jl] = (bf16)((i_ & 1) ? (w_ >> 16) : (w_ & 0xffffu)); } \
        _Pragma("unroll") for (int ks_ = 0; ks_ < 4; ++ks_) qc[ks_] = qn[ks_]; \
        dc = dn; } while (0)
#define GLA_BODY(c) do { \
        S0 = S0 * dc; S1 = S1 * dc; \
        _Pragma("unroll") for (int ks = 0; ks < 2; ++ks) { \
            const bf16x8 A_ = *(const LAS bf16x8*)(kdT + (16 * wave + l15) * 72 + ((((4 * ks + lq) ^ (2 * wave + (l15 >> 3))) & 7) << 3)); \
            const bf16x8 B0_ = *(const LAS bf16x8*)(vT + l15 * 72 + 32 * ks + 8 * lq), B1_ = *(const LAS bf16x8*)(vT + (16 + l15) * 72 + 32 * ks + 8 * lq); \
            S0 = __builtin_amdgcn_mfma_f32_16x16x32_bf16(A_, B0_, S0, 0, 0, 0); S1 = __builtin_amdgcn_mfma_f32_16x16x32_bf16(A_, B1_, S1, 0, 0, 0); } \
        { v2u w0_, w1_; w0_.x = pk2(S0.x, S0.y); w0_.y = pk2(S0.z, S0.w); w1_.x = pk2(S1.x, S1.y); w1_.y = pk2(S1.z, S1.w); \
          *(LAS v2u*)(ST + l15 * 136 + 16 * wave + 4 * lq) = w0_; *(LAS v2u*)(ST + (16 + l15) * 136 + 16 * wave + 4 * lq) = w1_; } \
        GLA_BAR(); \
        f32x4 O_ = (f32x4){0.f, 0.f, 0.f, 0.f}; \
        _Pragma("unroll") for (int ks = 0; ks < 4; ++ks) { const bf16x8 A_ = *(const LAS bf16x8*)(ST + (dvt + l15) * 136 + 32 * ks + 8 * lq); O_ = __builtin_amdgcn_mfma_f32_16x16x32_bf16(A_, qc[ks], O_, 0, 0, 0); } \
        { const f32x4 Os_ = O_ * 0.08838834764831845f; v2u ob_; ob_.x = pk2(Os_.x, Os_.y); ob_.y = pk2(Os_.z, Os_.w); \
          *(v2u*)(ogla + (size_t)(b * SEQ + (c) * 64 + jt + l15) * 1024 + hh * 256 + dvs * 32 + dvt + 4 * lq) = ob_; } } while (0)
    GLA_LOAD(0, kn0, en0, vn0, qn0, dn0); GLA_LOAD(1, kn1, en1, vn1, qn1, dn1);
    GLA_PREP(kn0, en0, vn0, qn0, dn0);
    GLA_BAR();
    for (int c = 0; c < NCH; c += 2) {
        { const int cn_ = c + 2 < NCH ? c + 2 : NCH - 1; GLA_LOAD(cn_, kn0, en0, vn0, qn0, dn0); }
        GLA_BODY(c);
        GLA_PREP(kn1, en1, vn1, qn1, dn1);
        GLA_BAR();
        { const int cn_ = c + 3 < NCH ? c + 3 : NCH - 1; GLA_LOAD(cn_, kn1, en1, vn1, qn1, dn1); }
        GLA_BODY(c + 1);
        GLA_PREP(kn0, en0, vn0, qn0, dn0);
        GLA_BAR();
    }
#undef GLA_BODY
#undef GLA_BAR
#undef GLA_LOAD
#undef GLA_PREP
}

__device__ __forceinline__ void unpack16(const v4u& p0, const v4u& p1, float (&o)[16]) {
#pragma unroll
    for (int j = 0; j < 4; ++j) { o[2 * j] = bflo(p0[j]); o[2 * j + 1] = bfhi(p0[j]); o[8 + 2 * j] = bflo(p1[j]); o[8 + 2 * j + 1] = bfhi(p1[j]); }
}
__device__ __forceinline__ void mixpost_chunk(const Args& a, int l, int lane, int wave, int ch) {
    const bf16* proj = (const bf16*)(a.ws + WS_PROJ); const bf16* ogla = (const bf16*)(a.ws + WS_OGLA);
    const int c0 = 16 * lane, tfirst = ch * 64 + wave * 8, sfirst = tfirst % SEQ;
    float gn[16], cw0[16], cw1[16], cw2[16], cn[16], u1[16], u2[16];
#pragma unroll
    for (int i = 0; i < 16; ++i) { gn[i] = a.in[7][l * 256 + ((c0 + i) & 255)]; cw0[i] = a.in[8][(size_t)l * 3072 + c0 + i]; cw1[i] = a.in[8][(size_t)l * 3072 + 1024 + c0 + i];
        cw2[i] = a.in[8][(size_t)l * 3072 + 2048 + c0 + i]; cn[i] = a.in[9][l * 1024 + c0 + i]; u1[i] = 0.f; u2[i] = 0.f; }
    if (sfirst >= 2) {
        float cc[16], chh[16];
        { const bf16* pr = proj + (size_t)(tfirst - 2) * NP; unpack16(*(const v4u*)(pr + PCC + c0), *(const v4u*)(pr + PCC + c0 + 8), cc); unpack16(*(const v4u*)(pr + PCH + c0), *(const v4u*)(pr + PCH + c0 + 8), chh); }
#pragma unroll
        for (int i = 0; i < 16; ++i) u2[i] = cc[i] * chh[i];
        { const bf16* pr = proj + (size_t)(tfirst - 1) * NP; unpack16(*(const v4u*)(pr + PCC + c0), *(const v4u*)(pr + PCC + c0 + 8), cc); unpack16(*(const v4u*)(pr + PCH + c0), *(const v4u*)(pr + PCH + c0 + 8), chh); }
#pragma unroll
        for (int i = 0; i < 16; ++i) u1[i] = cc[i] * chh[i];
    }
#pragma unroll 2
    for (int it = 0; it < 8; ++it) { const int t = tfirst + it; const bf16* pr = proj + (size_t)t * NP;
        float o[16], r[16], cb[16], cc[16], chh[16];
        unpack16(*(const v4u*)(ogla + (size_t)t * 1024 + c0), *(const v4u*)(ogla + (size_t)t * 1024 + c0 + 8), o);
        unpack16(*(const v4u*)(pr + PR + c0), *(const v4u*)(pr + PR + c0 + 8), r);
        unpack16(*(const v4u*)(pr + PCB + c0), *(const v4u*)(pr + PCB + c0 + 8), cb);
        unpack16(*(const v4u*)(pr + PCC + c0), *(const v4u*)(pr + PCC + c0 + 8), cc);
        unpack16(*(const v4u*)(pr + PCH + c0), *(const v4u*)(pr + PCH + c0 + 8), chh);
        float ss = 0.f;
#pragma unroll
        for (int i = 0; i < 16; ++i) ss += o[i] * o[i];
        ss += __shfl_xor(ss, 1); ss += __shfl_xor(ss, 2); ss += __shfl_xor(ss, 4); ss += __shfl_xor(ss, 8);
        const float rg = rsqrtf(ss * (1.0f / 256.f) + EPS);
        float val[16]; float s2 = 0.f;
#pragma unroll
        for (int i = 0; i < 16; ++i) { const float u0 = cc[i] * chh[i]; val[i] = cb[i] * (cw0[i] * u2[i] + cw1[i] * u1[i] + cw2[i] * u0); s2 += val[i] * val[i]; u2[i] = u1[i]; u1[i] = u0; }
        const float rc = rsqrtf(wave_sum(s2) * (1.0f / 1024.f) + EPS);
        float ya[16], yb[16]; float mx = 0.f;
#pragma unroll
        for (int i = 0; i < 16; ++i) { ya[i] = o[i] * rg * gn[i] * silu_f(r[i]); yb[i] = val[i] * rc * cn[i]; mx = fmaxf(mx, fmaxf(fabsf(ya[i]), fabsf(yb[i]))); }
#pragma unroll
        for (int o_ = 1; o_ < 64; o_ <<= 1) mx = fmaxf(mx, __shfl_xor(mx, o_));
        const float inv = mx > 0.f ? 127.0f / mx : 0.f;
        v4u y0, y1;
#pragma unroll
        for (int j = 0; j < 4; ++j) { y0[j] = pack_i8(ya[4 * j] * inv, ya[4 * j + 1] * inv, ya[4 * j + 2] * inv, ya[4 * j + 3] * inv); y1[j] = pack_i8(yb[4 * j] * inv, yb[4 * j + 1] * inv, yb[4 * j + 2] * inv, yb[4 * j + 3] * inv); }
        unsigned char* yr = a.ws + WS_Y8 + (size_t)t * D;
        *(v4u*)(yr + c0) = y0; *(v4u*)(yr + 1024 + c0) = y1;
#if !I8_OUT
        { v4u b0, b1, b2, b3;
#pragma unroll
          for (int j = 0; j < 4; ++j) { b0[j] = pk2(ya[2 * j], ya[2 * j + 1]); b1[j] = pk2(ya[8 + 2 * j], ya[9 + 2 * j]); b2[j] = pk2(yb[2 * j], yb[2 * j + 1]); b3[j] = pk2(yb[8 + 2 * j], yb[9 + 2 * j]); }
          bf16* ybr = (bf16*)(a.ws + WS_Y) + (size_t)t * D;
          *(v4u*)(ybr + c0) = b0; *(v4u*)(ybr + c0 + 8) = b1; *(v4u*)(ybr + 1024 + c0) = b2; *(v4u*)(ybr + 1024 + c0 + 8) = b3; }
#endif
        if (lane == 0) ((float*)(a.ws + WS_SAY))[t] = mx * (1.0f / 127.0f);
    }
}

__device__ __forceinline__ void ln1_chunk(const Args& a, int l, LAS unsigned char* lds, int lane, int wave, int ch) {
    const float* zbuf = (const float*)(a.ws + WS_Z); const float* mod = (const float*)(a.ws + WS_MOD);
    const int b = ch / NCH; const float* mb = mod + ((size_t)l * NB + b) * 6 * D;
#pragma unroll 2
    for (int it = 0; it < 8; ++it) { const int t = ch * 64 + wave * 8 + it;
        float z[32];
#pragma unroll
#if RES16_Z
        for (int c = 0; c < 8; ++c) { const v2u v0 = *(const v2u*)((const bf16*)zbuf + (size_t)t * D + (c * 64 + lane) * 4); z[c * 4] = bflo(v0.x); z[c * 4 + 1] = bfhi(v0.x); z[c * 4 + 2] = bflo(v0.y); z[c * 4 + 3] = bfhi(v0.y); }
#else
        for (int c = 0; c < 8; ++c) { const f32x4 v0 = *(const f32x4*)(zbuf + (size_t)t * D + (c * 64 + lane) * 4); z[c * 4] = v0.x; z[c * 4 + 1] = v0.y; z[c * 4 + 2] = v0.z; z[c * 4 + 3] = v0.w; }
#endif
        ln_tail(z, t, lane, a.in[11] + (size_t)l * D, a.in[12] + (size_t)l * D, RES16_X1 ? (float*)nullptr : (float*)(a.ws + WS_X1), mb + 3 * D, mb + 4 * D, I8_WQ ? (bf16*)nullptr : (bf16*)(a.ws + WS_H2), a.ws + WS_HQ8, (float*)(a.ws + WS_HSC), lds + wave * 2304, I8_WQ ? a.ws + WS_H28 : (unsigned char*)nullptr, nullptr, RES16_X1 ? (bf16*)(a.ws + WS_X1) : (bf16*)nullptr);
    }
}

template <int N> __device__ __forceinline__ void bitonic_sort_desc(float (&v)[N]) {
#pragma unroll
    for (int k = 2; k <= N; k <<= 1)
#pragma unroll
        for (int j = k >> 1; j > 0; j >>= 1)
#pragma unroll
            for (int i = 0; i < N; ++i) { const int p = i ^ j; if (p > i) { const bool desc = ((i & k) == 0); const float x = v[i], y = v[p]; const float mx = fmaxf(x, y), mn = fminf(x, y); v[i] = desc ? mx : mn; v[p] = desc ? mn : mx; } }
}
__device__ __forceinline__ void merge_top16(float (&x)[16], const float (&y)[16]) {
#pragma unroll
    for (int i = 0; i < 16; ++i) x[i] = fmaxf(x[i], y[15 - i]);
#pragma unroll
    for (int j = 8; j > 0; j >>= 1)
#pragma unroll
        for (int i = 0; i < 16; ++i) { const int p = i ^ j; if (p > i) { const float u = x[i], w = x[p]; x[i] = fmaxf(u, w); x[p] = fminf(u, w); } }
}
__device__ __forceinline__ void ce_desc(float& ka, int& pa, float& kb, int& pb) { const bool sw = kb > ka; const float k0 = sw ? kb : ka, k1 = sw ? ka : kb; const int p0 = sw ? pb : pa, p1 = sw ? pa : pb; ka = k0; pa = p0; kb = k1; pb = p1; }
__device__ __forceinline__ void bitonic_sort_desc_kp(float (&k)[16], int (&p)[16]) {
#pragma unroll
    for (int kk = 2; kk <= 16; kk <<= 1)
#pragma unroll
        for (int j = kk >> 1; j > 0; j >>= 1)
#pragma unroll
            for (int i = 0; i < 16; ++i) { const int q = i ^ j; if (q > i) { if ((i & kk) == 0) ce_desc(k[i], p[i], k[q], p[q]); else ce_desc(k[q], p[q], k[i], p[i]); } }
}
__device__ __forceinline__ void merge_top16_kp(float (&k)[16], int (&p)[16], const float (&k2)[16], const int (&p2)[16]) {
#pragma unroll
    for (int i = 0; i < 16; ++i) { const bool sw = k2[15 - i] > k[i]; k[i] = sw ? k2[15 - i] : k[i]; p[i] = sw ? p2[15 - i] : p[i]; }
#pragma unroll
    for (int j = 8; j > 0; j >>= 1)
#pragma unroll
        for (int i = 0; i < 16; ++i) { const int q = i ^ j; if (q > i) ce_desc(k[i], p[i], k[q], p[q]); }
}
__device__ constexpr int cand_i(int s) { return s < 16 ? 0 : s < 24 ? 1 : s < 29 ? 2 : s < 33 ? 3 : s < 36 ? 4 : s < 38 ? 5 : s < 40 ? 6 : s < 42 ? 7 : s < 50 ? s - 34 : -1; }
__device__ constexpr int cand_j(int s) { return s < 16 ? s : s < 24 ? s - 16 : s < 29 ? s - 24 : s < 33 ? s - 29 : s < 36 ? s - 33 : s < 38 ? s - 36 : s < 40 ? s - 38 : s < 42 ? s - 40 : s < 50 ? 0 : -1; }

__device__ __forceinline__ void peer_retrieve(const Args& a, int l, LAS unsigned char* lds, int lane, int wave, int ch) {
    const bf16* qbuf = (const bf16*)(a.ws + WS_Q); const bf16* keys = (const bf16*)(a.ws + WS_KEYS) + ((size_t)(l * 8 + wave) * 2) * 128 * 128;
    LAS int* eg_e = (LAS int*)lds; LAS float* eg_g = (LAS float*)(lds + 32768);
    const int l31 = lane & 31, l5 = lane >> 5, h = wave, t0 = ch * 64;
    for (int tt = 0; tt < 2; ++tt) {
        float sv[2][16];
#pragma unroll
        for (int p = 0; p < 2; ++p) {
            f32x16 acc[4];
#pragma unroll
            for (int nt = 0; nt < 4; ++nt)
#pragma unroll
                for (int r = 0; r < 16; ++r) acc[nt][r] = 0.f;
            const bf16* qp = qbuf + (size_t)(t0 + 32 * tt + l31) * D + h * 256 + p * 128 + 8 * l5;
            const bf16* kp = keys + (size_t)(p * 128 + l31) * 128 + 8 * l5;
#pragma unroll 2
            for (int ks = 0; ks < 8; ++ks) { const bf16x8 bq = *(const bf16x8*)(qp + 16 * ks);
#pragma unroll
                for (int nt = 0; nt < 4; ++nt) { const bf16x8 ak = *(const bf16x8*)(kp + (size_t)(32 * nt) * 128 + 16 * ks); acc[nt] = __builtin_amdgcn_mfma_f32_32x32x16_bf16(ak, bq, acc[nt], 0, 0, 0); } }
            float v[4][16];
#pragma unroll
            for (int nt = 0; nt < 4; ++nt)
#pragma unroll
                for (int r = 0; r < 16; ++r) { const unsigned idx = 32u * nt + (r & 3) + 8u * (r >> 2) + 4u * l5; v[nt][r] = __uint_as_float((__float_as_uint(acc[nt][r]) & 0xffffff80u) | idx); }
#pragma unroll
            for (int nt = 0; nt < 4; ++nt) bitonic_sort_desc<16>(v[nt]);
            merge_top16(v[0], v[1]); merge_top16(v[2], v[3]); merge_top16(v[0], v[2]);
            float o[16];
#pragma unroll
            for (int i = 0; i < 16; ++i) o[i] = __shfl_xor(v[0][i], 32);
            merge_top16(v[0], o);
#pragma unroll
            for (int i = 0; i < 16; ++i) sv[p][i] = v[0][i];
        }
        LAS unsigned char* idxb = (LAS unsigned char*)(lds + 69632) + wave * 2048 + lane * 32;
        { v4u w0, w1;
#pragma unroll
          for (int q4 = 0; q4 < 4; ++q4) {
              w0[q4] = (__float_as_uint(sv[0][4 * q4]) & 127u) | ((__float_as_uint(sv[0][4 * q4 + 1]) & 127u) << 8) | ((__float_as_uint(sv[0][4 * q4 + 2]) & 127u) << 16) | ((__float_as_uint(sv[0][4 * q4 + 3]) & 127u) << 24);
              w1[q4] = (__float_as_uint(sv[1][4 * q4]) & 127u) | ((__float_as_uint(sv[1][4 * q4 + 1]) & 127u) << 8) | ((__float_as_uint(sv[1][4 * q4 + 2]) & 127u) << 16) | ((__float_as_uint(sv[1][4 * q4 + 3]) & 127u) << 24); }
          *(LAS v4u*)(idxb) = w0; *(LAS v4u*)(idxb + 16) = w1; }
        float ck[4][16];
#pragma unroll
        for (int s = 0; s < 64; ++s) {
            if (cand_i(s) >= 0) { const unsigned b0 = __float_as_uint(sv[0][cand_i(s) < 0 ? 0 : cand_i(s)]), b1 = __float_as_uint(sv[1][cand_j(s) < 0 ? 0 : cand_j(s)]);
                const float sum = __uint_as_float(b0 & 0xffffff80u) + __uint_as_float(b1 & 0xffffff80u);
                ck[s >> 4][s & 15] = __uint_as_float((__float_as_uint(sum) & 0xffffff00u) | (unsigned)((cand_i(s) < 0 ? 0 : cand_i(s)) * 16 + (cand_j(s) < 0 ? 0 : cand_j(s)))); }
            else ck[s >> 4][s & 15] = -3.0e38f; }
        bitonic_sort_desc<16>(ck[1]); bitonic_sort_desc<16>(ck[2]);
        merge_top16(ck[0], ck[1]); merge_top16(ck[2], ck[3]); merge_top16(ck[0], ck[2]);
        LDS_WAIT(); asm volatile("" ::: "memory");
        float ex[16]; int ce[16]; float den = 0.f;
        const float cmax = __uint_as_float(__float_as_uint(ck[0][0]) & 0xffffff00u);
#pragma unroll
        for (int i = 0; i < 16; ++i) { const unsigned bits = __float_as_uint(ck[0][i]); ex[i] = __expf(__uint_as_float(bits & 0xffffff00u) - cmax); den += ex[i];
            ce[i] = (int)idxb[(bits >> 4) & 15u] * 128 + (int)idxb[16 + (bits & 15u)]; }
        const float inv = 1.0f / den;
        if (l5 == 0) {
            const int base = (32 * tt + l31) * 128 + h * 16;
#pragma unroll
            for (int i4 = 0; i4 < 4; ++i4) { *(LAS v4u*)(eg_e + base + 4 * i4) = (v4u){(unsigned)ce[4 * i4], (unsigned)ce[4 * i4 + 1], (unsigned)ce[4 * i4 + 2], (unsigned)ce[4 * i4 + 3]};
                *(LAS f32x4*)(eg_g + base + 4 * i4) = (f32x4){ex[4 * i4] * inv, ex[4 * i4 + 1] * inv, ex[4 * i4 + 2] * inv, ex[4 * i4 + 3] * inv}; }
        }
        LDS_WAIT(); asm volatile("" ::: "memory");
    }
}

typedef unsigned char uc4 __attribute__((ext_vector_type(4)));
constexpr int NSLICE = 16, SLICE_SHIFT = 10;
__device__ __forceinline__ int sdot4i(unsigned w, unsigned x, int acc) { return __builtin_amdgcn_sdot4((int)w, (int)x, acc, false); }
__device__ __forceinline__ void fma_ub4(unsigned w, float s, float& y0, float& y1, float& y2, float& y3) { const uc4 b = __builtin_bit_cast(uc4, w); y0 += s * (float)b.x; y1 += s * (float)b.y; y2 += s * (float)b.z; y3 += s * (float)b.w; }
#if TAB4
__device__ __forceinline__ void peer_tail(const Args& a, int l, int t, int lane, const bf16* Yrow, const float* mb, const float* mbn, bool last) {
    const float* x1buf = (const float*)(a.ws + WS_X1);
    float z[32];
#pragma unroll
    for (int c8 = 0; c8 < 8; ++c8) { const int col = (c8 * 64 + lane) * 4;
        const v2u yb = *(const v2u*)(Yrow + col); const f32x4 yv = (f32x4){bflo(yb.x), bfhi(yb.x), bflo(yb.y), bfhi(yb.y)};
#if RES16_X1
        const v2u xb_ = *(const v2u*)((const bf16*)x1buf + (size_t)t * D + col); const f32x4 x0 = (f32x4){bflo(xb_.x), bfhi(xb_.x), bflo(xb_.y), bfhi(xb_.y)}, g0 = *(const f32x4*)(mb + 5 * D + col);
#else
        const f32x4 x0 = *(const f32x4*)(x1buf + (size_t)t * D + col), g0 = *(const f32x4*)(mb + 5 * D + col);
#endif
        z[c8 * 4] = ALPHA * x0.x + (1.f + g0.x) * yv.x; z[c8 * 4 + 1] = ALPHA * x0.y + (1.f + g0.y) * yv.y; z[c8 * 4 + 2] = ALPHA * x0.z + (1.f + g0.z) * yv.z; z[c8 * 4 + 3] = ALPHA * x0.w + (1.f + g0.w) * yv.w; }
    ln_tail(z, t, lane, a.in[17] + (size_t)l * D, a.in[18] + (size_t)l * D, last ? a.out : (RES16_X ? (float*)nullptr : (float*)(a.ws + WS_X)), mbn, mbn + D, (last || I8_GATE) ? (bf16*)nullptr : (bf16*)(a.ws + WS_H), nullptr, nullptr, nullptr, last ? (unsigned char*)nullptr : a.ws + WS_H8, (float*)(a.ws + WS_SAH), (RES16_X && !last) ? (bf16*)(a.ws + WS_X) : (bf16*)nullptr);
}
template <class TT, int N, int M> __device__ __forceinline__ void treduce(TT (&v)[N], int lane) {
    const bool c0 = (lane & M) != 0, c1 = (lane & (2 * M)) != 0, c2 = (lane & (4 * M)) != 0;
#pragma unroll
    for (int m = 0; m < N / 2; ++m) { const TT keep = c0 ? v[2 * m + 1] : v[2 * m], send = c0 ? v[2 * m] : v[2 * m + 1]; v[m] = keep + __shfl_xor(send, M); }
#pragma unroll
    for (int m = 0; m < N / 4; ++m) { const TT keep = c1 ? v[2 * m + 1] : v[2 * m], send = c1 ? v[2 * m] : v[2 * m + 1]; v[m] = keep + __shfl_xor(send, 2 * M); }
#pragma unroll
    for (int m = 0; m < N / 8; ++m) { const TT keep = c2 ? v[2 * m + 1] : v[2 * m], send = c2 ? v[2 * m] : v[2 * m + 1]; v[m] = keep + __shfl_xor(send, 4 * M); }
}
__device__ __forceinline__ void tr4x4(unsigned a, unsigned b, unsigned c, unsigned d, unsigned& t0, unsigned& t1, unsigned& t2, unsigned& t3) {
    const unsigned x0 = __builtin_amdgcn_perm(b, a, 0x05010400u), x1 = __builtin_amdgcn_perm(b, a, 0x07030602u), y0 = __builtin_amdgcn_perm(d, c, 0x05010400u), y1 = __builtin_amdgcn_perm(d, c, 0x07030602u);
    t0 = __builtin_amdgcn_perm(y0, x0, 0x05040100u); t1 = __builtin_amdgcn_perm(y0, x0, 0x07060302u); t2 = __builtin_amdgcn_perm(y1, x1, 0x05040100u); t3 = __builtin_amdgcn_perm(y1, x1, 0x07060302u);
}
__device__ __forceinline__ int sdot8i(unsigned w, unsigned x, int acc) { return __builtin_amdgcn_sdot8((int)w, (int)x, acc, false); }
__device__ __forceinline__ float slot_scale(unsigned w3) { return __builtin_amdgcn_exp2f((float)(w3 >> 24) * 0.125f - 16.0f); }
__device__ __forceinline__ void peer_experts(const Args& a, int l, LAS unsigned char* lds, int lane0, int wave, int ch) {
    const float* mod = (const float*)(a.ws + WS_MOD);
    const unsigned char* ut = a.ws + WS_UT + (size_t)l * NE * 1152; const unsigned char* vt = a.ws + WS_VT + (size_t)l * NE * 1152; const unsigned char* hq8 = a.ws + WS_HQ8;
    const float* hsc = (const float*)(a.ws + WS_HSC);
    bf16* Ybuf = (bf16*)(a.ws + WS_Z);
    const LAS int* eg_e = (const LAS int*)lds; LAS float* sw = (LAS float*)(lds + 32768);
    LAS float* apart = (LAS float*)(lds + 65536);
    const int b = ch / NCH; const bool last = (l == NL - 1);
    const float* mb = mod + ((size_t)l * NB + b) * 6 * D; const float* mbn = mod + ((size_t)(last ? l : l + 1) * NB + b) * 6 * D;
    const int tlw = wave * 8;
    { const int lane = lane0;
#pragma unroll
      for (int i = 0; i < 16; ++i) apart[tlw * 128 + i * 64 + lane] = 0.f; }
    LDS_WAIT(); asm volatile("" ::: "memory");
    {
        int laneL = lane0; asm volatile("" : "+v"(laneL)); const int lane = laneL;
        const int g = lane >> 3, l7 = lane & 7;
        v4u bufA[16], bufB[16], hA0, hA1, hB0, hB1;
#define CU_LOAD(buf, h0_, h1_, idx_) do { const int u_ = (idx_) >> 3, tl_ = tlw + ((idx_) & 7); const unsigned soff_ = (unsigned)(u_ * 128 + l7 * 16); \
            const unsigned char* hp_ = hq8 + (size_t)(ch * 64 + tl_) * 2304 + (u_ * 8 + l7) * 32; h0_ = *(const v4u*)hp_; h1_ = *(const v4u*)(hp_ + 16); \
            _Pragma("unroll") for (int i_ = 0; i_ < 16; ++i_) { const unsigned e_ = (unsigned)eg_e[tl_ * 128 + 8 * i_ + g]; buf[i_] = *(const v4u*)(ut + (size_t)(e_ * 1152u + soff_)); } } while (0)
#define CU_COMP(buf, h0_, h1_, idx_) do { const int tl_ = tlw + ((idx_) & 7); float accv_[16]; \
            _Pragma("unroll") for (int i_ = 0; i_ < 16; ++i_) { int sl_ = 0, sh_ = 0; \
                _Pragma("unroll") for (int d_ = 0; d_ < 4; ++d_) { const unsigned x_ = buf[i_][d_] ^ 0x88888888u; sl_ = sdot8i(x_, h0_[d_], sl_); sh_ = sdot8i(x_, h1_[d_], sh_); } \
                accv_[i_] = slot_scale(buf[i_][3]) * (float)(16 * sh_ + sl_); } \
            treduce<float, 16, 1>(accv_, lane); \
            apart[tl_ * 128 + 8 * l7 + g] += accv_[0]; apart[tl_ * 128 + 8 * (8 + l7) + g] += accv_[1]; } while (0)
        CU_LOAD(bufA, hA0, hA1, 0);
        for (int idx = 0; idx < 72; idx += 2) {
            CU_LOAD(bufB, hB0, hB1, idx + 1);
            CU_COMP(bufA, hA0, hA1, idx);
            { const int nx_ = idx + 2 < 72 ? idx + 2 : 71; CU_LOAD(bufA, hA0, hA1, nx_); }
            CU_COMP(bufB, hB0, hB1, idx + 1);
        }
#undef CU_LOAD
#undef CU_COMP
        LDS_WAIT(); asm volatile("" ::: "memory");
        for (int it = 0; it < 8; ++it) { const int tl = tlw + it; const float shs = hsc[ch * 64 + tl];
            const float w0 = sw[tl * 128 + lane] * gelu_tanh_f(apart[tl * 128 + lane] * shs), w1 = sw[tl * 128 + 64 + lane] * gelu_tanh_f(apart[tl * 128 + 64 + lane] * shs);
            sw[tl * 128 + lane] = w0; sw[tl * 128 + 64 + lane] = w1; }
        LDS_WAIT(); asm volatile("" ::: "memory");
    }
    {
        int laneL = lane0; asm volatile("" : "+v"(laneL)); const int lane = laneL;
        const int g = lane >> 3, l7 = lane & 7;
        v4u bufA[16], bufB[16];
#define CV_LOAD(buf, idx_) do { const int u_ = (idx_) >> 3, tl_ = tlw + ((idx_) & 7); const unsigned soff_ = (unsigned)(u_ * 128 + l7 * 16); \
            _Pragma("unroll") for (int i_ = 0; i_ < 16; ++i_) { const unsigned e_ = (unsigned)eg_e[tl_ * 128 + 8 * i_ + g]; buf[i_] = *(const v4u*)(vt + (size_t)(e_ * 1152u + soff_)); } } while (0)
#define CV_COMP(buf, idx_) do { const int u_ = (idx_) >> 3, tl_ = tlw + ((idx_) & 7); \
            float wf_[16]; float wmx_ = 0.f; \
            _Pragma("unroll") for (int i_ = 0; i_ < 16; ++i_) { wf_[i_] = sw[tl_ * 128 + 8 * i_ + g] * slot_scale(buf[i_][3]); wmx_ = fmaxf(wmx_, fabsf(wf_[i_])); } \
            wmx_ = fmaxf(wmx_, __shfl_xor(wmx_, 8)); wmx_ = fmaxf(wmx_, __shfl_xor(wmx_, 16)); wmx_ = fmaxf(wmx_, __shfl_xor(wmx_, 32));     \
            const float winv_ = wmx_ > 0.f ? 127.0f / wmx_ : 0.f, wsc_ = wmx_ * (1.0f / 127.0f); \
              \
            unsigned wq4_[4]; int wsum_ = 0; \
            _Pragma("unroll") for (int gp_ = 0; gp_ < 4; ++gp_) { \
                const unsigned m0_ = __float_as_uint(wf_[4 * gp_] * winv_ + 12582912.0f), m1_ = __float_as_uint(wf_[4 * gp_ + 1] * winv_ + 12582912.0f), m2_ = __float_as_uint(wf_[4 * gp_ + 2] * winv_ + 12582912.0f), m3_ = __float_as_uint(wf_[4 * gp_ + 3] * winv_ + 12582912.0f); \
                wq4_[gp_] = __builtin_amdgcn_perm(__builtin_amdgcn_perm(m3_, m2_, 0x0c0c0400u), __builtin_amdgcn_perm(m1_, m0_, 0x0c0c0400u), 0x05040100u); \
                wsum_ = sdot4i(wq4_[gp_], 0x01010101u, wsum_); } \
            int yi_[32]; \
            _Pragma("unroll") for (int q_ = 0; q_ < 32; ++q_) yi_[q_] = 0; \
            _Pragma("unroll") for (int gp_ = 0; gp_ < 4; ++gp_) { \
                _Pragma("unroll") for (int d_ = 0; d_ < 4; ++d_) { const unsigned A_ = buf[4 * gp_][d_], B_ = buf[4 * gp_ + 1][d_], C_ = buf[4 * gp_ + 2][d_], D_ = buf[4 * gp_ + 3][d_]; \
                    unsigned t0_, t1_, t2_, t3_; \
                    tr4x4(A_, B_, C_, D_, t0_, t1_, t2_, t3_);     \
                    yi_[8 * d_]     = sdot4i(t0_ & 0x0f0f0f0fu, wq4_[gp_], yi_[8 * d_]);     yi_[8 * d_ + 1] = sdot4i((t0_ >> 4) & 0x0f0f0f0fu, wq4_[gp_], yi_[8 * d_ + 1]); \
                    yi_[8 * d_ + 2] = sdot4i(t1_ & 0x0f0f0f0fu, wq4_[gp_], yi_[8 * d_ + 2]); yi_[8 * d_ + 3] = sdot4i((t1_ >> 4) & 0x0f0f0f0fu, wq4_[gp_], yi_[8 * d_ + 3]); \
                    yi_[8 * d_ + 4] = sdot4i(t2_ & 0x0f0f0f0fu, wq4_[gp_], yi_[8 * d_ + 4]); yi_[8 * d_ + 5] = sdot4i((t2_ >> 4) & 0x0f0f0f0fu, wq4_[gp_], yi_[8 * d_ + 5]); \
                    yi_[8 * d_ + 6] = sdot4i(t3_ & 0x0f0f0f0fu, wq4_[gp_], yi_[8 * d_ + 6]); yi_[8 * d_ + 7] = sdot4i((t3_ >> 4) & 0x0f0f0f0fu, wq4_[gp_], yi_[8 * d_ + 7]); } } \
            treduce<int, 32, 8>(yi_, lane); \
            wsum_ += __shfl_xor(wsum_, 8); wsum_ += __shfl_xor(wsum_, 16); wsum_ += __shfl_xor(wsum_, 32);     \
            float y_[4]; \
            _Pragma("unroll") for (int q_ = 0; q_ < 4; ++q_) y_[q_] = wsc_ * (float)(yi_[q_] - 8 * wsum_); \
            { const int colb_ = u_ * 240 + l7 * 30 + g; bf16* yr_ = Ybuf + (size_t)(ch * 64 + tl_) * D + colb_; \
              _Pragma("unroll") for (int m_ = 0; m_ < 4; ++m_) if (8 * m_ + g < 30 && colb_ + 8 * m_ < D) yr_[8 * m_] = (bf16)(pk2(y_[m_], 0.f) & 0xffffu); } } while (0)
        CV_LOAD(bufA, 0);
        for (int idx = 0; idx < 72; idx += 2) {
            CV_LOAD(bufB, idx + 1);
            CV_COMP(bufA, idx);
            { const int nx_ = idx + 2 < 72 ? idx + 2 : 71; CV_LOAD(bufA, nx_); }
            CV_COMP(bufB, idx + 1);
        }
#undef CV_LOAD
#undef CV_COMP
    }
    asm volatile("s_waitcnt vmcnt(0)" ::: "memory");
    __builtin_amdgcn_fence(__ATOMIC_ACQUIRE, "agent");
    asm volatile("s_waitcnt vmcnt(0)" ::: "memory");
    for (int it = 0; it < 8; ++it) { int laneT = lane0; asm volatile("" : "+v"(laneT)); const int t = ch * 64 + tlw + it;
        peer_tail(a, l, t, laneT, Ybuf + (size_t)t * D, mb, mbn, last); }
}
#else
__device__ __forceinline__ void peer_tail(const Args& a, int l, int t, int lane, const float* Yrow, const float* mb, const float* mbn, bool last) {
    const float* x1buf = (const float*)(a.ws + WS_X1);
    float z[32];
#pragma unroll
    for (int c = 0; c < 2; ++c)
#pragma unroll
        for (int k = 0; k < 4; ++k) { const int c8 = 4 * c + k, col = (c8 * 64 + lane) * 4;
            const v2u yb = *(const v2u*)((const bf16*)Yrow + (c * 64 + lane) * 16 + 4 * k); const f32x4 yv = (f32x4){bflo(yb.x), bfhi(yb.x), bflo(yb.y), bfhi(yb.y)};
#if RES16_X1
            const v2u xb_ = *(const v2u*)((const bf16*)x1buf + (size_t)t * D + col); const f32x4 x0 = (f32x4){bflo(xb_.x), bfhi(xb_.x), bflo(xb_.y), bfhi(xb_.y)}, g0 = *(const f32x4*)(mb + 5 * D + col);
#else
            const f32x4 x0 = *(const f32x4*)(x1buf + (size_t)t * D + col), g0 = *(const f32x4*)(mb + 5 * D + col);
#endif
            z[c8 * 4] = ALPHA * x0.x + (1.f + g0.x) * yv.x; z[c8 * 4 + 1] = ALPHA * x0.y + (1.f + g0.y) * yv.y; z[c8 * 4 + 2] = ALPHA * x0.z + (1.f + g0.z) * yv.z; z[c8 * 4 + 3] = ALPHA * x0.w + (1.f + g0.w) * yv.w; }
    ln_tail(z, t, lane, a.in[17] + (size_t)l * D, a.in[18] + (size_t)l * D, last ? a.out : (RES16_X ? (float*)nullptr : (float*)(a.ws + WS_X)), mbn, mbn + D, (last || I8_GATE) ? (bf16*)nullptr : (bf16*)(a.ws + WS_H), nullptr, nullptr, nullptr, last ? (unsigned char*)nullptr : a.ws + WS_H8, (float*)(a.ws + WS_SAH), (RES16_X && !last) ? (bf16*)(a.ws + WS_X) : (bf16*)nullptr);
}
template <class TT, int M> __device__ __forceinline__ void treduce16(TT (&v)[16], int lane) {
    const bool c0 = (lane & M) != 0, c1 = (lane & (2 * M)) != 0, c2 = (lane & (4 * M)) != 0;
#pragma unroll
    for (int m = 0; m < 8; ++m) { const TT keep = c0 ? v[2 * m + 1] : v[2 * m], send = c0 ? v[2 * m] : v[2 * m + 1]; v[m] = keep + __shfl_xor(send, M); }
#pragma unroll
    for (int m = 0; m < 4; ++m) { const TT keep = c1 ? v[2 * m + 1] : v[2 * m], send = c1 ? v[2 * m] : v[2 * m + 1]; v[m] = keep + __shfl_xor(send, 2 * M); }
#pragma unroll
    for (int m = 0; m < 2; ++m) { const TT keep = c2 ? v[2 * m + 1] : v[2 * m], send = c2 ? v[2 * m] : v[2 * m + 1]; v[m] = keep + __shfl_xor(send, 4 * M); }
}
__device__ __forceinline__ void peer_experts(const Args& a, int l, LAS unsigned char* lds, int lane0, int wave, int ch) {
    const float* mod = (const float*)(a.ws + WS_MOD);
    const unsigned char* ut = a.ws + WS_UT + (size_t)l * NE * D; const unsigned char* vt = a.ws + WS_VT + (size_t)l * NE * D; const unsigned char* hq8 = a.ws + WS_HQ8;
    const float* su = (const float*)(a.ws + WS_SU) + (size_t)l * NE; const float* sv = (const float*)(a.ws + WS_SV) + (size_t)l * NE; const float* hsc = (const float*)(a.ws + WS_HSC);
    float* Ybuf = (float*)(a.ws + WS_Z);
    const LAS int* eg_e = (const LAS int*)lds; LAS float* sw = (LAS float*)(lds + 32768);
    LAS int* apart = (LAS int*)(lds + 65536); LAS float* wtotl = (LAS float*)(lds + LDSCTL_OFF + 256);
    const int b = ch / NCH; const bool last = (l == NL - 1);
    const float* mb = mod + ((size_t)l * NB + b) * 6 * D; const float* mbn = mod + ((size_t)(last ? l : l + 1) * NB + b) * 6 * D;
    const int tlw = wave * 8;
    { const int lane = lane0;
#pragma unroll
      for (int i = 0; i < 16; ++i) apart[tlw * 128 + i * 64 + lane] = 0; }
    LDS_WAIT(); asm volatile("" ::: "memory");
    {
        int laneL = lane0; asm volatile("" : "+v"(laneL)); const int lane = laneL;
        const int g = lane >> 3, l7 = lane & 7;
        v4u bufA[16], bufB[16], hA, hB;
#define CU_LOAD(buf, hh_, idx_) do { const int cs_ = (idx_) >> 3, tl_ = tlw + ((idx_) & 7); const unsigned coff_ = (unsigned)(cs_ * 128 + l7 * 16); \
            hh_ = *(const v4u*)(hq8 + (size_t)(ch * 64 + tl_) * D + coff_); \
            _Pragma("unroll") for (int i_ = 0; i_ < 16; ++i_) { const unsigned e_ = (unsigned)eg_e[tl_ * 128 + 8 * i_ + g]; buf[i_] = *(const v4u*)(ut + (size_t)(e_ * 2048u + coff_)); } } while (0)
#define CU_COMP(buf, hh_, idx_) do { const int tl_ = tlw + ((idx_) & 7); int acc_[16]; \
            _Pragma("unroll") for (int i_ = 0; i_ < 16; ++i_) { int s_ = 0; _Pragma("unroll") for (int q_ = 0; q_ < 4; ++q_) s_ = sdot4i(buf[i_][q_], hh_[q_], s_); acc_[i_] = s_; } \
            treduce16<int, 1>(acc_, lane); \
            apart[tl_ * 128 + 8 * l7 + g] += acc_[0]; apart[tl_ * 128 + 8 * (8 + l7) + g] += acc_[1]; } while (0)
        CU_LOAD(bufA, hA, 0);
        for (int idx = 0; idx < 128; idx += 2) {
            CU_LOAD(bufB, hB, idx + 1);
            CU_COMP(bufA, hA, idx);
            if (idx + 2 < 128) CU_LOAD(bufA, hA, idx + 2);
            CU_COMP(bufB, hB, idx + 1);
        }
#undef CU_LOAD
#undef CU_COMP
        LDS_WAIT(); asm volatile("" ::: "memory");
        for (int it = 0; it < 8; ++it) { const int tl = tlw + it; const float shs = hsc[ch * 64 + tl];
            const int e0 = eg_e[tl * 128 + lane], e1 = eg_e[tl * 128 + 64 + lane];
            const float w0 = sw[tl * 128 + lane] * gelu_tanh_f((float)apart[tl * 128 + lane] * su[e0] * shs) * sv[e0];
            const float w1 = sw[tl * 128 + 64 + lane] * gelu_tanh_f((float)apart[tl * 128 + 64 + lane] * su[e1] * shs) * sv[e1];
            sw[tl * 128 + lane] = w0; sw[tl * 128 + 64 + lane] = w1;
            const float ws = wave_sum(w0 + w1);
            if (lane == 0) wtotl[tl] = ws; }
        LDS_WAIT(); asm volatile("" ::: "memory");
    }
    {
        int laneL = lane0; asm volatile("" : "+v"(laneL)); const int lane = laneL;
        const int g = lane >> 3, l7 = lane & 7;
        v4u bufA[16], bufB[16];
#define CV_LOAD(buf, idx_) do { const int cs_ = (idx_) >> 3, tl_ = tlw + ((idx_) & 7); const unsigned coff_ = (unsigned)(cs_ * 128 + l7 * 16); \
            _Pragma("unroll") for (int i_ = 0; i_ < 16; ++i_) { const unsigned e_ = (unsigned)eg_e[tl_ * 128 + 8 * i_ + g]; buf[i_] = *(const v4u*)(vt + (size_t)(e_ * 2048u + coff_)); } } while (0)
#define CV_COMP(buf, idx_) do { const int cs_ = (idx_) >> 3, tl_ = tlw + ((idx_) & 7); float y_[16]; \
            _Pragma("unroll") for (int q_ = 0; q_ < 16; ++q_) y_[q_] = 0.f; \
            _Pragma("unroll") for (int i_ = 0; i_ < 16; ++i_) { const float wr_ = sw[tl_ * 128 + 8 * i_ + g]; \
                _Pragma("unroll") for (int q_ = 0; q_ < 4; ++q_) fma_ub4(buf[i_][q_], wr_, y_[4 * q_], y_[4 * q_ + 1], y_[4 * q_ + 2], y_[4 * q_ + 3]); } \
            treduce16<float, 8>(y_, lane); \
            const float woff_ = 128.0f * wtotl[tl_]; bf16* yr_ = (bf16*)Ybuf + (size_t)(ch * 64 + tl_) * D + cs_ * 128 + l7 * 16 + g; \
            yr_[0] = (bf16)(pk2(y_[0] - woff_, 0.f) & 0xffffu); yr_[8] = (bf16)(pk2(y_[1] - woff_, 0.f) & 0xffffu); } while (0)
        CV_LOAD(bufA, 0);
        for (int idx = 0; idx < 128; idx += 2) {
            CV_LOAD(bufB, idx + 1);
            CV_COMP(bufA, idx);
            if (idx + 2 < 128) CV_LOAD(bufA, idx + 2);
            CV_COMP(bufB, idx + 1);
        }
#undef CV_LOAD
#undef CV_COMP
    }
    asm volatile("s_waitcnt vmcnt(0)" ::: "memory");
    __builtin_amdgcn_fence(__ATOMIC_ACQUIRE, "agent");
    asm volatile("s_waitcnt vmcnt(0)" ::: "memory");
    for (int it = 0; it < 8; ++it) { int laneT = lane0; asm volatile("" : "+v"(laneT)); const int t = ch * 64 + tlw + it;
        peer_tail(a, l, t, laneT, (const float*)((const bf16*)Ybuf + (size_t)t * D), mb, mbn, last); }
}

#endif

#ifndef MK_PER_PHASE
#define MK_PER_PHASE 0
#endif
__global__ void __launch_bounds__(NTHREADS, 2) mk_fwd(Args a) {
    extern __shared__ __attribute__((aligned(16))) unsigned char lds_raw[];
    LAS unsigned char* lds = (LAS unsigned char*)lds_raw;
    const int tid = threadIdx.x, lane = tid & 63, wave = __builtin_amdgcn_readfirstlane(tid >> 6), G = gridDim.x, bx = blockIdx.x;
    if (tid < 64) ((LAS unsigned*)(lds + LDSCTL_OFF))[tid] = 0u;
    __syncthreads();
    unsigned* ctl = (unsigned*)(a.ws + WS_CTL);
    XcdBarrier bar; bar.bar = ctl + CW_BAR; bar.x = 0; bar.st = nullptr;
    const bool use_bar = (a.ph_hi - a.ph_lo) > 1;
    if (use_bar) bar = xcd_barrier_post(ctl + CW_BAR, (volatile LAS unsigned*)(lds + LDSCTL_OFF));
    const int lo = a.ph_lo, hi = a.ph_hi;
#ifndef PH_MASK
#define PH_MASK 0x1ff
#endif
#define IN(k) (lo <= (k) && (k) < hi)
#define EN(b) ((PH_MASK >> (b)) & 1)
#ifndef REP_MASK
#define REP_MASK 0
#endif
#ifndef REP_EXTRA
#define REP_EXTRA 2
#endif
#define REPS(b) (1 + ((REP_MASK >> (b)) & 1) * REP_EXTRA)
#define REP_BEGIN(b) for (int rep_ = 0; rep_ < REPS(b); ++rep_) {
#define REP_END(b) if (rep_ + 1 < REPS(b)) xcd_barrier(bar); }
#define SEAM(k) do { if (IN((k) + 1)) xcd_barrier(bar); } while (0)
#define PHASE_IDS() int tidp = tid; asm volatile("" : "+v"(tidp)); const int lanep = tidp & 63, wavep = __builtin_amdgcn_readfirstlane(tidp >> 6); (void)lanep; (void)wavep
    if (EN(0) && IN(0)) { REP_BEGIN(0) PHASE_IDS(); ph_prologue_a(a, lds, tidp, lanep, wavep, bx, G); REP_END(0) SEAM(0); }
    if (EN(1) && IN(1)) { REP_BEGIN(1) PHASE_IDS(); ph_prologue_b(a, lds, tidp, lanep, wavep, bx, G); REP_END(1) SEAM(1); }
    for (int l = 0; l < NL; ++l) {
        const int pb = 2 + 7 * l;
        const float* mod = (const float*)(a.ws + WS_MOD);
        if (EN(2) && IN(pb + 0)) {
            REP_BEGIN(2) PHASE_IDS();
#if I8_IN
            pg8::Gemm g{(const pg8::bf16_t*)(a.ws + WS_H8), (const pg8::bf16_t*)(a.ws + WS_WIN8 + (size_t)l * NP * D), T, NP, D / 2}; pg8::StaticOrder S; S.init(T, NP, G, bx, WGM_IN, KROT(bx));
            pg8::EpiBf16PS E{(pg8::bf16_t*)(a.ws + WS_PROJ), NP, (const float*)(a.ws + WS_SAH), (const float*)(a.ws + WS_SB) + l * SBL};
            pg8::gemm_phase<pg8::EpiBf16PS, pg8::StaticOrder, true, true, true>(lds + RING_OFF, g, S, E, tidp);
#else
            pg8::Gemm g{(const pg8::bf16_t*)(a.ws + WS_H), (const pg8::bf16_t*)(a.ws + WS_WIN) + (size_t)l * INW * D, T, NP, D}; pg8::StaticOrder S; S.init(T, NP, G, bx, WGM_IN, KROT(bx));
            pg8::EpiBf16P E{(pg8::bf16_t*)(a.ws + WS_PROJ), NP};
            pg8::gemm_phase<pg8::EpiBf16P, pg8::StaticOrder, true, true>(lds + RING_OFF, g, S, E, tidp);
#endif
            for (int ch = bx; ch < NCHUNK; ch += G) gate_prep(a, l, lds, tidp, lanep, wavep, ch);
            REP_END(2) SEAM(pb + 0);
        }
        if (EN(3) && IN(pb + 1)) { REP_BEGIN(3) PHASE_IDS(); for (int un = bx; un < 256; un += G) gla_unit(a, lds, tidp, lanep, wavep, un); REP_END(3) SEAM(pb + 1); }
        if (EN(4) && IN(pb + 2)) { REP_BEGIN(4) PHASE_IDS(); for (int ch = bx; ch < NCHUNK; ch += G) mixpost_chunk(a, l, lanep, wavep, ch); REP_END(4) SEAM(pb + 2); }
        if (EN(5) && IN(pb + 3)) {
            REP_BEGIN(5) PHASE_IDS();
#if I8_OUT
            pg8::Gemm g{(const pg8::bf16_t*)(a.ws + WS_Y8), (const pg8::bf16_t*)(a.ws + WS_WOUT8 + (size_t)l * D * D), T, D, D / 2}; pg8::StaticOrder S; S.init(T, D, G, bx, WGM_OUT, KROT(bx));
#if RES16_X || RES16_Z
            pg8::EpiResidS16<(RES16_X != 0), (RES16_Z != 0)> E{(void*)(a.ws + WS_Z), (RES16_X || l > 0) ? (const void*)(a.ws + WS_X) : (const void*)a.in[0], mod + (size_t)l * NB * 6 * D + 2 * D, (const float*)(a.ws + WS_SAY), (const float*)(a.ws + WS_SB) + l * SBL + NP, ALPHA};
            pg8::gemm_phase<pg8::EpiResidS16<(RES16_X != 0), (RES16_Z != 0)>, pg8::StaticOrder, true, true, true>(lds + RING_OFF, g, S, E, tidp);
#else
            pg8::EpiResidS E{(float*)(a.ws + WS_Z), l == 0 ? a.in[0] : (const float*)(a.ws + WS_X), mod + (size_t)l * NB * 6 * D + 2 * D, (const float*)(a.ws + WS_SAY), (const float*)(a.ws + WS_SB) + l * SBL + NP, ALPHA};
            pg8::gemm_phase<pg8::EpiResidS, pg8::StaticOrder, true, true, true>(lds + RING_OFF, g, S, E, tidp);
#endif
#else
            pg8::Gemm g{(const pg8::bf16_t*)(a.ws + WS_Y), (const pg8::bf16_t*)(a.ws + WS_WOUT) + (size_t)l * D * D, T, D, D}; pg8::StaticOrder S; S.init(T, D, G, bx, WGM_OUT, KROT(bx));
            pg8::EpiResid E{(float*)(a.ws + WS_Z), l == 0 ? a.in[0] : (const float*)(a.ws + WS_X), mod + (size_t)l * NB * 6 * D + 2 * D, ALPHA};
            pg8::gemm_phase<pg8::EpiResid, pg8::StaticOrder, true, true>(lds + RING_OFF, g, S, E, tidp);
#endif
            REP_END(5) SEAM(pb + 3);
        }
        if (EN(6) && IN(pb + 4)) { REP_BEGIN(6) PHASE_IDS(); for (int ch = bx; ch < NCHUNK; ch += G) ln1_chunk(a, l, lds, lanep, wavep, ch); REP_END(6) SEAM(pb + 4); }
        if (EN(7) && IN(pb + 5)) {
            REP_BEGIN(7) PHASE_IDS();
#if I8_WQ
            pg8::Gemm g{(const pg8::bf16_t*)(a.ws + WS_H28), (const pg8::bf16_t*)(a.ws + WS_WQ8 + (size_t)l * D * D), T, D, D / 2}; pg8::StaticOrder S; S.init(T, D, G, bx, WGM_WQ, KROT(bx));
            pg8::EpiBf16PS E{(pg8::bf16_t*)(a.ws + WS_Q), D, (const float*)(a.ws + WS_HSC), (const float*)(a.ws + WS_SB) + l * SBL + NP + D};
            pg8::gemm_phase<pg8::EpiBf16PS, pg8::StaticOrder, true, true, true>(lds + RING_OFF, g, S, E, tidp);
#else
            pg8::Gemm g{(const pg8::bf16_t*)(a.ws + WS_H2), (const pg8::bf16_t*)(a.ws + WS_WQ) + (size_t)l * D * D, T, D, D}; pg8::StaticOrder S; S.init(T, D, G, bx, WGM_WQ, KROT(bx));
            pg8::EpiBf16P E{(pg8::bf16_t*)(a.ws + WS_Q), D};
            pg8::gemm_phase<pg8::EpiBf16P, pg8::StaticOrder, true, true>(lds + RING_OFF, g, S, E, tidp);
#endif
            REP_END(7) SEAM(pb + 5);
        }
#ifndef PEER_DBG
#define PEER_DBG 0
#endif
#ifndef PE_REP_R
#define PE_REP_R 1
#endif
#ifndef L2PROBE
#define L2PROBE 0
#endif
        if (EN(8) && IN(pb + 6)) {
            REP_BEGIN(8)
            for (int ch = bx; ch < NCHUNK; ch += G) { for (int repr_ = 0; repr_ < PE_REP_R; ++repr_) { PHASE_IDS(); peer_retrieve(a, l, lds, lanep, wavep, ch); __syncthreads(); } __syncthreads(); { PHASE_IDS(); peer_experts(a, l, lds, lanep, wavep, ch); } __syncthreads(); }
            REP_END(8) SEAM(pb + 6);
        }
    }
#undef IN
#undef SEAM
}

extern "C" void kernel_launch(void* const* d_in, const int* in_sizes, int n_in, void* d_out, int out_size, void* d_ws, size_t ws_size, hipStream_t stream) {
    static int grid = 0;
    if (grid == 0) {
        if (n_in != 19 || in_sizes[0] != T * D || out_size != T * D || ws_size < WS_END) { fprintf(stderr, "kernel_launch: unexpected shapes / workspace (%d inputs, ws %zu); nothing launched\n", n_in, ws_size); grid = -1; return; }
        int dev = 0, cus = 0, per_cu = 0;
        if (hipGetDevice(&dev) != hipSuccess || hipDeviceGetAttribute(&cus, hipDeviceAttributeMultiprocessorCount, dev) != hipSuccess) { grid = -1; return; }
        if (hipFuncSetAttribute((const void*)mk_fwd, hipFuncAttributeMaxDynamicSharedMemorySize, LDS_BYTES) != hipSuccess) { fprintf(stderr, "kernel_launch: hipFuncSetAttribute failed\n"); grid = -1; return; }
        if (hipOccupancyMaxActiveBlocksPerMultiprocessor(&per_cu, (const void*)mk_fwd, NTHREADS, LDS_BYTES) != hipSuccess || per_cu < 1) fprintf(stderr, "kernel_launch: occupancy query reports %d\n", per_cu);
        (void)hipGetLastError();
        grid = cus;
    }
    if (grid < 0) return;
    if (hipMemsetAsync((char*)d_ws + WS_CTL, 0, CTL_ZERO_BYTES, stream) != hipSuccess) return;
    Args a{};
    for (int i = 0; i < 19; ++i) a.in[i] = (const float*)d_in[i];
    a.out = (float*)d_out; a.ws = (unsigned char*)d_ws;
#if MK_PER_PHASE
    for (int p = 0; p < NPHASES; ++p) { a.ph_lo = p; a.ph_hi = p + 1; hipLaunchKernelGGL(mk_fwd, dim3(grid), dim3(NTHREADS), LDS_BYTES, stream, a); }
#else
    a.ph_lo = 0; a.ph_hi = NPHASES;
    hipLaunchKernelGGL(mk_fwd, dim3(grid), dim3(NTHREADS), LDS_BYTES, stream, a);
#endif
}
```

```cpp
#include <hip/hip_runtime.h>
#include <cstdio>
#include <cstdint>
namespace pg8 {
#define PG8_LAS __attribute__((address_space(3)))
typedef unsigned short bf16_t;
typedef short bf16x8 __attribute__((ext_vector_type(8)));
typedef float f32x4 __attribute__((ext_vector_type(4)));
typedef unsigned u32x4 __attribute__((ext_vector_type(4)));
typedef int i32x4 __attribute__((ext_vector_type(4)));
constexpr int BM = 256, BK = 64, HALF = 128, HTB = HALF * BK * 2  , STAGE_BYTES = 8 * HTB, NXCD = 8, WGM = 8;

__host__ __device__ __forceinline__ int lds_byte(int r, int c) { const int st = (r >> 4) * 2 + (c >> 5), rr = r & 15, cc = c & 31, ob = rr * 64 + cc * 2; return st * 1024 + (ob ^ (((ob >> 9) & 1) << 5)); }
__host__ __device__ __forceinline__ void stage_rc(int b, int& R, int& C) { const int st = b / 1024, sb = b % 1024, swz = sb ^ (((sb >> 9) & 1) << 5); R = (st >> 1) * 16 + swz / 64; C = (st & 1) * 32 + (swz % 64) / 2; }
__host__ __device__ __forceinline__ int perm32(int rho) { const int n = rho >> 4, i = rho & 15; return 8 * (i >> 2) + 4 * n + (i & 3); }

struct Unit { int pm, pn; };
struct Gemm { const bf16_t* A; const bf16_t* Bt; int M, N, K; };

struct StaticOrder {
    int nM, nN, nwg, G, c, wgm, krot;
    __host__ __device__ void init(int M, int N, int G_, int c_, int wgm_ = WGM, int krot_ = 0) { nM = M / BM; nN = N / BM; nwg = nM * nN; G = G_; c = c_; wgm = wgm_; krot = krot_; }
    __host__ __device__ bool next(int i, Unit& u) const {
        const long L = (long)i * G + c; if (L >= nwg) return false;
        int wgid = (int)L; { const int q = nwg / NXCD, r = nwg % NXCD, xcd = wgid % NXCD, off = wgid / NXCD; wgid = (xcd < r ? xcd * (q + 1) : r * (q + 1) + (xcd - r) * q) + off; }
        const int nig = wgm * nN, gid = wgid / nig, fm = gid * wgm, gsz = (nM - fm) < wgm ? (nM - fm) : wgm;
        u.pm = fm + ((wgid % nig) % gsz); u.pn = (wgid % nig) / gsz; return true;
    }
    __device__ __forceinline__ void a_ready(const Unit&) const {}
    __device__ __forceinline__ void done(const Unit&) const {}
};
typedef __bf16 bf16x2_t __attribute__((ext_vector_type(2)));
__device__ __forceinline__ unsigned cvt_pk_bf16(float lo, float hi) { bf16x2_t r; r.x = (__bf16)lo; r.y = (__bf16)hi; return __builtin_bit_cast(unsigned, r); }
struct EpiBf16P {
    static constexpr bool PERM = true, AFTER_DRAIN = false;
    bf16_t* O; int ldc;
    __device__ __forceinline__ void operator()(const f32x4 (&acc)[2][2][4][2], const Unit& u, int wr, int wc, int fr, int fq) const {
        const int row0 = u.pm * BM + wr * 64 + fr, col0 = u.pn * BM + wc * 32 + 8 * fq;
#pragma unroll
        for (int ai = 0; ai < 2; ++ai)
#pragma unroll
            for (int m = 0; m < 4; ++m) { bf16_t* rowp = O + (size_t)(row0 + ai * HALF + m * 16) * ldc + col0;
#pragma unroll
                for (int bj = 0; bj < 2; ++bj) { const f32x4 v0 = acc[ai][bj][m][0], v1 = acc[ai][bj][m][1];
                    u32x4 w; w.x = cvt_pk_bf16(v0[0], v0[1]); w.y = cvt_pk_bf16(v0[2], v0[3]); w.z = cvt_pk_bf16(v1[0], v1[1]); w.w = cvt_pk_bf16(v1[2], v1[3]);
                    *(u32x4*)(rowp + bj * HALF) = w; } }
    }
};
struct EpiResid {
    static constexpr bool PERM = false, AFTER_DRAIN = false;
    float* Z; const float* X; const float* gate; float alpha;
    __device__ __forceinline__ void operator()(const f32x4 (&acc)[2][2][4][2], const Unit& u, int wr, int wc, int fr, int fq) const {
        const int row0 = u.pm * BM + wr * 64 + fr, col0 = u.pn * BM + wc * 32 + 4 * fq;
        const float* gb = gate + (size_t)(u.pm >> 3) * (6 * 2048) + col0;
        f32x4 gv[2][2];
#pragma unroll
        for (int bj = 0; bj < 2; ++bj)
#pragma unroll
            for (int n = 0; n < 2; ++n) gv[bj][n] = *(const f32x4*)(gb + bj * HALF + n * 16) + 1.0f;
#pragma unroll
        for (int ai = 0; ai < 2; ++ai)
#pragma unroll
            for (int m = 0; m < 4; ++m) { const size_t off = (size_t)(row0 + ai * HALF + m * 16) * 2048 + col0;
#pragma unroll
                for (int bj = 0; bj < 2; ++bj)
#pragma unroll
                    for (int n = 0; n < 2; ++n) { const f32x4 xv = *(const f32x4*)(X + off + bj * HALF + n * 16);
                        *(f32x4*)(Z + off + bj * HALF + n * 16) = xv * alpha + gv[bj][n] * acc[ai][bj][m][n]; }
                asm volatile("" ::: "memory"); }
    }
};
#ifndef PG8_NT
#define PG8_NT 0
#endif
#if PG8_NT
#define PG8_ST(TY, p, v) __builtin_nontemporal_store((v), (TY*)(p))
#else
#define PG8_ST(TY, p, v) (*(TY*)(p) = (v))
#endif
__device__ __forceinline__ f32x4 acc_i2f(const f32x4 v) { const i32x4 iv = __builtin_bit_cast(i32x4, v); return __builtin_convertvector(iv, f32x4); }
struct EpiBf16PS {
    static constexpr bool PERM = true, AFTER_DRAIN = false;
    bf16_t* O; int ldc; const float* sa; const float* sb;
    __device__ __forceinline__ void operator()(const f32x4 (&acc)[2][2][4][2], const Unit& u, int wr, int wc, int fr, int fq) const {
        const int row0 = u.pm * BM + wr * 64 + fr, col0 = u.pn * BM + wc * 32 + 8 * fq;
        f32x4 sbv[2][2];
#pragma unroll
        for (int bj = 0; bj < 2; ++bj)
#pragma unroll
            for (int n = 0; n < 2; ++n) sbv[bj][n] = *(const f32x4*)(sb + col0 + bj * HALF + 4 * n);
#pragma unroll
        for (int ai = 0; ai < 2; ++ai)
#pragma unroll
            for (int m = 0; m < 4; ++m) { const int row = row0 + ai * HALF + m * 16; bf16_t* rowp = O + (size_t)row * ldc + col0; const float sar = sa[row];
#pragma unroll
                for (int bj = 0; bj < 2; ++bj) { const f32x4 v0 = acc_i2f(acc[ai][bj][m][0]) * (sbv[bj][0] * sar), v1 = acc_i2f(acc[ai][bj][m][1]) * (sbv[bj][1] * sar);
                    u32x4 w; w.x = cvt_pk_bf16(v0[0], v0[1]); w.y = cvt_pk_bf16(v0[2], v0[3]); w.z = cvt_pk_bf16(v1[0], v1[1]); w.w = cvt_pk_bf16(v1[2], v1[3]);
                    PG8_ST(u32x4, rowp + bj * HALF, w); } }
    }
};
struct EpiResidS {
    static constexpr bool PERM = false, AFTER_DRAIN = false;
    float* Z; const float* X; const float* gate; const float* sa; const float* sb; float alpha;
    __device__ __forceinline__ void operator()(const f32x4 (&acc)[2][2][4][2], const Unit& u, int wr, int wc, int fr, int fq) const {
        const int row0 = u.pm * BM + wr * 64 + fr, col0 = u.pn * BM + wc * 32 + 4 * fq;
        const float* gb = gate + (size_t)(u.pm >> 3) * (6 * 2048) + col0;
        f32x4 gv[2][2];
#pragma unroll
        for (int bj = 0; bj < 2; ++bj)
#pragma unroll
            for (int n = 0; n < 2; ++n) gv[bj][n] = (*(const f32x4*)(gb + bj * HALF + n * 16) + 1.0f) * *(const f32x4*)(sb + col0 + bj * HALF + n * 16);
#pragma unroll
        for (int ai = 0; ai < 2; ++ai)
#pragma unroll
            for (int m = 0; m < 4; ++m) { const int row = row0 + ai * HALF + m * 16; const size_t off = (size_t)row * 2048 + col0; const float sar = sa[row];
#pragma unroll
                for (int bj = 0; bj < 2; ++bj)
#pragma unroll
                    for (int n = 0; n < 2; ++n) { const f32x4 xv = *(const f32x4*)(X + off + bj * HALF + n * 16);
                        PG8_ST(f32x4, Z + off + bj * HALF + n * 16, xv * alpha + (gv[bj][n] * sar) * acc_i2f(acc[ai][bj][m][n])); }
                asm volatile("" ::: "memory"); }
    }
};
template <bool XB, bool ZB> struct EpiResidS16 {
    static constexpr bool PERM = true, AFTER_DRAIN = false;
    void* Z; const void* X; const float* gate; const float* sa; const float* sb; float alpha;
    __device__ __forceinline__ void operator()(const f32x4 (&acc)[2][2][4][2], const Unit& u, int wr, int wc, int fr, int fq) const {
        const int row0 = u.pm * BM + wr * 64 + fr, col0 = u.pn * BM + wc * 32 + 8 * fq;
        const float* gb = gate + (size_t)(u.pm >> 3) * (6 * 2048) + col0;
        f32x4 gv[2][2];
#pragma unroll
        for (int bj = 0; bj < 2; ++bj)
#pragma unroll
            for (int n = 0; n < 2; ++n) gv[bj][n] = (*(const f32x4*)(gb + bj * HALF + 4 * n) + 1.0f) * *(const f32x4*)(sb + col0 + bj * HALF + 4 * n);
#pragma unroll
        for (int ai = 0; ai < 2; ++ai)
#pragma unroll
            for (int m = 0; m < 4; ++m) { const int row = row0 + ai * HALF + m * 16; const size_t off = (size_t)row * 2048 + col0; const float sar = sa[row];
#pragma unroll
                for (int bj = 0; bj < 2; ++bj) { f32x4 x0, x1;
                    if constexpr (XB) { const u32x4 xw = *(const u32x4*)((const bf16_t*)X + off + bj * HALF);
                        x0 = (f32x4){__uint_as_float(xw.x << 16), __uint_as_float(xw.x & 0xffff0000u), __uint_as_float(xw.y << 16), __uint_as_float(xw.y & 0xffff0000u)};
                        x1 = (f32x4){__uint_as_float(xw.z << 16), __uint_as_float(xw.z & 0xffff0000u), __uint_as_float(xw.w << 16), __uint_as_float(xw.w & 0xffff0000u)}; }
                    else { x0 = *(const f32x4*)((const float*)X + off + bj * HALF); x1 = *(const f32x4*)((const float*)X + off + bj * HALF + 4); }
                    const f32x4 v0 = x0 * alpha + (gv[bj][0] * sar) * acc_i2f(acc[ai][bj][m][0]), v1 = x1 * alpha + (gv[bj][1] * sar) * acc_i2f(acc[ai][bj][m][1]);
                    if constexpr (ZB) { u32x4 w; w.x = cvt_pk_bf16(v0[0], v0[1]); w.y = cvt_pk_bf16(v0[2], v0[3]); w.z = cvt_pk_bf16(v1[0], v1[1]); w.w = cvt_pk_bf16(v1[2], v1[3]);
                        PG8_ST(u32x4, (bf16_t*)Z + off + bj * HALF, w); }
                    else { PG8_ST(f32x4, (float*)Z + off + bj * HALF, v0); PG8_ST(f32x4, (float*)Z + off + bj * HALF + 4, v1); } }
                asm volatile("" ::: "memory"); }
    }
};
template <class Epi, class Sched, bool ALIGN_EPI = false, bool SP2 = false, bool I8 = false>
__device__ __forceinline__ void gemm_phase(PG8_LAS unsigned char* lds, const Gemm g, const Sched& S, const Epi& E, const int tid_in) {
    const int tid = tid_in, wid = __builtin_amdgcn_readfirstlane(tid >> 6), lane = tid & 63, wr = wid >> 2, wc = wid & 3, fr = lane & 15, fq = lane >> 4;
    const int K = g.K, nt = K / BK;
    const int krot = ((nt & (nt - 1)) == 0) ? (S.krot & (nt - 1)) : 0;
#define PG8_KOFS(t) ((size_t)(((t) + krot) & (nt - 1)) * kstep)
    unsigned voffA[2], voffB[2];
#pragma unroll
    for (int i = 0; i < 2; ++i) { int R, C; stage_rc(tid * 16 + i * 8192, R, C); const int Rb = Epi::PERM ? ((R & ~31) + perm32(R & 31)) : R;
        voffA[i] = (unsigned)(R * K + C) * 2u; voffB[i] = (unsigned)(Rb * K + C) * 2u; }
    const size_t kstep = (size_t)(BK * 2);
    const size_t hstep = (size_t)HALF * K * 2;
    const size_t tstep = 2 * hstep;
    const unsigned ldsw = (unsigned)wid * 1024u;
    const int aoff = lds_byte(wr * 64 + fr, fq * 8), boff = lds_byte(wc * 32 + fr, fq * 8);
#define PG8_SA(b, h) (((b) * 2 + (h)) * HTB)
#define PG8_SB(b, h) ((4 + (b) * 2 + (h)) * HTB)
#define PG8_STAGE(bufoff, gbase, voff) do { _Pragma("unroll") for (int _i = 0; _i < 2; ++_i) \
        __builtin_amdgcn_global_load_lds((const unsigned*)((const char*)(gbase) + (voff)[_i]), (PG8_LAS unsigned*)(lds + (bufoff) + ldsw + _i * 8192), 16, 0, 0); } while (0)
#define PG8_LDA(dst, b, h) do { _Pragma("unroll") for (int m = 0; m < 4; ++m) _Pragma("unroll") for (int k = 0; k < 2; ++k) dst[m][k] = *(const PG8_LAS bf16x8*)(lds + PG8_SA(b, h) + aoff + m * 2048 + k * 1024); } while (0)
#define PG8_LDB(dst, b, h) do { _Pragma("unroll") for (int n = 0; n < 2; ++n) _Pragma("unroll") for (int k = 0; k < 2; ++k) dst[n][k] = *(const PG8_LAS bf16x8*)(lds + PG8_SB(b, h) + boff + n * 2048 + k * 1024); } while (0)
#define PG8_MMA(ai, bj, At, Bt) do { __builtin_amdgcn_s_setprio(1); _Pragma("unroll") for (int m = 0; m < 4; ++m) _Pragma("unroll") for (int n = 0; n < 2; ++n) _Pragma("unroll") for (int k = 0; k < 2; ++k) \
        { if constexpr (I8) acc[ai][bj][m][n] = __builtin_bit_cast(f32x4, __builtin_amdgcn_mfma_i32_16x16x64_i8(__builtin_bit_cast(i32x4, Bt[n][k]), __builtin_bit_cast(i32x4, At[m][k]), __builtin_bit_cast(i32x4, acc[ai][bj][m][n]), 0, 0, 0)); \
          else acc[ai][bj][m][n] = __builtin_amdgcn_mfma_f32_16x16x32_bf16(Bt[n][k], At[m][k], acc[ai][bj][m][n], 0, 0, 0); } __builtin_amdgcn_s_setprio(0); } while (0)
#define PG8_WAIT_V(n) asm volatile("s_waitcnt vmcnt(" #n ")" ::: "memory")
#define PG8_WAIT_L(n) asm volatile("s_waitcnt lgkmcnt(" #n ")" ::: "memory")
#define PG8_BAR __builtin_amdgcn_s_barrier()
#define PG8_SCHED __builtin_amdgcn_sched_barrier(0)
    Unit cur, nxt; int ui = 0;
    if (!S.next(0, cur)) return;
    f32x4 acc[2][2][4][2];
#pragma unroll
    for (int a = 0; a < 2; ++a)
#pragma unroll
        for (int b = 0; b < 2; ++b)
#pragma unroll
            for (int m = 0; m < 4; ++m)
#pragma unroll
                for (int n = 0; n < 2; ++n) acc[a][b][m][n] = (f32x4){0.f, 0.f, 0.f, 0.f};
    bf16x8 At[4][2], B0[2][2], B1[2][2];
    const char* cA = (const char*)g.A + (size_t)cur.pm * tstep; const char* cB = (const char*)g.Bt + (size_t)cur.pn * tstep;
    S.a_ready(cur);
    if constexpr (SP2) {
        PG8_STAGE(PG8_SB(0, 0), cB + PG8_KOFS(0), voffB); PG8_STAGE(PG8_SB(0, 1), cB + hstep + PG8_KOFS(0), voffB); PG8_STAGE(PG8_SA(0, 0), cA + PG8_KOFS(0), voffA); PG8_STAGE(PG8_SA(0, 1), cA + hstep + PG8_KOFS(0), voffA);
        if (wr == 1) PG8_BAR;
        PG8_WAIT_V(2); PG8_BAR;
        PG8_STAGE(PG8_SB(1, 0), cB + PG8_KOFS(1), voffB); PG8_STAGE(PG8_SA(1, 0), cA + PG8_KOFS(1), voffA); PG8_STAGE(PG8_SB(1, 1), cB + hstep + PG8_KOFS(1), voffB);
        PG8_WAIT_V(6); PG8_BAR;
    } else {
        PG8_STAGE(PG8_SB(0, 0), cB + PG8_KOFS(0), voffB); PG8_STAGE(PG8_SA(0, 0), cA + PG8_KOFS(0), voffA); PG8_STAGE(PG8_SB(0, 1), cB + hstep + PG8_KOFS(0), voffB); PG8_STAGE(PG8_SA(0, 1), cA + hstep + PG8_KOFS(0), voffA);
        if (wr == 1) PG8_BAR;
        PG8_WAIT_V(4); PG8_BAR;
        PG8_STAGE(PG8_SB(1, 0), cB + PG8_KOFS(1), voffB); PG8_STAGE(PG8_SA(1, 0), cA + PG8_KOFS(1), voffA); PG8_STAGE(PG8_SB(1, 1), cB + hstep + PG8_KOFS(1), voffB);
        PG8_WAIT_V(6); PG8_BAR;
    }
    for (;;) {
        const bool has_next = S.next(ui + 1, nxt);
        const char* nA = has_next ? (const char*)g.A + (size_t)nxt.pm * tstep : cA; const char* nB = has_next ? (const char*)g.Bt + (size_t)nxt.pn * tstep : cB;
#ifdef PG8_KREP
        for (int kr_ = 0; kr_ < PG8_KREP; ++kr_) {
        if (kr_) {
#pragma unroll
        for (int a = 0; a < 2; ++a)
#pragma unroll
            for (int b = 0; b < 2; ++b)
#pragma unroll
                for (int m = 0; m < 4; ++m)
#pragma unroll
                    for (int n = 0; n < 2; ++n) acc[a][b][m][n] = (f32x4){0.f, 0.f, 0.f, 0.f}; }
        const char* nA_ = (kr_ + 1 < PG8_KREP) ? cA : nA; const char* nB_ = (kr_ + 1 < PG8_KREP) ? cB : nB;
#else
        const char* nA_ = nA; const char* nB_ = nB;
#endif
        for (int t = 0; t < nt; t += 2) {
            const bool last = (t == nt - 2);
            const char* a1 = cA + PG8_KOFS(t + 1);
            const char* a2 = (last ? nA_ : cA) + PG8_KOFS(t + 2); const char* b2 = (last ? nB_ : cB) + PG8_KOFS(t + 2);
            const char* a3 = (last ? nA_ : cA) + PG8_KOFS(t + 3); const char* b3 = (last ? nB_ : cB) + PG8_KOFS(t + 3);
            if (last && has_next) S.a_ready(nxt);
            if constexpr (SP2) {
            PG8_LDB(B0, 0, 0); PG8_LDB(B1, 0, 1); PG8_SCHED; PG8_LDA(At, 0, 0); PG8_STAGE(PG8_SA(1, 1), a1 + hstep, voffA);
            PG8_WAIT_V(8); PG8_WAIT_L(0); PG8_BAR; PG8_MMA(0, 0, At, B0); PG8_MMA(0, 1, At, B1); PG8_BAR; PG8_SCHED;
            PG8_LDA(At, 0, 1); PG8_STAGE(PG8_SB(0, 0), b2, voffB); PG8_STAGE(PG8_SB(0, 1), b2 + hstep, voffB); PG8_STAGE(PG8_SA(0, 0), a2, voffA);
            PG8_WAIT_V(8); PG8_WAIT_L(0); PG8_BAR; PG8_MMA(1, 0, At, B0); PG8_MMA(1, 1, At, B1); PG8_BAR; PG8_SCHED;
            PG8_LDB(B0, 1, 0); PG8_LDB(B1, 1, 1); PG8_SCHED; PG8_LDA(At, 1, 0); PG8_STAGE(PG8_SA(0, 1), a2 + hstep, voffA);
            PG8_WAIT_V(8); PG8_WAIT_L(0); PG8_BAR; PG8_MMA(0, 0, At, B0); PG8_MMA(0, 1, At, B1); PG8_BAR; PG8_SCHED;
            PG8_LDA(At, 1, 1); PG8_STAGE(PG8_SB(1, 0), b3, voffB); PG8_STAGE(PG8_SB(1, 1), b3 + hstep, voffB); PG8_STAGE(PG8_SA(1, 0), a3, voffA);
            PG8_WAIT_V(8); PG8_WAIT_L(0); PG8_BAR; PG8_MMA(1, 0, At, B0); PG8_MMA(1, 1, At, B1); PG8_BAR; PG8_SCHED;
            } else {
            PG8_LDB(B0, 0, 0); PG8_SCHED; PG8_LDA(At, 0, 0); PG8_STAGE(PG8_SA(1, 1), a1 + hstep, voffA);
            PG8_WAIT_L(8); PG8_BAR; PG8_WAIT_L(0); PG8_MMA(0, 0, At, B0); PG8_BAR; PG8_SCHED;
            PG8_LDB(B1, 0, 1); PG8_STAGE(PG8_SB(0, 0), b2, voffB);
            PG8_BAR; PG8_WAIT_L(0); PG8_MMA(0, 1, At, B1); PG8_BAR;
            PG8_LDA(At, 0, 1); PG8_STAGE(PG8_SA(0, 0), a2, voffA);
            PG8_BAR; PG8_WAIT_L(0); PG8_MMA(1, 0, At, B0); PG8_BAR; PG8_SCHED;
            PG8_STAGE(PG8_SB(0, 1), b2 + hstep, voffB);
            PG8_WAIT_V(6); PG8_BAR; PG8_MMA(1, 1, At, B1); PG8_BAR;
            PG8_LDB(B0, 1, 0); PG8_SCHED; PG8_LDA(At, 1, 0); PG8_STAGE(PG8_SA(0, 1), a2 + hstep, voffA);
            PG8_WAIT_L(8); PG8_BAR; PG8_WAIT_L(0); PG8_MMA(0, 0, At, B0); PG8_BAR; PG8_SCHED;
            PG8_LDB(B1, 1, 1); PG8_STAGE(PG8_SB(1, 0), b3, voffB);
            PG8_BAR; PG8_WAIT_L(0); PG8_MMA(0, 1, At, B1); PG8_BAR;
            PG8_LDA(At, 1, 1); PG8_STAGE(PG8_SA(1, 0), a3, voffA);
            PG8_BAR; PG8_WAIT_L(0); PG8_MMA(1, 0, At, B0); PG8_BAR; PG8_SCHED;
            PG8_STAGE(PG8_SB(1, 1), b3 + hstep, voffB);
            PG8_WAIT_V(6); PG8_BAR; PG8_MMA(1, 1, At, B1); PG8_BAR;
            }
        }
#ifdef PG8_KREP
        }
#endif
        if constexpr (ALIGN_EPI) { if (wr == 0) PG8_BAR; }
#ifdef PG8_EPI2
        if constexpr (!Epi::AFTER_DRAIN) { E(acc, cur, wr, wc, fr, fq); asm volatile("" ::: "memory"); }
#endif
        if constexpr (!Epi::AFTER_DRAIN) { E(acc, cur, wr, wc, fr, fq); S.done(cur); }
        if (!has_next) break;
#pragma unroll
        for (int a = 0; a < 2; ++a)
#pragma unroll
            for (int b = 0; b < 2; ++b)
#pragma unroll
                for (int m = 0; m < 4; ++m)
#pragma unroll
                    for (int n = 0; n < 2; ++n) acc[a][b][m][n] = (f32x4){0.f, 0.f, 0.f, 0.f};
        cur = nxt; cA = nA; cB = nB; ++ui;
        if constexpr (ALIGN_EPI) { if (wr == 1) PG8_BAR; }
    }
    PG8_WAIT_V(0);
    if constexpr (!ALIGN_EPI) { if (wr == 0) PG8_BAR; }
    PG8_BAR;
    if constexpr (Epi::AFTER_DRAIN) { E.fused(acc, cur, wr, wc, fr, fq, lds, wid, lane); S.done(cur); }
#undef PG8_SA
#undef PG8_SB
#undef PG8_STAGE
#undef PG8_LDA
#undef PG8_LDB
#undef PG8_MMA
#undef PG8_WAIT_V
#undef PG8_WAIT_L
#undef PG8_BAR
#undef PG8_SCHED
#undef PG8_KOFS
}
}
#define XB_TMO      128
#define XB_XCNT(j)  (256  + 64 * (j))
#define XB_XSUB(j)  (1280 + 64 * (j))
#define XB_XGEN(j)  (2304 + 64 * (j))
#define XB_TOP      3328
#define XB_TOPGEN   3392
#define XCD_BAR_WORDS 3456
#define XB_SPIN_CAP (1u << 18)
#define LAS __attribute__((address_space(3)))

__device__ __forceinline__ unsigned xb_ld(unsigned* p)              { return __hip_atomic_load(p, __ATOMIC_RELAXED, __HIP_MEMORY_SCOPE_AGENT); }
__device__ __forceinline__ unsigned xb_add(unsigned* p, unsigned v) { return __hip_atomic_fetch_add(p, v, __ATOMIC_RELAXED, __HIP_MEMORY_SCOPE_AGENT); }
__device__ __forceinline__ unsigned xb_xcc_id() { return (unsigned)__builtin_amdgcn_s_getreg((3 << 11) | 20) & 0xFu; }
#define XB_SPIN(cond, bar) do { unsigned _sp = 0; while (cond) { __builtin_amdgcn_s_sleep(1); \
    if ((++_sp & 255u) == 0u) { if (xb_ld(&(bar)[XB_TMO])) break; if (_sp > XB_SPIN_CAP) { atomicAdd(&(bar)[XB_TMO], 1u); break; } } } } while (0)

struct XcdBarrier {
    unsigned* bar; unsigned x;
    volatile LAS unsigned* st;
};

__device__ __forceinline__ XcdBarrier xcd_barrier_post(unsigned* bar, volatile LAS unsigned* st) {
    XcdBarrier b; b.bar = bar; b.x = xb_xcc_id(); b.st = st;
    if (threadIdx.x == 0) (void)xb_add(&bar[XB_XCNT(b.x)], 1u);
    return b;
}
__device__ __forceinline__ void xcd_barrier_complete(unsigned* bar, unsigned x, unsigned& nloc, unsigned& nx) {
    const unsigned G = gridDim.x * gridDim.y * gridDim.z;
    unsigned sum, cnt, mine, sp = 0u;
    for (;;) {
        sum = 0u; cnt = 0u; mine = 0u;
#pragma unroll
        for (unsigned j = 0; j < 16; ++j) { const unsigned c = xb_ld(&bar[XB_XCNT(j)]); sum += c; cnt += (c > 0u) ? 1u : 0u; mine = (j == x) ? c : mine; }
        if (sum == G) break;
        __builtin_amdgcn_s_sleep(1);
        if ((++sp & 255u) == 0u) { if (xb_ld(&bar[XB_TMO])) break; if (sp > XB_SPIN_CAP) { atomicAdd(&bar[XB_TMO], 1u); break; } }
    }
    nloc = mine > 0u ? mine : 1u; nx = cnt > 0u ? cnt : 1u;
}

__device__ __forceinline__ void xcd_barrier(const XcdBarrier& b) {
    asm volatile("s_waitcnt vmcnt(0)" ::: "memory");
    __syncthreads();
    if (threadIdx.x == 0) {
        unsigned* bar = b.bar;
        __builtin_amdgcn_s_waitcnt(0);
        unsigned nloc = b.st[0], nx = b.st[1];
        if (nloc == 0u) { xcd_barrier_complete(bar, b.x, nloc, nx); b.st[0] = nloc; b.st[1] = nx; }
        const unsigned old = xb_add(&bar[XB_XSUB(b.x)], 1u);
        const unsigned gen = old / nloc;
        if (old + 1u == (gen + 1u) * nloc) {
            __builtin_amdgcn_fence(__ATOMIC_RELEASE, "agent");
            asm volatile("s_waitcnt vmcnt(0)" ::: "memory");
            const unsigned og = xb_add(&bar[XB_TOP], 1u);
            const unsigned tg = og / nx;
            if (og + 1u == (tg + 1u) * nx) xb_add(&bar[XB_TOPGEN], 1u);
            else XB_SPIN(xb_ld(&bar[XB_TOPGEN]) == tg, bar);
            __builtin_amdgcn_fence(__ATOMIC_ACQUIRE, "agent");
            xb_add(&bar[XB_XGEN(b.x)], 1u);
            asm volatile("s_waitcnt vmcnt(0)" ::: "memory");
        } else {
            XB_SPIN(xb_ld(&bar[XB_XGEN(b.x)]) == gen, bar);
            __builtin_amdgcn_fence(__ATOMIC_ACQUIRE, "agent");
            asm volatile("s_waitcnt vmcnt(0)" ::: "memory");
        }
    }
    __syncthreads();
}
constexpr int D = 2048, NB = 8, SEQ = 2048, NL = 4, T = NB * SEQ;
constexpr int NCH = SEQ / 64, NCHUNK = T / 64;
constexpr int GKW = 512, RANK = 16;
constexpr int INW = 6160, NP = 6144;
constexpr int NE = 16384;
constexpr float ALPHA = 1.6817928305074290f, EPS = 1e-5f;
constexpr int PQ = 0, PK = 512, PV = 1024, PR = 2048, PCB = 3072, PCC = 4096, PCH = 5120;
constexpr int NWAVES = 8, NTHREADS = 512;
#ifndef WGM_IN
#define WGM_IN 4
#endif
#ifndef WGM_OUT
#define WGM_OUT 4
#endif
#ifndef WGM_WQ
#define WGM_WQ 4
#endif
#ifndef TAB4
#define TAB4 1
#endif
constexpr int NPHASES = 2 + 7 * NL;

constexpr size_t MiB = 1u << 20;
constexpr size_t WS_CTL = 0, CTL_ZERO_BYTES = 1 * MiB;
constexpr size_t WS_MOD = 1 * MiB, WS_PART = 3 * MiB, WS_KEYS = 15 * MiB, WS_DTOT = 17 * MiB, WS_WIN = 18 * MiB, WS_WOUT = 115 * MiB, WS_WQ = 147 * MiB;
constexpr size_t WS_UT = 179 * MiB, WS_VT = 435 * MiB, WS_H = 691 * MiB, WS_PROJ = 755 * MiB, WS_E = 947 * MiB, WS_OGLA = 979 * MiB, WS_Y = 1043 * MiB;
constexpr size_t WS_Z = 1107 * MiB, WS_X1 = 1235 * MiB, WS_X = 1363 * MiB, WS_Q = 1491 * MiB, WS_H2 = 1555 * MiB, WS_HQ8 = 1619 * MiB, WS_H8 = 1659 * MiB, WS_WIN8 = 1691 * MiB, WS_WOUT8 = 1739 * MiB, WS_WQ8 = 1755 * MiB, WS_Y8 = 1771 * MiB, WS_H28 = 1803 * MiB, WS_END = 1835 * MiB;
constexpr size_t WS_SU = 17 * MiB + 512 * 1024, WS_SV = 17 * MiB + 768 * 1024, WS_HSC = 2 * MiB + 640 * 1024;
static_assert(WS_WIN + (size_t)NL * INW * D * 2 <= WS_WOUT && WS_PART + (size_t)NL * 8 * NB * 6 * D * 4 <= WS_KEYS && WS_MOD + (size_t)NL * NB * 6 * D * 4 <= WS_PART, "ws map");
constexpr size_t WS_SAH = WS_SU, WS_SAY = WS_SU + 65536, WS_SB = WS_SV; constexpr int SBL = NP + 2 * D;
constexpr size_t WS_SBA = WS_SB + (size_t)NL * SBL * 4, WS_ALR8 = WS_SU + 131072;
#ifndef KROT_A
#define KROT_A 0
#endif
#ifndef KROT_B
#define KROT_B 0
#endif
#define KROT(c) (KROT_A * (((c) >> 3) & 3) + KROT_B * ((c) >> 5))
#ifndef RES16
#define RES16 1
#endif
#ifndef RES16_X
#define RES16_X RES16
#endif
#ifndef RES16_Z
#define RES16_Z RES16
#endif
#ifndef RES16_X1
#define RES16_X1 RES16
#endif
#ifndef I8_GATE
#define I8_GATE 1
#endif
#ifndef I8_WQ
#define I8_WQ 1
#endif
#ifndef I8_IN
#define I8_IN 1
#endif
#ifndef I8_OUT
#define I8_OUT 1
#endif
constexpr int CW_BAR = 4096;

constexpr int RING_OFF = 0, RING_BYTES = 131072, LDSCTL_OFF = RING_BYTES, LDS_BYTES = 147456;

#define GAS __attribute__((address_space(1)))
typedef unsigned short bf16;
typedef unsigned v4u __attribute__((ext_vector_type(4)));
typedef unsigned v2u __attribute__((ext_vector_type(2)));
typedef int v4i __attribute__((ext_vector_type(4)));
typedef float f32x4 __attribute__((ext_vector_type(4)));
typedef float f32x16 __attribute__((ext_vector_type(16)));
typedef short bf16x8 __attribute__((ext_vector_type(8)));
typedef __bf16 bf16x2v __attribute__((ext_vector_type(2)));
#define LDS_WAIT() asm volatile("s_waitcnt lgkmcnt(0)" ::: "memory")

__device__ __forceinline__ unsigned pk2(float lo, float hi) { return pg8::cvt_pk_bf16(lo, hi); }
__device__ __forceinline__ float dot2bf(unsigned w, unsigned x, float acc) { return __builtin_amdgcn_fdot2_f32_bf16(__builtin_bit_cast(bf16x2v, w), __builtin_bit_cast(bf16x2v, x), acc, false); }
__device__ __forceinline__ float bflo(unsigned u) { return __uint_as_float(u << 16); }
__device__ __forceinline__ float bfhi(unsigned u) { return __uint_as_float(u & 0xffff0000u); }
__device__ __forceinline__ float silu_f(float x) { return x / (1.0f + __expf(-x)); }
__device__ __forceinline__ float logsigmoid_f(float x) { return fminf(x, 0.0f) - log1pf(__expf(-fabsf(x))); }
__device__ __forceinline__ float logsigmoid_fast(float x) { return fminf(x, 0.0f) - __logf(1.0f + __expf(-fabsf(x))); }
__device__ __forceinline__ float gelu_tanh_f(float x) { const float u = 0.7978845608028654f * (x + 0.044715f * x * x * x); return 0.5f * x * (1.0f + tanhf(u)); }
__device__ __forceinline__ unsigned pack_i8(float a, float b, float c, float d) {
    const int q0 = (int)__builtin_rintf(a), q1 = (int)__builtin_rintf(b), q2 = (int)__builtin_rintf(c), q3 = (int)__builtin_rintf(d);
    return (unsigned)(q0 & 255) | ((unsigned)(q1 & 255) << 8) | ((unsigned)(q2 & 255) << 16) | ((unsigned)(q3 & 255) << 24); }
__device__ __forceinline__ float wave_sum(float v) {
#pragma unroll
    for (int o = 1; o < 64; o <<= 1) v += __shfl_xor(v, o);
    return v;
}

struct Args { const float* in[19]; float* out; unsigned char* ws; int ph_lo, ph_hi; };

__device__ __forceinline__ void transpose_item(const float* W, int ldw, int col0, bf16* WTrows, int k0, int nvalid, LAS float* scr, int lane) {
    const int n = lane & 31;
    float tv[32];
#pragma unroll
    for (int i = 0; i < 32; ++i) { const int kk = 2 * i + (lane >> 5); tv[i] = (n < nvalid) ? W[(size_t)(k0 + kk) * ldw + col0 + n] : 0.f; }
#pragma unroll
    for (int i = 0; i < 32; ++i) { const int kk = 2 * i + (lane >> 5); scr[kk * 33 + n] = tv[i]; }
    LDS_WAIT(); asm volatile("" ::: "memory");
    const int c = lane & 7;
#pragma unroll
    for (int j = 0; j < 4; ++j) { const int nn = (lane >> 3) + 8 * j; const LAS float* s = scr + (8 * c) * 33 + nn;
        v4u o; o.x = pk2(s[0 * 33], s[1 * 33]); o.y = pk2(s[2 * 33], s[3 * 33]); o.z = pk2(s[4 * 33], s[5 * 33]); o.w = pk2(s[6 * 33], s[7 * 33]);
        if (nn < nvalid) *(v4u*)(WTrows + (size_t)nn * D + k0 + 8 * c) = o; }
    LDS_WAIT(); asm volatile("" ::: "memory");
}
__device__ __forceinline__ void cvt_stream(const float* src, bf16* dst, size_t n4, size_t i0, size_t stride) {
    for (size_t i = i0; i < n4; i += stride) { const f32x4 v = ((const f32x4*)src)[i]; v2u o; o.x = pk2(v.x, v.y); o.y = pk2(v.z, v.w); ((v2u*)dst)[i] = o; }
}
__device__ __forceinline__ void ph_prologue_a(const Args& a, LAS unsigned char* lds, int tid, int lane, int wave, int bx, int G) {
    const int gw = bx * NWAVES + wave, NGW = G * NWAVES;
    LAS float* cact = (LAS float*)lds;
    for (int i = tid; i < NB * D; i += NTHREADS) { const int b = i / D, d = i % D; cact[d * 8 + b] = silu_f(a.in[1][i]); }
    __syncthreads();
    float* part = (float*)(a.ws + WS_PART);
    for (int it = gw; it < NL * 8 * 48; it += NGW) {
        const int cg = it % 48, dr = (it / 48) % 8, l = it / 384;
        f32x4 acc[8];
#pragma unroll
        for (int b = 0; b < 8; ++b) acc[b] = (f32x4){0.f, 0.f, 0.f, 0.f};
        const float* w = a.in[2] + ((size_t)l * D + dr * 256) * (6 * D) + cg * 256 + lane * 4;
#pragma unroll 4
        for (int d = 0; d < 256; ++d) {
            const f32x4 wv = *(const f32x4*)(w + (size_t)d * (6 * D));
            const f32x4 c0 = *(const LAS f32x4*)(cact + (dr * 256 + d) * 8), c1 = *(const LAS f32x4*)(cact + (dr * 256 + d) * 8 + 4);
            acc[0] += wv * c0.x; acc[1] += wv * c0.y; acc[2] += wv * c0.z; acc[3] += wv * c0.w;
            acc[4] += wv * c1.x; acc[5] += wv * c1.y; acc[6] += wv * c1.z; acc[7] += wv * c1.w;
        }
#pragma unroll
        for (int b = 0; b < 8; ++b) *(f32x4*)(part + (((size_t)l * 8 + dr) * NB + b) * (6 * D) + cg * 256 + lane * 4) = acc[b];
    }
    __syncthreads();
    LAS float* scr = (LAS float*)(lds + wave * 8448);
    bf16* winT = (bf16*)(a.ws + WS_WIN); bf16* woutT = (bf16*)(a.ws + WS_WOUT); bf16* wqT = (bf16*)(a.ws + WS_WQ);
    constexpr int IPL = 6144 + 32 + 2048 + 2048;
    for (int it = gw; it < NL * IPL; it += NGW) {
        const int l = it / IPL; int r = it % IPL;
        if (r < 6144) { const int nb = r % 192, kb = r / 192, n0 = nb * 32;
            transpose_item(a.in[4] + (size_t)l * D * INW, INW, n0 < 3072 ? n0 : n0 + 16, winT + ((size_t)l * INW + n0) * D, kb * 64, 32, scr, lane); continue; }
        r -= 6144;
        if (r < 32) { transpose_item(a.in[4] + (size_t)l * D * INW, INW, 3072, winT + ((size_t)l * INW + NP) * D, r * 64, 16, scr, lane); continue; }
        r -= 32;
        if (r < 2048) { const int nb = r % 64, kb = r / 64; transpose_item(a.in[10] + (size_t)l * D * D, D, nb * 32, woutT + ((size_t)l * D + nb * 32) * D, kb * 64, 32, scr, lane); continue; }
        r -= 2048;
        { const int nb = r % 64, kb = r / 64; transpose_item(a.in[13] + (size_t)l * D * D, D, nb * 32, wqT + ((size_t)l * D + nb * 32) * D, kb * 64, 32, scr, lane); }
    }
    const size_t i0 = (size_t)bx * NTHREADS + tid, stride = (size_t)G * NTHREADS;
    cvt_stream(a.in[14], (bf16*)(a.ws + WS_KEYS), (size_t)NL * 8 * 2 * 128 * 128 / 4, i0, stride);
#if TAB4
    __syncthreads();
    { LAS float* rowst = (LAS float*)(lds + wave * 8192);
      f32x4 vnx[8];
      if (gw < 2 * NL * NE) { const int tbl0 = gw / (NL * NE), r0 = gw % (NL * NE); const float* s0 = (tbl0 ? a.in[16] : a.in[15]) + (size_t)r0 * D;
#pragma unroll
          for (int c8 = 0; c8 < 8; ++c8) vnx[c8] = *(const f32x4*)(s0 + (c8 * 64 + lane) * 4); }
      for (int row = gw; row < 2 * NL * NE; row += NGW) {
        const int tbl = row / (NL * NE), r = row % (NL * NE);
#pragma unroll
        for (int c8 = 0; c8 < 8; ++c8) *(LAS f32x4*)(rowst + (c8 * 64 + lane) * 4) = vnx[c8];
        { const int rown = row + NGW < 2 * NL * NE ? row + NGW : row; const int tbln = rown / (NL * NE), rn = rown % (NL * NE); const float* sn = (tbln ? a.in[16] : a.in[15]) + (size_t)rn * D;
#pragma unroll
          for (int c8 = 0; c8 < 8; ++c8) vnx[c8] = *(const f32x4*)(sn + (c8 * 64 + lane) * 4); }
        LDS_WAIT(); asm volatile("" ::: "memory");
        unsigned char* tb = a.ws + (tbl ? WS_VT : WS_UT) + (size_t)r * 1152;
#pragma unroll
        for (int pass = 0; pass < 2; ++pass) { const int slot = lane + 64 * pass;
            if (slot < 72) { const int col0 = (slot >> 3) * 240 + (slot & 7) * 30;
                float x[30]; float mx = 0.f;
#pragma unroll
                for (int k = 0; k < 30; ++k) { x[k] = (col0 + k < D) ? rowst[col0 + k] : 0.f; mx = fmaxf(mx, fabsf(x[k])); }
                int code = 0; float inv = 0.f;
                if (mx > 0.f) { code = (int)ceilf(8.0f * log2f(mx * (1.0f / 7.0f))) + 128; code = code < 0 ? 0 : (code > 255 ? 255 : code); inv = __builtin_amdgcn_exp2f(16.0f - (float)code * 0.125f); }
                unsigned dw[4] = {0u, 0u, 0u, 0u};
#pragma unroll
                for (int kb = 0; kb < 15; ++kb) { int a0 = (int)__builtin_rintf(x[2 * kb] * inv), a1 = (int)__builtin_rintf(x[2 * kb + 1] * inv);
                    a0 = a0 < -7 ? -7 : (a0 > 7 ? 7 : a0); a1 = a1 < -7 ? -7 : (a1 > 7 ? 7 : a1);
                    dw[kb >> 2] |= ((unsigned)(a0 + 8) | ((unsigned)(a1 + 8) << 4)) << (8 * (kb & 3)); }
                dw[3] |= (unsigned)code << 24;
                *(v4u*)(tb + slot * 16) = (v4u){dw[0], dw[1], dw[2], dw[3]}; } }
        LDS_WAIT(); asm volatile("" ::: "memory");
      } }
#else
    for (int row = gw; row < 2 * NL * NE; row += NGW) {
        const int tbl = row / (NL * NE), r = row % (NL * NE);
        const float* src = (tbl ? a.in[16] : a.in[15]) + (size_t)r * D;
        f32x4 v[8]; float mx = 0.f;
#pragma unroll
        for (int c8 = 0; c8 < 8; ++c8) { v[c8] = *(const f32x4*)(src + (c8 * 64 + lane) * 4); mx = fmaxf(mx, fmaxf(fmaxf(fabsf(v[c8].x), fabsf(v[c8].y)), fmaxf(fabsf(v[c8].z), fabsf(v[c8].w)))); }
#pragma unroll
        for (int o = 1; o < 64; o <<= 1) mx = fmaxf(mx, __shfl_xor(mx, o));
        const float inv = mx > 0.f ? 127.0f / mx : 0.f; const int off = tbl ? 128 : 0;
        unsigned dw[8];
#pragma unroll
        for (int c8 = 0; c8 < 8; ++c8) { const int q0 = (int)__builtin_rintf(v[c8].x * inv) + off, q1 = (int)__builtin_rintf(v[c8].y * inv) + off, q2 = (int)__builtin_rintf(v[c8].z * inv) + off, q3 = (int)__builtin_rintf(v[c8].w * inv) + off;
            dw[c8] = (unsigned)(q0 & 255) | ((unsigned)(q1 & 255) << 8) | ((unsigned)(q2 & 255) << 16) | ((unsigned)(q3 & 255) << 24); }
        unsigned char* dst = a.ws + (tbl ? WS_VT : WS_UT) + (size_t)r * D;
        *(v4u*)(dst + lane * 16) = (v4u){dw[0], dw[1], dw[2], dw[3]}; *(v4u*)(dst + (64 + lane) * 16) = (v4u){dw[4], dw[5], dw[6], dw[7]};
        if (lane == 0) ((float*)(a.ws + (tbl ? WS_SV : WS_SU)))[r] = mx * (1.0f / 127.0f);
    }
#endif
}

__device__ __forceinline__ void ln_tail(const float (&z)[32], int t, int lane, const float* g, const float* bta, float* xout, const float* sh, const float* sc, bf16* hout, unsigned char* q8, float* q8s, LAS unsigned char* q8stage = nullptr, unsigned char* a8 = nullptr, float* a8s = nullptr, bf16* xb = nullptr) {
    float s = 0.f;
#pragma unroll
    for (int i = 0; i < 32; ++i) s += z[i];
    const float mu = wave_sum(s) * (1.0f / D);
    float q = 0.f;
#pragma unroll
    for (int i = 0; i < 32; ++i) { const float d = z[i] - mu; q += d * d; }
    const float rs = rsqrtf(wave_sum(q) * (1.0f / D) + EPS);
    float hv[32]; float mx = 0.f;
#pragma unroll
    for (int c = 0; c < 8; ++c) { const int col = (c * 64 + lane) * 4;
        const f32x4 g0 = *(const f32x4*)(g + col), b0 = *(const f32x4*)(bta + col);
        f32x4 x0;
        x0.x = (z[c * 4 + 0] - mu) * rs * g0.x + b0.x; x0.y = (z[c * 4 + 1] - mu) * rs * g0.y + b0.y; x0.z = (z[c * 4 + 2] - mu) * rs * g0.z + b0.z; x0.w = (z[c * 4 + 3] - mu) * rs * g0.w + b0.w;
        if (xb) { v2u o; o.x = pk2(x0.x, x0.y); o.y = pk2(x0.z, x0.w); *(v2u*)(xb + (size_t)t * D + col) = o; }
        else if (xout) *(f32x4*)(xout + (size_t)t * D + col) = x0;
        if (hout || q8 || a8) { const f32x4 s0 = *(const f32x4*)(sc + col), h0 = *(const f32x4*)(sh + col);
            hv[c * 4] = x0.x * (1.f + s0.x) + h0.x; hv[c * 4 + 1] = x0.y * (1.f + s0.y) + h0.y; hv[c * 4 + 2] = x0.z * (1.f + s0.z) + h0.z; hv[c * 4 + 3] = x0.w * (1.f + s0.w) + h0.w;
            if (hout) { v2u o; o.x = pk2(hv[c * 4], hv[c * 4 + 1]); o.y = pk2(hv[c * 4 + 2], hv[c * 4 + 3]);
                *(v2u*)(hout + (size_t)t * D + col) = o; }
            if (q8 || a8) mx = fmaxf(mx, fmaxf(fmaxf(fabsf(hv[c * 4]), fabsf(hv[c * 4 + 1])), fmaxf(fabsf(hv[c * 4 + 2]), fabsf(hv[c * 4 + 3])))); }
    }
    if (q8 || a8) {
#pragma unroll
        for (int o = 1; o < 64; o <<= 1) mx = fmaxf(mx, __shfl_xor(mx, o));
        const float qmax_ = (q8 && TAB4) ? 119.0f : 127.0f;
        const float inv = mx > 0.f ? qmax_ / mx : 0.f;
        unsigned dw[8];
#pragma unroll
        for (int c = 0; c < 8; ++c) { const int q0 = (int)__builtin_rintf(hv[c * 4] * inv), q1 = (int)__builtin_rintf(hv[c * 4 + 1] * inv), q2 = (int)__builtin_rintf(hv[c * 4 + 2] * inv), q3 = (int)__builtin_rintf(hv[c * 4 + 3] * inv);
            dw[c] = (unsigned)(q0 & 255) | ((unsigned)(q1 & 255) << 8) | ((unsigned)(q2 & 255) << 16) | ((unsigned)(q3 & 255) << 24); }
        if (a8) {
#pragma unroll
            for (int c = 0; c < 8; ++c) *(unsigned*)(a8 + (size_t)t * D + (c * 64 + lane) * 4) = dw[c];
            if (a8s && lane == 0) a8s[t] = mx / qmax_; }
        if (q8) {
#if TAB4
        { LAS unsigned* st32 = (LAS unsigned*)q8stage; LAS unsigned char* st8 = (LAS unsigned char*)q8stage;
#pragma unroll
          for (int i = 0; i < 9; ++i) st32[lane + 64 * i] = 0u;
          LDS_WAIT(); asm volatile("" ::: "memory");
#pragma unroll
          for (int c = 0; c < 8; ++c)
#pragma unroll
              for (int jp = 0; jp < 2; ++jp) { const int col = (c * 64 + lane) * 4 + 2 * jp, u = col / 240, r = col - u * 240, l7 = r / 30, k = r - l7 * 30;
                  const int q0 = (int)(signed char)((dw[c] >> (16 * jp)) & 255u), q1 = (int)(signed char)((dw[c] >> (16 * jp + 8)) & 255u);
                  const int l0 = ((q0 + 8) & 15) - 8, l1 = ((q1 + 8) & 15) - 8, h0 = (q0 - l0) >> 4, h1 = (q1 - l1) >> 4;
                  LAS unsigned char* sp = st8 + (u * 8 + l7) * 32 + (k >> 1);
                  sp[0] = (unsigned char)((l0 & 15) | ((l1 & 15) << 4)); sp[16] = (unsigned char)((h0 & 15) | ((h1 & 15) << 4)); }
          LDS_WAIT(); asm volatile("" ::: "memory");
          unsigned* d32 = (unsigned*)(q8 + (size_t)t * 2304);
#pragma unroll
          for (int i = 0; i < 9; ++i) d32[lane + 64 * i] = st32[lane + 64 * i];
          LDS_WAIT(); asm volatile("" ::: "memory"); }
#else
        unsigned char* dst = q8 + (size_t)t * D;
        *(v4u*)(dst + lane * 16) = (v4u){dw[0], dw[1], dw[2], dw[3]}; *(v4u*)(dst + (64 + lane) * 16) = (v4u){dw[4], dw[5], dw[6], dw[7]};
#endif
        if (lane == 0) q8s[t] = mx / qmax_; }
    }
}

__device__ __forceinline__ void ph_prologue_b(const Args& a, LAS unsigned char* lds, int tid, int lane, int wave, int bx, int G) {
    const float* part = (const float*)(a.ws + WS_PART); float* mod = (float*)(a.ws + WS_MOD);
    for (int i = bx * NTHREADS + tid; i < NL * NB * 6 * D / 4; i += G * NTHREADS) {
        const int idx = i * 4, e = idx % (6 * D), b = (idx / (6 * D)) % NB, l = idx / (6 * D * NB);
        f32x4 s = *(const f32x4*)(a.in[3] + l * 6 * D + e);
#pragma unroll
        for (int dr = 0; dr < 8; ++dr) s += *(const f32x4*)(part + (((size_t)l * 8 + dr) * NB + b) * (6 * D) + e);
        *(f32x4*)(mod + idx) = s;
    }
    LAS float* msh = (LAS float*)lds;
    bf16* hbuf = (bf16*)(a.ws + WS_H);
    for (int ch = bx; ch < NCHUNK; ch += G) {
        const int b = ch / NCH;
        for (int i = tid; i < 1024; i += NTHREADS) { const int e = i * 4;
            f32x4 s = *(const f32x4*)(a.in[3] + e);
#pragma unroll
            for (int dr = 0; dr < 8; ++dr) s += *(const f32x4*)(part + (((size_t)0 * 8 + dr) * NB + b) * (6 * D) + e);
            *(LAS f32x4*)(msh + e) = s; }
        __syncthreads();
        for (int i = 0; i < 8; ++i) { const int t = ch * 64 + wave * 8 + i;
            float hv[32]; float mx = 0.f;
#pragma unroll
            for (int c = 0; c < 4; ++c) { const int col = (c * 64 + lane) * 8;
                const f32x4 x0 = *(const f32x4*)(a.in[0] + (size_t)t * D + col), x1 = *(const f32x4*)(a.in[0] + (size_t)t * D + col + 4);
                const f32x4 h0 = *(const LAS f32x4*)(msh + col), h1 = *(const LAS f32x4*)(msh + col + 4), s0 = *(const LAS f32x4*)(msh + 2048 + col), s1 = *(const LAS f32x4*)(msh + 2048 + col + 4);
#pragma unroll
                for (int j = 0; j < 4; ++j) { hv[c * 8 + j] = x0[j] * (1.f + s0[j]) + h0[j]; hv[c * 8 + 4 + j] = x1[j] * (1.f + s1[j]) + h1[j]; }
                v4u o; o.x = pk2(hv[c * 8], hv[c * 8 + 1]); o.y = pk2(hv[c * 8 + 2], hv[c * 8 + 3]); o.z = pk2(hv[c * 8 + 4], hv[c * 8 + 5]); o.w = pk2(hv[c * 8 + 6], hv[c * 8 + 7]);
#if !I8_GATE
                *(v4u*)(hbuf + (size_t)t * D + col) = o;
#endif
#if RES16_X
                { v4u xo; xo.x = pk2(x0.x, x0.y); xo.y = pk2(x0.z, x0.w); xo.z = pk2(x1.x, x1.y); xo.w = pk2(x1.z, x1.w); *(v4u*)((bf16*)(a.ws + WS_X) + (size_t)t * D + col) = xo; }
#endif
#pragma unroll
                for (int j = 0; j < 8; ++j) mx = fmaxf(mx, fabsf(hv[c * 8 + j])); }
#pragma unroll
            for (int o = 1; o < 64; o <<= 1) mx = fmaxf(mx, __shfl_xor(mx, o));
            const float inv = mx > 0.f ? 127.0f / mx : 0.f;
#pragma unroll
            for (int c = 0; c < 4; ++c) { v2u o;
                o.x = pack_i8(hv[c * 8] * inv, hv[c * 8 + 1] * inv, hv[c * 8 + 2] * inv, hv[c * 8 + 3] * inv); o.y = pack_i8(hv[c * 8 + 4] * inv, hv[c * 8 + 5] * inv, hv[c * 8 + 6] * inv, hv[c * 8 + 7] * inv);
                *(v2u*)(a.ws + WS_H8 + (size_t)t * D + (c * 64 + lane) * 8) = o; }
            if (lane == 0) ((float*)(a.ws + WS_SAH))[t] = mx * (1.0f / 127.0f); }
        __syncthreads();
    }
    { const int gw = bx * NWAVES + wave, NGW = G * NWAVES;
      for (int row = gw; row < NL * (SBL + 16); row += NGW) { const int l = row / (SBL + 16), r = row % (SBL + 16);
          const bf16* src; unsigned char* dst; float* sdst;
          if (r < NP) { src = (const bf16*)(a.ws + WS_WIN) + ((size_t)l * INW + r) * D; dst = a.ws + WS_WIN8 + ((size_t)l * NP + r) * D; sdst = (float*)(a.ws + WS_SB) + l * SBL + r; }
          else if (r < NP + D) { src = (const bf16*)(a.ws + WS_WOUT) + ((size_t)l * D + (r - NP)) * D; dst = a.ws + WS_WOUT8 + ((size_t)l * D + (r - NP)) * D; sdst = (float*)(a.ws + WS_SB) + l * SBL + r; }
          else if (r < SBL) { src = (const bf16*)(a.ws + WS_WQ) + ((size_t)l * D + (r - NP - D)) * D; dst = a.ws + WS_WQ8 + ((size_t)l * D + (r - NP - D)) * D; sdst = (float*)(a.ws + WS_SB) + l * SBL + r; }
          else { src = (const bf16*)(a.ws + WS_WIN) + ((size_t)l * INW + NP + (r - SBL)) * D; dst = a.ws + WS_ALR8 + ((size_t)l * 16 + (r - SBL)) * D; sdst = (float*)(a.ws + WS_SBA) + l * 16 + (r - SBL); }
          v4u w[4]; float mx = 0.f;
#pragma unroll
          for (int c = 0; c < 4; ++c) w[c] = *(const v4u*)(src + (c * 64 + lane) * 8);
#pragma unroll
          for (int c = 0; c < 4; ++c)
#pragma unroll
              for (int j = 0; j < 4; ++j) mx = fmaxf(mx, fmaxf(fabsf(bflo(w[c][j])), fabsf(bfhi(w[c][j]))));
#pragma unroll
          for (int o = 1; o < 64; o <<= 1) mx = fmaxf(mx, __shfl_xor(mx, o));
          const float inv = mx > 0.f ? 127.0f / mx : 0.f;
#pragma unroll
          for (int c = 0; c < 4; ++c) { v2u o;
              o.x = pack_i8(bflo(w[c][0]) * inv, bfhi(w[c][0]) * inv, bflo(w[c][1]) * inv, bfhi(w[c][1]) * inv); o.y = pack_i8(bflo(w[c][2]) * inv, bfhi(w[c][2]) * inv, bflo(w[c][3]) * inv, bfhi(w[c][3]) * inv);
              *(v2u*)(dst + (c * 64 + lane) * 8) = o; }
          if (lane == 0) *sdst = mx * (1.0f / 127.0f); } }
}

__device__ __forceinline__ void gate_prep(const Args& a, int l, LAS unsigned char* lds, int tid, int lane, int wave, int ch) {
    const bf16* hbuf = (const bf16*)(a.ws + WS_H); const bf16* waT = (const bf16*)(a.ws + WS_WIN) + ((size_t)l * INW + NP) * D;
    bf16* Ebuf = (bf16*)(a.ws + WS_E); float* dtot = (float*)(a.ws + WS_DTOT);
    const int t0 = ch * 64, l15 = lane & 15, lq = lane >> 4, mt = wave & 3, kh = wave >> 2;
    LAS float* alr = (LAS float*)(lds + LDSCTL_OFF + 1024);
#if I8_GATE
    { v4i acc = (v4i){0, 0, 0, 0};
      const unsigned char* hA = a.ws + WS_H8 + (size_t)(t0 + 16 * mt + l15) * D + kh * 1024 + 16 * lq;
      const unsigned char* wB = a.ws + WS_ALR8 + ((size_t)l * 16 + l15) * D + kh * 1024 + 16 * lq;
#pragma unroll 8
      for (int ks = 0; ks < 16; ++ks) { const v4i av = *(const v4i*)(hA + 64 * ks), bv = *(const v4i*)(wB + 64 * ks); acc = __builtin_amdgcn_mfma_i32_16x16x64_i8(av, bv, acc, 0, 0, 0); }
      const float sw = ((const float*)(a.ws + WS_SBA))[l * 16 + l15];
#pragma unroll
      for (int r = 0; r < 4; ++r) { const int tl = 16 * mt + 4 * lq + r; alr[(kh * 64 + tl) * 16 + l15] = (float)acc[r] * (sw * ((const float*)(a.ws + WS_SAH))[t0 + tl]); } }
#else
    f32x4 acc = (f32x4){0.f, 0.f, 0.f, 0.f};
    const bf16* hA = hbuf + (size_t)(t0 + 16 * mt + l15) * D + kh * 1024 + 8 * lq;
    const bf16* wB = waT + (size_t)l15 * D + kh * 1024 + 8 * lq;
#pragma unroll 8
    for (int ks = 0; ks < 32; ++ks) { const bf16x8 av = *(const bf16x8*)(hA + 32 * ks), bv = *(const bf16x8*)(wB + 32 * ks); acc = __builtin_amdgcn_mfma_f32_16x16x32_bf16(av, bv, acc, 0, 0, 0); }
#pragma unroll
    for (int r = 0; r < 4; ++r) alr[(kh * 64 + 16 * mt + 4 * lq + r) * 16 + l15] = acc[r];
#endif
    __syncthreads();
    const int col = tid;
    float wg[16];
#pragma unroll
    for (int r = 0; r < 16; ++r) wg[r] = a.in[5][((size_t)l * RANK + r) * GKW + col];
    const float bgc = a.in[6][l * GKW + col];
    for (int i = tid; i < 256; i += NTHREADS) *(LAS f32x4*)(alr + i * 4) = *(const LAS f32x4*)(alr + i * 4) + *(const LAS f32x4*)(alr + 1024 + i * 4);
    __syncthreads();
    float tot = 0.f;
    LAS float* lac = (LAS float*)lds;
    for (int j = 0; j < 64; ++j) { float lg0 = bgc, lg1 = 0.f;
#pragma unroll
        for (int r4 = 0; r4 < 4; ++r4) { const f32x4 p = *(const LAS f32x4*)(alr + j * 16 + r4 * 4);
            lg0 += p.x * wg[r4 * 4] + p.z * wg[r4 * 4 + 2]; lg1 += p.y * wg[r4 * 4 + 1] + p.w * wg[r4 * 4 + 3]; }
        const float la = logsigmoid_fast(lg0 + lg1) * (1.0f / 16.0f); lac[j * GKW + col] = la; tot += la; }
    float run = 0.f;
    for (int j = 0; j < 64; ++j) { run += lac[j * GKW + col]; lac[j * GKW + col] = __expf(tot - run); }
    __syncthreads();
    for (int i = 0; i < 8; ++i) { const int j = wave * 8 + i;
        const f32x4 e0 = *(const LAS f32x4*)(lac + j * GKW + lane * 8), e1 = *(const LAS f32x4*)(lac + j * GKW + lane * 8 + 4);
        v4u o; o.x = pk2(e0.x, e0.y); o.y = pk2(e0.z, e0.w); o.z = pk2(e1.x, e1.y); o.w = pk2(e1.z, e1.w);
        *(v4u*)(Ebuf + (size_t)(t0 + j) * GKW + lane * 8) = o; }
    dtot[(size_t)ch * GKW + col] = __expf(tot);
    __syncthreads();
}

__device__ __forceinline__ void gla_unit(const Args& a, LAS unsigned char* lds, int tid, int lane, int wave, int un) {
    const bf16* proj = (const bf16*)(a.ws + WS_PROJ); const bf16* Ebuf = (const bf16*)(a.ws + WS_E); const float* dtot = (const float*)(a.ws + WS_DTOT); bf16* ogla = (bf16*)(a.ws + WS_OGLA);
    const int pair_ = (un & 7) * 4 + (un >> 6), dvs = (un >> 3) & 7, hh = pair_ & 3, b = pair_ >> 2;
    LAS bf16* kdT = (LAS bf16*)lds;
    LAS bf16* vT = (LAS bf16*)(lds + 18432);
    LAS bf16* ST = (LAS bf16*)(lds + 18432 + 4608);
    const int l15 = lane & 15, lq = lane >> 4, jl = tid >> 3, c0 = tid & 7, dv4 = (tid & 7) * 4, jt = (wave & 3) * 16, dvt = (wave >> 2) * 16;
#define GLA_BAR() do { asm volatile("s_waitcnt lgkmcnt(0)" ::: "memory"); __builtin_amdgcn_s_barrier(); asm volatile("" ::: "memory"); } while (0)
    f32x4 S0 = (f32x4){0.f, 0.f, 0.f, 0.f}, S1 = (f32x4){0.f, 0.f, 0.f, 0.f};
    v4u kn0[2], kn1[2], en0[2], en1[2]; v2u vn0, vn1; bf16x8 qn0[4], qn1[4], qc[4]; f32x4 dn0, dn1, dc;
#define GLA_LOAD(c, kn, en, vn, qn, dn) do { const int t0c = b * SEQ + (c) * 64; const bf16* pr = proj + (size_t)(t0c + jl) * NP; \
          \
        kn[0] = *(const v4u*)(pr + PK + hh * 128 + 8 * c0); kn[1] = *(const v4u*)(pr + PK + hh * 128 + 64 + 8 * c0); \
        en[0] = *(const v4u*)(Ebuf + (size_t)(t0c + jl) * GKW + hh * 128 + 8 * c0); en[1] = *(const v4u*)(Ebuf + (size_t)(t0c + jl) * GKW + hh * 128 + 64 + 8 * c0); \
        vn = *(const v2u*)(pr + PV + hh * 256 + dvs * 32 + dv4); \
        _Pragma("unroll") for (int ks_ = 0; ks_ < 4; ++ks_) qn[ks_] = *(const bf16x8*)(proj + (size_t)(t0c + jt + l15) * NP + PQ + hh * 128 + 32 * ks_ + 8 * lq); \
        dn = *(const f32x4*)(dtot + (size_t)(b * NCH + (c)) * GKW + hh * 128 + 16 * wave + 4 * lq); } while (0)
#define GLA_PREP(kn, en, vn, qn, dn) do { \
        _Pragma("unroll") for (int h_ = 0; h_ < 2; ++h_) _Pragma("unroll") for (int i_ = 0; i_ < 8; ++i_) { const unsigned w_ = kn[h_][i_ >> 1], e_ = en[h_][i_ >> 1]; \
            const float kf_ = (i_ & 1) ? bfhi(w_) : bflo(w_), ef_ = (i_ & 1) ? bfhi(e_) : bflo(e_); \
            kdT[(64 * h_ + 8 * c0 + i_) * 72 + ((((jl >> 3) ^ c0) & 7) << 3) + (jl & 7)] = (bf16)(pk2(kf_ * ef_, 0.f) & 0xffffu); }     \
        _Pragma("unroll") for (int i_ = 0; i_ < 4; ++i_) { const unsigned w_ = vn[i_ >> 1]; vT[(dv4 + i_) * 72 + jl] = (bf16)((i_ & 1) ? (w_ >> 16) : (w_ & 0xffffu)); } \
        _Pragma("unroll") for (int ks_ = 0; ks_ < 4; ++ks_) qc[ks_] = qn[ks_]; \
        dc = dn; } while (0)
#define GLA_BODY(c) do { \
        S0 = S0 * dc; S1 = S1 * dc; \
        _Pragma("unroll") for (int ks = 0; ks < 2; ++ks) { \
            const bf16x8 A_ = *(const LAS bf16x8*)(kdT + (16 * wave + l15) * 72 + ((((4 * ks + lq) ^ (2 * wave + (l15 >> 3))) & 7) << 3)); \
            const bf16x8 B0_ = *(const LAS bf16x8*)(vT + l15 * 72 + 32 * ks + 8 * lq), B1_ = *(const LAS bf16x8*)(vT + (16 + l15) * 72 + 32 * ks + 8 * lq); \
            S0 = __builtin_amdgcn_mfma_f32_16x16x32_bf16(A_, B0_, S0, 0, 0, 0); S1 = __builtin_amdgcn_mfma_f32_16x16x32_bf16(A_, B1_, S1, 0, 0, 0); } \
        { v2u w0_, w1_; w0_.x = pk2(S0.x, S0.y); w0_.y = pk2(S0.z, S0.w); w1_.x = pk2(S1.x, S1.y); w1_.y = pk2(S1.z, S1.w); \
          *(LAS v2u*)(ST + l15 * 136 + 16 * wave + 4 * lq) = w0_; *(LAS v2u*)(ST + (16 + l15) * 136 + 16 * wave + 4 * lq) = w1_; } \
        GLA_BAR(); \
        f32x4 O_ = (f32x4){0.f, 0.f, 0.f, 0.f}; \
        _Pragma("unroll") for (int ks = 0; ks < 4; ++ks) { const bf16x8 A_ = *(const LAS bf16x8*)(ST + (dvt + l15) * 136 + 32 * ks + 8 * lq); O_ = __builtin_amdgcn_mfma_f32_16x16x32_bf16(A_, qc[ks], O_, 0, 0, 0); } \
        { const f32x4 Os_ = O_ * 0.08838834764831845f; v2u ob_; ob_.x = pk2(Os_.x, Os_.y); ob_.y = pk2(Os_.z, Os_.w); \
          *(v2u*)(ogla + (size_t)(b * SEQ + (c) * 64 + jt + l15) * 1024 + hh * 256 + dvs * 32 + dvt + 4 * lq) = ob_; } } while (0)
    GLA_LOAD(0, kn0, en0, vn0, qn0, dn0); GLA_LOAD(1, kn1, en1, vn1, qn1, dn1);
    GLA_PREP(kn0, en0, vn0, qn0, dn0);
    GLA_BAR();
    for (int c = 0; c < NCH; c += 2) {
        { const int cn_ = c + 2 < NCH ? c + 2 : NCH - 1; GLA_LOAD(cn_, kn0, en0, vn0, qn0, dn0); }
        GLA_BODY(c);
        GLA_PREP(kn1, en1, vn1, qn1, dn1);
        GLA_BAR();
        { const int cn_ = c + 3 < NCH ? c + 3 : NCH - 1; GLA_LOAD(cn_, kn1, en1, vn1, qn1, dn1); }
        GLA_BODY(c + 1);
        GLA_PREP(kn0, en0, vn0, qn0, dn0);
        GLA_BAR();
    }
#undef GLA_BODY
#undef GLA_BAR
#undef GLA_LOAD
#undef GLA_PREP
}

__device__ __forceinline__ void unpack16(const v4u& p0, const v4u& p1, float (&o)[16]) {
#pragma unroll
    for (int j = 0; j < 4; ++j) { o[2 * j] = bflo(p0[j]); o[2 * j + 1] = bfhi(p0[j]); o[8 + 2 * j] = bflo(p1[j]); o[8 + 2 * j + 1] = bfhi(p1[j]); }
}
__device__ __forceinline__ void mixpost_chunk(const Args& a, int l, int lane, int wave, int ch) {
    const bf16* proj = (const bf16*)(a.ws + WS_PROJ); const bf16* ogla = (const bf16*)(a.ws + WS_OGLA);
    const int c0 = 16 * lane, tfirst = ch * 64 + wave * 8, sfirst = tfirst % SEQ;
    float gn[16], cw0[16], cw1[16], cw2[16], cn[16], u1[16], u2[16];
#pragma unroll
    for (int i = 0; i < 16; ++i) { gn[i] = a.in[7][l * 256 + ((c0 + i) & 255)]; cw0[i] = a.in[8][(size_t)l * 3072 + c0 + i]; cw1[i] = a.in[8][(size_t)l * 3072 + 1024 + c0 + i];
        cw2[i] = a.in[8][(size_t)l * 3072 + 2048 + c0 + i]; cn[i] = a.in[9][l * 1024 + c0 + i]; u1[i] = 0.f; u2[i] = 0.f; }
    if (sfirst >= 2) {
        float cc[16], chh[16];
        { const bf16* pr = proj + (size_t)(tfirst - 2) * NP; unpack16(*(const v4u*)(pr + PCC + c0), *(const v4u*)(pr + PCC + c0 + 8), cc); unpack16(*(const v4u*)(pr + PCH + c0), *(const v4u*)(pr + PCH + c0 + 8), chh); }
#pragma unroll
        for (int i = 0; i < 16; ++i) u2[i] = cc[i] * chh[i];
        { const bf16* pr = proj + (size_t)(tfirst - 1) * NP; unpack16(*(const v4u*)(pr + PCC + c0), *(const v4u*)(pr + PCC + c0 + 8), cc); unpack16(*(const v4u*)(pr + PCH + c0), *(const v4u*)(pr + PCH + c0 + 8), chh); }
#pragma unroll
        for (int i = 0; i < 16; ++i) u1[i] = cc[i] * chh[i];
    }
#pragma unroll 2
    for (int it = 0; it < 8; ++it) { const int t = tfirst + it; const bf16* pr = proj + (size_t)t * NP;
        float o[16], r[16], cb[16], cc[16], chh[16];
        unpack16(*(const v4u*)(ogla + (size_t)t * 1024 + c0), *(const v4u*)(ogla + (size_t)t * 1024 + c0 + 8), o);
        unpack16(*(const v4u*)(pr + PR + c0), *(const v4u*)(pr + PR + c0 + 8), r);
        unpack16(*(const v4u*)(pr + PCB + c0), *(const v4u*)(pr + PCB + c0 + 8), cb);
        unpack16(*(const v4u*)(pr + PCC + c0), *(const v4u*)(pr + PCC + c0 + 8), cc);
        unpack16(*(const v4u*)(pr + PCH + c0), *(const v4u*)(pr + PCH + c0 + 8), chh);
        float ss = 0.f;
#pragma unroll
        for (int i = 0; i < 16; ++i) ss += o[i] * o[i];
        ss += __shfl_xor(ss, 1); ss += __shfl_xor(ss, 2); ss += __shfl_xor(ss, 4); ss += __shfl_xor(ss, 8);
        const float rg = rsqrtf(ss * (1.0f / 256.f) + EPS);
        float val[16]; float s2 = 0.f;
#pragma unroll
        for (int i = 0; i < 16; ++i) { const float u0 = cc[i] * chh[i]; val[i] = cb[i] * (cw0[i] * u2[i] + cw1[i] * u1[i] + cw2[i] * u0); s2 += val[i] * val[i]; u2[i] = u1[i]; u1[i] = u0; }
        const float rc = rsqrtf(wave_sum(s2) * (1.0f / 1024.f) + EPS);
        float ya[16], yb[16]; float mx = 0.f;
#pragma unroll
        for (int i = 0; i < 16; ++i) { ya[i] = o[i] * rg * gn[i] * silu_f(r[i]); yb[i] = val[i] * rc * cn[i]; mx = fmaxf(mx, fmaxf(fabsf(ya[i]), fabsf(yb[i]))); }
#pragma unroll
        for (int o_ = 1; o_ < 64; o_ <<= 1) mx = fmaxf(mx, __shfl_xor(mx, o_));
        const float inv = mx > 0.f ? 127.0f / mx : 0.f;
        v4u y0, y1;
#pragma unroll
        for (int j = 0; j < 4; ++j) { y0[j] = pack_i8(ya[4 * j] * inv, ya[4 * j + 1] * inv, ya[4 * j + 2] * inv, ya[4 * j + 3] * inv); y1[j] = pack_i8(yb[4 * j] * inv, yb[4 * j + 1] * inv, yb[4 * j + 2] * inv, yb[4 * j + 3] * inv); }
        unsigned char* yr = a.ws + WS_Y8 + (size_t)t * D;
        *(v4u*)(yr + c0) = y0; *(v4u*)(yr + 1024 + c0) = y1;
#if !I8_OUT
        { v4u b0, b1, b2, b3;
#pragma unroll
          for (int j = 0; j < 4; ++j) { b0[j] = pk2(ya[2 * j], ya[2 * j + 1]); b1[j] = pk2(ya[8 + 2 * j], ya[9 + 2 * j]); b2[j] = pk2(yb[2 * j], yb[2 * j + 1]); b3[j] = pk2(yb[8 + 2 * j], yb[9 + 2 * j]); }
          bf16* ybr = (bf16*)(a.ws + WS_Y) + (size_t)t * D;
          *(v4u*)(ybr + c0) = b0; *(v4u*)(ybr + c0 + 8) = b1; *(v4u*)(ybr + 1024 + c0) = b2; *(v4u*)(ybr + 1024 + c0 + 8) = b3; }
#endif
        if (lane == 0) ((float*)(a.ws + WS_SAY))[t] = mx * (1.0f / 127.0f);
    }
}

__device__ __forceinline__ void ln1_chunk(const Args& a, int l, LAS unsigned char* lds, int lane, int wave, int ch) {
    const float* zbuf = (const float*)(a.ws + WS_Z); const float* mod = (const float*)(a.ws + WS_MOD);
    const int b = ch / NCH; const float* mb = mod + ((size_t)l * NB + b) * 6 * D;
#pragma unroll 2
    for (int it = 0; it < 8; ++it) { const int t = ch * 64 + wave * 8 + it;
        float z[32];
#pragma unroll
#if RES16_Z
        for (int c = 0; c < 8; ++c) { const v2u v0 = *(const v2u*)((const bf16*)zbuf + (size_t)t * D + (c * 64 + lane) * 4); z[c * 4] = bflo(v0.x); z[c * 4 + 1] = bfhi(v0.x); z[c * 4 + 2] = bflo(v0.y); z[c * 4 + 3] = bfhi(v0.y); }
#else
        for (int c = 0; c < 8; ++c) { const f32x4 v0 = *(const f32x4*)(zbuf + (size_t)t * D + (c * 64 + lane) * 4); z[c * 4] = v0.x; z[c * 4 + 1] = v0.y; z[c * 4 + 2] = v0.z; z[c * 4 + 3] = v0.w; }
#endif
        ln_tail(z, t, lane, a.in[11] + (size_t)l * D, a.in[12] + (size_t)l * D, RES16_X1 ? (float*)nullptr : (float*)(a.ws + WS_X1), mb + 3 * D, mb + 4 * D, I8_WQ ? (bf16*)nullptr : (bf16*)(a.ws + WS_H2), a.ws + WS_HQ8, (float*)(a.ws + WS_HSC), lds + wave * 2304, I8_WQ ? a.ws + WS_H28 : (unsigned char*)nullptr, nullptr, RES16_X1 ? (bf16*)(a.ws + WS_X1) : (bf16*)nullptr);
    }
}

template <int N> __device__ __forceinline__ void bitonic_sort_desc(float (&v)[N]) {
#pragma unroll
    for (int k = 2; k <= N; k <<= 1)
#pragma unroll
        for (int j = k >> 1; j > 0; j >>= 1)
#pragma unroll
            for (int i = 0; i < N; ++i) { const int p = i ^ j; if (p > i) { const bool desc = ((i & k) == 0); const float x = v[i], y = v[p]; const float mx = fmaxf(x, y), mn = fminf(x, y); v[i] = desc ? mx : mn; v[p] = desc ? mn : mx; } }
}
__device__ __forceinline__ void merge_top16(float (&x)[16], const float (&y)[16]) {
#pragma unroll
    for (int i = 0; i < 16; ++i) x[i] = fmaxf(x[i], y[15 - i]);
#pragma unroll
    for (int j = 8; j > 0; j >>= 1)
#pragma unroll
        for (int i = 0; i < 16; ++i) { const int p = i ^ j; if (p > i) { const float u = x[i], w = x[p]; x[i] = fmaxf(u, w); x[p] = fminf(u, w); } }
}
__device__ __forceinline__ void ce_desc(float& ka, int& pa, float& kb, int& pb) { const bool sw = kb > ka; const float k0 = sw ? kb : ka, k1 = sw ? ka : kb; const int p0 = sw ? pb : pa, p1 = sw ? pa : pb; ka = k0; pa = p0; kb = k1; pb = p1; }
__device__ __forceinline__ void bitonic_sort_desc_kp(float (&k)[16], int (&p)[16]) {
#pragma unroll
    for (int kk = 2; kk <= 16; kk <<= 1)
#pragma unroll
        for (int j = kk >> 1; j > 0; j >>= 1)
#pragma unroll
            for (int i = 0; i < 16; ++i) { const int q = i ^ j; if (q > i) { if ((i & kk) == 0) ce_desc(k[i], p[i], k[q], p[q]); else ce_desc(k[q], p[q], k[i], p[i]); } }
}
__device__ __forceinline__ void merge_top16_kp(float (&k)[16], int (&p)[16], const float (&k2)[16], const int (&p2)[16]) {
#pragma unroll
    for (int i = 0; i < 16; ++i) { const bool sw = k2[15 - i] > k[i]; k[i] = sw ? k2[15 - i] : k[i]; p[i] = sw ? p2[15 - i] : p[i]; }
#pragma unroll
    for (int j = 8; j > 0; j >>= 1)
#pragma unroll
        for (int i = 0; i < 16; ++i) { const int q = i ^ j; if (q > i) ce_desc(k[i], p[i], k[q], p[q]); }
}
__device__ constexpr int cand_i(int s) { return s < 16 ? 0 : s < 24 ? 1 : s < 29 ? 2 : s < 33 ? 3 : s < 36 ? 4 : s < 38 ? 5 : s < 40 ? 6 : s < 42 ? 7 : s < 50 ? s - 34 : -1; }
__device__ constexpr int cand_j(int s) { return s < 16 ? s : s < 24 ? s - 16 : s < 29 ? s - 24 : s < 33 ? s - 29 : s < 36 ? s - 33 : s < 38 ? s - 36 : s < 40 ? s - 38 : s < 42 ? s - 40 : s < 50 ? 0 : -1; }

__device__ __forceinline__ void peer_retrieve(const Args& a, int l, LAS unsigned char* lds, int lane, int wave, int ch) {
    const bf16* qbuf = (const bf16*)(a.ws + WS_Q); const bf16* keys = (const bf16*)(a.ws + WS_KEYS) + ((size_t)(l * 8 + wave) * 2) * 128 * 128;
    LAS int* eg_e = (LAS int*)lds; LAS float* eg_g = (LAS float*)(lds + 32768);
    const int l31 = lane & 31, l5 = lane >> 5, h = wave, t0 = ch * 64;
    for (int tt = 0; tt < 2; ++tt) {
        float sv[2][16];
#pragma unroll
        for (int p = 0; p < 2; ++p) {
            f32x16 acc[4];
#pragma unroll
            for (int nt = 0; nt < 4; ++nt)
#pragma unroll
                for (int r = 0; r < 16; ++r) acc[nt][r] = 0.f;
            const bf16* qp = qbuf + (size_t)(t0 + 32 * tt + l31) * D + h * 256 + p * 128 + 8 * l5;
            const bf16* kp = keys + (size_t)(p * 128 + l31) * 128 + 8 * l5;
#pragma unroll 2
            for (int ks = 0; ks < 8; ++ks) { const bf16x8 bq = *(const bf16x8*)(qp + 16 * ks);
#pragma unroll
                for (int nt = 0; nt < 4; ++nt) { const bf16x8 ak = *(const bf16x8*)(kp + (size_t)(32 * nt) * 128 + 16 * ks); acc[nt] = __builtin_amdgcn_mfma_f32_32x32x16_bf16(ak, bq, acc[nt], 0, 0, 0); } }
            float v[4][16];
#pragma unroll
            for (int nt = 0; nt < 4; ++nt)
#pragma unroll
                for (int r = 0; r < 16; ++r) { const unsigned idx = 32u * nt + (r & 3) + 8u * (r >> 2) + 4u * l5; v[nt][r] = __uint_as_float((__float_as_uint(acc[nt][r]) & 0xffffff80u) | idx); }
#pragma unroll
            for (int nt = 0; nt < 4; ++nt) bitonic_sort_desc<16>(v[nt]);
            merge_top16(v[0], v[1]); merge_top16(v[2], v[3]); merge_top16(v[0], v[2]);
            float o[16];
#pragma unroll
            for (int i = 0; i < 16; ++i) o[i] = __shfl_xor(v[0][i], 32);
            merge_top16(v[0], o);
#pragma unroll
            for (int i = 0; i < 16; ++i) sv[p][i] = v[0][i];
        }
        LAS unsigned char* idxb = (LAS unsigned char*)(lds + 69632) + wave * 2048 + lane * 32;
        { v4u w0, w1;
#pragma unroll
          for (int q4 = 0; q4 < 4; ++q4) {
              w0[q4] = (__float_as_uint(sv[0][4 * q4]) & 127u) | ((__float_as_uint(sv[0][4 * q4 + 1]) & 127u) << 8) | ((__float_as_uint(sv[0][4 * q4 + 2]) & 127u) << 16) | ((__float_as_uint(sv[0][4 * q4 + 3]) & 127u) << 24);
              w1[q4] = (__float_as_uint(sv[1][4 * q4]) & 127u) | ((__float_as_uint(sv[1][4 * q4 + 1]) & 127u) << 8) | ((__float_as_uint(sv[1][4 * q4 + 2]) & 127u) << 16) | ((__float_as_uint(sv[1][4 * q4 + 3]) & 127u) << 24); }
          *(LAS v4u*)(idxb) = w0; *(LAS v4u*)(idxb + 16) = w1; }
        float ck[4][16];
#pragma unroll
        for (int s = 0; s < 64; ++s) {
            if (cand_i(s) >= 0) { const unsigned b0 = __float_as_uint(sv[0][cand_i(s) < 0 ? 0 : cand_i(s)]), b1 = __float_as_uint(sv[1][cand_j(s) < 0 ? 0 : cand_j(s)]);
                const float sum = __uint_as_float(b0 & 0xffffff80u) + __uint_as_float(b1 & 0xffffff80u);
                ck[s >> 4][s & 15] = __uint_as_float((__float_as_uint(sum) & 0xffffff00u) | (unsigned)((cand_i(s) < 0 ? 0 : cand_i(s)) * 16 + (cand_j(s) < 0 ? 0 : cand_j(s)))); }
            else ck[s >> 4][s & 15] = -3.0e38f; }
        bitonic_sort_desc<16>(ck[1]); bitonic_sort_desc<16>(ck[2]);
        merge_top16(ck[0], ck[1]); merge_top16(ck[2], ck[3]); merge_top16(ck[0], ck[2]);
        LDS_WAIT(); asm volatile("" ::: "memory");
        float ex[16]; int ce[16]; float den = 0.f;
        const float cmax = __uint_as_float(__float_as_uint(ck[0][0]) & 0xffffff00u);
#pragma unroll
        for (int i = 0; i < 16; ++i) { const unsigned bits = __float_as_uint(ck[0][i]); ex[i] = __expf(__uint_as_float(bits & 0xffffff00u) - cmax); den += ex[i];
            ce[i] = (int)idxb[(bits >> 4) & 15u] * 128 + (int)idxb[16 + (bits & 15u)]; }
        const float inv = 1.0f / den;
        if (l5 == 0) {
            const int base = (32 * tt + l31) * 128 + h * 16;
#pragma unroll
            for (int i4 = 0; i4 < 4; ++i4) { *(LAS v4u*)(eg_e + base + 4 * i4) = (v4u){(unsigned)ce[4 * i4], (unsigned)ce[4 * i4 + 1], (unsigned)ce[4 * i4 + 2], (unsigned)ce[4 * i4 + 3]};
                *(LAS f32x4*)(eg_g + base + 4 * i4) = (f32x4){ex[4 * i4] * inv, ex[4 * i4 + 1] * inv, ex[4 * i4 + 2] * inv, ex[4 * i4 + 3] * inv}; }
        }
        LDS_WAIT(); asm volatile("" ::: "memory");
    }
}

typedef unsigned char uc4 __attribute__((ext_vector_type(4)));
constexpr int NSLICE = 16, SLICE_SHIFT = 10;
__device__ __forceinline__ int sdot4i(unsigned w, unsigned x, int acc) { return __builtin_amdgcn_sdot4((int)w, (int)x, acc, false); }
__device__ __forceinline__ void fma_ub4(unsigned w, float s, float& y0, float& y1, float& y2, float& y3) { const uc4 b = __builtin_bit_cast(uc4, w); y0 += s * (float)b.x; y1 += s * (float)b.y; y2 += s * (float)b.z; y3 += s * (float)b.w; }
#if TAB4
__device__ __forceinline__ void peer_tail(const Args& a, int l, int t, int lane, const bf16* Yrow, const float* mb, const float* mbn, bool last) {
    const float* x1buf = (const float*)(a.ws + WS_X1);
    float z[32];
#pragma unroll
    for (int c8 = 0; c8 < 8; ++c8) { const int col = (c8 * 64 + lane) * 4;
        const v2u yb = *(const v2u*)(Yrow + col); const f32x4 yv = (f32x4){bflo(yb.x), bfhi(yb.x), bflo(yb.y), bfhi(yb.y)};
#if RES16_X1
        const v2u xb_ = *(const v2u*)((const bf16*)x1buf + (size_t)t * D + col); const f32x4 x0 = (f32x4){bflo(xb_.x), bfhi(xb_.x), bflo(xb_.y), bfhi(xb_.y)}, g0 = *(const f32x4*)(mb + 5 * D + col);
#else
        const f32x4 x0 = *(const f32x4*)(x1buf + (size_t)t * D + col), g0 = *(const f32x4*)(mb + 5 * D + col);
#endif
        z[c8 * 4] = ALPHA * x0.x + (1.f + g0.x) * yv.x; z[c8 * 4 + 1] = ALPHA * x0.y + (1.f + g0.y) * yv.y; z[c8 * 4 + 2] = ALPHA * x0.z + (1.f + g0.z) * yv.z; z[c8 * 4 + 3] = ALPHA * x0.w + (1.f + g0.w) * yv.w; }
    ln_tail(z, t, lane, a.in[17] + (size_t)l * D, a.in[18] + (size_t)l * D, last ? a.out : (RES16_X ? (float*)nullptr : (float*)(a.ws + WS_X)), mbn, mbn + D, (last || I8_GATE) ? (bf16*)nullptr : (bf16*)(a.ws + WS_H), nullptr, nullptr, nullptr, last ? (unsigned char*)nullptr : a.ws + WS_H8, (float*)(a.ws + WS_SAH), (RES16_X && !last) ? (bf16*)(a.ws + WS_X) : (bf16*)nullptr);
}
template <class TT, int N, int M> __device__ __forceinline__ void treduce(TT (&v)[N], int lane) {
    const bool c0 = (lane & M) != 0, c1 = (lane & (2 * M)) != 0, c2 = (lane & (4 * M)) != 0;
#pragma unroll
    for (int m = 0; m < N / 2; ++m) { const TT keep = c0 ? v[2 * m + 1] : v[2 * m], send = c0 ? v[2 * m] : v[2 * m + 1]; v[m] = keep + __shfl_xor(send, M); }
#pragma unroll
    for (int m = 0; m < N / 4; ++m) { const TT keep = c1 ? v[2 * m + 1] : v[2 * m], send = c1 ? v[2 * m] : v[2 * m + 1]; v[m] = keep + __shfl_xor(send, 2 * M); }
#pragma unroll
    for (int m = 0; m < N / 8; ++m) { const TT keep = c2 ? v[2 * m + 1] : v[2 * m], send = c2 ? v[2 * m] : v[2 * m + 1]; v[m] = keep + __shfl_xor(send, 4 * M); }
}
__device__ __forceinline__ void tr4x4(unsigned a, unsigned b, unsigned c, unsigned d, unsigned& t0, unsigned& t1, unsigned& t2, unsigned& t3) {
    const unsigned x0 = __builtin_amdgcn_perm(b, a, 0x05010400u), x1 = __builtin_amdgcn_perm(b, a, 0x07030602u), y0 = __builtin_amdgcn_perm(d, c, 0x05010400u), y1 = __builtin_amdgcn_perm(d, c, 0x07030602u);
    t0 = __builtin_amdgcn_perm(y0, x0, 0x05040100u); t1 = __builtin_amdgcn_perm(y0, x0, 0x07060302u); t2 = __builtin_amdgcn_perm(y1, x1, 0x05040100u); t3 = __builtin_amdgcn_perm(y1, x1, 0x07060302u);
}
__device__ __forceinline__ int sdot8i(unsigned w, unsigned x, int acc) { return __builtin_amdgcn_sdot8((int)w, (int)x, acc, false); }
__device__ __forceinline__ float slot_scale(unsigned w3) { return __builtin_amdgcn_exp2f((float)(w3 >> 24) * 0.125f - 16.0f); }
__device__ __forceinline__ void peer_experts(const Args& a, int l, LAS unsigned char* lds, int lane0, int wave, int ch) {
    const float* mod = (const float*)(a.ws + WS_MOD);
    const unsigned char* ut = a.ws + WS_UT + (size_t)l * NE * 1152; const unsigned char* vt = a.ws + WS_VT + (size_t)l * NE * 1152; const unsigned char* hq8 = a.ws + WS_HQ8;
    const float* hsc = (const float*)(a.ws + WS_HSC);
    bf16* Ybuf = (bf16*)(a.ws + WS_Z);
    const LAS int* eg_e = (const LAS int*)lds; LAS float* sw = (LAS float*)(lds + 32768);
    LAS float* apart = (LAS float*)(lds + 65536);
    const int b = ch / NCH; const bool last = (l == NL - 1);
    const float* mb = mod + ((size_t)l * NB + b) * 6 * D; const float* mbn = mod + ((size_t)(last ? l : l + 1) * NB + b) * 6 * D;
    const int tlw = wave * 8;
    { const int lane = lane0;
#pragma unroll
      for (int i = 0; i < 16; ++i) apart[tlw * 128 + i * 64 + lane] = 0.f; }
    LDS_WAIT(); asm volatile("" ::: "memory");
    {
        int laneL = lane0; asm volatile("" : "+v"(laneL)); const int lane = laneL;
        const int g = lane >> 3, l7 = lane & 7;
        v4u bufA[16], bufB[16], hA0, hA1, hB0, hB1;
#define CU_LOAD(buf, h0_, h1_, idx_) do { const int u_ = (idx_) >> 3, tl_ = tlw + ((idx_) & 7); const unsigned soff_ = (unsigned)(u_ * 128 + l7 * 16); \
            const unsigned char* hp_ = hq8 + (size_t)(ch * 64 + tl_) * 2304 + (u_ * 8 + l7) * 32; h0_ = *(const v4u*)hp_; h1_ = *(const v4u*)(hp_ + 16); \
            _Pragma("unroll") for (int i_ = 0; i_ < 16; ++i_) { const unsigned e_ = (unsigned)eg_e[tl_ * 128 + 8 * i_ + g]; buf[i_] = *(const v4u*)(ut + (size_t)(e_ * 1152u + soff_)); } } while (0)
#define CU_COMP(buf, h0_, h1_, idx_) do { const int tl_ = tlw + ((idx_) & 7); float accv_[16]; \
            _Pragma("unroll") for (int i_ = 0; i_ < 16; ++i_) { int sl_ = 0, sh_ = 0; \
                _Pragma("unroll") for (int d_ = 0; d_ < 4; ++d_) { const unsigned x_ = buf[i_][d_] ^ 0x88888888u; sl_ = sdot8i(x_, h0_[d_], sl_); sh_ = sdot8i(x_, h1_[d_], sh_); } \
                accv_[i_] = slot_scale(buf[i_][3]) * (float)(16 * sh_ + sl_); } \
            treduce<float, 16, 1>(accv_, lane); \
            apart[tl_ * 128 + 8 * l7 + g] += accv_[0]; apart[tl_ * 128 + 8 * (8 + l7) + g] += accv_[1]; } while (0)
        CU_LOAD(bufA, hA0, hA1, 0);
        for (int idx = 0; idx < 72; idx += 2) {
            CU_LOAD(bufB, hB0, hB1, idx + 1);
            CU_COMP(bufA, hA0, hA1, idx);
            { const int nx_ = idx + 2 < 72 ? idx + 2 : 71; CU_LOAD(bufA, hA0, hA1, nx_); }
            CU_COMP(bufB, hB0, hB1, idx + 1);
        }
#undef CU_LOAD
#undef CU_COMP
        LDS_WAIT(); asm volatile("" ::: "memory");
        for (int it = 0; it < 8; ++it) { const int tl = tlw + it; const float shs = hsc[ch * 64 + tl];
            const float w0 = sw[tl * 128 + lane] * gelu_tanh_f(apart[tl * 128 + lane] * shs), w1 = sw[tl * 128 + 64 + lane] * gelu_tanh_f(apart[tl * 128 + 64 + lane] * shs);
            sw[tl * 128 + lane] = w0; sw[tl * 128 + 64 + lane] = w1; }
        LDS_WAIT(); asm volatile("" ::: "memory");
    }
    {
        int laneL = lane0; asm volatile("" : "+v"(laneL)); const int lane = laneL;
        const int g = lane >> 3, l7 = lane & 7;
        v4u bufA[16], bufB[16];
#define CV_LOAD(buf, idx_) do { const int u_ = (idx_) >> 3, tl_ = tlw + ((idx_) & 7); const unsigned soff_ = (unsigned)(u_ * 128 + l7 * 16); \
            _Pragma("unroll") for (int i_ = 0; i_ < 16; ++i_) { const unsigned e_ = (unsigned)eg_e[tl_ * 128 + 8 * i_ + g]; buf[i_] = *(const v4u*)(vt + (size_t)(e_ * 1152u + soff_)); } } while (0)
#define CV_COMP(buf, idx_) do { const int u_ = (idx_) >> 3, tl_ = tlw + ((idx_) & 7); \
            float wf_[16]; float wmx_ = 0.f; \
            _Pragma("unroll") for (int i_ = 0; i_ < 16; ++i_) { wf_[i_] = sw[tl_ * 128 + 8 * i_ + g] * slot_scale(buf[i_][3]); wmx_ = fmaxf(wmx_, fabsf(wf_[i_])); } \
            wmx_ = fmaxf(wmx_, __shfl_xor(wmx_, 8)); wmx_ = fmaxf(wmx_, __shfl_xor(wmx_, 16)); wmx_ = fmaxf(wmx_, __shfl_xor(wmx_, 32));     \
            const float winv_ = wmx_ > 0.f ? 127.0f / wmx_ : 0.f, wsc_ = wmx_ * (1.0f / 127.0f); \
              \
            unsigned wq4_[4]; int wsum_ = 0; \
            _Pragma("unroll") for (int gp_ = 0; gp_ < 4; ++gp_) { \
                const unsigned m0_ = __float_as_uint(wf_[4 * gp_] * winv_ + 12582912.0f), m1_ = __float_as_uint(wf_[4 * gp_ + 1] * winv_ + 12582912.0f), m2_ = __float_as_uint(wf_[4 * gp_ + 2] * winv_ + 12582912.0f), m3_ = __float_as_uint(wf_[4 * gp_ + 3] * winv_ + 12582912.0f); \
                wq4_[gp_] = __builtin_amdgcn_perm(__builtin_amdgcn_perm(m3_, m2_, 0x0c0c0400u), __builtin_amdgcn_perm(m1_, m0_, 0x0c0c0400u), 0x05040100u); \
                wsum_ = sdot4i(wq4_[gp_], 0x01010101u, wsum_); } \
            int yi_[32]; \
            _Pragma("unroll") for (int q_ = 0; q_ < 32; ++q_) yi_[q_] = 0; \
            _Pragma("unroll") for (int gp_ = 0; gp_ < 4; ++gp_) { \
                _Pragma("unroll") for (int d_ = 0; d_ < 4; ++d_) { const unsigned A_ = buf[4 * gp_][d_], B_ = buf[4 * gp_ + 1][d_], C_ = buf[4 * gp_ + 2][d_], D_ = buf[4 * gp_ + 3][d_]; \
                    unsigned t0_, t1_, t2_, t3_; \
                    tr4x4(A_, B_, C_, D_, t0_, t1_, t2_, t3_);     \
                    yi_[8 * d_]     = sdot4i(t0_ & 0x0f0f0f0fu, wq4_[gp_], yi_[8 * d_]);     yi_[8 * d_ + 1] = sdot4i((t0_ >> 4) & 0x0f0f0f0fu, wq4_[gp_], yi_[8 * d_ + 1]); \
                    yi_[8 * d_ + 2] = sdot4i(t1_ & 0x0f0f0f0fu, wq4_[gp_], yi_[8 * d_ + 2]); yi_[8 * d_ + 3] = sdot4i((t1_ >> 4) & 0x0f0f0f0fu, wq4_[gp_], yi_[8 * d_ + 3]); \
                    yi_[8 * d_ + 4] = sdot4i(t2_ & 0x0f0f0f0fu, wq4_[gp_], yi_[8 * d_ + 4]); yi_[8 * d_ + 5] = sdot4i((t2_ >> 4) & 0x0f0f0f0fu, wq4_[gp_], yi_[8 * d_ + 5]); \
                    yi_[8 * d_ + 6] = sdot4i(t3_ & 0x0f0f0f0fu, wq4_[gp_], yi_[8 * d_ + 6]); yi_[8 * d_ + 7] = sdot4i((t3_ >> 4) & 0x0f0f0f0fu, wq4_[gp_], yi_[8 * d_ + 7]); } } \
            treduce<int, 32, 8>(yi_, lane); \
            wsum_ += __shfl_xor(wsum_, 8); wsum_ += __shfl_xor(wsum_, 16); wsum_ += __shfl_xor(wsum_, 32);     \
            float y_[4]; \
            _Pragma("unroll") for (int q_ = 0; q_ < 4; ++q_) y_[q_] = wsc_ * (float)(yi_[q_] - 8 * wsum_); \
            { const int colb_ = u_ * 240 + l7 * 30 + g; bf16* yr_ = Ybuf + (size_t)(ch * 64 + tl_) * D + colb_; \
              _Pragma("unroll") for (int m_ = 0; m_ < 4; ++m_) if (8 * m_ + g < 30 && colb_ + 8 * m_ < D) yr_[8 * m_] = (bf16)(pk2(y_[m_], 0.f) & 0xffffu); } } while (0)
        CV_LOAD(bufA, 0);
        for (int idx = 0; idx < 72; idx += 2) {
            CV_LOAD(bufB, idx + 1);
            CV_COMP(bufA, idx);
            { const int nx_ = idx + 2 < 72 ? idx + 2 : 71; CV_LOAD(bufA, nx_); }
            CV_COMP(bufB, idx + 1);
        }
#undef CV_LOAD
#undef CV_COMP
    }
    asm volatile("s_waitcnt vmcnt(0)" ::: "memory");
    __builtin_amdgcn_fence(__ATOMIC_ACQUIRE, "agent");
    asm volatile("s_waitcnt vmcnt(0)" ::: "memory");
    for (int it = 0; it < 8; ++it) { int laneT = lane0; asm volatile("" : "+v"(laneT)); const int t = ch * 64 + tlw + it;
        peer_tail(a, l, t, laneT, Ybuf + (size_t)t * D, mb, mbn, last); }
}
#else
__device__ __forceinline__ void peer_tail(const Args& a, int l, int t, int lane, const float* Yrow, const float* mb, const float* mbn, bool last) {
    const float* x1buf = (const float*)(a.ws + WS_X1);
    float z[32];
#pragma unroll
    for (int c = 0; c < 2; ++c)
#pragma unroll
        for (int k = 0; k < 4; ++k) { const int c8 = 4 * c + k, col = (c8 * 64 + lane) * 4;
            const v2u yb = *(const v2u*)((const bf16*)Yrow + (c * 64 + lane) * 16 + 4 * k); const f32x4 yv = (f32x4){bflo(yb.x), bfhi(yb.x), bflo(yb.y), bfhi(yb.y)};
#if RES16_X1
            const v2u xb_ = *(const v2u*)((const bf16*)x1buf + (size_t)t * D + col); const f32x4 x0 = (f32x4){bflo(xb_.x), bfhi(xb_.x), bflo(xb_.y), bfhi(xb_.y)}, g0 = *(const f32x4*)(mb + 5 * D + col);
#else
            const f32x4 x0 = *(const f32x4*)(x1buf + (size_t)t * D + col), g0 = *(const f32x4*)(mb + 5 * D + col);
#endif
            z[c8 * 4] = ALPHA * x0.x + (1.f + g0.x) * yv.x; z[c8 * 4 + 1] = ALPHA * x0.y + (1.f + g0.y) * yv.y; z[c8 * 4 + 2] = ALPHA * x0.z + (1.f + g0.z) * yv.z; z[c8 * 4 + 3] = ALPHA * x0.w + (1.f + g0.w) * yv.w; }
    ln_tail(z, t, lane, a.in[17] + (size_t)l * D, a.in[18] + (size_t)l * D, last ? a.out : (RES16_X ? (float*)nullptr : (float*)(a.ws + WS_X)), mbn, mbn + D, (last || I8_GATE) ? (bf16*)nullptr : (bf16*)(a.ws + WS_H), nullptr, nullptr, nullptr, last ? (unsigned char*)nullptr : a.ws + WS_H8, (float*)(a.ws + WS_SAH), (RES16_X && !last) ? (bf16*)(a.ws + WS_X) : (bf16*)nullptr);
}
template <class TT, int M> __device__ __forceinline__ void treduce16(TT (&v)[16], int lane) {
    const bool c0 = (lane & M) != 0, c1 = (lane & (2 * M)) != 0, c2 = (lane & (4 * M)) != 0;
#pragma unroll
    for (int m = 0; m < 8; ++m) { const TT keep = c0 ? v[2 * m + 1] : v[2 * m], send = c0 ? v[2 * m] : v[2 * m + 1]; v[m] = keep + __shfl_xor(send, M); }
#pragma unroll
    for (int m = 0; m < 4; ++m) { const TT keep = c1 ? v[2 * m + 1] : v[2 * m], send = c1 ? v[2 * m] : v[2 * m + 1]; v[m] = keep + __shfl_xor(send, 2 * M); }
#pragma unroll
    for (int m = 0; m < 2; ++m) { const TT keep = c2 ? v[2 * m + 1] : v[2 * m], send = c2 ? v[2 * m] : v[2 * m + 1]; v[m] = keep + __shfl_xor(send, 4 * M); }
}
__device__ __forceinline__ void peer_experts(const Args& a, int l, LAS unsigned char* lds, int lane0, int wave, int ch) {
    const float* mod = (const float*)(a.ws + WS_MOD);
    const unsigned char* ut = a.ws + WS_UT + (size_t)l * NE * D; const unsigned char* vt = a.ws + WS_VT + (size_t)l * NE * D; const unsigned char* hq8 = a.ws + WS_HQ8;
    const float* su = (const float*)(a.ws + WS_SU) + (size_t)l * NE; const float* sv = (const float*)(a.ws + WS_SV) + (size_t)l * NE; const float* hsc = (const float*)(a.ws + WS_HSC);
    float* Ybuf = (float*)(a.ws + WS_Z);
    const LAS int* eg_e = (const LAS int*)lds; LAS float* sw = (LAS float*)(lds + 32768);
    LAS int* apart = (LAS int*)(lds + 65536); LAS float* wtotl = (LAS float*)(lds + LDSCTL_OFF + 256);
    const int b = ch / NCH; const bool last = (l == NL - 1);
    const float* mb = mod + ((size_t)l * NB + b) * 6 * D; const float* mbn = mod + ((size_t)(last ? l : l + 1) * NB + b) * 6 * D;
    const int tlw = wave * 8;
    { const int lane = lane0;
#pragma unroll
      for (int i = 0; i < 16; ++i) apart[tlw * 128 + i * 64 + lane] = 0; }
    LDS_WAIT(); asm volatile("" ::: "memory");
    {
        int laneL = lane0; asm volatile("" : "+v"(laneL)); const int lane = laneL;
        const int g = lane >> 3, l7 = lane & 7;
        v4u bufA[16], bufB[16], hA, hB;
#define CU_LOAD(buf, hh_, idx_) do { const int cs_ = (idx_) >> 3, tl_ = tlw + ((idx_) & 7); const unsigned coff_ = (unsigned)(cs_ * 128 + l7 * 16); \
            hh_ = *(const v4u*)(hq8 + (size_t)(ch * 64 + tl_) * D + coff_); \
            _Pragma("unroll") for (int i_ = 0; i_ < 16; ++i_) { const unsigned e_ = (unsigned)eg_e[tl_ * 128 + 8 * i_ + g]; buf[i_] = *(const v4u*)(ut + (size_t)(e_ * 2048u + coff_)); } } while (0)
#define CU_COMP(buf, hh_, idx_) do { const int tl_ = tlw + ((idx_) & 7); int acc_[16]; \
            _Pragma("unroll") for (int i_ = 0; i_ < 16; ++i_) { int s_ = 0; _Pragma("unroll") for (int q_ = 0; q_ < 4; ++q_) s_ = sdot4i(buf[i_][q_], hh_[q_], s_); acc_[i_] = s_; } \
            treduce16<int, 1>(acc_, lane); \
            apart[tl_ * 128 + 8 * l7 + g] += acc_[0]; apart[tl_ * 128 + 8 * (8 + l7) + g] += acc_[1]; } while (0)
        CU_LOAD(bufA, hA, 0);
        for (int idx = 0; idx < 128; idx += 2) {
            CU_LOAD(bufB, hB, idx + 1);
            CU_COMP(bufA, hA, idx);
            if (idx + 2 < 128) CU_LOAD(bufA, hA, idx + 2);
            CU_COMP(bufB, hB, idx + 1);
        }
#undef CU_LOAD
#undef CU_COMP
        LDS_WAIT(); asm volatile("" ::: "memory");
        for (int it = 0; it < 8; ++it) { const int tl = tlw + it; const float shs = hsc[ch * 64 + tl];
            const int e0 = eg_e[tl * 128 + lane], e1 = eg_e[tl * 128 + 64 + lane];
            const float w0 = sw[tl * 128 + lane] * gelu_tanh_f((float)apart[tl * 128 + lane] * su[e0] * shs) * sv[e0];
            const float w1 = sw[tl * 128 + 64 + lane] * gelu_tanh_f((float)apart[tl * 128 + 64 + lane] * su[e1] * shs) * sv[e1];
            sw[tl * 128 + lane] = w0; sw[tl * 128 + 64 + lane] = w1;
            const float ws = wave_sum(w0 + w1);
            if (lane == 0) wtotl[tl] = ws; }
        LDS_WAIT(); asm volatile("" ::: "memory");
    }
    {
        int laneL = lane0; asm volatile("" : "+v"(laneL)); const int lane = laneL;
        const int g = lane >> 3, l7 = lane & 7;
        v4u bufA[16], bufB[16];
#define CV_LOAD(buf, idx_) do { const int cs_ = (idx_) >> 3, tl_ = tlw + ((idx_) & 7); const unsigned coff_ = (unsigned)(cs_ * 128 + l7 * 16); \
            _Pragma("unroll") for (int i_ = 0; i_ < 16; ++i_) { const unsigned e_ = (unsigned)eg_e[tl_ * 128 + 8 * i_ + g]; buf[i_] = *(const v4u*)(vt + (size_t)(e_ * 2048u + coff_)); } } while (0)
#define CV_COMP(buf, idx_) do { const int cs_ = (idx_) >> 3, tl_ = tlw + ((idx_) & 7); float y_[16]; \
            _Pragma("unroll") for (int q_ = 0; q_ < 16; ++q_) y_[q_] = 0.f; \
            _Pragma("unroll") for (int i_ = 0; i_ < 16; ++i_) { const float wr_ = sw[tl_ * 128 + 8 * i_ + g]; \
                _Pragma("unroll") for (int q_ = 0; q_ < 4; ++q_) fma_ub4(buf[i_][q_], wr_, y_[4 * q_], y_[4 * q_ + 1], y_[4 * q_ + 2], y_[4 * q_ + 3]); } \
            treduce16<float, 8>(y_, lane); \
            const float woff_ = 128.0f * wtotl[tl_]; bf16* yr_ = (bf16*)Ybuf + (size_t)(ch * 64 + tl_) * D + cs_ * 128 + l7 * 16 + g; \
            yr_[0] = (bf16)(pk2(y_[0] - woff_, 0.f) & 0xffffu); yr_[8] = (bf16)(pk2(y_[1] - woff_, 0.f) & 0xffffu); } while (0)
        CV_LOAD(bufA, 0);
        for (int idx = 0; idx < 128; idx += 2) {
            CV_LOAD(bufB, idx + 1);
            CV_COMP(bufA, idx);
            if (idx + 2 < 128) CV_LOAD(bufA, idx + 2);
            CV_COMP(bufB, idx + 1);
        }
#undef CV_LOAD
#undef CV_COMP
    }
    asm volatile("s_waitcnt vmcnt(0)" ::: "memory");
    __builtin_amdgcn_fence(__ATOMIC_ACQUIRE, "agent");
    asm volatile("s_waitcnt vmcnt(0)" ::: "memory");
    for (int it = 0; it < 8; ++it) { int laneT = lane0; asm volatile("" : "+v"(laneT)); const int t = ch * 64 + tlw + it;
        peer_tail(a, l, t, laneT, (const float*)((const bf16*)Ybuf + (size_t)t * D), mb, mbn, last); }
}

#endif

#ifndef MK_PER_PHASE
#define MK_PER_PHASE 0
#endif
__global__ void __launch_bounds__(NTHREADS, 2) mk_fwd(Args a) {
    extern __shared__ __attribute__((aligned(16))) unsigned char lds_raw[];
    LAS unsigned char* lds = (LAS unsigned char*)lds_raw;
    const int tid = threadIdx.x, lane = tid & 63, wave = __builtin_amdgcn_readfirstlane(tid >> 6), G = gridDim.x, bx = blockIdx.x;
    if (tid < 64) ((LAS unsigned*)(lds + LDSCTL_OFF))[tid] = 0u;
    __syncthreads();
    unsigned* ctl = (unsigned*)(a.ws + WS_CTL);
    XcdBarrier bar; bar.bar = ctl + CW_BAR; bar.x = 0; bar.st = nullptr;
    const bool use_bar = (a.ph_hi - a.ph_lo) > 1;
    if (use_bar) bar = xcd_barrier_post(ctl + CW_BAR, (volatile LAS unsigned*)(lds + LDSCTL_OFF));
    const int lo = a.ph_lo, hi = a.ph_hi;
#ifndef PH_MASK
#define PH_MASK 0x1ff
#endif
#define IN(k) (lo <= (k) && (k) < hi)
#define EN(b) ((PH_MASK >> (b)) & 1)
#ifndef REP_MASK
#define REP_MASK 0
#endif
#ifndef REP_EXTRA
#define REP_EXTRA 2
#endif
#define REPS(b) (1 + ((REP_MASK >> (b)) & 1) * REP_EXTRA)
#define REP_BEGIN(b) for (int rep_ = 0; rep_ < REPS(b); ++rep_) {
#define REP_END(b) if (rep_ + 1 < REPS(b)) xcd_barrier(bar); }
#define SEAM(k) do { if (IN((k) + 1)) xcd_barrier(bar); } while (0)
#define PHASE_IDS() int tidp = tid; asm volatile("" : "+v"(tidp)); const int lanep = tidp & 63, wavep = __builtin_amdgcn_readfirstlane(tidp >> 6); (void)lanep; (void)wavep
    if (EN(0) && IN(0)) { REP_BEGIN(0) PHASE_IDS(); ph_prologue_a(a, lds, tidp, lanep, wavep, bx, G); REP_END(0) SEAM(0); }
    if (EN(1) && IN(1)) { REP_BEGIN(1) PHASE_IDS(); ph_prologue_b(a, lds, tidp, lanep, wavep, bx, G); REP_END(1) SEAM(1); }
    for (int l = 0; l < NL; ++l) {
        const int pb = 2 + 7 * l;
        const float* mod = (const float*)(a.ws + WS_MOD);
        if (EN(2) && IN(pb + 0)) {
            REP_BEGIN(2) PHASE_IDS();
#if I8_IN
            pg8::Gemm g{(const pg8::bf16_t*)(a.ws + WS_H8), (const pg8::bf16_t*)(a.ws + WS_WIN8 + (size_t)l * NP * D), T, NP, D / 2}; pg8::StaticOrder S; S.init(T, NP, G, bx, WGM_IN, KROT(bx));
            pg8::EpiBf16PS E{(pg8::bf16_t*)(a.ws + WS_PROJ), NP, (const float*)(a.ws + WS_SAH), (const float*)(a.ws + WS_SB) + l * SBL};
            pg8::gemm_phase<pg8::EpiBf16PS, pg8::StaticOrder, true, true, true>(lds + RING_OFF, g, S, E, tidp);
#else
            pg8::Gemm g{(const pg8::bf16_t*)(a.ws + WS_H), (const pg8::bf16_t*)(a.ws + WS_WIN) + (size_t)l * INW * D, T, NP, D}; pg8::StaticOrder S; S.init(T, NP, G, bx, WGM_IN, KROT(bx));
            pg8::EpiBf16P E{(pg8::bf16_t*)(a.ws + WS_PROJ), NP};
            pg8::gemm_phase<pg8::EpiBf16P, pg8::StaticOrder, true, true>(lds + RING_OFF, g, S, E, tidp);
#endif
#ifndef GP_REP
#define GP_REP 1
#endif
            for (int gpr_ = 0; gpr_ < GP_REP; ++gpr_) for (int ch = bx; ch < NCHUNK; ch += G) gate_prep(a, l, lds, tidp, lanep, wavep, ch);
            REP_END(2) SEAM(pb + 0);
        }
        if (EN(3) && IN(pb + 1)) { REP_BEGIN(3) PHASE_IDS(); for (int un = bx; un < 256; un += G) gla_unit(a, lds, tidp, lanep, wavep, un); REP_END(3) SEAM(pb + 1); }
        if (EN(4) && IN(pb + 2)) { REP_BEGIN(4) PHASE_IDS(); for (int ch = bx; ch < NCHUNK; ch += G) mixpost_chunk(a, l, lanep, wavep, ch); REP_END(4) SEAM(pb + 2); }
        if (EN(5) && IN(pb + 3)) {
            REP_BEGIN(5) PHASE_IDS();
#if I8_OUT
            pg8::Gemm g{(const pg8::bf16_t*)(a.ws + WS_Y8), (const pg8::bf16_t*)(a.ws + WS_WOUT8 + (size_t)l * D * D), T, D, D / 2}; pg8::StaticOrder S; S.init(T, D, G, bx, WGM_OUT, KROT(bx));
#if RES16_X || RES16_Z
            pg8::EpiResidS16<(RES16_X != 0), (RES16_Z != 0)> E{(void*)(a.ws + WS_Z), (RES16_X || l > 0) ? (const void*)(a.ws + WS_X) : (const void*)a.in[0], mod + (size_t)l * NB * 6 * D + 2 * D, (const float*)(a.ws + WS_SAY), (const float*)(a.ws + WS_SB) + l * SBL + NP, ALPHA};
            pg8::gemm_phase<pg8::EpiResidS16<(RES16_X != 0), (RES16_Z != 0)>, pg8::StaticOrder, true, true, true>(lds + RING_OFF, g, S, E, tidp);
#else
            pg8::EpiResidS E{(float*)(a.ws + WS_Z), l == 0 ? a.in[0] : (const float*)(a.ws + WS_X), mod + (size_t)l * NB * 6 * D + 2 * D, (const float*)(a.ws + WS_SAY), (const float*)(a.ws + WS_SB) + l * SBL + NP, ALPHA};
            pg8::gemm_phase<pg8::EpiResidS, pg8::StaticOrder, true, true, true>(lds + RING_OFF, g, S, E, tidp);
#endif
#else
            pg8::Gemm g{(const pg8::bf16_t*)(a.ws + WS_Y), (const pg8::bf16_t*)(a.ws + WS_WOUT) + (size_t)l * D * D, T, D, D}; pg8::StaticOrder S; S.init(T, D, G, bx, WGM_OUT, KROT(bx));
            pg8::EpiResid E{(float*)(a.ws + WS_Z), l == 0 ? a.in[0] : (const float*)(a.ws + WS_X), mod + (size_t)l * NB * 6 * D + 2 * D, ALPHA};
            pg8::gemm_phase<pg8::EpiResid, pg8::StaticOrder, true, true>(lds + RING_OFF, g, S, E, tidp);
#endif
            REP_END(5) SEAM(pb + 3);
        }
        if (EN(6) && IN(pb + 4)) { REP_BEGIN(6) PHASE_IDS(); for (int ch = bx; ch < NCHUNK; ch += G) ln1_chunk(a, l, lds, lanep, wavep, ch); REP_END(6) SEAM(pb + 4); }
        if (EN(7) && IN(pb + 5)) {
            REP_BEGIN(7) PHASE_IDS();
#if I8_WQ
            pg8::Gemm g{(const pg8::bf16_t*)(a.ws + WS_H28), (const pg8::bf16_t*)(a.ws + WS_WQ8 + (size_t)l * D * D), T, D, D / 2}; pg8::StaticOrder S; S.init(T, D, G, bx, WGM_WQ, KROT(bx));
            pg8::EpiBf16PS E{(pg8::bf16_t*)(a.ws + WS_Q), D, (const float*)(a.ws + WS_HSC), (const float*)(a.ws + WS_SB) + l * SBL + NP + D};
            pg8::gemm_phase<pg8::EpiBf16PS, pg8::StaticOrder, true, true, true>(lds + RING_OFF, g, S, E, tidp);
#else
            pg8::Gemm g{(const pg8::bf16_t*)(a.ws + WS_H2), (const pg8::bf16_t*)(a.ws + WS_WQ) + (size_t)l * D * D, T, D, D}; pg8::StaticOrder S; S.init(T, D, G, bx, WGM_WQ, KROT(bx));
            pg8::EpiBf16P E{(pg8::bf16_t*)(a.ws + WS_Q), D};
            pg8::gemm_phase<pg8::EpiBf16P, pg8::StaticOrder, true, true>(lds + RING_OFF, g, S, E, tidp);
#endif
            REP_END(7) SEAM(pb + 5);
        }
#ifndef PEER_DBG
#define PEER_DBG 0
#endif
#ifndef PE_REP_R
#define PE_REP_R 1
#endif
#ifndef L2PROBE
#define L2PROBE 0
#endif
        if (EN(8) && IN(pb + 6)) {
            REP_BEGIN(8)
            for (int ch = bx; ch < NCHUNK; ch += G) { for (int repr_ = 0; repr_ < PE_REP_R; ++repr_) { PHASE_IDS(); peer_retrieve(a, l, lds, lanep, wavep, ch); __syncthreads(); } __syncthreads(); { PHASE_IDS(); peer_experts(a, l, lds, lanep, wavep, ch); } __syncthreads(); }
            REP_END(8) SEAM(pb + 6);
        }
    }
#undef IN
#undef SEAM
}

extern "C" void kernel_launch(void* const* d_in, const int* in_sizes, int n_in, void* d_out, int out_size, void* d_ws, size_t ws_size, hipStream_t stream) {
    static int grid = 0;
    if (grid == 0) {
        if (n_in != 19 || in_sizes[0] != T * D || out_size != T * D || ws_size < WS_END) { fprintf(stderr, "kernel_launch: unexpected shapes / workspace (%d inputs, ws %zu); nothing launched\n", n_in, ws_size); grid = -1; return; }
        int dev = 0, cus = 0, per_cu = 0;
        if (hipGetDevice(&dev) != hipSuccess || hipDeviceGetAttribute(&cus, hipDeviceAttributeMultiprocessorCount, dev) != hipSuccess) { grid = -1; return; }
        if (hipFuncSetAttribute((const void*)mk_fwd, hipFuncAttributeMaxDynamicSharedMemorySize, LDS_BYTES) != hipSuccess) { fprintf(stderr, "kernel_launch: hipFuncSetAttribute failed\n"); grid = -1; return; }
        if (hipOccupancyMaxActiveBlocksPerMultiprocessor(&per_cu, (const void*)mk_fwd, NTHREADS, LDS_BYTES) != hipSuccess || per_cu < 1) fprintf(stderr, "kernel_launch: occupancy query reports %d\n", per_cu);
        (void)hipGetLastError();
        grid = cus;
    }
    if (grid < 0) return;
    if (hipMemsetAsync((char*)d_ws + WS_CTL, 0, CTL_ZERO_BYTES, stream) != hipSuccess) return;
    Args a{};
    for (int i = 0; i < 19; ++i) a.in[i] = (const float*)d_in[i];
    a.out = (float*)d_out; a.ws = (unsigned char*)d_ws;
#if MK_PER_PHASE
    for (int p = 0; p < NPHASES; ++p) { a.ph_lo = p; a.ph_hi = p + 1; hipLaunchKernelGGL(mk_fwd, dim3(grid), dim3(NTHREADS), LDS_BYTES, stream, a); }
#else
    a.ph_lo = 0; a.ph_hi = NPHASES;
    hipLaunchKernelGGL(mk_fwd, dim3(grid), dim3(NTHREADS), LDS_BYTES, stream, a);
#endif
}
```

```cpp
#include <hip/hip_runtime.h>
#include <cstdio>
#include <cstdint>
namespace pg8 {
#define PG8_LAS __attribute__((address_space(3)))
typedef unsigned short bf16_t;
typedef short bf16x8 __attribute__((ext_vector_type(8)));
typedef float f32x4 __attribute__((ext_vector_type(4)));
typedef unsigned u32x4 __attribute__((ext_vector_type(4)));
typedef int i32x4 __attribute__((ext_vector_type(4)));
constexpr int BM = 256, BK = 64, HALF = 128, HTB = HALF * BK * 2  , STAGE_BYTES = 8 * HTB, NXCD = 8, WGM = 8;

__host__ __device__ __forceinline__ int lds_byte(int r, int c) { const int st = (r >> 4) * 2 + (c >> 5), rr = r & 15, cc = c & 31, ob = rr * 64 + cc * 2; return st * 1024 + (ob ^ (((ob >> 9) & 1) << 5)); }
__host__ __device__ __forceinline__ void stage_rc(int b, int& R, int& C) { const int st = b / 1024, sb = b % 1024, swz = sb ^ (((sb >> 9) & 1) << 5); R = (st >> 1) * 16 + swz / 64; C = (st & 1) * 32 + (swz % 64) / 2; }
__host__ __device__ __forceinline__ int perm32(int rho) { const int n = rho >> 4, i = rho & 15; return 8 * (i >> 2) + 4 * n + (i & 3); }

struct Unit { int pm, pn; };
struct Gemm { const bf16_t* A; const bf16_t* Bt; int M, N, K; };

struct StaticOrder {
    int nM, nN, nwg, G, c, wgm, krot;
    __host__ __device__ void init(int M, int N, int G_, int c_, int wgm_ = WGM, int krot_ = 0) { nM = M / BM; nN = N / BM; nwg = nM * nN; G = G_; c = c_; wgm = wgm_; krot = krot_; }
    __host__ __device__ bool next(int i, Unit& u) const {
        const long L = (long)i * G + c; if (L >= nwg) return false;
        int wgid = (int)L; { const int q = nwg / NXCD, r = nwg % NXCD, xcd = wgid % NXCD, off = wgid / NXCD; wgid = (xcd < r ? xcd * (q + 1) : r * (q + 1) + (xcd - r) * q) + off; }
        const int nig = wgm * nN, gid = wgid / nig, fm = gid * wgm, gsz = (nM - fm) < wgm ? (nM - fm) : wgm;
        u.pm = fm + ((wgid % nig) % gsz); u.pn = (wgid % nig) / gsz; return true;
    }
    __device__ __forceinline__ void a_ready(const Unit&) const {}
    __device__ __forceinline__ void done(const Unit&) const {}
};
typedef __bf16 bf16x2_t __attribute__((ext_vector_type(2)));
__device__ __forceinline__ unsigned cvt_pk_bf16(float lo, float hi) { bf16x2_t r; r.x = (__bf16)lo; r.y = (__bf16)hi; return __builtin_bit_cast(unsigned, r); }
struct EpiBf16P {
    static constexpr bool PERM = true, AFTER_DRAIN = false;
    bf16_t* O; int ldc;
    __device__ __forceinline__ void operator()(const f32x4 (&acc)[2][2][4][2], const Unit& u, int wr, int wc, int fr, int fq) const {
        const int row0 = u.pm * BM + wr * 64 + fr, col0 = u.pn * BM + wc * 32 + 8 * fq;
#pragma unroll
        for (int ai = 0; ai < 2; ++ai)
#pragma unroll
            for (int m = 0; m < 4; ++m) { bf16_t* rowp = O + (size_t)(row0 + ai * HALF + m * 16) * ldc + col0;
#pragma unroll
                for (int bj = 0; bj < 2; ++bj) { const f32x4 v0 = acc[ai][bj][m][0], v1 = acc[ai][bj][m][1];
                    u32x4 w; w.x = cvt_pk_bf16(v0[0], v0[1]); w.y = cvt_pk_bf16(v0[2], v0[3]); w.z = cvt_pk_bf16(v1[0], v1[1]); w.w = cvt_pk_bf16(v1[2], v1[3]);
                    *(u32x4*)(rowp + bj * HALF) = w; } }
    }
};
struct EpiResid {
    static constexpr bool PERM = false, AFTER_DRAIN = false;
    float* Z; const float* X; const float* gate; float alpha;
    __device__ __forceinline__ void operator()(const f32x4 (&acc)[2][2][4][2], const Unit& u, int wr, int wc, int fr, int fq) const {
        const int row0 = u.pm * BM + wr * 64 + fr, col0 = u.pn * BM + wc * 32 + 4 * fq;
        const float* gb = gate + (size_t)(u.pm >> 3) * (6 * 2048) + col0;
        f32x4 gv[2][2];
#pragma unroll
        for (int bj = 0; bj < 2; ++bj)
#pragma unroll
            for (int n = 0; n < 2; ++n) gv[bj][n] = *(const f32x4*)(gb + bj * HALF + n * 16) + 1.0f;
#pragma unroll
        for (int ai = 0; ai < 2; ++ai)
#pragma unroll
            for (int m = 0; m < 4; ++m) { const size_t off = (size_t)(row0 + ai * HALF + m * 16) * 2048 + col0;
#pragma unroll
                for (int bj = 0; bj < 2; ++bj)
#pragma unroll
                    for (int n = 0; n < 2; ++n) { const f32x4 xv = *(const f32x4*)(X + off + bj * HALF + n * 16);
                        *(f32x4*)(Z + off + bj * HALF + n * 16) = xv * alpha + gv[bj][n] * acc[ai][bj][m][n]; }
                asm volatile("" ::: "memory"); }
    }
};
#ifndef PG8_NT
#define PG8_NT 0
#endif
#if PG8_NT
#define PG8_ST(TY, p, v) __builtin_nontemporal_store((v), (TY*)(p))
#else
#define PG8_ST(TY, p, v) (*(TY*)(p) = (v))
#endif
__device__ __forceinline__ f32x4 acc_i2f(const f32x4 v) { const i32x4 iv = __builtin_bit_cast(i32x4, v); return __builtin_convertvector(iv, f32x4); }
struct EpiBf16PS {
    static constexpr bool PERM = true, AFTER_DRAIN = false;
    bf16_t* O; int ldc; const float* sa; const float* sb;
    __device__ __forceinline__ void operator()(const f32x4 (&acc)[2][2][4][2], const Unit& u, int wr, int wc, int fr, int fq) const {
        const int row0 = u.pm * BM + wr * 64 + fr, col0 = u.pn * BM + wc * 32 + 8 * fq;
        f32x4 sbv[2][2];
#pragma unroll
        for (int bj = 0; bj < 2; ++bj)
#pragma unroll
            for (int n = 0; n < 2; ++n) sbv[bj][n] = *(const f32x4*)(sb + col0 + bj * HALF + 4 * n);
#pragma unroll
        for (int ai = 0; ai < 2; ++ai)
#pragma unroll
            for (int m = 0; m < 4; ++m) { const int row = row0 + ai * HALF + m * 16; bf16_t* rowp = O + (size_t)row * ldc + col0; const float sar = sa[row];
#pragma unroll
                for (int bj = 0; bj < 2; ++bj) { const f32x4 v0 = acc_i2f(acc[ai][bj][m][0]) * (sbv[bj][0] * sar), v1 = acc_i2f(acc[ai][bj][m][1]) * (sbv[bj][1] * sar);
                    u32x4 w; w.x = cvt_pk_bf16(v0[0], v0[1]); w.y = cvt_pk_bf16(v0[2], v0[3]); w.z = cvt_pk_bf16(v1[0], v1[1]); w.w = cvt_pk_bf16(v1[2], v1[3]);
                    PG8_ST(u32x4, rowp + bj * HALF, w); } }
    }
};
struct EpiResidS {
    static constexpr bool PERM = false, AFTER_DRAIN = false;
    float* Z; const float* X; const float* gate; const float* sa; const float* sb; float alpha;
    __device__ __forceinline__ void operator()(const f32x4 (&acc)[2][2][4][2], const Unit& u, int wr, int wc, int fr, int fq) const {
        const int row0 = u.pm * BM + wr * 64 + fr, col0 = u.pn * BM + wc * 32 + 4 * fq;
        const float* gb = gate + (size_t)(u.pm >> 3) * (6 * 2048) + col0;
        f32x4 gv[2][2];
#pragma unroll
        for (int bj = 0; bj < 2; ++bj)
#pragma unroll
            for (int n = 0; n < 2; ++n) gv[bj][n] = (*(const f32x4*)(gb + bj * HALF + n * 16) + 1.0f) * *(const f32x4*)(sb + col0 + bj * HALF + n * 16);
#pragma unroll
        for (int ai = 0; ai < 2; ++ai)
#pragma unroll
            for (int m = 0; m < 4; ++m) { const int row = row0 + ai * HALF + m * 16; const size_t off = (size_t)row * 2048 + col0; const float sar = sa[row];
#pragma unroll
                for (int bj = 0; bj < 2; ++bj)
#pragma unroll
                    for (int n = 0; n < 2; ++n) { const f32x4 xv = *(const f32x4*)(X + off + bj * HALF + n * 16);
                        PG8_ST(f32x4, Z + off + bj * HALF + n * 16, xv * alpha + (gv[bj][n] * sar) * acc_i2f(acc[ai][bj][m][n])); }
                asm volatile("" ::: "memory"); }
    }
};
template <bool XB, bool ZB> struct EpiResidS16 {
    static constexpr bool PERM = true, AFTER_DRAIN = false;
    void* Z; const void* X; const float* gate; const float* sa; const float* sb; float alpha;
    __device__ __forceinline__ void operator()(const f32x4 (&acc)[2][2][4][2], const Unit& u, int wr, int wc, int fr, int fq) const {
        const int row0 = u.pm * BM + wr * 64 + fr, col0 = u.pn * BM + wc * 32 + 8 * fq;
        const float* gb = gate + (size_t)(u.pm >> 3) * (6 * 2048) + col0;
        f32x4 gv[2][2];
#pragma unroll
        for (int bj = 0; bj < 2; ++bj)
#pragma unroll
            for (int n = 0; n < 2; ++n) gv[bj][n] = (*(const f32x4*)(gb + bj * HALF + 4 * n) + 1.0f) * *(const f32x4*)(sb + col0 + bj * HALF + 4 * n);
#pragma unroll
        for (int ai = 0; ai < 2; ++ai)
#pragma unroll
            for (int m = 0; m < 4; ++m) { const int row = row0 + ai * HALF + m * 16; const size_t off = (size_t)row * 2048 + col0; const float sar = sa[row];
#pragma unroll
                for (int bj = 0; bj < 2; ++bj) { f32x4 x0, x1;
                    if constexpr (XB) { const u32x4 xw = *(const u32x4*)((const bf16_t*)X + off + bj * HALF);
                        x0 = (f32x4){__uint_as_float(xw.x << 16), __uint_as_float(xw.x & 0xffff0000u), __uint_as_float(xw.y << 16), __uint_as_float(xw.y & 0xffff0000u)};
                        x1 = (f32x4){__uint_as_float(xw.z << 16), __uint_as_float(xw.z & 0xffff0000u), __uint_as_float(xw.w << 16), __uint_as_float(xw.w & 0xffff0000u)}; }
                    else { x0 = *(const f32x4*)((const float*)X + off + bj * HALF); x1 = *(const f32x4*)((const float*)X + off + bj * HALF + 4); }
                    const f32x4 v0 = x0 * alpha + (gv[bj][0] * sar) * acc_i2f(acc[ai][bj][m][0]), v1 = x1 * alpha + (gv[bj][1] * sar) * acc_i2f(acc[ai][bj][m][1]);
                    if constexpr (ZB) { u32x4 w; w.x = cvt_pk_bf16(v0[0], v0[1]); w.y = cvt_pk_bf16(v0[2], v0[3]); w.z = cvt_pk_bf16(v1[0], v1[1]); w.w = cvt_pk_bf16(v1[2], v1[3]);
                        PG8_ST(u32x4, (bf16_t*)Z + off + bj * HALF, w); }
                    else { PG8_ST(f32x4, (float*)Z + off + bj * HALF, v0); PG8_ST(f32x4, (float*)Z + off + bj * HALF + 4, v1); } }
                asm volatile("" ::: "memory"); }
    }
};
template <class Epi, class Sched, bool ALIGN_EPI = false, bool SP2 = false, bool I8 = false>
__device__ __forceinline__ void gemm_phase(PG8_LAS unsigned char* lds, const Gemm g, const Sched& S, const Epi& E, const int tid_in) {
    const int tid = tid_in, wid = __builtin_amdgcn_readfirstlane(tid >> 6), lane = tid & 63, wr = wid >> 2, wc = wid & 3, fr = lane & 15, fq = lane >> 4;
    const int K = g.K, nt = K / BK;
    const int krot = ((nt & (nt - 1)) == 0) ? (S.krot & (nt - 1)) : 0;
#define PG8_KOFS(t) ((size_t)(((t) + krot) & (nt - 1)) * kstep)
    unsigned voffA[2], voffB[2];
#pragma unroll
    for (int i = 0; i < 2; ++i) { int R, C; stage_rc(tid * 16 + i * 8192, R, C); const int Rb = Epi::PERM ? ((R & ~31) + perm32(R & 31)) : R;
        voffA[i] = (unsigned)(R * K + C) * 2u; voffB[i] = (unsigned)(Rb * K + C) * 2u; }
    const size_t kstep = (size_t)(BK * 2);
    const size_t hstep = (size_t)HALF * K * 2;
    const size_t tstep = 2 * hstep;
    const unsigned ldsw = (unsigned)wid * 1024u;
    const int aoff = lds_byte(wr * 64 + fr, fq * 8), boff = lds_byte(wc * 32 + fr, fq * 8);
#define PG8_SA(b, h) (((b) * 2 + (h)) * HTB)
#define PG8_SB(b, h) ((4 + (b) * 2 + (h)) * HTB)
#define PG8_STAGE(bufoff, gbase, voff) do { _Pragma("unroll") for (int _i = 0; _i < 2; ++_i) \
        __builtin_amdgcn_global_load_lds((const unsigned*)((const char*)(gbase) + (voff)[_i]), (PG8_LAS unsigned*)(lds + (bufoff) + ldsw + _i * 8192), 16, 0, 0); } while (0)
#define PG8_LDA(dst, b, h) do { _Pragma("unroll") for (int m = 0; m < 4; ++m) _Pragma("unroll") for (int k = 0; k < 2; ++k) dst[m][k] = *(const PG8_LAS bf16x8*)(lds + PG8_SA(b, h) + aoff + m * 2048 + k * 1024); } while (0)
#define PG8_LDB(dst, b, h) do { _Pragma("unroll") for (int n = 0; n < 2; ++n) _Pragma("unroll") for (int k = 0; k < 2; ++k) dst[n][k] = *(const PG8_LAS bf16x8*)(lds + PG8_SB(b, h) + boff + n * 2048 + k * 1024); } while (0)
#define PG8_MMA(ai, bj, At, Bt) do { __builtin_amdgcn_s_setprio(1); _Pragma("unroll") for (int m = 0; m < 4; ++m) _Pragma("unroll") for (int n = 0; n < 2; ++n) _Pragma("unroll") for (int k = 0; k < 2; ++k) \
        { if constexpr (I8) acc[ai][bj][m][n] = __builtin_bit_cast(f32x4, __builtin_amdgcn_mfma_i32_16x16x64_i8(__builtin_bit_cast(i32x4, Bt[n][k]), __builtin_bit_cast(i32x4, At[m][k]), __builtin_bit_cast(i32x4, acc[ai][bj][m][n]), 0, 0, 0)); \
          else acc[ai][bj][m][n] = __builtin_amdgcn_mfma_f32_16x16x32_bf16(Bt[n][k], At[m][k], acc[ai][bj][m][n], 0, 0, 0); } __builtin_amdgcn_s_setprio(0); } while (0)
#define PG8_WAIT_V(n) asm volatile("s_waitcnt vmcnt(" #n ")" ::: "memory")
#define PG8_WAIT_L(n) asm volatile("s_waitcnt lgkmcnt(" #n ")" ::: "memory")
#define PG8_BAR __builtin_amdgcn_s_barrier()
#define PG8_SCHED __builtin_amdgcn_sched_barrier(0)
    Unit cur, nxt; int ui = 0;
    if (!S.next(0, cur)) return;
    f32x4 acc[2][2][4][2];
#pragma unroll
    for (int a = 0; a < 2; ++a)
#pragma unroll
        for (int b = 0; b < 2; ++b)
#pragma unroll
            for (int m = 0; m < 4; ++m)
#pragma unroll
                for (int n = 0; n < 2; ++n) acc[a][b][m][n] = (f32x4){0.f, 0.f, 0.f, 0.f};
    bf16x8 At[4][2], B0[2][2], B1[2][2];
    const char* cA = (const char*)g.A + (size_t)cur.pm * tstep; const char* cB = (const char*)g.Bt + (size_t)cur.pn * tstep;
    S.a_ready(cur);
    if constexpr (SP2) {
        PG8_STAGE(PG8_SB(0, 0), cB + PG8_KOFS(0), voffB); PG8_STAGE(PG8_SB(0, 1), cB + hstep + PG8_KOFS(0), voffB); PG8_STAGE(PG8_SA(0, 0), cA + PG8_KOFS(0), voffA); PG8_STAGE(PG8_SA(0, 1), cA + hstep + PG8_KOFS(0), voffA);
        if (wr == 1) PG8_BAR;
        PG8_WAIT_V(2); PG8_BAR;
        PG8_STAGE(PG8_SB(1, 0), cB + PG8_KOFS(1), voffB); PG8_STAGE(PG8_SA(1, 0), cA + PG8_KOFS(1), voffA); PG8_STAGE(PG8_SB(1, 1), cB + hstep + PG8_KOFS(1), voffB);
        PG8_WAIT_V(6); PG8_BAR;
    } else {
        PG8_STAGE(PG8_SB(0, 0), cB + PG8_KOFS(0), voffB); PG8_STAGE(PG8_SA(0, 0), cA + PG8_KOFS(0), voffA); PG8_STAGE(PG8_SB(0, 1), cB + hstep + PG8_KOFS(0), voffB); PG8_STAGE(PG8_SA(0, 1), cA + hstep + PG8_KOFS(0), voffA);
        if (wr == 1) PG8_BAR;
        PG8_WAIT_V(4); PG8_BAR;
        PG8_STAGE(PG8_SB(1, 0), cB + PG8_KOFS(1), voffB); PG8_STAGE(PG8_SA(1, 0), cA + PG8_KOFS(1), voffA); PG8_STAGE(PG8_SB(1, 1), cB + hstep + PG8_KOFS(1), voffB);
        PG8_WAIT_V(6); PG8_BAR;
    }
    for (;;) {
        const bool has_next = S.next(ui + 1, nxt);
        const char* nA = has_next ? (const char*)g.A + (size_t)nxt.pm * tstep : cA; const char* nB = has_next ? (const char*)g.Bt + (size_t)nxt.pn * tstep : cB;
#ifdef PG8_KREP
        for (int kr_ = 0; kr_ < PG8_KREP; ++kr_) {
        if (kr_) {
#pragma unroll
        for (int a = 0; a < 2; ++a)
#pragma unroll
            for (int b = 0; b < 2; ++b)
#pragma unroll
                for (int m = 0; m < 4; ++m)
#pragma unroll
                    for (int n = 0; n < 2; ++n) acc[a][b][m][n] = (f32x4){0.f, 0.f, 0.f, 0.f}; }
        const char* nA_ = (kr_ + 1 < PG8_KREP) ? cA : nA; const char* nB_ = (kr_ + 1 < PG8_KREP) ? cB : nB;
#else
        const char* nA_ = nA; const char* nB_ = nB;
#endif
        for (int t = 0; t < nt; t += 2) {
            const bool last = (t == nt - 2);
            const char* a1 = cA + PG8_KOFS(t + 1);
            const char* a2 = (last ? nA_ : cA) + PG8_KOFS(t + 2); const char* b2 = (last ? nB_ : cB) + PG8_KOFS(t + 2);
            const char* a3 = (last ? nA_ : cA) + PG8_KOFS(t + 3); const char* b3 = (last ? nB_ : cB) + PG8_KOFS(t + 3);
            if (last && has_next) S.a_ready(nxt);
            if constexpr (SP2) {
            PG8_LDB(B0, 0, 0); PG8_LDB(B1, 0, 1); PG8_SCHED; PG8_LDA(At, 0, 0); PG8_STAGE(PG8_SA(1, 1), a1 + hstep, voffA);
            PG8_WAIT_V(8); PG8_WAIT_L(0); PG8_BAR; PG8_MMA(0, 0, At, B0); PG8_MMA(0, 1, At, B1); PG8_BAR; PG8_SCHED;
            PG8_LDA(At, 0, 1); PG8_STAGE(PG8_SB(0, 0), b2, voffB); PG8_STAGE(PG8_SB(0, 1), b2 + hstep, voffB); PG8_STAGE(PG8_SA(0, 0), a2, voffA);
            PG8_WAIT_V(8); PG8_WAIT_L(0); PG8_BAR; PG8_MMA(1, 0, At, B0); PG8_MMA(1, 1, At, B1); PG8_BAR; PG8_SCHED;
            PG8_LDB(B0, 1, 0); PG8_LDB(B1, 1, 1); PG8_SCHED; PG8_LDA(At, 1, 0); PG8_STAGE(PG8_SA(0, 1), a2 + hstep, voffA);
            PG8_WAIT_V(8); PG8_WAIT_L(0); PG8_BAR; PG8_MMA(0, 0, At, B0); PG8_MMA(0, 1, At, B1); PG8_BAR; PG8_SCHED;
            PG8_LDA(At, 1, 1); PG8_STAGE(PG8_SB(1, 0), b3, voffB); PG8_STAGE(PG8_SB(1, 1), b3 + hstep, voffB); PG8_STAGE(PG8_SA(1, 0), a3, voffA);
            PG8_WAIT_V(8); PG8_WAIT_L(0); PG8_BAR; PG8_MMA(1, 0, At, B0); PG8_MMA(1, 1, At, B1); PG8_BAR; PG8_SCHED;
            } else {
            PG8_LDB(B0, 0, 0); PG8_SCHED; PG8_LDA(At, 0, 0); PG8_STAGE(PG8_SA(1, 1), a1 + hstep, voffA);
            PG8_WAIT_L(8); PG8_BAR; PG8_WAIT_L(0); PG8_MMA(0, 0, At, B0); PG8_BAR; PG8_SCHED;
            PG8_LDB(B1, 0, 1); PG8_STAGE(PG8_SB(0, 0), b2, voffB);
            PG8_BAR; PG8_WAIT_L(0); PG8_MMA(0, 1, At, B1); PG8_BAR;
            PG8_LDA(At, 0, 1); PG8_STAGE(PG8_SA(0, 0), a2, voffA);
            PG8_BAR; PG8_WAIT_L(0); PG8_MMA(1, 0, At, B0); PG8_BAR; PG8_SCHED;
            PG8_STAGE(PG8_SB(0, 1), b2 + hstep, voffB);
            PG8_WAIT_V(6); PG8_BAR; PG8_MMA(1, 1, At, B1); PG8_BAR;
            PG8_LDB(B0, 1, 0); PG8_SCHED; PG8_LDA(At, 1, 0); PG8_STAGE(PG8_SA(0, 1), a2 + hstep, voffA);
            PG8_WAIT_L(8); PG8_BAR; PG8_WAIT_L(0); PG8_MMA(0, 0, At, B0); PG8_BAR; PG8_SCHED;
            PG8_LDB(B1, 1, 1); PG8_STAGE(PG8_SB(1, 0), b3, voffB);
            PG8_BAR; PG8_WAIT_L(0); PG8_MMA(0, 1, At, B1); PG8_BAR;
            PG8_LDA(At, 1, 1); PG8_STAGE(PG8_SA(1, 0), a3, voffA);
            PG8_BAR; PG8_WAIT_L(0); PG8_MMA(1, 0, At, B0); PG8_BAR; PG8_SCHED;
            PG8_STAGE(PG8_SB(1, 1), b3 + hstep, voffB);
            PG8_WAIT_V(6); PG8_BAR; PG8_MMA(1, 1, At, B1); PG8_BAR;
            }
        }
#ifdef PG8_KREP
        }
#endif
        if constexpr (ALIGN_EPI) { if (wr == 0) PG8_BAR; }
#ifdef PG8_EPI2
        if constexpr (!Epi::AFTER_DRAIN) { E(acc, cur, wr, wc, fr, fq); asm volatile("" ::: "memory"); }
#endif
        if constexpr (!Epi::AFTER_DRAIN) { E(acc, cur, wr, wc, fr, fq); S.done(cur); }
        if (!has_next) break;
#pragma unroll
        for (int a = 0; a < 2; ++a)
#pragma unroll
            for (int b = 0; b < 2; ++b)
#pragma unroll
                for (int m = 0; m < 4; ++m)
#pragma unroll
                    for (int n = 0; n < 2; ++n) acc[a][b][m][n] = (f32x4){0.f, 0.f, 0.f, 0.f};
        cur = nxt; cA = nA; cB = nB; ++ui;
        if constexpr (ALIGN_EPI) { if (wr == 1) PG8_BAR; }
    }
    PG8_WAIT_V(0);
    if constexpr (!ALIGN_EPI) { if (wr == 0) PG8_BAR; }
    PG8_BAR;
    if constexpr (Epi::AFTER_DRAIN) { E.fused(acc, cur, wr, wc, fr, fq, lds, wid, lane); S.done(cur); }
#undef PG8_SA
#undef PG8_SB
#undef PG8_STAGE
#undef PG8_LDA
#undef PG8_LDB
#undef PG8_MMA
#undef PG8_WAIT_V
#undef PG8_WAIT_L
#undef PG8_BAR
#undef PG8_SCHED
#undef PG8_KOFS
}
}
#define XB_TMO      128
#define XB_XCNT(j)  (256  + 64 * (j))
#define XB_XSUB(j)  (1280 + 64 * (j))
#define XB_XGEN(j)  (2304 + 64 * (j))
#define XB_TOP      3328
#define XB_TOPGEN   3392
#define XCD_BAR_WORDS 3456
#define XB_SPIN_CAP (1u << 18)
#define LAS __attribute__((address_space(3)))

__device__ __forceinline__ unsigned xb_ld(unsigned* p)              { return __hip_atomic_load(p, __ATOMIC_RELAXED, __HIP_MEMORY_SCOPE_AGENT); }
__device__ __forceinline__ unsigned xb_add(unsigned* p, unsigned v) { return __hip_atomic_fetch_add(p, v, __ATOMIC_RELAXED, __HIP_MEMORY_SCOPE_AGENT); }
__device__ __forceinline__ unsigned xb_xcc_id() { return (unsigned)__builtin_amdgcn_s_getreg((3 << 11) | 20) & 0xFu; }
#define XB_SPIN(cond, bar) do { unsigned _sp = 0; while (cond) { __builtin_amdgcn_s_sleep(1); \
    if ((++_sp & 255u) == 0u) { if (xb_ld(&(bar)[XB_TMO])) break; if (_sp > XB_SPIN_CAP) { atomicAdd(&(bar)[XB_TMO], 1u); break; } } } } while (0)

struct XcdBarrier {
    unsigned* bar; unsigned x;
    volatile LAS unsigned* st;
};

__device__ __forceinline__ XcdBarrier xcd_barrier_post(unsigned* bar, volatile LAS unsigned* st) {
    XcdBarrier b; b.bar = bar; b.x = xb_xcc_id(); b.st = st;
    if (threadIdx.x == 0) (void)xb_add(&bar[XB_XCNT(b.x)], 1u);
    return b;
}
__device__ __forceinline__ void xcd_barrier_complete(unsigned* bar, unsigned x, unsigned& nloc, unsigned& nx) {
    const unsigned G = gridDim.x * gridDim.y * gridDim.z;
    unsigned sum, cnt, mine, sp = 0u;
    for (;;) {
        sum = 0u; cnt = 0u; mine = 0u;
#pragma unroll
        for (unsigned j = 0; j < 16; ++j) { const unsigned c = xb_ld(&bar[XB_XCNT(j)]); sum += c; cnt += (c > 0u) ? 1u : 0u; mine = (j == x) ? c : mine; }
        if (sum == G) break;
        __builtin_amdgcn_s_sleep(1);
        if ((++sp & 255u) == 0u) { if (xb_ld(&bar[XB_TMO])) break; if (sp > XB_SPIN_CAP) { atomicAdd(&bar[XB_TMO], 1u); break; } }
    }
    nloc = mine > 0u ? mine : 1u; nx = cnt > 0u ? cnt : 1u;
}

__device__ __forceinline__ void xcd_barrier(const XcdBarrier& b) {
    asm volatile("s_waitcnt vmcnt(0)" ::: "memory");
    __syncthreads();
    if (threadIdx.x == 0) {
        unsigned* bar = b.bar;
        __builtin_amdgcn_s_waitcnt(0);
        unsigned nloc = b.st[0], nx = b.st[1];
        if (nloc == 0u) { xcd_barrier_complete(bar, b.x, nloc, nx); b.st[0] = nloc; b.st[1] = nx; }
        const unsigned old = xb_add(&bar[XB_XSUB(b.x)], 1u);
        const unsigned gen = old / nloc;
        if (old + 1u == (gen + 1u) * nloc) {
            __builtin_amdgcn_fence(__ATOMIC_RELEASE, "agent");
            asm volatile("s_waitcnt vmcnt(0)" ::: "memory");
            const unsigned og = xb_add(&bar[XB_TOP], 1u);
            const unsigned tg = og / nx;
            if (og + 1u == (tg + 1u) * nx) xb_add(&bar[XB_TOPGEN], 1u);
            else XB_SPIN(xb_ld(&bar[XB_TOPGEN]) == tg, bar);
            __builtin_amdgcn_fence(__ATOMIC_ACQUIRE, "agent");
            xb_add(&bar[XB_XGEN(b.x)], 1u);
            asm volatile("s_waitcnt vmcnt(0)" ::: "memory");
        } else {
            XB_SPIN(xb_ld(&bar[XB_XGEN(b.x)]) == gen, bar);
            __builtin_amdgcn_fence(__ATOMIC_ACQUIRE, "agent");
            asm volatile("s_waitcnt vmcnt(0)" ::: "memory");
        }
    }
    __syncthreads();
}
constexpr int D = 2048, NB = 8, SEQ = 2048, NL = 4, T = NB * SEQ;
constexpr int NCH = SEQ / 64, NCHUNK = T / 64;
constexpr int GKW = 512, RANK = 16;
constexpr int INW = 6160, NP = 6144;
constexpr int NE = 16384;
constexpr float ALPHA = 1.6817928305074290f, EPS = 1e-5f;
constexpr int PQ = 0, PK = 512, PV = 1024, PR = 2048, PCB = 3072, PCC = 4096, PCH = 5120;
constexpr int NWAVES = 8, NTHREADS = 512;
#ifndef WGM_IN
#define WGM_IN 4
#endif
#ifndef WGM_OUT
#define WGM_OUT 4
#endif
#ifndef WGM_WQ
#define WGM_WQ 4
#endif
#ifndef TAB4
#define TAB4 1
#endif
constexpr int NPHASES = 2 + 7 * NL;

constexpr size_t MiB = 1u << 20;
constexpr size_t WS_CTL = 0, CTL_ZERO_BYTES = 1 * MiB;
constexpr size_t WS_MOD = 1 * MiB, WS_PART = 3 * MiB, WS_KEYS = 15 * MiB, WS_DTOT = 17 * MiB, WS_WIN = 18 * MiB, WS_WOUT = 115 * MiB, WS_WQ = 147 * MiB;
constexpr size_t WS_UT = 179 * MiB, WS_VT = 435 * MiB, WS_H = 691 * MiB, WS_PROJ = 755 * MiB, WS_E = 947 * MiB, WS_OGLA = 979 * MiB, WS_Y = 1043 * MiB;
constexpr size_t WS_Z = 1107 * MiB, WS_X1 = 1235 * MiB, WS_X = 1363 * MiB, WS_Q = 1491 * MiB, WS_H2 = 1555 * MiB, WS_HQ8 = 1619 * MiB, WS_H8 = 1659 * MiB, WS_WIN8 = 1691 * MiB, WS_WOUT8 = 1739 * MiB, WS_WQ8 = 1755 * MiB, WS_Y8 = 1771 * MiB, WS_H28 = 1803 * MiB, WS_END = 1835 * MiB;
constexpr size_t WS_SU = 17 * MiB + 512 * 1024, WS_SV = 17 * MiB + 768 * 1024, WS_HSC = 2 * MiB + 640 * 1024;
static_assert(WS_WIN + (size_t)NL * INW * D * 2 <= WS_WOUT && WS_PART + (size_t)NL * 8 * NB * 6 * D * 4 <= WS_KEYS && WS_MOD + (size_t)NL * NB * 6 * D * 4 <= WS_PART, "ws map");
constexpr size_t WS_SAH = WS_SU, WS_SAY = WS_SU + 65536, WS_SB = WS_SV; constexpr int SBL = NP + 2 * D;
constexpr size_t WS_SBA = WS_SB + (size_t)NL * SBL * 4, WS_ALR8 = WS_SU + 131072;
#ifndef KROT_A
#define KROT_A 0
#endif
#ifndef KROT_B
#define KROT_B 0
#endif
#define KROT(c) (KROT_A * (((c) >> 3) & 3) + KROT_B * ((c) >> 5))
#ifndef RES16
#define RES16 1
#endif
#ifndef RES16_X
#define RES16_X RES16
#endif
#ifndef RES16_Z
#define RES16_Z RES16
#endif
#ifndef RES16_X1
#define RES16_X1 RES16
#endif
#ifndef I8_GATE
#define I8_GATE 1
#endif
#ifndef I8_WQ
#define I8_WQ 1
#endif
#ifndef I8_IN
#define I8_IN 1
#endif
#ifndef I8_OUT
#define I8_OUT 1
#endif
constexpr int CW_BAR = 4096;

constexpr int RING_OFF = 0, RING_BYTES = 131072, LDSCTL_OFF = RING_BYTES, LDS_BYTES = 147456;

#define GAS __attribute__((address_space(1)))
typedef unsigned short bf16;
typedef unsigned v4u __attribute__((ext_vector_type(4)));
typedef unsigned v2u __attribute__((ext_vector_type(2)));
typedef int v4i __attribute__((ext_vector_type(4)));
typedef float f32x4 __attribute__((ext_vector_type(4)));
typedef float f32x16 __attribute__((ext_vector_type(16)));
typedef short bf16x8 __attribute__((ext_vector_type(8)));
typedef __bf16 bf16x2v __attribute__((ext_vector_type(2)));
#define LDS_WAIT() asm volatile("s_waitcnt lgkmcnt(0)" ::: "memory")

__device__ __forceinline__ unsigned pk2(float lo, float hi) { return pg8::cvt_pk_bf16(lo, hi); }
__device__ __forceinline__ float dot2bf(unsigned w, unsigned x, float acc) { return __builtin_amdgcn_fdot2_f32_bf16(__builtin_bit_cast(bf16x2v, w), __builtin_bit_cast(bf16x2v, x), acc, false); }
__device__ __forceinline__ float bflo(unsigned u) { return __uint_as_float(u << 16); }
__device__ __forceinline__ float bfhi(unsigned u) { return __uint_as_float(u & 0xffff0000u); }
__device__ __forceinline__ float silu_f(float x) { return x / (1.0f + __expf(-x)); }
__device__ __forceinline__ float logsigmoid_f(float x) { return fminf(x, 0.0f) - log1pf(__expf(-fabsf(x))); }
__device__ __forceinline__ float logsigmoid_fast(float x) { return fminf(x, 0.0f) - __logf(1.0f + __expf(-fabsf(x))); }
__device__ __forceinline__ float gelu_tanh_f(float x) { const float u = 0.7978845608028654f * (x + 0.044715f * x * x * x); return 0.5f * x * (1.0f + tanhf(u)); }
__device__ __forceinline__ unsigned pack_i8(float a, float b, float c, float d) {
    const int q0 = (int)__builtin_rintf(a), q1 = (int)__builtin_rintf(b), q2 = (int)__builtin_rintf(c), q3 = (int)__builtin_rintf(d);
    return (unsigned)(q0 & 255) | ((unsigned)(q1 & 255) << 8) | ((unsigned)(q2 & 255) << 16) | ((unsigned)(q3 & 255) << 24); }
__device__ __forceinline__ float wave_sum(float v) {
#pragma unroll
    for (int o = 1; o < 64; o <<= 1) v += __shfl_xor(v, o);
    return v;
}

struct Args { const float* in[19]; float* out; unsigned char* ws; int ph_lo, ph_hi; };

__device__ __forceinline__ void transpose_item(const float* W, int ldw, int col0, bf16* WTrows, int k0, int nvalid, LAS float* scr, int lane) {
    const int n = lane & 31;
    float tv[32];
#pragma unroll
    for (int i = 0; i < 32; ++i) { const int kk = 2 * i + (lane >> 5); tv[i] = (n < nvalid) ? W[(size_t)(k0 + kk) * ldw + col0 + n] : 0.f; }
#pragma unroll
    for (int i = 0; i < 32; ++i) { const int kk = 2 * i + (lane >> 5); scr[kk * 33 + n] = tv[i]; }
    LDS_WAIT(); asm volatile("" ::: "memory");
    const int c = lane & 7;
#pragma unroll
    for (int j = 0; j < 4; ++j) { const int nn = (lane >> 3) + 8 * j; const LAS float* s = scr + (8 * c) * 33 + nn;
        v4u o; o.x = pk2(s[0 * 33], s[1 * 33]); o.y = pk2(s[2 * 33], s[3 * 33]); o.z = pk2(s[4 * 33], s[5 * 33]); o.w = pk2(s[6 * 33], s[7 * 33]);
        if (nn < nvalid) *(v4u*)(WTrows + (size_t)nn * D + k0 + 8 * c) = o; }
    LDS_WAIT(); asm volatile("" ::: "memory");
}
__device__ __forceinline__ void cvt_stream(const float* src, bf16* dst, size_t n4, size_t i0, size_t stride) {
    for (size_t i = i0; i < n4; i += stride) { const f32x4 v = ((const f32x4*)src)[i]; v2u o; o.x = pk2(v.x, v.y); o.y = pk2(v.z, v.w); ((v2u*)dst)[i] = o; }
}
__device__ __forceinline__ void ph_prologue_a(const Args& a, LAS unsigned char* lds, int tid, int lane, int wave, int bx, int G) {
    const int gw = bx * NWAVES + wave, NGW = G * NWAVES;
    LAS float* cact = (LAS float*)lds;
    for (int i = tid; i < NB * D; i += NTHREADS) { const int b = i / D, d = i % D; cact[d * 8 + b] = silu_f(a.in[1][i]); }
    __syncthreads();
    float* part = (float*)(a.ws + WS_PART);
    for (int it = gw; it < NL * 8 * 48; it += NGW) {
        const int cg = it % 48, dr = (it / 48) % 8, l = it / 384;
        f32x4 acc[8];
#pragma unroll
        for (int b = 0; b < 8; ++b) acc[b] = (f32x4){0.f, 0.f, 0.f, 0.f};
        const float* w = a.in[2] + ((size_t)l * D + dr * 256) * (6 * D) + cg * 256 + lane * 4;
#pragma unroll 4
        for (int d = 0; d < 256; ++d) {
            const f32x4 wv = *(const f32x4*)(w + (size_t)d * (6 * D));
            const f32x4 c0 = *(const LAS f32x4*)(cact + (dr * 256 + d) * 8), c1 = *(const LAS f32x4*)(cact + (dr * 256 + d) * 8 + 4);
            acc[0] += wv * c0.x; acc[1] += wv * c0.y; acc[2] += wv * c0.z; acc[3] += wv * c0.w;
            acc[4] += wv * c1.x; acc[5] += wv * c1.y; acc[6] += wv * c1.z; acc[7] += wv * c1.w;
        }
#pragma unroll
        for (int b = 0; b < 8; ++b) *(f32x4*)(part + (((size_t)l * 8 + dr) * NB + b) * (6 * D) + cg * 256 + lane * 4) = acc[b];
    }
    __syncthreads();
    LAS float* scr = (LAS float*)(lds + wave * 8448);
    bf16* winT = (bf16*)(a.ws + WS_WIN); bf16* woutT = (bf16*)(a.ws + WS_WOUT); bf16* wqT = (bf16*)(a.ws + WS_WQ);
    constexpr int IPL = 6144 + 32 + 2048 + 2048;
    for (int it = gw; it < NL * IPL; it += NGW) {
        const int l = it / IPL; int r = it % IPL;
        if (r < 6144) { const int nb = r % 192, kb = r / 192, n0 = nb * 32;
            transpose_item(a.in[4] + (size_t)l * D * INW, INW, n0 < 3072 ? n0 : n0 + 16, winT + ((size_t)l * INW + n0) * D, kb * 64, 32, scr, lane); continue; }
        r -= 6144;
        if (r < 32) { transpose_item(a.in[4] + (size_t)l * D * INW, INW, 3072, winT + ((size_t)l * INW + NP) * D, r * 64, 16, scr, lane); continue; }
        r -= 32;
        if (r < 2048) { const int nb = r % 64, kb = r / 64; transpose_item(a.in[10] + (size_t)l * D * D, D, nb * 32, woutT + ((size_t)l * D + nb * 32) * D, kb * 64, 32, scr, lane); continue; }
        r -= 2048;
        { const int nb = r % 64, kb = r / 64; transpose_item(a.in[13] + (size_t)l * D * D, D, nb * 32, wqT + ((size_t)l * D + nb * 32) * D, kb * 64, 32, scr, lane); }
    }
    const size_t i0 = (size_t)bx * NTHREADS + tid, stride = (size_t)G * NTHREADS;
    cvt_stream(a.in[14], (bf16*)(a.ws + WS_KEYS), (size_t)NL * 8 * 2 * 128 * 128 / 4, i0, stride);
#if TAB4
    __syncthreads();
    { LAS float* rowst = (LAS float*)(lds + wave * 8192);
      f32x4 vnx[8];
      if (gw < 2 * NL * NE) { const int tbl0 = gw / (NL * NE), r0 = gw % (NL * NE); const float* s0 = (tbl0 ? a.in[16] : a.in[15]) + (size_t)r0 * D;
#pragma unroll
          for (int c8 = 0; c8 < 8; ++c8) vnx[c8] = *(const f32x4*)(s0 + (c8 * 64 + lane) * 4); }
      for (int row = gw; row < 2 * NL * NE; row += NGW) {
        const int tbl = row / (NL * NE), r = row % (NL * NE);
#pragma unroll
        for (int c8 = 0; c8 < 8; ++c8) *(LAS f32x4*)(rowst + (c8 * 64 + lane) * 4) = vnx[c8];
        { const int rown = row + NGW < 2 * NL * NE ? row + NGW : row; const int tbln = rown / (NL * NE), rn = rown % (NL * NE); const float* sn = (tbln ? a.in[16] : a.in[15]) + (size_t)rn * D;
#pragma unroll
          for (int c8 = 0; c8 < 8; ++c8) vnx[c8] = *(const f32x4*)(sn + (c8 * 64 + lane) * 4); }
        LDS_WAIT(); asm volatile("" ::: "memory");
        unsigned char* tb = a.ws + (tbl ? WS_VT : WS_UT) + (size_t)r * 1152;
#pragma unroll
        for (int pass = 0; pass < 2; ++pass) { const int slot = lane + 64 * pass;
            if (slot < 72) { const int col0 = (slot >> 3) * 240 + (slot & 7) * 30;
                float x[30]; float mx = 0.f;
#pragma unroll
                for (int k = 0; k < 30; ++k) { x[k] = (col0 + k < D) ? rowst[col0 + k] : 0.f; mx = fmaxf(mx, fabsf(x[k])); }
                int code = 0; float inv = 0.f;
                if (mx > 0.f) { code = (int)ceilf(8.0f * log2f(mx * (1.0f / 7.0f))) + 128; code = code < 0 ? 0 : (code > 255 ? 255 : code); inv = __builtin_amdgcn_exp2f(16.0f - (float)code * 0.125f); }
                unsigned dw[4] = {0u, 0u, 0u, 0u};
#pragma unroll
                for (int kb = 0; kb < 15; ++kb) { int a0 = (int)__builtin_rintf(x[2 * kb] * inv), a1 = (int)__builtin_rintf(x[2 * kb + 1] * inv);
                    a0 = a0 < -7 ? -7 : (a0 > 7 ? 7 : a0); a1 = a1 < -7 ? -7 : (a1 > 7 ? 7 : a1);
                    dw[kb >> 2] |= ((unsigned)(a0 + 8) | ((unsigned)(a1 + 8) << 4)) << (8 * (kb & 3)); }
                dw[3] |= (unsigned)code << 24;
                *(v4u*)(tb + slot * 16) = (v4u){dw[0], dw[1], dw[2], dw[3]}; } }
        LDS_WAIT(); asm volatile("" ::: "memory");
      } }
#else
    for (int row = gw; row < 2 * NL * NE; row += NGW) {
        const int tbl = row / (NL * NE), r = row % (NL * NE);
        const float* src = (tbl ? a.in[16] : a.in[15]) + (size_t)r * D;
        f32x4 v[8]; float mx = 0.f;
#pragma unroll
        for (int c8 = 0; c8 < 8; ++c8) { v[c8] = *(const f32x4*)(src + (c8 * 64 + lane) * 4); mx = fmaxf(mx, fmaxf(fmaxf(fabsf(v[c8].x), fabsf(v[c8].y)), fmaxf(fabsf(v[c8].z), fabsf(v[c8].w)))); }
#pragma unroll
        for (int o = 1; o < 64; o <<= 1) mx = fmaxf(mx, __shfl_xor(mx, o));
        const float inv = mx > 0.f ? 127.0f / mx : 0.f; const int off = tbl ? 128 : 0;
        unsigned dw[8];
#pragma unroll
        for (int c8 = 0; c8 < 8; ++c8) { const int q0 = (int)__builtin_rintf(v[c8].x * inv) + off, q1 = (int)__builtin_rintf(v[c8].y * inv) + off, q2 = (int)__builtin_rintf(v[c8].z * inv) + off, q3 = (int)__builtin_rintf(v[c8].w * inv) + off;
            dw[c8] = (unsigned)(q0 & 255) | ((unsigned)(q1 & 255) << 8) | ((unsigned)(q2 & 255) << 16) | ((unsigned)(q3 & 255) << 24); }
        unsigned char* dst = a.ws + (tbl ? WS_VT : WS_UT) + (size_t)r * D;
        *(v4u*)(dst + lane * 16) = (v4u){dw[0], dw[1], dw[2], dw[3]}; *(v4u*)(dst + (64 + lane) * 16) = (v4u){dw[4], dw[5], dw[6], dw[7]};
        if (lane == 0) ((float*)(a.ws + (tbl ? WS_SV : WS_SU)))[r] = mx * (1.0f / 127.0f);
    }
#endif
}

__device__ __forceinline__ void ln_tail(const float (&z)[32], int t, int lane, const float* g, const float* bta, float* xout, const float* sh, const float* sc, bf16* hout, unsigned char* q8, float* q8s, LAS unsigned char* q8stage = nullptr, unsigned char* a8 = nullptr, float* a8s = nullptr, bf16* xb = nullptr) {
    float s = 0.f;
#pragma unroll
    for (int i = 0; i < 32; ++i) s += z[i];
    const float mu = wave_sum(s) * (1.0f / D);
    float q = 0.f;
#pragma unroll
    for (int i = 0; i < 32; ++i) { const float d = z[i] - mu; q += d * d; }
    const float rs = rsqrtf(wave_sum(q) * (1.0f / D) + EPS);
    float hv[32]; float mx = 0.f;
#pragma unroll
    for (int c = 0; c < 8; ++c) { const int col = (c * 64 + lane) * 4;
        const f32x4 g0 = *(const f32x4*)(g + col), b0 = *(const f32x4*)(bta + col);
        f32x4 x0;
        x0.x = (z[c * 4 + 0] - mu) * rs * g0.x + b0.x; x0.y = (z[c * 4 + 1] - mu) * rs * g0.y + b0.y; x0.z = (z[c * 4 + 2] - mu) * rs * g0.z + b0.z; x0.w = (z[c * 4 + 3] - mu) * rs * g0.w + b0.w;
        if (xb) { v2u o; o.x = pk2(x0.x, x0.y); o.y = pk2(x0.z, x0.w); *(v2u*)(xb + (size_t)t * D + col) = o; }
        else if (xout) *(f32x4*)(xout + (size_t)t * D + col) = x0;
        if (hout || q8 || a8) { const f32x4 s0 = *(const f32x4*)(sc + col), h0 = *(const f32x4*)(sh + col);
            hv[c * 4] = x0.x * (1.f + s0.x) + h0.x; hv[c * 4 + 1] = x0.y * (1.f + s0.y) + h0.y; hv[c * 4 + 2] = x0.z * (1.f + s0.z) + h0.z; hv[c * 4 + 3] = x0.w * (1.f + s0.w) + h0.w;
            if (hout) { v2u o; o.x = pk2(hv[c * 4], hv[c * 4 + 1]); o.y = pk2(hv[c * 4 + 2], hv[c * 4 + 3]);
                *(v2u*)(hout + (size_t)t * D + col) = o; }
            if (q8 || a8) mx = fmaxf(mx, fmaxf(fmaxf(fabsf(hv[c * 4]), fabsf(hv[c * 4 + 1])), fmaxf(fabsf(hv[c * 4 + 2]), fabsf(hv[c * 4 + 3])))); }
    }
    if (q8 || a8) {
#pragma unroll
        for (int o = 1; o < 64; o <<= 1) mx = fmaxf(mx, __shfl_xor(mx, o));
        const float qmax_ = (q8 && TAB4) ? 119.0f : 127.0f;
        const float inv = mx > 0.f ? qmax_ / mx : 0.f;
        unsigned dw[8];
#pragma unroll
        for (int c = 0; c < 8; ++c) { const int q0 = (int)__builtin_rintf(hv[c * 4] * inv), q1 = (int)__builtin_rintf(hv[c * 4 + 1] * inv), q2 = (int)__builtin_rintf(hv[c * 4 + 2] * inv), q3 = (int)__builtin_rintf(hv[c * 4 + 3] * inv);
            dw[c] = (unsigned)(q0 & 255) | ((unsigned)(q1 & 255) << 8) | ((unsigned)(q2 & 255) << 16) | ((unsigned)(q3 & 255) << 24); }
        if (a8) {
#pragma unroll
            for (int c = 0; c < 8; ++c) *(unsigned*)(a8 + (size_t)t * D + (c * 64 + lane) * 4) = dw[c];
            if (a8s && lane == 0) a8s[t] = mx / qmax_; }
        if (q8) {
#if TAB4
        { LAS unsigned* st32 = (LAS unsigned*)q8stage; LAS unsigned char* st8 = (LAS unsigned char*)q8stage;
#pragma unroll
          for (int i = 0; i < 9; ++i) st32[lane + 64 * i] = 0u;
          LDS_WAIT(); asm volatile("" ::: "memory");
#pragma unroll
          for (int c = 0; c < 8; ++c)
#pragma unroll
              for (int jp = 0; jp < 2; ++jp) { const int col = (c * 64 + lane) * 4 + 2 * jp, u = col / 240, r = col - u * 240, l7 = r / 30, k = r - l7 * 30;
                  const int q0 = (int)(signed char)((dw[c] >> (16 * jp)) & 255u), q1 = (int)(signed char)((dw[c] >> (16 * jp + 8)) & 255u);
                  const int l0 = ((q0 + 8) & 15) - 8, l1 = ((q1 + 8) & 15) - 8, h0 = (q0 - l0) >> 4, h1 = (q1 - l1) >> 4;
                  LAS unsigned char* sp = st8 + (u * 8 + l7) * 32 + (k >> 1);
                  sp[0] = (unsigned char)((l0 & 15) | ((l1 & 15) << 4)); sp[16] = (unsigned char)((h0 & 15) | ((h1 & 15) << 4)); }
          LDS_WAIT(); asm volatile("" ::: "memory");
          unsigned* d32 = (unsigned*)(q8 + (size_t)t * 2304);
#pragma unroll
          for (int i = 0; i < 9; ++i) d32[lane + 64 * i] = st32[lane + 64 * i];
          LDS_WAIT(); asm volatile("" ::: "memory"); }
#else
        unsigned char* dst = q8 + (size_t)t * D;
        *(v4u*)(dst + lane * 16) = (v4u){dw[0], dw[1], dw[2], dw[3]}; *(v4u*)(dst + (64 + lane) * 16) = (v4u){dw[4], dw[5], dw[6], dw[7]};
#endif
        if (lane == 0) q8s[t] = mx / qmax_; }
    }
}

__device__ __forceinline__ void ph_prologue_b(const Args& a, LAS unsigned char* lds, int tid, int lane, int wave, int bx, int G) {
    const float* part = (const float*)(a.ws + WS_PART); float* mod = (float*)(a.ws + WS_MOD);
    for (int i = bx * NTHREADS + tid; i < NL * NB * 6 * D / 4; i += G * NTHREADS) {
        const int idx = i * 4, e = idx % (6 * D), b = (idx / (6 * D)) % NB, l = idx / (6 * D * NB);
        f32x4 s = *(const f32x4*)(a.in[3] + l * 6 * D + e);
#pragma unroll
        for (int dr = 0; dr < 8; ++dr) s += *(const f32x4*)(part + (((size_t)l * 8 + dr) * NB + b) * (6 * D) + e);
        *(f32x4*)(mod + idx) = s;
    }
    LAS float* msh = (LAS float*)lds;
    bf16* hbuf = (bf16*)(a.ws + WS_H);
    for (int ch = bx; ch < NCHUNK; ch += G) {
        const int b = ch / NCH;
        for (int i = tid; i < 1024; i += NTHREADS) { const int e = i * 4;
            f32x4 s = *(const f32x4*)(a.in[3] + e);
#pragma unroll
            for (int dr = 0; dr < 8; ++dr) s += *(const f32x4*)(part + (((size_t)0 * 8 + dr) * NB + b) * (6 * D) + e);
            *(LAS f32x4*)(msh + e) = s; }
        __syncthreads();
        for (int i = 0; i < 8; ++i) { const int t = ch * 64 + wave * 8 + i;
            float hv[32]; float mx = 0.f;
#pragma unroll
            for (int c = 0; c < 4; ++c) { const int col = (c * 64 + lane) * 8;
                const f32x4 x0 = *(const f32x4*)(a.in[0] + (size_t)t * D + col), x1 = *(const f32x4*)(a.in[0] + (size_t)t * D + col + 4);
                const f32x4 h0 = *(const LAS f32x4*)(msh + col), h1 = *(const LAS f32x4*)(msh + col + 4), s0 = *(const LAS f32x4*)(msh + 2048 + col), s1 = *(const LAS f32x4*)(msh + 2048 + col + 4);
#pragma unroll
                for (int j = 0; j < 4; ++j) { hv[c * 8 + j] = x0[j] * (1.f + s0[j]) + h0[j]; hv[c * 8 + 4 + j] = x1[j] * (1.f + s1[j]) + h1[j]; }
                v4u o; o.x = pk2(hv[c * 8], hv[c * 8 + 1]); o.y = pk2(hv[c * 8 + 2], hv[c * 8 + 3]); o.z = pk2(hv[c * 8 + 4], hv[c * 8 + 5]); o.w = pk2(hv[c * 8 + 6], hv[c * 8 + 7]);
#if !I8_GATE
                *(v4u*)(hbuf + (size_t)t * D + col) = o;
#endif
#if RES16_X
                { v4u xo; xo.x = pk2(x0.x, x0.y); xo.y = pk2(x0.z, x0.w); xo.z = pk2(x1.x, x1.y); xo.w = pk2(x1.z, x1.w); *(v4u*)((bf16*)(a.ws + WS_X) + (size_t)t * D + col) = xo; }
#endif
#pragma unroll
                for (int j = 0; j < 8; ++j) mx = fmaxf(mx, fabsf(hv[c * 8 + j])); }
#pragma unroll
            for (int o = 1; o < 64; o <<= 1) mx = fmaxf(mx, __shfl_xor(mx, o));
            const float inv = mx > 0.f ? 127.0f / mx : 0.f;
#pragma unroll
            for (int c = 0; c < 4; ++c) { v2u o;
                o.x = pack_i8(hv[c * 8] * inv, hv[c * 8 + 1] * inv, hv[c * 8 + 2] * inv, hv[c * 8 + 3] * inv); o.y = pack_i8(hv[c * 8 + 4] * inv, hv[c * 8 + 5] * inv, hv[c * 8 + 6] * inv, hv[c * 8 + 7] * inv);
                *(v2u*)(a.ws + WS_H8 + (size_t)t * D + (c * 64 + lane) * 8) = o; }
            if (lane == 0) ((float*)(a.ws + WS_SAH))[t] = mx * (1.0f / 127.0f); }
        __syncthreads();
    }
    { const int gw = bx * NWAVES + wave, NGW = G * NWAVES;
      for (int row = gw; row < NL * (SBL + 16); row += NGW) { const int l = row / (SBL + 16), r = row % (SBL + 16);
          const bf16* src; unsigned char* dst; float* sdst;
          if (r < NP) { src = (const bf16*)(a.ws + WS_WIN) + ((size_t)l * INW + r) * D; dst = a.ws + WS_WIN8 + ((size_t)l * NP + r) * D; sdst = (float*)(a.ws + WS_SB) + l * SBL + r; }
          else if (r < NP + D) { src = (const bf16*)(a.ws + WS_WOUT) + ((size_t)l * D + (r - NP)) * D; dst = a.ws + WS_WOUT8 + ((size_t)l * D + (r - NP)) * D; sdst = (float*)(a.ws + WS_SB) + l * SBL + r; }
          else if (r < SBL) { src = (const bf16*)(a.ws + WS_WQ) + ((size_t)l * D + (r - NP - D)) * D; dst = a.ws + WS_WQ8 + ((size_t)l * D + (r - NP - D)) * D; sdst = (float*)(a.ws + WS_SB) + l * SBL + r; }
          else { src = (const bf16*)(a.ws + WS_WIN) + ((size_t)l * INW + NP + (r - SBL)) * D; dst = a.ws + WS_ALR8 + ((size_t)l * 16 + (r - SBL)) * D; sdst = (float*)(a.ws + WS_SBA) + l * 16 + (r - SBL); }
          v4u w[4]; float mx = 0.f;
#pragma unroll
          for (int c = 0; c < 4; ++c) w[c] = *(const v4u*)(src + (c * 64 + lane) * 8);
#pragma unroll
          for (int c = 0; c < 4; ++c)
#pragma unroll
              for (int j = 0; j < 4; ++j) mx = fmaxf(mx, fmaxf(fabsf(bflo(w[c][j])), fabsf(bfhi(w[c][j]))));
#pragma unroll
          for (int o = 1; o < 64; o <<= 1) mx = fmaxf(mx, __shfl_xor(mx, o));
          const float inv = mx > 0.f ? 127.0f / mx : 0.f;
#pragma unroll
          for (int c = 0; c < 4; ++c) { v2u o;
              o.x = pack_i8(bflo(w[c][0]) * inv, bfhi(w[c][0]) * inv, bflo(w[c][1]) * inv, bfhi(w[c][1]) * inv); o.y = pack_i8(bflo(w[c][2]) * inv, bfhi(w[c][2]) * inv, bflo(w[c][3]) * inv, bfhi(w[c][3]) * inv);
              *(v2u*)(dst + (c * 64 + lane) * 8) = o; }
          if (lane == 0) *sdst = mx * (1.0f / 127.0f); } }
}

__device__ __forceinline__ void gate_prep(const Args& a, int l, LAS unsigned char* lds, int tid, int lane, int wave, int ch) {
    const bf16* hbuf = (const bf16*)(a.ws + WS_H); const bf16* waT = (const bf16*)(a.ws + WS_WIN) + ((size_t)l * INW + NP) * D;
    bf16* Ebuf = (bf16*)(a.ws + WS_E); float* dtot = (float*)(a.ws + WS_DTOT);
    const int t0 = ch * 64, l15 = lane & 15, lq = lane >> 4, mt = wave & 3, kh = wave >> 2;
    LAS float* alr = (LAS float*)(lds + LDSCTL_OFF + 1024);
#if I8_GATE
    { v4i acc = (v4i){0, 0, 0, 0};
      const unsigned char* hA = a.ws + WS_H8 + (size_t)(t0 + 16 * mt + l15) * D + kh * 1024 + 16 * lq;
      const unsigned char* wB = a.ws + WS_ALR8 + ((size_t)l * 16 + l15) * D + kh * 1024 + 16 * lq;
#pragma unroll 8
      for (int ks = 0; ks < 16; ++ks) { const v4i av = *(const v4i*)(hA + 64 * ks), bv = *(const v4i*)(wB + 64 * ks); acc = __builtin_amdgcn_mfma_i32_16x16x64_i8(av, bv, acc, 0, 0, 0); }
      const float sw = ((const float*)(a.ws + WS_SBA))[l * 16 + l15];
#pragma unroll
      for (int r = 0; r < 4; ++r) { const int tl = 16 * mt + 4 * lq + r; alr[(kh * 64 + tl) * 16 + l15] = (float)acc[r] * (sw * ((const float*)(a.ws + WS_SAH))[t0 + tl]); } }
#else
    f32x4 acc = (f32x4){0.f, 0.f, 0.f, 0.f};
    const bf16* hA = hbuf + (size_t)(t0 + 16 * mt + l15) * D + kh * 1024 + 8 * lq;
    const bf16* wB = waT + (size_t)l15 * D + kh * 1024 + 8 * lq;
#pragma unroll 8
    for (int ks = 0; ks < 32; ++ks) { const bf16x8 av = *(const bf16x8*)(hA + 32 * ks), bv = *(const bf16x8*)(wB + 32 * ks); acc = __builtin_amdgcn_mfma_f32_16x16x32_bf16(av, bv, acc, 0, 0, 0); }
#pragma unroll
    for (int r = 0; r < 4; ++r) alr[(kh * 64 + 16 * mt + 4 * lq + r) * 16 + l15] = acc[r];
#endif
    __syncthreads();
    const int col = tid;
    float wg[16];
#pragma unroll
    for (int r = 0; r < 16; ++r) wg[r] = a.in[5][((size_t)l * RANK + r) * GKW + col];
    const float bgc = a.in[6][l * GKW + col];
    for (int i = tid; i < 256; i += NTHREADS) *(LAS f32x4*)(alr + i * 4) = *(const LAS f32x4*)(alr + i * 4) + *(const LAS f32x4*)(alr + 1024 + i * 4);
    __syncthreads();
    float tot = 0.f;
    LAS float* lac = (LAS float*)lds;
    for (int j = 0; j < 64; ++j) { float lg0 = bgc, lg1 = 0.f;
#pragma unroll
        for (int r4 = 0; r4 < 4; ++r4) { const f32x4 p = *(const LAS f32x4*)(alr + j * 16 + r4 * 4);
            lg0 += p.x * wg[r4 * 4] + p.z * wg[r4 * 4 + 2]; lg1 += p.y * wg[r4 * 4 + 1] + p.w * wg[r4 * 4 + 3]; }
        const float la = logsigmoid_fast(lg0 + lg1) * (1.0f / 16.0f); lac[j * GKW + col] = la; tot += la; }
    float run = 0.f;
    for (int j = 0; j < 64; ++j) { run += lac[j * GKW + col]; lac[j * GKW + col] = __expf(tot - run); }
    __syncthreads();
    for (int i = 0; i < 8; ++i) { const int j = wave * 8 + i;
        const f32x4 e0 = *(const LAS f32x4*)(lac + j * GKW + lane * 8), e1 = *(const LAS f32x4*)(lac + j * GKW + lane * 8 + 4);
        v4u o; o.x = pk2(e0.x, e0.y); o.y = pk2(e0.z, e0.w); o.z = pk2(e1.x, e1.y); o.w = pk2(e1.z, e1.w);
        *(v4u*)(Ebuf + (size_t)(t0 + j) * GKW + lane * 8) = o; }
    dtot[(size_t)ch * GKW + col] = __expf(tot);
    __syncthreads();
}

__device__ __forceinline__ void gla_unit(const Args& a, LAS unsigned char* lds, int tid, int lane, int wave, int un) {
    const bf16* proj = (const bf16*)(a.ws + WS_PROJ); const bf16* Ebuf = (const bf16*)(a.ws + WS_E); const float* dtot = (const float*)(a.ws + WS_DTOT); bf16* ogla = (bf16*)(a.ws + WS_OGLA);
    const int pair_ = (un & 7) * 4 + (un >> 6), dvs = (un >> 3) & 7, hh = pair_ & 3, b = pair_ >> 2;
    LAS bf16* kdT0 = (LAS bf16*)lds; LAS bf16* vT0 = (LAS bf16*)(lds + 18432); LAS bf16* ST0 = (LAS bf16*)(lds + 18432 + 4608);
    LAS bf16* kdT1 = (LAS bf16*)(lds + 32768); LAS bf16* vT1 = (LAS bf16*)(lds + 32768 + 18432); LAS bf16* ST1 = (LAS bf16*)(lds + 32768 + 18432 + 4608);
    const int l15 = lane & 15, lq = lane >> 4, jl = tid >> 3, dv4 = (tid & 7) * 4, jt = (wave & 3) * 16, dvt = (wave >> 2) * 16, jp = tid >> 4, c16 = tid & 15;
#define GLA_BAR() do { asm volatile("s_waitcnt lgkmcnt(0)" ::: "memory"); __builtin_amdgcn_s_barrier(); asm volatile("" ::: "memory"); } while (0)
    f32x4 S0 = (f32x4){0.f, 0.f, 0.f, 0.f}, S1 = (f32x4){0.f, 0.f, 0.f, 0.f};
    v4u kn0[2], kn1[2], kn2[2], en0[2], en1[2], en2[2]; v2u vn0, vn1, vn2; bf16x8 qn0[4], qn1[4], qn2[4], qc[4]; f32x4 dn0, dn1, dn2, dc;
#define GLA_LOAD(c, kn, en, vn, qn, dn) do { const int t0c = b * SEQ + (c) * 64; const bf16* pr = proj + (size_t)(t0c + jl) * NP; \
          \
        kn[0] = *(const v4u*)(proj + (size_t)(t0c + 2 * jp) * NP + PK + hh * 128 + 8 * c16); kn[1] = *(const v4u*)(proj + (size_t)(t0c + 2 * jp + 1) * NP + PK + hh * 128 + 8 * c16); \
        en[0] = *(const v4u*)(Ebuf + (size_t)(t0c + 2 * jp) * GKW + hh * 128 + 8 * c16); en[1] = *(const v4u*)(Ebuf + (size_t)(t0c + 2 * jp + 1) * GKW + hh * 128 + 8 * c16); \
        vn = *(const v2u*)(pr + PV + hh * 256 + dvs * 32 + dv4); \
        _Pragma("unroll") for (int ks_ = 0; ks_ < 4; ++ks_) qn[ks_] = *(const bf16x8*)(proj + (size_t)(t0c + jt + l15) * NP + PQ + hh * 128 + 32 * ks_ + 8 * lq); \
        dn = *(const f32x4*)(dtot + (size_t)(b * NCH + (c)) * GKW + hh * 128 + 16 * wave + 4 * lq); } while (0)
#define GLA_PREPL(kn, en, vn, kdT, vT) do { \
        _Pragma("unroll") for (int i_ = 0; i_ < 8; ++i_) { const unsigned wa_ = kn[0][i_ >> 1], wb_ = kn[1][i_ >> 1], ea_ = en[0][i_ >> 1], eb_ = en[1][i_ >> 1]; \
            const float pa_ = ((i_ & 1) ? bfhi(wa_) : bflo(wa_)) * ((i_ & 1) ? bfhi(ea_) : bflo(ea_)), pb_ = ((i_ & 1) ? bfhi(wb_) : bflo(wb_)) * ((i_ & 1) ? bfhi(eb_) : bflo(eb_)); \
            *(LAS unsigned*)(kdT + (8 * c16 + i_) * 72 + ((((jp >> 2) ^ c16) & 7) << 3) + ((2 * jp) & 7)) = pk2(pa_, pb_); }     \
        _Pragma("unroll") for (int i_ = 0; i_ < 4; ++i_) { const unsigned w_ = vn[i_ >> 1]; vT[(dv4 + i_) * 72 + jl] = (bf16)((i_ & 1) ? (w_ >> 16) : (w_ & 0xffffu)); } } while (0)
#define GLA_QD(qn, dn) do { _Pragma("unroll") for (int ks_ = 0; ks_ < 4; ++ks_) qc[ks_] = qn[ks_]; dc = dn; } while (0)
#define GLA_BODYA(kdT, vT, ST) do { \
        S0 = S0 * dc; S1 = S1 * dc; \
        _Pragma("unroll") for (int ks = 0; ks < 2; ++ks) { \
            const bf16x8 A_ = *(const LAS bf16x8*)(kdT + (16 * wave + l15) * 72 + ((((4 * ks + lq) ^ (2 * wave + (l15 >> 3))) & 7) << 3)); \
            const bf16x8 B0_ = *(const LAS bf16x8*)(vT + l15 * 72 + 32 * ks + 8 * lq), B1_ = *(const LAS bf16x8*)(vT + (16 + l15) * 72 + 32 * ks + 8 * lq); \
            S0 = __builtin_amdgcn_mfma_f32_16x16x32_bf16(A_, B0_, S0, 0, 0, 0); S1 = __builtin_amdgcn_mfma_f32_16x16x32_bf16(A_, B1_, S1, 0, 0, 0); } \
        { v2u w0_, w1_; w0_.x = pk2(S0.x, S0.y); w0_.y = pk2(S0.z, S0.w); w1_.x = pk2(S1.x, S1.y); w1_.y = pk2(S1.z, S1.w); \
          *(LAS v2u*)(ST + l15 * 136 + 16 * wave + 4 * lq) = w0_; *(LAS v2u*)(ST + (16 + l15) * 136 + 16 * wave + 4 * lq) = w1_; } } while (0)
#define GLA_BODYB(c, ST) do { \
        f32x4 O_ = (f32x4){0.f, 0.f, 0.f, 0.f}; \
        _Pragma("unroll") for (int ks = 0; ks < 4; ++ks) { const bf16x8 A_ = *(const LAS bf16x8*)(ST + (dvt + l15) * 136 + 32 * ks + 8 * lq); O_ = __builtin_amdgcn_mfma_f32_16x16x32_bf16(A_, qc[ks], O_, 0, 0, 0); } \
        { const f32x4 Os_ = O_ * 0.08838834764831845f; v2u ob_; ob_.x = pk2(Os_.x, Os_.y); ob_.y = pk2(Os_.z, Os_.w); \
          *(v2u*)(ogla + (size_t)(b * SEQ + (c) * 64 + jt + l15) * 1024 + hh * 256 + dvs * 32 + dvt + 4 * lq) = ob_; } } while (0)
#define GLA_STEP(c, RA, RB, LA, LB) do { { const int cn_ = (c) + 3 < NCH ? (c) + 3 : NCH - 1; GLA_LOAD(cn_, kn##RA, en##RA, vn##RA, qn##RA, dn##RA); } \
        GLA_BODYA(kdT##LA, vT##LA, ST##LA); GLA_PREPL(kn##RB, en##RB, vn##RB, kdT##LB, vT##LB); GLA_BAR(); GLA_BODYB(c, ST##LA); GLA_QD(qn##RB, dn##RB); } while (0)
    GLA_LOAD(0, kn0, en0, vn0, qn0, dn0); GLA_LOAD(1, kn1, en1, vn1, qn1, dn1); GLA_LOAD(2, kn2, en2, vn2, qn2, dn2);
    GLA_PREPL(kn0, en0, vn0, kdT0, vT0); GLA_QD(qn0, dn0);
    GLA_BAR();
    static_assert(NCH == 32, "the step schedule below is written for 32 chunks: 5 x 6 + 2");
    for (int c = 0; c < 30; c += 6) {
        GLA_STEP(c, 0, 1, 0, 1); GLA_STEP(c + 1, 1, 2, 1, 0); GLA_STEP(c + 2, 2, 0, 0, 1); GLA_STEP(c + 3, 0, 1, 1, 0); GLA_STEP(c + 4, 1, 2, 0, 1); GLA_STEP(c + 5, 2, 0, 1, 0);
    }
    GLA_STEP(30, 0, 1, 0, 1); GLA_STEP(31, 1, 2, 1, 0);
#undef GLA_STEP
#undef GLA_PREPL
#undef GLA_QD
#undef GLA_BODYA
#undef GLA_BODYB
#undef GLA_BAR
#undef GLA_LOAD
}

__device__ __forceinline__ void unpack16(const v4u& p0, const v4u& p1, float (&o)[16]) {
#pragma unroll
    for (int j = 0; j < 4; ++j) { o[2 * j] = bflo(p0[j]); o[2 * j + 1] = bfhi(p0[j]); o[8 + 2 * j] = bflo(p1[j]); o[8 + 2 * j + 1] = bfhi(p1[j]); }
}
__device__ __forceinline__ void mixpost_chunk(const Args& a, int l, int lane, int wave, int ch) {
    const bf16* proj = (const bf16*)(a.ws + WS_PROJ); const bf16* ogla = (const bf16*)(a.ws + WS_OGLA);
    const int c0 = 16 * lane, tfirst = ch * 64 + wave * 8, sfirst = tfirst % SEQ;
    float gn[16], cw0[16], cw1[16], cw2[16], cn[16], u1[16], u2[16];
#pragma unroll
    for (int i = 0; i < 16; ++i) { gn[i] = a.in[7][l * 256 + ((c0 + i) & 255)]; cw0[i] = a.in[8][(size_t)l * 3072 + c0 + i]; cw1[i] = a.in[8][(size_t)l * 3072 + 1024 + c0 + i];
        cw2[i] = a.in[8][(size_t)l * 3072 + 2048 + c0 + i]; cn[i] = a.in[9][l * 1024 + c0 + i]; u1[i] = 0.f; u2[i] = 0.f; }
    if (sfirst >= 2) {
        float cc[16], chh[16];
        { const bf16* pr = proj + (size_t)(tfirst - 2) * NP; unpack16(*(const v4u*)(pr + PCC + c0), *(const v4u*)(pr + PCC + c0 + 8), cc); unpack16(*(const v4u*)(pr + PCH + c0), *(const v4u*)(pr + PCH + c0 + 8), chh); }
#pragma unroll
        for (int i = 0; i < 16; ++i) u2[i] = cc[i] * chh[i];
        { const bf16* pr = proj + (size_t)(tfirst - 1) * NP; unpack16(*(const v4u*)(pr + PCC + c0), *(const v4u*)(pr + PCC + c0 + 8), cc); unpack16(*(const v4u*)(pr + PCH + c0), *(const v4u*)(pr + PCH + c0 + 8), chh); }
#pragma unroll
        for (int i = 0; i < 16; ++i) u1[i] = cc[i] * chh[i];
    }
#pragma unroll 2
    for (int it = 0; it < 8; ++it) { const int t = tfirst + it; const bf16* pr = proj + (size_t)t * NP;
        float o[16], r[16], cb[16], cc[16], chh[16];
        unpack16(*(const v4u*)(ogla + (size_t)t * 1024 + c0), *(const v4u*)(ogla + (size_t)t * 1024 + c0 + 8), o);
        unpack16(*(const v4u*)(pr + PR + c0), *(const v4u*)(pr + PR + c0 + 8), r);
        unpack16(*(const v4u*)(pr + PCB + c0), *(const v4u*)(pr + PCB + c0 + 8), cb);
        unpack16(*(const v4u*)(pr + PCC + c0), *(const v4u*)(pr + PCC + c0 + 8), cc);
        unpack16(*(const v4u*)(pr + PCH + c0), *(const v4u*)(pr + PCH + c0 + 8), chh);
        float ss = 0.f;
#pragma unroll
        for (int i = 0; i < 16; ++i) ss += o[i] * o[i];
        ss += __shfl_xor(ss, 1); ss += __shfl_xor(ss, 2); ss += __shfl_xor(ss, 4); ss += __shfl_xor(ss, 8);
        const float rg = rsqrtf(ss * (1.0f / 256.f) + EPS);
        float val[16]; float s2 = 0.f;
#pragma unroll
        for (int i = 0; i < 16; ++i) { const float u0 = cc[i] * chh[i]; val[i] = cb[i] * (cw0[i] * u2[i] + cw1[i] * u1[i] + cw2[i] * u0); s2 += val[i] * val[i]; u2[i] = u1[i]; u1[i] = u0; }
        const float rc = rsqrtf(wave_sum(s2) * (1.0f / 1024.f) + EPS);
        float ya[16], yb[16]; float mx = 0.f;
#pragma unroll
        for (int i = 0; i < 16; ++i) { ya[i] = o[i] * rg * gn[i] * silu_f(r[i]); yb[i] = val[i] * rc * cn[i]; mx = fmaxf(mx, fmaxf(fabsf(ya[i]), fabsf(yb[i]))); }
#pragma unroll
        for (int o_ = 1; o_ < 64; o_ <<= 1) mx = fmaxf(mx, __shfl_xor(mx, o_));
        const float inv = mx > 0.f ? 127.0f / mx : 0.f;
        v4u y0, y1;
#pragma unroll
        for (int j = 0; j < 4; ++j) { y0[j] = pack_i8(ya[4 * j] * inv, ya[4 * j + 1] * inv, ya[4 * j + 2] * inv, ya[4 * j + 3] * inv); y1[j] = pack_i8(yb[4 * j] * inv, yb[4 * j + 1] * inv, yb[4 * j + 2] * inv, yb[4 * j + 3] * inv); }
        unsigned char* yr = a.ws + WS_Y8 + (size_t)t * D;
        *(v4u*)(yr + c0) = y0; *(v4u*)(yr + 1024 + c0) = y1;
#if !I8_OUT
        { v4u b0, b1, b2, b3;
#pragma unroll
          for (int j = 0; j < 4; ++j) { b0[j] = pk2(ya[2 * j], ya[2 * j + 1]); b1[j] = pk2(ya[8 + 2 * j], ya[9 + 2 * j]); b2[j] = pk2(yb[2 * j], yb[2 * j + 1]); b3[j] = pk2(yb[8 + 2 * j], yb[9 + 2 * j]); }
          bf16* ybr = (bf16*)(a.ws + WS_Y) + (size_t)t * D;
          *(v4u*)(ybr + c0) = b0; *(v4u*)(ybr + c0 + 8) = b1; *(v4u*)(ybr + 1024 + c0) = b2; *(v4u*)(ybr + 1024 + c0 + 8) = b3; }
#endif
        if (lane == 0) ((float*)(a.ws + WS_SAY))[t] = mx * (1.0f / 127.0f);
    }
}

__device__ __forceinline__ void ln1_chunk(const Args& a, int l, LAS unsigned char* lds, int lane, int wave, int ch) {
    const float* zbuf = (const float*)(a.ws + WS_Z); const float* mod = (const float*)(a.ws + WS_MOD);
    const int b = ch / NCH; const float* mb = mod + ((size_t)l * NB + b) * 6 * D;
#pragma unroll 2
    for (int it = 0; it < 8; ++it) { const int t = ch * 64 + wave * 8 + it;
        float z[32];
#pragma unroll
#if RES16_Z
        for (int c = 0; c < 8; ++c) { const v2u v0 = *(const v2u*)((const bf16*)zbuf + (size_t)t * D + (c * 64 + lane) * 4); z[c * 4] = bflo(v0.x); z[c * 4 + 1] = bfhi(v0.x); z[c * 4 + 2] = bflo(v0.y); z[c * 4 + 3] = bfhi(v0.y); }
#else
        for (int c = 0; c < 8; ++c) { const f32x4 v0 = *(const f32x4*)(zbuf + (size_t)t * D + (c * 64 + lane) * 4); z[c * 4] = v0.x; z[c * 4 + 1] = v0.y; z[c * 4 + 2] = v0.z; z[c * 4 + 3] = v0.w; }
#endif
        ln_tail(z, t, lane, a.in[11] + (size_t)l * D, a.in[12] + (size_t)l * D, RES16_X1 ? (float*)nullptr : (float*)(a.ws + WS_X1), mb + 3 * D, mb + 4 * D, I8_WQ ? (bf16*)nullptr : (bf16*)(a.ws + WS_H2), a.ws + WS_HQ8, (float*)(a.ws + WS_HSC), lds + wave * 2304, I8_WQ ? a.ws + WS_H28 : (unsigned char*)nullptr, nullptr, RES16_X1 ? (bf16*)(a.ws + WS_X1) : (bf16*)nullptr);
    }
}

template <int N> __device__ __forceinline__ void bitonic_sort_desc(float (&v)[N]) {
#pragma unroll
    for (int k = 2; k <= N; k <<= 1)
#pragma unroll
        for (int j = k >> 1; j > 0; j >>= 1)
#pragma unroll
            for (int i = 0; i < N; ++i) { const int p = i ^ j; if (p > i) { const bool desc = ((i & k) == 0); const float x = v[i], y = v[p]; const float mx = fmaxf(x, y), mn = fminf(x, y); v[i] = desc ? mx : mn; v[p] = desc ? mn : mx; } }
}
__device__ __forceinline__ void merge_top16(float (&x)[16], const float (&y)[16]) {
#pragma unroll
    for (int i = 0; i < 16; ++i) x[i] = fmaxf(x[i], y[15 - i]);
#pragma unroll
    for (int j = 8; j > 0; j >>= 1)
#pragma unroll
        for (int i = 0; i < 16; ++i) { const int p = i ^ j; if (p > i) { const float u = x[i], w = x[p]; x[i] = fmaxf(u, w); x[p] = fminf(u, w); } }
}
__device__ __forceinline__ void ce_desc(float& ka, int& pa, float& kb, int& pb) { const bool sw = kb > ka; const float k0 = sw ? kb : ka, k1 = sw ? ka : kb; const int p0 = sw ? pb : pa, p1 = sw ? pa : pb; ka = k0; pa = p0; kb = k1; pb = p1; }
__device__ __forceinline__ void bitonic_sort_desc_kp(float (&k)[16], int (&p)[16]) {
#pragma unroll
    for (int kk = 2; kk <= 16; kk <<= 1)
#pragma unroll
        for (int j = kk >> 1; j > 0; j >>= 1)
#pragma unroll
            for (int i = 0; i < 16; ++i) { const int q = i ^ j; if (q > i) { if ((i & kk) == 0) ce_desc(k[i], p[i], k[q], p[q]); else ce_desc(k[q], p[q], k[i], p[i]); } }
}
__device__ __forceinline__ void merge_top16_kp(float (&k)[16], int (&p)[16], const float (&k2)[16], const int (&p2)[16]) {
#pragma unroll
    for (int i = 0; i < 16; ++i) { const bool sw = k2[15 - i] > k[i]; k[i] = sw ? k2[15 - i] : k[i]; p[i] = sw ? p2[15 - i] : p[i]; }
#pragma unroll
    for (int j = 8; j > 0; j >>= 1)
#pragma unroll
        for (int i = 0; i < 16; ++i) { const int q = i ^ j; if (q > i) ce_desc(k[i], p[i], k[q], p[q]); }
}
__device__ constexpr int cand_i(int s) { return s < 16 ? 0 : s < 24 ? 1 : s < 29 ? 2 : s < 33 ? 3 : s < 36 ? 4 : s < 38 ? 5 : s < 40 ? 6 : s < 42 ? 7 : s < 50 ? s - 34 : -1; }
__device__ constexpr int cand_j(int s) { return s < 16 ? s : s < 24 ? s - 16 : s < 29 ? s - 24 : s < 33 ? s - 29 : s < 36 ? s - 33 : s < 38 ? s - 36 : s < 40 ? s - 38 : s < 42 ? s - 40 : s < 50 ? 0 : -1; }

__device__ __forceinline__ void peer_retrieve(const Args& a, int l, LAS unsigned char* lds, int lane, int wave, int ch) {
    const bf16* qbuf = (const bf16*)(a.ws + WS_Q); const bf16* keys = (const bf16*)(a.ws + WS_KEYS) + ((size_t)(l * 8 + wave) * 2) * 128 * 128;
    LAS int* eg_e = (LAS int*)lds; LAS float* eg_g = (LAS float*)(lds + 32768);
    const int l31 = lane & 31, l5 = lane >> 5, h = wave, t0 = ch * 64;
    for (int tt = 0; tt < 2; ++tt) {
        float sv[2][16];
#pragma unroll
        for (int p = 0; p < 2; ++p) {
            f32x16 acc[4];
#pragma unroll
            for (int nt = 0; nt < 4; ++nt)
#pragma unroll
                for (int r = 0; r < 16; ++r) acc[nt][r] = 0.f;
            const bf16* qp = qbuf + (size_t)(t0 + 32 * tt + l31) * D + h * 256 + p * 128 + 8 * l5;
            const bf16* kp = keys + (size_t)(p * 128 + l31) * 128 + 8 * l5;
#pragma unroll 2
            for (int ks = 0; ks < 8; ++ks) { const bf16x8 bq = *(const bf16x8*)(qp + 16 * ks);
#pragma unroll
                for (int nt = 0; nt < 4; ++nt) { const bf16x8 ak = *(const bf16x8*)(kp + (size_t)(32 * nt) * 128 + 16 * ks); acc[nt] = __builtin_amdgcn_mfma_f32_32x32x16_bf16(ak, bq, acc[nt], 0, 0, 0); } }
            float v[4][16];
#pragma unroll
            for (int nt = 0; nt < 4; ++nt)
#pragma unroll
                for (int r = 0; r < 16; ++r) { const unsigned idx = 32u * nt + (r & 3) + 8u * (r >> 2) + 4u * l5; v[nt][r] = __uint_as_float((__float_as_uint(acc[nt][r]) & 0xffffff80u) | idx); }
#pragma unroll
            for (int nt = 0; nt < 4; ++nt) bitonic_sort_desc<16>(v[nt]);
            merge_top16(v[0], v[1]); merge_top16(v[2], v[3]); merge_top16(v[0], v[2]);
            float o[16];
#pragma unroll
            for (int i = 0; i < 16; ++i) o[i] = __shfl_xor(v[0][i], 32);
            merge_top16(v[0], o);
#pragma unroll
            for (int i = 0; i < 16; ++i) sv[p][i] = v[0][i];
        }
        LAS unsigned char* idxb = (LAS unsigned char*)(lds + 69632) + wave * 2048 + lane * 32;
        { v4u w0, w1;
#pragma unroll
          for (int q4 = 0; q4 < 4; ++q4) {
              w0[q4] = (__float_as_uint(sv[0][4 * q4]) & 127u) | ((__float_as_uint(sv[0][4 * q4 + 1]) & 127u) << 8) | ((__float_as_uint(sv[0][4 * q4 + 2]) & 127u) << 16) | ((__float_as_uint(sv[0][4 * q4 + 3]) & 127u) << 24);
              w1[q4] = (__float_as_uint(sv[1][4 * q4]) & 127u) | ((__float_as_uint(sv[1][4 * q4 + 1]) & 127u) << 8) | ((__float_as_uint(sv[1][4 * q4 + 2]) & 127u) << 16) | ((__float_as_uint(sv[1][4 * q4 + 3]) & 127u) << 24); }
          *(LAS v4u*)(idxb) = w0; *(LAS v4u*)(idxb + 16) = w1; }
        float ck[4][16];
#pragma unroll
        for (int s = 0; s < 64; ++s) {
            if (cand_i(s) >= 0) { const unsigned b0 = __float_as_uint(sv[0][cand_i(s) < 0 ? 0 : cand_i(s)]), b1 = __float_as_uint(sv[1][cand_j(s) < 0 ? 0 : cand_j(s)]);
                const float sum = __uint_as_float(b0 & 0xffffff80u) + __uint_as_float(b1 & 0xffffff80u);
                ck[s >> 4][s & 15] = __uint_as_float((__float_as_uint(sum) & 0xffffff00u) | (unsigned)((cand_i(s) < 0 ? 0 : cand_i(s)) * 16 + (cand_j(s) < 0 ? 0 : cand_j(s)))); }
            else ck[s >> 4][s & 15] = -3.0e38f; }
        bitonic_sort_desc<16>(ck[1]); bitonic_sort_desc<16>(ck[2]);
        merge_top16(ck[0], ck[1]); merge_top16(ck[2], ck[3]); merge_top16(ck[0], ck[2]);
        LDS_WAIT(); asm volatile("" ::: "memory");
        float ex[16]; int ce[16]; float den = 0.f;
        const float cmax = __uint_as_float(__float_as_uint(ck[0][0]) & 0xffffff00u);
#pragma unroll
        for (int i = 0; i < 16; ++i) { const unsigned bits = __float_as_uint(ck[0][i]); ex[i] = __expf(__uint_as_float(bits & 0xffffff00u) - cmax); den += ex[i];
            ce[i] = (int)idxb[(bits >> 4) & 15u] * 128 + (int)idxb[16 + (bits & 15u)]; }
        const float inv = 1.0f / den;
        if (l5 == 0) {
            const int base = (32 * tt + l31) * 128 + h * 16;
#pragma unroll
            for (int i4 = 0; i4 < 4; ++i4) { *(LAS v4u*)(eg_e + base + 4 * i4) = (v4u){(unsigned)ce[4 * i4], (unsigned)ce[4 * i4 + 1], (unsigned)ce[4 * i4 + 2], (unsigned)ce[4 * i4 + 3]};
                *(LAS f32x4*)(eg_g + base + 4 * i4) = (f32x4){ex[4 * i4] * inv, ex[4 * i4 + 1] * inv, ex[4 * i4 + 2] * inv, ex[4 * i4 + 3] * inv}; }
        }
        LDS_WAIT(); asm volatile("" ::: "memory");
    }
}

typedef unsigned char uc4 __attribute__((ext_vector_type(4)));
constexpr int NSLICE = 16, SLICE_SHIFT = 10;
__device__ __forceinline__ int sdot4i(unsigned w, unsigned x, int acc) { return __builtin_amdgcn_sdot4((int)w, (int)x, acc, false); }
__device__ __forceinline__ void fma_ub4(unsigned w, float s, float& y0, float& y1, float& y2, float& y3) { const uc4 b = __builtin_bit_cast(uc4, w); y0 += s * (float)b.x; y1 += s * (float)b.y; y2 += s * (float)b.z; y3 += s * (float)b.w; }
#if TAB4
__device__ __forceinline__ void peer_tail(const Args& a, int l, int t, int lane, const bf16* Yrow, const float* mb, const float* mbn, bool last) {
    const float* x1buf = (const float*)(a.ws + WS_X1);
    float z[32];
#pragma unroll
    for (int c8 = 0; c8 < 8; ++c8) { const int col = (c8 * 64 + lane) * 4;
        const v2u yb = *(const v2u*)(Yrow + col); const f32x4 yv = (f32x4){bflo(yb.x), bfhi(yb.x), bflo(yb.y), bfhi(yb.y)};
#if RES16_X1
        const v2u xb_ = *(const v2u*)((const bf16*)x1buf + (size_t)t * D + col); const f32x4 x0 = (f32x4){bflo(xb_.x), bfhi(xb_.x), bflo(xb_.y), bfhi(xb_.y)}, g0 = *(const f32x4*)(mb + 5 * D + col);
#else
        const f32x4 x0 = *(const f32x4*)(x1buf + (size_t)t * D + col), g0 = *(const f32x4*)(mb + 5 * D + col);
#endif
        z[c8 * 4] = ALPHA * x0.x + (1.f + g0.x) * yv.x; z[c8 * 4 + 1] = ALPHA * x0.y + (1.f + g0.y) * yv.y; z[c8 * 4 + 2] = ALPHA * x0.z + (1.f + g0.z) * yv.z; z[c8 * 4 + 3] = ALPHA * x0.w + (1.f + g0.w) * yv.w; }
    ln_tail(z, t, lane, a.in[17] + (size_t)l * D, a.in[18] + (size_t)l * D, last ? a.out : (RES16_X ? (float*)nullptr : (float*)(a.ws + WS_X)), mbn, mbn + D, (last || I8_GATE) ? (bf16*)nullptr : (bf16*)(a.ws + WS_H), nullptr, nullptr, nullptr, last ? (unsigned char*)nullptr : a.ws + WS_H8, (float*)(a.ws + WS_SAH), (RES16_X && !last) ? (bf16*)(a.ws + WS_X) : (bf16*)nullptr);
}
template <class TT, int N, int M> __device__ __forceinline__ void treduce(TT (&v)[N], int lane) {
    const bool c0 = (lane & M) != 0, c1 = (lane & (2 * M)) != 0, c2 = (lane & (4 * M)) != 0;
#pragma unroll
    for (int m = 0; m < N / 2; ++m) { const TT keep = c0 ? v[2 * m + 1] : v[2 * m], send = c0 ? v[2 * m] : v[2 * m + 1]; v[m] = keep + __shfl_xor(send, M); }
#pragma unroll
    for (int m = 0; m < N / 4; ++m) { const TT keep = c1 ? v[2 * m + 1] : v[2 * m], send = c1 ? v[2 * m] : v[2 * m + 1]; v[m] = keep + __shfl_xor(send, 2 * M); }
#pragma unroll
    for (int m = 0; m < N / 8; ++m) { const TT keep = c2 ? v[2 * m + 1] : v[2 * m], send = c2 ? v[2 * m] : v[2 * m + 1]; v[m] = keep + __shfl_xor(send, 4 * M); }
}
__device__ __forceinline__ void tr4x4(unsigned a, unsigned b, unsigned c, unsigned d, unsigned& t0, unsigned& t1, unsigned& t2, unsigned& t3) {
    const unsigned x0 = __builtin_amdgcn_perm(b, a, 0x05010400u), x1 = __builtin_amdgcn_perm(b, a, 0x07030602u), y0 = __builtin_amdgcn_perm(d, c, 0x05010400u), y1 = __builtin_amdgcn_perm(d, c, 0x07030602u);
    t0 = __builtin_amdgcn_perm(y0, x0, 0x05040100u); t1 = __builtin_amdgcn_perm(y0, x0, 0x07060302u); t2 = __builtin_amdgcn_perm(y1, x1, 0x05040100u); t3 = __builtin_amdgcn_perm(y1, x1, 0x07060302u);
}
__device__ __forceinline__ int sdot8i(unsigned w, unsigned x, int acc) { return __builtin_amdgcn_sdot8((int)w, (int)x, acc, false); }
__device__ __forceinline__ float slot_scale(unsigned w3) { return __builtin_amdgcn_exp2f((float)(w3 >> 24) * 0.125f - 16.0f); }
__device__ __forceinline__ void peer_experts(const Args& a, int l, LAS unsigned char* lds, int lane0, int wave, int ch) {
    const float* mod = (const float*)(a.ws + WS_MOD);
    const unsigned char* ut = a.ws + WS_UT + (size_t)l * NE * 1152; const unsigned char* vt = a.ws + WS_VT + (size_t)l * NE * 1152; const unsigned char* hq8 = a.ws + WS_HQ8;
    const float* hsc = (const float*)(a.ws + WS_HSC);
    bf16* Ybuf = (bf16*)(a.ws + WS_Z);
    const LAS int* eg_e = (const LAS int*)lds; LAS float* sw = (LAS float*)(lds + 32768);
    LAS float* apart = (LAS float*)(lds + 65536);
    const int b = ch / NCH; const bool last = (l == NL - 1);
    const float* mb = mod + ((size_t)l * NB + b) * 6 * D; const float* mbn = mod + ((size_t)(last ? l : l + 1) * NB + b) * 6 * D;
    const int tlw = wave * 8;
    { const int lane = lane0;
#pragma unroll
      for (int i = 0; i < 16; ++i) apart[tlw * 128 + i * 64 + lane] = 0.f; }
    LDS_WAIT(); asm volatile("" ::: "memory");
    {
        int laneL = lane0; asm volatile("" : "+v"(laneL)); const int lane = laneL;
        const int g = lane >> 3, l7 = lane & 7;
        v4u bufA[16], bufB[16], hA0, hA1, hB0, hB1;
#define CU_LOAD(buf, h0_, h1_, idx_) do { const int u_ = (idx_) >> 3, tl_ = tlw + ((idx_) & 7); const unsigned soff_ = (unsigned)(u_ * 128 + l7 * 16); \
            const unsigned char* hp_ = hq8 + (size_t)(ch * 64 + tl_) * 2304 + (u_ * 8 + l7) * 32; h0_ = *(const v4u*)hp_; h1_ = *(const v4u*)(hp_ + 16); \
            _Pragma("unroll") for (int i_ = 0; i_ < 16; ++i_) { const unsigned e_ = (unsigned)eg_e[tl_ * 128 + 8 * i_ + g]; buf[i_] = *(const v4u*)(ut + (size_t)(e_ * 1152u + soff_)); } } while (0)
#define CU_COMP(buf, h0_, h1_, idx_) do { const int tl_ = tlw + ((idx_) & 7); float accv_[16]; \
            _Pragma("unroll") for (int i_ = 0; i_ < 16; ++i_) { int sl_ = 0, sh_ = 0; \
                _Pragma("unroll") for (int d_ = 0; d_ < 4; ++d_) { const unsigned x_ = buf[i_][d_] ^ 0x88888888u; sl_ = sdot8i(x_, h0_[d_], sl_); sh_ = sdot8i(x_, h1_[d_], sh_); } \
                accv_[i_] = slot_scale(buf[i_][3]) * (float)(16 * sh_ + sl_); } \
            treduce<float, 16, 1>(accv_, lane); \
            apart[tl_ * 128 + 8 * l7 + g] += accv_[0]; apart[tl_ * 128 + 8 * (8 + l7) + g] += accv_[1]; } while (0)
        CU_LOAD(bufA, hA0, hA1, 0);
        for (int idx = 0; idx < 72; idx += 2) {
            CU_LOAD(bufB, hB0, hB1, idx + 1);
            CU_COMP(bufA, hA0, hA1, idx);
            { const int nx_ = idx + 2 < 72 ? idx + 2 : 71; CU_LOAD(bufA, hA0, hA1, nx_); }
            CU_COMP(bufB, hB0, hB1, idx + 1);
        }
#undef CU_LOAD
#undef CU_COMP
        LDS_WAIT(); asm volatile("" ::: "memory");
        for (int it = 0; it < 8; ++it) { const int tl = tlw + it; const float shs = hsc[ch * 64 + tl];
            const float w0 = sw[tl * 128 + lane] * gelu_tanh_f(apart[tl * 128 + lane] * shs), w1 = sw[tl * 128 + 64 + lane] * gelu_tanh_f(apart[tl * 128 + 64 + lane] * shs);
            sw[tl * 128 + lane] = w0; sw[tl * 128 + 64 + lane] = w1; }
        LDS_WAIT(); asm volatile("" ::: "memory");
    }
    {
        int laneL = lane0; asm volatile("" : "+v"(laneL)); const int lane = laneL;
        const int g = lane >> 3, l7 = lane & 7;
        v4u bufA[16], bufB[16];
#define CV_LOAD(buf, idx_) do { const int u_ = (idx_) >> 3, tl_ = tlw + ((idx_) & 7); const unsigned soff_ = (unsigned)(u_ * 128 + l7 * 16); \
            _Pragma("unroll") for (int i_ = 0; i_ < 16; ++i_) { const unsigned e_ = (unsigned)eg_e[tl_ * 128 + 8 * i_ + g]; buf[i_] = *(const v4u*)(vt + (size_t)(e_ * 1152u + soff_)); } } while (0)
#define CV_COMP(buf, idx_) do { const int u_ = (idx_) >> 3, tl_ = tlw + ((idx_) & 7); \
            float wf_[16]; float wmx_ = 0.f; \
            _Pragma("unroll") for (int i_ = 0; i_ < 16; ++i_) { wf_[i_] = sw[tl_ * 128 + 8 * i_ + g] * slot_scale(buf[i_][3]); wmx_ = fmaxf(wmx_, fabsf(wf_[i_])); } \
            wmx_ = fmaxf(wmx_, __shfl_xor(wmx_, 8)); wmx_ = fmaxf(wmx_, __shfl_xor(wmx_, 16)); wmx_ = fmaxf(wmx_, __shfl_xor(wmx_, 32));     \
            const float winv_ = wmx_ > 0.f ? 127.0f / wmx_ : 0.f, wsc_ = wmx_ * (1.0f / 127.0f); \
              \
            unsigned wq4_[4]; int wsum_ = 0; \
            _Pragma("unroll") for (int gp_ = 0; gp_ < 4; ++gp_) { \
                const unsigned m0_ = __float_as_uint(wf_[4 * gp_] * winv_ + 12582912.0f), m1_ = __float_as_uint(wf_[4 * gp_ + 1] * winv_ + 12582912.0f), m2_ = __float_as_uint(wf_[4 * gp_ + 2] * winv_ + 12582912.0f), m3_ = __float_as_uint(wf_[4 * gp_ + 3] * winv_ + 12582912.0f); \
                wq4_[gp_] = __builtin_amdgcn_perm(__builtin_amdgcn_perm(m3_, m2_, 0x0c0c0400u), __builtin_amdgcn_perm(m1_, m0_, 0x0c0c0400u), 0x05040100u); \
                wsum_ = sdot4i(wq4_[gp_], 0x01010101u, wsum_); } \
            int yi_[32]; \
            _Pragma("unroll") for (int q_ = 0; q_ < 32; ++q_) yi_[q_] = 0; \
            _Pragma("unroll") for (int gp_ = 0; gp_ < 4; ++gp_) { \
                _Pragma("unroll") for (int d_ = 0; d_ < 4; ++d_) { const unsigned A_ = buf[4 * gp_][d_], B_ = buf[4 * gp_ + 1][d_], C_ = buf[4 * gp_ + 2][d_], D_ = buf[4 * gp_ + 3][d_]; \
                    unsigned t0_, t1_, t2_, t3_; \
                    tr4x4(A_, B_, C_, D_, t0_, t1_, t2_, t3_);     \
                    yi_[8 * d_]     = sdot4i(t0_ & 0x0f0f0f0fu, wq4_[gp_], yi_[8 * d_]);     yi_[8 * d_ + 1] = sdot4i((t0_ >> 4) & 0x0f0f0f0fu, wq4_[gp_], yi_[8 * d_ + 1]); \
                    yi_[8 * d_ + 2] = sdot4i(t1_ & 0x0f0f0f0fu, wq4_[gp_], yi_[8 * d_ + 2]); yi_[8 * d_ + 3] = sdot4i((t1_ >> 4) & 0x0f0f0f0fu, wq4_[gp_], yi_[8 * d_ + 3]); \
                    yi_[8 * d_ + 4] = sdot4i(t2_ & 0x0f0f0f0fu, wq4_[gp_], yi_[8 * d_ + 4]); yi_[8 * d_ + 5] = sdot4i((t2_ >> 4) & 0x0f0f0f0fu, wq4_[gp_], yi_[8 * d_ + 5]); \
                    yi_[8 * d_ + 6] = sdot4i(t3_ & 0x0f0f0f0fu, wq4_[gp_], yi_[8 * d_ + 6]); yi_[8 * d_ + 7] = sdot4i((t3_ >> 4) & 0x0f0f0f0fu, wq4_[gp_], yi_[8 * d_ + 7]); } } \
            treduce<int, 32, 8>(yi_, lane); \
            wsum_ += __shfl_xor(wsum_, 8); wsum_ += __shfl_xor(wsum_, 16); wsum_ += __shfl_xor(wsum_, 32);     \
            float y_[4]; \
            _Pragma("unroll") for (int q_ = 0; q_ < 4; ++q_) y_[q_] = wsc_ * (float)(yi_[q_] - 8 * wsum_); \
            { const int colb_ = u_ * 240 + l7 * 30 + g; bf16* yr_ = Ybuf + (size_t)(ch * 64 + tl_) * D + colb_; \
              _Pragma("unroll") for (int m_ = 0; m_ < 4; ++m_) if (8 * m_ + g < 30 && colb_ + 8 * m_ < D) yr_[8 * m_] = (bf16)(pk2(y_[m_], 0.f) & 0xffffu); } } while (0)
        CV_LOAD(bufA, 0);
        for (int idx = 0; idx < 72; idx += 2) {
            CV_LOAD(bufB, idx + 1);
            CV_COMP(bufA, idx);
            { const int nx_ = idx + 2 < 72 ? idx + 2 : 71; CV_LOAD(bufA, nx_); }
            CV_COMP(bufB, idx + 1);
        }
#undef CV_LOAD
#undef CV_COMP
    }
    asm volatile("s_waitcnt vmcnt(0)" ::: "memory");
    __builtin_amdgcn_fence(__ATOMIC_ACQUIRE, "agent");
    asm volatile("s_waitcnt vmcnt(0)" ::: "memory");
    for (int it = 0; it < 8; ++it) { int laneT = lane0; asm volatile("" : "+v"(laneT)); const int t = ch * 64 + tlw + it;
        peer_tail(a, l, t, laneT, Ybuf + (size_t)t * D, mb, mbn, last); }
}
#else
__device__ __forceinline__ void peer_tail(const Args& a, int l, int t, int lane, const float* Yrow, const float* mb, const float* mbn, bool last) {
    const float* x1buf = (const float*)(a.ws + WS_X1);
    float z[32];
#pragma unroll
    for (int c = 0; c < 2; ++c)
#pragma unroll
        for (int k = 0; k < 4; ++k) { const int c8 = 4 * c + k, col = (c8 * 64 + lane) * 4;
            const v2u yb = *(const v2u*)((const bf16*)Yrow + (c * 64 + lane) * 16 + 4 * k); const f32x4 yv = (f32x4){bflo(yb.x), bfhi(yb.x), bflo(yb.y), bfhi(yb.y)};
#if RES16_X1
            const v2u xb_ = *(const v2u*)((const bf16*)x1buf + (size_t)t * D + col); const f32x4 x0 = (f32x4){bflo(xb_.x), bfhi(xb_.x), bflo(xb_.y), bfhi(xb_.y)}, g0 = *(const f32x4*)(mb + 5 * D + col);
#else
            const f32x4 x0 = *(const f32x4*)(x1buf + (size_t)t * D + col), g0 = *(const f32x4*)(mb + 5 * D + col);
#endif
            z[c8 * 4] = ALPHA * x0.x + (1.f + g0.x) * yv.x; z[c8 * 4 + 1] = ALPHA * x0.y + (1.f + g0.y) * yv.y; z[c8 * 4 + 2] = ALPHA * x0.z + (1.f + g0.z) * yv.z; z[c8 * 4 + 3] = ALPHA * x0.w + (1.f + g0.w) * yv.w; }
    ln_tail(z, t, lane, a.in[17] + (size_t)l * D, a.in[18] + (size_t)l * D, last ? a.out : (RES16_X ? (float*)nullptr : (float*)(a.ws + WS_X)), mbn, mbn + D, (last || I8_GATE) ? (bf16*)nullptr : (bf16*)(a.ws + WS_H), nullptr, nullptr, nullptr, last ? (unsigned char*)nullptr : a.ws + WS_H8, (float*)(a.ws + WS_SAH), (RES16_X && !last) ? (bf16*)(a.ws + WS_X) : (bf16*)nullptr);
}
template <class TT, int M> __device__ __forceinline__ void treduce16(TT (&v)[16], int lane) {
    const bool c0 = (lane & M) != 0, c1 = (lane & (2 * M)) != 0, c2 = (lane & (4 * M)) != 0;
#pragma unroll
    for (int m = 0; m < 8; ++m) { const TT keep = c0 ? v[2 * m + 1] : v[2 * m], send = c0 ? v[2 * m] : v[2 * m + 1]; v[m] = keep + __shfl_xor(send, M); }
#pragma unroll
    for (int m = 0; m < 4; ++m) { const TT keep = c1 ? v[2 * m + 1] : v[2 * m], send = c1 ? v[2 * m] : v[2 * m + 1]; v[m] = keep + __shfl_xor(send, 2 * M); }
#pragma unroll
    for (int m = 0; m < 2; ++m) { const TT keep = c2 ? v[2 * m + 1] : v[2 * m], send = c2 ? v[2 * m] : v[2 * m + 1]; v[m] = keep + __shfl_xor(send, 4 * M); }
}
__device__ __forceinline__ void peer_experts(const Args& a, int l, LAS unsigned char* lds, int lane0, int wave, int ch) {
    const float* mod = (const float*)(a.ws + WS_MOD);
    const unsigned char* ut = a.ws + WS_UT + (size_t)l * NE * D; const unsigned char* vt = a.ws + WS_VT + (size_t)l * NE * D; const unsigned char* hq8 = a.ws + WS_HQ8;
    const float* su = (const float*)(a.ws + WS_SU) + (size_t)l * NE; const float* sv = (const float*)(a.ws + WS_SV) + (size_t)l * NE; const float* hsc = (const float*)(a.ws + WS_HSC);
    float* Ybuf = (float*)(a.ws + WS_Z);
    const LAS int* eg_e = (const LAS int*)lds; LAS float* sw = (LAS float*)(lds + 32768);
    LAS int* apart = (LAS int*)(lds + 65536); LAS float* wtotl = (LAS float*)(lds + LDSCTL_OFF + 256);
    const int b = ch / NCH; const bool last = (l == NL - 1);
    const float* mb = mod + ((size_t)l * NB + b) * 6 * D; const float* mbn = mod + ((size_t)(last ? l : l + 1) * NB + b) * 6 * D;
    const int tlw = wave * 8;
    { const int lane = lane0;
#pragma unroll
      for (int i = 0; i < 16; ++i) apart[tlw * 128 + i * 64 + lane] = 0; }
    LDS_WAIT(); asm volatile("" ::: "memory");
    {
        int laneL = lane0; asm volatile("" : "+v"(laneL)); const int lane = laneL;
        const int g = lane >> 3, l7 = lane & 7;
        v4u bufA[16], bufB[16], hA, hB;
#define CU_LOAD(buf, hh_, idx_) do { const int cs_ = (idx_) >> 3, tl_ = tlw + ((idx_) & 7); const unsigned coff_ = (unsigned)(cs_ * 128 + l7 * 16); \
            hh_ = *(const v4u*)(hq8 + (size_t)(ch * 64 + tl_) * D + coff_); \
            _Pragma("unroll") for (int i_ = 0; i_ < 16; ++i_) { const unsigned e_ = (unsigned)eg_e[tl_ * 128 + 8 * i_ + g]; buf[i_] = *(const v4u*)(ut + (size_t)(e_ * 2048u + coff_)); } } while (0)
#define CU_COMP(buf, hh_, idx_) do { const int tl_ = tlw + ((idx_) & 7); int acc_[16]; \
            _Pragma("unroll") for (int i_ = 0; i_ < 16; ++i_) { int s_ = 0; _Pragma("unroll") for (int q_ = 0; q_ < 4; ++q_) s_ = sdot4i(buf[i_][q_], hh_[q_], s_); acc_[i_] = s_; } \
            treduce16<int, 1>(acc_, lane); \
            apart[tl_ * 128 + 8 * l7 + g] += acc_[0]; apart[tl_ * 128 + 8 * (8 + l7) + g] += acc_[1]; } while (0)
        CU_LOAD(bufA, hA, 0);
        for (int idx = 0; idx < 128; idx += 2) {
            CU_LOAD(bufB, hB, idx + 1);
            CU_COMP(bufA, hA, idx);
            if (idx + 2 < 128) CU_LOAD(bufA, hA, idx + 2);
            CU_COMP(bufB, hB, idx + 1);
        }
#undef CU_LOAD
#undef CU_COMP
        LDS_WAIT(); asm volatile("" ::: "memory");
        for (int it = 0; it < 8; ++it) { const int tl = tlw + it; const float shs = hsc[ch * 64 + tl];
            const int e0 = eg_e[tl * 128 + lane], e1 = eg_e[tl * 128 + 64 + lane];
            const float w0 = sw[tl * 128 + lane] * gelu_tanh_f((float)apart[tl * 128 + lane] * su[e0] * shs) * sv[e0];
            const float w1 = sw[tl * 128 + 64 + lane] * gelu_tanh_f((float)apart[tl * 128 + 64 + lane] * su[e1] * shs) * sv[e1];
            sw[tl * 128 + lane] = w0; sw[tl * 128 + 64 + lane] = w1;
            const float ws = wave_sum(w0 + w1);
            if (lane == 0) wtotl[tl] = ws; }
        LDS_WAIT(); asm volatile("" ::: "memory");
    }
    {
        int laneL = lane0; asm volatile("" : "+v"(laneL)); const int lane = laneL;
        const int g = lane >> 3, l7 = lane & 7;
        v4u bufA[16], bufB[16];
#define CV_LOAD(buf, idx_) do { const int cs_ = (idx_) >> 3, tl_ = tlw + ((idx_) & 7); const unsigned coff_ = (unsigned)(cs_ * 128 + l7 * 16); \
            _Pragma("unroll") for (int i_ = 0; i_ < 16; ++i_) { const unsigned e_ = (unsigned)eg_e[tl_ * 128 + 8 * i_ + g]; buf[i_] = *(const v4u*)(vt + (size_t)(e_ * 2048u + coff_)); } } while (0)
#define CV_COMP(buf, idx_) do { const int cs_ = (idx_) >> 3, tl_ = tlw + ((idx_) & 7); float y_[16]; \
            _Pragma("unroll") for (int q_ = 0; q_ < 16; ++q_) y_[q_] = 0.f; \
            _Pragma("unroll") for (int i_ = 0; i_ < 16; ++i_) { const float wr_ = sw[tl_ * 128 + 8 * i_ + g]; \
                _Pragma("unroll") for (int q_ = 0; q_ < 4; ++q_) fma_ub4(buf[i_][q_], wr_, y_[4 * q_], y_[4 * q_ + 1], y_[4 * q_ + 2], y_[4 * q_ + 3]); } \
            treduce16<float, 8>(y_, lane); \
            const float woff_ = 128.0f * wtotl[tl_]; bf16* yr_ = (bf16*)Ybuf + (size_t)(ch * 64 + tl_) * D + cs_ * 128 + l7 * 16 + g; \
            yr_[0] = (bf16)(pk2(y_[0] - woff_, 0.f) & 0xffffu); yr_[8] = (bf16)(pk2(y_[1] - woff_, 0.f) & 0xffffu); } while (0)
        CV_LOAD(bufA, 0);
        for (int idx = 0; idx < 128; idx += 2) {
            CV_LOAD(bufB, idx + 1);
            CV_COMP(bufA, idx);
            if (idx + 2 < 128) CV_LOAD(bufA, idx + 2);
            CV_COMP(bufB, idx + 1);
        }
#undef CV_LOAD
#undef CV_COMP
    }
    asm volatile("s_waitcnt vmcnt(0)" ::: "memory");
    __builtin_amdgcn_fence(__ATOMIC_ACQUIRE, "agent");
    asm volatile("s_waitcnt vmcnt(0)" ::: "memory");
    for (int it = 0; it < 8; ++it) { int laneT = lane0; asm volatile("" : "+v"(laneT)); const int t = ch * 64 + tlw + it;
        peer_tail(a, l, t, laneT, (const float*)((const bf16*)Ybuf + (size_t)t * D), mb, mbn, last); }
}

#endif

#ifndef MK_PER_PHASE
#define MK_PER_PHASE 0
#endif
__global__ void __launch_bounds__(NTHREADS, 2) mk_fwd(Args a) {
    extern __shared__ __attribute__((aligned(16))) unsigned char lds_raw[];
    LAS unsigned char* lds = (LAS unsigned char*)lds_raw;
    const int tid = threadIdx.x, lane = tid & 63, wave = __builtin_amdgcn_readfirstlane(tid >> 6), G = gridDim.x, bx = blockIdx.x;
    if (tid < 64) ((LAS unsigned*)(lds + LDSCTL_OFF))[tid] = 0u;
    __syncthreads();
    unsigned* ctl = (unsigned*)(a.ws + WS_CTL);
    XcdBarrier bar; bar.bar = ctl + CW_BAR; bar.x = 0; bar.st = nullptr;
    const bool use_bar = (a.ph_hi - a.ph_lo) > 1;
    if (use_bar) bar = xcd_barrier_post(ctl + CW_BAR, (volatile LAS unsigned*)(lds + LDSCTL_OFF));
    const int lo = a.ph_lo, hi = a.ph_hi;
#ifndef PH_MASK
#define PH_MASK 0x1ff
#endif
#define IN(k) (lo <= (k) && (k) < hi)
#define EN(b) ((PH_MASK >> (b)) & 1)
#ifndef REP_MASK
#define REP_MASK 0
#endif
#ifndef REP_EXTRA
#define REP_EXTRA 2
#endif
#define REPS(b) (1 + ((REP_MASK >> (b)) & 1) * REP_EXTRA)
#define REP_BEGIN(b) for (int rep_ = 0; rep_ < REPS(b); ++rep_) {
#define REP_END(b) if (rep_ + 1 < REPS(b)) xcd_barrier(bar); }
#define SEAM(k) do { if (IN((k) + 1)) xcd_barrier(bar); } while (0)
#define PHASE_IDS() int tidp = tid; asm volatile("" : "+v"(tidp)); const int lanep = tidp & 63, wavep = __builtin_amdgcn_readfirstlane(tidp >> 6); (void)lanep; (void)wavep
    if (EN(0) && IN(0)) { REP_BEGIN(0) PHASE_IDS(); ph_prologue_a(a, lds, tidp, lanep, wavep, bx, G); REP_END(0) SEAM(0); }
    if (EN(1) && IN(1)) { REP_BEGIN(1) PHASE_IDS(); ph_prologue_b(a, lds, tidp, lanep, wavep, bx, G); REP_END(1) SEAM(1); }
    for (int l = 0; l < NL; ++l) {
        const int pb = 2 + 7 * l;
        const float* mod = (const float*)(a.ws + WS_MOD);
        if (EN(2) && IN(pb + 0)) {
            REP_BEGIN(2) PHASE_IDS();
#if I8_IN
            pg8::Gemm g{(const pg8::bf16_t*)(a.ws + WS_H8), (const pg8::bf16_t*)(a.ws + WS_WIN8 + (size_t)l * NP * D), T, NP, D / 2}; pg8::StaticOrder S; S.init(T, NP, G, bx, WGM_IN, KROT(bx));
            pg8::EpiBf16PS E{(pg8::bf16_t*)(a.ws + WS_PROJ), NP, (const float*)(a.ws + WS_SAH), (const float*)(a.ws + WS_SB) + l * SBL};
            pg8::gemm_phase<pg8::EpiBf16PS, pg8::StaticOrder, true, true, true>(lds + RING_OFF, g, S, E, tidp);
#else
            pg8::Gemm g{(const pg8::bf16_t*)(a.ws + WS_H), (const pg8::bf16_t*)(a.ws + WS_WIN) + (size_t)l * INW * D, T, NP, D}; pg8::StaticOrder S; S.init(T, NP, G, bx, WGM_IN, KROT(bx));
            pg8::EpiBf16P E{(pg8::bf16_t*)(a.ws + WS_PROJ), NP};
            pg8::gemm_phase<pg8::EpiBf16P, pg8::StaticOrder, true, true>(lds + RING_OFF, g, S, E, tidp);
#endif
#ifndef GP_REP
#define GP_REP 1
#endif
            for (int gpr_ = 0; gpr_ < GP_REP; ++gpr_) for (int ch = bx; ch < NCHUNK; ch += G) gate_prep(a, l, lds, tidp, lanep, wavep, ch);
            REP_END(2) SEAM(pb + 0);
        }
        if (EN(3) && IN(pb + 1)) { REP_BEGIN(3) PHASE_IDS(); for (int un = bx; un < 256; un += G) gla_unit(a, lds, tidp, lanep, wavep, un); REP_END(3) SEAM(pb + 1); }
        if (EN(4) && IN(pb + 2)) { REP_BEGIN(4) PHASE_IDS(); for (int ch = bx; ch < NCHUNK; ch += G) mixpost_chunk(a, l, lanep, wavep, ch); REP_END(4) SEAM(pb + 2); }
        if (EN(5) && IN(pb + 3)) {
            REP_BEGIN(5) PHASE_IDS();
#if I8_OUT
            pg8::Gemm g{(const pg8::bf16_t*)(a.ws + WS_Y8), (const pg8::bf16_t*)(a.ws + WS_WOUT8 + (size_t)l * D * D), T, D, D / 2}; pg8::StaticOrder S; S.init(T, D, G, bx, WGM_OUT, KROT(bx));
#if RES16_X || RES16_Z
            pg8::EpiResidS16<(RES16_X != 0), (RES16_Z != 0)> E{(void*)(a.ws + WS_Z), (RES16_X || l > 0) ? (const void*)(a.ws + WS_X) : (const void*)a.in[0], mod + (size_t)l * NB * 6 * D + 2 * D, (const float*)(a.ws + WS_SAY), (const float*)(a.ws + WS_SB) + l * SBL + NP, ALPHA};
            pg8::gemm_phase<pg8::EpiResidS16<(RES16_X != 0), (RES16_Z != 0)>, pg8::StaticOrder, true, true, true>(lds + RING_OFF, g, S, E, tidp);
#else
            pg8::EpiResidS E{(float*)(a.ws + WS_Z), l == 0 ? a.in[0] : (const float*)(a.ws + WS_X), mod + (size_t)l * NB * 6 * D + 2 * D, (const float*)(a.ws + WS_SAY), (const float*)(a.ws + WS_SB) + l * SBL + NP, ALPHA};
            pg8::gemm_phase<pg8::EpiResidS, pg8::StaticOrder, true, true, true>(lds + RING_OFF, g, S, E, tidp);
#endif
#else
            pg8::Gemm g{(const pg8::bf16_t*)(a.ws + WS_Y), (const pg8::bf16_t*)(a.ws + WS_WOUT) + (size_t)l * D * D, T, D, D}; pg8::StaticOrder S; S.init(T, D, G, bx, WGM_OUT, KROT(bx));
            pg8::EpiResid E{(float*)(a.ws + WS_Z), l == 0 ? a.in[0] : (const float*)(a.ws + WS_X), mod + (size_t)l * NB * 6 * D + 2 * D, ALPHA};
            pg8::gemm_phase<pg8::EpiResid, pg8::StaticOrder, true, true>(lds + RING_OFF, g, S, E, tidp);
#endif
            REP_END(5) SEAM(pb + 3);
        }
        if (EN(6) && IN(pb + 4)) { REP_BEGIN(6) PHASE_IDS(); for (int ch = bx; ch < NCHUNK; ch += G) ln1_chunk(a, l, lds, lanep, wavep, ch); REP_END(6) SEAM(pb + 4); }
        if (EN(7) && IN(pb + 5)) {
            REP_BEGIN(7) PHASE_IDS();
#if I8_WQ
            pg8::Gemm g{(const pg8::bf16_t*)(a.ws + WS_H28), (const pg8::bf16_t*)(a.ws + WS_WQ8 + (size_t)l * D * D), T, D, D / 2}; pg8::StaticOrder S; S.init(T, D, G, bx, WGM_WQ, KROT(bx));
            pg8::EpiBf16PS E{(pg8::bf16_t*)(a.ws + WS_Q), D, (const float*)(a.ws + WS_HSC), (const float*)(a.ws + WS_SB) + l * SBL + NP + D};
            pg8::gemm_phase<pg8::EpiBf16PS, pg8::StaticOrder, true, true, true>(lds + RING_OFF, g, S, E, tidp);
#else
            pg8::Gemm g{(const pg8::bf16_t*)(a.ws + WS_H2), (const pg8::bf16_t*)(a.ws + WS_WQ) + (size_t)l * D * D, T, D, D}; pg8::StaticOrder S; S.init(T, D, G, bx, WGM_WQ, KROT(bx));
            pg8::EpiBf16P E{(pg8::bf16_t*)(a.ws + WS_Q), D};
            pg8::gemm_phase<pg8::EpiBf16P, pg8::StaticOrder, true, true>(lds + RING_OFF, g, S, E, tidp);
#endif
            REP_END(7) SEAM(pb + 5);
        }
#ifndef PEER_DBG
#define PEER_DBG 0
#endif
#ifndef PE_REP_R
#define PE_REP_R 1
#endif
#ifndef L2PROBE
#define L2PROBE 0
#endif
        if (EN(8) && IN(pb + 6)) {
            REP_BEGIN(8)
            for (int ch = bx; ch < NCHUNK; ch += G) { for (int repr_ = 0; repr_ < PE_REP_R; ++repr_) { PHASE_IDS(); peer_retrieve(a, l, lds, lanep, wavep, ch); __syncthreads(); } __syncthreads(); { PHASE_IDS(); peer_experts(a, l, lds, lanep, wavep, ch); } __syncthreads(); }
            REP_END(8) SEAM(pb + 6);
        }
    }
#undef IN
#undef SEAM
}

extern "C" void kernel_launch(void* const* d_in, const int* in_sizes, int n_in, void* d_out, int out_size, void* d_ws, size_t ws_size, hipStream_t stream) {
    static int grid = 0;
    if (grid == 0) {
        if (n_in != 19 || in_sizes[0] != T * D || out_size != T * D || ws_size < WS_END) { fprintf(stderr, "kernel_launch: unexpected shapes / workspace (%d inputs, ws %zu); nothing launched\n", n_in, ws_size); grid = -1; return; }
        int dev = 0, cus = 0, per_cu = 0;
        if (hipGetDevice(&dev) != hipSuccess || hipDeviceGetAttribute(&cus, hipDeviceAttributeMultiprocessorCount, dev) != hipSuccess) { grid = -1; return; }
        if (hipFuncSetAttribute((const void*)mk_fwd, hipFuncAttributeMaxDynamicSharedMemorySize, LDS_BYTES) != hipSuccess) { fprintf(stderr, "kernel_launch: hipFuncSetAttribute failed\n"); grid = -1; return; }
        if (hipOccupancyMaxActiveBlocksPerMultiprocessor(&per_cu, (const void*)mk_fwd, NTHREADS, LDS_BYTES) != hipSuccess || per_cu < 1) fprintf(stderr, "kernel_launch: occupancy query reports %d\n", per_cu);
        (void)hipGetLastError();
        grid = cus;
    }
    if (grid < 0) return;
    if (hipMemsetAsync((char*)d_ws + WS_CTL, 0, CTL_ZERO_BYTES, stream) != hipSuccess) return;
    Args a{};
    for (int i = 0; i < 19; ++i) a.in[i] = (const float*)d_in[i];
    a.out = (float*)d_out; a.ws = (unsigned char*)d_ws;
#if MK_PER_PHASE
    for (int p = 0; p < NPHASES; ++p) { a.ph_lo = p; a.ph_hi = p + 1; hipLaunchKernelGGL(mk_fwd, dim3(grid), dim3(NTHREADS), LDS_BYTES, stream, a); }
#else
    a.ph_lo = 0; a.ph_hi = NPHASES;
    hipLaunchKernelGGL(mk_fwd, dim3(grid), dim3(NTHREADS), LDS_BYTES, stream, a);
#endif
}
```

```cpp
#include <hip/hip_runtime.h>
#include <cstdio>
#include <cstdint>
namespace pg8 {
#define PG8_LAS __attribute__((address_space(3)))
typedef unsigned short bf16_t;
typedef short bf16x8 __attribute__((ext_vector_type(8)));
typedef float f32x4 __attribute__((ext_vector_type(4)));
typedef unsigned u32x4 __attribute__((ext_vector_type(4)));
typedef int i32x4 __attribute__((ext_vector_type(4)));
constexpr int BM = 256, BK = 64, HALF = 128, HTB = HALF * BK * 2  , STAGE_BYTES = 8 * HTB, NXCD = 8, WGM = 8;

__host__ __device__ __forceinline__ int lds_byte(int r, int c) { const int st = (r >> 4) * 2 + (c >> 5), rr = r & 15, cc = c & 31, ob = rr * 64 + cc * 2; return st * 1024 + (ob ^ (((ob >> 9) & 1) << 5)); }
__host__ __device__ __forceinline__ void stage_rc(int b, int& R, int& C) { const int st = b / 1024, sb = b % 1024, swz = sb ^ (((sb >> 9) & 1) << 5); R = (st >> 1) * 16 + swz / 64; C = (st & 1) * 32 + (swz % 64) / 2; }
__host__ __device__ __forceinline__ int perm32(int rho) { const int n = rho >> 4, i = rho & 15; return 8 * (i >> 2) + 4 * n + (i & 3); }

struct Unit { int pm, pn; };
struct Gemm { const bf16_t* A; const bf16_t* Bt; int M, N, K; };

struct StaticOrder {
    int nM, nN, nwg, G, c, wgm, krot;
    __host__ __device__ void init(int M, int N, int G_, int c_, int wgm_ = WGM, int krot_ = 0) { nM = M / BM; nN = N / BM; nwg = nM * nN; G = G_; c = c_; wgm = wgm_; krot = krot_; }
    __host__ __device__ bool next(int i, Unit& u) const {
        const long L = (long)i * G + c; if (L >= nwg) return false;
        int wgid = (int)L; { const int q = nwg / NXCD, r = nwg % NXCD, xcd = wgid % NXCD, off = wgid / NXCD; wgid = (xcd < r ? xcd * (q + 1) : r * (q + 1) + (xcd - r) * q) + off; }
        const int nig = wgm * nN, gid = wgid / nig, fm = gid * wgm, gsz = (nM - fm) < wgm ? (nM - fm) : wgm;
        u.pm = fm + ((wgid % nig) % gsz); u.pn = (wgid % nig) / gsz; return true;
    }
    __device__ __forceinline__ void a_ready(const Unit&) const {}
    __device__ __forceinline__ void done(const Unit&) const {}
};
typedef __bf16 bf16x2_t __attribute__((ext_vector_type(2)));
__device__ __forceinline__ unsigned cvt_pk_bf16(float lo, float hi) { bf16x2_t r; r.x = (__bf16)lo; r.y = (__bf16)hi; return __builtin_bit_cast(unsigned, r); }
struct EpiBf16P {
    static constexpr bool PERM = true, AFTER_DRAIN = false;
    bf16_t* O; int ldc;
    __device__ __forceinline__ void operator()(const f32x4 (&acc)[2][2][4][2], const Unit& u, int wr, int wc, int fr, int fq) const {
        const int row0 = u.pm * BM + wr * 64 + fr, col0 = u.pn * BM + wc * 32 + 8 * fq;
#pragma unroll
        for (int ai = 0; ai < 2; ++ai)
#pragma unroll
            for (int m = 0; m < 4; ++m) { bf16_t* rowp = O + (size_t)(row0 + ai * HALF + m * 16) * ldc + col0;
#pragma unroll
                for (int bj = 0; bj < 2; ++bj) { const f32x4 v0 = acc[ai][bj][m][0], v1 = acc[ai][bj][m][1];
                    u32x4 w; w.x = cvt_pk_bf16(v0[0], v0[1]); w.y = cvt_pk_bf16(v0[2], v0[3]); w.z = cvt_pk_bf16(v1[0], v1[1]); w.w = cvt_pk_bf16(v1[2], v1[3]);
                    *(u32x4*)(rowp + bj * HALF) = w; } }
    }
};
struct EpiResid {
    static constexpr bool PERM = false, AFTER_DRAIN = false;
    float* Z; const float* X; const float* gate; float alpha;
    __device__ __forceinline__ void operator()(const f32x4 (&acc)[2][2][4][2], const Unit& u, int wr, int wc, int fr, int fq) const {
        const int row0 = u.pm * BM + wr * 64 + fr, col0 = u.pn * BM + wc * 32 + 4 * fq;
        const float* gb = gate + (size_t)(u.pm >> 3) * (6 * 2048) + col0;
        f32x4 gv[2][2];
#pragma unroll
        for (int bj = 0; bj < 2; ++bj)
#pragma unroll
            for (int n = 0; n < 2; ++n) gv[bj][n] = *(const f32x4*)(gb + bj * HALF + n * 16) + 1.0f;
#pragma unroll
        for (int ai = 0; ai < 2; ++ai)
#pragma unroll
            for (int m = 0; m < 4; ++m) { const size_t off = (size_t)(row0 + ai * HALF + m * 16) * 2048 + col0;
#pragma unroll
                for (int bj = 0; bj < 2; ++bj)
#pragma unroll
                    for (int n = 0; n < 2; ++n) { const f32x4 xv = *(const f32x4*)(X + off + bj * HALF + n * 16);
                        *(f32x4*)(Z + off + bj * HALF + n * 16) = xv * alpha + gv[bj][n] * acc[ai][bj][m][n]; }
                asm volatile("" ::: "memory"); }
    }
};
#ifndef PG8_NT
#define PG8_NT 0
#endif
#if PG8_NT
#define PG8_ST(TY, p, v) __builtin_nontemporal_store((v), (TY*)(p))
#else
#define PG8_ST(TY, p, v) (*(TY*)(p) = (v))
#endif
__device__ __forceinline__ f32x4 acc_i2f(const f32x4 v) { const i32x4 iv = __builtin_bit_cast(i32x4, v); return __builtin_convertvector(iv, f32x4); }
struct EpiBf16PS {
    static constexpr bool PERM = true, AFTER_DRAIN = false;
    bf16_t* O; int ldc; const float* sa; const float* sb;
    __device__ __forceinline__ void operator()(const f32x4 (&acc)[2][2][4][2], const Unit& u, int wr, int wc, int fr, int fq) const {
        const int row0 = u.pm * BM + wr * 64 + fr, col0 = u.pn * BM + wc * 32 + 8 * fq;
        f32x4 sbv[2][2];
#pragma unroll
        for (int bj = 0; bj < 2; ++bj)
#pragma unroll
            for (int n = 0; n < 2; ++n) sbv[bj][n] = *(const f32x4*)(sb + col0 + bj * HALF + 4 * n);
#pragma unroll
        for (int ai = 0; ai < 2; ++ai)
#pragma unroll
            for (int m = 0; m < 4; ++m) { const int row = row0 + ai * HALF + m * 16; bf16_t* rowp = O + (size_t)row * ldc + col0; const float sar = sa[row];
#pragma unroll
                for (int bj = 0; bj < 2; ++bj) { const f32x4 v0 = acc_i2f(acc[ai][bj][m][0]) * (sbv[bj][0] * sar), v1 = acc_i2f(acc[ai][bj][m][1]) * (sbv[bj][1] * sar);
                    u32x4 w; w.x = cvt_pk_bf16(v0[0], v0[1]); w.y = cvt_pk_bf16(v0[2], v0[3]); w.z = cvt_pk_bf16(v1[0], v1[1]); w.w = cvt_pk_bf16(v1[2], v1[3]);
                    PG8_ST(u32x4, rowp + bj * HALF, w); } }
    }
};
struct EpiResidS {
    static constexpr bool PERM = false, AFTER_DRAIN = false;
    float* Z; const float* X; const float* gate; const float* sa; const float* sb; float alpha;
    __device__ __forceinline__ void operator()(const f32x4 (&acc)[2][2][4][2], const Unit& u, int wr, int wc, int fr, int fq) const {
        const int row0 = u.pm * BM + wr * 64 + fr, col0 = u.pn * BM + wc * 32 + 4 * fq;
        const float* gb = gate + (size_t)(u.pm >> 3) * (6 * 2048) + col0;
        f32x4 gv[2][2];
#pragma unroll
        for (int bj = 0; bj < 2; ++bj)
#pragma unroll
            for (int n = 0; n < 2; ++n) gv[bj][n] = (*(const f32x4*)(gb + bj * HALF + n * 16) + 1.0f) * *(const f32x4*)(sb + col0 + bj * HALF + n * 16);
#pragma unroll
        for (int ai = 0; ai < 2; ++ai)
#pragma unroll
            for (int m = 0; m < 4; ++m) { const int row = row0 + ai * HALF + m * 16; const size_t off = (size_t)row * 2048 + col0; const float sar = sa[row];
#pragma unroll
                for (int bj = 0; bj < 2; ++bj)
#pragma unroll
                    for (int n = 0; n < 2; ++n) { const f32x4 xv = *(const f32x4*)(X + off + bj * HALF + n * 16);
                        PG8_ST(f32x4, Z + off + bj * HALF + n * 16, xv * alpha + (gv[bj][n] * sar) * acc_i2f(acc[ai][bj][m][n])); }
                asm volatile("" ::: "memory"); }
    }
};
template <bool XB, bool ZB> struct EpiResidS16 {
    static constexpr bool PERM = true, AFTER_DRAIN = false;
    void* Z; const void* X; const float* gate; const float* sa; const float* sb; float alpha;
    __device__ __forceinline__ void operator()(const f32x4 (&acc)[2][2][4][2], const Unit& u, int wr, int wc, int fr, int fq) const {
        const int row0 = u.pm * BM + wr * 64 + fr, col0 = u.pn * BM + wc * 32 + 8 * fq;
        const float* gb = gate + (size_t)(u.pm >> 3) * (6 * 2048) + col0;
        f32x4 gv[2][2];
#pragma unroll
        for (int bj = 0; bj < 2; ++bj)
#pragma unroll
            for (int n = 0; n < 2; ++n) gv[bj][n] = (*(const f32x4*)(gb + bj * HALF + 4 * n) + 1.0f) * *(const f32x4*)(sb + col0 + bj * HALF + 4 * n);
#pragma unroll
        for (int ai = 0; ai < 2; ++ai)
#pragma unroll
            for (int m = 0; m < 4; ++m) { const int row = row0 + ai * HALF + m * 16; const size_t off = (size_t)row * 2048 + col0; const float sar = sa[row];
#pragma unroll
                for (int bj = 0; bj < 2; ++bj) { f32x4 x0, x1;
                    if constexpr (XB) { const u32x4 xw = *(const u32x4*)((const bf16_t*)X + off + bj * HALF);
                        x0 = (f32x4){__uint_as_float(xw.x << 16), __uint_as_float(xw.x & 0xffff0000u), __uint_as_float(xw.y << 16), __uint_as_float(xw.y & 0xffff0000u)};
                        x1 = (f32x4){__uint_as_float(xw.z << 16), __uint_as_float(xw.z & 0xffff0000u), __uint_as_float(xw.w << 16), __uint_as_float(xw.w & 0xffff0000u)}; }
                    else { x0 = *(const f32x4*)((const float*)X + off + bj * HALF); x1 = *(const f32x4*)((const float*)X + off + bj * HALF + 4); }
                    const f32x4 v0 = x0 * alpha + (gv[bj][0] * sar) * acc_i2f(acc[ai][bj][m][0]), v1 = x1 * alpha + (gv[bj][1] * sar) * acc_i2f(acc[ai][bj][m][1]);
                    if constexpr (ZB) { u32x4 w; w.x = cvt_pk_bf16(v0[0], v0[1]); w.y = cvt_pk_bf16(v0[2], v0[3]); w.z = cvt_pk_bf16(v1[0], v1[1]); w.w = cvt_pk_bf16(v1[2], v1[3]);
                        PG8_ST(u32x4, (bf16_t*)Z + off + bj * HALF, w); }
                    else { PG8_ST(f32x4, (float*)Z + off + bj * HALF, v0); PG8_ST(f32x4, (float*)Z + off + bj * HALF + 4, v1); } }
                asm volatile("" ::: "memory"); }
    }
};
template <class Epi, class Sched, bool ALIGN_EPI = false, bool SP2 = false, bool I8 = false>
__device__ __forceinline__ void gemm_phase(PG8_LAS unsigned char* lds, const Gemm g, const Sched& S, const Epi& E, const int tid_in) {
    const int tid = tid_in, wid = __builtin_amdgcn_readfirstlane(tid >> 6), lane = tid & 63, wr = wid >> 2, wc = wid & 3, fr = lane & 15, fq = lane >> 4;
    const int K = g.K, nt = K / BK;
    const int krot = ((nt & (nt - 1)) == 0) ? (S.krot & (nt - 1)) : 0;
#define PG8_KOFS(t) ((size_t)(((t) + krot) & (nt - 1)) * kstep)
    unsigned voffA[2], voffB[2];
#pragma unroll
    for (int i = 0; i < 2; ++i) { int R, C; stage_rc(tid * 16 + i * 8192, R, C); const int Rb = Epi::PERM ? ((R & ~31) + perm32(R & 31)) : R;
        voffA[i] = (unsigned)(R * K + C) * 2u; voffB[i] = (unsigned)(Rb * K + C) * 2u; }
    const size_t kstep = (size_t)(BK * 2);
    const size_t hstep = (size_t)HALF * K * 2;
    const size_t tstep = 2 * hstep;
    const unsigned ldsw = (unsigned)wid * 1024u;
    const int aoff = lds_byte(wr * 64 + fr, fq * 8), boff = lds_byte(wc * 32 + fr, fq * 8);
#define PG8_SA(b, h) (((b) * 2 + (h)) * HTB)
#define PG8_SB(b, h) ((4 + (b) * 2 + (h)) * HTB)
#define PG8_STAGE(bufoff, gbase, voff) do { _Pragma("unroll") for (int _i = 0; _i < 2; ++_i) \
        __builtin_amdgcn_global_load_lds((const unsigned*)((const char*)(gbase) + (voff)[_i]), (PG8_LAS unsigned*)(lds + (bufoff) + ldsw + _i * 8192), 16, 0, 0); } while (0)
#define PG8_LDA(dst, b, h) do { _Pragma("unroll") for (int m = 0; m < 4; ++m) _Pragma("unroll") for (int k = 0; k < 2; ++k) dst[m][k] = *(const PG8_LAS bf16x8*)(lds + PG8_SA(b, h) + aoff + m * 2048 + k * 1024); } while (0)
#define PG8_LDB(dst, b, h) do { _Pragma("unroll") for (int n = 0; n < 2; ++n) _Pragma("unroll") for (int k = 0; k < 2; ++k) dst[n][k] = *(const PG8_LAS bf16x8*)(lds + PG8_SB(b, h) + boff + n * 2048 + k * 1024); } while (0)
#define PG8_MMA(ai, bj, At, Bt) do { __builtin_amdgcn_s_setprio(1); _Pragma("unroll") for (int m = 0; m < 4; ++m) _Pragma("unroll") for (int n = 0; n < 2; ++n) _Pragma("unroll") for (int k = 0; k < 2; ++k) \
        { if constexpr (I8) acc[ai][bj][m][n] = __builtin_bit_cast(f32x4, __builtin_amdgcn_mfma_i32_16x16x64_i8(__builtin_bit_cast(i32x4, Bt[n][k]), __builtin_bit_cast(i32x4, At[m][k]), __builtin_bit_cast(i32x4, acc[ai][bj][m][n]), 0, 0, 0)); \
          else acc[ai][bj][m][n] = __builtin_amdgcn_mfma_f32_16x16x32_bf16(Bt[n][k], At[m][k], acc[ai][bj][m][n], 0, 0, 0); } __builtin_amdgcn_s_setprio(0); } while (0)
#define PG8_WAIT_V(n) asm volatile("s_waitcnt vmcnt(" #n ")" ::: "memory")
#define PG8_WAIT_L(n) asm volatile("s_waitcnt lgkmcnt(" #n ")" ::: "memory")
#define PG8_BAR __builtin_amdgcn_s_barrier()
#define PG8_SCHED __builtin_amdgcn_sched_barrier(0)
    Unit cur, nxt; int ui = 0;
    if (!S.next(0, cur)) return;
    f32x4 acc[2][2][4][2];
#pragma unroll
    for (int a = 0; a < 2; ++a)
#pragma unroll
        for (int b = 0; b < 2; ++b)
#pragma unroll
            for (int m = 0; m < 4; ++m)
#pragma unroll
                for (int n = 0; n < 2; ++n) acc[a][b][m][n] = (f32x4){0.f, 0.f, 0.f, 0.f};
    bf16x8 At[4][2], B0[2][2], B1[2][2];
    const char* cA = (const char*)g.A + (size_t)cur.pm * tstep; const char* cB = (const char*)g.Bt + (size_t)cur.pn * tstep;
    S.a_ready(cur);
    if constexpr (SP2) {
        PG8_STAGE(PG8_SB(0, 0), cB + PG8_KOFS(0), voffB); PG8_STAGE(PG8_SB(0, 1), cB + hstep + PG8_KOFS(0), voffB); PG8_STAGE(PG8_SA(0, 0), cA + PG8_KOFS(0), voffA); PG8_STAGE(PG8_SA(0, 1), cA + hstep + PG8_KOFS(0), voffA);
        if (wr == 1) PG8_BAR;
        PG8_WAIT_V(2); PG8_BAR;
        PG8_STAGE(PG8_SB(1, 0), cB + PG8_KOFS(1), voffB); PG8_STAGE(PG8_SA(1, 0), cA + PG8_KOFS(1), voffA); PG8_STAGE(PG8_SB(1, 1), cB + hstep + PG8_KOFS(1), voffB);
        PG8_WAIT_V(6); PG8_BAR;
    } else {
        PG8_STAGE(PG8_SB(0, 0), cB + PG8_KOFS(0), voffB); PG8_STAGE(PG8_SA(0, 0), cA + PG8_KOFS(0), voffA); PG8_STAGE(PG8_SB(0, 1), cB + hstep + PG8_KOFS(0), voffB); PG8_STAGE(PG8_SA(0, 1), cA + hstep + PG8_KOFS(0), voffA);
        if (wr == 1) PG8_BAR;
        PG8_WAIT_V(4); PG8_BAR;
        PG8_STAGE(PG8_SB(1, 0), cB + PG8_KOFS(1), voffB); PG8_STAGE(PG8_SA(1, 0), cA + PG8_KOFS(1), voffA); PG8_STAGE(PG8_SB(1, 1), cB + hstep + PG8_KOFS(1), voffB);
        PG8_WAIT_V(6); PG8_BAR;
    }
    for (;;) {
        const bool has_next = S.next(ui + 1, nxt);
        const char* nA = has_next ? (const char*)g.A + (size_t)nxt.pm * tstep : cA; const char* nB = has_next ? (const char*)g.Bt + (size_t)nxt.pn * tstep : cB;
#ifdef PG8_KREP
        for (int kr_ = 0; kr_ < PG8_KREP; ++kr_) {
        if (kr_) {
#pragma unroll
        for (int a = 0; a < 2; ++a)
#pragma unroll
            for (int b = 0; b < 2; ++b)
#pragma unroll
                for (int m = 0; m < 4; ++m)
#pragma unroll
                    for (int n = 0; n < 2; ++n) acc[a][b][m][n] = (f32x4){0.f, 0.f, 0.f, 0.f}; }
        const char* nA_ = (kr_ + 1 < PG8_KREP) ? cA : nA; const char* nB_ = (kr_ + 1 < PG8_KREP) ? cB : nB;
#else
        const char* nA_ = nA; const char* nB_ = nB;
#endif
        for (int t = 0; t < nt; t += 2) {
            const bool last = (t == nt - 2);
            const char* a1 = cA + PG8_KOFS(t + 1);
            const char* a2 = (last ? nA_ : cA) + PG8_KOFS(t + 2); const char* b2 = (last ? nB_ : cB) + PG8_KOFS(t + 2);
            const char* a3 = (last ? nA_ : cA) + PG8_KOFS(t + 3); const char* b3 = (last ? nB_ : cB) + PG8_KOFS(t + 3);
            if (last && has_next) S.a_ready(nxt);
            if constexpr (SP2) {
            PG8_LDB(B0, 0, 0); PG8_LDB(B1, 0, 1); PG8_SCHED; PG8_LDA(At, 0, 0); PG8_STAGE(PG8_SA(1, 1), a1 + hstep, voffA);
            PG8_WAIT_V(8); PG8_WAIT_L(0); PG8_BAR; PG8_MMA(0, 0, At, B0); PG8_MMA(0, 1, At, B1); PG8_BAR; PG8_SCHED;
            PG8_LDA(At, 0, 1); PG8_STAGE(PG8_SB(0, 0), b2, voffB); PG8_STAGE(PG8_SB(0, 1), b2 + hstep, voffB); PG8_STAGE(PG8_SA(0, 0), a2, voffA);
            PG8_WAIT_V(8); PG8_WAIT_L(0); PG8_BAR; PG8_MMA(1, 0, At, B0); PG8_MMA(1, 1, At, B1); PG8_BAR; PG8_SCHED;
            PG8_LDB(B0, 1, 0); PG8_LDB(B1, 1, 1); PG8_SCHED; PG8_LDA(At, 1, 0); PG8_STAGE(PG8_SA(0, 1), a2 + hstep, voffA);
            PG8_WAIT_V(8); PG8_WAIT_L(0); PG8_BAR; PG8_MMA(0, 0, At, B0); PG8_MMA(0, 1, At, B1); PG8_BAR; PG8_SCHED;
            PG8_LDA(At, 1, 1); PG8_STAGE(PG8_SB(1, 0), b3, voffB); PG8_STAGE(PG8_SB(1, 1), b3 + hstep, voffB); PG8_STAGE(PG8_SA(1, 0), a3, voffA);
            PG8_WAIT_V(8); PG8_WAIT_L(0); PG8_BAR; PG8_MMA(1, 0, At, B0); PG8_MMA(1, 1, At, B1); PG8_BAR; PG8_SCHED;
            } else {
            PG8_LDB(B0, 0, 0); PG8_SCHED; PG8_LDA(At, 0, 0); PG8_STAGE(PG8_SA(1, 1), a1 + hstep, voffA);
            PG8_WAIT_L(8); PG8_BAR; PG8_WAIT_L(0); PG8_MMA(0, 0, At, B0); PG8_BAR; PG8_SCHED;
            PG8_LDB(B1, 0, 1); PG8_STAGE(PG8_SB(0, 0), b2, voffB);
            PG8_BAR; PG8_WAIT_L(0); PG8_MMA(0, 1, At, B1); PG8_BAR;
            PG8_LDA(At, 0, 1); PG8_STAGE(PG8_SA(0, 0), a2, voffA);
            PG8_BAR; PG8_WAIT_L(0); PG8_MMA(1, 0, At, B0); PG8_BAR; PG8_SCHED;
            PG8_STAGE(PG8_SB(0, 1), b2 + hstep, voffB);
            PG8_WAIT_V(6); PG8_BAR; PG8_MMA(1, 1, At, B1); PG8_BAR;
            PG8_LDB(B0, 1, 0); PG8_SCHED; PG8_LDA(At, 1, 0); PG8_STAGE(PG8_SA(0, 1), a2 + hstep, voffA);
            PG8_WAIT_L(8); PG8_BAR; PG8_WAIT_L(0); PG8_MMA(0, 0, At, B0); PG8_BAR; PG8_SCHED;
            PG8_LDB(B1, 1, 1); PG8_STAGE(PG8_SB(1, 0), b3, voffB);
            PG8_BAR; PG8_WAIT_L(0); PG8_MMA(0, 1, At, B1); PG8_BAR;
            PG8_LDA(At, 1, 1); PG8_STAGE(PG8_SA(1, 0), a3, voffA);
            PG8_BAR; PG8_WAIT_L(0); PG8_MMA(1, 0, At, B0); PG8_BAR; PG8_SCHED;
            PG8_STAGE(PG8_SB(1, 1), b3 + hstep, voffB);
            PG8_WAIT_V(6); PG8_BAR; PG8_MMA(1, 1, At, B1); PG8_BAR;
            }
        }
#ifdef PG8_KREP
        }
#endif
        if constexpr (ALIGN_EPI) { if (wr == 0) PG8_BAR; }
#ifdef PG8_EPI2
        if constexpr (!Epi::AFTER_DRAIN) { E(acc, cur, wr, wc, fr, fq); asm volatile("" ::: "memory"); }
#endif
        if constexpr (!Epi::AFTER_DRAIN) { E(acc, cur, wr, wc, fr, fq); S.done(cur); }
        if (!has_next) break;
#pragma unroll
        for (int a = 0; a < 2; ++a)
#pragma unroll
            for (int b = 0; b < 2; ++b)
#pragma unroll
                for (int m = 0; m < 4; ++m)
#pragma unroll
                    for (int n = 0; n < 2; ++n) acc[a][b][m][n] = (f32x4){0.f, 0.f, 0.f, 0.f};
        cur = nxt; cA = nA; cB = nB; ++ui;
        if constexpr (ALIGN_EPI) { if (wr == 1) PG8_BAR; }
    }
    PG8_WAIT_V(0);
    if constexpr (!ALIGN_EPI) { if (wr == 0) PG8_BAR; }
    PG8_BAR;
    if constexpr (Epi::AFTER_DRAIN) { E.fused(acc, cur, wr, wc, fr, fq, lds, wid, lane); S.done(cur); }
#undef PG8_SA
#undef PG8_SB
#undef PG8_STAGE
#undef PG8_LDA
#undef PG8_LDB
#undef PG8_MMA
#undef PG8_WAIT_V
#undef PG8_WAIT_L
#undef PG8_BAR
#undef PG8_SCHED
#undef PG8_KOFS
}
}
#define XB_TMO      128
#define XB_XCNT(j)  (256  + 64 * (j))
#define XB_XSUB(j)  (1280 + 64 * (j))
#define XB_XGEN(j)  (2304 + 64 * (j))
#define XB_TOP      3328
#define XB_TOPGEN   3392
#define XCD_BAR_WORDS 3456
#define XB_SPIN_CAP (1u << 18)
#define LAS __attribute__((address_space(3)))

__device__ __forceinline__ unsigned xb_ld(unsigned* p)              { return __hip_atomic_load(p, __ATOMIC_RELAXED, __HIP_MEMORY_SCOPE_AGENT); }
__device__ __forceinline__ unsigned xb_add(unsigned* p, unsigned v) { return __hip_atomic_fetch_add(p, v, __ATOMIC_RELAXED, __HIP_MEMORY_SCOPE_AGENT); }
__device__ __forceinline__ unsigned xb_xcc_id() { return (unsigned)__builtin_amdgcn_s_getreg((3 << 11) | 20) & 0xFu; }
#define XB_SPIN(cond, bar) do { unsigned _sp = 0; while (cond) { __builtin_amdgcn_s_sleep(1); \
    if ((++_sp & 255u) == 0u) { if (xb_ld(&(bar)[XB_TMO])) break; if (_sp > XB_SPIN_CAP) { atomicAdd(&(bar)[XB_TMO], 1u); break; } } } } while (0)

struct XcdBarrier {
    unsigned* bar; unsigned x;
    volatile LAS unsigned* st;
};

__device__ __forceinline__ XcdBarrier xcd_barrier_post(unsigned* bar, volatile LAS unsigned* st) {
    XcdBarrier b; b.bar = bar; b.x = xb_xcc_id(); b.st = st;
    if (threadIdx.x == 0) (void)xb_add(&bar[XB_XCNT(b.x)], 1u);
    return b;
}
__device__ __forceinline__ void xcd_barrier_complete(unsigned* bar, unsigned x, unsigned& nloc, unsigned& nx) {
    const unsigned G = gridDim.x * gridDim.y * gridDim.z;
    unsigned sum, cnt, mine, sp = 0u;
    for (;;) {
        sum = 0u; cnt = 0u; mine = 0u;
#pragma unroll
        for (unsigned j = 0; j < 16; ++j) { const unsigned c = xb_ld(&bar[XB_XCNT(j)]); sum += c; cnt += (c > 0u) ? 1u : 0u; mine = (j == x) ? c : mine; }
        if (sum == G) break;
        __builtin_amdgcn_s_sleep(1);
        if ((++sp & 255u) == 0u) { if (xb_ld(&bar[XB_TMO])) break; if (sp > XB_SPIN_CAP) { atomicAdd(&bar[XB_TMO], 1u); break; } }
    }
    nloc = mine > 0u ? mine : 1u; nx = cnt > 0u ? cnt : 1u;
}

__device__ __forceinline__ void xcd_barrier(const XcdBarrier& b) {
    asm volatile("s_waitcnt vmcnt(0)" ::: "memory");
    __syncthreads();
    if (threadIdx.x == 0) {
        unsigned* bar = b.bar;
        __builtin_amdgcn_s_waitcnt(0);
        unsigned nloc = b.st[0], nx = b.st[1];
        if (nloc == 0u) { xcd_barrier_complete(bar, b.x, nloc, nx); b.st[0] = nloc; b.st[1] = nx; }
        const unsigned old = xb_add(&bar[XB_XSUB(b.x)], 1u);
        const unsigned gen = old / nloc;
        if (old + 1u == (gen + 1u) * nloc) {
            __builtin_amdgcn_fence(__ATOMIC_RELEASE, "agent");
            asm volatile("s_waitcnt vmcnt(0)" ::: "memory");
            const unsigned og = xb_add(&bar[XB_TOP], 1u);
            const unsigned tg = og / nx;
            if (og + 1u == (tg + 1u) * nx) xb_add(&bar[XB_TOPGEN], 1u);
            else XB_SPIN(xb_ld(&bar[XB_TOPGEN]) == tg, bar);
            __builtin_amdgcn_fence(__ATOMIC_ACQUIRE, "agent");
            xb_add(&bar[XB_XGEN(b.x)], 1u);
            asm volatile("s_waitcnt vmcnt(0)" ::: "memory");
        } else {
            XB_SPIN(xb_ld(&bar[XB_XGEN(b.x)]) == gen, bar);
            __builtin_amdgcn_fence(__ATOMIC_ACQUIRE, "agent");
            asm volatile("s_waitcnt vmcnt(0)" ::: "memory");
        }
    }
    __syncthreads();
}
constexpr int D = 2048, NB = 8, SEQ = 2048, NL = 4, T = NB * SEQ;
constexpr int NCH = SEQ / 64, NCHUNK = T / 64;
constexpr int GKW = 512, RANK = 16;
constexpr int INW = 6160, NP = 6144;
constexpr int NE = 16384;
constexpr float ALPHA = 1.6817928305074290f, EPS = 1e-5f;
constexpr int PQ = 0, PK = 512, PV = 1024, PR = 2048, PCB = 3072, PCC = 4096, PCH = 5120;
constexpr int NWAVES = 8, NTHREADS = 512;
#ifndef WGM_IN
#define WGM_IN 4
#endif
#ifndef WGM_OUT
#define WGM_OUT 4
#endif
#ifndef WGM_WQ
#define WGM_WQ 4
#endif
#ifndef TAB4
#define TAB4 1
#endif
constexpr int NPHASES = 2 + 7 * NL;

constexpr size_t MiB = 1u << 20;
constexpr size_t WS_CTL = 0, CTL_ZERO_BYTES = 1 * MiB;
constexpr size_t WS_MOD = 1 * MiB, WS_PART = 3 * MiB, WS_KEYS = 15 * MiB, WS_DTOT = 17 * MiB, WS_WIN = 18 * MiB, WS_WOUT = 115 * MiB, WS_WQ = 147 * MiB;
constexpr size_t WS_UT = 179 * MiB, WS_VT = 435 * MiB, WS_H = 691 * MiB, WS_PROJ = 755 * MiB, WS_E = 947 * MiB, WS_OGLA = 979 * MiB, WS_Y = 1043 * MiB;
constexpr size_t WS_Z = 1107 * MiB, WS_X1 = 1235 * MiB, WS_X = 1363 * MiB, WS_Q = 1491 * MiB, WS_H2 = 1555 * MiB, WS_HQ8 = 1619 * MiB, WS_H8 = 1659 * MiB, WS_WIN8 = 1691 * MiB, WS_WOUT8 = 1739 * MiB, WS_WQ8 = 1755 * MiB, WS_Y8 = 1771 * MiB, WS_H28 = 1803 * MiB, WS_END = 1835 * MiB;
constexpr size_t WS_SU = 17 * MiB + 512 * 1024, WS_SV = 17 * MiB + 768 * 1024, WS_HSC = 2 * MiB + 640 * 1024;
static_assert(WS_WIN + (size_t)NL * INW * D * 2 <= WS_WOUT && WS_PART + (size_t)NL * 8 * NB * 6 * D * 4 <= WS_KEYS && WS_MOD + (size_t)NL * NB * 6 * D * 4 <= WS_PART, "ws map");
constexpr size_t WS_SAH = WS_SU, WS_SAY = WS_SU + 65536, WS_SB = WS_SV; constexpr int SBL = NP + 2 * D;
constexpr size_t WS_SBA = WS_SB + (size_t)NL * SBL * 4, WS_ALR8 = WS_SU + 131072;
#ifndef KROT_A
#define KROT_A 0
#endif
#ifndef KROT_B
#define KROT_B 0
#endif
#define KROT(c) (KROT_A * (((c) >> 3) & 3) + KROT_B * ((c) >> 5))
#ifndef RES16
#define RES16 1
#endif
#ifndef RES16_X
#define RES16_X RES16
#endif
#ifndef RES16_Z
#define RES16_Z RES16
#endif
#ifndef RES16_X1
#define RES16_X1 RES16
#endif
#ifndef I8_GATE
#define I8_GATE 1
#endif
#ifndef I8_WQ
#define I8_WQ 1
#endif
#ifndef I8_IN
#define I8_IN 1
#endif
#ifndef I8_OUT
#define I8_OUT 1
#endif
constexpr int CW_BAR = 4096;

constexpr int RING_OFF = 0, RING_BYTES = 131072, LDSCTL_OFF = RING_BYTES, LDS_BYTES = 147456;

#define GAS __attribute__((address_space(1)))
typedef unsigned short bf16;
typedef unsigned v4u __attribute__((ext_vector_type(4)));
typedef unsigned v2u __attribute__((ext_vector_type(2)));
typedef int v4i __attribute__((ext_vector_type(4)));
typedef float f32x4 __attribute__((ext_vector_type(4)));
typedef float f32x16 __attribute__((ext_vector_type(16)));
typedef short bf16x8 __attribute__((ext_vector_type(8)));
typedef __bf16 bf16x2v __attribute__((ext_vector_type(2)));
#define LDS_WAIT() asm volatile("s_waitcnt lgkmcnt(0)" ::: "memory")

__device__ __forceinline__ unsigned pk2(float lo, float hi) { return pg8::cvt_pk_bf16(lo, hi); }
__device__ __forceinline__ float dot2bf(unsigned w, unsigned x, float acc) { return __builtin_amdgcn_fdot2_f32_bf16(__builtin_bit_cast(bf16x2v, w), __builtin_bit_cast(bf16x2v, x), acc, false); }
__device__ __forceinline__ float bflo(unsigned u) { return __uint_as_float(u << 16); }
__device__ __forceinline__ float bfhi(unsigned u) { return __uint_as_float(u & 0xffff0000u); }
__device__ __forceinline__ float silu_f(float x) { return x / (1.0f + __expf(-x)); }
__device__ __forceinline__ float logsigmoid_f(float x) { return fminf(x, 0.0f) - log1pf(__expf(-fabsf(x))); }
__device__ __forceinline__ float logsigmoid_fast(float x) { return fminf(x, 0.0f) - __logf(1.0f + __expf(-fabsf(x))); }
__device__ __forceinline__ float gelu_tanh_f(float x) { const float u = 0.7978845608028654f * (x + 0.044715f * x * x * x); return 0.5f * x * (1.0f + tanhf(u)); }
__device__ __forceinline__ unsigned pack_i8(float a, float b, float c, float d) {
    const int q0 = (int)__builtin_rintf(a), q1 = (int)__builtin_rintf(b), q2 = (int)__builtin_rintf(c), q3 = (int)__builtin_rintf(d);
    return (unsigned)(q0 & 255) | ((unsigned)(q1 & 255) << 8) | ((unsigned)(q2 & 255) << 16) | ((unsigned)(q3 & 255) << 24); }
__device__ __forceinline__ float wave_sum(float v) {
#pragma unroll
    for (int o = 1; o < 64; o <<= 1) v += __shfl_xor(v, o);
    return v;
}

struct Args { const float* in[19]; float* out; unsigned char* ws; int ph_lo, ph_hi; };

__device__ __forceinline__ void transpose_item(const float* W, int ldw, int col0, bf16* WTrows, int k0, int nvalid, LAS float* scr, int lane) {
    const int n = lane & 31;
    float tv[32];
#pragma unroll
    for (int i = 0; i < 32; ++i) { const int kk = 2 * i + (lane >> 5); tv[i] = (n < nvalid) ? W[(size_t)(k0 + kk) * ldw + col0 + n] : 0.f; }
#pragma unroll
    for (int i = 0; i < 32; ++i) { const int kk = 2 * i + (lane >> 5); scr[kk * 33 + n] = tv[i]; }
    LDS_WAIT(); asm volatile("" ::: "memory");
    const int c = lane & 7;
#pragma unroll
    for (int j = 0; j < 4; ++j) { const int nn = (lane >> 3) + 8 * j; const LAS float* s = scr + (8 * c) * 33 + nn;
        v4u o; o.x = pk2(s[0 * 33], s[1 * 33]); o.y = pk2(s[2 * 33], s[3 * 33]); o.z = pk2(s[4 * 33], s[5 * 33]); o.w = pk2(s[6 * 33], s[7 * 33]);
        if (nn < nvalid) *(v4u*)(WTrows + (size_t)nn * D + k0 + 8 * c) = o; }
    LDS_WAIT(); asm volatile("" ::: "memory");
}
__device__ __forceinline__ void cvt_stream(const float* src, bf16* dst, size_t n4, size_t i0, size_t stride) {
    for (size_t i = i0; i < n4; i += stride) { const f32x4 v = ((const f32x4*)src)[i]; v2u o; o.x = pk2(v.x, v.y); o.y = pk2(v.z, v.w); ((v2u*)dst)[i] = o; }
}
__device__ __forceinline__ void ph_prologue_a(const Args& a, LAS unsigned char* lds, int tid, int lane, int wave, int bx, int G) {
    const int gw = bx * NWAVES + wave, NGW = G * NWAVES;
    LAS float* cact = (LAS float*)lds;
    for (int i = tid; i < NB * D; i += NTHREADS) { const int b = i / D, d = i % D; cact[d * 8 + b] = silu_f(a.in[1][i]); }
    __syncthreads();
    float* part = (float*)(a.ws + WS_PART);
    for (int it = gw; it < NL * 8 * 48; it += NGW) {
        const int cg = it % 48, dr = (it / 48) % 8, l = it / 384;
        f32x4 acc[8];
#pragma unroll
        for (int b = 0; b < 8; ++b) acc[b] = (f32x4){0.f, 0.f, 0.f, 0.f};
        const float* w = a.in[2] + ((size_t)l * D + dr * 256) * (6 * D) + cg * 256 + lane * 4;
#pragma unroll 4
        for (int d = 0; d < 256; ++d) {
            const f32x4 wv = *(const f32x4*)(w + (size_t)d * (6 * D));
            const f32x4 c0 = *(const LAS f32x4*)(cact + (dr * 256 + d) * 8), c1 = *(const LAS f32x4*)(cact + (dr * 256 + d) * 8 + 4);
            acc[0] += wv * c0.x; acc[1] += wv * c0.y; acc[2] += wv * c0.z; acc[3] += wv * c0.w;
            acc[4] += wv * c1.x; acc[5] += wv * c1.y; acc[6] += wv * c1.z; acc[7] += wv * c1.w;
        }
#pragma unroll
        for (int b = 0; b < 8; ++b) *(f32x4*)(part + (((size_t)l * 8 + dr) * NB + b) * (6 * D) + cg * 256 + lane * 4) = acc[b];
    }
    __syncthreads();
    LAS float* scr = (LAS float*)(lds + wave * 8448);
    bf16* winT = (bf16*)(a.ws + WS_WIN); bf16* woutT = (bf16*)(a.ws + WS_WOUT); bf16* wqT = (bf16*)(a.ws + WS_WQ);
    constexpr int IPL = 6144 + 32 + 2048 + 2048;
    for (int it = gw; it < NL * IPL; it += NGW) {
        const int l = it / IPL; int r = it % IPL;
        if (r < 6144) { const int nb = r % 192, kb = r / 192, n0 = nb * 32;
            transpose_item(a.in[4] + (size_t)l * D * INW, INW, n0 < 3072 ? n0 : n0 + 16, winT + ((size_t)l * INW + n0) * D, kb * 64, 32, scr, lane); continue; }
        r -= 6144;
        if (r < 32) { transpose_item(a.in[4] + (size_t)l * D * INW, INW, 3072, winT + ((size_t)l * INW + NP) * D, r * 64, 16, scr, lane); continue; }
        r -= 32;
        if (r < 2048) { const int nb = r % 64, kb = r / 64; transpose_item(a.in[10] + (size_t)l * D * D, D, nb * 32, woutT + ((size_t)l * D + nb * 32) * D, kb * 64, 32, scr, lane); continue; }
        r -= 2048;
        { const int nb = r % 64, kb = r / 64; transpose_item(a.in[13] + (size_t)l * D * D, D, nb * 32, wqT + ((size_t)l * D + nb * 32) * D, kb * 64, 32, scr, lane); }
    }
    const size_t i0 = (size_t)bx * NTHREADS + tid, stride = (size_t)G * NTHREADS;
    cvt_stream(a.in[14], (bf16*)(a.ws + WS_KEYS), (size_t)NL * 8 * 2 * 128 * 128 / 4, i0, stride);
#if TAB4
    __syncthreads();
    { LAS float* rowst = (LAS float*)(lds + wave * 8192);
      f32x4 vnx[8];
      if (gw < 2 * NL * NE) { const int tbl0 = gw / (NL * NE), r0 = gw % (NL * NE); const float* s0 = (tbl0 ? a.in[16] : a.in[15]) + (size_t)r0 * D;
#pragma unroll
          for (int c8 = 0; c8 < 8; ++c8) vnx[c8] = *(const f32x4*)(s0 + (c8 * 64 + lane) * 4); }
      for (int row = gw; row < 2 * NL * NE; row += NGW) {
        const int tbl = row / (NL * NE), r = row % (NL * NE);
#pragma unroll
        for (int c8 = 0; c8 < 8; ++c8) *(LAS f32x4*)(rowst + (c8 * 64 + lane) * 4) = vnx[c8];
        { const int rown = row + NGW < 2 * NL * NE ? row + NGW : row; const int tbln = rown / (NL * NE), rn = rown % (NL * NE); const float* sn = (tbln ? a.in[16] : a.in[15]) + (size_t)rn * D;
#pragma unroll
          for (int c8 = 0; c8 < 8; ++c8) vnx[c8] = *(const f32x4*)(sn + (c8 * 64 + lane) * 4); }
        LDS_WAIT(); asm volatile("" ::: "memory");
        unsigned char* tb = a.ws + (tbl ? WS_VT : WS_UT) + (size_t)r * 1152;
#pragma unroll
        for (int pass = 0; pass < 2; ++pass) { const int slot = lane + 64 * pass;
            if (slot < 72) { const int col0 = (slot >> 3) * 240 + (slot & 7) * 30;
                float x[30]; float mx = 0.f;
#pragma unroll
                for (int k = 0; k < 30; ++k) { x[k] = (col0 + k < D) ? rowst[col0 + k] : 0.f; mx = fmaxf(mx, fabsf(x[k])); }
                int code = 0; float inv = 0.f;
                if (mx > 0.f) { code = (int)ceilf(8.0f * log2f(mx * (1.0f / 7.0f))) + 128; code = code < 0 ? 0 : (code > 255 ? 255 : code); inv = __builtin_amdgcn_exp2f(16.0f - (float)code * 0.125f); }
                unsigned dw[4] = {0u, 0u, 0u, 0u};
#pragma unroll
                for (int kb = 0; kb < 15; ++kb) { int a0 = (int)__builtin_rintf(x[2 * kb] * inv), a1 = (int)__builtin_rintf(x[2 * kb + 1] * inv);
                    a0 = a0 < -7 ? -7 : (a0 > 7 ? 7 : a0); a1 = a1 < -7 ? -7 : (a1 > 7 ? 7 : a1);
                    dw[kb >> 2] |= ((unsigned)(a0 + 8) | ((unsigned)(a1 + 8) << 4)) << (8 * (kb & 3)); }
                dw[3] |= (unsigned)code << 24;
                *(v4u*)(tb + slot * 16) = (v4u){dw[0], dw[1], dw[2], dw[3]}; } }
        LDS_WAIT(); asm volatile("" ::: "memory");
      } }
#else
    for (int row = gw; row < 2 * NL * NE; row += NGW) {
        const int tbl = row / (NL * NE), r = row % (NL * NE);
        const float* src = (tbl ? a.in[16] : a.in[15]) + (size_t)r * D;
        f32x4 v[8]; float mx = 0.f;
#pragma unroll
        for (int c8 = 0; c8 < 8; ++c8) { v[c8] = *(const f32x4*)(src + (c8 * 64 + lane) * 4); mx = fmaxf(mx, fmaxf(fmaxf(fabsf(v[c8].x), fabsf(v[c8].y)), fmaxf(fabsf(v[c8].z), fabsf(v[c8].w)))); }
#pragma unroll
        for (int o = 1; o < 64; o <<= 1) mx = fmaxf(mx, __shfl_xor(mx, o));
        const float inv = mx > 0.f ? 127.0f / mx : 0.f; const int off = tbl ? 128 : 0;
        unsigned dw[8];
#pragma unroll
        for (int c8 = 0; c8 < 8; ++c8) { const int q0 = (int)__builtin_rintf(v[c8].x * inv) + off, q1 = (int)__builtin_rintf(v[c8].y * inv) + off, q2 = (int)__builtin_rintf(v[c8].z * inv) + off, q3 = (int)__builtin_rintf(v[c8].w * inv) + off;
            dw[c8] = (unsigned)(q0 & 255) | ((unsigned)(q1 & 255) << 8) | ((unsigned)(q2 & 255) << 16) | ((unsigned)(q3 & 255) << 24); }
        unsigned char* dst = a.ws + (tbl ? WS_VT : WS_UT) + (size_t)r * D;
        *(v4u*)(dst + lane * 16) = (v4u){dw[0], dw[1], dw[2], dw[3]}; *(v4u*)(dst + (64 + lane) * 16) = (v4u){dw[4], dw[5], dw[6], dw[7]};
        if (lane == 0) ((float*)(a.ws + (tbl ? WS_SV : WS_SU)))[r] = mx * (1.0f / 127.0f);
    }
#endif
}

__device__ __forceinline__ void ln_tail(const float (&z)[32], int t, int lane, const float* g, const float* bta, float* xout, const float* sh, const float* sc, bf16* hout, unsigned char* q8, float* q8s, LAS unsigned char* q8stage = nullptr, unsigned char* a8 = nullptr, float* a8s = nullptr, bf16* xb = nullptr) {
    float s = 0.f;
#pragma unroll
    for (int i = 0; i < 32; ++i) s += z[i];
    const float mu = wave_sum(s) * (1.0f / D);
    float q = 0.f;
#pragma unroll
    for (int i = 0; i < 32; ++i) { const float d = z[i] - mu; q += d * d; }
    const float rs = rsqrtf(wave_sum(q) * (1.0f / D) + EPS);
    float hv[32]; float mx = 0.f;
#pragma unroll
    for (int c = 0; c < 8; ++c) { const int col = (c * 64 + lane) * 4;
        const f32x4 g0 = *(const f32x4*)(g + col), b0 = *(const f32x4*)(bta + col);
        f32x4 x0;
        x0.x = (z[c * 4 + 0] - mu) * rs * g0.x + b0.x; x0.y = (z[c * 4 + 1] - mu) * rs * g0.y + b0.y; x0.z = (z[c * 4 + 2] - mu) * rs * g0.z + b0.z; x0.w = (z[c * 4 + 3] - mu) * rs * g0.w + b0.w;
        if (xb) { v2u o; o.x = pk2(x0.x, x0.y); o.y = pk2(x0.z, x0.w); *(v2u*)(xb + (size_t)t * D + col) = o; }
        else if (xout) *(f32x4*)(xout + (size_t)t * D + col) = x0;
        if (hout || q8 || a8) { const f32x4 s0 = *(const f32x4*)(sc + col), h0 = *(const f32x4*)(sh + col);
            hv[c * 4] = x0.x * (1.f + s0.x) + h0.x; hv[c * 4 + 1] = x0.y * (1.f + s0.y) + h0.y; hv[c * 4 + 2] = x0.z * (1.f + s0.z) + h0.z; hv[c * 4 + 3] = x0.w * (1.f + s0.w) + h0.w;
            if (hout) { v2u o; o.x = pk2(hv[c * 4], hv[c * 4 + 1]); o.y = pk2(hv[c * 4 + 2], hv[c * 4 + 3]);
                *(v2u*)(hout + (size_t)t * D + col) = o; }
            if (q8 || a8) mx = fmaxf(mx, fmaxf(fmaxf(fabsf(hv[c * 4]), fabsf(hv[c * 4 + 1])), fmaxf(fabsf(hv[c * 4 + 2]), fabsf(hv[c * 4 + 3])))); }
    }
    if (q8 || a8) {
#pragma unroll
        for (int o = 1; o < 64; o <<= 1) mx = fmaxf(mx, __shfl_xor(mx, o));
        const float qmax_ = (q8 && TAB4) ? 119.0f : 127.0f;
        const float inv = mx > 0.f ? qmax_ / mx : 0.f;
        unsigned dw[8];
#pragma unroll
        for (int c = 0; c < 8; ++c) { const int q0 = (int)__builtin_rintf(hv[c * 4] * inv), q1 = (int)__builtin_rintf(hv[c * 4 + 1] * inv), q2 = (int)__builtin_rintf(hv[c * 4 + 2] * inv), q3 = (int)__builtin_rintf(hv[c * 4 + 3] * inv);
            dw[c] = (unsigned)(q0 & 255) | ((unsigned)(q1 & 255) << 8) | ((unsigned)(q2 & 255) << 16) | ((unsigned)(q3 & 255) << 24); }
        if (a8) {
#pragma unroll
            for (int c = 0; c < 8; ++c) *(unsigned*)(a8 + (size_t)t * D + (c * 64 + lane) * 4) = dw[c];
            if (a8s && lane == 0) a8s[t] = mx / qmax_; }
        if (q8) {
#if TAB4
        { LAS unsigned* st32 = (LAS unsigned*)q8stage; LAS unsigned char* st8 = (LAS unsigned char*)q8stage;
#pragma unroll
          for (int i = 0; i < 9; ++i) st32[lane + 64 * i] = 0u;
          LDS_WAIT(); asm volatile("" ::: "memory");
#pragma unroll
          for (int c = 0; c < 8; ++c)
#pragma unroll
              for (int jp = 0; jp < 2; ++jp) { const int col = (c * 64 + lane) * 4 + 2 * jp, u = col / 240, r = col - u * 240, l7 = r / 30, k = r - l7 * 30;
                  const int q0 = (int)(signed char)((dw[c] >> (16 * jp)) & 255u), q1 = (int)(signed char)((dw[c] >> (16 * jp + 8)) & 255u);
                  const int l0 = ((q0 + 8) & 15) - 8, l1 = ((q1 + 8) & 15) - 8, h0 = (q0 - l0) >> 4, h1 = (q1 - l1) >> 4;
                  LAS unsigned char* sp = st8 + (u * 8 + l7) * 32 + (k >> 1);
                  sp[0] = (unsigned char)((l0 & 15) | ((l1 & 15) << 4)); sp[16] = (unsigned char)((h0 & 15) | ((h1 & 15) << 4)); }
          LDS_WAIT(); asm volatile("" ::: "memory");
          unsigned* d32 = (unsigned*)(q8 + (size_t)t * 2304);
#pragma unroll
          for (int i = 0; i < 9; ++i) d32[lane + 64 * i] = st32[lane + 64 * i];
          LDS_WAIT(); asm volatile("" ::: "memory"); }
#else
        unsigned char* dst = q8 + (size_t)t * D;
        *(v4u*)(dst + lane * 16) = (v4u){dw[0], dw[1], dw[2], dw[3]}; *(v4u*)(dst + (64 + lane) * 16) = (v4u){dw[4], dw[5], dw[6], dw[7]};
#endif
        if (lane == 0) q8s[t] = mx / qmax_; }
    }
}

__device__ __forceinline__ void ph_prologue_b(const Args& a, LAS unsigned char* lds, int tid, int lane, int wave, int bx, int G) {
    const float* part = (const float*)(a.ws + WS_PART); float* mod = (float*)(a.ws + WS_MOD);
    for (int i = bx * NTHREADS + tid; i < NL * NB * 6 * D / 4; i += G * NTHREADS) {
        const int idx = i * 4, e = idx % (6 * D), b = (idx / (6 * D)) % NB, l = idx / (6 * D * NB);
        f32x4 s = *(const f32x4*)(a.in[3] + l * 6 * D + e);
#pragma unroll
        for (int dr = 0; dr < 8; ++dr) s += *(const f32x4*)(part + (((size_t)l * 8 + dr) * NB + b) * (6 * D) + e);
        *(f32x4*)(mod + idx) = s;
    }
    LAS float* msh = (LAS float*)lds;
    bf16* hbuf = (bf16*)(a.ws + WS_H);
    for (int ch = bx; ch < NCHUNK; ch += G) {
        const int b = ch / NCH;
        for (int i = tid; i < 1024; i += NTHREADS) { const int e = i * 4;
            f32x4 s = *(const f32x4*)(a.in[3] + e);
#pragma unroll
            for (int dr = 0; dr < 8; ++dr) s += *(const f32x4*)(part + (((size_t)0 * 8 + dr) * NB + b) * (6 * D) + e);
            *(LAS f32x4*)(msh + e) = s; }
        __syncthreads();
        for (int i = 0; i < 8; ++i) { const int t = ch * 64 + wave * 8 + i;
            float hv[32]; float mx = 0.f;
#pragma unroll
            for (int c = 0; c < 4; ++c) { const int col = (c * 64 + lane) * 8;
                const f32x4 x0 = *(const f32x4*)(a.in[0] + (size_t)t * D + col), x1 = *(const f32x4*)(a.in[0] + (size_t)t * D + col + 4);
                const f32x4 h0 = *(const LAS f32x4*)(msh + col), h1 = *(const LAS f32x4*)(msh + col + 4), s0 = *(const LAS f32x4*)(msh + 2048 + col), s1 = *(const LAS f32x4*)(msh + 2048 + col + 4);
#pragma unroll
                for (int j = 0; j < 4; ++j) { hv[c * 8 + j] = x0[j] * (1.f + s0[j]) + h0[j]; hv[c * 8 + 4 + j] = x1[j] * (1.f + s1[j]) + h1[j]; }
                v4u o; o.x = pk2(hv[c * 8], hv[c * 8 + 1]); o.y = pk2(hv[c * 8 + 2], hv[c * 8 + 3]); o.z = pk2(hv[c * 8 + 4], hv[c * 8 + 5]); o.w = pk2(hv[c * 8 + 6], hv[c * 8 + 7]);
#if !I8_GATE
                *(v4u*)(hbuf + (size_t)t * D + col) = o;
#endif
#if RES16_X
                { v4u xo; xo.x = pk2(x0.x, x0.y); xo.y = pk2(x0.z, x0.w); xo.z = pk2(x1.x, x1.y); xo.w = pk2(x1.z, x1.w); *(v4u*)((bf16*)(a.ws + WS_X) + (size_t)t * D + col) = xo; }
#endif
#pragma unroll
                for (int j = 0; j < 8; ++j) mx = fmaxf(mx, fabsf(hv[c * 8 + j])); }
#pragma unroll
            for (int o = 1; o < 64; o <<= 1) mx = fmaxf(mx, __shfl_xor(mx, o));
            const float inv = mx > 0.f ? 127.0f / mx : 0.f;
#pragma unroll
            for (int c = 0; c < 4; ++c) { v2u o;
                o.x = pack_i8(hv[c * 8] * inv, hv[c * 8 + 1] * inv, hv[c * 8 + 2] * inv, hv[c * 8 + 3] * inv); o.y = pack_i8(hv[c * 8 + 4] * inv, hv[c * 8 + 5] * inv, hv[c * 8 + 6] * inv, hv[c * 8 + 7] * inv);
                *(v2u*)(a.ws + WS_H8 + (size_t)t * D + (c * 64 + lane) * 8) = o; }
            if (lane == 0) ((float*)(a.ws + WS_SAH))[t] = mx * (1.0f / 127.0f); }
        __syncthreads();
    }
    { const int gw = bx * NWAVES + wave, NGW = G * NWAVES;
      for (int row = gw; row < NL * (SBL + 16); row += NGW) { const int l = row / (SBL + 16), r = row % (SBL + 16);
          const bf16* src; unsigned char* dst; float* sdst;
          if (r < NP) { src = (const bf16*)(a.ws + WS_WIN) + ((size_t)l * INW + r) * D; dst = a.ws + WS_WIN8 + ((size_t)l * NP + r) * D; sdst = (float*)(a.ws + WS_SB) + l * SBL + r; }
          else if (r < NP + D) { src = (const bf16*)(a.ws + WS_WOUT) + ((size_t)l * D + (r - NP)) * D; dst = a.ws + WS_WOUT8 + ((size_t)l * D + (r - NP)) * D; sdst = (float*)(a.ws + WS_SB) + l * SBL + r; }
          else if (r < SBL) { src = (const bf16*)(a.ws + WS_WQ) + ((size_t)l * D + (r - NP - D)) * D; dst = a.ws + WS_WQ8 + ((size_t)l * D + (r - NP - D)) * D; sdst = (float*)(a.ws + WS_SB) + l * SBL + r; }
          else { src = (const bf16*)(a.ws + WS_WIN) + ((size_t)l * INW + NP + (r - SBL)) * D; dst = a.ws + WS_ALR8 + ((size_t)l * 16 + (r - SBL)) * D; sdst = (float*)(a.ws + WS_SBA) + l * 16 + (r - SBL); }
          v4u w[4]; float mx = 0.f;
#pragma unroll
          for (int c = 0; c < 4; ++c) w[c] = *(const v4u*)(src + (c * 64 + lane) * 8);
#pragma unroll
          for (int c = 0; c < 4; ++c)
#pragma unroll
              for (int j = 0; j < 4; ++j) mx = fmaxf(mx, fmaxf(fabsf(bflo(w[c][j])), fabsf(bfhi(w[c][j]))));
#pragma unroll
          for (int o = 1; o < 64; o <<= 1) mx = fmaxf(mx, __shfl_xor(mx, o));
          const float inv = mx > 0.f ? 127.0f / mx : 0.f;
#pragma unroll
          for (int c = 0; c < 4; ++c) { v2u o;
              o.x = pack_i8(bflo(w[c][0]) * inv, bfhi(w[c][0]) * inv, bflo(w[c][1]) * inv, bfhi(w[c][1]) * inv); o.y = pack_i8(bflo(w[c][2]) * inv, bfhi(w[c][2]) * inv, bflo(w[c][3]) * inv, bfhi(w[c][3]) * inv);
              *(v2u*)(dst + (c * 64 + lane) * 8) = o; }
          if (lane == 0) *sdst = mx * (1.0f / 127.0f); } }
}

__device__ __forceinline__ void gate_prep(const Args& a, int l, LAS unsigned char* lds, int tid, int lane, int wave, int ch) {
    const bf16* hbuf = (const bf16*)(a.ws + WS_H); const bf16* waT = (const bf16*)(a.ws + WS_WIN) + ((size_t)l * INW + NP) * D;
    bf16* Ebuf = (bf16*)(a.ws + WS_E); float* dtot = (float*)(a.ws + WS_DTOT);
    const int t0 = ch * 64, l15 = lane & 15, lq = lane >> 4, mt = wave & 3, kh = wave >> 2;
    LAS float* alr = (LAS float*)(lds + LDSCTL_OFF + 1024);
#if I8_GATE
    { v4i acc = (v4i){0, 0, 0, 0};
      const unsigned char* hA = a.ws + WS_H8 + (size_t)(t0 + 16 * mt + l15) * D + kh * 1024 + 16 * lq;
      const unsigned char* wB = a.ws + WS_ALR8 + ((size_t)l * 16 + l15) * D + kh * 1024 + 16 * lq;
#pragma unroll 8
      for (int ks = 0; ks < 16; ++ks) { const v4i av = *(const v4i*)(hA + 64 * ks), bv = *(const v4i*)(wB + 64 * ks); acc = __builtin_amdgcn_mfma_i32_16x16x64_i8(av, bv, acc, 0, 0, 0); }
      const float sw = ((const float*)(a.ws + WS_SBA))[l * 16 + l15];
#pragma unroll
      for (int r = 0; r < 4; ++r) { const int tl = 16 * mt + 4 * lq + r; alr[(kh * 64 + tl) * 16 + l15] = (float)acc[r] * (sw * ((const float*)(a.ws + WS_SAH))[t0 + tl]); } }
#else
    f32x4 acc = (f32x4){0.f, 0.f, 0.f, 0.f};
    const bf16* hA = hbuf + (size_t)(t0 + 16 * mt + l15) * D + kh * 1024 + 8 * lq;
    const bf16* wB = waT + (size_t)l15 * D + kh * 1024 + 8 * lq;
#pragma unroll 8
    for (int ks = 0; ks < 32; ++ks) { const bf16x8 av = *(const bf16x8*)(hA + 32 * ks), bv = *(const bf16x8*)(wB + 32 * ks); acc = __builtin_amdgcn_mfma_f32_16x16x32_bf16(av, bv, acc, 0, 0, 0); }
#pragma unroll
    for (int r = 0; r < 4; ++r) alr[(kh * 64 + 16 * mt + 4 * lq + r) * 16 + l15] = acc[r];
#endif
    __syncthreads();
    const int col = tid;
    float wg[16];
#pragma unroll
    for (int r = 0; r < 16; ++r) wg[r] = a.in[5][((size_t)l * RANK + r) * GKW + col];
    const float bgc = a.in[6][l * GKW + col];
    for (int i = tid; i < 256; i += NTHREADS) *(LAS f32x4*)(alr + i * 4) = *(const LAS f32x4*)(alr + i * 4) + *(const LAS f32x4*)(alr + 1024 + i * 4);
    __syncthreads();
    float tot = 0.f;
    LAS float* lac = (LAS float*)lds;
    for (int j = 0; j < 64; ++j) { float lg0 = bgc, lg1 = 0.f;
#pragma unroll
        for (int r4 = 0; r4 < 4; ++r4) { const f32x4 p = *(const LAS f32x4*)(alr + j * 16 + r4 * 4);
            lg0 += p.x * wg[r4 * 4] + p.z * wg[r4 * 4 + 2]; lg1 += p.y * wg[r4 * 4 + 1] + p.w * wg[r4 * 4 + 3]; }
        const float la = logsigmoid_fast(lg0 + lg1) * (1.0f / 16.0f); lac[j * GKW + col] = la; tot += la; }
    float run = 0.f;
    for (int j = 0; j < 64; ++j) { run += lac[j * GKW + col]; lac[j * GKW + col] = __expf(tot - run); }
    __syncthreads();
    for (int i = 0; i < 8; ++i) { const int j = wave * 8 + i;
        const f32x4 e0 = *(const LAS f32x4*)(lac + j * GKW + lane * 8), e1 = *(const LAS f32x4*)(lac + j * GKW + lane * 8 + 4);
        v4u o; o.x = pk2(e0.x, e0.y); o.y = pk2(e0.z, e0.w); o.z = pk2(e1.x, e1.y); o.w = pk2(e1.z, e1.w);
        *(v4u*)(Ebuf + (size_t)(t0 + j) * GKW + lane * 8) = o; }
    dtot[(size_t)ch * GKW + col] = __expf(tot);
    __syncthreads();
}

__device__ __forceinline__ void gla_unit(const Args& a, LAS unsigned char* lds, int tid, int lane, int wave, int un) {
    const bf16* proj = (const bf16*)(a.ws + WS_PROJ); const bf16* Ebuf = (const bf16*)(a.ws + WS_E); const float* dtot = (const float*)(a.ws + WS_DTOT); bf16* ogla = (bf16*)(a.ws + WS_OGLA);
    const int pair_ = (un & 7) * 4 + (un >> 6), dvs = (un >> 3) & 7, hh = pair_ & 3, b = pair_ >> 2;
    LAS bf16* kdT0 = (LAS bf16*)lds; LAS bf16* vT0 = (LAS bf16*)(lds + 18432); LAS bf16* ST0 = (LAS bf16*)(lds + 18432 + 4608);
    LAS bf16* kdT1 = (LAS bf16*)(lds + 32768); LAS bf16* vT1 = (LAS bf16*)(lds + 32768 + 18432); LAS bf16* ST1 = (LAS bf16*)(lds + 32768 + 18432 + 4608);
    const int l15 = lane & 15, lq = lane >> 4, jl = tid >> 3, dv4 = (tid & 7) * 4, jt = (wave & 3) * 16, dvt = (wave >> 2) * 16, jp = tid >> 4, c16 = tid & 15;
#define GLA_BAR() do { asm volatile("s_waitcnt lgkmcnt(0)" ::: "memory"); __builtin_amdgcn_s_barrier(); asm volatile("" ::: "memory"); } while (0)
    f32x4 S0 = (f32x4){0.f, 0.f, 0.f, 0.f}, S1 = (f32x4){0.f, 0.f, 0.f, 0.f};
    v4u kn0[2], kn1[2], kn2[2], en0[2], en1[2], en2[2]; v2u vn0, vn1, vn2; bf16x8 qn0[4], qn1[4], qn2[4], qc[4]; f32x4 dn0, dn1, dn2, dc;
#define GLA_LOAD(c, kn, en, vn, qn, dn) do { const int t0c = b * SEQ + (c) * 64; const bf16* pr = proj + (size_t)(t0c + jl) * NP; \
          \
        kn[0] = *(const v4u*)(proj + (size_t)(t0c + 2 * jp) * NP + PK + hh * 128 + 8 * c16); kn[1] = *(const v4u*)(proj + (size_t)(t0c + 2 * jp + 1) * NP + PK + hh * 128 + 8 * c16); \
        en[0] = *(const v4u*)(Ebuf + (size_t)(t0c + 2 * jp) * GKW + hh * 128 + 8 * c16); en[1] = *(const v4u*)(Ebuf + (size_t)(t0c + 2 * jp + 1) * GKW + hh * 128 + 8 * c16); \
        vn = *(const v2u*)(pr + PV + hh * 256 + dvs * 32 + dv4); \
        _Pragma("unroll") for (int ks_ = 0; ks_ < 4; ++ks_) qn[ks_] = *(const bf16x8*)(proj + (size_t)(t0c + jt + l15) * NP + PQ + hh * 128 + 32 * ks_ + 8 * lq); \
        dn = *(const f32x4*)(dtot + (size_t)(b * NCH + (c)) * GKW + hh * 128 + 16 * wave + 4 * lq); } while (0)
#define GLA_PREPL(kn, en, vn, kdT, vT) do { \
        _Pragma("unroll") for (int i_ = 0; i_ < 8; ++i_) { const unsigned wa_ = kn[0][i_ >> 1], wb_ = kn[1][i_ >> 1], ea_ = en[0][i_ >> 1], eb_ = en[1][i_ >> 1]; \
            const float pa_ = ((i_ & 1) ? bfhi(wa_) : bflo(wa_)) * ((i_ & 1) ? bfhi(ea_) : bflo(ea_)), pb_ = ((i_ & 1) ? bfhi(wb_) : bflo(wb_)) * ((i_ & 1) ? bfhi(eb_) : bflo(eb_)); \
            *(LAS unsigned*)(kdT + (8 * c16 + i_) * 72 + ((((jp >> 2) ^ c16) & 7) << 3) + ((2 * jp) & 7)) = pk2(pa_, pb_); }     \
        _Pragma("unroll") for (int i_ = 0; i_ < 4; ++i_) { const unsigned w_ = vn[i_ >> 1]; vT[(dv4 + i_) * 72 + jl] = (bf16)((i_ & 1) ? (w_ >> 16) : (w_ & 0xffffu)); } } while (0)
#define GLA_QD(qn, dn) do { _Pragma("unroll") for (int ks_ = 0; ks_ < 4; ++ks_) qc[ks_] = qn[ks_]; dc = dn; } while (0)
#define GLA_BODYA(kdT, vT, ST) do { \
        S0 = S0 * dc; S1 = S1 * dc; \
        _Pragma("unroll") for (int ks = 0; ks < 2; ++ks) { \
            const bf16x8 A_ = *(const LAS bf16x8*)(kdT + (16 * wave + l15) * 72 + ((((4 * ks + lq) ^ (2 * wave + (l15 >> 3))) & 7) << 3)); \
            const bf16x8 B0_ = *(const LAS bf16x8*)(vT + l15 * 72 + 32 * ks + 8 * lq), B1_ = *(const LAS bf16x8*)(vT + (16 + l15) * 72 + 32 * ks + 8 * lq); \
            S0 = __builtin_amdgcn_mfma_f32_16x16x32_bf16(A_, B0_, S0, 0, 0, 0); S1 = __builtin_amdgcn_mfma_f32_16x16x32_bf16(A_, B1_, S1, 0, 0, 0); } \
        { v2u w0_, w1_; w0_.x = pk2(S0.x, S0.y); w0_.y = pk2(S0.z, S0.w); w1_.x = pk2(S1.x, S1.y); w1_.y = pk2(S1.z, S1.w); \
          *(LAS v2u*)(ST + l15 * 136 + 16 * wave + 4 * lq) = w0_; *(LAS v2u*)(ST + (16 + l15) * 136 + 16 * wave + 4 * lq) = w1_; } } while (0)
#define GLA_BODYB(c, ST) do { \
        f32x4 O_ = (f32x4){0.f, 0.f, 0.f, 0.f}; \
        _Pragma("unroll") for (int ks = 0; ks < 4; ++ks) { const bf16x8 A_ = *(const LAS bf16x8*)(ST + (dvt + l15) * 136 + 32 * ks + 8 * lq); O_ = __builtin_amdgcn_mfma_f32_16x16x32_bf16(A_, qc[ks], O_, 0, 0, 0); } \
        { const f32x4 Os_ = O_ * 0.08838834764831845f; v2u ob_; ob_.x = pk2(Os_.x, Os_.y); ob_.y = pk2(Os_.z, Os_.w); \
          *(v2u*)(ogla + (size_t)(b * SEQ + (c) * 64 + jt + l15) * 1024 + hh * 256 + dvs * 32 + dvt + 4 * lq) = ob_; } } while (0)
#define GLA_STEP(c, RA, RB, LA, LB) do { { const int cn_ = (c) + 3 < NCH ? (c) + 3 : NCH - 1; GLA_LOAD(cn_, kn##RA, en##RA, vn##RA, qn##RA, dn##RA); } \
        GLA_BODYA(kdT##LA, vT##LA, ST##LA); GLA_PREPL(kn##RB, en##RB, vn##RB, kdT##LB, vT##LB); GLA_BAR(); GLA_BODYB(c, ST##LA); GLA_QD(qn##RB, dn##RB); } while (0)
    GLA_LOAD(0, kn0, en0, vn0, qn0, dn0); GLA_LOAD(1, kn1, en1, vn1, qn1, dn1); GLA_LOAD(2, kn2, en2, vn2, qn2, dn2);
    GLA_PREPL(kn0, en0, vn0, kdT0, vT0); GLA_QD(qn0, dn0);
    GLA_BAR();
    static_assert(NCH == 32, "the step schedule below is written for 32 chunks: 5 x 6 + 2");
    for (int c = 0; c < 30; c += 6) {
        GLA_STEP(c, 0, 1, 0, 1); GLA_STEP(c + 1, 1, 2, 1, 0); GLA_STEP(c + 2, 2, 0, 0, 1); GLA_STEP(c + 3, 0, 1, 1, 0); GLA_STEP(c + 4, 1, 2, 0, 1); GLA_STEP(c + 5, 2, 0, 1, 0);
    }
    GLA_STEP(30, 0, 1, 0, 1); GLA_STEP(31, 1, 2, 1, 0);
#undef GLA_STEP
#undef GLA_PREPL
#undef GLA_QD
#undef GLA_BODYA
#undef GLA_BODYB
#undef GLA_BAR
#undef GLA_LOAD
}

__device__ __forceinline__ void unpack16(const v4u& p0, const v4u& p1, float (&o)[16]) {
#pragma unroll
    for (int j = 0; j < 4; ++j) { o[2 * j] = bflo(p0[j]); o[2 * j + 1] = bfhi(p0[j]); o[8 + 2 * j] = bflo(p1[j]); o[8 + 2 * j + 1] = bfhi(p1[j]); }
}
__device__ __forceinline__ void mixpost_chunk(const Args& a, int l, int lane, int wave, int ch) {
    const bf16* proj = (const bf16*)(a.ws + WS_PROJ); const bf16* ogla = (const bf16*)(a.ws + WS_OGLA);
    const int c0 = 16 * lane, tfirst = ch * 64 + wave * 8, sfirst = tfirst % SEQ;
    float gn[16], cw0[16], cw1[16], cw2[16], cn[16], u1[16], u2[16];
#pragma unroll
    for (int i = 0; i < 16; ++i) { gn[i] = a.in[7][l * 256 + ((c0 + i) & 255)]; cw0[i] = a.in[8][(size_t)l * 3072 + c0 + i]; cw1[i] = a.in[8][(size_t)l * 3072 + 1024 + c0 + i];
        cw2[i] = a.in[8][(size_t)l * 3072 + 2048 + c0 + i]; cn[i] = a.in[9][l * 1024 + c0 + i]; u1[i] = 0.f; u2[i] = 0.f; }
    if (sfirst >= 2) {
        float cc[16], chh[16];
        { const bf16* pr = proj + (size_t)(tfirst - 2) * NP; unpack16(*(const v4u*)(pr + PCC + c0), *(const v4u*)(pr + PCC + c0 + 8), cc); unpack16(*(const v4u*)(pr + PCH + c0), *(const v4u*)(pr + PCH + c0 + 8), chh); }
#pragma unroll
        for (int i = 0; i < 16; ++i) u2[i] = cc[i] * chh[i];
        { const bf16* pr = proj + (size_t)(tfirst - 1) * NP; unpack16(*(const v4u*)(pr + PCC + c0), *(const v4u*)(pr + PCC + c0 + 8), cc); unpack16(*(const v4u*)(pr + PCH + c0), *(const v4u*)(pr + PCH + c0 + 8), chh); }
#pragma unroll
        for (int i = 0; i < 16; ++i) u1[i] = cc[i] * chh[i];
    }
#pragma unroll 2
    for (int it = 0; it < 8; ++it) { const int t = tfirst + it; const bf16* pr = proj + (size_t)t * NP;
        float o[16], r[16], cb[16], cc[16], chh[16];
        unpack16(*(const v4u*)(ogla + (size_t)t * 1024 + c0), *(const v4u*)(ogla + (size_t)t * 1024 + c0 + 8), o);
        unpack16(*(const v4u*)(pr + PR + c0), *(const v4u*)(pr + PR + c0 + 8), r);
        unpack16(*(const v4u*)(pr + PCB + c0), *(const v4u*)(pr + PCB + c0 + 8), cb);
        unpack16(*(const v4u*)(pr + PCC + c0), *(const v4u*)(pr + PCC + c0 + 8), cc);
        unpack16(*(const v4u*)(pr + PCH + c0), *(const v4u*)(pr + PCH + c0 + 8), chh);
        float ss = 0.f;
#pragma unroll
        for (int i = 0; i < 16; ++i) ss += o[i] * o[i];
        ss += __shfl_xor(ss, 1); ss += __shfl_xor(ss, 2); ss += __shfl_xor(ss, 4); ss += __shfl_xor(ss, 8);
        const float rg = rsqrtf(ss * (1.0f / 256.f) + EPS);
        float val[16]; float s2 = 0.f;
#pragma unroll
        for (int i = 0; i < 16; ++i) { const float u0 = cc[i] * chh[i]; val[i] = cb[i] * (cw0[i] * u2[i] + cw1[i] * u1[i] + cw2[i] * u0); s2 += val[i] * val[i]; u2[i] = u1[i]; u1[i] = u0; }
        const float rc = rsqrtf(wave_sum(s2) * (1.0f / 1024.f) + EPS);
        float ya[16], yb[16]; float mx = 0.f;
#pragma unroll
        for (int i = 0; i < 16; ++i) { ya[i] = o[i] * rg * gn[i] * silu_f(r[i]); yb[i] = val[i] * rc * cn[i]; mx = fmaxf(mx, fmaxf(fabsf(ya[i]), fabsf(yb[i]))); }
#pragma unroll
        for (int o_ = 1; o_ < 64; o_ <<= 1) mx = fmaxf(mx, __shfl_xor(mx, o_));
        const float inv = mx > 0.f ? 127.0f / mx : 0.f;
        v4u y0, y1;
#pragma unroll
        for (int j = 0; j < 4; ++j) { y0[j] = pack_i8(ya[4 * j] * inv, ya[4 * j + 1] * inv, ya[4 * j + 2] * inv, ya[4 * j + 3] * inv); y1[j] = pack_i8(yb[4 * j] * inv, yb[4 * j + 1] * inv, yb[4 * j + 2] * inv, yb[4 * j + 3] * inv); }
        unsigned char* yr = a.ws + WS_Y8 + (size_t)t * D;
        *(v4u*)(yr + c0) = y0; *(v4u*)(yr + 1024 + c0) = y1;
#if !I8_OUT
        { v4u b0, b1, b2, b3;
#pragma unroll
          for (int j = 0; j < 4; ++j) { b0[j] = pk2(ya[2 * j], ya[2 * j + 1]); b1[j] = pk2(ya[8 + 2 * j], ya[9 + 2 * j]); b2[j] = pk2(yb[2 * j], yb[2 * j + 1]); b3[j] = pk2(yb[8 + 2 * j], yb[9 + 2 * j]); }
          bf16* ybr = (bf16*)(a.ws + WS_Y) + (size_t)t * D;
          *(v4u*)(ybr + c0) = b0; *(v4u*)(ybr + c0 + 8) = b1; *(v4u*)(ybr + 1024 + c0) = b2; *(v4u*)(ybr + 1024 + c0 + 8) = b3; }
#endif
        if (lane == 0) ((float*)(a.ws + WS_SAY))[t] = mx * (1.0f / 127.0f);
    }
}

__device__ __forceinline__ void ln1_chunk(const Args& a, int l, LAS unsigned char* lds, int lane, int wave, int ch) {
    const float* zbuf = (const float*)(a.ws + WS_Z); const float* mod = (const float*)(a.ws + WS_MOD);
    const int b = ch / NCH; const float* mb = mod + ((size_t)l * NB + b) * 6 * D;
#pragma unroll 2
    for (int it = 0; it < 8; ++it) { const int t = ch * 64 + wave * 8 + it;
        float z[32];
#pragma unroll
#if RES16_Z
        for (int c = 0; c < 8; ++c) { const v2u v0 = *(const v2u*)((const bf16*)zbuf + (size_t)t * D + (c * 64 + lane) * 4); z[c * 4] = bflo(v0.x); z[c * 4 + 1] = bfhi(v0.x); z[c * 4 + 2] = bflo(v0.y); z[c * 4 + 3] = bfhi(v0.y); }
#else
        for (int c = 0; c < 8; ++c) { const f32x4 v0 = *(const f32x4*)(zbuf + (size_t)t * D + (c * 64 + lane) * 4); z[c * 4] = v0.x; z[c * 4 + 1] = v0.y; z[c * 4 + 2] = v0.z; z[c * 4 + 3] = v0.w; }
#endif
        ln_tail(z, t, lane, a.in[11] + (size_t)l * D, a.in[12] + (size_t)l * D, RES16_X1 ? (float*)nullptr : (float*)(a.ws + WS_X1), mb + 3 * D, mb + 4 * D, I8_WQ ? (bf16*)nullptr : (bf16*)(a.ws + WS_H2), a.ws + WS_HQ8, (float*)(a.ws + WS_HSC), lds + wave * 2304, I8_WQ ? a.ws + WS_H28 : (unsigned char*)nullptr, nullptr, RES16_X1 ? (bf16*)(a.ws + WS_X1) : (bf16*)nullptr);
    }
}

template <int N> __device__ __forceinline__ void bitonic_sort_desc(float (&v)[N]) {
#pragma unroll
    for (int k = 2; k <= N; k <<= 1)
#pragma unroll
        for (int j = k >> 1; j > 0; j >>= 1)
#pragma unroll
            for (int i = 0; i < N; ++i) { const int p = i ^ j; if (p > i) { const bool desc = ((i & k) == 0); const float x = v[i], y = v[p]; const float mx = fmaxf(x, y), mn = fminf(x, y); v[i] = desc ? mx : mn; v[p] = desc ? mn : mx; } }
}
__device__ __forceinline__ void merge_top16(float (&x)[16], const float (&y)[16]) {
#pragma unroll
    for (int i = 0; i < 16; ++i) x[i] = fmaxf(x[i], y[15 - i]);
#pragma unroll
    for (int j = 8; j > 0; j >>= 1)
#pragma unroll
        for (int i = 0; i < 16; ++i) { const int p = i ^ j; if (p > i) { const float u = x[i], w = x[p]; x[i] = fmaxf(u, w); x[p] = fminf(u, w); } }
}
__device__ __forceinline__ void ce_desc(float& ka, int& pa, float& kb, int& pb) { const bool sw = kb > ka; const float k0 = sw ? kb : ka, k1 = sw ? ka : kb; const int p0 = sw ? pb : pa, p1 = sw ? pa : pb; ka = k0; pa = p0; kb = k1; pb = p1; }
__device__ __forceinline__ void bitonic_sort_desc_kp(float (&k)[16], int (&p)[16]) {
#pragma unroll
    for (int kk = 2; kk <= 16; kk <<= 1)
#pragma unroll
        for (int j = kk >> 1; j > 0; j >>= 1)
#pragma unroll
            for (int i = 0; i < 16; ++i) { const int q = i ^ j; if (q > i) { if ((i & kk) == 0) ce_desc(k[i], p[i], k[q], p[q]); else ce_desc(k[q], p[q], k[i], p[i]); } }
}
__device__ __forceinline__ void merge_top16_kp(float (&k)[16], int (&p)[16], const float (&k2)[16], const int (&p2)[16]) {
#pragma unroll
    for (int i = 0; i < 16; ++i) { const bool sw = k2[15 - i] > k[i]; k[i] = sw ? k2[15 - i] : k[i]; p[i] = sw ? p2[15 - i] : p[i]; }
#pragma unroll
    for (int j = 8; j > 0; j >>= 1)
#pragma unroll
        for (int i = 0; i < 16; ++i) { const int q = i ^ j; if (q > i) ce_desc(k[i], p[i], k[q], p[q]); }
}
__device__ constexpr int cand_i(int s) { return s < 16 ? 0 : s < 24 ? 1 : s < 29 ? 2 : s < 33 ? 3 : s < 36 ? 4 : s < 38 ? 5 : s < 40 ? 6 : s < 42 ? 7 : s < 50 ? s - 34 : -1; }
__device__ constexpr int cand_j(int s) { return s < 16 ? s : s < 24 ? s - 16 : s < 29 ? s - 24 : s < 33 ? s - 29 : s < 36 ? s - 33 : s < 38 ? s - 36 : s < 40 ? s - 38 : s < 42 ? s - 40 : s < 50 ? 0 : -1; }

__device__ __forceinline__ void peer_retrieve(const Args& a, int l, LAS unsigned char* lds, int lane, int wave, int ch) {
    const bf16* qbuf = (const bf16*)(a.ws + WS_Q); const bf16* keys = (const bf16*)(a.ws + WS_KEYS) + ((size_t)(l * 8 + wave) * 2) * 128 * 128;
    LAS int* eg_e = (LAS int*)lds; LAS float* eg_g = (LAS float*)(lds + 32768);
    const int l31 = lane & 31, l5 = lane >> 5, h = wave, t0 = ch * 64;
    for (int tt = 0; tt < 2; ++tt) {
        float sv[2][16];
#pragma unroll
        for (int p = 0; p < 2; ++p) {
            f32x16 acc[4];
#pragma unroll
            for (int nt = 0; nt < 4; ++nt)
#pragma unroll
                for (int r = 0; r < 16; ++r) acc[nt][r] = 0.f;
            const bf16* qp = qbuf + (size_t)(t0 + 32 * tt + l31) * D + h * 256 + p * 128 + 8 * l5;
            const bf16* kp = keys + (size_t)(p * 128 + l31) * 128 + 8 * l5;
#pragma unroll 4
            for (int ks = 0; ks < 8; ++ks) { const bf16x8 bq = *(const bf16x8*)(qp + 16 * ks);
#pragma unroll
                for (int nt = 0; nt < 4; ++nt) { const bf16x8 ak = *(const bf16x8*)(kp + (size_t)(32 * nt) * 128 + 16 * ks); acc[nt] = __builtin_amdgcn_mfma_f32_32x32x16_bf16(ak, bq, acc[nt], 0, 0, 0); } }
            float v[4][16];
#pragma unroll
            for (int nt = 0; nt < 4; ++nt)
#pragma unroll
                for (int r = 0; r < 16; ++r) { const unsigned idx = 32u * nt + (r & 3) + 8u * (r >> 2) + 4u * l5; v[nt][r] = __uint_as_float((__float_as_uint(acc[nt][r]) & 0xffffff80u) | idx); }
#pragma unroll
            for (int nt = 0; nt < 4; ++nt) bitonic_sort_desc<16>(v[nt]);
            merge_top16(v[0], v[1]); merge_top16(v[2], v[3]); merge_top16(v[0], v[2]);
            float o[16];
#pragma unroll
            for (int i = 0; i < 16; ++i) o[i] = __shfl_xor(v[0][i], 32);
            merge_top16(v[0], o);
#pragma unroll
            for (int i = 0; i < 16; ++i) sv[p][i] = v[0][i];
        }
        LAS unsigned char* idxb = (LAS unsigned char*)(lds + 69632) + wave * 2048 + lane * 32;
        { v4u w0, w1;
#pragma unroll
          for (int q4 = 0; q4 < 4; ++q4) {
              w0[q4] = (__float_as_uint(sv[0][4 * q4]) & 127u) | ((__float_as_uint(sv[0][4 * q4 + 1]) & 127u) << 8) | ((__float_as_uint(sv[0][4 * q4 + 2]) & 127u) << 16) | ((__float_as_uint(sv[0][4 * q4 + 3]) & 127u) << 24);
              w1[q4] = (__float_as_uint(sv[1][4 * q4]) & 127u) | ((__float_as_uint(sv[1][4 * q4 + 1]) & 127u) << 8) | ((__float_as_uint(sv[1][4 * q4 + 2]) & 127u) << 16) | ((__float_as_uint(sv[1][4 * q4 + 3]) & 127u) << 24); }
          *(LAS v4u*)(idxb) = w0; *(LAS v4u*)(idxb + 16) = w1; }
        float ck[4][16];
#pragma unroll
        for (int s = 0; s < 64; ++s) {
            if (cand_i(s) >= 0) { const unsigned b0 = __float_as_uint(sv[0][cand_i(s) < 0 ? 0 : cand_i(s)]), b1 = __float_as_uint(sv[1][cand_j(s) < 0 ? 0 : cand_j(s)]);
                const float sum = __uint_as_float(b0 & 0xffffff80u) + __uint_as_float(b1 & 0xffffff80u);
                ck[s >> 4][s & 15] = __uint_as_float((__float_as_uint(sum) & 0xffffff00u) | (unsigned)((cand_i(s) < 0 ? 0 : cand_i(s)) * 16 + (cand_j(s) < 0 ? 0 : cand_j(s)))); }
            else ck[s >> 4][s & 15] = -3.0e38f; }
        bitonic_sort_desc<16>(ck[1]); bitonic_sort_desc<16>(ck[2]);
        merge_top16(ck[0], ck[1]); merge_top16(ck[2], ck[3]); merge_top16(ck[0], ck[2]);
        LDS_WAIT(); asm volatile("" ::: "memory");
        float ex[16]; int ce[16]; float den = 0.f;
        const float cmax = __uint_as_float(__float_as_uint(ck[0][0]) & 0xffffff00u);
#pragma unroll
        for (int i = 0; i < 16; ++i) { const unsigned bits = __float_as_uint(ck[0][i]); ex[i] = __expf(__uint_as_float(bits & 0xffffff00u) - cmax); den += ex[i];
            ce[i] = (int)idxb[(bits >> 4) & 15u] * 128 + (int)idxb[16 + (bits & 15u)]; }
        const float inv = 1.0f / den;
        if (l5 == 0) {
            const int base = (32 * tt + l31) * 128 + h * 16;
#pragma unroll
            for (int i4 = 0; i4 < 4; ++i4) { *(LAS v4u*)(eg_e + base + 4 * i4) = (v4u){(unsigned)ce[4 * i4], (unsigned)ce[4 * i4 + 1], (unsigned)ce[4 * i4 + 2], (unsigned)ce[4 * i4 + 3]};
                *(LAS f32x4*)(eg_g + base + 4 * i4) = (f32x4){ex[4 * i4] * inv, ex[4 * i4 + 1] * inv, ex[4 * i4 + 2] * inv, ex[4 * i4 + 3] * inv}; }
        }
        LDS_WAIT(); asm volatile("" ::: "memory");
    }
}

typedef unsigned char uc4 __attribute__((ext_vector_type(4)));
constexpr int NSLICE = 16, SLICE_SHIFT = 10;
__device__ __forceinline__ int sdot4i(unsigned w, unsigned x, int acc) { return __builtin_amdgcn_sdot4((int)w, (int)x, acc, false); }
__device__ __forceinline__ void fma_ub4(unsigned w, float s, float& y0, float& y1, float& y2, float& y3) { const uc4 b = __builtin_bit_cast(uc4, w); y0 += s * (float)b.x; y1 += s * (float)b.y; y2 += s * (float)b.z; y3 += s * (float)b.w; }
#if TAB4
__device__ __forceinline__ void peer_tail(const Args& a, int l, int t, int lane, const bf16* Yrow, const float* mb, const float* mbn, bool last) {
    const float* x1buf = (const float*)(a.ws + WS_X1);
    float z[32];
#pragma unroll
    for (int c8 = 0; c8 < 8; ++c8) { const int col = (c8 * 64 + lane) * 4;
        const v2u yb = *(const v2u*)(Yrow + col); const f32x4 yv = (f32x4){bflo(yb.x), bfhi(yb.x), bflo(yb.y), bfhi(yb.y)};
#if RES16_X1
        const v2u xb_ = *(const v2u*)((const bf16*)x1buf + (size_t)t * D + col); const f32x4 x0 = (f32x4){bflo(xb_.x), bfhi(xb_.x), bflo(xb_.y), bfhi(xb_.y)}, g0 = *(const f32x4*)(mb + 5 * D + col);
#else
        const f32x4 x0 = *(const f32x4*)(x1buf + (size_t)t * D + col), g0 = *(const f32x4*)(mb + 5 * D + col);
#endif
        z[c8 * 4] = ALPHA * x0.x + (1.f + g0.x) * yv.x; z[c8 * 4 + 1] = ALPHA * x0.y + (1.f + g0.y) * yv.y; z[c8 * 4 + 2] = ALPHA * x0.z + (1.f + g0.z) * yv.z; z[c8 * 4 + 3] = ALPHA * x0.w + (1.f + g0.w) * yv.w; }
    ln_tail(z, t, lane, a.in[17] + (size_t)l * D, a.in[18] + (size_t)l * D, last ? a.out : (RES16_X ? (float*)nullptr : (float*)(a.ws + WS_X)), mbn, mbn + D, (last || I8_GATE) ? (bf16*)nullptr : (bf16*)(a.ws + WS_H), nullptr, nullptr, nullptr, last ? (unsigned char*)nullptr : a.ws + WS_H8, (float*)(a.ws + WS_SAH), (RES16_X && !last) ? (bf16*)(a.ws + WS_X) : (bf16*)nullptr);
}
template <class TT, int N, int M> __device__ __forceinline__ void treduce(TT (&v)[N], int lane) {
    const bool c0 = (lane & M) != 0, c1 = (lane & (2 * M)) != 0, c2 = (lane & (4 * M)) != 0;
#pragma unroll
    for (int m = 0; m < N / 2; ++m) { const TT keep = c0 ? v[2 * m + 1] : v[2 * m], send = c0 ? v[2 * m] : v[2 * m + 1]; v[m] = keep + __shfl_xor(send, M); }
#pragma unroll
    for (int m = 0; m < N / 4; ++m) { const TT keep = c1 ? v[2 * m + 1] : v[2 * m], send = c1 ? v[2 * m] : v[2 * m + 1]; v[m] = keep + __shfl_xor(send, 2 * M); }
#pragma unroll
    for (int m = 0; m < N / 8; ++m) { const TT keep = c2 ? v[2 * m + 1] : v[2 * m], send = c2 ? v[2 * m] : v[2 * m + 1]; v[m] = keep + __shfl_xor(send, 4 * M); }
}
__device__ __forceinline__ void tr4x4(unsigned a, unsigned b, unsigned c, unsigned d, unsigned& t0, unsigned& t1, unsigned& t2, unsigned& t3) {
    const unsigned x0 = __builtin_amdgcn_perm(b, a, 0x05010400u), x1 = __builtin_amdgcn_perm(b, a, 0x07030602u), y0 = __builtin_amdgcn_perm(d, c, 0x05010400u), y1 = __builtin_amdgcn_perm(d, c, 0x07030602u);
    t0 = __builtin_amdgcn_perm(y0, x0, 0x05040100u); t1 = __builtin_amdgcn_perm(y0, x0, 0x07060302u); t2 = __builtin_amdgcn_perm(y1, x1, 0x05040100u); t3 = __builtin_amdgcn_perm(y1, x1, 0x07060302u);
}
__device__ __forceinline__ int sdot8i(unsigned w, unsigned x, int acc) { return __builtin_amdgcn_sdot8((int)w, (int)x, acc, false); }
__device__ __forceinline__ float slot_scale(unsigned w3) { return __builtin_amdgcn_exp2f((float)(w3 >> 24) * 0.125f - 16.0f); }
__device__ __forceinline__ void peer_experts(const Args& a, int l, LAS unsigned char* lds, int lane0, int wave, int ch) {
    const float* mod = (const float*)(a.ws + WS_MOD);
    const unsigned char* ut = a.ws + WS_UT + (size_t)l * NE * 1152; const unsigned char* vt = a.ws + WS_VT + (size_t)l * NE * 1152; const unsigned char* hq8 = a.ws + WS_HQ8;
    const float* hsc = (const float*)(a.ws + WS_HSC);
    bf16* Ybuf = (bf16*)(a.ws + WS_Z);
    const LAS int* eg_e = (const LAS int*)lds; LAS float* sw = (LAS float*)(lds + 32768);
    LAS float* apart = (LAS float*)(lds + 65536);
    const int b = ch / NCH; const bool last = (l == NL - 1);
    const float* mb = mod + ((size_t)l * NB + b) * 6 * D; const float* mbn = mod + ((size_t)(last ? l : l + 1) * NB + b) * 6 * D;
    const int tlw = wave * 8;
    { const int lane = lane0;
#pragma unroll
      for (int i = 0; i < 16; ++i) apart[tlw * 128 + i * 64 + lane] = 0.f; }
    LDS_WAIT(); asm volatile("" ::: "memory");
    {
        int laneL = lane0; asm volatile("" : "+v"(laneL)); const int lane = laneL;
        const int g = lane >> 3, l7 = lane & 7;
        v4u bufA[16], bufB[16], hA0, hA1, hB0, hB1;
#define CU_LOAD(buf, h0_, h1_, idx_) do { const int u_ = (idx_) >> 3, tl_ = tlw + ((idx_) & 7); const unsigned soff_ = (unsigned)(u_ * 128 + l7 * 16); \
            const unsigned char* hp_ = hq8 + (size_t)(ch * 64 + tl_) * 2304 + (u_ * 8 + l7) * 32; h0_ = *(const v4u*)hp_; h1_ = *(const v4u*)(hp_ + 16); \
            _Pragma("unroll") for (int i_ = 0; i_ < 16; ++i_) { const unsigned e_ = (unsigned)eg_e[tl_ * 128 + 8 * i_ + g]; buf[i_] = *(const v4u*)(ut + (size_t)(e_ * 1152u + soff_)); } } while (0)
#define CU_COMP(buf, h0_, h1_, idx_) do { const int tl_ = tlw + ((idx_) & 7); float accv_[16]; \
            _Pragma("unroll") for (int i_ = 0; i_ < 16; ++i_) { int sl_ = 0, sh_ = 0; \
                _Pragma("unroll") for (int d_ = 0; d_ < 4; ++d_) { const unsigned x_ = buf[i_][d_] ^ 0x88888888u; sl_ = sdot8i(x_, h0_[d_], sl_); sh_ = sdot8i(x_, h1_[d_], sh_); } \
                accv_[i_] = slot_scale(buf[i_][3]) * (float)(16 * sh_ + sl_); } \
            treduce<float, 16, 1>(accv_, lane); \
            apart[tl_ * 128 + 8 * l7 + g] += accv_[0]; apart[tl_ * 128 + 8 * (8 + l7) + g] += accv_[1]; } while (0)
        CU_LOAD(bufA, hA0, hA1, 0);
        for (int idx = 0; idx < 72; idx += 2) {
            CU_LOAD(bufB, hB0, hB1, idx + 1);
            CU_COMP(bufA, hA0, hA1, idx);
            { const int nx_ = idx + 2 < 72 ? idx + 2 : 71; CU_LOAD(bufA, hA0, hA1, nx_); }
            CU_COMP(bufB, hB0, hB1, idx + 1);
        }
#undef CU_LOAD
#undef CU_COMP
        LDS_WAIT(); asm volatile("" ::: "memory");
        for (int it = 0; it < 8; ++it) { const int tl = tlw + it; const float shs = hsc[ch * 64 + tl];
            const float w0 = sw[tl * 128 + lane] * gelu_tanh_f(apart[tl * 128 + lane] * shs), w1 = sw[tl * 128 + 64 + lane] * gelu_tanh_f(apart[tl * 128 + 64 + lane] * shs);
            sw[tl * 128 + lane] = w0; sw[tl * 128 + 64 + lane] = w1; }
        LDS_WAIT(); asm volatile("" ::: "memory");
    }
    {
        int laneL = lane0; asm volatile("" : "+v"(laneL)); const int lane = laneL;
        const int g = lane >> 3, l7 = lane & 7;
        v4u bufA[16], bufB[16];
#define CV_LOAD(buf, idx_) do { const int u_ = (idx_) >> 3, tl_ = tlw + ((idx_) & 7); const unsigned soff_ = (unsigned)(u_ * 128 + l7 * 16); \
            _Pragma("unroll") for (int i_ = 0; i_ < 16; ++i_) { const unsigned e_ = (unsigned)eg_e[tl_ * 128 + 8 * i_ + g]; buf[i_] = *(const v4u*)(vt + (size_t)(e_ * 1152u + soff_)); } } while (0)
#define CV_COMP(buf, idx_) do { const int u_ = (idx_) >> 3, tl_ = tlw + ((idx_) & 7); \
            float wf_[16]; float wmx_ = 0.f; \
            _Pragma("unroll") for (int i_ = 0; i_ < 16; ++i_) { wf_[i_] = sw[tl_ * 128 + 8 * i_ + g] * slot_scale(buf[i_][3]); wmx_ = fmaxf(wmx_, fabsf(wf_[i_])); } \
            wmx_ = fmaxf(wmx_, __shfl_xor(wmx_, 8)); wmx_ = fmaxf(wmx_, __shfl_xor(wmx_, 16)); wmx_ = fmaxf(wmx_, __shfl_xor(wmx_, 32));     \
            const float winv_ = wmx_ > 0.f ? 127.0f / wmx_ : 0.f, wsc_ = wmx_ * (1.0f / 127.0f); \
              \
            unsigned wq4_[4]; int wsum_ = 0; \
            _Pragma("unroll") for (int gp_ = 0; gp_ < 4; ++gp_) { \
                const unsigned m0_ = __float_as_uint(wf_[4 * gp_] * winv_ + 12582912.0f), m1_ = __float_as_uint(wf_[4 * gp_ + 1] * winv_ + 12582912.0f), m2_ = __float_as_uint(wf_[4 * gp_ + 2] * winv_ + 12582912.0f), m3_ = __float_as_uint(wf_[4 * gp_ + 3] * winv_ + 12582912.0f); \
                wq4_[gp_] = __builtin_amdgcn_perm(__builtin_amdgcn_perm(m3_, m2_, 0x0c0c0400u), __builtin_amdgcn_perm(m1_, m0_, 0x0c0c0400u), 0x05040100u); \
                wsum_ = sdot4i(wq4_[gp_], 0x01010101u, wsum_); } \
            int yi_[32]; \
            _Pragma("unroll") for (int q_ = 0; q_ < 32; ++q_) yi_[q_] = 0; \
            _Pragma("unroll") for (int gp_ = 0; gp_ < 4; ++gp_) { \
                _Pragma("unroll") for (int d_ = 0; d_ < 4; ++d_) { const unsigned A_ = buf[4 * gp_][d_], B_ = buf[4 * gp_ + 1][d_], C_ = buf[4 * gp_ + 2][d_], D_ = buf[4 * gp_ + 3][d_]; \
                    unsigned t0_, t1_, t2_, t3_; \
                    tr4x4(A_, B_, C_, D_, t0_, t1_, t2_, t3_);     \
                    yi_[8 * d_]     = sdot4i(t0_ & 0x0f0f0f0fu, wq4_[gp_], yi_[8 * d_]);     yi_[8 * d_ + 1] = sdot4i((t0_ >> 4) & 0x0f0f0f0fu, wq4_[gp_], yi_[8 * d_ + 1]); \
                    yi_[8 * d_ + 2] = sdot4i(t1_ & 0x0f0f0f0fu, wq4_[gp_], yi_[8 * d_ + 2]); yi_[8 * d_ + 3] = sdot4i((t1_ >> 4) & 0x0f0f0f0fu, wq4_[gp_], yi_[8 * d_ + 3]); \
                    yi_[8 * d_ + 4] = sdot4i(t2_ & 0x0f0f0f0fu, wq4_[gp_], yi_[8 * d_ + 4]); yi_[8 * d_ + 5] = sdot4i((t2_ >> 4) & 0x0f0f0f0fu, wq4_[gp_], yi_[8 * d_ + 5]); \
                    yi_[8 * d_ + 6] = sdot4i(t3_ & 0x0f0f0f0fu, wq4_[gp_], yi_[8 * d_ + 6]); yi_[8 * d_ + 7] = sdot4i((t3_ >> 4) & 0x0f0f0f0fu, wq4_[gp_], yi_[8 * d_ + 7]); } } \
            treduce<int, 32, 8>(yi_, lane); \
            wsum_ += __shfl_xor(wsum_, 8); wsum_ += __shfl_xor(wsum_, 16); wsum_ += __shfl_xor(wsum_, 32);     \
            float y_[4]; \
            _Pragma("unroll") for (int q_ = 0; q_ < 4; ++q_) y_[q_] = wsc_ * (float)(yi_[q_] - 8 * wsum_); \
            { const int colb_ = u_ * 240 + l7 * 30 + g; bf16* yr_ = Ybuf + (size_t)(ch * 64 + tl_) * D + colb_; \
              _Pragma("unroll") for (int m_ = 0; m_ < 4; ++m_) if (8 * m_ + g < 30 && colb_ + 8 * m_ < D) yr_[8 * m_] = (bf16)(pk2(y_[m_], 0.f) & 0xffffu); } } while (0)
        CV_LOAD(bufA, 0);
        for (int idx = 0; idx < 72; idx += 2) {
            CV_LOAD(bufB, idx + 1);
            CV_COMP(bufA, idx);
            { const int nx_ = idx + 2 < 72 ? idx + 2 : 71; CV_LOAD(bufA, nx_); }
            CV_COMP(bufB, idx + 1);
        }
#undef CV_LOAD
#undef CV_COMP
    }
    asm volatile("s_waitcnt vmcnt(0)" ::: "memory");
    __builtin_amdgcn_fence(__ATOMIC_ACQUIRE, "agent");
    asm volatile("s_waitcnt vmcnt(0)" ::: "memory");
    for (int it = 0; it < 8; ++it) { int laneT = lane0; asm volatile("" : "+v"(laneT)); const int t = ch * 64 + tlw + it;
        peer_tail(a, l, t, laneT, Ybuf + (size_t)t * D, mb, mbn, last); }
}
#else
__device__ __forceinline__ void peer_tail(const Args& a, int l, int t, int lane, const float* Yrow, const float* mb, const float* mbn, bool last) {
    const float* x1buf = (const float*)(a.ws + WS_X1);
    float z[32];
#pragma unroll
    for (int c = 0; c < 2; ++c)
#pragma unroll
        for (int k = 0; k < 4; ++k) { const int c8 = 4 * c + k, col = (c8 * 64 + lane) * 4;
            const v2u yb = *(const v2u*)((const bf16*)Yrow + (c * 64 + lane) * 16 + 4 * k); const f32x4 yv = (f32x4){bflo(yb.x), bfhi(yb.x), bflo(yb.y), bfhi(yb.y)};
#if RES16_X1
            const v2u xb_ = *(const v2u*)((const bf16*)x1buf + (size_t)t * D + col); const f32x4 x0 = (f32x4){bflo(xb_.x), bfhi(xb_.x), bflo(xb_.y), bfhi(xb_.y)}, g0 = *(const f32x4*)(mb + 5 * D + col);
#else
            const f32x4 x0 = *(const f32x4*)(x1buf + (size_t)t * D + col), g0 = *(const f32x4*)(mb + 5 * D + col);
#endif
            z[c8 * 4] = ALPHA * x0.x + (1.f + g0.x) * yv.x; z[c8 * 4 + 1] = ALPHA * x0.y + (1.f + g0.y) * yv.y; z[c8 * 4 + 2] = ALPHA * x0.z + (1.f + g0.z) * yv.z; z[c8 * 4 + 3] = ALPHA * x0.w + (1.f + g0.w) * yv.w; }
    ln_tail(z, t, lane, a.in[17] + (size_t)l * D, a.in[18] + (size_t)l * D, last ? a.out : (RES16_X ? (float*)nullptr : (float*)(a.ws + WS_X)), mbn, mbn + D, (last || I8_GATE) ? (bf16*)nullptr : (bf16*)(a.ws + WS_H), nullptr, nullptr, nullptr, last ? (unsigned char*)nullptr : a.ws + WS_H8, (float*)(a.ws + WS_SAH), (RES16_X && !last) ? (bf16*)(a.ws + WS_X) : (bf16*)nullptr);
}
template <class TT, int M> __device__ __forceinline__ void treduce16(TT (&v)[16], int lane) {
    const bool c0 = (lane & M) != 0, c1 = (lane & (2 * M)) != 0, c2 = (lane & (4 * M)) != 0;
#pragma unroll
    for (int m = 0; m < 8; ++m) { const TT keep = c0 ? v[2 * m + 1] : v[2 * m], send = c0 ? v[2 * m] : v[2 * m + 1]; v[m] = keep + __shfl_xor(send, M); }
#pragma unroll
    for (int m = 0; m < 4; ++m) { const TT keep = c1 ? v[2 * m + 1] : v[2 * m], send = c1 ? v[2 * m] : v[2 * m + 1]; v[m] = keep + __shfl_xor(send, 2 * M); }
#pragma unroll
    for (int m = 0; m < 2; ++m) { const TT keep = c2 ? v[2 * m + 1] : v[2 * m], send = c2 ? v[2 * m] : v[2 * m + 1]; v[m] = keep + __shfl_xor(send, 4 * M); }
}
__device__ __forceinline__ void peer_experts(const Args& a, int l, LAS unsigned char* lds, int lane0, int wave, int ch) {
    const float* mod = (const float*)(a.ws + WS_MOD);
    const unsigned char* ut = a.ws + WS_UT + (size_t)l * NE * D; const unsigned char* vt = a.ws + WS_VT + (size_t)l * NE * D; const unsigned char* hq8 = a.ws + WS_HQ8;
    const float* su = (const float*)(a.ws + WS_SU) + (size_t)l * NE; const float* sv = (const float*)(a.ws + WS_SV) + (size_t)l * NE; const float* hsc = (const float*)(a.ws + WS_HSC);
    float* Ybuf = (float*)(a.ws + WS_Z);
    const LAS int* eg_e = (const LAS int*)lds; LAS float* sw = (LAS float*)(lds + 32768);
    LAS int* apart = (LAS int*)(lds + 65536); LAS float* wtotl = (LAS float*)(lds + LDSCTL_OFF + 256);
    const int b = ch / NCH; const bool last = (l == NL - 1);
    const float* mb = mod + ((size_t)l * NB + b) * 6 * D; const float* mbn = mod + ((size_t)(last ? l : l + 1) * NB + b) * 6 * D;
    const int tlw = wave * 8;
    { const int lane = lane0;
#pragma unroll
      for (int i = 0; i < 16; ++i) apart[tlw * 128 + i * 64 + lane] = 0; }
    LDS_WAIT(); asm volatile("" ::: "memory");
    {
        int laneL = lane0; asm volatile("" : "+v"(laneL)); const int lane = laneL;
        const int g = lane >> 3, l7 = lane & 7;
        v4u bufA[16], bufB[16], hA, hB;
#define CU_LOAD(buf, hh_, idx_) do { const int cs_ = (idx_) >> 3, tl_ = tlw + ((idx_) & 7); const unsigned coff_ = (unsigned)(cs_ * 128 + l7 * 16); \
            hh_ = *(const v4u*)(hq8 + (size_t)(ch * 64 + tl_) * D + coff_); \
            _Pragma("unroll") for (int i_ = 0; i_ < 16; ++i_) { const unsigned e_ = (unsigned)eg_e[tl_ * 128 + 8 * i_ + g]; buf[i_] = *(const v4u*)(ut + (size_t)(e_ * 2048u + coff_)); } } while (0)
#define CU_COMP(buf, hh_, idx_) do { const int tl_ = tlw + ((idx_) & 7); int acc_[16]; \
            _Pragma("unroll") for (int i_ = 0; i_ < 16; ++i_) { int s_ = 0; _Pragma("unroll") for (int q_ = 0; q_ < 4; ++q_) s_ = sdot4i(buf[i_][q_], hh_[q_], s_); acc_[i_] = s_; } \
            treduce16<int, 1>(acc_, lane); \
            apart[tl_ * 128 + 8 * l7 + g] += acc_[0]; apart[tl_ * 128 + 8 * (8 + l7) + g] += acc_[1]; } while (0)
        CU_LOAD(bufA, hA, 0);
        for (int idx = 0; idx < 128; idx += 2) {
            CU_LOAD(bufB, hB, idx + 1);
            CU_COMP(bufA, hA, idx);
            if (idx + 2 < 128) CU_LOAD(bufA, hA, idx + 2);
            CU_COMP(bufB, hB, idx + 1);
        }
#undef CU_LOAD
#undef CU_COMP
        LDS_WAIT(); asm volatile("" ::: "memory");
        for (int it = 0; it < 8; ++it) { const int tl = tlw + it; const float shs = hsc[ch * 64 + tl];
            const int e0 = eg_e[tl * 128 + lane], e1 = eg_e[tl * 128 + 64 + lane];
            const float w0 = sw[tl * 128 + lane] * gelu_tanh_f((float)apart[tl * 128 + lane] * su[e0] * shs) * sv[e0];
            const float w1 = sw[tl * 128 + 64 + lane] * gelu_tanh_f((float)apart[tl * 128 + 64 + lane] * su[e1] * shs) * sv[e1];
            sw[tl * 128 + lane] = w0; sw[tl * 128 + 64 + lane] = w1;
            const float ws = wave_sum(w0 + w1);
            if (lane == 0) wtotl[tl] = ws; }
        LDS_WAIT(); asm volatile("" ::: "memory");
    }
    {
        int laneL = lane0; asm volatile("" : "+v"(laneL)); const int lane = laneL;
        const int g = lane >> 3, l7 = lane & 7;
        v4u bufA[16], bufB[16];
#define CV_LOAD(buf, idx_) do { const int cs_ = (idx_) >> 3, tl_ = tlw + ((idx_) & 7); const unsigned coff_ = (unsigned)(cs_ * 128 + l7 * 16); \
            _Pragma("unroll") for (int i_ = 0; i_ < 16; ++i_) { const unsigned e_ = (unsigned)eg_e[tl_ * 128 + 8 * i_ + g]; buf[i_] = *(const v4u*)(vt + (size_t)(e_ * 2048u + coff_)); } } while (0)
#define CV_COMP(buf, idx_) do { const int cs_ = (idx_) >> 3, tl_ = tlw + ((idx_) & 7); float y_[16]; \
            _Pragma("unroll") for (int q_ = 0; q_ < 16; ++q_) y_[q_] = 0.f; \
            _Pragma("unroll") for (int i_ = 0; i_ < 16; ++i_) { const float wr_ = sw[tl_ * 128 + 8 * i_ + g]; \
                _Pragma("unroll") for (int q_ = 0; q_ < 4; ++q_) fma_ub4(buf[i_][q_], wr_, y_[4 * q_], y_[4 * q_ + 1], y_[4 * q_ + 2], y_[4 * q_ + 3]); } \
            treduce16<float, 8>(y_, lane); \
            const float woff_ = 128.0f * wtotl[tl_]; bf16* yr_ = (bf16*)Ybuf + (size_t)(ch * 64 + tl_) * D + cs_ * 128 + l7 * 16 + g; \
            yr_[0] = (bf16)(pk2(y_[0] - woff_, 0.f) & 0xffffu); yr_[8] = (bf16)(pk2(y_[1] - woff_, 0.f) & 0xffffu); } while (0)
        CV_LOAD(bufA, 0);
        for (int idx = 0; idx < 128; idx += 2) {
            CV_LOAD(bufB, idx + 1);
            CV_COMP(bufA, idx);
            if (idx + 2 < 128) CV_LOAD(bufA, idx + 2);
            CV_COMP(bufB, idx + 1);
        }
#undef CV_LOAD
#undef CV_COMP
    }
    asm volatile("s_waitcnt vmcnt(0)" ::: "memory");
    __builtin_amdgcn_fence(__ATOMIC_ACQUIRE, "agent");
    asm volatile("s_waitcnt vmcnt(0)" ::: "memory");
    for (int it = 0; it < 8; ++it) { int laneT = lane0; asm volatile("" : "+v"(laneT)); const int t = ch * 64 + tlw + it;
        peer_tail(a, l, t, laneT, (const float*)((const bf16*)Ybuf + (size_t)t * D), mb, mbn, last); }
}

#endif

#ifndef MK_PER_PHASE
#define MK_PER_PHASE 0
#endif
__global__ void __launch_bounds__(NTHREADS, 2) mk_fwd(Args a) {
    extern __shared__ __attribute__((aligned(16))) unsigned char lds_raw[];
    LAS unsigned char* lds = (LAS unsigned char*)lds_raw;
    const int tid = threadIdx.x, lane = tid & 63, wave = __builtin_amdgcn_readfirstlane(tid >> 6), G = gridDim.x, bx = blockIdx.x;
    if (tid < 64) ((LAS unsigned*)(lds + LDSCTL_OFF))[tid] = 0u;
    __syncthreads();
    unsigned* ctl = (unsigned*)(a.ws + WS_CTL);
    XcdBarrier bar; bar.bar = ctl + CW_BAR; bar.x = 0; bar.st = nullptr;
    const bool use_bar = (a.ph_hi - a.ph_lo) > 1;
    if (use_bar) bar = xcd_barrier_post(ctl + CW_BAR, (volatile LAS unsigned*)(lds + LDSCTL_OFF));
    const int lo = a.ph_lo, hi = a.ph_hi;
#ifndef PH_MASK
#define PH_MASK 0x1ff
#endif
#define IN(k) (lo <= (k) && (k) < hi)
#define EN(b) ((PH_MASK >> (b)) & 1)
#ifndef REP_MASK
#define REP_MASK 0
#endif
#ifndef REP_EXTRA
#define REP_EXTRA 2
#endif
#define REPS(b) (1 + ((REP_MASK >> (b)) & 1) * REP_EXTRA)
#define REP_BEGIN(b) for (int rep_ = 0; rep_ < REPS(b); ++rep_) {
#define REP_END(b) if (rep_ + 1 < REPS(b)) xcd_barrier(bar); }
#define SEAM(k) do { if (IN((k) + 1)) xcd_barrier(bar); } while (0)
#define PHASE_IDS() int tidp = tid; asm volatile("" : "+v"(tidp)); const int lanep = tidp & 63, wavep = __builtin_amdgcn_readfirstlane(tidp >> 6); (void)lanep; (void)wavep
    if (EN(0) && IN(0)) { REP_BEGIN(0) PHASE_IDS(); ph_prologue_a(a, lds, tidp, lanep, wavep, bx, G); REP_END(0) SEAM(0); }
    if (EN(1) && IN(1)) { REP_BEGIN(1) PHASE_IDS(); ph_prologue_b(a, lds, tidp, lanep, wavep, bx, G); REP_END(1) SEAM(1); }
    for (int l = 0; l < NL; ++l) {
        const int pb = 2 + 7 * l;
        const float* mod = (const float*)(a.ws + WS_MOD);
        if (EN(2) && IN(pb + 0)) {
            REP_BEGIN(2) PHASE_IDS();
#if I8_IN
            pg8::Gemm g{(const pg8::bf16_t*)(a.ws + WS_H8), (const pg8::bf16_t*)(a.ws + WS_WIN8 + (size_t)l * NP * D), T, NP, D / 2}; pg8::StaticOrder S; S.init(T, NP, G, bx, WGM_IN, KROT(bx));
            pg8::EpiBf16PS E{(pg8::bf16_t*)(a.ws + WS_PROJ), NP, (const float*)(a.ws + WS_SAH), (const float*)(a.ws + WS_SB) + l * SBL};
            pg8::gemm_phase<pg8::EpiBf16PS, pg8::StaticOrder, true, true, true>(lds + RING_OFF, g, S, E, tidp);
#else
            pg8::Gemm g{(const pg8::bf16_t*)(a.ws + WS_H), (const pg8::bf16_t*)(a.ws + WS_WIN) + (size_t)l * INW * D, T, NP, D}; pg8::StaticOrder S; S.init(T, NP, G, bx, WGM_IN, KROT(bx));
            pg8::EpiBf16P E{(pg8::bf16_t*)(a.ws + WS_PROJ), NP};
            pg8::gemm_phase<pg8::EpiBf16P, pg8::StaticOrder, true, true>(lds + RING_OFF, g, S, E, tidp);
#endif
#ifndef GP_REP
#define GP_REP 1
#endif
            for (int gpr_ = 0; gpr_ < GP_REP; ++gpr_) for (int ch = bx; ch < NCHUNK; ch += G) gate_prep(a, l, lds, tidp, lanep, wavep, ch);
            REP_END(2) SEAM(pb + 0);
        }
        if (EN(3) && IN(pb + 1)) { REP_BEGIN(3) PHASE_IDS(); for (int un = bx; un < 256; un += G) gla_unit(a, lds, tidp, lanep, wavep, un); REP_END(3) SEAM(pb + 1); }
        if (EN(4) && IN(pb + 2)) { REP_BEGIN(4) PHASE_IDS(); for (int ch = bx; ch < NCHUNK; ch += G) mixpost_chunk(a, l, lanep, wavep, ch); REP_END(4) SEAM(pb + 2); }
        if (EN(5) && IN(pb + 3)) {
            REP_BEGIN(5) PHASE_IDS();
#if I8_OUT
            pg8::Gemm g{(const pg8::bf16_t*)(a.ws + WS_Y8), (const pg8::bf16_t*)(a.ws + WS_WOUT8 + (size_t)l * D * D), T, D, D / 2}; pg8::StaticOrder S; S.init(T, D, G, bx, WGM_OUT, KROT(bx));
#if RES16_X || RES16_Z
            pg8::EpiResidS16<(RES16_X != 0), (RES16_Z != 0)> E{(void*)(a.ws + WS_Z), (RES16_X || l > 0) ? (const void*)(a.ws + WS_X) : (const void*)a.in[0], mod + (size_t)l * NB * 6 * D + 2 * D, (const float*)(a.ws + WS_SAY), (const float*)(a.ws + WS_SB) + l * SBL + NP, ALPHA};
            pg8::gemm_phase<pg8::EpiResidS16<(RES16_X != 0), (RES16_Z != 0)>, pg8::StaticOrder, true, true, true>(lds + RING_OFF, g, S, E, tidp);
#else
            pg8::EpiResidS E{(float*)(a.ws + WS_Z), l == 0 ? a.in[0] : (const float*)(a.ws + WS_X), mod + (size_t)l * NB * 6 * D + 2 * D, (const float*)(a.ws + WS_SAY), (const float*)(a.ws + WS_SB) + l * SBL + NP, ALPHA};
            pg8::gemm_phase<pg8::EpiResidS, pg8::StaticOrder, true, true, true>(lds + RING_OFF, g, S, E, tidp);
#endif
#else
            pg8::Gemm g{(const pg8::bf16_t*)(a.ws + WS_Y), (const pg8::bf16_t*)(a.ws + WS_WOUT) + (size_t)l * D * D, T, D, D}; pg8::StaticOrder S; S.init(T, D, G, bx, WGM_OUT, KROT(bx));
            pg8::EpiResid E{(float*)(a.ws + WS_Z), l == 0 ? a.in[0] : (const float*)(a.ws + WS_X), mod + (size_t)l * NB * 6 * D + 2 * D, ALPHA};
            pg8::gemm_phase<pg8::EpiResid, pg8::StaticOrder, true, true>(lds + RING_OFF, g, S, E, tidp);
#endif
            REP_END(5) SEAM(pb + 3);
        }
        if (EN(6) && IN(pb + 4)) { REP_BEGIN(6) PHASE_IDS(); for (int ch = bx; ch < NCHUNK; ch += G) ln1_chunk(a, l, lds, lanep, wavep, ch); REP_END(6) SEAM(pb + 4); }
        if (EN(7) && IN(pb + 5)) {
            REP_BEGIN(7) PHASE_IDS();
#if I8_WQ
            pg8::Gemm g{(const pg8::bf16_t*)(a.ws + WS_H28), (const pg8::bf16_t*)(a.ws + WS_WQ8 + (size_t)l * D * D), T, D, D / 2}; pg8::StaticOrder S; S.init(T, D, G, bx, WGM_WQ, KROT(bx));
            pg8::EpiBf16PS E{(pg8::bf16_t*)(a.ws + WS_Q), D, (const float*)(a.ws + WS_HSC), (const float*)(a.ws + WS_SB) + l * SBL + NP + D};
            pg8::gemm_phase<pg8::EpiBf16PS, pg8::StaticOrder, true, true, true>(lds + RING_OFF, g, S, E, tidp);
#else
            pg8::Gemm g{(const pg8::bf16_t*)(a.ws + WS_H2), (const pg8::bf16_t*)(a.ws + WS_WQ) + (size_t)l * D * D, T, D, D}; pg8::StaticOrder S; S.init(T, D, G, bx, WGM_WQ, KROT(bx));
            pg8::EpiBf16P E{(pg8::bf16_t*)(a.ws + WS_Q), D};
            pg8::gemm_phase<pg8::EpiBf16P, pg8::StaticOrder, true, true>(lds + RING_OFF, g, S, E, tidp);
#endif
            REP_END(7) SEAM(pb + 5);
        }
#ifndef PEER_DBG
#define PEER_DBG 0
#endif
#ifndef PE_REP_R
#define PE_REP_R 1
#endif
#ifndef L2PROBE
#define L2PROBE 0
#endif
        if (EN(8) && IN(pb + 6)) {
            REP_BEGIN(8)
            for (int ch = bx; ch < NCHUNK; ch += G) { for (int repr_ = 0; repr_ < PE_REP_R; ++repr_) { PHASE_IDS(); peer_retrieve(a, l, lds, lanep, wavep, ch); __syncthreads(); } __syncthreads(); { PHASE_IDS(); peer_experts(a, l, lds, lanep, wavep, ch); } __syncthreads(); }
            REP_END(8) SEAM(pb + 6);
        }
    }
#undef IN
#undef SEAM
}

extern "C" void kernel_launch(void* const* d_in, const int* in_sizes, int n_in, void* d_out, int out_size, void* d_ws, size_t ws_size, hipStream_t stream) {
    static int grid = 0;
    if (grid == 0) {
        if (n_in != 19 || in_sizes[0] != T * D || out_size != T * D || ws_size < WS_END) { fprintf(stderr, "kernel_launch: unexpected shapes / workspace (%d inputs, ws %zu); nothing launched\n", n_in, ws_size); grid = -1; return; }
        int dev = 0, cus = 0, per_cu = 0;
        if (hipGetDevice(&dev) != hipSuccess || hipDeviceGetAttribute(&cus, hipDeviceAttributeMultiprocessorCount, dev) != hipSuccess) { grid = -1; return; }
        if (hipFuncSetAttribute((const void*)mk_fwd, hipFuncAttributeMaxDynamicSharedMemorySize, LDS_BYTES) != hipSuccess) { fprintf(stderr, "kernel_launch: hipFuncSetAttribute failed\n"); grid = -1; return; }
        if (hipOccupancyMaxActiveBlocksPerMultiprocessor(&per_cu, (const void*)mk_fwd, NTHREADS, LDS_BYTES) != hipSuccess || per_cu < 1) fprintf(stderr, "kernel_launch: occupancy query reports %d\n", per_cu);
        (void)hipGetLastError();
        grid = cus;
    }
    if (grid < 0) return;
    if (hipMemsetAsync((char*)d_ws + WS_CTL, 0, CTL_ZERO_BYTES, stream) != hipSuccess) return;
    Args a{};
    for (int i = 0; i < 19; ++i) a.in[i] = (const float*)d_in[i];
    a.out = (float*)d_out; a.ws = (unsigned char*)d_ws;
#if MK_PER_PHASE
    for (int p = 0; p < NPHASES; ++p) { a.ph_lo = p; a.ph_hi = p + 1; hipLaunchKernelGGL(mk_fwd, dim3(grid), dim3(NTHREADS), LDS_BYTES, stream, a); }
#else
    a.ph_lo = 0; a.ph_hi = NPHASES;
    hipLaunchKernelGGL(mk_fwd, dim3(grid), dim3(NTHREADS), LDS_BYTES, stream, a);
#endif
}
```

```cpp
#include <hip/hip_runtime.h>
#include <cstdio>
#include <cstdint>
namespace pg8 {
#define PG8_LAS __attribute__((address_space(3)))
typedef unsigned short bf16_t;
typedef short bf16x8 __attribute__((ext_vector_type(8)));
typedef float f32x4 __attribute__((ext_vector_type(4)));
typedef unsigned u32x4 __attribute__((ext_vector_type(4)));
typedef int i32x4 __attribute__((ext_vector_type(4)));
constexpr int BM = 256, BK = 64, HALF = 128, HTB = HALF * BK * 2  , STAGE_BYTES = 8 * HTB, NXCD = 8, WGM = 8;

__host__ __device__ __forceinline__ int lds_byte(int r, int c) { const int st = (r >> 4) * 2 + (c >> 5), rr = r & 15, cc = c & 31, ob = rr * 64 + cc * 2; return st * 1024 + (ob ^ (((ob >> 9) & 1) << 5)); }
__host__ __device__ __forceinline__ void stage_rc(int b, int& R, int& C) { const int st = b / 1024, sb = b % 1024, swz = sb ^ (((sb >> 9) & 1) << 5); R = (st >> 1) * 16 + swz / 64; C = (st & 1) * 32 + (swz % 64) / 2; }
__host__ __device__ __forceinline__ int perm32(int rho) { const int n = rho >> 4, i = rho & 15; return 8 * (i >> 2) + 4 * n + (i & 3); }

struct Unit { int pm, pn; };
struct Gemm { const bf16_t* A; const bf16_t* Bt; int M, N, K; };

struct StaticOrder {
    int nM, nN, nwg, G, c, wgm, krot;
    __host__ __device__ void init(int M, int N, int G_, int c_, int wgm_ = WGM, int krot_ = 0) { nM = M / BM; nN = N / BM; nwg = nM * nN; G = G_; c = c_; wgm = wgm_; krot = krot_; }
    __host__ __device__ bool next(int i, Unit& u) const {
        const long L = (long)i * G + c; if (L >= nwg) return false;
        int wgid = (int)L; { const int q = nwg / NXCD, r = nwg % NXCD, xcd = wgid % NXCD, off = wgid / NXCD; wgid = (xcd < r ? xcd * (q + 1) : r * (q + 1) + (xcd - r) * q) + off; }
        const int nig = wgm * nN, gid = wgid / nig, fm = gid * wgm, gsz = (nM - fm) < wgm ? (nM - fm) : wgm;
        u.pm = fm + ((wgid % nig) % gsz); u.pn = (wgid % nig) / gsz; return true;
    }
    __device__ __forceinline__ void a_ready(const Unit&) const {}
    __device__ __forceinline__ void done(const Unit&) const {}
};
typedef __bf16 bf16x2_t __attribute__((ext_vector_type(2)));
__device__ __forceinline__ unsigned cvt_pk_bf16(float lo, float hi) { bf16x2_t r; r.x = (__bf16)lo; r.y = (__bf16)hi; return __builtin_bit_cast(unsigned, r); }
struct EpiBf16P {
    static constexpr bool PERM = true, AFTER_DRAIN = false;
    bf16_t* O; int ldc;
    __device__ __forceinline__ void operator()(const f32x4 (&acc)[2][2][4][2], const Unit& u, int wr, int wc, int fr, int fq) const {
        const int row0 = u.pm * BM + wr * 64 + fr, col0 = u.pn * BM + wc * 32 + 8 * fq;
#pragma unroll
        for (int ai = 0; ai < 2; ++ai)
#pragma unroll
            for (int m = 0; m < 4; ++m) { bf16_t* rowp = O + (size_t)(row0 + ai * HALF + m * 16) * ldc + col0;
#pragma unroll
                for (int bj = 0; bj < 2; ++bj) { const f32x4 v0 = acc[ai][bj][m][0], v1 = acc[ai][bj][m][1];
                    u32x4 w; w.x = cvt_pk_bf16(v0[0], v0[1]); w.y = cvt_pk_bf16(v0[2], v0[3]); w.z = cvt_pk_bf16(v1[0], v1[1]); w.w = cvt_pk_bf16(v1[2], v1[3]);
                    *(u32x4*)(rowp + bj * HALF) = w; } }
    }
};
struct EpiResid {
    static constexpr bool PERM = false, AFTER_DRAIN = false;
    float* Z; const float* X; const float* gate; float alpha;
    __device__ __forceinline__ void operator()(const f32x4 (&acc)[2][2][4][2], const Unit& u, int wr, int wc, int fr, int fq) const {
        const int row0 = u.pm * BM + wr * 64 + fr, col0 = u.pn * BM + wc * 32 + 4 * fq;
        const float* gb = gate + (size_t)(u.pm >> 3) * (6 * 2048) + col0;
        f32x4 gv[2][2];
#pragma unroll
        for (int bj = 0; bj < 2; ++bj)
#pragma unroll
            for (int n = 0; n < 2; ++n) gv[bj][n] = *(const f32x4*)(gb + bj * HALF + n * 16) + 1.0f;
#pragma unroll
        for (int ai = 0; ai < 2; ++ai)
#pragma unroll
            for (int m = 0; m < 4; ++m) { const size_t off = (size_t)(row0 + ai * HALF + m * 16) * 2048 + col0;
#pragma unroll
                for (int bj = 0; bj < 2; ++bj)
#pragma unroll
                    for (int n = 0; n < 2; ++n) { const f32x4 xv = *(const f32x4*)(X + off + bj * HALF + n * 16);
                        *(f32x4*)(Z + off + bj * HALF + n * 16) = xv * alpha + gv[bj][n] * acc[ai][bj][m][n]; }
                asm volatile("" ::: "memory"); }
    }
};
#ifndef PG8_NT
#define PG8_NT 0
#endif
#if PG8_NT
#define PG8_ST(TY, p, v) __builtin_nontemporal_store((v), (TY*)(p))
#else
#define PG8_ST(TY, p, v) (*(TY*)(p) = (v))
#endif
__device__ __forceinline__ f32x4 acc_i2f(const f32x4 v) { const i32x4 iv = __builtin_bit_cast(i32x4, v); return __builtin_convertvector(iv, f32x4); }
struct EpiBf16PS {
    static constexpr bool PERM = true, AFTER_DRAIN = false;
    bf16_t* O; int ldc; const float* sa; const float* sb;
    __device__ __forceinline__ void operator()(const f32x4 (&acc)[2][2][4][2], const Unit& u, int wr, int wc, int fr, int fq) const {
        const int row0 = u.pm * BM + wr * 64 + fr, col0 = u.pn * BM + wc * 32 + 8 * fq;
        f32x4 sbv[2][2];
#pragma unroll
        for (int bj = 0; bj < 2; ++bj)
#pragma unroll
            for (int n = 0; n < 2; ++n) sbv[bj][n] = *(const f32x4*)(sb + col0 + bj * HALF + 4 * n);
#pragma unroll
        for (int ai = 0; ai < 2; ++ai)
#pragma unroll
            for (int m = 0; m < 4; ++m) { const int row = row0 + ai * HALF + m * 16; bf16_t* rowp = O + (size_t)row * ldc + col0; const float sar = sa[row];
#pragma unroll
                for (int bj = 0; bj < 2; ++bj) { const f32x4 v0 = acc_i2f(acc[ai][bj][m][0]) * (sbv[bj][0] * sar), v1 = acc_i2f(acc[ai][bj][m][1]) * (sbv[bj][1] * sar);
                    u32x4 w; w.x = cvt_pk_bf16(v0[0], v0[1]); w.y = cvt_pk_bf16(v0[2], v0[3]); w.z = cvt_pk_bf16(v1[0], v1[1]); w.w = cvt_pk_bf16(v1[2], v1[3]);
                    PG8_ST(u32x4, rowp + bj * HALF, w); } }
    }
};
struct EpiResidS {
    static constexpr bool PERM = false, AFTER_DRAIN = false;
    float* Z; const float* X; const float* gate; const float* sa; const float* sb; float alpha;
    __device__ __forceinline__ void operator()(const f32x4 (&acc)[2][2][4][2], const Unit& u, int wr, int wc, int fr, int fq) const {
        const int row0 = u.pm * BM + wr * 64 + fr, col0 = u.pn * BM + wc * 32 + 4 * fq;
        const float* gb = gate + (size_t)(u.pm >> 3) * (6 * 2048) + col0;
        f32x4 gv[2][2];
#pragma unroll
        for (int bj = 0; bj < 2; ++bj)
#pragma unroll
            for (int n = 0; n < 2; ++n) gv[bj][n] = (*(const f32x4*)(gb + bj * HALF + n * 16) + 1.0f) * *(const f32x4*)(sb + col0 + bj * HALF + n * 16);
#pragma unroll
        for (int ai = 0; ai < 2; ++ai)
#pragma unroll
            for (int m = 0; m < 4; ++m) { const int row = row0 + ai * HALF + m * 16; const size_t off = (size_t)row * 2048 + col0; const float sar = sa[row];
#pragma unroll
                for (int bj = 0; bj < 2; ++bj)
#pragma unroll
                    for (int n = 0; n < 2; ++n) { const f32x4 xv = *(const f32x4*)(X + off + bj * HALF + n * 16);
                        PG8_ST(f32x4, Z + off + bj * HALF + n * 16, xv * alpha + (gv[bj][n] * sar) * acc_i2f(acc[ai][bj][m][n])); }
                asm volatile("" ::: "memory"); }
    }
};
template <bool XB, bool ZB> struct EpiResidS16 {
    static constexpr bool PERM = true, AFTER_DRAIN = false;
    void* Z; const void* X; const float* gate; const float* sa; const float* sb; float alpha;
    __device__ __forceinline__ void operator()(const f32x4 (&acc)[2][2][4][2], const Unit& u, int wr, int wc, int fr, int fq) const {
        const int row0 = u.pm * BM + wr * 64 + fr, col0 = u.pn * BM + wc * 32 + 8 * fq;
        const float* gb = gate + (size_t)(u.pm >> 3) * (6 * 2048) + col0;
        f32x4 gv[2][2];
#pragma unroll
        for (int bj = 0; bj < 2; ++bj)
#pragma unroll
            for (int n = 0; n < 2; ++n) gv[bj][n] = (*(const f32x4*)(gb + bj * HALF + 4 * n) + 1.0f) * *(const f32x4*)(sb + col0 + bj * HALF + 4 * n);
#pragma unroll
        for (int ai = 0; ai < 2; ++ai)
#pragma unroll
            for (int m = 0; m < 4; ++m) { const int row = row0 + ai * HALF + m * 16; const size_t off = (size_t)row * 2048 + col0; const float sar = sa[row];
#pragma unroll
                for (int bj = 0; bj < 2; ++bj) { f32x4 x0, x1;
                    if constexpr (XB) { const u32x4 xw = *(const u32x4*)((const bf16_t*)X + off + bj * HALF);
                        x0 = (f32x4){__uint_as_float(xw.x << 16), __uint_as_float(xw.x & 0xffff0000u), __uint_as_float(xw.y << 16), __uint_as_float(xw.y & 0xffff0000u)};
                        x1 = (f32x4){__uint_as_float(xw.z << 16), __uint_as_float(xw.z & 0xffff0000u), __uint_as_float(xw.w << 16), __uint_as_float(xw.w & 0xffff0000u)}; }
                    else { x0 = *(const f32x4*)((const float*)X + off + bj * HALF); x1 = *(const f32x4*)((const float*)X + off + bj * HALF + 4); }
                    const f32x4 v0 = x0 * alpha + (gv[bj][0] * sar) * acc_i2f(acc[ai][bj][m][0]), v1 = x1 * alpha + (gv[bj][1] * sar) * acc_i2f(acc[ai][bj][m][1]);
                    if constexpr (ZB) { u32x4 w; w.x = cvt_pk_bf16(v0[0], v0[1]); w.y = cvt_pk_bf16(v0[2], v0[3]); w.z = cvt_pk_bf16(v1[0], v1[1]); w.w = cvt_pk_bf16(v1[2], v1[3]);
                        PG8_ST(u32x4, (bf16_t*)Z + off + bj * HALF, w); }
                    else { PG8_ST(f32x4, (float*)Z + off + bj * HALF, v0); PG8_ST(f32x4, (float*)Z + off + bj * HALF + 4, v1); } }
                asm volatile("" ::: "memory"); }
    }
};
template <class Epi, class Sched, bool ALIGN_EPI = false, bool SP2 = false, bool I8 = false>
__device__ __forceinline__ void gemm_phase(PG8_LAS unsigned char* lds, const Gemm g, const Sched& S, const Epi& E, const int tid_in) {
    const int tid = tid_in, wid = __builtin_amdgcn_readfirstlane(tid >> 6), lane = tid & 63, wr = wid >> 2, wc = wid & 3, fr = lane & 15, fq = lane >> 4;
    const int K = g.K, nt = K / BK;
    const int krot = ((nt & (nt - 1)) == 0) ? (S.krot & (nt - 1)) : 0;
#define PG8_KOFS(t) ((size_t)(((t) + krot) & (nt - 1)) * kstep)
    unsigned voffA[2], voffB[2];
#pragma unroll
    for (int i = 0; i < 2; ++i) { int R, C; stage_rc(tid * 16 + i * 8192, R, C); const int Rb = Epi::PERM ? ((R & ~31) + perm32(R & 31)) : R;
        voffA[i] = (unsigned)(R * K + C) * 2u; voffB[i] = (unsigned)(Rb * K + C) * 2u; }
    const size_t kstep = (size_t)(BK * 2);
    const size_t hstep = (size_t)HALF * K * 2;
    const size_t tstep = 2 * hstep;
    const unsigned ldsw = (unsigned)wid * 1024u;
    const int aoff = lds_byte(wr * 64 + fr, fq * 8), boff = lds_byte(wc * 32 + fr, fq * 8);
#define PG8_SA(b, h) (((b) * 2 + (h)) * HTB)
#define PG8_SB(b, h) ((4 + (b) * 2 + (h)) * HTB)
#define PG8_STAGE(bufoff, gbase, voff) do { _Pragma("unroll") for (int _i = 0; _i < 2; ++_i) \
        __builtin_amdgcn_global_load_lds((const unsigned*)((const char*)(gbase) + (voff)[_i]), (PG8_LAS unsigned*)(lds + (bufoff) + ldsw + _i * 8192), 16, 0, 0); } while (0)
#define PG8_LDA(dst, b, h) do { _Pragma("unroll") for (int m = 0; m < 4; ++m) _Pragma("unroll") for (int k = 0; k < 2; ++k) dst[m][k] = *(const PG8_LAS bf16x8*)(lds + PG8_SA(b, h) + aoff + m * 2048 + k * 1024); } while (0)
#define PG8_LDB(dst, b, h) do { _Pragma("unroll") for (int n = 0; n < 2; ++n) _Pragma("unroll") for (int k = 0; k < 2; ++k) dst[n][k] = *(const PG8_LAS bf16x8*)(lds + PG8_SB(b, h) + boff + n * 2048 + k * 1024); } while (0)
#define PG8_MMA(ai, bj, At, Bt) do { __builtin_amdgcn_s_setprio(1); _Pragma("unroll") for (int m = 0; m < 4; ++m) _Pragma("unroll") for (int n = 0; n < 2; ++n) _Pragma("unroll") for (int k = 0; k < 2; ++k) \
        { if constexpr (I8) acc[ai][bj][m][n] = __builtin_bit_cast(f32x4, __builtin_amdgcn_mfma_i32_16x16x64_i8(__builtin_bit_cast(i32x4, Bt[n][k]), __builtin_bit_cast(i32x4, At[m][k]), __builtin_bit_cast(i32x4, acc[ai][bj][m][n]), 0, 0, 0)); \
          else acc[ai][bj][m][n] = __builtin_amdgcn_mfma_f32_16x16x32_bf16(Bt[n][k], At[m][k], acc[ai][bj][m][n], 0, 0, 0); } __builtin_amdgcn_s_setprio(0); } while (0)
#define PG8_WAIT_V(n) asm volatile("s_waitcnt vmcnt(" #n ")" ::: "memory")
#define PG8_WAIT_L(n) asm volatile("s_waitcnt lgkmcnt(" #n ")" ::: "memory")
#define PG8_BAR __builtin_amdgcn_s_barrier()
#define PG8_SCHED __builtin_amdgcn_sched_barrier(0)
    Unit cur, nxt; int ui = 0;
    if (!S.next(0, cur)) return;
    f32x4 acc[2][2][4][2];
#pragma unroll
    for (int a = 0; a < 2; ++a)
#pragma unroll
        for (int b = 0; b < 2; ++b)
#pragma unroll
            for (int m = 0; m < 4; ++m)
#pragma unroll
                for (int n = 0; n < 2; ++n) acc[a][b][m][n] = (f32x4){0.f, 0.f, 0.f, 0.f};
    bf16x8 At[4][2], B0[2][2], B1[2][2];
    const char* cA = (const char*)g.A + (size_t)cur.pm * tstep; const char* cB = (const char*)g.Bt + (size_t)cur.pn * tstep;
    S.a_ready(cur);
    if constexpr (SP2) {
        PG8_STAGE(PG8_SB(0, 0), cB + PG8_KOFS(0), voffB); PG8_STAGE(PG8_SB(0, 1), cB + hstep + PG8_KOFS(0), voffB); PG8_STAGE(PG8_SA(0, 0), cA + PG8_KOFS(0), voffA); PG8_STAGE(PG8_SA(0, 1), cA + hstep + PG8_KOFS(0), voffA);
        if (wr == 1) PG8_BAR;
        PG8_WAIT_V(2); PG8_BAR;
        PG8_STAGE(PG8_SB(1, 0), cB + PG8_KOFS(1), voffB); PG8_STAGE(PG8_SA(1, 0), cA + PG8_KOFS(1), voffA); PG8_STAGE(PG8_SB(1, 1), cB + hstep + PG8_KOFS(1), voffB);
        PG8_WAIT_V(6); PG8_BAR;
    } else {
        PG8_STAGE(PG8_SB(0, 0), cB + PG8_KOFS(0), voffB); PG8_STAGE(PG8_SA(0, 0), cA + PG8_KOFS(0), voffA); PG8_STAGE(PG8_SB(0, 1), cB + hstep + PG8_KOFS(0), voffB); PG8_STAGE(PG8_SA(0, 1), cA + hstep + PG8_KOFS(0), voffA);
        if (wr == 1) PG8_BAR;
        PG8_WAIT_V(4); PG8_BAR;
        PG8_STAGE(PG8_SB(1, 0), cB + PG8_KOFS(1), voffB); PG8_STAGE(PG8_SA(1, 0), cA + PG8_KOFS(1), voffA); PG8_STAGE(PG8_SB(1, 1), cB + hstep + PG8_KOFS(1), voffB);
        PG8_WAIT_V(6); PG8_BAR;
    }
    for (;;) {
        const bool has_next = S.next(ui + 1, nxt);
        const char* nA = has_next ? (const char*)g.A + (size_t)nxt.pm * tstep : cA; const char* nB = has_next ? (const char*)g.Bt + (size_t)nxt.pn * tstep : cB;
#ifdef PG8_KREP
        for (int kr_ = 0; kr_ < PG8_KREP; ++kr_) {
        if (kr_) {
#pragma unroll
        for (int a = 0; a < 2; ++a)
#pragma unroll
            for (int b = 0; b < 2; ++b)
#pragma unroll
                for (int m = 0; m < 4; ++m)
#pragma unroll
                    for (int n = 0; n < 2; ++n) acc[a][b][m][n] = (f32x4){0.f, 0.f, 0.f, 0.f}; }
        const char* nA_ = (kr_ + 1 < PG8_KREP) ? cA : nA; const char* nB_ = (kr_ + 1 < PG8_KREP) ? cB : nB;
#else
        const char* nA_ = nA; const char* nB_ = nB;
#endif
        for (int t = 0; t < nt; t += 2) {
            const bool last = (t == nt - 2);
            const char* a1 = cA + PG8_KOFS(t + 1);
            const char* a2 = (last ? nA_ : cA) + PG8_KOFS(t + 2); const char* b2 = (last ? nB_ : cB) + PG8_KOFS(t + 2);
            const char* a3 = (last ? nA_ : cA) + PG8_KOFS(t + 3); const char* b3 = (last ? nB_ : cB) + PG8_KOFS(t + 3);
            if (last && has_next) S.a_ready(nxt);
            if constexpr (SP2) {
            PG8_LDB(B0, 0, 0); PG8_LDB(B1, 0, 1); PG8_SCHED; PG8_LDA(At, 0, 0); PG8_STAGE(PG8_SA(1, 1), a1 + hstep, voffA);
            PG8_WAIT_V(8); PG8_WAIT_L(0); PG8_BAR; PG8_MMA(0, 0, At, B0); PG8_MMA(0, 1, At, B1); PG8_BAR; PG8_SCHED;
            PG8_LDA(At, 0, 1); PG8_STAGE(PG8_SB(0, 0), b2, voffB); PG8_STAGE(PG8_SB(0, 1), b2 + hstep, voffB); PG8_STAGE(PG8_SA(0, 0), a2, voffA);
            PG8_WAIT_V(8); PG8_WAIT_L(0); PG8_BAR; PG8_MMA(1, 0, At, B0); PG8_MMA(1, 1, At, B1); PG8_BAR; PG8_SCHED;
            PG8_LDB(B0, 1, 0); PG8_LDB(B1, 1, 1); PG8_SCHED; PG8_LDA(At, 1, 0); PG8_STAGE(PG8_SA(0, 1), a2 + hstep, voffA);
            PG8_WAIT_V(8); PG8_WAIT_L(0); PG8_BAR; PG8_MMA(0, 0, At, B0); PG8_MMA(0, 1, At, B1); PG8_BAR; PG8_SCHED;
            PG8_LDA(At, 1, 1); PG8_STAGE(PG8_SB(1, 0), b3, voffB); PG8_STAGE(PG8_SB(1, 1), b3 + hstep, voffB); PG8_STAGE(PG8_SA(1, 0), a3, voffA);
            PG8_WAIT_V(8); PG8_WAIT_L(0); PG8_BAR; PG8_MMA(1, 0, At, B0); PG8_MMA(1, 1, At, B1); PG8_BAR; PG8_SCHED;
            } else {
            PG8_LDB(B0, 0, 0); PG8_SCHED; PG8_LDA(At, 0, 0); PG8_STAGE(PG8_SA(1, 1), a1 + hstep, voffA);
            PG8_WAIT_L(8); PG8_BAR; PG8_WAIT_L(0); PG8_MMA(0, 0, At, B0); PG8_BAR; PG8_SCHED;
            PG8_LDB(B1, 0, 1); PG8_STAGE(PG8_SB(0, 0), b2, voffB);
            PG8_BAR; PG8_WAIT_L(0); PG8_MMA(0, 1, At, B1); PG8_BAR;
            PG8_LDA(At, 0, 1); PG8_STAGE(PG8_SA(0, 0), a2, voffA);
            PG8_BAR; PG8_WAIT_L(0); PG8_MMA(1, 0, At, B0); PG8_BAR; PG8_SCHED;
            PG8_STAGE(PG8_SB(0, 1), b2 + hstep, voffB);
            PG8_WAIT_V(6); PG8_BAR; PG8_MMA(1, 1, At, B1); PG8_BAR;
            PG8_LDB(B0, 1, 0); PG8_SCHED; PG8_LDA(At, 1, 0); PG8_STAGE(PG8_SA(0, 1), a2 + hstep, voffA);
            PG8_WAIT_L(8); PG8_BAR; PG8_WAIT_L(0); PG8_MMA(0, 0, At, B0); PG8_BAR; PG8_SCHED;
            PG8_LDB(B1, 1, 1); PG8_STAGE(PG8_SB(1, 0), b3, voffB);
            PG8_BAR; PG8_WAIT_L(0); PG8_MMA(0, 1, At, B1); PG8_BAR;
            PG8_LDA(At, 1, 1); PG8_STAGE(PG8_SA(1, 0), a3, voffA);
            PG8_BAR; PG8_WAIT_L(0); PG8_MMA(1, 0, At, B0); PG8_BAR; PG8_SCHED;
            PG8_STAGE(PG8_SB(1, 1), b3 + hstep, voffB);
            PG8_WAIT_V(6); PG8_BAR; PG8_MMA(1, 1, At, B1); PG8_BAR;
            }
        }
#ifdef PG8_KREP
        }
#endif
        if constexpr (ALIGN_EPI) { if (wr == 0) PG8_BAR; }
#ifdef PG8_EPI2
        if constexpr (!Epi::AFTER_DRAIN) { E(acc, cur, wr, wc, fr, fq); asm volatile("" ::: "memory"); }
#endif
        if constexpr (!Epi::AFTER_DRAIN) { E(acc, cur, wr, wc, fr, fq); S.done(cur); }
        if (!has_next) break;
#pragma unroll
        for (int a = 0; a < 2; ++a)
#pragma unroll
            for (int b = 0; b < 2; ++b)
#pragma unroll
                for (int m = 0; m < 4; ++m)
#pragma unroll
                    for (int n = 0; n < 2; ++n) acc[a][b][m][n] = (f32x4){0.f, 0.f, 0.f, 0.f};
        cur = nxt; cA = nA; cB = nB; ++ui;
        if constexpr (ALIGN_EPI) { if (wr == 1) PG8_BAR; }
    }
    PG8_WAIT_V(0);
    if constexpr (!ALIGN_EPI) { if (wr == 0) PG8_BAR; }
    PG8_BAR;
    if constexpr (Epi::AFTER_DRAIN) { E.fused(acc, cur, wr, wc, fr, fq, lds, wid, lane); S.done(cur); }
#undef PG8_SA
#undef PG8_SB
#undef PG8_STAGE
#undef PG8_LDA
#undef PG8_LDB
#undef PG8_MMA
#undef PG8_WAIT_V
#undef PG8_WAIT_L
#undef PG8_BAR
#undef PG8_SCHED
#undef PG8_KOFS
}
}
#define XB_TMO      128
#define XB_XCNT(j)  (256  + 64 * (j))
#define XB_XSUB(j)  (1280 + 64 * (j))
#define XB_XGEN(j)  (2304 + 64 * (j))
#define XB_TOP      3328
#define XB_TOPGEN   3392
#define XCD_BAR_WORDS 3456
#define XB_SPIN_CAP (1u << 18)
#define LAS __attribute__((address_space(3)))

__device__ __forceinline__ unsigned xb_ld(unsigned* p)              { return __hip_atomic_load(p, __ATOMIC_RELAXED, __HIP_MEMORY_SCOPE_AGENT); }
__device__ __forceinline__ unsigned xb_add(unsigned* p, unsigned v) { return __hip_atomic_fetch_add(p, v, __ATOMIC_RELAXED, __HIP_MEMORY_SCOPE_AGENT); }
__device__ __forceinline__ unsigned xb_xcc_id() { return (unsigned)__builtin_amdgcn_s_getreg((3 << 11) | 20) & 0xFu; }
#define XB_SPIN(cond, bar) do { unsigned _sp = 0; while (cond) { __builtin_amdgcn_s_sleep(1); \
    if ((++_sp & 255u) == 0u) { if (xb_ld(&(bar)[XB_TMO])) break; if (_sp > XB_SPIN_CAP) { atomicAdd(&(bar)[XB_TMO], 1u); break; } } } } while (0)

struct XcdBarrier {
    unsigned* bar; unsigned x;
    volatile LAS unsigned* st;
};

__device__ __forceinline__ XcdBarrier xcd_barrier_post(unsigned* bar, volatile LAS unsigned* st) {
    XcdBarrier b; b.bar = bar; b.x = xb_xcc_id(); b.st = st;
    if (threadIdx.x == 0) (void)xb_add(&bar[XB_XCNT(b.x)], 1u);
    return b;
}
__device__ __forceinline__ void xcd_barrier_complete(unsigned* bar, unsigned x, unsigned& nloc, unsigned& nx) {
    const unsigned G = gridDim.x * gridDim.y * gridDim.z;
    unsigned sum, cnt, mine, sp = 0u;
    for (;;) {
        sum = 0u; cnt = 0u; mine = 0u;
#pragma unroll
        for (unsigned j = 0; j < 16; ++j) { const unsigned c = xb_ld(&bar[XB_XCNT(j)]); sum += c; cnt += (c > 0u) ? 1u : 0u; mine = (j == x) ? c : mine; }
        if (sum == G) break;
        __builtin_amdgcn_s_sleep(1);
        if ((++sp & 255u) == 0u) { if (xb_ld(&bar[XB_TMO])) break; if (sp > XB_SPIN_CAP) { atomicAdd(&bar[XB_TMO], 1u); break; } }
    }
    nloc = mine > 0u ? mine : 1u; nx = cnt > 0u ? cnt : 1u;
}

__device__ __forceinline__ void xcd_barrier(const XcdBarrier& b) {
    asm volatile("s_waitcnt vmcnt(0)" ::: "memory");
    __syncthreads();
    if (threadIdx.x == 0) {
        unsigned* bar = b.bar;
        __builtin_amdgcn_s_waitcnt(0);
        unsigned nloc = b.st[0], nx = b.st[1];
        if (nloc == 0u) { xcd_barrier_complete(bar, b.x, nloc, nx); b.st[0] = nloc; b.st[1] = nx; }
        const unsigned old = xb_add(&bar[XB_XSUB(b.x)], 1u);
        const unsigned gen = old / nloc;
        if (old + 1u == (gen + 1u) * nloc) {
            __builtin_amdgcn_fence(__ATOMIC_RELEASE, "agent");
            asm volatile("s_waitcnt vmcnt(0)" ::: "memory");
            const unsigned og = xb_add(&bar[XB_TOP], 1u);
            const unsigned tg = og / nx;
            if (og + 1u == (tg + 1u) * nx) xb_add(&bar[XB_TOPGEN], 1u);
            else XB_SPIN(xb_ld(&bar[XB_TOPGEN]) == tg, bar);
            __builtin_amdgcn_fence(__ATOMIC_ACQUIRE, "agent");
            xb_add(&bar[XB_XGEN(b.x)], 1u);
            asm volatile("s_waitcnt vmcnt(0)" ::: "memory");
        } else {
            XB_SPIN(xb_ld(&bar[XB_XGEN(b.x)]) == gen, bar);
            __builtin_amdgcn_fence(__ATOMIC_ACQUIRE, "agent");
            asm volatile("s_waitcnt vmcnt(0)" ::: "memory");
        }
    }
    __syncthreads();
}
constexpr int D = 2048, NB = 8, SEQ = 2048, NL = 4, T = NB * SEQ;
constexpr int NCH = SEQ / 64, NCHUNK = T / 64;
constexpr int GKW = 512, RANK = 16;
constexpr int INW = 6160, NP = 6144;
constexpr int NE = 16384;
constexpr float ALPHA = 1.6817928305074290f, EPS = 1e-5f;
constexpr int PQ = 0, PK = 512, PV = 1024, PR = 2048, PCB = 3072, PCC = 4096, PCH = 5120;
constexpr int NWAVES = 8, NTHREADS = 512;
#ifndef WGM_IN
#define WGM_IN 4
#endif
#ifndef WGM_OUT
#define WGM_OUT 4
#endif
#ifndef WGM_WQ
#define WGM_WQ 4
#endif
#ifndef TAB4
#define TAB4 1
#endif
constexpr int NPHASES = 2 + 7 * NL;

constexpr size_t MiB = 1u << 20;
constexpr size_t WS_CTL = 0, CTL_ZERO_BYTES = 1 * MiB;
constexpr size_t WS_MOD = 1 * MiB, WS_PART = 3 * MiB, WS_KEYS = 15 * MiB, WS_DTOT = 17 * MiB, WS_WIN = 18 * MiB, WS_WOUT = 115 * MiB, WS_WQ = 147 * MiB;
constexpr size_t WS_UT = 179 * MiB, WS_VT = 435 * MiB, WS_H = 691 * MiB, WS_PROJ = 755 * MiB, WS_E = 947 * MiB, WS_OGLA = 979 * MiB, WS_Y = 1043 * MiB;
constexpr size_t WS_Z = 1107 * MiB, WS_X1 = 1235 * MiB, WS_X = 1363 * MiB, WS_Q = 1491 * MiB, WS_H2 = 1555 * MiB, WS_HQ8 = 1619 * MiB, WS_H8 = 1659 * MiB, WS_WIN8 = 1691 * MiB, WS_WOUT8 = 1739 * MiB, WS_WQ8 = 1755 * MiB, WS_Y8 = 1771 * MiB, WS_H28 = 1803 * MiB, WS_END = 1835 * MiB;
constexpr size_t WS_SU = 17 * MiB + 512 * 1024, WS_SV = 17 * MiB + 768 * 1024, WS_HSC = 2 * MiB + 640 * 1024;
static_assert(WS_WIN + (size_t)NL * INW * D * 2 <= WS_WOUT && WS_PART + (size_t)NL * 8 * NB * 6 * D * 4 <= WS_KEYS && WS_MOD + (size_t)NL * NB * 6 * D * 4 <= WS_PART, "ws map");
constexpr size_t WS_SAH = WS_SU, WS_SAY = WS_SU + 65536, WS_SB = WS_SV; constexpr int SBL = NP + 2 * D;
constexpr size_t WS_SBA = WS_SB + (size_t)NL * SBL * 4, WS_ALR8 = WS_SU + 131072;
#ifndef KROT_A
#define KROT_A 0
#endif
#ifndef KROT_B
#define KROT_B 0
#endif
#define KROT(c) (KROT_A * (((c) >> 3) & 3) + KROT_B * ((c) >> 5))
#ifndef RES16
#define RES16 1
#endif
#ifndef RES16_X
#define RES16_X RES16
#endif
#ifndef RES16_Z
#define RES16_Z RES16
#endif
#ifndef RES16_X1
#define RES16_X1 RES16
#endif
#ifndef I8_GATE
#define I8_GATE 1
#endif
#ifndef I8_WQ
#define I8_WQ 1
#endif
#ifndef I8_IN
#define I8_IN 1
#endif
#ifndef I8_OUT
#define I8_OUT 1
#endif
constexpr int CW_BAR = 4096;

constexpr int RING_OFF = 0, RING_BYTES = 131072, LDSCTL_OFF = RING_BYTES, LDS_BYTES = 147456;

#define GAS __attribute__((address_space(1)))
typedef unsigned short bf16;
typedef unsigned v4u __attribute__((ext_vector_type(4)));
typedef unsigned v2u __attribute__((ext_vector_type(2)));
typedef int v4i __attribute__((ext_vector_type(4)));
typedef float f32x4 __attribute__((ext_vector_type(4)));
typedef float f32x16 __attribute__((ext_vector_type(16)));
typedef short bf16x8 __attribute__((ext_vector_type(8)));
typedef __bf16 bf16x2v __attribute__((ext_vector_type(2)));
#define LDS_WAIT() asm volatile("s_waitcnt lgkmcnt(0)" ::: "memory")

__device__ __forceinline__ unsigned pk2(float lo, float hi) { return pg8::cvt_pk_bf16(lo, hi); }
__device__ __forceinline__ float dot2bf(unsigned w, unsigned x, float acc) { return __builtin_amdgcn_fdot2_f32_bf16(__builtin_bit_cast(bf16x2v, w), __builtin_bit_cast(bf16x2v, x), acc, false); }
__device__ __forceinline__ float bflo(unsigned u) { return __uint_as_float(u << 16); }
__device__ __forceinline__ float bfhi(unsigned u) { return __uint_as_float(u & 0xffff0000u); }
__device__ __forceinline__ float silu_f(float x) { return x / (1.0f + __expf(-x)); }
__device__ __forceinline__ float logsigmoid_f(float x) { return fminf(x, 0.0f) - log1pf(__expf(-fabsf(x))); }
__device__ __forceinline__ float logsigmoid_fast(float x) { return fminf(x, 0.0f) - __logf(1.0f + __expf(-fabsf(x))); }
__device__ __forceinline__ float gelu_tanh_f(float x) { const float u = 0.7978845608028654f * (x + 0.044715f * x * x * x); return 0.5f * x * (1.0f + tanhf(u)); }
__device__ __forceinline__ unsigned pack_i8(float a, float b, float c, float d) {
    const int q0 = (int)__builtin_rintf(a), q1 = (int)__builtin_rintf(b), q2 = (int)__builtin_rintf(c), q3 = (int)__builtin_rintf(d);
    return (unsigned)(q0 & 255) | ((unsigned)(q1 & 255) << 8) | ((unsigned)(q2 & 255) << 16) | ((unsigned)(q3 & 255) << 24); }
__device__ __forceinline__ float wave_sum(float v) {
#pragma unroll
    for (int o = 1; o < 64; o <<= 1) v += __shfl_xor(v, o);
    return v;
}

struct Args { const float* in[19]; float* out; unsigned char* ws; int ph_lo, ph_hi; };

__device__ __forceinline__ void transpose_item(const float* W, int ldw, int col0, bf16* WTrows, int k0, int nvalid, LAS float* scr, int lane) {
    const int n = lane & 31;
    float tv[32];
#pragma unroll
    for (int i = 0; i < 32; ++i) { const int kk = 2 * i + (lane >> 5); tv[i] = (n < nvalid) ? W[(size_t)(k0 + kk) * ldw + col0 + n] : 0.f; }
#pragma unroll
    for (int i = 0; i < 32; ++i) { const int kk = 2 * i + (lane >> 5); scr[kk * 33 + n] = tv[i]; }
    LDS_WAIT(); asm volatile("" ::: "memory");
    const int c = lane & 7;
#pragma unroll
    for (int j = 0; j < 4; ++j) { const int nn = (lane >> 3) + 8 * j; const LAS float* s = scr + (8 * c) * 33 + nn;
        v4u o; o.x = pk2(s[0 * 33], s[1 * 33]); o.y = pk2(s[2 * 33], s[3 * 33]); o.z = pk2(s[4 * 33], s[5 * 33]); o.w = pk2(s[6 * 33], s[7 * 33]);
        if (nn < nvalid) *(v4u*)(WTrows + (size_t)nn * D + k0 + 8 * c) = o; }
    LDS_WAIT(); asm volatile("" ::: "memory");
}
__device__ __forceinline__ void cvt_stream(const float* src, bf16* dst, size_t n4, size_t i0, size_t stride) {
    for (size_t i = i0; i < n4; i += stride) { const f32x4 v = ((const f32x4*)src)[i]; v2u o; o.x = pk2(v.x, v.y); o.y = pk2(v.z, v.w); ((v2u*)dst)[i] = o; }
}
__device__ __forceinline__ void ph_prologue_a(const Args& a, LAS unsigned char* lds, int tid, int lane, int wave, int bx, int G) {
    const int gw = bx * NWAVES + wave, NGW = G * NWAVES;
    LAS float* cact = (LAS float*)lds;
    for (int i = tid; i < NB * D; i += NTHREADS) { const int b = i / D, d = i % D; cact[d * 8 + b] = silu_f(a.in[1][i]); }
    __syncthreads();
    float* part = (float*)(a.ws + WS_PART);
    for (int it = gw; it < NL * 8 * 48; it += NGW) {
        const int cg = it % 48, dr = (it / 48) % 8, l = it / 384;
        f32x4 acc[8];
#pragma unroll
        for (int b = 0; b < 8; ++b) acc[b] = (f32x4){0.f, 0.f, 0.f, 0.f};
        const float* w = a.in[2] + ((size_t)l * D + dr * 256) * (6 * D) + cg * 256 + lane * 4;
#pragma unroll 4
        for (int d = 0; d < 256; ++d) {
            const f32x4 wv = *(const f32x4*)(w + (size_t)d * (6 * D));
            const f32x4 c0 = *(const LAS f32x4*)(cact + (dr * 256 + d) * 8), c1 = *(const LAS f32x4*)(cact + (dr * 256 + d) * 8 + 4);
            acc[0] += wv * c0.x; acc[1] += wv * c0.y; acc[2] += wv * c0.z; acc[3] += wv * c0.w;
            acc[4] += wv * c1.x; acc[5] += wv * c1.y; acc[6] += wv * c1.z; acc[7] += wv * c1.w;
        }
#pragma unroll
        for (int b = 0; b < 8; ++b) *(f32x4*)(part + (((size_t)l * 8 + dr) * NB + b) * (6 * D) + cg * 256 + lane * 4) = acc[b];
    }
    __syncthreads();
    LAS float* scr = (LAS float*)(lds + wave * 8448);
    bf16* winT = (bf16*)(a.ws + WS_WIN); bf16* woutT = (bf16*)(a.ws + WS_WOUT); bf16* wqT = (bf16*)(a.ws + WS_WQ);
    constexpr int IPL = 6144 + 32 + 2048 + 2048;
    for (int it = gw; it < NL * IPL; it += NGW) {
        const int l = it / IPL; int r = it % IPL;
        if (r < 6144) { const int nb = r % 192, kb = r / 192, n0 = nb * 32;
            transpose_item(a.in[4] + (size_t)l * D * INW, INW, n0 < 3072 ? n0 : n0 + 16, winT + ((size_t)l * INW + n0) * D, kb * 64, 32, scr, lane); continue; }
        r -= 6144;
        if (r < 32) { transpose_item(a.in[4] + (size_t)l * D * INW, INW, 3072, winT + ((size_t)l * INW + NP) * D, r * 64, 16, scr, lane); continue; }
        r -= 32;
        if (r < 2048) { const int nb = r % 64, kb = r / 64; transpose_item(a.in[10] + (size_t)l * D * D, D, nb * 32, woutT + ((size_t)l * D + nb * 32) * D, kb * 64, 32, scr, lane); continue; }
        r -= 2048;
        { const int nb = r % 64, kb = r / 64; transpose_item(a.in[13] + (size_t)l * D * D, D, nb * 32, wqT + ((size_t)l * D + nb * 32) * D, kb * 64, 32, scr, lane); }
    }
    const size_t i0 = (size_t)bx * NTHREADS + tid, stride = (size_t)G * NTHREADS;
    cvt_stream(a.in[14], (bf16*)(a.ws + WS_KEYS), (size_t)NL * 8 * 2 * 128 * 128 / 4, i0, stride);
#if TAB4
    __syncthreads();
    { LAS float* rowst = (LAS float*)(lds + wave * 8192);
      f32x4 vnx[8];
      if (gw < 2 * NL * NE) { const int tbl0 = gw / (NL * NE), r0 = gw % (NL * NE); const float* s0 = (tbl0 ? a.in[16] : a.in[15]) + (size_t)r0 * D;
#pragma unroll
          for (int c8 = 0; c8 < 8; ++c8) vnx[c8] = *(const f32x4*)(s0 + (c8 * 64 + lane) * 4); }
      for (int row = gw; row < 2 * NL * NE; row += NGW) {
        const int tbl = row / (NL * NE), r = row % (NL * NE);
#pragma unroll
        for (int c8 = 0; c8 < 8; ++c8) *(LAS f32x4*)(rowst + (c8 * 64 + lane) * 4) = vnx[c8];
        { const int rown = row + NGW < 2 * NL * NE ? row + NGW : row; const int tbln = rown / (NL * NE), rn = rown % (NL * NE); const float* sn = (tbln ? a.in[16] : a.in[15]) + (size_t)rn * D;
#pragma unroll
          for (int c8 = 0; c8 < 8; ++c8) vnx[c8] = *(const f32x4*)(sn + (c8 * 64 + lane) * 4); }
        LDS_WAIT(); asm volatile("" ::: "memory");
        unsigned char* tb = a.ws + (tbl ? WS_VT : WS_UT) + (size_t)r * 1152;
#pragma unroll
        for (int pass = 0; pass < 2; ++pass) { const int slot = lane + 64 * pass;
            if (slot < 72) { const int col0 = (slot >> 3) * 240 + (slot & 7) * 30;
                float x[30]; float mx = 0.f;
#pragma unroll
                for (int k = 0; k < 30; ++k) { x[k] = (col0 + k < D) ? rowst[col0 + k] : 0.f; mx = fmaxf(mx, fabsf(x[k])); }
                int code = 0; float inv = 0.f;
                if (mx > 0.f) { code = (int)ceilf(8.0f * log2f(mx * (1.0f / 7.0f))) + 128; code = code < 0 ? 0 : (code > 255 ? 255 : code); inv = __builtin_amdgcn_exp2f(16.0f - (float)code * 0.125f); }
                unsigned dw[4] = {0u, 0u, 0u, 0u};
#pragma unroll
                for (int kb = 0; kb < 15; ++kb) { int a0 = (int)__builtin_rintf(x[2 * kb] * inv), a1 = (int)__builtin_rintf(x[2 * kb + 1] * inv);
                    a0 = a0 < -7 ? -7 : (a0 > 7 ? 7 : a0); a1 = a1 < -7 ? -7 : (a1 > 7 ? 7 : a1);
                    dw[kb >> 2] |= ((unsigned)(a0 + 8) | ((unsigned)(a1 + 8) << 4)) << (8 * (kb & 3)); }
                dw[3] |= (unsigned)code << 24;
                *(v4u*)(tb + slot * 16) = (v4u){dw[0], dw[1], dw[2], dw[3]}; } }
        LDS_WAIT(); asm volatile("" ::: "memory");
      } }
#else
    for (int row = gw; row < 2 * NL * NE; row += NGW) {
        const int tbl = row / (NL * NE), r = row % (NL * NE);
        const float* src = (tbl ? a.in[16] : a.in[15]) + (size_t)r * D;
        f32x4 v[8]; float mx = 0.f;
#pragma unroll
        for (int c8 = 0; c8 < 8; ++c8) { v[c8] = *(const f32x4*)(src + (c8 * 64 + lane) * 4); mx = fmaxf(mx, fmaxf(fmaxf(fabsf(v[c8].x), fabsf(v[c8].y)), fmaxf(fabsf(v[c8].z), fabsf(v[c8].w)))); }
#pragma unroll
        for (int o = 1; o < 64; o <<= 1) mx = fmaxf(mx, __shfl_xor(mx, o));
        const float inv = mx > 0.f ? 127.0f / mx : 0.f; const int off = tbl ? 128 : 0;
        unsigned dw[8];
#pragma unroll
        for (int c8 = 0; c8 < 8; ++c8) { const int q0 = (int)__builtin_rintf(v[c8].x * inv) + off, q1 = (int)__builtin_rintf(v[c8].y * inv) + off, q2 = (int)__builtin_rintf(v[c8].z * inv) + off, q3 = (int)__builtin_rintf(v[c8].w * inv) + off;
            dw[c8] = (unsigned)(q0 & 255) | ((unsigned)(q1 & 255) << 8) | ((unsigned)(q2 & 255) << 16) | ((unsigned)(q3 & 255) << 24); }
        unsigned char* dst = a.ws + (tbl ? WS_VT : WS_UT) + (size_t)r * D;
        *(v4u*)(dst + lane * 16) = (v4u){dw[0], dw[1], dw[2], dw[3]}; *(v4u*)(dst + (64 + lane) * 16) = (v4u){dw[4], dw[5], dw[6], dw[7]};
        if (lane == 0) ((float*)(a.ws + (tbl ? WS_SV : WS_SU)))[r] = mx * (1.0f / 127.0f);
    }
#endif
}

__device__ __forceinline__ void ln_tail(const float (&z)[32], int t, int lane, const float* g, const float* bta, float* xout, const float* sh, const float* sc, bf16* hout, unsigned char* q8, float* q8s, LAS unsigned char* q8stage = nullptr, unsigned char* a8 = nullptr, float* a8s = nullptr, bf16* xb = nullptr) {
    float s = 0.f;
#pragma unroll
    for (int i = 0; i < 32; ++i) s += z[i];
    const float mu = wave_sum(s) * (1.0f / D);
    float q = 0.f;
#pragma unroll
    for (int i = 0; i < 32; ++i) { const float d = z[i] - mu; q += d * d; }
    const float rs = rsqrtf(wave_sum(q) * (1.0f / D) + EPS);
    float hv[32]; float mx = 0.f;
#pragma unroll
    for (int c = 0; c < 8; ++c) { const int col = (c * 64 + lane) * 4;
        const f32x4 g0 = *(const f32x4*)(g + col), b0 = *(const f32x4*)(bta + col);
        f32x4 x0;
        x0.x = (z[c * 4 + 0] - mu) * rs * g0.x + b0.x; x0.y = (z[c * 4 + 1] - mu) * rs * g0.y + b0.y; x0.z = (z[c * 4 + 2] - mu) * rs * g0.z + b0.z; x0.w = (z[c * 4 + 3] - mu) * rs * g0.w + b0.w;
        if (xb) { v2u o; o.x = pk2(x0.x, x0.y); o.y = pk2(x0.z, x0.w); *(v2u*)(xb + (size_t)t * D + col) = o; }
        else if (xout) *(f32x4*)(xout + (size_t)t * D + col) = x0;
        if (hout || q8 || a8) { const f32x4 s0 = *(const f32x4*)(sc + col), h0 = *(const f32x4*)(sh + col);
            hv[c * 4] = x0.x * (1.f + s0.x) + h0.x; hv[c * 4 + 1] = x0.y * (1.f + s0.y) + h0.y; hv[c * 4 + 2] = x0.z * (1.f + s0.z) + h0.z; hv[c * 4 + 3] = x0.w * (1.f + s0.w) + h0.w;
            if (hout) { v2u o; o.x = pk2(hv[c * 4], hv[c * 4 + 1]); o.y = pk2(hv[c * 4 + 2], hv[c * 4 + 3]);
                *(v2u*)(hout + (size_t)t * D + col) = o; }
            if (q8 || a8) mx = fmaxf(mx, fmaxf(fmaxf(fabsf(hv[c * 4]), fabsf(hv[c * 4 + 1])), fmaxf(fabsf(hv[c * 4 + 2]), fabsf(hv[c * 4 + 3])))); }
    }
    if (q8 || a8) {
#pragma unroll
        for (int o = 1; o < 64; o <<= 1) mx = fmaxf(mx, __shfl_xor(mx, o));
        const float qmax_ = (q8 && TAB4) ? 119.0f : 127.0f;
        const float inv = mx > 0.f ? qmax_ / mx : 0.f;
        unsigned dw[8];
#pragma unroll
        for (int c = 0; c < 8; ++c) { const int q0 = (int)__builtin_rintf(hv[c * 4] * inv), q1 = (int)__builtin_rintf(hv[c * 4 + 1] * inv), q2 = (int)__builtin_rintf(hv[c * 4 + 2] * inv), q3 = (int)__builtin_rintf(hv[c * 4 + 3] * inv);
            dw[c] = (unsigned)(q0 & 255) | ((unsigned)(q1 & 255) << 8) | ((unsigned)(q2 & 255) << 16) | ((unsigned)(q3 & 255) << 24); }
        if (a8) {
#pragma unroll
            for (int c = 0; c < 8; ++c) *(unsigned*)(a8 + (size_t)t * D + (c * 64 + lane) * 4) = dw[c];
            if (a8s && lane == 0) a8s[t] = mx / qmax_; }
        if (q8) {
#if TAB4
        { LAS unsigned* st32 = (LAS unsigned*)q8stage; LAS unsigned char* st8 = (LAS unsigned char*)q8stage;
#pragma unroll
          for (int i = 0; i < 9; ++i) st32[lane + 64 * i] = 0u;
          LDS_WAIT(); asm volatile("" ::: "memory");
#pragma unroll
          for (int c = 0; c < 8; ++c)
#pragma unroll
              for (int jp = 0; jp < 2; ++jp) { const int col = (c * 64 + lane) * 4 + 2 * jp, u = col / 240, r = col - u * 240, l7 = r / 30, k = r - l7 * 30;
                  const int q0 = (int)(signed char)((dw[c] >> (16 * jp)) & 255u), q1 = (int)(signed char)((dw[c] >> (16 * jp + 8)) & 255u);
                  const int l0 = ((q0 + 8) & 15) - 8, l1 = ((q1 + 8) & 15) - 8, h0 = (q0 - l0) >> 4, h1 = (q1 - l1) >> 4;
                  LAS unsigned char* sp = st8 + (u * 8 + l7) * 32 + (k >> 1);
                  sp[0] = (unsigned char)((l0 & 15) | ((l1 & 15) << 4)); sp[16] = (unsigned char)((h0 & 15) | ((h1 & 15) << 4)); }
          LDS_WAIT(); asm volatile("" ::: "memory");
          unsigned* d32 = (unsigned*)(q8 + (size_t)t * 2304);
#pragma unroll
          for (int i = 0; i < 9; ++i) d32[lane + 64 * i] = st32[lane + 64 * i];
          LDS_WAIT(); asm volatile("" ::: "memory"); }
#else
        unsigned char* dst = q8 + (size_t)t * D;
        *(v4u*)(dst + lane * 16) = (v4u){dw[0], dw[1], dw[2], dw[3]}; *(v4u*)(dst + (64 + lane) * 16) = (v4u){dw[4], dw[5], dw[6], dw[7]};
#endif
        if (lane == 0) q8s[t] = mx / qmax_; }
    }
}

__device__ __forceinline__ void ph_prologue_b(const Args& a, LAS unsigned char* lds, int tid, int lane, int wave, int bx, int G) {
    const float* part = (const float*)(a.ws + WS_PART); float* mod = (float*)(a.ws + WS_MOD);
    for (int i = bx * NTHREADS + tid; i < NL * NB * 6 * D / 4; i += G * NTHREADS) {
        const int idx = i * 4, e = idx % (6 * D), b = (idx / (6 * D)) % NB, l = idx / (6 * D * NB);
        f32x4 s = *(const f32x4*)(a.in[3] + l * 6 * D + e);
#pragma unroll
        for (int dr = 0; dr < 8; ++dr) s += *(const f32x4*)(part + (((size_t)l * 8 + dr) * NB + b) * (6 * D) + e);
        *(f32x4*)(mod + idx) = s;
    }
    LAS float* msh = (LAS float*)lds;
    bf16* hbuf = (bf16*)(a.ws + WS_H);
    for (int ch = bx; ch < NCHUNK; ch += G) {
        const int b = ch / NCH;
        for (int i = tid; i < 1024; i += NTHREADS) { const int e = i * 4;
            f32x4 s = *(const f32x4*)(a.in[3] + e);
#pragma unroll
            for (int dr = 0; dr < 8; ++dr) s += *(const f32x4*)(part + (((size_t)0 * 8 + dr) * NB + b) * (6 * D) + e);
            *(LAS f32x4*)(msh + e) = s; }
        __syncthreads();
        for (int i = 0; i < 8; ++i) { const int t = ch * 64 + wave * 8 + i;
            float hv[32]; float mx = 0.f;
#pragma unroll
            for (int c = 0; c < 4; ++c) { const int col = (c * 64 + lane) * 8;
                const f32x4 x0 = *(const f32x4*)(a.in[0] + (size_t)t * D + col), x1 = *(const f32x4*)(a.in[0] + (size_t)t * D + col + 4);
                const f32x4 h0 = *(const LAS f32x4*)(msh + col), h1 = *(const LAS f32x4*)(msh + col + 4), s0 = *(const LAS f32x4*)(msh + 2048 + col), s1 = *(const LAS f32x4*)(msh + 2048 + col + 4);
#pragma unroll
                for (int j = 0; j < 4; ++j) { hv[c * 8 + j] = x0[j] * (1.f + s0[j]) + h0[j]; hv[c * 8 + 4 + j] = x1[j] * (1.f + s1[j]) + h1[j]; }
                v4u o; o.x = pk2(hv[c * 8], hv[c * 8 + 1]); o.y = pk2(hv[c * 8 + 2], hv[c * 8 + 3]); o.z = pk2(hv[c * 8 + 4], hv[c * 8 + 5]); o.w = pk2(hv[c * 8 + 6], hv[c * 8 + 7]);
#if !I8_GATE
                *(v4u*)(hbuf + (size_t)t * D + col) = o;
#endif
#if RES16_X
                { v4u xo; xo.x = pk2(x0.x, x0.y); xo.y = pk2(x0.z, x0.w); xo.z = pk2(x1.x, x1.y); xo.w = pk2(x1.z, x1.w); *(v4u*)((bf16*)(a.ws + WS_X) + (size_t)t * D + col) = xo; }
#endif
#pragma unroll
                for (int j = 0; j < 8; ++j) mx = fmaxf(mx, fabsf(hv[c * 8 + j])); }
#pragma unroll
            for (int o = 1; o < 64; o <<= 1) mx = fmaxf(mx, __shfl_xor(mx, o));
            const float inv = mx > 0.f ? 127.0f / mx : 0.f;
#pragma unroll
            for (int c = 0; c < 4; ++c) { v2u o;
                o.x = pack_i8(hv[c * 8] * inv, hv[c * 8 + 1] * inv, hv[c * 8 + 2] * inv, hv[c * 8 + 3] * inv); o.y = pack_i8(hv[c * 8 + 4] * inv, hv[c * 8 + 5] * inv, hv[c * 8 + 6] * inv, hv[c * 8 + 7] * inv);
                *(v2u*)(a.ws + WS_H8 + (size_t)t * D + (c * 64 + lane) * 8) = o; }
            if (lane == 0) ((float*)(a.ws + WS_SAH))[t] = mx * (1.0f / 127.0f); }
        __syncthreads();
    }
    { const int gw = bx * NWAVES + wave, NGW = G * NWAVES;
      for (int row = gw; row < NL * (SBL + 16); row += NGW) { const int l = row / (SBL + 16), r = row % (SBL + 16);
          const bf16* src; unsigned char* dst; float* sdst;
          if (r < NP) { src = (const bf16*)(a.ws + WS_WIN) + ((size_t)l * INW + r) * D; dst = a.ws + WS_WIN8 + ((size_t)l * NP + r) * D; sdst = (float*)(a.ws + WS_SB) + l * SBL + r; }
          else if (r < NP + D) { src = (const bf16*)(a.ws + WS_WOUT) + ((size_t)l * D + (r - NP)) * D; dst = a.ws + WS_WOUT8 + ((size_t)l * D + (r - NP)) * D; sdst = (float*)(a.ws + WS_SB) + l * SBL + r; }
          else if (r < SBL) { src = (const bf16*)(a.ws + WS_WQ) + ((size_t)l * D + (r - NP - D)) * D; dst = a.ws + WS_WQ8 + ((size_t)l * D + (r - NP - D)) * D; sdst = (float*)(a.ws + WS_SB) + l * SBL + r; }
          else { src = (const bf16*)(a.ws + WS_WIN) + ((size_t)l * INW + NP + (r - SBL)) * D; dst = a.ws + WS_ALR8 + ((size_t)l * 16 + (r - SBL)) * D; sdst = (float*)(a.ws + WS_SBA) + l * 16 + (r - SBL); }
          v4u w[4]; float mx = 0.f;
#pragma unroll
          for (int c = 0; c < 4; ++c) w[c] = *(const v4u*)(src + (c * 64 + lane) * 8);
#pragma unroll
          for (int c = 0; c < 4; ++c)
#pragma unroll
              for (int j = 0; j < 4; ++j) mx = fmaxf(mx, fmaxf(fabsf(bflo(w[c][j])), fabsf(bfhi(w[c][j]))));
#pragma unroll
          for (int o = 1; o < 64; o <<= 1) mx = fmaxf(mx, __shfl_xor(mx, o));
          const float inv = mx > 0.f ? 127.0f / mx : 0.f;
#pragma unroll
          for (int c = 0; c < 4; ++c) { v2u o;
              o.x = pack_i8(bflo(w[c][0]) * inv, bfhi(w[c][0]) * inv, bflo(w[c][1]) * inv, bfhi(w[c][1]) * inv); o.y = pack_i8(bflo(w[c][2]) * inv, bfhi(w[c][2]) * inv, bflo(w[c][3]) * inv, bfhi(w[c][3]) * inv);
              *(v2u*)(dst + (c * 64 + lane) * 8) = o; }
          if (lane == 0) *sdst = mx * (1.0f / 127.0f); } }
}

__device__ __forceinline__ void gate_prep(const Args& a, int l, LAS unsigned char* lds, int tid, int lane, int wave, int ch) {
    const bf16* hbuf = (const bf16*)(a.ws + WS_H); const bf16* waT = (const bf16*)(a.ws + WS_WIN) + ((size_t)l * INW + NP) * D;
    bf16* Ebuf = (bf16*)(a.ws + WS_E); float* dtot = (float*)(a.ws + WS_DTOT);
    const int t0 = ch * 64, l15 = lane & 15, lq = lane >> 4, mt = wave & 3, kh = wave >> 2;
    LAS float* alr = (LAS float*)(lds + LDSCTL_OFF + 1024);
#if I8_GATE
    { v4i acc = (v4i){0, 0, 0, 0};
      const unsigned char* hA = a.ws + WS_H8 + (size_t)(t0 + 16 * mt + l15) * D + kh * 1024 + 16 * lq;
      const unsigned char* wB = a.ws + WS_ALR8 + ((size_t)l * 16 + l15) * D + kh * 1024 + 16 * lq;
#pragma unroll 8
      for (int ks = 0; ks < 16; ++ks) { const v4i av = *(const v4i*)(hA + 64 * ks), bv = *(const v4i*)(wB + 64 * ks); acc = __builtin_amdgcn_mfma_i32_16x16x64_i8(av, bv, acc, 0, 0, 0); }
      const float sw = ((const float*)(a.ws + WS_SBA))[l * 16 + l15];
#pragma unroll
      for (int r = 0; r < 4; ++r) { const int tl = 16 * mt + 4 * lq + r; alr[(kh * 64 + tl) * 16 + l15] = (float)acc[r] * (sw * ((const float*)(a.ws + WS_SAH))[t0 + tl]); } }
#else
    f32x4 acc = (f32x4){0.f, 0.f, 0.f, 0.f};
    const bf16* hA = hbuf + (size_t)(t0 + 16 * mt + l15) * D + kh * 1024 + 8 * lq;
    const bf16* wB = waT + (size_t)l15 * D + kh * 1024 + 8 * lq;
#pragma unroll 8
    for (int ks = 0; ks < 32; ++ks) { const bf16x8 av = *(const bf16x8*)(hA + 32 * ks), bv = *(const bf16x8*)(wB + 32 * ks); acc = __builtin_amdgcn_mfma_f32_16x16x32_bf16(av, bv, acc, 0, 0, 0); }
#pragma unroll
    for (int r = 0; r < 4; ++r) alr[(kh * 64 + 16 * mt + 4 * lq + r) * 16 + l15] = acc[r];
#endif
    __syncthreads();
    const int col = tid;
    float wg[16];
#pragma unroll
    for (int r = 0; r < 16; ++r) wg[r] = a.in[5][((size_t)l * RANK + r) * GKW + col];
    const float bgc = a.in[6][l * GKW + col];
    for (int i = tid; i < 256; i += NTHREADS) *(LAS f32x4*)(alr + i * 4) = *(const LAS f32x4*)(alr + i * 4) + *(const LAS f32x4*)(alr + 1024 + i * 4);
    __syncthreads();
    float tot = 0.f;
    LAS float* lac = (LAS float*)lds;
    for (int j = 0; j < 64; ++j) { float lg0 = bgc, lg1 = 0.f;
#pragma unroll
        for (int r4 = 0; r4 < 4; ++r4) { const f32x4 p = *(const LAS f32x4*)(alr + j * 16 + r4 * 4);
            lg0 += p.x * wg[r4 * 4] + p.z * wg[r4 * 4 + 2]; lg1 += p.y * wg[r4 * 4 + 1] + p.w * wg[r4 * 4 + 3]; }
        const float la = logsigmoid_fast(lg0 + lg1) * (1.0f / 16.0f); lac[j * GKW + col] = la; tot += la; }
    float run = 0.f;
    for (int j = 0; j < 64; ++j) { run += lac[j * GKW + col]; lac[j * GKW + col] = __expf(tot - run); }
    __syncthreads();
    for (int i = 0; i < 8; ++i) { const int j = wave * 8 + i;
        const f32x4 e0 = *(const LAS f32x4*)(lac + j * GKW + lane * 8), e1 = *(const LAS f32x4*)(lac + j * GKW + lane * 8 + 4);
        v4u o; o.x = pk2(e0.x, e0.y); o.y = pk2(e0.z, e0.w); o.z = pk2(e1.x, e1.y); o.w = pk2(e1.z, e1.w);
        *(v4u*)(Ebuf + (size_t)(t0 + j) * GKW + lane * 8) = o; }
    dtot[(size_t)ch * GKW + col] = __expf(tot);
    __syncthreads();
}

__device__ __forceinline__ void gla_unit(const Args& a, LAS unsigned char* lds, int tid, int lane, int wave, int un) {
    const bf16* proj = (const bf16*)(a.ws + WS_PROJ); const bf16* Ebuf = (const bf16*)(a.ws + WS_E); const float* dtot = (const float*)(a.ws + WS_DTOT); bf16* ogla = (bf16*)(a.ws + WS_OGLA);
    const int pair_ = (un & 7) * 4 + (un >> 6), dvs = (un >> 3) & 7, hh = pair_ & 3, b = pair_ >> 2;
    LAS bf16* kdT0 = (LAS bf16*)lds; LAS bf16* vT0 = (LAS bf16*)(lds + 18432); LAS bf16* ST0 = (LAS bf16*)(lds + 18432 + 4608);
    LAS bf16* kdT1 = (LAS bf16*)(lds + 32768); LAS bf16* vT1 = (LAS bf16*)(lds + 32768 + 18432); LAS bf16* ST1 = (LAS bf16*)(lds + 32768 + 18432 + 4608);
    const int l15 = lane & 15, lq = lane >> 4, jl = tid >> 3, dv4 = (tid & 7) * 4, jt = (wave & 3) * 16, dvt = (wave >> 2) * 16, jp = tid >> 4, c16 = tid & 15;
#define GLA_BAR() do { asm volatile("s_waitcnt lgkmcnt(0)" ::: "memory"); __builtin_amdgcn_s_barrier(); asm volatile("" ::: "memory"); } while (0)
    f32x4 S0 = (f32x4){0.f, 0.f, 0.f, 0.f}, S1 = (f32x4){0.f, 0.f, 0.f, 0.f};
    v4u kn0[2], kn1[2], kn2[2], en0[2], en1[2], en2[2]; v2u vn0, vn1, vn2; bf16x8 qn0[4], qn1[4], qn2[4], qc[4]; f32x4 dn0, dn1, dn2, dc;
#define GLA_LOAD(c, kn, en, vn, qn, dn) do { const int t0c = b * SEQ + (c) * 64; const bf16* pr = proj + (size_t)(t0c + jl) * NP; \
          \
        kn[0] = *(const v4u*)(proj + (size_t)(t0c + 2 * jp) * NP + PK + hh * 128 + 8 * c16); kn[1] = *(const v4u*)(proj + (size_t)(t0c + 2 * jp + 1) * NP + PK + hh * 128 + 8 * c16); \
        en[0] = *(const v4u*)(Ebuf + (size_t)(t0c + 2 * jp) * GKW + hh * 128 + 8 * c16); en[1] = *(const v4u*)(Ebuf + (size_t)(t0c + 2 * jp + 1) * GKW + hh * 128 + 8 * c16); \
        vn = *(const v2u*)(pr + PV + hh * 256 + dvs * 32 + dv4); \
        _Pragma("unroll") for (int ks_ = 0; ks_ < 4; ++ks_) qn[ks_] = *(const bf16x8*)(proj + (size_t)(t0c + jt + l15) * NP + PQ + hh * 128 + 32 * ks_ + 8 * lq); \
        dn = *(const f32x4*)(dtot + (size_t)(b * NCH + (c)) * GKW + hh * 128 + 16 * wave + 4 * lq); } while (0)
#define GLA_PREPL(kn, en, vn, kdT, vT) do { \
        _Pragma("unroll") for (int i_ = 0; i_ < 8; ++i_) { const unsigned wa_ = kn[0][i_ >> 1], wb_ = kn[1][i_ >> 1], ea_ = en[0][i_ >> 1], eb_ = en[1][i_ >> 1]; \
            const float pa_ = ((i_ & 1) ? bfhi(wa_) : bflo(wa_)) * ((i_ & 1) ? bfhi(ea_) : bflo(ea_)), pb_ = ((i_ & 1) ? bfhi(wb_) : bflo(wb_)) * ((i_ & 1) ? bfhi(eb_) : bflo(eb_)); \
            *(LAS unsigned*)(kdT + (8 * c16 + i_) * 72 + ((((jp >> 2) ^ c16) & 7) << 3) + ((2 * jp) & 7)) = pk2(pa_, pb_); }     \
        _Pragma("unroll") for (int i_ = 0; i_ < 4; ++i_) { const unsigned w_ = vn[i_ >> 1]; vT[(dv4 + i_) * 72 + jl] = (bf16)((i_ & 1) ? (w_ >> 16) : (w_ & 0xffffu)); } } while (0)
#define GLA_QD(qn, dn) do { _Pragma("unroll") for (int ks_ = 0; ks_ < 4; ++ks_) qc[ks_] = qn[ks_]; dc = dn; } while (0)
#define GLA_BODYA(kdT, vT, ST) do { \
        S0 = S0 * dc; S1 = S1 * dc; \
        _Pragma("unroll") for (int ks = 0; ks < 2; ++ks) { \
            const bf16x8 A_ = *(const LAS bf16x8*)(kdT + (16 * wave + l15) * 72 + ((((4 * ks + lq) ^ (2 * wave + (l15 >> 3))) & 7) << 3)); \
            const bf16x8 B0_ = *(const LAS bf16x8*)(vT + l15 * 72 + 32 * ks + 8 * lq), B1_ = *(const LAS bf16x8*)(vT + (16 + l15) * 72 + 32 * ks + 8 * lq); \
            S0 = __builtin_amdgcn_mfma_f32_16x16x32_bf16(A_, B0_, S0, 0, 0, 0); S1 = __builtin_amdgcn_mfma_f32_16x16x32_bf16(A_, B1_, S1, 0, 0, 0); } \
        { v2u w0_, w1_; w0_.x = pk2(S0.x, S0.y); w0_.y = pk2(S0.z, S0.w); w1_.x = pk2(S1.x, S1.y); w1_.y = pk2(S1.z, S1.w); \
          *(LAS v2u*)(ST + l15 * 136 + 16 * wave + 4 * lq) = w0_; *(LAS v2u*)(ST + (16 + l15) * 136 + 16 * wave + 4 * lq) = w1_; } } while (0)
#define GLA_BODYB(c, ST) do { \
        f32x4 O_ = (f32x4){0.f, 0.f, 0.f, 0.f}; \
        _Pragma("unroll") for (int ks = 0; ks < 4; ++ks) { const bf16x8 A_ = *(const LAS bf16x8*)(ST + (dvt + l15) * 136 + 32 * ks + 8 * lq); O_ = __builtin_amdgcn_mfma_f32_16x16x32_bf16(A_, qc[ks], O_, 0, 0, 0); } \
        { const f32x4 Os_ = O_ * 0.08838834764831845f; v2u ob_; ob_.x = pk2(Os_.x, Os_.y); ob_.y = pk2(Os_.z, Os_.w); \
          *(v2u*)(ogla + (size_t)(b * SEQ + (c) * 64 + jt + l15) * 1024 + hh * 256 + dvs * 32 + dvt + 4 * lq) = ob_; } } while (0)
#define GLA_STEP(c, RA, RB, LA, LB) do { { const int cn_ = (c) + 3 < NCH ? (c) + 3 : NCH - 1; GLA_LOAD(cn_, kn##RA, en##RA, vn##RA, qn##RA, dn##RA); } \
        GLA_BODYA(kdT##LA, vT##LA, ST##LA); GLA_PREPL(kn##RB, en##RB, vn##RB, kdT##LB, vT##LB); GLA_BAR(); GLA_BODYB(c, ST##LA); GLA_QD(qn##RB, dn##RB); } while (0)
    GLA_LOAD(0, kn0, en0, vn0, qn0, dn0); GLA_LOAD(1, kn1, en1, vn1, qn1, dn1); GLA_LOAD(2, kn2, en2, vn2, qn2, dn2);
    GLA_PREPL(kn0, en0, vn0, kdT0, vT0); GLA_QD(qn0, dn0);
    GLA_BAR();
    static_assert(NCH == 32, "the step schedule below is written for 32 chunks: 5 x 6 + 2");
    for (int c = 0; c < 30; c += 6) {
        GLA_STEP(c, 0, 1, 0, 1); GLA_STEP(c + 1, 1, 2, 1, 0); GLA_STEP(c + 2, 2, 0, 0, 1); GLA_STEP(c + 3, 0, 1, 1, 0); GLA_STEP(c + 4, 1, 2, 0, 1); GLA_STEP(c + 5, 2, 0, 1, 0);
    }
    GLA_STEP(30, 0, 1, 0, 1); GLA_STEP(31, 1, 2, 1, 0);
#undef GLA_STEP
#undef GLA_PREPL
#undef GLA_QD
#undef GLA_BODYA
#undef GLA_BODYB
#undef GLA_BAR
#undef GLA_LOAD
}

__device__ __forceinline__ void unpack16(const v4u& p0, const v4u& p1, float (&o)[16]) {
#pragma unroll
    for (int j = 0; j < 4; ++j) { o[2 * j] = bflo(p0[j]); o[2 * j + 1] = bfhi(p0[j]); o[8 + 2 * j] = bflo(p1[j]); o[8 + 2 * j + 1] = bfhi(p1[j]); }
}
__device__ __forceinline__ void mixpost_chunk(const Args& a, int l, int lane, int wave, int ch) {
    const bf16* proj = (const bf16*)(a.ws + WS_PROJ); const bf16* ogla = (const bf16*)(a.ws + WS_OGLA);
    const int c0 = 16 * lane, tfirst = ch * 64 + wave * 8, sfirst = tfirst % SEQ;
    float gn[16], cw0[16], cw1[16], cw2[16], cn[16], u1[16], u2[16];
#pragma unroll
    for (int i = 0; i < 16; ++i) { gn[i] = a.in[7][l * 256 + ((c0 + i) & 255)]; cw0[i] = a.in[8][(size_t)l * 3072 + c0 + i]; cw1[i] = a.in[8][(size_t)l * 3072 + 1024 + c0 + i];
        cw2[i] = a.in[8][(size_t)l * 3072 + 2048 + c0 + i]; cn[i] = a.in[9][l * 1024 + c0 + i]; u1[i] = 0.f; u2[i] = 0.f; }
    if (sfirst >= 2) {
        float cc[16], chh[16];
        { const bf16* pr = proj + (size_t)(tfirst - 2) * NP; unpack16(*(const v4u*)(pr + PCC + c0), *(const v4u*)(pr + PCC + c0 + 8), cc); unpack16(*(const v4u*)(pr + PCH + c0), *(const v4u*)(pr + PCH + c0 + 8), chh); }
#pragma unroll
        for (int i = 0; i < 16; ++i) u2[i] = cc[i] * chh[i];
        { const bf16* pr = proj + (size_t)(tfirst - 1) * NP; unpack16(*(const v4u*)(pr + PCC + c0), *(const v4u*)(pr + PCC + c0 + 8), cc); unpack16(*(const v4u*)(pr + PCH + c0), *(const v4u*)(pr + PCH + c0 + 8), chh); }
#pragma unroll
        for (int i = 0; i < 16; ++i) u1[i] = cc[i] * chh[i];
    }
#pragma unroll 2
    for (int it = 0; it < 8; ++it) { const int t = tfirst + it; const bf16* pr = proj + (size_t)t * NP;
        float o[16], r[16], cb[16], cc[16], chh[16];
        unpack16(*(const v4u*)(ogla + (size_t)t * 1024 + c0), *(const v4u*)(ogla + (size_t)t * 1024 + c0 + 8), o);
        unpack16(*(const v4u*)(pr + PR + c0), *(const v4u*)(pr + PR + c0 + 8), r);
        unpack16(*(const v4u*)(pr + PCB + c0), *(const v4u*)(pr + PCB + c0 + 8), cb);
        unpack16(*(const v4u*)(pr + PCC + c0), *(const v4u*)(pr + PCC + c0 + 8), cc);
        unpack16(*(const v4u*)(pr + PCH + c0), *(const v4u*)(pr + PCH + c0 + 8), chh);
        float ss = 0.f;
#pragma unroll
        for (int i = 0; i < 16; ++i) ss += o[i] * o[i];
        ss += __shfl_xor(ss, 1); ss += __shfl_xor(ss, 2); ss += __shfl_xor(ss, 4); ss += __shfl_xor(ss, 8);
        const float rg = rsqrtf(ss * (1.0f / 256.f) + EPS);
        float val[16]; float s2 = 0.f;
#pragma unroll
        for (int i = 0; i < 16; ++i) { const float u0 = cc[i] * chh[i]; val[i] = cb[i] * (cw0[i] * u2[i] + cw1[i] * u1[i] + cw2[i] * u0); s2 += val[i] * val[i]; u2[i] = u1[i]; u1[i] = u0; }
        const float rc = rsqrtf(wave_sum(s2) * (1.0f / 1024.f) + EPS);
        float ya[16], yb[16]; float mx = 0.f;
#pragma unroll
        for (int i = 0; i < 16; ++i) { ya[i] = o[i] * rg * gn[i] * silu_f(r[i]); yb[i] = val[i] * rc * cn[i]; mx = fmaxf(mx, fmaxf(fabsf(ya[i]), fabsf(yb[i]))); }
#pragma unroll
        for (int o_ = 1; o_ < 64; o_ <<= 1) mx = fmaxf(mx, __shfl_xor(mx, o_));
        const float inv = mx > 0.f ? 127.0f / mx : 0.f;
        v4u y0, y1;
#pragma unroll
        for (int j = 0; j < 4; ++j) { y0[j] = pack_i8(ya[4 * j] * inv, ya[4 * j + 1] * inv, ya[4 * j + 2] * inv, ya[4 * j + 3] * inv); y1[j] = pack_i8(yb[4 * j] * inv, yb[4 * j + 1] * inv, yb[4 * j + 2] * inv, yb[4 * j + 3] * inv); }
        unsigned char* yr = a.ws + WS_Y8 + (size_t)t * D;
        *(v4u*)(yr + c0) = y0; *(v4u*)(yr + 1024 + c0) = y1;
#if !I8_OUT
        { v4u b0, b1, b2, b3;
#pragma unroll
          for (int j = 0; j < 4; ++j) { b0[j] = pk2(ya[2 * j], ya[2 * j + 1]); b1[j] = pk2(ya[8 + 2 * j], ya[9 + 2 * j]); b2[j] = pk2(yb[2 * j], yb[2 * j + 1]); b3[j] = pk2(yb[8 + 2 * j], yb[9 + 2 * j]); }
          bf16* ybr = (bf16*)(a.ws + WS_Y) + (size_t)t * D;
          *(v4u*)(ybr + c0) = b0; *(v4u*)(ybr + c0 + 8) = b1; *(v4u*)(ybr + 1024 + c0) = b2; *(v4u*)(ybr + 1024 + c0 + 8) = b3; }
#endif
        if (lane == 0) ((float*)(a.ws + WS_SAY))[t] = mx * (1.0f / 127.0f);
    }
}

__device__ __forceinline__ void ln1_chunk(const Args& a, int l, LAS unsigned char* lds, int lane, int wave, int ch) {
    const float* zbuf = (const float*)(a.ws + WS_Z); const float* mod = (const float*)(a.ws + WS_MOD);
    const int b = ch / NCH; const float* mb = mod + ((size_t)l * NB + b) * 6 * D;
#pragma unroll 2
    for (int it = 0; it < 8; ++it) { const int t = ch * 64 + wave * 8 + it;
        float z[32];
#pragma unroll
#if RES16_Z
        for (int c = 0; c < 8; ++c) { const v2u v0 = *(const v2u*)((const bf16*)zbuf + (size_t)t * D + (c * 64 + lane) * 4); z[c * 4] = bflo(v0.x); z[c * 4 + 1] = bfhi(v0.x); z[c * 4 + 2] = bflo(v0.y); z[c * 4 + 3] = bfhi(v0.y); }
#else
        for (int c = 0; c < 8; ++c) { const f32x4 v0 = *(const f32x4*)(zbuf + (size_t)t * D + (c * 64 + lane) * 4); z[c * 4] = v0.x; z[c * 4 + 1] = v0.y; z[c * 4 + 2] = v0.z; z[c * 4 + 3] = v0.w; }
#endif
        ln_tail(z, t, lane, a.in[11] + (size_t)l * D, a.in[12] + (size_t)l * D, RES16_X1 ? (float*)nullptr : (float*)(a.ws + WS_X1), mb + 3 * D, mb + 4 * D, I8_WQ ? (bf16*)nullptr : (bf16*)(a.ws + WS_H2), a.ws + WS_HQ8, (float*)(a.ws + WS_HSC), lds + wave * 2304, I8_WQ ? a.ws + WS_H28 : (unsigned char*)nullptr, nullptr, RES16_X1 ? (bf16*)(a.ws + WS_X1) : (bf16*)nullptr);
    }
}

template <int N> __device__ __forceinline__ void bitonic_sort_desc(float (&v)[N]) {
#pragma unroll
    for (int k = 2; k <= N; k <<= 1)
#pragma unroll
        for (int j = k >> 1; j > 0; j >>= 1)
#pragma unroll
            for (int i = 0; i < N; ++i) { const int p = i ^ j; if (p > i) { const bool desc = ((i & k) == 0); const float x = v[i], y = v[p]; const float mx = fmaxf(x, y), mn = fminf(x, y); v[i] = desc ? mx : mn; v[p] = desc ? mn : mx; } }
}
__device__ __forceinline__ void merge_top16(float (&x)[16], const float (&y)[16]) {
#pragma unroll
    for (int i = 0; i < 16; ++i) x[i] = fmaxf(x[i], y[15 - i]);
#pragma unroll
    for (int j = 8; j > 0; j >>= 1)
#pragma unroll
        for (int i = 0; i < 16; ++i) { const int p = i ^ j; if (p > i) { const float u = x[i], w = x[p]; x[i] = fmaxf(u, w); x[p] = fminf(u, w); } }
}
__device__ __forceinline__ void ce_desc(float& ka, int& pa, float& kb, int& pb) { const bool sw = kb > ka; const float k0 = sw ? kb : ka, k1 = sw ? ka : kb; const int p0 = sw ? pb : pa, p1 = sw ? pa : pb; ka = k0; pa = p0; kb = k1; pb = p1; }
__device__ __forceinline__ void bitonic_sort_desc_kp(float (&k)[16], int (&p)[16]) {
#pragma unroll
    for (int kk = 2; kk <= 16; kk <<= 1)
#pragma unroll
        for (int j = kk >> 1; j > 0; j >>= 1)
#pragma unroll
            for (int i = 0; i < 16; ++i) { const int q = i ^ j; if (q > i) { if ((i & kk) == 0) ce_desc(k[i], p[i], k[q], p[q]); else ce_desc(k[q], p[q], k[i], p[i]); } }
}
__device__ __forceinline__ void merge_top16_kp(float (&k)[16], int (&p)[16], const float (&k2)[16], const int (&p2)[16]) {
#pragma unroll
    for (int i = 0; i < 16; ++i) { const bool sw = k2[15 - i] > k[i]; k[i] = sw ? k2[15 - i] : k[i]; p[i] = sw ? p2[15 - i] : p[i]; }
#pragma unroll
    for (int j = 8; j > 0; j >>= 1)
#pragma unroll
        for (int i = 0; i < 16; ++i) { const int q = i ^ j; if (q > i) ce_desc(k[i], p[i], k[q], p[q]); }
}
__device__ constexpr int cand_i(int s) { return s < 16 ? 0 : s < 24 ? 1 : s < 29 ? 2 : s < 33 ? 3 : s < 36 ? 4 : s < 38 ? 5 : s < 40 ? 6 : s < 42 ? 7 : s < 50 ? s - 34 : -1; }
__device__ constexpr int cand_j(int s) { return s < 16 ? s : s < 24 ? s - 16 : s < 29 ? s - 24 : s < 33 ? s - 29 : s < 36 ? s - 33 : s < 38 ? s - 36 : s < 40 ? s - 38 : s < 42 ? s - 40 : s < 50 ? 0 : -1; }

__device__ __forceinline__ void peer_retrieve(const Args& a, int l, LAS unsigned char* lds, int lane, int wave, int ch) {
    const bf16* qbuf = (const bf16*)(a.ws + WS_Q); const bf16* keys = (const bf16*)(a.ws + WS_KEYS) + ((size_t)(l * 8 + wave) * 2) * 128 * 128;
    LAS int* eg_e = (LAS int*)lds; LAS float* eg_g = (LAS float*)(lds + 32768);
    const int l31 = lane & 31, l5 = lane >> 5, h = wave, t0 = ch * 64;
    for (int tt = 0; tt < 2; ++tt) {
        float sv[2][16];
#pragma unroll
        for (int p = 0; p < 2; ++p) {
            f32x16 acc[4];
#pragma unroll
            for (int nt = 0; nt < 4; ++nt)
#pragma unroll
                for (int r = 0; r < 16; ++r) acc[nt][r] = 0.f;
            const bf16* qp = qbuf + (size_t)(t0 + 32 * tt + l31) * D + h * 256 + p * 128 + 8 * l5;
            const bf16* kp = keys + (size_t)(p * 128 + l31) * 128 + 8 * l5;
#pragma unroll 4
            for (int ks = 0; ks < 8; ++ks) { const bf16x8 bq = *(const bf16x8*)(qp + 16 * ks);
#pragma unroll
                for (int nt = 0; nt < 4; ++nt) { const bf16x8 ak = *(const bf16x8*)(kp + (size_t)(32 * nt) * 128 + 16 * ks); acc[nt] = __builtin_amdgcn_mfma_f32_32x32x16_bf16(ak, bq, acc[nt], 0, 0, 0); } }
            float v[4][16];
#pragma unroll
            for (int nt = 0; nt < 4; ++nt)
#pragma unroll
                for (int r = 0; r < 16; ++r) { const unsigned idx = 32u * nt + (r & 3) + 8u * (r >> 2) + 4u * l5; v[nt][r] = __uint_as_float((__float_as_uint(acc[nt][r]) & 0xffffff80u) | idx); }
#pragma unroll
            for (int nt = 0; nt < 4; ++nt) bitonic_sort_desc<16>(v[nt]);
            merge_top16(v[0], v[1]); merge_top16(v[2], v[3]); merge_top16(v[0], v[2]);
            float o[16];
#pragma unroll
            for (int i = 0; i < 16; ++i) o[i] = __shfl_xor(v[0][i], 32);
            merge_top16(v[0], o);
#pragma unroll
            for (int i = 0; i < 16; ++i) sv[p][i] = v[0][i];
        }
        LAS unsigned char* idxb = (LAS unsigned char*)(lds + 69632) + wave * 2048 + lane * 32;
        { v4u w0, w1;
#pragma unroll
          for (int q4 = 0; q4 < 4; ++q4) {
              w0[q4] = (__float_as_uint(sv[0][4 * q4]) & 127u) | ((__float_as_uint(sv[0][4 * q4 + 1]) & 127u) << 8) | ((__float_as_uint(sv[0][4 * q4 + 2]) & 127u) << 16) | ((__float_as_uint(sv[0][4 * q4 + 3]) & 127u) << 24);
              w1[q4] = (__float_as_uint(sv[1][4 * q4]) & 127u) | ((__float_as_uint(sv[1][4 * q4 + 1]) & 127u) << 8) | ((__float_as_uint(sv[1][4 * q4 + 2]) & 127u) << 16) | ((__float_as_uint(sv[1][4 * q4 + 3]) & 127u) << 24); }
          *(LAS v4u*)(idxb) = w0; *(LAS v4u*)(idxb + 16) = w1; }
        float ck[4][16];
#pragma unroll
        for (int s = 0; s < 64; ++s) {
            if (cand_i(s) >= 0) { const unsigned b0 = __float_as_uint(sv[0][cand_i(s) < 0 ? 0 : cand_i(s)]), b1 = __float_as_uint(sv[1][cand_j(s) < 0 ? 0 : cand_j(s)]);
                const float sum = __uint_as_float(b0 & 0xffffff80u) + __uint_as_float(b1 & 0xffffff80u);
                ck[s >> 4][s & 15] = __uint_as_float((__float_as_uint(sum) & 0xffffff00u) | (unsigned)((cand_i(s) < 0 ? 0 : cand_i(s)) * 16 + (cand_j(s) < 0 ? 0 : cand_j(s)))); }
            else ck[s >> 4][s & 15] = -3.0e38f; }
        bitonic_sort_desc<16>(ck[1]); bitonic_sort_desc<16>(ck[2]);
        merge_top16(ck[0], ck[1]); merge_top16(ck[2], ck[3]); merge_top16(ck[0], ck[2]);
        LDS_WAIT(); asm volatile("" ::: "memory");
        float ex[16]; int ce[16]; float den = 0.f;
        const float cmax = __uint_as_float(__float_as_uint(ck[0][0]) & 0xffffff00u);
#pragma unroll
        for (int i = 0; i < 16; ++i) { const unsigned bits = __float_as_uint(ck[0][i]); ex[i] = __expf(__uint_as_float(bits & 0xffffff00u) - cmax); den += ex[i];
            ce[i] = (int)idxb[(bits >> 4) & 15u] * 128 + (int)idxb[16 + (bits & 15u)]; }
        const float inv = 1.0f / den;
        if (l5 == 0) {
            const int base = (32 * tt + l31) * 128 + h * 16;
#pragma unroll
            for (int i4 = 0; i4 < 4; ++i4) { *(LAS v4u*)(eg_e + base + 4 * i4) = (v4u){(unsigned)ce[4 * i4], (unsigned)ce[4 * i4 + 1], (unsigned)ce[4 * i4 + 2], (unsigned)ce[4 * i4 + 3]};
                *(LAS f32x4*)(eg_g + base + 4 * i4) = (f32x4){ex[4 * i4] * inv, ex[4 * i4 + 1] * inv, ex[4 * i4 + 2] * inv, ex[4 * i4 + 3] * inv}; }
        }
        LDS_WAIT(); asm volatile("" ::: "memory");
    }
}

typedef unsigned char uc4 __attribute__((ext_vector_type(4)));
constexpr int NSLICE = 16, SLICE_SHIFT = 10;
__device__ __forceinline__ int sdot4i(unsigned w, unsigned x, int acc) { return __builtin_amdgcn_sdot4((int)w, (int)x, acc, false); }
__device__ __forceinline__ void fma_ub4(unsigned w, float s, float& y0, float& y1, float& y2, float& y3) { const uc4 b = __builtin_bit_cast(uc4, w); y0 += s * (float)b.x; y1 += s * (float)b.y; y2 += s * (float)b.z; y3 += s * (float)b.w; }
#if TAB4
__device__ __forceinline__ void peer_tail(const Args& a, int l, int t, int lane, const bf16* Yrow, const float* mb, const float* mbn, bool last) {
    const float* x1buf = (const float*)(a.ws + WS_X1);
    float z[32];
#pragma unroll
    for (int c8 = 0; c8 < 8; ++c8) { const int col = (c8 * 64 + lane) * 4;
        const v2u yb = *(const v2u*)(Yrow + col); const f32x4 yv = (f32x4){bflo(yb.x), bfhi(yb.x), bflo(yb.y), bfhi(yb.y)};
#if RES16_X1
        const v2u xb_ = *(const v2u*)((const bf16*)x1buf + (size_t)t * D + col); const f32x4 x0 = (f32x4){bflo(xb_.x), bfhi(xb_.x), bflo(xb_.y), bfhi(xb_.y)}, g0 = *(const f32x4*)(mb + 5 * D + col);
#else
        const f32x4 x0 = *(const f32x4*)(x1buf + (size_t)t * D + col), g0 = *(const f32x4*)(mb + 5 * D + col);
#endif
        z[c8 * 4] = ALPHA * x0.x + (1.f + g0.x) * yv.x; z[c8 * 4 + 1] = ALPHA * x0.y + (1.f + g0.y) * yv.y; z[c8 * 4 + 2] = ALPHA * x0.z + (1.f + g0.z) * yv.z; z[c8 * 4 + 3] = ALPHA * x0.w + (1.f + g0.w) * yv.w; }
    ln_tail(z, t, lane, a.in[17] + (size_t)l * D, a.in[18] + (size_t)l * D, last ? a.out : (RES16_X ? (float*)nullptr : (float*)(a.ws + WS_X)), mbn, mbn + D, (last || I8_GATE) ? (bf16*)nullptr : (bf16*)(a.ws + WS_H), nullptr, nullptr, nullptr, last ? (unsigned char*)nullptr : a.ws + WS_H8, (float*)(a.ws + WS_SAH), (RES16_X && !last) ? (bf16*)(a.ws + WS_X) : (bf16*)nullptr);
}
template <class TT, int N, int M> __device__ __forceinline__ void treduce(TT (&v)[N], int lane) {
    const bool c0 = (lane & M) != 0, c1 = (lane & (2 * M)) != 0, c2 = (lane & (4 * M)) != 0;
#pragma unroll
    for (int m = 0; m < N / 2; ++m) { const TT keep = c0 ? v[2 * m + 1] : v[2 * m], send = c0 ? v[2 * m] : v[2 * m + 1]; v[m] = keep + __shfl_xor(send, M); }
#pragma unroll
    for (int m = 0; m < N / 4; ++m) { const TT keep = c1 ? v[2 * m + 1] : v[2 * m], send = c1 ? v[2 * m] : v[2 * m + 1]; v[m] = keep + __shfl_xor(send, 2 * M); }
#pragma unroll
    for (int m = 0; m < N / 8; ++m) { const TT keep = c2 ? v[2 * m + 1] : v[2 * m], send = c2 ? v[2 * m] : v[2 * m + 1]; v[m] = keep + __shfl_xor(send, 4 * M); }
}
__device__ __forceinline__ int allsum_8_16_32(int x) {
    x += __builtin_amdgcn_update_dpp(0, x, 0x128, 0xf, 0xf, false);
    { const auto r = __builtin_amdgcn_permlane16_swap((unsigned)x, (unsigned)x, false, false); x = (int)(r[0] + r[1]); }
    { const auto r = __builtin_amdgcn_permlane32_swap((unsigned)x, (unsigned)x, false, false); x = (int)(r[0] + r[1]); }
    return x; }
__device__ __forceinline__ float allmax_8_16_32(float x) {
    x = fmaxf(x, __uint_as_float((unsigned)__builtin_amdgcn_update_dpp(0, (int)__float_as_uint(x), 0x128, 0xf, 0xf, false)));
    { const auto r = __builtin_amdgcn_permlane16_swap(__float_as_uint(x), __float_as_uint(x), false, false); x = fmaxf(__uint_as_float(r[0]), __uint_as_float(r[1])); }
    { const auto r = __builtin_amdgcn_permlane32_swap(__float_as_uint(x), __float_as_uint(x), false, false); x = fmaxf(__uint_as_float(r[0]), __uint_as_float(r[1])); }
    return x; }
__device__ __forceinline__ void treduce32x8(int (&v)[32], int lane) {
    const bool c0 = (lane & 8) != 0;
#pragma unroll
    for (int m = 0; m < 16; ++m) { const int keep = c0 ? v[2 * m + 1] : v[2 * m], send = c0 ? v[2 * m] : v[2 * m + 1]; v[m] = keep + __builtin_amdgcn_update_dpp(0, send, 0x128, 0xf, 0xf, false); }
#pragma unroll
    for (int m = 0; m < 8; ++m) { const auto r = __builtin_amdgcn_permlane16_swap((unsigned)v[2 * m], (unsigned)v[2 * m + 1], false, false); v[m] = (int)(r[0] + r[1]); }
#pragma unroll
    for (int m = 0; m < 4; ++m) { const auto r = __builtin_amdgcn_permlane32_swap((unsigned)v[2 * m], (unsigned)v[2 * m + 1], false, false); v[m] = (int)(r[0] + r[1]); }
}
__device__ __forceinline__ void tr4x4(unsigned a, unsigned b, unsigned c, unsigned d, unsigned& t0, unsigned& t1, unsigned& t2, unsigned& t3) {
    const unsigned x0 = __builtin_amdgcn_perm(b, a, 0x05010400u), x1 = __builtin_amdgcn_perm(b, a, 0x07030602u), y0 = __builtin_amdgcn_perm(d, c, 0x05010400u), y1 = __builtin_amdgcn_perm(d, c, 0x07030602u);
    t0 = __builtin_amdgcn_perm(y0, x0, 0x05040100u); t1 = __builtin_amdgcn_perm(y0, x0, 0x07060302u); t2 = __builtin_amdgcn_perm(y1, x1, 0x05040100u); t3 = __builtin_amdgcn_perm(y1, x1, 0x07060302u);
}
__device__ __forceinline__ int sdot8i(unsigned w, unsigned x, int acc) { return __builtin_amdgcn_sdot8((int)w, (int)x, acc, false); }
__device__ __forceinline__ float slot_scale(unsigned w3) { return __builtin_amdgcn_exp2f((float)(w3 >> 24) * 0.125f - 16.0f); }
__device__ __forceinline__ void peer_experts(const Args& a, int l, LAS unsigned char* lds, int lane0, int wave, int ch) {
    const float* mod = (const float*)(a.ws + WS_MOD);
    const unsigned char* ut = a.ws + WS_UT + (size_t)l * NE * 1152; const unsigned char* vt = a.ws + WS_VT + (size_t)l * NE * 1152; const unsigned char* hq8 = a.ws + WS_HQ8;
    const float* hsc = (const float*)(a.ws + WS_HSC);
    bf16* Ybuf = (bf16*)(a.ws + WS_Z);
    const LAS int* eg_e = (const LAS int*)lds; LAS float* sw = (LAS float*)(lds + 32768);
    LAS float* apart = (LAS float*)(lds + 65536);
    const int b = ch / NCH; const bool last = (l == NL - 1);
    const float* mb = mod + ((size_t)l * NB + b) * 6 * D; const float* mbn = mod + ((size_t)(last ? l : l + 1) * NB + b) * 6 * D;
    const int tlw = wave * 8;
    { const int lane = lane0;
#pragma unroll
      for (int i = 0; i < 16; ++i) apart[tlw * 128 + i * 64 + lane] = 0.f; }
    LDS_WAIT(); asm volatile("" ::: "memory");
    {
        int laneL = lane0; asm volatile("" : "+v"(laneL)); const int lane = laneL;
        const int g = lane >> 3, l7 = lane & 7;
        v4u bufA[16], bufB[16], hA0, hA1, hB0, hB1;
#define CU_LOAD(buf, h0_, h1_, idx_) do { const int u_ = (idx_) >> 3, tl_ = tlw + ((idx_) & 7); const unsigned soff_ = (unsigned)(u_ * 128 + l7 * 16); \
            const unsigned char* hp_ = hq8 + (size_t)(ch * 64 + tl_) * 2304 + (u_ * 8 + l7) * 32; h0_ = *(const v4u*)hp_; h1_ = *(const v4u*)(hp_ + 16); \
            _Pragma("unroll") for (int i_ = 0; i_ < 16; ++i_) { const unsigned e_ = (unsigned)eg_e[tl_ * 128 + 8 * i_ + g]; buf[i_] = *(const v4u*)(ut + (size_t)(e_ * 1152u + soff_)); } } while (0)
#define CU_COMP(buf, h0_, h1_, idx_) do { const int tl_ = tlw + ((idx_) & 7); float accv_[16]; \
            _Pragma("unroll") for (int i_ = 0; i_ < 16; ++i_) { int sl_ = 0, sh_ = 0; \
                _Pragma("unroll") for (int d_ = 0; d_ < 4; ++d_) { const unsigned x_ = buf[i_][d_] ^ 0x88888888u; sl_ = sdot8i(x_, h0_[d_], sl_); sh_ = sdot8i(x_, h1_[d_], sh_); } \
                accv_[i_] = slot_scale(buf[i_][3]) * (float)(16 * sh_ + sl_); } \
            treduce<float, 16, 1>(accv_, lane); \
            apart[tl_ * 128 + 8 * l7 + g] += accv_[0]; apart[tl_ * 128 + 8 * (8 + l7) + g] += accv_[1]; } while (0)
        CU_LOAD(bufA, hA0, hA1, 0);
        for (int idx = 0; idx < 72; idx += 2) {
            CU_LOAD(bufB, hB0, hB1, idx + 1);
            CU_COMP(bufA, hA0, hA1, idx);
            { const int nx_ = idx + 2 < 72 ? idx + 2 : 71; CU_LOAD(bufA, hA0, hA1, nx_); }
            CU_COMP(bufB, hB0, hB1, idx + 1);
        }
#undef CU_LOAD
#undef CU_COMP
        LDS_WAIT(); asm volatile("" ::: "memory");
        for (int it = 0; it < 8; ++it) { const int tl = tlw + it; const float shs = hsc[ch * 64 + tl];
            const float w0 = sw[tl * 128 + lane] * gelu_tanh_f(apart[tl * 128 + lane] * shs), w1 = sw[tl * 128 + 64 + lane] * gelu_tanh_f(apart[tl * 128 + 64 + lane] * shs);
            sw[tl * 128 + lane] = w0; sw[tl * 128 + 64 + lane] = w1; }
        LDS_WAIT(); asm volatile("" ::: "memory");
    }
    {
        int laneL = lane0; asm volatile("" : "+v"(laneL)); const int lane = laneL;
        const int g = lane >> 3, l7 = lane & 7;
        v4u bufA[16], bufB[16];
#define CV_LOAD(buf, idx_) do { const int u_ = (idx_) >> 3, tl_ = tlw + ((idx_) & 7); const unsigned soff_ = (unsigned)(u_ * 128 + l7 * 16); \
            _Pragma("unroll") for (int i_ = 0; i_ < 16; ++i_) { const unsigned e_ = (unsigned)eg_e[tl_ * 128 + 8 * i_ + g]; buf[i_] = *(const v4u*)(vt + (size_t)(e_ * 1152u + soff_)); } } while (0)
#define CV_COMP(buf, idx_) do { const int u_ = (idx_) >> 3, tl_ = tlw + ((idx_) & 7); \
            float wf_[16]; float wmx_ = 0.f; \
            _Pragma("unroll") for (int i_ = 0; i_ < 16; ++i_) { wf_[i_] = sw[tl_ * 128 + 8 * i_ + g] * slot_scale(buf[i_][3]); wmx_ = fmaxf(wmx_, fabsf(wf_[i_])); } \
            wmx_ = allmax_8_16_32(wmx_);     \
            const float winv_ = wmx_ > 0.f ? 127.0f / wmx_ : 0.f, wsc_ = wmx_ * (1.0f / 127.0f); \
              \
            unsigned wq4_[4]; int wsum_ = 0; \
            _Pragma("unroll") for (int gp_ = 0; gp_ < 4; ++gp_) { \
                const unsigned m0_ = __float_as_uint(wf_[4 * gp_] * winv_ + 12582912.0f), m1_ = __float_as_uint(wf_[4 * gp_ + 1] * winv_ + 12582912.0f), m2_ = __float_as_uint(wf_[4 * gp_ + 2] * winv_ + 12582912.0f), m3_ = __float_as_uint(wf_[4 * gp_ + 3] * winv_ + 12582912.0f); \
                wq4_[gp_] = __builtin_amdgcn_perm(__builtin_amdgcn_perm(m3_, m2_, 0x0c0c0400u), __builtin_amdgcn_perm(m1_, m0_, 0x0c0c0400u), 0x05040100u); \
                wsum_ = sdot4i(wq4_[gp_], 0x01010101u, wsum_); } \
            int yi_[32]; \
            _Pragma("unroll") for (int q_ = 0; q_ < 32; ++q_) yi_[q_] = 0; \
            _Pragma("unroll") for (int gp_ = 0; gp_ < 4; ++gp_) { \
                _Pragma("unroll") for (int d_ = 0; d_ < 4; ++d_) { const unsigned A_ = buf[4 * gp_][d_], B_ = buf[4 * gp_ + 1][d_], C_ = buf[4 * gp_ + 2][d_], D_ = buf[4 * gp_ + 3][d_]; \
                    unsigned t0_, t1_, t2_, t3_; \
                    tr4x4(A_, B_, C_, D_, t0_, t1_, t2_, t3_);     \
                    yi_[8 * d_]     = sdot4i(t0_ & 0x0f0f0f0fu, wq4_[gp_], yi_[8 * d_]);     yi_[8 * d_ + 1] = sdot4i((t0_ >> 4) & 0x0f0f0f0fu, wq4_[gp_], yi_[8 * d_ + 1]); \
                    yi_[8 * d_ + 2] = sdot4i(t1_ & 0x0f0f0f0fu, wq4_[gp_], yi_[8 * d_ + 2]); yi_[8 * d_ + 3] = sdot4i((t1_ >> 4) & 0x0f0f0f0fu, wq4_[gp_], yi_[8 * d_ + 3]); \
                    yi_[8 * d_ + 4] = sdot4i(t2_ & 0x0f0f0f0fu, wq4_[gp_], yi_[8 * d_ + 4]); yi_[8 * d_ + 5] = sdot4i((t2_ >> 4) & 0x0f0f0f0fu, wq4_[gp_], yi_[8 * d_ + 5]); \
                    yi_[8 * d_ + 6] = sdot4i(t3_ & 0x0f0f0f0fu, wq4_[gp_], yi_[8 * d_ + 6]); yi_[8 * d_ + 7] = sdot4i((t3_ >> 4) & 0x0f0f0f0fu, wq4_[gp_], yi_[8 * d_ + 7]); } } \
            treduce32x8(yi_, lane); \
            wsum_ = allsum_8_16_32(wsum_);     \
            float y_[4]; \
            _Pragma("unroll") for (int q_ = 0; q_ < 4; ++q_) y_[q_] = wsc_ * (float)(yi_[q_] - 8 * wsum_); \
            { const int colb_ = u_ * 240 + l7 * 30 + g; bf16* yr_ = Ybuf + (size_t)(ch * 64 + tl_) * D + colb_; \
              _Pragma("unroll") for (int m_ = 0; m_ < 4; ++m_) if (8 * m_ + g < 30 && colb_ + 8 * m_ < D) yr_[8 * m_] = (bf16)(pk2(y_[m_], 0.f) & 0xffffu); } } while (0)
        CV_LOAD(bufA, 0);
        for (int idx = 0; idx < 72; idx += 2) {
            CV_LOAD(bufB, idx + 1);
            CV_COMP(bufA, idx);
            { const int nx_ = idx + 2 < 72 ? idx + 2 : 71; CV_LOAD(bufA, nx_); }
            CV_COMP(bufB, idx + 1);
        }
#undef CV_LOAD
#undef CV_COMP
    }
    asm volatile("s_waitcnt vmcnt(0)" ::: "memory");
    __builtin_amdgcn_fence(__ATOMIC_ACQUIRE, "agent");
    asm volatile("s_waitcnt vmcnt(0)" ::: "memory");
    for (int it = 0; it < 8; ++it) { int laneT = lane0; asm volatile("" : "+v"(laneT)); const int t = ch * 64 + tlw + it;
        peer_tail(a, l, t, laneT, Ybuf + (size_t)t * D, mb, mbn, last); }
}
#else
__device__ __forceinline__ void peer_tail(const Args& a, int l, int t, int lane, const float* Yrow, const float* mb, const float* mbn, bool last) {
    const float* x1buf = (const float*)(a.ws + WS_X1);
    float z[32];
#pragma unroll
    for (int c = 0; c < 2; ++c)
#pragma unroll
        for (int k = 0; k < 4; ++k) { const int c8 = 4 * c + k, col = (c8 * 64 + lane) * 4;
            const v2u yb = *(const v2u*)((const bf16*)Yrow + (c * 64 + lane) * 16 + 4 * k); const f32x4 yv = (f32x4){bflo(yb.x), bfhi(yb.x), bflo(yb.y), bfhi(yb.y)};
#if RES16_X1
            const v2u xb_ = *(const v2u*)((const bf16*)x1buf + (size_t)t * D + col); const f32x4 x0 = (f32x4){bflo(xb_.x), bfhi(xb_.x), bflo(xb_.y), bfhi(xb_.y)}, g0 = *(const f32x4*)(mb + 5 * D + col);
#else
            const f32x4 x0 = *(const f32x4*)(x1buf + (size_t)t * D + col), g0 = *(const f32x4*)(mb + 5 * D + col);
#endif
            z[c8 * 4] = ALPHA * x0.x + (1.f + g0.x) * yv.x; z[c8 * 4 + 1] = ALPHA * x0.y + (1.f + g0.y) * yv.y; z[c8 * 4 + 2] = ALPHA * x0.z + (1.f + g0.z) * yv.z; z[c8 * 4 + 3] = ALPHA * x0.w + (1.f + g0.w) * yv.w; }
    ln_tail(z, t, lane, a.in[17] + (size_t)l * D, a.in[18] + (size_t)l * D, last ? a.out : (RES16_X ? (float*)nullptr : (float*)(a.ws + WS_X)), mbn, mbn + D, (last || I8_GATE) ? (bf16*)nullptr : (bf16*)(a.ws + WS_H), nullptr, nullptr, nullptr, last ? (unsigned char*)nullptr : a.ws + WS_H8, (float*)(a.ws + WS_SAH), (RES16_X && !last) ? (bf16*)(a.ws + WS_X) : (bf16*)nullptr);
}
template <class TT, int M> __device__ __forceinline__ void treduce16(TT (&v)[16], int lane) {
    const bool c0 = (lane & M) != 0, c1 = (lane & (2 * M)) != 0, c2 = (lane & (4 * M)) != 0;
#pragma unroll
    for (int m = 0; m < 8; ++m) { const TT keep = c0 ? v[2 * m + 1] : v[2 * m], send = c0 ? v[2 * m] : v[2 * m + 1]; v[m] = keep + __shfl_xor(send, M); }
#pragma unroll
    for (int m = 0; m < 4; ++m) { const TT keep = c1 ? v[2 * m + 1] : v[2 * m], send = c1 ? v[2 * m] : v[2 * m + 1]; v[m] = keep + __shfl_xor(send, 2 * M); }
#pragma unroll
    for (int m = 0; m < 2; ++m) { const TT keep = c2 ? v[2 * m + 1] : v[2 * m], send = c2 ? v[2 * m] : v[2 * m + 1]; v[m] = keep + __shfl_xor(send, 4 * M); }
}
__device__ __forceinline__ void peer_experts(const Args& a, int l, LAS unsigned char* lds, int lane0, int wave, int ch) {
    const float* mod = (const float*)(a.ws + WS_MOD);
    const unsigned char* ut = a.ws + WS_UT + (size_t)l * NE * D; const unsigned char* vt = a.ws + WS_VT + (size_t)l * NE * D; const unsigned char* hq8 = a.ws + WS_HQ8;
    const float* su = (const float*)(a.ws + WS_SU) + (size_t)l * NE; const float* sv = (const float*)(a.ws + WS_SV) + (size_t)l * NE; const float* hsc = (const float*)(a.ws + WS_HSC);
    float* Ybuf = (float*)(a.ws + WS_Z);
    const LAS int* eg_e = (const LAS int*)lds; LAS float* sw = (LAS float*)(lds + 32768);
    LAS int* apart = (LAS int*)(lds + 65536); LAS float* wtotl = (LAS float*)(lds + LDSCTL_OFF + 256);
    const int b = ch / NCH; const bool last = (l == NL - 1);
    const float* mb = mod + ((size_t)l * NB + b) * 6 * D; const float* mbn = mod + ((size_t)(last ? l : l + 1) * NB + b) * 6 * D;
    const int tlw = wave * 8;
    { const int lane = lane0;
#pragma unroll
      for (int i = 0; i < 16; ++i) apart[tlw * 128 + i * 64 + lane] = 0; }
    LDS_WAIT(); asm volatile("" ::: "memory");
    {
        int laneL = lane0; asm volatile("" : "+v"(laneL)); const int lane = laneL;
        const int g = lane >> 3, l7 = lane & 7;
        v4u bufA[16], bufB[16], hA, hB;
#define CU_LOAD(buf, hh_, idx_) do { const int cs_ = (idx_) >> 3, tl_ = tlw + ((idx_) & 7); const unsigned coff_ = (unsigned)(cs_ * 128 + l7 * 16); \
            hh_ = *(const v4u*)(hq8 + (size_t)(ch * 64 + tl_) * D + coff_); \
            _Pragma("unroll") for (int i_ = 0; i_ < 16; ++i_) { const unsigned e_ = (unsigned)eg_e[tl_ * 128 + 8 * i_ + g]; buf[i_] = *(const v4u*)(ut + (size_t)(e_ * 2048u + coff_)); } } while (0)
#define CU_COMP(buf, hh_, idx_) do { const int tl_ = tlw + ((idx_) & 7); int acc_[16]; \
            _Pragma("unroll") for (int i_ = 0; i_ < 16; ++i_) { int s_ = 0; _Pragma("unroll") for (int q_ = 0; q_ < 4; ++q_) s_ = sdot4i(buf[i_][q_], hh_[q_], s_); acc_[i_] = s_; } \
            treduce16<int, 1>(acc_, lane); \
            apart[tl_ * 128 + 8 * l7 + g] += acc_[0]; apart[tl_ * 128 + 8 * (8 + l7) + g] += acc_[1]; } while (0)
        CU_LOAD(bufA, hA, 0);
        for (int idx = 0; idx < 128; idx += 2) {
            CU_LOAD(bufB, hB, idx + 1);
            CU_COMP(bufA, hA, idx);
            if (idx + 2 < 128) CU_LOAD(bufA, hA, idx + 2);
            CU_COMP(bufB, hB, idx + 1);
        }
#undef CU_LOAD
#undef CU_COMP
        LDS_WAIT(); asm volatile("" ::: "memory");
        for (int it = 0; it < 8; ++it) { const int tl = tlw + it; const float shs = hsc[ch * 64 + tl];
            const int e0 = eg_e[tl * 128 + lane], e1 = eg_e[tl * 128 + 64 + lane];
            const float w0 = sw[tl * 128 + lane] * gelu_tanh_f((float)apart[tl * 128 + lane] * su[e0] * shs) * sv[e0];
            const float w1 = sw[tl * 128 + 64 + lane] * gelu_tanh_f((float)apart[tl * 128 + 64 + lane] * su[e1] * shs) * sv[e1];
            sw[tl * 128 + lane] = w0; sw[tl * 128 + 64 + lane] = w1;
            const float ws = wave_sum(w0 + w1);
            if (lane == 0) wtotl[tl] = ws; }
        LDS_WAIT(); asm volatile("" ::: "memory");
    }
    {
        int laneL = lane0; asm volatile("" : "+v"(laneL)); const int lane = laneL;
        const int g = lane >> 3, l7 = lane & 7;
        v4u bufA[16], bufB[16];
#define CV_LOAD(buf, idx_) do { const int cs_ = (idx_) >> 3, tl_ = tlw + ((idx_) & 7); const unsigned coff_ = (unsigned)(cs_ * 128 + l7 * 16); \
            _Pragma("unroll") for (int i_ = 0; i_ < 16; ++i_) { const unsigned e_ = (unsigned)eg_e[tl_ * 128 + 8 * i_ + g]; buf[i_] = *(const v4u*)(vt + (size_t)(e_ * 2048u + coff_)); } } while (0)
#define CV_COMP(buf, idx_) do { const int cs_ = (idx_) >> 3, tl_ = tlw + ((idx_) & 7); float y_[16]; \
            _Pragma("unroll") for (int q_ = 0; q_ < 16; ++q_) y_[q_] = 0.f; \
            _Pragma("unroll") for (int i_ = 0; i_ < 16; ++i_) { const float wr_ = sw[tl_ * 128 + 8 * i_ + g]; \
                _Pragma("unroll") for (int q_ = 0; q_ < 4; ++q_) fma_ub4(buf[i_][q_], wr_, y_[4 * q_], y_[4 * q_ + 1], y_[4 * q_ + 2], y_[4 * q_ + 3]); } \
            treduce16<float, 8>(y_, lane); \
            const float woff_ = 128.0f * wtotl[tl_]; bf16* yr_ = (bf16*)Ybuf + (size_t)(ch * 64 + tl_) * D + cs_ * 128 + l7 * 16 + g; \
            yr_[0] = (bf16)(pk2(y_[0] - woff_, 0.f) & 0xffffu); yr_[8] = (bf16)(pk2(y_[1] - woff_, 0.f) & 0xffffu); } while (0)
        CV_LOAD(bufA, 0);
        for (int idx = 0; idx < 128; idx += 2) {
            CV_LOAD(bufB, idx + 1);
            CV_COMP(bufA, idx);
            if (idx + 2 < 128) CV_LOAD(bufA, idx + 2);
            CV_COMP(bufB, idx + 1);
        }
#undef CV_LOAD
#undef CV_COMP
    }
    asm volatile("s_waitcnt vmcnt(0)" ::: "memory");
    __builtin_amdgcn_fence(__ATOMIC_ACQUIRE, "agent");
    asm volatile("s_waitcnt vmcnt(0)" ::: "memory");
    for (int it = 0; it < 8; ++it) { int laneT = lane0; asm volatile("" : "+v"(laneT)); const int t = ch * 64 + tlw + it;
        peer_tail(a, l, t, laneT, (const float*)((const bf16*)Ybuf + (size_t)t * D), mb, mbn, last); }
}

#endif

#ifndef MK_PER_PHASE
#define MK_PER_PHASE 0
#endif
__global__ void __launch_bounds__(NTHREADS, 2) mk_fwd(Args a) {
    extern __shared__ __attribute__((aligned(16))) unsigned char lds_raw[];
    LAS unsigned char* lds = (LAS unsigned char*)lds_raw;
    const int tid = threadIdx.x, lane = tid & 63, wave = __builtin_amdgcn_readfirstlane(tid >> 6), G = gridDim.x, bx = blockIdx.x;
    if (tid < 64) ((LAS unsigned*)(lds + LDSCTL_OFF))[tid] = 0u;
    __syncthreads();
    unsigned* ctl = (unsigned*)(a.ws + WS_CTL);
    XcdBarrier bar; bar.bar = ctl + CW_BAR; bar.x = 0; bar.st = nullptr;
    const bool use_bar = (a.ph_hi - a.ph_lo) > 1;
    if (use_bar) bar = xcd_barrier_post(ctl + CW_BAR, (volatile LAS unsigned*)(lds + LDSCTL_OFF));
    const int lo = a.ph_lo, hi = a.ph_hi;
#ifndef PH_MASK
#define PH_MASK 0x1ff
#endif
#define IN(k) (lo <= (k) && (k) < hi)
#define EN(b) ((PH_MASK >> (b)) & 1)
#ifndef REP_MASK
#define REP_MASK 0
#endif
#ifndef REP_EXTRA
#define REP_EXTRA 2
#endif
#define REPS(b) (1 + ((REP_MASK >> (b)) & 1) * REP_EXTRA)
#define REP_BEGIN(b) for (int rep_ = 0; rep_ < REPS(b); ++rep_) {
#define REP_END(b) if (rep_ + 1 < REPS(b)) xcd_barrier(bar); }
#define SEAM(k) do { if (IN((k) + 1)) xcd_barrier(bar); } while (0)
#define PHASE_IDS() int tidp = tid; asm volatile("" : "+v"(tidp)); const int lanep = tidp & 63, wavep = __builtin_amdgcn_readfirstlane(tidp >> 6); (void)lanep; (void)wavep
    if (EN(0) && IN(0)) { REP_BEGIN(0) PHASE_IDS(); ph_prologue_a(a, lds, tidp, lanep, wavep, bx, G); REP_END(0) SEAM(0); }
    if (EN(1) && IN(1)) { REP_BEGIN(1) PHASE_IDS(); ph_prologue_b(a, lds, tidp, lanep, wavep, bx, G); REP_END(1) SEAM(1); }
    for (int l = 0; l < NL; ++l) {
        const int pb = 2 + 7 * l;
        const float* mod = (const float*)(a.ws + WS_MOD);
        if (EN(2) && IN(pb + 0)) {
            REP_BEGIN(2) PHASE_IDS();
#if I8_IN
            pg8::Gemm g{(const pg8::bf16_t*)(a.ws + WS_H8), (const pg8::bf16_t*)(a.ws + WS_WIN8 + (size_t)l * NP * D), T, NP, D / 2}; pg8::StaticOrder S; S.init(T, NP, G, bx, WGM_IN, KROT(bx));
            pg8::EpiBf16PS E{(pg8::bf16_t*)(a.ws + WS_PROJ), NP, (const float*)(a.ws + WS_SAH), (const float*)(a.ws + WS_SB) + l * SBL};
            pg8::gemm_phase<pg8::EpiBf16PS, pg8::StaticOrder, true, true, true>(lds + RING_OFF, g, S, E, tidp);
#else
            pg8::Gemm g{(const pg8::bf16_t*)(a.ws + WS_H), (const pg8::bf16_t*)(a.ws + WS_WIN) + (size_t)l * INW * D, T, NP, D}; pg8::StaticOrder S; S.init(T, NP, G, bx, WGM_IN, KROT(bx));
            pg8::EpiBf16P E{(pg8::bf16_t*)(a.ws + WS_PROJ), NP};
            pg8::gemm_phase<pg8::EpiBf16P, pg8::StaticOrder, true, true>(lds + RING_OFF, g, S, E, tidp);
#endif
#ifndef GP_REP
#define GP_REP 1
#endif
            for (int gpr_ = 0; gpr_ < GP_REP; ++gpr_) for (int ch = bx; ch < NCHUNK; ch += G) gate_prep(a, l, lds, tidp, lanep, wavep, ch);
            REP_END(2) SEAM(pb + 0);
        }
        if (EN(3) && IN(pb + 1)) { REP_BEGIN(3) PHASE_IDS(); for (int un = bx; un < 256; un += G) gla_unit(a, lds, tidp, lanep, wavep, un); REP_END(3) SEAM(pb + 1); }
        if (EN(4) && IN(pb + 2)) { REP_BEGIN(4) PHASE_IDS(); for (int ch = bx; ch < NCHUNK; ch += G) mixpost_chunk(a, l, lanep, wavep, ch); REP_END(4) SEAM(pb + 2); }
        if (EN(5) && IN(pb + 3)) {
            REP_BEGIN(5) PHASE_IDS();
#if I8_OUT
            pg8::Gemm g{(const pg8::bf16_t*)(a.ws + WS_Y8), (const pg8::bf16_t*)(a.ws + WS_WOUT8 + (size_t)l * D * D), T, D, D / 2}; pg8::StaticOrder S; S.init(T, D, G, bx, WGM_OUT, KROT(bx));
#if RES16_X || RES16_Z
            pg8::EpiResidS16<(RES16_X != 0), (RES16_Z != 0)> E{(void*)(a.ws + WS_Z), (RES16_X || l > 0) ? (const void*)(a.ws + WS_X) : (const void*)a.in[0], mod + (size_t)l * NB * 6 * D + 2 * D, (const float*)(a.ws + WS_SAY), (const float*)(a.ws + WS_SB) + l * SBL + NP, ALPHA};
            pg8::gemm_phase<pg8::EpiResidS16<(RES16_X != 0), (RES16_Z != 0)>, pg8::StaticOrder, true, true, true>(lds + RING_OFF, g, S, E, tidp);
#else
            pg8::EpiResidS E{(float*)(a.ws + WS_Z), l == 0 ? a.in[0] : (const float*)(a.ws + WS_X), mod + (size_t)l * NB * 6 * D + 2 * D, (const float*)(a.ws + WS_SAY), (const float*)(a.ws + WS_SB) + l * SBL + NP, ALPHA};
            pg8::gemm_phase<pg8::EpiResidS, pg8::StaticOrder, true, true, true>(lds + RING_OFF, g, S, E, tidp);
#endif
#else
            pg8::Gemm g{(const pg8::bf16_t*)(a.ws + WS_Y), (const pg8::bf16_t*)(a.ws + WS_WOUT) + (size_t)l * D * D, T, D, D}; pg8::StaticOrder S; S.init(T, D, G, bx, WGM_OUT, KROT(bx));
            pg8::EpiResid E{(float*)(a.ws + WS_Z), l == 0 ? a.in[0] : (const float*)(a.ws + WS_X), mod + (size_t)l * NB * 6 * D + 2 * D, ALPHA};
            pg8::gemm_phase<pg8::EpiResid, pg8::StaticOrder, true, true>(lds + RING_OFF, g, S, E, tidp);
#endif
            REP_END(5) SEAM(pb + 3);
        }
        if (EN(6) && IN(pb + 4)) { REP_BEGIN(6) PHASE_IDS(); for (int ch = bx; ch < NCHUNK; ch += G) ln1_chunk(a, l, lds, lanep, wavep, ch); REP_END(6) SEAM(pb + 4); }
        if (EN(7) && IN(pb + 5)) {
            REP_BEGIN(7) PHASE_IDS();
#if I8_WQ
            pg8::Gemm g{(const pg8::bf16_t*)(a.ws + WS_H28), (const pg8::bf16_t*)(a.ws + WS_WQ8 + (size_t)l * D * D), T, D, D / 2}; pg8::StaticOrder S; S.init(T, D, G, bx, WGM_WQ, KROT(bx));
            pg8::EpiBf16PS E{(pg8::bf16_t*)(a.ws + WS_Q), D, (const float*)(a.ws + WS_HSC), (const float*)(a.ws + WS_SB) + l * SBL + NP + D};
            pg8::gemm_phase<pg8::EpiBf16PS, pg8::StaticOrder, true, true, true>(lds + RING_OFF, g, S, E, tidp);
#else
            pg8::Gemm g{(const pg8::bf16_t*)(a.ws + WS_H2), (const pg8::bf16_t*)(a.ws + WS_WQ) + (size_t)l * D * D, T, D, D}; pg8::StaticOrder S; S.init(T, D, G, bx, WGM_WQ, KROT(bx));
            pg8::EpiBf16P E{(pg8::bf16_t*)(a.ws + WS_Q), D};
            pg8::gemm_phase<pg8::EpiBf16P, pg8::StaticOrder, true, true>(lds + RING_OFF, g, S, E, tidp);
#endif
            REP_END(7) SEAM(pb + 5);
        }
#ifndef PEER_DBG
#define PEER_DBG 0
#endif
#ifndef PE_REP_R
#define PE_REP_R 1
#endif
#ifndef L2PROBE
#define L2PROBE 0
#endif
        if (EN(8) && IN(pb + 6)) {
            REP_BEGIN(8)
            for (int ch = bx; ch < NCHUNK; ch += G) { for (int repr_ = 0; repr_ < PE_REP_R; ++repr_) { PHASE_IDS(); peer_retrieve(a, l, lds, lanep, wavep, ch); __syncthreads(); } __syncthreads(); { PHASE_IDS(); peer_experts(a, l, lds, lanep, wavep, ch); } __syncthreads(); }
            REP_END(8) SEAM(pb + 6);
        }
    }
#undef IN
#undef SEAM
}

extern "C" void kernel_launch(void* const* d_in, const int* in_sizes, int n_in, void* d_out, int out_size, void* d_ws, size_t ws_size, hipStream_t stream) {
    static int grid = 0;
    if (grid == 0) {
        if (n_in != 19 || in_sizes[0] != T * D || out_size != T * D || ws_size < WS_END) { fprintf(stderr, "kernel_launch: unexpected shapes / workspace (%d inputs, ws %zu); nothing launched\n", n_in, ws_size); grid = -1; return; }
        int dev = 0, cus = 0, per_cu = 0;
        if (hipGetDevice(&dev) != hipSuccess || hipDeviceGetAttribute(&cus, hipDeviceAttributeMultiprocessorCount, dev) != hipSuccess) { grid = -1; return; }
        if (hipFuncSetAttribute((const void*)mk_fwd, hipFuncAttributeMaxDynamicSharedMemorySize, LDS_BYTES) != hipSuccess) { fprintf(stderr, "kernel_launch: hipFuncSetAttribute failed\n"); grid = -1; return; }
        if (hipOccupancyMaxActiveBlocksPerMultiprocessor(&per_cu, (const void*)mk_fwd, NTHREADS, LDS_BYTES) != hipSuccess || per_cu < 1) fprintf(stderr, "kernel_launch: occupancy query reports %d\n", per_cu);
        (void)hipGetLastError();
        grid = cus;
    }
    if (grid < 0) return;
    if (hipMemsetAsync((char*)d_ws + WS_CTL, 0, CTL_ZERO_BYTES, stream) != hipSuccess) return;
    Args a{};
    for (int i = 0; i < 19; ++i) a.in[i] = (const float*)d_in[i];
    a.out = (float*)d_out; a.ws = (unsigned char*)d_ws;
#if MK_PER_PHASE
    for (int p = 0; p < NPHASES; ++p) { a.ph_lo = p; a.ph_hi = p + 1; hipLaunchKernelGGL(mk_fwd, dim3(grid), dim3(NTHREADS), LDS_BYTES, stream, a); }
#else
    a.ph_lo = 0; a.ph_hi = NPHASES;
    hipLaunchKernelGGL(mk_fwd, dim3(grid), dim3(NTHREADS), LDS_BYTES, stream, a);
#endif
}
```

```cpp
#include <hip/hip_runtime.h>
#include <cstdio>
#include <cstdint>
namespace pg8 {
#define PG8_LAS __attribute__((address_space(3)))
typedef unsigned short bf16_t;
typedef short bf16x8 __attribute__((ext_vector_type(8)));
typedef float f32x4 __attribute__((ext_vector_type(4)));
typedef unsigned u32x4 __attribute__((ext_vector_type(4)));
typedef int i32x4 __attribute__((ext_vector_type(4)));
constexpr int BM = 256, BK = 64, HALF = 128, HTB = HALF * BK * 2  , STAGE_BYTES = 8 * HTB, NXCD = 8, WGM = 8;

__host__ __device__ __forceinline__ int lds_byte(int r, int c) { const int st = (r >> 4) * 2 + (c >> 5), rr = r & 15, cc = c & 31, ob = rr * 64 + cc * 2; return st * 1024 + (ob ^ (((ob >> 9) & 1) << 5)); }
__host__ __device__ __forceinline__ void stage_rc(int b, int& R, int& C) { const int st = b / 1024, sb = b % 1024, swz = sb ^ (((sb >> 9) & 1) << 5); R = (st >> 1) * 16 + swz / 64; C = (st & 1) * 32 + (swz % 64) / 2; }
__host__ __device__ __forceinline__ int perm32(int rho) { const int n = rho >> 4, i = rho & 15; return 8 * (i >> 2) + 4 * n + (i & 3); }

struct Unit { int pm, pn; };
struct Gemm { const bf16_t* A; const bf16_t* Bt; int M, N, K; };

struct StaticOrder {
    int nM, nN, nwg, G, c, wgm, krot;
    __host__ __device__ void init(int M, int N, int G_, int c_, int wgm_ = WGM, int krot_ = 0) { nM = M / BM; nN = N / BM; nwg = nM * nN; G = G_; c = c_; wgm = wgm_; krot = krot_; }
    __host__ __device__ bool next(int i, Unit& u) const {
        const long L = (long)i * G + c; if (L >= nwg) return false;
        int wgid = (int)L; { const int q = nwg / NXCD, r = nwg % NXCD, xcd = wgid % NXCD, off = wgid / NXCD; wgid = (xcd < r ? xcd * (q + 1) : r * (q + 1) + (xcd - r) * q) + off; }
        const int nig = wgm * nN, gid = wgid / nig, fm = gid * wgm, gsz = (nM - fm) < wgm ? (nM - fm) : wgm;
        u.pm = fm + ((wgid % nig) % gsz); u.pn = (wgid % nig) / gsz; return true;
    }
    __device__ __forceinline__ void a_ready(const Unit&) const {}
    __device__ __forceinline__ void done(const Unit&) const {}
};
typedef __bf16 bf16x2_t __attribute__((ext_vector_type(2)));
__device__ __forceinline__ unsigned cvt_pk_bf16(float lo, float hi) { bf16x2_t r; r.x = (__bf16)lo; r.y = (__bf16)hi; return __builtin_bit_cast(unsigned, r); }
struct EpiBf16P {
    static constexpr bool PERM = true, AFTER_DRAIN = false;
    bf16_t* O; int ldc;
    __device__ __forceinline__ void operator()(const f32x4 (&acc)[2][2][4][2], const Unit& u, int wr, int wc, int fr, int fq) const {
        const int row0 = u.pm * BM + wr * 64 + fr, col0 = u.pn * BM + wc * 32 + 8 * fq;
#pragma unroll
        for (int ai = 0; ai < 2; ++ai)
#pragma unroll
            for (int m = 0; m < 4; ++m) { bf16_t* rowp = O + (size_t)(row0 + ai * HALF + m * 16) * ldc + col0;
#pragma unroll
                for (int bj = 0; bj < 2; ++bj) { const f32x4 v0 = acc[ai][bj][m][0], v1 = acc[ai][bj][m][1];
                    u32x4 w; w.x = cvt_pk_bf16(v0[0], v0[1]); w.y = cvt_pk_bf16(v0[2], v0[3]); w.z = cvt_pk_bf16(v1[0], v1[1]); w.w = cvt_pk_bf16(v1[2], v1[3]);
                    *(u32x4*)(rowp + bj * HALF) = w; } }
    }
};
struct EpiResid {
    static constexpr bool PERM = false, AFTER_DRAIN = false;
    float* Z; const float* X; const float* gate; float alpha;
    __device__ __forceinline__ void operator()(const f32x4 (&acc)[2][2][4][2], const Unit& u, int wr, int wc, int fr, int fq) const {
        const int row0 = u.pm * BM + wr * 64 + fr, col0 = u.pn * BM + wc * 32 + 4 * fq;
        const float* gb = gate + (size_t)(u.pm >> 3) * (6 * 2048) + col0;
        f32x4 gv[2][2];
#pragma unroll
        for (int bj = 0; bj < 2; ++bj)
#pragma unroll
            for (int n = 0; n < 2; ++n) gv[bj][n] = *(const f32x4*)(gb + bj * HALF + n * 16) + 1.0f;
#pragma unroll
        for (int ai = 0; ai < 2; ++ai)
#pragma unroll
            for (int m = 0; m < 4; ++m) { const size_t off = (size_t)(row0 + ai * HALF + m * 16) * 2048 + col0;
#pragma unroll
                for (int bj = 0; bj < 2; ++bj)
#pragma unroll
                    for (int n = 0; n < 2; ++n) { const f32x4 xv = *(const f32x4*)(X + off + bj * HALF + n * 16);
                        *(f32x4*)(Z + off + bj * HALF + n * 16) = xv * alpha + gv[bj][n] * acc[ai][bj][m][n]; }
                asm volatile("" ::: "memory"); }
    }
};
#ifndef PG8_NT
#define PG8_NT 0
#endif
#if PG8_NT
#define PG8_ST(TY, p, v) __builtin_nontemporal_store((v), (TY*)(p))
#else
#define PG8_ST(TY, p, v) (*(TY*)(p) = (v))
#endif
__device__ __forceinline__ f32x4 acc_i2f(const f32x4 v) { const i32x4 iv = __builtin_bit_cast(i32x4, v); return __builtin_convertvector(iv, f32x4); }
struct EpiBf16PS {
    static constexpr bool PERM = true, AFTER_DRAIN = false;
    bf16_t* O; int ldc; const float* sa; const float* sb;
    __device__ __forceinline__ void operator()(const f32x4 (&acc)[2][2][4][2], const Unit& u, int wr, int wc, int fr, int fq) const {
        const int row0 = u.pm * BM + wr * 64 + fr, col0 = u.pn * BM + wc * 32 + 8 * fq;
        f32x4 sbv[2][2];
#pragma unroll
        for (int bj = 0; bj < 2; ++bj)
#pragma unroll
            for (int n = 0; n < 2; ++n) sbv[bj][n] = *(const f32x4*)(sb + col0 + bj * HALF + 4 * n);
#pragma unroll
        for (int ai = 0; ai < 2; ++ai)
#pragma unroll
            for (int m = 0; m < 4; ++m) { const int row = row0 + ai * HALF + m * 16; bf16_t* rowp = O + (size_t)row * ldc + col0; const float sar = sa[row];
#pragma unroll
                for (int bj = 0; bj < 2; ++bj) { const f32x4 v0 = acc_i2f(acc[ai][bj][m][0]) * (sbv[bj][0] * sar), v1 = acc_i2f(acc[ai][bj][m][1]) * (sbv[bj][1] * sar);
                    u32x4 w; w.x = cvt_pk_bf16(v0[0], v0[1]); w.y = cvt_pk_bf16(v0[2], v0[3]); w.z = cvt_pk_bf16(v1[0], v1[1]); w.w = cvt_pk_bf16(v1[2], v1[3]);
                    PG8_ST(u32x4, rowp + bj * HALF, w); } }
    }
};
struct EpiResidS {
    static constexpr bool PERM = false, AFTER_DRAIN = false;
    float* Z; const float* X; const float* gate; const float* sa; const float* sb; float alpha;
    __device__ __forceinline__ void operator()(const f32x4 (&acc)[2][2][4][2], const Unit& u, int wr, int wc, int fr, int fq) const {
        const int row0 = u.pm * BM + wr * 64 + fr, col0 = u.pn * BM + wc * 32 + 4 * fq;
        const float* gb = gate + (size_t)(u.pm >> 3) * (6 * 2048) + col0;
        f32x4 gv[2][2];
#pragma unroll
        for (int bj = 0; bj < 2; ++bj)
#pragma unroll
            for (int n = 0; n < 2; ++n) gv[bj][n] = (*(const f32x4*)(gb + bj * HALF + n * 16) + 1.0f) * *(const f32x4*)(sb + col0 + bj * HALF + n * 16);
#pragma unroll
        for (int ai = 0; ai < 2; ++ai)
#pragma unroll
            for (int m = 0; m < 4; ++m) { const int row = row0 + ai * HALF + m * 16; const size_t off = (size_t)row * 2048 + col0; const float sar = sa[row];
#pragma unroll
                for (int bj = 0; bj < 2; ++bj)
#pragma unroll
                    for (int n = 0; n < 2; ++n) { const f32x4 xv = *(const f32x4*)(X + off + bj * HALF + n * 16);
                        PG8_ST(f32x4, Z + off + bj * HALF + n * 16, xv * alpha + (gv[bj][n] * sar) * acc_i2f(acc[ai][bj][m][n])); }
                asm volatile("" ::: "memory"); }
    }
};
template <bool XB, bool ZB> struct EpiResidS16 {
    static constexpr bool PERM = true, AFTER_DRAIN = false;
    void* Z; const void* X; const float* gate; const float* sa; const float* sb; float alpha;
    __device__ __forceinline__ void operator()(const f32x4 (&acc)[2][2][4][2], const Unit& u, int wr, int wc, int fr, int fq) const {
        const int row0 = u.pm * BM + wr * 64 + fr, col0 = u.pn * BM + wc * 32 + 8 * fq;
        const float* gb = gate + (size_t)(u.pm >> 3) * (6 * 2048) + col0;
        f32x4 gv[2][2];
#pragma unroll
        for (int bj = 0; bj < 2; ++bj)
#pragma unroll
            for (int n = 0; n < 2; ++n) gv[bj][n] = (*(const f32x4*)(gb + bj * HALF + 4 * n) + 1.0f) * *(const f32x4*)(sb + col0 + bj * HALF + 4 * n);
#pragma unroll
        for (int ai = 0; ai < 2; ++ai)
#pragma unroll
            for (int m = 0; m < 4; ++m) { const int row = row0 + ai * HALF + m * 16; const size_t off = (size_t)row * 2048 + col0; const float sar = sa[row];
#pragma unroll
                for (int bj = 0; bj < 2; ++bj) { f32x4 x0, x1;
                    if constexpr (XB) { const u32x4 xw = *(const u32x4*)((const bf16_t*)X + off + bj * HALF);
                        x0 = (f32x4){__uint_as_float(xw.x << 16), __uint_as_float(xw.x & 0xffff0000u), __uint_as_float(xw.y << 16), __uint_as_float(xw.y & 0xffff0000u)};
                        x1 = (f32x4){__uint_as_float(xw.z << 16), __uint_as_float(xw.z & 0xffff0000u), __uint_as_float(xw.w << 16), __uint_as_float(xw.w & 0xffff0000u)}; }
                    else { x0 = *(const f32x4*)((const float*)X + off + bj * HALF); x1 = *(const f32x4*)((const float*)X + off + bj * HALF + 4); }
                    const f32x4 v0 = x0 * alpha + (gv[bj][0] * sar) * acc_i2f(acc[ai][bj][m][0]), v1 = x1 * alpha + (gv[bj][1] * sar) * acc_i2f(acc[ai][bj][m][1]);
                    if constexpr (ZB) { u32x4 w; w.x = cvt_pk_bf16(v0[0], v0[1]); w.y = cvt_pk_bf16(v0[2], v0[3]); w.z = cvt_pk_bf16(v1[0], v1[1]); w.w = cvt_pk_bf16(v1[2], v1[3]);
                        PG8_ST(u32x4, (bf16_t*)Z + off + bj * HALF, w); }
                    else { PG8_ST(f32x4, (float*)Z + off + bj * HALF, v0); PG8_ST(f32x4, (float*)Z + off + bj * HALF + 4, v1); } }
                asm volatile("" ::: "memory"); }
    }
};
template <class Epi, class Sched, bool ALIGN_EPI = false, bool SP2 = false, bool I8 = false>
__device__ __forceinline__ void gemm_phase(PG8_LAS unsigned char* lds, const Gemm g, const Sched& S, const Epi& E, const int tid_in) {
    const int tid = tid_in, wid = __builtin_amdgcn_readfirstlane(tid >> 6), lane = tid & 63, wr = wid >> 2, wc = wid & 3, fr = lane & 15, fq = lane >> 4;
    const int K = g.K, nt = K / BK;
    const int krot = ((nt & (nt - 1)) == 0) ? (S.krot & (nt - 1)) : 0;
#define PG8_KOFS(t) ((size_t)(((t) + krot) & (nt - 1)) * kstep)
    unsigned voffA[2], voffB[2];
#pragma unroll
    for (int i = 0; i < 2; ++i) { int R, C; stage_rc(tid * 16 + i * 8192, R, C); const int Rb = Epi::PERM ? ((R & ~31) + perm32(R & 31)) : R;
        voffA[i] = (unsigned)(R * K + C) * 2u; voffB[i] = (unsigned)(Rb * K + C) * 2u; }
    const size_t kstep = (size_t)(BK * 2);
    const size_t hstep = (size_t)HALF * K * 2;
    const size_t tstep = 2 * hstep;
    const unsigned ldsw = (unsigned)wid * 1024u;
    const int aoff = lds_byte(wr * 64 + fr, fq * 8), boff = lds_byte(wc * 32 + fr, fq * 8);
#define PG8_SA(b, h) (((b) * 2 + (h)) * HTB)
#define PG8_SB(b, h) ((4 + (b) * 2 + (h)) * HTB)
#define PG8_STAGE(bufoff, gbase, voff) do { _Pragma("unroll") for (int _i = 0; _i < 2; ++_i) \
        __builtin_amdgcn_global_load_lds((const unsigned*)((const char*)(gbase) + (voff)[_i]), (PG8_LAS unsigned*)(lds + (bufoff) + ldsw + _i * 8192), 16, 0, 0); } while (0)
#define PG8_LDA(dst, b, h) do { _Pragma("unroll") for (int m = 0; m < 4; ++m) _Pragma("unroll") for (int k = 0; k < 2; ++k) dst[m][k] = *(const PG8_LAS bf16x8*)(lds + PG8_SA(b, h) + aoff + m * 2048 + k * 1024); } while (0)
#define PG8_LDB(dst, b, h) do { _Pragma("unroll") for (int n = 0; n < 2; ++n) _Pragma("unroll") for (int k = 0; k < 2; ++k) dst[n][k] = *(const PG8_LAS bf16x8*)(lds + PG8_SB(b, h) + boff + n * 2048 + k * 1024); } while (0)
#define PG8_MMA(ai, bj, At, Bt) do { __builtin_amdgcn_s_setprio(1); _Pragma("unroll") for (int m = 0; m < 4; ++m) _Pragma("unroll") for (int n = 0; n < 2; ++n) _Pragma("unroll") for (int k = 0; k < 2; ++k) \
        { if constexpr (I8) acc[ai][bj][m][n] = __builtin_bit_cast(f32x4, __builtin_amdgcn_mfma_i32_16x16x64_i8(__builtin_bit_cast(i32x4, Bt[n][k]), __builtin_bit_cast(i32x4, At[m][k]), __builtin_bit_cast(i32x4, acc[ai][bj][m][n]), 0, 0, 0)); \
          else acc[ai][bj][m][n] = __builtin_amdgcn_mfma_f32_16x16x32_bf16(Bt[n][k], At[m][k], acc[ai][bj][m][n], 0, 0, 0); } __builtin_amdgcn_s_setprio(0); } while (0)
#define PG8_WAIT_V(n) asm volatile("s_waitcnt vmcnt(" #n ")" ::: "memory")
#define PG8_WAIT_L(n) asm volatile("s_waitcnt lgkmcnt(" #n ")" ::: "memory")
#define PG8_BAR __builtin_amdgcn_s_barrier()
#define PG8_SCHED __builtin_amdgcn_sched_barrier(0)
    Unit cur, nxt; int ui = 0;
    if (!S.next(0, cur)) return;
    f32x4 acc[2][2][4][2];
#pragma unroll
    for (int a = 0; a < 2; ++a)
#pragma unroll
        for (int b = 0; b < 2; ++b)
#pragma unroll
            for (int m = 0; m < 4; ++m)
#pragma unroll
                for (int n = 0; n < 2; ++n) acc[a][b][m][n] = (f32x4){0.f, 0.f, 0.f, 0.f};
    bf16x8 At[4][2], B0[2][2], B1[2][2];
    const char* cA = (const char*)g.A + (size_t)cur.pm * tstep; const char* cB = (const char*)g.Bt + (size_t)cur.pn * tstep;
    S.a_ready(cur);
    if constexpr (SP2) {
        PG8_STAGE(PG8_SB(0, 0), cB + PG8_KOFS(0), voffB); PG8_STAGE(PG8_SB(0, 1), cB + hstep + PG8_KOFS(0), voffB); PG8_STAGE(PG8_SA(0, 0), cA + PG8_KOFS(0), voffA); PG8_STAGE(PG8_SA(0, 1), cA + hstep + PG8_KOFS(0), voffA);
        if (wr == 1) PG8_BAR;
        PG8_WAIT_V(2); PG8_BAR;
        PG8_STAGE(PG8_SB(1, 0), cB + PG8_KOFS(1), voffB); PG8_STAGE(PG8_SA(1, 0), cA + PG8_KOFS(1), voffA); PG8_STAGE(PG8_SB(1, 1), cB + hstep + PG8_KOFS(1), voffB);
        PG8_WAIT_V(6); PG8_BAR;
    } else {
        PG8_STAGE(PG8_SB(0, 0), cB + PG8_KOFS(0), voffB); PG8_STAGE(PG8_SA(0, 0), cA + PG8_KOFS(0), voffA); PG8_STAGE(PG8_SB(0, 1), cB + hstep + PG8_KOFS(0), voffB); PG8_STAGE(PG8_SA(0, 1), cA + hstep + PG8_KOFS(0), voffA);
        if (wr == 1) PG8_BAR;
        PG8_WAIT_V(4); PG8_BAR;
        PG8_STAGE(PG8_SB(1, 0), cB + PG8_KOFS(1), voffB); PG8_STAGE(PG8_SA(1, 0), cA + PG8_KOFS(1), voffA); PG8_STAGE(PG8_SB(1, 1), cB + hstep + PG8_KOFS(1), voffB);
        PG8_WAIT_V(6); PG8_BAR;
    }
    for (;;) {
        const bool has_next = S.next(ui + 1, nxt);
        const char* nA = has_next ? (const char*)g.A + (size_t)nxt.pm * tstep : cA; const char* nB = has_next ? (const char*)g.Bt + (size_t)nxt.pn * tstep : cB;
#ifdef PG8_KREP
        for (int kr_ = 0; kr_ < PG8_KREP; ++kr_) {
        if (kr_) {
#pragma unroll
        for (int a = 0; a < 2; ++a)
#pragma unroll
            for (int b = 0; b < 2; ++b)
#pragma unroll
                for (int m = 0; m < 4; ++m)
#pragma unroll
                    for (int n = 0; n < 2; ++n) acc[a][b][m][n] = (f32x4){0.f, 0.f, 0.f, 0.f}; }
        const char* nA_ = (kr_ + 1 < PG8_KREP) ? cA : nA; const char* nB_ = (kr_ + 1 < PG8_KREP) ? cB : nB;
#else
        const char* nA_ = nA; const char* nB_ = nB;
#endif
        for (int t = 0; t < nt; t += 2) {
            const bool last = (t == nt - 2);
            const char* a1 = cA + PG8_KOFS(t + 1);
            const char* a2 = (last ? nA_ : cA) + PG8_KOFS(t + 2); const char* b2 = (last ? nB_ : cB) + PG8_KOFS(t + 2);
            const char* a3 = (last ? nA_ : cA) + PG8_KOFS(t + 3); const char* b3 = (last ? nB_ : cB) + PG8_KOFS(t + 3);
            if (last && has_next) S.a_ready(nxt);
            if constexpr (SP2) {
            PG8_LDB(B0, 0, 0); PG8_LDB(B1, 0, 1); PG8_SCHED; PG8_LDA(At, 0, 0); PG8_STAGE(PG8_SA(1, 1), a1 + hstep, voffA);
            PG8_WAIT_V(8); PG8_WAIT_L(0); PG8_BAR; PG8_MMA(0, 0, At, B0); PG8_MMA(0, 1, At, B1); PG8_BAR; PG8_SCHED;
            PG8_LDA(At, 0, 1); PG8_STAGE(PG8_SB(0, 0), b2, voffB); PG8_STAGE(PG8_SB(0, 1), b2 + hstep, voffB); PG8_STAGE(PG8_SA(0, 0), a2, voffA);
            PG8_WAIT_V(8); PG8_WAIT_L(0); PG8_BAR; PG8_MMA(1, 0, At, B0); PG8_MMA(1, 1, At, B1); PG8_BAR; PG8_SCHED;
            PG8_LDB(B0, 1, 0); PG8_LDB(B1, 1, 1); PG8_SCHED; PG8_LDA(At, 1, 0); PG8_STAGE(PG8_SA(0, 1), a2 + hstep, voffA);
            PG8_WAIT_V(8); PG8_WAIT_L(0); PG8_BAR; PG8_MMA(0, 0, At, B0); PG8_MMA(0, 1, At, B1); PG8_BAR; PG8_SCHED;
            PG8_LDA(At, 1, 1); PG8_STAGE(PG8_SB(1, 0), b3, voffB); PG8_STAGE(PG8_SB(1, 1), b3 + hstep, voffB); PG8_STAGE(PG8_SA(1, 0), a3, voffA);
            PG8_WAIT_V(8); PG8_WAIT_L(0); PG8_BAR; PG8_MMA(1, 0, At, B0); PG8_MMA(1, 1, At, B1); PG8_BAR; PG8_SCHED;
            } else {
            PG8_LDB(B0, 0, 0); PG8_SCHED; PG8_LDA(At, 0, 0); PG8_STAGE(PG8_SA(1, 1), a1 + hstep, voffA);
            PG8_WAIT_L(8); PG8_BAR; PG8_WAIT_L(0); PG8_MMA(0, 0, At, B0); PG8_BAR; PG8_SCHED;
            PG8_LDB(B1, 0, 1); PG8_STAGE(PG8_SB(0, 0), b2, voffB);
            PG8_BAR; PG8_WAIT_L(0); PG8_MMA(0, 1, At, B1); PG8_BAR;
            PG8_LDA(At, 0, 1); PG8_STAGE(PG8_SA(0, 0), a2, voffA);
            PG8_BAR; PG8_WAIT_L(0); PG8_MMA(1, 0, At, B0); PG8_BAR; PG8_SCHED;
            PG8_STAGE(PG8_SB(0, 1), b2 + hstep, voffB);
            PG8_WAIT_V(6); PG8_BAR; PG8_MMA(1, 1, At, B1); PG8_BAR;
            PG8_LDB(B0, 1, 0); PG8_SCHED; PG8_LDA(At, 1, 0); PG8_STAGE(PG8_SA(0, 1), a2 + hstep, voffA);
            PG8_WAIT_L(8); PG8_BAR; PG8_WAIT_L(0); PG8_MMA(0, 0, At, B0); PG8_BAR; PG8_SCHED;
            PG8_LDB(B1, 1, 1); PG8_STAGE(PG8_SB(1, 0), b3, voffB);
            PG8_BAR; PG8_WAIT_L(0); PG8_MMA(0, 1, At, B1); PG8_BAR;
            PG8_LDA(At, 1, 1); PG8_STAGE(PG8_SA(1, 0), a3, voffA);
            PG8_BAR; PG8_WAIT_L(0); PG8_MMA(1, 0, At, B0); PG8_BAR; PG8_SCHED;
            PG8_STAGE(PG8_SB(1, 1), b3 + hstep, voffB);
            PG8_WAIT_V(6); PG8_BAR; PG8_MMA(1, 1, At, B1); PG8_BAR;
            }
        }
#ifdef PG8_KREP
        }
#endif
        if constexpr (ALIGN_EPI) { if (wr == 0) PG8_BAR; }
#ifdef PG8_EPI2
        if constexpr (!Epi::AFTER_DRAIN) { E(acc, cur, wr, wc, fr, fq); asm volatile("" ::: "memory"); }
#endif
        if constexpr (!Epi::AFTER_DRAIN) { E(acc, cur, wr, wc, fr, fq); S.done(cur); }
        if (!has_next) break;
#pragma unroll
        for (int a = 0; a < 2; ++a)
#pragma unroll
            for (int b = 0; b < 2; ++b)
#pragma unroll
                for (int m = 0; m < 4; ++m)
#pragma unroll
                    for (int n = 0; n < 2; ++n) acc[a][b][m][n] = (f32x4){0.f, 0.f, 0.f, 0.f};
        cur = nxt; cA = nA; cB = nB; ++ui;
        if constexpr (ALIGN_EPI) { if (wr == 1) PG8_BAR; }
    }
    PG8_WAIT_V(0);
    if constexpr (!ALIGN_EPI) { if (wr == 0) PG8_BAR; }
    PG8_BAR;
    if constexpr (Epi::AFTER_DRAIN) { E.fused(acc, cur, wr, wc, fr, fq, lds, wid, lane); S.done(cur); }
#undef PG8_SA
#undef PG8_SB
#undef PG8_STAGE
#undef PG8_LDA
#undef PG8_LDB
#undef PG8_MMA
#undef PG8_WAIT_V
#undef PG8_WAIT_L
#undef PG8_BAR
#undef PG8_SCHED
#undef PG8_KOFS
}
}
#define XB_TMO      128
#define XB_XCNT(j)  (256  + 64 * (j))
#define XB_XSUB(j)  (1280 + 64 * (j))
#define XB_XGEN(j)  (2304 + 64 * (j))
#define XB_TOP      3328
#define XB_TOPGEN   3392
#define XCD_BAR_WORDS 3456
#define XB_SPIN_CAP (1u << 18)
#define LAS __attribute__((address_space(3)))

__device__ __forceinline__ unsigned xb_ld(unsigned* p)              { return __hip_atomic_load(p, __ATOMIC_RELAXED, __HIP_MEMORY_SCOPE_AGENT); }
__device__ __forceinline__ unsigned xb_add(unsigned* p, unsigned v) { return __hip_atomic_fetch_add(p, v, __ATOMIC_RELAXED, __HIP_MEMORY_SCOPE_AGENT); }
__device__ __forceinline__ unsigned xb_xcc_id() { return (unsigned)__builtin_amdgcn_s_getreg((3 << 11) | 20) & 0xFu; }
#define XB_SPIN(cond, bar) do { unsigned _sp = 0; while (cond) { __builtin_amdgcn_s_sleep(1); \
    if ((++_sp & 255u) == 0u) { if (xb_ld(&(bar)[XB_TMO])) break; if (_sp > XB_SPIN_CAP) { atomicAdd(&(bar)[XB_TMO], 1u); break; } } } } while (0)

struct XcdBarrier {
    unsigned* bar; unsigned x;
    volatile LAS unsigned* st;
};

__device__ __forceinline__ XcdBarrier xcd_barrier_post(unsigned* bar, volatile LAS unsigned* st) {
    XcdBarrier b; b.bar = bar; b.x = xb_xcc_id(); b.st = st;
    if (threadIdx.x == 0) (void)xb_add(&bar[XB_XCNT(b.x)], 1u);
    return b;
}
__device__ __forceinline__ void xcd_barrier_complete(unsigned* bar, unsigned x, unsigned& nloc, unsigned& nx) {
    const unsigned G = gridDim.x * gridDim.y * gridDim.z;
    unsigned sum, cnt, mine, sp = 0u;
    for (;;) {
        sum = 0u; cnt = 0u; mine = 0u;
#pragma unroll
        for (unsigned j = 0; j < 16; ++j) { const unsigned c = xb_ld(&bar[XB_XCNT(j)]); sum += c; cnt += (c > 0u) ? 1u : 0u; mine = (j == x) ? c : mine; }
        if (sum == G) break;
        __builtin_amdgcn_s_sleep(1);
        if ((++sp & 255u) == 0u) { if (xb_ld(&bar[XB_TMO])) break; if (sp > XB_SPIN_CAP) { atomicAdd(&bar[XB_TMO], 1u); break; } }
    }
    nloc = mine > 0u ? mine : 1u; nx = cnt > 0u ? cnt : 1u;
}

__device__ __forceinline__ void xcd_barrier(const XcdBarrier& b) {
    asm volatile("s_waitcnt vmcnt(0)" ::: "memory");
    __syncthreads();
    if (threadIdx.x == 0) {
        unsigned* bar = b.bar;
        __builtin_amdgcn_s_waitcnt(0);
        unsigned nloc = b.st[0], nx = b.st[1];
        if (nloc == 0u) { xcd_barrier_complete(bar, b.x, nloc, nx); b.st[0] = nloc; b.st[1] = nx; }
        const unsigned old = xb_add(&bar[XB_XSUB(b.x)], 1u);
        const unsigned gen = old / nloc;
        if (old + 1u == (gen + 1u) * nloc) {
            __builtin_amdgcn_fence(__ATOMIC_RELEASE, "agent");
            asm volatile("s_waitcnt vmcnt(0)" ::: "memory");
            const unsigned og = xb_add(&bar[XB_TOP], 1u);
            const unsigned tg = og / nx;
            if (og + 1u == (tg + 1u) * nx) xb_add(&bar[XB_TOPGEN], 1u);
            else XB_SPIN(xb_ld(&bar[XB_TOPGEN]) == tg, bar);
            __builtin_amdgcn_fence(__ATOMIC_ACQUIRE, "agent");
            xb_add(&bar[XB_XGEN(b.x)], 1u);
            asm volatile("s_waitcnt vmcnt(0)" ::: "memory");
        } else {
            XB_SPIN(xb_ld(&bar[XB_XGEN(b.x)]) == gen, bar);
            __builtin_amdgcn_fence(__ATOMIC_ACQUIRE, "agent");
            asm volatile("s_waitcnt vmcnt(0)" ::: "memory");
        }
    }
    __syncthreads();
}
constexpr int D = 2048, NB = 8, SEQ = 2048, NL = 4, T = NB * SEQ;
constexpr int NCH = SEQ / 64, NCHUNK = T / 64;
constexpr int GKW = 512, RANK = 16;
constexpr int INW = 6160, NP = 6144;
constexpr int NE = 16384;
constexpr float ALPHA = 1.6817928305074290f, EPS = 1e-5f;
constexpr int PQ = 0, PK = 512, PV = 1024, PR = 2048, PCB = 3072, PCC = 4096, PCH = 5120;
constexpr int NWAVES = 8, NTHREADS = 512;
#ifndef WGM_IN
#define WGM_IN 4
#endif
#ifndef WGM_OUT
#define WGM_OUT 4
#endif
#ifndef WGM_WQ
#define WGM_WQ 4
#endif
#ifndef TAB4
#define TAB4 1
#endif
constexpr int NPHASES = 2 + 7 * NL;

constexpr size_t MiB = 1u << 20;
constexpr size_t WS_CTL = 0, CTL_ZERO_BYTES = 1 * MiB;
constexpr size_t WS_MOD = 1 * MiB, WS_PART = 3 * MiB, WS_KEYS = 15 * MiB, WS_DTOT = 17 * MiB, WS_WIN = 18 * MiB, WS_WOUT = 115 * MiB, WS_WQ = 147 * MiB;
constexpr size_t WS_UT = 179 * MiB, WS_VT = 435 * MiB, WS_H = 691 * MiB, WS_PROJ = 755 * MiB, WS_E = 947 * MiB, WS_OGLA = 979 * MiB, WS_Y = 1043 * MiB;
constexpr size_t WS_Z = 1107 * MiB, WS_X1 = 1235 * MiB, WS_X = 1363 * MiB, WS_Q = 1491 * MiB, WS_H2 = 1555 * MiB, WS_HQ8 = 1619 * MiB, WS_H8 = 1659 * MiB, WS_WIN8 = 1691 * MiB, WS_WOUT8 = 1739 * MiB, WS_WQ8 = 1755 * MiB, WS_Y8 = 1771 * MiB, WS_H28 = 1803 * MiB, WS_END = 1835 * MiB;
constexpr size_t WS_SU = 17 * MiB + 512 * 1024, WS_SV = 17 * MiB + 768 * 1024, WS_HSC = 2 * MiB + 640 * 1024;
static_assert(WS_WIN + (size_t)NL * INW * D * 2 <= WS_WOUT && WS_PART + (size_t)NL * 8 * NB * 6 * D * 4 <= WS_KEYS && WS_MOD + (size_t)NL * NB * 6 * D * 4 <= WS_PART, "ws map");
constexpr size_t WS_SAH = WS_SU, WS_SAY = WS_SU + 65536, WS_SB = WS_SV; constexpr int SBL = NP + 2 * D;
constexpr size_t WS_SBA = WS_SB + (size_t)NL * SBL * 4, WS_ALR8 = WS_SU + 131072;
#ifndef KROT_A
#define KROT_A 0
#endif
#ifndef KROT_B
#define KROT_B 0
#endif
#define KROT(c) (KROT_A * (((c) >> 3) & 3) + KROT_B * ((c) >> 5))
#ifndef RES16
#define RES16 1
#endif
#ifndef RES16_X
#define RES16_X RES16
#endif
#ifndef RES16_Z
#define RES16_Z RES16
#endif
#ifndef RES16_X1
#define RES16_X1 RES16
#endif
#ifndef I8_GATE
#define I8_GATE 1
#endif
#ifndef I8_WQ
#define I8_WQ 1
#endif
#ifndef I8_IN
#define I8_IN 1
#endif
#ifndef I8_OUT
#define I8_OUT 1
#endif
constexpr int CW_BAR = 4096;

constexpr int RING_OFF = 0, RING_BYTES = 131072, LDSCTL_OFF = RING_BYTES, LDS_BYTES = 147456;

#define GAS __attribute__((address_space(1)))
typedef unsigned short bf16;
typedef unsigned v4u __attribute__((ext_vector_type(4)));
typedef unsigned v2u __attribute__((ext_vector_type(2)));
typedef int v4i __attribute__((ext_vector_type(4)));
typedef float f32x4 __attribute__((ext_vector_type(4)));
typedef float f32x16 __attribute__((ext_vector_type(16)));
typedef short bf16x8 __attribute__((ext_vector_type(8)));
typedef __bf16 bf16x2v __attribute__((ext_vector_type(2)));
#define LDS_WAIT() asm volatile("s_waitcnt lgkmcnt(0)" ::: "memory")

__device__ __forceinline__ unsigned pk2(float lo, float hi) { return pg8::cvt_pk_bf16(lo, hi); }
__device__ __forceinline__ float dot2bf(unsigned w, unsigned x, float acc) { return __builtin_amdgcn_fdot2_f32_bf16(__builtin_bit_cast(bf16x2v, w), __builtin_bit_cast(bf16x2v, x), acc, false); }
__device__ __forceinline__ float bflo(unsigned u) { return __uint_as_float(u << 16); }
__device__ __forceinline__ float bfhi(unsigned u) { return __uint_as_float(u & 0xffff0000u); }
__device__ __forceinline__ float silu_f(float x) { return x / (1.0f + __expf(-x)); }
__device__ __forceinline__ float logsigmoid_f(float x) { return fminf(x, 0.0f) - log1pf(__expf(-fabsf(x))); }
__device__ __forceinline__ float logsigmoid_fast(float x) { return fminf(x, 0.0f) - __logf(1.0f + __expf(-fabsf(x))); }
__device__ __forceinline__ float gelu_tanh_f(float x) { const float u = 0.7978845608028654f * (x + 0.044715f * x * x * x); return 0.5f * x * (1.0f + tanhf(u)); }
__device__ __forceinline__ unsigned pack_i8(float a, float b, float c, float d) {
    const int q0 = (int)__builtin_rintf(a), q1 = (int)__builtin_rintf(b), q2 = (int)__builtin_rintf(c), q3 = (int)__builtin_rintf(d);
    return (unsigned)(q0 & 255) | ((unsigned)(q1 & 255) << 8) | ((unsigned)(q2 & 255) << 16) | ((unsigned)(q3 & 255) << 24); }
#define WAVE_ALLREDUCE(v, OP) do { \
    v = OP(v, __uint_as_float((unsigned)__builtin_amdgcn_update_dpp(0, (int)__float_as_uint(v), 0xB1, 0xf, 0xf, false)));      \
    v = OP(v, __uint_as_float((unsigned)__builtin_amdgcn_update_dpp(0, (int)__float_as_uint(v), 0x4E, 0xf, 0xf, false)));      \
    v = OP(v, __uint_as_float((unsigned)__builtin_amdgcn_update_dpp(0, (int)__float_as_uint(v), 0x124, 0xf, 0xf, false)));     \
    v = OP(v, __uint_as_float((unsigned)__builtin_amdgcn_update_dpp(0, (int)__float_as_uint(v), 0x128, 0xf, 0xf, false)));     \
    { const auto r_ = __builtin_amdgcn_permlane16_swap(__float_as_uint(v), __float_as_uint(v), false, false); v = OP(__uint_as_float(r_[0]), __uint_as_float(r_[1])); } \
    { const auto r_ = __builtin_amdgcn_permlane32_swap(__float_as_uint(v), __float_as_uint(v), false, false); v = OP(__uint_as_float(r_[0]), __uint_as_float(r_[1])); } } while (0)
__device__ __forceinline__ float op_add_f(float a, float b) { return a + b; }
__device__ __forceinline__ float wave_sum(float v) { WAVE_ALLREDUCE(v, op_add_f); return v; }
__device__ __forceinline__ float wave_max(float v) { WAVE_ALLREDUCE(v, fmaxf); return v; }

struct Args { const float* in[19]; float* out; unsigned char* ws; int ph_lo, ph_hi; };

__device__ __forceinline__ void transpose_item(const float* W, int ldw, int col0, bf16* WTrows, int k0, int nvalid, LAS float* scr, int lane) {
    const int n = lane & 31;
    float tv[32];
#pragma unroll
    for (int i = 0; i < 32; ++i) { const int kk = 2 * i + (lane >> 5); tv[i] = (n < nvalid) ? W[(size_t)(k0 + kk) * ldw + col0 + n] : 0.f; }
#pragma unroll
    for (int i = 0; i < 32; ++i) { const int kk = 2 * i + (lane >> 5); scr[kk * 33 + n] = tv[i]; }
    LDS_WAIT(); asm volatile("" ::: "memory");
    const int c = lane & 7;
#pragma unroll
    for (int j = 0; j < 4; ++j) { const int nn = (lane >> 3) + 8 * j; const LAS float* s = scr + (8 * c) * 33 + nn;
        v4u o; o.x = pk2(s[0 * 33], s[1 * 33]); o.y = pk2(s[2 * 33], s[3 * 33]); o.z = pk2(s[4 * 33], s[5 * 33]); o.w = pk2(s[6 * 33], s[7 * 33]);
        if (nn < nvalid) *(v4u*)(WTrows + (size_t)nn * D + k0 + 8 * c) = o; }
    LDS_WAIT(); asm volatile("" ::: "memory");
}
__device__ __forceinline__ void cvt_stream(const float* src, bf16* dst, size_t n4, size_t i0, size_t stride) {
    for (size_t i = i0; i < n4; i += stride) { const f32x4 v = ((const f32x4*)src)[i]; v2u o; o.x = pk2(v.x, v.y); o.y = pk2(v.z, v.w); ((v2u*)dst)[i] = o; }
}
__device__ __forceinline__ void ph_prologue_a(const Args& a, LAS unsigned char* lds, int tid, int lane, int wave, int bx, int G) {
    const int gw = bx * NWAVES + wave, NGW = G * NWAVES;
    LAS float* cact = (LAS float*)lds;
    for (int i = tid; i < NB * D; i += NTHREADS) { const int b = i / D, d = i % D; cact[d * 8 + b] = silu_f(a.in[1][i]); }
    __syncthreads();
    float* part = (float*)(a.ws + WS_PART);
    for (int it = gw; it < NL * 8 * 48; it += NGW) {
        const int cg = it % 48, dr = (it / 48) % 8, l = it / 384;
        f32x4 acc[8];
#pragma unroll
        for (int b = 0; b < 8; ++b) acc[b] = (f32x4){0.f, 0.f, 0.f, 0.f};
        const float* w = a.in[2] + ((size_t)l * D + dr * 256) * (6 * D) + cg * 256 + lane * 4;
#pragma unroll 4
        for (int d = 0; d < 256; ++d) {
            const f32x4 wv = *(const f32x4*)(w + (size_t)d * (6 * D));
            const f32x4 c0 = *(const LAS f32x4*)(cact + (dr * 256 + d) * 8), c1 = *(const LAS f32x4*)(cact + (dr * 256 + d) * 8 + 4);
            acc[0] += wv * c0.x; acc[1] += wv * c0.y; acc[2] += wv * c0.z; acc[3] += wv * c0.w;
            acc[4] += wv * c1.x; acc[5] += wv * c1.y; acc[6] += wv * c1.z; acc[7] += wv * c1.w;
        }
#pragma unroll
        for (int b = 0; b < 8; ++b) *(f32x4*)(part + (((size_t)l * 8 + dr) * NB + b) * (6 * D) + cg * 256 + lane * 4) = acc[b];
    }
    __syncthreads();
    LAS float* scr = (LAS float*)(lds + wave * 8448);
    bf16* winT = (bf16*)(a.ws + WS_WIN); bf16* woutT = (bf16*)(a.ws + WS_WOUT); bf16* wqT = (bf16*)(a.ws + WS_WQ);
    constexpr int IPL = 6144 + 32 + 2048 + 2048;
    for (int it = gw; it < NL * IPL; it += NGW) {
        const int l = it / IPL; int r = it % IPL;
        if (r < 6144) { const int nb = r % 192, kb = r / 192, n0 = nb * 32;
            transpose_item(a.in[4] + (size_t)l * D * INW, INW, n0 < 3072 ? n0 : n0 + 16, winT + ((size_t)l * INW + n0) * D, kb * 64, 32, scr, lane); continue; }
        r -= 6144;
        if (r < 32) { transpose_item(a.in[4] + (size_t)l * D * INW, INW, 3072, winT + ((size_t)l * INW + NP) * D, r * 64, 16, scr, lane); continue; }
        r -= 32;
        if (r < 2048) { const int nb = r % 64, kb = r / 64; transpose_item(a.in[10] + (size_t)l * D * D, D, nb * 32, woutT + ((size_t)l * D + nb * 32) * D, kb * 64, 32, scr, lane); continue; }
        r -= 2048;
        { const int nb = r % 64, kb = r / 64; transpose_item(a.in[13] + (size_t)l * D * D, D, nb * 32, wqT + ((size_t)l * D + nb * 32) * D, kb * 64, 32, scr, lane); }
    }
    const size_t i0 = (size_t)bx * NTHREADS + tid, stride = (size_t)G * NTHREADS;
    cvt_stream(a.in[14], (bf16*)(a.ws + WS_KEYS), (size_t)NL * 8 * 2 * 128 * 128 / 4, i0, stride);
#if TAB4
    __syncthreads();
    { LAS float* rowst = (LAS float*)(lds + wave * 8192);
      f32x4 vnx[8];
      if (gw < 2 * NL * NE) { const int tbl0 = gw / (NL * NE), r0 = gw % (NL * NE); const float* s0 = (tbl0 ? a.in[16] : a.in[15]) + (size_t)r0 * D;
#pragma unroll
          for (int c8 = 0; c8 < 8; ++c8) vnx[c8] = *(const f32x4*)(s0 + (c8 * 64 + lane) * 4); }
      for (int row = gw; row < 2 * NL * NE; row += NGW) {
        const int tbl = row / (NL * NE), r = row % (NL * NE);
#pragma unroll
        for (int c8 = 0; c8 < 8; ++c8) *(LAS f32x4*)(rowst + (c8 * 64 + lane) * 4) = vnx[c8];
        { const int rown = row + NGW < 2 * NL * NE ? row + NGW : row; const int tbln = rown / (NL * NE), rn = rown % (NL * NE); const float* sn = (tbln ? a.in[16] : a.in[15]) + (size_t)rn * D;
#pragma unroll
          for (int c8 = 0; c8 < 8; ++c8) vnx[c8] = *(const f32x4*)(sn + (c8 * 64 + lane) * 4); }
        LDS_WAIT(); asm volatile("" ::: "memory");
        unsigned char* tb = a.ws + (tbl ? WS_VT : WS_UT) + (size_t)r * 1152;
#pragma unroll
        for (int pass = 0; pass < 2; ++pass) { const int slot = lane + 64 * pass;
            if (slot < 72) { const int col0 = (slot >> 3) * 240 + (slot & 7) * 30;
                float x[30]; float mx = 0.f;
#pragma unroll
                for (int k = 0; k < 30; ++k) { x[k] = (col0 + k < D) ? rowst[col0 + k] : 0.f; mx = fmaxf(mx, fabsf(x[k])); }
                int code = 0; float inv = 0.f;
                if (mx > 0.f) { code = (int)ceilf(8.0f * log2f(mx * (1.0f / 7.0f))) + 128; code = code < 0 ? 0 : (code > 255 ? 255 : code); inv = __builtin_amdgcn_exp2f(16.0f - (float)code * 0.125f); }
                unsigned dw[4] = {0u, 0u, 0u, 0u};
#pragma unroll
                for (int kb = 0; kb < 15; ++kb) { int a0 = (int)__builtin_rintf(x[2 * kb] * inv), a1 = (int)__builtin_rintf(x[2 * kb + 1] * inv);
                    a0 = a0 < -7 ? -7 : (a0 > 7 ? 7 : a0); a1 = a1 < -7 ? -7 : (a1 > 7 ? 7 : a1);
                    dw[kb >> 2] |= ((unsigned)(a0 + 8) | ((unsigned)(a1 + 8) << 4)) << (8 * (kb & 3)); }
                dw[3] |= (unsigned)code << 24;
                *(v4u*)(tb + slot * 16) = (v4u){dw[0], dw[1], dw[2], dw[3]}; } }
        LDS_WAIT(); asm volatile("" ::: "memory");
      } }
#else
    for (int row = gw; row < 2 * NL * NE; row += NGW) {
        const int tbl = row / (NL * NE), r = row % (NL * NE);
        const float* src = (tbl ? a.in[16] : a.in[15]) + (size_t)r * D;
        f32x4 v[8]; float mx = 0.f;
#pragma unroll
        for (int c8 = 0; c8 < 8; ++c8) { v[c8] = *(const f32x4*)(src + (c8 * 64 + lane) * 4); mx = fmaxf(mx, fmaxf(fmaxf(fabsf(v[c8].x), fabsf(v[c8].y)), fmaxf(fabsf(v[c8].z), fabsf(v[c8].w)))); }
        mx = wave_max(mx);
        const float inv = mx > 0.f ? 127.0f / mx : 0.f; const int off = tbl ? 128 : 0;
        unsigned dw[8];
#pragma unroll
        for (int c8 = 0; c8 < 8; ++c8) { const int q0 = (int)__builtin_rintf(v[c8].x * inv) + off, q1 = (int)__builtin_rintf(v[c8].y * inv) + off, q2 = (int)__builtin_rintf(v[c8].z * inv) + off, q3 = (int)__builtin_rintf(v[c8].w * inv) + off;
            dw[c8] = (unsigned)(q0 & 255) | ((unsigned)(q1 & 255) << 8) | ((unsigned)(q2 & 255) << 16) | ((unsigned)(q3 & 255) << 24); }
        unsigned char* dst = a.ws + (tbl ? WS_VT : WS_UT) + (size_t)r * D;
        *(v4u*)(dst + lane * 16) = (v4u){dw[0], dw[1], dw[2], dw[3]}; *(v4u*)(dst + (64 + lane) * 16) = (v4u){dw[4], dw[5], dw[6], dw[7]};
        if (lane == 0) ((float*)(a.ws + (tbl ? WS_SV : WS_SU)))[r] = mx * (1.0f / 127.0f);
    }
#endif
}

__device__ __forceinline__ void ln_tail(const float (&z)[32], int t, int lane, const float* g, const float* bta, float* xout, const float* sh, const float* sc, bf16* hout, unsigned char* q8, float* q8s, LAS unsigned char* q8stage = nullptr, unsigned char* a8 = nullptr, float* a8s = nullptr, bf16* xb = nullptr) {
    float s = 0.f;
#pragma unroll
    for (int i = 0; i < 32; ++i) s += z[i];
    const float mu = wave_sum(s) * (1.0f / D);
    float q = 0.f;
#pragma unroll
    for (int i = 0; i < 32; ++i) { const float d = z[i] - mu; q += d * d; }
    const float rs = rsqrtf(wave_sum(q) * (1.0f / D) + EPS);
    float hv[32]; float mx = 0.f;
#pragma unroll
    for (int c = 0; c < 8; ++c) { const int col = (c * 64 + lane) * 4;
        const f32x4 g0 = *(const f32x4*)(g + col), b0 = *(const f32x4*)(bta + col);
        f32x4 x0;
        x0.x = (z[c * 4 + 0] - mu) * rs * g0.x + b0.x; x0.y = (z[c * 4 + 1] - mu) * rs * g0.y + b0.y; x0.z = (z[c * 4 + 2] - mu) * rs * g0.z + b0.z; x0.w = (z[c * 4 + 3] - mu) * rs * g0.w + b0.w;
        if (xb) { v2u o; o.x = pk2(x0.x, x0.y); o.y = pk2(x0.z, x0.w); *(v2u*)(xb + (size_t)t * D + col) = o; }
        else if (xout) *(f32x4*)(xout + (size_t)t * D + col) = x0;
        if (hout || q8 || a8) { const f32x4 s0 = *(const f32x4*)(sc + col), h0 = *(const f32x4*)(sh + col);
            hv[c * 4] = x0.x * (1.f + s0.x) + h0.x; hv[c * 4 + 1] = x0.y * (1.f + s0.y) + h0.y; hv[c * 4 + 2] = x0.z * (1.f + s0.z) + h0.z; hv[c * 4 + 3] = x0.w * (1.f + s0.w) + h0.w;
            if (hout) { v2u o; o.x = pk2(hv[c * 4], hv[c * 4 + 1]); o.y = pk2(hv[c * 4 + 2], hv[c * 4 + 3]);
                *(v2u*)(hout + (size_t)t * D + col) = o; }
            if (q8 || a8) mx = fmaxf(mx, fmaxf(fmaxf(fabsf(hv[c * 4]), fabsf(hv[c * 4 + 1])), fmaxf(fabsf(hv[c * 4 + 2]), fabsf(hv[c * 4 + 3])))); }
    }
    if (q8 || a8) {
        mx = wave_max(mx);
        const float qmax_ = (q8 && TAB4) ? 119.0f : 127.0f;
        const float inv = mx > 0.f ? qmax_ / mx : 0.f;
        unsigned dw[8];
#pragma unroll
        for (int c = 0; c < 8; ++c) { const int q0 = (int)__builtin_rintf(hv[c * 4] * inv), q1 = (int)__builtin_rintf(hv[c * 4 + 1] * inv), q2 = (int)__builtin_rintf(hv[c * 4 + 2] * inv), q3 = (int)__builtin_rintf(hv[c * 4 + 3] * inv);
            dw[c] = (unsigned)(q0 & 255) | ((unsigned)(q1 & 255) << 8) | ((unsigned)(q2 & 255) << 16) | ((unsigned)(q3 & 255) << 24); }
        if (a8) {
#pragma unroll
            for (int c = 0; c < 8; ++c) *(unsigned*)(a8 + (size_t)t * D + (c * 64 + lane) * 4) = dw[c];
            if (a8s && lane == 0) a8s[t] = mx / qmax_; }
        if (q8) {
#if TAB4
        { LAS unsigned* st32 = (LAS unsigned*)q8stage; LAS unsigned char* st8 = (LAS unsigned char*)q8stage;
#pragma unroll
          for (int i = 0; i < 9; ++i) st32[lane + 64 * i] = 0u;
          LDS_WAIT(); asm volatile("" ::: "memory");
#pragma unroll
          for (int c = 0; c < 8; ++c)
#pragma unroll
              for (int jp = 0; jp < 2; ++jp) { const int col = (c * 64 + lane) * 4 + 2 * jp, u = col / 240, r = col - u * 240, l7 = r / 30, k = r - l7 * 30;
                  const int q0 = (int)(signed char)((dw[c] >> (16 * jp)) & 255u), q1 = (int)(signed char)((dw[c] >> (16 * jp + 8)) & 255u);
                  const int l0 = ((q0 + 8) & 15) - 8, l1 = ((q1 + 8) & 15) - 8, h0 = (q0 - l0) >> 4, h1 = (q1 - l1) >> 4;
                  LAS unsigned char* sp = st8 + (u * 8 + l7) * 32 + (k >> 1);
                  sp[0] = (unsigned char)((l0 & 15) | ((l1 & 15) << 4)); sp[16] = (unsigned char)((h0 & 15) | ((h1 & 15) << 4)); }
          LDS_WAIT(); asm volatile("" ::: "memory");
          unsigned* d32 = (unsigned*)(q8 + (size_t)t * 2304);
#pragma unroll
          for (int i = 0; i < 9; ++i) d32[lane + 64 * i] = st32[lane + 64 * i];
          LDS_WAIT(); asm volatile("" ::: "memory"); }
#else
        unsigned char* dst = q8 + (size_t)t * D;
        *(v4u*)(dst + lane * 16) = (v4u){dw[0], dw[1], dw[2], dw[3]}; *(v4u*)(dst + (64 + lane) * 16) = (v4u){dw[4], dw[5], dw[6], dw[7]};
#endif
        if (lane == 0) q8s[t] = mx / qmax_; }
    }
}

__device__ __forceinline__ void ph_prologue_b(const Args& a, LAS unsigned char* lds, int tid, int lane, int wave, int bx, int G) {
    const float* part = (const float*)(a.ws + WS_PART); float* mod = (float*)(a.ws + WS_MOD);
    for (int i = bx * NTHREADS + tid; i < NL * NB * 6 * D / 4; i += G * NTHREADS) {
        const int idx = i * 4, e = idx % (6 * D), b = (idx / (6 * D)) % NB, l = idx / (6 * D * NB);
        f32x4 s = *(const f32x4*)(a.in[3] + l * 6 * D + e);
#pragma unroll
        for (int dr = 0; dr < 8; ++dr) s += *(const f32x4*)(part + (((size_t)l * 8 + dr) * NB + b) * (6 * D) + e);
        *(f32x4*)(mod + idx) = s;
    }
    LAS float* msh = (LAS float*)lds;
    bf16* hbuf = (bf16*)(a.ws + WS_H);
    for (int ch = bx; ch < NCHUNK; ch += G) {
        const int b = ch / NCH;
        for (int i = tid; i < 1024; i += NTHREADS) { const int e = i * 4;
            f32x4 s = *(const f32x4*)(a.in[3] + e);
#pragma unroll
            for (int dr = 0; dr < 8; ++dr) s += *(const f32x4*)(part + (((size_t)0 * 8 + dr) * NB + b) * (6 * D) + e);
            *(LAS f32x4*)(msh + e) = s; }
        __syncthreads();
        for (int i = 0; i < 8; ++i) { const int t = ch * 64 + wave * 8 + i;
            float hv[32]; float mx = 0.f;
#pragma unroll
            for (int c = 0; c < 4; ++c) { const int col = (c * 64 + lane) * 8;
                const f32x4 x0 = *(const f32x4*)(a.in[0] + (size_t)t * D + col), x1 = *(const f32x4*)(a.in[0] + (size_t)t * D + col + 4);
                const f32x4 h0 = *(const LAS f32x4*)(msh + col), h1 = *(const LAS f32x4*)(msh + col + 4), s0 = *(const LAS f32x4*)(msh + 2048 + col), s1 = *(const LAS f32x4*)(msh + 2048 + col + 4);
#pragma unroll
                for (int j = 0; j < 4; ++j) { hv[c * 8 + j] = x0[j] * (1.f + s0[j]) + h0[j]; hv[c * 8 + 4 + j] = x1[j] * (1.f + s1[j]) + h1[j]; }
                v4u o; o.x = pk2(hv[c * 8], hv[c * 8 + 1]); o.y = pk2(hv[c * 8 + 2], hv[c * 8 + 3]); o.z = pk2(hv[c * 8 + 4], hv[c * 8 + 5]); o.w = pk2(hv[c * 8 + 6], hv[c * 8 + 7]);
#if !I8_GATE
                *(v4u*)(hbuf + (size_t)t * D + col) = o;
#endif
#if RES16_X
                { v4u xo; xo.x = pk2(x0.x, x0.y); xo.y = pk2(x0.z, x0.w); xo.z = pk2(x1.x, x1.y); xo.w = pk2(x1.z, x1.w); *(v4u*)((bf16*)(a.ws + WS_X) + (size_t)t * D + col) = xo; }
#endif
#pragma unroll
                for (int j = 0; j < 8; ++j) mx = fmaxf(mx, fabsf(hv[c * 8 + j])); }
#pragma unroll
            for (int o = 1; o < 64; o <<= 1) mx = fmaxf(mx, __shfl_xor(mx, o));
            const float inv = mx > 0.f ? 127.0f / mx : 0.f;
#pragma unroll
            for (int c = 0; c < 4; ++c) { v2u o;
                o.x = pack_i8(hv[c * 8] * inv, hv[c * 8 + 1] * inv, hv[c * 8 + 2] * inv, hv[c * 8 + 3] * inv); o.y = pack_i8(hv[c * 8 + 4] * inv, hv[c * 8 + 5] * inv, hv[c * 8 + 6] * inv, hv[c * 8 + 7] * inv);
                *(v2u*)(a.ws + WS_H8 + (size_t)t * D + (c * 64 + lane) * 8) = o; }
            if (lane == 0) ((float*)(a.ws + WS_SAH))[t] = mx * (1.0f / 127.0f); }
        __syncthreads();
    }
    { const int gw = bx * NWAVES + wave, NGW = G * NWAVES;
      for (int row = gw; row < NL * (SBL + 16); row += NGW) { const int l = row / (SBL + 16), r = row % (SBL + 16);
          const bf16* src; unsigned char* dst; float* sdst;
          if (r < NP) { src = (const bf16*)(a.ws + WS_WIN) + ((size_t)l * INW + r) * D; dst = a.ws + WS_WIN8 + ((size_t)l * NP + r) * D; sdst = (float*)(a.ws + WS_SB) + l * SBL + r; }
          else if (r < NP + D) { src = (const bf16*)(a.ws + WS_WOUT) + ((size_t)l * D + (r - NP)) * D; dst = a.ws + WS_WOUT8 + ((size_t)l * D + (r - NP)) * D; sdst = (float*)(a.ws + WS_SB) + l * SBL + r; }
          else if (r < SBL) { src = (const bf16*)(a.ws + WS_WQ) + ((size_t)l * D + (r - NP - D)) * D; dst = a.ws + WS_WQ8 + ((size_t)l * D + (r - NP - D)) * D; sdst = (float*)(a.ws + WS_SB) + l * SBL + r; }
          else { src = (const bf16*)(a.ws + WS_WIN) + ((size_t)l * INW + NP + (r - SBL)) * D; dst = a.ws + WS_ALR8 + ((size_t)l * 16 + (r - SBL)) * D; sdst = (float*)(a.ws + WS_SBA) + l * 16 + (r - SBL); }
          v4u w[4]; float mx = 0.f;
#pragma unroll
          for (int c = 0; c < 4; ++c) w[c] = *(const v4u*)(src + (c * 64 + lane) * 8);
#pragma unroll
          for (int c = 0; c < 4; ++c)
#pragma unroll
              for (int j = 0; j < 4; ++j) mx = fmaxf(mx, fmaxf(fabsf(bflo(w[c][j])), fabsf(bfhi(w[c][j]))));
#pragma unroll
          for (int o = 1; o < 64; o <<= 1) mx = fmaxf(mx, __shfl_xor(mx, o));
          const float inv = mx > 0.f ? 127.0f / mx : 0.f;
#pragma unroll
          for (int c = 0; c < 4; ++c) { v2u o;
              o.x = pack_i8(bflo(w[c][0]) * inv, bfhi(w[c][0]) * inv, bflo(w[c][1]) * inv, bfhi(w[c][1]) * inv); o.y = pack_i8(bflo(w[c][2]) * inv, bfhi(w[c][2]) * inv, bflo(w[c][3]) * inv, bfhi(w[c][3]) * inv);
              *(v2u*)(dst + (c * 64 + lane) * 8) = o; }
          if (lane == 0) *sdst = mx * (1.0f / 127.0f); } }
}

__device__ __forceinline__ void gate_prep(const Args& a, int l, LAS unsigned char* lds, int tid, int lane, int wave, int ch) {
    const bf16* hbuf = (const bf16*)(a.ws + WS_H); const bf16* waT = (const bf16*)(a.ws + WS_WIN) + ((size_t)l * INW + NP) * D;
    bf16* Ebuf = (bf16*)(a.ws + WS_E); float* dtot = (float*)(a.ws + WS_DTOT);
    const int t0 = ch * 64, l15 = lane & 15, lq = lane >> 4, mt = wave & 3, kh = wave >> 2;
    LAS float* alr = (LAS float*)(lds + LDSCTL_OFF + 1024);
#if I8_GATE
    { v4i acc = (v4i){0, 0, 0, 0};
      const unsigned char* hA = a.ws + WS_H8 + (size_t)(t0 + 16 * mt + l15) * D + kh * 1024 + 16 * lq;
      const unsigned char* wB = a.ws + WS_ALR8 + ((size_t)l * 16 + l15) * D + kh * 1024 + 16 * lq;
#pragma unroll 8
      for (int ks = 0; ks < 16; ++ks) { const v4i av = *(const v4i*)(hA + 64 * ks), bv = *(const v4i*)(wB + 64 * ks); acc = __builtin_amdgcn_mfma_i32_16x16x64_i8(av, bv, acc, 0, 0, 0); }
      const float sw = ((const float*)(a.ws + WS_SBA))[l * 16 + l15];
#pragma unroll
      for (int r = 0; r < 4; ++r) { const int tl = 16 * mt + 4 * lq + r; alr[(kh * 64 + tl) * 16 + l15] = (float)acc[r] * (sw * ((const float*)(a.ws + WS_SAH))[t0 + tl]); } }
#else
    f32x4 acc = (f32x4){0.f, 0.f, 0.f, 0.f};
    const bf16* hA = hbuf + (size_t)(t0 + 16 * mt + l15) * D + kh * 1024 + 8 * lq;
    const bf16* wB = waT + (size_t)l15 * D + kh * 1024 + 8 * lq;
#pragma unroll 8
    for (int ks = 0; ks < 32; ++ks) { const bf16x8 av = *(const bf16x8*)(hA + 32 * ks), bv = *(const bf16x8*)(wB + 32 * ks); acc = __builtin_amdgcn_mfma_f32_16x16x32_bf16(av, bv, acc, 0, 0, 0); }
#pragma unroll
    for (int r = 0; r < 4; ++r) alr[(kh * 64 + 16 * mt + 4 * lq + r) * 16 + l15] = acc[r];
#endif
    __syncthreads();
    const int col = tid;
    float wg[16];
#pragma unroll
    for (int r = 0; r < 16; ++r) wg[r] = a.in[5][((size_t)l * RANK + r) * GKW + col];
    const float bgc = a.in[6][l * GKW + col];
    for (int i = tid; i < 256; i += NTHREADS) *(LAS f32x4*)(alr + i * 4) = *(const LAS f32x4*)(alr + i * 4) + *(const LAS f32x4*)(alr + 1024 + i * 4);
    __syncthreads();
    float tot = 0.f;
    LAS float* lac = (LAS float*)lds;
    for (int j = 0; j < 64; ++j) { float lg0 = bgc, lg1 = 0.f;
#pragma unroll
        for (int r4 = 0; r4 < 4; ++r4) { const f32x4 p = *(const LAS f32x4*)(alr + j * 16 + r4 * 4);
            lg0 += p.x * wg[r4 * 4] + p.z * wg[r4 * 4 + 2]; lg1 += p.y * wg[r4 * 4 + 1] + p.w * wg[r4 * 4 + 3]; }
        const float la = logsigmoid_fast(lg0 + lg1) * (1.0f / 16.0f); lac[j * GKW + col] = la; tot += la; }
    float run = 0.f;
    for (int j = 0; j < 64; ++j) { run += lac[j * GKW + col]; lac[j * GKW + col] = __expf(tot - run); }
    __syncthreads();
    for (int i = 0; i < 8; ++i) { const int j = wave * 8 + i;
        const f32x4 e0 = *(const LAS f32x4*)(lac + j * GKW + lane * 8), e1 = *(const LAS f32x4*)(lac + j * GKW + lane * 8 + 4);
        v4u o; o.x = pk2(e0.x, e0.y); o.y = pk2(e0.z, e0.w); o.z = pk2(e1.x, e1.y); o.w = pk2(e1.z, e1.w);
        *(v4u*)(Ebuf + (size_t)(t0 + j) * GKW + lane * 8) = o; }
    dtot[(size_t)ch * GKW + col] = __expf(tot);
    __syncthreads();
}

__device__ __forceinline__ void gla_unit(const Args& a, LAS unsigned char* lds, int tid, int lane, int wave, int un) {
    const bf16* proj = (const bf16*)(a.ws + WS_PROJ); const bf16* Ebuf = (const bf16*)(a.ws + WS_E); const float* dtot = (const float*)(a.ws + WS_DTOT); bf16* ogla = (bf16*)(a.ws + WS_OGLA);
    const int pair_ = (un & 7) * 4 + (un >> 6), dvs = (un >> 3) & 7, hh = pair_ & 3, b = pair_ >> 2;
    LAS bf16* kdT0 = (LAS bf16*)lds; LAS bf16* vT0 = (LAS bf16*)(lds + 18432); LAS bf16* ST0 = (LAS bf16*)(lds + 18432 + 4608);
    LAS bf16* kdT1 = (LAS bf16*)(lds + 32768); LAS bf16* vT1 = (LAS bf16*)(lds + 32768 + 18432); LAS bf16* ST1 = (LAS bf16*)(lds + 32768 + 18432 + 4608);
    const int l15 = lane & 15, lq = lane >> 4, jl = tid >> 3, dv4 = (tid & 7) * 4, jt = (wave & 3) * 16, dvt = (wave >> 2) * 16, jp = tid >> 4, c16 = tid & 15;
#define GLA_BAR() do { asm volatile("s_waitcnt lgkmcnt(0)" ::: "memory"); __builtin_amdgcn_s_barrier(); asm volatile("" ::: "memory"); } while (0)
    f32x4 S0 = (f32x4){0.f, 0.f, 0.f, 0.f}, S1 = (f32x4){0.f, 0.f, 0.f, 0.f};
    v4u kn0[2], kn1[2], kn2[2], en0[2], en1[2], en2[2]; v2u vn0, vn1, vn2; bf16x8 qn0[4], qn1[4], qn2[4], qc[4]; f32x4 dn0, dn1, dn2, dc;
#define GLA_LOAD(c, kn, en, vn, qn, dn) do { const int t0c = b * SEQ + (c) * 64; const bf16* pr = proj + (size_t)(t0c + jl) * NP; \
          \
        kn[0] = *(const v4u*)(proj + (size_t)(t0c + 2 * jp) * NP + PK + hh * 128 + 8 * c16); kn[1] = *(const v4u*)(proj + (size_t)(t0c + 2 * jp + 1) * NP + PK + hh * 128 + 8 * c16); \
        en[0] = *(const v4u*)(Ebuf + (size_t)(t0c + 2 * jp) * GKW + hh * 128 + 8 * c16); en[1] = *(const v4u*)(Ebuf + (size_t)(t0c + 2 * jp + 1) * GKW + hh * 128 + 8 * c16); \
        vn = *(const v2u*)(pr + PV + hh * 256 + dvs * 32 + dv4); \
        _Pragma("unroll") for (int ks_ = 0; ks_ < 4; ++ks_) qn[ks_] = *(const bf16x8*)(proj + (size_t)(t0c + jt + l15) * NP + PQ + hh * 128 + 32 * ks_ + 8 * lq); \
        dn = *(const f32x4*)(dtot + (size_t)(b * NCH + (c)) * GKW + hh * 128 + 16 * wave + 4 * lq); } while (0)
#define GLA_PREPL(kn, en, vn, kdT, vT) do { \
        _Pragma("unroll") for (int i_ = 0; i_ < 8; ++i_) { const unsigned wa_ = kn[0][i_ >> 1], wb_ = kn[1][i_ >> 1], ea_ = en[0][i_ >> 1], eb_ = en[1][i_ >> 1]; \
            const float pa_ = ((i_ & 1) ? bfhi(wa_) : bflo(wa_)) * ((i_ & 1) ? bfhi(ea_) : bflo(ea_)), pb_ = ((i_ & 1) ? bfhi(wb_) : bflo(wb_)) * ((i_ & 1) ? bfhi(eb_) : bflo(eb_)); \
            *(LAS unsigned*)(kdT + (8 * c16 + i_) * 72 + ((((jp >> 2) ^ c16) & 7) << 3) + ((2 * jp) & 7)) = pk2(pa_, pb_); }     \
        _Pragma("unroll") for (int i_ = 0; i_ < 4; ++i_) { const unsigned w_ = vn[i_ >> 1]; vT[(dv4 + i_) * 72 + jl] = (bf16)((i_ & 1) ? (w_ >> 16) : (w_ & 0xffffu)); } } while (0)
#define GLA_QD(qn, dn) do { _Pragma("unroll") for (int ks_ = 0; ks_ < 4; ++ks_) qc[ks_] = qn[ks_]; dc = dn; } while (0)
#define GLA_BODYA(kdT, vT, ST) do { \
        S0 = S0 * dc; S1 = S1 * dc; \
        _Pragma("unroll") for (int ks = 0; ks < 2; ++ks) { \
            const bf16x8 A_ = *(const LAS bf16x8*)(kdT + (16 * wave + l15) * 72 + ((((4 * ks + lq) ^ (2 * wave + (l15 >> 3))) & 7) << 3)); \
            const bf16x8 B0_ = *(const LAS bf16x8*)(vT + l15 * 72 + 32 * ks + 8 * lq), B1_ = *(const LAS bf16x8*)(vT + (16 + l15) * 72 + 32 * ks + 8 * lq); \
            S0 = __builtin_amdgcn_mfma_f32_16x16x32_bf16(A_, B0_, S0, 0, 0, 0); S1 = __builtin_amdgcn_mfma_f32_16x16x32_bf16(A_, B1_, S1, 0, 0, 0); } \
        { v2u w0_, w1_; w0_.x = pk2(S0.x, S0.y); w0_.y = pk2(S0.z, S0.w); w1_.x = pk2(S1.x, S1.y); w1_.y = pk2(S1.z, S1.w); \
          *(LAS v2u*)(ST + l15 * 136 + 16 * wave + 4 * lq) = w0_; *(LAS v2u*)(ST + (16 + l15) * 136 + 16 * wave + 4 * lq) = w1_; } } while (0)
#define GLA_BODYB(c, ST) do { \
        f32x4 O_ = (f32x4){0.f, 0.f, 0.f, 0.f}; \
        _Pragma("unroll") for (int ks = 0; ks < 4; ++ks) { const bf16x8 A_ = *(const LAS bf16x8*)(ST + (dvt + l15) * 136 + 32 * ks + 8 * lq); O_ = __builtin_amdgcn_mfma_f32_16x16x32_bf16(A_, qc[ks], O_, 0, 0, 0); } \
        { const f32x4 Os_ = O_ * 0.08838834764831845f; v2u ob_; ob_.x = pk2(Os_.x, Os_.y); ob_.y = pk2(Os_.z, Os_.w); \
          *(v2u*)(ogla + (size_t)(b * SEQ + (c) * 64 + jt + l15) * 1024 + hh * 256 + dvs * 32 + dvt + 4 * lq) = ob_; } } while (0)
#define GLA_STEP(c, RA, RB, LA, LB) do { { const int cn_ = (c) + 3 < NCH ? (c) + 3 : NCH - 1; GLA_LOAD(cn_, kn##RA, en##RA, vn##RA, qn##RA, dn##RA); } \
        GLA_BODYA(kdT##LA, vT##LA, ST##LA); GLA_PREPL(kn##RB, en##RB, vn##RB, kdT##LB, vT##LB); GLA_BAR(); GLA_BODYB(c, ST##LA); GLA_QD(qn##RB, dn##RB); } while (0)
    GLA_LOAD(0, kn0, en0, vn0, qn0, dn0); GLA_LOAD(1, kn1, en1, vn1, qn1, dn1); GLA_LOAD(2, kn2, en2, vn2, qn2, dn2);
    GLA_PREPL(kn0, en0, vn0, kdT0, vT0); GLA_QD(qn0, dn0);
    GLA_BAR();
    static_assert(NCH == 32, "the step schedule below is written for 32 chunks: 5 x 6 + 2");
    for (int c = 0; c < 30; c += 6) {
        GLA_STEP(c, 0, 1, 0, 1); GLA_STEP(c + 1, 1, 2, 1, 0); GLA_STEP(c + 2, 2, 0, 0, 1); GLA_STEP(c + 3, 0, 1, 1, 0); GLA_STEP(c + 4, 1, 2, 0, 1); GLA_STEP(c + 5, 2, 0, 1, 0);
    }
    GLA_STEP(30, 0, 1, 0, 1); GLA_STEP(31, 1, 2, 1, 0);
#undef GLA_STEP
#undef GLA_PREPL
#undef GLA_QD
#undef GLA_BODYA
#undef GLA_BODYB
#undef GLA_BAR
#undef GLA_LOAD
}

__device__ __forceinline__ void unpack16(const v4u& p0, const v4u& p1, float (&o)[16]) {
#pragma unroll
    for (int j = 0; j < 4; ++j) { o[2 * j] = bflo(p0[j]); o[2 * j + 1] = bfhi(p0[j]); o[8 + 2 * j] = bflo(p1[j]); o[8 + 2 * j + 1] = bfhi(p1[j]); }
}
__device__ __forceinline__ void mixpost_chunk(const Args& a, int l, int lane, int wave, int ch) {
    const bf16* proj = (const bf16*)(a.ws + WS_PROJ); const bf16* ogla = (const bf16*)(a.ws + WS_OGLA);
    const int c0 = 16 * lane, tfirst = ch * 64 + wave * 8, sfirst = tfirst % SEQ;
    float gn[16], cw0[16], cw1[16], cw2[16], cn[16], u1[16], u2[16];
#pragma unroll
    for (int i = 0; i < 16; ++i) { gn[i] = a.in[7][l * 256 + ((c0 + i) & 255)]; cw0[i] = a.in[8][(size_t)l * 3072 + c0 + i]; cw1[i] = a.in[8][(size_t)l * 3072 + 1024 + c0 + i];
        cw2[i] = a.in[8][(size_t)l * 3072 + 2048 + c0 + i]; cn[i] = a.in[9][l * 1024 + c0 + i]; u1[i] = 0.f; u2[i] = 0.f; }
    if (sfirst >= 2) {
        float cc[16], chh[16];
        { const bf16* pr = proj + (size_t)(tfirst - 2) * NP; unpack16(*(const v4u*)(pr + PCC + c0), *(const v4u*)(pr + PCC + c0 + 8), cc); unpack16(*(const v4u*)(pr + PCH + c0), *(const v4u*)(pr + PCH + c0 + 8), chh); }
#pragma unroll
        for (int i = 0; i < 16; ++i) u2[i] = cc[i] * chh[i];
        { const bf16* pr = proj + (size_t)(tfirst - 1) * NP; unpack16(*(const v4u*)(pr + PCC + c0), *(const v4u*)(pr + PCC + c0 + 8), cc); unpack16(*(const v4u*)(pr + PCH + c0), *(const v4u*)(pr + PCH + c0 + 8), chh); }
#pragma unroll
        for (int i = 0; i < 16; ++i) u1[i] = cc[i] * chh[i];
    }
#pragma unroll 2
    for (int it = 0; it < 8; ++it) { const int t = tfirst + it; const bf16* pr = proj + (size_t)t * NP;
        float o[16], r[16], cb[16], cc[16], chh[16];
        unpack16(*(const v4u*)(ogla + (size_t)t * 1024 + c0), *(const v4u*)(ogla + (size_t)t * 1024 + c0 + 8), o);
        unpack16(*(const v4u*)(pr + PR + c0), *(const v4u*)(pr + PR + c0 + 8), r);
        unpack16(*(const v4u*)(pr + PCB + c0), *(const v4u*)(pr + PCB + c0 + 8), cb);
        unpack16(*(const v4u*)(pr + PCC + c0), *(const v4u*)(pr + PCC + c0 + 8), cc);
        unpack16(*(const v4u*)(pr + PCH + c0), *(const v4u*)(pr + PCH + c0 + 8), chh);
        float ss = 0.f;
#pragma unroll
        for (int i = 0; i < 16; ++i) ss += o[i] * o[i];
        ss += __uint_as_float((unsigned)__builtin_amdgcn_update_dpp(0, (int)__float_as_uint(ss), 0xB1, 0xf, 0xf, false)); ss += __uint_as_float((unsigned)__builtin_amdgcn_update_dpp(0, (int)__float_as_uint(ss), 0x4E, 0xf, 0xf, false));
        ss += __uint_as_float((unsigned)__builtin_amdgcn_update_dpp(0, (int)__float_as_uint(ss), 0x124, 0xf, 0xf, false)); ss += __uint_as_float((unsigned)__builtin_amdgcn_update_dpp(0, (int)__float_as_uint(ss), 0x128, 0xf, 0xf, false));
        const float rg = rsqrtf(ss * (1.0f / 256.f) + EPS);
        float val[16]; float s2 = 0.f;
#pragma unroll
        for (int i = 0; i < 16; ++i) { const float u0 = cc[i] * chh[i]; val[i] = cb[i] * (cw0[i] * u2[i] + cw1[i] * u1[i] + cw2[i] * u0); s2 += val[i] * val[i]; u2[i] = u1[i]; u1[i] = u0; }
        const float rc = rsqrtf(wave_sum(s2) * (1.0f / 1024.f) + EPS);
        float ya[16], yb[16]; float mx = 0.f;
#pragma unroll
        for (int i = 0; i < 16; ++i) { ya[i] = o[i] * rg * gn[i] * silu_f(r[i]); yb[i] = val[i] * rc * cn[i]; mx = fmaxf(mx, fmaxf(fabsf(ya[i]), fabsf(yb[i]))); }
        mx = wave_max(mx);
        const float inv = mx > 0.f ? 127.0f / mx : 0.f;
        v4u y0, y1;
#pragma unroll
        for (int j = 0; j < 4; ++j) { y0[j] = pack_i8(ya[4 * j] * inv, ya[4 * j + 1] * inv, ya[4 * j + 2] * inv, ya[4 * j + 3] * inv); y1[j] = pack_i8(yb[4 * j] * inv, yb[4 * j + 1] * inv, yb[4 * j + 2] * inv, yb[4 * j + 3] * inv); }
        unsigned char* yr = a.ws + WS_Y8 + (size_t)t * D;
        *(v4u*)(yr + c0) = y0; *(v4u*)(yr + 1024 + c0) = y1;
#if !I8_OUT
        { v4u b0, b1, b2, b3;
#pragma unroll
          for (int j = 0; j < 4; ++j) { b0[j] = pk2(ya[2 * j], ya[2 * j + 1]); b1[j] = pk2(ya[8 + 2 * j], ya[9 + 2 * j]); b2[j] = pk2(yb[2 * j], yb[2 * j + 1]); b3[j] = pk2(yb[8 + 2 * j], yb[9 + 2 * j]); }
          bf16* ybr = (bf16*)(a.ws + WS_Y) + (size_t)t * D;
          *(v4u*)(ybr + c0) = b0; *(v4u*)(ybr + c0 + 8) = b1; *(v4u*)(ybr + 1024 + c0) = b2; *(v4u*)(ybr + 1024 + c0 + 8) = b3; }
#endif
        if (lane == 0) ((float*)(a.ws + WS_SAY))[t] = mx * (1.0f / 127.0f);
    }
}

__device__ __forceinline__ void ln1_chunk(const Args& a, int l, LAS unsigned char* lds, int lane, int wave, int ch) {
    const float* zbuf = (const float*)(a.ws + WS_Z); const float* mod = (const float*)(a.ws + WS_MOD);
    const int b = ch / NCH; const float* mb = mod + ((size_t)l * NB + b) * 6 * D;
#pragma unroll 2
    for (int it = 0; it < 8; ++it) { const int t = ch * 64 + wave * 8 + it;
        float z[32];
#pragma unroll
#if RES16_Z
        for (int c = 0; c < 8; ++c) { const v2u v0 = *(const v2u*)((const bf16*)zbuf + (size_t)t * D + (c * 64 + lane) * 4); z[c * 4] = bflo(v0.x); z[c * 4 + 1] = bfhi(v0.x); z[c * 4 + 2] = bflo(v0.y); z[c * 4 + 3] = bfhi(v0.y); }
#else
        for (int c = 0; c < 8; ++c) { const f32x4 v0 = *(const f32x4*)(zbuf + (size_t)t * D + (c * 64 + lane) * 4); z[c * 4] = v0.x; z[c * 4 + 1] = v0.y; z[c * 4 + 2] = v0.z; z[c * 4 + 3] = v0.w; }
#endif
        ln_tail(z, t, lane, a.in[11] + (size_t)l * D, a.in[12] + (size_t)l * D, RES16_X1 ? (float*)nullptr : (float*)(a.ws + WS_X1), mb + 3 * D, mb + 4 * D, I8_WQ ? (bf16*)nullptr : (bf16*)(a.ws + WS_H2), a.ws + WS_HQ8, (float*)(a.ws + WS_HSC), lds + wave * 2304, I8_WQ ? a.ws + WS_H28 : (unsigned char*)nullptr, nullptr, RES16_X1 ? (bf16*)(a.ws + WS_X1) : (bf16*)nullptr);
    }
}

template <int N> __device__ __forceinline__ void bitonic_sort_desc(float (&v)[N]) {
#pragma unroll
    for (int k = 2; k <= N; k <<= 1)
#pragma unroll
        for (int j = k >> 1; j > 0; j >>= 1)
#pragma unroll
            for (int i = 0; i < N; ++i) { const int p = i ^ j; if (p > i) { const bool desc = ((i & k) == 0); const float x = v[i], y = v[p]; const float mx = fmaxf(x, y), mn = fminf(x, y); v[i] = desc ? mx : mn; v[p] = desc ? mn : mx; } }
}
__device__ __forceinline__ void merge_top16(float (&x)[16], const float (&y)[16]) {
#pragma unroll
    for (int i = 0; i < 16; ++i) x[i] = fmaxf(x[i], y[15 - i]);
#pragma unroll
    for (int j = 8; j > 0; j >>= 1)
#pragma unroll
        for (int i = 0; i < 16; ++i) { const int p = i ^ j; if (p > i) { const float u = x[i], w = x[p]; x[i] = fmaxf(u, w); x[p] = fminf(u, w); } }
}
__device__ __forceinline__ void ce_desc(float& ka, int& pa, float& kb, int& pb) { const bool sw = kb > ka; const float k0 = sw ? kb : ka, k1 = sw ? ka : kb; const int p0 = sw ? pb : pa, p1 = sw ? pa : pb; ka = k0; pa = p0; kb = k1; pb = p1; }
__device__ __forceinline__ void bitonic_sort_desc_kp(float (&k)[16], int (&p)[16]) {
#pragma unroll
    for (int kk = 2; kk <= 16; kk <<= 1)
#pragma unroll
        for (int j = kk >> 1; j > 0; j >>= 1)
#pragma unroll
            for (int i = 0; i < 16; ++i) { const int q = i ^ j; if (q > i) { if ((i & kk) == 0) ce_desc(k[i], p[i], k[q], p[q]); else ce_desc(k[q], p[q], k[i], p[i]); } }
}
__device__ __forceinline__ void merge_top16_kp(float (&k)[16], int (&p)[16], const float (&k2)[16], const int (&p2)[16]) {
#pragma unroll
    for (int i = 0; i < 16; ++i) { const bool sw = k2[15 - i] > k[i]; k[i] = sw ? k2[15 - i] : k[i]; p[i] = sw ? p2[15 - i] : p[i]; }
#pragma unroll
    for (int j = 8; j > 0; j >>= 1)
#pragma unroll
        for (int i = 0; i < 16; ++i) { const int q = i ^ j; if (q > i) ce_desc(k[i], p[i], k[q], p[q]); }
}
__device__ constexpr int cand_i(int s) { return s < 16 ? 0 : s < 24 ? 1 : s < 29 ? 2 : s < 33 ? 3 : s < 36 ? 4 : s < 38 ? 5 : s < 40 ? 6 : s < 42 ? 7 : s < 50 ? s - 34 : -1; }
__device__ constexpr int cand_j(int s) { return s < 16 ? s : s < 24 ? s - 16 : s < 29 ? s - 24 : s < 33 ? s - 29 : s < 36 ? s - 33 : s < 38 ? s - 36 : s < 40 ? s - 38 : s < 42 ? s - 40 : s < 50 ? 0 : -1; }

__device__ __forceinline__ void peer_retrieve(const Args& a, int l, LAS unsigned char* lds, int lane, int wave, int ch) {
    const bf16* qbuf = (const bf16*)(a.ws + WS_Q); const bf16* keys = (const bf16*)(a.ws + WS_KEYS) + ((size_t)(l * 8 + wave) * 2) * 128 * 128;
    LAS int* eg_e = (LAS int*)lds; LAS float* eg_g = (LAS float*)(lds + 32768);
    const int l31 = lane & 31, l5 = lane >> 5, h = wave, t0 = ch * 64;
    for (int tt = 0; tt < 2; ++tt) {
        float sv[2][16];
#pragma unroll
        for (int p = 0; p < 2; ++p) {
            f32x16 acc[4];
#pragma unroll
            for (int nt = 0; nt < 4; ++nt)
#pragma unroll
                for (int r = 0; r < 16; ++r) acc[nt][r] = 0.f;
            const bf16* qp = qbuf + (size_t)(t0 + 32 * tt + l31) * D + h * 256 + p * 128 + 8 * l5;
            const bf16* kp = keys + (size_t)(p * 128 + l31) * 128 + 8 * l5;
#pragma unroll 4
            for (int ks = 0; ks < 8; ++ks) { const bf16x8 bq = *(const bf16x8*)(qp + 16 * ks);
#pragma unroll
                for (int nt = 0; nt < 4; ++nt) { const bf16x8 ak = *(const bf16x8*)(kp + (size_t)(32 * nt) * 128 + 16 * ks); acc[nt] = __builtin_amdgcn_mfma_f32_32x32x16_bf16(ak, bq, acc[nt], 0, 0, 0); } }
            float v[4][16];
#pragma unroll
            for (int nt = 0; nt < 4; ++nt)
#pragma unroll
                for (int r = 0; r < 16; ++r) { const unsigned idx = 32u * nt + (r & 3) + 8u * (r >> 2) + 4u * l5; v[nt][r] = __uint_as_float((__float_as_uint(acc[nt][r]) & 0xffffff80u) | idx); }
#pragma unroll
            for (int nt = 0; nt < 4; ++nt) bitonic_sort_desc<16>(v[nt]);
            merge_top16(v[0], v[1]); merge_top16(v[2], v[3]); merge_top16(v[0], v[2]);
            float o[16];
#pragma unroll
            for (int i = 0; i < 16; ++i) o[i] = __shfl_xor(v[0][i], 32);
            merge_top16(v[0], o);
#pragma unroll
            for (int i = 0; i < 16; ++i) sv[p][i] = v[0][i];
        }
        LAS unsigned char* idxb = (LAS unsigned char*)(lds + 69632) + wave * 2048 + lane * 32;
        { v4u w0, w1;
#pragma unroll
          for (int q4 = 0; q4 < 4; ++q4) {
              w0[q4] = (__float_as_uint(sv[0][4 * q4]) & 127u) | ((__float_as_uint(sv[0][4 * q4 + 1]) & 127u) << 8) | ((__float_as_uint(sv[0][4 * q4 + 2]) & 127u) << 16) | ((__float_as_uint(sv[0][4 * q4 + 3]) & 127u) << 24);
              w1[q4] = (__float_as_uint(sv[1][4 * q4]) & 127u) | ((__float_as_uint(sv[1][4 * q4 + 1]) & 127u) << 8) | ((__float_as_uint(sv[1][4 * q4 + 2]) & 127u) << 16) | ((__float_as_uint(sv[1][4 * q4 + 3]) & 127u) << 24); }
          *(LAS v4u*)(idxb) = w0; *(LAS v4u*)(idxb + 16) = w1; }
        float ck[4][16];
#pragma unroll
        for (int s = 0; s < 64; ++s) {
            if (cand_i(s) >= 0) { const unsigned b0 = __float_as_uint(sv[0][cand_i(s) < 0 ? 0 : cand_i(s)]), b1 = __float_as_uint(sv[1][cand_j(s) < 0 ? 0 : cand_j(s)]);
                const float sum = __uint_as_float(b0 & 0xffffff80u) + __uint_as_float(b1 & 0xffffff80u);
                ck[s >> 4][s & 15] = __uint_as_float((__float_as_uint(sum) & 0xffffff00u) | (unsigned)((cand_i(s) < 0 ? 0 : cand_i(s)) * 16 + (cand_j(s) < 0 ? 0 : cand_j(s)))); }
            else ck[s >> 4][s & 15] = -3.0e38f; }
        bitonic_sort_desc<16>(ck[1]); bitonic_sort_desc<16>(ck[2]);
        merge_top16(ck[0], ck[1]); merge_top16(ck[2], ck[3]); merge_top16(ck[0], ck[2]);
        LDS_WAIT(); asm volatile("" ::: "memory");
        float ex[16]; int ce[16]; float den = 0.f;
        const float cmax = __uint_as_float(__float_as_uint(ck[0][0]) & 0xffffff00u);
#pragma unroll
        for (int i = 0; i < 16; ++i) { const unsigned bits = __float_as_uint(ck[0][i]); ex[i] = __expf(__uint_as_float(bits & 0xffffff00u) - cmax); den += ex[i];
            ce[i] = (int)idxb[(bits >> 4) & 15u] * 128 + (int)idxb[16 + (bits & 15u)]; }
        const float inv = 1.0f / den;
        if (l5 == 0) {
            const int base = (32 * tt + l31) * 128 + h * 16;
#pragma unroll
            for (int i4 = 0; i4 < 4; ++i4) { *(LAS v4u*)(eg_e + base + 4 * i4) = (v4u){(unsigned)ce[4 * i4], (unsigned)ce[4 * i4 + 1], (unsigned)ce[4 * i4 + 2], (unsigned)ce[4 * i4 + 3]};
                *(LAS f32x4*)(eg_g + base + 4 * i4) = (f32x4){ex[4 * i4] * inv, ex[4 * i4 + 1] * inv, ex[4 * i4 + 2] * inv, ex[4 * i4 + 3] * inv}; }
        }
        LDS_WAIT(); asm volatile("" ::: "memory");
    }
}

typedef unsigned char uc4 __attribute__((ext_vector_type(4)));
constexpr int NSLICE = 16, SLICE_SHIFT = 10;
__device__ __forceinline__ int sdot4i(unsigned w, unsigned x, int acc) { return __builtin_amdgcn_sdot4((int)w, (int)x, acc, false); }
__device__ __forceinline__ void fma_ub4(unsigned w, float s, float& y0, float& y1, float& y2, float& y3) { const uc4 b = __builtin_bit_cast(uc4, w); y0 += s * (float)b.x; y1 += s * (float)b.y; y2 += s * (float)b.z; y3 += s * (float)b.w; }
#if TAB4
__device__ __forceinline__ void peer_tail(const Args& a, int l, int t, int lane, const bf16* Yrow, const float* mb, const float* mbn, bool last) {
    const float* x1buf = (const float*)(a.ws + WS_X1);
    float z[32];
#pragma unroll
    for (int c8 = 0; c8 < 8; ++c8) { const int col = (c8 * 64 + lane) * 4;
        const v2u yb = *(const v2u*)(Yrow + col); const f32x4 yv = (f32x4){bflo(yb.x), bfhi(yb.x), bflo(yb.y), bfhi(yb.y)};
#if RES16_X1
        const v2u xb_ = *(const v2u*)((const bf16*)x1buf + (size_t)t * D + col); const f32x4 x0 = (f32x4){bflo(xb_.x), bfhi(xb_.x), bflo(xb_.y), bfhi(xb_.y)}, g0 = *(const f32x4*)(mb + 5 * D + col);
#else
        const f32x4 x0 = *(const f32x4*)(x1buf + (size_t)t * D + col), g0 = *(const f32x4*)(mb + 5 * D + col);
#endif
        z[c8 * 4] = ALPHA * x0.x + (1.f + g0.x) * yv.x; z[c8 * 4 + 1] = ALPHA * x0.y + (1.f + g0.y) * yv.y; z[c8 * 4 + 2] = ALPHA * x0.z + (1.f + g0.z) * yv.z; z[c8 * 4 + 3] = ALPHA * x0.w + (1.f + g0.w) * yv.w; }
    ln_tail(z, t, lane, a.in[17] + (size_t)l * D, a.in[18] + (size_t)l * D, last ? a.out : (RES16_X ? (float*)nullptr : (float*)(a.ws + WS_X)), mbn, mbn + D, (last || I8_GATE) ? (bf16*)nullptr : (bf16*)(a.ws + WS_H), nullptr, nullptr, nullptr, last ? (unsigned char*)nullptr : a.ws + WS_H8, (float*)(a.ws + WS_SAH), (RES16_X && !last) ? (bf16*)(a.ws + WS_X) : (bf16*)nullptr);
}
template <class TT, int N, int M> __device__ __forceinline__ void treduce(TT (&v)[N], int lane) {
    const bool c0 = (lane & M) != 0, c1 = (lane & (2 * M)) != 0, c2 = (lane & (4 * M)) != 0;
#pragma unroll
    for (int m = 0; m < N / 2; ++m) { const TT keep = c0 ? v[2 * m + 1] : v[2 * m], send = c0 ? v[2 * m] : v[2 * m + 1]; v[m] = keep + __shfl_xor(send, M); }
#pragma unroll
    for (int m = 0; m < N / 4; ++m) { const TT keep = c1 ? v[2 * m + 1] : v[2 * m], send = c1 ? v[2 * m] : v[2 * m + 1]; v[m] = keep + __shfl_xor(send, 2 * M); }
#pragma unroll
    for (int m = 0; m < N / 8; ++m) { const TT keep = c2 ? v[2 * m + 1] : v[2 * m], send = c2 ? v[2 * m] : v[2 * m + 1]; v[m] = keep + __shfl_xor(send, 4 * M); }
}
__device__ __forceinline__ int allsum_8_16_32(int x) {
    x += __builtin_amdgcn_update_dpp(0, x, 0x128, 0xf, 0xf, false);
    { const auto r = __builtin_amdgcn_permlane16_swap((unsigned)x, (unsigned)x, false, false); x = (int)(r[0] + r[1]); }
    { const auto r = __builtin_amdgcn_permlane32_swap((unsigned)x, (unsigned)x, false, false); x = (int)(r[0] + r[1]); }
    return x; }
__device__ __forceinline__ float allmax_8_16_32(float x) {
    x = fmaxf(x, __uint_as_float((unsigned)__builtin_amdgcn_update_dpp(0, (int)__float_as_uint(x), 0x128, 0xf, 0xf, false)));
    { const auto r = __builtin_amdgcn_permlane16_swap(__float_as_uint(x), __float_as_uint(x), false, false); x = fmaxf(__uint_as_float(r[0]), __uint_as_float(r[1])); }
    { const auto r = __builtin_amdgcn_permlane32_swap(__float_as_uint(x), __float_as_uint(x), false, false); x = fmaxf(__uint_as_float(r[0]), __uint_as_float(r[1])); }
    return x; }
__device__ __forceinline__ void treduce32x8(int (&v)[32], int lane) {
    const bool c0 = (lane & 8) != 0;
#pragma unroll
    for (int m = 0; m < 16; ++m) { const int keep = c0 ? v[2 * m + 1] : v[2 * m], send = c0 ? v[2 * m] : v[2 * m + 1]; v[m] = keep + __builtin_amdgcn_update_dpp(0, send, 0x128, 0xf, 0xf, false); }
#pragma unroll
    for (int m = 0; m < 8; ++m) { const auto r = __builtin_amdgcn_permlane16_swap((unsigned)v[2 * m], (unsigned)v[2 * m + 1], false, false); v[m] = (int)(r[0] + r[1]); }
#pragma unroll
    for (int m = 0; m < 4; ++m) { const auto r = __builtin_amdgcn_permlane32_swap((unsigned)v[2 * m], (unsigned)v[2 * m + 1], false, false); v[m] = (int)(r[0] + r[1]); }
}
__device__ __forceinline__ void tr4x4(unsigned a, unsigned b, unsigned c, unsigned d, unsigned& t0, unsigned& t1, unsigned& t2, unsigned& t3) {
    const unsigned x0 = __builtin_amdgcn_perm(b, a, 0x05010400u), x1 = __builtin_amdgcn_perm(b, a, 0x07030602u), y0 = __builtin_amdgcn_perm(d, c, 0x05010400u), y1 = __builtin_amdgcn_perm(d, c, 0x07030602u);
    t0 = __builtin_amdgcn_perm(y0, x0, 0x05040100u); t1 = __builtin_amdgcn_perm(y0, x0, 0x07060302u); t2 = __builtin_amdgcn_perm(y1, x1, 0x05040100u); t3 = __builtin_amdgcn_perm(y1, x1, 0x07060302u);
}
__device__ __forceinline__ int sdot8i(unsigned w, unsigned x, int acc) { return __builtin_amdgcn_sdot8((int)w, (int)x, acc, false); }
__device__ __forceinline__ float slot_scale(unsigned w3) { return __builtin_amdgcn_exp2f((float)(w3 >> 24) * 0.125f - 16.0f); }
__device__ __forceinline__ void peer_experts(const Args& a, int l, LAS unsigned char* lds, int lane0, int wave, int ch) {
    const float* mod = (const float*)(a.ws + WS_MOD);
    const unsigned char* ut = a.ws + WS_UT + (size_t)l * NE * 1152; const unsigned char* vt = a.ws + WS_VT + (size_t)l * NE * 1152; const unsigned char* hq8 = a.ws + WS_HQ8;
    const float* hsc = (const float*)(a.ws + WS_HSC);
    bf16* Ybuf = (bf16*)(a.ws + WS_Z);
    const LAS int* eg_e = (const LAS int*)lds; LAS float* sw = (LAS float*)(lds + 32768);
    LAS float* apart = (LAS float*)(lds + 65536);
    const int b = ch / NCH; const bool last = (l == NL - 1);
    const float* mb = mod + ((size_t)l * NB + b) * 6 * D; const float* mbn = mod + ((size_t)(last ? l : l + 1) * NB + b) * 6 * D;
    const int tlw = wave * 8;
    { const int lane = lane0;
#pragma unroll
      for (int i = 0; i < 16; ++i) apart[tlw * 128 + i * 64 + lane] = 0.f; }
    LDS_WAIT(); asm volatile("" ::: "memory");
    {
        int laneL = lane0; asm volatile("" : "+v"(laneL)); const int lane = laneL;
        const int g = lane >> 3, l7 = lane & 7;
        v4u bufA[16], bufB[16], hA0, hA1, hB0, hB1;
#define CU_LOAD(buf, h0_, h1_, idx_) do { const int u_ = (idx_) >> 3, tl_ = tlw + ((idx_) & 7); const unsigned soff_ = (unsigned)(u_ * 128 + l7 * 16); \
            const unsigned char* hp_ = hq8 + (size_t)(ch * 64 + tl_) * 2304 + (u_ * 8 + l7) * 32; h0_ = *(const v4u*)hp_; h1_ = *(const v4u*)(hp_ + 16); \
            _Pragma("unroll") for (int i_ = 0; i_ < 16; ++i_) { const unsigned e_ = (unsigned)eg_e[tl_ * 128 + 8 * i_ + g]; buf[i_] = *(const v4u*)(ut + (size_t)(e_ * 1152u + soff_)); } } while (0)
#define CU_COMP(buf, h0_, h1_, idx_) do { const int tl_ = tlw + ((idx_) & 7); float accv_[16]; \
            _Pragma("unroll") for (int i_ = 0; i_ < 16; ++i_) { int sl_ = 0, sh_ = 0; \
                _Pragma("unroll") for (int d_ = 0; d_ < 4; ++d_) { const unsigned x_ = buf[i_][d_] ^ 0x88888888u; sl_ = sdot8i(x_, h0_[d_], sl_); sh_ = sdot8i(x_, h1_[d_], sh_); } \
                accv_[i_] = slot_scale(buf[i_][3]) * (float)(16 * sh_ + sl_); } \
            treduce<float, 16, 1>(accv_, lane); \
            apart[tl_ * 128 + 8 * l7 + g] += accv_[0]; apart[tl_ * 128 + 8 * (8 + l7) + g] += accv_[1]; } while (0)
        CU_LOAD(bufA, hA0, hA1, 0);
        for (int idx = 0; idx < 72; idx += 2) {
            CU_LOAD(bufB, hB0, hB1, idx + 1);
            CU_COMP(bufA, hA0, hA1, idx);
            { const int nx_ = idx + 2 < 72 ? idx + 2 : 71; CU_LOAD(bufA, hA0, hA1, nx_); }
            CU_COMP(bufB, hB0, hB1, idx + 1);
        }
#undef CU_LOAD
#undef CU_COMP
        LDS_WAIT(); asm volatile("" ::: "memory");
        for (int it = 0; it < 8; ++it) { const int tl = tlw + it; const float shs = hsc[ch * 64 + tl];
            const float w0 = sw[tl * 128 + lane] * gelu_tanh_f(apart[tl * 128 + lane] * shs), w1 = sw[tl * 128 + 64 + lane] * gelu_tanh_f(apart[tl * 128 + 64 + lane] * shs);
            sw[tl * 128 + lane] = w0; sw[tl * 128 + 64 + lane] = w1; }
        LDS_WAIT(); asm volatile("" ::: "memory");
    }
    {
        int laneL = lane0; asm volatile("" : "+v"(laneL)); const int lane = laneL;
        const int g = lane >> 3, l7 = lane & 7;
        v4u bufA[16], bufB[16];
#define CV_LOAD(buf, idx_) do { const int u_ = (idx_) >> 3, tl_ = tlw + ((idx_) & 7); const unsigned soff_ = (unsigned)(u_ * 128 + l7 * 16); \
            _Pragma("unroll") for (int i_ = 0; i_ < 16; ++i_) { const unsigned e_ = (unsigned)eg_e[tl_ * 128 + 8 * i_ + g]; buf[i_] = *(const v4u*)(vt + (size_t)(e_ * 1152u + soff_)); } } while (0)
#define CV_COMP(buf, idx_) do { const int u_ = (idx_) >> 3, tl_ = tlw + ((idx_) & 7); \
            float wf_[16]; float wmx_ = 0.f; \
            _Pragma("unroll") for (int i_ = 0; i_ < 16; ++i_) { wf_[i_] = sw[tl_ * 128 + 8 * i_ + g] * slot_scale(buf[i_][3]); wmx_ = fmaxf(wmx_, fabsf(wf_[i_])); } \
            wmx_ = allmax_8_16_32(wmx_);     \
            const float winv_ = wmx_ > 0.f ? 127.0f / wmx_ : 0.f, wsc_ = wmx_ * (1.0f / 127.0f); \
              \
            unsigned wq4_[4]; int wsum_ = 0; \
            _Pragma("unroll") for (int gp_ = 0; gp_ < 4; ++gp_) { \
                const unsigned m0_ = __float_as_uint(wf_[4 * gp_] * winv_ + 12582912.0f), m1_ = __float_as_uint(wf_[4 * gp_ + 1] * winv_ + 12582912.0f), m2_ = __float_as_uint(wf_[4 * gp_ + 2] * winv_ + 12582912.0f), m3_ = __float_as_uint(wf_[4 * gp_ + 3] * winv_ + 12582912.0f); \
                wq4_[gp_] = __builtin_amdgcn_perm(__builtin_amdgcn_perm(m3_, m2_, 0x0c0c0400u), __builtin_amdgcn_perm(m1_, m0_, 0x0c0c0400u), 0x05040100u); \
                wsum_ = sdot4i(wq4_[gp_], 0x01010101u, wsum_); } \
            int yi_[32]; \
            _Pragma("unroll") for (int q_ = 0; q_ < 32; ++q_) yi_[q_] = 0; \
            _Pragma("unroll") for (int gp_ = 0; gp_ < 4; ++gp_) { \
                _Pragma("unroll") for (int d_ = 0; d_ < 4; ++d_) { const unsigned A_ = buf[4 * gp_][d_], B_ = buf[4 * gp_ + 1][d_], C_ = buf[4 * gp_ + 2][d_], D_ = buf[4 * gp_ + 3][d_]; \
                    unsigned t0_, t1_, t2_, t3_; \
                    tr4x4(A_, B_, C_, D_, t0_, t1_, t2_, t3_);     \
                    yi_[8 * d_]     = sdot4i(t0_ & 0x0f0f0f0fu, wq4_[gp_], yi_[8 * d_]);     yi_[8 * d_ + 1] = sdot4i((t0_ >> 4) & 0x0f0f0f0fu, wq4_[gp_], yi_[8 * d_ + 1]); \
                    yi_[8 * d_ + 2] = sdot4i(t1_ & 0x0f0f0f0fu, wq4_[gp_], yi_[8 * d_ + 2]); yi_[8 * d_ + 3] = sdot4i((t1_ >> 4) & 0x0f0f0f0fu, wq4_[gp_], yi_[8 * d_ + 3]); \
                    yi_[8 * d_ + 4] = sdot4i(t2_ & 0x0f0f0f0fu, wq4_[gp_], yi_[8 * d_ + 4]); yi_[8 * d_ + 5] = sdot4i((t2_ >> 4) & 0x0f0f0f0fu, wq4_[gp_], yi_[8 * d_ + 5]); \
                    yi_[8 * d_ + 6] = sdot4i(t3_ & 0x0f0f0f0fu, wq4_[gp_], yi_[8 * d_ + 6]); yi_[8 * d_ + 7] = sdot4i((t3_ >> 4) & 0x0f0f0f0fu, wq4_[gp_], yi_[8 * d_ + 7]); } } \
            treduce32x8(yi_, lane); \
            wsum_ = allsum_8_16_32(wsum_);     \
            float y_[4]; \
            _Pragma("unroll") for (int q_ = 0; q_ < 4; ++q_) y_[q_] = wsc_ * (float)(yi_[q_] - 8 * wsum_); \
            { const int colb_ = u_ * 240 + l7 * 30 + g; bf16* yr_ = Ybuf + (size_t)(ch * 64 + tl_) * D + colb_; \
              _Pragma("unroll") for (int m_ = 0; m_ < 4; ++m_) if (8 * m_ + g < 30 && colb_ + 8 * m_ < D) yr_[8 * m_] = (bf16)(pk2(y_[m_], 0.f) & 0xffffu); } } while (0)
        CV_LOAD(bufA, 0);
        for (int idx = 0; idx < 72; idx += 2) {
            CV_LOAD(bufB, idx + 1);
            CV_COMP(bufA, idx);
            { const int nx_ = idx + 2 < 72 ? idx + 2 : 71; CV_LOAD(bufA, nx_); }
            CV_COMP(bufB, idx + 1);
        }
#undef CV_LOAD
#undef CV_COMP
    }
    asm volatile("s_waitcnt vmcnt(0)" ::: "memory");
    __builtin_amdgcn_fence(__ATOMIC_ACQUIRE, "agent");
    asm volatile("s_waitcnt vmcnt(0)" ::: "memory");
    for (int it = 0; it < 8; ++it) { int laneT = lane0; asm volatile("" : "+v"(laneT)); const int t = ch * 64 + tlw + it;
        peer_tail(a, l, t, laneT, Ybuf + (size_t)t * D, mb, mbn, last); }
}
#else
__device__ __forceinline__ void peer_tail(const Args& a, int l, int t, int lane, const float* Yrow, const float* mb, const float* mbn, bool last) {
    const float* x1buf = (const float*)(a.ws + WS_X1);
    float z[32];
#pragma unroll
    for (int c = 0; c < 2; ++c)
#pragma unroll
        for (int k = 0; k < 4; ++k) { const int c8 = 4 * c + k, col = (c8 * 64 + lane) * 4;
            const v2u yb = *(const v2u*)((const bf16*)Yrow + (c * 64 + lane) * 16 + 4 * k); const f32x4 yv = (f32x4){bflo(yb.x), bfhi(yb.x), bflo(yb.y), bfhi(yb.y)};
#if RES16_X1
            const v2u xb_ = *(const v2u*)((const bf16*)x1buf + (size_t)t * D + col); const f32x4 x0 = (f32x4){bflo(xb_.x), bfhi(xb_.x), bflo(xb_.y), bfhi(xb_.y)}, g0 = *(const f32x4*)(mb + 5 * D + col);
#else
            const f32x4 x0 = *(const f32x4*)(x1buf + (size_t)t * D + col), g0 = *(const f32x4*)(mb + 5 * D + col);
#endif
            z[c8 * 4] = ALPHA * x0.x + (1.f + g0.x) * yv.x; z[c8 * 4 + 1] = ALPHA * x0.y + (1.f + g0.y) * yv.y; z[c8 * 4 + 2] = ALPHA * x0.z + (1.f + g0.z) * yv.z; z[c8 * 4 + 3] = ALPHA * x0.w + (1.f + g0.w) * yv.w; }
    ln_tail(z, t, lane, a.in[17] + (size_t)l * D, a.in[18] + (size_t)l * D, last ? a.out : (RES16_X ? (float*)nullptr : (float*)(a.ws + WS_X)), mbn, mbn + D, (last || I8_GATE) ? (bf16*)nullptr : (bf16*)(a.ws + WS_H), nullptr, nullptr, nullptr, last ? (unsigned char*)nullptr : a.ws + WS_H8, (float*)(a.ws + WS_SAH), (RES16_X && !last) ? (bf16*)(a.ws + WS_X) : (bf16*)nullptr);
}
template <class TT, int M> __device__ __forceinline__ void treduce16(TT (&v)[16], int lane) {
    const bool c0 = (lane & M) != 0, c1 = (lane & (2 * M)) != 0, c2 = (lane & (4 * M)) != 0;
#pragma unroll
    for (int m = 0; m < 8; ++m) { const TT keep = c0 ? v[2 * m + 1] : v[2 * m], send = c0 ? v[2 * m] : v[2 * m + 1]; v[m] = keep + __shfl_xor(send, M); }
#pragma unroll
    for (int m = 0; m < 4; ++m) { const TT keep = c1 ? v[2 * m + 1] : v[2 * m], send = c1 ? v[2 * m] : v[2 * m + 1]; v[m] = keep + __shfl_xor(send, 2 * M); }
#pragma unroll
    for (int m = 0; m < 2; ++m) { const TT keep = c2 ? v[2 * m + 1] : v[2 * m], send = c2 ? v[2 * m] : v[2 * m + 1]; v[m] = keep + __shfl_xor(send, 4 * M); }
}
__device__ __forceinline__ void peer_experts(const Args& a, int l, LAS unsigned char* lds, int lane0, int wave, int ch) {
    const float* mod = (const float*)(a.ws + WS_MOD);
    const unsigned char* ut = a.ws + WS_UT + (size_t)l * NE * D; const unsigned char* vt = a.ws + WS_VT + (size_t)l * NE * D; const unsigned char* hq8 = a.ws + WS_HQ8;
    const float* su = (const float*)(a.ws + WS_SU) + (size_t)l * NE; const float* sv = (const float*)(a.ws + WS_SV) + (size_t)l * NE; const float* hsc = (const float*)(a.ws + WS_HSC);
    float* Ybuf = (float*)(a.ws + WS_Z);
    const LAS int* eg_e = (const LAS int*)lds; LAS float* sw = (LAS float*)(lds + 32768);
    LAS int* apart = (LAS int*)(lds + 65536); LAS float* wtotl = (LAS float*)(lds + LDSCTL_OFF + 256);
    const int b = ch / NCH; const bool last = (l == NL - 1);
    const float* mb = mod + ((size_t)l * NB + b) * 6 * D; const float* mbn = mod + ((size_t)(last ? l : l + 1) * NB + b) * 6 * D;
    const int tlw = wave * 8;
    { const int lane = lane0;
#pragma unroll
      for (int i = 0; i < 16; ++i) apart[tlw * 128 + i * 64 + lane] = 0; }
    LDS_WAIT(); asm volatile("" ::: "memory");
    {
        int laneL = lane0; asm volatile("" : "+v"(laneL)); const int lane = laneL;
        const int g = lane >> 3, l7 = lane & 7;
        v4u bufA[16], bufB[16], hA, hB;
#define CU_LOAD(buf, hh_, idx_) do { const int cs_ = (idx_) >> 3, tl_ = tlw + ((idx_) & 7); const unsigned coff_ = (unsigned)(cs_ * 128 + l7 * 16); \
            hh_ = *(const v4u*)(hq8 + (size_t)(ch * 64 + tl_) * D + coff_); \
            _Pragma("unroll") for (int i_ = 0; i_ < 16; ++i_) { const unsigned e_ = (unsigned)eg_e[tl_ * 128 + 8 * i_ + g]; buf[i_] = *(const v4u*)(ut + (size_t)(e_ * 2048u + coff_)); } } while (0)
#define CU_COMP(buf, hh_, idx_) do { const int tl_ = tlw + ((idx_) & 7); int acc_[16]; \
            _Pragma("unroll") for (int i_ = 0; i_ < 16; ++i_) { int s_ = 0; _Pragma("unroll") for (int q_ = 0; q_ < 4; ++q_) s_ = sdot4i(buf[i_][q_], hh_[q_], s_); acc_[i_] = s_; } \
            treduce16<int, 1>(acc_, lane); \
            apart[tl_ * 128 + 8 * l7 + g] += acc_[0]; apart[tl_ * 128 + 8 * (8 + l7) + g] += acc_[1]; } while (0)
        CU_LOAD(bufA, hA, 0);
        for (int idx = 0; idx < 128; idx += 2) {
            CU_LOAD(bufB, hB, idx + 1);
            CU_COMP(bufA, hA, idx);
            if (idx + 2 < 128) CU_LOAD(bufA, hA, idx + 2);
            CU_COMP(bufB, hB, idx + 1);
        }
#undef CU_LOAD
#undef CU_COMP
        LDS_WAIT(); asm volatile("" ::: "memory");
        for (int it = 0; it < 8; ++it) { const int tl = tlw + it; const float shs = hsc[ch * 64 + tl];
            const int e0 = eg_e[tl * 128 + lane], e1 = eg_e[tl * 128 + 64 + lane];
            const float w0 = sw[tl * 128 + lane] * gelu_tanh_f((float)apart[tl * 128 + lane] * su[e0] * shs) * sv[e0];
            const float w1 = sw[tl * 128 + 64 + lane] * gelu_tanh_f((float)apart[tl * 128 + 64 + lane] * su[e1] * shs) * sv[e1];
            sw[tl * 128 + lane] = w0; sw[tl * 128 + 64 + lane] = w1;
            const float ws = wave_sum(w0 + w1);
            if (lane == 0) wtotl[tl] = ws; }
        LDS_WAIT(); asm volatile("" ::: "memory");
    }
    {
        int laneL = lane0; asm volatile("" : "+v"(laneL)); const int lane = laneL;
        const int g = lane >> 3, l7 = lane & 7;
        v4u bufA[16], bufB[16];
#define CV_LOAD(buf, idx_) do { const int cs_ = (idx_) >> 3, tl_ = tlw + ((idx_) & 7); const unsigned coff_ = (unsigned)(cs_ * 128 + l7 * 16); \
            _Pragma("unroll") for (int i_ = 0; i_ < 16; ++i_) { const unsigned e_ = (unsigned)eg_e[tl_ * 128 + 8 * i_ + g]; buf[i_] = *(const v4u*)(vt + (size_t)(e_ * 2048u + coff_)); } } while (0)
#define CV_COMP(buf, idx_) do { const int cs_ = (idx_) >> 3, tl_ = tlw + ((idx_) & 7); float y_[16]; \
            _Pragma("unroll") for (int q_ = 0; q_ < 16; ++q_) y_[q_] = 0.f; \
            _Pragma("unroll") for (int i_ = 0; i_ < 16; ++i_) { const float wr_ = sw[tl_ * 128 + 8 * i_ + g]; \
                _Pragma("unroll") for (int q_ = 0; q_ < 4; ++q_) fma_ub4(buf[i_][q_], wr_, y_[4 * q_], y_[4 * q_ + 1], y_[4 * q_ + 2], y_[4 * q_ + 3]); } \
            treduce16<float, 8>(y_, lane); \
            const float woff_ = 128.0f * wtotl[tl_]; bf16* yr_ = (bf16*)Ybuf + (size_t)(ch * 64 + tl_) * D + cs_ * 128 + l7 * 16 + g; \
            yr_[0] = (bf16)(pk2(y_[0] - woff_, 0.f) & 0xffffu); yr_[8] = (bf16)(pk2(y_[1] - woff_, 0.f) & 0xffffu); } while (0)
        CV_LOAD(bufA, 0);
        for (int idx = 0; idx < 128; idx += 2) {
            CV_LOAD(bufB, idx + 1);
            CV_COMP(bufA, idx);
            if (idx + 2 < 128) CV_LOAD(bufA, idx + 2);
            CV_COMP(bufB, idx + 1);
        }
#undef CV_LOAD
#undef CV_COMP
    }
    asm volatile("s_waitcnt vmcnt(0)" ::: "memory");
    __builtin_amdgcn_fence(__ATOMIC_ACQUIRE, "agent");
    asm volatile("s_waitcnt vmcnt(0)" ::: "memory");
    for (int it = 0; it < 8; ++it) { int laneT = lane0; asm volatile("" : "+v"(laneT)); const int t = ch * 64 + tlw + it;
        peer_tail(a, l, t, laneT, (const float*)((const bf16*)Ybuf + (size_t)t * D), mb, mbn, last); }
}

#endif

#ifndef MK_PER_PHASE
#define MK_PER_PHASE 0
#endif
__global__ void __launch_bounds__(NTHREADS, 2) mk_fwd(Args a) {
    extern __shared__ __attribute__((aligned(16))) unsigned char lds_raw[];
    LAS unsigned char* lds = (LAS unsigned char*)lds_raw;
    const int tid = threadIdx.x, lane = tid & 63, wave = __builtin_amdgcn_readfirstlane(tid >> 6), G = gridDim.x, bx = blockIdx.x;
    if (tid < 64) ((LAS unsigned*)(lds + LDSCTL_OFF))[tid] = 0u;
    __syncthreads();
    unsigned* ctl = (unsigned*)(a.ws + WS_CTL);
    XcdBarrier bar; bar.bar = ctl + CW_BAR; bar.x = 0; bar.st = nullptr;
    const bool use_bar = (a.ph_hi - a.ph_lo) > 1;
    if (use_bar) bar = xcd_barrier_post(ctl + CW_BAR, (volatile LAS unsigned*)(lds + LDSCTL_OFF));
    const int lo = a.ph_lo, hi = a.ph_hi;
#ifndef PH_MASK
#define PH_MASK 0x1ff
#endif
#define IN(k) (lo <= (k) && (k) < hi)
#define EN(b) ((PH_MASK >> (b)) & 1)
#ifndef REP_MASK
#define REP_MASK 0
#endif
#ifndef REP_EXTRA
#define REP_EXTRA 2
#endif
#define REPS(b) (1 + ((REP_MASK >> (b)) & 1) * REP_EXTRA)
#define REP_BEGIN(b) for (int rep_ = 0; rep_ < REPS(b); ++rep_) {
#define REP_END(b) if (rep_ + 1 < REPS(b)) xcd_barrier(bar); }
#define SEAM(k) do { if (IN((k) + 1)) xcd_barrier(bar); } while (0)
#define PHASE_IDS() int tidp = tid; asm volatile("" : "+v"(tidp)); const int lanep = tidp & 63, wavep = __builtin_amdgcn_readfirstlane(tidp >> 6); (void)lanep; (void)wavep
    if (EN(0) && IN(0)) { REP_BEGIN(0) PHASE_IDS(); ph_prologue_a(a, lds, tidp, lanep, wavep, bx, G); REP_END(0) SEAM(0); }
    if (EN(1) && IN(1)) { REP_BEGIN(1) PHASE_IDS(); ph_prologue_b(a, lds, tidp, lanep, wavep, bx, G); REP_END(1) SEAM(1); }
    for (int l = 0; l < NL; ++l) {
        const int pb = 2 + 7 * l;
        const float* mod = (const float*)(a.ws + WS_MOD);
        if (EN(2) && IN(pb + 0)) {
            REP_BEGIN(2) PHASE_IDS();
#if I8_IN
            pg8::Gemm g{(const pg8::bf16_t*)(a.ws + WS_H8), (const pg8::bf16_t*)(a.ws + WS_WIN8 + (size_t)l * NP * D), T, NP, D / 2}; pg8::StaticOrder S; S.init(T, NP, G, bx, WGM_IN, KROT(bx));
            pg8::EpiBf16PS E{(pg8::bf16_t*)(a.ws + WS_PROJ), NP, (const float*)(a.ws + WS_SAH), (const float*)(a.ws + WS_SB) + l * SBL};
            pg8::gemm_phase<pg8::EpiBf16PS, pg8::StaticOrder, true, true, true>(lds + RING_OFF, g, S, E, tidp);
#else
            pg8::Gemm g{(const pg8::bf16_t*)(a.ws + WS_H), (const pg8::bf16_t*)(a.ws + WS_WIN) + (size_t)l * INW * D, T, NP, D}; pg8::StaticOrder S; S.init(T, NP, G, bx, WGM_IN, KROT(bx));
            pg8::EpiBf16P E{(pg8::bf16_t*)(a.ws + WS_PROJ), NP};
            pg8::gemm_phase<pg8::EpiBf16P, pg8::StaticOrder, true, true>(lds + RING_OFF, g, S, E, tidp);
#endif
#ifndef GP_REP
#define GP_REP 1
#endif
            for (int gpr_ = 0; gpr_ < GP_REP; ++gpr_) for (int ch = bx; ch < NCHUNK; ch += G) gate_prep(a, l, lds, tidp, lanep, wavep, ch);
            REP_END(2) SEAM(pb + 0);
        }
        if (EN(3) && IN(pb + 1)) { REP_BEGIN(3) PHASE_IDS(); for (int un = bx; un < 256; un += G) gla_unit(a, lds, tidp, lanep, wavep, un); REP_END(3) SEAM(pb + 1); }
        if (EN(4) && IN(pb + 2)) { REP_BEGIN(4) PHASE_IDS(); for (int ch = bx; ch < NCHUNK; ch += G) mixpost_chunk(a, l, lanep, wavep, ch); REP_END(4) SEAM(pb + 2); }
        if (EN(5) && IN(pb + 3)) {
            REP_BEGIN(5) PHASE_IDS();
#if I8_OUT
            pg8::Gemm g{(const pg8::bf16_t*)(a.ws + WS_Y8), (const pg8::bf16_t*)(a.ws + WS_WOUT8 + (size_t)l * D * D), T, D, D / 2}; pg8::StaticOrder S; S.init(T, D, G, bx, WGM_OUT, KROT(bx));
#if RES16_X || RES16_Z
            pg8::EpiResidS16<(RES16_X != 0), (RES16_Z != 0)> E{(void*)(a.ws + WS_Z), (RES16_X || l > 0) ? (const void*)(a.ws + WS_X) : (const void*)a.in[0], mod + (size_t)l * NB * 6 * D + 2 * D, (const float*)(a.ws + WS_SAY), (const float*)(a.ws + WS_SB) + l * SBL + NP, ALPHA};
            pg8::gemm_phase<pg8::EpiResidS16<(RES16_X != 0), (RES16_Z != 0)>, pg8::StaticOrder, true, true, true>(lds + RING_OFF, g, S, E, tidp);
#else
            pg8::EpiResidS E{(float*)(a.ws + WS_Z), l == 0 ? a.in[0] : (const float*)(a.ws + WS_X), mod + (size_t)l * NB * 6 * D + 2 * D, (const float*)(a.ws + WS_SAY), (const float*)(a.ws + WS_SB) + l * SBL + NP, ALPHA};
            pg8::gemm_phase<pg8::EpiResidS, pg8::StaticOrder, true, true, true>(lds + RING_OFF, g, S, E, tidp);
#endif
#else
            pg8::Gemm g{(const pg8::bf16_t*)(a.ws + WS_Y), (const pg8::bf16_t*)(a.ws + WS_WOUT) + (size_t)l * D * D, T, D, D}; pg8::StaticOrder S; S.init(T, D, G, bx, WGM_OUT, KROT(bx));
            pg8::EpiResid E{(float*)(a.ws + WS_Z), l == 0 ? a.in[0] : (const float*)(a.ws + WS_X), mod + (size_t)l * NB * 6 * D + 2 * D, ALPHA};
            pg8::gemm_phase<pg8::EpiResid, pg8::StaticOrder, true, true>(lds + RING_OFF, g, S, E, tidp);
#endif
            REP_END(5) SEAM(pb + 3);
        }
        if (EN(6) && IN(pb + 4)) { REP_BEGIN(6) PHASE_IDS(); for (int ch = bx; ch < NCHUNK; ch += G) ln1_chunk(a, l, lds, lanep, wavep, ch); REP_END(6) SEAM(pb + 4); }
        if (EN(7) && IN(pb + 5)) {
            REP_BEGIN(7) PHASE_IDS();
#if I8_WQ
            pg8::Gemm g{(const pg8::bf16_t*)(a.ws + WS_H28), (const pg8::bf16_t*)(a.ws + WS_WQ8 + (size_t)l * D * D), T, D, D / 2}; pg8::StaticOrder S; S.init(T, D, G, bx, WGM_WQ, KROT(bx));
            pg8::EpiBf16PS E{(pg8::bf16_t*)(a.ws + WS_Q), D, (const float*)(a.ws + WS_HSC), (const float*)(a.ws + WS_SB) + l * SBL + NP + D};
            pg8::gemm_phase<pg8::EpiBf16PS, pg8::StaticOrder, true, true, true>(lds + RING_OFF, g, S, E, tidp);
#else
            pg8::Gemm g{(const pg8::bf16_t*)(a.ws + WS_H2), (const pg8::bf16_t*)(a.ws + WS_WQ) + (size_t)l * D * D, T, D, D}; pg8::StaticOrder S; S.init(T, D, G, bx, WGM_WQ, KROT(bx));
            pg8::EpiBf16P E{(pg8::bf16_t*)(a.ws + WS_Q), D};
            pg8::gemm_phase<pg8::EpiBf16P, pg8::StaticOrder, true, true>(lds + RING_OFF, g, S, E, tidp);
#endif
            REP_END(7) SEAM(pb + 5);
        }
#ifndef PEER_DBG
#define PEER_DBG 0
#endif
#ifndef PE_REP_R
#define PE_REP_R 1
#endif
#ifndef L2PROBE
#define L2PROBE 0
#endif
        if (EN(8) && IN(pb + 6)) {
            REP_BEGIN(8)
            for (int ch = bx; ch < NCHUNK; ch += G) { for (int repr_ = 0; repr_ < PE_REP_R; ++repr_) { PHASE_IDS(); peer_retrieve(a, l, lds, lanep, wavep, ch); __syncthreads(); } __syncthreads(); { PHASE_IDS(); peer_experts(a, l, lds, lanep, wavep, ch); } __syncthreads(); }
            REP_END(8) SEAM(pb + 6);
        }
    }
#undef IN
#undef SEAM
}

extern "C" void kernel_launch(void* const* d_in, const int* in_sizes, int n_in, void* d_out, int out_size, void* d_ws, size_t ws_size, hipStream_t stream) {
    static int grid = 0;
    if (grid == 0) {
        if (n_in != 19 || in_sizes[0] != T * D || out_size != T * D || ws_size < WS_END) { fprintf(stderr, "kernel_launch: unexpected shapes / workspace (%d inputs, ws %zu); nothing launched\n", n_in, ws_size); grid = -1; return; }
        int dev = 0, cus = 0, per_cu = 0;
        if (hipGetDevice(&dev) != hipSuccess || hipDeviceGetAttribute(&cus, hipDeviceAttributeMultiprocessorCount, dev) != hipSuccess) { grid = -1; return; }
        if (hipFuncSetAttribute((const void*)mk_fwd, hipFuncAttributeMaxDynamicSharedMemorySize, LDS_BYTES) != hipSuccess) { fprintf(stderr, "kernel_launch: hipFuncSetAttribute failed\n"); grid = -1; return; }
        if (hipOccupancyMaxActiveBlocksPerMultiprocessor(&per_cu, (const void*)mk_fwd, NTHREADS, LDS_BYTES) != hipSuccess || per_cu < 1) fprintf(stderr, "kernel_launch: occupancy query reports %d\n", per_cu);
        (void)hipGetLastError();
        grid = cus;
    }
    if (grid < 0) return;
    if (hipMemsetAsync((char*)d_ws + WS_CTL, 0, CTL_ZERO_BYTES, stream) != hipSuccess) return;
    Args a{};
    for (int i = 0; i < 19; ++i) a.in[i] = (const float*)d_in[i];
    a.out = (float*)d_out; a.ws = (unsigned char*)d_ws;
#if MK_PER_PHASE
    for (int p = 0; p < NPHASES; ++p) { a.ph_lo = p; a.ph_hi = p + 1; hipLaunchKernelGGL(mk_fwd, dim3(grid), dim3(NTHREADS), LDS_BYTES, stream, a); }
#else
    a.ph_lo = 0; a.ph_hi = NPHASES;
    hipLaunchKernelGGL(mk_fwd, dim3(grid), dim3(NTHREADS), LDS_BYTES, stream, a);
#endif
}
```

```cpp
#include <hip/hip_runtime.h>
#include <cstdio>
#include <cstdint>
namespace pg8 {
#define PG8_LAS __attribute__((address_space(3)))
typedef unsigned short bf16_t;
typedef short bf16x8 __attribute__((ext_vector_type(8)));
typedef float f32x4 __attribute__((ext_vector_type(4)));
typedef unsigned u32x4 __attribute__((ext_vector_type(4)));
typedef int i32x4 __attribute__((ext_vector_type(4)));
constexpr int BM = 256, BK = 64, HALF = 128, HTB = HALF * BK * 2  , STAGE_BYTES = 8 * HTB, NXCD = 8, WGM = 8;

__host__ __device__ __forceinline__ int lds_byte(int r, int c) { const int st = (r >> 4) * 2 + (c >> 5), rr = r & 15, cc = c & 31, ob = rr * 64 + cc * 2; return st * 1024 + (ob ^ (((ob >> 9) & 1) << 5)); }
__host__ __device__ __forceinline__ void stage_rc(int b, int& R, int& C) { const int st = b / 1024, sb = b % 1024, swz = sb ^ (((sb >> 9) & 1) << 5); R = (st >> 1) * 16 + swz / 64; C = (st & 1) * 32 + (swz % 64) / 2; }
__host__ __device__ __forceinline__ int perm32(int rho) { const int n = rho >> 4, i = rho & 15; return 8 * (i >> 2) + 4 * n + (i & 3); }

struct Unit { int pm, pn; };
struct Gemm { const bf16_t* A; const bf16_t* Bt; int M, N, K; };

struct StaticOrder {
    int nM, nN, nwg, G, c, wgm, krot;
    __host__ __device__ void init(int M, int N, int G_, int c_, int wgm_ = WGM, int krot_ = 0) { nM = M / BM; nN = N / BM; nwg = nM * nN; G = G_; c = c_; wgm = wgm_; krot = krot_; }
    __host__ __device__ bool next(int i, Unit& u) const {
        const long L = (long)i * G + c; if (L >= nwg) return false;
        int wgid = (int)L; { const int q = nwg / NXCD, r = nwg % NXCD, xcd = wgid % NXCD, off = wgid / NXCD; wgid = (xcd < r ? xcd * (q + 1) : r * (q + 1) + (xcd - r) * q) + off; }
        const int nig = wgm * nN, gid = wgid / nig, fm = gid * wgm, gsz = (nM - fm) < wgm ? (nM - fm) : wgm;
        u.pm = fm + ((wgid % nig) % gsz); u.pn = (wgid % nig) / gsz; return true;
    }
    __device__ __forceinline__ void a_ready(const Unit&) const {}
    __device__ __forceinline__ void done(const Unit&) const {}
};
typedef __bf16 bf16x2_t __attribute__((ext_vector_type(2)));
__device__ __forceinline__ unsigned cvt_pk_bf16(float lo, float hi) { bf16x2_t r; r.x = (__bf16)lo; r.y = (__bf16)hi; return __builtin_bit_cast(unsigned, r); }
struct EpiBf16P {
    static constexpr bool PERM = true, AFTER_DRAIN = false;
    bf16_t* O; int ldc;
    __device__ __forceinline__ void operator()(const f32x4 (&acc)[2][2][4][2], const Unit& u, int wr, int wc, int fr, int fq) const {
        const int row0 = u.pm * BM + wr * 64 + fr, col0 = u.pn * BM + wc * 32 + 8 * fq;
#pragma unroll
        for (int ai = 0; ai < 2; ++ai)
#pragma unroll
            for (int m = 0; m < 4; ++m) { bf16_t* rowp = O + (size_t)(row0 + ai * HALF + m * 16) * ldc + col0;
#pragma unroll
                for (int bj = 0; bj < 2; ++bj) { const f32x4 v0 = acc[ai][bj][m][0], v1 = acc[ai][bj][m][1];
                    u32x4 w; w.x = cvt_pk_bf16(v0[0], v0[1]); w.y = cvt_pk_bf16(v0[2], v0[3]); w.z = cvt_pk_bf16(v1[0], v1[1]); w.w = cvt_pk_bf16(v1[2], v1[3]);
                    *(u32x4*)(rowp + bj * HALF) = w; } }
    }
};
struct EpiResid {
    static constexpr bool PERM = false, AFTER_DRAIN = false;
    float* Z; const float* X; const float* gate; float alpha;
    __device__ __forceinline__ void operator()(const f32x4 (&acc)[2][2][4][2], const Unit& u, int wr, int wc, int fr, int fq) const {
        const int row0 = u.pm * BM + wr * 64 + fr, col0 = u.pn * BM + wc * 32 + 4 * fq;
        const float* gb = gate + (size_t)(u.pm >> 3) * (6 * 2048) + col0;
        f32x4 gv[2][2];
#pragma unroll
        for (int bj = 0; bj < 2; ++bj)
#pragma unroll
            for (int n = 0; n < 2; ++n) gv[bj][n] = *(const f32x4*)(gb + bj * HALF + n * 16) + 1.0f;
#pragma unroll
        for (int ai = 0; ai < 2; ++ai)
#pragma unroll
            for (int m = 0; m < 4; ++m) { const size_t off = (size_t)(row0 + ai * HALF + m * 16) * 2048 + col0;
#pragma unroll
                for (int bj = 0; bj < 2; ++bj)
#pragma unroll
                    for (int n = 0; n < 2; ++n) { const f32x4 xv = *(const f32x4*)(X + off + bj * HALF + n * 16);
                        *(f32x4*)(Z + off + bj * HALF + n * 16) = xv * alpha + gv[bj][n] * acc[ai][bj][m][n]; }
                asm volatile("" ::: "memory"); }
    }
};
#ifndef PG8_NT
#define PG8_NT 0
#endif
#if PG8_NT
#define PG8_ST(TY, p, v) __builtin_nontemporal_store((v), (TY*)(p))
#else
#define PG8_ST(TY, p, v) (*(TY*)(p) = (v))
#endif
__device__ __forceinline__ f32x4 acc_i2f(const f32x4 v) { const i32x4 iv = __builtin_bit_cast(i32x4, v); return __builtin_convertvector(iv, f32x4); }
struct EpiBf16PS {
    static constexpr bool PERM = true, AFTER_DRAIN = false;
    bf16_t* O; int ldc; const float* sa; const float* sb;
    __device__ __forceinline__ void operator()(const f32x4 (&acc)[2][2][4][2], const Unit& u, int wr, int wc, int fr, int fq) const {
        const int row0 = u.pm * BM + wr * 64 + fr, col0 = u.pn * BM + wc * 32 + 8 * fq;
        f32x4 sbv[2][2];
#pragma unroll
        for (int bj = 0; bj < 2; ++bj)
#pragma unroll
            for (int n = 0; n < 2; ++n) sbv[bj][n] = *(const f32x4*)(sb + col0 + bj * HALF + 4 * n);
#pragma unroll
        for (int ai = 0; ai < 2; ++ai)
#pragma unroll
            for (int m = 0; m < 4; ++m) { const int row = row0 + ai * HALF + m * 16; bf16_t* rowp = O + (size_t)row * ldc + col0; const float sar = sa[row];
#pragma unroll
                for (int bj = 0; bj < 2; ++bj) { const f32x4 v0 = acc_i2f(acc[ai][bj][m][0]) * (sbv[bj][0] * sar), v1 = acc_i2f(acc[ai][bj][m][1]) * (sbv[bj][1] * sar);
                    u32x4 w; w.x = cvt_pk_bf16(v0[0], v0[1]); w.y = cvt_pk_bf16(v0[2], v0[3]); w.z = cvt_pk_bf16(v1[0], v1[1]); w.w = cvt_pk_bf16(v1[2], v1[3]);
                    PG8_ST(u32x4, rowp + bj * HALF, w); } }
    }
};
struct EpiResidS {
    static constexpr bool PERM = false, AFTER_DRAIN = false;
    float* Z; const float* X; const float* gate; const float* sa; const float* sb; float alpha;
    __device__ __forceinline__ void operator()(const f32x4 (&acc)[2][2][4][2], const Unit& u, int wr, int wc, int fr, int fq) const {
        const int row0 = u.pm * BM + wr * 64 + fr, col0 = u.pn * BM + wc * 32 + 4 * fq;
        const float* gb = gate + (size_t)(u.pm >> 3) * (6 * 2048) + col0;
        f32x4 gv[2][2];
#pragma unroll
        for (int bj = 0; bj < 2; ++bj)
#pragma unroll
            for (int n = 0; n < 2; ++n) gv[bj][n] = (*(const f32x4*)(gb + bj * HALF + n * 16) + 1.0f) * *(const f32x4*)(sb + col0 + bj * HALF + n * 16);
#pragma unroll
        for (int ai = 0; ai < 2; ++ai)
#pragma unroll
            for (int m = 0; m < 4; ++m) { const int row = row0 + ai * HALF + m * 16; const size_t off = (size_t)row * 2048 + col0; const float sar = sa[row];
#pragma unroll
                for (int bj = 0; bj < 2; ++bj)
#pragma unroll
                    for (int n = 0; n < 2; ++n) { const f32x4 xv = *(const f32x4*)(X + off + bj * HALF + n * 16);
                        PG8_ST(f32x4, Z + off + bj * HALF + n * 16, xv * alpha + (gv[bj][n] * sar) * acc_i2f(acc[ai][bj][m][n])); }
                asm volatile("" ::: "memory"); }
    }
};
template <bool XB, bool ZB> struct EpiResidS16 {
    static constexpr bool PERM = true, AFTER_DRAIN = false;
    void* Z; const void* X; const float* gate; const float* sa; const float* sb; float alpha;
    __device__ __forceinline__ void operator()(const f32x4 (&acc)[2][2][4][2], const Unit& u, int wr, int wc, int fr, int fq) const {
        const int row0 = u.pm * BM + wr * 64 + fr, col0 = u.pn * BM + wc * 32 + 8 * fq;
        const float* gb = gate + (size_t)(u.pm >> 3) * (6 * 2048) + col0;
        f32x4 gv[2][2];
#pragma unroll
        for (int bj = 0; bj < 2; ++bj)
#pragma unroll
            for (int n = 0; n < 2; ++n) gv[bj][n] = (*(const f32x4*)(gb + bj * HALF + 4 * n) + 1.0f) * *(const f32x4*)(sb + col0 + bj * HALF + 4 * n);
#pragma unroll
        for (int ai = 0; ai < 2; ++ai)
#pragma unroll
            for (int m = 0; m < 4; ++m) { const int row = row0 + ai * HALF + m * 16; const size_t off = (size_t)row * 2048 + col0; const float sar = sa[row];
#pragma unroll
                for (int bj = 0; bj < 2; ++bj) { f32x4 x0, x1;
                    if constexpr (XB) { const u32x4 xw = *(const u32x4*)((const bf16_t*)X + off + bj * HALF);
                        x0 = (f32x4){__uint_as_float(xw.x << 16), __uint_as_float(xw.x & 0xffff0000u), __uint_as_float(xw.y << 16), __uint_as_float(xw.y & 0xffff0000u)};
                        x1 = (f32x4){__uint_as_float(xw.z << 16), __uint_as_float(xw.z & 0xffff0000u), __uint_as_float(xw.w << 16), __uint_as_float(xw.w & 0xffff0000u)}; }
                    else { x0 = *(const f32x4*)((const float*)X + off + bj * HALF); x1 = *(const f32x4*)((const float*)X + off + bj * HALF + 4); }
                    const f32x4 v0 = x0 * alpha + (gv[bj][0] * sar) * acc_i2f(acc[ai][bj][m][0]), v1 = x1 * alpha + (gv[bj][1] * sar) * acc_i2f(acc[ai][bj][m][1]);
                    if constexpr (ZB) { u32x4 w; w.x = cvt_pk_bf16(v0[0], v0[1]); w.y = cvt_pk_bf16(v0[2], v0[3]); w.z = cvt_pk_bf16(v1[0], v1[1]); w.w = cvt_pk_bf16(v1[2], v1[3]);
                        PG8_ST(u32x4, (bf16_t*)Z + off + bj * HALF, w); }
                    else { PG8_ST(f32x4, (float*)Z + off + bj * HALF, v0); PG8_ST(f32x4, (float*)Z + off + bj * HALF + 4, v1); } }
                asm volatile("" ::: "memory"); }
    }
};
template <class Epi, class Sched, bool ALIGN_EPI = false, bool SP2 = false, bool I8 = false>
__device__ __forceinline__ void gemm_phase(PG8_LAS unsigned char* lds, const Gemm g, const Sched& S, const Epi& E, const int tid_in) {
    const int tid = tid_in, wid = __builtin_amdgcn_readfirstlane(tid >> 6), lane = tid & 63, wr = wid >> 2, wc = wid & 3, fr = lane & 15, fq = lane >> 4;
    const int K = g.K, nt = K / BK;
    const int krot = ((nt & (nt - 1)) == 0) ? (S.krot & (nt - 1)) : 0;
#define PG8_KOFS(t) ((size_t)(((t) + krot) & (nt - 1)) * kstep)
    unsigned voffA[2], voffB[2];
#pragma unroll
    for (int i = 0; i < 2; ++i) { int R, C; stage_rc(tid * 16 + i * 8192, R, C); const int Rb = Epi::PERM ? ((R & ~31) + perm32(R & 31)) : R;
        voffA[i] = (unsigned)(R * K + C) * 2u; voffB[i] = (unsigned)(Rb * K + C) * 2u; }
    const size_t kstep = (size_t)(BK * 2);
    const size_t hstep = (size_t)HALF * K * 2;
    const size_t tstep = 2 * hstep;
    const unsigned ldsw = (unsigned)wid * 1024u;
    const int aoff = lds_byte(wr * 64 + fr, fq * 8), boff = lds_byte(wc * 32 + fr, fq * 8);
#define PG8_SA(b, h) (((b) * 2 + (h)) * HTB)
#define PG8_SB(b, h) ((4 + (b) * 2 + (h)) * HTB)
#define PG8_STAGE(bufoff, gbase, voff) do { _Pragma("unroll") for (int _i = 0; _i < 2; ++_i) \
        __builtin_amdgcn_global_load_lds((const unsigned*)((const char*)(gbase) + (voff)[_i]), (PG8_LAS unsigned*)(lds + (bufoff) + ldsw + _i * 8192), 16, 0, 0); } while (0)
#define PG8_LDA(dst, b, h) do { _Pragma("unroll") for (int m = 0; m < 4; ++m) _Pragma("unroll") for (int k = 0; k < 2; ++k) dst[m][k] = *(const PG8_LAS bf16x8*)(lds + PG8_SA(b, h) + aoff + m * 2048 + k * 1024); } while (0)
#define PG8_LDB(dst, b, h) do { _Pragma("unroll") for (int n = 0; n < 2; ++n) _Pragma("unroll") for (int k = 0; k < 2; ++k) dst[n][k] = *(const PG8_LAS bf16x8*)(lds + PG8_SB(b, h) + boff + n * 2048 + k * 1024); } while (0)
#define PG8_MMA(ai, bj, At, Bt) do { __builtin_amdgcn_s_setprio(1); _Pragma("unroll") for (int m = 0; m < 4; ++m) _Pragma("unroll") for (int n = 0; n < 2; ++n) _Pragma("unroll") for (int k = 0; k < 2; ++k) \
        { if constexpr (I8) acc[ai][bj][m][n] = __builtin_bit_cast(f32x4, __builtin_amdgcn_mfma_i32_16x16x64_i8(__builtin_bit_cast(i32x4, Bt[n][k]), __builtin_bit_cast(i32x4, At[m][k]), __builtin_bit_cast(i32x4, acc[ai][bj][m][n]), 0, 0, 0)); \
          else acc[ai][bj][m][n] = __builtin_amdgcn_mfma_f32_16x16x32_bf16(Bt[n][k], At[m][k], acc[ai][bj][m][n], 0, 0, 0); } __builtin_amdgcn_s_setprio(0); } while (0)
#define PG8_WAIT_V(n) asm volatile("s_waitcnt vmcnt(" #n ")" ::: "memory")
#define PG8_WAIT_L(n) asm volatile("s_waitcnt lgkmcnt(" #n ")" ::: "memory")
#define PG8_BAR __builtin_amdgcn_s_barrier()
#define PG8_SCHED __builtin_amdgcn_sched_barrier(0)
    Unit cur, nxt; int ui = 0;
    if (!S.next(0, cur)) return;
    f32x4 acc[2][2][4][2];
#pragma unroll
    for (int a = 0; a < 2; ++a)
#pragma unroll
        for (int b = 0; b < 2; ++b)
#pragma unroll
            for (int m = 0; m < 4; ++m)
#pragma unroll
                for (int n = 0; n < 2; ++n) acc[a][b][m][n] = (f32x4){0.f, 0.f, 0.f, 0.f};
    bf16x8 At[4][2], B0[2][2], B1[2][2];
    const char* cA = (const char*)g.A + (size_t)cur.pm * tstep; const char* cB = (const char*)g.Bt + (size_t)cur.pn * tstep;
    S.a_ready(cur);
    if constexpr (SP2) {
        PG8_STAGE(PG8_SB(0, 0), cB + PG8_KOFS(0), voffB); PG8_STAGE(PG8_SB(0, 1), cB + hstep + PG8_KOFS(0), voffB); PG8_STAGE(PG8_SA(0, 0), cA + PG8_KOFS(0), voffA); PG8_STAGE(PG8_SA(0, 1), cA + hstep + PG8_KOFS(0), voffA);
        if (wr == 1) PG8_BAR;
        PG8_WAIT_V(2); PG8_BAR;
        PG8_STAGE(PG8_SB(1, 0), cB + PG8_KOFS(1), voffB); PG8_STAGE(PG8_SA(1, 0), cA + PG8_KOFS(1), voffA); PG8_STAGE(PG8_SB(1, 1), cB + hstep + PG8_KOFS(1), voffB);
        PG8_WAIT_V(6); PG8_BAR;
    } else {
        PG8_STAGE(PG8_SB(0, 0), cB + PG8_KOFS(0), voffB); PG8_STAGE(PG8_SA(0, 0), cA + PG8_KOFS(0), voffA); PG8_STAGE(PG8_SB(0, 1), cB + hstep + PG8_KOFS(0), voffB); PG8_STAGE(PG8_SA(0, 1), cA + hstep + PG8_KOFS(0), voffA);
        if (wr == 1) PG8_BAR;
        PG8_WAIT_V(4); PG8_BAR;
        PG8_STAGE(PG8_SB(1, 0), cB + PG8_KOFS(1), voffB); PG8_STAGE(PG8_SA(1, 0), cA + PG8_KOFS(1), voffA); PG8_STAGE(PG8_SB(1, 1), cB + hstep + PG8_KOFS(1), voffB);
        PG8_WAIT_V(6); PG8_BAR;
    }
    for (;;) {
        const bool has_next = S.next(ui + 1, nxt);
        const char* nA = has_next ? (const char*)g.A + (size_t)nxt.pm * tstep : cA; const char* nB = has_next ? (const char*)g.Bt + (size_t)nxt.pn * tstep : cB;
#ifdef PG8_KREP
        for (int kr_ = 0; kr_ < PG8_KREP; ++kr_) {
        if (kr_) {
#pragma unroll
        for (int a = 0; a < 2; ++a)
#pragma unroll
            for (int b = 0; b < 2; ++b)
#pragma unroll
                for (int m = 0; m < 4; ++m)
#pragma unroll
                    for (int n = 0; n < 2; ++n) acc[a][b][m][n] = (f32x4){0.f, 0.f, 0.f, 0.f}; }
        const char* nA_ = (kr_ + 1 < PG8_KREP) ? cA : nA; const char* nB_ = (kr_ + 1 < PG8_KREP) ? cB : nB;
#else
        const char* nA_ = nA; const char* nB_ = nB;
#endif
        for (int t = 0; t < nt; t += 2) {
            const bool last = (t == nt - 2);
            const char* a1 = cA + PG8_KOFS(t + 1);
            const char* a2 = (last ? nA_ : cA) + PG8_KOFS(t + 2); const char* b2 = (last ? nB_ : cB) + PG8_KOFS(t + 2);
            const char* a3 = (last ? nA_ : cA) + PG8_KOFS(t + 3); const char* b3 = (last ? nB_ : cB) + PG8_KOFS(t + 3);
            if (last && has_next) S.a_ready(nxt);
            if constexpr (SP2) {
            PG8_LDB(B0, 0, 0); PG8_LDB(B1, 0, 1); PG8_SCHED; PG8_LDA(At, 0, 0); PG8_STAGE(PG8_SA(1, 1), a1 + hstep, voffA);
            PG8_WAIT_V(8); PG8_WAIT_L(0); PG8_BAR; PG8_MMA(0, 0, At, B0); PG8_MMA(0, 1, At, B1); PG8_BAR; PG8_SCHED;
            PG8_LDA(At, 0, 1); PG8_STAGE(PG8_SB(0, 0), b2, voffB); PG8_STAGE(PG8_SB(0, 1), b2 + hstep, voffB); PG8_STAGE(PG8_SA(0, 0), a2, voffA);
            PG8_WAIT_V(8); PG8_WAIT_L(0); PG8_BAR; PG8_MMA(1, 0, At, B0); PG8_MMA(1, 1, At, B1); PG8_BAR; PG8_SCHED;
            PG8_LDB(B0, 1, 0); PG8_LDB(B1, 1, 1); PG8_SCHED; PG8_LDA(At, 1, 0); PG8_STAGE(PG8_SA(0, 1), a2 + hstep, voffA);
            PG8_WAIT_V(8); PG8_WAIT_L(0); PG8_BAR; PG8_MMA(0, 0, At, B0); PG8_MMA(0, 1, At, B1); PG8_BAR; PG8_SCHED;
            PG8_LDA(At, 1, 1); PG8_STAGE(PG8_SB(1, 0), b3, voffB); PG8_STAGE(PG8_SB(1, 1), b3 + hstep, voffB); PG8_STAGE(PG8_SA(1, 0), a3, voffA);
            PG8_WAIT_V(8); PG8_WAIT_L(0); PG8_BAR; PG8_MMA(1, 0, At, B0); PG8_MMA(1, 1, At, B1); PG8_BAR; PG8_SCHED;
            } else {
            PG8_LDB(B0, 0, 0); PG8_SCHED; PG8_LDA(At, 0, 0); PG8_STAGE(PG8_SA(1, 1), a1 + hstep, voffA);
            PG8_WAIT_L(8); PG8_BAR; PG8_WAIT_L(0); PG8_MMA(0, 0, At, B0); PG8_BAR; PG8_SCHED;
            PG8_LDB(B1, 0, 1); PG8_STAGE(PG8_SB(0, 0), b2, voffB);
            PG8_BAR; PG8_WAIT_L(0); PG8_MMA(0, 1, At, B1); PG8_BAR;
            PG8_LDA(At, 0, 1); PG8_STAGE(PG8_SA(0, 0), a2, voffA);
            PG8_BAR; PG8_WAIT_L(0); PG8_MMA(1, 0, At, B0); PG8_BAR; PG8_SCHED;
            PG8_STAGE(PG8_SB(0, 1), b2 + hstep, voffB);
            PG8_WAIT_V(6); PG8_BAR; PG8_MMA(1, 1, At, B1); PG8_BAR;
            PG8_LDB(B0, 1, 0); PG8_SCHED; PG8_LDA(At, 1, 0); PG8_STAGE(PG8_SA(0, 1), a2 + hstep, voffA);
            PG8_WAIT_L(8); PG8_BAR; PG8_WAIT_L(0); PG8_MMA(0, 0, At, B0); PG8_BAR; PG8_SCHED;
            PG8_LDB(B1, 1, 1); PG8_STAGE(PG8_SB(1, 0), b3, voffB);
            PG8_BAR; PG8_WAIT_L(0); PG8_MMA(0, 1, At, B1); PG8_BAR;
            PG8_LDA(At, 1, 1); PG8_STAGE(PG8_SA(1, 0), a3, voffA);
            PG8_BAR; PG8_WAIT_L(0); PG8_MMA(1, 0, At, B0); PG8_BAR; PG8_SCHED;
            PG8_STAGE(PG8_SB(1, 1), b3 + hstep, voffB);
            PG8_WAIT_V(6); PG8_BAR; PG8_MMA(1, 1, At, B1); PG8_BAR;
            }
        }
#ifdef PG8_KREP
        }
#endif
        if constexpr (ALIGN_EPI) { if (wr == 0) PG8_BAR; }
#ifdef PG8_EPI2
        if constexpr (!Epi::AFTER_DRAIN) { E(acc, cur, wr, wc, fr, fq); asm volatile("" ::: "memory"); }
#endif
        if constexpr (!Epi::AFTER_DRAIN) { E(acc, cur, wr, wc, fr, fq); S.done(cur); }
        if (!has_next) break;
#pragma unroll
        for (int a = 0; a < 2; ++a)
#pragma unroll
            for (int b = 0; b < 2; ++b)
#pragma unroll
                for (int m = 0; m < 4; ++m)
#pragma unroll
                    for (int n = 0; n < 2; ++n) acc[a][b][m][n] = (f32x4){0.f, 0.f, 0.f, 0.f};
        cur = nxt; cA = nA; cB = nB; ++ui;
        if constexpr (ALIGN_EPI) { if (wr == 1) PG8_BAR; }
    }
    PG8_WAIT_V(0);
    if constexpr (!ALIGN_EPI) { if (wr == 0) PG8_BAR; }
    PG8_BAR;
    if constexpr (Epi::AFTER_DRAIN) { E.fused(acc, cur, wr, wc, fr, fq, lds, wid, lane); S.done(cur); }
#undef PG8_SA
#undef PG8_SB
#undef PG8_STAGE
#undef PG8_LDA
#undef PG8_LDB
#undef PG8_MMA
#undef PG8_WAIT_V
#undef PG8_WAIT_L
#undef PG8_BAR
#undef PG8_SCHED
#undef PG8_KOFS
}
}
#define XB_TMO      128
#define XB_XCNT(j)  (256  + 64 * (j))
#define XB_XSUB(j)  (1280 + 64 * (j))
#define XB_XGEN(j)  (2304 + 64 * (j))
#define XB_TOP      3328
#define XB_TOPGEN   3392
#define XCD_BAR_WORDS 3456
#define XB_SPIN_CAP (1u << 18)
#define LAS __attribute__((address_space(3)))

__device__ __forceinline__ unsigned xb_ld(unsigned* p)              { return __hip_atomic_load(p, __ATOMIC_RELAXED, __HIP_MEMORY_SCOPE_AGENT); }
__device__ __forceinline__ unsigned xb_add(unsigned* p, unsigned v) { return __hip_atomic_fetch_add(p, v, __ATOMIC_RELAXED, __HIP_MEMORY_SCOPE_AGENT); }
__device__ __forceinline__ unsigned xb_xcc_id() { return (unsigned)__builtin_amdgcn_s_getreg((3 << 11) | 20) & 0xFu; }
#define XB_SPIN(cond, bar) do { unsigned _sp = 0; while (cond) { __builtin_amdgcn_s_sleep(1); \
    if ((++_sp & 255u) == 0u) { if (xb_ld(&(bar)[XB_TMO])) break; if (_sp > XB_SPIN_CAP) { atomicAdd(&(bar)[XB_TMO], 1u); break; } } } } while (0)

struct XcdBarrier {
    unsigned* bar; unsigned x;
    volatile LAS unsigned* st;
};

__device__ __forceinline__ XcdBarrier xcd_barrier_post(unsigned* bar, volatile LAS unsigned* st) {
    XcdBarrier b; b.bar = bar; b.x = xb_xcc_id(); b.st = st;
    if (threadIdx.x == 0) (void)xb_add(&bar[XB_XCNT(b.x)], 1u);
    return b;
}
__device__ __forceinline__ void xcd_barrier_complete(unsigned* bar, unsigned x, unsigned& nloc, unsigned& nx) {
    const unsigned G = gridDim.x * gridDim.y * gridDim.z;
    unsigned sum, cnt, mine, sp = 0u;
    for (;;) {
        sum = 0u; cnt = 0u; mine = 0u;
#pragma unroll
        for (unsigned j = 0; j < 16; ++j) { const unsigned c = xb_ld(&bar[XB_XCNT(j)]); sum += c; cnt += (c > 0u) ? 1u : 0u; mine = (j == x) ? c : mine; }
        if (sum == G) break;
        __builtin_amdgcn_s_sleep(1);
        if ((++sp & 255u) == 0u) { if (xb_ld(&bar[XB_TMO])) break; if (sp > XB_SPIN_CAP) { atomicAdd(&bar[XB_TMO], 1u); break; } }
    }
    nloc = mine > 0u ? mine : 1u; nx = cnt > 0u ? cnt : 1u;
}

__device__ __forceinline__ void xcd_barrier(const XcdBarrier& b) {
    asm volatile("s_waitcnt vmcnt(0)" ::: "memory");
    __syncthreads();
    if (threadIdx.x == 0) {
        unsigned* bar = b.bar;
        __builtin_amdgcn_s_waitcnt(0);
        unsigned nloc = b.st[0], nx = b.st[1];
        if (nloc == 0u) { xcd_barrier_complete(bar, b.x, nloc, nx); b.st[0] = nloc; b.st[1] = nx; }
        const unsigned old = xb_add(&bar[XB_XSUB(b.x)], 1u);
        const unsigned gen = old / nloc;
        if (old + 1u == (gen + 1u) * nloc) {
            __builtin_amdgcn_fence(__ATOMIC_RELEASE, "agent");
            asm volatile("s_waitcnt vmcnt(0)" ::: "memory");
            const unsigned og = xb_add(&bar[XB_TOP], 1u);
            const unsigned tg = og / nx;
            if (og + 1u == (tg + 1u) * nx) xb_add(&bar[XB_TOPGEN], 1u);
            else XB_SPIN(xb_ld(&bar[XB_TOPGEN]) == tg, bar);
            __builtin_amdgcn_fence(__ATOMIC_ACQUIRE, "agent");
            xb_add(&bar[XB_XGEN(b.x)], 1u);
            asm volatile("s_waitcnt vmcnt(0)" ::: "memory");
        } else {
            XB_SPIN(xb_ld(&bar[XB_XGEN(b.x)]) == gen, bar);
            __builtin_amdgcn_fence(__ATOMIC_ACQUIRE, "agent");
            asm volatile("s_waitcnt vmcnt(0)" ::: "memory");
        }
    }
    __syncthreads();
}
constexpr int D = 2048, NB = 8, SEQ = 2048, NL = 4, T = NB * SEQ;
constexpr int NCH = SEQ / 64, NCHUNK = T / 64;
constexpr int GKW = 512, RANK = 16;
constexpr int INW = 6160, NP = 6144;
constexpr int NE = 16384;
constexpr float ALPHA = 1.6817928305074290f, EPS = 1e-5f;
constexpr int PQ = 0, PK = 512, PV = 1024, PR = 2048, PCB = 3072, PCC = 4096, PCH = 5120;
constexpr int NWAVES = 8, NTHREADS = 512;
#ifndef WGM_IN
#define WGM_IN 4
#endif
#ifndef WGM_OUT
#define WGM_OUT 4
#endif
#ifndef WGM_WQ
#define WGM_WQ 4
#endif
#ifndef TAB4
#define TAB4 1
#endif
constexpr int NPHASES = 2 + 7 * NL;

constexpr size_t MiB = 1u << 20;
constexpr size_t WS_CTL = 0, CTL_ZERO_BYTES = 1 * MiB;
constexpr size_t WS_MOD = 1 * MiB, WS_PART = 3 * MiB, WS_KEYS = 15 * MiB, WS_DTOT = 17 * MiB, WS_WIN = 18 * MiB, WS_WOUT = 115 * MiB, WS_WQ = 147 * MiB;
constexpr size_t WS_UT = 179 * MiB, WS_VT = 435 * MiB, WS_H = 691 * MiB, WS_PROJ = 755 * MiB, WS_E = 947 * MiB, WS_OGLA = 979 * MiB, WS_Y = 1043 * MiB;
constexpr size_t WS_Z = 1107 * MiB, WS_X1 = 1235 * MiB, WS_X = 1363 * MiB, WS_Q = 1491 * MiB, WS_H2 = 1555 * MiB, WS_HQ8 = 1619 * MiB, WS_H8 = 1659 * MiB, WS_WIN8 = 1691 * MiB, WS_WOUT8 = 1739 * MiB, WS_WQ8 = 1755 * MiB, WS_Y8 = 1771 * MiB, WS_H28 = 1803 * MiB, WS_END = 1835 * MiB;
constexpr size_t WS_SU = 17 * MiB + 512 * 1024, WS_SV = 17 * MiB + 768 * 1024, WS_HSC = 2 * MiB + 640 * 1024;
static_assert(WS_WIN + (size_t)NL * INW * D * 2 <= WS_WOUT && WS_PART + (size_t)NL * 8 * NB * 6 * D * 4 <= WS_KEYS && WS_MOD + (size_t)NL * NB * 6 * D * 4 <= WS_PART, "ws map");
constexpr size_t WS_SAH = WS_SU, WS_SAY = WS_SU + 65536, WS_SB = WS_SV; constexpr int SBL = NP + 2 * D;
constexpr size_t WS_SBA = WS_SB + (size_t)NL * SBL * 4, WS_ALR8 = WS_SU + 131072;
#ifndef KROT_A
#define KROT_A 0
#endif
#ifndef KROT_B
#define KROT_B 0
#endif
#define KROT(c) (KROT_A * (((c) >> 3) & 3) + KROT_B * ((c) >> 5))
#ifndef RES16
#define RES16 1
#endif
#ifndef RES16_X
#define RES16_X RES16
#endif
#ifndef RES16_Z
#define RES16_Z RES16
#endif
#ifndef RES16_X1
#define RES16_X1 RES16
#endif
#ifndef I8_GATE
#define I8_GATE 1
#endif
#ifndef I8_WQ
#define I8_WQ 1
#endif
#ifndef I8_IN
#define I8_IN 1
#endif
#ifndef I8_OUT
#define I8_OUT 1
#endif
constexpr int CW_BAR = 4096;

constexpr int RING_OFF = 0, RING_BYTES = 131072, LDSCTL_OFF = RING_BYTES, LDS_BYTES = 147456;

#define GAS __attribute__((address_space(1)))
typedef unsigned short bf16;
typedef unsigned v4u __attribute__((ext_vector_type(4)));
typedef unsigned v2u __attribute__((ext_vector_type(2)));
typedef int v4i __attribute__((ext_vector_type(4)));
typedef float f32x4 __attribute__((ext_vector_type(4)));
typedef float f32x16 __attribute__((ext_vector_type(16)));
typedef short bf16x8 __attribute__((ext_vector_type(8)));
typedef __bf16 bf16x2v __attribute__((ext_vector_type(2)));
#define LDS_WAIT() asm volatile("s_waitcnt lgkmcnt(0)" ::: "memory")

__device__ __forceinline__ unsigned pk2(float lo, float hi) { return pg8::cvt_pk_bf16(lo, hi); }
__device__ __forceinline__ float dot2bf(unsigned w, unsigned x, float acc) { return __builtin_amdgcn_fdot2_f32_bf16(__builtin_bit_cast(bf16x2v, w), __builtin_bit_cast(bf16x2v, x), acc, false); }
__device__ __forceinline__ float bflo(unsigned u) { return __uint_as_float(u << 16); }
__device__ __forceinline__ float bfhi(unsigned u) { return __uint_as_float(u & 0xffff0000u); }
__device__ __forceinline__ float silu_f(float x) { return x * __builtin_amdgcn_rcpf(1.0f + __expf(-x)); }
__device__ __forceinline__ float logsigmoid_f(float x) { return fminf(x, 0.0f) - log1pf(__expf(-fabsf(x))); }
__device__ __forceinline__ float logsigmoid_fast(float x) { return fminf(x, 0.0f) - __logf(1.0f + __expf(-fabsf(x))); }
__device__ __forceinline__ float gelu_tanh_f(float x) { const float u = 0.7978845608028654f * (x + 0.044715f * x * x * x); return 0.5f * x * (1.0f + tanhf(u)); }
__device__ __forceinline__ unsigned pack_i8(float a, float b, float c, float d) {
    const int q0 = (int)__builtin_rintf(a), q1 = (int)__builtin_rintf(b), q2 = (int)__builtin_rintf(c), q3 = (int)__builtin_rintf(d);
    return (unsigned)(q0 & 255) | ((unsigned)(q1 & 255) << 8) | ((unsigned)(q2 & 255) << 16) | ((unsigned)(q3 & 255) << 24); }
#define WAVE_ALLREDUCE(v, OP) do { \
    v = OP(v, __uint_as_float((unsigned)__builtin_amdgcn_update_dpp(0, (int)__float_as_uint(v), 0xB1, 0xf, 0xf, false)));      \
    v = OP(v, __uint_as_float((unsigned)__builtin_amdgcn_update_dpp(0, (int)__float_as_uint(v), 0x4E, 0xf, 0xf, false)));      \
    v = OP(v, __uint_as_float((unsigned)__builtin_amdgcn_update_dpp(0, (int)__float_as_uint(v), 0x124, 0xf, 0xf, false)));     \
    v = OP(v, __uint_as_float((unsigned)__builtin_amdgcn_update_dpp(0, (int)__float_as_uint(v), 0x128, 0xf, 0xf, false)));     \
    { const auto r_ = __builtin_amdgcn_permlane16_swap(__float_as_uint(v), __float_as_uint(v), false, false); v = OP(__uint_as_float(r_[0]), __uint_as_float(r_[1])); } \
    { const auto r_ = __builtin_amdgcn_permlane32_swap(__float_as_uint(v), __float_as_uint(v), false, false); v = OP(__uint_as_float(r_[0]), __uint_as_float(r_[1])); } } while (0)
__device__ __forceinline__ float op_add_f(float a, float b) { return a + b; }
__device__ __forceinline__ float wave_sum(float v) { WAVE_ALLREDUCE(v, op_add_f); return v; }
__device__ __forceinline__ float wave_max(float v) { WAVE_ALLREDUCE(v, fmaxf); return v; }

struct Args { const float* in[19]; float* out; unsigned char* ws; int ph_lo, ph_hi; };

__device__ __forceinline__ void transpose_item(const float* W, int ldw, int col0, bf16* WTrows, int k0, int nvalid, LAS float* scr, int lane) {
    const int n = lane & 31;
    float tv[32];
#pragma unroll
    for (int i = 0; i < 32; ++i) { const int kk = 2 * i + (lane >> 5); tv[i] = (n < nvalid) ? W[(size_t)(k0 + kk) * ldw + col0 + n] : 0.f; }
#pragma unroll
    for (int i = 0; i < 32; ++i) { const int kk = 2 * i + (lane >> 5); scr[kk * 33 + n] = tv[i]; }
    LDS_WAIT(); asm volatile("" ::: "memory");
    const int c = lane & 7;
#pragma unroll
    for (int j = 0; j < 4; ++j) { const int nn = (lane >> 3) + 8 * j; const LAS float* s = scr + (8 * c) * 33 + nn;
        v4u o; o.x = pk2(s[0 * 33], s[1 * 33]); o.y = pk2(s[2 * 33], s[3 * 33]); o.z = pk2(s[4 * 33], s[5 * 33]); o.w = pk2(s[6 * 33], s[7 * 33]);
        if (nn < nvalid) *(v4u*)(WTrows + (size_t)nn * D + k0 + 8 * c) = o; }
    LDS_WAIT(); asm volatile("" ::: "memory");
}
__device__ __forceinline__ void cvt_stream(const float* src, bf16* dst, size_t n4, size_t i0, size_t stride) {
    for (size_t i = i0; i < n4; i += stride) { const f32x4 v = ((const f32x4*)src)[i]; v2u o; o.x = pk2(v.x, v.y); o.y = pk2(v.z, v.w); ((v2u*)dst)[i] = o; }
}
__device__ __forceinline__ void ph_prologue_a(const Args& a, LAS unsigned char* lds, int tid, int lane, int wave, int bx, int G) {
    const int gw = bx * NWAVES + wave, NGW = G * NWAVES;
    LAS float* cact = (LAS float*)lds;
    for (int i = tid; i < NB * D; i += NTHREADS) { const int b = i / D, d = i % D; cact[d * 8 + b] = silu_f(a.in[1][i]); }
    __syncthreads();
    float* part = (float*)(a.ws + WS_PART);
    for (int it = gw; it < NL * 8 * 48; it += NGW) {
        const int cg = it % 48, dr = (it / 48) % 8, l = it / 384;
        f32x4 acc[8];
#pragma unroll
        for (int b = 0; b < 8; ++b) acc[b] = (f32x4){0.f, 0.f, 0.f, 0.f};
        const float* w = a.in[2] + ((size_t)l * D + dr * 256) * (6 * D) + cg * 256 + lane * 4;
#pragma unroll 4
        for (int d = 0; d < 256; ++d) {
            const f32x4 wv = *(const f32x4*)(w + (size_t)d * (6 * D));
            const f32x4 c0 = *(const LAS f32x4*)(cact + (dr * 256 + d) * 8), c1 = *(const LAS f32x4*)(cact + (dr * 256 + d) * 8 + 4);
            acc[0] += wv * c0.x; acc[1] += wv * c0.y; acc[2] += wv * c0.z; acc[3] += wv * c0.w;
            acc[4] += wv * c1.x; acc[5] += wv * c1.y; acc[6] += wv * c1.z; acc[7] += wv * c1.w;
        }
#pragma unroll
        for (int b = 0; b < 8; ++b) *(f32x4*)(part + (((size_t)l * 8 + dr) * NB + b) * (6 * D) + cg * 256 + lane * 4) = acc[b];
    }
    __syncthreads();
    LAS float* scr = (LAS float*)(lds + wave * 8448);
    bf16* winT = (bf16*)(a.ws + WS_WIN); bf16* woutT = (bf16*)(a.ws + WS_WOUT); bf16* wqT = (bf16*)(a.ws + WS_WQ);
    constexpr int IPL = 6144 + 32 + 2048 + 2048;
    for (int it = gw; it < NL * IPL; it += NGW) {
        const int l = it / IPL; int r = it % IPL;
        if (r < 6144) { const int nb = r % 192, kb = r / 192, n0 = nb * 32;
            transpose_item(a.in[4] + (size_t)l * D * INW, INW, n0 < 3072 ? n0 : n0 + 16, winT + ((size_t)l * INW + n0) * D, kb * 64, 32, scr, lane); continue; }
        r -= 6144;
        if (r < 32) { transpose_item(a.in[4] + (size_t)l * D * INW, INW, 3072, winT + ((size_t)l * INW + NP) * D, r * 64, 16, scr, lane); continue; }
        r -= 32;
        if (r < 2048) { const int nb = r % 64, kb = r / 64; transpose_item(a.in[10] + (size_t)l * D * D, D, nb * 32, woutT + ((size_t)l * D + nb * 32) * D, kb * 64, 32, scr, lane); continue; }
        r -= 2048;
        { const int nb = r % 64, kb = r / 64; transpose_item(a.in[13] + (size_t)l * D * D, D, nb * 32, wqT + ((size_t)l * D + nb * 32) * D, kb * 64, 32, scr, lane); }
    }
    const size_t i0 = (size_t)bx * NTHREADS + tid, stride = (size_t)G * NTHREADS;
    cvt_stream(a.in[14], (bf16*)(a.ws + WS_KEYS), (size_t)NL * 8 * 2 * 128 * 128 / 4, i0, stride);
#if TAB4
    __syncthreads();
    { LAS float* rowst = (LAS float*)(lds + wave * 8192);
      f32x4 vnx[8];
      if (gw < 2 * NL * NE) { const int tbl0 = gw / (NL * NE), r0 = gw % (NL * NE); const float* s0 = (tbl0 ? a.in[16] : a.in[15]) + (size_t)r0 * D;
#pragma unroll
          for (int c8 = 0; c8 < 8; ++c8) vnx[c8] = *(const f32x4*)(s0 + (c8 * 64 + lane) * 4); }
      for (int row = gw; row < 2 * NL * NE; row += NGW) {
        const int tbl = row / (NL * NE), r = row % (NL * NE);
#pragma unroll
        for (int c8 = 0; c8 < 8; ++c8) *(LAS f32x4*)(rowst + (c8 * 64 + lane) * 4) = vnx[c8];
        { const int rown = row + NGW < 2 * NL * NE ? row + NGW : row; const int tbln = rown / (NL * NE), rn = rown % (NL * NE); const float* sn = (tbln ? a.in[16] : a.in[15]) + (size_t)rn * D;
#pragma unroll
          for (int c8 = 0; c8 < 8; ++c8) vnx[c8] = *(const f32x4*)(sn + (c8 * 64 + lane) * 4); }
        LDS_WAIT(); asm volatile("" ::: "memory");
        unsigned char* tb = a.ws + (tbl ? WS_VT : WS_UT) + (size_t)r * 1152;
#pragma unroll
        for (int pass = 0; pass < 2; ++pass) { const int slot = lane + 64 * pass;
            if (slot < 72) { const int col0 = (slot >> 3) * 240 + (slot & 7) * 30;
                float x[30]; float mx = 0.f;
#pragma unroll
                for (int k = 0; k < 30; ++k) { x[k] = (col0 + k < D) ? rowst[col0 + k] : 0.f; mx = fmaxf(mx, fabsf(x[k])); }
                int code = 0; float inv = 0.f;
                if (mx > 0.f) { code = (int)ceilf(8.0f * log2f(mx * (1.0f / 7.0f))) + 128; code = code < 0 ? 0 : (code > 255 ? 255 : code); inv = __builtin_amdgcn_exp2f(16.0f - (float)code * 0.125f); }
                unsigned dw[4] = {0u, 0u, 0u, 0u};
#pragma unroll
                for (int kb = 0; kb < 15; ++kb) { int a0 = (int)__builtin_rintf(x[2 * kb] * inv), a1 = (int)__builtin_rintf(x[2 * kb + 1] * inv);
                    a0 = a0 < -7 ? -7 : (a0 > 7 ? 7 : a0); a1 = a1 < -7 ? -7 : (a1 > 7 ? 7 : a1);
                    dw[kb >> 2] |= ((unsigned)(a0 + 8) | ((unsigned)(a1 + 8) << 4)) << (8 * (kb & 3)); }
                dw[3] |= (unsigned)code << 24;
                *(v4u*)(tb + slot * 16) = (v4u){dw[0], dw[1], dw[2], dw[3]}; } }
        LDS_WAIT(); asm volatile("" ::: "memory");
      } }
#else
    for (int row = gw; row < 2 * NL * NE; row += NGW) {
        const int tbl = row / (NL * NE), r = row % (NL * NE);
        const float* src = (tbl ? a.in[16] : a.in[15]) + (size_t)r * D;
        f32x4 v[8]; float mx = 0.f;
#pragma unroll
        for (int c8 = 0; c8 < 8; ++c8) { v[c8] = *(const f32x4*)(src + (c8 * 64 + lane) * 4); mx = fmaxf(mx, fmaxf(fmaxf(fabsf(v[c8].x), fabsf(v[c8].y)), fmaxf(fabsf(v[c8].z), fabsf(v[c8].w)))); }
        mx = wave_max(mx);
        const float inv = mx > 0.f ? 127.0f / mx : 0.f; const int off = tbl ? 128 : 0;
        unsigned dw[8];
#pragma unroll
        for (int c8 = 0; c8 < 8; ++c8) { const int q0 = (int)__builtin_rintf(v[c8].x * inv) + off, q1 = (int)__builtin_rintf(v[c8].y * inv) + off, q2 = (int)__builtin_rintf(v[c8].z * inv) + off, q3 = (int)__builtin_rintf(v[c8].w * inv) + off;
            dw[c8] = (unsigned)(q0 & 255) | ((unsigned)(q1 & 255) << 8) | ((unsigned)(q2 & 255) << 16) | ((unsigned)(q3 & 255) << 24); }
        unsigned char* dst = a.ws + (tbl ? WS_VT : WS_UT) + (size_t)r * D;
        *(v4u*)(dst + lane * 16) = (v4u){dw[0], dw[1], dw[2], dw[3]}; *(v4u*)(dst + (64 + lane) * 16) = (v4u){dw[4], dw[5], dw[6], dw[7]};
        if (lane == 0) ((float*)(a.ws + (tbl ? WS_SV : WS_SU)))[r] = mx * (1.0f / 127.0f);
    }
#endif
}

__device__ __forceinline__ void ln_tail(const float (&z)[32], int t, int lane, const float* g, const float* bta, float* xout, const float* sh, const float* sc, bf16* hout, unsigned char* q8, float* q8s, LAS unsigned char* q8stage = nullptr, unsigned char* a8 = nullptr, float* a8s = nullptr, bf16* xb = nullptr) {
    float s = 0.f;
#pragma unroll
    for (int i = 0; i < 32; ++i) s += z[i];
    const float mu = wave_sum(s) * (1.0f / D);
    float q = 0.f;
#pragma unroll
    for (int i = 0; i < 32; ++i) { const float d = z[i] - mu; q += d * d; }
    const float rs = rsqrtf(wave_sum(q) * (1.0f / D) + EPS);
    float hv[32]; float mx = 0.f;
#pragma unroll
    for (int c = 0; c < 8; ++c) { const int col = (c * 64 + lane) * 4;
        const f32x4 g0 = *(const f32x4*)(g + col), b0 = *(const f32x4*)(bta + col);
        f32x4 x0;
        x0.x = (z[c * 4 + 0] - mu) * rs * g0.x + b0.x; x0.y = (z[c * 4 + 1] - mu) * rs * g0.y + b0.y; x0.z = (z[c * 4 + 2] - mu) * rs * g0.z + b0.z; x0.w = (z[c * 4 + 3] - mu) * rs * g0.w + b0.w;
        if (xb) { v2u o; o.x = pk2(x0.x, x0.y); o.y = pk2(x0.z, x0.w); *(v2u*)(xb + (size_t)t * D + col) = o; }
        else if (xout) *(f32x4*)(xout + (size_t)t * D + col) = x0;
        if (hout || q8 || a8) { const f32x4 s0 = *(const f32x4*)(sc + col), h0 = *(const f32x4*)(sh + col);
            hv[c * 4] = x0.x * (1.f + s0.x) + h0.x; hv[c * 4 + 1] = x0.y * (1.f + s0.y) + h0.y; hv[c * 4 + 2] = x0.z * (1.f + s0.z) + h0.z; hv[c * 4 + 3] = x0.w * (1.f + s0.w) + h0.w;
            if (hout) { v2u o; o.x = pk2(hv[c * 4], hv[c * 4 + 1]); o.y = pk2(hv[c * 4 + 2], hv[c * 4 + 3]);
                *(v2u*)(hout + (size_t)t * D + col) = o; }
            if (q8 || a8) mx = fmaxf(mx, fmaxf(fmaxf(fabsf(hv[c * 4]), fabsf(hv[c * 4 + 1])), fmaxf(fabsf(hv[c * 4 + 2]), fabsf(hv[c * 4 + 3])))); }
    }
    if (q8 || a8) {
        mx = wave_max(mx);
        const float qmax_ = (q8 && TAB4) ? 119.0f : 127.0f;
        const float inv = mx > 0.f ? qmax_ / mx : 0.f;
        unsigned dw[8];
#pragma unroll
        for (int c = 0; c < 8; ++c) { const int q0 = (int)__builtin_rintf(hv[c * 4] * inv), q1 = (int)__builtin_rintf(hv[c * 4 + 1] * inv), q2 = (int)__builtin_rintf(hv[c * 4 + 2] * inv), q3 = (int)__builtin_rintf(hv[c * 4 + 3] * inv);
            dw[c] = (unsigned)(q0 & 255) | ((unsigned)(q1 & 255) << 8) | ((unsigned)(q2 & 255) << 16) | ((unsigned)(q3 & 255) << 24); }
        if (a8) {
#pragma unroll
            for (int c = 0; c < 8; ++c) *(unsigned*)(a8 + (size_t)t * D + (c * 64 + lane) * 4) = dw[c];
            if (a8s && lane == 0) a8s[t] = mx / qmax_; }
        if (q8) {
#if TAB4
        { LAS unsigned* st32 = (LAS unsigned*)q8stage; LAS unsigned char* st8 = (LAS unsigned char*)q8stage;
#pragma unroll
          for (int i = 0; i < 9; ++i) st32[lane + 64 * i] = 0u;
          LDS_WAIT(); asm volatile("" ::: "memory");
#pragma unroll
          for (int c = 0; c < 8; ++c)
#pragma unroll
              for (int jp = 0; jp < 2; ++jp) { const int col = (c * 64 + lane) * 4 + 2 * jp, u = col / 240, r = col - u * 240, l7 = r / 30, k = r - l7 * 30;
                  const int q0 = (int)(signed char)((dw[c] >> (16 * jp)) & 255u), q1 = (int)(signed char)((dw[c] >> (16 * jp + 8)) & 255u);
                  const int l0 = ((q0 + 8) & 15) - 8, l1 = ((q1 + 8) & 15) - 8, h0 = (q0 - l0) >> 4, h1 = (q1 - l1) >> 4;
                  LAS unsigned char* sp = st8 + (u * 8 + l7) * 32 + (k >> 1);
                  sp[0] = (unsigned char)((l0 & 15) | ((l1 & 15) << 4)); sp[16] = (unsigned char)((h0 & 15) | ((h1 & 15) << 4)); }
          LDS_WAIT(); asm volatile("" ::: "memory");
          unsigned* d32 = (unsigned*)(q8 + (size_t)t * 2304);
#pragma unroll
          for (int i = 0; i < 9; ++i) d32[lane + 64 * i] = st32[lane + 64 * i];
          LDS_WAIT(); asm volatile("" ::: "memory"); }
#else
        unsigned char* dst = q8 + (size_t)t * D;
        *(v4u*)(dst + lane * 16) = (v4u){dw[0], dw[1], dw[2], dw[3]}; *(v4u*)(dst + (64 + lane) * 16) = (v4u){dw[4], dw[5], dw[6], dw[7]};
#endif
        if (lane == 0) q8s[t] = mx / qmax_; }
    }
}

__device__ __forceinline__ void ph_prologue_b(const Args& a, LAS unsigned char* lds, int tid, int lane, int wave, int bx, int G) {
    const float* part = (const float*)(a.ws + WS_PART); float* mod = (float*)(a.ws + WS_MOD);
    for (int i = bx * NTHREADS + tid; i < NL * NB * 6 * D / 4; i += G * NTHREADS) {
        const int idx = i * 4, e = idx % (6 * D), b = (idx / (6 * D)) % NB, l = idx / (6 * D * NB);
        f32x4 s = *(const f32x4*)(a.in[3] + l * 6 * D + e);
#pragma unroll
        for (int dr = 0; dr < 8; ++dr) s += *(const f32x4*)(part + (((size_t)l * 8 + dr) * NB + b) * (6 * D) + e);
        *(f32x4*)(mod + idx) = s;
    }
    LAS float* msh = (LAS float*)lds;
    bf16* hbuf = (bf16*)(a.ws + WS_H);
    for (int ch = bx; ch < NCHUNK; ch += G) {
        const int b = ch / NCH;
        for (int i = tid; i < 1024; i += NTHREADS) { const int e = i * 4;
            f32x4 s = *(const f32x4*)(a.in[3] + e);
#pragma unroll
            for (int dr = 0; dr < 8; ++dr) s += *(const f32x4*)(part + (((size_t)0 * 8 + dr) * NB + b) * (6 * D) + e);
            *(LAS f32x4*)(msh + e) = s; }
        __syncthreads();
        for (int i = 0; i < 8; ++i) { const int t = ch * 64 + wave * 8 + i;
            float hv[32]; float mx = 0.f;
#pragma unroll
            for (int c = 0; c < 4; ++c) { const int col = (c * 64 + lane) * 8;
                const f32x4 x0 = *(const f32x4*)(a.in[0] + (size_t)t * D + col), x1 = *(const f32x4*)(a.in[0] + (size_t)t * D + col + 4);
                const f32x4 h0 = *(const LAS f32x4*)(msh + col), h1 = *(const LAS f32x4*)(msh + col + 4), s0 = *(const LAS f32x4*)(msh + 2048 + col), s1 = *(const LAS f32x4*)(msh + 2048 + col + 4);
#pragma unroll
                for (int j = 0; j < 4; ++j) { hv[c * 8 + j] = x0[j] * (1.f + s0[j]) + h0[j]; hv[c * 8 + 4 + j] = x1[j] * (1.f + s1[j]) + h1[j]; }
                v4u o; o.x = pk2(hv[c * 8], hv[c * 8 + 1]); o.y = pk2(hv[c * 8 + 2], hv[c * 8 + 3]); o.z = pk2(hv[c * 8 + 4], hv[c * 8 + 5]); o.w = pk2(hv[c * 8 + 6], hv[c * 8 + 7]);
#if !I8_GATE
                *(v4u*)(hbuf + (size_t)t * D + col) = o;
#endif
#if RES16_X
                { v4u xo; xo.x = pk2(x0.x, x0.y); xo.y = pk2(x0.z, x0.w); xo.z = pk2(x1.x, x1.y); xo.w = pk2(x1.z, x1.w); *(v4u*)((bf16*)(a.ws + WS_X) + (size_t)t * D + col) = xo; }
#endif
#pragma unroll
                for (int j = 0; j < 8; ++j) mx = fmaxf(mx, fabsf(hv[c * 8 + j])); }
#pragma unroll
            for (int o = 1; o < 64; o <<= 1) mx = fmaxf(mx, __shfl_xor(mx, o));
            const float inv = mx > 0.f ? 127.0f / mx : 0.f;
#pragma unroll
            for (int c = 0; c < 4; ++c) { v2u o;
                o.x = pack_i8(hv[c * 8] * inv, hv[c * 8 + 1] * inv, hv[c * 8 + 2] * inv, hv[c * 8 + 3] * inv); o.y = pack_i8(hv[c * 8 + 4] * inv, hv[c * 8 + 5] * inv, hv[c * 8 + 6] * inv, hv[c * 8 + 7] * inv);
                *(v2u*)(a.ws + WS_H8 + (size_t)t * D + (c * 64 + lane) * 8) = o; }
            if (lane == 0) ((float*)(a.ws + WS_SAH))[t] = mx * (1.0f / 127.0f); }
        __syncthreads();
    }
    { const int gw = bx * NWAVES + wave, NGW = G * NWAVES;
      for (int row = gw; row < NL * (SBL + 16); row += NGW) { const int l = row / (SBL + 16), r = row % (SBL + 16);
          const bf16* src; unsigned char* dst; float* sdst;
          if (r < NP) { src = (const bf16*)(a.ws + WS_WIN) + ((size_t)l * INW + r) * D; dst = a.ws + WS_WIN8 + ((size_t)l * NP + r) * D; sdst = (float*)(a.ws + WS_SB) + l * SBL + r; }
          else if (r < NP + D) { src = (const bf16*)(a.ws + WS_WOUT) + ((size_t)l * D + (r - NP)) * D; dst = a.ws + WS_WOUT8 + ((size_t)l * D + (r - NP)) * D; sdst = (float*)(a.ws + WS_SB) + l * SBL + r; }
          else if (r < SBL) { src = (const bf16*)(a.ws + WS_WQ) + ((size_t)l * D + (r - NP - D)) * D; dst = a.ws + WS_WQ8 + ((size_t)l * D + (r - NP - D)) * D; sdst = (float*)(a.ws + WS_SB) + l * SBL + r; }
          else { src = (const bf16*)(a.ws + WS_WIN) + ((size_t)l * INW + NP + (r - SBL)) * D; dst = a.ws + WS_ALR8 + ((size_t)l * 16 + (r - SBL)) * D; sdst = (float*)(a.ws + WS_SBA) + l * 16 + (r - SBL); }
          v4u w[4]; float mx = 0.f;
#pragma unroll
          for (int c = 0; c < 4; ++c) w[c] = *(const v4u*)(src + (c * 64 + lane) * 8);
#pragma unroll
          for (int c = 0; c < 4; ++c)
#pragma unroll
              for (int j = 0; j < 4; ++j) mx = fmaxf(mx, fmaxf(fabsf(bflo(w[c][j])), fabsf(bfhi(w[c][j]))));
#pragma unroll
          for (int o = 1; o < 64; o <<= 1) mx = fmaxf(mx, __shfl_xor(mx, o));
          const float inv = mx > 0.f ? 127.0f / mx : 0.f;
#pragma unroll
          for (int c = 0; c < 4; ++c) { v2u o;
              o.x = pack_i8(bflo(w[c][0]) * inv, bfhi(w[c][0]) * inv, bflo(w[c][1]) * inv, bfhi(w[c][1]) * inv); o.y = pack_i8(bflo(w[c][2]) * inv, bfhi(w[c][2]) * inv, bflo(w[c][3]) * inv, bfhi(w[c][3]) * inv);
              *(v2u*)(dst + (c * 64 + lane) * 8) = o; }
          if (lane == 0) *sdst = mx * (1.0f / 127.0f); } }
}

__device__ __forceinline__ void gate_prep(const Args& a, int l, LAS unsigned char* lds, int tid, int lane, int wave, int ch) {
    const bf16* hbuf = (const bf16*)(a.ws + WS_H); const bf16* waT = (const bf16*)(a.ws + WS_WIN) + ((size_t)l * INW + NP) * D;
    bf16* Ebuf = (bf16*)(a.ws + WS_E); float* dtot = (float*)(a.ws + WS_DTOT);
    const int t0 = ch * 64, l15 = lane & 15, lq = lane >> 4, mt = wave & 3, kh = wave >> 2;
    LAS float* alr = (LAS float*)(lds + LDSCTL_OFF + 1024);
#if I8_GATE
    { v4i acc = (v4i){0, 0, 0, 0};
      const unsigned char* hA = a.ws + WS_H8 + (size_t)(t0 + 16 * mt + l15) * D + kh * 1024 + 16 * lq;
      const unsigned char* wB = a.ws + WS_ALR8 + ((size_t)l * 16 + l15) * D + kh * 1024 + 16 * lq;
#pragma unroll 8
      for (int ks = 0; ks < 16; ++ks) { const v4i av = *(const v4i*)(hA + 64 * ks), bv = *(const v4i*)(wB + 64 * ks); acc = __builtin_amdgcn_mfma_i32_16x16x64_i8(av, bv, acc, 0, 0, 0); }
      const float sw = ((const float*)(a.ws + WS_SBA))[l * 16 + l15];
#pragma unroll
      for (int r = 0; r < 4; ++r) { const int tl = 16 * mt + 4 * lq + r; alr[(kh * 64 + tl) * 16 + l15] = (float)acc[r] * (sw * ((const float*)(a.ws + WS_SAH))[t0 + tl]); } }
#else
    f32x4 acc = (f32x4){0.f, 0.f, 0.f, 0.f};
    const bf16* hA = hbuf + (size_t)(t0 + 16 * mt + l15) * D + kh * 1024 + 8 * lq;
    const bf16* wB = waT + (size_t)l15 * D + kh * 1024 + 8 * lq;
#pragma unroll 8
    for (int ks = 0; ks < 32; ++ks) { const bf16x8 av = *(const bf16x8*)(hA + 32 * ks), bv = *(const bf16x8*)(wB + 32 * ks); acc = __builtin_amdgcn_mfma_f32_16x16x32_bf16(av, bv, acc, 0, 0, 0); }
#pragma unroll
    for (int r = 0; r < 4; ++r) alr[(kh * 64 + 16 * mt + 4 * lq + r) * 16 + l15] = acc[r];
#endif
    __syncthreads();
    const int col = tid;
    float wg[16];
#pragma unroll
    for (int r = 0; r < 16; ++r) wg[r] = a.in[5][((size_t)l * RANK + r) * GKW + col];
    const float bgc = a.in[6][l * GKW + col];
    for (int i = tid; i < 256; i += NTHREADS) *(LAS f32x4*)(alr + i * 4) = *(const LAS f32x4*)(alr + i * 4) + *(const LAS f32x4*)(alr + 1024 + i * 4);
    __syncthreads();
    float tot = 0.f;
    LAS float* lac = (LAS float*)lds;
    for (int j = 0; j < 64; ++j) { float lg0 = bgc, lg1 = 0.f;
#pragma unroll
        for (int r4 = 0; r4 < 4; ++r4) { const f32x4 p = *(const LAS f32x4*)(alr + j * 16 + r4 * 4);
            lg0 += p.x * wg[r4 * 4] + p.z * wg[r4 * 4 + 2]; lg1 += p.y * wg[r4 * 4 + 1] + p.w * wg[r4 * 4 + 3]; }
        const float la = logsigmoid_fast(lg0 + lg1) * (1.0f / 16.0f); lac[j * GKW + col] = la; tot += la; }
    float run = 0.f;
    for (int j = 0; j < 64; ++j) { run += lac[j * GKW + col]; lac[j * GKW + col] = __expf(tot - run); }
    __syncthreads();
    for (int i = 0; i < 8; ++i) { const int j = wave * 8 + i;
        const f32x4 e0 = *(const LAS f32x4*)(lac + j * GKW + lane * 8), e1 = *(const LAS f32x4*)(lac + j * GKW + lane * 8 + 4);
        v4u o; o.x = pk2(e0.x, e0.y); o.y = pk2(e0.z, e0.w); o.z = pk2(e1.x, e1.y); o.w = pk2(e1.z, e1.w);
        *(v4u*)(Ebuf + (size_t)(t0 + j) * GKW + lane * 8) = o; }
    dtot[(size_t)ch * GKW + col] = __expf(tot);
    __syncthreads();
}

__device__ __forceinline__ void gla_unit(const Args& a, LAS unsigned char* lds, int tid, int lane, int wave, int un) {
    const bf16* proj = (const bf16*)(a.ws + WS_PROJ); const bf16* Ebuf = (const bf16*)(a.ws + WS_E); const float* dtot = (const float*)(a.ws + WS_DTOT); bf16* ogla = (bf16*)(a.ws + WS_OGLA);
    const int pair_ = (un & 7) * 4 + (un >> 6), dvs = (un >> 3) & 7, hh = pair_ & 3, b = pair_ >> 2;
    LAS bf16* kdT0 = (LAS bf16*)lds; LAS bf16* vT0 = (LAS bf16*)(lds + 18432); LAS bf16* ST0 = (LAS bf16*)(lds + 18432 + 4608);
    LAS bf16* kdT1 = (LAS bf16*)(lds + 32768); LAS bf16* vT1 = (LAS bf16*)(lds + 32768 + 18432); LAS bf16* ST1 = (LAS bf16*)(lds + 32768 + 18432 + 4608);
    const int l15 = lane & 15, lq = lane >> 4, jl = tid >> 3, dv4 = (tid & 7) * 4, jt = (wave & 3) * 16, dvt = (wave >> 2) * 16, jp = tid >> 4, c16 = tid & 15;
#define GLA_BAR() do { asm volatile("s_waitcnt lgkmcnt(0)" ::: "memory"); __builtin_amdgcn_s_barrier(); asm volatile("" ::: "memory"); } while (0)
    f32x4 S0 = (f32x4){0.f, 0.f, 0.f, 0.f}, S1 = (f32x4){0.f, 0.f, 0.f, 0.f};
    v4u kn0[2], kn1[2], kn2[2], en0[2], en1[2], en2[2]; v2u vn0, vn1, vn2; bf16x8 qn0[4], qn1[4], qn2[4], qc[4]; f32x4 dn0, dn1, dn2, dc;
#define GLA_LOAD(c, kn, en, vn, qn, dn) do { const int t0c = b * SEQ + (c) * 64; const bf16* pr = proj + (size_t)(t0c + jl) * NP; \
          \
        kn[0] = *(const v4u*)(proj + (size_t)(t0c + 2 * jp) * NP + PK + hh * 128 + 8 * c16); kn[1] = *(const v4u*)(proj + (size_t)(t0c + 2 * jp + 1) * NP + PK + hh * 128 + 8 * c16); \
        en[0] = *(const v4u*)(Ebuf + (size_t)(t0c + 2 * jp) * GKW + hh * 128 + 8 * c16); en[1] = *(const v4u*)(Ebuf + (size_t)(t0c + 2 * jp + 1) * GKW + hh * 128 + 8 * c16); \
        vn = *(const v2u*)(pr + PV + hh * 256 + dvs * 32 + dv4); \
        _Pragma("unroll") for (int ks_ = 0; ks_ < 4; ++ks_) qn[ks_] = *(const bf16x8*)(proj + (size_t)(t0c + jt + l15) * NP + PQ + hh * 128 + 32 * ks_ + 8 * lq); \
        dn = *(const f32x4*)(dtot + (size_t)(b * NCH + (c)) * GKW + hh * 128 + 16 * wave + 4 * lq); } while (0)
#define GLA_PREPL(kn, en, vn, kdT, vT) do { \
        _Pragma("unroll") for (int i_ = 0; i_ < 8; ++i_) { const unsigned wa_ = kn[0][i_ >> 1], wb_ = kn[1][i_ >> 1], ea_ = en[0][i_ >> 1], eb_ = en[1][i_ >> 1]; \
            const float pa_ = ((i_ & 1) ? bfhi(wa_) : bflo(wa_)) * ((i_ & 1) ? bfhi(ea_) : bflo(ea_)), pb_ = ((i_ & 1) ? bfhi(wb_) : bflo(wb_)) * ((i_ & 1) ? bfhi(eb_) : bflo(eb_)); \
            *(LAS unsigned*)(kdT + (8 * c16 + i_) * 72 + ((((jp >> 2) ^ c16) & 7) << 3) + ((2 * jp) & 7)) = pk2(pa_, pb_); }     \
        _Pragma("unroll") for (int i_ = 0; i_ < 4; ++i_) { const unsigned w_ = vn[i_ >> 1]; vT[(dv4 + i_) * 72 + jl] = (bf16)((i_ & 1) ? (w_ >> 16) : (w_ & 0xffffu)); } } while (0)
#define GLA_QD(qn, dn) do { _Pragma("unroll") for (int ks_ = 0; ks_ < 4; ++ks_) qc[ks_] = qn[ks_]; dc = dn; } while (0)
#define GLA_BODYA(kdT, vT, ST) do { \
        S0 = S0 * dc; S1 = S1 * dc; \
        _Pragma("unroll") for (int ks = 0; ks < 2; ++ks) { \
            const bf16x8 A_ = *(const LAS bf16x8*)(kdT + (16 * wave + l15) * 72 + ((((4 * ks + lq) ^ (2 * wave + (l15 >> 3))) & 7) << 3)); \
            const bf16x8 B0_ = *(const LAS bf16x8*)(vT + l15 * 72 + 32 * ks + 8 * lq), B1_ = *(const LAS bf16x8*)(vT + (16 + l15) * 72 + 32 * ks + 8 * lq); \
            S0 = __builtin_amdgcn_mfma_f32_16x16x32_bf16(A_, B0_, S0, 0, 0, 0); S1 = __builtin_amdgcn_mfma_f32_16x16x32_bf16(A_, B1_, S1, 0, 0, 0); } \
        { v2u w0_, w1_; w0_.x = pk2(S0.x, S0.y); w0_.y = pk2(S0.z, S0.w); w1_.x = pk2(S1.x, S1.y); w1_.y = pk2(S1.z, S1.w); \
          *(LAS v2u*)(ST + l15 * 136 + 16 * wave + 4 * lq) = w0_; *(LAS v2u*)(ST + (16 + l15) * 136 + 16 * wave + 4 * lq) = w1_; } } while (0)
#define GLA_BODYB(c, ST) do { \
        f32x4 O_ = (f32x4){0.f, 0.f, 0.f, 0.f}; \
        _Pragma("unroll") for (int ks = 0; ks < 4; ++ks) { const bf16x8 A_ = *(const LAS bf16x8*)(ST + (dvt + l15) * 136 + 32 * ks + 8 * lq); O_ = __builtin_amdgcn_mfma_f32_16x16x32_bf16(A_, qc[ks], O_, 0, 0, 0); } \
        { const f32x4 Os_ = O_ * 0.08838834764831845f; v2u ob_; ob_.x = pk2(Os_.x, Os_.y); ob_.y = pk2(Os_.z, Os_.w); \
          *(v2u*)(ogla + (size_t)(b * SEQ + (c) * 64 + jt + l15) * 1024 + hh * 256 + dvs * 32 + dvt + 4 * lq) = ob_; } } while (0)
#define GLA_STEP(c, RA, RB, LA, LB) do { { const int cn_ = (c) + 3 < NCH ? (c) + 3 : NCH - 1; GLA_LOAD(cn_, kn##RA, en##RA, vn##RA, qn##RA, dn##RA); } \
        GLA_BODYA(kdT##LA, vT##LA, ST##LA); GLA_PREPL(kn##RB, en##RB, vn##RB, kdT##LB, vT##LB); GLA_BAR(); GLA_BODYB(c, ST##LA); GLA_QD(qn##RB, dn##RB); } while (0)
    GLA_LOAD(0, kn0, en0, vn0, qn0, dn0); GLA_LOAD(1, kn1, en1, vn1, qn1, dn1); GLA_LOAD(2, kn2, en2, vn2, qn2, dn2);
    GLA_PREPL(kn0, en0, vn0, kdT0, vT0); GLA_QD(qn0, dn0);
    GLA_BAR();
    static_assert(NCH == 32, "the step schedule below is written for 32 chunks: 5 x 6 + 2");
    for (int c = 0; c < 30; c += 6) {
        GLA_STEP(c, 0, 1, 0, 1); GLA_STEP(c + 1, 1, 2, 1, 0); GLA_STEP(c + 2, 2, 0, 0, 1); GLA_STEP(c + 3, 0, 1, 1, 0); GLA_STEP(c + 4, 1, 2, 0, 1); GLA_STEP(c + 5, 2, 0, 1, 0);
    }
    GLA_STEP(30, 0, 1, 0, 1); GLA_STEP(31, 1, 2, 1, 0);
#undef GLA_STEP
#undef GLA_PREPL
#undef GLA_QD
#undef GLA_BODYA
#undef GLA_BODYB
#undef GLA_BAR
#undef GLA_LOAD
}

__device__ __forceinline__ void unpack16(const v4u& p0, const v4u& p1, float (&o)[16]) {
#pragma unroll
    for (int j = 0; j < 4; ++j) { o[2 * j] = bflo(p0[j]); o[2 * j + 1] = bfhi(p0[j]); o[8 + 2 * j] = bflo(p1[j]); o[8 + 2 * j + 1] = bfhi(p1[j]); }
}
__device__ __forceinline__ void mixpost_chunk(const Args& a, int l, int lane, int wave, int ch) {
    const bf16* proj = (const bf16*)(a.ws + WS_PROJ); const bf16* ogla = (const bf16*)(a.ws + WS_OGLA);
    const int c0 = 16 * lane, tfirst = ch * 64 + wave * 8, sfirst = tfirst % SEQ;
    float gn[16], cw0[16], cw1[16], cw2[16], cn[16], u1[16], u2[16];
#pragma unroll
    for (int i = 0; i < 16; ++i) { gn[i] = a.in[7][l * 256 + ((c0 + i) & 255)]; cw0[i] = a.in[8][(size_t)l * 3072 + c0 + i]; cw1[i] = a.in[8][(size_t)l * 3072 + 1024 + c0 + i];
        cw2[i] = a.in[8][(size_t)l * 3072 + 2048 + c0 + i]; cn[i] = a.in[9][l * 1024 + c0 + i]; u1[i] = 0.f; u2[i] = 0.f; }
    if (sfirst >= 2) {
        float cc[16], chh[16];
        { const bf16* pr = proj + (size_t)(tfirst - 2) * NP; unpack16(*(const v4u*)(pr + PCC + c0), *(const v4u*)(pr + PCC + c0 + 8), cc); unpack16(*(const v4u*)(pr + PCH + c0), *(const v4u*)(pr + PCH + c0 + 8), chh); }
#pragma unroll
        for (int i = 0; i < 16; ++i) u2[i] = cc[i] * chh[i];
        { const bf16* pr = proj + (size_t)(tfirst - 1) * NP; unpack16(*(const v4u*)(pr + PCC + c0), *(const v4u*)(pr + PCC + c0 + 8), cc); unpack16(*(const v4u*)(pr + PCH + c0), *(const v4u*)(pr + PCH + c0 + 8), chh); }
#pragma unroll
        for (int i = 0; i < 16; ++i) u1[i] = cc[i] * chh[i];
    }
#pragma unroll 2
    for (int it = 0; it < 8; ++it) { const int t = tfirst + it; const bf16* pr = proj + (size_t)t * NP;
        float o[16], r[16], cb[16], cc[16], chh[16];
        unpack16(*(const v4u*)(ogla + (size_t)t * 1024 + c0), *(const v4u*)(ogla + (size_t)t * 1024 + c0 + 8), o);
        unpack16(*(const v4u*)(pr + PR + c0), *(const v4u*)(pr + PR + c0 + 8), r);
        unpack16(*(const v4u*)(pr + PCB + c0), *(const v4u*)(pr + PCB + c0 + 8), cb);
        unpack16(*(const v4u*)(pr + PCC + c0), *(const v4u*)(pr + PCC + c0 + 8), cc);
        unpack16(*(const v4u*)(pr + PCH + c0), *(const v4u*)(pr + PCH + c0 + 8), chh);
        float ss = 0.f;
#pragma unroll
        for (int i = 0; i < 16; ++i) ss += o[i] * o[i];
        ss += __uint_as_float((unsigned)__builtin_amdgcn_update_dpp(0, (int)__float_as_uint(ss), 0xB1, 0xf, 0xf, false)); ss += __uint_as_float((unsigned)__builtin_amdgcn_update_dpp(0, (int)__float_as_uint(ss), 0x4E, 0xf, 0xf, false));
        ss += __uint_as_float((unsigned)__builtin_amdgcn_update_dpp(0, (int)__float_as_uint(ss), 0x124, 0xf, 0xf, false)); ss += __uint_as_float((unsigned)__builtin_amdgcn_update_dpp(0, (int)__float_as_uint(ss), 0x128, 0xf, 0xf, false));
        const float rg = rsqrtf(ss * (1.0f / 256.f) + EPS);
        float val[16]; float s2 = 0.f;
#pragma unroll
        for (int i = 0; i < 16; ++i) { const float u0 = cc[i] * chh[i]; val[i] = cb[i] * (cw0[i] * u2[i] + cw1[i] * u1[i] + cw2[i] * u0); s2 += val[i] * val[i]; u2[i] = u1[i]; u1[i] = u0; }
        const float rc = rsqrtf(wave_sum(s2) * (1.0f / 1024.f) + EPS);
        float ya[16], yb[16]; float mx = 0.f;
#pragma unroll
        for (int i = 0; i < 16; ++i) { ya[i] = o[i] * rg * gn[i] * silu_f(r[i]); yb[i] = val[i] * rc * cn[i]; mx = fmaxf(mx, fmaxf(fabsf(ya[i]), fabsf(yb[i]))); }
        mx = wave_max(mx);
        const float inv = mx > 0.f ? 127.0f / mx : 0.f;
        v4u y0, y1;
#pragma unroll
        for (int j = 0; j < 4; ++j) { y0[j] = pack_i8(ya[4 * j] * inv, ya[4 * j + 1] * inv, ya[4 * j + 2] * inv, ya[4 * j + 3] * inv); y1[j] = pack_i8(yb[4 * j] * inv, yb[4 * j + 1] * inv, yb[4 * j + 2] * inv, yb[4 * j + 3] * inv); }
        unsigned char* yr = a.ws + WS_Y8 + (size_t)t * D;
        *(v4u*)(yr + c0) = y0; *(v4u*)(yr + 1024 + c0) = y1;
#if !I8_OUT
        { v4u b0, b1, b2, b3;
#pragma unroll
          for (int j = 0; j < 4; ++j) { b0[j] = pk2(ya[2 * j], ya[2 * j + 1]); b1[j] = pk2(ya[8 + 2 * j], ya[9 + 2 * j]); b2[j] = pk2(yb[2 * j], yb[2 * j + 1]); b3[j] = pk2(yb[8 + 2 * j], yb[9 + 2 * j]); }
          bf16* ybr = (bf16*)(a.ws + WS_Y) + (size_t)t * D;
          *(v4u*)(ybr + c0) = b0; *(v4u*)(ybr + c0 + 8) = b1; *(v4u*)(ybr + 1024 + c0) = b2; *(v4u*)(ybr + 1024 + c0 + 8) = b3; }
#endif
        if (lane == 0) ((float*)(a.ws + WS_SAY))[t] = mx * (1.0f / 127.0f);
    }
}

__device__ __forceinline__ void ln1_chunk(const Args& a, int l, LAS unsigned char* lds, int lane, int wave, int ch) {
    const float* zbuf = (const float*)(a.ws + WS_Z); const float* mod = (const float*)(a.ws + WS_MOD);
    const int b = ch / NCH; const float* mb = mod + ((size_t)l * NB + b) * 6 * D;
#pragma unroll 2
    for (int it = 0; it < 8; ++it) { const int t = ch * 64 + wave * 8 + it;
        float z[32];
#pragma unroll
#if RES16_Z
        for (int c = 0; c < 8; ++c) { const v2u v0 = *(const v2u*)((const bf16*)zbuf + (size_t)t * D + (c * 64 + lane) * 4); z[c * 4] = bflo(v0.x); z[c * 4 + 1] = bfhi(v0.x); z[c * 4 + 2] = bflo(v0.y); z[c * 4 + 3] = bfhi(v0.y); }
#else
        for (int c = 0; c < 8; ++c) { const f32x4 v0 = *(const f32x4*)(zbuf + (size_t)t * D + (c * 64 + lane) * 4); z[c * 4] = v0.x; z[c * 4 + 1] = v0.y; z[c * 4 + 2] = v0.z; z[c * 4 + 3] = v0.w; }
#endif
        ln_tail(z, t, lane, a.in[11] + (size_t)l * D, a.in[12] + (size_t)l * D, RES16_X1 ? (float*)nullptr : (float*)(a.ws + WS_X1), mb + 3 * D, mb + 4 * D, I8_WQ ? (bf16*)nullptr : (bf16*)(a.ws + WS_H2), a.ws + WS_HQ8, (float*)(a.ws + WS_HSC), lds + wave * 2304, I8_WQ ? a.ws + WS_H28 : (unsigned char*)nullptr, nullptr, RES16_X1 ? (bf16*)(a.ws + WS_X1) : (bf16*)nullptr);
    }
}

template <int N> __device__ __forceinline__ void bitonic_sort_desc(float (&v)[N]) {
#pragma unroll
    for (int k = 2; k <= N; k <<= 1)
#pragma unroll
        for (int j = k >> 1; j > 0; j >>= 1)
#pragma unroll
            for (int i = 0; i < N; ++i) { const int p = i ^ j; if (p > i) { const bool desc = ((i & k) == 0); const float x = v[i], y = v[p]; const float mx = fmaxf(x, y), mn = fminf(x, y); v[i] = desc ? mx : mn; v[p] = desc ? mn : mx; } }
}
__device__ __forceinline__ void merge_top16(float (&x)[16], const float (&y)[16]) {
#pragma unroll
    for (int i = 0; i < 16; ++i) x[i] = fmaxf(x[i], y[15 - i]);
#pragma unroll
    for (int j = 8; j > 0; j >>= 1)
#pragma unroll
        for (int i = 0; i < 16; ++i) { const int p = i ^ j; if (p > i) { const float u = x[i], w = x[p]; x[i] = fmaxf(u, w); x[p] = fminf(u, w); } }
}
__device__ __forceinline__ void ce_desc(float& ka, int& pa, float& kb, int& pb) { const bool sw = kb > ka; const float k0 = sw ? kb : ka, k1 = sw ? ka : kb; const int p0 = sw ? pb : pa, p1 = sw ? pa : pb; ka = k0; pa = p0; kb = k1; pb = p1; }
__device__ __forceinline__ void bitonic_sort_desc_kp(float (&k)[16], int (&p)[16]) {
#pragma unroll
    for (int kk = 2; kk <= 16; kk <<= 1)
#pragma unroll
        for (int j = kk >> 1; j > 0; j >>= 1)
#pragma unroll
            for (int i = 0; i < 16; ++i) { const int q = i ^ j; if (q > i) { if ((i & kk) == 0) ce_desc(k[i], p[i], k[q], p[q]); else ce_desc(k[q], p[q], k[i], p[i]); } }
}
__device__ __forceinline__ void merge_top16_kp(float (&k)[16], int (&p)[16], const float (&k2)[16], const int (&p2)[16]) {
#pragma unroll
    for (int i = 0; i < 16; ++i) { const bool sw = k2[15 - i] > k[i]; k[i] = sw ? k2[15 - i] : k[i]; p[i] = sw ? p2[15 - i] : p[i]; }
#pragma unroll
    for (int j = 8; j > 0; j >>= 1)
#pragma unroll
        for (int i = 0; i < 16; ++i) { const int q = i ^ j; if (q > i) ce_desc(k[i], p[i], k[q], p[q]); }
}
__device__ constexpr int cand_i(int s) { return s < 16 ? 0 : s < 24 ? 1 : s < 29 ? 2 : s < 33 ? 3 : s < 36 ? 4 : s < 38 ? 5 : s < 40 ? 6 : s < 42 ? 7 : s < 50 ? s - 34 : -1; }
__device__ constexpr int cand_j(int s) { return s < 16 ? s : s < 24 ? s - 16 : s < 29 ? s - 24 : s < 33 ? s - 29 : s < 36 ? s - 33 : s < 38 ? s - 36 : s < 40 ? s - 38 : s < 42 ? s - 40 : s < 50 ? 0 : -1; }

__device__ __forceinline__ void peer_retrieve(const Args& a, int l, LAS unsigned char* lds, int lane, int wave, int ch) {
    const bf16* qbuf = (const bf16*)(a.ws + WS_Q); const bf16* keys = (const bf16*)(a.ws + WS_KEYS) + ((size_t)(l * 8 + wave) * 2) * 128 * 128;
    LAS int* eg_e = (LAS int*)lds; LAS float* eg_g = (LAS float*)(lds + 32768);
    const int l31 = lane & 31, l5 = lane >> 5, h = wave, t0 = ch * 64;
    for (int tt = 0; tt < 2; ++tt) {
        float sv[2][16];
#pragma unroll
        for (int p = 0; p < 2; ++p) {
            f32x16 acc[4];
#pragma unroll
            for (int nt = 0; nt < 4; ++nt)
#pragma unroll
                for (int r = 0; r < 16; ++r) acc[nt][r] = 0.f;
            const bf16* qp = qbuf + (size_t)(t0 + 32 * tt + l31) * D + h * 256 + p * 128 + 8 * l5;
            const bf16* kp = keys + (size_t)(p * 128 + l31) * 128 + 8 * l5;
#pragma unroll 4
            for (int ks = 0; ks < 8; ++ks) { const bf16x8 bq = *(const bf16x8*)(qp + 16 * ks);
#pragma unroll
                for (int nt = 0; nt < 4; ++nt) { const bf16x8 ak = *(const bf16x8*)(kp + (size_t)(32 * nt) * 128 + 16 * ks); acc[nt] = __builtin_amdgcn_mfma_f32_32x32x16_bf16(ak, bq, acc[nt], 0, 0, 0); } }
            float v[4][16];
#pragma unroll
            for (int nt = 0; nt < 4; ++nt)
#pragma unroll
                for (int r = 0; r < 16; ++r) { const unsigned idx = 32u * nt + (r & 3) + 8u * (r >> 2) + 4u * l5; v[nt][r] = __uint_as_float((__float_as_uint(acc[nt][r]) & 0xffffff80u) | idx); }
#pragma unroll
            for (int nt = 0; nt < 4; ++nt) bitonic_sort_desc<16>(v[nt]);
            merge_top16(v[0], v[1]); merge_top16(v[2], v[3]); merge_top16(v[0], v[2]);
            float o[16];
#pragma unroll
            for (int i = 0; i < 16; ++i) o[i] = __shfl_xor(v[0][i], 32);
            merge_top16(v[0], o);
#pragma unroll
            for (int i = 0; i < 16; ++i) sv[p][i] = v[0][i];
        }
        LAS unsigned char* idxb = (LAS unsigned char*)(lds + 69632) + wave * 2048 + lane * 32;
        { v4u w0, w1;
#pragma unroll
          for (int q4 = 0; q4 < 4; ++q4) {
              w0[q4] = (__float_as_uint(sv[0][4 * q4]) & 127u) | ((__float_as_uint(sv[0][4 * q4 + 1]) & 127u) << 8) | ((__float_as_uint(sv[0][4 * q4 + 2]) & 127u) << 16) | ((__float_as_uint(sv[0][4 * q4 + 3]) & 127u) << 24);
              w1[q4] = (__float_as_uint(sv[1][4 * q4]) & 127u) | ((__float_as_uint(sv[1][4 * q4 + 1]) & 127u) << 8) | ((__float_as_uint(sv[1][4 * q4 + 2]) & 127u) << 16) | ((__float_as_uint(sv[1][4 * q4 + 3]) & 127u) << 24); }
          *(LAS v4u*)(idxb) = w0; *(LAS v4u*)(idxb + 16) = w1; }
        float ck[4][16];
#pragma unroll
        for (int s = 0; s < 64; ++s) {
            if (cand_i(s) >= 0) { const unsigned b0 = __float_as_uint(sv[0][cand_i(s) < 0 ? 0 : cand_i(s)]), b1 = __float_as_uint(sv[1][cand_j(s) < 0 ? 0 : cand_j(s)]);
                const float sum = __uint_as_float(b0 & 0xffffff80u) + __uint_as_float(b1 & 0xffffff80u);
                ck[s >> 4][s & 15] = __uint_as_float((__float_as_uint(sum) & 0xffffff00u) | (unsigned)((cand_i(s) < 0 ? 0 : cand_i(s)) * 16 + (cand_j(s) < 0 ? 0 : cand_j(s)))); }
            else ck[s >> 4][s & 15] = -3.0e38f; }
        bitonic_sort_desc<16>(ck[1]); bitonic_sort_desc<16>(ck[2]);
        merge_top16(ck[0], ck[1]); merge_top16(ck[2], ck[3]); merge_top16(ck[0], ck[2]);
        LDS_WAIT(); asm volatile("" ::: "memory");
        float ex[16]; int ce[16]; float den = 0.f;
        const float cmax = __uint_as_float(__float_as_uint(ck[0][0]) & 0xffffff00u);
#pragma unroll
        for (int i = 0; i < 16; ++i) { const unsigned bits = __float_as_uint(ck[0][i]); ex[i] = __expf(__uint_as_float(bits & 0xffffff00u) - cmax); den += ex[i];
            ce[i] = (int)idxb[(bits >> 4) & 15u] * 128 + (int)idxb[16 + (bits & 15u)]; }
        const float inv = 1.0f / den;
        if (l5 == 0) {
            const int base = (32 * tt + l31) * 128 + h * 16;
#pragma unroll
            for (int i4 = 0; i4 < 4; ++i4) { *(LAS v4u*)(eg_e + base + 4 * i4) = (v4u){(unsigned)ce[4 * i4], (unsigned)ce[4 * i4 + 1], (unsigned)ce[4 * i4 + 2], (unsigned)ce[4 * i4 + 3]};
                *(LAS f32x4*)(eg_g + base + 4 * i4) = (f32x4){ex[4 * i4] * inv, ex[4 * i4 + 1] * inv, ex[4 * i4 + 2] * inv, ex[4 * i4 + 3] * inv}; }
        }
        LDS_WAIT(); asm volatile("" ::: "memory");
    }
}

typedef unsigned char uc4 __attribute__((ext_vector_type(4)));
constexpr int NSLICE = 16, SLICE_SHIFT = 10;
__device__ __forceinline__ int sdot4i(unsigned w, unsigned x, int acc) { return __builtin_amdgcn_sdot4((int)w, (int)x, acc, false); }
__device__ __forceinline__ void fma_ub4(unsigned w, float s, float& y0, float& y1, float& y2, float& y3) { const uc4 b = __builtin_bit_cast(uc4, w); y0 += s * (float)b.x; y1 += s * (float)b.y; y2 += s * (float)b.z; y3 += s * (float)b.w; }
#if TAB4
__device__ __forceinline__ void peer_tail(const Args& a, int l, int t, int lane, const bf16* Yrow, const float* mb, const float* mbn, bool last) {
    const float* x1buf = (const float*)(a.ws + WS_X1);
    float z[32];
#pragma unroll
    for (int c8 = 0; c8 < 8; ++c8) { const int col = (c8 * 64 + lane) * 4;
        const v2u yb = *(const v2u*)(Yrow + col); const f32x4 yv = (f32x4){bflo(yb.x), bfhi(yb.x), bflo(yb.y), bfhi(yb.y)};
#if RES16_X1
        const v2u xb_ = *(const v2u*)((const bf16*)x1buf + (size_t)t * D + col); const f32x4 x0 = (f32x4){bflo(xb_.x), bfhi(xb_.x), bflo(xb_.y), bfhi(xb_.y)}, g0 = *(const f32x4*)(mb + 5 * D + col);
#else
        const f32x4 x0 = *(const f32x4*)(x1buf + (size_t)t * D + col), g0 = *(const f32x4*)(mb + 5 * D + col);
#endif
        z[c8 * 4] = ALPHA * x0.x + (1.f + g0.x) * yv.x; z[c8 * 4 + 1] = ALPHA * x0.y + (1.f + g0.y) * yv.y; z[c8 * 4 + 2] = ALPHA * x0.z + (1.f + g0.z) * yv.z; z[c8 * 4 + 3] = ALPHA * x0.w + (1.f + g0.w) * yv.w; }
    ln_tail(z, t, lane, a.in[17] + (size_t)l * D, a.in[18] + (size_t)l * D, last ? a.out : (RES16_X ? (float*)nullptr : (float*)(a.ws + WS_X)), mbn, mbn + D, (last || I8_GATE) ? (bf16*)nullptr : (bf16*)(a.ws + WS_H), nullptr, nullptr, nullptr, last ? (unsigned char*)nullptr : a.ws + WS_H8, (float*)(a.ws + WS_SAH), (RES16_X && !last) ? (bf16*)(a.ws + WS_X) : (bf16*)nullptr);
}
template <class TT, int N, int M> __device__ __forceinline__ void treduce(TT (&v)[N], int lane) {
    const bool c0 = (lane & M) != 0, c1 = (lane & (2 * M)) != 0, c2 = (lane & (4 * M)) != 0;
#pragma unroll
    for (int m = 0; m < N / 2; ++m) { const TT keep = c0 ? v[2 * m + 1] : v[2 * m], send = c0 ? v[2 * m] : v[2 * m + 1]; v[m] = keep + __shfl_xor(send, M); }
#pragma unroll
    for (int m = 0; m < N / 4; ++m) { const TT keep = c1 ? v[2 * m + 1] : v[2 * m], send = c1 ? v[2 * m] : v[2 * m + 1]; v[m] = keep + __shfl_xor(send, 2 * M); }
#pragma unroll
    for (int m = 0; m < N / 8; ++m) { const TT keep = c2 ? v[2 * m + 1] : v[2 * m], send = c2 ? v[2 * m] : v[2 * m + 1]; v[m] = keep + __shfl_xor(send, 4 * M); }
}
__device__ __forceinline__ int allsum_8_16_32(int x) {
    x += __builtin_amdgcn_update_dpp(0, x, 0x128, 0xf, 0xf, false);
    { const auto r = __builtin_amdgcn_permlane16_swap((unsigned)x, (unsigned)x, false, false); x = (int)(r[0] + r[1]); }
    { const auto r = __builtin_amdgcn_permlane32_swap((unsigned)x, (unsigned)x, false, false); x = (int)(r[0] + r[1]); }
    return x; }
__device__ __forceinline__ float allmax_8_16_32(float x) {
    x = fmaxf(x, __uint_as_float((unsigned)__builtin_amdgcn_update_dpp(0, (int)__float_as_uint(x), 0x128, 0xf, 0xf, false)));
    { const auto r = __builtin_amdgcn_permlane16_swap(__float_as_uint(x), __float_as_uint(x), false, false); x = fmaxf(__uint_as_float(r[0]), __uint_as_float(r[1])); }
    { const auto r = __builtin_amdgcn_permlane32_swap(__float_as_uint(x), __float_as_uint(x), false, false); x = fmaxf(__uint_as_float(r[0]), __uint_as_float(r[1])); }
    return x; }
__device__ __forceinline__ void treduce32x8(int (&v)[32], int lane) {
    const bool c0 = (lane & 8) != 0;
#pragma unroll
    for (int m = 0; m < 16; ++m) { const int keep = c0 ? v[2 * m + 1] : v[2 * m], send = c0 ? v[2 * m] : v[2 * m + 1]; v[m] = keep + __builtin_amdgcn_update_dpp(0, send, 0x128, 0xf, 0xf, false); }
#pragma unroll
    for (int m = 0; m < 8; ++m) { const auto r = __builtin_amdgcn_permlane16_swap((unsigned)v[2 * m], (unsigned)v[2 * m + 1], false, false); v[m] = (int)(r[0] + r[1]); }
#pragma unroll
    for (int m = 0; m < 4; ++m) { const auto r = __builtin_amdgcn_permlane32_swap((unsigned)v[2 * m], (unsigned)v[2 * m + 1], false, false); v[m] = (int)(r[0] + r[1]); }
}
__device__ __forceinline__ void tr4x4(unsigned a, unsigned b, unsigned c, unsigned d, unsigned& t0, unsigned& t1, unsigned& t2, unsigned& t3) {
    const unsigned x0 = __builtin_amdgcn_perm(b, a, 0x05010400u), x1 = __builtin_amdgcn_perm(b, a, 0x07030602u), y0 = __builtin_amdgcn_perm(d, c, 0x05010400u), y1 = __builtin_amdgcn_perm(d, c, 0x07030602u);
    t0 = __builtin_amdgcn_perm(y0, x0, 0x05040100u); t1 = __builtin_amdgcn_perm(y0, x0, 0x07060302u); t2 = __builtin_amdgcn_perm(y1, x1, 0x05040100u); t3 = __builtin_amdgcn_perm(y1, x1, 0x07060302u);
}
__device__ __forceinline__ int sdot8i(unsigned w, unsigned x, int acc) { return __builtin_amdgcn_sdot8((int)w, (int)x, acc, false); }
__device__ __forceinline__ float slot_scale(unsigned w3) { return __builtin_amdgcn_exp2f((float)(w3 >> 24) * 0.125f - 16.0f); }
__device__ __forceinline__ void peer_experts(const Args& a, int l, LAS unsigned char* lds, int lane0, int wave, int ch) {
    const float* mod = (const float*)(a.ws + WS_MOD);
    const unsigned char* ut = a.ws + WS_UT + (size_t)l * NE * 1152; const unsigned char* vt = a.ws + WS_VT + (size_t)l * NE * 1152; const unsigned char* hq8 = a.ws + WS_HQ8;
    const float* hsc = (const float*)(a.ws + WS_HSC);
    bf16* Ybuf = (bf16*)(a.ws + WS_Z);
    const LAS int* eg_e = (const LAS int*)lds; LAS float* sw = (LAS float*)(lds + 32768);
    LAS float* apart = (LAS float*)(lds + 65536);
    const int b = ch / NCH; const bool last = (l == NL - 1);
    const float* mb = mod + ((size_t)l * NB + b) * 6 * D; const float* mbn = mod + ((size_t)(last ? l : l + 1) * NB + b) * 6 * D;
    const int tlw = wave * 8;
    { const int lane = lane0;
#pragma unroll
      for (int i = 0; i < 16; ++i) apart[tlw * 128 + i * 64 + lane] = 0.f; }
    LDS_WAIT(); asm volatile("" ::: "memory");
    {
        int laneL = lane0; asm volatile("" : "+v"(laneL)); const int lane = laneL;
        const int g = lane >> 3, l7 = lane & 7;
        v4u bufA[16], bufB[16], hA0, hA1, hB0, hB1;
#define CU_LOAD(buf, h0_, h1_, idx_) do { const int u_ = (idx_) >> 3, tl_ = tlw + ((idx_) & 7); const unsigned soff_ = (unsigned)(u_ * 128 + l7 * 16); \
            const unsigned char* hp_ = hq8 + (size_t)(ch * 64 + tl_) * 2304 + (u_ * 8 + l7) * 32; h0_ = *(const v4u*)hp_; h1_ = *(const v4u*)(hp_ + 16); \
            _Pragma("unroll") for (int i_ = 0; i_ < 16; ++i_) { const unsigned e_ = (unsigned)eg_e[tl_ * 128 + 8 * i_ + g]; buf[i_] = *(const v4u*)(ut + (size_t)(e_ * 1152u + soff_)); } } while (0)
#define CU_COMP(buf, h0_, h1_, idx_) do { const int tl_ = tlw + ((idx_) & 7); float accv_[16]; \
            _Pragma("unroll") for (int i_ = 0; i_ < 16; ++i_) { int sl_ = 0, sh_ = 0; \
                _Pragma("unroll") for (int d_ = 0; d_ < 4; ++d_) { const unsigned x_ = buf[i_][d_] ^ 0x88888888u; sl_ = sdot8i(x_, h0_[d_], sl_); sh_ = sdot8i(x_, h1_[d_], sh_); } \
                accv_[i_] = slot_scale(buf[i_][3]) * (float)(16 * sh_ + sl_); } \
            treduce<float, 16, 1>(accv_, lane); \
            apart[tl_ * 128 + 8 * l7 + g] += accv_[0]; apart[tl_ * 128 + 8 * (8 + l7) + g] += accv_[1]; } while (0)
        CU_LOAD(bufA, hA0, hA1, 0);
        for (int idx = 0; idx < 72; idx += 2) {
            CU_LOAD(bufB, hB0, hB1, idx + 1);
            CU_COMP(bufA, hA0, hA1, idx);
            { const int nx_ = idx + 2 < 72 ? idx + 2 : 71; CU_LOAD(bufA, hA0, hA1, nx_); }
            CU_COMP(bufB, hB0, hB1, idx + 1);
        }
#undef CU_LOAD
#undef CU_COMP
        LDS_WAIT(); asm volatile("" ::: "memory");
        for (int it = 0; it < 8; ++it) { const int tl = tlw + it; const float shs = hsc[ch * 64 + tl];
            const float w0 = sw[tl * 128 + lane] * gelu_tanh_f(apart[tl * 128 + lane] * shs), w1 = sw[tl * 128 + 64 + lane] * gelu_tanh_f(apart[tl * 128 + 64 + lane] * shs);
            sw[tl * 128 + lane] = w0; sw[tl * 128 + 64 + lane] = w1; }
        LDS_WAIT(); asm volatile("" ::: "memory");
    }
    {
        int laneL = lane0; asm volatile("" : "+v"(laneL)); const int lane = laneL;
        const int g = lane >> 3, l7 = lane & 7;
        v4u bufA[16], bufB[16];
#define CV_LOAD(buf, idx_) do { const int u_ = (idx_) >> 3, tl_ = tlw + ((idx_) & 7); const unsigned soff_ = (unsigned)(u_ * 128 + l7 * 16); \
            _Pragma("unroll") for (int i_ = 0; i_ < 16; ++i_) { const unsigned e_ = (unsigned)eg_e[tl_ * 128 + 8 * i_ + g]; buf[i_] = *(const v4u*)(vt + (size_t)(e_ * 1152u + soff_)); } } while (0)
#define CV_COMP(buf, idx_) do { const int u_ = (idx_) >> 3, tl_ = tlw + ((idx_) & 7); \
            float wf_[16]; float wmx_ = 0.f; \
            _Pragma("unroll") for (int i_ = 0; i_ < 16; ++i_) { wf_[i_] = sw[tl_ * 128 + 8 * i_ + g] * slot_scale(buf[i_][3]); wmx_ = fmaxf(wmx_, fabsf(wf_[i_])); } \
            wmx_ = allmax_8_16_32(wmx_);     \
            const float winv_ = wmx_ > 0.f ? 127.0f / wmx_ : 0.f, wsc_ = wmx_ * (1.0f / 127.0f); \
              \
            unsigned wq4_[4]; int wsum_ = 0; \
            _Pragma("unroll") for (int gp_ = 0; gp_ < 4; ++gp_) { \
                const unsigned m0_ = __float_as_uint(wf_[4 * gp_] * winv_ + 12582912.0f), m1_ = __float_as_uint(wf_[4 * gp_ + 1] * winv_ + 12582912.0f), m2_ = __float_as_uint(wf_[4 * gp_ + 2] * winv_ + 12582912.0f), m3_ = __float_as_uint(wf_[4 * gp_ + 3] * winv_ + 12582912.0f); \
                wq4_[gp_] = __builtin_amdgcn_perm(__builtin_amdgcn_perm(m3_, m2_, 0x0c0c0400u), __builtin_amdgcn_perm(m1_, m0_, 0x0c0c0400u), 0x05040100u); \
                wsum_ = sdot4i(wq4_[gp_], 0x01010101u, wsum_); } \
            int yi_[32]; \
            _Pragma("unroll") for (int q_ = 0; q_ < 32; ++q_) yi_[q_] = 0; \
            _Pragma("unroll") for (int gp_ = 0; gp_ < 4; ++gp_) { \
                _Pragma("unroll") for (int d_ = 0; d_ < 4; ++d_) { const unsigned A_ = buf[4 * gp_][d_], B_ = buf[4 * gp_ + 1][d_], C_ = buf[4 * gp_ + 2][d_], D_ = buf[4 * gp_ + 3][d_]; \
                    unsigned t0_, t1_, t2_, t3_; \
                    tr4x4(A_, B_, C_, D_, t0_, t1_, t2_, t3_);     \
                    yi_[8 * d_]     = sdot4i(t0_ & 0x0f0f0f0fu, wq4_[gp_], yi_[8 * d_]);     yi_[8 * d_ + 1] = sdot4i((t0_ >> 4) & 0x0f0f0f0fu, wq4_[gp_], yi_[8 * d_ + 1]); \
                    yi_[8 * d_ + 2] = sdot4i(t1_ & 0x0f0f0f0fu, wq4_[gp_], yi_[8 * d_ + 2]); yi_[8 * d_ + 3] = sdot4i((t1_ >> 4) & 0x0f0f0f0fu, wq4_[gp_], yi_[8 * d_ + 3]); \
                    yi_[8 * d_ + 4] = sdot4i(t2_ & 0x0f0f0f0fu, wq4_[gp_], yi_[8 * d_ + 4]); yi_[8 * d_ + 5] = sdot4i((t2_ >> 4) & 0x0f0f0f0fu, wq4_[gp_], yi_[8 * d_ + 5]); \
                    yi_[8 * d_ + 6] = sdot4i(t3_ & 0x0f0f0f0fu, wq4_[gp_], yi_[8 * d_ + 6]); yi_[8 * d_ + 7] = sdot4i((t3_ >> 4) & 0x0f0f0f0fu, wq4_[gp_], yi_[8 * d_ + 7]); } } \
            treduce32x8(yi_, lane); \
            wsum_ = allsum_8_16_32(wsum_);     \
            float y_[4]; \
            _Pragma("unroll") for (int q_ = 0; q_ < 4; ++q_) y_[q_] = wsc_ * (float)(yi_[q_] - 8 * wsum_); \
            { const int colb_ = u_ * 240 + l7 * 30 + g; bf16* yr_ = Ybuf + (size_t)(ch * 64 + tl_) * D + colb_; \
              _Pragma("unroll") for (int m_ = 0; m_ < 4; ++m_) if (8 * m_ + g < 30 && colb_ + 8 * m_ < D) yr_[8 * m_] = (bf16)(pk2(y_[m_], 0.f) & 0xffffu); } } while (0)
        CV_LOAD(bufA, 0);
        for (int idx = 0; idx < 72; idx += 2) {
            CV_LOAD(bufB, idx + 1);
            CV_COMP(bufA, idx);
            { const int nx_ = idx + 2 < 72 ? idx + 2 : 71; CV_LOAD(bufA, nx_); }
            CV_COMP(bufB, idx + 1);
        }
#undef CV_LOAD
#undef CV_COMP
    }
    asm volatile("s_waitcnt vmcnt(0)" ::: "memory");
    __builtin_amdgcn_fence(__ATOMIC_ACQUIRE, "agent");
    asm volatile("s_waitcnt vmcnt(0)" ::: "memory");
    for (int it = 0; it < 8; ++it) { int laneT = lane0; asm volatile("" : "+v"(laneT)); const int t = ch * 64 + tlw + it;
        peer_tail(a, l, t, laneT, Ybuf + (size_t)t * D, mb, mbn, last); }
}
#else
__device__ __forceinline__ void peer_tail(const Args& a, int l, int t, int lane, const float* Yrow, const float* mb, const float* mbn, bool last) {
    const float* x1buf = (const float*)(a.ws + WS_X1);
    float z[32];
#pragma unroll
    for (int c = 0; c < 2; ++c)
#pragma unroll
        for (int k = 0; k < 4; ++k) { const int c8 = 4 * c + k, col = (c8 * 64 + lane) * 4;
            const v2u yb = *(const v2u*)((const bf16*)Yrow + (c * 64 + lane) * 16 + 4 * k); const f32x4 yv = (f32x4){bflo(yb.x), bfhi(yb.x), bflo(yb.y), bfhi(yb.y)};
#if RES16_X1
            const v2u xb_ = *(const v2u*)((const bf16*)x1buf + (size_t)t * D + col); const f32x4 x0 = (f32x4){bflo(xb_.x), bfhi(xb_.x), bflo(xb_.y), bfhi(xb_.y)}, g0 = *(const f32x4*)(mb + 5 * D + col);
#else
            const f32x4 x0 = *(const f32x4*)(x1buf + (size_t)t * D + col), g0 = *(const f32x4*)(mb + 5 * D + col);
#endif
            z[c8 * 4] = ALPHA * x0.x + (1.f + g0.x) * yv.x; z[c8 * 4 + 1] = ALPHA * x0.y + (1.f + g0.y) * yv.y; z[c8 * 4 + 2] = ALPHA * x0.z + (1.f + g0.z) * yv.z; z[c8 * 4 + 3] = ALPHA * x0.w + (1.f + g0.w) * yv.w; }
    ln_tail(z, t, lane, a.in[17] + (size_t)l * D, a.in[18] + (size_t)l * D, last ? a.out : (RES16_X ? (float*)nullptr : (float*)(a.ws + WS_X)), mbn, mbn + D, (last || I8_GATE) ? (bf16*)nullptr : (bf16*)(a.ws + WS_H), nullptr, nullptr, nullptr, last ? (unsigned char*)nullptr : a.ws + WS_H8, (float*)(a.ws + WS_SAH), (RES16_X && !last) ? (bf16*)(a.ws + WS_X) : (bf16*)nullptr);
}
template <class TT, int M> __device__ __forceinline__ void treduce16(TT (&v)[16], int lane) {
    const bool c0 = (lane & M) != 0, c1 = (lane & (2 * M)) != 0, c2 = (lane & (4 * M)) != 0;
#pragma unroll
    for (int m = 0; m < 8; ++m) { const TT keep = c0 ? v[2 * m + 1] : v[2 * m], send = c0 ? v[2 * m] : v[2 * m + 1]; v[m] = keep + __shfl_xor(send, M); }
#pragma unroll
    for (int m = 0; m < 4; ++m) { const TT keep = c1 ? v[2 * m + 1] : v[2 * m], send = c1 ? v[2 * m] : v[2 * m + 1]; v[m] = keep + __shfl_xor(send, 2 * M); }
#pragma unroll
    for (int m = 0; m < 2; ++m) { const TT keep = c2 ? v[2 * m + 1] : v[2 * m], send = c2 ? v[2 * m] : v[2 * m + 1]; v[m] = keep + __shfl_xor(send, 4 * M); }
}
__device__ __forceinline__ void peer_experts(const Args& a, int l, LAS unsigned char* lds, int lane0, int wave, int ch) {
    const float* mod = (const float*)(a.ws + WS_MOD);
    const unsigned char* ut = a.ws + WS_UT + (size_t)l * NE * D; const unsigned char* vt = a.ws + WS_VT + (size_t)l * NE * D; const unsigned char* hq8 = a.ws + WS_HQ8;
    const float* su = (const float*)(a.ws + WS_SU) + (size_t)l * NE; const float* sv = (const float*)(a.ws + WS_SV) + (size_t)l * NE; const float* hsc = (const float*)(a.ws + WS_HSC);
    float* Ybuf = (float*)(a.ws + WS_Z);
    const LAS int* eg_e = (const LAS int*)lds; LAS float* sw = (LAS float*)(lds + 32768);
    LAS int* apart = (LAS int*)(lds + 65536); LAS float* wtotl = (LAS float*)(lds + LDSCTL_OFF + 256);
    const int b = ch / NCH; const bool last = (l == NL - 1);
    const float* mb = mod + ((size_t)l * NB + b) * 6 * D; const float* mbn = mod + ((size_t)(last ? l : l + 1) * NB + b) * 6 * D;
    const int tlw = wave * 8;
    { const int lane = lane0;
#pragma unroll
      for (int i = 0; i < 16; ++i) apart[tlw * 128 + i * 64 + lane] = 0; }
    LDS_WAIT(); asm volatile("" ::: "memory");
    {
        int laneL = lane0; asm volatile("" : "+v"(laneL)); const int lane = laneL;
        const int g = lane >> 3, l7 = lane & 7;
        v4u bufA[16], bufB[16], hA, hB;
#define CU_LOAD(buf, hh_, idx_) do { const int cs_ = (idx_) >> 3, tl_ = tlw + ((idx_) & 7); const unsigned coff_ = (unsigned)(cs_ * 128 + l7 * 16); \
            hh_ = *(const v4u*)(hq8 + (size_t)(ch * 64 + tl_) * D + coff_); \
            _Pragma("unroll") for (int i_ = 0; i_ < 16; ++i_) { const unsigned e_ = (unsigned)eg_e[tl_ * 128 + 8 * i_ + g]; buf[i_] = *(const v4u*)(ut + (size_t)(e_ * 2048u + coff_)); } } while (0)
#define CU_COMP(buf, hh_, idx_) do { const int tl_ = tlw + ((idx_) & 7); int acc_[16]; \
            _Pragma("unroll") for (int i_ = 0; i_ < 16; ++i_) { int s_ = 0; _Pragma("unroll") for (int q_ = 0; q_ < 4; ++q_) s_ = sdot4i(buf[i_][q_], hh_[q_], s_); acc_[i_] = s_; } \
            treduce16<int, 1>(acc_, lane); \
            apart[tl_ * 128 + 8 * l7 + g] += acc_[0]; apart[tl_ * 128 + 8 * (8 + l7) + g] += acc_[1]; } while (0)
        CU_LOAD(bufA, hA, 0);
        for (int idx = 0; idx < 128; idx += 2) {
            CU_LOAD(bufB, hB, idx + 1);
            CU_COMP(bufA, hA, idx);
            if (idx + 2 < 128) CU_LOAD(bufA, hA, idx + 2);
            CU_COMP(bufB, hB, idx + 1);
        }
#undef CU_LOAD
#undef CU_COMP
        LDS_WAIT(); asm volatile("" ::: "memory");
        for (int it = 0; it < 8; ++it) { const int tl = tlw + it; const float shs = hsc[ch * 64 + tl];
            const int e0 = eg_e[tl * 128 + lane], e1 = eg_e[tl * 128 + 64 + lane];
            const float w0 = sw[tl * 128 + lane] * gelu_tanh_f((float)apart[tl * 128 + lane] * su[e0] * shs) * sv[e0];
            const float w1 = sw[tl * 128 + 64 + lane] * gelu_tanh_f((float)apart[tl * 128 + 64 + lane] * su[e1] * shs) * sv[e1];
            sw[tl * 128 + lane] = w0; sw[tl * 128 + 64 + lane] = w1;
            const float ws = wave_sum(w0 + w1);
            if (lane == 0) wtotl[tl] = ws; }
        LDS_WAIT(); asm volatile("" ::: "memory");
    }
    {
        int laneL = lane0; asm volatile("" : "+v"(laneL)); const int lane = laneL;
        const int g = lane >> 3, l7 = lane & 7;
        v4u bufA[16], bufB[16];
#define CV_LOAD(buf, idx_) do { const int cs_ = (idx_) >> 3, tl_ = tlw + ((idx_) & 7); const unsigned coff_ = (unsigned)(cs_ * 128 + l7 * 16); \
            _Pragma("unroll") for (int i_ = 0; i_ < 16; ++i_) { const unsigned e_ = (unsigned)eg_e[tl_ * 128 + 8 * i_ + g]; buf[i_] = *(const v4u*)(vt + (size_t)(e_ * 2048u + coff_)); } } while (0)
#define CV_COMP(buf, idx_) do { const int cs_ = (idx_) >> 3, tl_ = tlw + ((idx_) & 7); float y_[16]; \
            _Pragma("unroll") for (int q_ = 0; q_ < 16; ++q_) y_[q_] = 0.f; \
            _Pragma("unroll") for (int i_ = 0; i_ < 16; ++i_) { const float wr_ = sw[tl_ * 128 + 8 * i_ + g]; \
                _Pragma("unroll") for (int q_ = 0; q_ < 4; ++q_) fma_ub4(buf[i_][q_], wr_, y_[4 * q_], y_[4 * q_ + 1], y_[4 * q_ + 2], y_[4 * q_ + 3]); } \
            treduce16<float, 8>(y_, lane); \
            const float woff_ = 128.0f * wtotl[tl_]; bf16* yr_ = (bf16*)Ybuf + (size_t)(ch * 64 + tl_) * D + cs_ * 128 + l7 * 16 + g; \
            yr_[0] = (bf16)(pk2(y_[0] - woff_, 0.f) & 0xffffu); yr_[8] = (bf16)(pk2(y_[1] - woff_, 0.f) & 0xffffu); } while (0)
        CV_LOAD(bufA, 0);
        for (int idx = 0; idx < 128; idx += 2) {
            CV_LOAD(bufB, idx + 1);
            CV_COMP(bufA, idx);
            if (idx + 2 < 128) CV_LOAD(bufA, idx + 2);
            CV_COMP(bufB, idx + 1);
        }
#undef CV_LOAD
#undef CV_COMP
    }
    asm volatile("s_waitcnt vmcnt(0)" ::: "memory");
    __builtin_amdgcn_fence(__ATOMIC_ACQUIRE, "agent");
    asm volatile("s_waitcnt vmcnt(0)" ::: "memory");
    for (int it = 0; it < 8; ++it) { int laneT = lane0; asm volatile("" : "+v"(laneT)); const int t = ch * 64 + tlw + it;
        peer_tail(a, l, t, laneT, (const float*)((const bf16*)Ybuf + (size_t)t * D), mb, mbn, last); }
}

#endif

#ifndef MK_PER_PHASE
#define MK_PER_PHASE 0
#endif
__global__ void __launch_bounds__(NTHREADS, 2) mk_fwd(Args a) {
    extern __shared__ __attribute__((aligned(16))) unsigned char lds_raw[];
    LAS unsigned char* lds = (LAS unsigned char*)lds_raw;
    const int tid = threadIdx.x, lane = tid & 63, wave = __builtin_amdgcn_readfirstlane(tid >> 6), G = gridDim.x, bx = blockIdx.x;
    if (tid < 64) ((LAS unsigned*)(lds + LDSCTL_OFF))[tid] = 0u;
    __syncthreads();
    unsigned* ctl = (unsigned*)(a.ws + WS_CTL);
    XcdBarrier bar; bar.bar = ctl + CW_BAR; bar.x = 0; bar.st = nullptr;
    const bool use_bar = (a.ph_hi - a.ph_lo) > 1;
    if (use_bar) bar = xcd_barrier_post(ctl + CW_BAR, (volatile LAS unsigned*)(lds + LDSCTL_OFF));
    const int lo = a.ph_lo, hi = a.ph_hi;
#ifndef PH_MASK
#define PH_MASK 0x1ff
#endif
#define IN(k) (lo <= (k) && (k) < hi)
#define EN(b) ((PH_MASK >> (b)) & 1)
#ifndef REP_MASK
#define REP_MASK 0
#endif
#ifndef REP_EXTRA
#define REP_EXTRA 2
#endif
#define REPS(b) (1 + ((REP_MASK >> (b)) & 1) * REP_EXTRA)
#define REP_BEGIN(b) for (int rep_ = 0; rep_ < REPS(b); ++rep_) {
#define REP_END(b) if (rep_ + 1 < REPS(b)) xcd_barrier(bar); }
#define SEAM(k) do { if (IN((k) + 1)) xcd_barrier(bar); } while (0)
#define PHASE_IDS() int tidp = tid; asm volatile("" : "+v"(tidp)); const int lanep = tidp & 63, wavep = __builtin_amdgcn_readfirstlane(tidp >> 6); (void)lanep; (void)wavep
    if (EN(0) && IN(0)) { REP_BEGIN(0) PHASE_IDS(); ph_prologue_a(a, lds, tidp, lanep, wavep, bx, G); REP_END(0) SEAM(0); }
    if (EN(1) && IN(1)) { REP_BEGIN(1) PHASE_IDS(); ph_prologue_b(a, lds, tidp, lanep, wavep, bx, G); REP_END(1) SEAM(1); }
    for (int l = 0; l < NL; ++l) {
        const int pb = 2 + 7 * l;
        const float* mod = (const float*)(a.ws + WS_MOD);
        if (EN(2) && IN(pb + 0)) {
            REP_BEGIN(2) PHASE_IDS();
#if I8_IN
            pg8::Gemm g{(const pg8::bf16_t*)(a.ws + WS_H8), (const pg8::bf16_t*)(a.ws + WS_WIN8 + (size_t)l * NP * D), T, NP, D / 2}; pg8::StaticOrder S; S.init(T, NP, G, bx, WGM_IN, KROT(bx));
            pg8::EpiBf16PS E{(pg8::bf16_t*)(a.ws + WS_PROJ), NP, (const float*)(a.ws + WS_SAH), (const float*)(a.ws + WS_SB) + l * SBL};
            pg8::gemm_phase<pg8::EpiBf16PS, pg8::StaticOrder, true, true, true>(lds + RING_OFF, g, S, E, tidp);
#else
            pg8::Gemm g{(const pg8::bf16_t*)(a.ws + WS_H), (const pg8::bf16_t*)(a.ws + WS_WIN) + (size_t)l * INW * D, T, NP, D}; pg8::StaticOrder S; S.init(T, NP, G, bx, WGM_IN, KROT(bx));
            pg8::EpiBf16P E{(pg8::bf16_t*)(a.ws + WS_PROJ), NP};
            pg8::gemm_phase<pg8::EpiBf16P, pg8::StaticOrder, true, true>(lds + RING_OFF, g, S, E, tidp);
#endif
#ifndef GP_REP
#define GP_REP 1
#endif
            for (int gpr_ = 0; gpr_ < GP_REP; ++gpr_) for (int ch = bx; ch < NCHUNK; ch += G) gate_prep(a, l, lds, tidp, lanep, wavep, ch);
            REP_END(2) SEAM(pb + 0);
        }
        if (EN(3) && IN(pb + 1)) { REP_BEGIN(3) PHASE_IDS(); for (int un = bx; un < 256; un += G) gla_unit(a, lds, tidp, lanep, wavep, un); REP_END(3) SEAM(pb + 1); }
        if (EN(4) && IN(pb + 2)) { REP_BEGIN(4) PHASE_IDS(); for (int ch = bx; ch < NCHUNK; ch += G) mixpost_chunk(a, l, lanep, wavep, ch); REP_END(4) SEAM(pb + 2); }
        if (EN(5) && IN(pb + 3)) {
            REP_BEGIN(5) PHASE_IDS();
#if I8_OUT
            pg8::Gemm g{(const pg8::bf16_t*)(a.ws + WS_Y8), (const pg8::bf16_t*)(a.ws + WS_WOUT8 + (size_t)l * D * D), T, D, D / 2}; pg8::StaticOrder S; S.init(T, D, G, bx, WGM_OUT, KROT(bx));
#if RES16_X || RES16_Z
            pg8::EpiResidS16<(RES16_X != 0), (RES16_Z != 0)> E{(void*)(a.ws + WS_Z), (RES16_X || l > 0) ? (const void*)(a.ws + WS_X) : (const void*)a.in[0], mod + (size_t)l * NB * 6 * D + 2 * D, (const float*)(a.ws + WS_SAY), (const float*)(a.ws + WS_SB) + l * SBL + NP, ALPHA};
            pg8::gemm_phase<pg8::EpiResidS16<(RES16_X != 0), (RES16_Z != 0)>, pg8::StaticOrder, true, true, true>(lds + RING_OFF, g, S, E, tidp);
#else
            pg8::EpiResidS E{(float*)(a.ws + WS_Z), l == 0 ? a.in[0] : (const float*)(a.ws + WS_X), mod + (size_t)l * NB * 6 * D + 2 * D, (const float*)(a.ws + WS_SAY), (const float*)(a.ws + WS_SB) + l * SBL + NP, ALPHA};
            pg8::gemm_phase<pg8::EpiResidS, pg8::StaticOrder, true, true, true>(lds + RING_OFF, g, S, E, tidp);
#endif
#else
            pg8::Gemm g{(const pg8::bf16_t*)(a.ws + WS_Y), (const pg8::bf16_t*)(a.ws + WS_WOUT) + (size_t)l * D * D, T, D, D}; pg8::StaticOrder S; S.init(T, D, G, bx, WGM_OUT, KROT(bx));
            pg8::EpiResid E{(float*)(a.ws + WS_Z), l == 0 ? a.in[0] : (const float*)(a.ws + WS_X), mod + (size_t)l * NB * 6 * D + 2 * D, ALPHA};
            pg8::gemm_phase<pg8::EpiResid, pg8::StaticOrder, true, true>(lds + RING_OFF, g, S, E, tidp);
#endif
            REP_END(5) SEAM(pb + 3);
        }
        if (EN(6) && IN(pb + 4)) { REP_BEGIN(6) PHASE_IDS(); for (int ch = bx; ch < NCHUNK; ch += G) ln1_chunk(a, l, lds, lanep, wavep, ch); REP_END(6) SEAM(pb + 4); }
        if (EN(7) && IN(pb + 5)) {
            REP_BEGIN(7) PHASE_IDS();
#if I8_WQ
            pg8::Gemm g{(const pg8::bf16_t*)(a.ws + WS_H28), (const pg8::bf16_t*)(a.ws + WS_WQ8 + (size_t)l * D * D), T, D, D / 2}; pg8::StaticOrder S; S.init(T, D, G, bx, WGM_WQ, KROT(bx));
            pg8::EpiBf16PS E{(pg8::bf16_t*)(a.ws + WS_Q), D, (const float*)(a.ws + WS_HSC), (const float*)(a.ws + WS_SB) + l * SBL + NP + D};
            pg8::gemm_phase<pg8::EpiBf16PS, pg8::StaticOrder, true, true, true>(lds + RING_OFF, g, S, E, tidp);
#else
            pg8::Gemm g{(const pg8::bf16_t*)(a.ws + WS_H2), (const pg8::bf16_t*)(a.ws + WS_WQ) + (size_t)l * D * D, T, D, D}; pg8::StaticOrder S; S.init(T, D, G, bx, WGM_WQ, KROT(bx));
            pg8::EpiBf16P E{(pg8::bf16_t*)(a.ws + WS_Q), D};
            pg8::gemm_phase<pg8::EpiBf16P, pg8::StaticOrder, true, true>(lds + RING_OFF, g, S, E, tidp);
#endif
            REP_END(7) SEAM(pb + 5);
        }
#ifndef PEER_DBG
#define PEER_DBG 0
#endif
#ifndef PE_REP_R
#define PE_REP_R 1
#endif
#ifndef L2PROBE
#define L2PROBE 0
#endif
        if (EN(8) && IN(pb + 6)) {
            REP_BEGIN(8)
            for (int ch = bx; ch < NCHUNK; ch += G) { for (int repr_ = 0; repr_ < PE_REP_R; ++repr_) { PHASE_IDS(); peer_retrieve(a, l, lds, lanep, wavep, ch); __syncthreads(); } __syncthreads(); { PHASE_IDS(); peer_experts(a, l, lds, lanep, wavep, ch); } __syncthreads(); }
            REP_END(8) SEAM(pb + 6);
        }
    }
#undef IN
#undef SEAM
}

extern "C" void kernel_launch(void* const* d_in, const int* in_sizes, int n_in, void* d_out, int out_size, void* d_ws, size_t ws_size, hipStream_t stream) {
    static int grid = 0;
    if (grid == 0) {
        if (n_in != 19 || in_sizes[0] != T * D || out_size != T * D || ws_size < WS_END) { fprintf(stderr, "kernel_launch: unexpected shapes / workspace (%d inputs, ws %zu); nothing launched\n", n_in, ws_size); grid = -1; return; }
        int dev = 0, cus = 0, per_cu = 0;
        if (hipGetDevice(&dev) != hipSuccess || hipDeviceGetAttribute(&cus, hipDeviceAttributeMultiprocessorCount, dev) != hipSuccess) { grid = -1; return; }
        if (hipFuncSetAttribute((const void*)mk_fwd, hipFuncAttributeMaxDynamicSharedMemorySize, LDS_BYTES) != hipSuccess) { fprintf(stderr, "kernel_launch: hipFuncSetAttribute failed\n"); grid = -1; return; }
        if (hipOccupancyMaxActiveBlocksPerMultiprocessor(&per_cu, (const void*)mk_fwd, NTHREADS, LDS_BYTES) != hipSuccess || per_cu < 1) fprintf(stderr, "kernel_launch: occupancy query reports %d\n", per_cu);
        (void)hipGetLastError();
        grid = cus;
    }
    if (grid < 0) return;
    if (hipMemsetAsync((char*)d_ws + WS_CTL, 0, CTL_ZERO_BYTES, stream) != hipSuccess) return;
    Args a{};
    for (int i = 0; i < 19; ++i) a.in[i] = (const float*)d_in[i];
    a.out = (float*)d_out; a.ws = (unsigned char*)d_ws;
#if MK_PER_PHASE
    for (int p = 0; p < NPHASES; ++p) { a.ph_lo = p; a.ph_hi = p + 1; hipLaunchKernelGGL(mk_fwd, dim3(grid), dim3(NTHREADS), LDS_BYTES, stream, a); }
#else
    a.ph_lo = 0; a.ph_hi = NPHASES;
    hipLaunchKernelGGL(mk_fwd, dim3(grid), dim3(NTHREADS), LDS_BYTES, stream, a);
#endif
}
```

```cpp
#include <hip/hip_runtime.h>
#include <cstdio>
#include <cstdint>
namespace pg8 {
#define PG8_LAS __attribute__((address_space(3)))
typedef unsigned short bf16_t;
typedef short bf16x8 __attribute__((ext_vector_type(8)));
typedef float f32x4 __attribute__((ext_vector_type(4)));
typedef unsigned u32x4 __attribute__((ext_vector_type(4)));
typedef int i32x4 __attribute__((ext_vector_type(4)));
constexpr int BM = 256, BK = 64, HALF = 128, HTB = HALF * BK * 2  , STAGE_BYTES = 8 * HTB, NXCD = 8, WGM = 8;

__host__ __device__ __forceinline__ int lds_byte(int r, int c) { const int st = (r >> 4) * 2 + (c >> 5), rr = r & 15, cc = c & 31, ob = rr * 64 + cc * 2; return st * 1024 + (ob ^ (((ob >> 9) & 1) << 5)); }
__host__ __device__ __forceinline__ void stage_rc(int b, int& R, int& C) { const int st = b / 1024, sb = b % 1024, swz = sb ^ (((sb >> 9) & 1) << 5); R = (st >> 1) * 16 + swz / 64; C = (st & 1) * 32 + (swz % 64) / 2; }
__host__ __device__ __forceinline__ int perm32(int rho) { const int n = rho >> 4, i = rho & 15; return 8 * (i >> 2) + 4 * n + (i & 3); }

struct Unit { int pm, pn; };
struct Gemm { const bf16_t* A; const bf16_t* Bt; int M, N, K; };

struct StaticOrder {
    int nM, nN, nwg, G, c, wgm, krot;
    __host__ __device__ void init(int M, int N, int G_, int c_, int wgm_ = WGM, int krot_ = 0) { nM = M / BM; nN = N / BM; nwg = nM * nN; G = G_; c = c_; wgm = wgm_; krot = krot_; }
    __host__ __device__ bool next(int i, Unit& u) const {
        const long L = (long)i * G + c; if (L >= nwg) return false;
        int wgid = (int)L; { const int q = nwg / NXCD, r = nwg % NXCD, xcd = wgid % NXCD, off = wgid / NXCD; wgid = (xcd < r ? xcd * (q + 1) : r * (q + 1) + (xcd - r) * q) + off; }
        const int nig = wgm * nN, gid = wgid / nig, fm = gid * wgm, gsz = (nM - fm) < wgm ? (nM - fm) : wgm;
        u.pm = fm + ((wgid % nig) % gsz); u.pn = (wgid % nig) / gsz; return true;
    }
    __device__ __forceinline__ void a_ready(const Unit&) const {}
    __device__ __forceinline__ void done(const Unit&) const {}
};
typedef __bf16 bf16x2_t __attribute__((ext_vector_type(2)));
__device__ __forceinline__ unsigned cvt_pk_bf16(float lo, float hi) { bf16x2_t r; r.x = (__bf16)lo; r.y = (__bf16)hi; return __builtin_bit_cast(unsigned, r); }
struct EpiBf16P {
    static constexpr bool PERM = true, AFTER_DRAIN = false;
    bf16_t* O; int ldc;
    __device__ __forceinline__ void operator()(const f32x4 (&acc)[2][2][4][2], const Unit& u, int wr, int wc, int fr, int fq) const {
        const int row0 = u.pm * BM + wr * 64 + fr, col0 = u.pn * BM + wc * 32 + 8 * fq;
#pragma unroll
        for (int ai = 0; ai < 2; ++ai)
#pragma unroll
            for (int m = 0; m < 4; ++m) { bf16_t* rowp = O + (size_t)(row0 + ai * HALF + m * 16) * ldc + col0;
#pragma unroll
                for (int bj = 0; bj < 2; ++bj) { const f32x4 v0 = acc[ai][bj][m][0], v1 = acc[ai][bj][m][1];
                    u32x4 w; w.x = cvt_pk_bf16(v0[0], v0[1]); w.y = cvt_pk_bf16(v0[2], v0[3]); w.z = cvt_pk_bf16(v1[0], v1[1]); w.w = cvt_pk_bf16(v1[2], v1[3]);
                    *(u32x4*)(rowp + bj * HALF) = w; } }
    }
};
struct EpiResid {
    static constexpr bool PERM = false, AFTER_DRAIN = false;
    float* Z; const float* X; const float* gate; float alpha;
    __device__ __forceinline__ void operator()(const f32x4 (&acc)[2][2][4][2], const Unit& u, int wr, int wc, int fr, int fq) const {
        const int row0 = u.pm * BM + wr * 64 + fr, col0 = u.pn * BM + wc * 32 + 4 * fq;
        const float* gb = gate + (size_t)(u.pm >> 3) * (6 * 2048) + col0;
        f32x4 gv[2][2];
#pragma unroll
        for (int bj = 0; bj < 2; ++bj)
#pragma unroll
            for (int n = 0; n < 2; ++n) gv[bj][n] = *(const f32x4*)(gb + bj * HALF + n * 16) + 1.0f;
#pragma unroll
        for (int ai = 0; ai < 2; ++ai)
#pragma unroll
            for (int m = 0; m < 4; ++m) { const size_t off = (size_t)(row0 + ai * HALF + m * 16) * 2048 + col0;
#pragma unroll
                for (int bj = 0; bj < 2; ++bj)
#pragma unroll
                    for (int n = 0; n < 2; ++n) { const f32x4 xv = *(const f32x4*)(X + off + bj * HALF + n * 16);
                        *(f32x4*)(Z + off + bj * HALF + n * 16) = xv * alpha + gv[bj][n] * acc[ai][bj][m][n]; }
                asm volatile("" ::: "memory"); }
    }
};
#ifndef PG8_NT
#define PG8_NT 0
#endif
#if PG8_NT
#define PG8_ST(TY, p, v) __builtin_nontemporal_store((v), (TY*)(p))
#else
#define PG8_ST(TY, p, v) (*(TY*)(p) = (v))
#endif
__device__ __forceinline__ f32x4 acc_i2f(const f32x4 v) { const i32x4 iv = __builtin_bit_cast(i32x4, v); return __builtin_convertvector(iv, f32x4); }
struct EpiBf16PS {
    static constexpr bool PERM = true, AFTER_DRAIN = false;
    bf16_t* O; int ldc; const float* sa; const float* sb;
    __device__ __forceinline__ void operator()(const f32x4 (&acc)[2][2][4][2], const Unit& u, int wr, int wc, int fr, int fq) const {
        const int row0 = u.pm * BM + wr * 64 + fr, col0 = u.pn * BM + wc * 32 + 8 * fq;
        f32x4 sbv[2][2];
#pragma unroll
        for (int bj = 0; bj < 2; ++bj)
#pragma unroll
            for (int n = 0; n < 2; ++n) sbv[bj][n] = *(const f32x4*)(sb + col0 + bj * HALF + 4 * n);
#pragma unroll
        for (int ai = 0; ai < 2; ++ai)
#pragma unroll
            for (int m = 0; m < 4; ++m) { const int row = row0 + ai * HALF + m * 16; bf16_t* rowp = O + (size_t)row * ldc + col0; const float sar = sa[row];
#pragma unroll
                for (int bj = 0; bj < 2; ++bj) { const f32x4 v0 = acc_i2f(acc[ai][bj][m][0]) * (sbv[bj][0] * sar), v1 = acc_i2f(acc[ai][bj][m][1]) * (sbv[bj][1] * sar);
                    u32x4 w; w.x = cvt_pk_bf16(v0[0], v0[1]); w.y = cvt_pk_bf16(v0[2], v0[3]); w.z = cvt_pk_bf16(v1[0], v1[1]); w.w = cvt_pk_bf16(v1[2], v1[3]);
                    PG8_ST(u32x4, rowp + bj * HALF, w); } }
    }
};
struct EpiResidS {
    static constexpr bool PERM = false, AFTER_DRAIN = false;
    float* Z; const float* X; const float* gate; const float* sa; const float* sb; float alpha;
    __device__ __forceinline__ void operator()(const f32x4 (&acc)[2][2][4][2], const Unit& u, int wr, int wc, int fr, int fq) const {
        const int row0 = u.pm * BM + wr * 64 + fr, col0 = u.pn * BM + wc * 32 + 4 * fq;
        const float* gb = gate + (size_t)(u.pm >> 3) * (6 * 2048) + col0;
        f32x4 gv[2][2];
#pragma unroll
        for (int bj = 0; bj < 2; ++bj)
#pragma unroll
            for (int n = 0; n < 2; ++n) gv[bj][n] = (*(const f32x4*)(gb + bj * HALF + n * 16) + 1.0f) * *(const f32x4*)(sb + col0 + bj * HALF + n * 16);
#pragma unroll
        for (int ai = 0; ai < 2; ++ai)
#pragma unroll
            for (int m = 0; m < 4; ++m) { const int row = row0 + ai * HALF + m * 16; const size_t off = (size_t)row * 2048 + col0; const float sar = sa[row];
#pragma unroll
                for (int bj = 0; bj < 2; ++bj)
#pragma unroll
                    for (int n = 0; n < 2; ++n) { const f32x4 xv = *(const f32x4*)(X + off + bj * HALF + n * 16);
                        PG8_ST(f32x4, Z + off + bj * HALF + n * 16, xv * alpha + (gv[bj][n] * sar) * acc_i2f(acc[ai][bj][m][n])); }
                asm volatile("" ::: "memory"); }
    }
};
template <bool XB, bool ZB> struct EpiResidS16 {
    static constexpr bool PERM = true, AFTER_DRAIN = false;
    void* Z; const void* X; const float* gate; const float* sa; const float* sb; float alpha;
    __device__ __forceinline__ void operator()(const f32x4 (&acc)[2][2][4][2], const Unit& u, int wr, int wc, int fr, int fq) const {
        const int row0 = u.pm * BM + wr * 64 + fr, col0 = u.pn * BM + wc * 32 + 8 * fq;
        const float* gb = gate + (size_t)(u.pm >> 3) * (6 * 2048) + col0;
        f32x4 gv[2][2];
#pragma unroll
        for (int bj = 0; bj < 2; ++bj)
#pragma unroll
            for (int n = 0; n < 2; ++n) gv[bj][n] = (*(const f32x4*)(gb + bj * HALF + 4 * n) + 1.0f) * *(const f32x4*)(sb + col0 + bj * HALF + 4 * n);
#pragma unroll
        for (int ai = 0; ai < 2; ++ai)
#pragma unroll
            for (int m = 0; m < 4; ++m) { const int row = row0 + ai * HALF + m * 16; const size_t off = (size_t)row * 2048 + col0; const float sar = sa[row];
#pragma unroll
                for (int bj = 0; bj < 2; ++bj) { f32x4 x0, x1;
                    if constexpr (XB) { const u32x4 xw = *(const u32x4*)((const bf16_t*)X + off + bj * HALF);
                        x0 = (f32x4){__uint_as_float(xw.x << 16), __uint_as_float(xw.x & 0xffff0000u), __uint_as_float(xw.y << 16), __uint_as_float(xw.y & 0xffff0000u)};
                        x1 = (f32x4){__uint_as_float(xw.z << 16), __uint_as_float(xw.z & 0xffff0000u), __uint_as_float(xw.w << 16), __uint_as_float(xw.w & 0xffff0000u)}; }
                    else { x0 = *(const f32x4*)((const float*)X + off + bj * HALF); x1 = *(const f32x4*)((const float*)X + off + bj * HALF + 4); }
                    const f32x4 v0 = x0 * alpha + (gv[bj][0] * sar) * acc_i2f(acc[ai][bj][m][0]), v1 = x1 * alpha + (gv[bj][1] * sar) * acc_i2f(acc[ai][bj][m][1]);
                    if constexpr (ZB) { u32x4 w; w.x = cvt_pk_bf16(v0[0], v0[1]); w.y = cvt_pk_bf16(v0[2], v0[3]); w.z = cvt_pk_bf16(v1[0], v1[1]); w.w = cvt_pk_bf16(v1[2], v1[3]);
                        PG8_ST(u32x4, (bf16_t*)Z + off + bj * HALF, w); }
                    else { PG8_ST(f32x4, (float*)Z + off + bj * HALF, v0); PG8_ST(f32x4, (float*)Z + off + bj * HALF + 4, v1); } }
                asm volatile("" ::: "memory"); }
    }
};
template <class Epi, class Sched, bool ALIGN_EPI = false, bool SP2 = false, bool I8 = false>
__device__ __forceinline__ void gemm_phase(PG8_LAS unsigned char* lds, const Gemm g, const Sched& S, const Epi& E, const int tid_in) {
    const int tid = tid_in, wid = __builtin_amdgcn_readfirstlane(tid >> 6), lane = tid & 63, wr = wid >> 2, wc = wid & 3, fr = lane & 15, fq = lane >> 4;
    const int K = g.K, nt = K / BK;
    const int krot = ((nt & (nt - 1)) == 0) ? (S.krot & (nt - 1)) : 0;
#define PG8_KOFS(t) ((size_t)(((t) + krot) & (nt - 1)) * kstep)
    unsigned voffA[2], voffB[2];
#pragma unroll
    for (int i = 0; i < 2; ++i) { int R, C; stage_rc(tid * 16 + i * 8192, R, C); const int Rb = Epi::PERM ? ((R & ~31) + perm32(R & 31)) : R;
        voffA[i] = (unsigned)(R * K + C) * 2u; voffB[i] = (unsigned)(Rb * K + C) * 2u; }
    const size_t kstep = (size_t)(BK * 2);
    const size_t hstep = (size_t)HALF * K * 2;
    const size_t tstep = 2 * hstep;
    const unsigned ldsw = (unsigned)wid * 1024u;
    const int aoff = lds_byte(wr * 64 + fr, fq * 8), boff = lds_byte(wc * 32 + fr, fq * 8);
#define PG8_SA(b, h) (((b) * 2 + (h)) * HTB)
#define PG8_SB(b, h) ((4 + (b) * 2 + (h)) * HTB)
#define PG8_STAGE(bufoff, gbase, voff) do { _Pragma("unroll") for (int _i = 0; _i < 2; ++_i) \
        __builtin_amdgcn_global_load_lds((const unsigned*)((const char*)(gbase) + (voff)[_i]), (PG8_LAS unsigned*)(lds + (bufoff) + ldsw + _i * 8192), 16, 0, 0); } while (0)
#define PG8_LDA(dst, b, h) do { _Pragma("unroll") for (int m = 0; m < 4; ++m) _Pragma("unroll") for (int k = 0; k < 2; ++k) dst[m][k] = *(const PG8_LAS bf16x8*)(lds + PG8_SA(b, h) + aoff + m * 2048 + k * 1024); } while (0)
#define PG8_LDB(dst, b, h) do { _Pragma("unroll") for (int n = 0; n < 2; ++n) _Pragma("unroll") for (int k = 0; k < 2; ++k) dst[n][k] = *(const PG8_LAS bf16x8*)(lds + PG8_SB(b, h) + boff + n * 2048 + k * 1024); } while (0)
#define PG8_MMA(ai, bj, At, Bt) do { __builtin_amdgcn_s_setprio(1); _Pragma("unroll") for (int m = 0; m < 4; ++m) _Pragma("unroll") for (int n = 0; n < 2; ++n) _Pragma("unroll") for (int k = 0; k < 2; ++k) \
        { if constexpr (I8) acc[ai][bj][m][n] = __builtin_bit_cast(f32x4, __builtin_amdgcn_mfma_i32_16x16x64_i8(__builtin_bit_cast(i32x4, Bt[n][k]), __builtin_bit_cast(i32x4, At[m][k]), __builtin_bit_cast(i32x4, acc[ai][bj][m][n]), 0, 0, 0)); \
          else acc[ai][bj][m][n] = __builtin_amdgcn_mfma_f32_16x16x32_bf16(Bt[n][k], At[m][k], acc[ai][bj][m][n], 0, 0, 0); } __builtin_amdgcn_s_setprio(0); } while (0)
#define PG8_WAIT_V(n) asm volatile("s_waitcnt vmcnt(" #n ")" ::: "memory")
#define PG8_WAIT_L(n) asm volatile("s_waitcnt lgkmcnt(" #n ")" ::: "memory")
#define PG8_BAR __builtin_amdgcn_s_barrier()
#define PG8_SCHED __builtin_amdgcn_sched_barrier(0)
    Unit cur, nxt; int ui = 0;
    if (!S.next(0, cur)) return;
    f32x4 acc[2][2][4][2];
#pragma unroll
    for (int a = 0; a < 2; ++a)
#pragma unroll
        for (int b = 0; b < 2; ++b)
#pragma unroll
            for (int m = 0; m < 4; ++m)
#pragma unroll
                for (int n = 0; n < 2; ++n) acc[a][b][m][n] = (f32x4){0.f, 0.f, 0.f, 0.f};
    bf16x8 At[4][2], B0[2][2], B1[2][2];
    const char* cA = (const char*)g.A + (size_t)cur.pm * tstep; const char* cB = (const char*)g.Bt + (size_t)cur.pn * tstep;
    S.a_ready(cur);
    if constexpr (SP2) {
        PG8_STAGE(PG8_SB(0, 0), cB + PG8_KOFS(0), voffB); PG8_STAGE(PG8_SB(0, 1), cB + hstep + PG8_KOFS(0), voffB); PG8_STAGE(PG8_SA(0, 0), cA + PG8_KOFS(0), voffA); PG8_STAGE(PG8_SA(0, 1), cA + hstep + PG8_KOFS(0), voffA);
        if (wr == 1) PG8_BAR;
        PG8_WAIT_V(2); PG8_BAR;
        PG8_STAGE(PG8_SB(1, 0), cB + PG8_KOFS(1), voffB); PG8_STAGE(PG8_SA(1, 0), cA + PG8_KOFS(1), voffA); PG8_STAGE(PG8_SB(1, 1), cB + hstep + PG8_KOFS(1), voffB);
        PG8_WAIT_V(6); PG8_BAR;
    } else {
        PG8_STAGE(PG8_SB(0, 0), cB + PG8_KOFS(0), voffB); PG8_STAGE(PG8_SA(0, 0), cA + PG8_KOFS(0), voffA); PG8_STAGE(PG8_SB(0, 1), cB + hstep + PG8_KOFS(0), voffB); PG8_STAGE(PG8_SA(0, 1), cA + hstep + PG8_KOFS(0), voffA);
        if (wr == 1) PG8_BAR;
        PG8_WAIT_V(4); PG8_BAR;
        PG8_STAGE(PG8_SB(1, 0), cB + PG8_KOFS(1), voffB); PG8_STAGE(PG8_SA(1, 0), cA + PG8_KOFS(1), voffA); PG8_STAGE(PG8_SB(1, 1), cB + hstep + PG8_KOFS(1), voffB);
        PG8_WAIT_V(6); PG8_BAR;
    }
    for (;;) {
        const bool has_next = S.next(ui + 1, nxt);
        const char* nA = has_next ? (const char*)g.A + (size_t)nxt.pm * tstep : cA; const char* nB = has_next ? (const char*)g.Bt + (size_t)nxt.pn * tstep : cB;
#ifdef PG8_KREP
        for (int kr_ = 0; kr_ < PG8_KREP; ++kr_) {
        if (kr_) {
#pragma unroll
        for (int a = 0; a < 2; ++a)
#pragma unroll
            for (int b = 0; b < 2; ++b)
#pragma unroll
                for (int m = 0; m < 4; ++m)
#pragma unroll
                    for (int n = 0; n < 2; ++n) acc[a][b][m][n] = (f32x4){0.f, 0.f, 0.f, 0.f}; }
        const char* nA_ = (kr_ + 1 < PG8_KREP) ? cA : nA; const char* nB_ = (kr_ + 1 < PG8_KREP) ? cB : nB;
#else
        const char* nA_ = nA; const char* nB_ = nB;
#endif
        for (int t = 0; t < nt; t += 2) {
            const bool last = (t == nt - 2);
            const char* a1 = cA + PG8_KOFS(t + 1);
            const char* a2 = (last ? nA_ : cA) + PG8_KOFS(t + 2); const char* b2 = (last ? nB_ : cB) + PG8_KOFS(t + 2);
            const char* a3 = (last ? nA_ : cA) + PG8_KOFS(t + 3); const char* b3 = (last ? nB_ : cB) + PG8_KOFS(t + 3);
            if (last && has_next) S.a_ready(nxt);
            if constexpr (SP2) {
            PG8_LDB(B0, 0, 0); PG8_LDB(B1, 0, 1); PG8_SCHED; PG8_LDA(At, 0, 0); PG8_STAGE(PG8_SA(1, 1), a1 + hstep, voffA);
            PG8_WAIT_V(8); PG8_WAIT_L(0); PG8_BAR; PG8_MMA(0, 0, At, B0); PG8_MMA(0, 1, At, B1); PG8_BAR; PG8_SCHED;
            PG8_LDA(At, 0, 1); PG8_STAGE(PG8_SB(0, 0), b2, voffB); PG8_STAGE(PG8_SB(0, 1), b2 + hstep, voffB); PG8_STAGE(PG8_SA(0, 0), a2, voffA);
            PG8_WAIT_V(8); PG8_WAIT_L(0); PG8_BAR; PG8_MMA(1, 0, At, B0); PG8_MMA(1, 1, At, B1); PG8_BAR; PG8_SCHED;
            PG8_LDB(B0, 1, 0); PG8_LDB(B1, 1, 1); PG8_SCHED; PG8_LDA(At, 1, 0); PG8_STAGE(PG8_SA(0, 1), a2 + hstep, voffA);
            PG8_WAIT_V(8); PG8_WAIT_L(0); PG8_BAR; PG8_MMA(0, 0, At, B0); PG8_MMA(0, 1, At, B1); PG8_BAR; PG8_SCHED;
            PG8_LDA(At, 1, 1); PG8_STAGE(PG8_SB(1, 0), b3, voffB); PG8_STAGE(PG8_SB(1, 1), b3 + hstep, voffB); PG8_STAGE(PG8_SA(1, 0), a3, voffA);
            PG8_WAIT_V(8); PG8_WAIT_L(0); PG8_BAR; PG8_MMA(1, 0, At, B0); PG8_MMA(1, 1, At, B1); PG8_BAR; PG8_SCHED;
            } else {
            PG8_LDB(B0, 0, 0); PG8_SCHED; PG8_LDA(At, 0, 0); PG8_STAGE(PG8_SA(1, 1), a1 + hstep, voffA);
            PG8_WAIT_L(8); PG8_BAR; PG8_WAIT_L(0); PG8_MMA(0, 0, At, B0); PG8_BAR; PG8_SCHED;
            PG8_LDB(B1, 0, 1); PG8_STAGE(PG8_SB(0, 0), b2, voffB);
            PG8_BAR; PG8_WAIT_L(0); PG8_MMA(0, 1, At, B1); PG8_BAR;
            PG8_LDA(At, 0, 1); PG8_STAGE(PG8_SA(0, 0), a2, voffA);
            PG8_BAR; PG8_WAIT_L(0); PG8_MMA(1, 0, At, B0); PG8_BAR; PG8_SCHED;
            PG8_STAGE(PG8_SB(0, 1), b2 + hstep, voffB);
            PG8_WAIT_V(6); PG8_BAR; PG8_MMA(1, 1, At, B1); PG8_BAR;
            PG8_LDB(B0, 1, 0); PG8_SCHED; PG8_LDA(At, 1, 0); PG8_STAGE(PG8_SA(0, 1), a2 + hstep, voffA);
            PG8_WAIT_L(8); PG8_BAR; PG8_WAIT_L(0); PG8_MMA(0, 0, At, B0); PG8_BAR; PG8_SCHED;
            PG8_LDB(B1, 1, 1); PG8_STAGE(PG8_SB(1, 0), b3, voffB);
            PG8_BAR; PG8_WAIT_L(0); PG8_MMA(0, 1, At, B1); PG8_BAR;
            PG8_LDA(At, 1, 1); PG8_STAGE(PG8_SA(1, 0), a3, voffA);
            PG8_BAR; PG8_WAIT_L(0); PG8_MMA(1, 0, At, B0); PG8_BAR; PG8_SCHED;
            PG8_STAGE(PG8_SB(1, 1), b3 + hstep, voffB);
            PG8_WAIT_V(6); PG8_BAR; PG8_MMA(1, 1, At, B1); PG8_BAR;
            }
        }
#ifdef PG8_KREP
        }
#endif
        if constexpr (ALIGN_EPI) { if (wr == 0) PG8_BAR; }
#ifdef PG8_EPI2
        if constexpr (!Epi::AFTER_DRAIN) { E(acc, cur, wr, wc, fr, fq); asm volatile("" ::: "memory"); }
#endif
        if constexpr (!Epi::AFTER_DRAIN) { E(acc, cur, wr, wc, fr, fq); S.done(cur); }
        if (!has_next) break;
#pragma unroll
        for (int a = 0; a < 2; ++a)
#pragma unroll
            for (int b = 0; b < 2; ++b)
#pragma unroll
                for (int m = 0; m < 4; ++m)
#pragma unroll
                    for (int n = 0; n < 2; ++n) acc[a][b][m][n] = (f32x4){0.f, 0.f, 0.f, 0.f};
        cur = nxt; cA = nA; cB = nB; ++ui;
        if constexpr (ALIGN_EPI) { if (wr == 1) PG8_BAR; }
    }
    PG8_WAIT_V(0);
    if constexpr (!ALIGN_EPI) { if (wr == 0) PG8_BAR; }
    PG8_BAR;
    if constexpr (Epi::AFTER_DRAIN) { E.fused(acc, cur, wr, wc, fr, fq, lds, wid, lane); S.done(cur); }
#undef PG8_SA
#undef PG8_SB
#undef PG8_STAGE
#undef PG8_LDA
#undef PG8_LDB
#undef PG8_MMA
#undef PG8_WAIT_V
#undef PG8_WAIT_L
#undef PG8_BAR
#undef PG8_SCHED
#undef PG8_KOFS
}
}
#define XB_TMO      128
#define XB_XCNT(j)  (256  + 64 * (j))
#define XB_XSUB(j)  (1280 + 64 * (j))
#define XB_XGEN(j)  (2304 + 64 * (j))
#define XB_TOP      3328
#define XB_TOPGEN   3392
#define XCD_BAR_WORDS 3456
#define XB_SPIN_CAP (1u << 18)
#define LAS __attribute__((address_space(3)))

__device__ __forceinline__ unsigned xb_ld(unsigned* p)              { return __hip_atomic_load(p, __ATOMIC_RELAXED, __HIP_MEMORY_SCOPE_AGENT); }
__device__ __forceinline__ unsigned xb_add(unsigned* p, unsigned v) { return __hip_atomic_fetch_add(p, v, __ATOMIC_RELAXED, __HIP_MEMORY_SCOPE_AGENT); }
__device__ __forceinline__ unsigned xb_xcc_id() { return (unsigned)__builtin_amdgcn_s_getreg((3 << 11) | 20) & 0xFu; }
#define XB_SPIN(cond, bar) do { unsigned _sp = 0; while (cond) { __builtin_amdgcn_s_sleep(1); \
    if ((++_sp & 255u) == 0u) { if (xb_ld(&(bar)[XB_TMO])) break; if (_sp > XB_SPIN_CAP) { atomicAdd(&(bar)[XB_TMO], 1u); break; } } } } while (0)

struct XcdBarrier {
    unsigned* bar; unsigned x;
    volatile LAS unsigned* st;
};

__device__ __forceinline__ XcdBarrier xcd_barrier_post(unsigned* bar, volatile LAS unsigned* st) {
    XcdBarrier b; b.bar = bar; b.x = xb_xcc_id(); b.st = st;
    if (threadIdx.x == 0) (void)xb_add(&bar[XB_XCNT(b.x)], 1u);
    return b;
}
__device__ __forceinline__ void xcd_barrier_complete(unsigned* bar, unsigned x, unsigned& nloc, unsigned& nx) {
    const unsigned G = gridDim.x * gridDim.y * gridDim.z;
    unsigned sum, cnt, mine, sp = 0u;
    for (;;) {
        sum = 0u; cnt = 0u; mine = 0u;
#pragma unroll
        for (unsigned j = 0; j < 16; ++j) { const unsigned c = xb_ld(&bar[XB_XCNT(j)]); sum += c; cnt += (c > 0u) ? 1u : 0u; mine = (j == x) ? c : mine; }
        if (sum == G) break;
        __builtin_amdgcn_s_sleep(1);
        if ((++sp & 255u) == 0u) { if (xb_ld(&bar[XB_TMO])) break; if (sp > XB_SPIN_CAP) { atomicAdd(&bar[XB_TMO], 1u); break; } }
    }
    nloc = mine > 0u ? mine : 1u; nx = cnt > 0u ? cnt : 1u;
}

__device__ __forceinline__ void xcd_barrier(const XcdBarrier& b) {
    asm volatile("s_waitcnt vmcnt(0)" ::: "memory");
    __syncthreads();
    if (threadIdx.x == 0) {
        unsigned* bar = b.bar;
        __builtin_amdgcn_s_waitcnt(0);
        unsigned nloc = b.st[0], nx = b.st[1];
        if (nloc == 0u) { xcd_barrier_complete(bar, b.x, nloc, nx); b.st[0] = nloc; b.st[1] = nx; }
        const unsigned old = xb_add(&bar[XB_XSUB(b.x)], 1u);
        const unsigned gen = old / nloc;
        if (old + 1u == (gen + 1u) * nloc) {
            __builtin_amdgcn_fence(__ATOMIC_RELEASE, "agent");
            asm volatile("s_waitcnt vmcnt(0)" ::: "memory");
            const unsigned og = xb_add(&bar[XB_TOP], 1u);
            const unsigned tg = og / nx;
            if (og + 1u == (tg + 1u) * nx) xb_add(&bar[XB_TOPGEN], 1u);
            else XB_SPIN(xb_ld(&bar[XB_TOPGEN]) == tg, bar);
            __builtin_amdgcn_fence(__ATOMIC_ACQUIRE, "agent");
            xb_add(&bar[XB_XGEN(b.x)], 1u);
            asm volatile("s_waitcnt vmcnt(0)" ::: "memory");
        } else {
            XB_SPIN(xb_ld(&bar[XB_XGEN(b.x)]) == gen, bar);
            __builtin_amdgcn_fence(__ATOMIC_ACQUIRE, "agent");
            asm volatile("s_waitcnt vmcnt(0)" ::: "memory");
        }
    }
    __syncthreads();
}
constexpr int D = 2048, NB = 8, SEQ = 2048, NL = 4, T = NB * SEQ;
constexpr int NCH = SEQ / 64, NCHUNK = T / 64;
constexpr int GKW = 512, RANK = 16;
constexpr int INW = 6160, NP = 6144;
constexpr int NE = 16384;
constexpr float ALPHA = 1.6817928305074290f, EPS = 1e-5f;
constexpr int PQ = 0, PK = 512, PV = 1024, PR = 2048, PCB = 3072, PCC = 4096, PCH = 5120;
constexpr int NWAVES = 8, NTHREADS = 512;
#ifndef WGM_IN
#define WGM_IN 4
#endif
#ifndef WGM_OUT
#define WGM_OUT 4
#endif
#ifndef WGM_WQ
#define WGM_WQ 4
#endif
#ifndef TAB4
#define TAB4 1
#endif
constexpr int NPHASES = 2 + 7 * NL;

constexpr size_t MiB = 1u << 20;
constexpr size_t WS_CTL = 0, CTL_ZERO_BYTES = 1 * MiB;
constexpr size_t WS_MOD = 1 * MiB, WS_PART = 3 * MiB, WS_KEYS = 15 * MiB, WS_DTOT = 17 * MiB, WS_WIN = 18 * MiB, WS_WOUT = 115 * MiB, WS_WQ = 147 * MiB;
constexpr size_t WS_UT = 179 * MiB, WS_VT = 435 * MiB, WS_H = 691 * MiB, WS_PROJ = 755 * MiB, WS_E = 947 * MiB, WS_OGLA = 979 * MiB, WS_Y = 1043 * MiB;
constexpr size_t WS_Z = 1107 * MiB, WS_X1 = 1235 * MiB, WS_X = 1363 * MiB, WS_Q = 1491 * MiB, WS_H2 = 1555 * MiB, WS_HQ8 = 1619 * MiB, WS_H8 = 1659 * MiB, WS_WIN8 = 1691 * MiB, WS_WOUT8 = 1739 * MiB, WS_WQ8 = 1755 * MiB, WS_Y8 = 1771 * MiB, WS_H28 = 1803 * MiB, WS_END = 1835 * MiB;
constexpr size_t WS_SU = 17 * MiB + 512 * 1024, WS_SV = 17 * MiB + 768 * 1024, WS_HSC = 2 * MiB + 640 * 1024;
static_assert(WS_WIN + (size_t)NL * INW * D * 2 <= WS_WOUT && WS_PART + (size_t)NL * 8 * NB * 6 * D * 4 <= WS_KEYS && WS_MOD + (size_t)NL * NB * 6 * D * 4 <= WS_PART, "ws map");
constexpr size_t WS_SAH = WS_SU, WS_SAY = WS_SU + 65536, WS_SB = WS_SV; constexpr int SBL = NP + 2 * D;
constexpr size_t WS_SBA = WS_SB + (size_t)NL * SBL * 4, WS_ALR8 = WS_SU + 131072;
#ifndef KROT_A
#define KROT_A 0
#endif
#ifndef KROT_B
#define KROT_B 0
#endif
#define KROT(c) (KROT_A * (((c) >> 3) & 3) + KROT_B * ((c) >> 5))
#ifndef RES16
#define RES16 1
#endif
#ifndef RES16_X
#define RES16_X RES16
#endif
#ifndef RES16_Z
#define RES16_Z RES16
#endif
#ifndef RES16_X1
#define RES16_X1 RES16
#endif
#ifndef I8_GATE
#define I8_GATE 1
#endif
#ifndef I8_WQ
#define I8_WQ 1
#endif
#ifndef I8_IN
#define I8_IN 1
#endif
#ifndef I8_OUT
#define I8_OUT 1
#endif
constexpr int CW_BAR = 4096;

constexpr int RING_OFF = 0, RING_BYTES = 131072, LDSCTL_OFF = RING_BYTES, LDS_BYTES = 147456;

#define GAS __attribute__((address_space(1)))
typedef unsigned short bf16;
typedef unsigned v4u __attribute__((ext_vector_type(4)));
typedef unsigned v2u __attribute__((ext_vector_type(2)));
typedef int v4i __attribute__((ext_vector_type(4)));
typedef float f32x4 __attribute__((ext_vector_type(4)));
typedef float f32x16 __attribute__((ext_vector_type(16)));
typedef short bf16x8 __attribute__((ext_vector_type(8)));
typedef __bf16 bf16x2v __attribute__((ext_vector_type(2)));
#define LDS_WAIT() asm volatile("s_waitcnt lgkmcnt(0)" ::: "memory")

__device__ __forceinline__ unsigned pk2(float lo, float hi) { return pg8::cvt_pk_bf16(lo, hi); }
__device__ __forceinline__ float dot2bf(unsigned w, unsigned x, float acc) { return __builtin_amdgcn_fdot2_f32_bf16(__builtin_bit_cast(bf16x2v, w), __builtin_bit_cast(bf16x2v, x), acc, false); }
__device__ __forceinline__ float bflo(unsigned u) { return __uint_as_float(u << 16); }
__device__ __forceinline__ float bfhi(unsigned u) { return __uint_as_float(u & 0xffff0000u); }
__device__ __forceinline__ float silu_f(float x) { return x * __builtin_amdgcn_rcpf(1.0f + __expf(-x)); }
__device__ __forceinline__ float logsigmoid_f(float x) { return fminf(x, 0.0f) - log1pf(__expf(-fabsf(x))); }
__device__ __forceinline__ float logsigmoid_fast(float x) { return fminf(x, 0.0f) - __logf(1.0f + __expf(-fabsf(x))); }
__device__ __forceinline__ float gelu_tanh_f(float x) { const float u = 0.7978845608028654f * (x + 0.044715f * x * x * x); return 0.5f * x * (1.0f + tanhf(u)); }
__device__ __forceinline__ unsigned pack_i8(float a, float b, float c, float d) {
    const int q0 = (int)__builtin_rintf(a), q1 = (int)__builtin_rintf(b), q2 = (int)__builtin_rintf(c), q3 = (int)__builtin_rintf(d);
    return (unsigned)(q0 & 255) | ((unsigned)(q1 & 255) << 8) | ((unsigned)(q2 & 255) << 16) | ((unsigned)(q3 & 255) << 24); }
#define WAVE_ALLREDUCE(v, OP) do { \
    v = OP(v, __uint_as_float((unsigned)__builtin_amdgcn_update_dpp(0, (int)__float_as_uint(v), 0xB1, 0xf, 0xf, false)));      \
    v = OP(v, __uint_as_float((unsigned)__builtin_amdgcn_update_dpp(0, (int)__float_as_uint(v), 0x4E, 0xf, 0xf, false)));      \
    v = OP(v, __uint_as_float((unsigned)__builtin_amdgcn_update_dpp(0, (int)__float_as_uint(v), 0x124, 0xf, 0xf, false)));     \
    v = OP(v, __uint_as_float((unsigned)__builtin_amdgcn_update_dpp(0, (int)__float_as_uint(v), 0x128, 0xf, 0xf, false)));     \
    { const auto r_ = __builtin_amdgcn_permlane16_swap(__float_as_uint(v), __float_as_uint(v), false, false); v = OP(__uint_as_float(r_[0]), __uint_as_float(r_[1])); } \
    { const auto r_ = __builtin_amdgcn_permlane32_swap(__float_as_uint(v), __float_as_uint(v), false, false); v = OP(__uint_as_float(r_[0]), __uint_as_float(r_[1])); } } while (0)
__device__ __forceinline__ float op_add_f(float a, float b) { return a + b; }
__device__ __forceinline__ float wave_sum(float v) { WAVE_ALLREDUCE(v, op_add_f); return v; }
__device__ __forceinline__ float wave_max(float v) { WAVE_ALLREDUCE(v, fmaxf); return v; }

struct Args { const float* in[19]; float* out; unsigned char* ws; int ph_lo, ph_hi; };

__device__ __forceinline__ void transpose_item(const float* W, int ldw, int col0, bf16* WTrows, int k0, int nvalid, LAS float* scr, int lane) {
    const int n = lane & 31;
    float tv[32];
#pragma unroll
    for (int i = 0; i < 32; ++i) { const int kk = 2 * i + (lane >> 5); tv[i] = (n < nvalid) ? W[(size_t)(k0 + kk) * ldw + col0 + n] : 0.f; }
#pragma unroll
    for (int i = 0; i < 32; ++i) { const int kk = 2 * i + (lane >> 5); scr[kk * 33 + n] = tv[i]; }
    LDS_WAIT(); asm volatile("" ::: "memory");
    const int c = lane & 7;
#pragma unroll
    for (int j = 0; j < 4; ++j) { const int nn = (lane >> 3) + 8 * j; const LAS float* s = scr + (8 * c) * 33 + nn;
        v4u o; o.x = pk2(s[0 * 33], s[1 * 33]); o.y = pk2(s[2 * 33], s[3 * 33]); o.z = pk2(s[4 * 33], s[5 * 33]); o.w = pk2(s[6 * 33], s[7 * 33]);
        if (nn < nvalid) *(v4u*)(WTrows + (size_t)nn * D + k0 + 8 * c) = o; }
    LDS_WAIT(); asm volatile("" ::: "memory");
}
__device__ __forceinline__ void cvt_stream(const float* src, bf16* dst, size_t n4, size_t i0, size_t stride) {
    for (size_t i = i0; i < n4; i += stride) { const f32x4 v = ((const f32x4*)src)[i]; v2u o; o.x = pk2(v.x, v.y); o.y = pk2(v.z, v.w); ((v2u*)dst)[i] = o; }
}
__device__ __forceinline__ void ph_prologue_a(const Args& a, LAS unsigned char* lds, int tid, int lane, int wave, int bx, int G) {
    const int gw = bx * NWAVES + wave, NGW = G * NWAVES;
    LAS float* cact = (LAS float*)lds;
    for (int i = tid; i < NB * D; i += NTHREADS) { const int b = i / D, d = i % D; cact[d * 8 + b] = silu_f(a.in[1][i]); }
    __syncthreads();
    float* part = (float*)(a.ws + WS_PART);
    for (int it = gw; it < NL * 8 * 48; it += NGW) {
        const int cg = it % 48, dr = (it / 48) % 8, l = it / 384;
        f32x4 acc[8];
#pragma unroll
        for (int b = 0; b < 8; ++b) acc[b] = (f32x4){0.f, 0.f, 0.f, 0.f};
        const float* w = a.in[2] + ((size_t)l * D + dr * 256) * (6 * D) + cg * 256 + lane * 4;
#pragma unroll 4
        for (int d = 0; d < 256; ++d) {
            const f32x4 wv = *(const f32x4*)(w + (size_t)d * (6 * D));
            const f32x4 c0 = *(const LAS f32x4*)(cact + (dr * 256 + d) * 8), c1 = *(const LAS f32x4*)(cact + (dr * 256 + d) * 8 + 4);
            acc[0] += wv * c0.x; acc[1] += wv * c0.y; acc[2] += wv * c0.z; acc[3] += wv * c0.w;
            acc[4] += wv * c1.x; acc[5] += wv * c1.y; acc[6] += wv * c1.z; acc[7] += wv * c1.w;
        }
#pragma unroll
        for (int b = 0; b < 8; ++b) *(f32x4*)(part + (((size_t)l * 8 + dr) * NB + b) * (6 * D) + cg * 256 + lane * 4) = acc[b];
    }
    __syncthreads();
    LAS float* scr = (LAS float*)(lds + wave * 8448);
    bf16* winT = (bf16*)(a.ws + WS_WIN); bf16* woutT = (bf16*)(a.ws + WS_WOUT); bf16* wqT = (bf16*)(a.ws + WS_WQ);
    constexpr int IPL = 6144 + 32 + 2048 + 2048;
    for (int it = gw; it < NL * IPL; it += NGW) {
        const int l = it / IPL; int r = it % IPL;
        if (r < 6144) { const int nb = r % 192, kb = r / 192, n0 = nb * 32;
            transpose_item(a.in[4] + (size_t)l * D * INW, INW, n0 < 3072 ? n0 : n0 + 16, winT + ((size_t)l * INW + n0) * D, kb * 64, 32, scr, lane); continue; }
        r -= 6144;
        if (r < 32) { transpose_item(a.in[4] + (size_t)l * D * INW, INW, 3072, winT + ((size_t)l * INW + NP) * D, r * 64, 16, scr, lane); continue; }
        r -= 32;
        if (r < 2048) { const int nb = r % 64, kb = r / 64; transpose_item(a.in[10] + (size_t)l * D * D, D, nb * 32, woutT + ((size_t)l * D + nb * 32) * D, kb * 64, 32, scr, lane); continue; }
        r -= 2048;
        { const int nb = r % 64, kb = r / 64; transpose_item(a.in[13] + (size_t)l * D * D, D, nb * 32, wqT + ((size_t)l * D + nb * 32) * D, kb * 64, 32, scr, lane); }
    }
    const size_t i0 = (size_t)bx * NTHREADS + tid, stride = (size_t)G * NTHREADS;
    cvt_stream(a.in[14], (bf16*)(a.ws + WS_KEYS), (size_t)NL * 8 * 2 * 128 * 128 / 4, i0, stride);
#if TAB4
    __syncthreads();
    { LAS float* rowst = (LAS float*)(lds + wave * 8192);
      f32x4 vnx[8];
      if (gw < 2 * NL * NE) { const int tbl0 = gw / (NL * NE), r0 = gw % (NL * NE); const float* s0 = (tbl0 ? a.in[16] : a.in[15]) + (size_t)r0 * D;
#pragma unroll
          for (int c8 = 0; c8 < 8; ++c8) vnx[c8] = *(const f32x4*)(s0 + (c8 * 64 + lane) * 4); }
      for (int row = gw; row < 2 * NL * NE; row += NGW) {
        const int tbl = row / (NL * NE), r = row % (NL * NE);
#pragma unroll
        for (int c8 = 0; c8 < 8; ++c8) *(LAS f32x4*)(rowst + (c8 * 64 + lane) * 4) = vnx[c8];
        { const int rown = row + NGW < 2 * NL * NE ? row + NGW : row; const int tbln = rown / (NL * NE), rn = rown % (NL * NE); const float* sn = (tbln ? a.in[16] : a.in[15]) + (size_t)rn * D;
#pragma unroll
          for (int c8 = 0; c8 < 8; ++c8) vnx[c8] = *(const f32x4*)(sn + (c8 * 64 + lane) * 4); }
        LDS_WAIT(); asm volatile("" ::: "memory");
        unsigned char* tb = a.ws + (tbl ? WS_VT : WS_UT) + (size_t)r * 1152;
#pragma unroll
        for (int pass = 0; pass < 2; ++pass) { const int slot = lane + 64 * pass;
            if (slot < 72) { const int col0 = (slot >> 3) * 240 + (slot & 7) * 30;
                float x[30]; float mx = 0.f;
#pragma unroll
                for (int k = 0; k < 30; ++k) { x[k] = (col0 + k < D) ? rowst[col0 + k] : 0.f; mx = fmaxf(mx, fabsf(x[k])); }
                int code = 0; float inv = 0.f;
                if (mx > 0.f) { code = (int)ceilf(8.0f * log2f(mx * (1.0f / 7.0f))) + 128; code = code < 0 ? 0 : (code > 255 ? 255 : code); inv = __builtin_amdgcn_exp2f(16.0f - (float)code * 0.125f); }
                unsigned dw[4] = {0u, 0u, 0u, 0u};
#pragma unroll
                for (int kb = 0; kb < 15; ++kb) { int a0 = (int)__builtin_rintf(x[2 * kb] * inv), a1 = (int)__builtin_rintf(x[2 * kb + 1] * inv);
                    a0 = a0 < -7 ? -7 : (a0 > 7 ? 7 : a0); a1 = a1 < -7 ? -7 : (a1 > 7 ? 7 : a1);
                    dw[kb >> 2] |= ((unsigned)(a0 + 8) | ((unsigned)(a1 + 8) << 4)) << (8 * (kb & 3)); }
                dw[3] |= (unsigned)code << 24;
                *(v4u*)(tb + slot * 16) = (v4u){dw[0], dw[1], dw[2], dw[3]}; } }
        LDS_WAIT(); asm volatile("" ::: "memory");
      } }
#else
    for (int row = gw; row < 2 * NL * NE; row += NGW) {
        const int tbl = row / (NL * NE), r = row % (NL * NE);
        const float* src = (tbl ? a.in[16] : a.in[15]) + (size_t)r * D;
        f32x4 v[8]; float mx = 0.f;
#pragma unroll
        for (int c8 = 0; c8 < 8; ++c8) { v[c8] = *(const f32x4*)(src + (c8 * 64 + lane) * 4); mx = fmaxf(mx, fmaxf(fmaxf(fabsf(v[c8].x), fabsf(v[c8].y)), fmaxf(fabsf(v[c8].z), fabsf(v[c8].w)))); }
        mx = wave_max(mx);
        const float inv = mx > 0.f ? 127.0f / mx : 0.f; const int off = tbl ? 128 : 0;
        unsigned dw[8];
#pragma unroll
        for (int c8 = 0; c8 < 8; ++c8) { const int q0 = (int)__builtin_rintf(v[c8].x * inv) + off, q1 = (int)__builtin_rintf(v[c8].y * inv) + off, q2 = (int)__builtin_rintf(v[c8].z * inv) + off, q3 = (int)__builtin_rintf(v[c8].w * inv) + off;
            dw[c8] = (unsigned)(q0 & 255) | ((unsigned)(q1 & 255) << 8) | ((unsigned)(q2 & 255) << 16) | ((unsigned)(q3 & 255) << 24); }
        unsigned char* dst = a.ws + (tbl ? WS_VT : WS_UT) + (size_t)r * D;
        *(v4u*)(dst + lane * 16) = (v4u){dw[0], dw[1], dw[2], dw[3]}; *(v4u*)(dst + (64 + lane) * 16) = (v4u){dw[4], dw[5], dw[6], dw[7]};
        if (lane == 0) ((float*)(a.ws + (tbl ? WS_SV : WS_SU)))[r] = mx * (1.0f / 127.0f);
    }
#endif
}

__device__ __forceinline__ void ln_tail(const float (&z)[32], int t, int lane, const float* g, const float* bta, float* xout, const float* sh, const float* sc, bf16* hout, unsigned char* q8, float* q8s, LAS unsigned char* q8stage = nullptr, unsigned char* a8 = nullptr, float* a8s = nullptr, bf16* xb = nullptr) {
    float s = 0.f;
#pragma unroll
    for (int i = 0; i < 32; ++i) s += z[i];
    const float mu = wave_sum(s) * (1.0f / D);
    float q = 0.f;
#pragma unroll
    for (int i = 0; i < 32; ++i) { const float d = z[i] - mu; q += d * d; }
    const float rs = rsqrtf(wave_sum(q) * (1.0f / D) + EPS);
    float hv[32]; float mx = 0.f;
#pragma unroll
    for (int c = 0; c < 8; ++c) { const int col = (c * 64 + lane) * 4;
        const f32x4 g0 = *(const f32x4*)(g + col), b0 = *(const f32x4*)(bta + col);
        f32x4 x0;
        x0.x = (z[c * 4 + 0] - mu) * rs * g0.x + b0.x; x0.y = (z[c * 4 + 1] - mu) * rs * g0.y + b0.y; x0.z = (z[c * 4 + 2] - mu) * rs * g0.z + b0.z; x0.w = (z[c * 4 + 3] - mu) * rs * g0.w + b0.w;
        if (xb) { v2u o; o.x = pk2(x0.x, x0.y); o.y = pk2(x0.z, x0.w); *(v2u*)(xb + (size_t)t * D + col) = o; }
        else if (xout) *(f32x4*)(xout + (size_t)t * D + col) = x0;
        if (hout || q8 || a8) { const f32x4 s0 = *(const f32x4*)(sc + col), h0 = *(const f32x4*)(sh + col);
            hv[c * 4] = x0.x * (1.f + s0.x) + h0.x; hv[c * 4 + 1] = x0.y * (1.f + s0.y) + h0.y; hv[c * 4 + 2] = x0.z * (1.f + s0.z) + h0.z; hv[c * 4 + 3] = x0.w * (1.f + s0.w) + h0.w;
            if (hout) { v2u o; o.x = pk2(hv[c * 4], hv[c * 4 + 1]); o.y = pk2(hv[c * 4 + 2], hv[c * 4 + 3]);
                *(v2u*)(hout + (size_t)t * D + col) = o; }
            if (q8 || a8) mx = fmaxf(mx, fmaxf(fmaxf(fabsf(hv[c * 4]), fabsf(hv[c * 4 + 1])), fmaxf(fabsf(hv[c * 4 + 2]), fabsf(hv[c * 4 + 3])))); }
    }
    if (q8 || a8) {
        mx = wave_max(mx);
        const float qmax_ = (q8 && TAB4) ? 119.0f : 127.0f;
        const float inv = mx > 0.f ? qmax_ / mx : 0.f;
        unsigned dw[8];
#pragma unroll
        for (int c = 0; c < 8; ++c) { const int q0 = (int)__builtin_rintf(hv[c * 4] * inv), q1 = (int)__builtin_rintf(hv[c * 4 + 1] * inv), q2 = (int)__builtin_rintf(hv[c * 4 + 2] * inv), q3 = (int)__builtin_rintf(hv[c * 4 + 3] * inv);
            dw[c] = (unsigned)(q0 & 255) | ((unsigned)(q1 & 255) << 8) | ((unsigned)(q2 & 255) << 16) | ((unsigned)(q3 & 255) << 24); }
        if (a8) {
#pragma unroll
            for (int c = 0; c < 8; ++c) *(unsigned*)(a8 + (size_t)t * D + (c * 64 + lane) * 4) = dw[c];
            if (a8s && lane == 0) a8s[t] = mx / qmax_; }
        if (q8) {
#if TAB4
        { LAS unsigned* st32 = (LAS unsigned*)q8stage; LAS unsigned char* st8 = (LAS unsigned char*)q8stage;
#pragma unroll
          for (int i = 0; i < 9; ++i) st32[lane + 64 * i] = 0u;
          LDS_WAIT(); asm volatile("" ::: "memory");
#pragma unroll
          for (int c = 0; c < 8; ++c)
#pragma unroll
              for (int jp = 0; jp < 2; ++jp) { const int col = (c * 64 + lane) * 4 + 2 * jp, u = col / 240, r = col - u * 240, l7 = r / 30, k = r - l7 * 30;
                  const int q0 = (int)(signed char)((dw[c] >> (16 * jp)) & 255u), q1 = (int)(signed char)((dw[c] >> (16 * jp + 8)) & 255u);
                  const int l0 = ((q0 + 8) & 15) - 8, l1 = ((q1 + 8) & 15) - 8, h0 = (q0 - l0) >> 4, h1 = (q1 - l1) >> 4;
                  LAS unsigned char* sp = st8 + (u * 8 + l7) * 32 + (k >> 1);
                  sp[0] = (unsigned char)((l0 & 15) | ((l1 & 15) << 4)); sp[16] = (unsigned char)((h0 & 15) | ((h1 & 15) << 4)); }
          LDS_WAIT(); asm volatile("" ::: "memory");
          unsigned* d32 = (unsigned*)(q8 + (size_t)t * 2304);
#pragma unroll
          for (int i = 0; i < 9; ++i) d32[lane + 64 * i] = st32[lane + 64 * i];
          LDS_WAIT(); asm volatile("" ::: "memory"); }
#else
        unsigned char* dst = q8 + (size_t)t * D;
        *(v4u*)(dst + lane * 16) = (v4u){dw[0], dw[1], dw[2], dw[3]}; *(v4u*)(dst + (64 + lane) * 16) = (v4u){dw[4], dw[5], dw[6], dw[7]};
#endif
        if (lane == 0) q8s[t] = mx / qmax_; }
    }
}

__device__ __forceinline__ void ph_prologue_b(const Args& a, LAS unsigned char* lds, int tid, int lane, int wave, int bx, int G) {
    const float* part = (const float*)(a.ws + WS_PART); float* mod = (float*)(a.ws + WS_MOD);
    for (int i = bx * NTHREADS + tid; i < NL * NB * 6 * D / 4; i += G * NTHREADS) {
        const int idx = i * 4, e = idx % (6 * D), b = (idx / (6 * D)) % NB, l = idx / (6 * D * NB);
        f32x4 s = *(const f32x4*)(a.in[3] + l * 6 * D + e);
#pragma unroll
        for (int dr = 0; dr < 8; ++dr) s += *(const f32x4*)(part + (((size_t)l * 8 + dr) * NB + b) * (6 * D) + e);
        *(f32x4*)(mod + idx) = s;
    }
    LAS float* msh = (LAS float*)lds;
    bf16* hbuf = (bf16*)(a.ws + WS_H);
    for (int ch = bx; ch < NCHUNK; ch += G) {
        const int b = ch / NCH;
        for (int i = tid; i < 1024; i += NTHREADS) { const int e = i * 4;
            f32x4 s = *(const f32x4*)(a.in[3] + e);
#pragma unroll
            for (int dr = 0; dr < 8; ++dr) s += *(const f32x4*)(part + (((size_t)0 * 8 + dr) * NB + b) * (6 * D) + e);
            *(LAS f32x4*)(msh + e) = s; }
        __syncthreads();
        for (int i = 0; i < 8; ++i) { const int t = ch * 64 + wave * 8 + i;
            float hv[32]; float mx = 0.f;
#pragma unroll
            for (int c = 0; c < 4; ++c) { const int col = (c * 64 + lane) * 8;
                const f32x4 x0 = *(const f32x4*)(a.in[0] + (size_t)t * D + col), x1 = *(const f32x4*)(a.in[0] + (size_t)t * D + col + 4);
                const f32x4 h0 = *(const LAS f32x4*)(msh + col), h1 = *(const LAS f32x4*)(msh + col + 4), s0 = *(const LAS f32x4*)(msh + 2048 + col), s1 = *(const LAS f32x4*)(msh + 2048 + col + 4);
#pragma unroll
                for (int j = 0; j < 4; ++j) { hv[c * 8 + j] = x0[j] * (1.f + s0[j]) + h0[j]; hv[c * 8 + 4 + j] = x1[j] * (1.f + s1[j]) + h1[j]; }
                v4u o; o.x = pk2(hv[c * 8], hv[c * 8 + 1]); o.y = pk2(hv[c * 8 + 2], hv[c * 8 + 3]); o.z = pk2(hv[c * 8 + 4], hv[c * 8 + 5]); o.w = pk2(hv[c * 8 + 6], hv[c * 8 + 7]);
#if !I8_GATE
                *(v4u*)(hbuf + (size_t)t * D + col) = o;
#endif
#if RES16_X
                { v4u xo; xo.x = pk2(x0.x, x0.y); xo.y = pk2(x0.z, x0.w); xo.z = pk2(x1.x, x1.y); xo.w = pk2(x1.z, x1.w); *(v4u*)((bf16*)(a.ws + WS_X) + (size_t)t * D + col) = xo; }
#endif
#pragma unroll
                for (int j = 0; j < 8; ++j) mx = fmaxf(mx, fabsf(hv[c * 8 + j])); }
            mx = wave_max(mx);
            const float inv = mx > 0.f ? 127.0f / mx : 0.f;
#pragma unroll
            for (int c = 0; c < 4; ++c) { v2u o;
                o.x = pack_i8(hv[c * 8] * inv, hv[c * 8 + 1] * inv, hv[c * 8 + 2] * inv, hv[c * 8 + 3] * inv); o.y = pack_i8(hv[c * 8 + 4] * inv, hv[c * 8 + 5] * inv, hv[c * 8 + 6] * inv, hv[c * 8 + 7] * inv);
                *(v2u*)(a.ws + WS_H8 + (size_t)t * D + (c * 64 + lane) * 8) = o; }
            if (lane == 0) ((float*)(a.ws + WS_SAH))[t] = mx * (1.0f / 127.0f); }
        __syncthreads();
    }
    { const int gw = bx * NWAVES + wave, NGW = G * NWAVES;
      for (int row = gw; row < NL * (SBL + 16); row += NGW) { const int l = row / (SBL + 16), r = row % (SBL + 16);
          const bf16* src; unsigned char* dst; float* sdst;
          if (r < NP) { src = (const bf16*)(a.ws + WS_WIN) + ((size_t)l * INW + r) * D; dst = a.ws + WS_WIN8 + ((size_t)l * NP + r) * D; sdst = (float*)(a.ws + WS_SB) + l * SBL + r; }
          else if (r < NP + D) { src = (const bf16*)(a.ws + WS_WOUT) + ((size_t)l * D + (r - NP)) * D; dst = a.ws + WS_WOUT8 + ((size_t)l * D + (r - NP)) * D; sdst = (float*)(a.ws + WS_SB) + l * SBL + r; }
          else if (r < SBL) { src = (const bf16*)(a.ws + WS_WQ) + ((size_t)l * D + (r - NP - D)) * D; dst = a.ws + WS_WQ8 + ((size_t)l * D + (r - NP - D)) * D; sdst = (float*)(a.ws + WS_SB) + l * SBL + r; }
          else { src = (const bf16*)(a.ws + WS_WIN) + ((size_t)l * INW + NP + (r - SBL)) * D; dst = a.ws + WS_ALR8 + ((size_t)l * 16 + (r - SBL)) * D; sdst = (float*)(a.ws + WS_SBA) + l * 16 + (r - SBL); }
          v4u w[4]; float mx = 0.f;
#pragma unroll
          for (int c = 0; c < 4; ++c) w[c] = *(const v4u*)(src + (c * 64 + lane) * 8);
#pragma unroll
          for (int c = 0; c < 4; ++c)
#pragma unroll
              for (int j = 0; j < 4; ++j) mx = fmaxf(mx, fmaxf(fabsf(bflo(w[c][j])), fabsf(bfhi(w[c][j]))));
          mx = wave_max(mx);
          const float inv = mx > 0.f ? 127.0f / mx : 0.f;
#pragma unroll
          for (int c = 0; c < 4; ++c) { v2u o;
              o.x = pack_i8(bflo(w[c][0]) * inv, bfhi(w[c][0]) * inv, bflo(w[c][1]) * inv, bfhi(w[c][1]) * inv); o.y = pack_i8(bflo(w[c][2]) * inv, bfhi(w[c][2]) * inv, bflo(w[c][3]) * inv, bfhi(w[c][3]) * inv);
              *(v2u*)(dst + (c * 64 + lane) * 8) = o; }
          if (lane == 0) *sdst = mx * (1.0f / 127.0f); } }
}

__device__ __forceinline__ void gate_prep(const Args& a, int l, LAS unsigned char* lds, int tid, int lane, int wave, int ch) {
    const bf16* hbuf = (const bf16*)(a.ws + WS_H); const bf16* waT = (const bf16*)(a.ws + WS_WIN) + ((size_t)l * INW + NP) * D;
    bf16* Ebuf = (bf16*)(a.ws + WS_E); float* dtot = (float*)(a.ws + WS_DTOT);
    const int t0 = ch * 64, l15 = lane & 15, lq = lane >> 4, mt = wave & 3, kh = wave >> 2;
    LAS float* alr = (LAS float*)(lds + LDSCTL_OFF + 1024);
#if I8_GATE
    { v4i acc = (v4i){0, 0, 0, 0};
      const unsigned char* hA = a.ws + WS_H8 + (size_t)(t0 + 16 * mt + l15) * D + kh * 1024 + 16 * lq;
      const unsigned char* wB = a.ws + WS_ALR8 + ((size_t)l * 16 + l15) * D + kh * 1024 + 16 * lq;
#pragma unroll 8
      for (int ks = 0; ks < 16; ++ks) { const v4i av = *(const v4i*)(hA + 64 * ks), bv = *(const v4i*)(wB + 64 * ks); acc = __builtin_amdgcn_mfma_i32_16x16x64_i8(av, bv, acc, 0, 0, 0); }
      const float sw = ((const float*)(a.ws + WS_SBA))[l * 16 + l15];
#pragma unroll
      for (int r = 0; r < 4; ++r) { const int tl = 16 * mt + 4 * lq + r; alr[(kh * 64 + tl) * 16 + l15] = (float)acc[r] * (sw * ((const float*)(a.ws + WS_SAH))[t0 + tl]); } }
#else
    f32x4 acc = (f32x4){0.f, 0.f, 0.f, 0.f};
    const bf16* hA = hbuf + (size_t)(t0 + 16 * mt + l15) * D + kh * 1024 + 8 * lq;
    const bf16* wB = waT + (size_t)l15 * D + kh * 1024 + 8 * lq;
#pragma unroll 8
    for (int ks = 0; ks < 32; ++ks) { const bf16x8 av = *(const bf16x8*)(hA + 32 * ks), bv = *(const bf16x8*)(wB + 32 * ks); acc = __builtin_amdgcn_mfma_f32_16x16x32_bf16(av, bv, acc, 0, 0, 0); }
#pragma unroll
    for (int r = 0; r < 4; ++r) alr[(kh * 64 + 16 * mt + 4 * lq + r) * 16 + l15] = acc[r];
#endif
    __syncthreads();
    const int col = tid;
    float wg[16];
#pragma unroll
    for (int r = 0; r < 16; ++r) wg[r] = a.in[5][((size_t)l * RANK + r) * GKW + col];
    const float bgc = a.in[6][l * GKW + col];
    for (int i = tid; i < 256; i += NTHREADS) *(LAS f32x4*)(alr + i * 4) = *(const LAS f32x4*)(alr + i * 4) + *(const LAS f32x4*)(alr + 1024 + i * 4);
    __syncthreads();
    float tot = 0.f;
    LAS float* lac = (LAS float*)lds;
    for (int j = 0; j < 64; ++j) { float lg0 = bgc, lg1 = 0.f;
#pragma unroll
        for (int r4 = 0; r4 < 4; ++r4) { const f32x4 p = *(const LAS f32x4*)(alr + j * 16 + r4 * 4);
            lg0 += p.x * wg[r4 * 4] + p.z * wg[r4 * 4 + 2]; lg1 += p.y * wg[r4 * 4 + 1] + p.w * wg[r4 * 4 + 3]; }
        const float la = logsigmoid_fast(lg0 + lg1) * (1.0f / 16.0f); lac[j * GKW + col] = la; tot += la; }
    float run = 0.f;
    for (int j = 0; j < 64; ++j) { run += lac[j * GKW + col]; lac[j * GKW + col] = __expf(tot - run); }
    __syncthreads();
    for (int i = 0; i < 8; ++i) { const int j = wave * 8 + i;
        const f32x4 e0 = *(const LAS f32x4*)(lac + j * GKW + lane * 8), e1 = *(const LAS f32x4*)(lac + j * GKW + lane * 8 + 4);
        v4u o; o.x = pk2(e0.x, e0.y); o.y = pk2(e0.z, e0.w); o.z = pk2(e1.x, e1.y); o.w = pk2(e1.z, e1.w);
        *(v4u*)(Ebuf + (size_t)(t0 + j) * GKW + lane * 8) = o; }
    dtot[(size_t)ch * GKW + col] = __expf(tot);
    __syncthreads();
}

__device__ __forceinline__ void gla_unit(const Args& a, LAS unsigned char* lds, int tid, int lane, int wave, int un) {
    const bf16* proj = (const bf16*)(a.ws + WS_PROJ); const bf16* Ebuf = (const bf16*)(a.ws + WS_E); const float* dtot = (const float*)(a.ws + WS_DTOT); bf16* ogla = (bf16*)(a.ws + WS_OGLA);
    const int pair_ = (un & 7) * 4 + (un >> 6), dvs = (un >> 3) & 7, hh = pair_ & 3, b = pair_ >> 2;
    LAS bf16* kdT0 = (LAS bf16*)lds; LAS bf16* vT0 = (LAS bf16*)(lds + 18432); LAS bf16* ST0 = (LAS bf16*)(lds + 18432 + 4608);
    LAS bf16* kdT1 = (LAS bf16*)(lds + 32768); LAS bf16* vT1 = (LAS bf16*)(lds + 32768 + 18432); LAS bf16* ST1 = (LAS bf16*)(lds + 32768 + 18432 + 4608);
    const int l15 = lane & 15, lq = lane >> 4, jl = tid >> 3, dv4 = (tid & 7) * 4, jt = (wave & 3) * 16, dvt = (wave >> 2) * 16, jp = tid >> 4, c16 = tid & 15;
#define GLA_BAR() do { asm volatile("s_waitcnt lgkmcnt(0)" ::: "memory"); __builtin_amdgcn_s_barrier(); asm volatile("" ::: "memory"); } while (0)
    f32x4 S0 = (f32x4){0.f, 0.f, 0.f, 0.f}, S1 = (f32x4){0.f, 0.f, 0.f, 0.f};
    v4u kn0[2], kn1[2], kn2[2], en0[2], en1[2], en2[2]; v2u vn0, vn1, vn2; bf16x8 qn0[4], qn1[4], qn2[4], qc[4]; f32x4 dn0, dn1, dn2, dc;
#define GLA_LOAD(c, kn, en, vn, qn, dn) do { const int t0c = b * SEQ + (c) * 64; const bf16* pr = proj + (size_t)(t0c + jl) * NP; \
          \
        kn[0] = *(const v4u*)(proj + (size_t)(t0c + 2 * jp) * NP + PK + hh * 128 + 8 * c16); kn[1] = *(const v4u*)(proj + (size_t)(t0c + 2 * jp + 1) * NP + PK + hh * 128 + 8 * c16); \
        en[0] = *(const v4u*)(Ebuf + (size_t)(t0c + 2 * jp) * GKW + hh * 128 + 8 * c16); en[1] = *(const v4u*)(Ebuf + (size_t)(t0c + 2 * jp + 1) * GKW + hh * 128 + 8 * c16); \
        vn = *(const v2u*)(pr + PV + hh * 256 + dvs * 32 + dv4); \
        _Pragma("unroll") for (int ks_ = 0; ks_ < 4; ++ks_) qn[ks_] = *(const bf16x8*)(proj + (size_t)(t0c + jt + l15) * NP + PQ + hh * 128 + 32 * ks_ + 8 * lq); \
        dn = *(const f32x4*)(dtot + (size_t)(b * NCH + (c)) * GKW + hh * 128 + 16 * wave + 4 * lq); } while (0)
#define GLA_PREPL(kn, en, vn, kdT, vT) do { \
        _Pragma("unroll") for (int i_ = 0; i_ < 8; ++i_) { const unsigned wa_ = kn[0][i_ >> 1], wb_ = kn[1][i_ >> 1], ea_ = en[0][i_ >> 1], eb_ = en[1][i_ >> 1]; \
            const float pa_ = ((i_ & 1) ? bfhi(wa_) : bflo(wa_)) * ((i_ & 1) ? bfhi(ea_) : bflo(ea_)), pb_ = ((i_ & 1) ? bfhi(wb_) : bflo(wb_)) * ((i_ & 1) ? bfhi(eb_) : bflo(eb_)); \
            *(LAS unsigned*)(kdT + (8 * c16 + i_) * 72 + ((((jp >> 2) ^ c16) & 7) << 3) + ((2 * jp) & 7)) = pk2(pa_, pb_); }     \
        _Pragma("unroll") for (int i_ = 0; i_ < 4; ++i_) { const unsigned w_ = vn[i_ >> 1]; vT[(dv4 + i_) * 72 + jl] = (bf16)((i_ & 1) ? (w_ >> 16) : (w_ & 0xffffu)); } } while (0)
#define GLA_QD(qn, dn) do { _Pragma("unroll") for (int ks_ = 0; ks_ < 4; ++ks_) qc[ks_] = qn[ks_]; dc = dn; } while (0)
#define GLA_BODYA(kdT, vT, ST) do { \
        S0 = S0 * dc; S1 = S1 * dc; \
        _Pragma("unroll") for (int ks = 0; ks < 2; ++ks) { \
            const bf16x8 A_ = *(const LAS bf16x8*)(kdT + (16 * wave + l15) * 72 + ((((4 * ks + lq) ^ (2 * wave + (l15 >> 3))) & 7) << 3)); \
            const bf16x8 B0_ = *(const LAS bf16x8*)(vT + l15 * 72 + 32 * ks + 8 * lq), B1_ = *(const LAS bf16x8*)(vT + (16 + l15) * 72 + 32 * ks + 8 * lq); \
            S0 = __builtin_amdgcn_mfma_f32_16x16x32_bf16(A_, B0_, S0, 0, 0, 0); S1 = __builtin_amdgcn_mfma_f32_16x16x32_bf16(A_, B1_, S1, 0, 0, 0); } \
        { v2u w0_, w1_; w0_.x = pk2(S0.x, S0.y); w0_.y = pk2(S0.z, S0.w); w1_.x = pk2(S1.x, S1.y); w1_.y = pk2(S1.z, S1.w); \
          *(LAS v2u*)(ST + l15 * 136 + 16 * wave + 4 * lq) = w0_; *(LAS v2u*)(ST + (16 + l15) * 136 + 16 * wave + 4 * lq) = w1_; } } while (0)
#define GLA_BODYB(c, ST) do { \
        f32x4 O_ = (f32x4){0.f, 0.f, 0.f, 0.f}; \
        _Pragma("unroll") for (int ks = 0; ks < 4; ++ks) { const bf16x8 A_ = *(const LAS bf16x8*)(ST + (dvt + l15) * 136 + 32 * ks + 8 * lq); O_ = __builtin_amdgcn_mfma_f32_16x16x32_bf16(A_, qc[ks], O_, 0, 0, 0); } \
        { const f32x4 Os_ = O_ * 0.08838834764831845f; v2u ob_; ob_.x = pk2(Os_.x, Os_.y); ob_.y = pk2(Os_.z, Os_.w); \
          *(v2u*)(ogla + (size_t)(b * SEQ + (c) * 64 + jt + l15) * 1024 + hh * 256 + dvs * 32 + dvt + 4 * lq) = ob_; } } while (0)
#define GLA_STEP(c, RA, RB, LA, LB) do { { const int cn_ = (c) + 3 < NCH ? (c) + 3 : NCH - 1; GLA_LOAD(cn_, kn##RA, en##RA, vn##RA, qn##RA, dn##RA); } \
        GLA_BODYA(kdT##LA, vT##LA, ST##LA); GLA_PREPL(kn##RB, en##RB, vn##RB, kdT##LB, vT##LB); GLA_BAR(); GLA_BODYB(c, ST##LA); GLA_QD(qn##RB, dn##RB); } while (0)
    GLA_LOAD(0, kn0, en0, vn0, qn0, dn0); GLA_LOAD(1, kn1, en1, vn1, qn1, dn1); GLA_LOAD(2, kn2, en2, vn2, qn2, dn2);
    GLA_PREPL(kn0, en0, vn0, kdT0, vT0); GLA_QD(qn0, dn0);
    GLA_BAR();
    static_assert(NCH == 32, "the step schedule below is written for 32 chunks: 5 x 6 + 2");
    for (int c = 0; c < 30; c += 6) {
        GLA_STEP(c, 0, 1, 0, 1); GLA_STEP(c + 1, 1, 2, 1, 0); GLA_STEP(c + 2, 2, 0, 0, 1); GLA_STEP(c + 3, 0, 1, 1, 0); GLA_STEP(c + 4, 1, 2, 0, 1); GLA_STEP(c + 5, 2, 0, 1, 0);
    }
    GLA_STEP(30, 0, 1, 0, 1); GLA_STEP(31, 1, 2, 1, 0);
#undef GLA_STEP
#undef GLA_PREPL
#undef GLA_QD
#undef GLA_BODYA
#undef GLA_BODYB
#undef GLA_BAR
#undef GLA_LOAD
}

__device__ __forceinline__ void unpack16(const v4u& p0, const v4u& p1, float (&o)[16]) {
#pragma unroll
    for (int j = 0; j < 4; ++j) { o[2 * j] = bflo(p0[j]); o[2 * j + 1] = bfhi(p0[j]); o[8 + 2 * j] = bflo(p1[j]); o[8 + 2 * j + 1] = bfhi(p1[j]); }
}
__device__ __forceinline__ void mixpost_chunk(const Args& a, int l, int lane, int wave, int ch) {
    const bf16* proj = (const bf16*)(a.ws + WS_PROJ); const bf16* ogla = (const bf16*)(a.ws + WS_OGLA);
    const int c0 = 16 * lane, tfirst = ch * 64 + wave * 8, sfirst = tfirst % SEQ;
    float gn[16], cw0[16], cw1[16], cw2[16], cn[16], u1[16], u2[16];
#pragma unroll
    for (int i = 0; i < 16; ++i) { gn[i] = a.in[7][l * 256 + ((c0 + i) & 255)]; cw0[i] = a.in[8][(size_t)l * 3072 + c0 + i]; cw1[i] = a.in[8][(size_t)l * 3072 + 1024 + c0 + i];
        cw2[i] = a.in[8][(size_t)l * 3072 + 2048 + c0 + i]; cn[i] = a.in[9][l * 1024 + c0 + i]; u1[i] = 0.f; u2[i] = 0.f; }
    if (sfirst >= 2) {
        float cc[16], chh[16];
        { const bf16* pr = proj + (size_t)(tfirst - 2) * NP; unpack16(*(const v4u*)(pr + PCC + c0), *(const v4u*)(pr + PCC + c0 + 8), cc); unpack16(*(const v4u*)(pr + PCH + c0), *(const v4u*)(pr + PCH + c0 + 8), chh); }
#pragma unroll
        for (int i = 0; i < 16; ++i) u2[i] = cc[i] * chh[i];
        { const bf16* pr = proj + (size_t)(tfirst - 1) * NP; unpack16(*(const v4u*)(pr + PCC + c0), *(const v4u*)(pr + PCC + c0 + 8), cc); unpack16(*(const v4u*)(pr + PCH + c0), *(const v4u*)(pr + PCH + c0 + 8), chh); }
#pragma unroll
        for (int i = 0; i < 16; ++i) u1[i] = cc[i] * chh[i];
    }
#pragma unroll 2
    for (int it = 0; it < 8; ++it) { const int t = tfirst + it; const bf16* pr = proj + (size_t)t * NP;
        float o[16], r[16], cb[16], cc[16], chh[16];
        unpack16(*(const v4u*)(ogla + (size_t)t * 1024 + c0), *(const v4u*)(ogla + (size_t)t * 1024 + c0 + 8), o);
        unpack16(*(const v4u*)(pr + PR + c0), *(const v4u*)(pr + PR + c0 + 8), r);
        unpack16(*(const v4u*)(pr + PCB + c0), *(const v4u*)(pr + PCB + c0 + 8), cb);
        unpack16(*(const v4u*)(pr + PCC + c0), *(const v4u*)(pr + PCC + c0 + 8), cc);
        unpack16(*(const v4u*)(pr + PCH + c0), *(const v4u*)(pr + PCH + c0 + 8), chh);
        float ss = 0.f;
#pragma unroll
        for (int i = 0; i < 16; ++i) ss += o[i] * o[i];
        ss += __uint_as_float((unsigned)__builtin_amdgcn_update_dpp(0, (int)__float_as_uint(ss), 0xB1, 0xf, 0xf, false)); ss += __uint_as_float((unsigned)__builtin_amdgcn_update_dpp(0, (int)__float_as_uint(ss), 0x4E, 0xf, 0xf, false));
        ss += __uint_as_float((unsigned)__builtin_amdgcn_update_dpp(0, (int)__float_as_uint(ss), 0x124, 0xf, 0xf, false)); ss += __uint_as_float((unsigned)__builtin_amdgcn_update_dpp(0, (int)__float_as_uint(ss), 0x128, 0xf, 0xf, false));
        const float rg = rsqrtf(ss * (1.0f / 256.f) + EPS);
        float val[16]; float s2 = 0.f;
#pragma unroll
        for (int i = 0; i < 16; ++i) { const float u0 = cc[i] * chh[i]; val[i] = cb[i] * (cw0[i] * u2[i] + cw1[i] * u1[i] + cw2[i] * u0); s2 += val[i] * val[i]; u2[i] = u1[i]; u1[i] = u0; }
        const float rc = rsqrtf(wave_sum(s2) * (1.0f / 1024.f) + EPS);
        float ya[16], yb[16]; float mx = 0.f;
#pragma unroll
        for (int i = 0; i < 16; ++i) { ya[i] = o[i] * rg * gn[i] * silu_f(r[i]); yb[i] = val[i] * rc * cn[i]; mx = fmaxf(mx, fmaxf(fabsf(ya[i]), fabsf(yb[i]))); }
        mx = wave_max(mx);
        const float inv = mx > 0.f ? 127.0f / mx : 0.f;
        v4u y0, y1;
#pragma unroll
        for (int j = 0; j < 4; ++j) { y0[j] = pack_i8(ya[4 * j] * inv, ya[4 * j + 1] * inv, ya[4 * j + 2] * inv, ya[4 * j + 3] * inv); y1[j] = pack_i8(yb[4 * j] * inv, yb[4 * j + 1] * inv, yb[4 * j + 2] * inv, yb[4 * j + 3] * inv); }
        unsigned char* yr = a.ws + WS_Y8 + (size_t)t * D;
        *(v4u*)(yr + c0) = y0; *(v4u*)(yr + 1024 + c0) = y1;
#if !I8_OUT
        { v4u b0, b1, b2, b3;
#pragma unroll
          for (int j = 0; j < 4; ++j) { b0[j] = pk2(ya[2 * j], ya[2 * j + 1]); b1[j] = pk2(ya[8 + 2 * j], ya[9 + 2 * j]); b2[j] = pk2(yb[2 * j], yb[2 * j + 1]); b3[j] = pk2(yb[8 + 2 * j], yb[9 + 2 * j]); }
          bf16* ybr = (bf16*)(a.ws + WS_Y) + (size_t)t * D;
          *(v4u*)(ybr + c0) = b0; *(v4u*)(ybr + c0 + 8) = b1; *(v4u*)(ybr + 1024 + c0) = b2; *(v4u*)(ybr + 1024 + c0 + 8) = b3; }
#endif
        if (lane == 0) ((float*)(a.ws + WS_SAY))[t] = mx * (1.0f / 127.0f);
    }
}

__device__ __forceinline__ void ln1_chunk(const Args& a, int l, LAS unsigned char* lds, int lane, int wave, int ch) {
    const float* zbuf = (const float*)(a.ws + WS_Z); const float* mod = (const float*)(a.ws + WS_MOD);
    const int b = ch / NCH; const float* mb = mod + ((size_t)l * NB + b) * 6 * D;
#pragma unroll 2
    for (int it = 0; it < 8; ++it) { const int t = ch * 64 + wave * 8 + it;
        float z[32];
#pragma unroll
#if RES16_Z
        for (int c = 0; c < 8; ++c) { const v2u v0 = *(const v2u*)((const bf16*)zbuf + (size_t)t * D + (c * 64 + lane) * 4); z[c * 4] = bflo(v0.x); z[c * 4 + 1] = bfhi(v0.x); z[c * 4 + 2] = bflo(v0.y); z[c * 4 + 3] = bfhi(v0.y); }
#else
        for (int c = 0; c < 8; ++c) { const f32x4 v0 = *(const f32x4*)(zbuf + (size_t)t * D + (c * 64 + lane) * 4); z[c * 4] = v0.x; z[c * 4 + 1] = v0.y; z[c * 4 + 2] = v0.z; z[c * 4 + 3] = v0.w; }
#endif
        ln_tail(z, t, lane, a.in[11] + (size_t)l * D, a.in[12] + (size_t)l * D, RES16_X1 ? (float*)nullptr : (float*)(a.ws + WS_X1), mb + 3 * D, mb + 4 * D, I8_WQ ? (bf16*)nullptr : (bf16*)(a.ws + WS_H2), a.ws + WS_HQ8, (float*)(a.ws + WS_HSC), lds + wave * 2304, I8_WQ ? a.ws + WS_H28 : (unsigned char*)nullptr, nullptr, RES16_X1 ? (bf16*)(a.ws + WS_X1) : (bf16*)nullptr);
    }
}

template <int N> __device__ __forceinline__ void bitonic_sort_desc(float (&v)[N]) {
#pragma unroll
    for (int k = 2; k <= N; k <<= 1)
#pragma unroll
        for (int j = k >> 1; j > 0; j >>= 1)
#pragma unroll
            for (int i = 0; i < N; ++i) { const int p = i ^ j; if (p > i) { const bool desc = ((i & k) == 0); const float x = v[i], y = v[p]; const float mx = fmaxf(x, y), mn = fminf(x, y); v[i] = desc ? mx : mn; v[p] = desc ? mn : mx; } }
}
__device__ __forceinline__ void merge_top16(float (&x)[16], const float (&y)[16]) {
#pragma unroll
    for (int i = 0; i < 16; ++i) x[i] = fmaxf(x[i], y[15 - i]);
#pragma unroll
    for (int j = 8; j > 0; j >>= 1)
#pragma unroll
        for (int i = 0; i < 16; ++i) { const int p = i ^ j; if (p > i) { const float u = x[i], w = x[p]; x[i] = fmaxf(u, w); x[p] = fminf(u, w); } }
}
__device__ __forceinline__ void ce_desc(float& ka, int& pa, float& kb, int& pb) { const bool sw = kb > ka; const float k0 = sw ? kb : ka, k1 = sw ? ka : kb; const int p0 = sw ? pb : pa, p1 = sw ? pa : pb; ka = k0; pa = p0; kb = k1; pb = p1; }
__device__ __forceinline__ void bitonic_sort_desc_kp(float (&k)[16], int (&p)[16]) {
#pragma unroll
    for (int kk = 2; kk <= 16; kk <<= 1)
#pragma unroll
        for (int j = kk >> 1; j > 0; j >>= 1)
#pragma unroll
            for (int i = 0; i < 16; ++i) { const int q = i ^ j; if (q > i) { if ((i & kk) == 0) ce_desc(k[i], p[i], k[q], p[q]); else ce_desc(k[q], p[q], k[i], p[i]); } }
}
__device__ __forceinline__ void merge_top16_kp(float (&k)[16], int (&p)[16], const float (&k2)[16], const int (&p2)[16]) {
#pragma unroll
    for (int i = 0; i < 16; ++i) { const bool sw = k2[15 - i] > k[i]; k[i] = sw ? k2[15 - i] : k[i]; p[i] = sw ? p2[15 - i] : p[i]; }
#pragma unroll
    for (int j = 8; j > 0; j >>= 1)
#pragma unroll
        for (int i = 0; i < 16; ++i) { const int q = i ^ j; if (q > i) ce_desc(k[i], p[i], k[q], p[q]); }
}
__device__ constexpr int cand_i(int s) { return s < 16 ? 0 : s < 24 ? 1 : s < 29 ? 2 : s < 33 ? 3 : s < 36 ? 4 : s < 38 ? 5 : s < 40 ? 6 : s < 42 ? 7 : s < 50 ? s - 34 : -1; }
__device__ constexpr int cand_j(int s) { return s < 16 ? s : s < 24 ? s - 16 : s < 29 ? s - 24 : s < 33 ? s - 29 : s < 36 ? s - 33 : s < 38 ? s - 36 : s < 40 ? s - 38 : s < 42 ? s - 40 : s < 50 ? 0 : -1; }

__device__ __forceinline__ void peer_retrieve(const Args& a, int l, LAS unsigned char* lds, int lane, int wave, int ch) {
    const bf16* qbuf = (const bf16*)(a.ws + WS_Q); const bf16* keys = (const bf16*)(a.ws + WS_KEYS) + ((size_t)(l * 8 + wave) * 2) * 128 * 128;
    LAS int* eg_e = (LAS int*)lds; LAS float* eg_g = (LAS float*)(lds + 32768);
    const int l31 = lane & 31, l5 = lane >> 5, h = wave, t0 = ch * 64;
    for (int tt = 0; tt < 2; ++tt) {
        float sv[2][16];
#pragma unroll
        for (int p = 0; p < 2; ++p) {
            f32x16 acc[4];
#pragma unroll
            for (int nt = 0; nt < 4; ++nt)
#pragma unroll
                for (int r = 0; r < 16; ++r) acc[nt][r] = 0.f;
            const bf16* qp = qbuf + (size_t)(t0 + 32 * tt + l31) * D + h * 256 + p * 128 + 8 * l5;
            const bf16* kp = keys + (size_t)(p * 128 + l31) * 128 + 8 * l5;
#pragma unroll 4
            for (int ks = 0; ks < 8; ++ks) { const bf16x8 bq = *(const bf16x8*)(qp + 16 * ks);
#pragma unroll
                for (int nt = 0; nt < 4; ++nt) { const bf16x8 ak = *(const bf16x8*)(kp + (size_t)(32 * nt) * 128 + 16 * ks); acc[nt] = __builtin_amdgcn_mfma_f32_32x32x16_bf16(ak, bq, acc[nt], 0, 0, 0); } }
            float v[4][16];
#pragma unroll
            for (int nt = 0; nt < 4; ++nt)
#pragma unroll
                for (int r = 0; r < 16; ++r) { const unsigned idx = 32u * nt + (r & 3) + 8u * (r >> 2) + 4u * l5; v[nt][r] = __uint_as_float((__float_as_uint(acc[nt][r]) & 0xffffff80u) | idx); }
#pragma unroll
            for (int nt = 0; nt < 4; ++nt) bitonic_sort_desc<16>(v[nt]);
            merge_top16(v[0], v[1]); merge_top16(v[2], v[3]); merge_top16(v[0], v[2]);
            float o[16];
#pragma unroll
            for (int i = 0; i < 16; ++i) o[i] = __shfl_xor(v[0][i], 32);
            merge_top16(v[0], o);
#pragma unroll
            for (int i = 0; i < 16; ++i) sv[p][i] = v[0][i];
        }
        LAS unsigned char* idxb = (LAS unsigned char*)(lds + 69632) + wave * 2048 + lane * 32;
        { v4u w0, w1;
#pragma unroll
          for (int q4 = 0; q4 < 4; ++q4) {
              w0[q4] = (__float_as_uint(sv[0][4 * q4]) & 127u) | ((__float_as_uint(sv[0][4 * q4 + 1]) & 127u) << 8) | ((__float_as_uint(sv[0][4 * q4 + 2]) & 127u) << 16) | ((__float_as_uint(sv[0][4 * q4 + 3]) & 127u) << 24);
              w1[q4] = (__float_as_uint(sv[1][4 * q4]) & 127u) | ((__float_as_uint(sv[1][4 * q4 + 1]) & 127u) << 8) | ((__float_as_uint(sv[1][4 * q4 + 2]) & 127u) << 16) | ((__float_as_uint(sv[1][4 * q4 + 3]) & 127u) << 24); }
          *(LAS v4u*)(idxb) = w0; *(LAS v4u*)(idxb + 16) = w1; }
        float ck[4][16];
#pragma unroll
        for (int s = 0; s < 64; ++s) {
            if (cand_i(s) >= 0) { const unsigned b0 = __float_as_uint(sv[0][cand_i(s) < 0 ? 0 : cand_i(s)]), b1 = __float_as_uint(sv[1][cand_j(s) < 0 ? 0 : cand_j(s)]);
                const float sum = __uint_as_float(b0 & 0xffffff80u) + __uint_as_float(b1 & 0xffffff80u);
                ck[s >> 4][s & 15] = __uint_as_float((__float_as_uint(sum) & 0xffffff00u) | (unsigned)((cand_i(s) < 0 ? 0 : cand_i(s)) * 16 + (cand_j(s) < 0 ? 0 : cand_j(s)))); }
            else ck[s >> 4][s & 15] = -3.0e38f; }
        bitonic_sort_desc<16>(ck[1]); bitonic_sort_desc<16>(ck[2]);
        merge_top16(ck[0], ck[1]); merge_top16(ck[2], ck[3]); merge_top16(ck[0], ck[2]);
        LDS_WAIT(); asm volatile("" ::: "memory");
        float ex[16]; int ce[16]; float den = 0.f;
        const float cmax = __uint_as_float(__float_as_uint(ck[0][0]) & 0xffffff00u);
#pragma unroll
        for (int i = 0; i < 16; ++i) { const unsigned bits = __float_as_uint(ck[0][i]); ex[i] = __expf(__uint_as_float(bits & 0xffffff00u) - cmax); den += ex[i];
            ce[i] = (int)idxb[(bits >> 4) & 15u] * 128 + (int)idxb[16 + (bits & 15u)]; }
        const float inv = 1.0f / den;
        if (l5 == 0) {
            const int base = (32 * tt + l31) * 128 + h * 16;
#pragma unroll
            for (int i4 = 0; i4 < 4; ++i4) { *(LAS v4u*)(eg_e + base + 4 * i4) = (v4u){(unsigned)ce[4 * i4], (unsigned)ce[4 * i4 + 1], (unsigned)ce[4 * i4 + 2], (unsigned)ce[4 * i4 + 3]};
                *(LAS f32x4*)(eg_g + base + 4 * i4) = (f32x4){ex[4 * i4] * inv, ex[4 * i4 + 1] * inv, ex[4 * i4 + 2] * inv, ex[4 * i4 + 3] * inv}; }
        }
        LDS_WAIT(); asm volatile("" ::: "memory");
    }
}

typedef unsigned char uc4 __attribute__((ext_vector_type(4)));
constexpr int NSLICE = 16, SLICE_SHIFT = 10;
__device__ __forceinline__ int sdot4i(unsigned w, unsigned x, int acc) { return __builtin_amdgcn_sdot4((int)w, (int)x, acc, false); }
__device__ __forceinline__ void fma_ub4(unsigned w, float s, float& y0, float& y1, float& y2, float& y3) { const uc4 b = __builtin_bit_cast(uc4, w); y0 += s * (float)b.x; y1 += s * (float)b.y; y2 += s * (float)b.z; y3 += s * (float)b.w; }
#if TAB4
__device__ __forceinline__ void peer_tail(const Args& a, int l, int t, int lane, const bf16* Yrow, const float* mb, const float* mbn, bool last) {
    const float* x1buf = (const float*)(a.ws + WS_X1);
    float z[32];
#pragma unroll
    for (int c8 = 0; c8 < 8; ++c8) { const int col = (c8 * 64 + lane) * 4;
        const v2u yb = *(const v2u*)(Yrow + col); const f32x4 yv = (f32x4){bflo(yb.x), bfhi(yb.x), bflo(yb.y), bfhi(yb.y)};
#if RES16_X1
        const v2u xb_ = *(const v2u*)((const bf16*)x1buf + (size_t)t * D + col); const f32x4 x0 = (f32x4){bflo(xb_.x), bfhi(xb_.x), bflo(xb_.y), bfhi(xb_.y)}, g0 = *(const f32x4*)(mb + 5 * D + col);
#else
        const f32x4 x0 = *(const f32x4*)(x1buf + (size_t)t * D + col), g0 = *(const f32x4*)(mb + 5 * D + col);
#endif
        z[c8 * 4] = ALPHA * x0.x + (1.f + g0.x) * yv.x; z[c8 * 4 + 1] = ALPHA * x0.y + (1.f + g0.y) * yv.y; z[c8 * 4 + 2] = ALPHA * x0.z + (1.f + g0.z) * yv.z; z[c8 * 4 + 3] = ALPHA * x0.w + (1.f + g0.w) * yv.w; }
    ln_tail(z, t, lane, a.in[17] + (size_t)l * D, a.in[18] + (size_t)l * D, last ? a.out : (RES16_X ? (float*)nullptr : (float*)(a.ws + WS_X)), mbn, mbn + D, (last || I8_GATE) ? (bf16*)nullptr : (bf16*)(a.ws + WS_H), nullptr, nullptr, nullptr, last ? (unsigned char*)nullptr : a.ws + WS_H8, (float*)(a.ws + WS_SAH), (RES16_X && !last) ? (bf16*)(a.ws + WS_X) : (bf16*)nullptr);
}
template <class TT, int N, int M> __device__ __forceinline__ void treduce(TT (&v)[N], int lane) {
    const bool c0 = (lane & M) != 0, c1 = (lane & (2 * M)) != 0, c2 = (lane & (4 * M)) != 0;
#pragma unroll
    for (int m = 0; m < N / 2; ++m) { const TT keep = c0 ? v[2 * m + 1] : v[2 * m], send = c0 ? v[2 * m] : v[2 * m + 1]; v[m] = keep + __shfl_xor(send, M); }
#pragma unroll
    for (int m = 0; m < N / 4; ++m) { const TT keep = c1 ? v[2 * m + 1] : v[2 * m], send = c1 ? v[2 * m] : v[2 * m + 1]; v[m] = keep + __shfl_xor(send, 2 * M); }
#pragma unroll
    for (int m = 0; m < N / 8; ++m) { const TT keep = c2 ? v[2 * m + 1] : v[2 * m], send = c2 ? v[2 * m] : v[2 * m + 1]; v[m] = keep + __shfl_xor(send, 4 * M); }
}
__device__ __forceinline__ int allsum_8_16_32(int x) {
    x += __builtin_amdgcn_update_dpp(0, x, 0x128, 0xf, 0xf, false);
    { const auto r = __builtin_amdgcn_permlane16_swap((unsigned)x, (unsigned)x, false, false); x = (int)(r[0] + r[1]); }
    { const auto r = __builtin_amdgcn_permlane32_swap((unsigned)x, (unsigned)x, false, false); x = (int)(r[0] + r[1]); }
    return x; }
__device__ __forceinline__ float allmax_8_16_32(float x) {
    x = fmaxf(x, __uint_as_float((unsigned)__builtin_amdgcn_update_dpp(0, (int)__float_as_uint(x), 0x128, 0xf, 0xf, false)));
    { const auto r = __builtin_amdgcn_permlane16_swap(__float_as_uint(x), __float_as_uint(x), false, false); x = fmaxf(__uint_as_float(r[0]), __uint_as_float(r[1])); }
    { const auto r = __builtin_amdgcn_permlane32_swap(__float_as_uint(x), __float_as_uint(x), false, false); x = fmaxf(__uint_as_float(r[0]), __uint_as_float(r[1])); }
    return x; }
__device__ __forceinline__ void treduce32x8(int (&v)[32], int lane) {
    const bool c0 = (lane & 8) != 0;
#pragma unroll
    for (int m = 0; m < 16; ++m) { const int keep = c0 ? v[2 * m + 1] : v[2 * m], send = c0 ? v[2 * m] : v[2 * m + 1]; v[m] = keep + __builtin_amdgcn_update_dpp(0, send, 0x128, 0xf, 0xf, false); }
#pragma unroll
    for (int m = 0; m < 8; ++m) { const auto r = __builtin_amdgcn_permlane16_swap((unsigned)v[2 * m], (unsigned)v[2 * m + 1], false, false); v[m] = (int)(r[0] + r[1]); }
#pragma unroll
    for (int m = 0; m < 4; ++m) { const auto r = __builtin_amdgcn_permlane32_swap((unsigned)v[2 * m], (unsigned)v[2 * m + 1], false, false); v[m] = (int)(r[0] + r[1]); }
}
__device__ __forceinline__ void tr4x4(unsigned a, unsigned b, unsigned c, unsigned d, unsigned& t0, unsigned& t1, unsigned& t2, unsigned& t3) {
    const unsigned x0 = __builtin_amdgcn_perm(b, a, 0x05010400u), x1 = __builtin_amdgcn_perm(b, a, 0x07030602u), y0 = __builtin_amdgcn_perm(d, c, 0x05010400u), y1 = __builtin_amdgcn_perm(d, c, 0x07030602u);
    t0 = __builtin_amdgcn_perm(y0, x0, 0x05040100u); t1 = __builtin_amdgcn_perm(y0, x0, 0x07060302u); t2 = __builtin_amdgcn_perm(y1, x1, 0x05040100u); t3 = __builtin_amdgcn_perm(y1, x1, 0x07060302u);
}
__device__ __forceinline__ int sdot8i(unsigned w, unsigned x, int acc) { return __builtin_amdgcn_sdot8((int)w, (int)x, acc, false); }
__device__ __forceinline__ float slot_scale(unsigned w3) { return __builtin_amdgcn_exp2f((float)(w3 >> 24) * 0.125f - 16.0f); }
__device__ __forceinline__ void peer_experts(const Args& a, int l, LAS unsigned char* lds, int lane0, int wave, int ch) {
    const float* mod = (const float*)(a.ws + WS_MOD);
    const unsigned char* ut = a.ws + WS_UT + (size_t)l * NE * 1152; const unsigned char* vt = a.ws + WS_VT + (size_t)l * NE * 1152; const unsigned char* hq8 = a.ws + WS_HQ8;
    const float* hsc = (const float*)(a.ws + WS_HSC);
    bf16* Ybuf = (bf16*)(a.ws + WS_Z);
    const LAS int* eg_e = (const LAS int*)lds; LAS float* sw = (LAS float*)(lds + 32768);
    LAS float* apart = (LAS float*)(lds + 65536);
    const int b = ch / NCH; const bool last = (l == NL - 1);
    const float* mb = mod + ((size_t)l * NB + b) * 6 * D; const float* mbn = mod + ((size_t)(last ? l : l + 1) * NB + b) * 6 * D;
    const int tlw = wave * 8;
    { const int lane = lane0;
#pragma unroll
      for (int i = 0; i < 16; ++i) apart[tlw * 128 + i * 64 + lane] = 0.f; }
    LDS_WAIT(); asm volatile("" ::: "memory");
    {
        int laneL = lane0; asm volatile("" : "+v"(laneL)); const int lane = laneL;
        const int g = lane >> 3, l7 = lane & 7;
        v4u bufA[16], bufB[16], hA0, hA1, hB0, hB1;
#define CU_LOAD(buf, h0_, h1_, idx_) do { const int u_ = (idx_) >> 3, tl_ = tlw + ((idx_) & 7); const unsigned soff_ = (unsigned)(u_ * 128 + l7 * 16); \
            const unsigned char* hp_ = hq8 + (size_t)(ch * 64 + tl_) * 2304 + (u_ * 8 + l7) * 32; h0_ = *(const v4u*)hp_; h1_ = *(const v4u*)(hp_ + 16); \
            _Pragma("unroll") for (int i_ = 0; i_ < 16; ++i_) { const unsigned e_ = (unsigned)eg_e[tl_ * 128 + 8 * i_ + g]; buf[i_] = *(const v4u*)(ut + (size_t)(e_ * 1152u + soff_)); } } while (0)
#define CU_COMP(buf, h0_, h1_, idx_) do { const int tl_ = tlw + ((idx_) & 7); float accv_[16]; \
            _Pragma("unroll") for (int i_ = 0; i_ < 16; ++i_) { int sl_ = 0, sh_ = 0; \
                _Pragma("unroll") for (int d_ = 0; d_ < 4; ++d_) { const unsigned x_ = buf[i_][d_] ^ 0x88888888u; sl_ = sdot8i(x_, h0_[d_], sl_); sh_ = sdot8i(x_, h1_[d_], sh_); } \
                accv_[i_] = slot_scale(buf[i_][3]) * (float)(16 * sh_ + sl_); } \
            treduce<float, 16, 1>(accv_, lane); \
            apart[tl_ * 128 + 8 * l7 + g] += accv_[0]; apart[tl_ * 128 + 8 * (8 + l7) + g] += accv_[1]; } while (0)
        CU_LOAD(bufA, hA0, hA1, 0);
        for (int idx = 0; idx < 72; idx += 2) {
            CU_LOAD(bufB, hB0, hB1, idx + 1);
            CU_COMP(bufA, hA0, hA1, idx);
            { const int nx_ = idx + 2 < 72 ? idx + 2 : 71; CU_LOAD(bufA, hA0, hA1, nx_); }
            CU_COMP(bufB, hB0, hB1, idx + 1);
        }
#undef CU_LOAD
#undef CU_COMP
        LDS_WAIT(); asm volatile("" ::: "memory");
        for (int it = 0; it < 8; ++it) { const int tl = tlw + it; const float shs = hsc[ch * 64 + tl];
            const float w0 = sw[tl * 128 + lane] * gelu_tanh_f(apart[tl * 128 + lane] * shs), w1 = sw[tl * 128 + 64 + lane] * gelu_tanh_f(apart[tl * 128 + 64 + lane] * shs);
            sw[tl * 128 + lane] = w0; sw[tl * 128 + 64 + lane] = w1; }
        LDS_WAIT(); asm volatile("" ::: "memory");
    }
    {
        int laneL = lane0; asm volatile("" : "+v"(laneL)); const int lane = laneL;
        const int g = lane >> 3, l7 = lane & 7;
        v4u bufA[16], bufB[16];
#define CV_LOAD(buf, idx_) do { const int u_ = (idx_) >> 3, tl_ = tlw + ((idx_) & 7); const unsigned soff_ = (unsigned)(u_ * 128 + l7 * 16); \
            _Pragma("unroll") for (int i_ = 0; i_ < 16; ++i_) { const unsigned e_ = (unsigned)eg_e[tl_ * 128 + 8 * i_ + g]; buf[i_] = *(const v4u*)(vt + (size_t)(e_ * 1152u + soff_)); } } while (0)
#define CV_COMP(buf, idx_) do { const int u_ = (idx_) >> 3, tl_ = tlw + ((idx_) & 7); \
            float wf_[16]; float wmx_ = 0.f; \
            _Pragma("unroll") for (int i_ = 0; i_ < 16; ++i_) { wf_[i_] = sw[tl_ * 128 + 8 * i_ + g] * slot_scale(buf[i_][3]); wmx_ = fmaxf(wmx_, fabsf(wf_[i_])); } \
            wmx_ = allmax_8_16_32(wmx_);     \
            const float winv_ = wmx_ > 0.f ? 127.0f / wmx_ : 0.f, wsc_ = wmx_ * (1.0f / 127.0f); \
              \
            unsigned wq4_[4]; int wsum_ = 0; \
            _Pragma("unroll") for (int gp_ = 0; gp_ < 4; ++gp_) { \
                const unsigned m0_ = __float_as_uint(wf_[4 * gp_] * winv_ + 12582912.0f), m1_ = __float_as_uint(wf_[4 * gp_ + 1] * winv_ + 12582912.0f), m2_ = __float_as_uint(wf_[4 * gp_ + 2] * winv_ + 12582912.0f), m3_ = __float_as_uint(wf_[4 * gp_ + 3] * winv_ + 12582912.0f); \
                wq4_[gp_] = __builtin_amdgcn_perm(__builtin_amdgcn_perm(m3_, m2_, 0x0c0c0400u), __builtin_amdgcn_perm(m1_, m0_, 0x0c0c0400u), 0x05040100u); \
                wsum_ = sdot4i(wq4_[gp_], 0x01010101u, wsum_); } \
            int yi_[32]; \
            _Pragma("unroll") for (int q_ = 0; q_ < 32; ++q_) yi_[q_] = 0; \
            _Pragma("unroll") for (int gp_ = 0; gp_ < 4; ++gp_) { \
                _Pragma("unroll") for (int d_ = 0; d_ < 4; ++d_) { const unsigned A_ = buf[4 * gp_][d_], B_ = buf[4 * gp_ + 1][d_], C_ = buf[4 * gp_ + 2][d_], D_ = buf[4 * gp_ + 3][d_]; \
                    unsigned t0_, t1_, t2_, t3_; \
                    tr4x4(A_, B_, C_, D_, t0_, t1_, t2_, t3_);     \
                    yi_[8 * d_]     = sdot4i(t0_ & 0x0f0f0f0fu, wq4_[gp_], yi_[8 * d_]);     yi_[8 * d_ + 1] = sdot4i((t0_ >> 4) & 0x0f0f0f0fu, wq4_[gp_], yi_[8 * d_ + 1]); \
                    yi_[8 * d_ + 2] = sdot4i(t1_ & 0x0f0f0f0fu, wq4_[gp_], yi_[8 * d_ + 2]); yi_[8 * d_ + 3] = sdot4i((t1_ >> 4) & 0x0f0f0f0fu, wq4_[gp_], yi_[8 * d_ + 3]); \
                    yi_[8 * d_ + 4] = sdot4i(t2_ & 0x0f0f0f0fu, wq4_[gp_], yi_[8 * d_ + 4]); yi_[8 * d_ + 5] = sdot4i((t2_ >> 4) & 0x0f0f0f0fu, wq4_[gp_], yi_[8 * d_ + 5]); \
                    yi_[8 * d_ + 6] = sdot4i(t3_ & 0x0f0f0f0fu, wq4_[gp_], yi_[8 * d_ + 6]); yi_[8 * d_ + 7] = sdot4i((t3_ >> 4) & 0x0f0f0f0fu, wq4_[gp_], yi_[8 * d_ + 7]); } } \
            treduce32x8(yi_, lane); \
            wsum_ = allsum_8_16_32(wsum_);     \
            float y_[4]; \
            _Pragma("unroll") for (int q_ = 0; q_ < 4; ++q_) y_[q_] = wsc_ * (float)(yi_[q_] - 8 * wsum_); \
            { const int colb_ = u_ * 240 + l7 * 30 + g; bf16* yr_ = Ybuf + (size_t)(ch * 64 + tl_) * D + colb_; \
              _Pragma("unroll") for (int m_ = 0; m_ < 4; ++m_) if (8 * m_ + g < 30 && colb_ + 8 * m_ < D) yr_[8 * m_] = (bf16)(pk2(y_[m_], 0.f) & 0xffffu); } } while (0)
        CV_LOAD(bufA, 0);
        for (int idx = 0; idx < 72; idx += 2) {
            CV_LOAD(bufB, idx + 1);
            CV_COMP(bufA, idx);
            { const int nx_ = idx + 2 < 72 ? idx + 2 : 71; CV_LOAD(bufA, nx_); }
            CV_COMP(bufB, idx + 1);
        }
#undef CV_LOAD
#undef CV_COMP
    }
    asm volatile("s_waitcnt vmcnt(0)" ::: "memory");
    __builtin_amdgcn_fence(__ATOMIC_ACQUIRE, "agent");
    asm volatile("s_waitcnt vmcnt(0)" ::: "memory");
    for (int it = 0; it < 8; ++it) { int laneT = lane0; asm volatile("" : "+v"(laneT)); const int t = ch * 64 + tlw + it;
        peer_tail(a, l, t, laneT, Ybuf + (size_t)t * D, mb, mbn, last); }
}
#else
__device__ __forceinline__ void peer_tail(const Args& a, int l, int t, int lane, const float* Yrow, const float* mb, const float* mbn, bool last) {
    const float* x1buf = (const float*)(a.ws + WS_X1);
    float z[32];
#pragma unroll
    for (int c = 0; c < 2; ++c)
#pragma unroll
        for (int k = 0; k < 4; ++k) { const int c8 = 4 * c + k, col = (c8 * 64 + lane) * 4;
            const v2u yb = *(const v2u*)((const bf16*)Yrow + (c * 64 + lane) * 16 + 4 * k); const f32x4 yv = (f32x4){bflo(yb.x), bfhi(yb.x), bflo(yb.y), bfhi(yb.y)};
#if RES16_X1
            const v2u xb_ = *(const v2u*)((const bf16*)x1buf + (size_t)t * D + col); const f32x4 x0 = (f32x4){bflo(xb_.x), bfhi(xb_.x), bflo(xb_.y), bfhi(xb_.y)}, g0 = *(const f32x4*)(mb + 5 * D + col);
#else
            const f32x4 x0 = *(const f32x4*)(x1buf + (size_t)t * D + col), g0 = *(const f32x4*)(mb + 5 * D + col);
#endif
            z[c8 * 4] = ALPHA * x0.x + (1.f + g0.x) * yv.x; z[c8 * 4 + 1] = ALPHA * x0.y + (1.f + g0.y) * yv.y; z[c8 * 4 + 2] = ALPHA * x0.z + (1.f + g0.z) * yv.z; z[c8 * 4 + 3] = ALPHA * x0.w + (1.f + g0.w) * yv.w; }
    ln_tail(z, t, lane, a.in[17] + (size_t)l * D, a.in[18] + (size_t)l * D, last ? a.out : (RES16_X ? (float*)nullptr : (float*)(a.ws + WS_X)), mbn, mbn + D, (last || I8_GATE) ? (bf16*)nullptr : (bf16*)(a.ws + WS_H), nullptr, nullptr, nullptr, last ? (unsigned char*)nullptr : a.ws + WS_H8, (float*)(a.ws + WS_SAH), (RES16_X && !last) ? (bf16*)(a.ws + WS_X) : (bf16*)nullptr);
}
template <class TT, int M> __device__ __forceinline__ void treduce16(TT (&v)[16], int lane) {
    const bool c0 = (lane & M) != 0, c1 = (lane & (2 * M)) != 0, c2 = (lane & (4 * M)) != 0;
#pragma unroll
    for (int m = 0; m < 8; ++m) { const TT keep = c0 ? v[2 * m + 1] : v[2 * m], send = c0 ? v[2 * m] : v[2 * m + 1]; v[m] = keep + __shfl_xor(send, M); }
#pragma unroll
    for (int m = 0; m < 4; ++m) { const TT keep = c1 ? v[2 * m + 1] : v[2 * m], send = c1 ? v[2 * m] : v[2 * m + 1]; v[m] = keep + __shfl_xor(send, 2 * M); }
#pragma unroll
    for (int m = 0; m < 2; ++m) { const TT keep = c2 ? v[2 * m + 1] : v[2 * m], send = c2 ? v[2 * m] : v[2 * m + 1]; v[m] = keep + __shfl_xor(send, 4 * M); }
}
__device__ __forceinline__ void peer_experts(const Args& a, int l, LAS unsigned char* lds, int lane0, int wave, int ch) {
    const float* mod = (const float*)(a.ws + WS_MOD);
    const unsigned char* ut = a.ws + WS_UT + (size_t)l * NE * D; const unsigned char* vt = a.ws + WS_VT + (size_t)l * NE * D; const unsigned char* hq8 = a.ws + WS_HQ8;
    const float* su = (const float*)(a.ws + WS_SU) + (size_t)l * NE; const float* sv = (const float*)(a.ws + WS_SV) + (size_t)l * NE; const float* hsc = (const float*)(a.ws + WS_HSC);
    float* Ybuf = (float*)(a.ws + WS_Z);
    const LAS int* eg_e = (const LAS int*)lds; LAS float* sw = (LAS float*)(lds + 32768);
    LAS int* apart = (LAS int*)(lds + 65536); LAS float* wtotl = (LAS float*)(lds + LDSCTL_OFF + 256);
    const int b = ch / NCH; const bool last = (l == NL - 1);
    const float* mb = mod + ((size_t)l * NB + b) * 6 * D; const float* mbn = mod + ((size_t)(last ? l : l + 1) * NB + b) * 6 * D;
    const int tlw = wave * 8;
    { const int lane = lane0;
#pragma unroll
      for (int i = 0; i < 16; ++i) apart[tlw * 128 + i * 64 + lane] = 0; }
    LDS_WAIT(); asm volatile("" ::: "memory");
    {
        int laneL = lane0; asm volatile("" : "+v"(laneL)); const int lane = laneL;
        const int g = lane >> 3, l7 = lane & 7;
        v4u bufA[16], bufB[16], hA, hB;
#define CU_LOAD(buf, hh_, idx_) do { const int cs_ = (idx_) >> 3, tl_ = tlw + ((idx_) & 7); const unsigned coff_ = (unsigned)(cs_ * 128 + l7 * 16); \
            hh_ = *(const v4u*)(hq8 + (size_t)(ch * 64 + tl_) * D + coff_); \
            _Pragma("unroll") for (int i_ = 0; i_ < 16; ++i_) { const unsigned e_ = (unsigned)eg_e[tl_ * 128 + 8 * i_ + g]; buf[i_] = *(const v4u*)(ut + (size_t)(e_ * 2048u + coff_)); } } while (0)
#define CU_COMP(buf, hh_, idx_) do { const int tl_ = tlw + ((idx_) & 7); int acc_[16]; \
            _Pragma("unroll") for (int i_ = 0; i_ < 16; ++i_) { int s_ = 0; _Pragma("unroll") for (int q_ = 0; q_ < 4; ++q_) s_ = sdot4i(buf[i_][q_], hh_[q_], s_); acc_[i_] = s_; } \
            treduce16<int, 1>(acc_, lane); \
            apart[tl_ * 128 + 8 * l7 + g] += acc_[0]; apart[tl_ * 128 + 8 * (8 + l7) + g] += acc_[1]; } while (0)
        CU_LOAD(bufA, hA, 0);
        for (int idx = 0; idx < 128; idx += 2) {
            CU_LOAD(bufB, hB, idx + 1);
            CU_COMP(bufA, hA, idx);
            if (idx + 2 < 128) CU_LOAD(bufA, hA, idx + 2);
            CU_COMP(bufB, hB, idx + 1);
        }
#undef CU_LOAD
#undef CU_COMP
        LDS_WAIT(); asm volatile("" ::: "memory");
        for (int it = 0; it < 8; ++it) { const int tl = tlw + it; const float shs = hsc[ch * 64 + tl];
            const int e0 = eg_e[tl * 128 + lane], e1 = eg_e[tl * 128 + 64 + lane];
            const float w0 = sw[tl * 128 + lane] * gelu_tanh_f((float)apart[tl * 128 + lane] * su[e0] * shs) * sv[e0];
            const float w1 = sw[tl * 128 + 64 + lane] * gelu_tanh_f((float)apart[tl * 128 + 64 + lane] * su[e1] * shs) * sv[e1];
            sw[tl * 128 + lane] = w0; sw[tl * 128 + 64 + lane] = w1;
            const float ws = wave_sum(w0 + w1);
            if (lane == 0) wtotl[tl] = ws; }
        LDS_WAIT(); asm volatile("" ::: "memory");
    }
    {
        int laneL = lane0; asm volatile("" : "+v"(laneL)); const int lane = laneL;
        const int g = lane >> 3, l7 = lane & 7;
        v4u bufA[16], bufB[16];
#define CV_LOAD(buf, idx_) do { const int cs_ = (idx_) >> 3, tl_ = tlw + ((idx_) & 7); const unsigned coff_ = (unsigned)(cs_ * 128 + l7 * 16); \
            _Pragma("unroll") for (int i_ = 0; i_ < 16; ++i_) { const unsigned e_ = (unsigned)eg_e[tl_ * 128 + 8 * i_ + g]; buf[i_] = *(const v4u*)(vt + (size_t)(e_ * 2048u + coff_)); } } while (0)
#define CV_COMP(buf, idx_) do { const int cs_ = (idx_) >> 3, tl_ = tlw + ((idx_) & 7); float y_[16]; \
            _Pragma("unroll") for (int q_ = 0; q_ < 16; ++q_) y_[q_] = 0.f; \
            _Pragma("unroll") for (int i_ = 0; i_ < 16; ++i_) { const float wr_ = sw[tl_ * 128 + 8 * i_ + g]; \
                _Pragma("unroll") for (int q_ = 0; q_ < 4; ++q_) fma_ub4(buf[i_][q_], wr_, y_[4 * q_], y_[4 * q_ + 1], y_[4 * q_ + 2], y_[4 * q_ + 3]); } \
            treduce16<float, 8>(y_, lane); \
            const float woff_ = 128.0f * wtotl[tl_]; bf16* yr_ = (bf16*)Ybuf + (size_t)(ch * 64 + tl_) * D + cs_ * 128 + l7 * 16 + g; \
            yr_[0] = (bf16)(pk2(y_[0] - woff_, 0.f) & 0xffffu); yr_[8] = (bf16)(pk2(y_[1] - woff_, 0.f) & 0xffffu); } while (0)
        CV_LOAD(bufA, 0);
        for (int idx = 0; idx < 128; idx += 2) {
            CV_LOAD(bufB, idx + 1);
            CV_COMP(bufA, idx);
            if (idx + 2 < 128) CV_LOAD(bufA, idx + 2);
            CV_COMP(bufB, idx + 1);
        }
#undef CV_LOAD
#undef CV_COMP
    }
    asm volatile("s_waitcnt vmcnt(0)" ::: "memory");
    __builtin_amdgcn_fence(__ATOMIC_ACQUIRE, "agent");
    asm volatile("s_waitcnt vmcnt(0)" ::: "memory");
    for (int it = 0; it < 8; ++it) { int laneT = lane0; asm volatile("" : "+v"(laneT)); const int t = ch * 64 + tlw + it;
        peer_tail(a, l, t, laneT, (const float*)((const bf16*)Ybuf + (size_t)t * D), mb, mbn, last); }
}

#endif

#ifndef MK_PER_PHASE
#define MK_PER_PHASE 0
#endif
__global__ void __launch_bounds__(NTHREADS, 2) mk_fwd(Args a) {
    extern __shared__ __attribute__((aligned(16))) unsigned char lds_raw[];
    LAS unsigned char* lds = (LAS unsigned char*)lds_raw;
    const int tid = threadIdx.x, lane = tid & 63, wave = __builtin_amdgcn_readfirstlane(tid >> 6), G = gridDim.x, bx = blockIdx.x;
    if (tid < 64) ((LAS unsigned*)(lds + LDSCTL_OFF))[tid] = 0u;
    __syncthreads();
    unsigned* ctl = (unsigned*)(a.ws + WS_CTL);
    XcdBarrier bar; bar.bar = ctl + CW_BAR; bar.x = 0; bar.st = nullptr;
    const bool use_bar = (a.ph_hi - a.ph_lo) > 1;
    if (use_bar) bar = xcd_barrier_post(ctl + CW_BAR, (volatile LAS unsigned*)(lds + LDSCTL_OFF));
    const int lo = a.ph_lo, hi = a.ph_hi;
#ifndef PH_MASK
#define PH_MASK 0x1ff
#endif
#define IN(k) (lo <= (k) && (k) < hi)
#define EN(b) ((PH_MASK >> (b)) & 1)
#ifndef REP_MASK
#define REP_MASK 0
#endif
#ifndef REP_EXTRA
#define REP_EXTRA 2
#endif
#define REPS(b) (1 + ((REP_MASK >> (b)) & 1) * REP_EXTRA)
#define REP_BEGIN(b) for (int rep_ = 0; rep_ < REPS(b); ++rep_) {
#define REP_END(b) if (rep_ + 1 < REPS(b)) xcd_barrier(bar); }
#define SEAM(k) do { if (IN((k) + 1)) xcd_barrier(bar); } while (0)
#define PHASE_IDS() int tidp = tid; asm volatile("" : "+v"(tidp)); const int lanep = tidp & 63, wavep = __builtin_amdgcn_readfirstlane(tidp >> 6); (void)lanep; (void)wavep
    if (EN(0) && IN(0)) { REP_BEGIN(0) PHASE_IDS(); ph_prologue_a(a, lds, tidp, lanep, wavep, bx, G); REP_END(0) SEAM(0); }
    if (EN(1) && IN(1)) { REP_BEGIN(1) PHASE_IDS(); ph_prologue_b(a, lds, tidp, lanep, wavep, bx, G); REP_END(1) SEAM(1); }
    for (int l = 0; l < NL; ++l) {
        const int pb = 2 + 7 * l;
        const float* mod = (const float*)(a.ws + WS_MOD);
        if (EN(2) && IN(pb + 0)) {
            REP_BEGIN(2) PHASE_IDS();
#if I8_IN
            pg8::Gemm g{(const pg8::bf16_t*)(a.ws + WS_H8), (const pg8::bf16_t*)(a.ws + WS_WIN8 + (size_t)l * NP * D), T, NP, D / 2}; pg8::StaticOrder S; S.init(T, NP, G, bx, WGM_IN, KROT(bx));
            pg8::EpiBf16PS E{(pg8::bf16_t*)(a.ws + WS_PROJ), NP, (const float*)(a.ws + WS_SAH), (const float*)(a.ws + WS_SB) + l * SBL};
            pg8::gemm_phase<pg8::EpiBf16PS, pg8::StaticOrder, true, true, true>(lds + RING_OFF, g, S, E, tidp);
#else
            pg8::Gemm g{(const pg8::bf16_t*)(a.ws + WS_H), (const pg8::bf16_t*)(a.ws + WS_WIN) + (size_t)l * INW * D, T, NP, D}; pg8::StaticOrder S; S.init(T, NP, G, bx, WGM_IN, KROT(bx));
            pg8::EpiBf16P E{(pg8::bf16_t*)(a.ws + WS_PROJ), NP};
            pg8::gemm_phase<pg8::EpiBf16P, pg8::StaticOrder, true, true>(lds + RING_OFF, g, S, E, tidp);
#endif
#ifndef GP_REP
#define GP_REP 1
#endif
            for (int gpr_ = 0; gpr_ < GP_REP; ++gpr_) for (int ch = bx; ch < NCHUNK; ch += G) gate_prep(a, l, lds, tidp, lanep, wavep, ch);
            REP_END(2) SEAM(pb + 0);
        }
        if (EN(3) && IN(pb + 1)) { REP_BEGIN(3) PHASE_IDS(); for (int un = bx; un < 256; un += G) gla_unit(a, lds, tidp, lanep, wavep, un); REP_END(3) SEAM(pb + 1); }
        if (EN(4) && IN(pb + 2)) { REP_BEGIN(4) PHASE_IDS(); for (int ch = bx; ch < NCHUNK; ch += G) mixpost_chunk(a, l, lanep, wavep, ch); REP_END(4) SEAM(pb + 2); }
        if (EN(5) && IN(pb + 3)) {
            REP_BEGIN(5) PHASE_IDS();
#if I8_OUT
            pg8::Gemm g{(const pg8::bf16_t*)(a.ws + WS_Y8), (const pg8::bf16_t*)(a.ws + WS_WOUT8 + (size_t)l * D * D), T, D, D / 2}; pg8::StaticOrder S; S.init(T, D, G, bx, WGM_OUT, KROT(bx));
#if RES16_X || RES16_Z
            pg8::EpiResidS16<(RES16_X != 0), (RES16_Z != 0)> E{(void*)(a.ws + WS_Z), (RES16_X || l > 0) ? (const void*)(a.ws + WS_X) : (const void*)a.in[0], mod + (size_t)l * NB * 6 * D + 2 * D, (const float*)(a.ws + WS_SAY), (const float*)(a.ws + WS_SB) + l * SBL + NP, ALPHA};
            pg8::gemm_phase<pg8::EpiResidS16<(RES16_X != 0), (RES16_Z != 0)>, pg8::StaticOrder, true, true, true>(lds + RING_OFF, g, S, E, tidp);
#else
            pg8::EpiResidS E{(float*)(a.ws + WS_Z), l == 0 ? a.in[0] : (const float*)(a.ws + WS_X), mod + (size_t)l * NB * 6 * D + 2 * D, (const float*)(a.ws + WS_SAY), (const float*)(a.ws + WS_SB) + l * SBL + NP, ALPHA};
            pg8::gemm_phase<pg8::EpiResidS, pg8::StaticOrder, true, true, true>(lds + RING_OFF, g, S, E, tidp);
#endif
#else
            pg8::Gemm g{(const pg8::bf16_t*)(a.ws + WS_Y), (const pg8::bf16_t*)(a.ws + WS_WOUT) + (size_t)l * D * D, T, D, D}; pg8::StaticOrder S; S.init(T, D, G, bx, WGM_OUT, KROT(bx));
            pg8::EpiResid E{(float*)(a.ws + WS_Z), l == 0 ? a.in[0] : (const float*)(a.ws + WS_X), mod + (size_t)l * NB * 6 * D + 2 * D, ALPHA};
            pg8::gemm_phase<pg8::EpiResid, pg8::StaticOrder, true, true>(lds + RING_OFF, g, S, E, tidp);
#endif
            REP_END(5) SEAM(pb + 3);
        }
        if (EN(6) && IN(pb + 4)) { REP_BEGIN(6) PHASE_IDS(); for (int ch = bx; ch < NCHUNK; ch += G) ln1_chunk(a, l, lds, lanep, wavep, ch); REP_END(6) SEAM(pb + 4); }
        if (EN(7) && IN(pb + 5)) {
            REP_BEGIN(7) PHASE_IDS();
#if I8_WQ
            pg8::Gemm g{(const pg8::bf16_t*)(a.ws + WS_H28), (const pg8::bf16_t*)(a.ws + WS_WQ8 + (size_t)l * D * D), T, D, D / 2}; pg8::StaticOrder S; S.init(T, D, G, bx, WGM_WQ, KROT(bx));
            pg8::EpiBf16PS E{(pg8::bf16_t*)(a.ws + WS_Q), D, (const float*)(a.ws + WS_HSC), (const float*)(a.ws + WS_SB) + l * SBL + NP + D};
            pg8::gemm_phase<pg8::EpiBf16PS, pg8::StaticOrder, true, true, true>(lds + RING_OFF, g, S, E, tidp);
#else
            pg8::Gemm g{(const pg8::bf16_t*)(a.ws + WS_H2), (const pg8::bf16_t*)(a.ws + WS_WQ) + (size_t)l * D * D, T, D, D}; pg8::StaticOrder S; S.init(T, D, G, bx, WGM_WQ, KROT(bx));
            pg8::EpiBf16P E{(pg8::bf16_t*)(a.ws + WS_Q), D};
            pg8::gemm_phase<pg8::EpiBf16P, pg8::StaticOrder, true, true>(lds + RING_OFF, g, S, E, tidp);
#endif
            REP_END(7) SEAM(pb + 5);
        }
#ifndef PEER_DBG
#define PEER_DBG 0
#endif
#ifndef PE_REP_R
#define PE_REP_R 1
#endif
#ifndef L2PROBE
#define L2PROBE 0
#endif
        if (EN(8) && IN(pb + 6)) {
            REP_BEGIN(8)
            for (int ch = bx; ch < NCHUNK; ch += G) { for (int repr_ = 0; repr_ < PE_REP_R; ++repr_) { PHASE_IDS(); peer_retrieve(a, l, lds, lanep, wavep, ch); __syncthreads(); } __syncthreads(); { PHASE_IDS(); peer_experts(a, l, lds, lanep, wavep, ch); } __syncthreads(); }
            REP_END(8) SEAM(pb + 6);
        }
    }
#undef IN
#undef SEAM
}

extern "C" void kernel_launch(void* const* d_in, const int* in_sizes, int n_in, void* d_out, int out_size, void* d_ws, size_t ws_size, hipStream_t stream) {
    static int grid = 0;
    if (grid == 0) {
        if (n_in != 19 || in_sizes[0] != T * D || out_size != T * D || ws_size < WS_END) { fprintf(stderr, "kernel_launch: unexpected shapes / workspace (%d inputs, ws %zu); nothing launched\n", n_in, ws_size); grid = -1; return; }
        int dev = 0, cus = 0, per_cu = 0;
        if (hipGetDevice(&dev) != hipSuccess || hipDeviceGetAttribute(&cus, hipDeviceAttributeMultiprocessorCount, dev) != hipSuccess) { grid = -1; return; }
        if (hipFuncSetAttribute((const void*)mk_fwd, hipFuncAttributeMaxDynamicSharedMemorySize, LDS_BYTES) != hipSuccess) { fprintf(stderr, "kernel_launch: hipFuncSetAttribute failed\n"); grid = -1; return; }
        if (hipOccupancyMaxActiveBlocksPerMultiprocessor(&per_cu, (const void*)mk_fwd, NTHREADS, LDS_BYTES) != hipSuccess || per_cu < 1) fprintf(stderr, "kernel_launch: occupancy query reports %d\n", per_cu);
        (void)hipGetLastError();
        grid = cus;
    }
    if (grid < 0) return;
    if (hipMemsetAsync((char*)d_ws + WS_CTL, 0, CTL_ZERO_BYTES, stream) != hipSuccess) return;
    Args a{};
    for (int i = 0; i < 19; ++i) a.in[i] = (const float*)d_in[i];
    a.out = (float*)d_out; a.ws = (unsigned char*)d_ws;
#if MK_PER_PHASE
    for (int p = 0; p < NPHASES; ++p) { a.ph_lo = p; a.ph_hi = p + 1; hipLaunchKernelGGL(mk_fwd, dim3(grid), dim3(NTHREADS), LDS_BYTES, stream, a); }
#else
    a.ph_lo = 0; a.ph_hi = NPHASES;
    hipLaunchKernelGGL(mk_fwd, dim3(grid), dim3(NTHREADS), LDS_BYTES, stream, a);
#endif
}
```

```cpp
#include <hip/hip_runtime.h>
#include <cstdio>
#include <cstdint>
namespace pg8 {
#define PG8_LAS __attribute__((address_space(3)))
typedef unsigned short bf16_t;
typedef short bf16x8 __attribute__((ext_vector_type(8)));
typedef float f32x4 __attribute__((ext_vector_type(4)));
typedef unsigned u32x4 __attribute__((ext_vector_type(4)));
typedef int i32x4 __attribute__((ext_vector_type(4)));
constexpr int BM = 256, BK = 64, HALF = 128, HTB = HALF * BK * 2  , STAGE_BYTES = 8 * HTB, NXCD = 8, WGM = 8;

__host__ __device__ __forceinline__ int lds_byte(int r, int c) { const int st = (r >> 4) * 2 + (c >> 5), rr = r & 15, cc = c & 31, ob = rr * 64 + cc * 2; return st * 1024 + (ob ^ (((ob >> 9) & 1) << 5)); }
__host__ __device__ __forceinline__ void stage_rc(int b, int& R, int& C) { const int st = b / 1024, sb = b % 1024, swz = sb ^ (((sb >> 9) & 1) << 5); R = (st >> 1) * 16 + swz / 64; C = (st & 1) * 32 + (swz % 64) / 2; }
__host__ __device__ __forceinline__ int perm32(int rho) { const int n = rho >> 4, i = rho & 15; return 8 * (i >> 2) + 4 * n + (i & 3); }

struct Unit { int pm, pn; };
struct Gemm { const bf16_t* A; const bf16_t* Bt; int M, N, K; };

struct StaticOrder {
    int nM, nN, nwg, G, c, wgm, krot;
    __host__ __device__ void init(int M, int N, int G_, int c_, int wgm_ = WGM, int krot_ = 0) { nM = M / BM; nN = N / BM; nwg = nM * nN; G = G_; c = c_; wgm = wgm_; krot = krot_; }
    __host__ __device__ bool next(int i, Unit& u) const {
        const long L = (long)i * G + c; if (L >= nwg) return false;
        int wgid = (int)L; { const int q = nwg / NXCD, r = nwg % NXCD, xcd = wgid % NXCD, off = wgid / NXCD; wgid = (xcd < r ? xcd * (q + 1) : r * (q + 1) + (xcd - r) * q) + off; }
        const int nig = wgm * nN, gid = wgid / nig, fm = gid * wgm, gsz = (nM - fm) < wgm ? (nM - fm) : wgm;
        u.pm = fm + ((wgid % nig) % gsz); u.pn = (wgid % nig) / gsz; return true;
    }
    __device__ __forceinline__ void a_ready(const Unit&) const {}
    __device__ __forceinline__ void done(const Unit&) const {}
};
typedef __bf16 bf16x2_t __attribute__((ext_vector_type(2)));
__device__ __forceinline__ unsigned cvt_pk_bf16(float lo, float hi) { bf16x2_t r; r.x = (__bf16)lo; r.y = (__bf16)hi; return __builtin_bit_cast(unsigned, r); }
struct EpiBf16P {
    static constexpr bool PERM = true, AFTER_DRAIN = false;
    bf16_t* O; int ldc;
    __device__ __forceinline__ void operator()(const f32x4 (&acc)[2][2][4][2], const Unit& u, int wr, int wc, int fr, int fq) const {
        const int row0 = u.pm * BM + wr * 64 + fr, col0 = u.pn * BM + wc * 32 + 8 * fq;
#pragma unroll
        for (int ai = 0; ai < 2; ++ai)
#pragma unroll
            for (int m = 0; m < 4; ++m) { bf16_t* rowp = O + (size_t)(row0 + ai * HALF + m * 16) * ldc + col0;
#pragma unroll
                for (int bj = 0; bj < 2; ++bj) { const f32x4 v0 = acc[ai][bj][m][0], v1 = acc[ai][bj][m][1];
                    u32x4 w; w.x = cvt_pk_bf16(v0[0], v0[1]); w.y = cvt_pk_bf16(v0[2], v0[3]); w.z = cvt_pk_bf16(v1[0], v1[1]); w.w = cvt_pk_bf16(v1[2], v1[3]);
                    *(u32x4*)(rowp + bj * HALF) = w; } }
    }
};
struct EpiResid {
    static constexpr bool PERM = false, AFTER_DRAIN = false;
    float* Z; const float* X; const float* gate; float alpha;
    __device__ __forceinline__ void operator()(const f32x4 (&acc)[2][2][4][2], const Unit& u, int wr, int wc, int fr, int fq) const {
        const int row0 = u.pm * BM + wr * 64 + fr, col0 = u.pn * BM + wc * 32 + 4 * fq;
        const float* gb = gate + (size_t)(u.pm >> 3) * (6 * 2048) + col0;
        f32x4 gv[2][2];
#pragma unroll
        for (int bj = 0; bj < 2; ++bj)
#pragma unroll
            for (int n = 0; n < 2; ++n) gv[bj][n] = *(const f32x4*)(gb + bj * HALF + n * 16) + 1.0f;
#pragma unroll
        for (int ai = 0; ai < 2; ++ai)
#pragma unroll
            for (int m = 0; m < 4; ++m) { const size_t off = (size_t)(row0 + ai * HALF + m * 16) * 2048 + col0;
#pragma unroll
                for (int bj = 0; bj < 2; ++bj)
#pragma unroll
                    for (int n = 0; n < 2; ++n) { const f32x4 xv = *(const f32x4*)(X + off + bj * HALF + n * 16);
                        *(f32x4*)(Z + off + bj * HALF + n * 16) = xv * alpha + gv[bj][n] * acc[ai][bj][m][n]; }
                asm volatile("" ::: "memory"); }
    }
};
#ifndef PG8_NT
#define PG8_NT 0
#endif
#if PG8_NT
#define PG8_ST(TY, p, v) __builtin_nontemporal_store((v), (TY*)(p))
#else
#define PG8_ST(TY, p, v) (*(TY*)(p) = (v))
#endif
__device__ __forceinline__ f32x4 acc_i2f(const f32x4 v) { const i32x4 iv = __builtin_bit_cast(i32x4, v); return __builtin_convertvector(iv, f32x4); }
struct EpiBf16PS {
    static constexpr bool PERM = true, AFTER_DRAIN = false;
    bf16_t* O; int ldc; const float* sa; const float* sb;
    __device__ __forceinline__ void operator()(const f32x4 (&acc)[2][2][4][2], const Unit& u, int wr, int wc, int fr, int fq) const {
        const int row0 = u.pm * BM + wr * 64 + fr, col0 = u.pn * BM + wc * 32 + 8 * fq;
        f32x4 sbv[2][2];
#pragma unroll
        for (int bj = 0; bj < 2; ++bj)
#pragma unroll
            for (int n = 0; n < 2; ++n) sbv[bj][n] = *(const f32x4*)(sb + col0 + bj * HALF + 4 * n);
#pragma unroll
        for (int ai = 0; ai < 2; ++ai)
#pragma unroll
            for (int m = 0; m < 4; ++m) { const int row = row0 + ai * HALF + m * 16; bf16_t* rowp = O + (size_t)row * ldc + col0; const float sar = sa[row];
#pragma unroll
                for (int bj = 0; bj < 2; ++bj) { const f32x4 v0 = acc_i2f(acc[ai][bj][m][0]) * (sbv[bj][0] * sar), v1 = acc_i2f(acc[ai][bj][m][1]) * (sbv[bj][1] * sar);
                    u32x4 w; w.x = cvt_pk_bf16(v0[0], v0[1]); w.y = cvt_pk_bf16(v0[2], v0[3]); w.z = cvt_pk_bf16(v1[0], v1[1]); w.w = cvt_pk_bf16(v1[2], v1[3]);
                    PG8_ST(u32x4, rowp + bj * HALF, w); } }
    }
};
struct EpiResidS {
    static constexpr bool PERM = false, AFTER_DRAIN = false;
    float* Z; const float* X; const float* gate; const float* sa; const float* sb; float alpha;
    __device__ __forceinline__ void operator()(const f32x4 (&acc)[2][2][4][2], const Unit& u, int wr, int wc, int fr, int fq) const {
        const int row0 = u.pm * BM + wr * 64 + fr, col0 = u.pn * BM + wc * 32 + 4 * fq;
        const float* gb = gate + (size_t)(u.pm >> 3) * (6 * 2048) + col0;
        f32x4 gv[2][2];
#pragma unroll
        for (int bj = 0; bj < 2; ++bj)
#pragma unroll
            for (int n = 0; n < 2; ++n) gv[bj][n] = (*(const f32x4*)(gb + bj * HALF + n * 16) + 1.0f) * *(const f32x4*)(sb + col0 + bj * HALF + n * 16);
#pragma unroll
        for (int ai = 0; ai < 2; ++ai)
#pragma unroll
            for (int m = 0; m < 4; ++m) { const int row = row0 + ai * HALF + m * 16; const size_t off = (size_t)row * 2048 + col0; const float sar = sa[row];
#pragma unroll
                for (int bj = 0; bj < 2; ++bj)
#pragma unroll
                    for (int n = 0; n < 2; ++n) { const f32x4 xv = *(const f32x4*)(X + off + bj * HALF + n * 16);
                        PG8_ST(f32x4, Z + off + bj * HALF + n * 16, xv * alpha + (gv[bj][n] * sar) * acc_i2f(acc[ai][bj][m][n])); }
                asm volatile("" ::: "memory"); }
    }
};
template <bool XB, bool ZB> struct EpiResidS16 {
    static constexpr bool PERM = true, AFTER_DRAIN = false;
    void* Z; const void* X; const float* gate; const float* sa; const float* sb; float alpha;
    __device__ __forceinline__ void operator()(const f32x4 (&acc)[2][2][4][2], const Unit& u, int wr, int wc, int fr, int fq) const {
        const int row0 = u.pm * BM + wr * 64 + fr, col0 = u.pn * BM + wc * 32 + 8 * fq;
        const float* gb = gate + (size_t)(u.pm >> 3) * (6 * 2048) + col0;
        f32x4 gv[2][2];
#pragma unroll
        for (int bj = 0; bj < 2; ++bj)
#pragma unroll
            for (int n = 0; n < 2; ++n) gv[bj][n] = (*(const f32x4*)(gb + bj * HALF + 4 * n) + 1.0f) * *(const f32x4*)(sb + col0 + bj * HALF + 4 * n);
#pragma unroll
        for (int ai = 0; ai < 2; ++ai)
#pragma unroll
            for (int m = 0; m < 4; ++m) { const int row = row0 + ai * HALF + m * 16; const size_t off = (size_t)row * 2048 + col0; const float sar = sa[row];
#pragma unroll
                for (int bj = 0; bj < 2; ++bj) { f32x4 x0, x1;
                    if constexpr (XB) { const u32x4 xw = *(const u32x4*)((const bf16_t*)X + off + bj * HALF);
                        x0 = (f32x4){__uint_as_float(xw.x << 16), __uint_as_float(xw.x & 0xffff0000u), __uint_as_float(xw.y << 16), __uint_as_float(xw.y & 0xffff0000u)};
                        x1 = (f32x4){__uint_as_float(xw.z << 16), __uint_as_float(xw.z & 0xffff0000u), __uint_as_float(xw.w << 16), __uint_as_float(xw.w & 0xffff0000u)}; }
                    else { x0 = *(const f32x4*)((const float*)X + off + bj * HALF); x1 = *(const f32x4*)((const float*)X + off + bj * HALF + 4); }
                    const f32x4 v0 = x0 * alpha + (gv[bj][0] * sar) * acc_i2f(acc[ai][bj][m][0]), v1 = x1 * alpha + (gv[bj][1] * sar) * acc_i2f(acc[ai][bj][m][1]);
                    if constexpr (ZB) { u32x4 w; w.x = cvt_pk_bf16(v0[0], v0[1]); w.y = cvt_pk_bf16(v0[2], v0[3]); w.z = cvt_pk_bf16(v1[0], v1[1]); w.w = cvt_pk_bf16(v1[2], v1[3]);
                        PG8_ST(u32x4, (bf16_t*)Z + off + bj * HALF, w); }
                    else { PG8_ST(f32x4, (float*)Z + off + bj * HALF, v0); PG8_ST(f32x4, (float*)Z + off + bj * HALF + 4, v1); } }
                asm volatile("" ::: "memory"); }
    }
};
template <class Epi, class Sched, bool ALIGN_EPI = false, bool SP2 = false, bool I8 = false>
__device__ __forceinline__ void gemm_phase(PG8_LAS unsigned char* lds, const Gemm g, const Sched& S, const Epi& E, const int tid_in) {
    const int tid = tid_in, wid = __builtin_amdgcn_readfirstlane(tid >> 6), lane = tid & 63, wr = wid >> 2, wc = wid & 3, fr = lane & 15, fq = lane >> 4;
    const int K = g.K, nt = K / BK;
    const int krot = ((nt & (nt - 1)) == 0) ? (S.krot & (nt - 1)) : 0;
#define PG8_KOFS(t) ((size_t)(((t) + krot) & (nt - 1)) * kstep)
    unsigned voffA[2], voffB[2];
#pragma unroll
    for (int i = 0; i < 2; ++i) { int R, C; stage_rc(tid * 16 + i * 8192, R, C); const int Rb = Epi::PERM ? ((R & ~31) + perm32(R & 31)) : R;
        voffA[i] = (unsigned)(R * K + C) * 2u; voffB[i] = (unsigned)(Rb * K + C) * 2u; }
    const size_t kstep = (size_t)(BK * 2);
    const size_t hstep = (size_t)HALF * K * 2;
    const size_t tstep = 2 * hstep;
    const unsigned ldsw = (unsigned)wid * 1024u;
    const int aoff = lds_byte(wr * 64 + fr, fq * 8), boff = lds_byte(wc * 32 + fr, fq * 8);
#define PG8_SA(b, h) (((b) * 2 + (h)) * HTB)
#define PG8_SB(b, h) ((4 + (b) * 2 + (h)) * HTB)
#define PG8_STAGE(bufoff, gbase, voff) do { _Pragma("unroll") for (int _i = 0; _i < 2; ++_i) \
        __builtin_amdgcn_global_load_lds((const unsigned*)((const char*)(gbase) + (voff)[_i]), (PG8_LAS unsigned*)(lds + (bufoff) + ldsw + _i * 8192), 16, 0, 0); } while (0)
#define PG8_LDA(dst, b, h) do { _Pragma("unroll") for (int m = 0; m < 4; ++m) _Pragma("unroll") for (int k = 0; k < 2; ++k) dst[m][k] = *(const PG8_LAS bf16x8*)(lds + PG8_SA(b, h) + aoff + m * 2048 + k * 1024); } while (0)
#define PG8_LDB(dst, b, h) do { _Pragma("unroll") for (int n = 0; n < 2; ++n) _Pragma("unroll") for (int k = 0; k < 2; ++k) dst[n][k] = *(const PG8_LAS bf16x8*)(lds + PG8_SB(b, h) + boff + n * 2048 + k * 1024); } while (0)
#define PG8_MMA(ai, bj, At, Bt) do { __builtin_amdgcn_s_setprio(1); _Pragma("unroll") for (int m = 0; m < 4; ++m) _Pragma("unroll") for (int n = 0; n < 2; ++n) _Pragma("unroll") for (int k = 0; k < 2; ++k) \
        { if constexpr (I8) acc[ai][bj][m][n] = __builtin_bit_cast(f32x4, __builtin_amdgcn_mfma_i32_16x16x64_i8(__builtin_bit_cast(i32x4, Bt[n][k]), __builtin_bit_cast(i32x4, At[m][k]), __builtin_bit_cast(i32x4, acc[ai][bj][m][n]), 0, 0, 0)); \
          else acc[ai][bj][m][n] = __builtin_amdgcn_mfma_f32_16x16x32_bf16(Bt[n][k], At[m][k], acc[ai][bj][m][n], 0, 0, 0); } __builtin_amdgcn_s_setprio(0); } while (0)
#define PG8_WAIT_V(n) asm volatile("s_waitcnt vmcnt(" #n ")" ::: "memory")
#define PG8_WAIT_L(n) asm volatile("s_waitcnt lgkmcnt(" #n ")" ::: "memory")
#define PG8_BAR __builtin_amdgcn_s_barrier()
#define PG8_SCHED __builtin_amdgcn_sched_barrier(0)
    Unit cur, nxt; int ui = 0;
    if (!S.next(0, cur)) return;
    f32x4 acc[2][2][4][2];
#pragma unroll
    for (int a = 0; a < 2; ++a)
#pragma unroll
        for (int b = 0; b < 2; ++b)
#pragma unroll
            for (int m = 0; m < 4; ++m)
#pragma unroll
                for (int n = 0; n < 2; ++n) acc[a][b][m][n] = (f32x4){0.f, 0.f, 0.f, 0.f};
    bf16x8 At[4][2], B0[2][2], B1[2][2];
    const char* cA = (const char*)g.A + (size_t)cur.pm * tstep; const char* cB = (const char*)g.Bt + (size_t)cur.pn * tstep;
    S.a_ready(cur);
    if constexpr (SP2) {
        PG8_STAGE(PG8_SB(0, 0), cB + PG8_KOFS(0), voffB); PG8_STAGE(PG8_SB(0, 1), cB + hstep + PG8_KOFS(0), voffB); PG8_STAGE(PG8_SA(0, 0), cA + PG8_KOFS(0), voffA); PG8_STAGE(PG8_SA(0, 1), cA + hstep + PG8_KOFS(0), voffA);
        if (wr == 1) PG8_BAR;
        PG8_WAIT_V(2); PG8_BAR;
        PG8_STAGE(PG8_SB(1, 0), cB + PG8_KOFS(1), voffB); PG8_STAGE(PG8_SA(1, 0), cA + PG8_KOFS(1), voffA); PG8_STAGE(PG8_SB(1, 1), cB + hstep + PG8_KOFS(1), voffB);
        PG8_WAIT_V(6); PG8_BAR;
    } else {
        PG8_STAGE(PG8_SB(0, 0), cB + PG8_KOFS(0), voffB); PG8_STAGE(PG8_SA(0, 0), cA + PG8_KOFS(0), voffA); PG8_STAGE(PG8_SB(0, 1), cB + hstep + PG8_KOFS(0), voffB); PG8_STAGE(PG8_SA(0, 1), cA + hstep + PG8_KOFS(0), voffA);
        if (wr == 1) PG8_BAR;
        PG8_WAIT_V(4); PG8_BAR;
        PG8_STAGE(PG8_SB(1, 0), cB + PG8_KOFS(1), voffB); PG8_STAGE(PG8_SA(1, 0), cA + PG8_KOFS(1), voffA); PG8_STAGE(PG8_SB(1, 1), cB + hstep + PG8_KOFS(1), voffB);
        PG8_WAIT_V(6); PG8_BAR;
    }
    for (;;) {
        const bool has_next = S.next(ui + 1, nxt);
        const char* nA = has_next ? (const char*)g.A + (size_t)nxt.pm * tstep : cA; const char* nB = has_next ? (const char*)g.Bt + (size_t)nxt.pn * tstep : cB;
#ifdef PG8_KREP
        for (int kr_ = 0; kr_ < PG8_KREP; ++kr_) {
        if (kr_) {
#pragma unroll
        for (int a = 0; a < 2; ++a)
#pragma unroll
            for (int b = 0; b < 2; ++b)
#pragma unroll
                for (int m = 0; m < 4; ++m)
#pragma unroll
                    for (int n = 0; n < 2; ++n) acc[a][b][m][n] = (f32x4){0.f, 0.f, 0.f, 0.f}; }
        const char* nA_ = (kr_ + 1 < PG8_KREP) ? cA : nA; const char* nB_ = (kr_ + 1 < PG8_KREP) ? cB : nB;
#else
        const char* nA_ = nA; const char* nB_ = nB;
#endif
        for (int t = 0; t < nt; t += 2) {
            const bool last = (t == nt - 2);
            const char* a1 = cA + PG8_KOFS(t + 1);
            const char* a2 = (last ? nA_ : cA) + PG8_KOFS(t + 2); const char* b2 = (last ? nB_ : cB) + PG8_KOFS(t + 2);
            const char* a3 = (last ? nA_ : cA) + PG8_KOFS(t + 3); const char* b3 = (last ? nB_ : cB) + PG8_KOFS(t + 3);
            if (last && has_next) S.a_ready(nxt);
            if constexpr (SP2) {
            PG8_LDB(B0, 0, 0); PG8_LDB(B1, 0, 1); PG8_SCHED; PG8_LDA(At, 0, 0); PG8_STAGE(PG8_SA(1, 1), a1 + hstep, voffA);
            PG8_WAIT_V(8); PG8_WAIT_L(0); PG8_BAR; PG8_MMA(0, 0, At, B0); PG8_MMA(0, 1, At, B1); PG8_BAR; PG8_SCHED;
            PG8_LDA(At, 0, 1); PG8_STAGE(PG8_SB(0, 0), b2, voffB); PG8_STAGE(PG8_SB(0, 1), b2 + hstep, voffB); PG8_STAGE(PG8_SA(0, 0), a2, voffA);
            PG8_WAIT_V(8); PG8_WAIT_L(0); PG8_BAR; PG8_MMA(1, 0, At, B0); PG8_MMA(1, 1, At, B1); PG8_BAR; PG8_SCHED;
            PG8_LDB(B0, 1, 0); PG8_LDB(B1, 1, 1); PG8_SCHED; PG8_LDA(At, 1, 0); PG8_STAGE(PG8_SA(0, 1), a2 + hstep, voffA);
            PG8_WAIT_V(8); PG8_WAIT_L(0); PG8_BAR; PG8_MMA(0, 0, At, B0); PG8_MMA(0, 1, At, B1); PG8_BAR; PG8_SCHED;
            PG8_LDA(At, 1, 1); PG8_STAGE(PG8_SB(1, 0), b3, voffB); PG8_STAGE(PG8_SB(1, 1), b3 + hstep, voffB); PG8_STAGE(PG8_SA(1, 0), a3, voffA);
            PG8_WAIT_V(8); PG8_WAIT_L(0); PG8_BAR; PG8_MMA(1, 0, At, B0); PG8_MMA(1, 1, At, B1); PG8_BAR; PG8_SCHED;
            } else {
            PG8_LDB(B0, 0, 0); PG8_SCHED; PG8_LDA(At, 0, 0); PG8_STAGE(PG8_SA(1, 1), a1 + hstep, voffA);
            PG8_WAIT_L(8); PG8_BAR; PG8_WAIT_L(0); PG8_MMA(0, 0, At, B0); PG8_BAR; PG8_SCHED;
            PG8_LDB(B1, 0, 1); PG8_STAGE(PG8_SB(0, 0), b2, voffB);
            PG8_BAR; PG8_WAIT_L(0); PG8_MMA(0, 1, At, B1); PG8_BAR;
            PG8_LDA(At, 0, 1); PG8_STAGE(PG8_SA(0, 0), a2, voffA);
            PG8_BAR; PG8_WAIT_L(0); PG8_MMA(1, 0, At, B0); PG8_BAR; PG8_SCHED;
            PG8_STAGE(PG8_SB(0, 1), b2 + hstep, voffB);
            PG8_WAIT_V(6); PG8_BAR; PG8_MMA(1, 1, At, B1); PG8_BAR;
            PG8_LDB(B0, 1, 0); PG8_SCHED; PG8_LDA(At, 1, 0); PG8_STAGE(PG8_SA(0, 1), a2 + hstep, voffA);
            PG8_WAIT_L(8); PG8_BAR; PG8_WAIT_L(0); PG8_MMA(0, 0, At, B0); PG8_BAR; PG8_SCHED;
            PG8_LDB(B1, 1, 1); PG8_STAGE(PG8_SB(1, 0), b3, voffB);
            PG8_BAR; PG8_WAIT_L(0); PG8_MMA(0, 1, At, B1); PG8_BAR;
            PG8_LDA(At, 1, 1); PG8_STAGE(PG8_SA(1, 0), a3, voffA);
            PG8_BAR; PG8_WAIT_L(0); PG8_MMA(1, 0, At, B0); PG8_BAR; PG8_SCHED;
            PG8_STAGE(PG8_SB(1, 1), b3 + hstep, voffB);
            PG8_WAIT_V(6); PG8_BAR; PG8_MMA(1, 1, At, B1); PG8_BAR;
            }
        }
#ifdef PG8_KREP
        }
#endif
        if constexpr (ALIGN_EPI) { if (wr == 0) PG8_BAR; }
#ifdef PG8_EPI2
        if constexpr (!Epi::AFTER_DRAIN) { E(acc, cur, wr, wc, fr, fq); asm volatile("" ::: "memory"); }
#endif
        if constexpr (!Epi::AFTER_DRAIN) { E(acc, cur, wr, wc, fr, fq); S.done(cur); }
        if (!has_next) break;
#pragma unroll
        for (int a = 0; a < 2; ++a)
#pragma unroll
            for (int b = 0; b < 2; ++b)
#pragma unroll
                for (int m = 0; m < 4; ++m)
#pragma unroll
                    for (int n = 0; n < 2; ++n) acc[a][b][m][n] = (f32x4){0.f, 0.f, 0.f, 0.f};
        cur = nxt; cA = nA; cB = nB; ++ui;
        if constexpr (ALIGN_EPI) { if (wr == 1) PG8_BAR; }
    }
    PG8_WAIT_V(0);
    if constexpr (!ALIGN_EPI) { if (wr == 0) PG8_BAR; }
    PG8_BAR;
    if constexpr (Epi::AFTER_DRAIN) { E.fused(acc, cur, wr, wc, fr, fq, lds, wid, lane); S.done(cur); }
#undef PG8_SA
#undef PG8_SB
#undef PG8_STAGE
#undef PG8_LDA
#undef PG8_LDB
#undef PG8_MMA
#undef PG8_WAIT_V
#undef PG8_WAIT_L
#undef PG8_BAR
#undef PG8_SCHED
#undef PG8_KOFS
}
}
#define XB_TMO      128
#define XB_XCNT(j)  (256  + 64 * (j))
#define XB_XSUB(j)  (1280 + 64 * (j))
#define XB_XGEN(j)  (2304 + 64 * (j))
#define XB_TOP      3328
#define XB_TOPGEN   3392
#define XCD_BAR_WORDS 3456
#define XB_SPIN_CAP (1u << 18)
#define LAS __attribute__((address_space(3)))

__device__ __forceinline__ unsigned xb_ld(unsigned* p)              { return __hip_atomic_load(p, __ATOMIC_RELAXED, __HIP_MEMORY_SCOPE_AGENT); }
__device__ __forceinline__ unsigned xb_add(unsigned* p, unsigned v) { return __hip_atomic_fetch_add(p, v, __ATOMIC_RELAXED, __HIP_MEMORY_SCOPE_AGENT); }
__device__ __forceinline__ unsigned xb_xcc_id() { return (unsigned)__builtin_amdgcn_s_getreg((3 << 11) | 20) & 0xFu; }
#define XB_SPIN(cond, bar) do { unsigned _sp = 0; while (cond) { __builtin_amdgcn_s_sleep(1); \
    if ((++_sp & 255u) == 0u) { if (xb_ld(&(bar)[XB_TMO])) break; if (_sp > XB_SPIN_CAP) { atomicAdd(&(bar)[XB_TMO], 1u); break; } } } } while (0)

struct XcdBarrier {
    unsigned* bar; unsigned x;
    volatile LAS unsigned* st;
};

__device__ __forceinline__ XcdBarrier xcd_barrier_post(unsigned* bar, volatile LAS unsigned* st) {
    XcdBarrier b; b.bar = bar; b.x = xb_xcc_id(); b.st = st;
    if (threadIdx.x == 0) (void)xb_add(&bar[XB_XCNT(b.x)], 1u);
    return b;
}
__device__ __forceinline__ void xcd_barrier_complete(unsigned* bar, unsigned x, unsigned& nloc, unsigned& nx) {
    const unsigned G = gridDim.x * gridDim.y * gridDim.z;
    unsigned sum, cnt, mine, sp = 0u;
    for (;;) {
        sum = 0u; cnt = 0u; mine = 0u;
#pragma unroll
        for (unsigned j = 0; j < 16; ++j) { const unsigned c = xb_ld(&bar[XB_XCNT(j)]); sum += c; cnt += (c > 0u) ? 1u : 0u; mine = (j == x) ? c : mine; }
        if (sum == G) break;
        __builtin_amdgcn_s_sleep(1);
        if ((++sp & 255u) == 0u) { if (xb_ld(&bar[XB_TMO])) break; if (sp > XB_SPIN_CAP) { atomicAdd(&bar[XB_TMO], 1u); break; } }
    }
    nloc = mine > 0u ? mine : 1u; nx = cnt > 0u ? cnt : 1u;
}

__device__ __forceinline__ void xcd_barrier(const XcdBarrier& b) {
    asm volatile("s_waitcnt vmcnt(0)" ::: "memory");
    __syncthreads();
    if (threadIdx.x == 0) {
        unsigned* bar = b.bar;
        __builtin_amdgcn_s_waitcnt(0);
        unsigned nloc = b.st[0], nx = b.st[1];
        if (nloc == 0u) { xcd_barrier_complete(bar, b.x, nloc, nx); b.st[0] = nloc; b.st[1] = nx; }
        const unsigned old = xb_add(&bar[XB_XSUB(b.x)], 1u);
        const unsigned gen = old / nloc;
        if (old + 1u == (gen + 1u) * nloc) {
            __builtin_amdgcn_fence(__ATOMIC_RELEASE, "agent");
            asm volatile("s_waitcnt vmcnt(0)" ::: "memory");
            const unsigned og = xb_add(&bar[XB_TOP], 1u);
            const unsigned tg = og / nx;
            if (og + 1u == (tg + 1u) * nx) xb_add(&bar[XB_TOPGEN], 1u);
            else XB_SPIN(xb_ld(&bar[XB_TOPGEN]) == tg, bar);
            __builtin_amdgcn_fence(__ATOMIC_ACQUIRE, "agent");
            xb_add(&bar[XB_XGEN(b.x)], 1u);
            asm volatile("s_waitcnt vmcnt(0)" ::: "memory");
        } else {
            XB_SPIN(xb_ld(&bar[XB_XGEN(b.x)]) == gen, bar);
            __builtin_amdgcn_fence(__ATOMIC_ACQUIRE, "agent");
            asm volatile("s_waitcnt vmcnt(0)" ::: "memory");
        }
    }
    __syncthreads();
}
constexpr int D = 2048, NB = 8, SEQ = 2048, NL = 4, T = NB * SEQ;
constexpr int NCH = SEQ / 64, NCHUNK = T / 64;
constexpr int GKW = 512, RANK = 16;
constexpr int INW = 6160, NP = 6144;
constexpr int NE = 16384;
constexpr float ALPHA = 1.6817928305074290f, EPS = 1e-5f;
constexpr int PQ = 0, PK = 512, PV = 1024, PR = 2048, PCB = 3072, PCC = 4096, PCH = 5120;
constexpr int NWAVES = 8, NTHREADS = 512;
#ifndef WGM_IN
#define WGM_IN 4
#endif
#ifndef WGM_OUT
#define WGM_OUT 4
#endif
#ifndef WGM_WQ
#define WGM_WQ 4
#endif
#ifndef TAB4
#define TAB4 1
#endif
constexpr int NPHASES = 2 + 7 * NL;

constexpr size_t MiB = 1u << 20;
constexpr size_t WS_CTL = 0, CTL_ZERO_BYTES = 1 * MiB;
constexpr size_t WS_MOD = 1 * MiB, WS_PART = 3 * MiB, WS_KEYS = 15 * MiB, WS_DTOT = 17 * MiB, WS_WIN = 18 * MiB, WS_WOUT = 115 * MiB, WS_WQ = 147 * MiB;
constexpr size_t WS_UT = 179 * MiB, WS_VT = 435 * MiB, WS_H = 691 * MiB, WS_PROJ = 755 * MiB, WS_E = 947 * MiB, WS_OGLA = 979 * MiB, WS_Y = 1043 * MiB;
constexpr size_t WS_Z = 1107 * MiB, WS_X1 = 1235 * MiB, WS_X = 1363 * MiB, WS_Q = 1491 * MiB, WS_H2 = 1555 * MiB, WS_HQ8 = 1619 * MiB, WS_H8 = 1659 * MiB, WS_WIN8 = 1691 * MiB, WS_WOUT8 = 1739 * MiB, WS_WQ8 = 1755 * MiB, WS_Y8 = 1771 * MiB, WS_H28 = 1803 * MiB, WS_END = 1835 * MiB;
constexpr size_t WS_SU = 17 * MiB + 512 * 1024, WS_SV = 17 * MiB + 768 * 1024, WS_HSC = 2 * MiB + 640 * 1024;
static_assert(WS_WIN + (size_t)NL * INW * D * 2 <= WS_WOUT && WS_PART + (size_t)NL * 8 * NB * 6 * D * 4 <= WS_KEYS && WS_MOD + (size_t)NL * NB * 6 * D * 4 <= WS_PART, "ws map");
constexpr size_t WS_SAH = WS_SU, WS_SAY = WS_SU + 65536, WS_SB = WS_SV; constexpr int SBL = NP + 2 * D;
constexpr size_t WS_SBA = WS_SB + (size_t)NL * SBL * 4, WS_ALR8 = WS_SU + 131072;
#ifndef KROT_A
#define KROT_A 0
#endif
#ifndef KROT_B
#define KROT_B 0
#endif
#define KROT(c) (KROT_A * (((c) >> 3) & 3) + KROT_B * ((c) >> 5))
#ifndef RES16
#define RES16 1
#endif
#ifndef RES16_X
#define RES16_X RES16
#endif
#ifndef RES16_Z
#define RES16_Z RES16
#endif
#ifndef RES16_X1
#define RES16_X1 RES16
#endif
#ifndef I8_GATE
#define I8_GATE 1
#endif
#ifndef I8_WQ
#define I8_WQ 1
#endif
#ifndef I8_IN
#define I8_IN 1
#endif
#ifndef I8_OUT
#define I8_OUT 1
#endif
constexpr int CW_BAR = 4096;

constexpr int RING_OFF = 0, RING_BYTES = 131072, LDSCTL_OFF = RING_BYTES, LDS_BYTES = 147456;

#define GAS __attribute__((address_space(1)))
typedef unsigned short bf16;
typedef unsigned v4u __attribute__((ext_vector_type(4)));
typedef unsigned v2u __attribute__((ext_vector_type(2)));
typedef int v4i __attribute__((ext_vector_type(4)));
typedef float f32x4 __attribute__((ext_vector_type(4)));
typedef float f32x16 __attribute__((ext_vector_type(16)));
typedef short bf16x8 __attribute__((ext_vector_type(8)));
typedef __bf16 bf16x2v __attribute__((ext_vector_type(2)));
#define LDS_WAIT() asm volatile("s_waitcnt lgkmcnt(0)" ::: "memory")

__device__ __forceinline__ unsigned pk2(float lo, float hi) { return pg8::cvt_pk_bf16(lo, hi); }
__device__ __forceinline__ float dot2bf(unsigned w, unsigned x, float acc) { return __builtin_amdgcn_fdot2_f32_bf16(__builtin_bit_cast(bf16x2v, w), __builtin_bit_cast(bf16x2v, x), acc, false); }
__device__ __forceinline__ float bflo(unsigned u) { return __uint_as_float(u << 16); }
__device__ __forceinline__ float bfhi(unsigned u) { return __uint_as_float(u & 0xffff0000u); }
__device__ __forceinline__ float silu_f(float x) { return x * __builtin_amdgcn_rcpf(1.0f + __expf(-x)); }
__device__ __forceinline__ float logsigmoid_f(float x) { return fminf(x, 0.0f) - log1pf(__expf(-fabsf(x))); }
__device__ __forceinline__ float logsigmoid_fast(float x) { return fminf(x, 0.0f) - __logf(1.0f + __expf(-fabsf(x))); }
__device__ __forceinline__ float gelu_tanh_f(float x) { const float u = 0.7978845608028654f * (x + 0.044715f * x * x * x); return 0.5f * x * (1.0f + tanhf(u)); }
__device__ __forceinline__ unsigned pack_i8(float a, float b, float c, float d) {
    const int q0 = (int)__builtin_rintf(a), q1 = (int)__builtin_rintf(b), q2 = (int)__builtin_rintf(c), q3 = (int)__builtin_rintf(d);
    return (unsigned)(q0 & 255) | ((unsigned)(q1 & 255) << 8) | ((unsigned)(q2 & 255) << 16) | ((unsigned)(q3 & 255) << 24); }
#define WAVE_ALLREDUCE(v, OP) do { \
    v = OP(v, __uint_as_float((unsigned)__builtin_amdgcn_update_dpp(0, (int)__float_as_uint(v), 0xB1, 0xf, 0xf, false)));      \
    v = OP(v, __uint_as_float((unsigned)__builtin_amdgcn_update_dpp(0, (int)__float_as_uint(v), 0x4E, 0xf, 0xf, false)));      \
    v = OP(v, __uint_as_float((unsigned)__builtin_amdgcn_update_dpp(0, (int)__float_as_uint(v), 0x124, 0xf, 0xf, false)));     \
    v = OP(v, __uint_as_float((unsigned)__builtin_amdgcn_update_dpp(0, (int)__float_as_uint(v), 0x128, 0xf, 0xf, false)));     \
    { const auto r_ = __builtin_amdgcn_permlane16_swap(__float_as_uint(v), __float_as_uint(v), false, false); v = OP(__uint_as_float(r_[0]), __uint_as_float(r_[1])); } \
    { const auto r_ = __builtin_amdgcn_permlane32_swap(__float_as_uint(v), __float_as_uint(v), false, false); v = OP(__uint_as_float(r_[0]), __uint_as_float(r_[1])); } } while (0)
__device__ __forceinline__ float op_add_f(float a, float b) { return a + b; }
__device__ __forceinline__ float wave_sum(float v) { WAVE_ALLREDUCE(v, op_add_f); return v; }
__device__ __forceinline__ float wave_max(float v) { WAVE_ALLREDUCE(v, fmaxf); return v; }

struct Args { const float* in[19]; float* out; unsigned char* ws; int ph_lo, ph_hi; };

__device__ __forceinline__ void transpose_item(const float* W, int ldw, int col0, bf16* WTrows, int k0, int nvalid, LAS float* scr, int lane) {
    const int n = lane & 31;
    float tv[32];
#pragma unroll
    for (int i = 0; i < 32; ++i) { const int kk = 2 * i + (lane >> 5); tv[i] = (n < nvalid) ? W[(size_t)(k0 + kk) * ldw + col0 + n] : 0.f; }
#pragma unroll
    for (int i = 0; i < 32; ++i) { const int kk = 2 * i + (lane >> 5); scr[kk * 33 + n] = tv[i]; }
    LDS_WAIT(); asm volatile("" ::: "memory");
    const int c = lane & 7;
#pragma unroll
    for (int j = 0; j < 4; ++j) { const int nn = (lane >> 3) + 8 * j; const LAS float* s = scr + (8 * c) * 33 + nn;
        v4u o; o.x = pk2(s[0 * 33], s[1 * 33]); o.y = pk2(s[2 * 33], s[3 * 33]); o.z = pk2(s[4 * 33], s[5 * 33]); o.w = pk2(s[6 * 33], s[7 * 33]);
        if (nn < nvalid) *(v4u*)(WTrows + (size_t)nn * D + k0 + 8 * c) = o; }
    LDS_WAIT(); asm volatile("" ::: "memory");
}
__device__ __forceinline__ void cvt_stream(const float* src, bf16* dst, size_t n4, size_t i0, size_t stride) {
    for (size_t i = i0; i < n4; i += stride) { const f32x4 v = ((const f32x4*)src)[i]; v2u o; o.x = pk2(v.x, v.y); o.y = pk2(v.z, v.w); ((v2u*)dst)[i] = o; }
}
__device__ __forceinline__ void ph_prologue_a(const Args& a, LAS unsigned char* lds, int tid, int lane, int wave, int bx, int G) {
    const int gw = bx * NWAVES + wave, NGW = G * NWAVES;
    LAS float* cact = (LAS float*)lds;
    for (int i = tid; i < NB * D; i += NTHREADS) { const int b = i / D, d = i % D; cact[d * 8 + b] = silu_f(a.in[1][i]); }
    __syncthreads();
    float* part = (float*)(a.ws + WS_PART);
    for (int it = gw; it < NL * 8 * 48; it += NGW) {
        const int cg = it % 48, dr = (it / 48) % 8, l = it / 384;
        f32x4 acc[8];
#pragma unroll
        for (int b = 0; b < 8; ++b) acc[b] = (f32x4){0.f, 0.f, 0.f, 0.f};
        const float* w = a.in[2] + ((size_t)l * D + dr * 256) * (6 * D) + cg * 256 + lane * 4;
#pragma unroll 4
        for (int d = 0; d < 256; ++d) {
            const f32x4 wv = *(const f32x4*)(w + (size_t)d * (6 * D));
            const f32x4 c0 = *(const LAS f32x4*)(cact + (dr * 256 + d) * 8), c1 = *(const LAS f32x4*)(cact + (dr * 256 + d) * 8 + 4);
            acc[0] += wv * c0.x; acc[1] += wv * c0.y; acc[2] += wv * c0.z; acc[3] += wv * c0.w;
            acc[4] += wv * c1.x; acc[5] += wv * c1.y; acc[6] += wv * c1.z; acc[7] += wv * c1.w;
        }
#pragma unroll
        for (int b = 0; b < 8; ++b) *(f32x4*)(part + (((size_t)l * 8 + dr) * NB + b) * (6 * D) + cg * 256 + lane * 4) = acc[b];
    }
    __syncthreads();
    LAS float* scr = (LAS float*)(lds + wave * 8448);
    bf16* winT = (bf16*)(a.ws + WS_WIN); bf16* woutT = (bf16*)(a.ws + WS_WOUT); bf16* wqT = (bf16*)(a.ws + WS_WQ);
    constexpr int IPL = 6144 + 32 + 2048 + 2048;
    for (int it = gw; it < NL * IPL; it += NGW) {
        const int l = it / IPL; int r = it % IPL;
        if (r < 6144) { const int nb = r % 192, kb = r / 192, n0 = nb * 32;
            transpose_item(a.in[4] + (size_t)l * D * INW, INW, n0 < 3072 ? n0 : n0 + 16, winT + ((size_t)l * INW + n0) * D, kb * 64, 32, scr, lane); continue; }
        r -= 6144;
        if (r < 32) { transpose_item(a.in[4] + (size_t)l * D * INW, INW, 3072, winT + ((size_t)l * INW + NP) * D, r * 64, 16, scr, lane); continue; }
        r -= 32;
        if (r < 2048) { const int nb = r % 64, kb = r / 64; transpose_item(a.in[10] + (size_t)l * D * D, D, nb * 32, woutT + ((size_t)l * D + nb * 32) * D, kb * 64, 32, scr, lane); continue; }
        r -= 2048;
        { const int nb = r % 64, kb = r / 64; transpose_item(a.in[13] + (size_t)l * D * D, D, nb * 32, wqT + ((size_t)l * D + nb * 32) * D, kb * 64, 32, scr, lane); }
    }
    const size_t i0 = (size_t)bx * NTHREADS + tid, stride = (size_t)G * NTHREADS;
    cvt_stream(a.in[14], (bf16*)(a.ws + WS_KEYS), (size_t)NL * 8 * 2 * 128 * 128 / 4, i0, stride);
#if TAB4
    __syncthreads();
    { LAS float* rowst = (LAS float*)(lds + wave * 8192);
      f32x4 vnx[8];
      if (gw < 2 * NL * NE) { const int tbl0 = gw / (NL * NE), r0 = gw % (NL * NE); const float* s0 = (tbl0 ? a.in[16] : a.in[15]) + (size_t)r0 * D;
#pragma unroll
          for (int c8 = 0; c8 < 8; ++c8) vnx[c8] = *(const f32x4*)(s0 + (c8 * 64 + lane) * 4); }
      for (int row = gw; row < 2 * NL * NE; row += NGW) {
        const int tbl = row / (NL * NE), r = row % (NL * NE);
#pragma unroll
        for (int c8 = 0; c8 < 8; ++c8) *(LAS f32x4*)(rowst + (c8 * 64 + lane) * 4) = vnx[c8];
        { const int rown = row + NGW < 2 * NL * NE ? row + NGW : row; const int tbln = rown / (NL * NE), rn = rown % (NL * NE); const float* sn = (tbln ? a.in[16] : a.in[15]) + (size_t)rn * D;
#pragma unroll
          for (int c8 = 0; c8 < 8; ++c8) vnx[c8] = *(const f32x4*)(sn + (c8 * 64 + lane) * 4); }
        LDS_WAIT(); asm volatile("" ::: "memory");
        unsigned char* tb = a.ws + (tbl ? WS_VT : WS_UT) + (size_t)r * 1152;
#pragma unroll
        for (int pass = 0; pass < 2; ++pass) { const int slot = lane + 64 * pass;
            if (slot < 72) { const int col0 = (slot >> 3) * 240 + (slot & 7) * 30;
                float x[30]; float mx = 0.f;
#pragma unroll
                for (int k = 0; k < 30; ++k) { x[k] = (col0 + k < D) ? rowst[col0 + k] : 0.f; mx = fmaxf(mx, fabsf(x[k])); }
                int code = 0; float inv = 0.f;
                if (mx > 0.f) { code = (int)ceilf(8.0f * log2f(mx * (1.0f / 7.0f))) + 128; code = code < 0 ? 0 : (code > 255 ? 255 : code); inv = __builtin_amdgcn_exp2f(16.0f - (float)code * 0.125f); }
                unsigned dw[4] = {0u, 0u, 0u, 0u};
#pragma unroll
                for (int kb = 0; kb < 15; ++kb) { int a0 = (int)__builtin_rintf(x[2 * kb] * inv), a1 = (int)__builtin_rintf(x[2 * kb + 1] * inv);
                    a0 = a0 < -7 ? -7 : (a0 > 7 ? 7 : a0); a1 = a1 < -7 ? -7 : (a1 > 7 ? 7 : a1);
                    dw[kb >> 2] |= ((tbl ? (unsigned)(a0 + 8) : ((unsigned)a0 & 15u)) | (((unsigned)a1 & 15u) << 4)) << (8 * (kb & 3)); }
                dw[3] |= (unsigned)code << 24;
                *(v4u*)(tb + slot * 16) = (v4u){dw[0], dw[1], dw[2], dw[3]}; } }
        LDS_WAIT(); asm volatile("" ::: "memory");
      } }
#else
    for (int row = gw; row < 2 * NL * NE; row += NGW) {
        const int tbl = row / (NL * NE), r = row % (NL * NE);
        const float* src = (tbl ? a.in[16] : a.in[15]) + (size_t)r * D;
        f32x4 v[8]; float mx = 0.f;
#pragma unroll
        for (int c8 = 0; c8 < 8; ++c8) { v[c8] = *(const f32x4*)(src + (c8 * 64 + lane) * 4); mx = fmaxf(mx, fmaxf(fmaxf(fabsf(v[c8].x), fabsf(v[c8].y)), fmaxf(fabsf(v[c8].z), fabsf(v[c8].w)))); }
        mx = wave_max(mx);
        const float inv = mx > 0.f ? 127.0f / mx : 0.f; const int off = tbl ? 128 : 0;
        unsigned dw[8];
#pragma unroll
        for (int c8 = 0; c8 < 8; ++c8) { const int q0 = (int)__builtin_rintf(v[c8].x * inv) + off, q1 = (int)__builtin_rintf(v[c8].y * inv) + off, q2 = (int)__builtin_rintf(v[c8].z * inv) + off, q3 = (int)__builtin_rintf(v[c8].w * inv) + off;
            dw[c8] = (unsigned)(q0 & 255) | ((unsigned)(q1 & 255) << 8) | ((unsigned)(q2 & 255) << 16) | ((unsigned)(q3 & 255) << 24); }
        unsigned char* dst = a.ws + (tbl ? WS_VT : WS_UT) + (size_t)r * D;
        *(v4u*)(dst + lane * 16) = (v4u){dw[0], dw[1], dw[2], dw[3]}; *(v4u*)(dst + (64 + lane) * 16) = (v4u){dw[4], dw[5], dw[6], dw[7]};
        if (lane == 0) ((float*)(a.ws + (tbl ? WS_SV : WS_SU)))[r] = mx * (1.0f / 127.0f);
    }
#endif
}

__device__ __forceinline__ void ln_tail(const float (&z)[32], int t, int lane, const float* g, const float* bta, float* xout, const float* sh, const float* sc, bf16* hout, unsigned char* q8, float* q8s, LAS unsigned char* q8stage = nullptr, unsigned char* a8 = nullptr, float* a8s = nullptr, bf16* xb = nullptr) {
    float s = 0.f;
#pragma unroll
    for (int i = 0; i < 32; ++i) s += z[i];
    const float mu = wave_sum(s) * (1.0f / D);
    float q = 0.f;
#pragma unroll
    for (int i = 0; i < 32; ++i) { const float d = z[i] - mu; q += d * d; }
    const float rs = rsqrtf(wave_sum(q) * (1.0f / D) + EPS);
    float hv[32]; float mx = 0.f;
#pragma unroll
    for (int c = 0; c < 8; ++c) { const int col = (c * 64 + lane) * 4;
        const f32x4 g0 = *(const f32x4*)(g + col), b0 = *(const f32x4*)(bta + col);
        f32x4 x0;
        x0.x = (z[c * 4 + 0] - mu) * rs * g0.x + b0.x; x0.y = (z[c * 4 + 1] - mu) * rs * g0.y + b0.y; x0.z = (z[c * 4 + 2] - mu) * rs * g0.z + b0.z; x0.w = (z[c * 4 + 3] - mu) * rs * g0.w + b0.w;
        if (xb) { v2u o; o.x = pk2(x0.x, x0.y); o.y = pk2(x0.z, x0.w); *(v2u*)(xb + (size_t)t * D + col) = o; }
        else if (xout) *(f32x4*)(xout + (size_t)t * D + col) = x0;
        if (hout || q8 || a8) { const f32x4 s0 = *(const f32x4*)(sc + col), h0 = *(const f32x4*)(sh + col);
            hv[c * 4] = x0.x * (1.f + s0.x) + h0.x; hv[c * 4 + 1] = x0.y * (1.f + s0.y) + h0.y; hv[c * 4 + 2] = x0.z * (1.f + s0.z) + h0.z; hv[c * 4 + 3] = x0.w * (1.f + s0.w) + h0.w;
            if (hout) { v2u o; o.x = pk2(hv[c * 4], hv[c * 4 + 1]); o.y = pk2(hv[c * 4 + 2], hv[c * 4 + 3]);
                *(v2u*)(hout + (size_t)t * D + col) = o; }
            if (q8 || a8) mx = fmaxf(mx, fmaxf(fmaxf(fabsf(hv[c * 4]), fabsf(hv[c * 4 + 1])), fmaxf(fabsf(hv[c * 4 + 2]), fabsf(hv[c * 4 + 3])))); }
    }
    if (q8 || a8) {
        mx = wave_max(mx);
        const float qmax_ = (q8 && TAB4) ? 119.0f : 127.0f;
        const float inv = mx > 0.f ? qmax_ / mx : 0.f;
        unsigned dw[8];
#pragma unroll
        for (int c = 0; c < 8; ++c) { const int q0 = (int)__builtin_rintf(hv[c * 4] * inv), q1 = (int)__builtin_rintf(hv[c * 4 + 1] * inv), q2 = (int)__builtin_rintf(hv[c * 4 + 2] * inv), q3 = (int)__builtin_rintf(hv[c * 4 + 3] * inv);
            dw[c] = (unsigned)(q0 & 255) | ((unsigned)(q1 & 255) << 8) | ((unsigned)(q2 & 255) << 16) | ((unsigned)(q3 & 255) << 24); }
        if (a8) {
#pragma unroll
            for (int c = 0; c < 8; ++c) *(unsigned*)(a8 + (size_t)t * D + (c * 64 + lane) * 4) = dw[c];
            if (a8s && lane == 0) a8s[t] = mx / qmax_; }
        if (q8) {
#if TAB4
        { LAS unsigned* st32 = (LAS unsigned*)q8stage; LAS unsigned char* st8 = (LAS unsigned char*)q8stage;
#pragma unroll
          for (int i = 0; i < 9; ++i) st32[lane + 64 * i] = 0u;
          LDS_WAIT(); asm volatile("" ::: "memory");
#pragma unroll
          for (int c = 0; c < 8; ++c)
#pragma unroll
              for (int jp = 0; jp < 2; ++jp) { const int col = (c * 64 + lane) * 4 + 2 * jp, u = col / 240, r = col - u * 240, l7 = r / 30, k = r - l7 * 30;
                  const int q0 = (int)(signed char)((dw[c] >> (16 * jp)) & 255u), q1 = (int)(signed char)((dw[c] >> (16 * jp + 8)) & 255u);
                  const int l0 = ((q0 + 8) & 15) - 8, l1 = ((q1 + 8) & 15) - 8, h0 = (q0 - l0) >> 4, h1 = (q1 - l1) >> 4;
                  LAS unsigned char* sp = st8 + (u * 8 + l7) * 32 + (k >> 1);
                  sp[0] = (unsigned char)((l0 & 15) | ((l1 & 15) << 4)); sp[16] = (unsigned char)((h0 & 15) | ((h1 & 15) << 4)); }
          LDS_WAIT(); asm volatile("" ::: "memory");
          unsigned* d32 = (unsigned*)(q8 + (size_t)t * 2304);
#pragma unroll
          for (int i = 0; i < 9; ++i) d32[lane + 64 * i] = st32[lane + 64 * i];
          LDS_WAIT(); asm volatile("" ::: "memory"); }
#else
        unsigned char* dst = q8 + (size_t)t * D;
        *(v4u*)(dst + lane * 16) = (v4u){dw[0], dw[1], dw[2], dw[3]}; *(v4u*)(dst + (64 + lane) * 16) = (v4u){dw[4], dw[5], dw[6], dw[7]};
#endif
        if (lane == 0) q8s[t] = mx / qmax_; }
    }
}

__device__ __forceinline__ void ph_prologue_b(const Args& a, LAS unsigned char* lds, int tid, int lane, int wave, int bx, int G) {
    const float* part = (const float*)(a.ws + WS_PART); float* mod = (float*)(a.ws + WS_MOD);
    for (int i = bx * NTHREADS + tid; i < NL * NB * 6 * D / 4; i += G * NTHREADS) {
        const int idx = i * 4, e = idx % (6 * D), b = (idx / (6 * D)) % NB, l = idx / (6 * D * NB);
        f32x4 s = *(const f32x4*)(a.in[3] + l * 6 * D + e);
#pragma unroll
        for (int dr = 0; dr < 8; ++dr) s += *(const f32x4*)(part + (((size_t)l * 8 + dr) * NB + b) * (6 * D) + e);
        *(f32x4*)(mod + idx) = s;
    }
    LAS float* msh = (LAS float*)lds;
    bf16* hbuf = (bf16*)(a.ws + WS_H);
    for (int ch = bx; ch < NCHUNK; ch += G) {
        const int b = ch / NCH;
        for (int i = tid; i < 1024; i += NTHREADS) { const int e = i * 4;
            f32x4 s = *(const f32x4*)(a.in[3] + e);
#pragma unroll
            for (int dr = 0; dr < 8; ++dr) s += *(const f32x4*)(part + (((size_t)0 * 8 + dr) * NB + b) * (6 * D) + e);
            *(LAS f32x4*)(msh + e) = s; }
        __syncthreads();
        for (int i = 0; i < 8; ++i) { const int t = ch * 64 + wave * 8 + i;
            float hv[32]; float mx = 0.f;
#pragma unroll
            for (int c = 0; c < 4; ++c) { const int col = (c * 64 + lane) * 8;
                const f32x4 x0 = *(const f32x4*)(a.in[0] + (size_t)t * D + col), x1 = *(const f32x4*)(a.in[0] + (size_t)t * D + col + 4);
                const f32x4 h0 = *(const LAS f32x4*)(msh + col), h1 = *(const LAS f32x4*)(msh + col + 4), s0 = *(const LAS f32x4*)(msh + 2048 + col), s1 = *(const LAS f32x4*)(msh + 2048 + col + 4);
#pragma unroll
                for (int j = 0; j < 4; ++j) { hv[c * 8 + j] = x0[j] * (1.f + s0[j]) + h0[j]; hv[c * 8 + 4 + j] = x1[j] * (1.f + s1[j]) + h1[j]; }
                v4u o; o.x = pk2(hv[c * 8], hv[c * 8 + 1]); o.y = pk2(hv[c * 8 + 2], hv[c * 8 + 3]); o.z = pk2(hv[c * 8 + 4], hv[c * 8 + 5]); o.w = pk2(hv[c * 8 + 6], hv[c * 8 + 7]);
#if !I8_GATE
                *(v4u*)(hbuf + (size_t)t * D + col) = o;
#endif
#if RES16_X
                { v4u xo; xo.x = pk2(x0.x, x0.y); xo.y = pk2(x0.z, x0.w); xo.z = pk2(x1.x, x1.y); xo.w = pk2(x1.z, x1.w); *(v4u*)((bf16*)(a.ws + WS_X) + (size_t)t * D + col) = xo; }
#endif
#pragma unroll
                for (int j = 0; j < 8; ++j) mx = fmaxf(mx, fabsf(hv[c * 8 + j])); }
            mx = wave_max(mx);
            const float inv = mx > 0.f ? 127.0f / mx : 0.f;
#pragma unroll
            for (int c = 0; c < 4; ++c) { v2u o;
                o.x = pack_i8(hv[c * 8] * inv, hv[c * 8 + 1] * inv, hv[c * 8 + 2] * inv, hv[c * 8 + 3] * inv); o.y = pack_i8(hv[c * 8 + 4] * inv, hv[c * 8 + 5] * inv, hv[c * 8 + 6] * inv, hv[c * 8 + 7] * inv);
                *(v2u*)(a.ws + WS_H8 + (size_t)t * D + (c * 64 + lane) * 8) = o; }
            if (lane == 0) ((float*)(a.ws + WS_SAH))[t] = mx * (1.0f / 127.0f); }
        __syncthreads();
    }
    { const int gw = bx * NWAVES + wave, NGW = G * NWAVES;
      for (int row = gw; row < NL * (SBL + 16); row += NGW) { const int l = row / (SBL + 16), r = row % (SBL + 16);
          const bf16* src; unsigned char* dst; float* sdst;
          if (r < NP) { src = (const bf16*)(a.ws + WS_WIN) + ((size_t)l * INW + r) * D; dst = a.ws + WS_WIN8 + ((size_t)l * NP + r) * D; sdst = (float*)(a.ws + WS_SB) + l * SBL + r; }
          else if (r < NP + D) { src = (const bf16*)(a.ws + WS_WOUT) + ((size_t)l * D + (r - NP)) * D; dst = a.ws + WS_WOUT8 + ((size_t)l * D + (r - NP)) * D; sdst = (float*)(a.ws + WS_SB) + l * SBL + r; }
          else if (r < SBL) { src = (const bf16*)(a.ws + WS_WQ) + ((size_t)l * D + (r - NP - D)) * D; dst = a.ws + WS_WQ8 + ((size_t)l * D + (r - NP - D)) * D; sdst = (float*)(a.ws + WS_SB) + l * SBL + r; }
          else { src = (const bf16*)(a.ws + WS_WIN) + ((size_t)l * INW + NP + (r - SBL)) * D; dst = a.ws + WS_ALR8 + ((size_t)l * 16 + (r - SBL)) * D; sdst = (float*)(a.ws + WS_SBA) + l * 16 + (r - SBL); }
          v4u w[4]; float mx = 0.f;
#pragma unroll
          for (int c = 0; c < 4; ++c) w[c] = *(const v4u*)(src + (c * 64 + lane) * 8);
#pragma unroll
          for (int c = 0; c < 4; ++c)
#pragma unroll
              for (int j = 0; j < 4; ++j) mx = fmaxf(mx, fmaxf(fabsf(bflo(w[c][j])), fabsf(bfhi(w[c][j]))));
          mx = wave_max(mx);
          const float inv = mx > 0.f ? 127.0f / mx : 0.f;
#pragma unroll
          for (int c = 0; c < 4; ++c) { v2u o;
              o.x = pack_i8(bflo(w[c][0]) * inv, bfhi(w[c][0]) * inv, bflo(w[c][1]) * inv, bfhi(w[c][1]) * inv); o.y = pack_i8(bflo(w[c][2]) * inv, bfhi(w[c][2]) * inv, bflo(w[c][3]) * inv, bfhi(w[c][3]) * inv);
              *(v2u*)(dst + (c * 64 + lane) * 8) = o; }
          if (lane == 0) *sdst = mx * (1.0f / 127.0f); } }
}

__device__ __forceinline__ void gate_prep(const Args& a, int l, LAS unsigned char* lds, int tid, int lane, int wave, int ch) {
    const bf16* hbuf = (const bf16*)(a.ws + WS_H); const bf16* waT = (const bf16*)(a.ws + WS_WIN) + ((size_t)l * INW + NP) * D;
    bf16* Ebuf = (bf16*)(a.ws + WS_E); float* dtot = (float*)(a.ws + WS_DTOT);
    const int t0 = ch * 64, l15 = lane & 15, lq = lane >> 4, mt = wave & 3, kh = wave >> 2;
    LAS float* alr = (LAS float*)(lds + LDSCTL_OFF + 1024);
#if I8_GATE
    { v4i acc = (v4i){0, 0, 0, 0};
      const unsigned char* hA = a.ws + WS_H8 + (size_t)(t0 + 16 * mt + l15) * D + kh * 1024 + 16 * lq;
      const unsigned char* wB = a.ws + WS_ALR8 + ((size_t)l * 16 + l15) * D + kh * 1024 + 16 * lq;
#pragma unroll 8
      for (int ks = 0; ks < 16; ++ks) { const v4i av = *(const v4i*)(hA + 64 * ks), bv = *(const v4i*)(wB + 64 * ks); acc = __builtin_amdgcn_mfma_i32_16x16x64_i8(av, bv, acc, 0, 0, 0); }
      const float sw = ((const float*)(a.ws + WS_SBA))[l * 16 + l15];
#pragma unroll
      for (int r = 0; r < 4; ++r) { const int tl = 16 * mt + 4 * lq + r; alr[(kh * 64 + tl) * 16 + l15] = (float)acc[r] * (sw * ((const float*)(a.ws + WS_SAH))[t0 + tl]); } }
#else
    f32x4 acc = (f32x4){0.f, 0.f, 0.f, 0.f};
    const bf16* hA = hbuf + (size_t)(t0 + 16 * mt + l15) * D + kh * 1024 + 8 * lq;
    const bf16* wB = waT + (size_t)l15 * D + kh * 1024 + 8 * lq;
#pragma unroll 8
    for (int ks = 0; ks < 32; ++ks) { const bf16x8 av = *(const bf16x8*)(hA + 32 * ks), bv = *(const bf16x8*)(wB + 32 * ks); acc = __builtin_amdgcn_mfma_f32_16x16x32_bf16(av, bv, acc, 0, 0, 0); }
#pragma unroll
    for (int r = 0; r < 4; ++r) alr[(kh * 64 + 16 * mt + 4 * lq + r) * 16 + l15] = acc[r];
#endif
    __syncthreads();
    const int col = tid;
    float wg[16];
#pragma unroll
    for (int r = 0; r < 16; ++r) wg[r] = a.in[5][((size_t)l * RANK + r) * GKW + col];
    const float bgc = a.in[6][l * GKW + col];
    for (int i = tid; i < 256; i += NTHREADS) *(LAS f32x4*)(alr + i * 4) = *(const LAS f32x4*)(alr + i * 4) + *(const LAS f32x4*)(alr + 1024 + i * 4);
    __syncthreads();
    float tot = 0.f;
    LAS float* lac = (LAS float*)lds;
    for (int j = 0; j < 64; ++j) { float lg0 = bgc, lg1 = 0.f;
#pragma unroll
        for (int r4 = 0; r4 < 4; ++r4) { const f32x4 p = *(const LAS f32x4*)(alr + j * 16 + r4 * 4);
            lg0 += p.x * wg[r4 * 4] + p.z * wg[r4 * 4 + 2]; lg1 += p.y * wg[r4 * 4 + 1] + p.w * wg[r4 * 4 + 3]; }
        const float la = logsigmoid_fast(lg0 + lg1) * (1.0f / 16.0f); lac[j * GKW + col] = la; tot += la; }
    float run = 0.f;
    for (int j = 0; j < 64; ++j) { run += lac[j * GKW + col]; lac[j * GKW + col] = __expf(tot - run); }
    __syncthreads();
    for (int i = 0; i < 8; ++i) { const int j = wave * 8 + i;
        const f32x4 e0 = *(const LAS f32x4*)(lac + j * GKW + lane * 8), e1 = *(const LAS f32x4*)(lac + j * GKW + lane * 8 + 4);
        v4u o; o.x = pk2(e0.x, e0.y); o.y = pk2(e0.z, e0.w); o.z = pk2(e1.x, e1.y); o.w = pk2(e1.z, e1.w);
        *(v4u*)(Ebuf + (size_t)(t0 + j) * GKW + lane * 8) = o; }
    dtot[(size_t)ch * GKW + col] = __expf(tot);
    __syncthreads();
}

__device__ __forceinline__ void gla_unit(const Args& a, LAS unsigned char* lds, int tid, int lane, int wave, int un) {
    const bf16* proj = (const bf16*)(a.ws + WS_PROJ); const bf16* Ebuf = (const bf16*)(a.ws + WS_E); const float* dtot = (const float*)(a.ws + WS_DTOT); bf16* ogla = (bf16*)(a.ws + WS_OGLA);
    const int pair_ = (un & 7) * 4 + (un >> 6), dvs = (un >> 3) & 7, hh = pair_ & 3, b = pair_ >> 2;
    LAS bf16* kdT0 = (LAS bf16*)lds; LAS bf16* vT0 = (LAS bf16*)(lds + 18432); LAS bf16* ST0 = (LAS bf16*)(lds + 18432 + 4608);
    LAS bf16* kdT1 = (LAS bf16*)(lds + 32768); LAS bf16* vT1 = (LAS bf16*)(lds + 32768 + 18432); LAS bf16* ST1 = (LAS bf16*)(lds + 32768 + 18432 + 4608);
    const int l15 = lane & 15, lq = lane >> 4, jl = tid >> 3, dv4 = (tid & 7) * 4, jt = (wave & 3) * 16, dvt = (wave >> 2) * 16, jp = tid >> 4, c16 = tid & 15;
#define GLA_BAR() do { asm volatile("s_waitcnt lgkmcnt(0)" ::: "memory"); __builtin_amdgcn_s_barrier(); asm volatile("" ::: "memory"); } while (0)
    f32x4 S0 = (f32x4){0.f, 0.f, 0.f, 0.f}, S1 = (f32x4){0.f, 0.f, 0.f, 0.f};
    v4u kn0[2], kn1[2], kn2[2], en0[2], en1[2], en2[2]; v2u vn0, vn1, vn2; bf16x8 qn0[4], qn1[4], qn2[4], qc[4]; f32x4 dn0, dn1, dn2, dc;
#define GLA_LOAD(c, kn, en, vn, qn, dn) do { const int t0c = b * SEQ + (c) * 64; const bf16* pr = proj + (size_t)(t0c + jl) * NP; \
          \
        kn[0] = *(const v4u*)(proj + (size_t)(t0c + 2 * jp) * NP + PK + hh * 128 + 8 * c16); kn[1] = *(const v4u*)(proj + (size_t)(t0c + 2 * jp + 1) * NP + PK + hh * 128 + 8 * c16); \
        en[0] = *(const v4u*)(Ebuf + (size_t)(t0c + 2 * jp) * GKW + hh * 128 + 8 * c16); en[1] = *(const v4u*)(Ebuf + (size_t)(t0c + 2 * jp + 1) * GKW + hh * 128 + 8 * c16); \
        vn = *(const v2u*)(pr + PV + hh * 256 + dvs * 32 + dv4); \
        _Pragma("unroll") for (int ks_ = 0; ks_ < 4; ++ks_) qn[ks_] = *(const bf16x8*)(proj + (size_t)(t0c + jt + l15) * NP + PQ + hh * 128 + 32 * ks_ + 8 * lq); \
        dn = *(const f32x4*)(dtot + (size_t)(b * NCH + (c)) * GKW + hh * 128 + 16 * wave + 4 * lq); } while (0)
#define GLA_PREPL(kn, en, vn, kdT, vT) do { \
        _Pragma("unroll") for (int i_ = 0; i_ < 8; ++i_) { const unsigned wa_ = kn[0][i_ >> 1], wb_ = kn[1][i_ >> 1], ea_ = en[0][i_ >> 1], eb_ = en[1][i_ >> 1]; \
            const float pa_ = ((i_ & 1) ? bfhi(wa_) : bflo(wa_)) * ((i_ & 1) ? bfhi(ea_) : bflo(ea_)), pb_ = ((i_ & 1) ? bfhi(wb_) : bflo(wb_)) * ((i_ & 1) ? bfhi(eb_) : bflo(eb_)); \
            *(LAS unsigned*)(kdT + (8 * c16 + i_) * 72 + ((((jp >> 2) ^ c16) & 7) << 3) + ((2 * jp) & 7)) = pk2(pa_, pb_); }     \
        _Pragma("unroll") for (int i_ = 0; i_ < 4; ++i_) { const unsigned w_ = vn[i_ >> 1]; vT[(dv4 + i_) * 72 + jl] = (bf16)((i_ & 1) ? (w_ >> 16) : (w_ & 0xffffu)); } } while (0)
#define GLA_QD(qn, dn) do { _Pragma("unroll") for (int ks_ = 0; ks_ < 4; ++ks_) qc[ks_] = qn[ks_]; dc = dn; } while (0)
#define GLA_BODYA(kdT, vT, ST) do { \
        S0 = S0 * dc; S1 = S1 * dc; \
        _Pragma("unroll") for (int ks = 0; ks < 2; ++ks) { \
            const bf16x8 A_ = *(const LAS bf16x8*)(kdT + (16 * wave + l15) * 72 + ((((4 * ks + lq) ^ (2 * wave + (l15 >> 3))) & 7) << 3)); \
            const bf16x8 B0_ = *(const LAS bf16x8*)(vT + l15 * 72 + 32 * ks + 8 * lq), B1_ = *(const LAS bf16x8*)(vT + (16 + l15) * 72 + 32 * ks + 8 * lq); \
            S0 = __builtin_amdgcn_mfma_f32_16x16x32_bf16(A_, B0_, S0, 0, 0, 0); S1 = __builtin_amdgcn_mfma_f32_16x16x32_bf16(A_, B1_, S1, 0, 0, 0); } \
        { v2u w0_, w1_; w0_.x = pk2(S0.x, S0.y); w0_.y = pk2(S0.z, S0.w); w1_.x = pk2(S1.x, S1.y); w1_.y = pk2(S1.z, S1.w); \
          *(LAS v2u*)(ST + l15 * 136 + 16 * wave + 4 * lq) = w0_; *(LAS v2u*)(ST + (16 + l15) * 136 + 16 * wave + 4 * lq) = w1_; } } while (0)
#define GLA_BODYB(c, ST) do { \
        f32x4 O_ = (f32x4){0.f, 0.f, 0.f, 0.f}; \
        _Pragma("unroll") for (int ks = 0; ks < 4; ++ks) { const bf16x8 A_ = *(const LAS bf16x8*)(ST + (dvt + l15) * 136 + 32 * ks + 8 * lq); O_ = __builtin_amdgcn_mfma_f32_16x16x32_bf16(A_, qc[ks], O_, 0, 0, 0); } \
        { const f32x4 Os_ = O_ * 0.08838834764831845f; v2u ob_; ob_.x = pk2(Os_.x, Os_.y); ob_.y = pk2(Os_.z, Os_.w); \
          *(v2u*)(ogla + (size_t)(b * SEQ + (c) * 64 + jt + l15) * 1024 + hh * 256 + dvs * 32 + dvt + 4 * lq) = ob_; } } while (0)
#define GLA_STEP(c, RA, RB, LA, LB) do { { const int cn_ = (c) + 3 < NCH ? (c) + 3 : NCH - 1; GLA_LOAD(cn_, kn##RA, en##RA, vn##RA, qn##RA, dn##RA); } \
        GLA_BODYA(kdT##LA, vT##LA, ST##LA); GLA_PREPL(kn##RB, en##RB, vn##RB, kdT##LB, vT##LB); GLA_BAR(); GLA_BODYB(c, ST##LA); GLA_QD(qn##RB, dn##RB); } while (0)
    GLA_LOAD(0, kn0, en0, vn0, qn0, dn0); GLA_LOAD(1, kn1, en1, vn1, qn1, dn1); GLA_LOAD(2, kn2, en2, vn2, qn2, dn2);
    GLA_PREPL(kn0, en0, vn0, kdT0, vT0); GLA_QD(qn0, dn0);
    GLA_BAR();
    static_assert(NCH == 32, "the step schedule below is written for 32 chunks: 5 x 6 + 2");
    for (int c = 0; c < 30; c += 6) {
        GLA_STEP(c, 0, 1, 0, 1); GLA_STEP(c + 1, 1, 2, 1, 0); GLA_STEP(c + 2, 2, 0, 0, 1); GLA_STEP(c + 3, 0, 1, 1, 0); GLA_STEP(c + 4, 1, 2, 0, 1); GLA_STEP(c + 5, 2, 0, 1, 0);
    }
    GLA_STEP(30, 0, 1, 0, 1); GLA_STEP(31, 1, 2, 1, 0);
#undef GLA_STEP
#undef GLA_PREPL
#undef GLA_QD
#undef GLA_BODYA
#undef GLA_BODYB
#undef GLA_BAR
#undef GLA_LOAD
}

__device__ __forceinline__ void unpack16(const v4u& p0, const v4u& p1, float (&o)[16]) {
#pragma unroll
    for (int j = 0; j < 4; ++j) { o[2 * j] = bflo(p0[j]); o[2 * j + 1] = bfhi(p0[j]); o[8 + 2 * j] = bflo(p1[j]); o[8 + 2 * j + 1] = bfhi(p1[j]); }
}
__device__ __forceinline__ void mixpost_chunk(const Args& a, int l, int lane, int wave, int ch) {
    const bf16* proj = (const bf16*)(a.ws + WS_PROJ); const bf16* ogla = (const bf16*)(a.ws + WS_OGLA);
    const int c0 = 16 * lane, tfirst = ch * 64 + wave * 8, sfirst = tfirst % SEQ;
    float gn[16], cw0[16], cw1[16], cw2[16], cn[16], u1[16], u2[16];
#pragma unroll
    for (int i = 0; i < 16; ++i) { gn[i] = a.in[7][l * 256 + ((c0 + i) & 255)]; cw0[i] = a.in[8][(size_t)l * 3072 + c0 + i]; cw1[i] = a.in[8][(size_t)l * 3072 + 1024 + c0 + i];
        cw2[i] = a.in[8][(size_t)l * 3072 + 2048 + c0 + i]; cn[i] = a.in[9][l * 1024 + c0 + i]; u1[i] = 0.f; u2[i] = 0.f; }
    if (sfirst >= 2) {
        float cc[16], chh[16];
        { const bf16* pr = proj + (size_t)(tfirst - 2) * NP; unpack16(*(const v4u*)(pr + PCC + c0), *(const v4u*)(pr + PCC + c0 + 8), cc); unpack16(*(const v4u*)(pr + PCH + c0), *(const v4u*)(pr + PCH + c0 + 8), chh); }
#pragma unroll
        for (int i = 0; i < 16; ++i) u2[i] = cc[i] * chh[i];
        { const bf16* pr = proj + (size_t)(tfirst - 1) * NP; unpack16(*(const v4u*)(pr + PCC + c0), *(const v4u*)(pr + PCC + c0 + 8), cc); unpack16(*(const v4u*)(pr + PCH + c0), *(const v4u*)(pr + PCH + c0 + 8), chh); }
#pragma unroll
        for (int i = 0; i < 16; ++i) u1[i] = cc[i] * chh[i];
    }
#pragma unroll 2
    for (int it = 0; it < 8; ++it) { const int t = tfirst + it; const bf16* pr = proj + (size_t)t * NP;
        float o[16], r[16], cb[16], cc[16], chh[16];
        unpack16(*(const v4u*)(ogla + (size_t)t * 1024 + c0), *(const v4u*)(ogla + (size_t)t * 1024 + c0 + 8), o);
        unpack16(*(const v4u*)(pr + PR + c0), *(const v4u*)(pr + PR + c0 + 8), r);
        unpack16(*(const v4u*)(pr + PCB + c0), *(const v4u*)(pr + PCB + c0 + 8), cb);
        unpack16(*(const v4u*)(pr + PCC + c0), *(const v4u*)(pr + PCC + c0 + 8), cc);
        unpack16(*(const v4u*)(pr + PCH + c0), *(const v4u*)(pr + PCH + c0 + 8), chh);
        float ss = 0.f;
#pragma unroll
        for (int i = 0; i < 16; ++i) ss += o[i] * o[i];
        ss += __uint_as_float((unsigned)__builtin_amdgcn_update_dpp(0, (int)__float_as_uint(ss), 0xB1, 0xf, 0xf, false)); ss += __uint_as_float((unsigned)__builtin_amdgcn_update_dpp(0, (int)__float_as_uint(ss), 0x4E, 0xf, 0xf, false));
        ss += __uint_as_float((unsigned)__builtin_amdgcn_update_dpp(0, (int)__float_as_uint(ss), 0x124, 0xf, 0xf, false)); ss += __uint_as_float((unsigned)__builtin_amdgcn_update_dpp(0, (int)__float_as_uint(ss), 0x128, 0xf, 0xf, false));
        const float rg = rsqrtf(ss * (1.0f / 256.f) + EPS);
        float val[16]; float s2 = 0.f;
#pragma unroll
        for (int i = 0; i < 16; ++i) { const float u0 = cc[i] * chh[i]; val[i] = cb[i] * (cw0[i] * u2[i] + cw1[i] * u1[i] + cw2[i] * u0); s2 += val[i] * val[i]; u2[i] = u1[i]; u1[i] = u0; }
        const float rc = rsqrtf(wave_sum(s2) * (1.0f / 1024.f) + EPS);
        float ya[16], yb[16]; float mx = 0.f;
#pragma unroll
        for (int i = 0; i < 16; ++i) { ya[i] = o[i] * rg * gn[i] * silu_f(r[i]); yb[i] = val[i] * rc * cn[i]; mx = fmaxf(mx, fmaxf(fabsf(ya[i]), fabsf(yb[i]))); }
        mx = wave_max(mx);
        const float inv = mx > 0.f ? 127.0f / mx : 0.f;
        v4u y0, y1;
#pragma unroll
        for (int j = 0; j < 4; ++j) { y0[j] = pack_i8(ya[4 * j] * inv, ya[4 * j + 1] * inv, ya[4 * j + 2] * inv, ya[4 * j + 3] * inv); y1[j] = pack_i8(yb[4 * j] * inv, yb[4 * j + 1] * inv, yb[4 * j + 2] * inv, yb[4 * j + 3] * inv); }
        unsigned char* yr = a.ws + WS_Y8 + (size_t)t * D;
        *(v4u*)(yr + c0) = y0; *(v4u*)(yr + 1024 + c0) = y1;
#if !I8_OUT
        { v4u b0, b1, b2, b3;
#pragma unroll
          for (int j = 0; j < 4; ++j) { b0[j] = pk2(ya[2 * j], ya[2 * j + 1]); b1[j] = pk2(ya[8 + 2 * j], ya[9 + 2 * j]); b2[j] = pk2(yb[2 * j], yb[2 * j + 1]); b3[j] = pk2(yb[8 + 2 * j], yb[9 + 2 * j]); }
          bf16* ybr = (bf16*)(a.ws + WS_Y) + (size_t)t * D;
          *(v4u*)(ybr + c0) = b0; *(v4u*)(ybr + c0 + 8) = b1; *(v4u*)(ybr + 1024 + c0) = b2; *(v4u*)(ybr + 1024 + c0 + 8) = b3; }
#endif
        if (lane == 0) ((float*)(a.ws + WS_SAY))[t] = mx * (1.0f / 127.0f);
    }
}

__device__ __forceinline__ void ln1_chunk(const Args& a, int l, LAS unsigned char* lds, int lane, int wave, int ch) {
    const float* zbuf = (const float*)(a.ws + WS_Z); const float* mod = (const float*)(a.ws + WS_MOD);
    const int b = ch / NCH; const float* mb = mod + ((size_t)l * NB + b) * 6 * D;
#pragma unroll 2
    for (int it = 0; it < 8; ++it) { const int t = ch * 64 + wave * 8 + it;
        float z[32];
#pragma unroll
#if RES16_Z
        for (int c = 0; c < 8; ++c) { const v2u v0 = *(const v2u*)((const bf16*)zbuf + (size_t)t * D + (c * 64 + lane) * 4); z[c * 4] = bflo(v0.x); z[c * 4 + 1] = bfhi(v0.x); z[c * 4 + 2] = bflo(v0.y); z[c * 4 + 3] = bfhi(v0.y); }
#else
        for (int c = 0; c < 8; ++c) { const f32x4 v0 = *(const f32x4*)(zbuf + (size_t)t * D + (c * 64 + lane) * 4); z[c * 4] = v0.x; z[c * 4 + 1] = v0.y; z[c * 4 + 2] = v0.z; z[c * 4 + 3] = v0.w; }
#endif
        ln_tail(z, t, lane, a.in[11] + (size_t)l * D, a.in[12] + (size_t)l * D, RES16_X1 ? (float*)nullptr : (float*)(a.ws + WS_X1), mb + 3 * D, mb + 4 * D, I8_WQ ? (bf16*)nullptr : (bf16*)(a.ws + WS_H2), a.ws + WS_HQ8, (float*)(a.ws + WS_HSC), lds + wave * 2304, I8_WQ ? a.ws + WS_H28 : (unsigned char*)nullptr, nullptr, RES16_X1 ? (bf16*)(a.ws + WS_X1) : (bf16*)nullptr);
    }
}

template <int N> __device__ __forceinline__ void bitonic_sort_desc(float (&v)[N]) {
#pragma unroll
    for (int k = 2; k <= N; k <<= 1)
#pragma unroll
        for (int j = k >> 1; j > 0; j >>= 1)
#pragma unroll
            for (int i = 0; i < N; ++i) { const int p = i ^ j; if (p > i) { const bool desc = ((i & k) == 0); const float x = v[i], y = v[p]; const float mx = fmaxf(x, y), mn = fminf(x, y); v[i] = desc ? mx : mn; v[p] = desc ? mn : mx; } }
}
__device__ __forceinline__ void merge_top16(float (&x)[16], const float (&y)[16]) {
#pragma unroll
    for (int i = 0; i < 16; ++i) x[i] = fmaxf(x[i], y[15 - i]);
#pragma unroll
    for (int j = 8; j > 0; j >>= 1)
#pragma unroll
        for (int i = 0; i < 16; ++i) { const int p = i ^ j; if (p > i) { const float u = x[i], w = x[p]; x[i] = fmaxf(u, w); x[p] = fminf(u, w); } }
}
__device__ __forceinline__ void ce_desc(float& ka, int& pa, float& kb, int& pb) { const bool sw = kb > ka; const float k0 = sw ? kb : ka, k1 = sw ? ka : kb; const int p0 = sw ? pb : pa, p1 = sw ? pa : pb; ka = k0; pa = p0; kb = k1; pb = p1; }
__device__ __forceinline__ void bitonic_sort_desc_kp(float (&k)[16], int (&p)[16]) {
#pragma unroll
    for (int kk = 2; kk <= 16; kk <<= 1)
#pragma unroll
        for (int j = kk >> 1; j > 0; j >>= 1)
#pragma unroll
            for (int i = 0; i < 16; ++i) { const int q = i ^ j; if (q > i) { if ((i & kk) == 0) ce_desc(k[i], p[i], k[q], p[q]); else ce_desc(k[q], p[q], k[i], p[i]); } }
}
__device__ __forceinline__ void merge_top16_kp(float (&k)[16], int (&p)[16], const float (&k2)[16], const int (&p2)[16]) {
#pragma unroll
    for (int i = 0; i < 16; ++i) { const bool sw = k2[15 - i] > k[i]; k[i] = sw ? k2[15 - i] : k[i]; p[i] = sw ? p2[15 - i] : p[i]; }
#pragma unroll
    for (int j = 8; j > 0; j >>= 1)
#pragma unroll
        for (int i = 0; i < 16; ++i) { const int q = i ^ j; if (q > i) ce_desc(k[i], p[i], k[q], p[q]); }
}
__device__ constexpr int cand_i(int s) { return s < 16 ? 0 : s < 24 ? 1 : s < 29 ? 2 : s < 33 ? 3 : s < 36 ? 4 : s < 38 ? 5 : s < 40 ? 6 : s < 42 ? 7 : s < 50 ? s - 34 : -1; }
__device__ constexpr int cand_j(int s) { return s < 16 ? s : s < 24 ? s - 16 : s < 29 ? s - 24 : s < 33 ? s - 29 : s < 36 ? s - 33 : s < 38 ? s - 36 : s < 40 ? s - 38 : s < 42 ? s - 40 : s < 50 ? 0 : -1; }

__device__ __forceinline__ void peer_retrieve(const Args& a, int l, LAS unsigned char* lds, int lane, int wave, int ch) {
    const bf16* qbuf = (const bf16*)(a.ws + WS_Q); const bf16* keys = (const bf16*)(a.ws + WS_KEYS) + ((size_t)(l * 8 + wave) * 2) * 128 * 128;
    LAS int* eg_e = (LAS int*)lds; LAS float* eg_g = (LAS float*)(lds + 32768);
    const int l31 = lane & 31, l5 = lane >> 5, h = wave, t0 = ch * 64;
    for (int tt = 0; tt < 2; ++tt) {
        float sv[2][16];
#pragma unroll
        for (int p = 0; p < 2; ++p) {
            f32x16 acc[4];
#pragma unroll
            for (int nt = 0; nt < 4; ++nt)
#pragma unroll
                for (int r = 0; r < 16; ++r) acc[nt][r] = 0.f;
            const bf16* qp = qbuf + (size_t)(t0 + 32 * tt + l31) * D + h * 256 + p * 128 + 8 * l5;
            const bf16* kp = keys + (size_t)(p * 128 + l31) * 128 + 8 * l5;
#pragma unroll 4
            for (int ks = 0; ks < 8; ++ks) { const bf16x8 bq = *(const bf16x8*)(qp + 16 * ks);
#pragma unroll
                for (int nt = 0; nt < 4; ++nt) { const bf16x8 ak = *(const bf16x8*)(kp + (size_t)(32 * nt) * 128 + 16 * ks); acc[nt] = __builtin_amdgcn_mfma_f32_32x32x16_bf16(ak, bq, acc[nt], 0, 0, 0); } }
            float v[4][16];
#pragma unroll
            for (int nt = 0; nt < 4; ++nt)
#pragma unroll
                for (int r = 0; r < 16; ++r) { const unsigned idx = 32u * nt + (r & 3) + 8u * (r >> 2) + 4u * l5; v[nt][r] = __uint_as_float((__float_as_uint(acc[nt][r]) & 0xffffff80u) | idx); }
#pragma unroll
            for (int nt = 0; nt < 4; ++nt) bitonic_sort_desc<16>(v[nt]);
            merge_top16(v[0], v[1]); merge_top16(v[2], v[3]); merge_top16(v[0], v[2]);
            float o[16];
#pragma unroll
            for (int i = 0; i < 16; ++i) o[i] = __shfl_xor(v[0][i], 32);
            merge_top16(v[0], o);
#pragma unroll
            for (int i = 0; i < 16; ++i) sv[p][i] = v[0][i];
        }
        LAS unsigned char* idxb = (LAS unsigned char*)(lds + 69632) + wave * 2048 + lane * 32;
        { v4u w0, w1;
#pragma unroll
          for (int q4 = 0; q4 < 4; ++q4) {
              w0[q4] = (__float_as_uint(sv[0][4 * q4]) & 127u) | ((__float_as_uint(sv[0][4 * q4 + 1]) & 127u) << 8) | ((__float_as_uint(sv[0][4 * q4 + 2]) & 127u) << 16) | ((__float_as_uint(sv[0][4 * q4 + 3]) & 127u) << 24);
              w1[q4] = (__float_as_uint(sv[1][4 * q4]) & 127u) | ((__float_as_uint(sv[1][4 * q4 + 1]) & 127u) << 8) | ((__float_as_uint(sv[1][4 * q4 + 2]) & 127u) << 16) | ((__float_as_uint(sv[1][4 * q4 + 3]) & 127u) << 24); }
          *(LAS v4u*)(idxb) = w0; *(LAS v4u*)(idxb + 16) = w1; }
        float ck[4][16];
#pragma unroll
        for (int s = 0; s < 64; ++s) {
            if (cand_i(s) >= 0) { const unsigned b0 = __float_as_uint(sv[0][cand_i(s) < 0 ? 0 : cand_i(s)]), b1 = __float_as_uint(sv[1][cand_j(s) < 0 ? 0 : cand_j(s)]);
                const float sum = __uint_as_float(b0 & 0xffffff80u) + __uint_as_float(b1 & 0xffffff80u);
                ck[s >> 4][s & 15] = __uint_as_float((__float_as_uint(sum) & 0xffffff00u) | (unsigned)((cand_i(s) < 0 ? 0 : cand_i(s)) * 16 + (cand_j(s) < 0 ? 0 : cand_j(s)))); }
            else ck[s >> 4][s & 15] = -3.0e38f; }
        bitonic_sort_desc<16>(ck[1]); bitonic_sort_desc<16>(ck[2]);
        merge_top16(ck[0], ck[1]); merge_top16(ck[2], ck[3]); merge_top16(ck[0], ck[2]);
        LDS_WAIT(); asm volatile("" ::: "memory");
        float ex[16]; int ce[16]; float den = 0.f;
        const float cmax = __uint_as_float(__float_as_uint(ck[0][0]) & 0xffffff00u);
#pragma unroll
        for (int i = 0; i < 16; ++i) { const unsigned bits = __float_as_uint(ck[0][i]); ex[i] = __expf(__uint_as_float(bits & 0xffffff00u) - cmax); den += ex[i];
            ce[i] = (int)idxb[(bits >> 4) & 15u] * 128 + (int)idxb[16 + (bits & 15u)]; }
        const float inv = 1.0f / den;
        if (l5 == 0) {
            const int base = (32 * tt + l31) * 128 + h * 16;
#pragma unroll
            for (int i4 = 0; i4 < 4; ++i4) { *(LAS v4u*)(eg_e + base + 4 * i4) = (v4u){(unsigned)ce[4 * i4], (unsigned)ce[4 * i4 + 1], (unsigned)ce[4 * i4 + 2], (unsigned)ce[4 * i4 + 3]};
                *(LAS f32x4*)(eg_g + base + 4 * i4) = (f32x4){ex[4 * i4] * inv, ex[4 * i4 + 1] * inv, ex[4 * i4 + 2] * inv, ex[4 * i4 + 3] * inv}; }
        }
        LDS_WAIT(); asm volatile("" ::: "memory");
    }
}

typedef unsigned char uc4 __attribute__((ext_vector_type(4)));
constexpr int NSLICE = 16, SLICE_SHIFT = 10;
__device__ __forceinline__ int sdot4i(unsigned w, unsigned x, int acc) { return __builtin_amdgcn_sdot4((int)w, (int)x, acc, false); }
__device__ __forceinline__ void fma_ub4(unsigned w, float s, float& y0, float& y1, float& y2, float& y3) { const uc4 b = __builtin_bit_cast(uc4, w); y0 += s * (float)b.x; y1 += s * (float)b.y; y2 += s * (float)b.z; y3 += s * (float)b.w; }
#if TAB4
__device__ __forceinline__ void peer_tail(const Args& a, int l, int t, int lane, const bf16* Yrow, const float* mb, const float* mbn, bool last) {
    const float* x1buf = (const float*)(a.ws + WS_X1);
    float z[32];
#pragma unroll
    for (int c8 = 0; c8 < 8; ++c8) { const int col = (c8 * 64 + lane) * 4;
        const v2u yb = *(const v2u*)(Yrow + col); const f32x4 yv = (f32x4){bflo(yb.x), bfhi(yb.x), bflo(yb.y), bfhi(yb.y)};
#if RES16_X1
        const v2u xb_ = *(const v2u*)((const bf16*)x1buf + (size_t)t * D + col); const f32x4 x0 = (f32x4){bflo(xb_.x), bfhi(xb_.x), bflo(xb_.y), bfhi(xb_.y)}, g0 = *(const f32x4*)(mb + 5 * D + col);
#else
        const f32x4 x0 = *(const f32x4*)(x1buf + (size_t)t * D + col), g0 = *(const f32x4*)(mb + 5 * D + col);
#endif
        z[c8 * 4] = ALPHA * x0.x + (1.f + g0.x) * yv.x; z[c8 * 4 + 1] = ALPHA * x0.y + (1.f + g0.y) * yv.y; z[c8 * 4 + 2] = ALPHA * x0.z + (1.f + g0.z) * yv.z; z[c8 * 4 + 3] = ALPHA * x0.w + (1.f + g0.w) * yv.w; }
    ln_tail(z, t, lane, a.in[17] + (size_t)l * D, a.in[18] + (size_t)l * D, last ? a.out : (RES16_X ? (float*)nullptr : (float*)(a.ws + WS_X)), mbn, mbn + D, (last || I8_GATE) ? (bf16*)nullptr : (bf16*)(a.ws + WS_H), nullptr, nullptr, nullptr, last ? (unsigned char*)nullptr : a.ws + WS_H8, (float*)(a.ws + WS_SAH), (RES16_X && !last) ? (bf16*)(a.ws + WS_X) : (bf16*)nullptr);
}
template <class TT, int N, int M> __device__ __forceinline__ void treduce(TT (&v)[N], int lane) {
    const bool c0 = (lane & M) != 0, c1 = (lane & (2 * M)) != 0, c2 = (lane & (4 * M)) != 0;
#pragma unroll
    for (int m = 0; m < N / 2; ++m) { const TT keep = c0 ? v[2 * m + 1] : v[2 * m], send = c0 ? v[2 * m] : v[2 * m + 1]; v[m] = keep + __shfl_xor(send, M); }
#pragma unroll
    for (int m = 0; m < N / 4; ++m) { const TT keep = c1 ? v[2 * m + 1] : v[2 * m], send = c1 ? v[2 * m] : v[2 * m + 1]; v[m] = keep + __shfl_xor(send, 2 * M); }
#pragma unroll
    for (int m = 0; m < N / 8; ++m) { const TT keep = c2 ? v[2 * m + 1] : v[2 * m], send = c2 ? v[2 * m] : v[2 * m + 1]; v[m] = keep + __shfl_xor(send, 4 * M); }
}
__device__ __forceinline__ int allsum_8_16_32(int x) {
    x += __builtin_amdgcn_update_dpp(0, x, 0x128, 0xf, 0xf, false);
    { const auto r = __builtin_amdgcn_permlane16_swap((unsigned)x, (unsigned)x, false, false); x = (int)(r[0] + r[1]); }
    { const auto r = __builtin_amdgcn_permlane32_swap((unsigned)x, (unsigned)x, false, false); x = (int)(r[0] + r[1]); }
    return x; }
__device__ __forceinline__ float allmax_8_16_32(float x) {
    x = fmaxf(x, __uint_as_float((unsigned)__builtin_amdgcn_update_dpp(0, (int)__float_as_uint(x), 0x128, 0xf, 0xf, false)));
    { const auto r = __builtin_amdgcn_permlane16_swap(__float_as_uint(x), __float_as_uint(x), false, false); x = fmaxf(__uint_as_float(r[0]), __uint_as_float(r[1])); }
    { const auto r = __builtin_amdgcn_permlane32_swap(__float_as_uint(x), __float_as_uint(x), false, false); x = fmaxf(__uint_as_float(r[0]), __uint_as_float(r[1])); }
    return x; }
__device__ __forceinline__ void treduce32x8(int (&v)[32], int lane) {
    const bool c0 = (lane & 8) != 0;
#pragma unroll
    for (int m = 0; m < 16; ++m) { const int keep = c0 ? v[2 * m + 1] : v[2 * m], send = c0 ? v[2 * m] : v[2 * m + 1]; v[m] = keep + __builtin_amdgcn_update_dpp(0, send, 0x128, 0xf, 0xf, false); }
#pragma unroll
    for (int m = 0; m < 8; ++m) { const auto r = __builtin_amdgcn_permlane16_swap((unsigned)v[2 * m], (unsigned)v[2 * m + 1], false, false); v[m] = (int)(r[0] + r[1]); }
#pragma unroll
    for (int m = 0; m < 4; ++m) { const auto r = __builtin_amdgcn_permlane32_swap((unsigned)v[2 * m], (unsigned)v[2 * m + 1], false, false); v[m] = (int)(r[0] + r[1]); }
}
__device__ __forceinline__ void tr4x4(unsigned a, unsigned b, unsigned c, unsigned d, unsigned& t0, unsigned& t1, unsigned& t2, unsigned& t3) {
    const unsigned x0 = __builtin_amdgcn_perm(b, a, 0x05010400u), x1 = __builtin_amdgcn_perm(b, a, 0x07030602u), y0 = __builtin_amdgcn_perm(d, c, 0x05010400u), y1 = __builtin_amdgcn_perm(d, c, 0x07030602u);
    t0 = __builtin_amdgcn_perm(y0, x0, 0x05040100u); t1 = __builtin_amdgcn_perm(y0, x0, 0x07060302u); t2 = __builtin_amdgcn_perm(y1, x1, 0x05040100u); t3 = __builtin_amdgcn_perm(y1, x1, 0x07060302u);
}
__device__ __forceinline__ int sdot8i(unsigned w, unsigned x, int acc) { return __builtin_amdgcn_sdot8((int)w, (int)x, acc, false); }
__device__ __forceinline__ float slot_scale(unsigned w3) { return __builtin_amdgcn_exp2f((float)(w3 >> 24) * 0.125f - 16.0f); }
__device__ __forceinline__ void peer_experts(const Args& a, int l, LAS unsigned char* lds, int lane0, int wave, int ch) {
    const float* mod = (const float*)(a.ws + WS_MOD);
    const unsigned char* ut = a.ws + WS_UT + (size_t)l * NE * 1152; const unsigned char* vt = a.ws + WS_VT + (size_t)l * NE * 1152; const unsigned char* hq8 = a.ws + WS_HQ8;
    const float* hsc = (const float*)(a.ws + WS_HSC);
    bf16* Ybuf = (bf16*)(a.ws + WS_Z);
    const LAS int* eg_e = (const LAS int*)lds; LAS float* sw = (LAS float*)(lds + 32768);
    LAS float* apart = (LAS float*)(lds + 65536);
    const int b = ch / NCH; const bool last = (l == NL - 1);
    const float* mb = mod + ((size_t)l * NB + b) * 6 * D; const float* mbn = mod + ((size_t)(last ? l : l + 1) * NB + b) * 6 * D;
    const int tlw = wave * 8;
    { const int lane = lane0;
#pragma unroll
      for (int i = 0; i < 16; ++i) apart[tlw * 128 + i * 64 + lane] = 0.f; }
    LDS_WAIT(); asm volatile("" ::: "memory");
    {
        int laneL = lane0; asm volatile("" : "+v"(laneL)); const int lane = laneL;
        const int g = lane >> 3, l7 = lane & 7;
        v4u bufA[16], bufB[16], hA0, hA1, hB0, hB1;
#define CU_LOAD(buf, h0_, h1_, idx_) do { const int u_ = (idx_) >> 3, tl_ = tlw + ((idx_) & 7); const unsigned soff_ = (unsigned)(u_ * 128 + l7 * 16); \
            const unsigned char* hp_ = hq8 + (size_t)(ch * 64 + tl_) * 2304 + (u_ * 8 + l7) * 32; h0_ = *(const v4u*)hp_; h1_ = *(const v4u*)(hp_ + 16); \
            _Pragma("unroll") for (int i_ = 0; i_ < 16; ++i_) { const unsigned e_ = (unsigned)eg_e[tl_ * 128 + 8 * i_ + g]; buf[i_] = *(const v4u*)(ut + (size_t)(e_ * 1152u + soff_)); } } while (0)
#define CU_COMP(buf, h0_, h1_, idx_) do { const int tl_ = tlw + ((idx_) & 7); float accv_[16]; \
            _Pragma("unroll") for (int i_ = 0; i_ < 16; ++i_) { int sl_ = 0, sh_ = 0; \
                _Pragma("unroll") for (int d_ = 0; d_ < 4; ++d_) { const unsigned x_ = buf[i_][d_]; sl_ = sdot8i(x_, h0_[d_], sl_); sh_ = sdot8i(x_, h1_[d_], sh_); } \
                accv_[i_] = slot_scale(buf[i_][3]) * (float)(16 * sh_ + sl_); } \
            treduce<float, 16, 1>(accv_, lane); \
            apart[tl_ * 128 + 8 * l7 + g] += accv_[0]; apart[tl_ * 128 + 8 * (8 + l7) + g] += accv_[1]; } while (0)
        CU_LOAD(bufA, hA0, hA1, 0);
        for (int idx = 0; idx < 72; idx += 2) {
            CU_LOAD(bufB, hB0, hB1, idx + 1);
            CU_COMP(bufA, hA0, hA1, idx);
            { const int nx_ = idx + 2 < 72 ? idx + 2 : 71; CU_LOAD(bufA, hA0, hA1, nx_); }
            CU_COMP(bufB, hB0, hB1, idx + 1);
        }
#undef CU_LOAD
#undef CU_COMP
        LDS_WAIT(); asm volatile("" ::: "memory");
        for (int it = 0; it < 8; ++it) { const int tl = tlw + it; const float shs = hsc[ch * 64 + tl];
            const float w0 = sw[tl * 128 + lane] * gelu_tanh_f(apart[tl * 128 + lane] * shs), w1 = sw[tl * 128 + 64 + lane] * gelu_tanh_f(apart[tl * 128 + 64 + lane] * shs);
            sw[tl * 128 + lane] = w0; sw[tl * 128 + 64 + lane] = w1; }
        LDS_WAIT(); asm volatile("" ::: "memory");
    }
    {
        int laneL = lane0; asm volatile("" : "+v"(laneL)); const int lane = laneL;
        const int g = lane >> 3, l7 = lane & 7;
        v4u bufA[16], bufB[16];
#define CV_LOAD(buf, idx_) do { const int u_ = (idx_) >> 3, tl_ = tlw + ((idx_) & 7); const unsigned soff_ = (unsigned)(u_ * 128 + l7 * 16); \
            _Pragma("unroll") for (int i_ = 0; i_ < 16; ++i_) { const unsigned e_ = (unsigned)eg_e[tl_ * 128 + 8 * i_ + g]; buf[i_] = *(const v4u*)(vt + (size_t)(e_ * 1152u + soff_)); } } while (0)
#define CV_COMP(buf, idx_) do { const int u_ = (idx_) >> 3, tl_ = tlw + ((idx_) & 7); \
            float wf_[16]; float wmx_ = 0.f; \
            _Pragma("unroll") for (int i_ = 0; i_ < 16; ++i_) { wf_[i_] = sw[tl_ * 128 + 8 * i_ + g] * slot_scale(buf[i_][3]); wmx_ = fmaxf(wmx_, fabsf(wf_[i_])); } \
            wmx_ = allmax_8_16_32(wmx_);     \
            const float winv_ = wmx_ > 0.f ? 127.0f / wmx_ : 0.f, wsc_ = wmx_ * (1.0f / 127.0f); \
              \
            unsigned wq4_[4]; int wsum_ = 0; \
            _Pragma("unroll") for (int gp_ = 0; gp_ < 4; ++gp_) { \
                const unsigned m0_ = __float_as_uint(wf_[4 * gp_] * winv_ + 12582912.0f), m1_ = __float_as_uint(wf_[4 * gp_ + 1] * winv_ + 12582912.0f), m2_ = __float_as_uint(wf_[4 * gp_ + 2] * winv_ + 12582912.0f), m3_ = __float_as_uint(wf_[4 * gp_ + 3] * winv_ + 12582912.0f); \
                wq4_[gp_] = __builtin_amdgcn_perm(__builtin_amdgcn_perm(m3_, m2_, 0x0c0c0400u), __builtin_amdgcn_perm(m1_, m0_, 0x0c0c0400u), 0x05040100u); \
                wsum_ = sdot4i(wq4_[gp_], 0x01010101u, wsum_); } \
            int yi_[32]; \
            _Pragma("unroll") for (int q_ = 0; q_ < 32; ++q_) yi_[q_] = 0; \
            _Pragma("unroll") for (int gp_ = 0; gp_ < 4; ++gp_) { \
                _Pragma("unroll") for (int d_ = 0; d_ < 4; ++d_) { const unsigned A_ = buf[4 * gp_][d_], B_ = buf[4 * gp_ + 1][d_], C_ = buf[4 * gp_ + 2][d_], D_ = buf[4 * gp_ + 3][d_]; \
                    unsigned t0_, t1_, t2_, t3_; \
                    tr4x4(A_, B_, C_, D_, t0_, t1_, t2_, t3_);     \
                      \
                    yi_[8 * d_]     = sdot4i(t0_ & 0x0f0f0f0fu, wq4_[gp_], yi_[8 * d_]);     yi_[8 * d_ + 1] = sdot4i(t0_, wq4_[gp_], yi_[8 * d_ + 1]); \
                    yi_[8 * d_ + 2] = sdot4i(t1_ & 0x0f0f0f0fu, wq4_[gp_], yi_[8 * d_ + 2]); yi_[8 * d_ + 3] = sdot4i(t1_, wq4_[gp_], yi_[8 * d_ + 3]); \
                    yi_[8 * d_ + 4] = sdot4i(t2_ & 0x0f0f0f0fu, wq4_[gp_], yi_[8 * d_ + 4]); yi_[8 * d_ + 5] = sdot4i(t2_, wq4_[gp_], yi_[8 * d_ + 5]); \
                    yi_[8 * d_ + 6] = sdot4i(t3_ & 0x0f0f0f0fu, wq4_[gp_], yi_[8 * d_ + 6]); yi_[8 * d_ + 7] = sdot4i(t3_, wq4_[gp_], yi_[8 * d_ + 7]); } } \
            _Pragma("unroll") for (int p_ = 0; p_ < 16; ++p_) yi_[2 * p_ + 1] = (yi_[2 * p_ + 1] - yi_[2 * p_]) >> 4; \
            treduce32x8(yi_, lane); \
            wsum_ = allsum_8_16_32(wsum_);     \
            float y_[4]; \
            { const int corr_ = (g & 1) ? 0 : 8 * wsum_;     \
              _Pragma("unroll") for (int q_ = 0; q_ < 4; ++q_) y_[q_] = wsc_ * (float)(yi_[q_] - corr_); } \
            { const int colb_ = u_ * 240 + l7 * 30 + g; bf16* yr_ = Ybuf + (size_t)(ch * 64 + tl_) * D + colb_; \
              _Pragma("unroll") for (int m_ = 0; m_ < 4; ++m_) if (8 * m_ + g < 30 && colb_ + 8 * m_ < D) yr_[8 * m_] = (bf16)(pk2(y_[m_], 0.f) & 0xffffu); } } while (0)
        CV_LOAD(bufA, 0);
        for (int idx = 0; idx < 72; idx += 2) {
            CV_LOAD(bufB, idx + 1);
            CV_COMP(bufA, idx);
            { const int nx_ = idx + 2 < 72 ? idx + 2 : 71; CV_LOAD(bufA, nx_); }
            CV_COMP(bufB, idx + 1);
        }
#undef CV_LOAD
#undef CV_COMP
    }
    asm volatile("s_waitcnt vmcnt(0)" ::: "memory");
    __builtin_amdgcn_fence(__ATOMIC_ACQUIRE, "agent");
    asm volatile("s_waitcnt vmcnt(0)" ::: "memory");
    for (int it = 0; it < 8; ++it) { int laneT = lane0; asm volatile("" : "+v"(laneT)); const int t = ch * 64 + tlw + it;
        peer_tail(a, l, t, laneT, Ybuf + (size_t)t * D, mb, mbn, last); }
}
#else
__device__ __forceinline__ void peer_tail(const Args& a, int l, int t, int lane, const float* Yrow, const float* mb, const float* mbn, bool last) {
    const float* x1buf = (const float*)(a.ws + WS_X1);
    float z[32];
#pragma unroll
    for (int c = 0; c < 2; ++c)
#pragma unroll
        for (int k = 0; k < 4; ++k) { const int c8 = 4 * c + k, col = (c8 * 64 + lane) * 4;
            const v2u yb = *(const v2u*)((const bf16*)Yrow + (c * 64 + lane) * 16 + 4 * k); const f32x4 yv = (f32x4){bflo(yb.x), bfhi(yb.x), bflo(yb.y), bfhi(yb.y)};
#if RES16_X1
            const v2u xb_ = *(const v2u*)((const bf16*)x1buf + (size_t)t * D + col); const f32x4 x0 = (f32x4){bflo(xb_.x), bfhi(xb_.x), bflo(xb_.y), bfhi(xb_.y)}, g0 = *(const f32x4*)(mb + 5 * D + col);
#else
            const f32x4 x0 = *(const f32x4*)(x1buf + (size_t)t * D + col), g0 = *(const f32x4*)(mb + 5 * D + col);
#endif
            z[c8 * 4] = ALPHA * x0.x + (1.f + g0.x) * yv.x; z[c8 * 4 + 1] = ALPHA * x0.y + (1.f + g0.y) * yv.y; z[c8 * 4 + 2] = ALPHA * x0.z + (1.f + g0.z) * yv.z; z[c8 * 4 + 3] = ALPHA * x0.w + (1.f + g0.w) * yv.w; }
    ln_tail(z, t, lane, a.in[17] + (size_t)l * D, a.in[18] + (size_t)l * D, last ? a.out : (RES16_X ? (float*)nullptr : (float*)(a.ws + WS_X)), mbn, mbn + D, (last || I8_GATE) ? (bf16*)nullptr : (bf16*)(a.ws + WS_H), nullptr, nullptr, nullptr, last ? (unsigned char*)nullptr : a.ws + WS_H8, (float*)(a.ws + WS_SAH), (RES16_X && !last) ? (bf16*)(a.ws + WS_X) : (bf16*)nullptr);
}
template <class TT, int M> __device__ __forceinline__ void treduce16(TT (&v)[16], int lane) {
    const bool c0 = (lane & M) != 0, c1 = (lane & (2 * M)) != 0, c2 = (lane & (4 * M)) != 0;
#pragma unroll
    for (int m = 0; m < 8; ++m) { const TT keep = c0 ? v[2 * m + 1] : v[2 * m], send = c0 ? v[2 * m] : v[2 * m + 1]; v[m] = keep + __shfl_xor(send, M); }
#pragma unroll
    for (int m = 0; m < 4; ++m) { const TT keep = c1 ? v[2 * m + 1] : v[2 * m], send = c1 ? v[2 * m] : v[2 * m + 1]; v[m] = keep + __shfl_xor(send, 2 * M); }
#pragma unroll
    for (int m = 0; m < 2; ++m) { const TT keep = c2 ? v[2 * m + 1] : v[2 * m], send = c2 ? v[2 * m] : v[2 * m + 1]; v[m] = keep + __shfl_xor(send, 4 * M); }
}
__device__ __forceinline__ void peer_experts(const Args& a, int l, LAS unsigned char* lds, int lane0, int wave, int ch) {
    const float* mod = (const float*)(a.ws + WS_MOD);
    const unsigned char* ut = a.ws + WS_UT + (size_t)l * NE * D; const unsigned char* vt = a.ws + WS_VT + (size_t)l * NE * D; const unsigned char* hq8 = a.ws + WS_HQ8;
    const float* su = (const float*)(a.ws + WS_SU) + (size_t)l * NE; const float* sv = (const float*)(a.ws + WS_SV) + (size_t)l * NE; const float* hsc = (const float*)(a.ws + WS_HSC);
    float* Ybuf = (float*)(a.ws + WS_Z);
    const LAS int* eg_e = (const LAS int*)lds; LAS float* sw = (LAS float*)(lds + 32768);
    LAS int* apart = (LAS int*)(lds + 65536); LAS float* wtotl = (LAS float*)(lds + LDSCTL_OFF + 256);
    const int b = ch / NCH; const bool last = (l == NL - 1);
    const float* mb = mod + ((size_t)l * NB + b) * 6 * D; const float* mbn = mod + ((size_t)(last ? l : l + 1) * NB + b) * 6 * D;
    const int tlw = wave * 8;
    { const int lane = lane0;
#pragma unroll
      for (int i = 0; i < 16; ++i) apart[tlw * 128 + i * 64 + lane] = 0; }
    LDS_WAIT(); asm volatile("" ::: "memory");
    {
        int laneL = lane0; asm volatile("" : "+v"(laneL)); const int lane = laneL;
        const int g = lane >> 3, l7 = lane & 7;
        v4u bufA[16], bufB[16], hA, hB;
#define CU_LOAD(buf, hh_, idx_) do { const int cs_ = (idx_) >> 3, tl_ = tlw + ((idx_) & 7); const unsigned coff_ = (unsigned)(cs_ * 128 + l7 * 16); \
            hh_ = *(const v4u*)(hq8 + (size_t)(ch * 64 + tl_) * D + coff_); \
            _Pragma("unroll") for (int i_ = 0; i_ < 16; ++i_) { const unsigned e_ = (unsigned)eg_e[tl_ * 128 + 8 * i_ + g]; buf[i_] = *(const v4u*)(ut + (size_t)(e_ * 2048u + coff_)); } } while (0)
#define CU_COMP(buf, hh_, idx_) do { const int tl_ = tlw + ((idx_) & 7); int acc_[16]; \
            _Pragma("unroll") for (int i_ = 0; i_ < 16; ++i_) { int s_ = 0; _Pragma("unroll") for (int q_ = 0; q_ < 4; ++q_) s_ = sdot4i(buf[i_][q_], hh_[q_], s_); acc_[i_] = s_; } \
            treduce16<int, 1>(acc_, lane); \
            apart[tl_ * 128 + 8 * l7 + g] += acc_[0]; apart[tl_ * 128 + 8 * (8 + l7) + g] += acc_[1]; } while (0)
        CU_LOAD(bufA, hA, 0);
        for (int idx = 0; idx < 128; idx += 2) {
            CU_LOAD(bufB, hB, idx + 1);
            CU_COMP(bufA, hA, idx);
            if (idx + 2 < 128) CU_LOAD(bufA, hA, idx + 2);
            CU_COMP(bufB, hB, idx + 1);
        }
#undef CU_LOAD
#undef CU_COMP
        LDS_WAIT(); asm volatile("" ::: "memory");
        for (int it = 0; it < 8; ++it) { const int tl = tlw + it; const float shs = hsc[ch * 64 + tl];
            const int e0 = eg_e[tl * 128 + lane], e1 = eg_e[tl * 128 + 64 + lane];
            const float w0 = sw[tl * 128 + lane] * gelu_tanh_f((float)apart[tl * 128 + lane] * su[e0] * shs) * sv[e0];
            const float w1 = sw[tl * 128 + 64 + lane] * gelu_tanh_f((float)apart[tl * 128 + 64 + lane] * su[e1] * shs) * sv[e1];
            sw[tl * 128 + lane] = w0; sw[tl * 128 + 64 + lane] = w1;
            const float ws = wave_sum(w0 + w1);
            if (lane == 0) wtotl[tl] = ws; }
        LDS_WAIT(); asm volatile("" ::: "memory");
    }
    {
        int laneL = lane0; asm volatile("" : "+v"(laneL)); const int lane = laneL;
        const int g = lane >> 3, l7 = lane & 7;
        v4u bufA[16], bufB[16];
#define CV_LOAD(buf, idx_) do { const int cs_ = (idx_) >> 3, tl_ = tlw + ((idx_) & 7); const unsigned coff_ = (unsigned)(cs_ * 128 + l7 * 16); \
            _Pragma("unroll") for (int i_ = 0; i_ < 16; ++i_) { const unsigned e_ = (unsigned)eg_e[tl_ * 128 + 8 * i_ + g]; buf[i_] = *(const v4u*)(vt + (size_t)(e_ * 2048u + coff_)); } } while (0)
#define CV_COMP(buf, idx_) do { const int cs_ = (idx_) >> 3, tl_ = tlw + ((idx_) & 7); float y_[16]; \
            _Pragma("unroll") for (int q_ = 0; q_ < 16; ++q_) y_[q_] = 0.f; \
            _Pragma("unroll") for (int i_ = 0; i_ < 16; ++i_) { const float wr_ = sw[tl_ * 128 + 8 * i_ + g]; \
                _Pragma("unroll") for (int q_ = 0; q_ < 4; ++q_) fma_ub4(buf[i_][q_], wr_, y_[4 * q_], y_[4 * q_ + 1], y_[4 * q_ + 2], y_[4 * q_ + 3]); } \
            treduce16<float, 8>(y_, lane); \
            const float woff_ = 128.0f * wtotl[tl_]; bf16* yr_ = (bf16*)Ybuf + (size_t)(ch * 64 + tl_) * D + cs_ * 128 + l7 * 16 + g; \
            yr_[0] = (bf16)(pk2(y_[0] - woff_, 0.f) & 0xffffu); yr_[8] = (bf16)(pk2(y_[1] - woff_, 0.f) & 0xffffu); } while (0)
        CV_LOAD(bufA, 0);
        for (int idx = 0; idx < 128; idx += 2) {
            CV_LOAD(bufB, idx + 1);
            CV_COMP(bufA, idx);
            if (idx + 2 < 128) CV_LOAD(bufA, idx + 2);
            CV_COMP(bufB, idx + 1);
        }
#undef CV_LOAD
#undef CV_COMP
    }
    asm volatile("s_waitcnt vmcnt(0)" ::: "memory");
    __builtin_amdgcn_fence(__ATOMIC_ACQUIRE, "agent");
    asm volatile("s_waitcnt vmcnt(0)" ::: "memory");
    for (int it = 0; it < 8; ++it) { int laneT = lane0; asm volatile("" : "+v"(laneT)); const int t = ch * 64 + tlw + it;
        peer_tail(a, l, t, laneT, (const float*)((const bf16*)Ybuf + (size_t)t * D), mb, mbn, last); }
}

#endif

#ifndef MK_PER_PHASE
#define MK_PER_PHASE 0
#endif
__global__ void __launch_bounds__(NTHREADS, 2) mk_fwd(Args a) {
    extern __shared__ __attribute__((aligned(16))) unsigned char lds_raw[];
    LAS unsigned char* lds = (LAS unsigned char*)lds_raw;
    const int tid = threadIdx.x, lane = tid & 63, wave = __builtin_amdgcn_readfirstlane(tid >> 6), G = gridDim.x, bx = blockIdx.x;
    if (tid < 64) ((LAS unsigned*)(lds + LDSCTL_OFF))[tid] = 0u;
    __syncthreads();
    unsigned* ctl = (unsigned*)(a.ws + WS_CTL);
    XcdBarrier bar; bar.bar = ctl + CW_BAR; bar.x = 0; bar.st = nullptr;
    const bool use_bar = (a.ph_hi - a.ph_lo) > 1;
    if (use_bar) bar = xcd_barrier_post(ctl + CW_BAR, (volatile LAS unsigned*)(lds + LDSCTL_OFF));
    const int lo = a.ph_lo, hi = a.ph_hi;
#ifndef PH_MASK
#define PH_MASK 0x1ff
#endif
#define IN(k) (lo <= (k) && (k) < hi)
#define EN(b) ((PH_MASK >> (b)) & 1)
#ifndef REP_MASK
#define REP_MASK 0
#endif
#ifndef REP_EXTRA
#define REP_EXTRA 2
#endif
#define REPS(b) (1 + ((REP_MASK >> (b)) & 1) * REP_EXTRA)
#define REP_BEGIN(b) for (int rep_ = 0; rep_ < REPS(b); ++rep_) {
#define REP_END(b) if (rep_ + 1 < REPS(b)) xcd_barrier(bar); }
#define SEAM(k) do { if (IN((k) + 1)) xcd_barrier(bar); } while (0)
#define PHASE_IDS() int tidp = tid; asm volatile("" : "+v"(tidp)); const int lanep = tidp & 63, wavep = __builtin_amdgcn_readfirstlane(tidp >> 6); (void)lanep; (void)wavep
    if (EN(0) && IN(0)) { REP_BEGIN(0) PHASE_IDS(); ph_prologue_a(a, lds, tidp, lanep, wavep, bx, G); REP_END(0) SEAM(0); }
    if (EN(1) && IN(1)) { REP_BEGIN(1) PHASE_IDS(); ph_prologue_b(a, lds, tidp, lanep, wavep, bx, G); REP_END(1) SEAM(1); }
    for (int l = 0; l < NL; ++l) {
        const int pb = 2 + 7 * l;
        const float* mod = (const float*)(a.ws + WS_MOD);
        if (EN(2) && IN(pb + 0)) {
            REP_BEGIN(2) PHASE_IDS();
#if I8_IN
            pg8::Gemm g{(const pg8::bf16_t*)(a.ws + WS_H8), (const pg8::bf16_t*)(a.ws + WS_WIN8 + (size_t)l * NP * D), T, NP, D / 2}; pg8::StaticOrder S; S.init(T, NP, G, bx, WGM_IN, KROT(bx));
            pg8::EpiBf16PS E{(pg8::bf16_t*)(a.ws + WS_PROJ), NP, (const float*)(a.ws + WS_SAH), (const float*)(a.ws + WS_SB) + l * SBL};
            pg8::gemm_phase<pg8::EpiBf16PS, pg8::StaticOrder, true, true, true>(lds + RING_OFF, g, S, E, tidp);
#else
            pg8::Gemm g{(const pg8::bf16_t*)(a.ws + WS_H), (const pg8::bf16_t*)(a.ws + WS_WIN) + (size_t)l * INW * D, T, NP, D}; pg8::StaticOrder S; S.init(T, NP, G, bx, WGM_IN, KROT(bx));
            pg8::EpiBf16P E{(pg8::bf16_t*)(a.ws + WS_PROJ), NP};
            pg8::gemm_phase<pg8::EpiBf16P, pg8::StaticOrder, true, true>(lds + RING_OFF, g, S, E, tidp);
#endif
#ifndef GP_REP
#define GP_REP 1
#endif
            for (int gpr_ = 0; gpr_ < GP_REP; ++gpr_) for (int ch = bx; ch < NCHUNK; ch += G) gate_prep(a, l, lds, tidp, lanep, wavep, ch);
            REP_END(2) SEAM(pb + 0);
        }
        if (EN(3) && IN(pb + 1)) { REP_BEGIN(3) PHASE_IDS(); for (int un = bx; un < 256; un += G) gla_unit(a, lds, tidp, lanep, wavep, un); REP_END(3) SEAM(pb + 1); }
        if (EN(4) && IN(pb + 2)) { REP_BEGIN(4) PHASE_IDS(); for (int ch = bx; ch < NCHUNK; ch += G) mixpost_chunk(a, l, lanep, wavep, ch); REP_END(4) SEAM(pb + 2); }
        if (EN(5) && IN(pb + 3)) {
            REP_BEGIN(5) PHASE_IDS();
#if I8_OUT
            pg8::Gemm g{(const pg8::bf16_t*)(a.ws + WS_Y8), (const pg8::bf16_t*)(a.ws + WS_WOUT8 + (size_t)l * D * D), T, D, D / 2}; pg8::StaticOrder S; S.init(T, D, G, bx, WGM_OUT, KROT(bx));
#if RES16_X || RES16_Z
            pg8::EpiResidS16<(RES16_X != 0), (RES16_Z != 0)> E{(void*)(a.ws + WS_Z), (RES16_X || l > 0) ? (const void*)(a.ws + WS_X) : (const void*)a.in[0], mod + (size_t)l * NB * 6 * D + 2 * D, (const float*)(a.ws + WS_SAY), (const float*)(a.ws + WS_SB) + l * SBL + NP, ALPHA};
            pg8::gemm_phase<pg8::EpiResidS16<(RES16_X != 0), (RES16_Z != 0)>, pg8::StaticOrder, true, true, true>(lds + RING_OFF, g, S, E, tidp);
#else
            pg8::EpiResidS E{(float*)(a.ws + WS_Z), l == 0 ? a.in[0] : (const float*)(a.ws + WS_X), mod + (size_t)l * NB * 6 * D + 2 * D, (const float*)(a.ws + WS_SAY), (const float*)(a.ws + WS_SB) + l * SBL + NP, ALPHA};
            pg8::gemm_phase<pg8::EpiResidS, pg8::StaticOrder, true, true, true>(lds + RING_OFF, g, S, E, tidp);
#endif
#else
            pg8::Gemm g{(const pg8::bf16_t*)(a.ws + WS_Y), (const pg8::bf16_t*)(a.ws + WS_WOUT) + (size_t)l * D * D, T, D, D}; pg8::StaticOrder S; S.init(T, D, G, bx, WGM_OUT, KROT(bx));
            pg8::EpiResid E{(float*)(a.ws + WS_Z), l == 0 ? a.in[0] : (const float*)(a.ws + WS_X), mod + (size_t)l * NB * 6 * D + 2 * D, ALPHA};
            pg8::gemm_phase<pg8::EpiResid, pg8::StaticOrder, true, true>(lds + RING_OFF, g, S, E, tidp);
#endif
            REP_END(5) SEAM(pb + 3);
        }
        if (EN(6) && IN(pb + 4)) { REP_BEGIN(6) PHASE_IDS(); for (int ch = bx; ch < NCHUNK; ch += G) ln1_chunk(a, l, lds, lanep, wavep, ch); REP_END(6) SEAM(pb + 4); }
        if (EN(7) && IN(pb + 5)) {
            REP_BEGIN(7) PHASE_IDS();
#if I8_WQ
            pg8::Gemm g{(const pg8::bf16_t*)(a.ws + WS_H28), (const pg8::bf16_t*)(a.ws + WS_WQ8 + (size_t)l * D * D), T, D, D / 2}; pg8::StaticOrder S; S.init(T, D, G, bx, WGM_WQ, KROT(bx));
            pg8::EpiBf16PS E{(pg8::bf16_t*)(a.ws + WS_Q), D, (const float*)(a.ws + WS_HSC), (const float*)(a.ws + WS_SB) + l * SBL + NP + D};
            pg8::gemm_phase<pg8::EpiBf16PS, pg8::StaticOrder, true, true, true>(lds + RING_OFF, g, S, E, tidp);
#else
            pg8::Gemm g{(const pg8::bf16_t*)(a.ws + WS_H2), (const pg8::bf16_t*)(a.ws + WS_WQ) + (size_t)l * D * D, T, D, D}; pg8::StaticOrder S; S.init(T, D, G, bx, WGM_WQ, KROT(bx));
            pg8::EpiBf16P E{(pg8::bf16_t*)(a.ws + WS_Q), D};
            pg8::gemm_phase<pg8::EpiBf16P, pg8::StaticOrder, true, true>(lds + RING_OFF, g, S, E, tidp);
#endif
            REP_END(7) SEAM(pb + 5);
        }
#ifndef PEER_DBG
#define PEER_DBG 0
#endif
#ifndef PE_REP_R
#define PE_REP_R 1
#endif
#ifndef L2PROBE
#define L2PROBE 0
#endif
        if (EN(8) && IN(pb + 6)) {
            REP_BEGIN(8)
            for (int ch = bx; ch < NCHUNK; ch += G) { for (int repr_ = 0; repr_ < PE_REP_R; ++repr_) { PHASE_IDS(); peer_retrieve(a, l, lds, lanep, wavep, ch); __syncthreads(); } __syncthreads(); { PHASE_IDS(); peer_experts(a, l, lds, lanep, wavep, ch); } __syncthreads(); }
            REP_END(8) SEAM(pb + 6);
        }
    }
#undef IN
#undef SEAM
}

extern "C" void kernel_launch(void* const* d_in, const int* in_sizes, int n_in, void* d_out, int out_size, void* d_ws, size_t ws_size, hipStream_t stream) {
    static int grid = 0;
    if (grid == 0) {
        if (n_in != 19 || in_sizes[0] != T * D || out_size != T * D || ws_size < WS_END) { fprintf(stderr, "kernel_launch: unexpected shapes / workspace (%d inputs, ws %zu); nothing launched\n", n_in, ws_size); grid = -1; return; }
        int dev = 0, cus = 0, per_cu = 0;
        if (hipGetDevice(&dev) != hipSuccess || hipDeviceGetAttribute(&cus, hipDeviceAttributeMultiprocessorCount, dev) != hipSuccess) { grid = -1; return; }
        if (hipFuncSetAttribute((const void*)mk_fwd, hipFuncAttributeMaxDynamicSharedMemorySize, LDS_BYTES) != hipSuccess) { fprintf(stderr, "kernel_launch: hipFuncSetAttribute failed\n"); grid = -1; return; }
        if (hipOccupancyMaxActiveBlocksPerMultiprocessor(&per_cu, (const void*)mk_fwd, NTHREADS, LDS_BYTES) != hipSuccess || per_cu < 1) fprintf(stderr, "kernel_launch: occupancy query reports %d\n", per_cu);
        (void)hipGetLastError();
        grid = cus;
    }
    if (grid < 0) return;
    if (hipMemsetAsync((char*)d_ws + WS_CTL, 0, CTL_ZERO_BYTES, stream) != hipSuccess) return;
    Args a{};
    for (int i = 0; i < 19; ++i) a.in[i] = (const float*)d_in[i];
    a.out = (float*)d_out; a.ws = (unsigned char*)d_ws;
#if MK_PER_PHASE
    for (int p = 0; p < NPHASES; ++p) { a.ph_lo = p; a.ph_hi = p + 1; hipLaunchKernelGGL(mk_fwd, dim3(grid), dim3(NTHREADS), LDS_BYTES, stream, a); }
#else
    a.ph_lo = 0; a.ph_hi = NPHASES;
    hipLaunchKernelGGL(mk_fwd, dim3(grid), dim3(NTHREADS), LDS_BYTES, stream, a);
#endif
}
```

```cpp
#include <hip/hip_runtime.h>
#include <cstdio>
#include <cstdint>
namespace pg8 {
#define PG8_LAS __attribute__((address_space(3)))
typedef unsigned short bf16_t;
typedef short bf16x8 __attribute__((ext_vector_type(8)));
typedef float f32x4 __attribute__((ext_vector_type(4)));
typedef unsigned u32x4 __attribute__((ext_vector_type(4)));
typedef int i32x4 __attribute__((ext_vector_type(4)));
constexpr int BM = 256, BK = 64, HALF = 128, HTB = HALF * BK * 2  , STAGE_BYTES = 8 * HTB, NXCD = 8, WGM = 8;

__host__ __device__ __forceinline__ int lds_byte(int r, int c) { const int st = (r >> 4) * 2 + (c >> 5), rr = r & 15, cc = c & 31, ob = rr * 64 + cc * 2; return st * 1024 + (ob ^ (((ob >> 9) & 1) << 5)); }
__host__ __device__ __forceinline__ void stage_rc(int b, int& R, int& C) { const int st = b / 1024, sb = b % 1024, swz = sb ^ (((sb >> 9) & 1) << 5); R = (st >> 1) * 16 + swz / 64; C = (st & 1) * 32 + (swz % 64) / 2; }
__host__ __device__ __forceinline__ int perm32(int rho) { const int n = rho >> 4, i = rho & 15; return 8 * (i >> 2) + 4 * n + (i & 3); }

struct Unit { int pm, pn; };
struct Gemm { const bf16_t* A; const bf16_t* Bt; int M, N, K; };

struct StaticOrder {
    int nM, nN, nwg, G, c, wgm, krot;
    __host__ __device__ void init(int M, int N, int G_, int c_, int wgm_ = WGM, int krot_ = 0) { nM = M / BM; nN = N / BM; nwg = nM * nN; G = G_; c = c_; wgm = wgm_; krot = krot_; }
    __host__ __device__ bool next(int i, Unit& u) const {
        const long L = (long)i * G + c; if (L >= nwg) return false;
        int wgid = (int)L; { const int q = nwg / NXCD, r = nwg % NXCD, xcd = wgid % NXCD, off = wgid / NXCD; wgid = (xcd < r ? xcd * (q + 1) : r * (q + 1) + (xcd - r) * q) + off; }
        const int nig = wgm * nN, gid = wgid / nig, fm = gid * wgm, gsz = (nM - fm) < wgm ? (nM - fm) : wgm;
        u.pm = fm + ((wgid % nig) % gsz); u.pn = (wgid % nig) / gsz; return true;
    }
    __device__ __forceinline__ void a_ready(const Unit&) const {}
    __device__ __forceinline__ void done(const Unit&) const {}
};
typedef __bf16 bf16x2_t __attribute__((ext_vector_type(2)));
__device__ __forceinline__ unsigned cvt_pk_bf16(float lo, float hi) { bf16x2_t r; r.x = (__bf16)lo; r.y = (__bf16)hi; return __builtin_bit_cast(unsigned, r); }
struct EpiBf16P {
    static constexpr bool PERM = true, AFTER_DRAIN = false;
    bf16_t* O; int ldc;
    __device__ __forceinline__ void operator()(const f32x4 (&acc)[2][2][4][2], const Unit& u, int wr, int wc, int fr, int fq) const {
        const int row0 = u.pm * BM + wr * 64 + fr, col0 = u.pn * BM + wc * 32 + 8 * fq;
#pragma unroll
        for (int ai = 0; ai < 2; ++ai)
#pragma unroll
            for (int m = 0; m < 4; ++m) { bf16_t* rowp = O + (size_t)(row0 + ai * HALF + m * 16) * ldc + col0;
#pragma unroll
                for (int bj = 0; bj < 2; ++bj) { const f32x4 v0 = acc[ai][bj][m][0], v1 = acc[ai][bj][m][1];
                    u32x4 w; w.x = cvt_pk_bf16(v0[0], v0[1]); w.y = cvt_pk_bf16(v0[2], v0[3]); w.z = cvt_pk_bf16(v1[0], v1[1]); w.w = cvt_pk_bf16(v1[2], v1[3]);
                    *(u32x4*)(rowp + bj * HALF) = w; } }
    }
};
struct EpiResid {
    static constexpr bool PERM = false, AFTER_DRAIN = false;
    float* Z; const float* X; const float* gate; float alpha;
    __device__ __forceinline__ void operator()(const f32x4 (&acc)[2][2][4][2], const Unit& u, int wr, int wc, int fr, int fq) const {
        const int row0 = u.pm * BM + wr * 64 + fr, col0 = u.pn * BM + wc * 32 + 4 * fq;
        const float* gb = gate + (size_t)(u.pm >> 3) * (6 * 2048) + col0;
        f32x4 gv[2][2];
#pragma unroll
        for (int bj = 0; bj < 2; ++bj)
#pragma unroll
            for (int n = 0; n < 2; ++n) gv[bj][n] = *(const f32x4*)(gb + bj * HALF + n * 16) + 1.0f;
#pragma unroll
        for (int ai = 0; ai < 2; ++ai)
#pragma unroll
            for (int m = 0; m < 4; ++m) { const size_t off = (size_t)(row0 + ai * HALF + m * 16) * 2048 + col0;
#pragma unroll
                for (int bj = 0; bj < 2; ++bj)
#pragma unroll
                    for (int n = 0; n < 2; ++n) { const f32x4 xv = *(const f32x4*)(X + off + bj * HALF + n * 16);
                        *(f32x4*)(Z + off + bj * HALF + n * 16) = xv * alpha + gv[bj][n] * acc[ai][bj][m][n]; }
                asm volatile("" ::: "memory"); }
    }
};
#ifndef PG8_NT
#define PG8_NT 0
#endif
#if PG8_NT
#define PG8_ST(TY, p, v) __builtin_nontemporal_store((v), (TY*)(p))
#else
#define PG8_ST(TY, p, v) (*(TY*)(p) = (v))
#endif
__device__ __forceinline__ f32x4 acc_i2f(const f32x4 v) { const i32x4 iv = __builtin_bit_cast(i32x4, v); return __builtin_convertvector(iv, f32x4); }
struct EpiBf16PS {
    static constexpr bool PERM = true, AFTER_DRAIN = false;
    bf16_t* O; int ldc; const float* sa; const float* sb;
    __device__ __forceinline__ void operator()(const f32x4 (&acc)[2][2][4][2], const Unit& u, int wr, int wc, int fr, int fq) const {
        const int row0 = u.pm * BM + wr * 64 + fr, col0 = u.pn * BM + wc * 32 + 8 * fq;
        f32x4 sbv[2][2];
#pragma unroll
        for (int bj = 0; bj < 2; ++bj)
#pragma unroll
            for (int n = 0; n < 2; ++n) sbv[bj][n] = *(const f32x4*)(sb + col0 + bj * HALF + 4 * n);
#pragma unroll
        for (int ai = 0; ai < 2; ++ai)
#pragma unroll
            for (int m = 0; m < 4; ++m) { const int row = row0 + ai * HALF + m * 16; bf16_t* rowp = O + (size_t)row * ldc + col0; const float sar = sa[row];
#pragma unroll
                for (int bj = 0; bj < 2; ++bj) { const f32x4 v0 = acc_i2f(acc[ai][bj][m][0]) * (sbv[bj][0] * sar), v1 = acc_i2f(acc[ai][bj][m][1]) * (sbv[bj][1] * sar);
                    u32x4 w; w.x = cvt_pk_bf16(v0[0], v0[1]); w.y = cvt_pk_bf16(v0[2], v0[3]); w.z = cvt_pk_bf16(v1[0], v1[1]); w.w = cvt_pk_bf16(v1[2], v1[3]);
                    PG8_ST(u32x4, rowp + bj * HALF, w); } }
    }
};
struct EpiResidS {
    static constexpr bool PERM = false, AFTER_DRAIN = false;
    float* Z; const float* X; const float* gate; const float* sa; const float* sb; float alpha;
    __device__ __forceinline__ void operator()(const f32x4 (&acc)[2][2][4][2], const Unit& u, int wr, int wc, int fr, int fq) const {
        const int row0 = u.pm * BM + wr * 64 + fr, col0 = u.pn * BM + wc * 32 + 4 * fq;
        const float* gb = gate + (size_t)(u.pm >> 3) * (6 * 2048) + col0;
        f32x4 gv[2][2];
#pragma unroll
        for (int bj = 0; bj < 2; ++bj)
#pragma unroll
            for (int n = 0; n < 2; ++n) gv[bj][n] = (*(const f32x4*)(gb + bj * HALF + n * 16) + 1.0f) * *(const f32x4*)(sb + col0 + bj * HALF + n * 16);
#pragma unroll
        for (int ai = 0; ai < 2; ++ai)
#pragma unroll
            for (int m = 0; m < 4; ++m) { const int row = row0 + ai * HALF + m * 16; const size_t off = (size_t)row * 2048 + col0; const float sar = sa[row];
#pragma unroll
                for (int bj = 0; bj < 2; ++bj)
#pragma unroll
                    for (int n = 0; n < 2; ++n) { const f32x4 xv = *(const f32x4*)(X + off + bj * HALF + n * 16);
                        PG8_ST(f32x4, Z + off + bj * HALF + n * 16, xv * alpha + (gv[bj][n] * sar) * acc_i2f(acc[ai][bj][m][n])); }
                asm volatile("" ::: "memory"); }
    }
};
template <bool XB, bool ZB> struct EpiResidS16 {
    static constexpr bool PERM = true, AFTER_DRAIN = false;
    void* Z; const void* X; const float* gate; const float* sa; const float* sb; float alpha;
    __device__ __forceinline__ void operator()(const f32x4 (&acc)[2][2][4][2], const Unit& u, int wr, int wc, int fr, int fq) const {
        const int row0 = u.pm * BM + wr * 64 + fr, col0 = u.pn * BM + wc * 32 + 8 * fq;
        const float* gb = gate + (size_t)(u.pm >> 3) * (6 * 2048) + col0;
        f32x4 gv[2][2];
#pragma unroll
        for (int bj = 0; bj < 2; ++bj)
#pragma unroll
            for (int n = 0; n < 2; ++n) gv[bj][n] = (*(const f32x4*)(gb + bj * HALF + 4 * n) + 1.0f) * *(const f32x4*)(sb + col0 + bj * HALF + 4 * n);
#pragma unroll
        for (int ai = 0; ai < 2; ++ai)
#pragma unroll
            for (int m = 0; m < 4; ++m) { const int row = row0 + ai * HALF + m * 16; const size_t off = (size_t)row * 2048 + col0; const float sar = sa[row];
#pragma unroll
                for (int bj = 0; bj < 2; ++bj) { f32x4 x0, x1;
                    if constexpr (XB) { const u32x4 xw = *(const u32x4*)((const bf16_t*)X + off + bj * HALF);
                        x0 = (f32x4){__uint_as_float(xw.x << 16), __uint_as_float(xw.x & 0xffff0000u), __uint_as_float(xw.y << 16), __uint_as_float(xw.y & 0xffff0000u)};
                        x1 = (f32x4){__uint_as_float(xw.z << 16), __uint_as_float(xw.z & 0xffff0000u), __uint_as_float(xw.w << 16), __uint_as_float(xw.w & 0xffff0000u)}; }
                    else { x0 = *(const f32x4*)((const float*)X + off + bj * HALF); x1 = *(const f32x4*)((const float*)X + off + bj * HALF + 4); }
                    const f32x4 v0 = x0 * alpha + (gv[bj][0] * sar) * acc_i2f(acc[ai][bj][m][0]), v1 = x1 * alpha + (gv[bj][1] * sar) * acc_i2f(acc[ai][bj][m][1]);
                    if constexpr (ZB) { u32x4 w; w.x = cvt_pk_bf16(v0[0], v0[1]); w.y = cvt_pk_bf16(v0[2], v0[3]); w.z = cvt_pk_bf16(v1[0], v1[1]); w.w = cvt_pk_bf16(v1[2], v1[3]);
                        PG8_ST(u32x4, (bf16_t*)Z + off + bj * HALF, w); }
                    else { PG8_ST(f32x4, (float*)Z + off + bj * HALF, v0); PG8_ST(f32x4, (float*)Z + off + bj * HALF + 4, v1); } }
                asm volatile("" ::: "memory"); }
    }
};
template <class Epi, class Sched, bool ALIGN_EPI = false, bool SP2 = false, bool I8 = false>
__device__ __forceinline__ void gemm_phase(PG8_LAS unsigned char* lds, const Gemm g, const Sched& S, const Epi& E, const int tid_in) {
    const int tid = tid_in, wid = __builtin_amdgcn_readfirstlane(tid >> 6), lane = tid & 63, wr = wid >> 2, wc = wid & 3, fr = lane & 15, fq = lane >> 4;
    const int K = g.K, nt = K / BK;
    const int krot = ((nt & (nt - 1)) == 0) ? (S.krot & (nt - 1)) : 0;
#define PG8_KOFS(t) ((size_t)(((t) + krot) & (nt - 1)) * kstep)
    unsigned voffA[2], voffB[2];
#pragma unroll
    for (int i = 0; i < 2; ++i) { int R, C; stage_rc(tid * 16 + i * 8192, R, C); const int Rb = Epi::PERM ? ((R & ~31) + perm32(R & 31)) : R;
        voffA[i] = (unsigned)(R * K + C) * 2u; voffB[i] = (unsigned)(Rb * K + C) * 2u; }
    const size_t kstep = (size_t)(BK * 2);
    const size_t hstep = (size_t)HALF * K * 2;
    const size_t tstep = 2 * hstep;
    const unsigned ldsw = (unsigned)wid * 1024u;
    const int aoff = lds_byte(wr * 64 + fr, fq * 8), boff = lds_byte(wc * 32 + fr, fq * 8);
#define PG8_SA(b, h) (((b) * 2 + (h)) * HTB)
#define PG8_SB(b, h) ((4 + (b) * 2 + (h)) * HTB)
#define PG8_STAGE(bufoff, gbase, voff) do { _Pragma("unroll") for (int _i = 0; _i < 2; ++_i) \
        __builtin_amdgcn_global_load_lds((const unsigned*)((const char*)(gbase) + (voff)[_i]), (PG8_LAS unsigned*)(lds + (bufoff) + ldsw + _i * 8192), 16, 0, 0); } while (0)
#define PG8_LDA(dst, b, h) do { _Pragma("unroll") for (int m = 0; m < 4; ++m) _Pragma("unroll") for (int k = 0; k < 2; ++k) dst[m][k] = *(const PG8_LAS bf16x8*)(lds + PG8_SA(b, h) + aoff + m * 2048 + k * 1024); } while (0)
#define PG8_LDB(dst, b, h) do { _Pragma("unroll") for (int n = 0; n < 2; ++n) _Pragma("unroll") for (int k = 0; k < 2; ++k) dst[n][k] = *(const PG8_LAS bf16x8*)(lds + PG8_SB(b, h) + boff + n * 2048 + k * 1024); } while (0)
#define PG8_MMA(ai, bj, At, Bt) do { __builtin_amdgcn_s_setprio(1); _Pragma("unroll") for (int m = 0; m < 4; ++m) _Pragma("unroll") for (int n = 0; n < 2; ++n) _Pragma("unroll") for (int k = 0; k < 2; ++k) \
        { if constexpr (I8) acc[ai][bj][m][n] = __builtin_bit_cast(f32x4, __builtin_amdgcn_mfma_i32_16x16x64_i8(__builtin_bit_cast(i32x4, Bt[n][k]), __builtin_bit_cast(i32x4, At[m][k]), __builtin_bit_cast(i32x4, acc[ai][bj][m][n]), 0, 0, 0)); \
          else acc[ai][bj][m][n] = __builtin_amdgcn_mfma_f32_16x16x32_bf16(Bt[n][k], At[m][k], acc[ai][bj][m][n], 0, 0, 0); } __builtin_amdgcn_s_setprio(0); } while (0)
#define PG8_WAIT_V(n) asm volatile("s_waitcnt vmcnt(" #n ")" ::: "memory")
#define PG8_WAIT_L(n) asm volatile("s_waitcnt lgkmcnt(" #n ")" ::: "memory")
#define PG8_BAR __builtin_amdgcn_s_barrier()
#define PG8_SCHED __builtin_amdgcn_sched_barrier(0)
    Unit cur, nxt; int ui = 0;
    if (!S.next(0, cur)) return;
    f32x4 acc[2][2][4][2];
#pragma unroll
    for (int a = 0; a < 2; ++a)
#pragma unroll
        for (int b = 0; b < 2; ++b)
#pragma unroll
            for (int m = 0; m < 4; ++m)
#pragma unroll
                for (int n = 0; n < 2; ++n) acc[a][b][m][n] = (f32x4){0.f, 0.f, 0.f, 0.f};
    bf16x8 At[4][2], B0[2][2], B1[2][2];
    const char* cA = (const char*)g.A + (size_t)cur.pm * tstep; const char* cB = (const char*)g.Bt + (size_t)cur.pn * tstep;
    S.a_ready(cur);
    if constexpr (SP2) {
        PG8_STAGE(PG8_SB(0, 0), cB + PG8_KOFS(0), voffB); PG8_STAGE(PG8_SB(0, 1), cB + hstep + PG8_KOFS(0), voffB); PG8_STAGE(PG8_SA(0, 0), cA + PG8_KOFS(0), voffA); PG8_STAGE(PG8_SA(0, 1), cA + hstep + PG8_KOFS(0), voffA);
        if (wr == 1) PG8_BAR;
        PG8_WAIT_V(2); PG8_BAR;
        PG8_STAGE(PG8_SB(1, 0), cB + PG8_KOFS(1), voffB); PG8_STAGE(PG8_SA(1, 0), cA + PG8_KOFS(1), voffA); PG8_STAGE(PG8_SB(1, 1), cB + hstep + PG8_KOFS(1), voffB);
        PG8_WAIT_V(6); PG8_BAR;
    } else {
        PG8_STAGE(PG8_SB(0, 0), cB + PG8_KOFS(0), voffB); PG8_STAGE(PG8_SA(0, 0), cA + PG8_KOFS(0), voffA); PG8_STAGE(PG8_SB(0, 1), cB + hstep + PG8_KOFS(0), voffB); PG8_STAGE(PG8_SA(0, 1), cA + hstep + PG8_KOFS(0), voffA);
        if (wr == 1) PG8_BAR;
        PG8_WAIT_V(4); PG8_BAR;
        PG8_STAGE(PG8_SB(1, 0), cB + PG8_KOFS(1), voffB); PG8_STAGE(PG8_SA(1, 0), cA + PG8_KOFS(1), voffA); PG8_STAGE(PG8_SB(1, 1), cB + hstep + PG8_KOFS(1), voffB);
        PG8_WAIT_V(6); PG8_BAR;
    }
    for (;;) {
        const bool has_next = S.next(ui + 1, nxt);
        const char* nA = has_next ? (const char*)g.A + (size_t)nxt.pm * tstep : cA; const char* nB = has_next ? (const char*)g.Bt + (size_t)nxt.pn * tstep : cB;
#ifdef PG8_KREP
        for (int kr_ = 0; kr_ < PG8_KREP; ++kr_) {
        if (kr_) {
#pragma unroll
        for (int a = 0; a < 2; ++a)
#pragma unroll
            for (int b = 0; b < 2; ++b)
#pragma unroll
                for (int m = 0; m < 4; ++m)
#pragma unroll
                    for (int n = 0; n < 2; ++n) acc[a][b][m][n] = (f32x4){0.f, 0.f, 0.f, 0.f}; }
        const char* nA_ = (kr_ + 1 < PG8_KREP) ? cA : nA; const char* nB_ = (kr_ + 1 < PG8_KREP) ? cB : nB;
#else
        const char* nA_ = nA; const char* nB_ = nB;
#endif
        for (int t = 0; t < nt; t += 2) {
            const bool last = (t == nt - 2);
            const char* a1 = cA + PG8_KOFS(t + 1);
            const char* a2 = (last ? nA_ : cA) + PG8_KOFS(t + 2); const char* b2 = (last ? nB_ : cB) + PG8_KOFS(t + 2);
            const char* a3 = (last ? nA_ : cA) + PG8_KOFS(t + 3); const char* b3 = (last ? nB_ : cB) + PG8_KOFS(t + 3);
            if (last && has_next) S.a_ready(nxt);
            if constexpr (SP2) {
            PG8_LDB(B0, 0, 0); PG8_LDB(B1, 0, 1); PG8_SCHED; PG8_LDA(At, 0, 0); PG8_STAGE(PG8_SA(1, 1), a1 + hstep, voffA);
            PG8_WAIT_V(8); PG8_WAIT_L(0); PG8_BAR; PG8_MMA(0, 0, At, B0); PG8_MMA(0, 1, At, B1); PG8_BAR; PG8_SCHED;
            PG8_LDA(At, 0, 1); PG8_STAGE(PG8_SB(0, 0), b2, voffB); PG8_STAGE(PG8_SB(0, 1), b2 + hstep, voffB); PG8_STAGE(PG8_SA(0, 0), a2, voffA);
            PG8_WAIT_V(8); PG8_WAIT_L(0); PG8_BAR; PG8_MMA(1, 0, At, B0); PG8_MMA(1, 1, At, B1); PG8_BAR; PG8_SCHED;
            PG8_LDB(B0, 1, 0); PG8_LDB(B1, 1, 1); PG8_SCHED; PG8_LDA(At, 1, 0); PG8_STAGE(PG8_SA(0, 1), a2 + hstep, voffA);
            PG8_WAIT_V(8); PG8_WAIT_L(0); PG8_BAR; PG8_MMA(0, 0, At, B0); PG8_MMA(0, 1, At, B1); PG8_BAR; PG8_SCHED;
            PG8_LDA(At, 1, 1); PG8_STAGE(PG8_SB(1, 0), b3, voffB); PG8_STAGE(PG8_SB(1, 1), b3 + hstep, voffB); PG8_STAGE(PG8_SA(1, 0), a3, voffA);
            PG8_WAIT_V(8); PG8_WAIT_L(0); PG8_BAR; PG8_MMA(1, 0, At, B0); PG8_MMA(1, 1, At, B1); PG8_BAR; PG8_SCHED;
            } else {
            PG8_LDB(B0, 0, 0); PG8_SCHED; PG8_LDA(At, 0, 0); PG8_STAGE(PG8_SA(1, 1), a1 + hstep, voffA);
            PG8_WAIT_L(8); PG8_BAR; PG8_WAIT_L(0); PG8_MMA(0, 0, At, B0); PG8_BAR; PG8_SCHED;
            PG8_LDB(B1, 0, 1); PG8_STAGE(PG8_SB(0, 0), b2, voffB);
            PG8_BAR; PG8_WAIT_L(0); PG8_MMA(0, 1, At, B1); PG8_BAR;
            PG8_LDA(At, 0, 1); PG8_STAGE(PG8_SA(0, 0), a2, voffA);
            PG8_BAR; PG8_WAIT_L(0); PG8_MMA(1, 0, At, B0); PG8_BAR; PG8_SCHED;
            PG8_STAGE(PG8_SB(0, 1), b2 + hstep, voffB);
            PG8_WAIT_V(6); PG8_BAR; PG8_MMA(1, 1, At, B1); PG8_BAR;
            PG8_LDB(B0, 1, 0); PG8_SCHED; PG8_LDA(At, 1, 0); PG8_STAGE(PG8_SA(0, 1), a2 + hstep, voffA);
            PG8_WAIT_L(8); PG8_BAR; PG8_WAIT_L(0); PG8_MMA(0, 0, At, B0); PG8_BAR; PG8_SCHED;
            PG8_LDB(B1, 1, 1); PG8_STAGE(PG8_SB(1, 0), b3, voffB);
            PG8_BAR; PG8_WAIT_L(0); PG8_MMA(0, 1, At, B1); PG8_BAR;
            PG8_LDA(At, 1, 1); PG8_STAGE(PG8_SA(1, 0), a3, voffA);
            PG8_BAR; PG8_WAIT_L(0); PG8_MMA(1, 0, At, B0); PG8_BAR; PG8_SCHED;
            PG8_STAGE(PG8_SB(1, 1), b3 + hstep, voffB);
            PG8_WAIT_V(6); PG8_BAR; PG8_MMA(1, 1, At, B1); PG8_BAR;
            }
        }
#ifdef PG8_KREP
        }
#endif
        if constexpr (ALIGN_EPI) { if (wr == 0) PG8_BAR; }
#ifdef PG8_EPI2
        if constexpr (!Epi::AFTER_DRAIN) { E(acc, cur, wr, wc, fr, fq); asm volatile("" ::: "memory"); }
#endif
        if constexpr (!Epi::AFTER_DRAIN) { E(acc, cur, wr, wc, fr, fq); S.done(cur); }
        if (!has_next) break;
#pragma unroll
        for (int a = 0; a < 2; ++a)
#pragma unroll
            for (int b = 0; b < 2; ++b)
#pragma unroll
                for (int m = 0; m < 4; ++m)
#pragma unroll
                    for (int n = 0; n < 2; ++n) acc[a][b][m][n] = (f32x4){0.f, 0.f, 0.f, 0.f};
        cur = nxt; cA = nA; cB = nB; ++ui;
        if constexpr (ALIGN_EPI) { if (wr == 1) PG8_BAR; }
    }
    PG8_WAIT_V(0);
    if constexpr (!ALIGN_EPI) { if (wr == 0) PG8_BAR; }
    PG8_BAR;
    if constexpr (Epi::AFTER_DRAIN) { E.fused(acc, cur, wr, wc, fr, fq, lds, wid, lane); S.done(cur); }
#undef PG8_SA
#undef PG8_SB
#undef PG8_STAGE
#undef PG8_LDA
#undef PG8_LDB
#undef PG8_MMA
#undef PG8_WAIT_V
#undef PG8_WAIT_L
#undef PG8_BAR
#undef PG8_SCHED
#undef PG8_KOFS
}
}
#define XB_TMO      128
#define XB_XCNT(j)  (256  + 64 * (j))
#define XB_XSUB(j)  (1280 + 64 * (j))
#define XB_XGEN(j)  (2304 + 64 * (j))
#define XB_TOP      3328
#define XB_TOPGEN   3392
#define XCD_BAR_WORDS 3456
#define XB_SPIN_CAP (1u << 18)
#define LAS __attribute__((address_space(3)))

__device__ __forceinline__ unsigned xb_ld(unsigned* p)              { return __hip_atomic_load(p, __ATOMIC_RELAXED, __HIP_MEMORY_SCOPE_AGENT); }
__device__ __forceinline__ unsigned xb_add(unsigned* p, unsigned v) { return __hip_atomic_fetch_add(p, v, __ATOMIC_RELAXED, __HIP_MEMORY_SCOPE_AGENT); }
__device__ __forceinline__ unsigned xb_xcc_id() { return (unsigned)__builtin_amdgcn_s_getreg((3 << 11) | 20) & 0xFu; }
#define XB_SPIN(cond, bar) do { unsigned _sp = 0; while (cond) { __builtin_amdgcn_s_sleep(1); \
    if ((++_sp & 255u) == 0u) { if (xb_ld(&(bar)[XB_TMO])) break; if (_sp > XB_SPIN_CAP) { atomicAdd(&(bar)[XB_TMO], 1u); break; } } } } while (0)

struct XcdBarrier {
    unsigned* bar; unsigned x;
    volatile LAS unsigned* st;
};

__device__ __forceinline__ XcdBarrier xcd_barrier_post(unsigned* bar, volatile LAS unsigned* st) {
    XcdBarrier b; b.bar = bar; b.x = xb_xcc_id(); b.st = st;
    if (threadIdx.x == 0) (void)xb_add(&bar[XB_XCNT(b.x)], 1u);
    return b;
}
__device__ __forceinline__ void xcd_barrier_complete(unsigned* bar, unsigned x, unsigned& nloc, unsigned& nx) {
    const unsigned G = gridDim.x * gridDim.y * gridDim.z;
    unsigned sum, cnt, mine, sp = 0u;
    for (;;) {
        sum = 0u; cnt = 0u; mine = 0u;
#pragma unroll
        for (unsigned j = 0; j < 16; ++j) { const unsigned c = xb_ld(&bar[XB_XCNT(j)]); sum += c; cnt += (c > 0u) ? 1u : 0u; mine = (j == x) ? c : mine; }
        if (sum == G) break;
        __builtin_amdgcn_s_sleep(1);
        if ((++sp & 255u) == 0u) { if (xb_ld(&bar[XB_TMO])) break; if (sp > XB_SPIN_CAP) { atomicAdd(&bar[XB_TMO], 1u); break; } }
    }
    nloc = mine > 0u ? mine : 1u; nx = cnt > 0u ? cnt : 1u;
}

__device__ __forceinline__ void xcd_barrier(const XcdBarrier& b) {
    asm volatile("s_waitcnt vmcnt(0)" ::: "memory");
    __syncthreads();
    if (threadIdx.x == 0) {
        unsigned* bar = b.bar;
        __builtin_amdgcn_s_waitcnt(0);
        unsigned nloc = b.st[0], nx = b.st[1];
        if (nloc == 0u) { xcd_barrier_complete(bar, b.x, nloc, nx); b.st[0] = nloc; b.st[1] = nx; }
        const unsigned old = xb_add(&bar[XB_XSUB(b.x)], 1u);
        const unsigned gen = old / nloc;
        if (old + 1u == (gen + 1u) * nloc) {
            __builtin_amdgcn_fence(__ATOMIC_RELEASE, "agent");
            asm volatile("s_waitcnt vmcnt(0)" ::: "memory");
            const unsigned og = xb_add(&bar[XB_TOP], 1u);
            const unsigned tg = og / nx;
            if (og + 1u == (tg + 1u) * nx) xb_add(&bar[XB_TOPGEN], 1u);
            else XB_SPIN(xb_ld(&bar[XB_TOPGEN]) == tg, bar);
            __builtin_amdgcn_fence(__ATOMIC_ACQUIRE, "agent");
            xb_add(&bar[XB_XGEN(b.x)], 1u);
            asm volatile("s_waitcnt vmcnt(0)" ::: "memory");
        } else {
            XB_SPIN(xb_ld(&bar[XB_XGEN(b.x)]) == gen, bar);
            __builtin_amdgcn_fence(__ATOMIC_ACQUIRE, "agent");
            asm volatile("s_waitcnt vmcnt(0)" ::: "memory");
        }
    }
    __syncthreads();
}
constexpr int D = 2048, NB = 8, SEQ = 2048, NL = 4, T = NB * SEQ;
constexpr int NCH = SEQ / 64, NCHUNK = T / 64;
constexpr int GKW = 512, RANK = 16;
constexpr int INW = 6160, NP = 6144;
constexpr int NE = 16384;
constexpr float ALPHA = 1.6817928305074290f, EPS = 1e-5f;
constexpr int PQ = 0, PK = 512, PV = 1024, PR = 2048, PCB = 3072, PCC = 4096, PCH = 5120;
constexpr int NWAVES = 8, NTHREADS = 512;
#ifndef WGM_IN
#define WGM_IN 4
#endif
#ifndef WGM_OUT
#define WGM_OUT 4
#endif
#ifndef WGM_WQ
#define WGM_WQ 4
#endif
#ifndef TAB4
#define TAB4 1
#endif
constexpr int NPHASES = 2 + 7 * NL;

constexpr size_t MiB = 1u << 20;
constexpr size_t WS_CTL = 0, CTL_ZERO_BYTES = 1 * MiB;
constexpr size_t WS_MOD = 1 * MiB, WS_PART = 3 * MiB, WS_KEYS = 15 * MiB, WS_DTOT = 17 * MiB, WS_WIN = 18 * MiB, WS_WOUT = 115 * MiB, WS_WQ = 147 * MiB;
constexpr size_t WS_UT = 179 * MiB, WS_VT = 435 * MiB, WS_H = 691 * MiB, WS_PROJ = 755 * MiB, WS_E = 947 * MiB, WS_OGLA = 979 * MiB, WS_Y = 1043 * MiB;
constexpr size_t WS_Z = 1107 * MiB, WS_X1 = 1235 * MiB, WS_X = 1363 * MiB, WS_Q = 1491 * MiB, WS_H2 = 1555 * MiB, WS_HQ8 = 1619 * MiB, WS_H8 = 1659 * MiB, WS_WIN8 = 1691 * MiB, WS_WOUT8 = 1739 * MiB, WS_WQ8 = 1755 * MiB, WS_Y8 = 1771 * MiB, WS_H28 = 1803 * MiB, WS_END = 1835 * MiB;
constexpr size_t WS_SU = 17 * MiB + 512 * 1024, WS_SV = 17 * MiB + 768 * 1024, WS_HSC = 2 * MiB + 640 * 1024;
static_assert(WS_WIN + (size_t)NL * INW * D * 2 <= WS_WOUT && WS_PART + (size_t)NL * 8 * NB * 6 * D * 4 <= WS_KEYS && WS_MOD + (size_t)NL * NB * 6 * D * 4 <= WS_PART, "ws map");
constexpr size_t WS_SAH = WS_SU, WS_SAY = WS_SU + 65536, WS_SB = WS_SV; constexpr int SBL = NP + 2 * D;
constexpr size_t WS_SBA = WS_SB + (size_t)NL * SBL * 4, WS_ALR8 = WS_SU + 131072;
#ifndef KROT_A
#define KROT_A 0
#endif
#ifndef KROT_B
#define KROT_B 0
#endif
#define KROT(c) (KROT_A * (((c) >> 3) & 3) + KROT_B * ((c) >> 5))
#ifndef RES16
#define RES16 1
#endif
#ifndef RES16_X
#define RES16_X RES16
#endif
#ifndef RES16_Z
#define RES16_Z RES16
#endif
#ifndef RES16_X1
#define RES16_X1 RES16
#endif
#ifndef I8_GATE
#define I8_GATE 1
#endif
#ifndef I8_WQ
#define I8_WQ 1
#endif
#ifndef I8_IN
#define I8_IN 1
#endif
#ifndef I8_OUT
#define I8_OUT 1
#endif
constexpr int CW_BAR = 4096;

constexpr int RING_OFF = 0, RING_BYTES = 131072, LDSCTL_OFF = RING_BYTES, LDS_BYTES = 147456;

#define GAS __attribute__((address_space(1)))
typedef unsigned short bf16;
typedef unsigned v4u __attribute__((ext_vector_type(4)));
typedef unsigned v2u __attribute__((ext_vector_type(2)));
typedef int v4i __attribute__((ext_vector_type(4)));
typedef float f32x4 __attribute__((ext_vector_type(4)));
typedef float f32x16 __attribute__((ext_vector_type(16)));
typedef short bf16x8 __attribute__((ext_vector_type(8)));
typedef __bf16 bf16x2v __attribute__((ext_vector_type(2)));
#define LDS_WAIT() asm volatile("s_waitcnt lgkmcnt(0)" ::: "memory")

__device__ __forceinline__ unsigned pk2(float lo, float hi) { return pg8::cvt_pk_bf16(lo, hi); }
__device__ __forceinline__ float dot2bf(unsigned w, unsigned x, float acc) { return __builtin_amdgcn_fdot2_f32_bf16(__builtin_bit_cast(bf16x2v, w), __builtin_bit_cast(bf16x2v, x), acc, false); }
__device__ __forceinline__ float bflo(unsigned u) { return __uint_as_float(u << 16); }
__device__ __forceinline__ float bfhi(unsigned u) { return __uint_as_float(u & 0xffff0000u); }
__device__ __forceinline__ float silu_f(float x) { return x * __builtin_amdgcn_rcpf(1.0f + __expf(-x)); }
__device__ __forceinline__ float logsigmoid_f(float x) { return fminf(x, 0.0f) - log1pf(__expf(-fabsf(x))); }
__device__ __forceinline__ float logsigmoid_fast(float x) { return fminf(x, 0.0f) - __logf(1.0f + __expf(-fabsf(x))); }
__device__ __forceinline__ float gelu_tanh_f(float x) { const float u = 0.7978845608028654f * (x + 0.044715f * x * x * x); return 0.5f * x * (1.0f + tanhf(u)); }
__device__ __forceinline__ unsigned pack_i8(float a, float b, float c, float d) {
    const int q0 = (int)__builtin_rintf(a), q1 = (int)__builtin_rintf(b), q2 = (int)__builtin_rintf(c), q3 = (int)__builtin_rintf(d);
    return (unsigned)(q0 & 255) | ((unsigned)(q1 & 255) << 8) | ((unsigned)(q2 & 255) << 16) | ((unsigned)(q3 & 255) << 24); }
#define WAVE_ALLREDUCE(v, OP) do { \
    v = OP(v, __uint_as_float((unsigned)__builtin_amdgcn_update_dpp(0, (int)__float_as_uint(v), 0xB1, 0xf, 0xf, false)));      \
    v = OP(v, __uint_as_float((unsigned)__builtin_amdgcn_update_dpp(0, (int)__float_as_uint(v), 0x4E, 0xf, 0xf, false)));      \
    v = OP(v, __uint_as_float((unsigned)__builtin_amdgcn_update_dpp(0, (int)__float_as_uint(v), 0x124, 0xf, 0xf, false)));     \
    v = OP(v, __uint_as_float((unsigned)__builtin_amdgcn_update_dpp(0, (int)__float_as_uint(v), 0x128, 0xf, 0xf, false)));     \
    { const auto r_ = __builtin_amdgcn_permlane16_swap(__float_as_uint(v), __float_as_uint(v), false, false); v = OP(__uint_as_float(r_[0]), __uint_as_float(r_[1])); } \
    { const auto r_ = __builtin_amdgcn_permlane32_swap(__float_as_uint(v), __float_as_uint(v), false, false); v = OP(__uint_as_float(r_[0]), __uint_as_float(r_[1])); } } while (0)
__device__ __forceinline__ float op_add_f(float a, float b) { return a + b; }
__device__ __forceinline__ float wave_sum(float v) { WAVE_ALLREDUCE(v, op_add_f); return v; }
__device__ __forceinline__ float wave_max(float v) { WAVE_ALLREDUCE(v, fmaxf); return v; }

struct Args { const float* in[19]; float* out; unsigned char* ws; int ph_lo, ph_hi; };

__device__ __forceinline__ void transpose_item(const float* W, int ldw, int col0, bf16* WTrows, int k0, int nvalid, LAS float* scr, int lane) {
    const int n = lane & 31;
    float tv[32];
#pragma unroll
    for (int i = 0; i < 32; ++i) { const int kk = 2 * i + (lane >> 5); tv[i] = (n < nvalid) ? W[(size_t)(k0 + kk) * ldw + col0 + n] : 0.f; }
#pragma unroll
    for (int i = 0; i < 32; ++i) { const int kk = 2 * i + (lane >> 5); scr[kk * 33 + n] = tv[i]; }
    LDS_WAIT(); asm volatile("" ::: "memory");
    const int c = lane & 7;
#pragma unroll
    for (int j = 0; j < 4; ++j) { const int nn = (lane >> 3) + 8 * j; const LAS float* s = scr + (8 * c) * 33 + nn;
        v4u o; o.x = pk2(s[0 * 33], s[1 * 33]); o.y = pk2(s[2 * 33], s[3 * 33]); o.z = pk2(s[4 * 33], s[5 * 33]); o.w = pk2(s[6 * 33], s[7 * 33]);
        if (nn < nvalid) *(v4u*)(WTrows + (size_t)nn * D + k0 + 8 * c) = o; }
    LDS_WAIT(); asm volatile("" ::: "memory");
}
__device__ __forceinline__ void cvt_stream(const float* src, bf16* dst, size_t n4, size_t i0, size_t stride) {
    for (size_t i = i0; i < n4; i += stride) { const f32x4 v = ((const f32x4*)src)[i]; v2u o; o.x = pk2(v.x, v.y); o.y = pk2(v.z, v.w); ((v2u*)dst)[i] = o; }
}
__device__ __forceinline__ void ph_prologue_a(const Args& a, LAS unsigned char* lds, int tid, int lane, int wave, int bx, int G) {
    const int gw = bx * NWAVES + wave, NGW = G * NWAVES;
    LAS float* cact = (LAS float*)lds;
    for (int i = tid; i < NB * D; i += NTHREADS) { const int b = i / D, d = i % D; cact[d * 8 + b] = silu_f(a.in[1][i]); }
    __syncthreads();
    float* part = (float*)(a.ws + WS_PART);
    for (int it = gw; it < NL * 8 * 48; it += NGW) {
        const int cg = it % 48, dr = (it / 48) % 8, l = it / 384;
        f32x4 acc[8];
#pragma unroll
        for (int b = 0; b < 8; ++b) acc[b] = (f32x4){0.f, 0.f, 0.f, 0.f};
        const float* w = a.in[2] + ((size_t)l * D + dr * 256) * (6 * D) + cg * 256 + lane * 4;
#pragma unroll 4
        for (int d = 0; d < 256; ++d) {
            const f32x4 wv = *(const f32x4*)(w + (size_t)d * (6 * D));
            const f32x4 c0 = *(const LAS f32x4*)(cact + (dr * 256 + d) * 8), c1 = *(const LAS f32x4*)(cact + (dr * 256 + d) * 8 + 4);
            acc[0] += wv * c0.x; acc[1] += wv * c0.y; acc[2] += wv * c0.z; acc[3] += wv * c0.w;
            acc[4] += wv * c1.x; acc[5] += wv * c1.y; acc[6] += wv * c1.z; acc[7] += wv * c1.w;
        }
#pragma unroll
        for (int b = 0; b < 8; ++b) *(f32x4*)(part + (((size_t)l * 8 + dr) * NB + b) * (6 * D) + cg * 256 + lane * 4) = acc[b];
    }
    __syncthreads();
    LAS float* scr = (LAS float*)(lds + wave * 8448);
    bf16* winT = (bf16*)(a.ws + WS_WIN); bf16* woutT = (bf16*)(a.ws + WS_WOUT); bf16* wqT = (bf16*)(a.ws + WS_WQ);
    constexpr int IPL = 6144 + 32 + 2048 + 2048;
    for (int it = gw; it < NL * IPL; it += NGW) {
        const int l = it / IPL; int r = it % IPL;
        if (r < 6144) { const int nb = r % 192, kb = r / 192, n0 = nb * 32;
            transpose_item(a.in[4] + (size_t)l * D * INW, INW, n0 < 3072 ? n0 : n0 + 16, winT + ((size_t)l * INW + n0) * D, kb * 64, 32, scr, lane); continue; }
        r -= 6144;
        if (r < 32) { transpose_item(a.in[4] + (size_t)l * D * INW, INW, 3072, winT + ((size_t)l * INW + NP) * D, r * 64, 16, scr, lane); continue; }
        r -= 32;
        if (r < 2048) { const int nb = r % 64, kb = r / 64; transpose_item(a.in[10] + (size_t)l * D * D, D, nb * 32, woutT + ((size_t)l * D + nb * 32) * D, kb * 64, 32, scr, lane); continue; }
        r -= 2048;
        { const int nb = r % 64, kb = r / 64; transpose_item(a.in[13] + (size_t)l * D * D, D, nb * 32, wqT + ((size_t)l * D + nb * 32) * D, kb * 64, 32, scr, lane); }
    }
    const size_t i0 = (size_t)bx * NTHREADS + tid, stride = (size_t)G * NTHREADS;
    cvt_stream(a.in[14], (bf16*)(a.ws + WS_KEYS), (size_t)NL * 8 * 2 * 128 * 128 / 4, i0, stride);
#if TAB4
    __syncthreads();
    { LAS float* rowst = (LAS float*)(lds + wave * 8192);
      f32x4 vnx[8];
      if (gw < 2 * NL * NE) { const int tbl0 = gw / (NL * NE), r0 = gw % (NL * NE); const float* s0 = (tbl0 ? a.in[16] : a.in[15]) + (size_t)r0 * D;
#pragma unroll
          for (int c8 = 0; c8 < 8; ++c8) vnx[c8] = *(const f32x4*)(s0 + (c8 * 64 + lane) * 4); }
      for (int row = gw; row < 2 * NL * NE; row += NGW) {
        const int tbl = row / (NL * NE), r = row % (NL * NE);
#pragma unroll
        for (int c8 = 0; c8 < 8; ++c8) *(LAS f32x4*)(rowst + (c8 * 64 + lane) * 4) = vnx[c8];
        { const int rown = row + NGW < 2 * NL * NE ? row + NGW : row; const int tbln = rown / (NL * NE), rn = rown % (NL * NE); const float* sn = (tbln ? a.in[16] : a.in[15]) + (size_t)rn * D;
#pragma unroll
          for (int c8 = 0; c8 < 8; ++c8) vnx[c8] = *(const f32x4*)(sn + (c8 * 64 + lane) * 4); }
        LDS_WAIT(); asm volatile("" ::: "memory");
        unsigned char* tb = a.ws + (tbl ? WS_VT : WS_UT) + (size_t)r * 1152;
#pragma unroll
        for (int pass = 0; pass < 2; ++pass) { const int slot = lane + 64 * pass;
            if (slot < 72) { const int col0 = (slot >> 3) * 240 + (slot & 7) * 30;
                float x[30]; float mx = 0.f;
#pragma unroll
                for (int k = 0; k < 30; ++k) { x[k] = (col0 + k < D) ? rowst[col0 + k] : 0.f; mx = fmaxf(mx, fabsf(x[k])); }
                int code = 0; float inv = 0.f;
                if (mx > 0.f) { code = (int)ceilf(8.0f * log2f(mx * (1.0f / 7.0f))) + 128; code = code < 0 ? 0 : (code > 255 ? 255 : code); inv = __builtin_amdgcn_exp2f(16.0f - (float)code * 0.125f); }
                unsigned dw[4] = {0u, 0u, 0u, 0u};
#pragma unroll
                for (int kb = 0; kb < 15; ++kb) { int a0 = (int)__builtin_rintf(x[2 * kb] * inv), a1 = (int)__builtin_rintf(x[2 * kb + 1] * inv);
                    a0 = a0 < -7 ? -7 : (a0 > 7 ? 7 : a0); a1 = a1 < -7 ? -7 : (a1 > 7 ? 7 : a1);
                    dw[kb >> 2] |= ((tbl ? (unsigned)(a0 + 8) : ((unsigned)a0 & 15u)) | (((unsigned)a1 & 15u) << 4)) << (8 * (kb & 3)); }
                dw[3] |= (unsigned)code << 24;
                *(v4u*)(tb + slot * 16) = (v4u){dw[0], dw[1], dw[2], dw[3]}; } }
        LDS_WAIT(); asm volatile("" ::: "memory");
      } }
#else
    for (int row = gw; row < 2 * NL * NE; row += NGW) {
        const int tbl = row / (NL * NE), r = row % (NL * NE);
        const float* src = (tbl ? a.in[16] : a.in[15]) + (size_t)r * D;
        f32x4 v[8]; float mx = 0.f;
#pragma unroll
        for (int c8 = 0; c8 < 8; ++c8) { v[c8] = *(const f32x4*)(src + (c8 * 64 + lane) * 4); mx = fmaxf(mx, fmaxf(fmaxf(fabsf(v[c8].x), fabsf(v[c8].y)), fmaxf(fabsf(v[c8].z), fabsf(v[c8].w)))); }
        mx = wave_max(mx);
        const float inv = mx > 0.f ? 127.0f / mx : 0.f; const int off = tbl ? 128 : 0;
        unsigned dw[8];
#pragma unroll
        for (int c8 = 0; c8 < 8; ++c8) { const int q0 = (int)__builtin_rintf(v[c8].x * inv) + off, q1 = (int)__builtin_rintf(v[c8].y * inv) + off, q2 = (int)__builtin_rintf(v[c8].z * inv) + off, q3 = (int)__builtin_rintf(v[c8].w * inv) + off;
            dw[c8] = (unsigned)(q0 & 255) | ((unsigned)(q1 & 255) << 8) | ((unsigned)(q2 & 255) << 16) | ((unsigned)(q3 & 255) << 24); }
        unsigned char* dst = a.ws + (tbl ? WS_VT : WS_UT) + (size_t)r * D;
        *(v4u*)(dst + lane * 16) = (v4u){dw[0], dw[1], dw[2], dw[3]}; *(v4u*)(dst + (64 + lane) * 16) = (v4u){dw[4], dw[5], dw[6], dw[7]};
        if (lane == 0) ((float*)(a.ws + (tbl ? WS_SV : WS_SU)))[r] = mx * (1.0f / 127.0f);
    }
#endif
}

__device__ __forceinline__ void ln_tail(const float (&z)[32], int t, int lane, const float* g, const float* bta, float* xout, const float* sh, const float* sc, bf16* hout, unsigned char* q8, float* q8s, LAS unsigned char* q8stage = nullptr, unsigned char* a8 = nullptr, float* a8s = nullptr, bf16* xb = nullptr) {
    float s = 0.f;
#pragma unroll
    for (int i = 0; i < 32; ++i) s += z[i];
    const float mu = wave_sum(s) * (1.0f / D);
    float q = 0.f;
#pragma unroll
    for (int i = 0; i < 32; ++i) { const float d = z[i] - mu; q += d * d; }
    const float rs = rsqrtf(wave_sum(q) * (1.0f / D) + EPS);
    float hv[32]; float mx = 0.f;
#pragma unroll
    for (int c = 0; c < 8; ++c) { const int col = (c * 64 + lane) * 4;
        const f32x4 g0 = *(const f32x4*)(g + col), b0 = *(const f32x4*)(bta + col);
        f32x4 x0;
        x0.x = (z[c * 4 + 0] - mu) * rs * g0.x + b0.x; x0.y = (z[c * 4 + 1] - mu) * rs * g0.y + b0.y; x0.z = (z[c * 4 + 2] - mu) * rs * g0.z + b0.z; x0.w = (z[c * 4 + 3] - mu) * rs * g0.w + b0.w;
        if (xb) { v2u o; o.x = pk2(x0.x, x0.y); o.y = pk2(x0.z, x0.w); *(v2u*)(xb + (size_t)t * D + col) = o; }
        else if (xout) *(f32x4*)(xout + (size_t)t * D + col) = x0;
        if (hout || q8 || a8) { const f32x4 s0 = *(const f32x4*)(sc + col), h0 = *(const f32x4*)(sh + col);
            hv[c * 4] = x0.x * (1.f + s0.x) + h0.x; hv[c * 4 + 1] = x0.y * (1.f + s0.y) + h0.y; hv[c * 4 + 2] = x0.z * (1.f + s0.z) + h0.z; hv[c * 4 + 3] = x0.w * (1.f + s0.w) + h0.w;
            if (hout) { v2u o; o.x = pk2(hv[c * 4], hv[c * 4 + 1]); o.y = pk2(hv[c * 4 + 2], hv[c * 4 + 3]);
                *(v2u*)(hout + (size_t)t * D + col) = o; }
            if (q8 || a8) mx = fmaxf(mx, fmaxf(fmaxf(fabsf(hv[c * 4]), fabsf(hv[c * 4 + 1])), fmaxf(fabsf(hv[c * 4 + 2]), fabsf(hv[c * 4 + 3])))); }
    }
    if (q8 || a8) {
        mx = wave_max(mx);
        const float qmax_ = (q8 && TAB4) ? 119.0f : 127.0f;
        const float inv = mx > 0.f ? qmax_ / mx : 0.f;
        unsigned dw[8];
#pragma unroll
        for (int c = 0; c < 8; ++c) { const int q0 = (int)__builtin_rintf(hv[c * 4] * inv), q1 = (int)__builtin_rintf(hv[c * 4 + 1] * inv), q2 = (int)__builtin_rintf(hv[c * 4 + 2] * inv), q3 = (int)__builtin_rintf(hv[c * 4 + 3] * inv);
            dw[c] = (unsigned)(q0 & 255) | ((unsigned)(q1 & 255) << 8) | ((unsigned)(q2 & 255) << 16) | ((unsigned)(q3 & 255) << 24); }
        if (a8) {
#pragma unroll
            for (int c = 0; c < 8; ++c) *(unsigned*)(a8 + (size_t)t * D + (c * 64 + lane) * 4) = dw[c];
            if (a8s && lane == 0) a8s[t] = mx / qmax_; }
        if (q8) {
#if TAB4
        { LAS unsigned* st32 = (LAS unsigned*)q8stage; LAS unsigned char* st8 = (LAS unsigned char*)q8stage;
#pragma unroll
          for (int i = 0; i < 9; ++i) st32[lane + 64 * i] = 0u;
          LDS_WAIT(); asm volatile("" ::: "memory");
#pragma unroll
          for (int c = 0; c < 8; ++c)
#pragma unroll
              for (int jp = 0; jp < 2; ++jp) { const int col = (c * 64 + lane) * 4 + 2 * jp, u = col / 240, r = col - u * 240, l7 = r / 30, k = r - l7 * 30;
                  const int q0 = (int)(signed char)((dw[c] >> (16 * jp)) & 255u), q1 = (int)(signed char)((dw[c] >> (16 * jp + 8)) & 255u);
                  const int l0 = ((q0 + 8) & 15) - 8, l1 = ((q1 + 8) & 15) - 8, h0 = (q0 - l0) >> 4, h1 = (q1 - l1) >> 4;
                  LAS unsigned char* sp = st8 + (u * 8 + l7) * 32 + (k >> 1);
                  sp[0] = (unsigned char)((l0 & 15) | ((l1 & 15) << 4)); sp[16] = (unsigned char)((h0 & 15) | ((h1 & 15) << 4)); }
          LDS_WAIT(); asm volatile("" ::: "memory");
          unsigned* d32 = (unsigned*)(q8 + (size_t)t * 2304);
#pragma unroll
          for (int i = 0; i < 9; ++i) d32[lane + 64 * i] = st32[lane + 64 * i];
          LDS_WAIT(); asm volatile("" ::: "memory"); }
#else
        unsigned char* dst = q8 + (size_t)t * D;
        *(v4u*)(dst + lane * 16) = (v4u){dw[0], dw[1], dw[2], dw[3]}; *(v4u*)(dst + (64 + lane) * 16) = (v4u){dw[4], dw[5], dw[6], dw[7]};
#endif
        if (lane == 0) q8s[t] = mx / qmax_; }
    }
}

__device__ __forceinline__ void ph_prologue_b(const Args& a, LAS unsigned char* lds, int tid, int lane, int wave, int bx, int G) {
    const float* part = (const float*)(a.ws + WS_PART); float* mod = (float*)(a.ws + WS_MOD);
    for (int i = bx * NTHREADS + tid; i < NL * NB * 6 * D / 4; i += G * NTHREADS) {
        const int idx = i * 4, e = idx % (6 * D), b = (idx / (6 * D)) % NB, l = idx / (6 * D * NB);
        f32x4 s = *(const f32x4*)(a.in[3] + l * 6 * D + e);
#pragma unroll
        for (int dr = 0; dr < 8; ++dr) s += *(const f32x4*)(part + (((size_t)l * 8 + dr) * NB + b) * (6 * D) + e);
        *(f32x4*)(mod + idx) = s;
    }
    LAS float* msh = (LAS float*)lds;
    bf16* hbuf = (bf16*)(a.ws + WS_H);
    for (int ch = bx; ch < NCHUNK; ch += G) {
        const int b = ch / NCH;
        for (int i = tid; i < 1024; i += NTHREADS) { const int e = i * 4;
            f32x4 s = *(const f32x4*)(a.in[3] + e);
#pragma unroll
            for (int dr = 0; dr < 8; ++dr) s += *(const f32x4*)(part + (((size_t)0 * 8 + dr) * NB + b) * (6 * D) + e);
            *(LAS f32x4*)(msh + e) = s; }
        __syncthreads();
        for (int i = 0; i < 8; ++i) { const int t = ch * 64 + wave * 8 + i;
            float hv[32]; float mx = 0.f;
#pragma unroll
            for (int c = 0; c < 4; ++c) { const int col = (c * 64 + lane) * 8;
                const f32x4 x0 = *(const f32x4*)(a.in[0] + (size_t)t * D + col), x1 = *(const f32x4*)(a.in[0] + (size_t)t * D + col + 4);
                const f32x4 h0 = *(const LAS f32x4*)(msh + col), h1 = *(const LAS f32x4*)(msh + col + 4), s0 = *(const LAS f32x4*)(msh + 2048 + col), s1 = *(const LAS f32x4*)(msh + 2048 + col + 4);
#pragma unroll
                for (int j = 0; j < 4; ++j) { hv[c * 8 + j] = x0[j] * (1.f + s0[j]) + h0[j]; hv[c * 8 + 4 + j] = x1[j] * (1.f + s1[j]) + h1[j]; }
                v4u o; o.x = pk2(hv[c * 8], hv[c * 8 + 1]); o.y = pk2(hv[c * 8 + 2], hv[c * 8 + 3]); o.z = pk2(hv[c * 8 + 4], hv[c * 8 + 5]); o.w = pk2(hv[c * 8 + 6], hv[c * 8 + 7]);
#if !I8_GATE
                *(v4u*)(hbuf + (size_t)t * D + col) = o;
#endif
#if RES16_X
                { v4u xo; xo.x = pk2(x0.x, x0.y); xo.y = pk2(x0.z, x0.w); xo.z = pk2(x1.x, x1.y); xo.w = pk2(x1.z, x1.w); *(v4u*)((bf16*)(a.ws + WS_X) + (size_t)t * D + col) = xo; }
#endif
#pragma unroll
                for (int j = 0; j < 8; ++j) mx = fmaxf(mx, fabsf(hv[c * 8 + j])); }
            mx = wave_max(mx);
            const float inv = mx > 0.f ? 127.0f / mx : 0.f;
#pragma unroll
            for (int c = 0; c < 4; ++c) { v2u o;
                o.x = pack_i8(hv[c * 8] * inv, hv[c * 8 + 1] * inv, hv[c * 8 + 2] * inv, hv[c * 8 + 3] * inv); o.y = pack_i8(hv[c * 8 + 4] * inv, hv[c * 8 + 5] * inv, hv[c * 8 + 6] * inv, hv[c * 8 + 7] * inv);
                *(v2u*)(a.ws + WS_H8 + (size_t)t * D + (c * 64 + lane) * 8) = o; }
            if (lane == 0) ((float*)(a.ws + WS_SAH))[t] = mx * (1.0f / 127.0f); }
        __syncthreads();
    }
    { const int gw = bx * NWAVES + wave, NGW = G * NWAVES;
      for (int row = gw; row < NL * (SBL + 16); row += NGW) { const int l = row / (SBL + 16), r = row % (SBL + 16);
          const bf16* src; unsigned char* dst; float* sdst;
          if (r < NP) { src = (const bf16*)(a.ws + WS_WIN) + ((size_t)l * INW + r) * D; dst = a.ws + WS_WIN8 + ((size_t)l * NP + r) * D; sdst = (float*)(a.ws + WS_SB) + l * SBL + r; }
          else if (r < NP + D) { src = (const bf16*)(a.ws + WS_WOUT) + ((size_t)l * D + (r - NP)) * D; dst = a.ws + WS_WOUT8 + ((size_t)l * D + (r - NP)) * D; sdst = (float*)(a.ws + WS_SB) + l * SBL + r; }
          else if (r < SBL) { src = (const bf16*)(a.ws + WS_WQ) + ((size_t)l * D + (r - NP - D)) * D; dst = a.ws + WS_WQ8 + ((size_t)l * D + (r - NP - D)) * D; sdst = (float*)(a.ws + WS_SB) + l * SBL + r; }
          else { src = (const bf16*)(a.ws + WS_WIN) + ((size_t)l * INW + NP + (r - SBL)) * D; dst = a.ws + WS_ALR8 + ((size_t)l * 16 + (r - SBL)) * D; sdst = (float*)(a.ws + WS_SBA) + l * 16 + (r - SBL); }
          v4u w[4]; float mx = 0.f;
#pragma unroll
          for (int c = 0; c < 4; ++c) w[c] = *(const v4u*)(src + (c * 64 + lane) * 8);
#pragma unroll
          for (int c = 0; c < 4; ++c)
#pragma unroll
              for (int j = 0; j < 4; ++j) mx = fmaxf(mx, fmaxf(fabsf(bflo(w[c][j])), fabsf(bfhi(w[c][j]))));
          mx = wave_max(mx);
          const float inv = mx > 0.f ? 127.0f / mx : 0.f;
#pragma unroll
          for (int c = 0; c < 4; ++c) { v2u o;
              o.x = pack_i8(bflo(w[c][0]) * inv, bfhi(w[c][0]) * inv, bflo(w[c][1]) * inv, bfhi(w[c][1]) * inv); o.y = pack_i8(bflo(w[c][2]) * inv, bfhi(w[c][2]) * inv, bflo(w[c][3]) * inv, bfhi(w[c][3]) * inv);
              *(v2u*)(dst + (c * 64 + lane) * 8) = o; }
          if (lane == 0) *sdst = mx * (1.0f / 127.0f); } }
}

__device__ __forceinline__ void gate_prep(const Args& a, int l, LAS unsigned char* lds, int tid, int lane, int wave, int ch) {
    const bf16* hbuf = (const bf16*)(a.ws + WS_H); const bf16* waT = (const bf16*)(a.ws + WS_WIN) + ((size_t)l * INW + NP) * D;
    bf16* Ebuf = (bf16*)(a.ws + WS_E); float* dtot = (float*)(a.ws + WS_DTOT);
    const int t0 = ch * 64, l15 = lane & 15, lq = lane >> 4, mt = wave & 3, kh = wave >> 2;
    LAS float* alr = (LAS float*)(lds + LDSCTL_OFF + 1024);
#if I8_GATE
    { v4i acc = (v4i){0, 0, 0, 0};
      const unsigned char* hA = a.ws + WS_H8 + (size_t)(t0 + 16 * mt + l15) * D + kh * 1024 + 16 * lq;
      const unsigned char* wB = a.ws + WS_ALR8 + ((size_t)l * 16 + l15) * D + kh * 1024 + 16 * lq;
#pragma unroll 8
      for (int ks = 0; ks < 16; ++ks) { const v4i av = *(const v4i*)(hA + 64 * ks), bv = *(const v4i*)(wB + 64 * ks); acc = __builtin_amdgcn_mfma_i32_16x16x64_i8(av, bv, acc, 0, 0, 0); }
      const float sw = ((const float*)(a.ws + WS_SBA))[l * 16 + l15];
#pragma unroll
      for (int r = 0; r < 4; ++r) { const int tl = 16 * mt + 4 * lq + r; alr[(kh * 64 + tl) * 16 + l15] = (float)acc[r] * (sw * ((const float*)(a.ws + WS_SAH))[t0 + tl]); } }
#else
    f32x4 acc = (f32x4){0.f, 0.f, 0.f, 0.f};
    const bf16* hA = hbuf + (size_t)(t0 + 16 * mt + l15) * D + kh * 1024 + 8 * lq;
    const bf16* wB = waT + (size_t)l15 * D + kh * 1024 + 8 * lq;
#pragma unroll 8
    for (int ks = 0; ks < 32; ++ks) { const bf16x8 av = *(const bf16x8*)(hA + 32 * ks), bv = *(const bf16x8*)(wB + 32 * ks); acc = __builtin_amdgcn_mfma_f32_16x16x32_bf16(av, bv, acc, 0, 0, 0); }
#pragma unroll
    for (int r = 0; r < 4; ++r) alr[(kh * 64 + 16 * mt + 4 * lq + r) * 16 + l15] = acc[r];
#endif
    __syncthreads();
    const int col = tid;
    float wg[16];
#pragma unroll
    for (int r = 0; r < 16; ++r) wg[r] = a.in[5][((size_t)l * RANK + r) * GKW + col];
    const float bgc = a.in[6][l * GKW + col];
    for (int i = tid; i < 256; i += NTHREADS) *(LAS f32x4*)(alr + i * 4) = *(const LAS f32x4*)(alr + i * 4) + *(const LAS f32x4*)(alr + 1024 + i * 4);
    __syncthreads();
    float tot = 0.f;
    LAS float* lac = (LAS float*)lds;
    for (int j = 0; j < 64; ++j) { float lg0 = bgc, lg1 = 0.f;
#pragma unroll
        for (int r4 = 0; r4 < 4; ++r4) { const f32x4 p = *(const LAS f32x4*)(alr + j * 16 + r4 * 4);
            lg0 += p.x * wg[r4 * 4] + p.z * wg[r4 * 4 + 2]; lg1 += p.y * wg[r4 * 4 + 1] + p.w * wg[r4 * 4 + 3]; }
        const float la = logsigmoid_fast(lg0 + lg1) * (1.0f / 16.0f); lac[j * GKW + col] = la; tot += la; }
    float run = 0.f;
    for (int j = 0; j < 64; ++j) { run += lac[j * GKW + col]; lac[j * GKW + col] = __expf(tot - run); }
    __syncthreads();
    for (int i = 0; i < 8; ++i) { const int j = wave * 8 + i;
        const f32x4 e0 = *(const LAS f32x4*)(lac + j * GKW + lane * 8), e1 = *(const LAS f32x4*)(lac + j * GKW + lane * 8 + 4);
        v4u o; o.x = pk2(e0.x, e0.y); o.y = pk2(e0.z, e0.w); o.z = pk2(e1.x, e1.y); o.w = pk2(e1.z, e1.w);
        *(v4u*)(Ebuf + (size_t)(t0 + j) * GKW + lane * 8) = o; }
    dtot[(size_t)ch * GKW + col] = __expf(tot);
    __syncthreads();
}

__device__ __forceinline__ void gla_unit(const Args& a, LAS unsigned char* lds, int tid, int lane, int wave, int un) {
    const bf16* proj = (const bf16*)(a.ws + WS_PROJ); const bf16* Ebuf = (const bf16*)(a.ws + WS_E); const float* dtot = (const float*)(a.ws + WS_DTOT); bf16* ogla = (bf16*)(a.ws + WS_OGLA);
    const int pair_ = (un & 7) * 4 + (un >> 6), dvs = (un >> 3) & 7, hh = pair_ & 3, b = pair_ >> 2;
    LAS bf16* kdT0 = (LAS bf16*)lds; LAS bf16* vT0 = (LAS bf16*)(lds + 18432); LAS bf16* ST0 = (LAS bf16*)(lds + 18432 + 4608);
    LAS bf16* kdT1 = (LAS bf16*)(lds + 32768); LAS bf16* vT1 = (LAS bf16*)(lds + 32768 + 18432); LAS bf16* ST1 = (LAS bf16*)(lds + 32768 + 18432 + 4608);
    const int l15 = lane & 15, lq = lane >> 4, jl = tid >> 3, dv4 = (tid & 7) * 4, jt = (wave & 3) * 16, dvt = (wave >> 2) * 16, jp = tid >> 4, c16 = tid & 15;
#define GLA_BAR() do { asm volatile("s_waitcnt lgkmcnt(0)" ::: "memory"); __builtin_amdgcn_s_barrier(); asm volatile("" ::: "memory"); } while (0)
    f32x4 S0 = (f32x4){0.f, 0.f, 0.f, 0.f}, S1 = (f32x4){0.f, 0.f, 0.f, 0.f};
    v4u kn0[2], kn1[2], kn2[2], en0[2], en1[2], en2[2]; v2u vn0, vn1, vn2; bf16x8 qn0[4], qn1[4], qn2[4], qc[4]; f32x4 dn0, dn1, dn2, dc;
#define GLA_LOAD(c, kn, en, vn, qn, dn) do { const int t0c = b * SEQ + (c) * 64; const bf16* pr = proj + (size_t)(t0c + jl) * NP; \
          \
        kn[0] = *(const v4u*)(proj + (size_t)(t0c + 2 * jp) * NP + PK + hh * 128 + 8 * c16); kn[1] = *(const v4u*)(proj + (size_t)(t0c + 2 * jp + 1) * NP + PK + hh * 128 + 8 * c16); \
        en[0] = *(const v4u*)(Ebuf + (size_t)(t0c + 2 * jp) * GKW + hh * 128 + 8 * c16); en[1] = *(const v4u*)(Ebuf + (size_t)(t0c + 2 * jp + 1) * GKW + hh * 128 + 8 * c16); \
        vn = *(const v2u*)(pr + PV + hh * 256 + dvs * 32 + dv4); \
        _Pragma("unroll") for (int ks_ = 0; ks_ < 4; ++ks_) qn[ks_] = *(const bf16x8*)(proj + (size_t)(t0c + jt + l15) * NP + PQ + hh * 128 + 32 * ks_ + 8 * lq); \
        dn = *(const f32x4*)(dtot + (size_t)(b * NCH + (c)) * GKW + hh * 128 + 16 * wave + 4 * lq); } while (0)
#define GLA_PREPL(kn, en, vn, kdT, vT) do { \
        _Pragma("unroll") for (int i_ = 0; i_ < 8; ++i_) { const unsigned wa_ = kn[0][i_ >> 1], wb_ = kn[1][i_ >> 1], ea_ = en[0][i_ >> 1], eb_ = en[1][i_ >> 1]; \
            const float pa_ = ((i_ & 1) ? bfhi(wa_) : bflo(wa_)) * ((i_ & 1) ? bfhi(ea_) : bflo(ea_)), pb_ = ((i_ & 1) ? bfhi(wb_) : bflo(wb_)) * ((i_ & 1) ? bfhi(eb_) : bflo(eb_)); \
            *(LAS unsigned*)(kdT + (8 * c16 + i_) * 72 + ((((jp >> 2) ^ c16) & 7) << 3) + ((2 * jp) & 7)) = pk2(pa_, pb_); }     \
        _Pragma("unroll") for (int i_ = 0; i_ < 4; ++i_) { const unsigned w_ = vn[i_ >> 1]; vT[(dv4 + i_) * 72 + jl] = (bf16)((i_ & 1) ? (w_ >> 16) : (w_ & 0xffffu)); } } while (0)
#define GLA_QD(qn, dn) do { _Pragma("unroll") for (int ks_ = 0; ks_ < 4; ++ks_) qc[ks_] = qn[ks_]; dc = dn; } while (0)
#define GLA_BODYA(kdT, vT, ST) do { \
        S0 = S0 * dc; S1 = S1 * dc; \
        _Pragma("unroll") for (int ks = 0; ks < 2; ++ks) { \
            const bf16x8 A_ = *(const LAS bf16x8*)(kdT + (16 * wave + l15) * 72 + ((((4 * ks + lq) ^ (2 * wave + (l15 >> 3))) & 7) << 3)); \
            const bf16x8 B0_ = *(const LAS bf16x8*)(vT + l15 * 72 + 32 * ks + 8 * lq), B1_ = *(const LAS bf16x8*)(vT + (16 + l15) * 72 + 32 * ks + 8 * lq); \
            S0 = __builtin_amdgcn_mfma_f32_16x16x32_bf16(A_, B0_, S0, 0, 0, 0); S1 = __builtin_amdgcn_mfma_f32_16x16x32_bf16(A_, B1_, S1, 0, 0, 0); } \
        { v2u w0_, w1_; w0_.x = pk2(S0.x, S0.y); w0_.y = pk2(S0.z, S0.w); w1_.x = pk2(S1.x, S1.y); w1_.y = pk2(S1.z, S1.w); \
          *(LAS v2u*)(ST + l15 * 136 + 16 * wave + 4 * lq) = w0_; *(LAS v2u*)(ST + (16 + l15) * 136 + 16 * wave + 4 * lq) = w1_; } } while (0)
#define GLA_BODYB(c, ST) do { \
        f32x4 O_ = (f32x4){0.f, 0.f, 0.f, 0.f}; \
        _Pragma("unroll") for (int ks = 0; ks < 4; ++ks) { const bf16x8 A_ = *(const LAS bf16x8*)(ST + (dvt + l15) * 136 + 32 * ks + 8 * lq); O_ = __builtin_amdgcn_mfma_f32_16x16x32_bf16(A_, qc[ks], O_, 0, 0, 0); } \
        { const f32x4 Os_ = O_ * 0.08838834764831845f; v2u ob_; ob_.x = pk2(Os_.x, Os_.y); ob_.y = pk2(Os_.z, Os_.w); \
          *(v2u*)(ogla + (size_t)(b * SEQ + (c) * 64 + jt + l15) * 1024 + hh * 256 + dvs * 32 + dvt + 4 * lq) = ob_; } } while (0)
#define GLA_STEP(c, RA, RB, LA, LB) do { { const int cn_ = (c) + 3 < NCH ? (c) + 3 : NCH - 1; GLA_LOAD(cn_, kn##RA, en##RA, vn##RA, qn##RA, dn##RA); } \
        GLA_BODYA(kdT##LA, vT##LA, ST##LA); GLA_PREPL(kn##RB, en##RB, vn##RB, kdT##LB, vT##LB); GLA_BAR(); GLA_BODYB(c, ST##LA); GLA_QD(qn##RB, dn##RB); } while (0)
    GLA_LOAD(0, kn0, en0, vn0, qn0, dn0); GLA_LOAD(1, kn1, en1, vn1, qn1, dn1); GLA_LOAD(2, kn2, en2, vn2, qn2, dn2);
    GLA_PREPL(kn0, en0, vn0, kdT0, vT0); GLA_QD(qn0, dn0);
    GLA_BAR();
    static_assert(NCH == 32, "the step schedule below is written for 32 chunks: 5 x 6 + 2");
    for (int c = 0; c < 30; c += 6) {
        GLA_STEP(c, 0, 1, 0, 1); GLA_STEP(c + 1, 1, 2, 1, 0); GLA_STEP(c + 2, 2, 0, 0, 1); GLA_STEP(c + 3, 0, 1, 1, 0); GLA_STEP(c + 4, 1, 2, 0, 1); GLA_STEP(c + 5, 2, 0, 1, 0);
    }
    GLA_STEP(30, 0, 1, 0, 1); GLA_STEP(31, 1, 2, 1, 0);
#undef GLA_STEP
#undef GLA_PREPL
#undef GLA_QD
#undef GLA_BODYA
#undef GLA_BODYB
#undef GLA_BAR
#undef GLA_LOAD
}

__device__ __forceinline__ void unpack16(const v4u& p0, const v4u& p1, float (&o)[16]) {
#pragma unroll
    for (int j = 0; j < 4; ++j) { o[2 * j] = bflo(p0[j]); o[2 * j + 1] = bfhi(p0[j]); o[8 + 2 * j] = bflo(p1[j]); o[8 + 2 * j + 1] = bfhi(p1[j]); }
}
__device__ __forceinline__ void mixpost_chunk(const Args& a, int l, int lane, int wave, int ch) {
    const bf16* proj = (const bf16*)(a.ws + WS_PROJ); const bf16* ogla = (const bf16*)(a.ws + WS_OGLA);
    const int c0 = 16 * lane, tfirst = ch * 64 + wave * 8, sfirst = tfirst % SEQ;
    float gn[16], cw0[16], cw1[16], cw2[16], cn[16], u1[16], u2[16];
#pragma unroll
    for (int i = 0; i < 16; ++i) { gn[i] = a.in[7][l * 256 + ((c0 + i) & 255)]; cw0[i] = a.in[8][(size_t)l * 3072 + c0 + i]; cw1[i] = a.in[8][(size_t)l * 3072 + 1024 + c0 + i];
        cw2[i] = a.in[8][(size_t)l * 3072 + 2048 + c0 + i]; cn[i] = a.in[9][l * 1024 + c0 + i]; u1[i] = 0.f; u2[i] = 0.f; }
    if (sfirst >= 2) {
        float cc[16], chh[16];
        { const bf16* pr = proj + (size_t)(tfirst - 2) * NP; unpack16(*(const v4u*)(pr + PCC + c0), *(const v4u*)(pr + PCC + c0 + 8), cc); unpack16(*(const v4u*)(pr + PCH + c0), *(const v4u*)(pr + PCH + c0 + 8), chh); }
#pragma unroll
        for (int i = 0; i < 16; ++i) u2[i] = cc[i] * chh[i];
        { const bf16* pr = proj + (size_t)(tfirst - 1) * NP; unpack16(*(const v4u*)(pr + PCC + c0), *(const v4u*)(pr + PCC + c0 + 8), cc); unpack16(*(const v4u*)(pr + PCH + c0), *(const v4u*)(pr + PCH + c0 + 8), chh); }
#pragma unroll
        for (int i = 0; i < 16; ++i) u1[i] = cc[i] * chh[i];
    }
#pragma unroll 2
    for (int it = 0; it < 8; ++it) { const int t = tfirst + it; const bf16* pr = proj + (size_t)t * NP;
        float o[16], r[16], cb[16], cc[16], chh[16];
        unpack16(*(const v4u*)(ogla + (size_t)t * 1024 + c0), *(const v4u*)(ogla + (size_t)t * 1024 + c0 + 8), o);
        unpack16(*(const v4u*)(pr + PR + c0), *(const v4u*)(pr + PR + c0 + 8), r);
        unpack16(*(const v4u*)(pr + PCB + c0), *(const v4u*)(pr + PCB + c0 + 8), cb);
        unpack16(*(const v4u*)(pr + PCC + c0), *(const v4u*)(pr + PCC + c0 + 8), cc);
        unpack16(*(const v4u*)(pr + PCH + c0), *(const v4u*)(pr + PCH + c0 + 8), chh);
        float ss = 0.f;
#pragma unroll
        for (int i = 0; i < 16; ++i) ss += o[i] * o[i];
        ss += __uint_as_float((unsigned)__builtin_amdgcn_update_dpp(0, (int)__float_as_uint(ss), 0xB1, 0xf, 0xf, false)); ss += __uint_as_float((unsigned)__builtin_amdgcn_update_dpp(0, (int)__float_as_uint(ss), 0x4E, 0xf, 0xf, false));
        ss += __uint_as_float((unsigned)__builtin_amdgcn_update_dpp(0, (int)__float_as_uint(ss), 0x124, 0xf, 0xf, false)); ss += __uint_as_float((unsigned)__builtin_amdgcn_update_dpp(0, (int)__float_as_uint(ss), 0x128, 0xf, 0xf, false));
        const float rg = rsqrtf(ss * (1.0f / 256.f) + EPS);
        float val[16]; float s2 = 0.f;
#pragma unroll
        for (int i = 0; i < 16; ++i) { const float u0 = cc[i] * chh[i]; val[i] = cb[i] * (cw0[i] * u2[i] + cw1[i] * u1[i] + cw2[i] * u0); s2 += val[i] * val[i]; u2[i] = u1[i]; u1[i] = u0; }
        const float rc = rsqrtf(wave_sum(s2) * (1.0f / 1024.f) + EPS);
        float ya[16], yb[16]; float mx = 0.f;
#pragma unroll
        for (int i = 0; i < 16; ++i) { ya[i] = o[i] * rg * gn[i] * silu_f(r[i]); yb[i] = val[i] * rc * cn[i]; mx = fmaxf(mx, fmaxf(fabsf(ya[i]), fabsf(yb[i]))); }
        mx = wave_max(mx);
        const float inv = mx > 0.f ? 127.0f / mx : 0.f;
        v4u y0, y1;
#pragma unroll
        for (int j = 0; j < 4; ++j) { y0[j] = pack_i8(ya[4 * j] * inv, ya[4 * j + 1] * inv, ya[4 * j + 2] * inv, ya[4 * j + 3] * inv); y1[j] = pack_i8(yb[4 * j] * inv, yb[4 * j + 1] * inv, yb[4 * j + 2] * inv, yb[4 * j + 3] * inv); }
        unsigned char* yr = a.ws + WS_Y8 + (size_t)t * D;
        *(v4u*)(yr + c0) = y0; *(v4u*)(yr + 1024 + c0) = y1;
#if !I8_OUT
        { v4u b0, b1, b2, b3;
#pragma unroll
          for (int j = 0; j < 4; ++j) { b0[j] = pk2(ya[2 * j], ya[2 * j + 1]); b1[j] = pk2(ya[8 + 2 * j], ya[9 + 2 * j]); b2[j] = pk2(yb[2 * j], yb[2 * j + 1]); b3[j] = pk2(yb[8 + 2 * j], yb[9 + 2 * j]); }
          bf16* ybr = (bf16*)(a.ws + WS_Y) + (size_t)t * D;
          *(v4u*)(ybr + c0) = b0; *(v4u*)(ybr + c0 + 8) = b1; *(v4u*)(ybr + 1024 + c0) = b2; *(v4u*)(ybr + 1024 + c0 + 8) = b3; }
#endif
        if (lane == 0) ((float*)(a.ws + WS_SAY))[t] = mx * (1.0f / 127.0f);
    }
}

__device__ __forceinline__ void ln1_chunk(const Args& a, int l, LAS unsigned char* lds, int lane, int wave, int ch) {
    const float* zbuf = (const float*)(a.ws + WS_Z); const float* mod = (const float*)(a.ws + WS_MOD);
    const int b = ch / NCH; const float* mb = mod + ((size_t)l * NB + b) * 6 * D;
#pragma unroll 2
    for (int it = 0; it < 8; ++it) { const int t = ch * 64 + wave * 8 + it;
        float z[32];
#pragma unroll
#if RES16_Z
        for (int c = 0; c < 8; ++c) { const v2u v0 = *(const v2u*)((const bf16*)zbuf + (size_t)t * D + (c * 64 + lane) * 4); z[c * 4] = bflo(v0.x); z[c * 4 + 1] = bfhi(v0.x); z[c * 4 + 2] = bflo(v0.y); z[c * 4 + 3] = bfhi(v0.y); }
#else
        for (int c = 0; c < 8; ++c) { const f32x4 v0 = *(const f32x4*)(zbuf + (size_t)t * D + (c * 64 + lane) * 4); z[c * 4] = v0.x; z[c * 4 + 1] = v0.y; z[c * 4 + 2] = v0.z; z[c * 4 + 3] = v0.w; }
#endif
        ln_tail(z, t, lane, a.in[11] + (size_t)l * D, a.in[12] + (size_t)l * D, RES16_X1 ? (float*)nullptr : (float*)(a.ws + WS_X1), mb + 3 * D, mb + 4 * D, I8_WQ ? (bf16*)nullptr : (bf16*)(a.ws + WS_H2), a.ws + WS_HQ8, (float*)(a.ws + WS_HSC), lds + wave * 2304, I8_WQ ? a.ws + WS_H28 : (unsigned char*)nullptr, nullptr, RES16_X1 ? (bf16*)(a.ws + WS_X1) : (bf16*)nullptr);
    }
}

template <int N> __device__ __forceinline__ void bitonic_sort_desc(float (&v)[N]) {
#pragma unroll
    for (int k = 2; k <= N; k <<= 1)
#pragma unroll
        for (int j = k >> 1; j > 0; j >>= 1)
#pragma unroll
            for (int i = 0; i < N; ++i) { const int p = i ^ j; if (p > i) { const bool desc = ((i & k) == 0); const float x = v[i], y = v[p]; const float mx = fmaxf(x, y), mn = fminf(x, y); v[i] = desc ? mx : mn; v[p] = desc ? mn : mx; } }
}
__device__ __forceinline__ void merge_top16(float (&x)[16], const float (&y)[16]) {
#pragma unroll
    for (int i = 0; i < 16; ++i) x[i] = fmaxf(x[i], y[15 - i]);
#pragma unroll
    for (int j = 8; j > 0; j >>= 1)
#pragma unroll
        for (int i = 0; i < 16; ++i) { const int p = i ^ j; if (p > i) { const float u = x[i], w = x[p]; x[i] = fmaxf(u, w); x[p] = fminf(u, w); } }
}
__device__ __forceinline__ void ce_desc(float& ka, int& pa, float& kb, int& pb) { const bool sw = kb > ka; const float k0 = sw ? kb : ka, k1 = sw ? ka : kb; const int p0 = sw ? pb : pa, p1 = sw ? pa : pb; ka = k0; pa = p0; kb = k1; pb = p1; }
__device__ __forceinline__ void bitonic_sort_desc_kp(float (&k)[16], int (&p)[16]) {
#pragma unroll
    for (int kk = 2; kk <= 16; kk <<= 1)
#pragma unroll
        for (int j = kk >> 1; j > 0; j >>= 1)
#pragma unroll
            for (int i = 0; i < 16; ++i) { const int q = i ^ j; if (q > i) { if ((i & kk) == 0) ce_desc(k[i], p[i], k[q], p[q]); else ce_desc(k[q], p[q], k[i], p[i]); } }
}
__device__ __forceinline__ void merge_top16_kp(float (&k)[16], int (&p)[16], const float (&k2)[16], const int (&p2)[16]) {
#pragma unroll
    for (int i = 0; i < 16; ++i) { const bool sw = k2[15 - i] > k[i]; k[i] = sw ? k2[15 - i] : k[i]; p[i] = sw ? p2[15 - i] : p[i]; }
#pragma unroll
    for (int j = 8; j > 0; j >>= 1)
#pragma unroll
        for (int i = 0; i < 16; ++i) { const int q = i ^ j; if (q > i) ce_desc(k[i], p[i], k[q], p[q]); }
}
__device__ constexpr int cand_i(int s) { return s < 16 ? 0 : s < 24 ? 1 : s < 29 ? 2 : s < 33 ? 3 : s < 36 ? 4 : s < 38 ? 5 : s < 40 ? 6 : s < 42 ? 7 : s < 50 ? s - 34 : -1; }
__device__ constexpr int cand_j(int s) { return s < 16 ? s : s < 24 ? s - 16 : s < 29 ? s - 24 : s < 33 ? s - 29 : s < 36 ? s - 33 : s < 38 ? s - 36 : s < 40 ? s - 38 : s < 42 ? s - 40 : s < 50 ? 0 : -1; }

__device__ __forceinline__ void peer_retrieve(const Args& a, int l, LAS unsigned char* lds, int lane, int wave, int ch) {
    const bf16* qbuf = (const bf16*)(a.ws + WS_Q); const bf16* keys = (const bf16*)(a.ws + WS_KEYS) + ((size_t)(l * 8 + wave) * 2) * 128 * 128;
    LAS int* eg_e = (LAS int*)lds; LAS float* eg_g = (LAS float*)(lds + 32768);
    const int l31 = lane & 31, l5 = lane >> 5, h = wave, t0 = ch * 64;
    for (int tt = 0; tt < 2; ++tt) {
        float sv[2][16];
#pragma unroll
        for (int p = 0; p < 2; ++p) {
            f32x16 acc[4];
#pragma unroll
            for (int nt = 0; nt < 4; ++nt)
#pragma unroll
                for (int r = 0; r < 16; ++r) acc[nt][r] = 0.f;
            const bf16* qp = qbuf + (size_t)(t0 + 32 * tt + l31) * D + h * 256 + p * 128 + 8 * l5;
            const bf16* kp = keys + (size_t)(p * 128 + l31) * 128 + 8 * l5;
#pragma unroll 4
            for (int ks = 0; ks < 8; ++ks) { const bf16x8 bq = *(const bf16x8*)(qp + 16 * ks);
#pragma unroll
                for (int nt = 0; nt < 4; ++nt) { const bf16x8 ak = *(const bf16x8*)(kp + (size_t)(32 * nt) * 128 + 16 * ks); acc[nt] = __builtin_amdgcn_mfma_f32_32x32x16_bf16(ak, bq, acc[nt], 0, 0, 0); } }
            float v[4][16];
#pragma unroll
            for (int nt = 0; nt < 4; ++nt)
#pragma unroll
                for (int r = 0; r < 16; ++r) { const unsigned idx = 32u * nt + (r & 3) + 8u * (r >> 2) + 4u * l5; v[nt][r] = __uint_as_float((__float_as_uint(acc[nt][r]) & 0xffffff80u) | idx); }
#pragma unroll
            for (int nt = 0; nt < 4; ++nt) bitonic_sort_desc<16>(v[nt]);
            merge_top16(v[0], v[1]); merge_top16(v[2], v[3]); merge_top16(v[0], v[2]);
            float o[16];
#pragma unroll
            for (int i = 0; i < 16; ++i) o[i] = __shfl_xor(v[0][i], 32);
            merge_top16(v[0], o);
#pragma unroll
            for (int i = 0; i < 16; ++i) sv[p][i] = v[0][i];
        }
        LAS unsigned char* idxb = (LAS unsigned char*)(lds + 69632) + wave * 2048 + lane * 32;
        { v4u w0, w1;
#pragma unroll
          for (int q4 = 0; q4 < 4; ++q4) {
              w0[q4] = (__float_as_uint(sv[0][4 * q4]) & 127u) | ((__float_as_uint(sv[0][4 * q4 + 1]) & 127u) << 8) | ((__float_as_uint(sv[0][4 * q4 + 2]) & 127u) << 16) | ((__float_as_uint(sv[0][4 * q4 + 3]) & 127u) << 24);
              w1[q4] = (__float_as_uint(sv[1][4 * q4]) & 127u) | ((__float_as_uint(sv[1][4 * q4 + 1]) & 127u) << 8) | ((__float_as_uint(sv[1][4 * q4 + 2]) & 127u) << 16) | ((__float_as_uint(sv[1][4 * q4 + 3]) & 127u) << 24); }
          *(LAS v4u*)(idxb) = w0; *(LAS v4u*)(idxb + 16) = w1; }
        float ck[4][16];
#pragma unroll
        for (int s = 0; s < 64; ++s) {
            if (cand_i(s) >= 0) { const unsigned b0 = __float_as_uint(sv[0][cand_i(s) < 0 ? 0 : cand_i(s)]), b1 = __float_as_uint(sv[1][cand_j(s) < 0 ? 0 : cand_j(s)]);
                const float sum = __uint_as_float(b0 & 0xffffff80u) + __uint_as_float(b1 & 0xffffff80u);
                ck[s >> 4][s & 15] = __uint_as_float((__float_as_uint(sum) & 0xffffff00u) | (unsigned)((cand_i(s) < 0 ? 0 : cand_i(s)) * 16 + (cand_j(s) < 0 ? 0 : cand_j(s)))); }
            else ck[s >> 4][s & 15] = -3.0e38f; }
        bitonic_sort_desc<16>(ck[1]); bitonic_sort_desc<16>(ck[2]);
        merge_top16(ck[0], ck[1]); merge_top16(ck[2], ck[3]); merge_top16(ck[0], ck[2]);
        LDS_WAIT(); asm volatile("" ::: "memory");
        float ex[16]; int ce[16]; float den = 0.f;
        const float cmax = __uint_as_float(__float_as_uint(ck[0][0]) & 0xffffff00u);
#pragma unroll
        for (int i = 0; i < 16; ++i) { const unsigned bits = __float_as_uint(ck[0][i]); ex[i] = __expf(__uint_as_float(bits & 0xffffff00u) - cmax); den += ex[i];
            ce[i] = (int)idxb[(bits >> 4) & 15u] * 128 + (int)idxb[16 + (bits & 15u)]; }
        const float inv = 1.0f / den;
        if (l5 == 0) {
            const int base = (32 * tt + l31) * 128 + h * 16;
#pragma unroll
            for (int i4 = 0; i4 < 4; ++i4) { *(LAS v4u*)(eg_e + base + 4 * i4) = (v4u){(unsigned)ce[4 * i4], (unsigned)ce[4 * i4 + 1], (unsigned)ce[4 * i4 + 2], (unsigned)ce[4 * i4 + 3]};
                *(LAS f32x4*)(eg_g + base + 4 * i4) = (f32x4){ex[4 * i4] * inv, ex[4 * i4 + 1] * inv, ex[4 * i4 + 2] * inv, ex[4 * i4 + 3] * inv}; }
        }
        LDS_WAIT(); asm volatile("" ::: "memory");
    }
}

typedef unsigned char uc4 __attribute__((ext_vector_type(4)));
constexpr int NSLICE = 16, SLICE_SHIFT = 10;
__device__ __forceinline__ int sdot4i(unsigned w, unsigned x, int acc) { return __builtin_amdgcn_sdot4((int)w, (int)x, acc, false); }
__device__ __forceinline__ void fma_ub4(unsigned w, float s, float& y0, float& y1, float& y2, float& y3) { const uc4 b = __builtin_bit_cast(uc4, w); y0 += s * (float)b.x; y1 += s * (float)b.y; y2 += s * (float)b.z; y3 += s * (float)b.w; }
#if TAB4
__device__ __forceinline__ void peer_tail(const Args& a, int l, int t, int lane, const bf16* Yrow, const float* mb, const float* mbn, bool last) {
    const float* x1buf = (const float*)(a.ws + WS_X1);
    float z[32];
#pragma unroll
    for (int c8 = 0; c8 < 8; ++c8) { const int col = (c8 * 64 + lane) * 4;
        const v2u yb = *(const v2u*)(Yrow + col); const f32x4 yv = (f32x4){bflo(yb.x), bfhi(yb.x), bflo(yb.y), bfhi(yb.y)};
#if RES16_X1
        const v2u xb_ = *(const v2u*)((const bf16*)x1buf + (size_t)t * D + col); const f32x4 x0 = (f32x4){bflo(xb_.x), bfhi(xb_.x), bflo(xb_.y), bfhi(xb_.y)}, g0 = *(const f32x4*)(mb + 5 * D + col);
#else
        const f32x4 x0 = *(const f32x4*)(x1buf + (size_t)t * D + col), g0 = *(const f32x4*)(mb + 5 * D + col);
#endif
        z[c8 * 4] = ALPHA * x0.x + (1.f + g0.x) * yv.x; z[c8 * 4 + 1] = ALPHA * x0.y + (1.f + g0.y) * yv.y; z[c8 * 4 + 2] = ALPHA * x0.z + (1.f + g0.z) * yv.z; z[c8 * 4 + 3] = ALPHA * x0.w + (1.f + g0.w) * yv.w; }
    ln_tail(z, t, lane, a.in[17] + (size_t)l * D, a.in[18] + (size_t)l * D, last ? a.out : (RES16_X ? (float*)nullptr : (float*)(a.ws + WS_X)), mbn, mbn + D, (last || I8_GATE) ? (bf16*)nullptr : (bf16*)(a.ws + WS_H), nullptr, nullptr, nullptr, last ? (unsigned char*)nullptr : a.ws + WS_H8, (float*)(a.ws + WS_SAH), (RES16_X && !last) ? (bf16*)(a.ws + WS_X) : (bf16*)nullptr);
}
template <class TT, int N, int M> __device__ __forceinline__ void treduce(TT (&v)[N], int lane) {
    const bool c0 = (lane & M) != 0, c1 = (lane & (2 * M)) != 0, c2 = (lane & (4 * M)) != 0;
#pragma unroll
    for (int m = 0; m < N / 2; ++m) { const TT keep = c0 ? v[2 * m + 1] : v[2 * m], send = c0 ? v[2 * m] : v[2 * m + 1]; v[m] = keep + __shfl_xor(send, M); }
#pragma unroll
    for (int m = 0; m < N / 4; ++m) { const TT keep = c1 ? v[2 * m + 1] : v[2 * m], send = c1 ? v[2 * m] : v[2 * m + 1]; v[m] = keep + __shfl_xor(send, 2 * M); }
#pragma unroll
    for (int m = 0; m < N / 8; ++m) { const TT keep = c2 ? v[2 * m + 1] : v[2 * m], send = c2 ? v[2 * m] : v[2 * m + 1]; v[m] = keep + __shfl_xor(send, 4 * M); }
}
__device__ __forceinline__ int allsum_8_16_32(int x) {
    x += __builtin_amdgcn_update_dpp(0, x, 0x128, 0xf, 0xf, false);
    { const auto r = __builtin_amdgcn_permlane16_swap((unsigned)x, (unsigned)x, false, false); x = (int)(r[0] + r[1]); }
    { const auto r = __builtin_amdgcn_permlane32_swap((unsigned)x, (unsigned)x, false, false); x = (int)(r[0] + r[1]); }
    return x; }
__device__ __forceinline__ float allmax_8_16_32(float xf) {
    unsigned x = __float_as_uint(xf);
    { const unsigned y = (unsigned)__builtin_amdgcn_update_dpp(0, (int)x, 0x128, 0xf, 0xf, false); x = x > y ? x : y; }
    { const auto r = __builtin_amdgcn_permlane16_swap(x, x, false, false); x = r[0] > r[1] ? r[0] : r[1]; }
    { const auto r = __builtin_amdgcn_permlane32_swap(x, x, false, false); x = r[0] > r[1] ? r[0] : r[1]; }
    return __uint_as_float(x); }
__device__ __forceinline__ void treduce32x8(int (&v)[32], int lane) {
    const bool c0 = (lane & 8) != 0;
#pragma unroll
    for (int m = 0; m < 16; ++m) { const int keep = c0 ? v[2 * m + 1] : v[2 * m], send = c0 ? v[2 * m] : v[2 * m + 1]; v[m] = keep + __builtin_amdgcn_update_dpp(0, send, 0x128, 0xf, 0xf, false); }
#pragma unroll
    for (int m = 0; m < 8; ++m) { const auto r = __builtin_amdgcn_permlane16_swap((unsigned)v[2 * m], (unsigned)v[2 * m + 1], false, false); v[m] = (int)(r[0] + r[1]); }
#pragma unroll
    for (int m = 0; m < 4; ++m) { const auto r = __builtin_amdgcn_permlane32_swap((unsigned)v[2 * m], (unsigned)v[2 * m + 1], false, false); v[m] = (int)(r[0] + r[1]); }
}
__device__ __forceinline__ void tr4x4(unsigned a, unsigned b, unsigned c, unsigned d, unsigned& t0, unsigned& t1, unsigned& t2, unsigned& t3) {
    const unsigned x0 = __builtin_amdgcn_perm(b, a, 0x05010400u), x1 = __builtin_amdgcn_perm(b, a, 0x07030602u), y0 = __builtin_amdgcn_perm(d, c, 0x05010400u), y1 = __builtin_amdgcn_perm(d, c, 0x07030602u);
    t0 = __builtin_amdgcn_perm(y0, x0, 0x05040100u); t1 = __builtin_amdgcn_perm(y0, x0, 0x07060302u); t2 = __builtin_amdgcn_perm(y1, x1, 0x05040100u); t3 = __builtin_amdgcn_perm(y1, x1, 0x07060302u);
}
__device__ __forceinline__ int sdot4z(unsigned w, unsigned x) { int d; asm("v_dot4_i32_i8 %0, %1, %2, 0" : "=v"(d) : "v"(w), "v"(x)); return d; }
__device__ __forceinline__ int sdot8i(unsigned w, unsigned x, int acc) { return __builtin_amdgcn_sdot8((int)w, (int)x, acc, false); }
__device__ __forceinline__ float slot_scale(unsigned w3) { return __builtin_amdgcn_exp2f((float)(w3 >> 24) * 0.125f - 16.0f); }
__device__ __forceinline__ void peer_experts(const Args& a, int l, LAS unsigned char* lds, int lane0, int wave, int ch) {
    const float* mod = (const float*)(a.ws + WS_MOD);
    const unsigned char* ut = a.ws + WS_UT + (size_t)l * NE * 1152; const unsigned char* vt = a.ws + WS_VT + (size_t)l * NE * 1152; const unsigned char* hq8 = a.ws + WS_HQ8;
    const float* hsc = (const float*)(a.ws + WS_HSC);
    bf16* Ybuf = (bf16*)(a.ws + WS_Z);
    const LAS int* eg_e = (const LAS int*)lds; LAS float* sw = (LAS float*)(lds + 32768);
    LAS float* apart = (LAS float*)(lds + 65536);
    const int b = ch / NCH; const bool last = (l == NL - 1);
    const float* mb = mod + ((size_t)l * NB + b) * 6 * D; const float* mbn = mod + ((size_t)(last ? l : l + 1) * NB + b) * 6 * D;
    const int tlw = wave * 8;
    { const int lane = lane0;
#pragma unroll
      for (int i = 0; i < 16; ++i) apart[tlw * 128 + i * 64 + lane] = 0.f; }
    LDS_WAIT(); asm volatile("" ::: "memory");
    {
        int laneL = lane0; asm volatile("" : "+v"(laneL)); const int lane = laneL;
        const int g = lane >> 3, l7 = lane & 7;
        v4u bufA[16], bufB[16], hA0, hA1, hB0, hB1;
#define CU_LOAD(buf, h0_, h1_, idx_) do { const int u_ = (idx_) >> 3, tl_ = tlw + ((idx_) & 7); const unsigned soff_ = (unsigned)(u_ * 128 + l7 * 16); \
            const unsigned char* hp_ = hq8 + (size_t)(ch * 64 + tl_) * 2304 + (u_ * 8 + l7) * 32; h0_ = *(const v4u*)hp_; h1_ = *(const v4u*)(hp_ + 16); \
            _Pragma("unroll") for (int i_ = 0; i_ < 16; ++i_) { const unsigned e_ = (unsigned)eg_e[tl_ * 128 + 8 * i_ + g]; buf[i_] = *(const v4u*)(ut + (size_t)(e_ * 1152u + soff_)); } } while (0)
#define CU_COMP(buf, h0_, h1_, idx_) do { const int tl_ = tlw + ((idx_) & 7); float accv_[16]; \
            _Pragma("unroll") for (int i_ = 0; i_ < 16; ++i_) { int sl_ = 0, sh_ = 0; \
                _Pragma("unroll") for (int d_ = 0; d_ < 4; ++d_) { const unsigned x_ = buf[i_][d_]; sl_ = sdot8i(x_, h0_[d_], sl_); sh_ = sdot8i(x_, h1_[d_], sh_); } \
                accv_[i_] = slot_scale(buf[i_][3]) * (float)(16 * sh_ + sl_); } \
            treduce<float, 16, 1>(accv_, lane); \
            apart[tl_ * 128 + 8 * l7 + g] += accv_[0]; apart[tl_ * 128 + 8 * (8 + l7) + g] += accv_[1]; } while (0)
        CU_LOAD(bufA, hA0, hA1, 0);
        for (int idx = 0; idx < 72; idx += 2) {
            CU_LOAD(bufB, hB0, hB1, idx + 1);
            CU_COMP(bufA, hA0, hA1, idx);
            { const int nx_ = idx + 2 < 72 ? idx + 2 : 71; CU_LOAD(bufA, hA0, hA1, nx_); }
            CU_COMP(bufB, hB0, hB1, idx + 1);
        }
#undef CU_LOAD
#undef CU_COMP
        LDS_WAIT(); asm volatile("" ::: "memory");
        for (int it = 0; it < 8; ++it) { const int tl = tlw + it; const float shs = hsc[ch * 64 + tl];
            const float w0 = sw[tl * 128 + lane] * gelu_tanh_f(apart[tl * 128 + lane] * shs), w1 = sw[tl * 128 + 64 + lane] * gelu_tanh_f(apart[tl * 128 + 64 + lane] * shs);
            sw[tl * 128 + lane] = w0; sw[tl * 128 + 64 + lane] = w1; }
        LDS_WAIT(); asm volatile("" ::: "memory");
    }
    {
        int laneL = lane0; asm volatile("" : "+v"(laneL)); const int lane = laneL;
        const int g = lane >> 3, l7 = lane & 7;
        v4u bufA[16], bufB[16];
#define CV_LOAD(buf, idx_) do { const int u_ = (idx_) >> 3, tl_ = tlw + ((idx_) & 7); const unsigned soff_ = (unsigned)(u_ * 128 + l7 * 16); \
            _Pragma("unroll") for (int i_ = 0; i_ < 16; ++i_) { const unsigned e_ = (unsigned)eg_e[tl_ * 128 + 8 * i_ + g]; buf[i_] = *(const v4u*)(vt + (size_t)(e_ * 1152u + soff_)); } } while (0)
#define CV_COMP(buf, idx_) do { const int u_ = (idx_) >> 3, tl_ = tlw + ((idx_) & 7); \
            float wf_[16]; float wmx_ = 0.f; \
            _Pragma("unroll") for (int i_ = 0; i_ < 16; ++i_) { wf_[i_] = sw[tl_ * 128 + 8 * i_ + g] * slot_scale(buf[i_][3]); wmx_ = fmaxf(wmx_, fabsf(wf_[i_])); } \
            wmx_ = allmax_8_16_32(wmx_);     \
            const float winv_ = wmx_ > 0.f ? 127.0f * __builtin_amdgcn_rcpf(wmx_) : 0.f, wsc_ = wmx_ * (1.0f / 127.0f); \
              \
            unsigned wq4_[4]; int wsum_ = 0; \
            _Pragma("unroll") for (int gp_ = 0; gp_ < 4; ++gp_) { \
                const unsigned m0_ = __float_as_uint(wf_[4 * gp_] * winv_ + 12582912.0f), m1_ = __float_as_uint(wf_[4 * gp_ + 1] * winv_ + 12582912.0f), m2_ = __float_as_uint(wf_[4 * gp_ + 2] * winv_ + 12582912.0f), m3_ = __float_as_uint(wf_[4 * gp_ + 3] * winv_ + 12582912.0f); \
                wq4_[gp_] = __builtin_amdgcn_perm(__builtin_amdgcn_perm(m3_, m2_, 0x0c0c0400u), __builtin_amdgcn_perm(m1_, m0_, 0x0c0c0400u), 0x05040100u); \
                wsum_ = sdot4i(wq4_[gp_], 0x01010101u, wsum_); } \
            int yi_[32]; \
            _Pragma("unroll") for (int gp_ = 0; gp_ < 4; ++gp_) { \
                _Pragma("unroll") for (int d_ = 0; d_ < 4; ++d_) { const unsigned A_ = buf[4 * gp_][d_], B_ = buf[4 * gp_ + 1][d_], C_ = buf[4 * gp_ + 2][d_], D_ = buf[4 * gp_ + 3][d_]; \
                    unsigned t0_, t1_, t2_, t3_; \
                    tr4x4(A_, B_, C_, D_, t0_, t1_, t2_, t3_);     \
                      \
                    yi_[8 * d_ + 0] = gp_ == 0 ? sdot4z(t0_ & 0x0f0f0f0fu, wq4_[gp_]) : sdot4i(t0_ & 0x0f0f0f0fu, wq4_[gp_], yi_[8 * d_ + 0]); yi_[8 * d_ + 0 + 1] = gp_ == 0 ? sdot4z(t0_, wq4_[gp_]) : sdot4i(t0_, wq4_[gp_], yi_[8 * d_ + 0 + 1]); \
                    yi_[8 * d_ + 2] = gp_ == 0 ? sdot4z(t1_ & 0x0f0f0f0fu, wq4_[gp_]) : sdot4i(t1_ & 0x0f0f0f0fu, wq4_[gp_], yi_[8 * d_ + 2]); yi_[8 * d_ + 2 + 1] = gp_ == 0 ? sdot4z(t1_, wq4_[gp_]) : sdot4i(t1_, wq4_[gp_], yi_[8 * d_ + 2 + 1]); \
                    yi_[8 * d_ + 4] = gp_ == 0 ? sdot4z(t2_ & 0x0f0f0f0fu, wq4_[gp_]) : sdot4i(t2_ & 0x0f0f0f0fu, wq4_[gp_], yi_[8 * d_ + 4]); yi_[8 * d_ + 4 + 1] = gp_ == 0 ? sdot4z(t2_, wq4_[gp_]) : sdot4i(t2_, wq4_[gp_], yi_[8 * d_ + 4 + 1]); \
                    yi_[8 * d_ + 6] = gp_ == 0 ? sdot4z(t3_ & 0x0f0f0f0fu, wq4_[gp_]) : sdot4i(t3_ & 0x0f0f0f0fu, wq4_[gp_], yi_[8 * d_ + 6]); yi_[8 * d_ + 6 + 1] = gp_ == 0 ? sdot4z(t3_, wq4_[gp_]) : sdot4i(t3_, wq4_[gp_], yi_[8 * d_ + 6 + 1]);  } } \
            _Pragma("unroll") for (int p_ = 0; p_ < 16; ++p_) yi_[2 * p_ + 1] = (yi_[2 * p_ + 1] - yi_[2 * p_]) >> 4; \
            treduce32x8(yi_, lane); \
            wsum_ = allsum_8_16_32(wsum_);     \
            float y_[4]; \
            { const int corr_ = (g & 1) ? 0 : 8 * wsum_;     \
              _Pragma("unroll") for (int q_ = 0; q_ < 4; ++q_) y_[q_] = wsc_ * (float)(yi_[q_] - corr_); } \
            { const int colb_ = u_ * 240 + l7 * 30 + g; bf16* yr_ = Ybuf + (size_t)(ch * 64 + tl_) * D + colb_; \
              _Pragma("unroll") for (int m_ = 0; m_ < 4; ++m_) if (8 * m_ + g < 30 && colb_ + 8 * m_ < D) yr_[8 * m_] = (bf16)(pk2(y_[m_], 0.f) & 0xffffu); } } while (0)
        CV_LOAD(bufA, 0);
        for (int idx = 0; idx < 72; idx += 2) {
            CV_LOAD(bufB, idx + 1);
            CV_COMP(bufA, idx);
            { const int nx_ = idx + 2 < 72 ? idx + 2 : 71; CV_LOAD(bufA, nx_); }
            CV_COMP(bufB, idx + 1);
        }
#undef CV_LOAD
#undef CV_COMP
    }
    asm volatile("s_waitcnt vmcnt(0)" ::: "memory");
    __builtin_amdgcn_fence(__ATOMIC_ACQUIRE, "agent");
    asm volatile("s_waitcnt vmcnt(0)" ::: "memory");
    for (int it = 0; it < 8; ++it) { int laneT = lane0; asm volatile("" : "+v"(laneT)); const int t = ch * 64 + tlw + it;
        peer_tail(a, l, t, laneT, Ybuf + (size_t)t * D, mb, mbn, last); }
}
#else
__device__ __forceinline__ void peer_tail(const Args& a, int l, int t, int lane, const float* Yrow, const float* mb, const float* mbn, bool last) {
    const float* x1buf = (const float*)(a.ws + WS_X1);
    float z[32];
#pragma unroll
    for (int c = 0; c < 2; ++c)
#pragma unroll
        for (int k = 0; k < 4; ++k) { const int c8 = 4 * c + k, col = (c8 * 64 + lane) * 4;
            const v2u yb = *(const v2u*)((const bf16*)Yrow + (c * 64 + lane) * 16 + 4 * k); const f32x4 yv = (f32x4){bflo(yb.x), bfhi(yb.x), bflo(yb.y), bfhi(yb.y)};
#if RES16_X1
            const v2u xb_ = *(const v2u*)((const bf16*)x1buf + (size_t)t * D + col); const f32x4 x0 = (f32x4){bflo(xb_.x), bfhi(xb_.x), bflo(xb_.y), bfhi(xb_.y)}, g0 = *(const f32x4*)(mb + 5 * D + col);
#else
            const f32x4 x0 = *(const f32x4*)(x1buf + (size_t)t * D + col), g0 = *(const f32x4*)(mb + 5 * D + col);
#endif
            z[c8 * 4] = ALPHA * x0.x + (1.f + g0.x) * yv.x; z[c8 * 4 + 1] = ALPHA * x0.y + (1.f + g0.y) * yv.y; z[c8 * 4 + 2] = ALPHA * x0.z + (1.f + g0.z) * yv.z; z[c8 * 4 + 3] = ALPHA * x0.w + (1.f + g0.w) * yv.w; }
    ln_tail(z, t, lane, a.in[17] + (size_t)l * D, a.in[18] + (size_t)l * D, last ? a.out : (RES16_X ? (float*)nullptr : (float*)(a.ws + WS_X)), mbn, mbn + D, (last || I8_GATE) ? (bf16*)nullptr : (bf16*)(a.ws + WS_H), nullptr, nullptr, nullptr, last ? (unsigned char*)nullptr : a.ws + WS_H8, (float*)(a.ws + WS_SAH), (RES16_X && !last) ? (bf16*)(a.ws + WS_X) : (bf16*)nullptr);
}
template <class TT, int M> __device__ __forceinline__ void treduce16(TT (&v)[16], int lane) {
    const bool c0 = (lane & M) != 0, c1 = (lane & (2 * M)) != 0, c2 = (lane & (4 * M)) != 0;
#pragma unroll
    for (int m = 0; m < 8; ++m) { const TT keep = c0 ? v[2 * m + 1] : v[2 * m], send = c0 ? v[2 * m] : v[2 * m + 1]; v[m] = keep + __shfl_xor(send, M); }
#pragma unroll
    for (int m = 0; m < 4; ++m) { const TT keep = c1 ? v[2 * m + 1] : v[2 * m], send = c1 ? v[2 * m] : v[2 * m + 1]; v[m] = keep + __shfl_xor(send, 2 * M); }
#pragma unroll
    for (int m = 0; m < 2; ++m) { const TT keep = c2 ? v[2 * m + 1] : v[2 * m], send = c2 ? v[2 * m] : v[2 * m + 1]; v[m] = keep + __shfl_xor(send, 4 * M); }
}
__device__ __forceinline__ void peer_experts(const Args& a, int l, LAS unsigned char* lds, int lane0, int wave, int ch) {
    const float* mod = (const float*)(a.ws + WS_MOD);
    const unsigned char* ut = a.ws + WS_UT + (size_t)l * NE * D; const unsigned char* vt = a.ws + WS_VT + (size_t)l * NE * D; const unsigned char* hq8 = a.ws + WS_HQ8;
    const float* su = (const float*)(a.ws + WS_SU) + (size_t)l * NE; const float* sv = (const float*)(a.ws + WS_SV) + (size_t)l * NE; const float* hsc = (const float*)(a.ws + WS_HSC);
    float* Ybuf = (float*)(a.ws + WS_Z);
    const LAS int* eg_e = (const LAS int*)lds; LAS float* sw = (LAS float*)(lds + 32768);
    LAS int* apart = (LAS int*)(lds + 65536); LAS float* wtotl = (LAS float*)(lds + LDSCTL_OFF + 256);
    const int b = ch / NCH; const bool last = (l == NL - 1);
    const float* mb = mod + ((size_t)l * NB + b) * 6 * D; const float* mbn = mod + ((size_t)(last ? l : l + 1) * NB + b) * 6 * D;
    const int tlw = wave * 8;
    { const int lane = lane0;
#pragma unroll
      for (int i = 0; i < 16; ++i) apart[tlw * 128 + i * 64 + lane] = 0; }
    LDS_WAIT(); asm volatile("" ::: "memory");
    {
        int laneL = lane0; asm volatile("" : "+v"(laneL)); const int lane = laneL;
        const int g = lane >> 3, l7 = lane & 7;
        v4u bufA[16], bufB[16], hA, hB;
#define CU_LOAD(buf, hh_, idx_) do { const int cs_ = (idx_) >> 3, tl_ = tlw + ((idx_) & 7); const unsigned coff_ = (unsigned)(cs_ * 128 + l7 * 16); \
            hh_ = *(const v4u*)(hq8 + (size_t)(ch * 64 + tl_) * D + coff_); \
            _Pragma("unroll") for (int i_ = 0; i_ < 16; ++i_) { const unsigned e_ = (unsigned)eg_e[tl_ * 128 + 8 * i_ + g]; buf[i_] = *(const v4u*)(ut + (size_t)(e_ * 2048u + coff_)); } } while (0)
#define CU_COMP(buf, hh_, idx_) do { const int tl_ = tlw + ((idx_) & 7); int acc_[16]; \
            _Pragma("unroll") for (int i_ = 0; i_ < 16; ++i_) { int s_ = 0; _Pragma("unroll") for (int q_ = 0; q_ < 4; ++q_) s_ = sdot4i(buf[i_][q_], hh_[q_], s_); acc_[i_] = s_; } \
            treduce16<int, 1>(acc_, lane); \
            apart[tl_ * 128 + 8 * l7 + g] += acc_[0]; apart[tl_ * 128 + 8 * (8 + l7) + g] += acc_[1]; } while (0)
        CU_LOAD(bufA, hA, 0);
        for (int idx = 0; idx < 128; idx += 2) {
            CU_LOAD(bufB, hB, idx + 1);
            CU_COMP(bufA, hA, idx);
            if (idx + 2 < 128) CU_LOAD(bufA, hA, idx + 2);
            CU_COMP(bufB, hB, idx + 1);
        }
#undef CU_LOAD
#undef CU_COMP
        LDS_WAIT(); asm volatile("" ::: "memory");
        for (int it = 0; it < 8; ++it) { const int tl = tlw + it; const float shs = hsc[ch * 64 + tl];
            const int e0 = eg_e[tl * 128 + lane], e1 = eg_e[tl * 128 + 64 + lane];
            const float w0 = sw[tl * 128 + lane] * gelu_tanh_f((float)apart[tl * 128 + lane] * su[e0] * shs) * sv[e0];
            const float w1 = sw[tl * 128 + 64 + lane] * gelu_tanh_f((float)apart[tl * 128 + 64 + lane] * su[e1] * shs) * sv[e1];
            sw[tl * 128 + lane] = w0; sw[tl * 128 + 64 + lane] = w1;
            const float ws = wave_sum(w0 + w1);
            if (lane == 0) wtotl[tl] = ws; }
        LDS_WAIT(); asm volatile("" ::: "memory");
    }
    {
        int laneL = lane0; asm volatile("" : "+v"(laneL)); const int lane = laneL;
        const int g = lane >> 3, l7 = lane & 7;
        v4u bufA[16], bufB[16];
#define CV_LOAD(buf, idx_) do { const int cs_ = (idx_) >> 3, tl_ = tlw + ((idx_) & 7); const unsigned coff_ = (unsigned)(cs_ * 128 + l7 * 16); \
            _Pragma("unroll") for (int i_ = 0; i_ < 16; ++i_) { const unsigned e_ = (unsigned)eg_e[tl_ * 128 + 8 * i_ + g]; buf[i_] = *(const v4u*)(vt + (size_t)(e_ * 2048u + coff_)); } } while (0)
#define CV_COMP(buf, idx_) do { const int cs_ = (idx_) >> 3, tl_ = tlw + ((idx_) & 7); float y_[16]; \
            _Pragma("unroll") for (int q_ = 0; q_ < 16; ++q_) y_[q_] = 0.f; \
            _Pragma("unroll") for (int i_ = 0; i_ < 16; ++i_) { const float wr_ = sw[tl_ * 128 + 8 * i_ + g]; \
                _Pragma("unroll") for (int q_ = 0; q_ < 4; ++q_) fma_ub4(buf[i_][q_], wr_, y_[4 * q_], y_[4 * q_ + 1], y_[4 * q_ + 2], y_[4 * q_ + 3]); } \
            treduce16<float, 8>(y_, lane); \
            const float woff_ = 128.0f * wtotl[tl_]; bf16* yr_ = (bf16*)Ybuf + (size_t)(ch * 64 + tl_) * D + cs_ * 128 + l7 * 16 + g; \
            yr_[0] = (bf16)(pk2(y_[0] - woff_, 0.f) & 0xffffu); yr_[8] = (bf16)(pk2(y_[1] - woff_, 0.f) & 0xffffu); } while (0)
        CV_LOAD(bufA, 0);
        for (int idx = 0; idx < 128; idx += 2) {
            CV_LOAD(bufB, idx + 1);
            CV_COMP(bufA, idx);
            if (idx + 2 < 128) CV_LOAD(bufA, idx + 2);
            CV_COMP(bufB, idx + 1);
        }
#undef CV_LOAD
#undef CV_COMP
    }
    asm volatile("s_waitcnt vmcnt(0)" ::: "memory");
    __builtin_amdgcn_fence(__ATOMIC_ACQUIRE, "agent");
    asm volatile("s_waitcnt vmcnt(0)" ::: "memory");
    for (int it = 0; it < 8; ++it) { int laneT = lane0; asm volatile("" : "+v"(laneT)); const int t = ch * 64 + tlw + it;
        peer_tail(a, l, t, laneT, (const float*)((const bf16*)Ybuf + (size_t)t * D), mb, mbn, last); }
}

#endif

#ifndef MK_PER_PHASE
#define MK_PER_PHASE 0
#endif
__global__ void __launch_bounds__(NTHREADS, 2) mk_fwd(Args a) {
    extern __shared__ __attribute__((aligned(16))) unsigned char lds_raw[];
    LAS unsigned char* lds = (LAS unsigned char*)lds_raw;
    const int tid = threadIdx.x, lane = tid & 63, wave = __builtin_amdgcn_readfirstlane(tid >> 6), G = gridDim.x, bx = blockIdx.x;
    if (tid < 64) ((LAS unsigned*)(lds + LDSCTL_OFF))[tid] = 0u;
    __syncthreads();
    unsigned* ctl = (unsigned*)(a.ws + WS_CTL);
    XcdBarrier bar; bar.bar = ctl + CW_BAR; bar.x = 0; bar.st = nullptr;
    const bool use_bar = (a.ph_hi - a.ph_lo) > 1;
    if (use_bar) bar = xcd_barrier_post(ctl + CW_BAR, (volatile LAS unsigned*)(lds + LDSCTL_OFF));
    const int lo = a.ph_lo, hi = a.ph_hi;
#ifndef PH_MASK
#define PH_MASK 0x1ff
#endif
#define IN(k) (lo <= (k) && (k) < hi)
#define EN(b) ((PH_MASK >> (b)) & 1)
#ifndef REP_MASK
#define REP_MASK 0
#endif
#ifndef REP_EXTRA
#define REP_EXTRA 2
#endif
#define REPS(b) (1 + ((REP_MASK >> (b)) & 1) * REP_EXTRA)
#define REP_BEGIN(b) for (int rep_ = 0; rep_ < REPS(b); ++rep_) {
#define REP_END(b) if (rep_ + 1 < REPS(b)) xcd_barrier(bar); }
#define SEAM(k) do { if (IN((k) + 1)) xcd_barrier(bar); } while (0)
#define PHASE_IDS() int tidp = tid; asm volatile("" : "+v"(tidp)); const int lanep = tidp & 63, wavep = __builtin_amdgcn_readfirstlane(tidp >> 6); (void)lanep; (void)wavep
    if (EN(0) && IN(0)) { REP_BEGIN(0) PHASE_IDS(); ph_prologue_a(a, lds, tidp, lanep, wavep, bx, G); REP_END(0) SEAM(0); }
    if (EN(1) && IN(1)) { REP_BEGIN(1) PHASE_IDS(); ph_prologue_b(a, lds, tidp, lanep, wavep, bx, G); REP_END(1) SEAM(1); }
    for (int l = 0; l < NL; ++l) {
        const int pb = 2 + 7 * l;
        const float* mod = (const float*)(a.ws + WS_MOD);
        if (EN(2) && IN(pb + 0)) {
            REP_BEGIN(2) PHASE_IDS();
#if I8_IN
            pg8::Gemm g{(const pg8::bf16_t*)(a.ws + WS_H8), (const pg8::bf16_t*)(a.ws + WS_WIN8 + (size_t)l * NP * D), T, NP, D / 2}; pg8::StaticOrder S; S.init(T, NP, G, bx, WGM_IN, KROT(bx));
            pg8::EpiBf16PS E{(pg8::bf16_t*)(a.ws + WS_PROJ), NP, (const float*)(a.ws + WS_SAH), (const float*)(a.ws + WS_SB) + l * SBL};
            pg8::gemm_phase<pg8::EpiBf16PS, pg8::StaticOrder, true, true, true>(lds + RING_OFF, g, S, E, tidp);
#else
            pg8::Gemm g{(const pg8::bf16_t*)(a.ws + WS_H), (const pg8::bf16_t*)(a.ws + WS_WIN) + (size_t)l * INW * D, T, NP, D}; pg8::StaticOrder S; S.init(T, NP, G, bx, WGM_IN, KROT(bx));
            pg8::EpiBf16P E{(pg8::bf16_t*)(a.ws + WS_PROJ), NP};
            pg8::gemm_phase<pg8::EpiBf16P, pg8::StaticOrder, true, true>(lds + RING_OFF, g, S, E, tidp);
#endif
#ifndef GP_REP
#define GP_REP 1
#endif
            for (int gpr_ = 0; gpr_ < GP_REP; ++gpr_) for (int ch = bx; ch < NCHUNK; ch += G) gate_prep(a, l, lds, tidp, lanep, wavep, ch);
            REP_END(2) SEAM(pb + 0);
        }
        if (EN(3) && IN(pb + 1)) { REP_BEGIN(3) PHASE_IDS(); for (int un = bx; un < 256; un += G) gla_unit(a, lds, tidp, lanep, wavep, un); REP_END(3) SEAM(pb + 1); }
        if (EN(4) && IN(pb + 2)) { REP_BEGIN(4) PHASE_IDS(); for (int ch = bx; ch < NCHUNK; ch += G) mixpost_chunk(a, l, lanep, wavep, ch); REP_END(4) SEAM(pb + 2); }
        if (EN(5) && IN(pb + 3)) {
            REP_BEGIN(5) PHASE_IDS();
#if I8_OUT
            pg8::Gemm g{(const pg8::bf16_t*)(a.ws + WS_Y8), (const pg8::bf16_t*)(a.ws + WS_WOUT8 + (size_t)l * D * D), T, D, D / 2}; pg8::StaticOrder S; S.init(T, D, G, bx, WGM_OUT, KROT(bx));
#if RES16_X || RES16_Z
            pg8::EpiResidS16<(RES16_X != 0), (RES16_Z != 0)> E{(void*)(a.ws + WS_Z), (RES16_X || l > 0) ? (const void*)(a.ws + WS_X) : (const void*)a.in[0], mod + (size_t)l * NB * 6 * D + 2 * D, (const float*)(a.ws + WS_SAY), (const float*)(a.ws + WS_SB) + l * SBL + NP, ALPHA};
            pg8::gemm_phase<pg8::EpiResidS16<(RES16_X != 0), (RES16_Z != 0)>, pg8::StaticOrder, true, true, true>(lds + RING_OFF, g, S, E, tidp);
#else
            pg8::EpiResidS E{(float*)(a.ws + WS_Z), l == 0 ? a.in[0] : (const float*)(a.ws + WS_X), mod + (size_t)l * NB * 6 * D + 2 * D, (const float*)(a.ws + WS_SAY), (const float*)(a.ws + WS_SB) + l * SBL + NP, ALPHA};
            pg8::gemm_phase<pg8::EpiResidS, pg8::StaticOrder, true, true, true>(lds + RING_OFF, g, S, E, tidp);
#endif
#else
            pg8::Gemm g{(const pg8::bf16_t*)(a.ws + WS_Y), (const pg8::bf16_t*)(a.ws + WS_WOUT) + (size_t)l * D * D, T, D, D}; pg8::StaticOrder S; S.init(T, D, G, bx, WGM_OUT, KROT(bx));
            pg8::EpiResid E{(float*)(a.ws + WS_Z), l == 0 ? a.in[0] : (const float*)(a.ws + WS_X), mod + (size_t)l * NB * 6 * D + 2 * D, ALPHA};
            pg8::gemm_phase<pg8::EpiResid, pg8::StaticOrder, true, true>(lds + RING_OFF, g, S, E, tidp);
#endif
            REP_END(5) SEAM(pb + 3);
        }
        if (EN(6) && IN(pb + 4)) { REP_BEGIN(6) PHASE_IDS(); for (int ch = bx; ch < NCHUNK; ch += G) ln1_chunk(a, l, lds, lanep, wavep, ch); REP_END(6) SEAM(pb + 4); }
        if (EN(7) && IN(pb + 5)) {
            REP_BEGIN(7) PHASE_IDS();
#if I8_WQ
            pg8::Gemm g{(const pg8::bf16_t*)(a.ws + WS_H28), (const pg8::bf16_t*)(a.ws + WS_WQ8 + (size_t)l * D * D), T, D, D / 2}; pg8::StaticOrder S; S.init(T, D, G, bx, WGM_WQ, KROT(bx));
            pg8::EpiBf16PS E{(pg8::bf16_t*)(a.ws + WS_Q), D, (const float*)(a.ws + WS_HSC), (const float*)(a.ws + WS_SB) + l * SBL + NP + D};
            pg8::gemm_phase<pg8::EpiBf16PS, pg8::StaticOrder, true, true, true>(lds + RING_OFF, g, S, E, tidp);
#else
            pg8::Gemm g{(const pg8::bf16_t*)(a.ws + WS_H2), (const pg8::bf16_t*)(a.ws + WS_WQ) + (size_t)l * D * D, T, D, D}; pg8::StaticOrder S; S.init(T, D, G, bx, WGM_WQ, KROT(bx));
            pg8::EpiBf16P E{(pg8::bf16_t*)(a.ws + WS_Q), D};
            pg8::gemm_phase<pg8::EpiBf16P, pg8::StaticOrder, true, true>(lds + RING_OFF, g, S, E, tidp);
#endif
            REP_END(7) SEAM(pb + 5);
        }
#ifndef PEER_DBG
#define PEER_DBG 0
#endif
#ifndef PE_REP_R
#define PE_REP_R 1
#endif
#ifndef L2PROBE
#define L2PROBE 0
#endif
        if (EN(8) && IN(pb + 6)) {
            REP_BEGIN(8)
            for (int ch = bx; ch < NCHUNK; ch += G) { for (int repr_ = 0; repr_ < PE_REP_R; ++repr_) { PHASE_IDS(); peer_retrieve(a, l, lds, lanep, wavep, ch); __syncthreads(); } __syncthreads(); { PHASE_IDS(); peer_experts(a, l, lds, lanep, wavep, ch); } __syncthreads(); }
            REP_END(8) SEAM(pb + 6);
        }
    }
#undef IN
#undef SEAM
}

extern "C" void kernel_launch(void* const* d_in, const int* in_sizes, int n_in, void* d_out, int out_size, void* d_ws, size_t ws_size, hipStream_t stream) {
    static int grid = 0;
    if (grid == 0) {
        if (n_in != 19 || in_sizes[0] != T * D || out_size != T * D || ws_size < WS_END) { fprintf(stderr, "kernel_launch: unexpected shapes / workspace (%d inputs, ws %zu); nothing launched\n", n_in, ws_size); grid = -1; return; }
        int dev = 0, cus = 0, per_cu = 0;
        if (hipGetDevice(&dev) != hipSuccess || hipDeviceGetAttribute(&cus, hipDeviceAttributeMultiprocessorCount, dev) != hipSuccess) { grid = -1; return; }
        if (hipFuncSetAttribute((const void*)mk_fwd, hipFuncAttributeMaxDynamicSharedMemorySize, LDS_BYTES) != hipSuccess) { fprintf(stderr, "kernel_launch: hipFuncSetAttribute failed\n"); grid = -1; return; }
        if (hipOccupancyMaxActiveBlocksPerMultiprocessor(&per_cu, (const void*)mk_fwd, NTHREADS, LDS_BYTES) != hipSuccess || per_cu < 1) fprintf(stderr, "kernel_launch: occupancy query reports %d\n", per_cu);
        (void)hipGetLastError();
        grid = cus;
    }
    if (grid < 0) return;
    if (hipMemsetAsync((char*)d_ws + WS_CTL, 0, CTL_ZERO_BYTES, stream) != hipSuccess) return;
    Args a{};
    for (int i = 0; i < 19; ++i) a.in[i] = (const float*)d_in[i];
    a.out = (float*)d_out; a.ws = (unsigned char*)d_ws;
#if MK_PER_PHASE
    for (int p = 0; p < NPHASES; ++p) { a.ph_lo = p; a.ph_hi = p + 1; hipLaunchKernelGGL(mk_fwd, dim3(grid), dim3(NTHREADS), LDS_BYTES, stream, a); }
#else
    a.ph_lo = 0; a.ph_hi = NPHASES;
    hipLaunchKernelGGL(mk_fwd, dim3(grid), dim3(NTHREADS), LDS_BYTES, stream, a);
#endif
}
```

```cpp
#include <hip/hip_runtime.h>
#include <cstdio>
#include <cstdint>
namespace pg8 {
#define PG8_LAS __attribute__((address_space(3)))
typedef unsigned short bf16_t;
typedef short bf16x8 __attribute__((ext_vector_type(8)));
typedef float f32x4 __attribute__((ext_vector_type(4)));
typedef unsigned u32x4 __attribute__((ext_vector_type(4)));
typedef int i32x4 __attribute__((ext_vector_type(4)));
constexpr int BM = 256, BK = 64, HALF = 128, HTB = HALF * BK * 2  , STAGE_BYTES = 8 * HTB, NXCD = 8, WGM = 8;

__host__ __device__ __forceinline__ int lds_byte(int r, int c) { const int st = (r >> 4) * 2 + (c >> 5), rr = r & 15, cc = c & 31, ob = rr * 64 + cc * 2; return st * 1024 + (ob ^ (((ob >> 9) & 1) << 5)); }
__host__ __device__ __forceinline__ void stage_rc(int b, int& R, int& C) { const int st = b / 1024, sb = b % 1024, swz = sb ^ (((sb >> 9) & 1) << 5); R = (st >> 1) * 16 + swz / 64; C = (st & 1) * 32 + (swz % 64) / 2; }
__host__ __device__ __forceinline__ int perm32(int rho) { const int n = rho >> 4, i = rho & 15; return 8 * (i >> 2) + 4 * n + (i & 3); }

struct Unit { int pm, pn; };
struct Gemm { const bf16_t* A; const bf16_t* Bt; int M, N, K; };

struct StaticOrder {
    int nM, nN, nwg, G, c, wgm, krot;
    __host__ __device__ void init(int M, int N, int G_, int c_, int wgm_ = WGM, int krot_ = 0) { nM = M / BM; nN = N / BM; nwg = nM * nN; G = G_; c = c_; wgm = wgm_; krot = krot_; }
    __host__ __device__ bool next(int i, Unit& u) const {
        const long L = (long)i * G + c; if (L >= nwg) return false;
        int wgid = (int)L; { const int q = nwg / NXCD, r = nwg % NXCD, xcd = wgid % NXCD, off = wgid / NXCD; wgid = (xcd < r ? xcd * (q + 1) : r * (q + 1) + (xcd - r) * q) + off; }
        const int nig = wgm * nN, gid = wgid / nig, fm = gid * wgm, gsz = (nM - fm) < wgm ? (nM - fm) : wgm;
        u.pm = fm + ((wgid % nig) % gsz); u.pn = (wgid % nig) / gsz; return true;
    }
    __device__ __forceinline__ void a_ready(const Unit&) const {}
    __device__ __forceinline__ void done(const Unit&) const {}
};
typedef __bf16 bf16x2_t __attribute__((ext_vector_type(2)));
__device__ __forceinline__ unsigned cvt_pk_bf16(float lo, float hi) { bf16x2_t r; r.x = (__bf16)lo; r.y = (__bf16)hi; return __builtin_bit_cast(unsigned, r); }
struct EpiBf16P {
    static constexpr bool PERM = true, AFTER_DRAIN = false;
    bf16_t* O; int ldc;
    __device__ __forceinline__ void operator()(const f32x4 (&acc)[2][2][4][2], const Unit& u, int wr, int wc, int fr, int fq) const {
        const int row0 = u.pm * BM + wr * 64 + fr, col0 = u.pn * BM + wc * 32 + 8 * fq;
#pragma unroll
        for (int ai = 0; ai < 2; ++ai)
#pragma unroll
            for (int m = 0; m < 4; ++m) { bf16_t* rowp = O + (size_t)(row0 + ai * HALF + m * 16) * ldc + col0;
#pragma unroll
                for (int bj = 0; bj < 2; ++bj) { const f32x4 v0 = acc[ai][bj][m][0], v1 = acc[ai][bj][m][1];
                    u32x4 w; w.x = cvt_pk_bf16(v0[0], v0[1]); w.y = cvt_pk_bf16(v0[2], v0[3]); w.z = cvt_pk_bf16(v1[0], v1[1]); w.w = cvt_pk_bf16(v1[2], v1[3]);
                    *(u32x4*)(rowp + bj * HALF) = w; } }
    }
};
struct EpiResid {
    static constexpr bool PERM = false, AFTER_DRAIN = false;
    float* Z; const float* X; const float* gate; float alpha;
    __device__ __forceinline__ void operator()(const f32x4 (&acc)[2][2][4][2], const Unit& u, int wr, int wc, int fr, int fq) const {
        const int row0 = u.pm * BM + wr * 64 + fr, col0 = u.pn * BM + wc * 32 + 4 * fq;
        const float* gb = gate + (size_t)(u.pm >> 3) * (6 * 2048) + col0;
        f32x4 gv[2][2];
#pragma unroll
        for (int bj = 0; bj < 2; ++bj)
#pragma unroll
            for (int n = 0; n < 2; ++n) gv[bj][n] = *(const f32x4*)(gb + bj * HALF + n * 16) + 1.0f;
#pragma unroll
        for (int ai = 0; ai < 2; ++ai)
#pragma unroll
            for (int m = 0; m < 4; ++m) { const size_t off = (size_t)(row0 + ai * HALF + m * 16) * 2048 + col0;
#pragma unroll
                for (int bj = 0; bj < 2; ++bj)
#pragma unroll
                    for (int n = 0; n < 2; ++n) { const f32x4 xv = *(const f32x4*)(X + off + bj * HALF + n * 16);
                        *(f32x4*)(Z + off + bj * HALF + n * 16) = xv * alpha + gv[bj][n] * acc[ai][bj][m][n]; }
                asm volatile("" ::: "memory"); }
    }
};
#ifndef PG8_NT
#define PG8_NT 0
#endif
#if PG8_NT
#define PG8_ST(TY, p, v) __builtin_nontemporal_store((v), (TY*)(p))
#else
#define PG8_ST(TY, p, v) (*(TY*)(p) = (v))
#endif
__device__ __forceinline__ f32x4 acc_i2f(const f32x4 v) { const i32x4 iv = __builtin_bit_cast(i32x4, v); return __builtin_convertvector(iv, f32x4); }
struct EpiBf16PS {
    static constexpr bool PERM = true, AFTER_DRAIN = false;
    bf16_t* O; int ldc; const float* sa; const float* sb;
    __device__ __forceinline__ void operator()(const f32x4 (&acc)[2][2][4][2], const Unit& u, int wr, int wc, int fr, int fq) const {
        const int row0 = u.pm * BM + wr * 64 + fr, col0 = u.pn * BM + wc * 32 + 8 * fq;
        f32x4 sbv[2][2];
#pragma unroll
        for (int bj = 0; bj < 2; ++bj)
#pragma unroll
            for (int n = 0; n < 2; ++n) sbv[bj][n] = *(const f32x4*)(sb + col0 + bj * HALF + 4 * n);
#pragma unroll
        for (int ai = 0; ai < 2; ++ai)
#pragma unroll
            for (int m = 0; m < 4; ++m) { const int row = row0 + ai * HALF + m * 16; bf16_t* rowp = O + (size_t)row * ldc + col0; const float sar = sa[row];
#pragma unroll
                for (int bj = 0; bj < 2; ++bj) { const f32x4 v0 = acc_i2f(acc[ai][bj][m][0]) * (sbv[bj][0] * sar), v1 = acc_i2f(acc[ai][bj][m][1]) * (sbv[bj][1] * sar);
                    u32x4 w; w.x = cvt_pk_bf16(v0[0], v0[1]); w.y = cvt_pk_bf16(v0[2], v0[3]); w.z = cvt_pk_bf16(v1[0], v1[1]); w.w = cvt_pk_bf16(v1[2], v1[3]);
                    PG8_ST(u32x4, rowp + bj * HALF, w); } }
    }
};
struct EpiResidS {
    static constexpr bool PERM = false, AFTER_DRAIN = false;
    float* Z; const float* X; const float* gate; const float* sa; const float* sb; float alpha;
    __device__ __forceinline__ void operator()(const f32x4 (&acc)[2][2][4][2], const Unit& u, int wr, int wc, int fr, int fq) const {
        const int row0 = u.pm * BM + wr * 64 + fr, col0 = u.pn * BM + wc * 32 + 4 * fq;
        const float* gb = gate + (size_t)(u.pm >> 3) * (6 * 2048) + col0;
        f32x4 gv[2][2];
#pragma unroll
        for (int bj = 0; bj < 2; ++bj)
#pragma unroll
            for (int n = 0; n < 2; ++n) gv[bj][n] = (*(const f32x4*)(gb + bj * HALF + n * 16) + 1.0f) * *(const f32x4*)(sb + col0 + bj * HALF + n * 16);
#pragma unroll
        for (int ai = 0; ai < 2; ++ai)
#pragma unroll
            for (int m = 0; m < 4; ++m) { const int row = row0 + ai * HALF + m * 16; const size_t off = (size_t)row * 2048 + col0; const float sar = sa[row];
#pragma unroll
                for (int bj = 0; bj < 2; ++bj)
#pragma unroll
                    for (int n = 0; n < 2; ++n) { const f32x4 xv = *(const f32x4*)(X + off + bj * HALF + n * 16);
                        PG8_ST(f32x4, Z + off + bj * HALF + n * 16, xv * alpha + (gv[bj][n] * sar) * acc_i2f(acc[ai][bj][m][n])); }
                asm volatile("" ::: "memory"); }
    }
};
template <bool XB, bool ZB> struct EpiResidS16 {
    static constexpr bool PERM = true, AFTER_DRAIN = false;
    void* Z; const void* X; const float* gate; const float* sa; const float* sb; float alpha;
    __device__ __forceinline__ void operator()(const f32x4 (&acc)[2][2][4][2], const Unit& u, int wr, int wc, int fr, int fq) const {
        const int row0 = u.pm * BM + wr * 64 + fr, col0 = u.pn * BM + wc * 32 + 8 * fq;
        const float* gb = gate + (size_t)(u.pm >> 3) * (6 * 2048) + col0;
        f32x4 gv[2][2];
#pragma unroll
        for (int bj = 0; bj < 2; ++bj)
#pragma unroll
            for (int n = 0; n < 2; ++n) gv[bj][n] = (*(const f32x4*)(gb + bj * HALF + 4 * n) + 1.0f) * *(const f32x4*)(sb + col0 + bj * HALF + 4 * n);
#pragma unroll
        for (int ai = 0; ai < 2; ++ai)
#pragma unroll
            for (int m = 0; m < 4; ++m) { const int row = row0 + ai * HALF + m * 16; const size_t off = (size_t)row * 2048 + col0; const float sar = sa[row];
#pragma unroll
                for (int bj = 0; bj < 2; ++bj) { f32x4 x0, x1;
                    if constexpr (XB) { const u32x4 xw = *(const u32x4*)((const bf16_t*)X + off + bj * HALF);
                        x0 = (f32x4){__uint_as_float(xw.x << 16), __uint_as_float(xw.x & 0xffff0000u), __uint_as_float(xw.y << 16), __uint_as_float(xw.y & 0xffff0000u)};
                        x1 = (f32x4){__uint_as_float(xw.z << 16), __uint_as_float(xw.z & 0xffff0000u), __uint_as_float(xw.w << 16), __uint_as_float(xw.w & 0xffff0000u)}; }
                    else { x0 = *(const f32x4*)((const float*)X + off + bj * HALF); x1 = *(const f32x4*)((const float*)X + off + bj * HALF + 4); }
                    const f32x4 v0 = x0 * alpha + (gv[bj][0] * sar) * acc_i2f(acc[ai][bj][m][0]), v1 = x1 * alpha + (gv[bj][1] * sar) * acc_i2f(acc[ai][bj][m][1]);
                    if constexpr (ZB) { u32x4 w; w.x = cvt_pk_bf16(v0[0], v0[1]); w.y = cvt_pk_bf16(v0[2], v0[3]); w.z = cvt_pk_bf16(v1[0], v1[1]); w.w = cvt_pk_bf16(v1[2], v1[3]);
                        PG8_ST(u32x4, (bf16_t*)Z + off + bj * HALF, w); }
                    else { PG8_ST(f32x4, (float*)Z + off + bj * HALF, v0); PG8_ST(f32x4, (float*)Z + off + bj * HALF + 4, v1); } }
                asm volatile("" ::: "memory"); }
    }
};
template <class Epi, class Sched, bool ALIGN_EPI = false, bool SP2 = false, bool I8 = false>
__device__ __forceinline__ void gemm_phase(PG8_LAS unsigned char* lds, const Gemm g, const Sched& S, const Epi& E, const int tid_in) {
    const int tid = tid_in, wid = __builtin_amdgcn_readfirstlane(tid >> 6), lane = tid & 63, wr = wid >> 2, wc = wid & 3, fr = lane & 15, fq = lane >> 4;
    const int K = g.K, nt = K / BK;
    const int krot = ((nt & (nt - 1)) == 0) ? (S.krot & (nt - 1)) : 0;
#define PG8_KOFS(t) ((size_t)(((t) + krot) & (nt - 1)) * kstep)
    unsigned voffA[2], voffB[2];
#pragma unroll
    for (int i = 0; i < 2; ++i) { int R, C; stage_rc(tid * 16 + i * 8192, R, C); const int Rb = Epi::PERM ? ((R & ~31) + perm32(R & 31)) : R;
        voffA[i] = (unsigned)(R * K + C) * 2u; voffB[i] = (unsigned)(Rb * K + C) * 2u; }
    const size_t kstep = (size_t)(BK * 2);
    const size_t hstep = (size_t)HALF * K * 2;
    const size_t tstep = 2 * hstep;
    const unsigned ldsw = (unsigned)wid * 1024u;
    const int aoff = lds_byte(wr * 64 + fr, fq * 8), boff = lds_byte(wc * 32 + fr, fq * 8);
#define PG8_SA(b, h) (((b) * 2 + (h)) * HTB)
#define PG8_SB(b, h) ((4 + (b) * 2 + (h)) * HTB)
#define PG8_STAGE(bufoff, gbase, voff) do { _Pragma("unroll") for (int _i = 0; _i < 2; ++_i) \
        __builtin_amdgcn_global_load_lds((const unsigned*)((const char*)(gbase) + (voff)[_i]), (PG8_LAS unsigned*)(lds + (bufoff) + ldsw + _i * 8192), 16, 0, 0); } while (0)
#define PG8_LDA(dst, b, h) do { _Pragma("unroll") for (int m = 0; m < 4; ++m) _Pragma("unroll") for (int k = 0; k < 2; ++k) dst[m][k] = *(const PG8_LAS bf16x8*)(lds + PG8_SA(b, h) + aoff + m * 2048 + k * 1024); } while (0)
#define PG8_LDB(dst, b, h) do { _Pragma("unroll") for (int n = 0; n < 2; ++n) _Pragma("unroll") for (int k = 0; k < 2; ++k) dst[n][k] = *(const PG8_LAS bf16x8*)(lds + PG8_SB(b, h) + boff + n * 2048 + k * 1024); } while (0)
#define PG8_MMA(ai, bj, At, Bt) do { __builtin_amdgcn_s_setprio(1); _Pragma("unroll") for (int m = 0; m < 4; ++m) _Pragma("unroll") for (int n = 0; n < 2; ++n) _Pragma("unroll") for (int k = 0; k < 2; ++k) \
        { if constexpr (I8) acc[ai][bj][m][n] = __builtin_bit_cast(f32x4, __builtin_amdgcn_mfma_i32_16x16x64_i8(__builtin_bit_cast(i32x4, Bt[n][k]), __builtin_bit_cast(i32x4, At[m][k]), __builtin_bit_cast(i32x4, acc[ai][bj][m][n]), 0, 0, 0)); \
          else acc[ai][bj][m][n] = __builtin_amdgcn_mfma_f32_16x16x32_bf16(Bt[n][k], At[m][k], acc[ai][bj][m][n], 0, 0, 0); } __builtin_amdgcn_s_setprio(0); } while (0)
#define PG8_WAIT_V(n) asm volatile("s_waitcnt vmcnt(" #n ")" ::: "memory")
#define PG8_WAIT_L(n) asm volatile("s_waitcnt lgkmcnt(" #n ")" ::: "memory")
#define PG8_BAR __builtin_amdgcn_s_barrier()
#define PG8_SCHED __builtin_amdgcn_sched_barrier(0)
    Unit cur, nxt; int ui = 0;
    if (!S.next(0, cur)) return;
    f32x4 acc[2][2][4][2];
#pragma unroll
    for (int a = 0; a < 2; ++a)
#pragma unroll
        for (int b = 0; b < 2; ++b)
#pragma unroll
            for (int m = 0; m < 4; ++m)
#pragma unroll
                for (int n = 0; n < 2; ++n) acc[a][b][m][n] = (f32x4){0.f, 0.f, 0.f, 0.f};
    bf16x8 At[4][2], B0[2][2], B1[2][2];
    const char* cA = (const char*)g.A + (size_t)cur.pm * tstep; const char* cB = (const char*)g.Bt + (size_t)cur.pn * tstep;
    S.a_ready(cur);
    if constexpr (SP2) {
        PG8_STAGE(PG8_SB(0, 0), cB + PG8_KOFS(0), voffB); PG8_STAGE(PG8_SB(0, 1), cB + hstep + PG8_KOFS(0), voffB); PG8_STAGE(PG8_SA(0, 0), cA + PG8_KOFS(0), voffA); PG8_STAGE(PG8_SA(0, 1), cA + hstep + PG8_KOFS(0), voffA);
        if (wr == 1) PG8_BAR;
        PG8_WAIT_V(2); PG8_BAR;
        PG8_STAGE(PG8_SB(1, 0), cB + PG8_KOFS(1), voffB); PG8_STAGE(PG8_SA(1, 0), cA + PG8_KOFS(1), voffA); PG8_STAGE(PG8_SB(1, 1), cB + hstep + PG8_KOFS(1), voffB);
        PG8_WAIT_V(6); PG8_BAR;
    } else {
        PG8_STAGE(PG8_SB(0, 0), cB + PG8_KOFS(0), voffB); PG8_STAGE(PG8_SA(0, 0), cA + PG8_KOFS(0), voffA); PG8_STAGE(PG8_SB(0, 1), cB + hstep + PG8_KOFS(0), voffB); PG8_STAGE(PG8_SA(0, 1), cA + hstep + PG8_KOFS(0), voffA);
        if (wr == 1) PG8_BAR;
        PG8_WAIT_V(4); PG8_BAR;
        PG8_STAGE(PG8_SB(1, 0), cB + PG8_KOFS(1), voffB); PG8_STAGE(PG8_SA(1, 0), cA + PG8_KOFS(1), voffA); PG8_STAGE(PG8_SB(1, 1), cB + hstep + PG8_KOFS(1), voffB);
        PG8_WAIT_V(6); PG8_BAR;
    }
    for (;;) {
        const bool has_next = S.next(ui + 1, nxt);
        const char* nA = has_next ? (const char*)g.A + (size_t)nxt.pm * tstep : cA; const char* nB = has_next ? (const char*)g.Bt + (size_t)nxt.pn * tstep : cB;
#ifdef PG8_KREP
        for (int kr_ = 0; kr_ < PG8_KREP; ++kr_) {
        if (kr_) {
#pragma unroll
        for (int a = 0; a < 2; ++a)
#pragma unroll
            for (int b = 0; b < 2; ++b)
#pragma unroll
                for (int m = 0; m < 4; ++m)
#pragma unroll
                    for (int n = 0; n < 2; ++n) acc[a][b][m][n] = (f32x4){0.f, 0.f, 0.f, 0.f}; }
        const char* nA_ = (kr_ + 1 < PG8_KREP) ? cA : nA; const char* nB_ = (kr_ + 1 < PG8_KREP) ? cB : nB;
#else
        const char* nA_ = nA; const char* nB_ = nB;
#endif
        for (int t = 0; t < nt; t += 2) {
            const bool last = (t == nt - 2);
            const char* a1 = cA + PG8_KOFS(t + 1);
            const char* a2 = (last ? nA_ : cA) + PG8_KOFS(t + 2); const char* b2 = (last ? nB_ : cB) + PG8_KOFS(t + 2);
            const char* a3 = (last ? nA_ : cA) + PG8_KOFS(t + 3); const char* b3 = (last ? nB_ : cB) + PG8_KOFS(t + 3);
            if (last && has_next) S.a_ready(nxt);
            if constexpr (SP2) {
            PG8_LDB(B0, 0, 0); PG8_LDB(B1, 0, 1); PG8_SCHED; PG8_LDA(At, 0, 0); PG8_STAGE(PG8_SA(1, 1), a1 + hstep, voffA);
            PG8_WAIT_V(8); PG8_WAIT_L(0); PG8_BAR; PG8_MMA(0, 0, At, B0); PG8_MMA(0, 1, At, B1); PG8_BAR; PG8_SCHED;
            PG8_LDA(At, 0, 1); PG8_STAGE(PG8_SB(0, 0), b2, voffB); PG8_STAGE(PG8_SB(0, 1), b2 + hstep, voffB); PG8_STAGE(PG8_SA(0, 0), a2, voffA);
            PG8_WAIT_V(8); PG8_WAIT_L(0); PG8_BAR; PG8_MMA(1, 0, At, B0); PG8_MMA(1, 1, At, B1); PG8_BAR; PG8_SCHED;
            PG8_LDB(B0, 1, 0); PG8_LDB(B1, 1, 1); PG8_SCHED; PG8_LDA(At, 1, 0); PG8_STAGE(PG8_SA(0, 1), a2 + hstep, voffA);
            PG8_WAIT_V(8); PG8_WAIT_L(0); PG8_BAR; PG8_MMA(0, 0, At, B0); PG8_MMA(0, 1, At, B1); PG8_BAR; PG8_SCHED;
            PG8_LDA(At, 1, 1); PG8_STAGE(PG8_SB(1, 0), b3, voffB); PG8_STAGE(PG8_SB(1, 1), b3 + hstep, voffB); PG8_STAGE(PG8_SA(1, 0), a3, voffA);
            PG8_WAIT_V(8); PG8_WAIT_L(0); PG8_BAR; PG8_MMA(1, 0, At, B0); PG8_MMA(1, 1, At, B1); PG8_BAR; PG8_SCHED;
            } else {
            PG8_LDB(B0, 0, 0); PG8_SCHED; PG8_LDA(At, 0, 0); PG8_STAGE(PG8_SA(1, 1), a1 + hstep, voffA);
            PG8_WAIT_L(8); PG8_BAR; PG8_WAIT_L(0); PG8_MMA(0, 0, At, B0); PG8_BAR; PG8_SCHED;
            PG8_LDB(B1, 0, 1); PG8_STAGE(PG8_SB(0, 0), b2, voffB);
            PG8_BAR; PG8_WAIT_L(0); PG8_MMA(0, 1, At, B1); PG8_BAR;
            PG8_LDA(At, 0, 1); PG8_STAGE(PG8_SA(0, 0), a2, voffA);
            PG8_BAR; PG8_WAIT_L(0); PG8_MMA(1, 0, At, B0); PG8_BAR; PG8_SCHED;
            PG8_STAGE(PG8_SB(0, 1), b2 + hstep, voffB);
            PG8_WAIT_V(6); PG8_BAR; PG8_MMA(1, 1, At, B1); PG8_BAR;
            PG8_LDB(B0, 1, 0); PG8_SCHED; PG8_LDA(At, 1, 0); PG8_STAGE(PG8_SA(0, 1), a2 + hstep, voffA);
            PG8_WAIT_L(8); PG8_BAR; PG8_WAIT_L(0); PG8_MMA(0, 0, At, B0); PG8_BAR; PG8_SCHED;
            PG8_LDB(B1, 1, 1); PG8_STAGE(PG8_SB(1, 0), b3, voffB);
            PG8_BAR; PG8_WAIT_L(0); PG8_MMA(0, 1, At, B1); PG8_BAR;
            PG8_LDA(At, 1, 1); PG8_STAGE(PG8_SA(1, 0), a3, voffA);
            PG8_BAR; PG8_WAIT_L(0); PG8_MMA(1, 0, At, B0); PG8_BAR; PG8_SCHED;
            PG8_STAGE(PG8_SB(1, 1), b3 + hstep, voffB);
            PG8_WAIT_V(6); PG8_BAR; PG8_MMA(1, 1, At, B1); PG8_BAR;
            }
        }
#ifdef PG8_KREP
        }
#endif
        if constexpr (ALIGN_EPI) { if (wr == 0) PG8_BAR; }
#ifdef PG8_EPI2
        if constexpr (!Epi::AFTER_DRAIN) { E(acc, cur, wr, wc, fr, fq); asm volatile("" ::: "memory"); }
#endif
        if constexpr (!Epi::AFTER_DRAIN) { E(acc, cur, wr, wc, fr, fq); S.done(cur); }
        if (!has_next) break;
#pragma unroll
        for (int a = 0; a < 2; ++a)
#pragma unroll
            for (int b = 0; b < 2; ++b)
#pragma unroll
                for (int m = 0; m < 4; ++m)
#pragma unroll
                    for (int n = 0; n < 2; ++n) acc[a][b][m][n] = (f32x4){0.f, 0.f, 0.f, 0.f};
        cur = nxt; cA = nA; cB = nB; ++ui;
        if constexpr (ALIGN_EPI) { if (wr == 1) PG8_BAR; }
    }
    PG8_WAIT_V(0);
    if constexpr (!ALIGN_EPI) { if (wr == 0) PG8_BAR; }
    PG8_BAR;
    if constexpr (Epi::AFTER_DRAIN) { E.fused(acc, cur, wr, wc, fr, fq, lds, wid, lane); S.done(cur); }
#undef PG8_SA
#undef PG8_SB
#undef PG8_STAGE
#undef PG8_LDA
#undef PG8_LDB
#undef PG8_MMA
#undef PG8_WAIT_V
#undef PG8_WAIT_L
#undef PG8_BAR
#undef PG8_SCHED
#undef PG8_KOFS
}
}
#define XB_TMO      128
#define XB_XCNT(j)  (256  + 64 * (j))
#define XB_XSUB(j)  (1280 + 64 * (j))
#define XB_XGEN(j)  (2304 + 64 * (j))
#define XB_TOP      3328
#define XB_TOPGEN   3392
#define XCD_BAR_WORDS 3456
#define XB_SPIN_CAP (1u << 18)
#define LAS __attribute__((address_space(3)))

__device__ __forceinline__ unsigned xb_ld(unsigned* p)              { return __hip_atomic_load(p, __ATOMIC_RELAXED, __HIP_MEMORY_SCOPE_AGENT); }
__device__ __forceinline__ unsigned xb_add(unsigned* p, unsigned v) { return __hip_atomic_fetch_add(p, v, __ATOMIC_RELAXED, __HIP_MEMORY_SCOPE_AGENT); }
__device__ __forceinline__ unsigned xb_xcc_id() { return (unsigned)__builtin_amdgcn_s_getreg((3 << 11) | 20) & 0xFu; }
#define XB_SPIN(cond, bar) do { unsigned _sp = 0; while (cond) { __builtin_amdgcn_s_sleep(1); \
    if ((++_sp & 255u) == 0u) { if (xb_ld(&(bar)[XB_TMO])) break; if (_sp > XB_SPIN_CAP) { atomicAdd(&(bar)[XB_TMO], 1u); break; } } } } while (0)

struct XcdBarrier {
    unsigned* bar; unsigned x;
    volatile LAS unsigned* st;
};

__device__ __forceinline__ XcdBarrier xcd_barrier_post(unsigned* bar, volatile LAS unsigned* st) {
    XcdBarrier b; b.bar = bar; b.x = xb_xcc_id(); b.st = st;
    if (threadIdx.x == 0) (void)xb_add(&bar[XB_XCNT(b.x)], 1u);
    return b;
}
__device__ __forceinline__ void xcd_barrier_complete(unsigned* bar, unsigned x, unsigned& nloc, unsigned& nx) {
    const unsigned G = gridDim.x * gridDim.y * gridDim.z;
    unsigned sum, cnt, mine, sp = 0u;
    for (;;) {
        sum = 0u; cnt = 0u; mine = 0u;
#pragma unroll
        for (unsigned j = 0; j < 16; ++j) { const unsigned c = xb_ld(&bar[XB_XCNT(j)]); sum += c; cnt += (c > 0u) ? 1u : 0u; mine = (j == x) ? c : mine; }
        if (sum == G) break;
        __builtin_amdgcn_s_sleep(1);
        if ((++sp & 255u) == 0u) { if (xb_ld(&bar[XB_TMO])) break; if (sp > XB_SPIN_CAP) { atomicAdd(&bar[XB_TMO], 1u); break; } }
    }
    nloc = mine > 0u ? mine : 1u; nx = cnt > 0u ? cnt : 1u;
}

__device__ __forceinline__ void xcd_barrier(const XcdBarrier& b) {
    asm volatile("s_waitcnt vmcnt(0)" ::: "memory");
    __syncthreads();
    if (threadIdx.x == 0) {
        unsigned* bar = b.bar;
        __builtin_amdgcn_s_waitcnt(0);
        unsigned nloc = b.st[0], nx = b.st[1];
        if (nloc == 0u) { xcd_barrier_complete(bar, b.x, nloc, nx); b.st[0] = nloc; b.st[1] = nx; }
        const unsigned old = xb_add(&bar[XB_XSUB(b.x)], 1u);
        const unsigned gen = old / nloc;
        if (old + 1u == (gen + 1u) * nloc) {
            __builtin_amdgcn_fence(__ATOMIC_RELEASE, "agent");
            asm volatile("s_waitcnt vmcnt(0)" ::: "memory");
            const unsigned og = xb_add(&bar[XB_TOP], 1u);
            const unsigned tg = og / nx;
            if (og + 1u == (tg + 1u) * nx) xb_add(&bar[XB_TOPGEN], 1u);
            else XB_SPIN(xb_ld(&bar[XB_TOPGEN]) == tg, bar);
            __builtin_amdgcn_fence(__ATOMIC_ACQUIRE, "agent");
            xb_add(&bar[XB_XGEN(b.x)], 1u);
            asm volatile("s_waitcnt vmcnt(0)" ::: "memory");
        } else {
            XB_SPIN(xb_ld(&bar[XB_XGEN(b.x)]) == gen, bar);
            __builtin_amdgcn_fence(__ATOMIC_ACQUIRE, "agent");
            asm volatile("s_waitcnt vmcnt(0)" ::: "memory");
        }
    }
    __syncthreads();
}
constexpr int D = 2048, NB = 8, SEQ = 2048, NL = 4, T = NB * SEQ;
constexpr int NCH = SEQ / 64, NCHUNK = T / 64;
constexpr int GKW = 512, RANK = 16;
constexpr int INW = 6160, NP = 6144;
constexpr int NE = 16384;
constexpr float ALPHA = 1.6817928305074290f, EPS = 1e-5f;
constexpr int PQ = 0, PK = 512, PV = 1024, PR = 2048, PCB = 3072, PCC = 4096, PCH = 5120;
constexpr int NWAVES = 8, NTHREADS = 512;
#ifndef WGM_IN
#define WGM_IN 4
#endif
#ifndef WGM_OUT
#define WGM_OUT 4
#endif
#ifndef WGM_WQ
#define WGM_WQ 4
#endif
#ifndef TAB4
#define TAB4 1
#endif
constexpr int NPHASES = 2 + 7 * NL;

constexpr size_t MiB = 1u << 20;
constexpr size_t WS_CTL = 0, CTL_ZERO_BYTES = 1 * MiB;
constexpr size_t WS_MOD = 1 * MiB, WS_PART = 3 * MiB, WS_KEYS = 15 * MiB, WS_DTOT = 17 * MiB, WS_WIN = 18 * MiB, WS_WOUT = 115 * MiB, WS_WQ = 147 * MiB;
constexpr size_t WS_UT = 179 * MiB, WS_VT = 435 * MiB, WS_H = 691 * MiB, WS_PROJ = 755 * MiB, WS_E = 947 * MiB, WS_OGLA = 979 * MiB, WS_Y = 1043 * MiB;
constexpr size_t WS_Z = 1107 * MiB, WS_X1 = 1235 * MiB, WS_X = 1363 * MiB, WS_Q = 1491 * MiB, WS_H2 = 1555 * MiB, WS_HQ8 = 1619 * MiB, WS_H8 = 1659 * MiB, WS_WIN8 = 1691 * MiB, WS_WOUT8 = 1739 * MiB, WS_WQ8 = 1755 * MiB, WS_Y8 = 1771 * MiB, WS_H28 = 1803 * MiB, WS_END = 1835 * MiB;
constexpr size_t WS_SU = 17 * MiB + 512 * 1024, WS_SV = 17 * MiB + 768 * 1024, WS_HSC = 2 * MiB + 640 * 1024;
static_assert(WS_WIN + (size_t)NL * INW * D * 2 <= WS_WOUT && WS_PART + (size_t)NL * 8 * NB * 6 * D * 4 <= WS_KEYS && WS_MOD + (size_t)NL * NB * 6 * D * 4 <= WS_PART, "ws map");
constexpr size_t WS_SAH = WS_SU, WS_SAY = WS_SU + 65536, WS_SB = WS_SV; constexpr int SBL = NP + 2 * D;
constexpr size_t WS_SBA = WS_SB + (size_t)NL * SBL * 4, WS_ALR8 = WS_SU + 131072;
#ifndef KROT_A
#define KROT_A 0
#endif
#ifndef KROT_B
#define KROT_B 0
#endif
#define KROT(c) (KROT_A * (((c) >> 3) & 3) + KROT_B * ((c) >> 5))
#ifndef RES16
#define RES16 1
#endif
#ifndef RES16_X
#define RES16_X RES16
#endif
#ifndef RES16_Z
#define RES16_Z RES16
#endif
#ifndef RES16_X1
#define RES16_X1 RES16
#endif
#ifndef LN1SPLIT
#define LN1SPLIT 0
#endif
#ifndef PTSPLIT
#define PTSPLIT 1
#endif
#ifndef I8_GATE
#define I8_GATE 1
#endif
#ifndef I8_WQ
#define I8_WQ 1
#endif
#ifndef I8_IN
#define I8_IN 1
#endif
#ifndef I8_OUT
#define I8_OUT 1
#endif
constexpr int CW_BAR = 4096;

constexpr int RING_OFF = 0, RING_BYTES = 131072, LDSCTL_OFF = RING_BYTES, LDS_BYTES = 147456;

#define GAS __attribute__((address_space(1)))
typedef unsigned short bf16;
typedef unsigned v4u __attribute__((ext_vector_type(4)));
typedef unsigned v2u __attribute__((ext_vector_type(2)));
typedef int v4i __attribute__((ext_vector_type(4)));
typedef float f32x4 __attribute__((ext_vector_type(4)));
typedef float f32x16 __attribute__((ext_vector_type(16)));
typedef short bf16x8 __attribute__((ext_vector_type(8)));
typedef __bf16 bf16x2v __attribute__((ext_vector_type(2)));
#define LDS_WAIT() asm volatile("s_waitcnt lgkmcnt(0)" ::: "memory")

__device__ __forceinline__ unsigned pk2(float lo, float hi) { return pg8::cvt_pk_bf16(lo, hi); }
__device__ __forceinline__ float dot2bf(unsigned w, unsigned x, float acc) { return __builtin_amdgcn_fdot2_f32_bf16(__builtin_bit_cast(bf16x2v, w), __builtin_bit_cast(bf16x2v, x), acc, false); }
__device__ __forceinline__ float bflo(unsigned u) { return __uint_as_float(u << 16); }
__device__ __forceinline__ float bfhi(unsigned u) { return __uint_as_float(u & 0xffff0000u); }
__device__ __forceinline__ float silu_f(float x) { return x * __builtin_amdgcn_rcpf(1.0f + __expf(-x)); }
__device__ __forceinline__ float logsigmoid_f(float x) { return fminf(x, 0.0f) - log1pf(__expf(-fabsf(x))); }
__device__ __forceinline__ float logsigmoid_fast(float x) { return fminf(x, 0.0f) - __logf(1.0f + __expf(-fabsf(x))); }
__device__ __forceinline__ float gelu_tanh_f(float x) { const float u = 0.7978845608028654f * (x + 0.044715f * x * x * x); return 0.5f * x * (1.0f + tanhf(u)); }
__device__ __forceinline__ unsigned pack_i8(float a, float b, float c, float d) {
    const int q0 = (int)__builtin_rintf(a), q1 = (int)__builtin_rintf(b), q2 = (int)__builtin_rintf(c), q3 = (int)__builtin_rintf(d);
    return (unsigned)(q0 & 255) | ((unsigned)(q1 & 255) << 8) | ((unsigned)(q2 & 255) << 16) | ((unsigned)(q3 & 255) << 24); }
#define WAVE_ALLREDUCE(v, OP) do { \
    v = OP(v, __uint_as_float((unsigned)__builtin_amdgcn_update_dpp(0, (int)__float_as_uint(v), 0xB1, 0xf, 0xf, false)));      \
    v = OP(v, __uint_as_float((unsigned)__builtin_amdgcn_update_dpp(0, (int)__float_as_uint(v), 0x4E, 0xf, 0xf, false)));      \
    v = OP(v, __uint_as_float((unsigned)__builtin_amdgcn_update_dpp(0, (int)__float_as_uint(v), 0x124, 0xf, 0xf, false)));     \
    v = OP(v, __uint_as_float((unsigned)__builtin_amdgcn_update_dpp(0, (int)__float_as_uint(v), 0x128, 0xf, 0xf, false)));     \
    { const auto r_ = __builtin_amdgcn_permlane16_swap(__float_as_uint(v), __float_as_uint(v), false, false); v = OP(__uint_as_float(r_[0]), __uint_as_float(r_[1])); } \
    { const auto r_ = __builtin_amdgcn_permlane32_swap(__float_as_uint(v), __float_as_uint(v), false, false); v = OP(__uint_as_float(r_[0]), __uint_as_float(r_[1])); } } while (0)
__device__ __forceinline__ float op_add_f(float a, float b) { return a + b; }
__device__ __forceinline__ float wave_sum(float v) { WAVE_ALLREDUCE(v, op_add_f); return v; }
__device__ __forceinline__ float wave_max(float v) { WAVE_ALLREDUCE(v, fmaxf); return v; }

struct Args { const float* in[19]; float* out; unsigned char* ws; int ph_lo, ph_hi; };

__device__ __forceinline__ void transpose_item(const float* W, int ldw, int col0, bf16* WTrows, int k0, int nvalid, LAS float* scr, int lane) {
    const int n = lane & 31;
    float tv[32];
#pragma unroll
    for (int i = 0; i < 32; ++i) { const int kk = 2 * i + (lane >> 5); tv[i] = (n < nvalid) ? W[(size_t)(k0 + kk) * ldw + col0 + n] : 0.f; }
#pragma unroll
    for (int i = 0; i < 32; ++i) { const int kk = 2 * i + (lane >> 5); scr[kk * 33 + n] = tv[i]; }
    LDS_WAIT(); asm volatile("" ::: "memory");
    const int c = lane & 7;
#pragma unroll
    for (int j = 0; j < 4; ++j) { const int nn = (lane >> 3) + 8 * j; const LAS float* s = scr + (8 * c) * 33 + nn;
        v4u o; o.x = pk2(s[0 * 33], s[1 * 33]); o.y = pk2(s[2 * 33], s[3 * 33]); o.z = pk2(s[4 * 33], s[5 * 33]); o.w = pk2(s[6 * 33], s[7 * 33]);
        if (nn < nvalid) *(v4u*)(WTrows + (size_t)nn * D + k0 + 8 * c) = o; }
    LDS_WAIT(); asm volatile("" ::: "memory");
}
__device__ __forceinline__ void cvt_stream(const float* src, bf16* dst, size_t n4, size_t i0, size_t stride) {
    for (size_t i = i0; i < n4; i += stride) { const f32x4 v = ((const f32x4*)src)[i]; v2u o; o.x = pk2(v.x, v.y); o.y = pk2(v.z, v.w); ((v2u*)dst)[i] = o; }
}
__device__ __forceinline__ void ph_prologue_a(const Args& a, LAS unsigned char* lds, int tid, int lane, int wave, int bx, int G) {
    const int gw = bx * NWAVES + wave, NGW = G * NWAVES;
    LAS float* cact = (LAS float*)lds;
    for (int i = tid; i < NB * D; i += NTHREADS) { const int b = i / D, d = i % D; cact[d * 8 + b] = silu_f(a.in[1][i]); }
    __syncthreads();
    float* part = (float*)(a.ws + WS_PART);
    for (int it = gw; it < NL * 8 * 48; it += NGW) {
        const int cg = it % 48, dr = (it / 48) % 8, l = it / 384;
        f32x4 acc[8];
#pragma unroll
        for (int b = 0; b < 8; ++b) acc[b] = (f32x4){0.f, 0.f, 0.f, 0.f};
        const float* w = a.in[2] + ((size_t)l * D + dr * 256) * (6 * D) + cg * 256 + lane * 4;
#pragma unroll 4
        for (int d = 0; d < 256; ++d) {
            const f32x4 wv = *(const f32x4*)(w + (size_t)d * (6 * D));
            const f32x4 c0 = *(const LAS f32x4*)(cact + (dr * 256 + d) * 8), c1 = *(const LAS f32x4*)(cact + (dr * 256 + d) * 8 + 4);
            acc[0] += wv * c0.x; acc[1] += wv * c0.y; acc[2] += wv * c0.z; acc[3] += wv * c0.w;
            acc[4] += wv * c1.x; acc[5] += wv * c1.y; acc[6] += wv * c1.z; acc[7] += wv * c1.w;
        }
#pragma unroll
        for (int b = 0; b < 8; ++b) *(f32x4*)(part + (((size_t)l * 8 + dr) * NB + b) * (6 * D) + cg * 256 + lane * 4) = acc[b];
    }
    __syncthreads();
    LAS float* scr = (LAS float*)(lds + wave * 8448);
    bf16* winT = (bf16*)(a.ws + WS_WIN); bf16* woutT = (bf16*)(a.ws + WS_WOUT); bf16* wqT = (bf16*)(a.ws + WS_WQ);
    constexpr int IPL = 6144 + 32 + 2048 + 2048;
    for (int it = gw; it < NL * IPL; it += NGW) {
        const int l = it / IPL; int r = it % IPL;
        if (r < 6144) { const int nb = r % 192, kb = r / 192, n0 = nb * 32;
            transpose_item(a.in[4] + (size_t)l * D * INW, INW, n0 < 3072 ? n0 : n0 + 16, winT + ((size_t)l * INW + n0) * D, kb * 64, 32, scr, lane); continue; }
        r -= 6144;
        if (r < 32) { transpose_item(a.in[4] + (size_t)l * D * INW, INW, 3072, winT + ((size_t)l * INW + NP) * D, r * 64, 16, scr, lane); continue; }
        r -= 32;
        if (r < 2048) { const int nb = r % 64, kb = r / 64; transpose_item(a.in[10] + (size_t)l * D * D, D, nb * 32, woutT + ((size_t)l * D + nb * 32) * D, kb * 64, 32, scr, lane); continue; }
        r -= 2048;
        { const int nb = r % 64, kb = r / 64; transpose_item(a.in[13] + (size_t)l * D * D, D, nb * 32, wqT + ((size_t)l * D + nb * 32) * D, kb * 64, 32, scr, lane); }
    }
    const size_t i0 = (size_t)bx * NTHREADS + tid, stride = (size_t)G * NTHREADS;
    cvt_stream(a.in[14], (bf16*)(a.ws + WS_KEYS), (size_t)NL * 8 * 2 * 128 * 128 / 4, i0, stride);
#if TAB4
    __syncthreads();
    { LAS float* rowst = (LAS float*)(lds + wave * 8192);
      f32x4 vnx[8];
      if (gw < 2 * NL * NE) { const int tbl0 = gw / (NL * NE), r0 = gw % (NL * NE); const float* s0 = (tbl0 ? a.in[16] : a.in[15]) + (size_t)r0 * D;
#pragma unroll
          for (int c8 = 0; c8 < 8; ++c8) vnx[c8] = *(const f32x4*)(s0 + (c8 * 64 + lane) * 4); }
      for (int row = gw; row < 2 * NL * NE; row += NGW) {
        const int tbl = row / (NL * NE), r = row % (NL * NE);
#pragma unroll
        for (int c8 = 0; c8 < 8; ++c8) *(LAS f32x4*)(rowst + (c8 * 64 + lane) * 4) = vnx[c8];
        { const int rown = row + NGW < 2 * NL * NE ? row + NGW : row; const int tbln = rown / (NL * NE), rn = rown % (NL * NE); const float* sn = (tbln ? a.in[16] : a.in[15]) + (size_t)rn * D;
#pragma unroll
          for (int c8 = 0; c8 < 8; ++c8) vnx[c8] = *(const f32x4*)(sn + (c8 * 64 + lane) * 4); }
        LDS_WAIT(); asm volatile("" ::: "memory");
        unsigned char* tb = a.ws + (tbl ? WS_VT : WS_UT) + (size_t)r * 1152;
#pragma unroll
        for (int pass = 0; pass < 2; ++pass) { const int slot = lane + 64 * pass;
            if (slot < 72) { const int col0 = (slot >> 3) * 240 + (slot & 7) * 30;
                float x[30]; float mx = 0.f;
#pragma unroll
                for (int k = 0; k < 30; ++k) { x[k] = (col0 + k < D) ? rowst[col0 + k] : 0.f; mx = fmaxf(mx, fabsf(x[k])); }
                int code = 0; float inv = 0.f;
                if (mx > 0.f) { code = (int)ceilf(8.0f * log2f(mx * (1.0f / 7.0f))) + 128; code = code < 0 ? 0 : (code > 255 ? 255 : code); inv = __builtin_amdgcn_exp2f(16.0f - (float)code * 0.125f); }
                unsigned dw[4] = {0u, 0u, 0u, 0u};
#pragma unroll
                for (int kb = 0; kb < 15; ++kb) { int a0 = (int)__builtin_rintf(x[2 * kb] * inv), a1 = (int)__builtin_rintf(x[2 * kb + 1] * inv);
                    a0 = a0 < -7 ? -7 : (a0 > 7 ? 7 : a0); a1 = a1 < -7 ? -7 : (a1 > 7 ? 7 : a1);
                    dw[kb >> 2] |= ((tbl ? (unsigned)(a0 + 8) : ((unsigned)a0 & 15u)) | (((unsigned)a1 & 15u) << 4)) << (8 * (kb & 3)); }
                dw[3] |= (unsigned)code << 24;
                *(v4u*)(tb + slot * 16) = (v4u){dw[0], dw[1], dw[2], dw[3]}; } }
        LDS_WAIT(); asm volatile("" ::: "memory");
      } }
#else
    for (int row = gw; row < 2 * NL * NE; row += NGW) {
        const int tbl = row / (NL * NE), r = row % (NL * NE);
        const float* src = (tbl ? a.in[16] : a.in[15]) + (size_t)r * D;
        f32x4 v[8]; float mx = 0.f;
#pragma unroll
        for (int c8 = 0; c8 < 8; ++c8) { v[c8] = *(const f32x4*)(src + (c8 * 64 + lane) * 4); mx = fmaxf(mx, fmaxf(fmaxf(fabsf(v[c8].x), fabsf(v[c8].y)), fmaxf(fabsf(v[c8].z), fabsf(v[c8].w)))); }
        mx = wave_max(mx);
        const float inv = mx > 0.f ? 127.0f / mx : 0.f; const int off = tbl ? 128 : 0;
        unsigned dw[8];
#pragma unroll
        for (int c8 = 0; c8 < 8; ++c8) { const int q0 = (int)__builtin_rintf(v[c8].x * inv) + off, q1 = (int)__builtin_rintf(v[c8].y * inv) + off, q2 = (int)__builtin_rintf(v[c8].z * inv) + off, q3 = (int)__builtin_rintf(v[c8].w * inv) + off;
            dw[c8] = (unsigned)(q0 & 255) | ((unsigned)(q1 & 255) << 8) | ((unsigned)(q2 & 255) << 16) | ((unsigned)(q3 & 255) << 24); }
        unsigned char* dst = a.ws + (tbl ? WS_VT : WS_UT) + (size_t)r * D;
        *(v4u*)(dst + lane * 16) = (v4u){dw[0], dw[1], dw[2], dw[3]}; *(v4u*)(dst + (64 + lane) * 16) = (v4u){dw[4], dw[5], dw[6], dw[7]};
        if (lane == 0) ((float*)(a.ws + (tbl ? WS_SV : WS_SU)))[r] = mx * (1.0f / 127.0f);
    }
#endif
}

template <bool SPLIT> __device__ __forceinline__ void ln_tail(const float (&z)[32], int t, int lane, const float* g, const float* bta, float* xout, const float* sh, const float* sc, bf16* hout, unsigned char* q8, float* q8s, LAS unsigned char* q8stage = nullptr, unsigned char* a8 = nullptr, float* a8s = nullptr, bf16* xb = nullptr) {
    float s = 0.f;
#pragma unroll
    for (int i = 0; i < 32; ++i) s += z[i];
    const float mu = wave_sum(s) * (1.0f / D);
    float q = 0.f;
#pragma unroll
    for (int i = 0; i < 32; ++i) { const float d = z[i] - mu; q += d * d; }
    const float rs = rsqrtf(wave_sum(q) * (1.0f / D) + EPS);
    float hv[32]; float mx = 0.f; f32x4 xf[8];
#pragma unroll
    for (int c = 0; c < 8; ++c) { const int col = (c * 64 + lane) * 4;
        const f32x4 g0 = *(const f32x4*)(g + col), b0 = *(const f32x4*)(bta + col);
        f32x4 x0;
        x0.x = (z[c * 4 + 0] - mu) * rs * g0.x + b0.x; x0.y = (z[c * 4 + 1] - mu) * rs * g0.y + b0.y; x0.z = (z[c * 4 + 2] - mu) * rs * g0.z + b0.z; x0.w = (z[c * 4 + 3] - mu) * rs * g0.w + b0.w;
        if (SPLIT) { if (xb || xout) xf[c] = x0; }
        else { if (xb) { v2u o; o.x = pk2(x0.x, x0.y); o.y = pk2(x0.z, x0.w); *(v2u*)(xb + (size_t)t * D + col) = o; } else if (xout) *(f32x4*)(xout + (size_t)t * D + col) = x0; }
        if (hout || q8 || a8) { const f32x4 s0 = *(const f32x4*)(sc + col), h0 = *(const f32x4*)(sh + col);
            hv[c * 4] = x0.x * (1.f + s0.x) + h0.x; hv[c * 4 + 1] = x0.y * (1.f + s0.y) + h0.y; hv[c * 4 + 2] = x0.z * (1.f + s0.z) + h0.z; hv[c * 4 + 3] = x0.w * (1.f + s0.w) + h0.w;
            if (!SPLIT && hout) { v2u o; o.x = pk2(hv[c * 4], hv[c * 4 + 1]); o.y = pk2(hv[c * 4 + 2], hv[c * 4 + 3]); *(v2u*)(hout + (size_t)t * D + col) = o; }
            if (q8 || a8) mx = fmaxf(mx, fmaxf(fmaxf(fabsf(hv[c * 4]), fabsf(hv[c * 4 + 1])), fmaxf(fabsf(hv[c * 4 + 2]), fabsf(hv[c * 4 + 3])))); }
        if (SPLIT && c == 3) asm volatile("" ::: "memory");
    }
    if (SPLIT)
#pragma unroll
    for (int c = 0; c < 8; ++c) { const int col = (c * 64 + lane) * 4;
        if (xb) { v2u o; o.x = pk2(xf[c].x, xf[c].y); o.y = pk2(xf[c].z, xf[c].w); *(v2u*)(xb + (size_t)t * D + col) = o; }
        else if (xout) *(f32x4*)(xout + (size_t)t * D + col) = xf[c];
        if (hout) { v2u o; o.x = pk2(hv[c * 4], hv[c * 4 + 1]); o.y = pk2(hv[c * 4 + 2], hv[c * 4 + 3]); *(v2u*)(hout + (size_t)t * D + col) = o; }
    }
    if (q8 || a8) {
        mx = wave_max(mx);
        const float qmax_ = (q8 && TAB4) ? 119.0f : 127.0f;
        const float inv = mx > 0.f ? qmax_ / mx : 0.f;
        unsigned dw[8];
#pragma unroll
        for (int c = 0; c < 8; ++c) { const int q0 = (int)__builtin_rintf(hv[c * 4] * inv), q1 = (int)__builtin_rintf(hv[c * 4 + 1] * inv), q2 = (int)__builtin_rintf(hv[c * 4 + 2] * inv), q3 = (int)__builtin_rintf(hv[c * 4 + 3] * inv);
            dw[c] = (unsigned)(q0 & 255) | ((unsigned)(q1 & 255) << 8) | ((unsigned)(q2 & 255) << 16) | ((unsigned)(q3 & 255) << 24); }
        if (a8) {
#pragma unroll
            for (int c = 0; c < 8; ++c) *(unsigned*)(a8 + (size_t)t * D + (c * 64 + lane) * 4) = dw[c];
            if (a8s && lane == 0) a8s[t] = mx / qmax_; }
        if (q8) {
#if TAB4
        { LAS unsigned* st32 = (LAS unsigned*)q8stage; LAS unsigned char* st8 = (LAS unsigned char*)q8stage;
#pragma unroll
          for (int i = 0; i < 9; ++i) st32[lane + 64 * i] = 0u;
          LDS_WAIT(); asm volatile("" ::: "memory");
#pragma unroll
          for (int c = 0; c < 8; ++c)
#pragma unroll
              for (int jp = 0; jp < 2; ++jp) { const int col = (c * 64 + lane) * 4 + 2 * jp, u = col / 240, r = col - u * 240, l7 = r / 30, k = r - l7 * 30;
                  const int q0 = (int)(signed char)((dw[c] >> (16 * jp)) & 255u), q1 = (int)(signed char)((dw[c] >> (16 * jp + 8)) & 255u);
                  const int l0 = ((q0 + 8) & 15) - 8, l1 = ((q1 + 8) & 15) - 8, h0 = (q0 - l0) >> 4, h1 = (q1 - l1) >> 4;
                  LAS unsigned char* sp = st8 + (u * 8 + l7) * 32 + (k >> 1);
                  sp[0] = (unsigned char)((l0 & 15) | ((l1 & 15) << 4)); sp[16] = (unsigned char)((h0 & 15) | ((h1 & 15) << 4)); }
          LDS_WAIT(); asm volatile("" ::: "memory");
          unsigned* d32 = (unsigned*)(q8 + (size_t)t * 2304);
#pragma unroll
          for (int i = 0; i < 9; ++i) d32[lane + 64 * i] = st32[lane + 64 * i];
          LDS_WAIT(); asm volatile("" ::: "memory"); }
#else
        unsigned char* dst = q8 + (size_t)t * D;
        *(v4u*)(dst + lane * 16) = (v4u){dw[0], dw[1], dw[2], dw[3]}; *(v4u*)(dst + (64 + lane) * 16) = (v4u){dw[4], dw[5], dw[6], dw[7]};
#endif
        if (lane == 0) q8s[t] = mx / qmax_; }
    }
}

__device__ __forceinline__ void ph_prologue_b(const Args& a, LAS unsigned char* lds, int tid, int lane, int wave, int bx, int G) {
    const float* part = (const float*)(a.ws + WS_PART); float* mod = (float*)(a.ws + WS_MOD);
    for (int i = bx * NTHREADS + tid; i < NL * NB * 6 * D / 4; i += G * NTHREADS) {
        const int idx = i * 4, e = idx % (6 * D), b = (idx / (6 * D)) % NB, l = idx / (6 * D * NB);
        f32x4 s = *(const f32x4*)(a.in[3] + l * 6 * D + e);
#pragma unroll
        for (int dr = 0; dr < 8; ++dr) s += *(const f32x4*)(part + (((size_t)l * 8 + dr) * NB + b) * (6 * D) + e);
        *(f32x4*)(mod + idx) = s;
    }
    LAS float* msh = (LAS float*)lds;
    bf16* hbuf = (bf16*)(a.ws + WS_H);
    for (int ch = bx; ch < NCHUNK; ch += G) {
        const int b = ch / NCH;
        for (int i = tid; i < 1024; i += NTHREADS) { const int e = i * 4;
            f32x4 s = *(const f32x4*)(a.in[3] + e);
#pragma unroll
            for (int dr = 0; dr < 8; ++dr) s += *(const f32x4*)(part + (((size_t)0 * 8 + dr) * NB + b) * (6 * D) + e);
            *(LAS f32x4*)(msh + e) = s; }
        __syncthreads();
        for (int i = 0; i < 8; ++i) { const int t = ch * 64 + wave * 8 + i;
            float hv[32]; float mx = 0.f;
#pragma unroll
            for (int c = 0; c < 4; ++c) { const int col = (c * 64 + lane) * 8;
                const f32x4 x0 = *(const f32x4*)(a.in[0] + (size_t)t * D + col), x1 = *(const f32x4*)(a.in[0] + (size_t)t * D + col + 4);
                const f32x4 h0 = *(const LAS f32x4*)(msh + col), h1 = *(const LAS f32x4*)(msh + col + 4), s0 = *(const LAS f32x4*)(msh + 2048 + col), s1 = *(const LAS f32x4*)(msh + 2048 + col + 4);
#pragma unroll
                for (int j = 0; j < 4; ++j) { hv[c * 8 + j] = x0[j] * (1.f + s0[j]) + h0[j]; hv[c * 8 + 4 + j] = x1[j] * (1.f + s1[j]) + h1[j]; }
                v4u o; o.x = pk2(hv[c * 8], hv[c * 8 + 1]); o.y = pk2(hv[c * 8 + 2], hv[c * 8 + 3]); o.z = pk2(hv[c * 8 + 4], hv[c * 8 + 5]); o.w = pk2(hv[c * 8 + 6], hv[c * 8 + 7]);
#if !I8_GATE
                *(v4u*)(hbuf + (size_t)t * D + col) = o;
#endif
#if RES16_X
                { v4u xo; xo.x = pk2(x0.x, x0.y); xo.y = pk2(x0.z, x0.w); xo.z = pk2(x1.x, x1.y); xo.w = pk2(x1.z, x1.w); *(v4u*)((bf16*)(a.ws + WS_X) + (size_t)t * D + col) = xo; }
#endif
#pragma unroll
                for (int j = 0; j < 8; ++j) mx = fmaxf(mx, fabsf(hv[c * 8 + j])); }
            mx = wave_max(mx);
            const float inv = mx > 0.f ? 127.0f / mx : 0.f;
#pragma unroll
            for (int c = 0; c < 4; ++c) { v2u o;
                o.x = pack_i8(hv[c * 8] * inv, hv[c * 8 + 1] * inv, hv[c * 8 + 2] * inv, hv[c * 8 + 3] * inv); o.y = pack_i8(hv[c * 8 + 4] * inv, hv[c * 8 + 5] * inv, hv[c * 8 + 6] * inv, hv[c * 8 + 7] * inv);
                *(v2u*)(a.ws + WS_H8 + (size_t)t * D + (c * 64 + lane) * 8) = o; }
            if (lane == 0) ((float*)(a.ws + WS_SAH))[t] = mx * (1.0f / 127.0f); }
        __syncthreads();
    }
    { const int gw = bx * NWAVES + wave, NGW = G * NWAVES;
      for (int row = gw; row < NL * (SBL + 16); row += NGW) { const int l = row / (SBL + 16), r = row % (SBL + 16);
          const bf16* src; unsigned char* dst; float* sdst;
          if (r < NP) { src = (const bf16*)(a.ws + WS_WIN) + ((size_t)l * INW + r) * D; dst = a.ws + WS_WIN8 + ((size_t)l * NP + r) * D; sdst = (float*)(a.ws + WS_SB) + l * SBL + r; }
          else if (r < NP + D) { src = (const bf16*)(a.ws + WS_WOUT) + ((size_t)l * D + (r - NP)) * D; dst = a.ws + WS_WOUT8 + ((size_t)l * D + (r - NP)) * D; sdst = (float*)(a.ws + WS_SB) + l * SBL + r; }
          else if (r < SBL) { src = (const bf16*)(a.ws + WS_WQ) + ((size_t)l * D + (r - NP - D)) * D; dst = a.ws + WS_WQ8 + ((size_t)l * D + (r - NP - D)) * D; sdst = (float*)(a.ws + WS_SB) + l * SBL + r; }
          else { src = (const bf16*)(a.ws + WS_WIN) + ((size_t)l * INW + NP + (r - SBL)) * D; dst = a.ws + WS_ALR8 + ((size_t)l * 16 + (r - SBL)) * D; sdst = (float*)(a.ws + WS_SBA) + l * 16 + (r - SBL); }
          v4u w[4]; float mx = 0.f;
#pragma unroll
          for (int c = 0; c < 4; ++c) w[c] = *(const v4u*)(src + (c * 64 + lane) * 8);
#pragma unroll
          for (int c = 0; c < 4; ++c)
#pragma unroll
              for (int j = 0; j < 4; ++j) mx = fmaxf(mx, fmaxf(fabsf(bflo(w[c][j])), fabsf(bfhi(w[c][j]))));
          mx = wave_max(mx);
          const float inv = mx > 0.f ? 127.0f / mx : 0.f;
#pragma unroll
          for (int c = 0; c < 4; ++c) { v2u o;
              o.x = pack_i8(bflo(w[c][0]) * inv, bfhi(w[c][0]) * inv, bflo(w[c][1]) * inv, bfhi(w[c][1]) * inv); o.y = pack_i8(bflo(w[c][2]) * inv, bfhi(w[c][2]) * inv, bflo(w[c][3]) * inv, bfhi(w[c][3]) * inv);
              *(v2u*)(dst + (c * 64 + lane) * 8) = o; }
          if (lane == 0) *sdst = mx * (1.0f / 127.0f); } }
}

__device__ __forceinline__ void gate_prep(const Args& a, int l, LAS unsigned char* lds, int tid, int lane, int wave, int ch) {
    const bf16* hbuf = (const bf16*)(a.ws + WS_H); const bf16* waT = (const bf16*)(a.ws + WS_WIN) + ((size_t)l * INW + NP) * D;
    bf16* Ebuf = (bf16*)(a.ws + WS_E); float* dtot = (float*)(a.ws + WS_DTOT);
    const int t0 = ch * 64, l15 = lane & 15, lq = lane >> 4, mt = wave & 3, kh = wave >> 2;
    LAS float* alr = (LAS float*)(lds + LDSCTL_OFF + 1024);
#if I8_GATE
    { v4i acc = (v4i){0, 0, 0, 0};
      const unsigned char* hA = a.ws + WS_H8 + (size_t)(t0 + 16 * mt + l15) * D + kh * 1024 + 16 * lq;
      const unsigned char* wB = a.ws + WS_ALR8 + ((size_t)l * 16 + l15) * D + kh * 1024 + 16 * lq;
#pragma unroll 8
      for (int ks = 0; ks < 16; ++ks) { const v4i av = *(const v4i*)(hA + 64 * ks), bv = *(const v4i*)(wB + 64 * ks); acc = __builtin_amdgcn_mfma_i32_16x16x64_i8(av, bv, acc, 0, 0, 0); }
      const float sw = ((const float*)(a.ws + WS_SBA))[l * 16 + l15];
#pragma unroll
      for (int r = 0; r < 4; ++r) { const int tl = 16 * mt + 4 * lq + r; alr[(kh * 64 + tl) * 16 + l15] = (float)acc[r] * (sw * ((const float*)(a.ws + WS_SAH))[t0 + tl]); } }
#else
    f32x4 acc = (f32x4){0.f, 0.f, 0.f, 0.f};
    const bf16* hA = hbuf + (size_t)(t0 + 16 * mt + l15) * D + kh * 1024 + 8 * lq;
    const bf16* wB = waT + (size_t)l15 * D + kh * 1024 + 8 * lq;
#pragma unroll 8
    for (int ks = 0; ks < 32; ++ks) { const bf16x8 av = *(const bf16x8*)(hA + 32 * ks), bv = *(const bf16x8*)(wB + 32 * ks); acc = __builtin_amdgcn_mfma_f32_16x16x32_bf16(av, bv, acc, 0, 0, 0); }
#pragma unroll
    for (int r = 0; r < 4; ++r) alr[(kh * 64 + 16 * mt + 4 * lq + r) * 16 + l15] = acc[r];
#endif
    __syncthreads();
    const int col = tid;
    float wg[16];
#pragma unroll
    for (int r = 0; r < 16; ++r) wg[r] = a.in[5][((size_t)l * RANK + r) * GKW + col];
    const float bgc = a.in[6][l * GKW + col];
    for (int i = tid; i < 256; i += NTHREADS) *(LAS f32x4*)(alr + i * 4) = *(const LAS f32x4*)(alr + i * 4) + *(const LAS f32x4*)(alr + 1024 + i * 4);
    __syncthreads();
    float tot = 0.f;
    LAS float* lac = (LAS float*)lds;
    for (int j = 0; j < 64; ++j) { float lg0 = bgc, lg1 = 0.f;
#pragma unroll
        for (int r4 = 0; r4 < 4; ++r4) { const f32x4 p = *(const LAS f32x4*)(alr + j * 16 + r4 * 4);
            lg0 += p.x * wg[r4 * 4] + p.z * wg[r4 * 4 + 2]; lg1 += p.y * wg[r4 * 4 + 1] + p.w * wg[r4 * 4 + 3]; }
        const float la = logsigmoid_fast(lg0 + lg1) * (1.0f / 16.0f); lac[j * GKW + col] = la; tot += la; }
    float run = 0.f;
    for (int j = 0; j < 64; ++j) { run += lac[j * GKW + col]; lac[j * GKW + col] = __expf(tot - run); }
    __syncthreads();
    for (int i = 0; i < 8; ++i) { const int j = wave * 8 + i;
        const f32x4 e0 = *(const LAS f32x4*)(lac + j * GKW + lane * 8), e1 = *(const LAS f32x4*)(lac + j * GKW + lane * 8 + 4);
        v4u o; o.x = pk2(e0.x, e0.y); o.y = pk2(e0.z, e0.w); o.z = pk2(e1.x, e1.y); o.w = pk2(e1.z, e1.w);
        *(v4u*)(Ebuf + (size_t)(t0 + j) * GKW + lane * 8) = o; }
    dtot[(size_t)ch * GKW + col] = __expf(tot);
    __syncthreads();
}

__device__ __forceinline__ void gla_unit(const Args& a, LAS unsigned char* lds, int tid, int lane, int wave, int un) {
    const bf16* proj = (const bf16*)(a.ws + WS_PROJ); const bf16* Ebuf = (const bf16*)(a.ws + WS_E); const float* dtot = (const float*)(a.ws + WS_DTOT); bf16* ogla = (bf16*)(a.ws + WS_OGLA);
    const int pair_ = (un & 7) * 4 + (un >> 6), dvs = (un >> 3) & 7, hh = pair_ & 3, b = pair_ >> 2;
    LAS bf16* kdT0 = (LAS bf16*)lds; LAS bf16* vT0 = (LAS bf16*)(lds + 18432); LAS bf16* ST0 = (LAS bf16*)(lds + 18432 + 4608);
    LAS bf16* kdT1 = (LAS bf16*)(lds + 32768); LAS bf16* vT1 = (LAS bf16*)(lds + 32768 + 18432); LAS bf16* ST1 = (LAS bf16*)(lds + 32768 + 18432 + 4608);
    const int l15 = lane & 15, lq = lane >> 4, jl = tid >> 3, dv4 = (tid & 7) * 4, jt = (wave & 3) * 16, dvt = (wave >> 2) * 16, jp = tid >> 4, c16 = tid & 15;
#define GLA_BAR() do { asm volatile("s_waitcnt lgkmcnt(0)" ::: "memory"); __builtin_amdgcn_s_barrier(); asm volatile("" ::: "memory"); } while (0)
    f32x4 S0 = (f32x4){0.f, 0.f, 0.f, 0.f}, S1 = (f32x4){0.f, 0.f, 0.f, 0.f};
    v4u kn0[2], kn1[2], kn2[2], en0[2], en1[2], en2[2]; v2u vn0, vn1, vn2; bf16x8 qn0[4], qn1[4], qn2[4], qc[4]; f32x4 dn0, dn1, dn2, dc;
#define GLA_LOAD(c, kn, en, vn, qn, dn) do { const int t0c = b * SEQ + (c) * 64; const bf16* pr = proj + (size_t)(t0c + jl) * NP; \
          \
        kn[0] = *(const v4u*)(proj + (size_t)(t0c + 2 * jp) * NP + PK + hh * 128 + 8 * c16); kn[1] = *(const v4u*)(proj + (size_t)(t0c + 2 * jp + 1) * NP + PK + hh * 128 + 8 * c16); \
        en[0] = *(const v4u*)(Ebuf + (size_t)(t0c + 2 * jp) * GKW + hh * 128 + 8 * c16); en[1] = *(const v4u*)(Ebuf + (size_t)(t0c + 2 * jp + 1) * GKW + hh * 128 + 8 * c16); \
        vn = *(const v2u*)(pr + PV + hh * 256 + dvs * 32 + dv4); \
        _Pragma("unroll") for (int ks_ = 0; ks_ < 4; ++ks_) qn[ks_] = *(const bf16x8*)(proj + (size_t)(t0c + jt + l15) * NP + PQ + hh * 128 + 32 * ks_ + 8 * lq); \
        dn = *(const f32x4*)(dtot + (size_t)(b * NCH + (c)) * GKW + hh * 128 + 16 * wave + 4 * lq); } while (0)
#define GLA_PREPL(kn, en, vn, kdT, vT) do { \
        _Pragma("unroll") for (int i_ = 0; i_ < 8; ++i_) { const unsigned wa_ = kn[0][i_ >> 1], wb_ = kn[1][i_ >> 1], ea_ = en[0][i_ >> 1], eb_ = en[1][i_ >> 1]; \
            const float pa_ = ((i_ & 1) ? bfhi(wa_) : bflo(wa_)) * ((i_ & 1) ? bfhi(ea_) : bflo(ea_)), pb_ = ((i_ & 1) ? bfhi(wb_) : bflo(wb_)) * ((i_ & 1) ? bfhi(eb_) : bflo(eb_)); \
            *(LAS unsigned*)(kdT + (8 * c16 + i_) * 72 + ((((jp >> 2) ^ c16) & 7) << 3) + ((2 * jp) & 7)) = pk2(pa_, pb_); }     \
        _Pragma("unroll") for (int i_ = 0; i_ < 4; ++i_) { const unsigned w_ = vn[i_ >> 1]; vT[(dv4 + i_) * 72 + jl] = (bf16)((i_ & 1) ? (w_ >> 16) : (w_ & 0xffffu)); } } while (0)
#define GLA_QD(qn, dn) do { _Pragma("unroll") for (int ks_ = 0; ks_ < 4; ++ks_) qc[ks_] = qn[ks_]; dc = dn; } while (0)
#define GLA_BODYA(kdT, vT, ST) do { \
        S0 = S0 * dc; S1 = S1 * dc; \
        _Pragma("unroll") for (int ks = 0; ks < 2; ++ks) { \
            const bf16x8 A_ = *(const LAS bf16x8*)(kdT + (16 * wave + l15) * 72 + ((((4 * ks + lq) ^ (2 * wave + (l15 >> 3))) & 7) << 3)); \
            const bf16x8 B0_ = *(const LAS bf16x8*)(vT + l15 * 72 + 32 * ks + 8 * lq), B1_ = *(const LAS bf16x8*)(vT + (16 + l15) * 72 + 32 * ks + 8 * lq); \
            S0 = __builtin_amdgcn_mfma_f32_16x16x32_bf16(A_, B0_, S0, 0, 0, 0); S1 = __builtin_amdgcn_mfma_f32_16x16x32_bf16(A_, B1_, S1, 0, 0, 0); } \
        { v2u w0_, w1_; w0_.x = pk2(S0.x, S0.y); w0_.y = pk2(S0.z, S0.w); w1_.x = pk2(S1.x, S1.y); w1_.y = pk2(S1.z, S1.w); \
          *(LAS v2u*)(ST + l15 * 136 + 16 * wave + 4 * lq) = w0_; *(LAS v2u*)(ST + (16 + l15) * 136 + 16 * wave + 4 * lq) = w1_; } } while (0)
#define GLA_BODYB(c, ST) do { \
        f32x4 O_ = (f32x4){0.f, 0.f, 0.f, 0.f}; \
        _Pragma("unroll") for (int ks = 0; ks < 4; ++ks) { const bf16x8 A_ = *(const LAS bf16x8*)(ST + (dvt + l15) * 136 + 32 * ks + 8 * lq); O_ = __builtin_amdgcn_mfma_f32_16x16x32_bf16(A_, qc[ks], O_, 0, 0, 0); } \
        { const f32x4 Os_ = O_ * 0.08838834764831845f; v2u ob_; ob_.x = pk2(Os_.x, Os_.y); ob_.y = pk2(Os_.z, Os_.w); \
          *(v2u*)(ogla + (size_t)(b * SEQ + (c) * 64 + jt + l15) * 1024 + hh * 256 + dvs * 32 + dvt + 4 * lq) = ob_; } } while (0)
#define GLA_STEP(c, RA, RB, LA, LB) do { { const int cn_ = (c) + 3 < NCH ? (c) + 3 : NCH - 1; GLA_LOAD(cn_, kn##RA, en##RA, vn##RA, qn##RA, dn##RA); } \
        GLA_BODYA(kdT##LA, vT##LA, ST##LA); GLA_PREPL(kn##RB, en##RB, vn##RB, kdT##LB, vT##LB); GLA_BAR(); GLA_BODYB(c, ST##LA); GLA_QD(qn##RB, dn##RB); } while (0)
    GLA_LOAD(0, kn0, en0, vn0, qn0, dn0); GLA_LOAD(1, kn1, en1, vn1, qn1, dn1); GLA_LOAD(2, kn2, en2, vn2, qn2, dn2);
    GLA_PREPL(kn0, en0, vn0, kdT0, vT0); GLA_QD(qn0, dn0);
    GLA_BAR();
    static_assert(NCH == 32, "the step schedule below is written for 32 chunks: 5 x 6 + 2");
    for (int c = 0; c < 30; c += 6) {
        GLA_STEP(c, 0, 1, 0, 1); GLA_STEP(c + 1, 1, 2, 1, 0); GLA_STEP(c + 2, 2, 0, 0, 1); GLA_STEP(c + 3, 0, 1, 1, 0); GLA_STEP(c + 4, 1, 2, 0, 1); GLA_STEP(c + 5, 2, 0, 1, 0);
    }
    GLA_STEP(30, 0, 1, 0, 1); GLA_STEP(31, 1, 2, 1, 0);
#undef GLA_STEP
#undef GLA_PREPL
#undef GLA_QD
#undef GLA_BODYA
#undef GLA_BODYB
#undef GLA_BAR
#undef GLA_LOAD
}

__device__ __forceinline__ void unpack16(const v4u& p0, const v4u& p1, float (&o)[16]) {
#pragma unroll
    for (int j = 0; j < 4; ++j) { o[2 * j] = bflo(p0[j]); o[2 * j + 1] = bfhi(p0[j]); o[8 + 2 * j] = bflo(p1[j]); o[8 + 2 * j + 1] = bfhi(p1[j]); }
}
__device__ __forceinline__ void mixpost_chunk(const Args& a, int l, int lane, int wave, int ch) {
    const bf16* proj = (const bf16*)(a.ws + WS_PROJ); const bf16* ogla = (const bf16*)(a.ws + WS_OGLA);
    const int c0 = 16 * lane, tfirst = ch * 64 + wave * 8, sfirst = tfirst % SEQ;
    float gn[16], cw0[16], cw1[16], cw2[16], cn[16], u1[16], u2[16];
#pragma unroll
    for (int i = 0; i < 16; ++i) { gn[i] = a.in[7][l * 256 + ((c0 + i) & 255)]; cw0[i] = a.in[8][(size_t)l * 3072 + c0 + i]; cw1[i] = a.in[8][(size_t)l * 3072 + 1024 + c0 + i];
        cw2[i] = a.in[8][(size_t)l * 3072 + 2048 + c0 + i]; cn[i] = a.in[9][l * 1024 + c0 + i]; u1[i] = 0.f; u2[i] = 0.f; }
    if (sfirst >= 2) {
        float cc[16], chh[16];
        { const bf16* pr = proj + (size_t)(tfirst - 2) * NP; unpack16(*(const v4u*)(pr + PCC + c0), *(const v4u*)(pr + PCC + c0 + 8), cc); unpack16(*(const v4u*)(pr + PCH + c0), *(const v4u*)(pr + PCH + c0 + 8), chh); }
#pragma unroll
        for (int i = 0; i < 16; ++i) u2[i] = cc[i] * chh[i];
        { const bf16* pr = proj + (size_t)(tfirst - 1) * NP; unpack16(*(const v4u*)(pr + PCC + c0), *(const v4u*)(pr + PCC + c0 + 8), cc); unpack16(*(const v4u*)(pr + PCH + c0), *(const v4u*)(pr + PCH + c0 + 8), chh); }
#pragma unroll
        for (int i = 0; i < 16; ++i) u1[i] = cc[i] * chh[i];
    }
#pragma unroll 2
    for (int it = 0; it < 8; ++it) { const int t = tfirst + it; const bf16* pr = proj + (size_t)t * NP;
        float o[16], r[16], cb[16], cc[16], chh[16];
        unpack16(*(const v4u*)(ogla + (size_t)t * 1024 + c0), *(const v4u*)(ogla + (size_t)t * 1024 + c0 + 8), o);
        unpack16(*(const v4u*)(pr + PR + c0), *(const v4u*)(pr + PR + c0 + 8), r);
        unpack16(*(const v4u*)(pr + PCB + c0), *(const v4u*)(pr + PCB + c0 + 8), cb);
        unpack16(*(const v4u*)(pr + PCC + c0), *(const v4u*)(pr + PCC + c0 + 8), cc);
        unpack16(*(const v4u*)(pr + PCH + c0), *(const v4u*)(pr + PCH + c0 + 8), chh);
        float ss = 0.f;
#pragma unroll
        for (int i = 0; i < 16; ++i) ss += o[i] * o[i];
        ss += __uint_as_float((unsigned)__builtin_amdgcn_update_dpp(0, (int)__float_as_uint(ss), 0xB1, 0xf, 0xf, false)); ss += __uint_as_float((unsigned)__builtin_amdgcn_update_dpp(0, (int)__float_as_uint(ss), 0x4E, 0xf, 0xf, false));
        ss += __uint_as_float((unsigned)__builtin_amdgcn_update_dpp(0, (int)__float_as_uint(ss), 0x124, 0xf, 0xf, false)); ss += __uint_as_float((unsigned)__builtin_amdgcn_update_dpp(0, (int)__float_as_uint(ss), 0x128, 0xf, 0xf, false));
        const float rg = rsqrtf(ss * (1.0f / 256.f) + EPS);
        float val[16]; float s2 = 0.f;
#pragma unroll
        for (int i = 0; i < 16; ++i) { const float u0 = cc[i] * chh[i]; val[i] = cb[i] * (cw0[i] * u2[i] + cw1[i] * u1[i] + cw2[i] * u0); s2 += val[i] * val[i]; u2[i] = u1[i]; u1[i] = u0; }
        const float rc = rsqrtf(wave_sum(s2) * (1.0f / 1024.f) + EPS);
        float ya[16], yb[16]; float mx = 0.f;
#pragma unroll
        for (int i = 0; i < 16; ++i) { ya[i] = o[i] * rg * gn[i] * silu_f(r[i]); yb[i] = val[i] * rc * cn[i]; mx = fmaxf(mx, fmaxf(fabsf(ya[i]), fabsf(yb[i]))); }
        mx = wave_max(mx);
        const float inv = mx > 0.f ? 127.0f / mx : 0.f;
        v4u y0, y1;
#pragma unroll
        for (int j = 0; j < 4; ++j) { y0[j] = pack_i8(ya[4 * j] * inv, ya[4 * j + 1] * inv, ya[4 * j + 2] * inv, ya[4 * j + 3] * inv); y1[j] = pack_i8(yb[4 * j] * inv, yb[4 * j + 1] * inv, yb[4 * j + 2] * inv, yb[4 * j + 3] * inv); }
        unsigned char* yr = a.ws + WS_Y8 + (size_t)t * D;
        *(v4u*)(yr + c0) = y0; *(v4u*)(yr + 1024 + c0) = y1;
#if !I8_OUT
        { v4u b0, b1, b2, b3;
#pragma unroll
          for (int j = 0; j < 4; ++j) { b0[j] = pk2(ya[2 * j], ya[2 * j + 1]); b1[j] = pk2(ya[8 + 2 * j], ya[9 + 2 * j]); b2[j] = pk2(yb[2 * j], yb[2 * j + 1]); b3[j] = pk2(yb[8 + 2 * j], yb[9 + 2 * j]); }
          bf16* ybr = (bf16*)(a.ws + WS_Y) + (size_t)t * D;
          *(v4u*)(ybr + c0) = b0; *(v4u*)(ybr + c0 + 8) = b1; *(v4u*)(ybr + 1024 + c0) = b2; *(v4u*)(ybr + 1024 + c0 + 8) = b3; }
#endif
        if (lane == 0) ((float*)(a.ws + WS_SAY))[t] = mx * (1.0f / 127.0f);
    }
}

__device__ __forceinline__ void ln1_chunk(const Args& a, int l, LAS unsigned char* lds, int lane, int wave, int ch) {
    const float* zbuf = (const float*)(a.ws + WS_Z); const float* mod = (const float*)(a.ws + WS_MOD);
    const int b = ch / NCH; const float* mb = mod + ((size_t)l * NB + b) * 6 * D;
#pragma unroll 2
    for (int it = 0; it < 8; ++it) { const int t = ch * 64 + wave * 8 + it;
        float z[32];
#pragma unroll
#if RES16_Z
        for (int c = 0; c < 8; ++c) { const v2u v0 = *(const v2u*)((const bf16*)zbuf + (size_t)t * D + (c * 64 + lane) * 4); z[c * 4] = bflo(v0.x); z[c * 4 + 1] = bfhi(v0.x); z[c * 4 + 2] = bflo(v0.y); z[c * 4 + 3] = bfhi(v0.y); }
#else
        for (int c = 0; c < 8; ++c) { const f32x4 v0 = *(const f32x4*)(zbuf + (size_t)t * D + (c * 64 + lane) * 4); z[c * 4] = v0.x; z[c * 4 + 1] = v0.y; z[c * 4 + 2] = v0.z; z[c * 4 + 3] = v0.w; }
#endif
        ln_tail<LN1SPLIT>(z, t, lane, a.in[11] + (size_t)l * D, a.in[12] + (size_t)l * D, RES16_X1 ? (float*)nullptr : (float*)(a.ws + WS_X1), mb + 3 * D, mb + 4 * D, I8_WQ ? (bf16*)nullptr : (bf16*)(a.ws + WS_H2), a.ws + WS_HQ8, (float*)(a.ws + WS_HSC), lds + wave * 2304, I8_WQ ? a.ws + WS_H28 : (unsigned char*)nullptr, nullptr, RES16_X1 ? (bf16*)(a.ws + WS_X1) : (bf16*)nullptr);
    }
}

template <int N> __device__ __forceinline__ void bitonic_sort_desc(float (&v)[N]) {
#pragma unroll
    for (int k = 2; k <= N; k <<= 1)
#pragma unroll
        for (int j = k >> 1; j > 0; j >>= 1)
#pragma unroll
            for (int i = 0; i < N; ++i) { const int p = i ^ j; if (p > i) { const bool desc = ((i & k) == 0); const float x = v[i], y = v[p]; const float mx = fmaxf(x, y), mn = fminf(x, y); v[i] = desc ? mx : mn; v[p] = desc ? mn : mx; } }
}
__device__ __forceinline__ void merge_top16(float (&x)[16], const float (&y)[16]) {
#pragma unroll
    for (int i = 0; i < 16; ++i) x[i] = fmaxf(x[i], y[15 - i]);
#pragma unroll
    for (int j = 8; j > 0; j >>= 1)
#pragma unroll
        for (int i = 0; i < 16; ++i) { const int p = i ^ j; if (p > i) { const float u = x[i], w = x[p]; x[i] = fmaxf(u, w); x[p] = fminf(u, w); } }
}
__device__ __forceinline__ void ce_desc(float& ka, int& pa, float& kb, int& pb) { const bool sw = kb > ka; const float k0 = sw ? kb : ka, k1 = sw ? ka : kb; const int p0 = sw ? pb : pa, p1 = sw ? pa : pb; ka = k0; pa = p0; kb = k1; pb = p1; }
__device__ __forceinline__ void bitonic_sort_desc_kp(float (&k)[16], int (&p)[16]) {
#pragma unroll
    for (int kk = 2; kk <= 16; kk <<= 1)
#pragma unroll
        for (int j = kk >> 1; j > 0; j >>= 1)
#pragma unroll
            for (int i = 0; i < 16; ++i) { const int q = i ^ j; if (q > i) { if ((i & kk) == 0) ce_desc(k[i], p[i], k[q], p[q]); else ce_desc(k[q], p[q], k[i], p[i]); } }
}
__device__ __forceinline__ void merge_top16_kp(float (&k)[16], int (&p)[16], const float (&k2)[16], const int (&p2)[16]) {
#pragma unroll
    for (int i = 0; i < 16; ++i) { const bool sw = k2[15 - i] > k[i]; k[i] = sw ? k2[15 - i] : k[i]; p[i] = sw ? p2[15 - i] : p[i]; }
#pragma unroll
    for (int j = 8; j > 0; j >>= 1)
#pragma unroll
        for (int i = 0; i < 16; ++i) { const int q = i ^ j; if (q > i) ce_desc(k[i], p[i], k[q], p[q]); }
}
__device__ constexpr int cand_i(int s) { return s < 16 ? 0 : s < 24 ? 1 : s < 29 ? 2 : s < 33 ? 3 : s < 36 ? 4 : s < 38 ? 5 : s < 40 ? 6 : s < 42 ? 7 : s < 50 ? s - 34 : -1; }
__device__ constexpr int cand_j(int s) { return s < 16 ? s : s < 24 ? s - 16 : s < 29 ? s - 24 : s < 33 ? s - 29 : s < 36 ? s - 33 : s < 38 ? s - 36 : s < 40 ? s - 38 : s < 42 ? s - 40 : s < 50 ? 0 : -1; }

__device__ __forceinline__ void peer_retrieve(const Args& a, int l, LAS unsigned char* lds, int lane, int wave, int ch) {
    const bf16* qbuf = (const bf16*)(a.ws + WS_Q); const bf16* keys = (const bf16*)(a.ws + WS_KEYS) + ((size_t)(l * 8 + wave) * 2) * 128 * 128;
    LAS int* eg_e = (LAS int*)lds; LAS float* eg_g = (LAS float*)(lds + 32768);
    const int l31 = lane & 31, l5 = lane >> 5, h = wave, t0 = ch * 64;
    for (int tt = 0; tt < 2; ++tt) {
        float sv[2][16];
#pragma unroll
        for (int p = 0; p < 2; ++p) {
            f32x16 acc[4];
#pragma unroll
            for (int nt = 0; nt < 4; ++nt)
#pragma unroll
                for (int r = 0; r < 16; ++r) acc[nt][r] = 0.f;
            const bf16* qp = qbuf + (size_t)(t0 + 32 * tt + l31) * D + h * 256 + p * 128 + 8 * l5;
            const bf16* kp = keys + (size_t)(p * 128 + l31) * 128 + 8 * l5;
#pragma unroll 4
            for (int ks = 0; ks < 8; ++ks) { const bf16x8 bq = *(const bf16x8*)(qp + 16 * ks);
#pragma unroll
                for (int nt = 0; nt < 4; ++nt) { const bf16x8 ak = *(const bf16x8*)(kp + (size_t)(32 * nt) * 128 + 16 * ks); acc[nt] = __builtin_amdgcn_mfma_f32_32x32x16_bf16(ak, bq, acc[nt], 0, 0, 0); } }
            float v[4][16];
#pragma unroll
            for (int nt = 0; nt < 4; ++nt)
#pragma unroll
                for (int r = 0; r < 16; ++r) { const unsigned idx = 32u * nt + (r & 3) + 8u * (r >> 2) + 4u * l5; v[nt][r] = __uint_as_float((__float_as_uint(acc[nt][r]) & 0xffffff80u) | idx); }
#pragma unroll
            for (int nt = 0; nt < 4; ++nt) bitonic_sort_desc<16>(v[nt]);
            merge_top16(v[0], v[1]); merge_top16(v[2], v[3]); merge_top16(v[0], v[2]);
            float o[16];
#pragma unroll
            for (int i = 0; i < 16; ++i) o[i] = __shfl_xor(v[0][i], 32);
            merge_top16(v[0], o);
#pragma unroll
            for (int i = 0; i < 16; ++i) sv[p][i] = v[0][i];
        }
        LAS unsigned char* idxb = (LAS unsigned char*)(lds + 69632) + wave * 2048 + lane * 32;
        { v4u w0, w1;
#pragma unroll
          for (int q4 = 0; q4 < 4; ++q4) {
              w0[q4] = (__float_as_uint(sv[0][4 * q4]) & 127u) | ((__float_as_uint(sv[0][4 * q4 + 1]) & 127u) << 8) | ((__float_as_uint(sv[0][4 * q4 + 2]) & 127u) << 16) | ((__float_as_uint(sv[0][4 * q4 + 3]) & 127u) << 24);
              w1[q4] = (__float_as_uint(sv[1][4 * q4]) & 127u) | ((__float_as_uint(sv[1][4 * q4 + 1]) & 127u) << 8) | ((__float_as_uint(sv[1][4 * q4 + 2]) & 127u) << 16) | ((__float_as_uint(sv[1][4 * q4 + 3]) & 127u) << 24); }
          *(LAS v4u*)(idxb) = w0; *(LAS v4u*)(idxb + 16) = w1; }
        float ck[4][16];
#pragma unroll
        for (int s = 0; s < 64; ++s) {
            if (cand_i(s) >= 0) { const unsigned b0 = __float_as_uint(sv[0][cand_i(s) < 0 ? 0 : cand_i(s)]), b1 = __float_as_uint(sv[1][cand_j(s) < 0 ? 0 : cand_j(s)]);
                const float sum = __uint_as_float(b0 & 0xffffff80u) + __uint_as_float(b1 & 0xffffff80u);
                ck[s >> 4][s & 15] = __uint_as_float((__float_as_uint(sum) & 0xffffff00u) | (unsigned)((cand_i(s) < 0 ? 0 : cand_i(s)) * 16 + (cand_j(s) < 0 ? 0 : cand_j(s)))); }
            else ck[s >> 4][s & 15] = -3.0e38f; }
        bitonic_sort_desc<16>(ck[1]); bitonic_sort_desc<16>(ck[2]);
        merge_top16(ck[0], ck[1]); merge_top16(ck[2], ck[3]); merge_top16(ck[0], ck[2]);
        LDS_WAIT(); asm volatile("" ::: "memory");
        float ex[16]; int ce[16]; float den = 0.f;
        const float cmax = __uint_as_float(__float_as_uint(ck[0][0]) & 0xffffff00u);
#pragma unroll
        for (int i = 0; i < 16; ++i) { const unsigned bits = __float_as_uint(ck[0][i]); ex[i] = __expf(__uint_as_float(bits & 0xffffff00u) - cmax); den += ex[i];
            ce[i] = (int)idxb[(bits >> 4) & 15u] * 128 + (int)idxb[16 + (bits & 15u)]; }
        const float inv = 1.0f / den;
        if (l5 == 0) {
            const int base = (32 * tt + l31) * 128 + h * 16;
#pragma unroll
            for (int i4 = 0; i4 < 4; ++i4) { *(LAS v4u*)(eg_e + base + 4 * i4) = (v4u){(unsigned)ce[4 * i4], (unsigned)ce[4 * i4 + 1], (unsigned)ce[4 * i4 + 2], (unsigned)ce[4 * i4 + 3]};
                *(LAS f32x4*)(eg_g + base + 4 * i4) = (f32x4){ex[4 * i4] * inv, ex[4 * i4 + 1] * inv, ex[4 * i4 + 2] * inv, ex[4 * i4 + 3] * inv}; }
        }
        LDS_WAIT(); asm volatile("" ::: "memory");
    }
}

typedef unsigned char uc4 __attribute__((ext_vector_type(4)));
constexpr int NSLICE = 16, SLICE_SHIFT = 10;
__device__ __forceinline__ int sdot4i(unsigned w, unsigned x, int acc) { return __builtin_amdgcn_sdot4((int)w, (int)x, acc, false); }
__device__ __forceinline__ void fma_ub4(unsigned w, float s, float& y0, float& y1, float& y2, float& y3) { const uc4 b = __builtin_bit_cast(uc4, w); y0 += s * (float)b.x; y1 += s * (float)b.y; y2 += s * (float)b.z; y3 += s * (float)b.w; }
#if TAB4
__device__ __forceinline__ void peer_tail(const Args& a, int l, int t, int lane, const bf16* Yrow, const float* mb, const float* mbn, bool last) {
    const float* x1buf = (const float*)(a.ws + WS_X1);
    float z[32];
#pragma unroll
    for (int c8 = 0; c8 < 8; ++c8) { const int col = (c8 * 64 + lane) * 4;
        const v2u yb = *(const v2u*)(Yrow + col); const f32x4 yv = (f32x4){bflo(yb.x), bfhi(yb.x), bflo(yb.y), bfhi(yb.y)};
#if RES16_X1
        const v2u xb_ = *(const v2u*)((const bf16*)x1buf + (size_t)t * D + col); const f32x4 x0 = (f32x4){bflo(xb_.x), bfhi(xb_.x), bflo(xb_.y), bfhi(xb_.y)}, g0 = *(const f32x4*)(mb + 5 * D + col);
#else
        const f32x4 x0 = *(const f32x4*)(x1buf + (size_t)t * D + col), g0 = *(const f32x4*)(mb + 5 * D + col);
#endif
        z[c8 * 4] = ALPHA * x0.x + (1.f + g0.x) * yv.x; z[c8 * 4 + 1] = ALPHA * x0.y + (1.f + g0.y) * yv.y; z[c8 * 4 + 2] = ALPHA * x0.z + (1.f + g0.z) * yv.z; z[c8 * 4 + 3] = ALPHA * x0.w + (1.f + g0.w) * yv.w; }
    ln_tail<PTSPLIT>(z, t, lane, a.in[17] + (size_t)l * D, a.in[18] + (size_t)l * D, last ? a.out : (RES16_X ? (float*)nullptr : (float*)(a.ws + WS_X)), mbn, mbn + D, (last || I8_GATE) ? (bf16*)nullptr : (bf16*)(a.ws + WS_H), nullptr, nullptr, nullptr, last ? (unsigned char*)nullptr : a.ws + WS_H8, (float*)(a.ws + WS_SAH), (RES16_X && !last) ? (bf16*)(a.ws + WS_X) : (bf16*)nullptr);
}
template <class TT, int N, int M> __device__ __forceinline__ void treduce(TT (&v)[N], int lane) {
    const bool c0 = (lane & M) != 0, c1 = (lane & (2 * M)) != 0, c2 = (lane & (4 * M)) != 0;
#pragma unroll
    for (int m = 0; m < N / 2; ++m) { const TT keep = c0 ? v[2 * m + 1] : v[2 * m], send = c0 ? v[2 * m] : v[2 * m + 1]; v[m] = keep + __shfl_xor(send, M); }
#pragma unroll
    for (int m = 0; m < N / 4; ++m) { const TT keep = c1 ? v[2 * m + 1] : v[2 * m], send = c1 ? v[2 * m] : v[2 * m + 1]; v[m] = keep + __shfl_xor(send, 2 * M); }
#pragma unroll
    for (int m = 0; m < N / 8; ++m) { const TT keep = c2 ? v[2 * m + 1] : v[2 * m], send = c2 ? v[2 * m] : v[2 * m + 1]; v[m] = keep + __shfl_xor(send, 4 * M); }
}
__device__ __forceinline__ int allsum_8_16_32(int x) {
    x += __builtin_amdgcn_update_dpp(0, x, 0x128, 0xf, 0xf, false);
    { const auto r = __builtin_amdgcn_permlane16_swap((unsigned)x, (unsigned)x, false, false); x = (int)(r[0] + r[1]); }
    { const auto r = __builtin_amdgcn_permlane32_swap((unsigned)x, (unsigned)x, false, false); x = (int)(r[0] + r[1]); }
    return x; }
__device__ __forceinline__ float allmax_8_16_32(float xf) {
    unsigned x = __float_as_uint(xf);
    { const unsigned y = (unsigned)__builtin_amdgcn_update_dpp(0, (int)x, 0x128, 0xf, 0xf, false); x = x > y ? x : y; }
    { const auto r = __builtin_amdgcn_permlane16_swap(x, x, false, false); x = r[0] > r[1] ? r[0] : r[1]; }
    { const auto r = __builtin_amdgcn_permlane32_swap(x, x, false, false); x = r[0] > r[1] ? r[0] : r[1]; }
    return __uint_as_float(x); }
__device__ __forceinline__ void treduce32x8(int (&v)[32], int lane) {
    const bool c0 = (lane & 8) != 0;
#pragma unroll
    for (int m = 0; m < 16; ++m) { const int keep = c0 ? v[2 * m + 1] : v[2 * m], send = c0 ? v[2 * m] : v[2 * m + 1]; v[m] = keep + __builtin_amdgcn_update_dpp(0, send, 0x128, 0xf, 0xf, false); }
#pragma unroll
    for (int m = 0; m < 8; ++m) { const auto r = __builtin_amdgcn_permlane16_swap((unsigned)v[2 * m], (unsigned)v[2 * m + 1], false, false); v[m] = (int)(r[0] + r[1]); }
#pragma unroll
    for (int m = 0; m < 4; ++m) { const auto r = __builtin_amdgcn_permlane32_swap((unsigned)v[2 * m], (unsigned)v[2 * m + 1], false, false); v[m] = (int)(r[0] + r[1]); }
}
__device__ __forceinline__ void tr4x4(unsigned a, unsigned b, unsigned c, unsigned d, unsigned& t0, unsigned& t1, unsigned& t2, unsigned& t3) {
    const unsigned x0 = __builtin_amdgcn_perm(b, a, 0x05010400u), x1 = __builtin_amdgcn_perm(b, a, 0x07030602u), y0 = __builtin_amdgcn_perm(d, c, 0x05010400u), y1 = __builtin_amdgcn_perm(d, c, 0x07030602u);
    t0 = __builtin_amdgcn_perm(y0, x0, 0x05040100u); t1 = __builtin_amdgcn_perm(y0, x0, 0x07060302u); t2 = __builtin_amdgcn_perm(y1, x1, 0x05040100u); t3 = __builtin_amdgcn_perm(y1, x1, 0x07060302u);
}
__device__ __forceinline__ int sdot4z(unsigned w, unsigned x) { int d; asm("v_dot4_i32_i8 %0, %1, %2, 0" : "=v"(d) : "v"(w), "v"(x)); return d; }
__device__ __forceinline__ int sdot8i(unsigned w, unsigned x, int acc) { return __builtin_amdgcn_sdot8((int)w, (int)x, acc, false); }
__device__ __forceinline__ float slot_scale(unsigned w3) { return __builtin_amdgcn_exp2f((float)(w3 >> 24) * 0.125f - 16.0f); }
__device__ __forceinline__ void peer_experts(const Args& a, int l, LAS unsigned char* lds, int lane0, int wave, int ch) {
    const float* mod = (const float*)(a.ws + WS_MOD);
    const unsigned char* ut = a.ws + WS_UT + (size_t)l * NE * 1152; const unsigned char* vt = a.ws + WS_VT + (size_t)l * NE * 1152; const unsigned char* hq8 = a.ws + WS_HQ8;
    const float* hsc = (const float*)(a.ws + WS_HSC);
    bf16* Ybuf = (bf16*)(a.ws + WS_Z);
    const LAS int* eg_e = (const LAS int*)lds; LAS float* sw = (LAS float*)(lds + 32768);
    LAS float* apart = (LAS float*)(lds + 65536);
    const int b = ch / NCH; const bool last = (l == NL - 1);
    const float* mb = mod + ((size_t)l * NB + b) * 6 * D; const float* mbn = mod + ((size_t)(last ? l : l + 1) * NB + b) * 6 * D;
    const int tlw = wave * 8;
    { const int lane = lane0;
#pragma unroll
      for (int i = 0; i < 16; ++i) apart[tlw * 128 + i * 64 + lane] = 0.f; }
    LDS_WAIT(); asm volatile("" ::: "memory");
    {
        int laneL = lane0; asm volatile("" : "+v"(laneL)); const int lane = laneL;
        const int g = lane >> 3, l7 = lane & 7;
        v4u bufA[16], bufB[16], hA0, hA1, hB0, hB1;
#define CU_LOAD(buf, h0_, h1_, idx_) do { const int u_ = (idx_) >> 3, tl_ = tlw + ((idx_) & 7); const unsigned soff_ = (unsigned)(u_ * 128 + l7 * 16); \
            const unsigned char* hp_ = hq8 + (size_t)(ch * 64 + tl_) * 2304 + (u_ * 8 + l7) * 32; h0_ = *(const v4u*)hp_; h1_ = *(const v4u*)(hp_ + 16); \
            _Pragma("unroll") for (int i_ = 0; i_ < 16; ++i_) { const unsigned e_ = (unsigned)eg_e[tl_ * 128 + 8 * i_ + g]; buf[i_] = *(const v4u*)(ut + (size_t)(e_ * 1152u + soff_)); } } while (0)
#define CU_COMP(buf, h0_, h1_, idx_) do { const int tl_ = tlw + ((idx_) & 7); float accv_[16]; \
            _Pragma("unroll") for (int i_ = 0; i_ < 16; ++i_) { int sl_ = 0, sh_ = 0; \
                _Pragma("unroll") for (int d_ = 0; d_ < 4; ++d_) { const unsigned x_ = buf[i_][d_]; sl_ = sdot8i(x_, h0_[d_], sl_); sh_ = sdot8i(x_, h1_[d_], sh_); } \
                accv_[i_] = slot_scale(buf[i_][3]) * (float)(16 * sh_ + sl_); } \
            treduce<float, 16, 1>(accv_, lane); \
            apart[tl_ * 128 + 8 * l7 + g] += accv_[0]; apart[tl_ * 128 + 8 * (8 + l7) + g] += accv_[1]; } while (0)
        CU_LOAD(bufA, hA0, hA1, 0);
        for (int idx = 0; idx < 72; idx += 2) {
            CU_LOAD(bufB, hB0, hB1, idx + 1);
            CU_COMP(bufA, hA0, hA1, idx);
            { const int nx_ = idx + 2 < 72 ? idx + 2 : 71; CU_LOAD(bufA, hA0, hA1, nx_); }
            CU_COMP(bufB, hB0, hB1, idx + 1);
        }
#undef CU_LOAD
#undef CU_COMP
        LDS_WAIT(); asm volatile("" ::: "memory");
        for (int it = 0; it < 8; ++it) { const int tl = tlw + it; const float shs = hsc[ch * 64 + tl];
            const float w0 = sw[tl * 128 + lane] * gelu_tanh_f(apart[tl * 128 + lane] * shs), w1 = sw[tl * 128 + 64 + lane] * gelu_tanh_f(apart[tl * 128 + 64 + lane] * shs);
            sw[tl * 128 + lane] = w0; sw[tl * 128 + 64 + lane] = w1; }
        LDS_WAIT(); asm volatile("" ::: "memory");
    }
    {
        int laneL = lane0; asm volatile("" : "+v"(laneL)); const int lane = laneL;
        const int g = lane >> 3, l7 = lane & 7;
        v4u bufA[16], bufB[16];
#define CV_LOAD(buf, idx_) do { const int u_ = (idx_) >> 3, tl_ = tlw + ((idx_) & 7); const unsigned soff_ = (unsigned)(u_ * 128 + l7 * 16); \
            _Pragma("unroll") for (int i_ = 0; i_ < 16; ++i_) { const unsigned e_ = (unsigned)eg_e[tl_ * 128 + 8 * i_ + g]; buf[i_] = *(const v4u*)(vt + (size_t)(e_ * 1152u + soff_)); } } while (0)
#define CV_COMP(buf, idx_) do { const int u_ = (idx_) >> 3, tl_ = tlw + ((idx_) & 7); \
            float wf_[16]; float wmx_ = 0.f; \
            _Pragma("unroll") for (int i_ = 0; i_ < 16; ++i_) { wf_[i_] = sw[tl_ * 128 + 8 * i_ + g] * slot_scale(buf[i_][3]); wmx_ = fmaxf(wmx_, fabsf(wf_[i_])); } \
            wmx_ = allmax_8_16_32(wmx_);     \
            const float winv_ = wmx_ > 0.f ? 127.0f * __builtin_amdgcn_rcpf(wmx_) : 0.f, wsc_ = wmx_ * (1.0f / 127.0f); \
              \
            unsigned wq4_[4]; int wsum_ = 0; \
            _Pragma("unroll") for (int gp_ = 0; gp_ < 4; ++gp_) { \
                const unsigned m0_ = __float_as_uint(wf_[4 * gp_] * winv_ + 12582912.0f), m1_ = __float_as_uint(wf_[4 * gp_ + 1] * winv_ + 12582912.0f), m2_ = __float_as_uint(wf_[4 * gp_ + 2] * winv_ + 12582912.0f), m3_ = __float_as_uint(wf_[4 * gp_ + 3] * winv_ + 12582912.0f); \
                wq4_[gp_] = __builtin_amdgcn_perm(__builtin_amdgcn_perm(m3_, m2_, 0x0c0c0400u), __builtin_amdgcn_perm(m1_, m0_, 0x0c0c0400u), 0x05040100u); \
                wsum_ = sdot4i(wq4_[gp_], 0x01010101u, wsum_); } \
            int yi_[32]; \
            _Pragma("unroll") for (int gp_ = 0; gp_ < 4; ++gp_) { \
                _Pragma("unroll") for (int d_ = 0; d_ < 4; ++d_) { const unsigned A_ = buf[4 * gp_][d_], B_ = buf[4 * gp_ + 1][d_], C_ = buf[4 * gp_ + 2][d_], D_ = buf[4 * gp_ + 3][d_]; \
                    unsigned t0_, t1_, t2_, t3_; \
                    tr4x4(A_, B_, C_, D_, t0_, t1_, t2_, t3_);     \
                      \
                    yi_[8 * d_ + 0] = gp_ == 0 ? sdot4z(t0_ & 0x0f0f0f0fu, wq4_[gp_]) : sdot4i(t0_ & 0x0f0f0f0fu, wq4_[gp_], yi_[8 * d_ + 0]); yi_[8 * d_ + 0 + 1] = gp_ == 0 ? sdot4z(t0_, wq4_[gp_]) : sdot4i(t0_, wq4_[gp_], yi_[8 * d_ + 0 + 1]); \
                    yi_[8 * d_ + 2] = gp_ == 0 ? sdot4z(t1_ & 0x0f0f0f0fu, wq4_[gp_]) : sdot4i(t1_ & 0x0f0f0f0fu, wq4_[gp_], yi_[8 * d_ + 2]); yi_[8 * d_ + 2 + 1] = gp_ == 0 ? sdot4z(t1_, wq4_[gp_]) : sdot4i(t1_, wq4_[gp_], yi_[8 * d_ + 2 + 1]); \
                    yi_[8 * d_ + 4] = gp_ == 0 ? sdot4z(t2_ & 0x0f0f0f0fu, wq4_[gp_]) : sdot4i(t2_ & 0x0f0f0f0fu, wq4_[gp_], yi_[8 * d_ + 4]); yi_[8 * d_ + 4 + 1] = gp_ == 0 ? sdot4z(t2_, wq4_[gp_]) : sdot4i(t2_, wq4_[gp_], yi_[8 * d_ + 4 + 1]); \
                    yi_[8 * d_ + 6] = gp_ == 0 ? sdot4z(t3_ & 0x0f0f0f0fu, wq4_[gp_]) : sdot4i(t3_ & 0x0f0f0f0fu, wq4_[gp_], yi_[8 * d_ + 6]); yi_[8 * d_ + 6 + 1] = gp_ == 0 ? sdot4z(t3_, wq4_[gp_]) : sdot4i(t3_, wq4_[gp_], yi_[8 * d_ + 6 + 1]);  } } \
            _Pragma("unroll") for (int p_ = 0; p_ < 16; ++p_) yi_[2 * p_ + 1] = (yi_[2 * p_ + 1] - yi_[2 * p_]) >> 4; \
            treduce32x8(yi_, lane); \
            wsum_ = allsum_8_16_32(wsum_);     \
            float y_[4]; \
            { const int corr_ = (g & 1) ? 0 : 8 * wsum_;     \
              _Pragma("unroll") for (int q_ = 0; q_ < 4; ++q_) y_[q_] = wsc_ * (float)(yi_[q_] - corr_); } \
            { const int colb_ = u_ * 240 + l7 * 30 + g; bf16* yr_ = Ybuf + (size_t)(ch * 64 + tl_) * D + colb_; \
              _Pragma("unroll") for (int m_ = 0; m_ < 4; ++m_) if (8 * m_ + g < 30 && colb_ + 8 * m_ < D) yr_[8 * m_] = (bf16)(pk2(y_[m_], 0.f) & 0xffffu); } } while (0)
        CV_LOAD(bufA, 0);
        for (int idx = 0; idx < 72; idx += 2) {
            CV_LOAD(bufB, idx + 1);
            CV_COMP(bufA, idx);
            { const int nx_ = idx + 2 < 72 ? idx + 2 : 71; CV_LOAD(bufA, nx_); }
            CV_COMP(bufB, idx + 1);
        }
#undef CV_LOAD
#undef CV_COMP
    }
    asm volatile("s_waitcnt vmcnt(0)" ::: "memory");
    __builtin_amdgcn_fence(__ATOMIC_ACQUIRE, "agent");
    asm volatile("s_waitcnt vmcnt(0)" ::: "memory");
    for (int it = 0; it < 8; ++it) { int laneT = lane0; asm volatile("" : "+v"(laneT)); const int t = ch * 64 + tlw + it;
        peer_tail(a, l, t, laneT, Ybuf + (size_t)t * D, mb, mbn, last); }
}
#else
__device__ __forceinline__ void peer_tail(const Args& a, int l, int t, int lane, const float* Yrow, const float* mb, const float* mbn, bool last) {
    const float* x1buf = (const float*)(a.ws + WS_X1);
    float z[32];
#pragma unroll
    for (int c = 0; c < 2; ++c)
#pragma unroll
        for (int k = 0; k < 4; ++k) { const int c8 = 4 * c + k, col = (c8 * 64 + lane) * 4;
            const v2u yb = *(const v2u*)((const bf16*)Yrow + (c * 64 + lane) * 16 + 4 * k); const f32x4 yv = (f32x4){bflo(yb.x), bfhi(yb.x), bflo(yb.y), bfhi(yb.y)};
#if RES16_X1
            const v2u xb_ = *(const v2u*)((const bf16*)x1buf + (size_t)t * D + col); const f32x4 x0 = (f32x4){bflo(xb_.x), bfhi(xb_.x), bflo(xb_.y), bfhi(xb_.y)}, g0 = *(const f32x4*)(mb + 5 * D + col);
#else
            const f32x4 x0 = *(const f32x4*)(x1buf + (size_t)t * D + col), g0 = *(const f32x4*)(mb + 5 * D + col);
#endif
            z[c8 * 4] = ALPHA * x0.x + (1.f + g0.x) * yv.x; z[c8 * 4 + 1] = ALPHA * x0.y + (1.f + g0.y) * yv.y; z[c8 * 4 + 2] = ALPHA * x0.z + (1.f + g0.z) * yv.z; z[c8 * 4 + 3] = ALPHA * x0.w + (1.f + g0.w) * yv.w; }
    ln_tail<PTSPLIT>(z, t, lane, a.in[17] + (size_t)l * D, a.in[18] + (size_t)l * D, last ? a.out : (RES16_X ? (float*)nullptr : (float*)(a.ws + WS_X)), mbn, mbn + D, (last || I8_GATE) ? (bf16*)nullptr : (bf16*)(a.ws + WS_H), nullptr, nullptr, nullptr, last ? (unsigned char*)nullptr : a.ws + WS_H8, (float*)(a.ws + WS_SAH), (RES16_X && !last) ? (bf16*)(a.ws + WS_X) : (bf16*)nullptr);
}
template <class TT, int M> __device__ __forceinline__ void treduce16(TT (&v)[16], int lane) {
    const bool c0 = (lane & M) != 0, c1 = (lane & (2 * M)) != 0, c2 = (lane & (4 * M)) != 0;
#pragma unroll
    for (int m = 0; m < 8; ++m) { const TT keep = c0 ? v[2 * m + 1] : v[2 * m], send = c0 ? v[2 * m] : v[2 * m + 1]; v[m] = keep + __shfl_xor(send, M); }
#pragma unroll
    for (int m = 0; m < 4; ++m) { const TT keep = c1 ? v[2 * m + 1] : v[2 * m], send = c1 ? v[2 * m] : v[2 * m + 1]; v[m] = keep + __shfl_xor(send, 2 * M); }
#pragma unroll
    for (int m = 0; m < 2; ++m) { const TT keep = c2 ? v[2 * m + 1] : v[2 * m], send = c2 ? v[2 * m] : v[2 * m + 1]; v[m] = keep + __shfl_xor(send, 4 * M); }
}
__device__ __forceinline__ void peer_experts(const Args& a, int l, LAS unsigned char* lds, int lane0, int wave, int ch) {
    const float* mod = (const float*)(a.ws + WS_MOD);
    const unsigned char* ut = a.ws + WS_UT + (size_t)l * NE * D; const unsigned char* vt = a.ws + WS_VT + (size_t)l * NE * D; const unsigned char* hq8 = a.ws + WS_HQ8;
    const float* su = (const float*)(a.ws + WS_SU) + (size_t)l * NE; const float* sv = (const float*)(a.ws + WS_SV) + (size_t)l * NE; const float* hsc = (const float*)(a.ws + WS_HSC);
    float* Ybuf = (float*)(a.ws + WS_Z);
    const LAS int* eg_e = (const LAS int*)lds; LAS float* sw = (LAS float*)(lds + 32768);
    LAS int* apart = (LAS int*)(lds + 65536); LAS float* wtotl = (LAS float*)(lds + LDSCTL_OFF + 256);
    const int b = ch / NCH; const bool last = (l == NL - 1);
    const float* mb = mod + ((size_t)l * NB + b) * 6 * D; const float* mbn = mod + ((size_t)(last ? l : l + 1) * NB + b) * 6 * D;
    const int tlw = wave * 8;
    { const int lane = lane0;
#pragma unroll
      for (int i = 0; i < 16; ++i) apart[tlw * 128 + i * 64 + lane] = 0; }
    LDS_WAIT(); asm volatile("" ::: "memory");
    {
        int laneL = lane0; asm volatile("" : "+v"(laneL)); const int lane = laneL;
        const int g = lane >> 3, l7 = lane & 7;
        v4u bufA[16], bufB[16], hA, hB;
#define CU_LOAD(buf, hh_, idx_) do { const int cs_ = (idx_) >> 3, tl_ = tlw + ((idx_) & 7); const unsigned coff_ = (unsigned)(cs_ * 128 + l7 * 16); \
            hh_ = *(const v4u*)(hq8 + (size_t)(ch * 64 + tl_) * D + coff_); \
            _Pragma("unroll") for (int i_ = 0; i_ < 16; ++i_) { const unsigned e_ = (unsigned)eg_e[tl_ * 128 + 8 * i_ + g]; buf[i_] = *(const v4u*)(ut + (size_t)(e_ * 2048u + coff_)); } } while (0)
#define CU_COMP(buf, hh_, idx_) do { const int tl_ = tlw + ((idx_) & 7); int acc_[16]; \
            _Pragma("unroll") for (int i_ = 0; i_ < 16; ++i_) { int s_ = 0; _Pragma("unroll") for (int q_ = 0; q_ < 4; ++q_) s_ = sdot4i(buf[i_][q_], hh_[q_], s_); acc_[i_] = s_; } \
            treduce16<int, 1>(acc_, lane); \
            apart[tl_ * 128 + 8 * l7 + g] += acc_[0]; apart[tl_ * 128 + 8 * (8 + l7) + g] += acc_[1]; } while (0)
        CU_LOAD(bufA, hA, 0);
        for (int idx = 0; idx < 128; idx += 2) {
            CU_LOAD(bufB, hB, idx + 1);
            CU_COMP(bufA, hA, idx);
            if (idx + 2 < 128) CU_LOAD(bufA, hA, idx + 2);
            CU_COMP(bufB, hB, idx + 1);
        }
#undef CU_LOAD
#undef CU_COMP
        LDS_WAIT(); asm volatile("" ::: "memory");
        for (int it = 0; it < 8; ++it) { const int tl = tlw + it; const float shs = hsc[ch * 64 + tl];
            const int e0 = eg_e[tl * 128 + lane], e1 = eg_e[tl * 128 + 64 + lane];
            const float w0 = sw[tl * 128 + lane] * gelu_tanh_f((float)apart[tl * 128 + lane] * su[e0] * shs) * sv[e0];
            const float w1 = sw[tl * 128 + 64 + lane] * gelu_tanh_f((float)apart[tl * 128 + 64 + lane] * su[e1] * shs) * sv[e1];
            sw[tl * 128 + lane] = w0; sw[tl * 128 + 64 + lane] = w1;
            const float ws = wave_sum(w0 + w1);
            if (lane == 0) wtotl[tl] = ws; }
        LDS_WAIT(); asm volatile("" ::: "memory");
    }
    {
        int laneL = lane0; asm volatile("" : "+v"(laneL)); const int lane = laneL;
        const int g = lane >> 3, l7 = lane & 7;
        v4u bufA[16], bufB[16];
#define CV_LOAD(buf, idx_) do { const int cs_ = (idx_) >> 3, tl_ = tlw + ((idx_) & 7); const unsigned coff_ = (unsigned)(cs_ * 128 + l7 * 16); \
            _Pragma("unroll") for (int i_ = 0; i_ < 16; ++i_) { const unsigned e_ = (unsigned)eg_e[tl_ * 128 + 8 * i_ + g]; buf[i_] = *(const v4u*)(vt + (size_t)(e_ * 2048u + coff_)); } } while (0)
#define CV_COMP(buf, idx_) do { const int cs_ = (idx_) >> 3, tl_ = tlw + ((idx_) & 7); float y_[16]; \
            _Pragma("unroll") for (int q_ = 0; q_ < 16; ++q_) y_[q_] = 0.f; \
            _Pragma("unroll") for (int i_ = 0; i_ < 16; ++i_) { const float wr_ = sw[tl_ * 128 + 8 * i_ + g]; \
                _Pragma("unroll") for (int q_ = 0; q_ < 4; ++q_) fma_ub4(buf[i_][q_], wr_, y_[4 * q_], y_[4 * q_ + 1], y_[4 * q_ + 2], y_[4 * q_ + 3]); } \
            treduce16<float, 8>(y_, lane); \
            const float woff_ = 128.0f * wtotl[tl_]; bf16* yr_ = (bf16*)Ybuf + (size_t)(ch * 64 + tl_) * D + cs_ * 128 + l7 * 16 + g; \
            yr_[0] = (bf16)(pk2(y_[0] - woff_, 0.f) & 0xffffu); yr_[8] = (bf16)(pk2(y_[1] - woff_, 0.f) & 0xffffu); } while (0)
        CV_LOAD(bufA, 0);
        for (int idx = 0; idx < 128; idx += 2) {
            CV_LOAD(bufB, idx + 1);
            CV_COMP(bufA, idx);
            if (idx + 2 < 128) CV_LOAD(bufA, idx + 2);
            CV_COMP(bufB, idx + 1);
        }
#undef CV_LOAD
#undef CV_COMP
    }
    asm volatile("s_waitcnt vmcnt(0)" ::: "memory");
    __builtin_amdgcn_fence(__ATOMIC_ACQUIRE, "agent");
    asm volatile("s_waitcnt vmcnt(0)" ::: "memory");
    for (int it = 0; it < 8; ++it) { int laneT = lane0; asm volatile("" : "+v"(laneT)); const int t = ch * 64 + tlw + it;
        peer_tail(a, l, t, laneT, (const float*)((const bf16*)Ybuf + (size_t)t * D), mb, mbn, last); }
}

#endif

#ifndef MK_PER_PHASE
#define MK_PER_PHASE 0
#endif
__global__ void __launch_bounds__(NTHREADS, 2) mk_fwd(Args a) {
    extern __shared__ __attribute__((aligned(16))) unsigned char lds_raw[];
    LAS unsigned char* lds = (LAS unsigned char*)lds_raw;
    const int tid = threadIdx.x, lane = tid & 63, wave = __builtin_amdgcn_readfirstlane(tid >> 6), G = gridDim.x, bx = blockIdx.x;
    if (tid < 64) ((LAS unsigned*)(lds + LDSCTL_OFF))[tid] = 0u;
    __syncthreads();
    unsigned* ctl = (unsigned*)(a.ws + WS_CTL);
    XcdBarrier bar; bar.bar = ctl + CW_BAR; bar.x = 0; bar.st = nullptr;
    const bool use_bar = (a.ph_hi - a.ph_lo) > 1;
    if (use_bar) bar = xcd_barrier_post(ctl + CW_BAR, (volatile LAS unsigned*)(lds + LDSCTL_OFF));
    const int lo = a.ph_lo, hi = a.ph_hi;
#ifndef PH_MASK
#define PH_MASK 0x1ff
#endif
#define IN(k) (lo <= (k) && (k) < hi)
#define EN(b) ((PH_MASK >> (b)) & 1)
#ifndef REP_MASK
#define REP_MASK 0
#endif
#ifndef REP_EXTRA
#define REP_EXTRA 2
#endif
#define REPS(b) (1 + ((REP_MASK >> (b)) & 1) * REP_EXTRA)
#define REP_BEGIN(b) for (int rep_ = 0; rep_ < REPS(b); ++rep_) {
#define REP_END(b) if (rep_ + 1 < REPS(b)) xcd_barrier(bar); }
#define SEAM(k) do { if (IN((k) + 1)) xcd_barrier(bar); } while (0)
#define PHASE_IDS() int tidp = tid; asm volatile("" : "+v"(tidp)); const int lanep = tidp & 63, wavep = __builtin_amdgcn_readfirstlane(tidp >> 6); (void)lanep; (void)wavep
    if (EN(0) && IN(0)) { REP_BEGIN(0) PHASE_IDS(); ph_prologue_a(a, lds, tidp, lanep, wavep, bx, G); REP_END(0) SEAM(0); }
    if (EN(1) && IN(1)) { REP_BEGIN(1) PHASE_IDS(); ph_prologue_b(a, lds, tidp, lanep, wavep, bx, G); REP_END(1) SEAM(1); }
    for (int l = 0; l < NL; ++l) {
        const int pb = 2 + 7 * l;
        const float* mod = (const float*)(a.ws + WS_MOD);
        if (EN(2) && IN(pb + 0)) {
            REP_BEGIN(2) PHASE_IDS();
#if I8_IN
            pg8::Gemm g{(const pg8::bf16_t*)(a.ws + WS_H8), (const pg8::bf16_t*)(a.ws + WS_WIN8 + (size_t)l * NP * D), T, NP, D / 2}; pg8::StaticOrder S; S.init(T, NP, G, bx, WGM_IN, KROT(bx));
            pg8::EpiBf16PS E{(pg8::bf16_t*)(a.ws + WS_PROJ), NP, (const float*)(a.ws + WS_SAH), (const float*)(a.ws + WS_SB) + l * SBL};
            pg8::gemm_phase<pg8::EpiBf16PS, pg8::StaticOrder, true, true, true>(lds + RING_OFF, g, S, E, tidp);
#else
            pg8::Gemm g{(const pg8::bf16_t*)(a.ws + WS_H), (const pg8::bf16_t*)(a.ws + WS_WIN) + (size_t)l * INW * D, T, NP, D}; pg8::StaticOrder S; S.init(T, NP, G, bx, WGM_IN, KROT(bx));
            pg8::EpiBf16P E{(pg8::bf16_t*)(a.ws + WS_PROJ), NP};
            pg8::gemm_phase<pg8::EpiBf16P, pg8::StaticOrder, true, true>(lds + RING_OFF, g, S, E, tidp);
#endif
#ifndef GP_REP
#define GP_REP 1
#endif
            for (int gpr_ = 0; gpr_ < GP_REP; ++gpr_) for (int ch = bx; ch < NCHUNK; ch += G) gate_prep(a, l, lds, tidp, lanep, wavep, ch);
            REP_END(2) SEAM(pb + 0);
        }
        if (EN(3) && IN(pb + 1)) { REP_BEGIN(3) PHASE_IDS(); for (int un = bx; un < 256; un += G) gla_unit(a, lds, tidp, lanep, wavep, un); REP_END(3) SEAM(pb + 1); }
        if (EN(4) && IN(pb + 2)) { REP_BEGIN(4) PHASE_IDS(); for (int ch = bx; ch < NCHUNK; ch += G) mixpost_chunk(a, l, lanep, wavep, ch); REP_END(4) SEAM(pb + 2); }
        if (EN(5) && IN(pb + 3)) {
            REP_BEGIN(5) PHASE_IDS();
#if I8_OUT
            pg8::Gemm g{(const pg8::bf16_t*)(a.ws + WS_Y8), (const pg8::bf16_t*)(a.ws + WS_WOUT8 + (size_t)l * D * D), T, D, D / 2}; pg8::StaticOrder S; S.init(T, D, G, bx, WGM_OUT, KROT(bx));
#if RES16_X || RES16_Z
            pg8::EpiResidS16<(RES16_X != 0), (RES16_Z != 0)> E{(void*)(a.ws + WS_Z), (RES16_X || l > 0) ? (const void*)(a.ws + WS_X) : (const void*)a.in[0], mod + (size_t)l * NB * 6 * D + 2 * D, (const float*)(a.ws + WS_SAY), (const float*)(a.ws + WS_SB) + l * SBL + NP, ALPHA};
            pg8::gemm_phase<pg8::EpiResidS16<(RES16_X != 0), (RES16_Z != 0)>, pg8::StaticOrder, true, true, true>(lds + RING_OFF, g, S, E, tidp);
#else
            pg8::EpiResidS E{(float*)(a.ws + WS_Z), l == 0 ? a.in[0] : (const float*)(a.ws + WS_X), mod + (size_t)l * NB * 6 * D + 2 * D, (const float*)(a.ws + WS_SAY), (const float*)(a.ws + WS_SB) + l * SBL + NP, ALPHA};
            pg8::gemm_phase<pg8::EpiResidS, pg8::StaticOrder, true, true, true>(lds + RING_OFF, g, S, E, tidp);
#endif
#else
            pg8::Gemm g{(const pg8::bf16_t*)(a.ws + WS_Y), (const pg8::bf16_t*)(a.ws + WS_WOUT) + (size_t)l * D * D, T, D, D}; pg8::StaticOrder S; S.init(T, D, G, bx, WGM_OUT, KROT(bx));
            pg8::EpiResid E{(float*)(a.ws + WS_Z), l == 0 ? a.in[0] : (const float*)(a.ws + WS_X), mod + (size_t)l * NB * 6 * D + 2 * D, ALPHA};
            pg8::gemm_phase<pg8::EpiResid, pg8::StaticOrder, true, true>(lds + RING_OFF, g, S, E, tidp);
#endif
            REP_END(5) SEAM(pb + 3);
        }
        if (EN(6) && IN(pb + 4)) { REP_BEGIN(6) PHASE_IDS(); for (int ch = bx; ch < NCHUNK; ch += G) ln1_chunk(a, l, lds, lanep, wavep, ch); REP_END(6) SEAM(pb + 4); }
        if (EN(7) && IN(pb + 5)) {
            REP_BEGIN(7) PHASE_IDS();
#if I8_WQ
            pg8::Gemm g{(const pg8::bf16_t*)(a.ws + WS_H28), (const pg8::bf16_t*)(a.ws + WS_WQ8 + (size_t)l * D * D), T, D, D / 2}; pg8::StaticOrder S; S.init(T, D, G, bx, WGM_WQ, KROT(bx));
            pg8::EpiBf16PS E{(pg8::bf16_t*)(a.ws + WS_Q), D, (const float*)(a.ws + WS_HSC), (const float*)(a.ws + WS_SB) + l * SBL + NP + D};
            pg8::gemm_phase<pg8::EpiBf16PS, pg8::StaticOrder, true, true, true>(lds + RING_OFF, g, S, E, tidp);
#else
            pg8::Gemm g{(const pg8::bf16_t*)(a.ws + WS_H2), (const pg8::bf16_t*)(a.ws + WS_WQ) + (size_t)l * D * D, T, D, D}; pg8::StaticOrder S; S.init(T, D, G, bx, WGM_WQ, KROT(bx));
            pg8::EpiBf16P E{(pg8::bf16_t*)(a.ws + WS_Q), D};
            pg8::gemm_phase<pg8::EpiBf16P, pg8::StaticOrder, true, true>(lds + RING_OFF, g, S, E, tidp);
#endif
            REP_END(7) SEAM(pb + 5);
        }
#ifndef PEER_DBG
#define PEER_DBG 0
#endif
#ifndef PE_REP_R
#define PE_REP_R 1
#endif
#ifndef L2PROBE
#define L2PROBE 0
#endif
        if (EN(8) && IN(pb + 6)) {
            REP_BEGIN(8)
            for (int ch = bx; ch < NCHUNK; ch += G) { for (int repr_ = 0; repr_ < PE_REP_R; ++repr_) { PHASE_IDS(); peer_retrieve(a, l, lds, lanep, wavep, ch); __syncthreads(); } __syncthreads(); { PHASE_IDS(); peer_experts(a, l, lds, lanep, wavep, ch); } __syncthreads(); }
            REP_END(8) SEAM(pb + 6);
        }
    }
#undef IN
#undef SEAM
}

extern "C" void kernel_launch(void* const* d_in, const int* in_sizes, int n_in, void* d_out, int out_size, void* d_ws, size_t ws_size, hipStream_t stream) {
    static int grid = 0;
    if (grid == 0) {
        if (n_in != 19 || in_sizes[0] != T * D || out_size != T * D || ws_size < WS_END) { fprintf(stderr, "kernel_launch: unexpected shapes / workspace (%d inputs, ws %zu); nothing launched\n", n_in, ws_size); grid = -1; return; }
        int dev = 0, cus = 0, per_cu = 0;
        if (hipGetDevice(&dev) != hipSuccess || hipDeviceGetAttribute(&cus, hipDeviceAttributeMultiprocessorCount, dev) != hipSuccess) { grid = -1; return; }
        if (hipFuncSetAttribute((const void*)mk_fwd, hipFuncAttributeMaxDynamicSharedMemorySize, LDS_BYTES) != hipSuccess) { fprintf(stderr, "kernel_launch: hipFuncSetAttribute failed\n"); grid = -1; return; }
        if (hipOccupancyMaxActiveBlocksPerMultiprocessor(&per_cu, (const void*)mk_fwd, NTHREADS, LDS_BYTES) != hipSuccess || per_cu < 1) fprintf(stderr, "kernel_launch: occupancy query reports %d\n", per_cu);
        (void)hipGetLastError();
        grid = cus;
    }
    if (grid < 0) return;
    if (hipMemsetAsync((char*)d_ws + WS_CTL, 0, CTL_ZERO_BYTES, stream) != hipSuccess) return;
    Args a{};
    for (int i = 0; i < 19; ++i) a.in[i] = (const float*)d_in[i];
    a.out = (float*)d_out; a.ws = (unsigned char*)d_ws;
#if MK_PER_PHASE
    for (int p = 0; p < NPHASES; ++p) { a.ph_lo = p; a.ph_hi = p + 1; hipLaunchKernelGGL(mk_fwd, dim3(grid), dim3(NTHREADS), LDS_BYTES, stream, a); }
#else
    a.ph_lo = 0; a.ph_hi = NPHASES;
    hipLaunchKernelGGL(mk_fwd, dim3(grid), dim3(NTHREADS), LDS_BYTES, stream, a);
#endif
}
```
